# Optimizing an MI355X kernel written in HIP

```python
import math
import jax
import jax.numpy as jnp
from jax import lax

D_MODEL = 1024
BATCH = 8
SEQ = 4096
DEPTH = 4

GRID_W = 64
CTX_LEN = 256
N_EVEN = (DEPTH + 1) // 2
N_ODD = DEPTH // 2

MLSTM_HEADS = 4
MLSTM_DQK = 64
MLSTM_DV = 128
MLSTM_CHUNK = 64
HGRN_HEADS = 4
HGRN_DK = 128
HGRN_DV = 128
HGRN_CHUNK = 32
HYENA_WIDTH = 512
HYENA_GROUPS = 8
HYENA_ORDER = 2
HYENA_EMB = 33
HYENA_FILTER_HIDDEN = 64
HYENA_SHORT = 3
HYENA_TARGET = 1e-2
HYENA_FAST_PCT = 0.3
HYENA_SLOW_PCT = 1.5
RET_HEADS = 4
RET_DQK = 128
RET_DV = 128
RET_CHUNK = 64
ROPE_BASE = 10000.0
N_EXPERTS = 64
TOP_K = 8
EXPERT_HIDDEN = 256
SHARED_HIDDEN = 256
ROUTED_SCALE = 2.5
MOE_BLOCK = 128
DEEPNORM_ALPHA = (2 * DEPTH) ** 0.25
DEEPNORM_BETA = (8 * DEPTH) ** -0.25
EPS = 1e-5
NEG_BIG = -1e30

MLSTM_SPLITS = (MLSTM_HEADS * MLSTM_DQK, MLSTM_HEADS * MLSTM_DQK, MLSTM_HEADS * MLSTM_DV, MLSTM_HEADS * MLSTM_DV, 4 * MLSTM_HEADS)
HGRN_SPLITS = (HGRN_HEADS * HGRN_DK, HGRN_HEADS * HGRN_DV, HGRN_HEADS * HGRN_DK, HGRN_HEADS * HGRN_DK, HGRN_HEADS * HGRN_DV)
EVEN_SPLITS = MLSTM_SPLITS + HGRN_SPLITS
EVEN_PROJ = sum(EVEN_SPLITS)
EVEN_MIX = MLSTM_HEADS * MLSTM_DV + HGRN_HEADS * HGRN_DV
RET_SPLITS = (RET_HEADS * RET_DQK, RET_HEADS * RET_DQK, RET_HEADS * RET_DV, RET_HEADS * RET_DV)
ODD_SPLITS = ((HYENA_ORDER + 1) * HYENA_WIDTH,) + RET_SPLITS
ODD_PROJ = sum(ODD_SPLITS)
ODD_MIX = HYENA_WIDTH + RET_HEADS * RET_DV

F32 = jnp.float32

kernel_name = 'hybrid_mlstm_hgrn2_hyena_retention_moe'


def split_cols(a, sizes):
    out, start = [], 0
    for s in sizes:
        out.append(a[..., start:start + s])
        start += s
    return out


def to_heads(a, n_heads):
    b, l, w = a.shape
    return a.reshape(b, l, n_heads, w // n_heads).transpose(0, 2, 1, 3)


def chunk(a, cs):
    b, h, l = a.shape[:3]
    return a.reshape((b, h, l // cs, cs) + a.shape[3:])


def layer_norm(x, w, b):
    xf = x.astype(F32)
    mu = jnp.mean(xf, -1, keepdims=True)
    var = jnp.mean(jnp.square(xf - mu), -1, keepdims=True)
    return ((xf - mu) * lax.rsqrt(var + EPS) * w + b).astype(x.dtype)


def head_norm(h, w, rms):
    h = h.transpose(0, 2, 1, 3)
    if not rms:
        h = h - jnp.mean(h, -1, keepdims=True)
    h = h * lax.rsqrt(jnp.mean(jnp.square(h), -1, keepdims=True) + EPS)
    b, l, nh, dh = h.shape
    return h.reshape(b, l, nh * dh) * w


def group_rms(z, w):
    b, l, wd = z.shape
    zg = z.reshape(b, l, HYENA_GROUPS, wd // HYENA_GROUPS)
    zg = zg * lax.rsqrt(jnp.mean(jnp.square(zg), -1, keepdims=True) + EPS)
    return zg.reshape(b, l, wd) * w


def run_direction(scan_fn, ctx_seq, lat_seq, const, state0, reverse):
    if reverse:
        ctx_seq = tuple(jnp.flip(a, axis=2) for a in ctx_seq)
        lat_seq = tuple(jnp.flip(a, axis=2) for a in lat_seq)
    y_ctx, state = scan_fn(ctx_seq, const, state0)
    y_lat, _ = scan_fn(lat_seq, const, state)
    if reverse:
        y_ctx = jnp.flip(y_ctx, axis=2)
        y_lat = jnp.flip(y_lat, axis=2)
    return y_lat, y_ctx


def mlstm_scan(seq, const, state):
    q, k, v, ig, lf = seq
    cs = MLSTM_CHUNK
    qc, kc, vc, igc, lfc = (chunk(a, cs) for a in seq)
    b = jnp.cumsum(lfc, axis=-1)
    g = b[..., -1]
    a = g[..., None] - b + igc
    m_loc = jnp.max(a, axis=-1)
    w = jnp.exp(a - m_loc[..., None])
    c_loc = jnp.einsum('bhcs,bhcsv,bhcsk->bhcvk', w, vc, kc)
    n_loc = jnp.einsum('bhcs,bhcsk->bhck', w, kc)

    def step(carry, inp):
        c_st, n_st, m_st = carry
        g_j, ml_j, cl_j, nl_j = inp
        m_new = jnp.maximum(g_j + m_st, ml_j)
        sp = jnp.exp(g_j + m_st - m_new)
        sl = jnp.exp(ml_j - m_new)
        new = (sp[..., None, None] * c_st + sl[..., None, None] * cl_j, sp[..., None] * n_st + sl[..., None] * nl_j, m_new)
        return new, carry

    final, (c_in, n_in, m_in) = lax.scan(step, state, tuple(jnp.moveaxis(t, 2, 0) for t in (g, m_loc, c_loc, n_loc)))
    c_in, n_in, m_in = jnp.moveaxis(c_in, 0, 2), jnp.moveaxis(n_in, 0, 2), jnp.moveaxis(m_in, 0, 2)
    tri = jnp.tril(jnp.ones((cs, cs), bool))
    log_d = jnp.where(tri, b[..., :, None] - b[..., None, :] + igc[..., None, :], -jnp.inf)
    inter = b + m_in[..., None]
    m_out = jnp.maximum(inter, jnp.max(log_d, -1))
    s = jnp.einsum('bhctk,bhcsk->bhcts', qc, kc) * jnp.exp(log_d - m_out[..., None])
    e_int = jnp.exp(inter - m_out)
    num = jnp.einsum('bhcts,bhcsv->bhctv', s, vc) + e_int[..., None] * jnp.einsum('bhctk,bhcvk->bhctv', qc, c_in)
    den = jnp.sum(s, -1) + e_int * jnp.einsum('bhctk,bhck->bhct', qc, n_in)
    h = num / jnp.maximum(jnp.abs(den), jnp.exp(-m_out))[..., None]
    return h.reshape(v.shape), final


def hgrn2_scan(seq, const, state):
    q, k, v, lf = seq
    cs = HGRN_CHUNK
    qc, kc, vc, lfc = (chunk(a, cs) for a in seq)
    a_cum = jnp.cumsum(lfc, axis=3)
    a_end = a_cum[:, :, :, -1]
    s_loc = jnp.einsum('bhcsk,bhcsv->bhckv', kc * jnp.exp(a_end[:, :, :, None] - a_cum), vc)

    def step(s_st, inp):
        a_j, sl_j = inp
        return jnp.exp(a_j)[..., None] * s_st + sl_j, s_st

    final, s_in = lax.scan(step, state, (jnp.moveaxis(a_end, 2, 0), jnp.moveaxis(s_loc, 2, 0)))
    s_in = jnp.moveaxis(s_in, 0, 2)
    inter = jnp.einsum('bhctk,bhckv->bhctv', qc * jnp.exp(a_cum), s_in)
    a_mid = a_cum[:, :, :, cs // 2 - 1:cs // 2]
    tri = jnp.tril(jnp.ones((cs, cs), bool))
    sc = jnp.einsum('bhctk,bhcsk->bhcts', qc * jnp.exp(a_cum - a_mid), kc * jnp.exp(a_mid - a_cum))
    sc = jnp.where(tri, sc, 0.0)
    out = inter + jnp.einsum('bhcts,bhcsv->bhctv', sc, vc)
    return out.reshape(v.shape), final


def retention_scan(seq, log_gamma, state):
    q, k, v = seq
    cs = RET_CHUNK
    qc, kc, vc = (chunk(a, cs) for a in seq)
    pos = jnp.arange(cs, dtype=F32)
    tri = jnp.tril(jnp.ones((cs, cs), bool))
    delta = pos[:, None] - pos[None, :]
    decay = jnp.exp(jnp.where(tri, delta[None] * log_gamma[:, None, None], -jnp.inf))
    sc = jnp.einsum('bhctk,bhcsk->bhcts', qc, kc) * decay[:, None]
    intra = jnp.einsum('bhcts,bhcsv->bhctv', sc, vc)
    q_dec = jnp.exp((pos + 1.0)[None, :] * log_gamma[:, None])
    k_dec = jnp.exp((cs - 1.0 - pos)[None, :] * log_gamma[:, None])
    s_loc = jnp.einsum('bhcsk,hs,bhcsv->bhckv', kc, k_dec, vc)
    chunk_decay = jnp.exp(cs * log_gamma)[None, :, None, None]

    def step(s_st, sl_j):
        return chunk_decay * s_st + sl_j, s_st

    final, s_in = lax.scan(step, state, jnp.moveaxis(s_loc, 2, 0))
    s_in = jnp.moveaxis(s_in, 0, 2)
    inter = jnp.einsum('bhctk,ht,bhckv->bhctv', qc, q_dec, s_in)
    return (inter + intra).reshape(v.shape), final


def rope_1d(x, pos):
    d = x.shape[-1]
    inv = ROPE_BASE ** (-jnp.arange(0, d, 2, dtype=F32) / d)
    ang = pos[:, None] * inv[None, :]
    cos = jnp.cos(ang)[None, :, None, :]
    sin = jnp.sin(ang)[None, :, None, :]
    x1, x2 = x[..., :d // 2], x[..., d // 2:]
    return jnp.concatenate([x1 * cos - x2 * sin, x1 * sin + x2 * cos], -1)


def axial_rope(x, row, col):
    half = x.shape[-1] // 2
    return jnp.concatenate([rope_1d(x[..., :half], row), rope_1d(x[..., half:], col)], -1)


def mlstm_group(cols_lat, cols_ctx, gate_b, norm_w):
    def prep(cols):
        q, k, v, o, gates = cols
        b, l, _ = q.shape
        q = to_heads(q, MLSTM_HEADS) * MLSTM_DQK ** -0.5
        k = to_heads(k, MLSTM_HEADS)
        v = to_heads(v, MLSTM_HEADS)
        gates = (gates.reshape(b, l, 4, MLSTM_HEADS) + gate_b).transpose(2, 0, 3, 1)
        fwd = (q, k, v, gates[0], jax.nn.log_sigmoid(gates[1]))
        bwd = (q, k, v, gates[2], jax.nn.log_sigmoid(gates[3]))
        return fwd, bwd, o

    fwd_l, bwd_l, o_l = prep(cols_lat)
    fwd_c, bwd_c, o_c = prep(cols_ctx)
    batch = o_l.shape[0]
    state0 = (jnp.zeros((batch, MLSTM_HEADS, MLSTM_DV, MLSTM_DQK), F32),
              jnp.zeros((batch, MLSTM_HEADS, MLSTM_DQK), F32),
              jnp.full((batch, MLSTM_HEADS), NEG_BIG, F32))
    hf_lat, hf_ctx = run_direction(mlstm_scan, fwd_c, fwd_l, None, state0, False)
    hb_lat, hb_ctx = run_direction(mlstm_scan, bwd_c, bwd_l, None, state0, True)
    y_lat = head_norm(hf_lat + hb_lat, norm_w, False) * jax.nn.sigmoid(o_l)
    y_ctx = head_norm(hf_ctx + hb_ctx, norm_w, False) * jax.nn.sigmoid(o_c)
    return y_lat, y_ctx


def hgrn_group(cols_lat, cols_ctx, lb, norm_w):
    def prep(cols):
        q, i, f_fwd, f_bwd, g = cols
        q = to_heads(jax.nn.silu(q), HGRN_HEADS)
        v = to_heads(i, HGRN_HEADS)

        def gate(fp):
            f = lb + (1.0 - lb) * jax.nn.sigmoid(fp)
            return to_heads(1.0 - f, HGRN_HEADS), to_heads(jnp.log(f), HGRN_HEADS)

        k_f, lf_f = gate(f_fwd)
        k_b, lf_b = gate(f_bwd)
        return (q, k_f, v, lf_f), (q, k_b, v, lf_b), g

    fwd_l, bwd_l, g_l = prep(cols_lat)
    fwd_c, bwd_c, g_c = prep(cols_ctx)
    state0 = jnp.zeros((g_l.shape[0], HGRN_HEADS, HGRN_DK, HGRN_DV), F32)
    yf_lat, yf_ctx = run_direction(hgrn2_scan, fwd_c, fwd_l, None, state0, False)
    yb_lat, yb_ctx = run_direction(hgrn2_scan, bwd_c, bwd_l, None, state0, True)
    y_lat = head_norm(yf_lat + yb_lat, norm_w, True) * jax.nn.silu(g_l)
    y_ctx = head_norm(yf_ctx + yb_ctx, norm_w, True) * jax.nn.silu(g_c)
    return y_lat, y_ctx


def hyena_filters(length, fw1, fb1, fw2, fb2, fw3, fb3, freq, wout):
    pos = jnp.arange(length, dtype=F32)
    t = (pos / max(length - 1, 1))[:, None]
    bands = (HYENA_EMB - 1) // 2
    w = 2.0 * math.pi * pos[:, None] / length * jnp.linspace(1e-4, bands - 1, bands)[None, :]
    z = jnp.concatenate([t, jnp.cos(w), jnp.sin(w)], -1)
    hid = jnp.sin(freq * (z @ fw1 + fb1))
    hid = jnp.sin(freq * (hid @ fw2 + fb2))
    hid = jnp.sin(freq * (hid @ fw3 + fb3))
    h = (hid @ wout).reshape(length, HYENA_ORDER, 2, HYENA_WIDTH)
    deltas = jnp.abs(jnp.linspace(math.log(HYENA_TARGET) / HYENA_SLOW_PCT, math.log(HYENA_TARGET) / HYENA_FAST_PCT, HYENA_WIDTH))
    decay = jnp.exp(-t * deltas[None, :])
    return (h * decay[:, None, None, :]).transpose(1, 2, 0, 3)


def bidir_fftconv(u, h_fwd, h_bwd, d_skip):
    length, width = h_fwd.shape
    kern = jnp.concatenate([h_fwd, jnp.zeros((1, width), F32), jnp.flip(h_bwd[1:], axis=0)], axis=0)
    spec = jnp.fft.rfft(u, n=2 * length, axis=1) * jnp.fft.rfft(kern, axis=0)[None]
    y = jnp.fft.irfft(spec, n=2 * length, axis=1)[:, :length]
    return y + u * d_skip


def hyena_group(u_lat, u_ctx, conv_w, conv_b, fw1, fb1, fw2, fb2, fw3, fb3, freq, wout, skip, norm_w):
    def run(u):
        length = u.shape[1]
        up = jnp.pad(u, ((0, 0), (1, 1), (0, 0)))
        u = up[:, :-2] * conv_w[0] + up[:, 1:-1] * conv_w[1] + up[:, 2:] * conv_w[2] + conv_b
        streams = jnp.split(u, HYENA_ORDER + 1, axis=-1)
        gates, z = streams[:-1], streams[-1]
        h = hyena_filters(length, fw1, fb1, fw2, fb2, fw3, fb3, freq, wout)
        for n in range(HYENA_ORDER):
            z = gates[n] * bidir_fftconv(z, h[n, 0], h[n, 1], skip[n])
        return group_rms(z, norm_w)

    return run(u_lat), run(u_ctx)


def retention_group(cols_lat, cols_ctx, log_decay, norm_w, row, col):
    def prep(cols, rotary):
        q, k, v, g = cols
        b, l, _ = q.shape
        q = q.reshape(b, l, RET_HEADS, RET_DQK)
        k = k.reshape(b, l, RET_HEADS, RET_DQK)
        if rotary:
            q = axial_rope(q, row, col)
            k = axial_rope(k, row, col)
        q = q.transpose(0, 2, 1, 3)
        k = k.transpose(0, 2, 1, 3) * RET_DQK ** -0.5
        return (q, k, to_heads(v, RET_HEADS)), g

    lat, g_l = prep(cols_lat, True)
    ctx, g_c = prep(cols_ctx, False)
    state0 = jnp.zeros((g_l.shape[0], RET_HEADS, RET_DQK, RET_DV), F32)
    yf_lat, yf_ctx = run_direction(retention_scan, ctx, lat, log_decay[0], state0, False)
    yb_lat, yb_ctx = run_direction(retention_scan, ctx, lat, log_decay[1], state0, True)
    y_lat = head_norm(yf_lat + yb_lat, norm_w, False) * jax.nn.silu(g_l)
    y_ctx = head_norm(yf_ctx + yb_ctx, norm_w, False) * jax.nn.silu(g_c)
    return y_lat, y_ctx


def even_mixer(u_lat, u_ctx, w_in, gate_b, mlstm_norm_w, lb, hgrn_norm_w, w_out):
    w_in = w_in.astype(F32)
    w_out = w_out.astype(F32)
    p_lat = split_cols(u_lat.astype(F32) @ w_in, EVEN_SPLITS)
    p_ctx = split_cols(u_ctx.astype(F32) @ w_in, EVEN_SPLITS)
    n_a = len(MLSTM_SPLITS)
    a_lat, a_ctx = mlstm_group(p_lat[:n_a], p_ctx[:n_a], gate_b.astype(F32), mlstm_norm_w.astype(F32))
    b_lat, b_ctx = hgrn_group(p_lat[n_a:], p_ctx[n_a:], lb, hgrn_norm_w.astype(F32))
    return jnp.concatenate([a_lat, b_lat], -1) @ w_out, jnp.concatenate([a_ctx, b_ctx], -1) @ w_out


def odd_mixer(u_lat, u_ctx, w_in, hyena_p, log_decay, ret_norm_w, w_out, row, col):
    w_in = w_in.astype(F32)
    w_out = w_out.astype(F32)
    p_lat = split_cols(u_lat.astype(F32) @ w_in, ODD_SPLITS)
    p_ctx = split_cols(u_ctx.astype(F32) @ w_in, ODD_SPLITS)
    hy_lat, hy_ctx = hyena_group(p_lat[0], p_ctx[0], *[p.astype(F32) for p in hyena_p])
    r_lat, r_ctx = retention_group(p_lat[1:], p_ctx[1:], log_decay.astype(F32), ret_norm_w.astype(F32), row, col)
    return jnp.concatenate([hy_lat, r_lat], -1) @ w_out, jnp.concatenate([hy_ctx, r_ctx], -1) @ w_out


def moe_ffn(t, router_w, router_bias, w1, w3, w2, sw1, sw3, sw2):
    n_tok, d = t.shape
    tf = t.astype(F32)
    scores = jax.nn.sigmoid(tf @ router_w.astype(F32))
    _, idx = lax.top_k(scores + router_bias.astype(F32), TOP_K)
    gate = jnp.take_along_axis(scores, idx, axis=1)
    gate = ROUTED_SCALE * gate / jnp.sum(gate, -1, keepdims=True)
    n_assign = n_tok * TOP_K
    e_flat = idx.reshape(-1)
    g_flat = gate.reshape(-1)
    tok_flat = jnp.arange(n_assign, dtype=jnp.int32) // TOP_K
    order = jnp.argsort(e_flat)
    e_s, tok_s, g_s = e_flat[order], tok_flat[order], g_flat[order]
    counts = jnp.bincount(e_flat, length=N_EXPERTS)
    padded = (counts + MOE_BLOCK - 1) // MOE_BLOCK * MOE_BLOCK
    start = jnp.cumsum(counts) - counts
    pend = jnp.cumsum(padded)
    pstart = pend - padded
    dest = pstart[e_s] + jnp.arange(n_assign, dtype=jnp.int32) - start[e_s]
    n_blocks = -(-(n_assign + N_EXPERTS * (MOE_BLOCK - 1)) // MOE_BLOCK)
    slot_tok = jnp.full((n_blocks * MOE_BLOCK,), n_tok, jnp.int32).at[dest].set(tok_s)
    slot_gate = jnp.zeros((n_blocks * MOE_BLOCK,), F32).at[dest].set(g_s)
    block_e = jnp.minimum(jnp.searchsorted(pend, jnp.arange(n_blocks, dtype=jnp.int32) * MOE_BLOCK, side='right'), N_EXPERTS - 1)
    t_ext = jnp.concatenate([tf, jnp.zeros((1, d), F32)], 0)

    def expert_block(acc, blk):
        tok, g, e = blk
        xb = t_ext[tok]
        hb = jax.nn.silu(xb @ w1[e]) * (xb @ w3[e])
        return acc.at[tok].add((hb @ w2[e]) * g[:, None]), None

    acc, _ = lax.scan(expert_block, jnp.zeros((n_tok + 1, d), F32),
                      (slot_tok.reshape(n_blocks, MOE_BLOCK), slot_gate.reshape(n_blocks, MOE_BLOCK), block_e))
    shared = (jax.nn.silu(tf @ sw1) * (tf @ sw3)) @ sw2
    return acc[:n_tok] + shared


def setup_inputs(seed: int = 0) -> dict:
    key = jax.random.key(seed)
    keys = iter(jax.random.split(key, 48))

    def nrm(shape, scale=1.0):
        return scale * jax.random.normal(next(keys), shape, F32)

    d = D_MODEL
    hfh = HYENA_FILTER_HIDDEN
    hyw = (HYENA_ORDER + 1) * HYENA_WIDTH
    f_bias = jnp.linspace(3.0, 6.0, MLSTM_HEADS)
    gate_base = jnp.stack([jnp.zeros(MLSTM_HEADS), f_bias, jnp.zeros(MLSTM_HEADS), f_bias])
    ret_base = jnp.log(1.0 - 2.0 ** (-5.0 - jnp.arange(RET_HEADS, dtype=F32)))
    return {
        'x': nrm((BATCH, SEQ, d)),
        'c': nrm((BATCH, d)),
        'ctx': nrm((BATCH, CTX_LEN, d)),
        'c_ctx': nrm((d,)),
        'ada_w': nrm((DEPTH, d, 6 * d), d ** -0.5),
        'ada_b': nrm((DEPTH, 6 * d), 0.02),
        'ln_w': 1.0 + nrm((DEPTH, 2, d), 0.02),
        'ln_b': nrm((DEPTH, 2, d), 0.02),
        'even_w_in': nrm((N_EVEN, d, EVEN_PROJ), d ** -0.5),
        'mlstm_gate_b': gate_base + nrm((N_EVEN, 4, MLSTM_HEADS), 0.1),
        'mlstm_norm_w': 1.0 + nrm((N_EVEN, MLSTM_HEADS * MLSTM_DV), 0.02),
        'hgrn_lb': nrm((N_EVEN, HGRN_HEADS * HGRN_DK), 1.0),
        'hgrn_norm_w': 1.0 + nrm((N_EVEN, HGRN_HEADS * HGRN_DV), 0.02),
        'even_w_out': nrm((N_EVEN, EVEN_MIX, d), DEEPNORM_BETA * EVEN_MIX ** -0.5),
        'odd_w_in': nrm((N_ODD, d, ODD_PROJ), d ** -0.5),
        'hy_conv_w': nrm((N_ODD, HYENA_SHORT, hyw), HYENA_SHORT ** -0.5),
        'hy_conv_b': nrm((N_ODD, hyw), 0.02),
        'hy_f_w1': nrm((N_ODD, HYENA_EMB, hfh), HYENA_EMB ** -0.5),
        'hy_f_b1': nrm((N_ODD, hfh), 0.1),
        'hy_f_w2': nrm((N_ODD, hfh, hfh), hfh ** -0.5),
        'hy_f_b2': nrm((N_ODD, hfh), 0.1),
        'hy_f_w3': nrm((N_ODD, hfh, hfh), hfh ** -0.5),
        'hy_f_b3': nrm((N_ODD, hfh), 0.1),
        'hy_f_freq': 1.0 + nrm((N_ODD, hfh), 0.02),
        'hy_f_wout': nrm((N_ODD, hfh, HYENA_ORDER * 2 * HYENA_WIDTH), hfh ** -0.5),
        'hy_skip': nrm((N_ODD, HYENA_ORDER, HYENA_WIDTH), 1.0),
        'hy_norm_w': 1.0 + nrm((N_ODD, HYENA_WIDTH), 0.02),
        'ret_log_decay': ret_base * (1.0 + nrm((N_ODD, 2, RET_HEADS), 0.05)),
        'ret_norm_w': 1.0 + nrm((N_ODD, RET_HEADS * RET_DV), 0.02),
        'odd_w_out': nrm((N_ODD, ODD_MIX, d), DEEPNORM_BETA * ODD_MIX ** -0.5),
        'router_w': nrm((DEPTH, d, N_EXPERTS), d ** -0.5),
        'router_bias': nrm((DEPTH, N_EXPERTS), 0.01),
        'exp_w1': nrm((DEPTH, N_EXPERTS, d, EXPERT_HIDDEN), d ** -0.5),
        'exp_w3': nrm((DEPTH, N_EXPERTS, d, EXPERT_HIDDEN), d ** -0.5),
        'exp_w2': nrm((DEPTH, N_EXPERTS, EXPERT_HIDDEN, d), DEEPNORM_BETA * EXPERT_HIDDEN ** -0.5),
        'sh_w1': nrm((DEPTH, d, SHARED_HIDDEN), d ** -0.5),
        'sh_w3': nrm((DEPTH, d, SHARED_HIDDEN), d ** -0.5),
        'sh_w2': nrm((DEPTH, SHARED_HIDDEN, d), DEEPNORM_BETA * SHARED_HIDDEN ** -0.5),
    }


def reference(x, c, ctx, c_ctx, ada_w, ada_b, ln_w, ln_b, even_w_in, mlstm_gate_b, mlstm_norm_w, hgrn_lb, hgrn_norm_w, even_w_out, odd_w_in, hy_conv_w, hy_conv_b, hy_f_w1, hy_f_b1, hy_f_w2, hy_f_b2, hy_f_w3, hy_f_b3, hy_f_freq, hy_f_wout, hy_skip, hy_norm_w, ret_log_decay, ret_norm_w, odd_w_out, router_w, router_bias, exp_w1, exp_w3, exp_w2, sh_w1, sh_w3, sh_w2):
    batch, n_lat, d = x.shape
    n_ctx = ctx.shape[1]
    rows = n_lat // GRID_W
    row = jnp.repeat(jnp.arange(rows, dtype=F32), GRID_W)
    col = jnp.tile(jnp.arange(GRID_W, dtype=F32), rows)
    sm = jax.nn.softmax(hgrn_lb.astype(F32), axis=0)
    lower_bounds = jnp.cumsum(sm, axis=0) - sm[0]
    c_act = jax.nn.silu(c.astype(F32))
    cc_act = jax.nn.silu(c_ctx.astype(F32))
    h_lat, h_ctx = x, ctx
    for l in range(DEPTH):
        last = l == DEPTH - 1
        ada_wl = ada_w[l].astype(F32)
        mod_lat = jnp.split((c_act @ ada_wl + ada_b[l])[:, None, :], 6, axis=-1)
        mod_ctx = jnp.split((cc_act @ ada_wl + ada_b[l])[None, None, :], 6, axis=-1)
        u_lat = h_lat * (1.0 + mod_lat[1]) + mod_lat[0]
        u_ctx = h_ctx * (1.0 + mod_ctx[1]) + mod_ctx[0]
        if l % 2 == 0:
            e = l // 2
            y_lat, y_ctx = even_mixer(u_lat, u_ctx, even_w_in[e], mlstm_gate_b[e], mlstm_norm_w[e], lower_bounds[e], hgrn_norm_w[e], even_w_out[e])
        else:
            o = l // 2
            hyena_p = (hy_conv_w[o], hy_conv_b[o], hy_f_w1[o], hy_f_b1[o], hy_f_w2[o], hy_f_b2[o], hy_f_w3[o], hy_f_b3[o], hy_f_freq[o], hy_f_wout[o], hy_skip[o], hy_norm_w[o])
            y_lat, y_ctx = odd_mixer(u_lat, u_ctx, odd_w_in[o], hyena_p, ret_log_decay[o], ret_norm_w[o], odd_w_out[o], row, col)
        h_lat = layer_norm(DEEPNORM_ALPHA * h_lat + (mod_lat[2] * y_lat).astype(h_lat.dtype), ln_w[l, 0], ln_b[l, 0])
        v_lat = (h_lat * (1.0 + mod_lat[4]) + mod_lat[3]).reshape(batch * n_lat, d)
        if last:
            f_lat = moe_ffn(v_lat, router_w[l], router_bias[l], exp_w1[l], exp_w3[l], exp_w2[l], sh_w1[l], sh_w3[l], sh_w2[l])
        else:
            h_ctx = layer_norm(DEEPNORM_ALPHA * h_ctx + (mod_ctx[2] * y_ctx).astype(h_ctx.dtype), ln_w[l, 0], ln_b[l, 0])
            v_ctx = (h_ctx * (1.0 + mod_ctx[4]) + mod_ctx[3]).reshape(batch * n_ctx, d)
            f_all = moe_ffn(jnp.concatenate([v_lat, v_ctx], 0), router_w[l], router_bias[l], exp_w1[l], exp_w3[l], exp_w2[l], sh_w1[l], sh_w3[l], sh_w2[l])
            f_lat = f_all[:batch * n_lat]
            f_ctx = f_all[batch * n_lat:].reshape(batch, n_ctx, d)
            h_ctx = layer_norm(DEEPNORM_ALPHA * h_ctx + (mod_ctx[5] * f_ctx).astype(h_ctx.dtype), ln_w[l, 1], ln_b[l, 1])
        h_lat = layer_norm(DEEPNORM_ALPHA * h_lat + (mod_lat[5] * f_lat.reshape(batch, n_lat, d)).astype(h_lat.dtype), ln_w[l, 1], ln_b[l, 1])
    return h_lat
```

```cpp
#include <hip/hip_runtime.h>
#include <stdint.h>
#include <stdio.h>

#define DM 1024
#define NBATCH 8
#define SEQ 4096
#define CTXL 256
#define NL (NBATCH * SEQ)
#define NC (NBATCH * CTXL)
#define NT (NL + NC)
#define ZROW NT
#define NEXP 64
#define TOPK 8
#define EH 256
#define EVEN_N 4112
#define ODD_N 3584
#define MAXROWS (NT * 8 + 64 * 256 + NT)
#define ALPHA 1.681792830507429f
#define LN_EPS 1e-5f

typedef float act_t;

#define MiB ((size_t)1 << 20)
#define OFF_CNT   ((size_t)64 << 10)
#define OFF_OFFS  ((size_t)80 << 10)
#define OFF_LB    ((size_t)96 << 10)
#define OFF_MOD   ((size_t)128 << 10)
#define OFF_HCTX  (4 * MiB)
#define OFF_TIDX  (12 * MiB)
#define OFF_TGATE (14 * MiB)
#define OFF_TPOS  (16 * MiB)
#define OFF_STOK  (18 * MiB)
#define OFF_SGATE (20 * MiB)
#define OFF_U     (22 * MiB)
#define OFF_BIG   (160 * MiB)
#define OFF_H     (OFF_BIG + 140 * MiB)
#define OFF_AUX   (708 * MiB)
#define OFF_Z1    (OFF_AUX + 136 * MiB)
#define OFF_Z2    (OFF_Z1 + 68 * MiB)
#define OFF_FILT  (OFF_Z2 + 68 * MiB)
#define WS_END    (OFF_FILT + 36 * MiB)

struct Params {
    const float* in[38];
    float* out;
    unsigned char* ws;
};

enum { I_X = 0, I_C, I_CTX, I_CCTX, I_ADAW, I_ADAB, I_LNW, I_LNB, I_EWIN, I_MGB, I_MNW, I_HLB, I_HNW, I_EWOUT, I_OWIN, I_HCW, I_HCB,
       I_HW1, I_HB1, I_HW2, I_HB2, I_HW3, I_HB3, I_HFREQ, I_HWOUT, I_HSKIP, I_HNORM, I_RLD, I_RNW, I_OWOUT, I_RW, I_RB, I_W1, I_W3, I_W2, I_SW1, I_SW3, I_SW2 };

__device__ __forceinline__ float ldf(const float* p) { return *p; }
__device__ __forceinline__ void stf(float* p, float v) { *p = v; }
__device__ __forceinline__ float sigmoidf_(float x) { return 1.f / (1.f + expf(-x)); }
__device__ __forceinline__ float siluf_(float x) { return x / (1.f + expf(-x)); }
__device__ __forceinline__ float wave_sum(float v) {
#pragma unroll
    for (int o = 32; o > 0; o >>= 1) v += __shfl_xor(v, o, 64);
    return v;
}
__device__ __forceinline__ float* hrow(const Params& p, int tok) {
    return tok < NL ? p.out + (size_t)tok * DM : (float*)(p.ws + OFF_HCTX) + (size_t)(tok - NL) * DM;
}
__device__ __forceinline__ const float* modrow(const Params& p, int l, int tok) {
    const int r = tok < NL ? (tok >> 12) : 8;
    return (const float*)(p.ws + OFF_MOD) + ((size_t)l * 9 + r) * 6144;
}
__device__ __forceinline__ int scan_tok(int b, int i, int dir) {
    return i < CTXL ? NL + b * CTXL + (dir ? CTXL - 1 - i : i) : b * SEQ + (dir ? SEQ - 1 - (i - CTXL) : (i - CTXL));
}

__device__ void ph_prologue(const Params& p, int bid, int nb, float* sm) {
    const int tid = threadIdx.x;
    {
        const float4* x4 = (const float4*)p.in[I_X]; float4* o4 = (float4*)p.out;
        for (size_t i = (size_t)bid * 512 + tid; i < (size_t)NL * 256; i += (size_t)nb * 512) o4[i] = x4[i];
        const float4* c4 = (const float4*)p.in[I_CTX]; float4* h4 = (float4*)(p.ws + OFF_HCTX);
        for (size_t i = (size_t)bid * 512 + tid; i < (size_t)NC * 256; i += (size_t)nb * 512) h4[i] = c4[i];
    }
    if (bid == 0) {
        act_t* z = (act_t*)(p.ws + OFF_U) + (size_t)ZROW * DM;
        for (int i = tid; i < DM; i += 512) z[i] = 0;
        int* cnt = (int*)(p.ws + OFF_CNT);
        if (tid < 256) cnt[tid] = 0;
    }
    if (bid == 1 % nb) {
        float* lb = (float*)(p.ws + OFF_LB);
        const float* hl = p.in[I_HLB];
        for (int j = tid; j < 512; j += 512) {
            const float a = hl[j], b = hl[512 + j], mx = fmaxf(a, b);
            const float ea = expf(a - mx), eb = expf(b - mx);
            lb[j] = 0.f; lb[512 + j] = eb / (ea + eb);
        }
    }
    {
        float* act = sm;
        bool filled = false;
        for (int item = bid; item < 48; item += nb) {
            if (!filled) {
                for (int i = tid; i < 9 * 1024; i += 512) {
                    const int r = i >> 10, k = i & 1023;
                    const float v = r < 8 ? p.in[I_C][r * 1024 + k] : p.in[I_CCTX][k];
                    act[i] = siluf_(v);
                }
                __syncthreads(); filled = true;
            }
            const int l = item / 12, j = (item % 12) * 512 + tid;
            const float* w = p.in[I_ADAW] + (size_t)l * 1024 * 6144 + j;
            float acc[9];
#pragma unroll
            for (int r = 0; r < 9; ++r) acc[r] = 0.f;
            for (int k = 0; k < 1024; ++k) {
                const float wv = w[(size_t)k * 6144];
#pragma unroll
                for (int r = 0; r < 9; ++r) acc[r] += act[r * 1024 + k] * wv;
            }
            const float bv = p.in[I_ADAB][l * 6144 + j];
            float* mod = (float*)(p.ws + OFF_MOD);
#pragma unroll
            for (int r = 0; r < 9; ++r) mod[((size_t)l * 9 + r) * 6144 + j] = acc[r] + bv;
        }
    }
}

__device__ void ph_modulate(const Params& p, int l, int bid, int nb) {
    const int tid = threadIdx.x;
    act_t* U = (act_t*)(p.ws + OFF_U);
    for (size_t i = (size_t)bid * 512 + tid; i < (size_t)NT * 256; i += (size_t)nb * 512) {
        const int tok = (int)(i >> 8), d4 = (int)(i & 255) * 4;
        const float4 h = *(const float4*)(hrow(p, tok) + d4);
        const float* m = modrow(p, l, tok);
        const float4 sh = *(const float4*)(m + d4), sc = *(const float4*)(m + 1024 + d4);
        float4 u; u.x = h.x * (1.f + sc.x) + sh.x; u.y = h.y * (1.f + sc.y) + sh.y; u.z = h.z * (1.f + sc.z) + sh.z; u.w = h.w * (1.f + sc.w) + sh.w;
        *(float4*)(U + (size_t)tok * DM + d4) = u;
    }
}

template <bool DUAL, class ARow, class Epi>
__device__ __forceinline__ void gemm_tile_naive(float* sm, ARow arow, const float* B0, const float* B1, int ldb, int N, int K, int m0, int n0, Epi epi) {
    float* As = sm;
    float* Bs = sm + 16 * 132;
    float* Bs2 = Bs + 16 * 128;
    const int tid = threadIdx.x, ty = tid >> 5, tx = tid & 31;
    float acc[8][4], acc2[8][4];
#pragma unroll
    for (int i = 0; i < 8; ++i)
#pragma unroll
        for (int j = 0; j < 4; ++j) { acc[i][j] = 0.f; acc2[i][j] = 0.f; }
    const int ar = tid >> 2, ak = (tid & 3) * 4;
    const act_t* ap = arow(m0 + ar);
    const int bk = tid >> 5, bn = (tid & 31) * 4;
    const bool bok = (n0 + bn) < N;
    for (int k0 = 0; k0 < K; k0 += 16) {
        const float a0 = ldf(ap + k0 + ak), a1 = ldf(ap + k0 + ak + 1), a2 = ldf(ap + k0 + ak + 2), a3 = ldf(ap + k0 + ak + 3);
        float4 b = make_float4(0.f, 0.f, 0.f, 0.f), b2 = b;
        if (bok) { b = *(const float4*)(B0 + (size_t)(k0 + bk) * ldb + n0 + bn); if (DUAL) b2 = *(const float4*)(B1 + (size_t)(k0 + bk) * ldb + n0 + bn); }
        __syncthreads();
        As[(ak + 0) * 132 + ar] = a0; As[(ak + 1) * 132 + ar] = a1; As[(ak + 2) * 132 + ar] = a2; As[(ak + 3) * 132 + ar] = a3;
        *(float4*)(Bs + bk * 128 + bn) = b;
        if (DUAL) *(float4*)(Bs2 + bk * 128 + bn) = b2;
        __syncthreads();
#pragma unroll
        for (int kk = 0; kk < 16; ++kk) {
            const float4 x0 = *(const float4*)(As + kk * 132 + ty * 8), x1 = *(const float4*)(As + kk * 132 + ty * 8 + 4);
            const float4 y = *(const float4*)(Bs + kk * 128 + tx * 4);
            const float a[8] = {x0.x, x0.y, x0.z, x0.w, x1.x, x1.y, x1.z, x1.w};
            const float bb[4] = {y.x, y.y, y.z, y.w};
#pragma unroll
            for (int i = 0; i < 8; ++i)
#pragma unroll
                for (int j = 0; j < 4; ++j) acc[i][j] += a[i] * bb[j];
            if (DUAL) {
                const float4 y2 = *(const float4*)(Bs2 + kk * 128 + tx * 4);
                const float b2v[4] = {y2.x, y2.y, y2.z, y2.w};
#pragma unroll
                for (int i = 0; i < 8; ++i)
#pragma unroll
                    for (int j = 0; j < 4; ++j) acc2[i][j] += a[i] * b2v[j];
            }
        }
    }
#pragma unroll
    for (int i = 0; i < 8; ++i)
#pragma unroll
        for (int j = 0; j < 4; ++j) {
            const int c = n0 + tx * 4 + j;
            if (c < N) epi(m0 + ty * 8 + i, c, acc[i][j], acc2[i][j]);
        }
    __syncthreads();
}

__device__ void ph_gemm_in(const Params& p, int l, int bid, int nb, float* sm) {
    const bool even = (l & 1) == 0;
    const int N = even ? EVEN_N : ODD_N;
    const float* W = even ? p.in[I_EWIN] + (size_t)(l >> 1) * 1024 * EVEN_N : p.in[I_OWIN] + (size_t)(l >> 1) * 1024 * ODD_N;
    const act_t* U = (const act_t*)(p.ws + OFF_U);
    act_t* P = (act_t*)(p.ws + OFF_BIG);
    const int ntn = (N + 127) / 128, ntm = NT / 128;
    for (int t = bid; t < ntm * ntn; t += nb) {
        const int tm = t / ntn, tn = t % ntn;
        gemm_tile_naive<false>(sm, [&](int r) { return U + (size_t)r * DM; }, W, W, N, N, 1024, tm * 128, tn * 128,
                               [&](int r, int c, float v, float) { stf(P + (size_t)r * N + c, v); });
    }
}

__device__ void ph_gemm_out(const Params& p, int l, int bid, int nb, float* sm) {
    const bool even = (l & 1) == 0;
    const float* W = (even ? p.in[I_EWOUT] : p.in[I_OWOUT]) + (size_t)(l >> 1) * 1024 * 1024;
    const act_t* A = (const act_t*)(p.ws + OFF_U);
    float* Y = (float*)(p.ws + OFF_BIG);
    for (int t = bid; t < (NT / 128) * 8; t += nb) {
        const int tm = t / 8, tn = t % 8;
        gemm_tile_naive<false>(sm, [&](int r) { return A + (size_t)r * DM; }, W, W, 1024, 1024, 1024, tm * 128, tn * 128,
                               [&](int r, int c, float v, float) { Y[(size_t)r * DM + c] = v; });
    }
}

__device__ void ph_scan_even(const Params& p, int l, int dir, int bid, int nb) {
    const int tid = threadIdx.x, v = tid >> 2, kq = tid & 3;
    const act_t* P = (const act_t*)(p.ws + OFF_BIG);
    float* HX = (float*)(p.ws + OFF_AUX);
    const int e = l >> 1;
    for (int item = bid; item < 64; item += nb) {
        const int kind = item >> 5, b = (item >> 2) & 7, h = item & 3;
        if (kind == 0) {
            const float* gb = p.in[I_MGB] + e * 16;
            const float gbi = gb[(dir ? 2 : 0) * 4 + h], gbf = gb[(dir ? 3 : 1) * 4 + h];
            float C[16], n[16];
#pragma unroll
            for (int j = 0; j < 16; ++j) { C[j] = 0.f; n[j] = 0.f; }
            float m = -1e30f;
            for (int i = 0; i < CTXL + SEQ; ++i) {
                const int tok = scan_tok(b, i, dir);
                const act_t* pr = P + (size_t)tok * EVEN_N;
                const float ig = ldf(pr + 1536 + (dir ? 8 : 0) + h) + gbi;
                const float fg = ldf(pr + 1536 + (dir ? 12 : 4) + h) + gbf;
                const float lf = fminf(fg, 0.f) - log1pf(expf(-fabsf(fg)));
                const float m_new = fmaxf(lf + m, ig);
                const float a = expf(lf + m - m_new), bg = expf(ig - m_new);
                const float vv = ldf(pr + 512 + h * 128 + v);
                float num = 0.f, den = 0.f;
#pragma unroll
                for (int j = 0; j < 16; ++j) {
                    const float kj = ldf(pr + 256 + h * 64 + kq * 16 + j), qj = ldf(pr + h * 64 + kq * 16 + j) * 0.125f;
                    C[j] = a * C[j] + bg * vv * kj; n[j] = a * n[j] + bg * kj;
                    num += C[j] * qj; den += n[j] * qj;
                }
                num += __shfl_xor(num, 1, 64); num += __shfl_xor(num, 2, 64);
                den += __shfl_xor(den, 1, 64); den += __shfl_xor(den, 2, 64);
                const float hv = num / fmaxf(fabsf(den), expf(-m_new));
                if (kq == 0) { float* o = HX + (size_t)tok * 1024 + h * 128 + v; *o = dir ? *o + hv : hv; }
                m = m_new;
            }
        } else {
            const float* lbp = (const float*)(p.ws + OFF_LB) + e * 512 + h * 128 + kq * 32;
            float S[32], lb[32];
#pragma unroll
            for (int j = 0; j < 32; ++j) { S[j] = 0.f; lb[j] = lbp[j]; }
            for (int i = 0; i < CTXL + SEQ; ++i) {
                const int tok = scan_tok(b, i, dir);
                const act_t* pr = P + (size_t)tok * EVEN_N;
                const float iv = ldf(pr + 2064 + h * 128 + v);
                float o = 0.f;
#pragma unroll
                for (int j = 0; j < 32; ++j) {
                    const int k = h * 128 + kq * 32 + j;
                    const float fp = ldf(pr + (dir ? 3088 : 2576) + k);
                    const float f = lb[j] + (1.f - lb[j]) * sigmoidf_(fp);
                    const float qj = siluf_(ldf(pr + 1552 + k));
                    S[j] = f * S[j] + (1.f - f) * iv;
                    o += qj * S[j];
                }
                o += __shfl_xor(o, 1, 64); o += __shfl_xor(o, 2, 64);
                if (kq == 0) { float* op = HX + (size_t)tok * 1024 + 512 + h * 128 + v; *op = dir ? *op + o : o; }
            }
        }
    }
}

__device__ void ph_normgate_even(const Params& p, int l, int bid, int nb) {
    const int tid = threadIdx.x, lane = tid & 63, wv = tid >> 6;
    const act_t* P = (const act_t*)(p.ws + OFF_BIG);
    const float* HX = (const float*)(p.ws + OFF_AUX);
    act_t* MIX = (act_t*)(p.ws + OFF_U);
    const int e = l >> 1;
    for (int it = bid * 8 + wv; it < NT * 8; it += nb * 8) {
        const int tok = it >> 3, g = it & 7;
        const float* hx = HX + (size_t)tok * 1024 + g * 128;
        float x0 = hx[lane], x1 = hx[lane + 64];
        const act_t* pr = P + (size_t)tok * EVEN_N;
        if (g < 4) {
            const float mean = wave_sum(x0 + x1) * (1.f / 128.f);
            x0 -= mean; x1 -= mean;
            const float var = wave_sum(x0 * x0 + x1 * x1) * (1.f / 128.f);
            const float r = rsqrtf(var + LN_EPS);
            const float* nw = p.in[I_MNW] + e * 512 + g * 128;
            const float o0 = ldf(pr + 1024 + g * 128 + lane), o1 = ldf(pr + 1024 + g * 128 + lane + 64);
            stf(MIX + (size_t)tok * DM + g * 128 + lane, x0 * r * nw[lane] * sigmoidf_(o0));
            stf(MIX + (size_t)tok * DM + g * 128 + lane + 64, x1 * r * nw[lane + 64] * sigmoidf_(o1));
        } else {
            const int h = g - 4;
            const float ms = wave_sum(x0 * x0 + x1 * x1) * (1.f / 128.f);
            const float r = rsqrtf(ms + LN_EPS);
            const float* nw = p.in[I_HNW] + e * 512 + h * 128;
            const float g0 = ldf(pr + 3600 + h * 128 + lane), g1 = ldf(pr + 3600 + h * 128 + lane + 64);
            stf(MIX + (size_t)tok * DM + 512 + h * 128 + lane, x0 * r * nw[lane] * siluf_(g0));
            stf(MIX + (size_t)tok * DM + 512 + h * 128 + lane + 64, x1 * r * nw[lane + 64] * siluf_(g1));
        }
    }
}

__device__ void ph_scan_odd(const Params& p, int l, int dir, int bid, int nb) {
    const int tid = threadIdx.x, v = tid >> 2, kq = tid & 3;
    const act_t* P = (const act_t*)(p.ws + OFF_BIG);
    float* HX = (float*)(p.ws + OFF_AUX);
    const int o = l >> 1;
    for (int item = bid; item < 32; item += nb) {
        const int b = item >> 2, h = item & 3;
        const float gamma = expf(p.in[I_RLD][o * 8 + dir * 4 + h]);
        float S[32], inv[32];
#pragma unroll
        for (int j = 0; j < 32; ++j) { S[j] = 0.f; inv[j] = powf(10000.f, -(float)j / 32.f); }
        for (int i = 0; i < CTXL + SEQ; ++i) {
            const int tok = scan_tok(b, i, dir);
            const bool lat = tok < NL;
            const int t = tok & (SEQ - 1);
            const float pos = (kq < 2) ? (float)(t >> 6) : (float)(t & 63);
            const act_t* pr = P + (size_t)tok * ODD_N;
            const float vv = ldf(pr + 2560 + h * 128 + v);
            float acc = 0.f;
#pragma unroll
            for (int j = 0; j < 32; ++j) {
                const int dim = kq * 32 + j, pd = dim ^ 32;
                float qv = ldf(pr + 1536 + h * 128 + dim), kv = ldf(pr + 2048 + h * 128 + dim);
                if (lat) {
                    const float qp = ldf(pr + 1536 + h * 128 + pd), kp = ldf(pr + 2048 + h * 128 + pd);
                    const float ang = pos * inv[j];
                    const float c = cosf(ang), s = sinf(ang);
                    if ((dim & 32) == 0) { qv = qv * c - qp * s; kv = kv * c - kp * s; }
                    else { qv = qp * s + qv * c; kv = kp * s + kv * c; }
                }
                kv *= 0.08838834764831845f;
                S[j] = gamma * S[j] + kv * vv;
                acc += qv * S[j];
            }
            acc += __shfl_xor(acc, 1, 64); acc += __shfl_xor(acc, 2, 64);
            if (kq == 0) { float* op = HX + (size_t)tok * 1024 + 512 + h * 128 + v; *op = dir ? *op + acc : acc; }
        }
    }
}

__device__ void ph_hy_filt(const Params& p, int l, int bid, int nb, float* sm) {
    const int tid = threadIdx.x, o = l >> 1;
    float* z = sm;
    float* h1 = sm + 64;
    float* h2 = sm + 128;
    float* h3 = sm + 192;
    const float* fw1 = p.in[I_HW1] + o * 33 * 64; const float* fb1 = p.in[I_HB1] + o * 64;
    const float* fw2 = p.in[I_HW2] + o * 64 * 64; const float* fb2 = p.in[I_HB2] + o * 64;
    const float* fw3 = p.in[I_HW3] + o * 64 * 64; const float* fb3 = p.in[I_HB3] + o * 64;
    const float* freq = p.in[I_HFREQ] + o * 64;
    const float* wout = p.in[I_HWOUT] + (size_t)o * 64 * 2048;
    float* Flat = (float*)(p.ws + OFF_FILT);
    float* Fctx = Flat + (size_t)2 * 2 * 512 * 4096;
    for (int item = bid; item < SEQ + CTXL; item += nb) {
        const bool isctx = item >= SEQ;
        const int L = isctx ? CTXL : SEQ, pos = isctx ? item - SEQ : item;
        const float t = (float)pos / (float)(L - 1);
        __syncthreads();
        if (tid == 0) z[0] = t;
        if (tid < 16) {
            const float f = 1e-4f + (float)tid * ((15.0f - 1e-4f) / 15.0f);
            const float w = 2.0f * 3.14159265358979323846f * (float)pos / (float)L * f;
            z[1 + tid] = cosf(w); z[17 + tid] = sinf(w);
        }
        __syncthreads();
        if (tid < 64) { float a = fb1[tid];
#pragma unroll 1
            for (int k = 0; k < 33; ++k) a += z[k] * fw1[k * 64 + tid]; h1[tid] = sinf(freq[tid] * a); }
        __syncthreads();
        if (tid < 64) { float a = fb2[tid];
#pragma unroll 4
            for (int k = 0; k < 64; ++k) a += h1[k] * fw2[k * 64 + tid]; h2[tid] = sinf(freq[tid] * a); }
        __syncthreads();
        if (tid < 64) { float a = fb3[tid];
#pragma unroll 4
            for (int k = 0; k < 64; ++k) a += h2[k] * fw3[k * 64 + tid]; h3[tid] = sinf(freq[tid] * a); }
        __syncthreads();
#pragma unroll 1
        for (int r = 0; r < 4; ++r) {
            const int col = tid + 512 * r, c = col & 511, od = col >> 9;
            float a = 0.f;
#pragma unroll 4
            for (int k = 0; k < 64; ++k) a += h3[k] * wout[k * 2048 + col];
            const float delta = 3.0701134573253944f + (float)c * ((15.350567286626972f - 3.0701134573253944f) / 511.0f);
            a *= expf(-t * delta);
            if (isctx) Fctx[((size_t)od * 512 + c) * CTXL + pos] = a; else Flat[((size_t)od * 512 + c) * SEQ + pos] = a;
        }
    }
}

__device__ __forceinline__ float hy_conv3(const act_t* P, const float* cw, const float* cb, int tok, int j) {
    const bool lat = tok < NL;
    const int L = lat ? SEQ : CTXL, t = lat ? (tok & (SEQ - 1)) : ((tok - NL) & (CTXL - 1));
    const act_t* pr = P + (size_t)tok * ODD_N + j;
    float a = ldf(pr) * cw[1536 + j] + cb[j];
    if (t > 0) a += ldf(pr - ODD_N) * cw[j];
    if (t < L - 1) a += ldf(pr + ODD_N) * cw[2 * 1536 + j];
    return a;
}

__device__ void ph_hy_conv(const Params& p, int l, int order, int bid, int nb, float* sm) {
    const int tid = threadIdx.x, o = l >> 1;
    const act_t* P = (const act_t*)(p.ws + OFF_BIG);
    const float* cw = p.in[I_HCW] + o * 3 * 1536; const float* cb = p.in[I_HCB] + o * 1536;
    const float* skip = p.in[I_HSKIP] + o * 1024 + order * 512;
    const float* Zin = (const float*)(p.ws + OFF_Z1);
    float* Zout = (float*)(p.ws + (order == 0 ? OFF_Z1 : OFF_Z2));
    const float* Flat = (const float*)(p.ws + OFF_FILT);
    const float* Fctx = Flat + (size_t)2 * 2 * 512 * 4096;
    for (int item = bid; item < 1024 + 512; item += nb) {
        __syncthreads();
        if (item < 1024) {
            const int c = item >> 1, bg = item & 1;
            float* Kc = sm;
            float* zb = sm + 8192;
            const float* hf = Flat + ((size_t)(order * 2 + 0) * 512 + c) * SEQ;
            const float* hb = Flat + ((size_t)(order * 2 + 1) * 512 + c) * SEQ;
            for (int i = tid; i < 8192; i += 512) { const int lag = i - 4096; Kc[i] = lag >= 0 ? hf[lag] : (lag > -4096 ? hb[-lag] : 0.f); }
            for (int i = tid; i < 4 * SEQ; i += 512) {
                const int bb = i >> 12, s = i & (SEQ - 1), tok = (bg * 4 + bb) * SEQ + s;
                zb[i] = order == 0 ? hy_conv3(P, cw, cb, tok, 1024 + c) : Zin[(size_t)tok * 512 + c];
            }
            __syncthreads();
            float acc[8][4];
#pragma unroll
            for (int i = 0; i < 8; ++i)
#pragma unroll
                for (int bb = 0; bb < 4; ++bb) acc[i][bb] = 0.f;
            for (int s = 0; s < SEQ; ++s) {
                float zv[4];
#pragma unroll
                for (int bb = 0; bb < 4; ++bb) zv[bb] = zb[bb * SEQ + s];
#pragma unroll
                for (int i = 0; i < 8; ++i) {
                    const float kv = Kc[tid + 512 * i - s + 4096];
#pragma unroll
                    for (int bb = 0; bb < 4; ++bb) acc[i][bb] += kv * zv[bb];
                }
            }
            const float sk = skip[c];
#pragma unroll
            for (int i = 0; i < 8; ++i)
#pragma unroll
                for (int bb = 0; bb < 4; ++bb) {
                    const int t = tid + 512 * i, tok = (bg * 4 + bb) * SEQ + t;
                    const float g = hy_conv3(P, cw, cb, tok, order * 512 + c);
                    Zout[(size_t)tok * 512 + c] = g * (acc[i][bb] + zb[bb * SEQ + t] * sk);
                }
        } else {
            const int c = item - 1024;
            float* Kc = sm;
            float* zb = sm + 512;
            const float* hf = Fctx + ((size_t)(order * 2 + 0) * 512 + c) * CTXL;
            const float* hb = Fctx + ((size_t)(order * 2 + 1) * 512 + c) * CTXL;
            for (int i = tid; i < 512; i += 512) { const int lag = i - 256; Kc[i] = lag >= 0 ? hf[lag] : (lag > -256 ? hb[-lag] : 0.f); }
            for (int i = tid; i < 8 * CTXL; i += 512) {
                const int bb = i >> 8, s = i & (CTXL - 1), tok = NL + bb * CTXL + s;
                zb[i] = order == 0 ? hy_conv3(P, cw, cb, tok, 1024 + c) : Zin[(size_t)tok * 512 + c];
            }
            __syncthreads();
            const int bb = tid >> 6, tl = tid & 63;
            float acc[4] = {0.f, 0.f, 0.f, 0.f};
            for (int s = 0; s < CTXL; ++s) {
                const float zv = zb[bb * CTXL + s];
#pragma unroll
                for (int i = 0; i < 4; ++i) acc[i] += Kc[tl + 64 * i - s + 256] * zv;
            }
            const float sk = skip[c];
#pragma unroll
            for (int i = 0; i < 4; ++i) {
                const int t = tl + 64 * i, tok = NL + bb * CTXL + t;
                const float g = hy_conv3(P, cw, cb, tok, order * 512 + c);
                Zout[(size_t)tok * 512 + c] = g * (acc[i] + zb[bb * CTXL + t] * sk);
            }
        }
    }
}

__device__ void ph_normgate_odd(const Params& p, int l, int bid, int nb) {
    const int tid = threadIdx.x, lane = tid & 63, wv = tid >> 6, o = l >> 1;
    const act_t* P = (const act_t*)(p.ws + OFF_BIG);
    const float* HX = (const float*)(p.ws + OFF_AUX);
    const float* Z2 = (const float*)(p.ws + OFF_Z2);
    act_t* MIX = (act_t*)(p.ws + OFF_U);
    for (int tok = bid * 8 + wv; tok < NT; tok += nb * 8) {
        const act_t* pr = P + (size_t)tok * ODD_N;
#pragma unroll
        for (int g = 0; g < 8; ++g) {
            const float x = Z2[(size_t)tok * 512 + g * 64 + lane];
            const float ms = wave_sum(x * x) * (1.f / 64.f);
            stf(MIX + (size_t)tok * DM + g * 64 + lane, x * rsqrtf(ms + LN_EPS) * p.in[I_HNORM][o * 512 + g * 64 + lane]);
        }
#pragma unroll
        for (int h = 0; h < 4; ++h) {
            const float* hx = HX + (size_t)tok * 1024 + 512 + h * 128;
            float x0 = hx[lane], x1 = hx[lane + 64];
            const float mean = wave_sum(x0 + x1) * (1.f / 128.f);
            x0 -= mean; x1 -= mean;
            const float var = wave_sum(x0 * x0 + x1 * x1) * (1.f / 128.f);
            const float r = rsqrtf(var + LN_EPS);
            const float* nw = p.in[I_RNW] + o * 512 + h * 128;
            const float g0 = ldf(pr + 3072 + h * 128 + lane), g1 = ldf(pr + 3072 + h * 128 + lane + 64);
            stf(MIX + (size_t)tok * DM + 512 + h * 128 + lane, x0 * r * nw[lane] * siluf_(g0));
            stf(MIX + (size_t)tok * DM + 512 + h * 128 + lane + 64, x1 * r * nw[lane + 64] * siluf_(g1));
        }
    }
}

__device__ void ph_ln(const Params& p, int l, int which, int ntok, int bid, int nb) {
    const int tid = threadIdx.x, lane = tid & 63, wv = tid >> 6;
    const float* R = (const float*)(p.ws + OFF_BIG);
    act_t* U = (act_t*)(p.ws + OFF_U);
    const float* lw = p.in[I_LNW] + (l * 2 + which) * 1024; const float* lb = p.in[I_LNB] + (l * 2 + which) * 1024;
    const int gi = which == 0 ? 2 : 5;
    for (int tok = bid * 8 + wv; tok < ntok; tok += nb * 8) {
        float* h = hrow(p, tok);
        const float* m = modrow(p, l, tok);
        const float* r = R + (size_t)tok * DM;
        float x[16]; float s = 0.f;
#pragma unroll
        for (int i = 0; i < 16; ++i) { const int d = lane + 64 * i; x[i] = ALPHA * h[d] + m[gi * 1024 + d] * r[d]; s += x[i]; }
        const float mean = wave_sum(s) * (1.f / 1024.f);
        float q = 0.f;
#pragma unroll
        for (int i = 0; i < 16; ++i) { x[i] -= mean; q += x[i] * x[i]; }
        const float rs = rsqrtf(wave_sum(q) * (1.f / 1024.f) + LN_EPS);
#pragma unroll
        for (int i = 0; i < 16; ++i) {
            const int d = lane + 64 * i;
            const float y = x[i] * rs * lw[d] + lb[d];
            h[d] = y;
            if (which == 0) stf(U + (size_t)tok * DM + d, y * (1.f + m[4 * 1024 + d]) + m[3 * 1024 + d]);
        }
    }
}

__device__ void ph_router(const Params& p, int l, int ntok, int bid, int nb) {
    const int tid = threadIdx.x, lane = tid & 63, wv = tid >> 6;
    const act_t* U = (const act_t*)(p.ws + OFF_U);
    const float* rw = p.in[I_RW] + (size_t)l * 1024 * 64;
    const float rb = p.in[I_RB][l * 64 + lane];
    int* cnt = (int*)(p.ws + OFF_CNT) + l * 64;
    int* tidx = (int*)(p.ws + OFF_TIDX); float* tgate = (float*)(p.ws + OFF_TGATE); int* tpos = (int*)(p.ws + OFF_TPOS);
    {
        int* stok = (int*)(p.ws + OFF_STOK); float* sgate = (float*)(p.ws + OFF_SGATE);
        for (int i = bid * 512 + tid; i < MAXROWS; i += nb * 512) { stok[i] = ZROW; sgate[i] = 0.f; }
        float4* F4 = (float4*)(p.ws + OFF_BIG);
        for (size_t i = (size_t)bid * 512 + tid; i < (size_t)NT * 256; i += (size_t)nb * 512) F4[i] = make_float4(0.f, 0.f, 0.f, 0.f);
    }
    for (int tok = bid * 8 + wv; tok < ntok; tok += nb * 8) {
        const act_t* u = U + (size_t)tok * DM;
        float a = 0.f;
        for (int k = 0; k < 1024; ++k) a += ldf(u + k) * rw[k * 64 + lane];
        const float score = sigmoidf_(a);
        float key = score + rb;
        float mysel = 0.f; int myidx = 0; float gsum = 0.f;
#pragma unroll
        for (int s = 0; s < TOPK; ++s) {
            float bv = key; int bi = lane;
#pragma unroll
            for (int o = 32; o > 0; o >>= 1) {
                const float ov = __shfl_xor(bv, o, 64); const int oi = __shfl_xor(bi, o, 64);
                if (ov > bv || (ov == bv && oi < bi)) { bv = ov; bi = oi; }
            }
            const float sc = __shfl(score, bi, 64);
            gsum += sc;
            if (lane == s) { mysel = sc; myidx = bi; }
            if (lane == bi) key = -1e30f;
        }
        if (lane < TOPK) {
            const int pos = atomicAdd(&cnt[myidx], 1);
            tidx[tok * 8 + lane] = myidx; tgate[tok * 8 + lane] = 2.5f * mysel / gsum; tpos[tok * 8 + lane] = pos;
        }
    }
}

__device__ __forceinline__ void moe_offsets(const Params& p, int l, int ntok, int* offs) {
    if (threadIdx.x == 0) {
        const int* cnt = (const int*)(p.ws + OFF_CNT) + l * 64;
        int a = 0;
        for (int e = 0; e < 64; ++e) { offs[e] = a; a += (cnt[e] + 255) & ~255; }
        offs[64] = a; offs[65] = a + ntok;
    }
    __syncthreads();
}

__device__ void ph_scatter(const Params& p, int l, int ntok, int bid, int nb, float* sm) {
    int* offs = (int*)sm;
    moe_offsets(p, l, ntok, offs);
    const int tid = threadIdx.x;
    const int* tidx = (const int*)(p.ws + OFF_TIDX); const float* tgate = (const float*)(p.ws + OFF_TGATE); const int* tpos = (const int*)(p.ws + OFF_TPOS);
    int* stok = (int*)(p.ws + OFF_STOK); float* sgate = (float*)(p.ws + OFF_SGATE);
    for (int i = bid * 512 + tid; i < ntok * 9; i += nb * 512) {
        if (i < ntok * 8) { const int row = offs[tidx[i]] + tpos[i]; stok[row] = i >> 3; sgate[row] = tgate[i]; }
        else { const int tok = i - ntok * 8; stok[offs[64] + tok] = tok; sgate[offs[64] + tok] = 1.f; }
    }
    __syncthreads();
}

__device__ __forceinline__ int moe_expert_of(const int* offs, int row) { int e = 0; while (e < 64 && row >= offs[e + 1]) ++e; return e; }

__device__ void ph_moe1(const Params& p, int l, int ntok, int bid, int nb, float* sm) {
    int* offs = (int*)(sm + 16 * 132 + 2 * 16 * 128);
    moe_offsets(p, l, ntok, offs);
    const act_t* U = (const act_t*)(p.ws + OFF_U);
    const int* stok = (const int*)(p.ws + OFF_STOK);
    float* H = (float*)(p.ws + OFF_H);
    const int nrt = offs[65] / 128;
    for (int t = bid; t < nrt * 2; t += nb) {
        const int tm = t >> 1, tn = t & 1, e = moe_expert_of(offs, tm * 128);
        const float* w1 = e < 64 ? p.in[I_W1] + ((size_t)l * 64 + e) * 1024 * 256 : p.in[I_SW1] + (size_t)l * 1024 * 256;
        const float* w3 = e < 64 ? p.in[I_W3] + ((size_t)l * 64 + e) * 1024 * 256 : p.in[I_SW3] + (size_t)l * 1024 * 256;
        gemm_tile_naive<true>(sm, [&](int r) { return U + (size_t)stok[r] * DM; }, w1, w3, 256, 256, 1024, tm * 128, tn * 128,
                              [&](int r, int c, float v, float v2) { H[(size_t)r * 256 + c] = siluf_(v) * v2; });
    }
    __syncthreads();
}

__device__ void ph_moe2(const Params& p, int l, int ntok, int bid, int nb, float* sm) {
    int* offs = (int*)(sm + 16 * 132 + 2 * 16 * 128);
    moe_offsets(p, l, ntok, offs);
    const int* stok = (const int*)(p.ws + OFF_STOK); const float* sgate = (const float*)(p.ws + OFF_SGATE);
    const float* H = (const float*)(p.ws + OFF_H);
    float* F = (float*)(p.ws + OFF_BIG);
    const int nrt = offs[65] / 128;
    for (int t = bid; t < nrt * 8; t += nb) {
        const int tm = t >> 3, tn = t & 7, e = moe_expert_of(offs, tm * 128);
        const float* w2 = e < 64 ? p.in[I_W2] + ((size_t)l * 64 + e) * 256 * 1024 : p.in[I_SW2] + (size_t)l * 256 * 1024;
        gemm_tile_naive<false>(sm, [&](int r) { return H + (size_t)r * 256; }, w2, w2, 1024, 1024, 256, tm * 128, tn * 128,
                               [&](int r, int c, float v, float) { const int tok = stok[r]; if (tok != ZROW) atomicAdd(F + (size_t)tok * DM + c, v * sgate[r]); });
    }
    __syncthreads();
}

#define NAIVE_LDS (98304 + 1024)
#define KARGS Params p, int l, int a
__global__ void __launch_bounds__(512, 2) k_prologue(KARGS) { extern __shared__ __attribute__((aligned(16))) float sm[]; ph_prologue(p, blockIdx.x, gridDim.x, sm); }
__global__ void __launch_bounds__(512, 2) k_modulate(KARGS) { ph_modulate(p, l, blockIdx.x, gridDim.x); }
__global__ void __launch_bounds__(512, 2) k_gemm_in(KARGS) { extern __shared__ __attribute__((aligned(16))) float sm[]; ph_gemm_in(p, l, blockIdx.x, gridDim.x, sm); }
__global__ void __launch_bounds__(512, 2) k_gemm_out(KARGS) { extern __shared__ __attribute__((aligned(16))) float sm[]; ph_gemm_out(p, l, blockIdx.x, gridDim.x, sm); }
__global__ void __launch_bounds__(512, 2) k_scan_even(KARGS) { ph_scan_even(p, l, a, blockIdx.x, gridDim.x); }
__global__ void __launch_bounds__(512, 2) k_normgate_even(KARGS) { ph_normgate_even(p, l, blockIdx.x, gridDim.x); }
__global__ void __launch_bounds__(512, 2) k_scan_odd(KARGS) { ph_scan_odd(p, l, a, blockIdx.x, gridDim.x); }
__global__ void __launch_bounds__(512, 2) k_hy_filt(KARGS) { extern __shared__ __attribute__((aligned(16))) float sm[]; ph_hy_filt(p, l, blockIdx.x, gridDim.x, sm); }
__global__ void __launch_bounds__(512, 2) k_hy_conv(KARGS) { extern __shared__ __attribute__((aligned(16))) float sm[]; ph_hy_conv(p, l, a, blockIdx.x, gridDim.x, sm); }
__global__ void __launch_bounds__(512, 2) k_normgate_odd(KARGS) { ph_normgate_odd(p, l, blockIdx.x, gridDim.x); }
__global__ void __launch_bounds__(512, 2) k_ln(KARGS) { ph_ln(p, l, a, (l == 3) ? NL : NT, blockIdx.x, gridDim.x); }
__global__ void __launch_bounds__(512, 2) k_router(KARGS) { ph_router(p, l, (l == 3) ? NL : NT, blockIdx.x, gridDim.x); }
__global__ void __launch_bounds__(512, 2) k_scatter(KARGS) { extern __shared__ __attribute__((aligned(16))) float sm[]; ph_scatter(p, l, (l == 3) ? NL : NT, blockIdx.x, gridDim.x, sm); }
__global__ void __launch_bounds__(512, 2) k_moe1(KARGS) { extern __shared__ __attribute__((aligned(16))) float sm[]; ph_moe1(p, l, (l == 3) ? NL : NT, blockIdx.x, gridDim.x, sm); }
__global__ void __launch_bounds__(512, 2) k_moe2(KARGS) { extern __shared__ __attribute__((aligned(16))) float sm[]; ph_moe2(p, l, (l == 3) ? NL : NT, blockIdx.x, gridDim.x, sm); }

extern "C" void kernel_launch(void* const* d_in, const int* in_sizes, int n_in, void* d_out, int out_size, void* d_ws, size_t ws_size, hipStream_t stream) {
    static int ok = 0;
    if (ok == 0) {
        if (n_in != 38 || out_size != NL * DM || ws_size < WS_END) { fprintf(stderr, "kernel_launch: bad shapes n_in %d out %d ws %zu (need %zu)\n", n_in, out_size, ws_size, (size_t)WS_END); ok = -1; return; }
        const void* ks[] = {(const void*)k_prologue, (const void*)k_gemm_in, (const void*)k_gemm_out, (const void*)k_hy_filt, (const void*)k_hy_conv, (const void*)k_scatter, (const void*)k_moe1, (const void*)k_moe2};
        for (auto k : ks) if (hipFuncSetAttribute(k, hipFuncAttributeMaxDynamicSharedMemorySize, NAIVE_LDS) != hipSuccess) { fprintf(stderr, "kernel_launch: hipFuncSetAttribute failed\n"); ok = -1; return; }
        ok = 1;
    }
    if (ok < 0) return;
    Params p{};
    for (int i = 0; i < 38; ++i) p.in[i] = (const float*)d_in[i];
    p.out = (float*)d_out; p.ws = (unsigned char*)d_ws;
    const int G = 1024;
#define LAUNCH(k, grid, lds, l, a) hipLaunchKernelGGL(k, dim3(grid), dim3(512), lds, stream, p, l, a)
    LAUNCH(k_prologue, G, NAIVE_LDS, 0, 0);
    for (int l = 0; l < 4; ++l) {
        LAUNCH(k_modulate, G, 0, l, 0);
        LAUNCH(k_gemm_in, G, NAIVE_LDS, l, 0);
        if ((l & 1) == 0) {
            LAUNCH(k_scan_even, 64, 0, l, 0);
            LAUNCH(k_scan_even, 64, 0, l, 1);
            LAUNCH(k_normgate_even, G, 0, l, 0);
        } else {
            LAUNCH(k_scan_odd, 32, 0, l, 0);
            LAUNCH(k_scan_odd, 32, 0, l, 1);
            LAUNCH(k_hy_filt, G, NAIVE_LDS, l, 0);
            LAUNCH(k_hy_conv, G, NAIVE_LDS, l, 0);
            LAUNCH(k_hy_conv, G, NAIVE_LDS, l, 1);
            LAUNCH(k_normgate_odd, G, 0, l, 0);
        }
        LAUNCH(k_gemm_out, G, NAIVE_LDS, l, 0);
        LAUNCH(k_ln, G, 0, l, 0);
        LAUNCH(k_router, G, 0, l, 0);
        LAUNCH(k_scatter, G, NAIVE_LDS, l, 0);
        LAUNCH(k_moe1, G, NAIVE_LDS, l, 0);
        LAUNCH(k_moe2, G, NAIVE_LDS, l, 0);
        LAUNCH(k_ln, G, 0, l, 1);
    }
}
```

```cpp
#include <hip/hip_runtime.h>
#include <stdint.h>
#include <stdio.h>

#define DM 1024
#define NBATCH 8
#define SEQ 4096
#define CTXL 256
#define NL (NBATCH * SEQ)
#define NC (NBATCH * CTXL)
#define NT (NL + NC)
#define ZROW NT
#define NEXP 64
#define TOPK 8
#define EH 256
#define EVEN_N 4112
#define ODD_N 3584
#define MAXROWS (NT * 8 + 64 * 256 + NT)
#define ALPHA 1.681792830507429f
#define LN_EPS 1e-5f

typedef float act_t;

#define MiB ((size_t)1 << 20)
#define OFF_CNT   ((size_t)64 << 10)
#define OFF_OFFS  ((size_t)80 << 10)
#define OFF_LB    ((size_t)96 << 10)
#define OFF_MOD   ((size_t)128 << 10)
#define OFF_HCTX  (4 * MiB)
#define OFF_TIDX  (12 * MiB)
#define OFF_TGATE (14 * MiB)
#define OFF_TPOS  (16 * MiB)
#define OFF_STOK  (18 * MiB)
#define OFF_SGATE (20 * MiB)
#define OFF_U     (22 * MiB)
#define OFF_BIG   (160 * MiB)
#define OFF_H     (OFF_BIG + 140 * MiB)
#define OFF_AUX   (708 * MiB)
#define OFF_Z1    (OFF_AUX + 136 * MiB)
#define OFF_Z2    (OFF_Z1 + 68 * MiB)
#define OFF_FILT  (OFF_Z2 + 68 * MiB)
#define WS_END    (OFF_FILT + 36 * MiB)

struct Params {
    const float* in[38];
    float* out;
    unsigned char* ws;
};

enum { I_X = 0, I_C, I_CTX, I_CCTX, I_ADAW, I_ADAB, I_LNW, I_LNB, I_EWIN, I_MGB, I_MNW, I_HLB, I_HNW, I_EWOUT, I_OWIN, I_HCW, I_HCB,
       I_HW1, I_HB1, I_HW2, I_HB2, I_HW3, I_HB3, I_HFREQ, I_HWOUT, I_HSKIP, I_HNORM, I_RLD, I_RNW, I_OWOUT, I_RW, I_RB, I_W1, I_W3, I_W2, I_SW1, I_SW3, I_SW2 };

__device__ __forceinline__ int opaque_tid() { int t = threadIdx.x; asm volatile("" : "+v"(t)); return t; }
__device__ __forceinline__ float ldf(const float* p) { return *p; }
__device__ __forceinline__ void stf(float* p, float v) { *p = v; }
__device__ __forceinline__ float sigmoidf_(float x) { return 1.f / (1.f + expf(-x)); }
__device__ __forceinline__ float siluf_(float x) { return x / (1.f + expf(-x)); }
__device__ __forceinline__ float wave_sum(float v) {
#pragma unroll
    for (int o = 32; o > 0; o >>= 1) v += __shfl_xor(v, o, 64);
    return v;
}
__device__ __forceinline__ float* hrow(const Params& p, int tok) {
    return tok < NL ? p.out + (size_t)tok * DM : (float*)(p.ws + OFF_HCTX) + (size_t)(tok - NL) * DM;
}
__device__ __forceinline__ const float* modrow(const Params& p, int l, int tok) {
    const int r = tok < NL ? (tok >> 12) : 8;
    return (const float*)(p.ws + OFF_MOD) + ((size_t)l * 9 + r) * 6144;
}
__device__ __forceinline__ int scan_tok(int b, int i, int dir) {
    return i < CTXL ? NL + b * CTXL + (dir ? CTXL - 1 - i : i) : b * SEQ + (dir ? SEQ - 1 - (i - CTXL) : (i - CTXL));
}

#define XB_TMO      128
#define XB_XCNT(j)  (256  + 64 * (j))
#define XB_XSUB(j)  (1280 + 64 * (j))
#define XB_XGEN(j)  (2304 + 64 * (j))
#define XB_TOP      3328
#define XB_TOPGEN   3392
#define XCD_BAR_WORDS 3456
#define XB_SPIN_CAP (1u << 24)
#define LAS __attribute__((address_space(3)))
__device__ __forceinline__ unsigned xb_ld(unsigned* p)              { return __hip_atomic_load(p, __ATOMIC_RELAXED, __HIP_MEMORY_SCOPE_AGENT); }
__device__ __forceinline__ unsigned xb_add(unsigned* p, unsigned v) { return __hip_atomic_fetch_add(p, v, __ATOMIC_RELAXED, __HIP_MEMORY_SCOPE_AGENT); }
__device__ __forceinline__ unsigned xb_xcc_id() { return (unsigned)__builtin_amdgcn_s_getreg((3 << 11) | 20) & 0xFu; }
#define XB_SPIN(cond, bar) do { unsigned _sp = 0; while (cond) { __builtin_amdgcn_s_sleep(1); \
    if ((++_sp & 255u) == 0u) { if (xb_ld(&(bar)[XB_TMO])) break; if (_sp > XB_SPIN_CAP) { atomicAdd(&(bar)[XB_TMO], 1u); break; } } } } while (0)
struct XcdBarrier { unsigned* bar; unsigned x; volatile LAS unsigned* st; };
__device__ __forceinline__ XcdBarrier xcd_barrier_post(unsigned* bar, volatile LAS unsigned* st) {
    XcdBarrier b; b.bar = bar; b.x = xb_xcc_id(); b.st = st;
    if (threadIdx.x == 0) (void)xb_add(&bar[XB_XCNT(b.x)], 1u);
    return b;
}
__device__ __forceinline__ void xcd_barrier_complete(unsigned* bar, unsigned x, unsigned& nloc, unsigned& nx) {
    const unsigned G = gridDim.x * gridDim.y * gridDim.z;
    unsigned sum, cnt, mine, sp = 0u;
    for (;;) {
        sum = 0u; cnt = 0u; mine = 0u;
#pragma unroll
        for (unsigned j = 0; j < 16; ++j) { const unsigned c = xb_ld(&bar[XB_XCNT(j)]); sum += c; cnt += (c > 0u) ? 1u : 0u; mine = (j == x) ? c : mine; }
        if (sum == G) break;
        __builtin_amdgcn_s_sleep(1);
        if ((++sp & 255u) == 0u) { if (xb_ld(&bar[XB_TMO])) break; if (sp > XB_SPIN_CAP) { atomicAdd(&bar[XB_TMO], 1u); break; } }
    }
    nloc = mine > 0u ? mine : 1u; nx = cnt > 0u ? cnt : 1u;
}
__device__ __forceinline__ void xcd_barrier(const XcdBarrier& b) {
    asm volatile("s_waitcnt vmcnt(0)" ::: "memory");
    __syncthreads();
    if (threadIdx.x == 0) {
        unsigned* bar = b.bar;
        __builtin_amdgcn_s_waitcnt(0);
        unsigned nloc = b.st[0], nx = b.st[1];
        if (nloc == 0u) { xcd_barrier_complete(bar, b.x, nloc, nx); b.st[0] = nloc; b.st[1] = nx; }
        const unsigned old = xb_add(&bar[XB_XSUB(b.x)], 1u);
        const unsigned gen = old / nloc;
        if (old + 1u == (gen + 1u) * nloc) {
            __builtin_amdgcn_fence(__ATOMIC_RELEASE, "agent");
            asm volatile("s_waitcnt vmcnt(0)" ::: "memory");
            const unsigned og = xb_add(&bar[XB_TOP], 1u);
            const unsigned tg = og / nx;
            if (og + 1u == (tg + 1u) * nx) xb_add(&bar[XB_TOPGEN], 1u);
            else XB_SPIN(xb_ld(&bar[XB_TOPGEN]) == tg, bar);
            __builtin_amdgcn_fence(__ATOMIC_ACQUIRE, "agent");
            xb_add(&bar[XB_XGEN(b.x)], 1u);
            asm volatile("s_waitcnt vmcnt(0)" ::: "memory");
        } else {
            XB_SPIN(xb_ld(&bar[XB_XGEN(b.x)]) == gen, bar);
            __builtin_amdgcn_fence(__ATOMIC_ACQUIRE, "agent");
            asm volatile("s_waitcnt vmcnt(0)" ::: "memory");
        }
    }
    __syncthreads();
}

__device__ __forceinline__ void ph_prologue(const Params& p, int bid, int nb, float* sm) {
    const int tid = opaque_tid();
    {
        const float4* x4 = (const float4*)p.in[I_X]; float4* o4 = (float4*)p.out;
        for (size_t i = (size_t)bid * 512 + tid; i < (size_t)NL * 256; i += (size_t)nb * 512) o4[i] = x4[i];
        const float4* c4 = (const float4*)p.in[I_CTX]; float4* h4 = (float4*)(p.ws + OFF_HCTX);
        for (size_t i = (size_t)bid * 512 + tid; i < (size_t)NC * 256; i += (size_t)nb * 512) h4[i] = c4[i];
    }
    if (bid == 0) {
        act_t* z = (act_t*)(p.ws + OFF_U) + (size_t)ZROW * DM;
        for (int i = tid; i < DM; i += 512) z[i] = 0;
    }
    if (bid == 1 % nb) {
        float* lb = (float*)(p.ws + OFF_LB);
        const float* hl = p.in[I_HLB];
        for (int j = tid; j < 512; j += 512) {
            const float a = hl[j], b = hl[512 + j], mx = fmaxf(a, b);
            const float ea = expf(a - mx), eb = expf(b - mx);
            lb[j] = 0.f; lb[512 + j] = eb / (ea + eb);
        }
    }
    {
        float* act = sm;
        bool filled = false;
        for (int item = bid; item < 48; item += nb) {
            if (!filled) {
                for (int i = tid; i < 9 * 1024; i += 512) {
                    const int r = i >> 10, k = i & 1023;
                    const float v = r < 8 ? p.in[I_C][r * 1024 + k] : p.in[I_CCTX][k];
                    act[i] = siluf_(v);
                }
                __syncthreads(); filled = true;
            }
            const int l = item / 12, j = (item % 12) * 512 + tid;
            const float* w = p.in[I_ADAW] + (size_t)l * 1024 * 6144 + j;
            float acc[9];
#pragma unroll
            for (int r = 0; r < 9; ++r) acc[r] = 0.f;
            for (int k = 0; k < 1024; ++k) {
                const float wv = w[(size_t)k * 6144];
#pragma unroll
                for (int r = 0; r < 9; ++r) acc[r] += act[r * 1024 + k] * wv;
            }
            const float bv = p.in[I_ADAB][l * 6144 + j];
            float* mod = (float*)(p.ws + OFF_MOD);
#pragma unroll
            for (int r = 0; r < 9; ++r) mod[((size_t)l * 9 + r) * 6144 + j] = acc[r] + bv;
        }
    }
}

__device__ __forceinline__ void ph_modulate(const Params& p, int l, int bid, int nb) {
    const int tid = opaque_tid();
    act_t* U = (act_t*)(p.ws + OFF_U);
    for (size_t i = (size_t)bid * 512 + tid; i < (size_t)NT * 256; i += (size_t)nb * 512) {
        const int tok = (int)(i >> 8), d4 = (int)(i & 255) * 4;
        const float4 h = *(const float4*)(hrow(p, tok) + d4);
        const float* m = modrow(p, l, tok);
        const float4 sh = *(const float4*)(m + d4), sc = *(const float4*)(m + 1024 + d4);
        float4 u; u.x = h.x * (1.f + sc.x) + sh.x; u.y = h.y * (1.f + sc.y) + sh.y; u.z = h.z * (1.f + sc.z) + sh.z; u.w = h.w * (1.f + sc.w) + sh.w;
        *(float4*)(U + (size_t)tok * DM + d4) = u;
    }
}

template <bool DUAL, class ARow, class Epi>
__device__ __forceinline__ void gemm_tile_naive(float* sm, ARow arow, const float* B0, const float* B1, int ldb, int N, int K, int m0, int n0, Epi epi) {
    float* As = sm;
    float* Bs = sm + 16 * 132;
    float* Bs2 = Bs + 16 * 128;
    const int tid = opaque_tid(), ty = tid >> 5, tx = tid & 31;
    float acc[8][4], acc2[8][4];
#pragma unroll
    for (int i = 0; i < 8; ++i)
#pragma unroll
        for (int j = 0; j < 4; ++j) { acc[i][j] = 0.f; acc2[i][j] = 0.f; }
    const int ar = tid >> 2, ak = (tid & 3) * 4;
    const act_t* ap = arow(m0 + ar);
    const int bk = tid >> 5, bn = (tid & 31) * 4;
    const bool bok = (n0 + bn) < N;
    for (int k0 = 0; k0 < K; k0 += 16) {
        const float a0 = ldf(ap + k0 + ak), a1 = ldf(ap + k0 + ak + 1), a2 = ldf(ap + k0 + ak + 2), a3 = ldf(ap + k0 + ak + 3);
        float4 b = make_float4(0.f, 0.f, 0.f, 0.f), b2 = b;
        if (bok) { b = *(const float4*)(B0 + (size_t)(k0 + bk) * ldb + n0 + bn); if (DUAL) b2 = *(const float4*)(B1 + (size_t)(k0 + bk) * ldb + n0 + bn); }
        __syncthreads();
        As[(ak + 0) * 132 + ar] = a0; As[(ak + 1) * 132 + ar] = a1; As[(ak + 2) * 132 + ar] = a2; As[(ak + 3) * 132 + ar] = a3;
        *(float4*)(Bs + bk * 128 + bn) = b;
        if (DUAL) *(float4*)(Bs2 + bk * 128 + bn) = b2;
        __syncthreads();
#pragma unroll
        for (int kk = 0; kk < 16; ++kk) {
            const float4 x0 = *(const float4*)(As + kk * 132 + ty * 8), x1 = *(const float4*)(As + kk * 132 + ty * 8 + 4);
            const float4 y = *(const float4*)(Bs + kk * 128 + tx * 4);
            const float a[8] = {x0.x, x0.y, x0.z, x0.w, x1.x, x1.y, x1.z, x1.w};
            const float bb[4] = {y.x, y.y, y.z, y.w};
#pragma unroll
            for (int i = 0; i < 8; ++i)
#pragma unroll
                for (int j = 0; j < 4; ++j) acc[i][j] += a[i] * bb[j];
            if (DUAL) {
                const float4 y2 = *(const float4*)(Bs2 + kk * 128 + tx * 4);
                const float b2v[4] = {y2.x, y2.y, y2.z, y2.w};
#pragma unroll
                for (int i = 0; i < 8; ++i)
#pragma unroll
                    for (int j = 0; j < 4; ++j) acc2[i][j] += a[i] * b2v[j];
            }
        }
    }
#pragma unroll
    for (int i = 0; i < 8; ++i)
#pragma unroll
        for (int j = 0; j < 4; ++j) {
            const int c = n0 + tx * 4 + j;
            if (c < N) epi(m0 + ty * 8 + i, c, acc[i][j], acc2[i][j]);
        }
    __syncthreads();
}

__device__ __forceinline__ void ph_gemm_in(const Params& p, int l, int bid, int nb, float* sm) {
    const bool even = (l & 1) == 0;
    const int N = even ? EVEN_N : ODD_N;
    const float* W = even ? p.in[I_EWIN] + (size_t)(l >> 1) * 1024 * EVEN_N : p.in[I_OWIN] + (size_t)(l >> 1) * 1024 * ODD_N;
    const act_t* U = (const act_t*)(p.ws + OFF_U);
    act_t* P = (act_t*)(p.ws + OFF_BIG);
    const int ntn = (N + 127) / 128, ntm = NT / 128;
    for (int t = bid; t < ntm * ntn; t += nb) {
        const int tm = t / ntn, tn = t % ntn;
        gemm_tile_naive<false>(sm, [&](int r) { return U + (size_t)r * DM; }, W, W, N, N, 1024, tm * 128, tn * 128,
                               [&](int r, int c, float v, float) { stf(P + (size_t)r * N + c, v); });
    }
}

__device__ __forceinline__ void ph_gemm_out(const Params& p, int l, int bid, int nb, float* sm) {
    const bool even = (l & 1) == 0;
    const float* W = (even ? p.in[I_EWOUT] : p.in[I_OWOUT]) + (size_t)(l >> 1) * 1024 * 1024;
    const act_t* A = (const act_t*)(p.ws + OFF_U);
    float* Y = (float*)(p.ws + OFF_BIG);
    for (int t = bid; t < (NT / 128) * 8; t += nb) {
        const int tm = t / 8, tn = t % 8;
        gemm_tile_naive<false>(sm, [&](int r) { return A + (size_t)r * DM; }, W, W, 1024, 1024, 1024, tm * 128, tn * 128,
                               [&](int r, int c, float v, float) { Y[(size_t)r * DM + c] = v; });
    }
}

__device__ __forceinline__ void ph_scan_even(const Params& p, int l, int dir, int bid, int nb) {
    const int tid = opaque_tid(), v = tid >> 2, kq = tid & 3;
    const act_t* P = (const act_t*)(p.ws + OFF_BIG);
    float* HX = (float*)(p.ws + OFF_AUX);
    const int e = l >> 1;
    for (int item = bid; item < 64; item += nb) {
        const int kind = item >> 5, b = (item >> 2) & 7, h = item & 3;
        if (kind == 0) {
            const float* gb = p.in[I_MGB] + e * 16;
            const float gbi = gb[(dir ? 2 : 0) * 4 + h], gbf = gb[(dir ? 3 : 1) * 4 + h];
            float C[16], n[16];
#pragma unroll
            for (int j = 0; j < 16; ++j) { C[j] = 0.f; n[j] = 0.f; }
            float m = -1e30f;
            for (int i = 0; i < CTXL + SEQ; ++i) {
                const int tok = scan_tok(b, i, dir);
                const act_t* pr = P + (size_t)tok * EVEN_N;
                const float ig = ldf(pr + 1536 + (dir ? 8 : 0) + h) + gbi;
                const float fg = ldf(pr + 1536 + (dir ? 12 : 4) + h) + gbf;
                const float lf = fminf(fg, 0.f) - log1pf(expf(-fabsf(fg)));
                const float m_new = fmaxf(lf + m, ig);
                const float a = expf(lf + m - m_new), bg = expf(ig - m_new);
                const float vv = ldf(pr + 512 + h * 128 + v);
                float num = 0.f, den = 0.f;
#pragma unroll
                for (int j = 0; j < 16; ++j) {
                    const float kj = ldf(pr + 256 + h * 64 + kq * 16 + j), qj = ldf(pr + h * 64 + kq * 16 + j) * 0.125f;
                    C[j] = a * C[j] + bg * vv * kj; n[j] = a * n[j] + bg * kj;
                    num += C[j] * qj; den += n[j] * qj;
                }
                num += __shfl_xor(num, 1, 64); num += __shfl_xor(num, 2, 64);
                den += __shfl_xor(den, 1, 64); den += __shfl_xor(den, 2, 64);
                const float hv = num / fmaxf(fabsf(den), expf(-m_new));
                if (kq == 0) { float* o = HX + (size_t)tok * 1024 + h * 128 + v; *o = dir ? *o + hv : hv; }
                m = m_new;
            }
        } else {
            const float* lbp = (const float*)(p.ws + OFF_LB) + e * 512 + h * 128 + kq * 32;
            float S[32], lb[32];
#pragma unroll
            for (int j = 0; j < 32; ++j) { S[j] = 0.f; lb[j] = lbp[j]; }
            for (int i = 0; i < CTXL + SEQ; ++i) {
                const int tok = scan_tok(b, i, dir);
                const act_t* pr = P + (size_t)tok * EVEN_N;
                const float iv = ldf(pr + 2064 + h * 128 + v);
                float o = 0.f;
#pragma unroll
                for (int j = 0; j < 32; ++j) {
                    const int k = h * 128 + kq * 32 + j;
                    const float fp = ldf(pr + (dir ? 3088 : 2576) + k);
                    const float f = lb[j] + (1.f - lb[j]) * sigmoidf_(fp);
                    const float qj = siluf_(ldf(pr + 1552 + k));
                    S[j] = f * S[j] + (1.f - f) * iv;
                    o += qj * S[j];
                }
                o += __shfl_xor(o, 1, 64); o += __shfl_xor(o, 2, 64);
                if (kq == 0) { float* op = HX + (size_t)tok * 1024 + 512 + h * 128 + v; *op = dir ? *op + o : o; }
            }
        }
    }
}

__device__ __forceinline__ void ph_normgate_even(const Params& p, int l, int bid, int nb) {
    const int tid = opaque_tid(), lane = tid & 63, wv = tid >> 6;
    const act_t* P = (const act_t*)(p.ws + OFF_BIG);
    const float* HX = (const float*)(p.ws + OFF_AUX);
    act_t* MIX = (act_t*)(p.ws + OFF_U);
    const int e = l >> 1;
    for (int it = bid * 8 + wv; it < NT * 8; it += nb * 8) {
        const int tok = it >> 3, g = it & 7;
        const float* hx = HX + (size_t)tok * 1024 + g * 128;
        float x0 = hx[lane], x1 = hx[lane + 64];
        const act_t* pr = P + (size_t)tok * EVEN_N;
        if (g < 4) {
            const float mean = wave_sum(x0 + x1) * (1.f / 128.f);
            x0 -= mean; x1 -= mean;
            const float var = wave_sum(x0 * x0 + x1 * x1) * (1.f / 128.f);
            const float r = rsqrtf(var + LN_EPS);
            const float* nw = p.in[I_MNW] + e * 512 + g * 128;
            const float o0 = ldf(pr + 1024 + g * 128 + lane), o1 = ldf(pr + 1024 + g * 128 + lane + 64);
            stf(MIX + (size_t)tok * DM + g * 128 + lane, x0 * r * nw[lane] * sigmoidf_(o0));
            stf(MIX + (size_t)tok * DM + g * 128 + lane + 64, x1 * r * nw[lane + 64] * sigmoidf_(o1));
        } else {
            const int h = g - 4;
            const float ms = wave_sum(x0 * x0 + x1 * x1) * (1.f / 128.f);
            const float r = rsqrtf(ms + LN_EPS);
            const float* nw = p.in[I_HNW] + e * 512 + h * 128;
            const float g0 = ldf(pr + 3600 + h * 128 + lane), g1 = ldf(pr + 3600 + h * 128 + lane + 64);
            stf(MIX + (size_t)tok * DM + 512 + h * 128 + lane, x0 * r * nw[lane] * siluf_(g0));
            stf(MIX + (size_t)tok * DM + 512 + h * 128 + lane + 64, x1 * r * nw[lane + 64] * siluf_(g1));
        }
    }
}

__device__ __forceinline__ void ph_scan_odd(const Params& p, int l, int dir, int bid, int nb) {
    const int tid = opaque_tid(), v = tid >> 2, kq = tid & 3;
    const act_t* P = (const act_t*)(p.ws + OFF_BIG);
    float* HX = (float*)(p.ws + OFF_AUX);
    const int o = l >> 1;
    for (int item = bid; item < 32; item += nb) {
        const int b = item >> 2, h = item & 3;
        const float gamma = expf(p.in[I_RLD][o * 8 + dir * 4 + h]);
        float S[32], inv[32];
#pragma unroll
        for (int j = 0; j < 32; ++j) { S[j] = 0.f; inv[j] = powf(10000.f, -(float)j / 32.f); }
        for (int i = 0; i < CTXL + SEQ; ++i) {
            const int tok = scan_tok(b, i, dir);
            const bool lat = tok < NL;
            const int t = tok & (SEQ - 1);
            const float pos = (kq < 2) ? (float)(t >> 6) : (float)(t & 63);
            const act_t* pr = P + (size_t)tok * ODD_N;
            const float vv = ldf(pr + 2560 + h * 128 + v);
            float acc = 0.f;
#pragma unroll
            for (int j = 0; j < 32; ++j) {
                const int dim = kq * 32 + j, pd = dim ^ 32;
                float qv = ldf(pr + 1536 + h * 128 + dim), kv = ldf(pr + 2048 + h * 128 + dim);
                if (lat) {
                    const float qp = ldf(pr + 1536 + h * 128 + pd), kp = ldf(pr + 2048 + h * 128 + pd);
                    const float ang = pos * inv[j];
                    const float c = cosf(ang), s = sinf(ang);
                    if ((dim & 32) == 0) { qv = qv * c - qp * s; kv = kv * c - kp * s; }
                    else { qv = qp * s + qv * c; kv = kp * s + kv * c; }
                }
                kv *= 0.08838834764831845f;
                S[j] = gamma * S[j] + kv * vv;
                acc += qv * S[j];
            }
            acc += __shfl_xor(acc, 1, 64); acc += __shfl_xor(acc, 2, 64);
            if (kq == 0) { float* op = HX + (size_t)tok * 1024 + 512 + h * 128 + v; *op = dir ? *op + acc : acc; }
        }
    }
}

__device__ __forceinline__ void ph_hy_filt(const Params& p, int l, int bid, int nb, float* sm) {
    const int tid = opaque_tid(), o = l >> 1;
    float* z = sm;
    float* h1 = sm + 64;
    float* h2 = sm + 128;
    float* h3 = sm + 192;
    const float* fw1 = p.in[I_HW1] + o * 33 * 64; const float* fb1 = p.in[I_HB1] + o * 64;
    const float* fw2 = p.in[I_HW2] + o * 64 * 64; const float* fb2 = p.in[I_HB2] + o * 64;
    const float* fw3 = p.in[I_HW3] + o * 64 * 64; const float* fb3 = p.in[I_HB3] + o * 64;
    const float* freq = p.in[I_HFREQ] + o * 64;
    const float* wout = p.in[I_HWOUT] + (size_t)o * 64 * 2048;
    float* Flat = (float*)(p.ws + OFF_FILT);
    float* Fctx = Flat + (size_t)2 * 2 * 512 * 4096;
    for (int item = bid; item < SEQ + CTXL; item += nb) {
        const bool isctx = item >= SEQ;
        const int L = isctx ? CTXL : SEQ, pos = isctx ? item - SEQ : item;
        const float t = (float)pos / (float)(L - 1);
        __syncthreads();
        if (tid == 0) z[0] = t;
        if (tid < 16) {
            const float f = 1e-4f + (float)tid * ((15.0f - 1e-4f) / 15.0f);
            const float w = 2.0f * 3.14159265358979323846f * (float)pos / (float)L * f;
            z[1 + tid] = cosf(w); z[17 + tid] = sinf(w);
        }
        __syncthreads();
        if (tid < 64) { float a = fb1[tid];
#pragma unroll 1
            for (int k = 0; k < 33; ++k) a += z[k] * fw1[k * 64 + tid]; h1[tid] = sinf(freq[tid] * a); }
        __syncthreads();
        if (tid < 64) { float a = fb2[tid];
#pragma unroll 4
            for (int k = 0; k < 64; ++k) a += h1[k] * fw2[k * 64 + tid]; h2[tid] = sinf(freq[tid] * a); }
        __syncthreads();
        if (tid < 64) { float a = fb3[tid];
#pragma unroll 4
            for (int k = 0; k < 64; ++k) a += h2[k] * fw3[k * 64 + tid]; h3[tid] = sinf(freq[tid] * a); }
        __syncthreads();
#pragma unroll 1
        for (int r = 0; r < 4; ++r) {
            const int col = tid + 512 * r, c = col & 511, od = col >> 9;
            float a = 0.f;
#pragma unroll 4
            for (int k = 0; k < 64; ++k) a += h3[k] * wout[k * 2048 + col];
            const float delta = 3.0701134573253944f + (float)c * ((15.350567286626972f - 3.0701134573253944f) / 511.0f);
            a *= expf(-t * delta);
            if (isctx) Fctx[((size_t)od * 512 + c) * CTXL + pos] = a; else Flat[((size_t)od * 512 + c) * SEQ + pos] = a;
        }
    }
}

__device__ __forceinline__ float hy_conv3(const act_t* P, const float* cw, const float* cb, int tok, int j) {
    const bool lat = tok < NL;
    const int L = lat ? SEQ : CTXL, t = lat ? (tok & (SEQ - 1)) : ((tok - NL) & (CTXL - 1));
    const act_t* pr = P + (size_t)tok * ODD_N + j;
    float a = ldf(pr) * cw[1536 + j] + cb[j];
    if (t > 0) a += ldf(pr - ODD_N) * cw[j];
    if (t < L - 1) a += ldf(pr + ODD_N) * cw[2 * 1536 + j];
    return a;
}

__device__ __forceinline__ void ph_hy_conv(const Params& p, int l, int order, int bid, int nb, float* sm) {
    const int tid = opaque_tid(), o = l >> 1;
    const act_t* P = (const act_t*)(p.ws + OFF_BIG);
    const float* cw = p.in[I_HCW] + o * 3 * 1536; const float* cb = p.in[I_HCB] + o * 1536;
    const float* skip = p.in[I_HSKIP] + o * 1024 + order * 512;
    const float* Zin = (const float*)(p.ws + OFF_Z1);
    float* Zout = (float*)(p.ws + (order == 0 ? OFF_Z1 : OFF_Z2));
    const float* Flat = (const float*)(p.ws + OFF_FILT);
    const float* Fctx = Flat + (size_t)2 * 2 * 512 * 4096;
    for (int item = bid; item < 1024 + 512; item += nb) {
        __syncthreads();
        if (item < 1024) {
            const int c = item >> 1, bg = item & 1;
            float* Kc = sm;
            float* zb = sm + 8192;
            const float* hf = Flat + ((size_t)(order * 2 + 0) * 512 + c) * SEQ;
            const float* hb = Flat + ((size_t)(order * 2 + 1) * 512 + c) * SEQ;
            for (int i = tid; i < 8192; i += 512) { const int lag = i - 4096; Kc[i] = lag >= 0 ? hf[lag] : (lag > -4096 ? hb[-lag] : 0.f); }
            for (int i = tid; i < 4 * SEQ; i += 512) {
                const int bb = i >> 12, s = i & (SEQ - 1), tok = (bg * 4 + bb) * SEQ + s;
                zb[i] = order == 0 ? hy_conv3(P, cw, cb, tok, 1024 + c) : Zin[(size_t)tok * 512 + c];
            }
            __syncthreads();
            float acc[8][4];
#pragma unroll
            for (int i = 0; i < 8; ++i)
#pragma unroll
                for (int bb = 0; bb < 4; ++bb) acc[i][bb] = 0.f;
            for (int s = 0; s < SEQ; ++s) {
                float zv[4];
#pragma unroll
                for (int bb = 0; bb < 4; ++bb) zv[bb] = zb[bb * SEQ + s];
#pragma unroll
                for (int i = 0; i < 8; ++i) {
                    const float kv = Kc[tid + 512 * i - s + 4096];
#pragma unroll
                    for (int bb = 0; bb < 4; ++bb) acc[i][bb] += kv * zv[bb];
                }
            }
            const float sk = skip[c];
#pragma unroll
            for (int i = 0; i < 8; ++i)
#pragma unroll
                for (int bb = 0; bb < 4; ++bb) {
                    const int t = tid + 512 * i, tok = (bg * 4 + bb) * SEQ + t;
                    const float g = hy_conv3(P, cw, cb, tok, order * 512 + c);
                    Zout[(size_t)tok * 512 + c] = g * (acc[i][bb] + zb[bb * SEQ + t] * sk);
                }
        } else {
            const int c = item - 1024;
            float* Kc = sm;
            float* zb = sm + 512;
            const float* hf = Fctx + ((size_t)(order * 2 + 0) * 512 + c) * CTXL;
            const float* hb = Fctx + ((size_t)(order * 2 + 1) * 512 + c) * CTXL;
            for (int i = tid; i < 512; i += 512) { const int lag = i - 256; Kc[i] = lag >= 0 ? hf[lag] : (lag > -256 ? hb[-lag] : 0.f); }
            for (int i = tid; i < 8 * CTXL; i += 512) {
                const int bb = i >> 8, s = i & (CTXL - 1), tok = NL + bb * CTXL + s;
                zb[i] = order == 0 ? hy_conv3(P, cw, cb, tok, 1024 + c) : Zin[(size_t)tok * 512 + c];
            }
            __syncthreads();
            const int bb = tid >> 6, tl = tid & 63;
            float acc[4] = {0.f, 0.f, 0.f, 0.f};
            for (int s = 0; s < CTXL; ++s) {
                const float zv = zb[bb * CTXL + s];
#pragma unroll
                for (int i = 0; i < 4; ++i) acc[i] += Kc[tl + 64 * i - s + 256] * zv;
            }
            const float sk = skip[c];
#pragma unroll
            for (int i = 0; i < 4; ++i) {
                const int t = tl + 64 * i, tok = NL + bb * CTXL + t;
                const float g = hy_conv3(P, cw, cb, tok, order * 512 + c);
                Zout[(size_t)tok * 512 + c] = g * (acc[i] + zb[bb * CTXL + t] * sk);
            }
        }
    }
}

__device__ __forceinline__ void ph_normgate_odd(const Params& p, int l, int bid, int nb) {
    const int tid = opaque_tid(), lane = tid & 63, wv = tid >> 6, o = l >> 1;
    const act_t* P = (const act_t*)(p.ws + OFF_BIG);
    const float* HX = (const float*)(p.ws + OFF_AUX);
    const float* Z2 = (const float*)(p.ws + OFF_Z2);
    act_t* MIX = (act_t*)(p.ws + OFF_U);
    for (int tok = bid * 8 + wv; tok < NT; tok += nb * 8) {
        const act_t* pr = P + (size_t)tok * ODD_N;
#pragma unroll
        for (int g = 0; g < 8; ++g) {
            const float x = Z2[(size_t)tok * 512 + g * 64 + lane];
            const float ms = wave_sum(x * x) * (1.f / 64.f);
            stf(MIX + (size_t)tok * DM + g * 64 + lane, x * rsqrtf(ms + LN_EPS) * p.in[I_HNORM][o * 512 + g * 64 + lane]);
        }
#pragma unroll
        for (int h = 0; h < 4; ++h) {
            const float* hx = HX + (size_t)tok * 1024 + 512 + h * 128;
            float x0 = hx[lane], x1 = hx[lane + 64];
            const float mean = wave_sum(x0 + x1) * (1.f / 128.f);
            x0 -= mean; x1 -= mean;
            const float var = wave_sum(x0 * x0 + x1 * x1) * (1.f / 128.f);
            const float r = rsqrtf(var + LN_EPS);
            const float* nw = p.in[I_RNW] + o * 512 + h * 128;
            const float g0 = ldf(pr + 3072 + h * 128 + lane), g1 = ldf(pr + 3072 + h * 128 + lane + 64);
            stf(MIX + (size_t)tok * DM + 512 + h * 128 + lane, x0 * r * nw[lane] * siluf_(g0));
            stf(MIX + (size_t)tok * DM + 512 + h * 128 + lane + 64, x1 * r * nw[lane + 64] * siluf_(g1));
        }
    }
}

__device__ __forceinline__ void ph_ln(const Params& p, int l, int which, int ntok, int bid, int nb) {
    const int tid = opaque_tid(), lane = tid & 63, wv = tid >> 6;
    const float* R = (const float*)(p.ws + OFF_BIG);
    act_t* U = (act_t*)(p.ws + OFF_U);
    const float* lw = p.in[I_LNW] + (l * 2 + which) * 1024; const float* lb = p.in[I_LNB] + (l * 2 + which) * 1024;
    const int gi = which == 0 ? 2 : 5;
    for (int tok = bid * 8 + wv; tok < ntok; tok += nb * 8) {
        float* h = hrow(p, tok);
        const float* m = modrow(p, l, tok);
        const float* r = R + (size_t)tok * DM;
        float x[16]; float s = 0.f;
#pragma unroll
        for (int i = 0; i < 16; ++i) { const int d = lane + 64 * i; const float rv = which ? __hip_atomic_load(r + d, __ATOMIC_RELAXED, __HIP_MEMORY_SCOPE_AGENT) : r[d]; x[i] = ALPHA * h[d] + m[gi * 1024 + d] * rv; s += x[i]; }
        const float mean = wave_sum(s) * (1.f / 1024.f);
        float q = 0.f;
#pragma unroll
        for (int i = 0; i < 16; ++i) { x[i] -= mean; q += x[i] * x[i]; }
        const float rs = rsqrtf(wave_sum(q) * (1.f / 1024.f) + LN_EPS);
#pragma unroll
        for (int i = 0; i < 16; ++i) {
            const int d = lane + 64 * i;
            const float y = x[i] * rs * lw[d] + lb[d];
            h[d] = y;
            if (which == 0) stf(U + (size_t)tok * DM + d, y * (1.f + m[4 * 1024 + d]) + m[3 * 1024 + d]);
        }
    }
}

__device__ __forceinline__ void ph_router(const Params& p, int l, int ntok, int bid, int nb) {
    const int tid = opaque_tid(), lane = tid & 63, wv = tid >> 6;
    const act_t* U = (const act_t*)(p.ws + OFF_U);
    const float* rw = p.in[I_RW] + (size_t)l * 1024 * 64;
    const float rb = p.in[I_RB][l * 64 + lane];
    int* cnt = (int*)(p.ws + OFF_CNT) + l * 64;
    int* tidx = (int*)(p.ws + OFF_TIDX); float* tgate = (float*)(p.ws + OFF_TGATE); int* tpos = (int*)(p.ws + OFF_TPOS);
    {
        int* stok = (int*)(p.ws + OFF_STOK); float* sgate = (float*)(p.ws + OFF_SGATE);
        for (int i = bid * 512 + tid; i < MAXROWS; i += nb * 512) { stok[i] = ZROW; sgate[i] = 0.f; }
        float* F1 = (float*)(p.ws + OFF_BIG);
        for (size_t i = (size_t)bid * 512 + tid; i < (size_t)NT * 1024; i += (size_t)nb * 512) __hip_atomic_store(F1 + i, 0.f, __ATOMIC_RELAXED, __HIP_MEMORY_SCOPE_AGENT);
    }
    for (int tok = bid * 8 + wv; tok < ntok; tok += nb * 8) {
        const act_t* u = U + (size_t)tok * DM;
        float a = 0.f;
        for (int k = 0; k < 1024; ++k) a += ldf(u + k) * rw[k * 64 + lane];
        const float score = sigmoidf_(a);
        float key = score + rb;
        float mysel = 0.f; int myidx = 0; float gsum = 0.f;
#pragma unroll
        for (int s = 0; s < TOPK; ++s) {
            float bv = key; int bi = lane;
#pragma unroll
            for (int o = 32; o > 0; o >>= 1) {
                const float ov = __shfl_xor(bv, o, 64); const int oi = __shfl_xor(bi, o, 64);
                if (ov > bv || (ov == bv && oi < bi)) { bv = ov; bi = oi; }
            }
            const float sc = __shfl(score, bi, 64);
            gsum += sc;
            if (lane == s) { mysel = sc; myidx = bi; }
            if (lane == bi) key = -1e30f;
        }
        if (lane < TOPK) {
            const int pos = atomicAdd(&cnt[myidx], 1);
            tidx[tok * 8 + lane] = myidx; tgate[tok * 8 + lane] = 2.5f * mysel / gsum; tpos[tok * 8 + lane] = pos;
        }
    }
}

__device__ __forceinline__ void moe_offsets(const Params& p, int l, int ntok, int* offs) {
    if (threadIdx.x == 0) {
        const int* cnt = (const int*)(p.ws + OFF_CNT) + l * 64;
        int a = 0;
        for (int e = 0; e < 64; ++e) { offs[e] = a; a += (__hip_atomic_load(cnt + e, __ATOMIC_RELAXED, __HIP_MEMORY_SCOPE_AGENT) + 255) & ~255; }
        offs[64] = a; offs[65] = a + ntok;
    }
    __syncthreads();
}

__device__ __forceinline__ void ph_scatter(const Params& p, int l, int ntok, int bid, int nb, float* sm) {
    int* offs = (int*)sm;
    moe_offsets(p, l, ntok, offs);
    const int tid = opaque_tid();
    const int* tidx = (const int*)(p.ws + OFF_TIDX); const float* tgate = (const float*)(p.ws + OFF_TGATE); const int* tpos = (const int*)(p.ws + OFF_TPOS);
    int* stok = (int*)(p.ws + OFF_STOK); float* sgate = (float*)(p.ws + OFF_SGATE);
    for (int i = bid * 512 + tid; i < ntok * 9; i += nb * 512) {
        if (i < ntok * 8) { const int row = offs[tidx[i]] + tpos[i]; stok[row] = i >> 3; sgate[row] = tgate[i]; }
        else { const int tok = i - ntok * 8; stok[offs[64] + tok] = tok; sgate[offs[64] + tok] = 1.f; }
    }
    __syncthreads();
}

__device__ __forceinline__ int moe_expert_of(const int* offs, int row) { int e = 0; while (e < 64 && row >= offs[e + 1]) ++e; return e; }

__device__ __forceinline__ void ph_moe1(const Params& p, int l, int ntok, int bid, int nb, float* sm) {
    int* offs = (int*)(sm + 16 * 132 + 2 * 16 * 128);
    moe_offsets(p, l, ntok, offs);
    const act_t* U = (const act_t*)(p.ws + OFF_U);
    const int* stok = (const int*)(p.ws + OFF_STOK);
    float* H = (float*)(p.ws + OFF_H);
    const int nrt = offs[65] / 128;
    for (int t = bid; t < nrt * 2; t += nb) {
        const int tm = t >> 1, tn = t & 1, e = moe_expert_of(offs, tm * 128);
        const float* w1 = e < 64 ? p.in[I_W1] + ((size_t)l * 64 + e) * 1024 * 256 : p.in[I_SW1] + (size_t)l * 1024 * 256;
        const float* w3 = e < 64 ? p.in[I_W3] + ((size_t)l * 64 + e) * 1024 * 256 : p.in[I_SW3] + (size_t)l * 1024 * 256;
        gemm_tile_naive<true>(sm, [&](int r) { return U + (size_t)stok[r] * DM; }, w1, w3, 256, 256, 1024, tm * 128, tn * 128,
                              [&](int r, int c, float v, float v2) { H[(size_t)r * 256 + c] = siluf_(v) * v2; });
    }
    __syncthreads();
}

__device__ __forceinline__ void ph_moe2(const Params& p, int l, int ntok, int bid, int nb, float* sm) {
    int* offs = (int*)(sm + 16 * 132 + 2 * 16 * 128);
    moe_offsets(p, l, ntok, offs);
    const int* stok = (const int*)(p.ws + OFF_STOK); const float* sgate = (const float*)(p.ws + OFF_SGATE);
    const float* H = (const float*)(p.ws + OFF_H);
    float* F = (float*)(p.ws + OFF_BIG);
    const int nrt = offs[65] / 128;
    for (int t = bid; t < nrt * 8; t += nb) {
        const int tm = t >> 3, tn = t & 7, e = moe_expert_of(offs, tm * 128);
        const float* w2 = e < 64 ? p.in[I_W2] + ((size_t)l * 64 + e) * 256 * 1024 : p.in[I_SW2] + (size_t)l * 256 * 1024;
        gemm_tile_naive<false>(sm, [&](int r) { return H + (size_t)r * 256; }, w2, w2, 1024, 1024, 256, tm * 128, tn * 128,
                               [&](int r, int c, float v, float) { const int tok = stok[r]; if (tok != ZROW) atomicAdd(F + (size_t)tok * DM + c, v * sgate[r]); });
    }
    __syncthreads();
}

#define NAIVE_LDS (98304 + 1024)
#define MEGA_LDS (NAIVE_LDS + 64)
#define SYNC() xcd_barrier(bar)
template <int l>
__device__ __forceinline__ void layer_fwd(const Params& p, const XcdBarrier& bar, int bid, int nb, float* sm) {
    constexpr int ntok = (l == 3) ? NL : NT;
    ph_modulate(p, l, bid, nb); SYNC();
    ph_gemm_in(p, l, bid, nb, sm); SYNC();
    if ((l & 1) == 0) {
        ph_scan_even(p, l, 0, bid, nb); SYNC();
        ph_scan_even(p, l, 1, bid, nb); SYNC();
        ph_normgate_even(p, l, bid, nb); SYNC();
    } else {
        ph_scan_odd(p, l, 0, bid, nb); ph_hy_filt(p, l, bid, nb, sm); SYNC();
        ph_scan_odd(p, l, 1, bid, nb); ph_hy_conv(p, l, 0, bid, nb, sm); SYNC();
        ph_hy_conv(p, l, 1, bid, nb, sm); SYNC();
        ph_normgate_odd(p, l, bid, nb); SYNC();
    }
    ph_gemm_out(p, l, bid, nb, sm); SYNC();
    ph_ln(p, l, 0, ntok, bid, nb); SYNC();
    ph_router(p, l, ntok, bid, nb); SYNC();
    ph_scatter(p, l, ntok, bid, nb, sm); SYNC();
    ph_moe1(p, l, ntok, bid, nb, sm); SYNC();
    ph_moe2(p, l, ntok, bid, nb, sm); SYNC();
    ph_ln(p, l, 1, ntok, bid, nb);
    if (l < 3) SYNC();
}
__global__ void __launch_bounds__(512, 2) mega_fwd(Params p) {
    extern __shared__ __attribute__((aligned(16))) float smraw[];
    float* sm = smraw + 16;
    if (threadIdx.x == 0) { ((uint4*)smraw)[0] = make_uint4(0u, 0u, 0u, 0u); }
    __syncthreads();
    XcdBarrier bar = xcd_barrier_post((unsigned*)p.ws, (volatile LAS unsigned*)smraw);
    const int bid = blockIdx.x, nb = gridDim.x;
    ph_prologue(p, bid, nb, sm); SYNC();
    layer_fwd<0>(p, bar, bid, nb, sm);
    layer_fwd<1>(p, bar, bid, nb, sm);
    layer_fwd<2>(p, bar, bid, nb, sm);
    layer_fwd<3>(p, bar, bid, nb, sm);
    __syncthreads();
    if (bid == 0 && threadIdx.x == 0 && xb_ld((unsigned*)p.ws + XB_TMO) != 0u) p.out[0] = __builtin_nanf("");
}

extern "C" void kernel_launch(void* const* d_in, const int* in_sizes, int n_in, void* d_out, int out_size, void* d_ws, size_t ws_size, hipStream_t stream) {
    static int grid = 0;
    if (grid == 0) {
        if (n_in != 38 || out_size != NL * DM || ws_size < WS_END) { fprintf(stderr, "kernel_launch: bad shapes n_in %d out %d ws %zu (need %zu)\n", n_in, out_size, ws_size, (size_t)WS_END); grid = -1; return; }
        int dev = 0, cus = 0, per_cu = 0;
        if (hipGetDevice(&dev) != hipSuccess || hipDeviceGetAttribute(&cus, hipDeviceAttributeMultiprocessorCount, dev) != hipSuccess) { grid = -1; return; }
        if (hipFuncSetAttribute((const void*)mega_fwd, hipFuncAttributeMaxDynamicSharedMemorySize, MEGA_LDS) != hipSuccess) { fprintf(stderr, "kernel_launch: hipFuncSetAttribute failed\n"); grid = -1; return; }
        if (hipOccupancyMaxActiveBlocksPerMultiprocessor(&per_cu, (const void*)mega_fwd, 512, MEGA_LDS) != hipSuccess || per_cu < 1) { fprintf(stderr, "kernel_launch: occupancy query says %d\n", per_cu); (void)hipGetLastError(); grid = -1; return; }
        grid = cus;
    }
    if (grid < 0) return;
    if (hipMemsetAsync(d_ws, 0, OFF_OFFS, stream) != hipSuccess) return;
    Params p{};
    for (int i = 0; i < 38; ++i) p.in[i] = (const float*)d_in[i];
    p.out = (float*)d_out; p.ws = (unsigned char*)d_ws;
    hipLaunchKernelGGL(mega_fwd, dim3(grid), dim3(512), MEGA_LDS, stream, p);
}
```

```cpp
#include <hip/hip_runtime.h>
#include <stdint.h>
#include <stdio.h>

#define DM 1024
#define NBATCH 8
#define SEQ 4096
#define CTXL 256
#define NL (NBATCH * SEQ)
#define NC (NBATCH * CTXL)
#define NT (NL + NC)
#define ZROW NT
#define TOPK 8
#define EVEN_N 4112
#define ODD_N 3584
#define EVEN_LD 4096
#define ODD_LD 3584
#define MAXROWS (NT * 8 + 64 * 256 + NT)
#define ALPHA 1.681792830507429f
#define LN_EPS 1e-5f
#define E_MQ 0
#define E_MK 256
#define E_MV 512
#define E_MO 1024
#define E_HQ 1536
#define E_HI 2048
#define E_HFF 2560
#define E_HFB 3072
#define E_HG 3584

typedef unsigned short bf16_t;
#define LAS __attribute__((address_space(3)))

#define MiB ((size_t)1 << 20)
#define OFF_CNT   ((size_t)64 << 10)
#define OFF_LB    ((size_t)96 << 10)
#define OFF_MOD   ((size_t)128 << 10)
#define OFF_TILEE (2 * MiB)
#define OFF_HCTX  (4 * MiB)
#define OFF_TIDX  (12 * MiB)
#define OFF_TGATE (14 * MiB)
#define OFF_TPOS  (16 * MiB)
#define OFF_STOK  (18 * MiB)
#define OFF_SGATE (20 * MiB)
#define OFF_SDST  (22 * MiB)
#define OFF_G     (24 * MiB)
#define OFF_U     (28 * MiB)
#define OFF_W     (98 * MiB)
#define OFF_WIN   (OFF_W)
#define OFF_WOUT  (OFF_W + 8 * MiB)
#define OFF_W13   (OFF_W + 10 * MiB)
#define OFF_W2    (OFF_W + 75 * MiB)
#define OFF_BIG   (208 * MiB)
#define OFF_AUX   (480 * MiB)
#define OFF_Z1    (OFF_AUX + 136 * MiB)
#define OFF_Z2    (OFF_Z1 + 68 * MiB)
#define OFF_FILT  (OFF_Z2 + 68 * MiB)
#define OFF_YS    (370 * MiB)
#define WS_END    (984 * MiB)

struct Params {
    const float* in[38];
    float* out;
    unsigned char* ws;
};

enum { I_X = 0, I_C, I_CTX, I_CCTX, I_ADAW, I_ADAB, I_LNW, I_LNB, I_EWIN, I_MGB, I_MNW, I_HLB, I_HNW, I_EWOUT, I_OWIN, I_HCW, I_HCB,
       I_HW1, I_HB1, I_HW2, I_HB2, I_HW3, I_HB3, I_HFREQ, I_HWOUT, I_HSKIP, I_HNORM, I_RLD, I_RNW, I_OWOUT, I_RW, I_RB, I_W1, I_W3, I_W2, I_SW1, I_SW3, I_SW2 };

typedef const __attribute__((address_space(4))) Params* KP;
__device__ __forceinline__ KP kparams() { KP k = (KP)__builtin_amdgcn_kernarg_segment_ptr(); asm volatile("" : "+s"(k)); return k; }
__device__ __forceinline__ int opaque_tid() { int t = threadIdx.x; asm volatile("" : "+v"(t)); return t; }
__device__ __forceinline__ unsigned cvt_pk_bf16(float lo, float hi) { unsigned r; asm volatile("v_cvt_pk_bf16_f32 %0, %1, %2" : "=v"(r) : "v"(lo), "v"(hi)); return r; }
__device__ __forceinline__ float bf2f(bf16_t b) { return __uint_as_float(((unsigned)b) << 16); }
__device__ __forceinline__ float bflo(unsigned w) { return __uint_as_float(w << 16); }
__device__ __forceinline__ float bfhi(unsigned w) { return __uint_as_float(w & 0xffff0000u); }
__device__ __forceinline__ float ldf(const float* p) { return *p; }
__device__ __forceinline__ float ldf(const bf16_t* p) { return bf2f(*p); }
__device__ __forceinline__ void stf(float* p, float v) { *p = v; }
__device__ __forceinline__ void stf(bf16_t* p, float v) { *p = (bf16_t)(cvt_pk_bf16(v, 0.f) & 0xffffu); }
__device__ __forceinline__ float sigmoidf_(float x) { return 1.f / (1.f + expf(-x)); }
__device__ __forceinline__ float siluf_(float x) { return x / (1.f + expf(-x)); }
__device__ __forceinline__ float wave_sum(float v) {
#pragma unroll
    for (int o = 32; o > 0; o >>= 1) v += __shfl_xor(v, o, 64);
    return v;
}
__device__ __forceinline__ float* hrow(KP p, int tok) {
    return tok < NL ? p->out + (size_t)tok * DM : (float*)(p->ws + OFF_HCTX) + (size_t)(tok - NL) * DM;
}
__device__ __forceinline__ const float* modrow(KP p, int l, int tok) {
    const int r = tok < NL ? (tok >> 12) : 8;
    return (const float*)(p->ws + OFF_MOD) + ((size_t)l * 9 + r) * 6144;
}
__device__ __forceinline__ int scan_tok(int b, int i, int dir) {
    return i < CTXL ? NL + b * CTXL + (dir ? CTXL - 1 - i : i) : b * SEQ + (dir ? SEQ - 1 - (i - CTXL) : (i - CTXL));
}

#define XB_TMO      128
#define XB_XCNT(j)  (256  + 64 * (j))
#define XB_XSUB(j)  (1280 + 64 * (j))
#define XB_XGEN(j)  (2304 + 64 * (j))
#define XB_TOP      3328
#define XB_TOPGEN   3392
#define XCD_BAR_WORDS 3456
#define XB_SPIN_CAP (1u << 24)
__device__ __forceinline__ unsigned xb_ld(unsigned* p)              { return __hip_atomic_load(p, __ATOMIC_RELAXED, __HIP_MEMORY_SCOPE_AGENT); }
__device__ __forceinline__ unsigned xb_add(unsigned* p, unsigned v) { return __hip_atomic_fetch_add(p, v, __ATOMIC_RELAXED, __HIP_MEMORY_SCOPE_AGENT); }
__device__ __forceinline__ unsigned xb_xcc_id() { return (unsigned)__builtin_amdgcn_s_getreg((3 << 11) | 20) & 0xFu; }
#define XB_SPIN(cond, bar) do { unsigned _sp = 0; while (cond) { __builtin_amdgcn_s_sleep(1); \
    if ((++_sp & 255u) == 0u) { if (xb_ld(&(bar)[XB_TMO])) break; if (_sp > XB_SPIN_CAP) { atomicAdd(&(bar)[XB_TMO], 1u); break; } } } } while (0)
struct XcdBarrier { unsigned* bar; unsigned x; volatile LAS unsigned* st; };
__device__ __forceinline__ XcdBarrier xcd_barrier_post(unsigned* bar, volatile LAS unsigned* st) {
    XcdBarrier b; b.bar = bar; b.x = xb_xcc_id(); b.st = st;
    if (threadIdx.x == 0) (void)xb_add(&bar[XB_XCNT(b.x)], 1u);
    return b;
}
__device__ __forceinline__ void xcd_barrier_complete(unsigned* bar, unsigned x, unsigned& nloc, unsigned& nx) {
    const unsigned G = gridDim.x * gridDim.y * gridDim.z;
    unsigned sum, cnt, mine, sp = 0u;
    for (;;) {
        sum = 0u; cnt = 0u; mine = 0u;
#pragma unroll
        for (unsigned j = 0; j < 16; ++j) { const unsigned c = xb_ld(&bar[XB_XCNT(j)]); sum += c; cnt += (c > 0u) ? 1u : 0u; mine = (j == x) ? c : mine; }
        if (sum == G) break;
        __builtin_amdgcn_s_sleep(1);
        if ((++sp & 255u) == 0u) { if (xb_ld(&bar[XB_TMO])) break; if (sp > XB_SPIN_CAP) { atomicAdd(&bar[XB_TMO], 1u); break; } }
    }
    nloc = mine > 0u ? mine : 1u; nx = cnt > 0u ? cnt : 1u;
}
__device__ __forceinline__ void xcd_barrier(const XcdBarrier& b) {
    asm volatile("s_waitcnt vmcnt(0)" ::: "memory");
    __syncthreads();
    if (threadIdx.x == 0) {
        unsigned* bar = b.bar;
        __builtin_amdgcn_s_waitcnt(0);
        unsigned nloc = b.st[0], nx = b.st[1];
        if (nloc == 0u) { xcd_barrier_complete(bar, b.x, nloc, nx); b.st[0] = nloc; b.st[1] = nx; }
        const unsigned old = xb_add(&bar[XB_XSUB(b.x)], 1u);
        const unsigned gen = old / nloc;
        if (old + 1u == (gen + 1u) * nloc) {
            __builtin_amdgcn_fence(__ATOMIC_RELEASE, "agent");
            asm volatile("s_waitcnt vmcnt(0)" ::: "memory");
            const unsigned og = xb_add(&bar[XB_TOP], 1u);
            const unsigned tg = og / nx;
            if (og + 1u == (tg + 1u) * nx) xb_add(&bar[XB_TOPGEN], 1u);
            else XB_SPIN(xb_ld(&bar[XB_TOPGEN]) == tg, bar);
            __builtin_amdgcn_fence(__ATOMIC_ACQUIRE, "agent");
            xb_add(&bar[XB_XGEN(b.x)], 1u);
            asm volatile("s_waitcnt vmcnt(0)" ::: "memory");
        } else {
            XB_SPIN(xb_ld(&bar[XB_XGEN(b.x)]) == gen, bar);
            __builtin_amdgcn_fence(__ATOMIC_ACQUIRE, "agent");
            asm volatile("s_waitcnt vmcnt(0)" ::: "memory");
        }
    }
    __syncthreads();
}

__device__ __forceinline__ void ph_prologue(KP p, int bid, int nb, float* sm) {
    const int tid = opaque_tid();
    {
        const float4* x4 = (const float4*)p->in[I_X]; float4* o4 = (float4*)p->out;
        #pragma unroll 1
        for (size_t i = (size_t)bid * 512 + tid; i < (size_t)NL * 256; i += (size_t)nb * 512) o4[i] = x4[i];
        const float4* c4 = (const float4*)p->in[I_CTX]; float4* h4 = (float4*)(p->ws + OFF_HCTX);
        #pragma unroll 1
        for (size_t i = (size_t)bid * 512 + tid; i < (size_t)NC * 256; i += (size_t)nb * 512) h4[i] = c4[i];
    }
    if (bid == 0) {
        bf16_t* z = (bf16_t*)(p->ws + OFF_U) + (size_t)ZROW * DM;
        for (int i = tid; i < DM; i += 512) z[i] = 0;
    }
    if (bid == 1 % nb) {
        float* lb = (float*)(p->ws + OFF_LB);
        const float* hl = p->in[I_HLB];
        for (int j = tid; j < 512; j += 512) {
            const float a = hl[j], b = hl[512 + j], mx = fmaxf(a, b);
            const float ea = expf(a - mx), eb = expf(b - mx);
            lb[j] = 0.f; lb[512 + j] = eb / (ea + eb);
        }
    }
    {
        float* act = sm;
        bool filled = false;
        #pragma unroll 1
        for (int item = bid; item < 48; item += nb) {
            if (!filled) {
                for (int i = tid; i < 9 * 1024; i += 512) {
                    const int r = i >> 10, k = i & 1023;
                    const float v = r < 8 ? p->in[I_C][r * 1024 + k] : p->in[I_CCTX][k];
                    act[i] = siluf_(v);
                }
                __syncthreads(); filled = true;
            }
            const int l = item / 12, j = (item % 12) * 512 + tid;
            const float* w = p->in[I_ADAW] + (size_t)l * 1024 * 6144 + j;
            float acc[9];
#pragma unroll
            for (int r = 0; r < 9; ++r) acc[r] = 0.f;
            for (int k = 0; k < 1024; ++k) {
                const float wv = w[(size_t)k * 6144];
#pragma unroll
                for (int r = 0; r < 9; ++r) acc[r] += act[r * 1024 + k] * wv;
            }
            const float bv = p->in[I_ADAB][l * 6144 + j];
            float* mod = (float*)(p->ws + OFF_MOD);
#pragma unroll
            for (int r = 0; r < 9; ++r) mod[((size_t)l * 9 + r) * 6144 + j] = acc[r] + bv;
        }
    }
}


template <class Src>
__device__ __forceinline__ void cvt_tile(float* sm, Src src, int srcld, int k0, bf16_t* dst, int dstld, int n0) {
    const int tid = opaque_tid();
    const float* sp = src(n0 + (tid & 127));
#pragma unroll
    for (int j = 0; j < 16; ++j) { const int k = (tid >> 7) + 4 * j; sm[k * 129 + (tid & 127)] = sp[(size_t)(k0 + k) * srcld]; }
    __syncthreads();
    const int n = tid >> 2, kc = (tid & 3) * 16;
    unsigned w[8];
#pragma unroll
    for (int q = 0; q < 8; ++q) w[q] = cvt_pk_bf16(sm[(kc + 2 * q) * 129 + n], sm[(kc + 2 * q + 1) * 129 + n]);
    uint4* d4 = (uint4*)(dst + (size_t)(n0 + n) * dstld + k0 + kc);
    d4[0] = make_uint4(w[0], w[1], w[2], w[3]); d4[1] = make_uint4(w[4], w[5], w[6], w[7]);
    __syncthreads();
}

__device__ __forceinline__ void ph_convert(KP p, int l, int bid, int nb, float* sm) {
    const bool even = (l & 1) == 0;
    const int NP = even ? EVEN_LD : ODD_LD;
    const int t_in = 16 * (NP / 128), t_out = 16 * 8, t_13 = 65 * 16 * 4, t_2 = 65 * 4 * 8;
    const int total = t_in + t_out + t_13 + t_2;
    #pragma unroll 1
    for (int t = bid; t < total; t += nb) {
        if (t < t_in) {
            const int kt = t & 15, nt = t >> 4;
            const float* W = even ? p->in[I_EWIN] + (size_t)(l >> 1) * 1024 * EVEN_N : p->in[I_OWIN] + (size_t)(l >> 1) * 1024 * ODD_N;
            cvt_tile(sm, [&](int n) { return W + ((even && n >= 1536) ? n + 16 : n); }, even ? EVEN_N : ODD_N, kt * 64, (bf16_t*)(p->ws + OFF_WIN), 1024, nt * 128);
        } else if (t < t_in + t_out) {
            const int u = t - t_in, kt = u & 15, nt = u >> 4;
            const float* W = (even ? p->in[I_EWOUT] : p->in[I_OWOUT]) + (size_t)(l >> 1) * 1024 * 1024;
            cvt_tile(sm, [&](int n) { return W + n; }, 1024, kt * 64, (bf16_t*)(p->ws + OFF_WOUT), 1024, nt * 128);
        } else if (t < t_in + t_out + t_13) {
            const int u = t - t_in - t_out, e = u >> 6, kt = u & 15, nt = (u >> 4) & 3;
            const float* w1 = e < 64 ? p->in[I_W1] + ((size_t)l * 64 + e) * 1024 * 256 : p->in[I_SW1] + (size_t)l * 1024 * 256;
            const float* w3 = e < 64 ? p->in[I_W3] + ((size_t)l * 64 + e) * 1024 * 256 : p->in[I_SW3] + (size_t)l * 1024 * 256;
            cvt_tile(sm, [&](int n) { const int g = n >> 5, w = n & 31; return w < 16 ? w1 + 16 * g + w : w3 + 16 * g + w - 16; }, 256, kt * 64,
                     (bf16_t*)(p->ws + OFF_W13) + (size_t)e * 512 * 1024, 1024, nt * 128);
        } else {
            const int u = t - t_in - t_out - t_13, e = u >> 5, kt = u & 3, nt = (u >> 2) & 7;
            const float* w2 = e < 64 ? p->in[I_W2] + ((size_t)l * 64 + e) * 256 * 1024 : p->in[I_SW2] + (size_t)l * 256 * 1024;
            cvt_tile(sm, [&](int n) { return w2 + n; }, 1024, kt * 64, (bf16_t*)(p->ws + OFF_W2) + (size_t)e * 1024 * 256, 256, nt * 128);
        }
    }
}

namespace gp {
typedef short bf16x8 __attribute__((ext_vector_type(8)));
typedef float f32x4 __attribute__((ext_vector_type(4)));
typedef unsigned u32x4 __attribute__((ext_vector_type(4)));
typedef unsigned u32x2 __attribute__((ext_vector_type(2)));
constexpr int BM = 256, BK = 64, HALF = 128, HTB = HALF * BK * 2, STAGE_BYTES = 8 * HTB, NXCD = 8, WGM = 8;
__device__ __forceinline__ int lds_byte(int r, int c) { const int st = (r >> 4) * 2 + (c >> 5), rr = r & 15, cc = c & 31, ob = rr * 64 + cc * 2; return st * 1024 + (ob ^ (((ob >> 9) & 1) << 5)); }
__device__ __forceinline__ void stage_rc(int b, int& R, int& C) { const int st = b / 1024, sb = b % 1024, swz = sb ^ (((sb >> 9) & 1) << 5); R = (st >> 1) * 16 + swz / 64; C = (st & 1) * 32 + (swz % 64) / 2; }
__device__ __forceinline__ int perm32(int rho) { const int n = rho >> 4, i = rho & 15; return 8 * (i >> 2) + 4 * n + (i & 3); }

struct Unit { const char* A; const char* B; int r0, c0, aux; };

struct DenseSched {
    const char* A; const char* B; int nM, nN, nwg, G, c; size_t tstep;
    __device__ __forceinline__ void init(const void* A_, const void* B_, int M, int N, int K, int G_, int c_) { A = (const char*)A_; B = (const char*)B_; nM = M / BM; nN = N / BM; nwg = nM * nN; G = G_; c = c_; tstep = (size_t)BM * K * 2; }
    __device__ __forceinline__ bool next(int i, Unit& u) const {
        const long L = (long)i * G + c; if (L >= nwg) return false;
        int wgid = (int)L; { const int q = nwg / NXCD, r = nwg % NXCD, xcd = wgid % NXCD, off = wgid / NXCD; wgid = (xcd < r ? xcd * (q + 1) : r * (q + 1) + (xcd - r) * q) + off; }
        const int nig = WGM * nN, gid = wgid / nig, fm = gid * WGM, gsz = (nM - fm) < WGM ? (nM - fm) : WGM;
        const int pm = fm + ((wgid % nig) % gsz), pn = (wgid % nig) / gsz;
        u.A = A + (size_t)pm * tstep; u.B = B + (size_t)pn * tstep; u.r0 = pm * BM; u.c0 = pn * BM; u.aux = 0; return true;
    }
    __device__ __forceinline__ void lane_off(const Unit&, int, int, int, int, unsigned (&)[2][2]) const {}
};

template <bool GATHER, bool PERM, class Sched, class Epi>
__device__ __forceinline__ void gemm_phase(LAS unsigned char* lds, const int K_, const Sched& S, const Epi& E) {
    int K = K_; asm volatile("" : "+s"(K));
    const int tid = opaque_tid(), wid = __builtin_amdgcn_readfirstlane(tid >> 6), lane = tid & 63, wr = wid >> 2, wc = wid & 3, fr = lane & 15, fq = lane >> 4;
    const int nt = K / BK;
    unsigned voffA[2], voffB[2]; int sR[2], sC[2];
#pragma unroll
    for (int i = 0; i < 2; ++i) { int R, C; stage_rc(tid * 16 + i * 8192, R, C); const int Rb = PERM ? ((R & ~31) + perm32(R & 31)) : R;
        voffA[i] = (unsigned)(R * K + C) * 2u; voffB[i] = (unsigned)(Rb * K + C) * 2u; sR[i] = R; sC[i] = C; }
    const size_t kstep = (size_t)(BK * 2);
    const size_t hstep = (size_t)HALF * K * 2;
    const unsigned ldsw = (unsigned)wid * 1024u;
    const int aoff = lds_byte(wr * 64 + fr, fq * 8), boff = lds_byte(wc * 32 + fr, fq * 8);
    unsigned cvo[2][2] = {{0u, 0u}, {0u, 0u}}, nvo[2][2] = {{0u, 0u}, {0u, 0u}};
#define GP_SA(b, h) (((b) * 2 + (h)) * HTB)
#define GP_SB(b, h) ((4 + (b) * 2 + (h)) * HTB)
#define GP_GLDS(gp_, lp_) __builtin_amdgcn_global_load_lds((const unsigned*)(gp_), (LAS unsigned*)(lp_), 16, 0, 0)
#define GP_STAGE_B(bufoff, gbase, h) do { const char* _g = (gbase) + (size_t)(h) * hstep; \
        GP_GLDS(_g + voffB[0], lds + (bufoff) + ldsw); GP_GLDS(_g + voffB[1], lds + (bufoff) + ldsw + 8192); } while (0)
#define GP_STAGE_A(bufoff, gbase, h, usenext) do { \
        if (GATHER) { const unsigned _o0 = (usenext) ? nvo[h][0] : cvo[h][0], _o1 = (usenext) ? nvo[h][1] : cvo[h][1]; \
            GP_GLDS((gbase) + _o0, lds + (bufoff) + ldsw); GP_GLDS((gbase) + _o1, lds + (bufoff) + ldsw + 8192); } \
        else { const char* _g = (gbase) + (size_t)(h) * hstep; GP_GLDS(_g + voffA[0], lds + (bufoff) + ldsw); GP_GLDS(_g + voffA[1], lds + (bufoff) + ldsw + 8192); } } while (0)
#define GP_LDA(dst, b, h) do { _Pragma("unroll") for (int m = 0; m < 4; ++m) _Pragma("unroll") for (int k = 0; k < 2; ++k) dst[m][k] = *(const LAS bf16x8*)(lds + GP_SA(b, h) + aoff + m * 2048 + k * 1024); } while (0)
#define GP_LDB(dst, b, h) do { _Pragma("unroll") for (int n = 0; n < 2; ++n) _Pragma("unroll") for (int k = 0; k < 2; ++k) dst[n][k] = *(const LAS bf16x8*)(lds + GP_SB(b, h) + boff + n * 2048 + k * 1024); } while (0)
#define GP_MMA(ai, bj, At, Bt) do { __builtin_amdgcn_s_setprio(1); _Pragma("unroll") for (int m = 0; m < 4; ++m) _Pragma("unroll") for (int n = 0; n < 2; ++n) _Pragma("unroll") for (int k = 0; k < 2; ++k) \
        acc[ai][bj][m][n] = __builtin_amdgcn_mfma_f32_16x16x32_bf16(Bt[n][k], At[m][k], acc[ai][bj][m][n], 0, 0, 0); __builtin_amdgcn_s_setprio(0); } while (0)
#define GP_WAIT_V(n) asm volatile("s_waitcnt vmcnt(" #n ")" ::: "memory")
#define GP_WAIT_L(n) asm volatile("s_waitcnt lgkmcnt(" #n ")" ::: "memory")
#define GP_BAR __builtin_amdgcn_s_barrier()
#define GP_SCHED __builtin_amdgcn_sched_barrier(0)
    Unit cur, nxt; int ui = 0;
    if (!S.next(0, cur)) return;
    f32x4 acc[2][2][4][2];
#pragma unroll
    for (int a = 0; a < 2; ++a)
#pragma unroll
        for (int b = 0; b < 2; ++b)
#pragma unroll
            for (int m = 0; m < 4; ++m)
#pragma unroll
                for (int n = 0; n < 2; ++n) acc[a][b][m][n] = (f32x4){0.f, 0.f, 0.f, 0.f};
    bf16x8 At[4][2], B0[2][2], B1[2][2];
    if (GATHER) S.lane_off(cur, sR[0], sR[1], sC[0], sC[1], cvo);
    const char* cA = cur.A; const char* cB = cur.B;
    GP_STAGE_B(GP_SB(0, 0), cB, 0); GP_STAGE_A(GP_SA(0, 0), cA, 0, false); GP_STAGE_B(GP_SB(0, 1), cB, 1); GP_STAGE_A(GP_SA(0, 1), cA, 1, false);
    if (wr == 1) GP_BAR;
    GP_WAIT_V(4); GP_BAR;
    GP_STAGE_B(GP_SB(1, 0), cB + kstep, 0); GP_STAGE_A(GP_SA(1, 0), cA + kstep, 0, false); GP_STAGE_B(GP_SB(1, 1), cB + kstep, 1);
    GP_WAIT_V(6); GP_BAR;
    for (;;) {
        const bool has_next = S.next(ui + 1, nxt);
        if (GATHER && has_next) S.lane_off(nxt, sR[0], sR[1], sC[0], sC[1], nvo);
        const char* nA = has_next ? nxt.A : cA; const char* nB = has_next ? nxt.B : cB;
        for (int t = 0; t < nt; t += 2) {
            const bool last = (t == nt - 2);
            const bool un = last && has_next;
            const char* a1 = cA + (size_t)(t + 1) * kstep;
            const char* a2 = last ? nA : cA + (size_t)(t + 2) * kstep; const char* b2 = last ? nB : cB + (size_t)(t + 2) * kstep;
            const char* a3 = a2 + kstep; const char* b3 = b2 + kstep;
            GP_LDB(B0, 0, 0); GP_SCHED; GP_LDA(At, 0, 0); GP_STAGE_A(GP_SA(1, 1), a1, 1, false);
            GP_WAIT_L(8); GP_BAR; GP_WAIT_L(0); GP_MMA(0, 0, At, B0); GP_BAR; GP_SCHED;
            GP_LDB(B1, 0, 1); GP_STAGE_B(GP_SB(0, 0), b2, 0);
            GP_BAR; GP_WAIT_L(0); GP_MMA(0, 1, At, B1); GP_BAR;
            GP_LDA(At, 0, 1); GP_STAGE_A(GP_SA(0, 0), a2, 0, un);
            GP_BAR; GP_WAIT_L(0); GP_MMA(1, 0, At, B0); GP_BAR; GP_SCHED;
            GP_STAGE_B(GP_SB(0, 1), b2, 1);
            GP_WAIT_V(6); GP_BAR; GP_MMA(1, 1, At, B1); GP_BAR;
            GP_LDB(B0, 1, 0); GP_SCHED; GP_LDA(At, 1, 0); GP_STAGE_A(GP_SA(0, 1), a2, 1, un);
            GP_WAIT_L(8); GP_BAR; GP_WAIT_L(0); GP_MMA(0, 0, At, B0); GP_BAR; GP_SCHED;
            GP_LDB(B1, 1, 1); GP_STAGE_B(GP_SB(1, 0), b3, 0);
            GP_BAR; GP_WAIT_L(0); GP_MMA(0, 1, At, B1); GP_BAR;
            GP_LDA(At, 1, 1); GP_STAGE_A(GP_SA(1, 0), a3, 0, un);
            GP_BAR; GP_WAIT_L(0); GP_MMA(1, 0, At, B0); GP_BAR; GP_SCHED;
            GP_STAGE_B(GP_SB(1, 1), b3, 1);
            GP_WAIT_V(6); GP_BAR; GP_MMA(1, 1, At, B1); GP_BAR;
        }
        E(acc, cur, wr, wc, fr, fq);
        if (!has_next) break;
#pragma unroll
        for (int a = 0; a < 2; ++a)
#pragma unroll
            for (int b = 0; b < 2; ++b)
#pragma unroll
                for (int m = 0; m < 4; ++m)
#pragma unroll
                    for (int n = 0; n < 2; ++n) acc[a][b][m][n] = (f32x4){0.f, 0.f, 0.f, 0.f};
        cur = nxt; cA = nA; cB = nB; ++ui;
        if (GATHER) { cvo[0][0] = nvo[0][0]; cvo[0][1] = nvo[0][1]; cvo[1][0] = nvo[1][0]; cvo[1][1] = nvo[1][1]; }
    }
    GP_WAIT_V(0);
    if (wr == 0) GP_BAR;
    GP_BAR;
#undef GP_SA
#undef GP_SB
#undef GP_GLDS
#undef GP_STAGE_A
#undef GP_STAGE_B
#undef GP_LDA
#undef GP_LDB
#undef GP_MMA
#undef GP_WAIT_V
#undef GP_WAIT_L
#undef GP_BAR
#undef GP_SCHED
}

struct EpiF32 {
    float* C; int ldc;
    __device__ __forceinline__ void operator()(const f32x4 (&acc)[2][2][4][2], const Unit& u, int wr, int wc, int fr, int fq) const {
        const int row0 = u.r0 + wr * 64 + fr, col0 = u.c0 + wc * 32 + 4 * fq;
#pragma unroll
        for (int ai = 0; ai < 2; ++ai)
#pragma unroll
            for (int m = 0; m < 4; ++m) { float* rowp = C + (size_t)(row0 + ai * HALF + m * 16) * ldc + col0;
#pragma unroll
                for (int bj = 0; bj < 2; ++bj)
#pragma unroll
                    for (int n = 0; n < 2; ++n) *(f32x4*)(rowp + bj * HALF + n * 16) = acc[ai][bj][m][n];
                __builtin_amdgcn_sched_barrier(0); }
    }
};
struct EpiBf16 {
    bf16_t* O; int ldc;
    __device__ __forceinline__ void operator()(const f32x4 (&acc)[2][2][4][2], const Unit& u, int wr, int wc, int fr, int fq) const {
        const int row0 = u.r0 + wr * 64 + fr, col0 = u.c0 + wc * 32 + 8 * fq;
#pragma unroll
        for (int ai = 0; ai < 2; ++ai)
#pragma unroll
            for (int m = 0; m < 4; ++m) { bf16_t* rowp = O + (size_t)(row0 + ai * HALF + m * 16) * ldc + col0;
#pragma unroll
                for (int bj = 0; bj < 2; ++bj) { const f32x4 v0 = acc[ai][bj][m][0], v1 = acc[ai][bj][m][1];
                    u32x4 w; w.x = cvt_pk_bf16(v0[0], v0[1]); w.y = cvt_pk_bf16(v0[2], v0[3]); w.z = cvt_pk_bf16(v1[0], v1[1]); w.w = cvt_pk_bf16(v1[2], v1[3]);
                    *(u32x4*)(rowp + bj * HALF) = w; }
                __builtin_amdgcn_sched_barrier(0); }
    }
};
}

__device__ __forceinline__ void ph_modin(KP p, int l, int bid, int nb) {
    const int tid = opaque_tid(), lane = tid & 63, wv = tid >> 6;
    const bool even = (l & 1) == 0;
    bf16_t* U = (bf16_t*)(p->ws + OFF_U);
    float* G = (float*)(p->ws + OFF_G);
    const float* wg = p->in[I_EWIN] + (size_t)(l >> 1) * 1024 * EVEN_N + 1536;
    #pragma unroll 1
    for (int tok = bid * 8 + wv; tok < NT; tok += nb * 8) {
        const float* h = hrow(p, tok);
        const float* m = modrow(p, l, tok);
        float ga[16];
#pragma unroll
        for (int j = 0; j < 16; ++j) ga[j] = 0.f;
#pragma unroll
        for (int c = 0; c < 4; ++c) {
            const int d = 4 * (lane + 64 * c);
            const float4 hv = *(const float4*)(h + d), sh = *(const float4*)(m + d), sc = *(const float4*)(m + 1024 + d);
            const float u0 = hv.x * (1.f + sc.x) + sh.x, u1 = hv.y * (1.f + sc.y) + sh.y, u2 = hv.z * (1.f + sc.z) + sh.z, u3 = hv.w * (1.f + sc.w) + sh.w;
            *(uint2*)(U + (size_t)tok * DM + d) = make_uint2(cvt_pk_bf16(u0, u1), cvt_pk_bf16(u2, u3));
            if (even) {
                const float uu[4] = {u0, u1, u2, u3};
#pragma unroll
                for (int q = 0; q < 4; ++q) {
                    const float4* wr = (const float4*)(wg + (size_t)(d + q) * EVEN_N);
#pragma unroll
                    for (int j4 = 0; j4 < 4; ++j4) { const float4 w = wr[j4]; ga[4 * j4] += uu[q] * w.x; ga[4 * j4 + 1] += uu[q] * w.y; ga[4 * j4 + 2] += uu[q] * w.z; ga[4 * j4 + 3] += uu[q] * w.w; }
                }
            }
        }
        if (even) {
            float mine = 0.f;
#pragma unroll
            for (int j = 0; j < 16; ++j) { const float s = wave_sum(ga[j]); if (lane == j) mine = s; }
            if (lane < 16) G[(size_t)tok * 16 + lane] = mine;
        }
    }
}

__device__ __forceinline__ void ph_gemm_in(KP p, int l, int bid, int nb, LAS unsigned char* lds) {
    const int N = ((l & 1) == 0) ? EVEN_LD : ODD_LD;
    gp::DenseSched S; S.init(p->ws + OFF_U, p->ws + OFF_WIN, NT, N, 1024, nb, bid);
    gp::EpiBf16 E{(bf16_t*)(p->ws + OFF_BIG), N};
    gp::gemm_phase<false, true>(lds, 1024, S, E);
}
__device__ __forceinline__ void ph_gemm_out(KP p, int l, int bid, int nb, LAS unsigned char* lds) {
    gp::DenseSched S; S.init(p->ws + OFF_U, p->ws + OFF_WOUT, NT, 1024, 1024, nb, bid);
    gp::EpiF32 E{(float*)(p->ws + OFF_BIG), 1024};
    gp::gemm_phase<false, false>(lds, 1024, S, E);
}

__device__ __forceinline__ void ph_scan_even(KP p, int l, int dir, int bid, int nb) {
    const int tid = opaque_tid(), v = tid >> 2, kq = tid & 3;
    const bf16_t* P = (const bf16_t*)(p->ws + OFF_BIG);
    const float* G = (const float*)(p->ws + OFF_G);
    float* HX = (float*)(p->ws + OFF_AUX);
    const int e = l >> 1;
    #pragma unroll 1
    for (int item = bid; item < 64; item += nb) {
        const int kind = item >> 5, b = (item >> 2) & 7, h = item & 3;
        if (kind == 0) {
            const float* gb = p->in[I_MGB] + e * 16;
            const float gbi = gb[(dir ? 2 : 0) * 4 + h], gbf = gb[(dir ? 3 : 1) * 4 + h];
            float C[16], n[16];
#pragma unroll
            for (int j = 0; j < 16; ++j) { C[j] = 0.f; n[j] = 0.f; }
            float m = -1e30f;
            for (int i = 0; i < CTXL + SEQ; ++i) {
                const int tok = scan_tok(b, i, dir);
                const bf16_t* pr = P + (size_t)tok * EVEN_LD;
                const float ig = G[(size_t)tok * 16 + (dir ? 8 : 0) + h] + gbi;
                const float fg = G[(size_t)tok * 16 + (dir ? 12 : 4) + h] + gbf;
                const float lf = fminf(fg, 0.f) - log1pf(expf(-fabsf(fg)));
                const float m_new = fmaxf(lf + m, ig);
                const float a = expf(lf + m - m_new), bg = expf(ig - m_new);
                const float vv = ldf(pr + E_MV + h * 128 + v);
                float num = 0.f, den = 0.f;
#pragma unroll
                for (int j = 0; j < 16; ++j) {
                    const float kj = ldf(pr + E_MK + h * 64 + kq * 16 + j), qj = ldf(pr + E_MQ + h * 64 + kq * 16 + j) * 0.125f;
                    C[j] = a * C[j] + bg * vv * kj; n[j] = a * n[j] + bg * kj;
                    num += C[j] * qj; den += n[j] * qj;
                }
                num += __shfl_xor(num, 1, 64); num += __shfl_xor(num, 2, 64);
                den += __shfl_xor(den, 1, 64); den += __shfl_xor(den, 2, 64);
                const float hv = num / fmaxf(fabsf(den), expf(-m_new));
                if (kq == 0) { float* o = HX + (size_t)tok * 1024 + h * 128 + v; *o = dir ? *o + hv : hv; }
                m = m_new;
            }
        } else {
            const float* lbp = (const float*)(p->ws + OFF_LB) + e * 512 + h * 128 + kq * 32;
            float S[32], lb[32];
#pragma unroll
            for (int j = 0; j < 32; ++j) { S[j] = 0.f; lb[j] = lbp[j]; }
            for (int i = 0; i < CTXL + SEQ; ++i) {
                const int tok = scan_tok(b, i, dir);
                const bf16_t* pr = P + (size_t)tok * EVEN_LD;
                const float iv = ldf(pr + E_HI + h * 128 + v);
                float o = 0.f;
#pragma unroll
                for (int j = 0; j < 32; ++j) {
                    const int k = h * 128 + kq * 32 + j;
                    const float fp = ldf(pr + (dir ? E_HFB : E_HFF) + k);
                    const float f = lb[j] + (1.f - lb[j]) * sigmoidf_(fp);
                    const float qj = siluf_(ldf(pr + E_HQ + k));
                    S[j] = f * S[j] + (1.f - f) * iv;
                    o += qj * S[j];
                }
                o += __shfl_xor(o, 1, 64); o += __shfl_xor(o, 2, 64);
                if (kq == 0) { float* op = HX + (size_t)tok * 1024 + 512 + h * 128 + v; *op = dir ? *op + o : o; }
            }
        }
    }
}

__device__ __forceinline__ void ph_normgate_even(KP p, int l, int bid, int nb) {
    const int tid = opaque_tid(), lane = tid & 63, wv = tid >> 6;
    const bf16_t* P = (const bf16_t*)(p->ws + OFF_BIG);
    const float* HX = (const float*)(p->ws + OFF_AUX);
    bf16_t* MIX = (bf16_t*)(p->ws + OFF_U);
    const int e = l >> 1;
    #pragma unroll 1
    for (int it = bid * 8 + wv; it < NT * 8; it += nb * 8) {
        const int tok = it >> 3, g = it & 7;
        const float* hx = HX + (size_t)tok * 1024 + g * 128;
        float x0 = hx[lane], x1 = hx[lane + 64];
        const bf16_t* pr = P + (size_t)tok * EVEN_LD;
        if (g < 4) {
            const float mean = wave_sum(x0 + x1) * (1.f / 128.f);
            x0 -= mean; x1 -= mean;
            const float var = wave_sum(x0 * x0 + x1 * x1) * (1.f / 128.f);
            const float r = rsqrtf(var + LN_EPS);
            const float* nw = p->in[I_MNW] + e * 512 + g * 128;
            const float o0 = ldf(pr + E_MO + g * 128 + lane), o1 = ldf(pr + E_MO + g * 128 + lane + 64);
            stf(MIX + (size_t)tok * DM + g * 128 + lane, x0 * r * nw[lane] * sigmoidf_(o0));
            stf(MIX + (size_t)tok * DM + g * 128 + lane + 64, x1 * r * nw[lane + 64] * sigmoidf_(o1));
        } else {
            const int h = g - 4;
            const float ms = wave_sum(x0 * x0 + x1 * x1) * (1.f / 128.f);
            const float r = rsqrtf(ms + LN_EPS);
            const float* nw = p->in[I_HNW] + e * 512 + h * 128;
            const float g0 = ldf(pr + E_HG + h * 128 + lane), g1 = ldf(pr + E_HG + h * 128 + lane + 64);
            stf(MIX + (size_t)tok * DM + 512 + h * 128 + lane, x0 * r * nw[lane] * siluf_(g0));
            stf(MIX + (size_t)tok * DM + 512 + h * 128 + lane + 64, x1 * r * nw[lane + 64] * siluf_(g1));
        }
    }
}

__device__ __forceinline__ void ph_scan_odd(KP p, int l, int dir, int bid, int nb) {
    const int tid = opaque_tid(), v = tid >> 2, kq = tid & 3;
    const bf16_t* P = (const bf16_t*)(p->ws + OFF_BIG);
    float* HX = (float*)(p->ws + OFF_AUX);
    const int o = l >> 1;
    #pragma unroll 1
    for (int item = bid; item < 32; item += nb) {
        const int b = item >> 2, h = item & 3;
        const float gamma = expf(p->in[I_RLD][o * 8 + dir * 4 + h]);
        float S[32];
#pragma unroll
        for (int j = 0; j < 32; ++j) S[j] = 0.f;
        for (int i = 0; i < CTXL + SEQ; ++i) {
            const int tok = scan_tok(b, i, dir);
            const bool lat = tok < NL;
            const int t = tok & (SEQ - 1);
            const float pos = (kq < 2) ? (float)(t >> 6) : (float)(t & 63);
            const bf16_t* pr = P + (size_t)tok * ODD_N;
            const float vv = ldf(pr + 2560 + h * 128 + v);
            float acc = 0.f;
#pragma unroll
            for (int j = 0; j < 32; ++j) {
                const int dim = kq * 32 + j, pd = dim ^ 32;
                float qv = ldf(pr + 1536 + h * 128 + dim), kv = ldf(pr + 2048 + h * 128 + dim);
                if (lat) {
                    const float qp = ldf(pr + 1536 + h * 128 + pd), kp = ldf(pr + 2048 + h * 128 + pd);
                    const float ang = pos * exp2f(-(float)j * 0.41524101186092029f);
                    const float c = __cosf(ang), s = __sinf(ang);
                    if ((dim & 32) == 0) { qv = qv * c - qp * s; kv = kv * c - kp * s; }
                    else { qv = qp * s + qv * c; kv = kp * s + kv * c; }
                }
                kv *= 0.08838834764831845f;
                S[j] = gamma * S[j] + kv * vv;
                acc += qv * S[j];
            }
            acc += __shfl_xor(acc, 1, 64); acc += __shfl_xor(acc, 2, 64);
            if (kq == 0) { float* op = HX + (size_t)tok * 1024 + 512 + h * 128 + v; *op = dir ? *op + acc : acc; }
        }
    }
}

__device__ __forceinline__ void ph_hy_filt(KP p, int l, int bid, int nb, float* sm) {
    const int tid = opaque_tid(), o = l >> 1;
    float* z = sm;
    float* h1 = sm + 64;
    float* h2 = sm + 128;
    float* h3 = sm + 192;
    const float* fw1 = p->in[I_HW1] + o * 33 * 64; const float* fb1 = p->in[I_HB1] + o * 64;
    const float* fw2 = p->in[I_HW2] + o * 64 * 64; const float* fb2 = p->in[I_HB2] + o * 64;
    const float* fw3 = p->in[I_HW3] + o * 64 * 64; const float* fb3 = p->in[I_HB3] + o * 64;
    const float* freq = p->in[I_HFREQ] + o * 64;
    const float* wout = p->in[I_HWOUT] + (size_t)o * 64 * 2048;
    float* Flat = (float*)(p->ws + OFF_FILT);
    float* Fctx = Flat + (size_t)2 * 2 * 512 * 4096;
    #pragma unroll 1
    for (int item = bid; item < SEQ + CTXL; item += nb) {
        const bool isctx = item >= SEQ;
        const int L = isctx ? CTXL : SEQ, pos = isctx ? item - SEQ : item;
        const float t = (float)pos / (float)(L - 1);
        __syncthreads();
        if (tid == 0) z[0] = t;
        if (tid < 16) {
            const float f = 1e-4f + (float)tid * ((15.0f - 1e-4f) / 15.0f);
            const float w = 2.0f * 3.14159265358979323846f * (float)pos / (float)L * f;
            z[1 + tid] = cosf(w); z[17 + tid] = sinf(w);
        }
        __syncthreads();
        if (tid < 64) { float a = fb1[tid];
#pragma unroll 1
            for (int k = 0; k < 33; ++k) a += z[k] * fw1[k * 64 + tid]; h1[tid] = sinf(freq[tid] * a); }
        __syncthreads();
        if (tid < 64) { float a = fb2[tid];
#pragma unroll 4
            for (int k = 0; k < 64; ++k) a += h1[k] * fw2[k * 64 + tid]; h2[tid] = sinf(freq[tid] * a); }
        __syncthreads();
        if (tid < 64) { float a = fb3[tid];
#pragma unroll 4
            for (int k = 0; k < 64; ++k) a += h2[k] * fw3[k * 64 + tid]; h3[tid] = sinf(freq[tid] * a); }
        __syncthreads();
#pragma unroll 1
        for (int r = 0; r < 4; ++r) {
            const int col = tid + 512 * r, c = col & 511, od = col >> 9;
            float a = 0.f;
#pragma unroll 4
            for (int k = 0; k < 64; ++k) a += h3[k] * wout[k * 2048 + col];
            const float delta = 3.0701134573253944f + (float)c * ((15.350567286626972f - 3.0701134573253944f) / 511.0f);
            a *= expf(-t * delta);
            if (isctx) Fctx[((size_t)od * 512 + c) * CTXL + pos] = a; else Flat[((size_t)od * 512 + c) * SEQ + pos] = a;
        }
    }
}

__device__ __forceinline__ float hy_conv3(const bf16_t* P, const float* cw, const float* cb, int tok, int j) {
    const bool lat = tok < NL;
    const int L = lat ? SEQ : CTXL, t = lat ? (tok & (SEQ - 1)) : ((tok - NL) & (CTXL - 1));
    const bf16_t* pr = P + (size_t)tok * ODD_N + j;
    float a = ldf(pr) * cw[1536 + j] + cb[j];
    if (t > 0) a += ldf(pr - ODD_N) * cw[j];
    if (t < L - 1) a += ldf(pr + ODD_N) * cw[2 * 1536 + j];
    return a;
}

__device__ __forceinline__ void ph_hy_conv(KP p, int l, int order, int bid, int nb, float* sm) {
    const int tid = opaque_tid(), o = l >> 1;
    const bf16_t* P = (const bf16_t*)(p->ws + OFF_BIG);
    const float* cw = p->in[I_HCW] + o * 3 * 1536; const float* cb = p->in[I_HCB] + o * 1536;
    const float* skip = p->in[I_HSKIP] + o * 1024 + order * 512;
    const float* Zin = (const float*)(p->ws + OFF_Z1);
    float* Zout = (float*)(p->ws + (order == 0 ? OFF_Z1 : OFF_Z2));
    const float* Flat = (const float*)(p->ws + OFF_FILT);
    const float* Fctx = Flat + (size_t)2 * 2 * 512 * 4096;
    #pragma unroll 1
    for (int item = bid; item < 1024 + 512; item += nb) {
        __syncthreads();
        if (item < 1024) {
            const int c = item >> 1, bg = item & 1;
            float* Kc = sm;
            float* zb = sm + 8192;
            const float* hf = Flat + ((size_t)(order * 2 + 0) * 512 + c) * SEQ;
            const float* hb = Flat + ((size_t)(order * 2 + 1) * 512 + c) * SEQ;
            for (int i = tid; i < 8192; i += 512) { const int lag = i - 4096; Kc[i] = lag >= 0 ? hf[lag] : (lag > -4096 ? hb[-lag] : 0.f); }
            for (int i = tid; i < 4 * SEQ; i += 512) {
                const int bb = i >> 12, s = i & (SEQ - 1), tok = (bg * 4 + bb) * SEQ + s;
                zb[i] = order == 0 ? hy_conv3(P, cw, cb, tok, 1024 + c) : Zin[(size_t)tok * 512 + c];
            }
            __syncthreads();
            float acc[8][4];
#pragma unroll
            for (int i = 0; i < 8; ++i)
#pragma unroll
                for (int bb = 0; bb < 4; ++bb) acc[i][bb] = 0.f;
            for (int s = 0; s < SEQ; ++s) {
                float zv[4];
#pragma unroll
                for (int bb = 0; bb < 4; ++bb) zv[bb] = zb[bb * SEQ + s];
#pragma unroll
                for (int i = 0; i < 8; ++i) {
                    const float kv = Kc[tid + 512 * i - s + 4096];
#pragma unroll
                    for (int bb = 0; bb < 4; ++bb) acc[i][bb] += kv * zv[bb];
                }
            }
            const float sk = skip[c];
#pragma unroll
            for (int i = 0; i < 8; ++i)
#pragma unroll
                for (int bb = 0; bb < 4; ++bb) {
                    const int t = tid + 512 * i, tok = (bg * 4 + bb) * SEQ + t;
                    const float g = hy_conv3(P, cw, cb, tok, order * 512 + c);
                    Zout[(size_t)tok * 512 + c] = g * (acc[i][bb] + zb[bb * SEQ + t] * sk);
                }
        } else {
            const int c = item - 1024;
            float* Kc = sm;
            float* zb = sm + 512;
            const float* hf = Fctx + ((size_t)(order * 2 + 0) * 512 + c) * CTXL;
            const float* hb = Fctx + ((size_t)(order * 2 + 1) * 512 + c) * CTXL;
            for (int i = tid; i < 512; i += 512) { const int lag = i - 256; Kc[i] = lag >= 0 ? hf[lag] : (lag > -256 ? hb[-lag] : 0.f); }
            for (int i = tid; i < 8 * CTXL; i += 512) {
                const int bb = i >> 8, s = i & (CTXL - 1), tok = NL + bb * CTXL + s;
                zb[i] = order == 0 ? hy_conv3(P, cw, cb, tok, 1024 + c) : Zin[(size_t)tok * 512 + c];
            }
            __syncthreads();
            const int bb = tid >> 6, tl = tid & 63;
            float acc[4] = {0.f, 0.f, 0.f, 0.f};
            for (int s = 0; s < CTXL; ++s) {
                const float zv = zb[bb * CTXL + s];
#pragma unroll
                for (int i = 0; i < 4; ++i) acc[i] += Kc[tl + 64 * i - s + 256] * zv;
            }
            const float sk = skip[c];
#pragma unroll
            for (int i = 0; i < 4; ++i) {
                const int t = tl + 64 * i, tok = NL + bb * CTXL + t;
                const float g = hy_conv3(P, cw, cb, tok, order * 512 + c);
                Zout[(size_t)tok * 512 + c] = g * (acc[i] + zb[bb * CTXL + t] * sk);
            }
        }
    }
}

__device__ __forceinline__ void ph_normgate_odd(KP p, int l, int bid, int nb) {
    const int tid = opaque_tid(), lane = tid & 63, wv = tid >> 6, o = l >> 1;
    const bf16_t* P = (const bf16_t*)(p->ws + OFF_BIG);
    const float* HX = (const float*)(p->ws + OFF_AUX);
    const float* Z2 = (const float*)(p->ws + OFF_Z2);
    bf16_t* MIX = (bf16_t*)(p->ws + OFF_U);
    #pragma unroll 1
    for (int tok = bid * 8 + wv; tok < NT; tok += nb * 8) {
        const bf16_t* pr = P + (size_t)tok * ODD_N;
#pragma unroll
        for (int g = 0; g < 8; ++g) {
            const float x = Z2[(size_t)tok * 512 + g * 64 + lane];
            const float ms = wave_sum(x * x) * (1.f / 64.f);
            stf(MIX + (size_t)tok * DM + g * 64 + lane, x * rsqrtf(ms + LN_EPS) * p->in[I_HNORM][o * 512 + g * 64 + lane]);
        }
#pragma unroll
        for (int h = 0; h < 4; ++h) {
            const float* hx = HX + (size_t)tok * 1024 + 512 + h * 128;
            float x0 = hx[lane], x1 = hx[lane + 64];
            const float mean = wave_sum(x0 + x1) * (1.f / 128.f);
            x0 -= mean; x1 -= mean;
            const float var = wave_sum(x0 * x0 + x1 * x1) * (1.f / 128.f);
            const float r = rsqrtf(var + LN_EPS);
            const float* nw = p->in[I_RNW] + o * 512 + h * 128;
            const float g0 = ldf(pr + 3072 + h * 128 + lane), g1 = ldf(pr + 3072 + h * 128 + lane + 64);
            stf(MIX + (size_t)tok * DM + 512 + h * 128 + lane, x0 * r * nw[lane] * siluf_(g0));
            stf(MIX + (size_t)tok * DM + 512 + h * 128 + lane + 64, x1 * r * nw[lane + 64] * siluf_(g1));
        }
    }
}


__device__ __forceinline__ void ph_ln1_router(KP p, int l, int ntok, int bid, int nb, float* sm) {
    const int tid = opaque_tid(), lane = tid & 63, wv = tid >> 6;
    const float* Y = (const float*)(p->ws + OFF_BIG);
    bf16_t* U = (bf16_t*)(p->ws + OFF_U);
    const float* lw = p->in[I_LNW] + (l * 2) * 1024; const float* lb = p->in[I_LNB] + (l * 2) * 1024;
    const float* rw = p->in[I_RW] + (size_t)l * 1024 * 64;
    const float rb = p->in[I_RB][l * 64 + lane];
    int* cnt = (int*)(p->ws + OFF_CNT) + l * 64;
    int* tidx = (int*)(p->ws + OFF_TIDX); float* tgate = (float*)(p->ws + OFF_TGATE); int* tpos = (int*)(p->ws + OFF_TPOS);
    float* Vs = sm + wv * 4096;
    {
        int* stok = (int*)(p->ws + OFF_STOK); float* sgate = (float*)(p->ws + OFF_SGATE); int* sdst = (int*)(p->ws + OFF_SDST);
        #pragma unroll 1
        for (int i = bid * 512 + tid; i < MAXROWS; i += nb * 512) { stok[i] = ZROW; sgate[i] = 0.f; sdst[i] = -1; }
    }
    #pragma unroll 1
    for (int base = bid * 32; base < ntok; base += nb * 32) {
#pragma unroll 1
        for (int j = 0; j < 4; ++j) {
            const int tok = base + wv * 4 + j;
            float* h = hrow(p, tok);
            const float* m = modrow(p, l, tok);
            const float* r = Y + (size_t)tok * DM;
            float x[16]; float s = 0.f;
#pragma unroll
            for (int c = 0; c < 4; ++c) {
                const int d = 4 * (lane + 64 * c);
                const float4 hv = *(const float4*)(h + d), gv = *(const float4*)(m + 2 * 1024 + d), rv = *(const float4*)(r + d);
                x[4 * c] = ALPHA * hv.x + gv.x * rv.x; x[4 * c + 1] = ALPHA * hv.y + gv.y * rv.y; x[4 * c + 2] = ALPHA * hv.z + gv.z * rv.z; x[4 * c + 3] = ALPHA * hv.w + gv.w * rv.w;
                s += x[4 * c] + x[4 * c + 1] + x[4 * c + 2] + x[4 * c + 3];
            }
            const float mean = wave_sum(s) * (1.f / 1024.f);
            float q = 0.f;
#pragma unroll
            for (int i = 0; i < 16; ++i) { x[i] -= mean; q += x[i] * x[i]; }
            const float rs = rsqrtf(wave_sum(q) * (1.f / 1024.f) + LN_EPS);
#pragma unroll
            for (int c = 0; c < 4; ++c) {
                const int d = 4 * (lane + 64 * c);
                const float4 w4 = *(const float4*)(lw + d), b4 = *(const float4*)(lb + d), sh = *(const float4*)(m + 3 * 1024 + d), sc = *(const float4*)(m + 4 * 1024 + d);
                float4 y; y.x = x[4 * c] * rs * w4.x + b4.x; y.y = x[4 * c + 1] * rs * w4.y + b4.y; y.z = x[4 * c + 2] * rs * w4.z + b4.z; y.w = x[4 * c + 3] * rs * w4.w + b4.w;
                *(float4*)(h + d) = y;
                float4 v; v.x = y.x * (1.f + sc.x) + sh.x; v.y = y.y * (1.f + sc.y) + sh.y; v.z = y.z * (1.f + sc.z) + sh.z; v.w = y.w * (1.f + sc.w) + sh.w;
                *(uint2*)(U + (size_t)tok * DM + d) = make_uint2(cvt_pk_bf16(v.x, v.y), cvt_pk_bf16(v.z, v.w));
                *(float4*)(Vs + j * 1024 + d) = v;
            }
        }
        __syncthreads();
        float a[4] = {0.f, 0.f, 0.f, 0.f};
#pragma unroll 2
        for (int d = 0; d < 1024; d += 4) {
            const float w0 = rw[(d + 0) * 64 + lane], w1 = rw[(d + 1) * 64 + lane], w2 = rw[(d + 2) * 64 + lane], w3 = rw[(d + 3) * 64 + lane];
#pragma unroll
            for (int j = 0; j < 4; ++j) { const float4 v = *(const float4*)(Vs + j * 1024 + d); a[j] += v.x * w0 + v.y * w1 + v.z * w2 + v.w * w3; }
        }
#pragma unroll
        for (int j = 0; j < 4; ++j) {
            const int tok = base + wv * 4 + j;
            const float score = sigmoidf_(a[j]);
            float key = score + rb;
            float mysel = 0.f; int myidx = 0; float gsum = 0.f;
#pragma unroll
            for (int s = 0; s < TOPK; ++s) {
                float bv = key; int bi = lane;
#pragma unroll
                for (int o = 32; o > 0; o >>= 1) {
                    const float ov = __shfl_xor(bv, o, 64); const int oi = __shfl_xor(bi, o, 64);
                    if (ov > bv || (ov == bv && oi < bi)) { bv = ov; bi = oi; }
                }
                const float sc = __shfl(score, bi, 64);
                gsum += sc;
                if (lane == s) { mysel = sc; myidx = bi; }
                if (lane == bi) key = -1e30f;
            }
            if (lane < TOPK) {
                const int pos = atomicAdd(&cnt[myidx], 1);
                tidx[tok * 8 + lane] = myidx; tgate[tok * 8 + lane] = 2.5f * mysel / gsum; tpos[tok * 8 + lane] = pos;
            }
        }
        __syncthreads();
    }
}

__device__ __forceinline__ void moe_offsets(KP p, int l, int ntok, LAS int* offs) {
    if (threadIdx.x == 0) {
        int* cnt = (int*)(p->ws + OFF_CNT) + l * 64;
        int a = 0;
#pragma unroll 1
        for (int e = 0; e < 64; ++e) { offs[e] = a; a += (__hip_atomic_load(cnt + e, __ATOMIC_RELAXED, __HIP_MEMORY_SCOPE_AGENT) + 255) & ~255; }
        offs[64] = a; offs[65] = a + ntok;
    }
    __syncthreads();
}
__device__ __forceinline__ int moe_expert_of(const LAS int* offs, int row) { int e = 0;
#pragma unroll 1
    while (e < 64 && row >= offs[e + 1]) ++e;
    return e; }

__device__ __forceinline__ void ph_scatter(KP p, int l, int ntok, int bid, int nb, LAS unsigned char* lds) {
    LAS int* offs = (LAS int*)lds;
    moe_offsets(p, l, ntok, offs);
    const int tid = opaque_tid();
    const int* tidx = (const int*)(p->ws + OFF_TIDX); const float* tgate = (const float*)(p->ws + OFF_TGATE); const int* tpos = (const int*)(p->ws + OFF_TPOS);
    int* stok = (int*)(p->ws + OFF_STOK); float* sgate = (float*)(p->ws + OFF_SGATE); int* sdst = (int*)(p->ws + OFF_SDST);
    int* tile_e = (int*)(p->ws + OFF_TILEE);
    #pragma unroll 1
    for (int i = bid * 512 + tid; i < ntok * 9; i += nb * 512) {
        if (i < ntok * 8) { const int row = offs[tidx[i]] + tpos[i], tok = i >> 3; stok[row] = tok; sgate[row] = tgate[i]; sdst[row] = tok * 9 + (i & 7); }
        else { const int tok = i - ntok * 8, row = offs[64] + tok; stok[row] = tok; sgate[row] = 1.f; sdst[row] = tok * 9 + 8; }
    }
    const int nrt = offs[65] >> 8;
    #pragma unroll 1
    for (int rt = bid * 512 + tid; rt < nrt; rt += nb * 512) tile_e[rt] = moe_expert_of(offs, rt * 256);
    __syncthreads();
}

#define MOE_TAB (gp::STAGE_BYTES + 256)
#define MOE_MAXT 8
struct Moe1Sched {
    const char* U; const char* W; const LAS int* tabE; const LAS int* tabS; int nper, bid, nb;
    __device__ __forceinline__ bool next(int i, gp::Unit& u) const {
        const int j = i >> 1; if (j >= nper) return false;
        u.A = U; u.B = W + (size_t)tabE[j] * (512 * 1024 * 2) + (size_t)(i & 1) * (256 * 1024 * 2); u.r0 = (bid + j * nb) * 256; u.c0 = (i & 1) * 256; u.aux = j; return true;
    }
    __device__ __forceinline__ void lane_off(const gp::Unit& u, int R0, int R1, int C0, int C1, unsigned (&vo)[2][2]) const {
        const LAS int* t = tabS + u.aux * 256;
        vo[0][0] = (unsigned)t[R0] * 2048u + (unsigned)C0 * 2u; vo[0][1] = (unsigned)t[R1] * 2048u + (unsigned)C1 * 2u;
        vo[1][0] = (unsigned)t[128 + R0] * 2048u + (unsigned)C0 * 2u; vo[1][1] = (unsigned)t[128 + R1] * 2048u + (unsigned)C1 * 2u;
    }
};
struct EpiH {
    bf16_t* H;
    __device__ __forceinline__ void operator()(const gp::f32x4 (&acc)[2][2][4][2], const gp::Unit& u, int wr, int wc, int fr, int fq) const {
        const int row0 = u.r0 + wr * 64 + fr;
#pragma unroll
        for (int ai = 0; ai < 2; ++ai)
#pragma unroll
            for (int m = 0; m < 4; ++m) { bf16_t* rowp = H + (size_t)(row0 + ai * 128 + m * 16) * 256;
#pragma unroll
                for (int bj = 0; bj < 2; ++bj) {
                    const int j0 = ((u.c0 + bj * 128 + wc * 32) >> 5) * 16 + 4 * fq;
                    const gp::f32x4 a = acc[ai][bj][m][0], b = acc[ai][bj][m][1];
                    const float h0 = siluf_(a[0]) * b[0], h1 = siluf_(a[1]) * b[1], h2 = siluf_(a[2]) * b[2], h3 = siluf_(a[3]) * b[3];
                    *(uint2*)(rowp + j0) = make_uint2(cvt_pk_bf16(h0, h1), cvt_pk_bf16(h2, h3)); }
                __builtin_amdgcn_sched_barrier(0); }
    }
};
__device__ __forceinline__ void ph_moe1(KP p, int l, int ntok, int bid, int nb, LAS unsigned char* lds) {
    LAS int* offs = (LAS int*)(lds + MOE_TAB);
    LAS int* tabE = offs + 128;
    LAS int* tabS = offs + 256;
    moe_offsets(p, l, ntok, offs);
    const int tid = opaque_tid();
    const int nrt = offs[65] >> 8;
    const int nper = bid < nrt ? (nrt - bid + nb - 1) / nb : 0;
    const int* stok = (const int*)(p->ws + OFF_STOK); const int* tile_e = (const int*)(p->ws + OFF_TILEE);
    for (int i = tid; i < nper * 256; i += 512) tabS[i] = stok[(size_t)(bid + (i >> 8) * nb) * 256 + (i & 255)];
    if (tid < nper) tabE[tid] = tile_e[bid + tid * nb];
    __syncthreads();
    Moe1Sched S{(const char*)(p->ws + OFF_U), (const char*)(p->ws + OFF_W13), tabE, tabS, nper, bid, nb};
    EpiH E{(bf16_t*)(p->ws + OFF_BIG)};
    gp::gemm_phase<true, false>(lds, 1024, S, E);
}

struct Moe2Sched {
    const char* H; const char* W; const LAS int* tabE; int nper, bid, nb;
    __device__ __forceinline__ bool next(int i, gp::Unit& u) const {
        const int j = i >> 2; if (j >= nper) return false;
        u.A = H + (size_t)(bid + j * nb) * (256 * 256 * 2); u.B = W + (size_t)tabE[j] * (1024 * 256 * 2) + (size_t)(i & 3) * (256 * 256 * 2); u.r0 = j * 256; u.c0 = (i & 3) * 256; u.aux = j; return true;
    }
    __device__ __forceinline__ void lane_off(const gp::Unit&, int, int, int, int, unsigned (&)[2][2]) const {}
};
struct EpiY {
    bf16_t* Ys; const LAS int* tabD; const LAS float* tabG;
    __device__ __forceinline__ void operator()(const gp::f32x4 (&acc)[2][2][4][2], const gp::Unit& u, int wr, int wc, int fr, int fq) const {
        const int rl0 = u.r0 + wr * 64 + fr, col0 = u.c0 + wc * 32 + 8 * fq;
#pragma unroll
        for (int ai = 0; ai < 2; ++ai)
#pragma unroll
            for (int m = 0; m < 4; ++m) {
                const int rl = rl0 + ai * 128 + m * 16;
                const int dst = tabD[rl]; const float g = tabG[rl];
                if (dst >= 0) { bf16_t* rowp = Ys + (size_t)dst * 1024 + col0;
#pragma unroll
                    for (int bj = 0; bj < 2; ++bj) { const gp::f32x4 v0 = acc[ai][bj][m][0] * g, v1 = acc[ai][bj][m][1] * g;
                        gp::u32x4 w; w.x = cvt_pk_bf16(v0[0], v0[1]); w.y = cvt_pk_bf16(v0[2], v0[3]); w.z = cvt_pk_bf16(v1[0], v1[1]); w.w = cvt_pk_bf16(v1[2], v1[3]);
                        *(gp::u32x4*)(rowp + bj * 128) = w; } }
                __builtin_amdgcn_sched_barrier(0); }
    }
};
__device__ __forceinline__ void ph_moe2(KP p, int l, int ntok, int bid, int nb, LAS unsigned char* lds) {
    LAS int* offs = (LAS int*)(lds + MOE_TAB);
    LAS int* tabE = offs + 128;
    LAS int* tabD = offs + 256;
    LAS float* tabG = (LAS float*)(tabD + MOE_MAXT * 256);
    moe_offsets(p, l, ntok, offs);
    const int tid = opaque_tid();
    const int nrt = offs[65] >> 8;
    const int nper = bid < nrt ? (nrt - bid + nb - 1) / nb : 0;
    const int* sdst = (const int*)(p->ws + OFF_SDST); const float* sgate = (const float*)(p->ws + OFF_SGATE); const int* tile_e = (const int*)(p->ws + OFF_TILEE);
    for (int i = tid; i < nper * 256; i += 512) { const size_t r = (size_t)(bid + (i >> 8) * nb) * 256 + (i & 255); tabD[i] = sdst[r]; tabG[i] = sgate[r]; }
    if (tid < nper) tabE[tid] = tile_e[bid + tid * nb];
    __syncthreads();
    Moe2Sched S{(const char*)(p->ws + OFF_BIG), (const char*)(p->ws + OFF_W2), tabE, nper, bid, nb};
    EpiY E{(bf16_t*)(p->ws + OFF_YS), tabD, tabG};
    gp::gemm_phase<false, true>(lds, 256, S, E);
}

__device__ __forceinline__ void ph_combine_ln2(KP p, int l, int ntok, int bid, int nb) {
    const int tid = opaque_tid(), lane = tid & 63, wv = tid >> 6;
    const bf16_t* Ys = (const bf16_t*)(p->ws + OFF_YS);
    const float* lw = p->in[I_LNW] + (l * 2 + 1) * 1024; const float* lb = p->in[I_LNB] + (l * 2 + 1) * 1024;
    #pragma unroll 1
    for (int tok = bid * 8 + wv; tok < ntok; tok += nb * 8) {
        float* h = hrow(p, tok);
        const float* m = modrow(p, l, tok);
        float f[16];
#pragma unroll
        for (int i = 0; i < 16; ++i) f[i] = 0.f;
#pragma unroll
        for (int s = 0; s < 9; ++s)
#pragma unroll
            for (int c = 0; c < 2; ++c) {
                const uint4 w = *(const uint4*)(Ys + ((size_t)tok * 9 + s) * 1024 + 8 * (lane + 64 * c));
                f[8 * c + 0] += bflo(w.x); f[8 * c + 1] += bfhi(w.x); f[8 * c + 2] += bflo(w.y); f[8 * c + 3] += bfhi(w.y);
                f[8 * c + 4] += bflo(w.z); f[8 * c + 5] += bfhi(w.z); f[8 * c + 6] += bflo(w.w); f[8 * c + 7] += bfhi(w.w);
            }
        float x[16]; float sum = 0.f;
#pragma unroll
        for (int c = 0; c < 2; ++c)
#pragma unroll
            for (int q = 0; q < 2; ++q) {
                const int d = 8 * (lane + 64 * c) + 4 * q;
                const float4 hv = *(const float4*)(h + d), gv = *(const float4*)(m + 5 * 1024 + d);
                x[8 * c + 4 * q + 0] = ALPHA * hv.x + gv.x * f[8 * c + 4 * q + 0]; x[8 * c + 4 * q + 1] = ALPHA * hv.y + gv.y * f[8 * c + 4 * q + 1];
                x[8 * c + 4 * q + 2] = ALPHA * hv.z + gv.z * f[8 * c + 4 * q + 2]; x[8 * c + 4 * q + 3] = ALPHA * hv.w + gv.w * f[8 * c + 4 * q + 3];
                sum += x[8 * c + 4 * q] + x[8 * c + 4 * q + 1] + x[8 * c + 4 * q + 2] + x[8 * c + 4 * q + 3];
            }
        const float mean = wave_sum(sum) * (1.f / 1024.f);
        float q2 = 0.f;
#pragma unroll
        for (int i = 0; i < 16; ++i) { x[i] -= mean; q2 += x[i] * x[i]; }
        const float rs = rsqrtf(wave_sum(q2) * (1.f / 1024.f) + LN_EPS);
#pragma unroll
        for (int c = 0; c < 2; ++c)
#pragma unroll
            for (int q = 0; q < 2; ++q) {
                const int d = 8 * (lane + 64 * c) + 4 * q;
                const float4 w4 = *(const float4*)(lw + d), b4 = *(const float4*)(lb + d);
                float4 y; y.x = x[8 * c + 4 * q] * rs * w4.x + b4.x; y.y = x[8 * c + 4 * q + 1] * rs * w4.y + b4.y; y.z = x[8 * c + 4 * q + 2] * rs * w4.z + b4.z; y.w = x[8 * c + 4 * q + 3] * rs * w4.w + b4.w;
                *(float4*)(h + d) = y;
            }
    }
}

#define MEGA_LDS (131072 + 256 + 20480)
#define NBLK 256
#define BAR_LDS 131072
#define SYNC() do { XcdBarrier _b; _b.bar = (unsigned*)kparams()->ws; _b.x = xb_xcc_id(); _b.st = (volatile LAS unsigned*)((LAS unsigned char*)smraw_base() + BAR_LDS); xcd_barrier(_b); } while (0)
extern __shared__ __attribute__((aligned(16))) unsigned char smraw_all[];
__device__ __forceinline__ LAS unsigned char* smraw_base() { return (LAS unsigned char*)smraw_all; }
__device__ __forceinline__ unsigned char* smraw_generic() { return smraw_all; }
template <int PAR>
__device__ __forceinline__ void layer_fwd(const int l) {
    LAS unsigned char* lds = smraw_base(); float* sm = (float*)smraw_generic();
    const int bid = blockIdx.x; constexpr int nb = NBLK;
    const int ntok = (l == 3) ? NL : NT;
    ph_convert(kparams(), l, bid, nb, sm); ph_modin(kparams(), l, bid, nb); SYNC();
    ph_gemm_in(kparams(), l, bid, nb, lds); SYNC();
    if (PAR == 0) {
        ph_scan_even(kparams(), l, 0, bid, nb); SYNC();
        ph_scan_even(kparams(), l, 1, bid, nb); SYNC();
        ph_normgate_even(kparams(), l, bid, nb); SYNC();
    } else {
        ph_scan_odd(kparams(), l, 0, bid, nb); ph_hy_filt(kparams(), l, bid, nb, sm); SYNC();
        ph_scan_odd(kparams(), l, 1, bid, nb); ph_hy_conv(kparams(), l, 0, bid, nb, sm); SYNC();
        ph_hy_conv(kparams(), l, 1, bid, nb, sm); SYNC();
        ph_normgate_odd(kparams(), l, bid, nb); SYNC();
    }
    ph_gemm_out(kparams(), l, bid, nb, lds); SYNC();
    ph_ln1_router(kparams(), l, ntok, bid, nb, sm); SYNC();
    ph_scatter(kparams(), l, ntok, bid, nb, lds); SYNC();
    ph_moe1(kparams(), l, ntok, bid, nb, lds); SYNC();
    ph_moe2(kparams(), l, ntok, bid, nb, lds); SYNC();
    ph_combine_ln2(kparams(), l, ntok, bid, nb);
    if (l < 3) SYNC();
}
__global__ void __launch_bounds__(512, 2) mega_fwd(Params p) {
    LAS unsigned char* lds = smraw_base(); float* sm = (float*)smraw_generic();
    if (threadIdx.x < 4) ((LAS unsigned*)(lds + 131072))[threadIdx.x] = 0u;
    __syncthreads();
    (void)xcd_barrier_post((unsigned*)kparams()->ws, (volatile LAS unsigned*)(lds + BAR_LDS));
    const int bid = blockIdx.x; constexpr int nb = NBLK;
    ph_prologue(kparams(), bid, nb, sm); SYNC();
#pragma unroll 1
    for (int lp = 0; lp < 2; ++lp) {
        layer_fwd<0>(2 * lp);
        layer_fwd<1>(2 * lp + 1);
    }
    __syncthreads();
    if (blockIdx.x == 0 && threadIdx.x == 0 && xb_ld((unsigned*)kparams()->ws + XB_TMO) != 0u) kparams()->out[0] = __builtin_nanf("");
}

extern "C" void kernel_launch(void* const* d_in, const int* in_sizes, int n_in, void* d_out, int out_size, void* d_ws, size_t ws_size, hipStream_t stream) {
    static int grid = 0;
    if (grid == 0) {
        if (n_in != 38 || out_size != NL * DM || ws_size < WS_END) { fprintf(stderr, "kernel_launch: bad shapes n_in %d out %d ws %zu (need %zu)\n", n_in, out_size, ws_size, (size_t)WS_END); grid = -1; return; }
        int dev = 0, cus = 0, per_cu = 0;
        if (hipGetDevice(&dev) != hipSuccess || hipDeviceGetAttribute(&cus, hipDeviceAttributeMultiprocessorCount, dev) != hipSuccess) { grid = -1; return; }
        if (hipFuncSetAttribute((const void*)mega_fwd, hipFuncAttributeMaxDynamicSharedMemorySize, MEGA_LDS) != hipSuccess) { fprintf(stderr, "kernel_launch: hipFuncSetAttribute failed\n"); grid = -1; return; }
        if (hipOccupancyMaxActiveBlocksPerMultiprocessor(&per_cu, (const void*)mega_fwd, 512, MEGA_LDS) != hipSuccess || per_cu < 1) { fprintf(stderr, "kernel_launch: occupancy query says %d\n", per_cu); (void)hipGetLastError(); grid = -1; return; }
        if (cus != 256) { fprintf(stderr, "kernel_launch: built for 256 CUs, found %d\n", cus); grid = -1; return; }
        grid = NBLK;
    }
    if (grid < 0) return;
    if (hipMemsetAsync(d_ws, 0, OFF_LB, stream) != hipSuccess) return;
    Params p{};
    for (int i = 0; i < 38; ++i) p.in[i] = (const float*)d_in[i];
    p.out = (float*)d_out; p.ws = (unsigned char*)d_ws;
    hipLaunchKernelGGL(mega_fwd, dim3(grid), dim3(512), MEGA_LDS, stream, p);
}
```

```cpp
#include <hip/hip_runtime.h>
#include <stdint.h>
#include <stdio.h>

#define DM 1024
#define NBATCH 8
#define SEQ 4096
#define CTXL 256
#define NL (NBATCH * SEQ)
#define NC (NBATCH * CTXL)
#define NT (NL + NC)
#define ZROW NT
#define TOPK 8
#define EVEN_N 4112
#define ODD_N 3584
#define EVEN_LD 4096
#define ODD_LD 3584
#define MAXROWS (NT * 8 + 64 * 256 + NT)
#define ALPHA 1.681792830507429f
#define LN_EPS 1e-5f
#define E_MQ 0
#define E_MK 256
#define E_MV 512
#define E_MO 1024
#define E_HQ 1536
#define E_HI 2048
#define E_HFF 2560
#define E_HFB 3072
#define E_HG 3584

typedef unsigned short bf16_t;
#define LAS __attribute__((address_space(3)))

#define MiB ((size_t)1 << 20)
#define OFF_CNT   ((size_t)64 << 10)
#define OFF_LB    ((size_t)96 << 10)
#define OFF_MOD   ((size_t)128 << 10)
#define OFF_ROPE  ((size_t)1536 << 10)
#define OFF_TILEE (2 * MiB)
#define OFF_HCTX  (4 * MiB)
#define OFF_TIDX  (12 * MiB)
#define OFF_TGATE (14 * MiB)
#define OFF_TPOS  (16 * MiB)
#define OFF_STOK  (18 * MiB)
#define OFF_SGATE (20 * MiB)
#define OFF_SDST  (22 * MiB)
#define OFF_G     (24 * MiB)
#define OFF_U     (28 * MiB)
#define OFF_W     (98 * MiB)
#define OFF_WIN   (OFF_W)
#define OFF_WOUT  (OFF_W + 8 * MiB)
#define OFF_W13   (OFF_W + 10 * MiB)
#define OFF_W2    (OFF_W + 75 * MiB)
#define OFF_BIG   (208 * MiB)
#define OFF_AUX   (480 * MiB)
#define OFF_Z1    (OFF_AUX + 136 * MiB)
#define OFF_Z2    (OFF_Z1 + 68 * MiB)
#define OFF_FILT  (OFF_Z2 + 68 * MiB)
#define OFF_YS    (370 * MiB)
#define WS_END    (984 * MiB)

struct Params {
    const float* in[38];
    float* out;
    unsigned char* ws;
};

enum { I_X = 0, I_C, I_CTX, I_CCTX, I_ADAW, I_ADAB, I_LNW, I_LNB, I_EWIN, I_MGB, I_MNW, I_HLB, I_HNW, I_EWOUT, I_OWIN, I_HCW, I_HCB,
       I_HW1, I_HB1, I_HW2, I_HB2, I_HW3, I_HB3, I_HFREQ, I_HWOUT, I_HSKIP, I_HNORM, I_RLD, I_RNW, I_OWOUT, I_RW, I_RB, I_W1, I_W3, I_W2, I_SW1, I_SW3, I_SW2 };

typedef const __attribute__((address_space(4))) Params* KP;
__device__ __forceinline__ KP kparams() { KP k = (KP)__builtin_amdgcn_kernarg_segment_ptr(); asm volatile("" : "+s"(k)); return k; }
extern __shared__ __attribute__((aligned(16))) unsigned char smraw_all[];
__device__ __forceinline__ LAS unsigned char* smraw_base() { return (LAS unsigned char*)smraw_all; }
__device__ __forceinline__ unsigned char* smraw_generic() { return smraw_all; }
__device__ __forceinline__ int opaque_tid() { int t = threadIdx.x; asm volatile("" : "+v"(t)); return t; }
typedef __bf16 bf16x2_n __attribute__((ext_vector_type(2)));
typedef float f32x2_n __attribute__((ext_vector_type(2)));
__device__ __forceinline__ unsigned cvt_pk_bf16(float lo, float hi) { const f32x2_n v = {lo, hi}; return __builtin_bit_cast(unsigned, __builtin_convertvector(v, bf16x2_n)); }
__device__ __forceinline__ float bf2f(bf16_t b) { return __uint_as_float(((unsigned)b) << 16); }
__device__ __forceinline__ float bflo(unsigned w) { return __uint_as_float(w << 16); }
__device__ __forceinline__ float bfhi(unsigned w) { return __uint_as_float(w & 0xffff0000u); }
__device__ __forceinline__ float ldf(const float* p) { return *p; }
__device__ __forceinline__ float ldf(const bf16_t* p) { return bf2f(*p); }
__device__ __forceinline__ void stf(float* p, float v) { *p = v; }
__device__ __forceinline__ void stf(bf16_t* p, float v) { *p = (bf16_t)(cvt_pk_bf16(v, 0.f) & 0xffffu); }
__device__ __forceinline__ float sigmoidf_(float x) { return 1.f / (1.f + expf(-x)); }
__device__ __forceinline__ float siluf_(float x) { return x / (1.f + expf(-x)); }
__device__ __forceinline__ float wave_sum(float v) {
#pragma unroll
    for (int o = 32; o > 0; o >>= 1) v += __shfl_xor(v, o, 64);
    return v;
}
__device__ __forceinline__ float* hrow(KP p, int tok) {
    return tok < NL ? p->out + (size_t)tok * DM : (float*)(p->ws + OFF_HCTX) + (size_t)(tok - NL) * DM;
}
__device__ __forceinline__ const float* modrow(KP p, int l, int tok) {
    const int r = tok < NL ? (tok >> 12) : 8;
    return (const float*)(p->ws + OFF_MOD) + ((size_t)l * 9 + r) * 6144;
}
__device__ __forceinline__ int scan_tok(int b, int i, int dir) {
    return i < CTXL ? NL + b * CTXL + (dir ? CTXL - 1 - i : i) : b * SEQ + (dir ? SEQ - 1 - (i - CTXL) : (i - CTXL));
}

#define XB_TMO      128
#define XB_XCNT(j)  (256  + 64 * (j))
#define XB_XSUB(j)  (1280 + 64 * (j))
#define XB_XGEN(j)  (2304 + 64 * (j))
#define XB_TOP      3328
#define XB_TOPGEN   3392
#define XCD_BAR_WORDS 3456
#define XB_SPIN_CAP (1u << 24)
__device__ __forceinline__ unsigned xb_ld(unsigned* p)              { return __hip_atomic_load(p, __ATOMIC_RELAXED, __HIP_MEMORY_SCOPE_AGENT); }
__device__ __forceinline__ unsigned xb_add(unsigned* p, unsigned v) { return __hip_atomic_fetch_add(p, v, __ATOMIC_RELAXED, __HIP_MEMORY_SCOPE_AGENT); }
__device__ __forceinline__ unsigned xb_xcc_id() { return (unsigned)__builtin_amdgcn_s_getreg((3 << 11) | 20) & 0xFu; }
#define XB_SPIN(cond, bar) do { unsigned _sp = 0; while (cond) { __builtin_amdgcn_s_sleep(1); \
    if ((++_sp & 255u) == 0u) { if (xb_ld(&(bar)[XB_TMO])) break; if (_sp > XB_SPIN_CAP) { atomicAdd(&(bar)[XB_TMO], 1u); break; } } } } while (0)
struct XcdBarrier { unsigned* bar; unsigned x; volatile LAS unsigned* st; };
__device__ __forceinline__ XcdBarrier xcd_barrier_post(unsigned* bar, volatile LAS unsigned* st) {
    XcdBarrier b; b.bar = bar; b.x = xb_xcc_id(); b.st = st;
    if (threadIdx.x == 0) (void)xb_add(&bar[XB_XCNT(b.x)], 1u);
    return b;
}
__device__ __forceinline__ void xcd_barrier_complete(unsigned* bar, unsigned x, unsigned& nloc, unsigned& nx) {
    const unsigned G = gridDim.x * gridDim.y * gridDim.z;
    unsigned sum, cnt, mine, sp = 0u;
    for (;;) {
        sum = 0u; cnt = 0u; mine = 0u;
#pragma unroll
        for (unsigned j = 0; j < 16; ++j) { const unsigned c = xb_ld(&bar[XB_XCNT(j)]); sum += c; cnt += (c > 0u) ? 1u : 0u; mine = (j == x) ? c : mine; }
        if (sum == G) break;
        __builtin_amdgcn_s_sleep(1);
        if ((++sp & 255u) == 0u) { if (xb_ld(&bar[XB_TMO])) break; if (sp > XB_SPIN_CAP) { atomicAdd(&bar[XB_TMO], 1u); break; } }
    }
    nloc = mine > 0u ? mine : 1u; nx = cnt > 0u ? cnt : 1u;
}
__device__ __forceinline__ void xcd_barrier(const XcdBarrier& b) {
    asm volatile("s_waitcnt vmcnt(0)" ::: "memory");
    __syncthreads();
    if (threadIdx.x == 0) {
        unsigned* bar = b.bar;
        __builtin_amdgcn_s_waitcnt(0);
        unsigned nloc = b.st[0], nx = b.st[1];
        if (nloc == 0u) { xcd_barrier_complete(bar, b.x, nloc, nx); b.st[0] = nloc; b.st[1] = nx; }
        const unsigned old = xb_add(&bar[XB_XSUB(b.x)], 1u);
        const unsigned gen = old / nloc;
        if (old + 1u == (gen + 1u) * nloc) {
            __builtin_amdgcn_fence(__ATOMIC_RELEASE, "agent");
            asm volatile("s_waitcnt vmcnt(0)" ::: "memory");
            const unsigned og = xb_add(&bar[XB_TOP], 1u);
            const unsigned tg = og / nx;
            if (og + 1u == (tg + 1u) * nx) xb_add(&bar[XB_TOPGEN], 1u);
            else XB_SPIN(xb_ld(&bar[XB_TOPGEN]) == tg, bar);
            __builtin_amdgcn_fence(__ATOMIC_ACQUIRE, "agent");
            xb_add(&bar[XB_XGEN(b.x)], 1u);
            asm volatile("s_waitcnt vmcnt(0)" ::: "memory");
        } else {
            XB_SPIN(xb_ld(&bar[XB_XGEN(b.x)]) == gen, bar);
            __builtin_amdgcn_fence(__ATOMIC_ACQUIRE, "agent");
            asm volatile("s_waitcnt vmcnt(0)" ::: "memory");
        }
    }
    __syncthreads();
}

__device__ __forceinline__ void ph_prologue(KP p, int bid, int nb, float* sm) {
    const int tid = opaque_tid();
    {
        const float4* x4 = (const float4*)p->in[I_X]; float4* o4 = (float4*)p->out;
        #pragma unroll 1
        for (size_t i = (size_t)bid * 512 + tid; i < (size_t)NL * 256; i += (size_t)nb * 512) o4[i] = x4[i];
        const float4* c4 = (const float4*)p->in[I_CTX]; float4* h4 = (float4*)(p->ws + OFF_HCTX);
        #pragma unroll 1
        for (size_t i = (size_t)bid * 512 + tid; i < (size_t)NC * 256; i += (size_t)nb * 512) h4[i] = c4[i];
    }
    if (bid == 0) {
        bf16_t* z = (bf16_t*)(p->ws + OFF_U) + (size_t)ZROW * DM;
        for (int i = tid; i < DM; i += 512) z[i] = 0;
    }
    if (bid == 1 % nb) {
        float* lb = (float*)(p->ws + OFF_LB);
        const float* hl = p->in[I_HLB];
        for (int j = tid; j < 512; j += 512) {
            const float a = hl[j], b = hl[512 + j], mx = fmaxf(a, b);
            const float ea = expf(a - mx), eb = expf(b - mx);
            lb[j] = 0.f; lb[512 + j] = eb / (ea + eb);
        }
    }
    if (bid == 2 % nb) {
        float2* rt = (float2*)(p->ws + OFF_ROPE);
        for (int i = tid; i < 64 * 32; i += 512) { const float ang = (float)(i >> 5) * powf(10000.f, -(float)(2 * (i & 31)) / 64.f); rt[i] = make_float2(cosf(ang), sinf(ang)); }
    }
    {
        float* act = sm;
        bool filled = false;
        #pragma unroll 1
        for (int item = bid; item < 48; item += nb) {
            if (!filled) {
                for (int i = tid; i < 9 * 1024; i += 512) {
                    const int r = i >> 10, k = i & 1023;
                    const float v = r < 8 ? p->in[I_C][r * 1024 + k] : p->in[I_CCTX][k];
                    act[i] = siluf_(v);
                }
                __syncthreads(); filled = true;
            }
            const int l = item / 12, j = (item % 12) * 512 + tid;
            const float* w = p->in[I_ADAW] + (size_t)l * 1024 * 6144 + j;
            float acc[9];
#pragma unroll
            for (int r = 0; r < 9; ++r) acc[r] = 0.f;
            for (int k = 0; k < 1024; ++k) {
                const float wv = w[(size_t)k * 6144];
#pragma unroll
                for (int r = 0; r < 9; ++r) acc[r] += act[r * 1024 + k] * wv;
            }
            const float bv = p->in[I_ADAB][l * 6144 + j];
            float* mod = (float*)(p->ws + OFF_MOD);
#pragma unroll
            for (int r = 0; r < 9; ++r) mod[((size_t)l * 9 + r) * 6144 + j] = acc[r] + bv;
        }
    }
}


template <class Src>
__device__ __forceinline__ void cvt_tile(float* sm, Src src, int srcld, int k0, bf16_t* dst, int dstld, int n0) {
    const int tid = opaque_tid();
    const float* sp = src(n0 + (tid & 127));
#pragma unroll
    for (int j = 0; j < 16; ++j) { const int k = (tid >> 7) + 4 * j; sm[k * 129 + (tid & 127)] = sp[(size_t)(k0 + k) * srcld]; }
    __syncthreads();
    const int n = tid >> 2, kc = (tid & 3) * 16;
    unsigned w[8];
#pragma unroll
    for (int q = 0; q < 8; ++q) w[q] = cvt_pk_bf16(sm[(kc + 2 * q) * 129 + n], sm[(kc + 2 * q + 1) * 129 + n]);
    uint4* d4 = (uint4*)(dst + (size_t)(n0 + n) * dstld + k0 + kc);
    d4[0] = make_uint4(w[0], w[1], w[2], w[3]); d4[1] = make_uint4(w[4], w[5], w[6], w[7]);
    __syncthreads();
}

__device__ __forceinline__ void ph_convert(KP p, int l, int bid, int nb, float* sm) {
    const bool even = (l & 1) == 0;
    const int NP = even ? EVEN_LD : ODD_LD;
    const int t_in = 16 * (NP / 128), t_out = 16 * 8, t_13 = 65 * 16 * 4, t_2 = 65 * 4 * 8;
    const int total = t_in + t_out + t_13 + t_2;
    #pragma unroll 1
    for (int t = bid; t < total; t += nb) {
        if (t < t_in) {
            const int kt = t & 15, nt = t >> 4;
            const float* W = even ? p->in[I_EWIN] + (size_t)(l >> 1) * 1024 * EVEN_N : p->in[I_OWIN] + (size_t)(l >> 1) * 1024 * ODD_N;
            cvt_tile(sm, [&](int n) { return W + ((even && n >= 1536) ? n + 16 : n); }, even ? EVEN_N : ODD_N, kt * 64, (bf16_t*)(p->ws + OFF_WIN), 1024, nt * 128);
        } else if (t < t_in + t_out) {
            const int u = t - t_in, kt = u & 15, nt = u >> 4;
            const float* W = (even ? p->in[I_EWOUT] : p->in[I_OWOUT]) + (size_t)(l >> 1) * 1024 * 1024;
            cvt_tile(sm, [&](int n) { return W + n; }, 1024, kt * 64, (bf16_t*)(p->ws + OFF_WOUT), 1024, nt * 128);
        } else if (t < t_in + t_out + t_13) {
            const int u = t - t_in - t_out, e = u >> 6, kt = u & 15, nt = (u >> 4) & 3;
            const float* w1 = e < 64 ? p->in[I_W1] + ((size_t)l * 64 + e) * 1024 * 256 : p->in[I_SW1] + (size_t)l * 1024 * 256;
            const float* w3 = e < 64 ? p->in[I_W3] + ((size_t)l * 64 + e) * 1024 * 256 : p->in[I_SW3] + (size_t)l * 1024 * 256;
            cvt_tile(sm, [&](int n) { const int g = n >> 5, w = n & 31; return w < 16 ? w1 + 16 * g + w : w3 + 16 * g + w - 16; }, 256, kt * 64,
                     (bf16_t*)(p->ws + OFF_W13) + (size_t)e * 512 * 1024, 1024, nt * 128);
        } else {
            const int u = t - t_in - t_out - t_13, e = u >> 5, kt = u & 3, nt = (u >> 2) & 7;
            const float* w2 = e < 64 ? p->in[I_W2] + ((size_t)l * 64 + e) * 256 * 1024 : p->in[I_SW2] + (size_t)l * 256 * 1024;
            cvt_tile(sm, [&](int n) { return w2 + n; }, 1024, kt * 64, (bf16_t*)(p->ws + OFF_W2) + (size_t)e * 1024 * 256, 256, nt * 128);
        }
    }
}

namespace gp {
typedef short bf16x8 __attribute__((ext_vector_type(8)));
typedef float f32x4 __attribute__((ext_vector_type(4)));
typedef unsigned u32x4 __attribute__((ext_vector_type(4)));
typedef unsigned u32x2 __attribute__((ext_vector_type(2)));
constexpr int BM = 256, BK = 64, HALF = 128, HTB = HALF * BK * 2, STAGE_BYTES = 8 * HTB, NXCD = 8, WGM = 8;
__device__ __forceinline__ int lds_byte(int r, int c) { const int st = (r >> 4) * 2 + (c >> 5), rr = r & 15, cc = c & 31, ob = rr * 64 + cc * 2; return st * 1024 + (ob ^ (((ob >> 9) & 1) << 5)); }
__device__ __forceinline__ void stage_rc(int b, int& R, int& C) { const int st = b / 1024, sb = b % 1024, swz = sb ^ (((sb >> 9) & 1) << 5); R = (st >> 1) * 16 + swz / 64; C = (st & 1) * 32 + (swz % 64) / 2; }
__device__ __forceinline__ int perm32(int rho) { const int n = rho >> 4, i = rho & 15; return 8 * (i >> 2) + 4 * n + (i & 3); }

struct Unit { const char* A; const char* B; int r0, c0, aux; };

struct DenseSched {
    const char* A; const char* B; int nM, nN, nwg, G, c; size_t tstep;
    __device__ __forceinline__ void init(const void* A_, const void* B_, int M, int N, int K, int G_, int c_) { A = (const char*)A_; B = (const char*)B_; nM = M / BM; nN = N / BM; nwg = nM * nN; G = G_; c = c_; tstep = (size_t)BM * K * 2; }
    __device__ __forceinline__ bool next(int i, Unit& u) const {
        const long L = (long)i * G + c; if (L >= nwg) return false;
        int wgid = (int)L; { const int q = nwg / NXCD, r = nwg % NXCD, xcd = wgid % NXCD, off = wgid / NXCD; wgid = (xcd < r ? xcd * (q + 1) : r * (q + 1) + (xcd - r) * q) + off; }
        const int nig = WGM * nN, gid = wgid / nig, fm = gid * WGM, gsz = (nM - fm) < WGM ? (nM - fm) : WGM;
        const int pm = fm + ((wgid % nig) % gsz), pn = (wgid % nig) / gsz;
        u.A = A + (size_t)pm * tstep; u.B = B + (size_t)pn * tstep; u.r0 = pm * BM; u.c0 = pn * BM; u.aux = 0; return true;
    }
    __device__ __forceinline__ void lane_off(const Unit&, int, int, int, int, unsigned (&)[2][2]) const {}
};

template <bool GATHER, bool PERM, class Sched, class Epi>
__device__ __forceinline__ void gemm_phase(LAS unsigned char* lds, const int K_, const Sched& S, const Epi& E) {
    int K = K_; asm volatile("" : "+s"(K));
    const int tid = opaque_tid(), wid = __builtin_amdgcn_readfirstlane(tid >> 6), lane = tid & 63, wr = wid >> 2, wc = wid & 3, fr = lane & 15, fq = lane >> 4;
    const int nt = K / BK;
    unsigned voffA[2], voffB[2]; int sR[2], sC[2];
#pragma unroll
    for (int i = 0; i < 2; ++i) { int R, C; stage_rc(tid * 16 + i * 8192, R, C); const int Rb = PERM ? ((R & ~31) + perm32(R & 31)) : R;
        voffA[i] = (unsigned)(R * K + C) * 2u; voffB[i] = (unsigned)(Rb * K + C) * 2u; sR[i] = R; sC[i] = C; }
    const size_t kstep = (size_t)(BK * 2);
    const size_t hstep = (size_t)HALF * K * 2;
    const unsigned ldsw = (unsigned)wid * 1024u;
    const int aoff = lds_byte(wr * 64 + fr, fq * 8), boff = lds_byte(wc * 32 + fr, fq * 8);
    unsigned cvo[2][2] = {{0u, 0u}, {0u, 0u}}, nvo[2][2] = {{0u, 0u}, {0u, 0u}};
#define GP_SA(b, h) (((b) * 2 + (h)) * HTB)
#define GP_SB(b, h) ((4 + (b) * 2 + (h)) * HTB)
#define GP_GLDS(gp_, lp_) __builtin_amdgcn_global_load_lds((const unsigned*)(gp_), (LAS unsigned*)(lp_), 16, 0, 0)
#define GP_STAGE_B(bufoff, gbase, h) do { const char* _g = (gbase) + (size_t)(h) * hstep; \
        GP_GLDS(_g + voffB[0], lds + (bufoff) + ldsw); GP_GLDS(_g + voffB[1], lds + (bufoff) + ldsw + 8192); } while (0)
#define GP_STAGE_A(bufoff, gbase, h, usenext) do { \
        if (GATHER) { const unsigned _o0 = (usenext) ? nvo[h][0] : cvo[h][0], _o1 = (usenext) ? nvo[h][1] : cvo[h][1]; \
            GP_GLDS((gbase) + _o0, lds + (bufoff) + ldsw); GP_GLDS((gbase) + _o1, lds + (bufoff) + ldsw + 8192); } \
        else { const char* _g = (gbase) + (size_t)(h) * hstep; GP_GLDS(_g + voffA[0], lds + (bufoff) + ldsw); GP_GLDS(_g + voffA[1], lds + (bufoff) + ldsw + 8192); } } while (0)
#define GP_LDA(dst, b, h) do { _Pragma("unroll") for (int m = 0; m < 4; ++m) _Pragma("unroll") for (int k = 0; k < 2; ++k) dst[m][k] = *(const LAS bf16x8*)(lds + GP_SA(b, h) + aoff + m * 2048 + k * 1024); } while (0)
#define GP_LDB(dst, b, h) do { _Pragma("unroll") for (int n = 0; n < 2; ++n) _Pragma("unroll") for (int k = 0; k < 2; ++k) dst[n][k] = *(const LAS bf16x8*)(lds + GP_SB(b, h) + boff + n * 2048 + k * 1024); } while (0)
#define GP_MMA(ai, bj, At, Bt) do { __builtin_amdgcn_s_setprio(1); _Pragma("unroll") for (int m = 0; m < 4; ++m) _Pragma("unroll") for (int n = 0; n < 2; ++n) _Pragma("unroll") for (int k = 0; k < 2; ++k) \
        acc[ai][bj][m][n] = __builtin_amdgcn_mfma_f32_16x16x32_bf16(Bt[n][k], At[m][k], acc[ai][bj][m][n], 0, 0, 0); __builtin_amdgcn_s_setprio(0); } while (0)
#define GP_WAIT_V(n) asm volatile("s_waitcnt vmcnt(" #n ")" ::: "memory")
#define GP_WAIT_L(n) asm volatile("s_waitcnt lgkmcnt(" #n ")" ::: "memory")
#define GP_BAR __builtin_amdgcn_s_barrier()
#define GP_SCHED __builtin_amdgcn_sched_barrier(0)
    Unit cur, nxt; int ui = 0;
    if (!S.next(0, cur)) return;
    f32x4 acc[2][2][4][2];
#pragma unroll
    for (int a = 0; a < 2; ++a)
#pragma unroll
        for (int b = 0; b < 2; ++b)
#pragma unroll
            for (int m = 0; m < 4; ++m)
#pragma unroll
                for (int n = 0; n < 2; ++n) acc[a][b][m][n] = (f32x4){0.f, 0.f, 0.f, 0.f};
    bf16x8 At[4][2], B0[2][2], B1[2][2];
    if (GATHER) S.lane_off(cur, sR[0], sR[1], sC[0], sC[1], cvo);
    const char* cA = cur.A; const char* cB = cur.B;
    GP_STAGE_B(GP_SB(0, 0), cB, 0); GP_STAGE_A(GP_SA(0, 0), cA, 0, false); GP_STAGE_B(GP_SB(0, 1), cB, 1); GP_STAGE_A(GP_SA(0, 1), cA, 1, false);
    if (wr == 1) GP_BAR;
    GP_WAIT_V(4); GP_BAR;
    GP_STAGE_B(GP_SB(1, 0), cB + kstep, 0); GP_STAGE_A(GP_SA(1, 0), cA + kstep, 0, false); GP_STAGE_B(GP_SB(1, 1), cB + kstep, 1);
    GP_WAIT_V(6); GP_BAR;
    for (;;) {
        const bool has_next = S.next(ui + 1, nxt);
        if (GATHER && has_next) S.lane_off(nxt, sR[0], sR[1], sC[0], sC[1], nvo);
        const char* nA = has_next ? nxt.A : cA; const char* nB = has_next ? nxt.B : cB;
        for (int t = 0; t < nt; t += 2) {
            const bool last = (t == nt - 2);
            const bool un = last && has_next;
            const char* a1 = cA + (size_t)(t + 1) * kstep;
            const char* a2 = last ? nA : cA + (size_t)(t + 2) * kstep; const char* b2 = last ? nB : cB + (size_t)(t + 2) * kstep;
            const char* a3 = a2 + kstep; const char* b3 = b2 + kstep;
            GP_LDB(B0, 0, 0); GP_SCHED; GP_LDA(At, 0, 0); GP_STAGE_A(GP_SA(1, 1), a1, 1, false);
            GP_WAIT_L(8); GP_BAR; GP_WAIT_L(0); GP_MMA(0, 0, At, B0); GP_BAR; GP_SCHED;
            GP_LDB(B1, 0, 1); GP_STAGE_B(GP_SB(0, 0), b2, 0);
            GP_BAR; GP_WAIT_L(0); GP_MMA(0, 1, At, B1); GP_BAR;
            GP_LDA(At, 0, 1); GP_STAGE_A(GP_SA(0, 0), a2, 0, un);
            GP_BAR; GP_WAIT_L(0); GP_MMA(1, 0, At, B0); GP_BAR; GP_SCHED;
            GP_STAGE_B(GP_SB(0, 1), b2, 1);
            GP_WAIT_V(6); GP_BAR; GP_MMA(1, 1, At, B1); GP_BAR;
            GP_LDB(B0, 1, 0); GP_SCHED; GP_LDA(At, 1, 0); GP_STAGE_A(GP_SA(0, 1), a2, 1, un);
            GP_WAIT_L(8); GP_BAR; GP_WAIT_L(0); GP_MMA(0, 0, At, B0); GP_BAR; GP_SCHED;
            GP_LDB(B1, 1, 1); GP_STAGE_B(GP_SB(1, 0), b3, 0);
            GP_BAR; GP_WAIT_L(0); GP_MMA(0, 1, At, B1); GP_BAR;
            GP_LDA(At, 1, 1); GP_STAGE_A(GP_SA(1, 0), a3, 0, un);
            GP_BAR; GP_WAIT_L(0); GP_MMA(1, 0, At, B0); GP_BAR; GP_SCHED;
            GP_STAGE_B(GP_SB(1, 1), b3, 1);
            GP_WAIT_V(6); GP_BAR; GP_MMA(1, 1, At, B1); GP_BAR;
        }
        E(acc, cur, wr, wc, fr, fq);
        if (!has_next) break;
#pragma unroll
        for (int a = 0; a < 2; ++a)
#pragma unroll
            for (int b = 0; b < 2; ++b)
#pragma unroll
                for (int m = 0; m < 4; ++m)
#pragma unroll
                    for (int n = 0; n < 2; ++n) acc[a][b][m][n] = (f32x4){0.f, 0.f, 0.f, 0.f};
        cur = nxt; cA = nA; cB = nB; ++ui;
        if (GATHER) { cvo[0][0] = nvo[0][0]; cvo[0][1] = nvo[0][1]; cvo[1][0] = nvo[1][0]; cvo[1][1] = nvo[1][1]; }
    }
    GP_WAIT_V(0);
    if (wr == 0) GP_BAR;
    GP_BAR;
#undef GP_SA
#undef GP_SB
#undef GP_GLDS
#undef GP_STAGE_A
#undef GP_STAGE_B
#undef GP_LDA
#undef GP_LDB
#undef GP_MMA
#undef GP_WAIT_V
#undef GP_WAIT_L
#undef GP_BAR
#undef GP_SCHED
}

struct EpiF32 {
    float* C; int ldc;
    __device__ __forceinline__ void operator()(const f32x4 (&acc)[2][2][4][2], const Unit& u, int wr, int wc, int fr, int fq) const {
        const int row0 = u.r0 + wr * 64 + fr, col0 = u.c0 + wc * 32 + 4 * fq;
#pragma unroll
        for (int ai = 0; ai < 2; ++ai)
#pragma unroll
            for (int m = 0; m < 4; ++m) { float* rowp = C + (size_t)(row0 + ai * HALF + m * 16) * ldc + col0;
#pragma unroll
                for (int bj = 0; bj < 2; ++bj)
#pragma unroll
                    for (int n = 0; n < 2; ++n) *(f32x4*)(rowp + bj * HALF + n * 16) = acc[ai][bj][m][n];
                __builtin_amdgcn_sched_barrier(0); }
    }
};
struct EpiBf16 {
    bf16_t* O; int ldc;
    __device__ __forceinline__ void operator()(const f32x4 (&acc)[2][2][4][2], const Unit& u, int wr, int wc, int fr, int fq) const {
        const int row0 = u.r0 + wr * 64 + fr, col0 = u.c0 + wc * 32 + 8 * fq;
#pragma unroll
        for (int ai = 0; ai < 2; ++ai)
#pragma unroll
            for (int m = 0; m < 4; ++m) { bf16_t* rowp = O + (size_t)(row0 + ai * HALF + m * 16) * ldc + col0;
#pragma unroll
                for (int bj = 0; bj < 2; ++bj) { const f32x4 v0 = acc[ai][bj][m][0], v1 = acc[ai][bj][m][1];
                    u32x4 w; w.x = cvt_pk_bf16(v0[0], v0[1]); w.y = cvt_pk_bf16(v0[2], v0[3]); w.z = cvt_pk_bf16(v1[0], v1[1]); w.w = cvt_pk_bf16(v1[2], v1[3]);
                    *(u32x4*)(rowp + bj * HALF) = w; }
                __builtin_amdgcn_sched_barrier(0); }
    }
};
}

__device__ __forceinline__ void ph_modin(KP p, int l, int bid, int nb) {
    const int tid = opaque_tid(), lane = tid & 63, wv = tid >> 6;
    const bool even = (l & 1) == 0;
    bf16_t* U = (bf16_t*)(p->ws + OFF_U);
    float* G = (float*)(p->ws + OFF_G);
    const float* wg = p->in[I_EWIN] + (size_t)(l >> 1) * 1024 * EVEN_N + 1536;
    #pragma unroll 1
    for (int tok = bid * 8 + wv; tok < NT; tok += nb * 8) {
        const float* h = hrow(p, tok);
        const float* m = modrow(p, l, tok);
        float ga[16];
#pragma unroll
        for (int j = 0; j < 16; ++j) ga[j] = 0.f;
#pragma unroll
        for (int c = 0; c < 4; ++c) {
            const int d = 4 * (lane + 64 * c);
            const float4 hv = *(const float4*)(h + d), sh = *(const float4*)(m + d), sc = *(const float4*)(m + 1024 + d);
            const float u0 = hv.x * (1.f + sc.x) + sh.x, u1 = hv.y * (1.f + sc.y) + sh.y, u2 = hv.z * (1.f + sc.z) + sh.z, u3 = hv.w * (1.f + sc.w) + sh.w;
            *(uint2*)(U + (size_t)tok * DM + d) = make_uint2(cvt_pk_bf16(u0, u1), cvt_pk_bf16(u2, u3));
            if (even) {
                const float uu[4] = {u0, u1, u2, u3};
#pragma unroll
                for (int q = 0; q < 4; ++q) {
                    const float4* wr = (const float4*)(wg + (size_t)(d + q) * EVEN_N);
#pragma unroll
                    for (int j4 = 0; j4 < 4; ++j4) { const float4 w = wr[j4]; ga[4 * j4] += uu[q] * w.x; ga[4 * j4 + 1] += uu[q] * w.y; ga[4 * j4 + 2] += uu[q] * w.z; ga[4 * j4 + 3] += uu[q] * w.w; }
                }
            }
        }
        if (even) {
            float mine = 0.f;
#pragma unroll
            for (int j = 0; j < 16; ++j) { const float s = wave_sum(ga[j]); if (lane == j) mine = s; }
            if (lane < 16) G[(size_t)tok * 16 + lane] = mine;
        }
    }
}

__device__ __forceinline__ void ph_gemm_in(KP p, int l, int bid, int nb, LAS unsigned char* lds) {
    const int N = ((l & 1) == 0) ? EVEN_LD : ODD_LD;
    gp::DenseSched S; S.init(p->ws + OFF_U, p->ws + OFF_WIN, NT, N, 1024, nb, bid);
    gp::EpiBf16 E{(bf16_t*)(p->ws + OFF_BIG), N};
    gp::gemm_phase<false, true>(lds, 1024, S, E);
}
__device__ __forceinline__ void ph_gemm_out(KP p, int l, int bid, int nb, LAS unsigned char* lds) {
    gp::DenseSched S; S.init(p->ws + OFF_U, p->ws + OFF_WOUT, NT, 1024, 1024, nb, bid);
    gp::EpiF32 E{(float*)(p->ws + OFF_BIG), 1024};
    gp::gemm_phase<false, false>(lds, 1024, S, E);
}


namespace sc {
typedef short bf16x8 __attribute__((ext_vector_type(8)));
typedef short bf16x4 __attribute__((ext_vector_type(4)));
typedef float f32x4 __attribute__((ext_vector_type(4)));
#define SC_MFMA(a, b, c) __builtin_amdgcn_mfma_f32_16x16x32_bf16(a, b, c, 0, 0, 0)
__device__ __forceinline__ bf16x8 rd_row(unsigned img, int row, int stride, int k0) { return *(const LAS bf16x8*)(size_t)(img + (unsigned)(row * stride + k0 * 2)); }
__device__ __forceinline__ bf16x8 rd_tr(unsigned img, int k0, int n0, int stride, int lane) {
    const int g = lane >> 4, i = lane & 15;
    const unsigned a0 = img + (unsigned)((k0 + 8 * g + (i >> 2)) * stride + (n0 + 4 * (i & 3)) * 2), a1 = a0 + 4u * (unsigned)stride;
    bf16x4 lo, hi;
    asm volatile("ds_read_b64_tr_b16 %0, %2\n\tds_read_b64_tr_b16 %1, %3\n\ts_waitcnt lgkmcnt(0)" : "=&v"(lo), "=&v"(hi) : "v"(a0), "v"(a1) : "memory");
    return (bf16x8){lo[0], lo[1], lo[2], lo[3], hi[0], hi[1], hi[2], hi[3]};
}
typedef unsigned u32x2_ __attribute__((ext_vector_type(2)));
typedef unsigned u32x4_ __attribute__((ext_vector_type(4)));
__device__ __forceinline__ void st8(unsigned addr, uint2 v) { *(LAS u32x2_*)(size_t)addr = (u32x2_){v.x, v.y}; }
__device__ __forceinline__ void st16(unsigned addr, uint4 v) { *(LAS u32x4_*)(size_t)addr = (u32x4_){v.x, v.y, v.z, v.w}; }
__device__ __forceinline__ float scan_add64(float v, int lane) {
#pragma unroll
    for (int o = 1; o < 64; o <<= 1) { const float t = __shfl_up(v, o, 64); if (lane >= o) v += t; }
    return v;
}
__device__ __forceinline__ float scan_max64(float v, int lane) {
#pragma unroll
    for (int o = 1; o < 64; o <<= 1) { const float t = __shfl_up(v, o, 64); if (lane >= o) v = fmaxf(v, t); }
    return v;
}

template <int MODE>
__device__ __forceinline__ void scan_item(KP p, int l, int b, int h, int dir, int vs) {
    constexpr int CS = (MODE == 1) ? 32 : 64, DK = (MODE == 0) ? 64 : 128, EXT = (MODE == 0) ? 1 : 0;
    constexpr int QS = (DK + 8) * 2, VS = (64 + 16 * EXT + 8) * 2, SS = (CS + 8) * 2, NVR = 64 + 16 * EXT;
    constexpr int NCH = (CTXL + SEQ) / CS;
    constexpr int LD = (MODE == 2) ? ODD_LD : EVEN_LD;
    constexpr unsigned O_QA = 0, O_KA = O_QA + CS * QS, O_QB = O_KA + CS * QS, O_KW = O_QB + (MODE == 1 ? CS * QS : 0), O_V = O_KW + CS * QS,
                       O_SSC = O_V + CS * VS, O_ST = O_SSC + CS * SS, O_DKV = O_ST + 2 * NVR * QS, O_END = O_DKV + 512;
    static_assert(O_END <= 131072, "scan LDS");
    const int tid = opaque_tid(), lane = tid & 63, wv = __builtin_amdgcn_readfirstlane(tid >> 6), r16 = lane & 15, q4 = lane >> 4;
    const unsigned L0 = (unsigned)(size_t)smraw_base();
    const bf16_t* P = (const bf16_t*)(p->ws + OFF_BIG);
    bf16_t* HXo = (bf16_t*)(p->ws + OFF_AUX) + (size_t)dir * NT * 1024;
    const int e2 = l >> 1;
    const int cQ = (MODE == 0) ? E_MQ + h * 64 : (MODE == 1) ? E_HQ + h * 128 : 1536 + h * 128;
    const int cK = (MODE == 0) ? E_MK + h * 64 : (MODE == 1) ? (dir ? E_HFB : E_HFF) + h * 128 : 2048 + h * 128;
    const int cV = (MODE == 0) ? E_MV + h * 128 + vs * 64 : (MODE == 1) ? E_HI + h * 128 + vs * 64 : 2560 + h * 128 + vs * 64;
    const int cO = (MODE == 0) ? h * 128 + vs * 64 : 512 + h * 128 + vs * 64;
    const int lt = (MODE == 1) ? (tid & 31) : (tid >> 3);
    const int lj = (MODE == 0) ? (tid & 7) : (MODE == 1) ? (tid >> 5) : ((tid >> 2) & 1) * 8 + (tid & 3);
    const int vt_ = tid >> 3, vj = tid & 7;
    float lbv[8]; float gbi = 0.f, gbf = 0.f, lg = 0.f;
    if (MODE == 1) {
        const float* lbp = (const float*)(p->ws + OFF_LB) + e2 * 512 + h * 128 + lj * 8;
#pragma unroll
        for (int i = 0; i < 8; ++i) lbv[i] = lbp[i];
    } else {
#pragma unroll
        for (int i = 0; i < 8; ++i) lbv[i] = 0.f;
    }
    if (MODE == 0) { const float* gb = p->in[I_MGB] + e2 * 16; gbi = gb[(dir ? 2 : 0) * 4 + h]; gbf = gb[(dir ? 3 : 1) * 4 + h]; }
    if (MODE == 2) lg = p->in[I_RLD][e2 * 8 + dir * 4 + h];
    const float* G = (const float*)(p->ws + OFF_G);
    const float* ropet = (const float*)(p->ws + OFF_ROPE);
    unsigned oz = 0u; asm volatile("" : "+v"(oz));
    for (unsigned o = tid * 16; o < 2u * NVR * QS; o += 512 * 16) st16(L0 + O_ST + o, make_uint4(oz, oz, oz, oz));
    if (EXT) { if (tid < CS) { st16(L0 + O_V + tid * VS + 128, make_uint4(0x3f80u | oz, oz, oz, oz)); st16(L0 + O_V + tid * VS + 144, make_uint4(oz, oz, oz, oz)); } }
    f32x4 sacc[4];
#pragma unroll
    for (int i = 0; i < 4; ++i) sacc[i] = (f32x4){0.f, 0.f, 0.f, 0.f};
    float m_in = -1e30f;
    uint4 rq0, rq1, rk0, rk1, rv; float rg0 = 0.f, rg1 = 0.f;
    rq1 = make_uint4(0u, 0u, 0u, 0u); rk1 = rq1;
    auto load_chunk = [&](int c) {
        const int i0 = c * CS;
        const int tq = scan_tok(b, i0 + lt, dir);
        const bf16_t* pr = P + (size_t)tq * LD;
        rq0 = *(const uint4*)(pr + cQ + lj * 8); rk0 = *(const uint4*)(pr + cK + lj * 8);
        if (MODE == 2) { rq1 = *(const uint4*)(pr + cQ + lj * 8 + 32); rk1 = *(const uint4*)(pr + cK + lj * 8 + 32); }
        if (MODE != 1 || tid < 256) { const int tv = scan_tok(b, i0 + vt_, dir); rv = *(const uint4*)(P + (size_t)tv * LD + cV + vj * 8); }
        if (MODE == 0) { const int tg = scan_tok(b, i0 + lane, dir); rg0 = G[(size_t)tg * 16 + (dir ? 8 : 0) + h]; rg1 = G[(size_t)tg * 16 + (dir ? 12 : 4) + h]; }
    };
    load_chunk(0);
#pragma unroll 1
    for (int c = 0; c < NCH; ++c) {
        const unsigned ST_R = L0 + O_ST + (unsigned)(c & 1) * NVR * QS, ST_W = L0 + O_ST + (unsigned)((c + 1) & 1) * NVR * QS;
        float sp = 1.f;
        float v_u = 0.f, v_M = 0.f, v_e = 1.f, v_low = 0.f, v_w = 1.f;
        if (MODE == 0) {
            const float ig = rg0 + gbi, fg = rg1 + gbf;
            const float lf = fminf(fg, 0.f) - log1pf(expf(-fabsf(fg)));
            const float bb = scan_add64(lf, lane);
            const float g = __shfl(bb, 63, 64);
            v_u = ig - bb;
            const float cu = scan_max64(v_u, lane);
            v_M = fmaxf(m_in, cu);
            const float m_new = fmaxf(g + m_in, g + __shfl(cu, 63, 64));
            sp = expf(g + m_in - m_new);
            v_w = expf(g + v_u - m_new);
            v_e = expf(m_in - v_M);
            v_low = expf(-(bb + v_M));
            m_in = m_new;
            st16(L0 + O_QA + lt * QS + lj * 16, rq0);
            st16(L0 + O_KA + lt * QS + lj * 16, rk0);
            const float wr = __shfl(v_w, lt, 64);
            uint4 kw; kw.x = cvt_pk_bf16(bflo(rk0.x) * wr, bfhi(rk0.x) * wr); kw.y = cvt_pk_bf16(bflo(rk0.y) * wr, bfhi(rk0.y) * wr);
            kw.z = cvt_pk_bf16(bflo(rk0.z) * wr, bfhi(rk0.z) * wr); kw.w = cvt_pk_bf16(bflo(rk0.w) * wr, bfhi(rk0.w) * wr);
            st16(L0 + O_KW + lt * QS + lj * 16, kw);
            st16(L0 + O_V + vt_ * VS + vj * 16, rv);
        } else if (MODE == 2) {
            sp = expf(64.f * lg);
            const bool lat = c >= CTXL / CS;
            float q[16], k[16];
            const unsigned qa[8] = {rq0.x, rq0.y, rq0.z, rq0.w, rq1.x, rq1.y, rq1.z, rq1.w}, ka[8] = {rk0.x, rk0.y, rk0.z, rk0.w, rk1.x, rk1.y, rk1.z, rk1.w};
#pragma unroll
            for (int i = 0; i < 8; ++i) { q[2 * i] = bflo(qa[i]); q[2 * i + 1] = bfhi(qa[i]); k[2 * i] = bflo(ka[i]); k[2 * i + 1] = bfhi(ka[i]); }
            if (lat) {
                const int tq = scan_tok(b, c * CS + lt, dir), tt = tq & (SEQ - 1);
                const int pos = ((tid >> 2) & 1) ? (tt & 63) : (tt >> 6);
                const float2* rt = (const float2*)ropet + pos * 32 + (tid & 3) * 8;
#pragma unroll
                for (int i = 0; i < 8; ++i) {
                    const float2 cs2 = rt[i];
                    const float q1 = q[i], q2 = q[8 + i], k1 = k[i], k2 = k[8 + i];
                    q[i] = q1 * cs2.x - q2 * cs2.y; q[8 + i] = q1 * cs2.y + q2 * cs2.x;
                    k[i] = k1 * cs2.x - k2 * cs2.y; k[8 + i] = k1 * cs2.y + k2 * cs2.x;
                }
            }
            const float wr = 0.08838834764831845f * expf((float)(63 - lt) * lg);
            uint4 o0, o1, w0, w1, x0, x1;
            o0.x = cvt_pk_bf16(q[0], q[1]); o0.y = cvt_pk_bf16(q[2], q[3]); o0.z = cvt_pk_bf16(q[4], q[5]); o0.w = cvt_pk_bf16(q[6], q[7]);
            o1.x = cvt_pk_bf16(q[8], q[9]); o1.y = cvt_pk_bf16(q[10], q[11]); o1.z = cvt_pk_bf16(q[12], q[13]); o1.w = cvt_pk_bf16(q[14], q[15]);
            w0.x = cvt_pk_bf16(k[0], k[1]); w0.y = cvt_pk_bf16(k[2], k[3]); w0.z = cvt_pk_bf16(k[4], k[5]); w0.w = cvt_pk_bf16(k[6], k[7]);
            w1.x = cvt_pk_bf16(k[8], k[9]); w1.y = cvt_pk_bf16(k[10], k[11]); w1.z = cvt_pk_bf16(k[12], k[13]); w1.w = cvt_pk_bf16(k[14], k[15]);
            x0.x = cvt_pk_bf16(k[0] * wr, k[1] * wr); x0.y = cvt_pk_bf16(k[2] * wr, k[3] * wr); x0.z = cvt_pk_bf16(k[4] * wr, k[5] * wr); x0.w = cvt_pk_bf16(k[6] * wr, k[7] * wr);
            x1.x = cvt_pk_bf16(k[8] * wr, k[9] * wr); x1.y = cvt_pk_bf16(k[10] * wr, k[11] * wr); x1.z = cvt_pk_bf16(k[12] * wr, k[13] * wr); x1.w = cvt_pk_bf16(k[14] * wr, k[15] * wr);
            st16(L0 + O_QA + lt * QS + lj * 16, o0); st16(L0 + O_QA + lt * QS + lj * 16 + 64, o1);
            st16(L0 + O_KA + lt * QS + lj * 16, w0); st16(L0 + O_KA + lt * QS + lj * 16 + 64, w1);
            st16(L0 + O_KW + lt * QS + lj * 16, x0); st16(L0 + O_KW + lt * QS + lj * 16 + 64, x1);
            st16(L0 + O_V + vt_ * VS + vj * 16, rv);
        } else {
            const unsigned qa[4] = {rq0.x, rq0.y, rq0.z, rq0.w}, fa[4] = {rk0.x, rk0.y, rk0.z, rk0.w};
            float qv[8], kk[8], A[8];
#pragma unroll
            for (int i = 0; i < 8; ++i) {
                const float qr = (i & 1) ? bfhi(qa[i >> 1]) : bflo(qa[i >> 1]), fr = (i & 1) ? bfhi(fa[i >> 1]) : bflo(fa[i >> 1]);
                const float f = lbv[i] + (1.f - lbv[i]) * sigmoidf_(fr);
                qv[i] = siluf_(qr); kk[i] = 1.f - f; A[i] = logf(f);
            }
#pragma unroll
            for (int o = 1; o < 32; o <<= 1)
#pragma unroll
                for (int i = 0; i < 8; ++i) { const float t = __shfl_up(A[i], o, 32); if (lt >= o) A[i] += t; }
            float qa_[8], qb_[8], ka_[8], kw_[8];
#pragma unroll
            for (int i = 0; i < 8; ++i) {
                const float am = __shfl(A[i], 15, 32), ae = __shfl(A[i], 31, 32);
                qa_[i] = qv[i] * expf(A[i] - am); qb_[i] = qv[i] * expf(A[i]); ka_[i] = kk[i] * expf(am - A[i]); kw_[i] = kk[i] * expf(ae - A[i]);
                if (lt == 31) *(LAS float*)(size_t)(L0 + O_DKV + (lj * 8 + i) * 4) = expf(ae);
            }
            uint4 w;
            w.x = cvt_pk_bf16(qa_[0], qa_[1]); w.y = cvt_pk_bf16(qa_[2], qa_[3]); w.z = cvt_pk_bf16(qa_[4], qa_[5]); w.w = cvt_pk_bf16(qa_[6], qa_[7]); st16(L0 + O_QA + lt * QS + lj * 16, w);
            w.x = cvt_pk_bf16(qb_[0], qb_[1]); w.y = cvt_pk_bf16(qb_[2], qb_[3]); w.z = cvt_pk_bf16(qb_[4], qb_[5]); w.w = cvt_pk_bf16(qb_[6], qb_[7]); st16(L0 + O_QB + lt * QS + lj * 16, w);
            w.x = cvt_pk_bf16(ka_[0], ka_[1]); w.y = cvt_pk_bf16(ka_[2], ka_[3]); w.z = cvt_pk_bf16(ka_[4], ka_[5]); w.w = cvt_pk_bf16(ka_[6], ka_[7]); st16(L0 + O_KA + lt * QS + lj * 16, w);
            w.x = cvt_pk_bf16(kw_[0], kw_[1]); w.y = cvt_pk_bf16(kw_[2], kw_[3]); w.z = cvt_pk_bf16(kw_[4], kw_[5]); w.w = cvt_pk_bf16(kw_[6], kw_[7]); st16(L0 + O_KW + lt * QS + lj * 16, w);
            if (tid < 256) st16(L0 + O_V + vt_ * VS + vj * 16, rv);
        }
        __syncthreads();
        if (c + 1 < NCH) load_chunk(c + 1);
        {
            constexpr int NT1 = CS / 16;
            const bool act = (MODE == 1) ? (wv < 4) : true;
            const int tb = (MODE == 1) ? (wv & 1) : (wv & 3);
#pragma unroll
            for (int u2 = 0; u2 < ((MODE == 1) ? 1 : 2); ++u2) {
                const int sb = (MODE == 1) ? (wv >> 1) : 2 * (wv >> 2) + u2;
                if (act) {
                    f32x4 d = (f32x4){0.f, 0.f, 0.f, 0.f};
                    if (sb <= tb) {
#pragma unroll
                        for (int kk2 = 0; kk2 < DK / 32; ++kk2)
                            d = SC_MFMA(rd_row(L0 + O_KA, sb * 16 + r16, QS, kk2 * 32 + q4 * 8), rd_row(L0 + O_QA, tb * 16 + r16, QS, kk2 * 32 + q4 * 8), d);
                        const int t = tb * 16 + r16, s0 = sb * 16 + q4 * 4;
                        if (MODE == 0) {
                            const float Mt = __shfl(v_M, t, 64);
#pragma unroll
                            for (int jj = 0; jj < 4; ++jj) { const float us = __shfl(v_u, s0 + jj, 64); d[jj] = (s0 + jj <= t) ? d[jj] * 0.125f * expf(us - Mt) : 0.f; }
                        } else if (MODE == 2) {
#pragma unroll
                            for (int jj = 0; jj < 4; ++jj) d[jj] = (s0 + jj <= t) ? d[jj] * 0.08838834764831845f * expf((float)(t - s0 - jj) * lg) : 0.f;
                        } else {
#pragma unroll
                            for (int jj = 0; jj < 4; ++jj) d[jj] = (s0 + jj <= t) ? d[jj] : 0.f;
                        }
                    }
                    st8(L0 + O_SSC + (tb * 16 + r16) * SS + (sb * 16 + q4 * 4) * 2, make_uint2(cvt_pk_bf16(d[0], d[1]), cvt_pk_bf16(d[2], d[3])));
                }
            }
            (void)NT1;
        }
        __syncthreads();
        {
            const int tb = (MODE == 1) ? (wv & 1) : (wv & 3);
            const int t = tb * 16 + r16;
            const int tok = scan_tok(b, c * CS + t, dir);
            constexpr int NV = (MODE == 1) ? 1 : 2;
            f32x4 oi[NV + EXT], oo[NV + EXT];
#pragma unroll
            for (int u2 = 0; u2 < NV + EXT; ++u2) {
                const int vt = (u2 == NV) ? 4 : ((MODE == 1) ? (wv >> 1) : 2 * (wv >> 2) + u2);
                f32x4 a1 = (f32x4){0.f, 0.f, 0.f, 0.f}, a2 = a1;
#pragma unroll
                for (int sb2 = 0; sb2 < CS / 32; ++sb2)
                    a1 = SC_MFMA(rd_tr(L0 + O_V, sb2 * 32, vt * 16, VS, lane), rd_row(L0 + O_SSC, t, SS, sb2 * 32 + q4 * 8), a1);
#pragma unroll
                for (int kk2 = 0; kk2 < DK / 32; ++kk2)
                    a2 = SC_MFMA(rd_row(ST_R, vt * 16 + r16, QS, kk2 * 32 + q4 * 8), rd_row(L0 + ((MODE == 1) ? O_QB : O_QA), t, QS, kk2 * 32 + q4 * 8), a2);
                oi[u2] = a1; oo[u2] = a2;
            }
            float den = 1.f, ei = 1.f;
            if (MODE == 0) {
                ei = 0.125f * __shfl(v_e, t, 64);
                const float dsum = oi[NV][0] + ei * oo[NV][0];
                const float dd = __shfl(dsum, r16, 64);
                den = 1.f / fmaxf(fabsf(dd), __shfl(v_low, t, 64));
            } else if (MODE == 2) {
                ei = expf((float)(t + 1) * lg);
            }
#pragma unroll
            for (int u2 = 0; u2 < NV; ++u2) {
                const int vt = (MODE == 1) ? (wv >> 1) : 2 * (wv >> 2) + u2;
                float o[4];
#pragma unroll
                for (int jj = 0; jj < 4; ++jj) o[jj] = (oi[u2][jj] + ei * oo[u2][jj]) * den;
                *(uint2*)(HXo + (size_t)tok * 1024 + cO + vt * 16 + q4 * 4) = make_uint2(cvt_pk_bf16(o[0], o[1]), cvt_pk_bf16(o[2], o[3]));
            }
        }
        {
            constexpr int NS = (MODE == 0) ? 3 : 4;
            const int kt = (MODE == 0) ? (wv & 3) : wv;
            float dk[4] = {sp, sp, sp, sp};
            if (MODE == 1) { const f32x4 dv = *(const LAS f32x4*)(size_t)(L0 + O_DKV + (kt * 16 + q4 * 4) * 4); dk[0] = dv[0]; dk[1] = dv[1]; dk[2] = dv[2]; dk[3] = dv[3]; }
#pragma unroll
            for (int u2 = 0; u2 < NS; ++u2) {
                const int vt = (MODE == 0) ? ((u2 == 2) ? 4 : 2 * (wv >> 2) + u2) : u2;
                f32x4 a = sacc[u2];
#pragma unroll
                for (int jj = 0; jj < 4; ++jj) a[jj] *= dk[jj];
#pragma unroll
                for (int sb2 = 0; sb2 < CS / 32; ++sb2)
                    a = SC_MFMA(rd_tr(L0 + O_KW, sb2 * 32, kt * 16, QS, lane), rd_tr(L0 + O_V, sb2 * 32, vt * 16, VS, lane), a);
                sacc[u2] = a;
                st8(ST_W + (vt * 16 + r16) * QS + (kt * 16 + q4 * 4) * 2, make_uint2(cvt_pk_bf16(a[0], a[1]), cvt_pk_bf16(a[2], a[3])));
            }
        }
        __syncthreads();
    }
}
}

__device__ __forceinline__ void ph_scan_even2(KP p, int l, int bid, int nb) {
#pragma unroll 1
    for (int item = bid; item < 256; item += nb) {
        const int kind = item >> 7, b = (item >> 4) & 7, h = (item >> 2) & 3, dir = (item >> 1) & 1, vs = item & 1;
        if (kind == 0) sc::scan_item<0>(p, l, b, h, dir, vs); else sc::scan_item<1>(p, l, b, h, dir, vs);
        __syncthreads();
    }
}
__device__ __forceinline__ void ph_scan_odd2(KP p, int l, int bid, int nb) {
#pragma unroll 1
    for (int item = bid; item < 128; item += nb) {
        const int b = (item >> 4) & 7, h = (item >> 2) & 3, dir = (item >> 1) & 1, vs = item & 1;
        sc::scan_item<2>(p, l, b, h, dir, vs);
        __syncthreads();
    }
}

__device__ __forceinline__ void ph_normgate_even(KP p, int l, int bid, int nb) {
    const int tid = opaque_tid(), lane = tid & 63, wv = tid >> 6;
    const bf16_t* P = (const bf16_t*)(p->ws + OFF_BIG);
    const bf16_t* HX = (const bf16_t*)(p->ws + OFF_AUX);
    const bf16_t* HX1 = HX + (size_t)NT * 1024;
    bf16_t* MIX = (bf16_t*)(p->ws + OFF_U);
    const int e = l >> 1;
    #pragma unroll 1
    for (int it = bid * 8 + wv; it < NT * 8; it += nb * 8) {
        const int tok = it >> 3, g = it & 7;
        const size_t hxo = (size_t)tok * 1024 + g * 128;
        float x0 = bf2f(HX[hxo + lane]) + bf2f(HX1[hxo + lane]), x1 = bf2f(HX[hxo + lane + 64]) + bf2f(HX1[hxo + lane + 64]);
        const bf16_t* pr = P + (size_t)tok * EVEN_LD;
        if (g < 4) {
            const float mean = wave_sum(x0 + x1) * (1.f / 128.f);
            x0 -= mean; x1 -= mean;
            const float var = wave_sum(x0 * x0 + x1 * x1) * (1.f / 128.f);
            const float r = rsqrtf(var + LN_EPS);
            const float* nw = p->in[I_MNW] + e * 512 + g * 128;
            const float o0 = ldf(pr + E_MO + g * 128 + lane), o1 = ldf(pr + E_MO + g * 128 + lane + 64);
            stf(MIX + (size_t)tok * DM + g * 128 + lane, x0 * r * nw[lane] * sigmoidf_(o0));
            stf(MIX + (size_t)tok * DM + g * 128 + lane + 64, x1 * r * nw[lane + 64] * sigmoidf_(o1));
        } else {
            const int h = g - 4;
            const float ms = wave_sum(x0 * x0 + x1 * x1) * (1.f / 128.f);
            const float r = rsqrtf(ms + LN_EPS);
            const float* nw = p->in[I_HNW] + e * 512 + h * 128;
            const float g0 = ldf(pr + E_HG + h * 128 + lane), g1 = ldf(pr + E_HG + h * 128 + lane + 64);
            stf(MIX + (size_t)tok * DM + 512 + h * 128 + lane, x0 * r * nw[lane] * siluf_(g0));
            stf(MIX + (size_t)tok * DM + 512 + h * 128 + lane + 64, x1 * r * nw[lane + 64] * siluf_(g1));
        }
    }
}

__device__ __forceinline__ void ph_hy_filt(KP p, int l, int bid, int nb, float* sm) {
    const int tid = opaque_tid(), o = l >> 1;
    float* z = sm;
    float* h1 = sm + 64;
    float* h2 = sm + 128;
    float* h3 = sm + 192;
    const float* fw1 = p->in[I_HW1] + o * 33 * 64; const float* fb1 = p->in[I_HB1] + o * 64;
    const float* fw2 = p->in[I_HW2] + o * 64 * 64; const float* fb2 = p->in[I_HB2] + o * 64;
    const float* fw3 = p->in[I_HW3] + o * 64 * 64; const float* fb3 = p->in[I_HB3] + o * 64;
    const float* freq = p->in[I_HFREQ] + o * 64;
    const float* wout = p->in[I_HWOUT] + (size_t)o * 64 * 2048;
    float* Flat = (float*)(p->ws + OFF_FILT);
    float* Fctx = Flat + (size_t)2 * 2 * 512 * 4096;
    #pragma unroll 1
    for (int item = bid; item < SEQ + CTXL; item += nb) {
        const bool isctx = item >= SEQ;
        const int L = isctx ? CTXL : SEQ, pos = isctx ? item - SEQ : item;
        const float t = (float)pos / (float)(L - 1);
        __syncthreads();
        if (tid == 0) z[0] = t;
        if (tid < 16) {
            const float f = 1e-4f + (float)tid * ((15.0f - 1e-4f) / 15.0f);
            const float w = 2.0f * 3.14159265358979323846f * (float)pos / (float)L * f;
            z[1 + tid] = cosf(w); z[17 + tid] = sinf(w);
        }
        __syncthreads();
        if (tid < 64) { float a = fb1[tid];
#pragma unroll 1
            for (int k = 0; k < 33; ++k) a += z[k] * fw1[k * 64 + tid]; h1[tid] = sinf(freq[tid] * a); }
        __syncthreads();
        if (tid < 64) { float a = fb2[tid];
#pragma unroll 4
            for (int k = 0; k < 64; ++k) a += h1[k] * fw2[k * 64 + tid]; h2[tid] = sinf(freq[tid] * a); }
        __syncthreads();
        if (tid < 64) { float a = fb3[tid];
#pragma unroll 4
            for (int k = 0; k < 64; ++k) a += h2[k] * fw3[k * 64 + tid]; h3[tid] = sinf(freq[tid] * a); }
        __syncthreads();
#pragma unroll 1
        for (int r = 0; r < 4; ++r) {
            const int col = tid + 512 * r, c = col & 511, od = col >> 9;
            float a = 0.f;
#pragma unroll 4
            for (int k = 0; k < 64; ++k) a += h3[k] * wout[k * 2048 + col];
            const float delta = 3.0701134573253944f + (float)c * ((15.350567286626972f - 3.0701134573253944f) / 511.0f);
            a *= expf(-t * delta);
            if (isctx) Fctx[((size_t)od * 512 + c) * CTXL + pos] = a; else Flat[((size_t)od * 512 + c) * SEQ + pos] = a;
        }
    }
}

__device__ __forceinline__ float hy_conv3(const bf16_t* P, const float* cw, const float* cb, int tok, int j) {
    const bool lat = tok < NL;
    const int L = lat ? SEQ : CTXL, t = lat ? (tok & (SEQ - 1)) : ((tok - NL) & (CTXL - 1));
    const bf16_t* pr = P + (size_t)tok * ODD_N + j;
    float a = ldf(pr) * cw[1536 + j] + cb[j];
    if (t > 0) a += ldf(pr - ODD_N) * cw[j];
    if (t < L - 1) a += ldf(pr + ODD_N) * cw[2 * 1536 + j];
    return a;
}

__device__ __forceinline__ void ph_hy_conv(KP p, int l, int order, int bid, int nb, float* sm) {
    const int tid = opaque_tid(), o = l >> 1;
    const bf16_t* P = (const bf16_t*)(p->ws + OFF_BIG);
    const float* cw = p->in[I_HCW] + o * 3 * 1536; const float* cb = p->in[I_HCB] + o * 1536;
    const float* skip = p->in[I_HSKIP] + o * 1024 + order * 512;
    const float* Zin = (const float*)(p->ws + OFF_Z1);
    float* Zout = (float*)(p->ws + (order == 0 ? OFF_Z1 : OFF_Z2));
    const float* Flat = (const float*)(p->ws + OFF_FILT);
    const float* Fctx = Flat + (size_t)2 * 2 * 512 * 4096;
    #pragma unroll 1
    for (int item = bid; item < 1024 + 512; item += nb) {
        __syncthreads();
        if (item < 1024) {
            const int c = item >> 1, bg = item & 1;
            float* Kc = sm;
            float* zb = sm + 8192;
            const float* hf = Flat + ((size_t)(order * 2 + 0) * 512 + c) * SEQ;
            const float* hb = Flat + ((size_t)(order * 2 + 1) * 512 + c) * SEQ;
            for (int i = tid; i < 8192; i += 512) { const int lag = i - 4096; Kc[i] = lag >= 0 ? hf[lag] : (lag > -4096 ? hb[-lag] : 0.f); }
            for (int i = tid; i < 4 * SEQ; i += 512) {
                const int bb = i >> 12, s = i & (SEQ - 1), tok = (bg * 4 + bb) * SEQ + s;
                zb[i] = order == 0 ? hy_conv3(P, cw, cb, tok, 1024 + c) : Zin[(size_t)tok * 512 + c];
            }
            __syncthreads();
            float acc[8][4];
#pragma unroll
            for (int i = 0; i < 8; ++i)
#pragma unroll
                for (int bb = 0; bb < 4; ++bb) acc[i][bb] = 0.f;
            for (int s = 0; s < SEQ; ++s) {
                float zv[4];
#pragma unroll
                for (int bb = 0; bb < 4; ++bb) zv[bb] = zb[bb * SEQ + s];
#pragma unroll
                for (int i = 0; i < 8; ++i) {
                    const float kv = Kc[tid + 512 * i - s + 4096];
#pragma unroll
                    for (int bb = 0; bb < 4; ++bb) acc[i][bb] += kv * zv[bb];
                }
            }
            const float sk = skip[c];
#pragma unroll
            for (int i = 0; i < 8; ++i)
#pragma unroll
                for (int bb = 0; bb < 4; ++bb) {
                    const int t = tid + 512 * i, tok = (bg * 4 + bb) * SEQ + t;
                    const float g = hy_conv3(P, cw, cb, tok, order * 512 + c);
                    Zout[(size_t)tok * 512 + c] = g * (acc[i][bb] + zb[bb * SEQ + t] * sk);
                }
        } else {
            const int c = item - 1024;
            float* Kc = sm;
            float* zb = sm + 512;
            const float* hf = Fctx + ((size_t)(order * 2 + 0) * 512 + c) * CTXL;
            const float* hb = Fctx + ((size_t)(order * 2 + 1) * 512 + c) * CTXL;
            for (int i = tid; i < 512; i += 512) { const int lag = i - 256; Kc[i] = lag >= 0 ? hf[lag] : (lag > -256 ? hb[-lag] : 0.f); }
            for (int i = tid; i < 8 * CTXL; i += 512) {
                const int bb = i >> 8, s = i & (CTXL - 1), tok = NL + bb * CTXL + s;
                zb[i] = order == 0 ? hy_conv3(P, cw, cb, tok, 1024 + c) : Zin[(size_t)tok * 512 + c];
            }
            __syncthreads();
            const int bb = tid >> 6, tl = tid & 63;
            float acc[4] = {0.f, 0.f, 0.f, 0.f};
            for (int s = 0; s < CTXL; ++s) {
                const float zv = zb[bb * CTXL + s];
#pragma unroll
                for (int i = 0; i < 4; ++i) acc[i] += Kc[tl + 64 * i - s + 256] * zv;
            }
            const float sk = skip[c];
#pragma unroll
            for (int i = 0; i < 4; ++i) {
                const int t = tl + 64 * i, tok = NL + bb * CTXL + t;
                const float g = hy_conv3(P, cw, cb, tok, order * 512 + c);
                Zout[(size_t)tok * 512 + c] = g * (acc[i] + zb[bb * CTXL + t] * sk);
            }
        }
    }
}

__device__ __forceinline__ void ph_normgate_odd(KP p, int l, int bid, int nb) {
    const int tid = opaque_tid(), lane = tid & 63, wv = tid >> 6, o = l >> 1;
    const bf16_t* P = (const bf16_t*)(p->ws + OFF_BIG);
    const bf16_t* HX = (const bf16_t*)(p->ws + OFF_AUX);
    const bf16_t* HX1 = HX + (size_t)NT * 1024;
    const float* Z2 = (const float*)(p->ws + OFF_Z2);
    bf16_t* MIX = (bf16_t*)(p->ws + OFF_U);
    #pragma unroll 1
    for (int tok = bid * 8 + wv; tok < NT; tok += nb * 8) {
        const bf16_t* pr = P + (size_t)tok * ODD_N;
#pragma unroll
        for (int g = 0; g < 8; ++g) {
            const float x = Z2[(size_t)tok * 512 + g * 64 + lane];
            const float ms = wave_sum(x * x) * (1.f / 64.f);
            stf(MIX + (size_t)tok * DM + g * 64 + lane, x * rsqrtf(ms + LN_EPS) * p->in[I_HNORM][o * 512 + g * 64 + lane]);
        }
#pragma unroll
        for (int h = 0; h < 4; ++h) {
            const size_t hxo = (size_t)tok * 1024 + 512 + h * 128;
            float x0 = bf2f(HX[hxo + lane]) + bf2f(HX1[hxo + lane]), x1 = bf2f(HX[hxo + lane + 64]) + bf2f(HX1[hxo + lane + 64]);
            const float mean = wave_sum(x0 + x1) * (1.f / 128.f);
            x0 -= mean; x1 -= mean;
            const float var = wave_sum(x0 * x0 + x1 * x1) * (1.f / 128.f);
            const float r = rsqrtf(var + LN_EPS);
            const float* nw = p->in[I_RNW] + o * 512 + h * 128;
            const float g0 = ldf(pr + 3072 + h * 128 + lane), g1 = ldf(pr + 3072 + h * 128 + lane + 64);
            stf(MIX + (size_t)tok * DM + 512 + h * 128 + lane, x0 * r * nw[lane] * siluf_(g0));
            stf(MIX + (size_t)tok * DM + 512 + h * 128 + lane + 64, x1 * r * nw[lane + 64] * siluf_(g1));
        }
    }
}


__device__ __forceinline__ void ph_ln1_router(KP p, int l, int ntok, int bid, int nb, float* sm) {
    const int tid = opaque_tid(), lane = tid & 63, wv = tid >> 6;
    const float* Y = (const float*)(p->ws + OFF_BIG);
    bf16_t* U = (bf16_t*)(p->ws + OFF_U);
    const float* lw = p->in[I_LNW] + (l * 2) * 1024; const float* lb = p->in[I_LNB] + (l * 2) * 1024;
    const float* rw = p->in[I_RW] + (size_t)l * 1024 * 64;
    const float rb = p->in[I_RB][l * 64 + lane];
    int* cnt = (int*)(p->ws + OFF_CNT) + l * 64;
    int* tidx = (int*)(p->ws + OFF_TIDX); float* tgate = (float*)(p->ws + OFF_TGATE); int* tpos = (int*)(p->ws + OFF_TPOS);
    float* Vs = sm + wv * 4096;
    {
        int* stok = (int*)(p->ws + OFF_STOK); float* sgate = (float*)(p->ws + OFF_SGATE); int* sdst = (int*)(p->ws + OFF_SDST);
        #pragma unroll 1
        for (int i = bid * 512 + tid; i < MAXROWS; i += nb * 512) { stok[i] = ZROW; sgate[i] = 0.f; sdst[i] = -1; }
    }
    #pragma unroll 1
    for (int base = bid * 32; base < ntok; base += nb * 32) {
#pragma unroll 1
        for (int j = 0; j < 4; ++j) {
            const int tok = base + wv * 4 + j;
            float* h = hrow(p, tok);
            const float* m = modrow(p, l, tok);
            const float* r = Y + (size_t)tok * DM;
            float x[16]; float s = 0.f;
#pragma unroll
            for (int c = 0; c < 4; ++c) {
                const int d = 4 * (lane + 64 * c);
                const float4 hv = *(const float4*)(h + d), gv = *(const float4*)(m + 2 * 1024 + d), rv = *(const float4*)(r + d);
                x[4 * c] = ALPHA * hv.x + gv.x * rv.x; x[4 * c + 1] = ALPHA * hv.y + gv.y * rv.y; x[4 * c + 2] = ALPHA * hv.z + gv.z * rv.z; x[4 * c + 3] = ALPHA * hv.w + gv.w * rv.w;
                s += x[4 * c] + x[4 * c + 1] + x[4 * c + 2] + x[4 * c + 3];
            }
            const float mean = wave_sum(s) * (1.f / 1024.f);
            float q = 0.f;
#pragma unroll
            for (int i = 0; i < 16; ++i) { x[i] -= mean; q += x[i] * x[i]; }
            const float rs = rsqrtf(wave_sum(q) * (1.f / 1024.f) + LN_EPS);
#pragma unroll
            for (int c = 0; c < 4; ++c) {
                const int d = 4 * (lane + 64 * c);
                const float4 w4 = *(const float4*)(lw + d), b4 = *(const float4*)(lb + d), sh = *(const float4*)(m + 3 * 1024 + d), sc = *(const float4*)(m + 4 * 1024 + d);
                float4 y; y.x = x[4 * c] * rs * w4.x + b4.x; y.y = x[4 * c + 1] * rs * w4.y + b4.y; y.z = x[4 * c + 2] * rs * w4.z + b4.z; y.w = x[4 * c + 3] * rs * w4.w + b4.w;
                *(float4*)(h + d) = y;
                float4 v; v.x = y.x * (1.f + sc.x) + sh.x; v.y = y.y * (1.f + sc.y) + sh.y; v.z = y.z * (1.f + sc.z) + sh.z; v.w = y.w * (1.f + sc.w) + sh.w;
                *(uint2*)(U + (size_t)tok * DM + d) = make_uint2(cvt_pk_bf16(v.x, v.y), cvt_pk_bf16(v.z, v.w));
                *(float4*)(Vs + j * 1024 + d) = v;
            }
        }
        __syncthreads();
        float a[4] = {0.f, 0.f, 0.f, 0.f};
#pragma unroll 2
        for (int d = 0; d < 1024; d += 4) {
            const float w0 = rw[(d + 0) * 64 + lane], w1 = rw[(d + 1) * 64 + lane], w2 = rw[(d + 2) * 64 + lane], w3 = rw[(d + 3) * 64 + lane];
#pragma unroll
            for (int j = 0; j < 4; ++j) { const float4 v = *(const float4*)(Vs + j * 1024 + d); a[j] += v.x * w0 + v.y * w1 + v.z * w2 + v.w * w3; }
        }
#pragma unroll
        for (int j = 0; j < 4; ++j) {
            const int tok = base + wv * 4 + j;
            const float score = sigmoidf_(a[j]);
            float key = score + rb;
            float mysel = 0.f; int myidx = 0; float gsum = 0.f;
#pragma unroll
            for (int s = 0; s < TOPK; ++s) {
                float bv = key; int bi = lane;
#pragma unroll
                for (int o = 32; o > 0; o >>= 1) {
                    const float ov = __shfl_xor(bv, o, 64); const int oi = __shfl_xor(bi, o, 64);
                    if (ov > bv || (ov == bv && oi < bi)) { bv = ov; bi = oi; }
                }
                const float sc = __shfl(score, bi, 64);
                gsum += sc;
                if (lane == s) { mysel = sc; myidx = bi; }
                if (lane == bi) key = -1e30f;
            }
            if (lane < TOPK) {
                const int pos = atomicAdd(&cnt[myidx], 1);
                tidx[tok * 8 + lane] = myidx; tgate[tok * 8 + lane] = 2.5f * mysel / gsum; tpos[tok * 8 + lane] = pos;
            }
        }
        __syncthreads();
    }
}

__device__ __forceinline__ void moe_offsets(KP p, int l, int ntok, LAS int* offs) {
    if (threadIdx.x == 0) {
        int* cnt = (int*)(p->ws + OFF_CNT) + l * 64;
        int a = 0;
#pragma unroll 1
        for (int e = 0; e < 64; ++e) { offs[e] = a; a += (__hip_atomic_load(cnt + e, __ATOMIC_RELAXED, __HIP_MEMORY_SCOPE_AGENT) + 255) & ~255; }
        offs[64] = a; offs[65] = a + ntok;
    }
    __syncthreads();
}
__device__ __forceinline__ int moe_expert_of(const LAS int* offs, int row) { int e = 0;
#pragma unroll 1
    while (e < 64 && row >= offs[e + 1]) ++e;
    return e; }

__device__ __forceinline__ void ph_scatter(KP p, int l, int ntok, int bid, int nb, LAS unsigned char* lds) {
    LAS int* offs = (LAS int*)lds;
    moe_offsets(p, l, ntok, offs);
    const int tid = opaque_tid();
    const int* tidx = (const int*)(p->ws + OFF_TIDX); const float* tgate = (const float*)(p->ws + OFF_TGATE); const int* tpos = (const int*)(p->ws + OFF_TPOS);
    int* stok = (int*)(p->ws + OFF_STOK); float* sgate = (float*)(p->ws + OFF_SGATE); int* sdst = (int*)(p->ws + OFF_SDST);
    int* tile_e = (int*)(p->ws + OFF_TILEE);
    #pragma unroll 1
    for (int i = bid * 512 + tid; i < ntok * 9; i += nb * 512) {
        if (i < ntok * 8) { const int row = offs[tidx[i]] + tpos[i], tok = i >> 3; stok[row] = tok; sgate[row] = tgate[i]; sdst[row] = tok * 9 + (i & 7); }
        else { const int tok = i - ntok * 8, row = offs[64] + tok; stok[row] = tok; sgate[row] = 1.f; sdst[row] = tok * 9 + 8; }
    }
    const int nrt = offs[65] >> 8;
    #pragma unroll 1
    for (int rt = bid * 512 + tid; rt < nrt; rt += nb * 512) tile_e[rt] = moe_expert_of(offs, rt * 256);
    __syncthreads();
}

#define MOE_TAB (gp::STAGE_BYTES + 256)
#define MOE_MAXT 8
struct Moe1Sched {
    const char* U; const char* W; const LAS int* tabE; const LAS int* tabS; int nper, bid, nb;
    __device__ __forceinline__ bool next(int i, gp::Unit& u) const {
        const int j = i >> 1; if (j >= nper) return false;
        u.A = U; u.B = W + (size_t)tabE[j] * (512 * 1024 * 2) + (size_t)(i & 1) * (256 * 1024 * 2); u.r0 = (bid + j * nb) * 256; u.c0 = (i & 1) * 256; u.aux = j; return true;
    }
    __device__ __forceinline__ void lane_off(const gp::Unit& u, int R0, int R1, int C0, int C1, unsigned (&vo)[2][2]) const {
        const LAS int* t = tabS + u.aux * 256;
        vo[0][0] = (unsigned)t[R0] * 2048u + (unsigned)C0 * 2u; vo[0][1] = (unsigned)t[R1] * 2048u + (unsigned)C1 * 2u;
        vo[1][0] = (unsigned)t[128 + R0] * 2048u + (unsigned)C0 * 2u; vo[1][1] = (unsigned)t[128 + R1] * 2048u + (unsigned)C1 * 2u;
    }
};
struct EpiH {
    bf16_t* H;
    __device__ __forceinline__ void operator()(const gp::f32x4 (&acc)[2][2][4][2], const gp::Unit& u, int wr, int wc, int fr, int fq) const {
        const int row0 = u.r0 + wr * 64 + fr;
#pragma unroll
        for (int ai = 0; ai < 2; ++ai)
#pragma unroll
            for (int m = 0; m < 4; ++m) { bf16_t* rowp = H + (size_t)(row0 + ai * 128 + m * 16) * 256;
#pragma unroll
                for (int bj = 0; bj < 2; ++bj) {
                    const int j0 = ((u.c0 + bj * 128 + wc * 32) >> 5) * 16 + 4 * fq;
                    const gp::f32x4 a = acc[ai][bj][m][0], b = acc[ai][bj][m][1];
                    const float h0 = siluf_(a[0]) * b[0], h1 = siluf_(a[1]) * b[1], h2 = siluf_(a[2]) * b[2], h3 = siluf_(a[3]) * b[3];
                    *(uint2*)(rowp + j0) = make_uint2(cvt_pk_bf16(h0, h1), cvt_pk_bf16(h2, h3)); }
                __builtin_amdgcn_sched_barrier(0); }
    }
};
__device__ __forceinline__ void ph_moe1(KP p, int l, int ntok, int bid, int nb, LAS unsigned char* lds) {
    LAS int* offs = (LAS int*)(lds + MOE_TAB);
    LAS int* tabE = offs + 128;
    LAS int* tabS = offs + 256;
    moe_offsets(p, l, ntok, offs);
    const int tid = opaque_tid();
    const int nrt = offs[65] >> 8;
    const int nper = bid < nrt ? (nrt - bid + nb - 1) / nb : 0;
    const int* stok = (const int*)(p->ws + OFF_STOK); const int* tile_e = (const int*)(p->ws + OFF_TILEE);
    for (int i = tid; i < nper * 256; i += 512) tabS[i] = stok[(size_t)(bid + (i >> 8) * nb) * 256 + (i & 255)];
    if (tid < nper) tabE[tid] = tile_e[bid + tid * nb];
    __syncthreads();
    Moe1Sched S{(const char*)(p->ws + OFF_U), (const char*)(p->ws + OFF_W13), tabE, tabS, nper, bid, nb};
    EpiH E{(bf16_t*)(p->ws + OFF_BIG)};
    gp::gemm_phase<true, false>(lds, 1024, S, E);
}

struct Moe2Sched {
    const char* H; const char* W; const LAS int* tabE; int nper, bid, nb;
    __device__ __forceinline__ bool next(int i, gp::Unit& u) const {
        const int j = i >> 2; if (j >= nper) return false;
        u.A = H + (size_t)(bid + j * nb) * (256 * 256 * 2); u.B = W + (size_t)tabE[j] * (1024 * 256 * 2) + (size_t)(i & 3) * (256 * 256 * 2); u.r0 = j * 256; u.c0 = (i & 3) * 256; u.aux = j; return true;
    }
    __device__ __forceinline__ void lane_off(const gp::Unit&, int, int, int, int, unsigned (&)[2][2]) const {}
};
struct EpiY {
    bf16_t* Ys; const LAS int* tabD; const LAS float* tabG;
    __device__ __forceinline__ void operator()(const gp::f32x4 (&acc)[2][2][4][2], const gp::Unit& u, int wr, int wc, int fr, int fq) const {
        const int rl0 = u.r0 + wr * 64 + fr, col0 = u.c0 + wc * 32 + 8 * fq;
#pragma unroll
        for (int ai = 0; ai < 2; ++ai)
#pragma unroll
            for (int m = 0; m < 4; ++m) {
                const int rl = rl0 + ai * 128 + m * 16;
                const int dst = tabD[rl]; const float g = tabG[rl];
                if (dst >= 0) { bf16_t* rowp = Ys + (size_t)dst * 1024 + col0;
#pragma unroll
                    for (int bj = 0; bj < 2; ++bj) { const gp::f32x4 v0 = acc[ai][bj][m][0] * g, v1 = acc[ai][bj][m][1] * g;
                        gp::u32x4 w; w.x = cvt_pk_bf16(v0[0], v0[1]); w.y = cvt_pk_bf16(v0[2], v0[3]); w.z = cvt_pk_bf16(v1[0], v1[1]); w.w = cvt_pk_bf16(v1[2], v1[3]);
                        *(gp::u32x4*)(rowp + bj * 128) = w; } }
                __builtin_amdgcn_sched_barrier(0); }
    }
};
__device__ __forceinline__ void ph_moe2(KP p, int l, int ntok, int bid, int nb, LAS unsigned char* lds) {
    LAS int* offs = (LAS int*)(lds + MOE_TAB);
    LAS int* tabE = offs + 128;
    LAS int* tabD = offs + 256;
    LAS float* tabG = (LAS float*)(tabD + MOE_MAXT * 256);
    moe_offsets(p, l, ntok, offs);
    const int tid = opaque_tid();
    const int nrt = offs[65] >> 8;
    const int nper = bid < nrt ? (nrt - bid + nb - 1) / nb : 0;
    const int* sdst = (const int*)(p->ws + OFF_SDST); const float* sgate = (const float*)(p->ws + OFF_SGATE); const int* tile_e = (const int*)(p->ws + OFF_TILEE);
    for (int i = tid; i < nper * 256; i += 512) { const size_t r = (size_t)(bid + (i >> 8) * nb) * 256 + (i & 255); tabD[i] = sdst[r]; tabG[i] = sgate[r]; }
    if (tid < nper) tabE[tid] = tile_e[bid + tid * nb];
    __syncthreads();
    Moe2Sched S{(const char*)(p->ws + OFF_BIG), (const char*)(p->ws + OFF_W2), tabE, nper, bid, nb};
    EpiY E{(bf16_t*)(p->ws + OFF_YS), tabD, tabG};
    gp::gemm_phase<false, true>(lds, 256, S, E);
}

__device__ __forceinline__ void ph_combine_ln2(KP p, int l, int ntok, int bid, int nb) {
    const int tid = opaque_tid(), lane = tid & 63, wv = tid >> 6;
    const bf16_t* Ys = (const bf16_t*)(p->ws + OFF_YS);
    const float* lw = p->in[I_LNW] + (l * 2 + 1) * 1024; const float* lb = p->in[I_LNB] + (l * 2 + 1) * 1024;
    #pragma unroll 1
    for (int tok = bid * 8 + wv; tok < ntok; tok += nb * 8) {
        float* h = hrow(p, tok);
        const float* m = modrow(p, l, tok);
        float f[16];
#pragma unroll
        for (int i = 0; i < 16; ++i) f[i] = 0.f;
#pragma unroll
        for (int s = 0; s < 9; ++s)
#pragma unroll
            for (int c = 0; c < 2; ++c) {
                const uint4 w = *(const uint4*)(Ys + ((size_t)tok * 9 + s) * 1024 + 8 * (lane + 64 * c));
                f[8 * c + 0] += bflo(w.x); f[8 * c + 1] += bfhi(w.x); f[8 * c + 2] += bflo(w.y); f[8 * c + 3] += bfhi(w.y);
                f[8 * c + 4] += bflo(w.z); f[8 * c + 5] += bfhi(w.z); f[8 * c + 6] += bflo(w.w); f[8 * c + 7] += bfhi(w.w);
            }
        float x[16]; float sum = 0.f;
#pragma unroll
        for (int c = 0; c < 2; ++c)
#pragma unroll
            for (int q = 0; q < 2; ++q) {
                const int d = 8 * (lane + 64 * c) + 4 * q;
                const float4 hv = *(const float4*)(h + d), gv = *(const float4*)(m + 5 * 1024 + d);
                x[8 * c + 4 * q + 0] = ALPHA * hv.x + gv.x * f[8 * c + 4 * q + 0]; x[8 * c + 4 * q + 1] = ALPHA * hv.y + gv.y * f[8 * c + 4 * q + 1];
                x[8 * c + 4 * q + 2] = ALPHA * hv.z + gv.z * f[8 * c + 4 * q + 2]; x[8 * c + 4 * q + 3] = ALPHA * hv.w + gv.w * f[8 * c + 4 * q + 3];
                sum += x[8 * c + 4 * q] + x[8 * c + 4 * q + 1] + x[8 * c + 4 * q + 2] + x[8 * c + 4 * q + 3];
            }
        const float mean = wave_sum(sum) * (1.f / 1024.f);
        float q2 = 0.f;
#pragma unroll
        for (int i = 0; i < 16; ++i) { x[i] -= mean; q2 += x[i] * x[i]; }
        const float rs = rsqrtf(wave_sum(q2) * (1.f / 1024.f) + LN_EPS);
#pragma unroll
        for (int c = 0; c < 2; ++c)
#pragma unroll
            for (int q = 0; q < 2; ++q) {
                const int d = 8 * (lane + 64 * c) + 4 * q;
                const float4 w4 = *(const float4*)(lw + d), b4 = *(const float4*)(lb + d);
                float4 y; y.x = x[8 * c + 4 * q] * rs * w4.x + b4.x; y.y = x[8 * c + 4 * q + 1] * rs * w4.y + b4.y; y.z = x[8 * c + 4 * q + 2] * rs * w4.z + b4.z; y.w = x[8 * c + 4 * q + 3] * rs * w4.w + b4.w;
                *(float4*)(h + d) = y;
            }
    }
}

#define MEGA_LDS (131072 + 256 + 20480)
#define NBLK 256
#define BAR_LDS 131072
#define SYNC() do { XcdBarrier _b; _b.bar = (unsigned*)kparams()->ws; _b.x = xb_xcc_id(); _b.st = (volatile LAS unsigned*)((LAS unsigned char*)smraw_base() + BAR_LDS); xcd_barrier(_b); } while (0)
template <int PAR>
__device__ __forceinline__ void layer_fwd(const int l) {
    LAS unsigned char* lds = smraw_base(); float* sm = (float*)smraw_generic();
    const int bid = blockIdx.x; constexpr int nb = NBLK;
    const int ntok = (l == 3) ? NL : NT;
    ph_convert(kparams(), l, bid, nb, sm); ph_modin(kparams(), l, bid, nb); SYNC();
    ph_gemm_in(kparams(), l, bid, nb, lds); SYNC();
    if (PAR == 0) {
        ph_scan_even2(kparams(), l, bid, nb); SYNC();
        ph_normgate_even(kparams(), l, bid, nb); SYNC();
    } else {
        ph_scan_odd2(kparams(), l, bid, nb); ph_hy_filt(kparams(), l, bid, nb, sm); SYNC();
        ph_hy_conv(kparams(), l, 0, bid, nb, sm); SYNC();
        ph_hy_conv(kparams(), l, 1, bid, nb, sm); SYNC();
        ph_normgate_odd(kparams(), l, bid, nb); SYNC();
    }
    ph_gemm_out(kparams(), l, bid, nb, lds); SYNC();
    ph_ln1_router(kparams(), l, ntok, bid, nb, sm); SYNC();
    ph_scatter(kparams(), l, ntok, bid, nb, lds); SYNC();
    ph_moe1(kparams(), l, ntok, bid, nb, lds); SYNC();
    ph_moe2(kparams(), l, ntok, bid, nb, lds); SYNC();
    ph_combine_ln2(kparams(), l, ntok, bid, nb);
    if (l < 3) SYNC();
}
__global__ void __launch_bounds__(512, 2) mega_fwd(Params p) {
    LAS unsigned char* lds = smraw_base(); float* sm = (float*)smraw_generic();
    if (threadIdx.x < 4) ((LAS unsigned*)(lds + 131072))[threadIdx.x] = 0u;
    __syncthreads();
    (void)xcd_barrier_post((unsigned*)kparams()->ws, (volatile LAS unsigned*)(lds + BAR_LDS));
    const int bid = blockIdx.x; constexpr int nb = NBLK;
    ph_prologue(kparams(), bid, nb, sm); SYNC();
#pragma unroll 1
    for (int lp = 0; lp < 2; ++lp) {
        layer_fwd<0>(2 * lp);
        layer_fwd<1>(2 * lp + 1);
    }
    __syncthreads();
    if (blockIdx.x == 0 && threadIdx.x == 0 && xb_ld((unsigned*)kparams()->ws + XB_TMO) != 0u) kparams()->out[0] = __builtin_nanf("");
}

extern "C" void kernel_launch(void* const* d_in, const int* in_sizes, int n_in, void* d_out, int out_size, void* d_ws, size_t ws_size, hipStream_t stream) {
    static int grid = 0;
    if (grid == 0) {
        if (n_in != 38 || out_size != NL * DM || ws_size < WS_END) { fprintf(stderr, "kernel_launch: bad shapes n_in %d out %d ws %zu (need %zu)\n", n_in, out_size, ws_size, (size_t)WS_END); grid = -1; return; }
        int dev = 0, cus = 0, per_cu = 0;
        if (hipGetDevice(&dev) != hipSuccess || hipDeviceGetAttribute(&cus, hipDeviceAttributeMultiprocessorCount, dev) != hipSuccess) { grid = -1; return; }
        if (hipFuncSetAttribute((const void*)mega_fwd, hipFuncAttributeMaxDynamicSharedMemorySize, MEGA_LDS) != hipSuccess) { fprintf(stderr, "kernel_launch: hipFuncSetAttribute failed\n"); grid = -1; return; }
        if (hipOccupancyMaxActiveBlocksPerMultiprocessor(&per_cu, (const void*)mega_fwd, 512, MEGA_LDS) != hipSuccess || per_cu < 1) { fprintf(stderr, "kernel_launch: occupancy query says %d\n", per_cu); (void)hipGetLastError(); grid = -1; return; }
        if (cus != 256) { fprintf(stderr, "kernel_launch: built for 256 CUs, found %d\n", cus); grid = -1; return; }
        grid = NBLK;
    }
    if (grid < 0) return;
    if (hipMemsetAsync(d_ws, 0, OFF_LB, stream) != hipSuccess) return;
    Params p{};
    for (int i = 0; i < 38; ++i) p.in[i] = (const float*)d_in[i];
    p.out = (float*)d_out; p.ws = (unsigned char*)d_ws;
    hipLaunchKernelGGL(mega_fwd, dim3(grid), dim3(512), MEGA_LDS, stream, p);
}
```

```cpp
#include <hip/hip_runtime.h>
#include <stdint.h>
#include <stdio.h>

#define DM 1024
#define NBATCH 8
#define SEQ 4096
#define CTXL 256
#define NL (NBATCH * SEQ)
#define NC (NBATCH * CTXL)
#define NT (NL + NC)
#define ZROW NT
#define TOPK 8
#define EVEN_N 4112
#define ODD_N 3584
#define EVEN_LD 4096
#define ODD_LD 3584
#define MAXROWS (NT * 8 + 64 * 256 + NT)
#define ALPHA 1.681792830507429f
#define LN_EPS 1e-5f
#define E_MQ 0
#define E_MK 256
#define E_MV 512
#define E_MO 1024
#define E_HQ 1536
#define E_HI 2048
#define E_HFF 2560
#define E_HFB 3072
#define E_HG 3584

typedef unsigned short bf16_t;
#define LAS __attribute__((address_space(3)))

#define MiB ((size_t)1 << 20)
#define OFF_CNT   ((size_t)64 << 10)
#define OFF_LB    ((size_t)96 << 10)
#define OFF_MOD   ((size_t)128 << 10)
#define OFF_ROPE  ((size_t)1536 << 10)
#define OFF_TILEE (2 * MiB)
#define OFF_HCTX  (4 * MiB)
#define OFF_TIDX  (12 * MiB)
#define OFF_TGATE (14 * MiB)
#define OFF_TPOS  (16 * MiB)
#define OFF_STOK  (18 * MiB)
#define OFF_SGATE (20 * MiB)
#define OFF_SDST  (22 * MiB)
#define OFF_G     (24 * MiB)
#define OFF_U     (28 * MiB)
#define OFF_W     (98 * MiB)
#define OFF_WIN   (OFF_W)
#define OFF_WOUT  (OFF_W + 8 * MiB)
#define OFF_W13   (OFF_W + 10 * MiB)
#define OFF_W2    (OFF_W + 75 * MiB)
#define OFF_BIG   (208 * MiB)
#define OFF_AUX   (480 * MiB)
#define OFF_Z1    (OFF_AUX + 136 * MiB)
#define OFF_Z2    (OFF_Z1 + 68 * MiB)
#define OFF_FILT  (OFF_Z2 + 68 * MiB)
#define OFF_YS    (370 * MiB)
#define WS_END    (984 * MiB)

struct Params {
    const float* in[38];
    float* out;
    unsigned char* ws;
};

enum { I_X = 0, I_C, I_CTX, I_CCTX, I_ADAW, I_ADAB, I_LNW, I_LNB, I_EWIN, I_MGB, I_MNW, I_HLB, I_HNW, I_EWOUT, I_OWIN, I_HCW, I_HCB,
       I_HW1, I_HB1, I_HW2, I_HB2, I_HW3, I_HB3, I_HFREQ, I_HWOUT, I_HSKIP, I_HNORM, I_RLD, I_RNW, I_OWOUT, I_RW, I_RB, I_W1, I_W3, I_W2, I_SW1, I_SW3, I_SW2 };

typedef const __attribute__((address_space(4))) Params* KP;
__device__ __forceinline__ KP kparams() { KP k = (KP)__builtin_amdgcn_kernarg_segment_ptr(); asm volatile("" : "+s"(k)); return k; }
extern __shared__ __attribute__((aligned(16))) unsigned char smraw_all[];
__device__ __forceinline__ LAS unsigned char* smraw_base() { return (LAS unsigned char*)smraw_all; }
__device__ __forceinline__ unsigned char* smraw_generic() { return smraw_all; }
__device__ __forceinline__ int opaque_tid() { int t = threadIdx.x; asm volatile("" : "+v"(t)); return t; }
typedef __bf16 bf16x2_n __attribute__((ext_vector_type(2)));
typedef float f32x2_n __attribute__((ext_vector_type(2)));
__device__ __forceinline__ unsigned cvt_pk_bf16(float lo, float hi) { const f32x2_n v = {lo, hi}; return __builtin_bit_cast(unsigned, __builtin_convertvector(v, bf16x2_n)); }
__device__ __forceinline__ float bf2f(bf16_t b) { return __uint_as_float(((unsigned)b) << 16); }
__device__ __forceinline__ float bflo(unsigned w) { return __uint_as_float(w << 16); }
__device__ __forceinline__ float bfhi(unsigned w) { return __uint_as_float(w & 0xffff0000u); }
__device__ __forceinline__ float ldf(const float* p) { return *p; }
__device__ __forceinline__ float ldf(const bf16_t* p) { return bf2f(*p); }
__device__ __forceinline__ void stf(float* p, float v) { *p = v; }
__device__ __forceinline__ void stf(bf16_t* p, float v) { *p = (bf16_t)(cvt_pk_bf16(v, 0.f) & 0xffffu); }
__device__ __forceinline__ float sigmoidf_(float x) { return 1.f / (1.f + expf(-x)); }
__device__ __forceinline__ float siluf_(float x) { return x / (1.f + expf(-x)); }
__device__ __forceinline__ float wave_sum(float v) {
#pragma unroll
    for (int o = 32; o > 0; o >>= 1) v += __shfl_xor(v, o, 64);
    return v;
}
__device__ __forceinline__ float* hrow(KP p, int tok) {
    return tok < NL ? p->out + (size_t)tok * DM : (float*)(p->ws + OFF_HCTX) + (size_t)(tok - NL) * DM;
}
__device__ __forceinline__ const float* modrow(KP p, int l, int tok) {
    const int r = tok < NL ? (tok >> 12) : 8;
    return (const float*)(p->ws + OFF_MOD) + ((size_t)l * 9 + r) * 6144;
}
__device__ __forceinline__ int scan_tok(int b, int i, int dir) {
    return i < CTXL ? NL + b * CTXL + (dir ? CTXL - 1 - i : i) : b * SEQ + (dir ? SEQ - 1 - (i - CTXL) : (i - CTXL));
}

#define XB_TMO      128
#define XB_XCNT(j)  (256  + 64 * (j))
#define XB_XSUB(j)  (1280 + 64 * (j))
#define XB_XGEN(j)  (2304 + 64 * (j))
#define XB_TOP      3328
#define XB_TOPGEN   3392
#define XCD_BAR_WORDS 3456
#define XB_SPIN_CAP (1u << 24)
__device__ __forceinline__ unsigned xb_ld(unsigned* p)              { return __hip_atomic_load(p, __ATOMIC_RELAXED, __HIP_MEMORY_SCOPE_AGENT); }
__device__ __forceinline__ unsigned xb_add(unsigned* p, unsigned v) { return __hip_atomic_fetch_add(p, v, __ATOMIC_RELAXED, __HIP_MEMORY_SCOPE_AGENT); }
__device__ __forceinline__ unsigned xb_xcc_id() { return (unsigned)__builtin_amdgcn_s_getreg((3 << 11) | 20) & 0xFu; }
#define XB_SPIN(cond, bar) do { unsigned _sp = 0; while (cond) { __builtin_amdgcn_s_sleep(1); \
    if ((++_sp & 255u) == 0u) { if (xb_ld(&(bar)[XB_TMO])) break; if (_sp > XB_SPIN_CAP) { atomicAdd(&(bar)[XB_TMO], 1u); break; } } } } while (0)
struct XcdBarrier { unsigned* bar; unsigned x; volatile LAS unsigned* st; };
__device__ __forceinline__ XcdBarrier xcd_barrier_post(unsigned* bar, volatile LAS unsigned* st) {
    XcdBarrier b; b.bar = bar; b.x = xb_xcc_id(); b.st = st;
    if (threadIdx.x == 0) (void)xb_add(&bar[XB_XCNT(b.x)], 1u);
    return b;
}
__device__ __forceinline__ void xcd_barrier_complete(unsigned* bar, unsigned x, unsigned& nloc, unsigned& nx) {
    const unsigned G = gridDim.x * gridDim.y * gridDim.z;
    unsigned sum, cnt, mine, sp = 0u;
    for (;;) {
        sum = 0u; cnt = 0u; mine = 0u;
#pragma unroll
        for (unsigned j = 0; j < 16; ++j) { const unsigned c = xb_ld(&bar[XB_XCNT(j)]); sum += c; cnt += (c > 0u) ? 1u : 0u; mine = (j == x) ? c : mine; }
        if (sum == G) break;
        __builtin_amdgcn_s_sleep(1);
        if ((++sp & 255u) == 0u) { if (xb_ld(&bar[XB_TMO])) break; if (sp > XB_SPIN_CAP) { atomicAdd(&bar[XB_TMO], 1u); break; } }
    }
    nloc = mine > 0u ? mine : 1u; nx = cnt > 0u ? cnt : 1u;
}
__device__ __forceinline__ void xcd_barrier(const XcdBarrier& b) {
    asm volatile("s_waitcnt vmcnt(0)" ::: "memory");
    __syncthreads();
    if (threadIdx.x == 0) {
        unsigned* bar = b.bar;
        __builtin_amdgcn_s_waitcnt(0);
        unsigned nloc = b.st[0], nx = b.st[1];
        if (nloc == 0u) { xcd_barrier_complete(bar, b.x, nloc, nx); b.st[0] = nloc; b.st[1] = nx; }
        const unsigned old = xb_add(&bar[XB_XSUB(b.x)], 1u);
        const unsigned gen = old / nloc;
        if (old + 1u == (gen + 1u) * nloc) {
            __builtin_amdgcn_fence(__ATOMIC_RELEASE, "agent");
            asm volatile("s_waitcnt vmcnt(0)" ::: "memory");
            const unsigned og = xb_add(&bar[XB_TOP], 1u);
            const unsigned tg = og / nx;
            if (og + 1u == (tg + 1u) * nx) xb_add(&bar[XB_TOPGEN], 1u);
            else XB_SPIN(xb_ld(&bar[XB_TOPGEN]) == tg, bar);
            __builtin_amdgcn_fence(__ATOMIC_ACQUIRE, "agent");
            xb_add(&bar[XB_XGEN(b.x)], 1u);
            asm volatile("s_waitcnt vmcnt(0)" ::: "memory");
        } else {
            XB_SPIN(xb_ld(&bar[XB_XGEN(b.x)]) == gen, bar);
            __builtin_amdgcn_fence(__ATOMIC_ACQUIRE, "agent");
            asm volatile("s_waitcnt vmcnt(0)" ::: "memory");
        }
    }
    __syncthreads();
}

__device__ __forceinline__ void ph_prologue(KP p, int bid, int nb, float* sm) {
    const int tid = opaque_tid();
    {
        const float4* x4 = (const float4*)p->in[I_X]; float4* o4 = (float4*)p->out;
        #pragma unroll 1
        for (size_t i = (size_t)bid * 512 + tid; i < (size_t)NL * 256; i += (size_t)nb * 512) o4[i] = x4[i];
        const float4* c4 = (const float4*)p->in[I_CTX]; float4* h4 = (float4*)(p->ws + OFF_HCTX);
        #pragma unroll 1
        for (size_t i = (size_t)bid * 512 + tid; i < (size_t)NC * 256; i += (size_t)nb * 512) h4[i] = c4[i];
    }
    if (bid == 0) {
        bf16_t* z = (bf16_t*)(p->ws + OFF_U) + (size_t)ZROW * DM;
        for (int i = tid; i < DM; i += 512) z[i] = 0;
    }
    if (bid == 1 % nb) {
        float* lb = (float*)(p->ws + OFF_LB);
        const float* hl = p->in[I_HLB];
        for (int j = tid; j < 512; j += 512) {
            const float a = hl[j], b = hl[512 + j], mx = fmaxf(a, b);
            const float ea = expf(a - mx), eb = expf(b - mx);
            lb[j] = 0.f; lb[512 + j] = eb / (ea + eb);
        }
    }
    if (bid == 2 % nb) {
        float2* rt = (float2*)(p->ws + OFF_ROPE);
        for (int i = tid; i < 64 * 32; i += 512) { const float ang = (float)(i >> 5) * powf(10000.f, -(float)(2 * (i & 31)) / 64.f); rt[i] = make_float2(cosf(ang), sinf(ang)); }
    }
    {
        float* act = sm;
        bool filled = false;
        #pragma unroll 1
        for (int item = bid; item < 48; item += nb) {
            if (!filled) {
                for (int i = tid; i < 9 * 1024; i += 512) {
                    const int r = i >> 10, k = i & 1023;
                    const float v = r < 8 ? p->in[I_C][r * 1024 + k] : p->in[I_CCTX][k];
                    act[i] = siluf_(v);
                }
                __syncthreads(); filled = true;
            }
            const int l = item / 12, j = (item % 12) * 512 + tid;
            const float* w = p->in[I_ADAW] + (size_t)l * 1024 * 6144 + j;
            float acc[9];
#pragma unroll
            for (int r = 0; r < 9; ++r) acc[r] = 0.f;
            for (int k = 0; k < 1024; ++k) {
                const float wv = w[(size_t)k * 6144];
#pragma unroll
                for (int r = 0; r < 9; ++r) acc[r] += act[r * 1024 + k] * wv;
            }
            const float bv = p->in[I_ADAB][l * 6144 + j];
            float* mod = (float*)(p->ws + OFF_MOD);
#pragma unroll
            for (int r = 0; r < 9; ++r) mod[((size_t)l * 9 + r) * 6144 + j] = acc[r] + bv;
        }
    }
}


template <class Src>
__device__ __forceinline__ void cvt_tile(float* sm, Src src, int srcld, int k0, bf16_t* dst, int dstld, int n0) {
    const int tid = opaque_tid();
    const float* sp = src(n0 + (tid & 127));
#pragma unroll
    for (int j = 0; j < 16; ++j) { const int k = (tid >> 7) + 4 * j; sm[k * 129 + (tid & 127)] = sp[(size_t)(k0 + k) * srcld]; }
    __syncthreads();
    const int n = tid >> 2, kc = (tid & 3) * 16;
    unsigned w[8];
#pragma unroll
    for (int q = 0; q < 8; ++q) w[q] = cvt_pk_bf16(sm[(kc + 2 * q) * 129 + n], sm[(kc + 2 * q + 1) * 129 + n]);
    uint4* d4 = (uint4*)(dst + (size_t)(n0 + n) * dstld + k0 + kc);
    d4[0] = make_uint4(w[0], w[1], w[2], w[3]); d4[1] = make_uint4(w[4], w[5], w[6], w[7]);
    __syncthreads();
}

__device__ __forceinline__ void ph_convert(KP p, int l, int bid, int nb, float* sm) {
    const bool even = (l & 1) == 0;
    const int NP = even ? EVEN_LD : ODD_LD;
    const int t_in = 16 * (NP / 128), t_out = 16 * 8, t_13 = 65 * 16 * 4, t_2 = 65 * 4 * 8;
    const int total = t_in + t_out + t_13 + t_2;
    #pragma unroll 1
    for (int t = bid; t < total; t += nb) {
        if (t < t_in) {
            const int kt = t & 15, nt = t >> 4;
            const float* W = even ? p->in[I_EWIN] + (size_t)(l >> 1) * 1024 * EVEN_N : p->in[I_OWIN] + (size_t)(l >> 1) * 1024 * ODD_N;
            cvt_tile(sm, [&](int n) { return W + ((even && n >= 1536) ? n + 16 : n); }, even ? EVEN_N : ODD_N, kt * 64, (bf16_t*)(p->ws + OFF_WIN), 1024, nt * 128);
        } else if (t < t_in + t_out) {
            const int u = t - t_in, kt = u & 15, nt = u >> 4;
            const float* W = (even ? p->in[I_EWOUT] : p->in[I_OWOUT]) + (size_t)(l >> 1) * 1024 * 1024;
            cvt_tile(sm, [&](int n) { return W + n; }, 1024, kt * 64, (bf16_t*)(p->ws + OFF_WOUT), 1024, nt * 128);
        } else if (t < t_in + t_out + t_13) {
            const int u = t - t_in - t_out, e = u >> 6, kt = u & 15, nt = (u >> 4) & 3;
            const float* w1 = e < 64 ? p->in[I_W1] + ((size_t)l * 64 + e) * 1024 * 256 : p->in[I_SW1] + (size_t)l * 1024 * 256;
            const float* w3 = e < 64 ? p->in[I_W3] + ((size_t)l * 64 + e) * 1024 * 256 : p->in[I_SW3] + (size_t)l * 1024 * 256;
            cvt_tile(sm, [&](int n) { const int g = n >> 5, w = n & 31; return w < 16 ? w1 + 16 * g + w : w3 + 16 * g + w - 16; }, 256, kt * 64,
                     (bf16_t*)(p->ws + OFF_W13) + (size_t)e * 512 * 1024, 1024, nt * 128);
        } else {
            const int u = t - t_in - t_out - t_13, e = u >> 5, kt = u & 3, nt = (u >> 2) & 7;
            const float* w2 = e < 64 ? p->in[I_W2] + ((size_t)l * 64 + e) * 256 * 1024 : p->in[I_SW2] + (size_t)l * 256 * 1024;
            cvt_tile(sm, [&](int n) { return w2 + n; }, 1024, kt * 64, (bf16_t*)(p->ws + OFF_W2) + (size_t)e * 1024 * 256, 256, nt * 128);
        }
    }
}

namespace gp {
typedef short bf16x8 __attribute__((ext_vector_type(8)));
typedef float f32x4 __attribute__((ext_vector_type(4)));
typedef unsigned u32x4 __attribute__((ext_vector_type(4)));
typedef unsigned u32x2 __attribute__((ext_vector_type(2)));
constexpr int BM = 256, BK = 64, HALF = 128, HTB = HALF * BK * 2, STAGE_BYTES = 8 * HTB, NXCD = 8, WGM = 8;
__device__ __forceinline__ int lds_byte(int r, int c) { const int st = (r >> 4) * 2 + (c >> 5), rr = r & 15, cc = c & 31, ob = rr * 64 + cc * 2; return st * 1024 + (ob ^ (((ob >> 9) & 1) << 5)); }
__device__ __forceinline__ void stage_rc(int b, int& R, int& C) { const int st = b / 1024, sb = b % 1024, swz = sb ^ (((sb >> 9) & 1) << 5); R = (st >> 1) * 16 + swz / 64; C = (st & 1) * 32 + (swz % 64) / 2; }
__device__ __forceinline__ int perm32(int rho) { const int n = rho >> 4, i = rho & 15; return 8 * (i >> 2) + 4 * n + (i & 3); }

struct Unit { const char* A; const char* B; int r0, c0, aux; };

struct DenseSched {
    const char* A; const char* B; int nM, nN, nwg, G, c; size_t tstep;
    __device__ __forceinline__ void init(const void* A_, const void* B_, int M, int N, int K, int G_, int c_) { A = (const char*)A_; B = (const char*)B_; nM = M / BM; nN = N / BM; nwg = nM * nN; G = G_; c = c_; tstep = (size_t)BM * K * 2; }
    __device__ __forceinline__ bool next(int i, Unit& u) const {
        const long L = (long)i * G + c; if (L >= nwg) return false;
        int wgid = (int)L; { const int q = nwg / NXCD, r = nwg % NXCD, xcd = wgid % NXCD, off = wgid / NXCD; wgid = (xcd < r ? xcd * (q + 1) : r * (q + 1) + (xcd - r) * q) + off; }
        const int nig = WGM * nN, gid = wgid / nig, fm = gid * WGM, gsz = (nM - fm) < WGM ? (nM - fm) : WGM;
        const int pm = fm + ((wgid % nig) % gsz), pn = (wgid % nig) / gsz;
        u.A = A + (size_t)pm * tstep; u.B = B + (size_t)pn * tstep; u.r0 = pm * BM; u.c0 = pn * BM; u.aux = 0; return true;
    }
    __device__ __forceinline__ void lane_off(const Unit&, int, int, int, int, unsigned (&)[2][2]) const {}
};

template <bool GATHER, bool PERM, class Sched, class Epi>
__device__ __forceinline__ void gemm_phase(LAS unsigned char* lds, const int K_, const Sched& S, const Epi& E) {
    int K = K_; asm volatile("" : "+s"(K));
    const int tid = opaque_tid(), wid = __builtin_amdgcn_readfirstlane(tid >> 6), lane = tid & 63, wr = wid >> 2, wc = wid & 3, fr = lane & 15, fq = lane >> 4;
    const int nt = K / BK;
    unsigned voffA[2], voffB[2]; int sR[2], sC[2];
#pragma unroll
    for (int i = 0; i < 2; ++i) { int R, C; stage_rc(tid * 16 + i * 8192, R, C); const int Rb = PERM ? ((R & ~31) + perm32(R & 31)) : R;
        voffA[i] = (unsigned)(R * K + C) * 2u; voffB[i] = (unsigned)(Rb * K + C) * 2u; sR[i] = R; sC[i] = C; }
    const size_t kstep = (size_t)(BK * 2);
    const size_t hstep = (size_t)HALF * K * 2;
    const unsigned ldsw = (unsigned)wid * 1024u;
    const int aoff = lds_byte(wr * 64 + fr, fq * 8), boff = lds_byte(wc * 32 + fr, fq * 8);
    unsigned cvo[2][2] = {{0u, 0u}, {0u, 0u}}, nvo[2][2] = {{0u, 0u}, {0u, 0u}};
#define GP_SA(b, h) (((b) * 2 + (h)) * HTB)
#define GP_SB(b, h) ((4 + (b) * 2 + (h)) * HTB)
#define GP_GLDS(gp_, lp_) __builtin_amdgcn_global_load_lds((const unsigned*)(gp_), (LAS unsigned*)(lp_), 16, 0, 0)
#define GP_STAGE_B(bufoff, gbase, h) do { const char* _g = (gbase) + (size_t)(h) * hstep; \
        GP_GLDS(_g + voffB[0], lds + (bufoff) + ldsw); GP_GLDS(_g + voffB[1], lds + (bufoff) + ldsw + 8192); } while (0)
#define GP_STAGE_A(bufoff, gbase, h, usenext) do { \
        if (GATHER) { const unsigned _o0 = (usenext) ? nvo[h][0] : cvo[h][0], _o1 = (usenext) ? nvo[h][1] : cvo[h][1]; \
            GP_GLDS((gbase) + _o0, lds + (bufoff) + ldsw); GP_GLDS((gbase) + _o1, lds + (bufoff) + ldsw + 8192); } \
        else { const char* _g = (gbase) + (size_t)(h) * hstep; GP_GLDS(_g + voffA[0], lds + (bufoff) + ldsw); GP_GLDS(_g + voffA[1], lds + (bufoff) + ldsw + 8192); } } while (0)
#define GP_LDA(dst, b, h) do { _Pragma("unroll") for (int m = 0; m < 4; ++m) _Pragma("unroll") for (int k = 0; k < 2; ++k) dst[m][k] = *(const LAS bf16x8*)(lds + GP_SA(b, h) + aoff + m * 2048 + k * 1024); } while (0)
#define GP_LDB(dst, b, h) do { _Pragma("unroll") for (int n = 0; n < 2; ++n) _Pragma("unroll") for (int k = 0; k < 2; ++k) dst[n][k] = *(const LAS bf16x8*)(lds + GP_SB(b, h) + boff + n * 2048 + k * 1024); } while (0)
#define GP_MMA(ai, bj, At, Bt) do { __builtin_amdgcn_s_setprio(1); _Pragma("unroll") for (int m = 0; m < 4; ++m) _Pragma("unroll") for (int n = 0; n < 2; ++n) _Pragma("unroll") for (int k = 0; k < 2; ++k) \
        acc[ai][bj][m][n] = __builtin_amdgcn_mfma_f32_16x16x32_bf16(Bt[n][k], At[m][k], acc[ai][bj][m][n], 0, 0, 0); __builtin_amdgcn_s_setprio(0); } while (0)
#define GP_WAIT_V(n) asm volatile("s_waitcnt vmcnt(" #n ")" ::: "memory")
#define GP_WAIT_L(n) asm volatile("s_waitcnt lgkmcnt(" #n ")" ::: "memory")
#define GP_BAR __builtin_amdgcn_s_barrier()
#define GP_SCHED __builtin_amdgcn_sched_barrier(0)
    Unit cur, nxt; int ui = 0;
    if (!S.next(0, cur)) return;
    f32x4 acc[2][2][4][2];
#pragma unroll
    for (int a = 0; a < 2; ++a)
#pragma unroll
        for (int b = 0; b < 2; ++b)
#pragma unroll
            for (int m = 0; m < 4; ++m)
#pragma unroll
                for (int n = 0; n < 2; ++n) acc[a][b][m][n] = (f32x4){0.f, 0.f, 0.f, 0.f};
    bf16x8 At[4][2], B0[2][2], B1[2][2];
    if (GATHER) S.lane_off(cur, sR[0], sR[1], sC[0], sC[1], cvo);
    const char* cA = cur.A; const char* cB = cur.B;
    GP_STAGE_B(GP_SB(0, 0), cB, 0); GP_STAGE_A(GP_SA(0, 0), cA, 0, false); GP_STAGE_B(GP_SB(0, 1), cB, 1); GP_STAGE_A(GP_SA(0, 1), cA, 1, false);
    if (wr == 1) GP_BAR;
    GP_WAIT_V(4); GP_BAR;
    GP_STAGE_B(GP_SB(1, 0), cB + kstep, 0); GP_STAGE_A(GP_SA(1, 0), cA + kstep, 0, false); GP_STAGE_B(GP_SB(1, 1), cB + kstep, 1);
    GP_WAIT_V(6); GP_BAR;
    for (;;) {
        const bool has_next = S.next(ui + 1, nxt);
        if (GATHER && has_next) S.lane_off(nxt, sR[0], sR[1], sC[0], sC[1], nvo);
        const char* nA = has_next ? nxt.A : cA; const char* nB = has_next ? nxt.B : cB;
        for (int t = 0; t < nt; t += 2) {
            const bool last = (t == nt - 2);
            const bool un = last && has_next;
            const char* a1 = cA + (size_t)(t + 1) * kstep;
            const char* a2 = last ? nA : cA + (size_t)(t + 2) * kstep; const char* b2 = last ? nB : cB + (size_t)(t + 2) * kstep;
            const char* a3 = a2 + kstep; const char* b3 = b2 + kstep;
            GP_LDB(B0, 0, 0); GP_SCHED; GP_LDA(At, 0, 0); GP_STAGE_A(GP_SA(1, 1), a1, 1, false);
            GP_WAIT_L(8); GP_BAR; GP_WAIT_L(0); GP_MMA(0, 0, At, B0); GP_BAR; GP_SCHED;
            GP_LDB(B1, 0, 1); GP_STAGE_B(GP_SB(0, 0), b2, 0);
            GP_BAR; GP_WAIT_L(0); GP_MMA(0, 1, At, B1); GP_BAR;
            GP_LDA(At, 0, 1); GP_STAGE_A(GP_SA(0, 0), a2, 0, un);
            GP_BAR; GP_WAIT_L(0); GP_MMA(1, 0, At, B0); GP_BAR; GP_SCHED;
            GP_STAGE_B(GP_SB(0, 1), b2, 1);
            GP_WAIT_V(6); GP_BAR; GP_MMA(1, 1, At, B1); GP_BAR;
            GP_LDB(B0, 1, 0); GP_SCHED; GP_LDA(At, 1, 0); GP_STAGE_A(GP_SA(0, 1), a2, 1, un);
            GP_WAIT_L(8); GP_BAR; GP_WAIT_L(0); GP_MMA(0, 0, At, B0); GP_BAR; GP_SCHED;
            GP_LDB(B1, 1, 1); GP_STAGE_B(GP_SB(1, 0), b3, 0);
            GP_BAR; GP_WAIT_L(0); GP_MMA(0, 1, At, B1); GP_BAR;
            GP_LDA(At, 1, 1); GP_STAGE_A(GP_SA(1, 0), a3, 0, un);
            GP_BAR; GP_WAIT_L(0); GP_MMA(1, 0, At, B0); GP_BAR; GP_SCHED;
            GP_STAGE_B(GP_SB(1, 1), b3, 1);
            GP_WAIT_V(6); GP_BAR; GP_MMA(1, 1, At, B1); GP_BAR;
        }
        E(acc, cur, wr, wc, fr, fq);
        if (!has_next) break;
#pragma unroll
        for (int a = 0; a < 2; ++a)
#pragma unroll
            for (int b = 0; b < 2; ++b)
#pragma unroll
                for (int m = 0; m < 4; ++m)
#pragma unroll
                    for (int n = 0; n < 2; ++n) acc[a][b][m][n] = (f32x4){0.f, 0.f, 0.f, 0.f};
        cur = nxt; cA = nA; cB = nB; ++ui;
        if (GATHER) { cvo[0][0] = nvo[0][0]; cvo[0][1] = nvo[0][1]; cvo[1][0] = nvo[1][0]; cvo[1][1] = nvo[1][1]; }
    }
    GP_WAIT_V(0);
    if (wr == 0) GP_BAR;
    GP_BAR;
#undef GP_SA
#undef GP_SB
#undef GP_GLDS
#undef GP_STAGE_A
#undef GP_STAGE_B
#undef GP_LDA
#undef GP_LDB
#undef GP_MMA
#undef GP_WAIT_V
#undef GP_WAIT_L
#undef GP_BAR
#undef GP_SCHED
}

struct EpiF32 {
    float* C; int ldc;
    __device__ __forceinline__ void operator()(const f32x4 (&acc)[2][2][4][2], const Unit& u, int wr, int wc, int fr, int fq) const {
        const int row0 = u.r0 + wr * 64 + fr, col0 = u.c0 + wc * 32 + 4 * fq;
#pragma unroll
        for (int ai = 0; ai < 2; ++ai)
#pragma unroll
            for (int m = 0; m < 4; ++m) { float* rowp = C + (size_t)(row0 + ai * HALF + m * 16) * ldc + col0;
#pragma unroll
                for (int bj = 0; bj < 2; ++bj)
#pragma unroll
                    for (int n = 0; n < 2; ++n) *(f32x4*)(rowp + bj * HALF + n * 16) = acc[ai][bj][m][n];
                __builtin_amdgcn_sched_barrier(0); }
    }
};
struct EpiBf16 {
    bf16_t* O; int ldc;
    __device__ __forceinline__ void operator()(const f32x4 (&acc)[2][2][4][2], const Unit& u, int wr, int wc, int fr, int fq) const {
        const int row0 = u.r0 + wr * 64 + fr, col0 = u.c0 + wc * 32 + 8 * fq;
#pragma unroll
        for (int ai = 0; ai < 2; ++ai)
#pragma unroll
            for (int m = 0; m < 4; ++m) { bf16_t* rowp = O + (size_t)(row0 + ai * HALF + m * 16) * ldc + col0;
#pragma unroll
                for (int bj = 0; bj < 2; ++bj) { const f32x4 v0 = acc[ai][bj][m][0], v1 = acc[ai][bj][m][1];
                    u32x4 w; w.x = cvt_pk_bf16(v0[0], v0[1]); w.y = cvt_pk_bf16(v0[2], v0[3]); w.z = cvt_pk_bf16(v1[0], v1[1]); w.w = cvt_pk_bf16(v1[2], v1[3]);
                    *(u32x4*)(rowp + bj * HALF) = w; }
                __builtin_amdgcn_sched_barrier(0); }
    }
};
}

__device__ __forceinline__ void ph_modin(KP p, int l, int bid, int nb) {
    const int tid = opaque_tid(), lane = tid & 63, wv = tid >> 6;
    const bool even = (l & 1) == 0;
    bf16_t* U = (bf16_t*)(p->ws + OFF_U);
    float* G = (float*)(p->ws + OFF_G);
    const float* wg = p->in[I_EWIN] + (size_t)(l >> 1) * 1024 * EVEN_N + 1536;
    #pragma unroll 1
    for (int tok = bid * 8 + wv; tok < NT; tok += nb * 8) {
        const float* h = hrow(p, tok);
        const float* m = modrow(p, l, tok);
        float ga[16];
#pragma unroll
        for (int j = 0; j < 16; ++j) ga[j] = 0.f;
#pragma unroll
        for (int c = 0; c < 4; ++c) {
            const int d = 4 * (lane + 64 * c);
            const float4 hv = *(const float4*)(h + d), sh = *(const float4*)(m + d), sc = *(const float4*)(m + 1024 + d);
            const float u0 = hv.x * (1.f + sc.x) + sh.x, u1 = hv.y * (1.f + sc.y) + sh.y, u2 = hv.z * (1.f + sc.z) + sh.z, u3 = hv.w * (1.f + sc.w) + sh.w;
            *(uint2*)(U + (size_t)tok * DM + d) = make_uint2(cvt_pk_bf16(u0, u1), cvt_pk_bf16(u2, u3));
            if (even) {
                const float uu[4] = {u0, u1, u2, u3};
#pragma unroll
                for (int q = 0; q < 4; ++q) {
                    const float4* wr = (const float4*)(wg + (size_t)(d + q) * EVEN_N);
#pragma unroll
                    for (int j4 = 0; j4 < 4; ++j4) { const float4 w = wr[j4]; ga[4 * j4] += uu[q] * w.x; ga[4 * j4 + 1] += uu[q] * w.y; ga[4 * j4 + 2] += uu[q] * w.z; ga[4 * j4 + 3] += uu[q] * w.w; }
                }
            }
        }
        if (even) {
            float mine = 0.f;
#pragma unroll
            for (int j = 0; j < 16; ++j) { const float s = wave_sum(ga[j]); if (lane == j) mine = s; }
            if (lane < 16) G[(size_t)tok * 16 + lane] = mine;
        }
    }
}

__device__ __forceinline__ void ph_gemm_in(KP p, int l, int bid, int nb, LAS unsigned char* lds) {
    const int N = ((l & 1) == 0) ? EVEN_LD : ODD_LD;
    gp::DenseSched S; S.init(p->ws + OFF_U, p->ws + OFF_WIN, NT, N, 1024, nb, bid);
    gp::EpiBf16 E{(bf16_t*)(p->ws + OFF_BIG), N};
    gp::gemm_phase<false, true>(lds, 1024, S, E);
}
__device__ __forceinline__ void ph_gemm_out(KP p, int l, int bid, int nb, LAS unsigned char* lds) {
    gp::DenseSched S; S.init(p->ws + OFF_U, p->ws + OFF_WOUT, NT, 1024, 1024, nb, bid);
    gp::EpiF32 E{(float*)(p->ws + OFF_BIG), 1024};
    gp::gemm_phase<false, false>(lds, 1024, S, E);
}


namespace sc {
typedef short bf16x8 __attribute__((ext_vector_type(8)));
typedef short bf16x4 __attribute__((ext_vector_type(4)));
typedef float f32x4 __attribute__((ext_vector_type(4)));
#define SC_MFMA(a, b, c) __builtin_amdgcn_mfma_f32_16x16x32_bf16(a, b, c, 0, 0, 0)
__device__ __forceinline__ bf16x8 rd_row(unsigned img, int row, int stride, int k0) { return *(const LAS bf16x8*)(size_t)(img + (unsigned)(row * stride + k0 * 2)); }
__device__ __forceinline__ bf16x8 rd_tr(unsigned img, int k0, int n0, int stride, int lane) {
    const int g = lane >> 4, i = lane & 15;
    const unsigned a0 = img + (unsigned)((k0 + 8 * g + (i >> 2)) * stride + (n0 + 4 * (i & 3)) * 2), a1 = a0 + 4u * (unsigned)stride;
    bf16x4 lo, hi;
    asm volatile("ds_read_b64_tr_b16 %0, %2\n\tds_read_b64_tr_b16 %1, %3\n\ts_waitcnt lgkmcnt(0)" : "=&v"(lo), "=&v"(hi) : "v"(a0), "v"(a1) : "memory");
    return (bf16x8){lo[0], lo[1], lo[2], lo[3], hi[0], hi[1], hi[2], hi[3]};
}
typedef unsigned u32x2_ __attribute__((ext_vector_type(2)));
typedef unsigned u32x4_ __attribute__((ext_vector_type(4)));
__device__ __forceinline__ void st8(unsigned addr, uint2 v) { *(LAS u32x2_*)(size_t)addr = (u32x2_){v.x, v.y}; }
__device__ __forceinline__ void st16(unsigned addr, uint4 v) { *(LAS u32x4_*)(size_t)addr = (u32x4_){v.x, v.y, v.z, v.w}; }
__device__ __forceinline__ float scan_add64(float v, int lane) {
#pragma unroll
    for (int o = 1; o < 64; o <<= 1) { const float t = __shfl_up(v, o, 64); if (lane >= o) v += t; }
    return v;
}
__device__ __forceinline__ float scan_max64(float v, int lane) {
#pragma unroll
    for (int o = 1; o < 64; o <<= 1) { const float t = __shfl_up(v, o, 64); if (lane >= o) v = fmaxf(v, t); }
    return v;
}

template <int MODE>
__device__ __forceinline__ void scan_item(KP p, int l, int b, int h, int dir, int vs) {
    constexpr int CS = (MODE == 1) ? 32 : 64, DK = (MODE == 0) ? 64 : 128, EXT = (MODE == 0) ? 1 : 0;
    constexpr int QS = (DK + 8) * 2, VS = (64 + 16 * EXT + 8) * 2, SS = (CS + 8) * 2, NVR = 64 + 16 * EXT;
    constexpr int NCH = (CTXL + SEQ) / CS;
    constexpr int LD = (MODE == 2) ? ODD_LD : EVEN_LD;
    constexpr unsigned O_QA = 0, O_KA = O_QA + CS * QS, O_QB = O_KA + CS * QS, O_KW = O_QB + (MODE == 1 ? CS * QS : 0), O_V = O_KW + CS * QS,
                       O_SSC = O_V + CS * VS, O_ST = O_SSC + CS * SS, O_DKV = O_ST + 2 * NVR * QS, O_END = O_DKV + 512;
    static_assert(O_END <= 131072, "scan LDS");
    const int tid = opaque_tid(), lane = tid & 63, wv = __builtin_amdgcn_readfirstlane(tid >> 6), r16 = lane & 15, q4 = lane >> 4;
    const unsigned L0 = (unsigned)(size_t)smraw_base();
    const bf16_t* P = (const bf16_t*)(p->ws + OFF_BIG);
    bf16_t* HXo = (bf16_t*)(p->ws + OFF_AUX) + (size_t)dir * NT * 1024;
    const int e2 = l >> 1;
    const int cQ = (MODE == 0) ? E_MQ + h * 64 : (MODE == 1) ? E_HQ + h * 128 : 1536 + h * 128;
    const int cK = (MODE == 0) ? E_MK + h * 64 : (MODE == 1) ? (dir ? E_HFB : E_HFF) + h * 128 : 2048 + h * 128;
    const int cV = (MODE == 0) ? E_MV + h * 128 + vs * 64 : (MODE == 1) ? E_HI + h * 128 + vs * 64 : 2560 + h * 128 + vs * 64;
    const int cO = (MODE == 0) ? h * 128 + vs * 64 : 512 + h * 128 + vs * 64;
    const int lt = (MODE == 1) ? (tid & 31) : (tid >> 3);
    const int lj = (MODE == 0) ? (tid & 7) : (MODE == 1) ? (tid >> 5) : ((tid >> 2) & 1) * 8 + (tid & 3);
    const int vt_ = tid >> 3, vj = tid & 7;
    float lbv[8]; float gbi = 0.f, gbf = 0.f, lg = 0.f;
    if (MODE == 1) {
        const float* lbp = (const float*)(p->ws + OFF_LB) + e2 * 512 + h * 128 + lj * 8;
#pragma unroll
        for (int i = 0; i < 8; ++i) lbv[i] = lbp[i];
    } else {
#pragma unroll
        for (int i = 0; i < 8; ++i) lbv[i] = 0.f;
    }
    if (MODE == 0) { const float* gb = p->in[I_MGB] + e2 * 16; gbi = gb[(dir ? 2 : 0) * 4 + h]; gbf = gb[(dir ? 3 : 1) * 4 + h]; }
    if (MODE == 2) lg = p->in[I_RLD][e2 * 8 + dir * 4 + h];
    const float* G = (const float*)(p->ws + OFF_G);
    const float* ropet = (const float*)(p->ws + OFF_ROPE);
    unsigned oz = 0u; asm volatile("" : "+v"(oz));
    for (unsigned o = tid * 16; o < 2u * NVR * QS; o += 512 * 16) st16(L0 + O_ST + o, make_uint4(oz, oz, oz, oz));
    if (EXT) { if (tid < CS) { st16(L0 + O_V + tid * VS + 128, make_uint4(0x3f80u | oz, oz, oz, oz)); st16(L0 + O_V + tid * VS + 144, make_uint4(oz, oz, oz, oz)); } }
    f32x4 sacc[4];
#pragma unroll
    for (int i = 0; i < 4; ++i) sacc[i] = (f32x4){0.f, 0.f, 0.f, 0.f};
    float m_in = -1e30f;
    uint4 rq0, rq1, rk0, rk1, rv; float rg0 = 0.f, rg1 = 0.f;
    rq1 = make_uint4(0u, 0u, 0u, 0u); rk1 = rq1;
    auto load_chunk = [&](int c) {
        const int i0 = c * CS;
        const int tq = scan_tok(b, i0 + lt, dir);
        const bf16_t* pr = P + (size_t)tq * LD;
        rq0 = *(const uint4*)(pr + cQ + lj * 8); rk0 = *(const uint4*)(pr + cK + lj * 8);
        if (MODE == 2) { rq1 = *(const uint4*)(pr + cQ + lj * 8 + 32); rk1 = *(const uint4*)(pr + cK + lj * 8 + 32); }
        if (MODE != 1 || tid < 256) { const int tv = scan_tok(b, i0 + vt_, dir); rv = *(const uint4*)(P + (size_t)tv * LD + cV + vj * 8); }
        if (MODE == 0) { const int tg = scan_tok(b, i0 + lane, dir); rg0 = G[(size_t)tg * 16 + (dir ? 8 : 0) + h]; rg1 = G[(size_t)tg * 16 + (dir ? 12 : 4) + h]; }
    };
    load_chunk(0);
#pragma unroll 1
    for (int c = 0; c < NCH; ++c) {
        const unsigned ST_R = L0 + O_ST + (unsigned)(c & 1) * NVR * QS, ST_W = L0 + O_ST + (unsigned)((c + 1) & 1) * NVR * QS;
        float sp = 1.f;
        float v_u = 0.f, v_M = 0.f, v_e = 1.f, v_low = 0.f, v_w = 1.f;
        if (MODE == 0) {
            const float ig = rg0 + gbi, fg = rg1 + gbf;
            const float lf = fminf(fg, 0.f) - log1pf(expf(-fabsf(fg)));
            const float bb = scan_add64(lf, lane);
            const float g = __shfl(bb, 63, 64);
            v_u = ig - bb;
            const float cu = scan_max64(v_u, lane);
            v_M = fmaxf(m_in, cu);
            const float m_new = fmaxf(g + m_in, g + __shfl(cu, 63, 64));
            sp = expf(g + m_in - m_new);
            v_w = expf(g + v_u - m_new);
            v_e = expf(m_in - v_M);
            v_low = expf(-(bb + v_M));
            m_in = m_new;
            st16(L0 + O_QA + lt * QS + lj * 16, rq0);
            st16(L0 + O_KA + lt * QS + lj * 16, rk0);
            const float wr = __shfl(v_w, lt, 64);
            uint4 kw; kw.x = cvt_pk_bf16(bflo(rk0.x) * wr, bfhi(rk0.x) * wr); kw.y = cvt_pk_bf16(bflo(rk0.y) * wr, bfhi(rk0.y) * wr);
            kw.z = cvt_pk_bf16(bflo(rk0.z) * wr, bfhi(rk0.z) * wr); kw.w = cvt_pk_bf16(bflo(rk0.w) * wr, bfhi(rk0.w) * wr);
            st16(L0 + O_KW + lt * QS + lj * 16, kw);
            st16(L0 + O_V + vt_ * VS + vj * 16, rv);
        } else if (MODE == 2) {
            sp = expf(64.f * lg);
            const bool lat = c >= CTXL / CS;
            float q[16], k[16];
            const unsigned qa[8] = {rq0.x, rq0.y, rq0.z, rq0.w, rq1.x, rq1.y, rq1.z, rq1.w}, ka[8] = {rk0.x, rk0.y, rk0.z, rk0.w, rk1.x, rk1.y, rk1.z, rk1.w};
#pragma unroll
            for (int i = 0; i < 8; ++i) { q[2 * i] = bflo(qa[i]); q[2 * i + 1] = bfhi(qa[i]); k[2 * i] = bflo(ka[i]); k[2 * i + 1] = bfhi(ka[i]); }
            if (lat) {
                const int tq = scan_tok(b, c * CS + lt, dir), tt = tq & (SEQ - 1);
                const int pos = ((tid >> 2) & 1) ? (tt & 63) : (tt >> 6);
                const float2* rt = (const float2*)ropet + pos * 32 + (tid & 3) * 8;
#pragma unroll
                for (int i = 0; i < 8; ++i) {
                    const float2 cs2 = rt[i];
                    const float q1 = q[i], q2 = q[8 + i], k1 = k[i], k2 = k[8 + i];
                    q[i] = q1 * cs2.x - q2 * cs2.y; q[8 + i] = q1 * cs2.y + q2 * cs2.x;
                    k[i] = k1 * cs2.x - k2 * cs2.y; k[8 + i] = k1 * cs2.y + k2 * cs2.x;
                }
            }
            const float wr = 0.08838834764831845f * expf((float)(63 - lt) * lg);
            uint4 o0, o1, w0, w1, x0, x1;
            o0.x = cvt_pk_bf16(q[0], q[1]); o0.y = cvt_pk_bf16(q[2], q[3]); o0.z = cvt_pk_bf16(q[4], q[5]); o0.w = cvt_pk_bf16(q[6], q[7]);
            o1.x = cvt_pk_bf16(q[8], q[9]); o1.y = cvt_pk_bf16(q[10], q[11]); o1.z = cvt_pk_bf16(q[12], q[13]); o1.w = cvt_pk_bf16(q[14], q[15]);
            w0.x = cvt_pk_bf16(k[0], k[1]); w0.y = cvt_pk_bf16(k[2], k[3]); w0.z = cvt_pk_bf16(k[4], k[5]); w0.w = cvt_pk_bf16(k[6], k[7]);
            w1.x = cvt_pk_bf16(k[8], k[9]); w1.y = cvt_pk_bf16(k[10], k[11]); w1.z = cvt_pk_bf16(k[12], k[13]); w1.w = cvt_pk_bf16(k[14], k[15]);
            x0.x = cvt_pk_bf16(k[0] * wr, k[1] * wr); x0.y = cvt_pk_bf16(k[2] * wr, k[3] * wr); x0.z = cvt_pk_bf16(k[4] * wr, k[5] * wr); x0.w = cvt_pk_bf16(k[6] * wr, k[7] * wr);
            x1.x = cvt_pk_bf16(k[8] * wr, k[9] * wr); x1.y = cvt_pk_bf16(k[10] * wr, k[11] * wr); x1.z = cvt_pk_bf16(k[12] * wr, k[13] * wr); x1.w = cvt_pk_bf16(k[14] * wr, k[15] * wr);
            st16(L0 + O_QA + lt * QS + lj * 16, o0); st16(L0 + O_QA + lt * QS + lj * 16 + 64, o1);
            st16(L0 + O_KA + lt * QS + lj * 16, w0); st16(L0 + O_KA + lt * QS + lj * 16 + 64, w1);
            st16(L0 + O_KW + lt * QS + lj * 16, x0); st16(L0 + O_KW + lt * QS + lj * 16 + 64, x1);
            st16(L0 + O_V + vt_ * VS + vj * 16, rv);
        } else {
            const unsigned qa[4] = {rq0.x, rq0.y, rq0.z, rq0.w}, fa[4] = {rk0.x, rk0.y, rk0.z, rk0.w};
            float qv[8], kk[8], A[8];
#pragma unroll
            for (int i = 0; i < 8; ++i) {
                const float qr = (i & 1) ? bfhi(qa[i >> 1]) : bflo(qa[i >> 1]), fr = (i & 1) ? bfhi(fa[i >> 1]) : bflo(fa[i >> 1]);
                const float f = lbv[i] + (1.f - lbv[i]) * sigmoidf_(fr);
                qv[i] = siluf_(qr); kk[i] = 1.f - f; A[i] = logf(f);
            }
#pragma unroll
            for (int o = 1; o < 32; o <<= 1)
#pragma unroll
                for (int i = 0; i < 8; ++i) { const float t = __shfl_up(A[i], o, 32); if (lt >= o) A[i] += t; }
            float qa_[8], qb_[8], ka_[8], kw_[8];
#pragma unroll
            for (int i = 0; i < 8; ++i) {
                const float am = __shfl(A[i], 15, 32), ae = __shfl(A[i], 31, 32);
                qa_[i] = qv[i] * expf(A[i] - am); qb_[i] = qv[i] * expf(A[i]); ka_[i] = kk[i] * expf(am - A[i]); kw_[i] = kk[i] * expf(ae - A[i]);
                if (lt == 31) *(LAS float*)(size_t)(L0 + O_DKV + (lj * 8 + i) * 4) = expf(ae);
            }
            uint4 w;
            w.x = cvt_pk_bf16(qa_[0], qa_[1]); w.y = cvt_pk_bf16(qa_[2], qa_[3]); w.z = cvt_pk_bf16(qa_[4], qa_[5]); w.w = cvt_pk_bf16(qa_[6], qa_[7]); st16(L0 + O_QA + lt * QS + lj * 16, w);
            w.x = cvt_pk_bf16(qb_[0], qb_[1]); w.y = cvt_pk_bf16(qb_[2], qb_[3]); w.z = cvt_pk_bf16(qb_[4], qb_[5]); w.w = cvt_pk_bf16(qb_[6], qb_[7]); st16(L0 + O_QB + lt * QS + lj * 16, w);
            w.x = cvt_pk_bf16(ka_[0], ka_[1]); w.y = cvt_pk_bf16(ka_[2], ka_[3]); w.z = cvt_pk_bf16(ka_[4], ka_[5]); w.w = cvt_pk_bf16(ka_[6], ka_[7]); st16(L0 + O_KA + lt * QS + lj * 16, w);
            w.x = cvt_pk_bf16(kw_[0], kw_[1]); w.y = cvt_pk_bf16(kw_[2], kw_[3]); w.z = cvt_pk_bf16(kw_[4], kw_[5]); w.w = cvt_pk_bf16(kw_[6], kw_[7]); st16(L0 + O_KW + lt * QS + lj * 16, w);
            if (tid < 256) st16(L0 + O_V + vt_ * VS + vj * 16, rv);
        }
        __syncthreads();
        if (c + 1 < NCH) load_chunk(c + 1);
        {
            constexpr int NT1 = CS / 16;
            const bool act = (MODE == 1) ? (wv < 4) : true;
            const int tb = (MODE == 1) ? (wv & 1) : (wv & 3);
#pragma unroll
            for (int u2 = 0; u2 < ((MODE == 1) ? 1 : 2); ++u2) {
                const int sb = (MODE == 1) ? (wv >> 1) : 2 * (wv >> 2) + u2;
                if (act) {
                    f32x4 d = (f32x4){0.f, 0.f, 0.f, 0.f};
                    if (sb <= tb) {
#pragma unroll
                        for (int kk2 = 0; kk2 < DK / 32; ++kk2)
                            d = SC_MFMA(rd_row(L0 + O_KA, sb * 16 + r16, QS, kk2 * 32 + q4 * 8), rd_row(L0 + O_QA, tb * 16 + r16, QS, kk2 * 32 + q4 * 8), d);
                        const int t = tb * 16 + r16, s0 = sb * 16 + q4 * 4;
                        if (MODE == 0) {
                            const float Mt = __shfl(v_M, t, 64);
#pragma unroll
                            for (int jj = 0; jj < 4; ++jj) { const float us = __shfl(v_u, s0 + jj, 64); d[jj] = (s0 + jj <= t) ? d[jj] * 0.125f * expf(us - Mt) : 0.f; }
                        } else if (MODE == 2) {
#pragma unroll
                            for (int jj = 0; jj < 4; ++jj) d[jj] = (s0 + jj <= t) ? d[jj] * 0.08838834764831845f * expf((float)(t - s0 - jj) * lg) : 0.f;
                        } else {
#pragma unroll
                            for (int jj = 0; jj < 4; ++jj) d[jj] = (s0 + jj <= t) ? d[jj] : 0.f;
                        }
                    }
                    st8(L0 + O_SSC + (tb * 16 + r16) * SS + (sb * 16 + q4 * 4) * 2, make_uint2(cvt_pk_bf16(d[0], d[1]), cvt_pk_bf16(d[2], d[3])));
                }
            }
            (void)NT1;
        }
        __syncthreads();
        {
            const int tb = (MODE == 1) ? (wv & 1) : (wv & 3);
            const int t = tb * 16 + r16;
            const int tok = scan_tok(b, c * CS + t, dir);
            constexpr int NV = (MODE == 1) ? 1 : 2;
            f32x4 oi[NV + EXT], oo[NV + EXT];
#pragma unroll
            for (int u2 = 0; u2 < NV + EXT; ++u2) {
                const int vt = (u2 == NV) ? 4 : ((MODE == 1) ? (wv >> 1) : 2 * (wv >> 2) + u2);
                f32x4 a1 = (f32x4){0.f, 0.f, 0.f, 0.f}, a2 = a1;
#pragma unroll
                for (int sb2 = 0; sb2 < CS / 32; ++sb2)
                    a1 = SC_MFMA(rd_tr(L0 + O_V, sb2 * 32, vt * 16, VS, lane), rd_row(L0 + O_SSC, t, SS, sb2 * 32 + q4 * 8), a1);
#pragma unroll
                for (int kk2 = 0; kk2 < DK / 32; ++kk2)
                    a2 = SC_MFMA(rd_row(ST_R, vt * 16 + r16, QS, kk2 * 32 + q4 * 8), rd_row(L0 + ((MODE == 1) ? O_QB : O_QA), t, QS, kk2 * 32 + q4 * 8), a2);
                oi[u2] = a1; oo[u2] = a2;
            }
            float den = 1.f, ei = 1.f;
            if (MODE == 0) {
                ei = 0.125f * __shfl(v_e, t, 64);
                const float dsum = oi[NV][0] + ei * oo[NV][0];
                const float dd = __shfl(dsum, r16, 64);
                den = 1.f / fmaxf(fabsf(dd), __shfl(v_low, t, 64));
            } else if (MODE == 2) {
                ei = expf((float)(t + 1) * lg);
            }
#pragma unroll
            for (int u2 = 0; u2 < NV; ++u2) {
                const int vt = (MODE == 1) ? (wv >> 1) : 2 * (wv >> 2) + u2;
                float o[4];
#pragma unroll
                for (int jj = 0; jj < 4; ++jj) o[jj] = (oi[u2][jj] + ei * oo[u2][jj]) * den;
                *(uint2*)(HXo + (size_t)tok * 1024 + cO + vt * 16 + q4 * 4) = make_uint2(cvt_pk_bf16(o[0], o[1]), cvt_pk_bf16(o[2], o[3]));
            }
        }
        {
            constexpr int NS = (MODE == 0) ? 3 : 4;
            const int kt = (MODE == 0) ? (wv & 3) : wv;
            float dk[4] = {sp, sp, sp, sp};
            if (MODE == 1) { const f32x4 dv = *(const LAS f32x4*)(size_t)(L0 + O_DKV + (kt * 16 + q4 * 4) * 4); dk[0] = dv[0]; dk[1] = dv[1]; dk[2] = dv[2]; dk[3] = dv[3]; }
#pragma unroll
            for (int u2 = 0; u2 < NS; ++u2) {
                const int vt = (MODE == 0) ? ((u2 == 2) ? 4 : 2 * (wv >> 2) + u2) : u2;
                f32x4 a = sacc[u2];
#pragma unroll
                for (int jj = 0; jj < 4; ++jj) a[jj] *= dk[jj];
#pragma unroll
                for (int sb2 = 0; sb2 < CS / 32; ++sb2)
                    a = SC_MFMA(rd_tr(L0 + O_KW, sb2 * 32, kt * 16, QS, lane), rd_tr(L0 + O_V, sb2 * 32, vt * 16, VS, lane), a);
                sacc[u2] = a;
                st8(ST_W + (vt * 16 + r16) * QS + (kt * 16 + q4 * 4) * 2, make_uint2(cvt_pk_bf16(a[0], a[1]), cvt_pk_bf16(a[2], a[3])));
            }
        }
        __syncthreads();
    }
}
}

__device__ __forceinline__ void ph_scan_even2(KP p, int l, int bid, int nb) {
#pragma unroll 1
    for (int item = bid; item < 256; item += nb) {
        const int kind = item >> 7, b = (item >> 4) & 7, h = (item >> 2) & 3, dir = (item >> 1) & 1, vs = item & 1;
        if (kind == 0) sc::scan_item<0>(p, l, b, h, dir, vs); else sc::scan_item<1>(p, l, b, h, dir, vs);
        __syncthreads();
    }
}
__device__ __forceinline__ void ph_scan_odd2(KP p, int l, int bid, int nb) {
#pragma unroll 1
    for (int item = bid; item < 128; item += nb) {
        const int b = (item >> 4) & 7, h = (item >> 2) & 3, dir = (item >> 1) & 1, vs = item & 1;
        sc::scan_item<2>(p, l, b, h, dir, vs);
        __syncthreads();
    }
}

__device__ __forceinline__ void ph_normgate_even(KP p, int l, int bid, int nb) {
    const int tid = opaque_tid(), lane = tid & 63, wv = tid >> 6;
    const bf16_t* P = (const bf16_t*)(p->ws + OFF_BIG);
    const bf16_t* HX = (const bf16_t*)(p->ws + OFF_AUX);
    const bf16_t* HX1 = HX + (size_t)NT * 1024;
    bf16_t* MIX = (bf16_t*)(p->ws + OFF_U);
    const int e = l >> 1;
    #pragma unroll 1
    for (int it = bid * 8 + wv; it < NT * 8; it += nb * 8) {
        const int tok = it >> 3, g = it & 7;
        const size_t hxo = (size_t)tok * 1024 + g * 128;
        float x0 = bf2f(HX[hxo + lane]) + bf2f(HX1[hxo + lane]), x1 = bf2f(HX[hxo + lane + 64]) + bf2f(HX1[hxo + lane + 64]);
        const bf16_t* pr = P + (size_t)tok * EVEN_LD;
        if (g < 4) {
            const float mean = wave_sum(x0 + x1) * (1.f / 128.f);
            x0 -= mean; x1 -= mean;
            const float var = wave_sum(x0 * x0 + x1 * x1) * (1.f / 128.f);
            const float r = rsqrtf(var + LN_EPS);
            const float* nw = p->in[I_MNW] + e * 512 + g * 128;
            const float o0 = ldf(pr + E_MO + g * 128 + lane), o1 = ldf(pr + E_MO + g * 128 + lane + 64);
            stf(MIX + (size_t)tok * DM + g * 128 + lane, x0 * r * nw[lane] * sigmoidf_(o0));
            stf(MIX + (size_t)tok * DM + g * 128 + lane + 64, x1 * r * nw[lane + 64] * sigmoidf_(o1));
        } else {
            const int h = g - 4;
            const float ms = wave_sum(x0 * x0 + x1 * x1) * (1.f / 128.f);
            const float r = rsqrtf(ms + LN_EPS);
            const float* nw = p->in[I_HNW] + e * 512 + h * 128;
            const float g0 = ldf(pr + E_HG + h * 128 + lane), g1 = ldf(pr + E_HG + h * 128 + lane + 64);
            stf(MIX + (size_t)tok * DM + 512 + h * 128 + lane, x0 * r * nw[lane] * siluf_(g0));
            stf(MIX + (size_t)tok * DM + 512 + h * 128 + lane + 64, x1 * r * nw[lane + 64] * siluf_(g1));
        }
    }
}


#define OFF_UT   (OFF_AUX + 136 * MiB)
#define OFF_FK   (OFF_UT + 102 * MiB)
#define OFF_FKC  (OFF_FK + 32 * MiB)
#define OFF_ZOT  (OFF_FKC + 2 * MiB)

__device__ __forceinline__ void ph_hy_filt2(KP p, int l, int bid, int nb, float* sm) {
    const int tid = opaque_tid(), o = l >> 1;
    float* zf = sm;
    float* h1 = sm + 1024;
    float* h2 = sm + 2048;
    float* h3 = sm + 3072;
    const float* fw1 = p->in[I_HW1] + o * 33 * 64; const float* fb1 = p->in[I_HB1] + o * 64;
    const float* fw2 = p->in[I_HW2] + o * 64 * 64; const float* fb2 = p->in[I_HB2] + o * 64;
    const float* fw3 = p->in[I_HW3] + o * 64 * 64; const float* fb3 = p->in[I_HB3] + o * 64;
    const float* freq = p->in[I_HFREQ] + o * 64;
    const float* wout = p->in[I_HWOUT] + (size_t)o * 64 * 2048;
    float* FK = (float*)(p->ws + OFF_FK); float* FKC = (float*)(p->ws + OFF_FKC);
#pragma unroll 1
    for (int item = bid; item < (SEQ + CTXL) / 16; item += nb) {
        const bool isctx = item >= SEQ / 16;
        const int L = isctx ? CTXL : SEQ, pos0 = (isctx ? item - SEQ / 16 : item) * 16;
        __syncthreads();
        if (tid < 16 * 17) {
            const int pp = tid / 17, j = tid % 17, pos = pos0 + pp;
            if (j == 16) zf[pp * 36] = (float)pos / (float)(L - 1);
            else { const float f = 1e-4f + (float)j * ((15.0f - 1e-4f) / 15.0f); const float w = 2.0f * 3.14159265358979323846f * (float)pos / (float)L * f; zf[pp * 36 + 1 + j] = cosf(w); zf[pp * 36 + 17 + j] = sinf(w); }
        }
        __syncthreads();
        const int pp = tid >> 5, u0 = (tid & 31) * 2;
        { float a0 = fb1[u0], a1 = fb1[u0 + 1];
#pragma unroll 1
          for (int k = 0; k < 33; ++k) { const float z = zf[pp * 36 + k]; a0 += z * fw1[k * 64 + u0]; a1 += z * fw1[k * 64 + u0 + 1]; }
          h1[pp * 64 + u0] = sinf(freq[u0] * a0); h1[pp * 64 + u0 + 1] = sinf(freq[u0 + 1] * a1); }
        __syncthreads();
        { float a0 = fb2[u0], a1 = fb2[u0 + 1];
#pragma unroll 4
          for (int k = 0; k < 64; ++k) { const float z = h1[pp * 64 + k]; a0 += z * fw2[k * 64 + u0]; a1 += z * fw2[k * 64 + u0 + 1]; }
          h2[pp * 64 + u0] = sinf(freq[u0] * a0); h2[pp * 64 + u0 + 1] = sinf(freq[u0 + 1] * a1); }
        __syncthreads();
        { float a0 = fb3[u0], a1 = fb3[u0 + 1];
#pragma unroll 4
          for (int k = 0; k < 64; ++k) { const float z = h2[pp * 64 + k]; a0 += z * fw3[k * 64 + u0]; a1 += z * fw3[k * 64 + u0 + 1]; }
          h3[pp * 64 + u0] = sinf(freq[u0] * a0); h3[pp * 64 + u0 + 1] = sinf(freq[u0 + 1] * a1); }
        __syncthreads();
#pragma unroll 1
        for (int r = 0; r < 4; ++r) {
            const int col = tid + 512 * r, c = col & 511, od = col >> 9, order = od >> 1, dirn = od & 1;
            float a[16];
#pragma unroll
            for (int i = 0; i < 16; ++i) a[i] = 0.f;
#pragma unroll 2
            for (int k = 0; k < 64; ++k) { const float w = wout[k * 2048 + col];
#pragma unroll
                for (int i = 0; i < 16; ++i) a[i] += h3[i * 64 + k] * w; }
            const float delta = 3.0701134573253944f + (float)c * ((15.350567286626972f - 3.0701134573253944f) / 511.0f);
#pragma unroll
            for (int i = 0; i < 16; ++i) a[i] *= expf(-((float)(pos0 + i) / (float)(L - 1)) * delta);
            float* dst = isctx ? FKC + ((size_t)order * 512 + c) * 512 + 256 : FK + ((size_t)order * 512 + c) * 8192 + 4096;
            if (dirn == 0) {
#pragma unroll
                for (int i = 0; i < 16; i += 4) *(float4*)(dst + pos0 + i) = make_float4(a[i], a[i + 1], a[i + 2], a[i + 3]);
            } else {
#pragma unroll
                for (int i = 0; i < 16; ++i) if (pos0 + i > 0) dst[-(pos0 + i)] = a[i];
                if (pos0 == 0) dst[-L] = 0.f;
            }
        }
    }
}

__device__ __forceinline__ void ph_hy_prep(KP p, int l, int bid, int nb, float* sm) {
    const int tid = opaque_tid(), o = l >> 1;
    const bf16_t* P = (const bf16_t*)(p->ws + OFF_BIG);
    bf16_t* UT = (bf16_t*)(p->ws + OFF_UT);
    const float* cw = p->in[I_HCW] + o * 3 * 1536; const float* cb = p->in[I_HCB] + o * 1536;
    float* tile = sm;
#pragma unroll 1
    for (int item = bid; item < (NT / 256) * 96; item += nb) {
        const int tt = item / 96, ct = item % 96, tok0 = tt * 256, col0 = ct * 16;
        const bool lat = tok0 < NL;
        const int L = lat ? SEQ : CTXL, t0 = lat ? (tok0 & (SEQ - 1)) : ((tok0 - NL) & (CTXL - 1));
        __syncthreads();
        for (int i = tid; i < 258 * 2; i += 512) {
            const int rr = i >> 1, hf = i & 1, t = t0 + rr - 1;
            uint4 v = make_uint4(0u, 0u, 0u, 0u);
            if (t >= 0 && t < L) v = *(const uint4*)(P + (size_t)(tok0 + rr - 1) * ODD_LD + col0 + hf * 8);
            float* d = tile + rr * 17 + hf * 8;
            d[0] = bflo(v.x); d[1] = bfhi(v.x); d[2] = bflo(v.y); d[3] = bfhi(v.y); d[4] = bflo(v.z); d[5] = bfhi(v.z); d[6] = bflo(v.w); d[7] = bfhi(v.w);
        }
        __syncthreads();
        const int cc = tid >> 5, tc = (tid & 31) * 8, col = col0 + cc;
        const float w0 = cw[col], w1 = cw[1536 + col], w2 = cw[3072 + col], bb = cb[col];
        float y[8];
#pragma unroll
        for (int i = 0; i < 8; ++i) y[i] = tile[(tc + i) * 17 + cc] * w0 + tile[(tc + i + 1) * 17 + cc] * w1 + tile[(tc + i + 2) * 17 + cc] * w2 + bb;
        *(uint4*)(UT + (size_t)col * NT + tok0 + tc) = make_uint4(cvt_pk_bf16(y[0], y[1]), cvt_pk_bf16(y[2], y[3]), cvt_pk_bf16(y[4], y[5]), cvt_pk_bf16(y[6], y[7]));
    }
}

__device__ __forceinline__ void hy_item_lat(KP p, int l, int c) {
    constexpr int ZSB = (SEQ + 8) * 2;
    constexpr unsigned O_Z = 0, O_KF = O_Z + 8 * ZSB, O_T = O_KF + 8192 * 4, O_END = O_T + 2 * 64 * 144;
    static_assert(O_END <= 131072, "hyena LDS");
    const int tid = opaque_tid(), lane = tid & 63, wv = __builtin_amdgcn_readfirstlane(tid >> 6), r16 = lane & 15, q4 = lane >> 4, o = l >> 1;
    const unsigned L0 = (unsigned)(size_t)smraw_base();
    const bf16_t* UT = (const bf16_t*)(p->ws + OFF_UT);
    bf16_t* ZOT = (bf16_t*)(p->ws + OFF_ZOT);
    const float* FK = (const float*)(p->ws + OFF_FK);
    for (int i = tid; i < 8 * 512; i += 512) { const int b = i >> 9, ch = i & 511; sc::st16(L0 + O_Z + b * ZSB + ch * 16, *(const uint4*)(UT + (size_t)(1024 + c) * NT + b * SEQ + ch * 8)); }
#pragma unroll 1
    for (int order = 0; order < 2; ++order) {
        const float* fk = FK + ((size_t)order * 512 + c) * 8192;
        for (int i = tid; i < 2048; i += 512) { const float4 v = *(const float4*)(fk + i * 4); *(LAS sc::f32x4*)(size_t)(L0 + O_KF + i * 16) = (sc::f32x4){v.x, v.y, v.z, v.w}; }
        __syncthreads();
        sc::f32x4 acc[4][4];
#pragma unroll
        for (int a = 0; a < 4; ++a)
#pragma unroll
            for (int b2 = 0; b2 < 4; ++b2) acc[a][b2] = (sc::f32x4){0.f, 0.f, 0.f, 0.f};
        auto build_T = [&](int D, int buf) {
            const int t2 = tid >> 3, ch = tid & 7;
            const unsigned base = L0 + O_KF + (unsigned)(4096 + 64 * D + t2 - 8 * ch) * 4u;
            float v[8];
#pragma unroll
            for (int j = 0; j < 8; ++j) v[j] = *(const LAS float*)(size_t)(base - 4u * j);
            sc::st16(L0 + O_T + buf * 9216 + t2 * 144 + ch * 16, make_uint4(cvt_pk_bf16(v[0], v[1]), cvt_pk_bf16(v[2], v[3]), cvt_pk_bf16(v[4], v[5]), cvt_pk_bf16(v[6], v[7])));
        };
        build_T(-63, 1);
        __syncthreads();
#pragma unroll 1
        for (int D = -63; D <= 63; ++D) {
            const int buf = D & 1;
            if (D < 63) build_T(D + 1, buf ^ 1);
            const unsigned TB = L0 + O_T + buf * 9216;
            sc::bf16x8 af[4][2];
#pragma unroll
            for (int it = 0; it < 4; ++it)
#pragma unroll
                for (int kk = 0; kk < 2; ++kk) af[it][kk] = sc::rd_row(TB, it * 16 + r16, 144, kk * 32 + q4 * 8);
#pragma unroll
            for (int cg = 0; cg < 4; ++cg) {
                const int tA = wv + 8 * cg, sA = tA - D, sB = tA + 32 - D;
                const bool vA = (unsigned)sA < 64u, vB = (unsigned)sB < 64u;
                if (vA || vB) {
                    const int s1 = (r16 < 8) ? sA : sB;
                    const bool ok = (unsigned)s1 < 64u;
                    const unsigned za = L0 + O_Z + (unsigned)((r16 & 7) * ZSB + ((ok ? s1 : 0) * 64 + q4 * 8) * 2);
                    sc::bf16x8 b0 = *(const LAS sc::bf16x8*)(size_t)za, b1 = *(const LAS sc::bf16x8*)(size_t)(za + 64);
                    if (!ok) { b0 = (sc::bf16x8){0, 0, 0, 0, 0, 0, 0, 0}; b1 = b0; }
#pragma unroll
                    for (int it = 0; it < 4; ++it) { acc[cg][it] = SC_MFMA(af[it][0], b0, acc[cg][it]); acc[cg][it] = SC_MFMA(af[it][1], b1, acc[cg][it]); }
                }
            }
            __syncthreads();
        }
        const float sk = p->in[I_HSKIP][o * 1024 + order * 512 + c];
        const bf16_t* gt = UT + (size_t)(order * 512 + c) * NT;
        const int bb = r16 & 7;
#pragma unroll
        for (int cg = 0; cg < 4; ++cg) {
            const int t1 = wv + 8 * cg + ((r16 < 8) ? 0 : 32);
#pragma unroll
            for (int it = 0; it < 4; ++it) {
                const int t = t1 * 64 + it * 16 + q4 * 4;
                const sc::u32x2_ zo_ = *(const LAS sc::u32x2_*)(size_t)(L0 + O_Z + bb * ZSB + t * 2); const uint2 zo = make_uint2(zo_[0], zo_[1]);
                const uint2 gv = *(const uint2*)(gt + bb * SEQ + t);
                const float y0 = bflo(gv.x) * (acc[cg][it][0] + sk * bflo(zo.x)), y1 = bfhi(gv.x) * (acc[cg][it][1] + sk * bfhi(zo.x));
                const float y2 = bflo(gv.y) * (acc[cg][it][2] + sk * bflo(zo.y)), y3 = bfhi(gv.y) * (acc[cg][it][3] + sk * bfhi(zo.y));
                const uint2 w = make_uint2(cvt_pk_bf16(y0, y1), cvt_pk_bf16(y2, y3));
                if (order == 0) sc::st8(L0 + O_Z + bb * ZSB + t * 2, w);
                else *(uint2*)(ZOT + (size_t)c * NT + bb * SEQ + t) = w;
            }
        }
        __syncthreads();
    }
}

__device__ __forceinline__ void hy_item_ctx(KP p, int l, int c, float* sm) {
    const int tid = opaque_tid(), o = l >> 1;
    const bf16_t* UT = (const bf16_t*)(p->ws + OFF_UT);
    bf16_t* ZOT = (bf16_t*)(p->ws + OFF_ZOT);
    const float* FKC = (const float*)(p->ws + OFF_FKC);
    float* Kc = sm;
    float* zb = sm + 1024;
    for (int i = tid; i < 1024; i += 512) Kc[i] = FKC[((size_t)(i >> 9) * 512 + c) * 512 + (i & 511)];
    for (int i = tid; i < 8 * CTXL; i += 512) zb[i] = bf2f(UT[(size_t)(1024 + c) * NT + NL + i]);
    __syncthreads();
    const int bb = tid >> 6, tl = tid & 63;
#pragma unroll 1
    for (int order = 0; order < 2; ++order) {
        float acc[4] = {0.f, 0.f, 0.f, 0.f};
#pragma unroll 4
        for (int s = 0; s < CTXL; ++s) {
            const float zv = zb[bb * CTXL + s];
#pragma unroll
            for (int i = 0; i < 4; ++i) acc[i] += Kc[order * 512 + tl + 64 * i - s + 256] * zv;
        }
        const float sk = p->in[I_HSKIP][o * 1024 + order * 512 + c];
        float zn[4];
#pragma unroll
        for (int i = 0; i < 4; ++i) { const int t = tl + 64 * i; zn[i] = bf2f(UT[(size_t)(order * 512 + c) * NT + NL + bb * CTXL + t]) * (acc[i] + zb[bb * CTXL + t] * sk); }
        __syncthreads();
#pragma unroll
        for (int i = 0; i < 4; ++i) { const int t = tl + 64 * i; if (order == 0) zb[bb * CTXL + t] = bf2f((bf16_t)(cvt_pk_bf16(zn[i], 0.f) & 0xffffu)); else stf(ZOT + (size_t)c * NT + NL + bb * CTXL + t, zn[i]); }
        __syncthreads();
    }
}

__device__ __forceinline__ void ph_mix_odd(KP p, int l, int bid, int nb, float* sm) {
    if (bid < 128) {
        const int item = bid, b = (item >> 4) & 7, h = (item >> 2) & 3, dir = (item >> 1) & 1, vs = item & 1;
        sc::scan_item<2>(p, l, b, h, dir, vs);
        __syncthreads();
    } else {
#pragma unroll 1
        for (int c = bid - 128; c < 512; c += 128) { hy_item_lat(p, l, c); __syncthreads(); hy_item_ctx(p, l, c, sm); __syncthreads(); }
    }
}

__device__ __forceinline__ void ph_hy_norm(KP p, int l, int bid, int nb, float* sm) {
    const int tid = opaque_tid(), o = l >> 1;
    const bf16_t* ZOT = (const bf16_t*)(p->ws + OFF_ZOT);
    bf16_t* MIX = (bf16_t*)(p->ws + OFF_U);
    const float* nw = p->in[I_HNORM] + o * 512;
    float* tile = sm;
    float* part = sm + 64 * 65;
#pragma unroll 1
    for (int item = bid; item < (NT / 64) * 8; item += nb) {
        const int tt = item >> 3, g = item & 7, tok0 = tt * 64;
        __syncthreads();
        { const int cc = tid >> 3, ch = tid & 7;
          const uint4 v = *(const uint4*)(ZOT + (size_t)(g * 64 + cc) * NT + tok0 + ch * 8);
          float* d = tile + cc * 65 + ch * 8;
          d[0] = bflo(v.x); d[1] = bfhi(v.x); d[2] = bflo(v.y); d[3] = bfhi(v.y); d[4] = bflo(v.z); d[5] = bfhi(v.z); d[6] = bflo(v.w); d[7] = bfhi(v.w); }
        __syncthreads();
        { const int tk = tid & 63, pt = tid >> 6; float s = 0.f;
#pragma unroll
          for (int i = 0; i < 8; ++i) { const float x = tile[(pt * 8 + i) * 65 + tk]; s += x * x; }
          part[pt * 64 + tk] = s; }
        __syncthreads();
        { const int tk = tid >> 3, ch = tid & 7; float s = 0.f;
#pragma unroll
          for (int i = 0; i < 8; ++i) s += part[i * 64 + tk];
          const float rs = rsqrtf(s * (1.f / 64.f) + LN_EPS);
          float y[8];
#pragma unroll
          for (int i = 0; i < 8; ++i) y[i] = tile[(ch * 8 + i) * 65 + tk] * rs * nw[g * 64 + ch * 8 + i];
          *(uint4*)(MIX + (size_t)(tok0 + tk) * DM + g * 64 + ch * 8) = make_uint4(cvt_pk_bf16(y[0], y[1]), cvt_pk_bf16(y[2], y[3]), cvt_pk_bf16(y[4], y[5]), cvt_pk_bf16(y[6], y[7])); }
    }
}

__device__ __forceinline__ void ph_normgate_odd(KP p, int l, int bid, int nb) {
    const int tid = opaque_tid(), lane = tid & 63, wv = tid >> 6, o = l >> 1;
    const bf16_t* P = (const bf16_t*)(p->ws + OFF_BIG);
    const bf16_t* HX = (const bf16_t*)(p->ws + OFF_AUX);
    const bf16_t* HX1 = HX + (size_t)NT * 1024;
    bf16_t* MIX = (bf16_t*)(p->ws + OFF_U);
    #pragma unroll 1
    for (int tok = bid * 8 + wv; tok < NT; tok += nb * 8) {
        const bf16_t* pr = P + (size_t)tok * ODD_N;
#pragma unroll
        for (int h = 0; h < 4; ++h) {
            const size_t hxo = (size_t)tok * 1024 + 512 + h * 128;
            float x0 = bf2f(HX[hxo + lane]) + bf2f(HX1[hxo + lane]), x1 = bf2f(HX[hxo + lane + 64]) + bf2f(HX1[hxo + lane + 64]);
            const float mean = wave_sum(x0 + x1) * (1.f / 128.f);
            x0 -= mean; x1 -= mean;
            const float var = wave_sum(x0 * x0 + x1 * x1) * (1.f / 128.f);
            const float r = rsqrtf(var + LN_EPS);
            const float* nw = p->in[I_RNW] + o * 512 + h * 128;
            const float g0 = ldf(pr + 3072 + h * 128 + lane), g1 = ldf(pr + 3072 + h * 128 + lane + 64);
            stf(MIX + (size_t)tok * DM + 512 + h * 128 + lane, x0 * r * nw[lane] * siluf_(g0));
            stf(MIX + (size_t)tok * DM + 512 + h * 128 + lane + 64, x1 * r * nw[lane + 64] * siluf_(g1));
        }
    }
}


__device__ __forceinline__ void ph_ln1_router(KP p, int l, int ntok, int bid, int nb, float* sm) {
    const int tid = opaque_tid(), lane = tid & 63, wv = tid >> 6;
    const float* Y = (const float*)(p->ws + OFF_BIG);
    bf16_t* U = (bf16_t*)(p->ws + OFF_U);
    const float* lw = p->in[I_LNW] + (l * 2) * 1024; const float* lb = p->in[I_LNB] + (l * 2) * 1024;
    const float* rw = p->in[I_RW] + (size_t)l * 1024 * 64;
    const float rb = p->in[I_RB][l * 64 + lane];
    int* cnt = (int*)(p->ws + OFF_CNT) + l * 64;
    int* tidx = (int*)(p->ws + OFF_TIDX); float* tgate = (float*)(p->ws + OFF_TGATE); int* tpos = (int*)(p->ws + OFF_TPOS);
    float* Vs = sm + wv * 4096;
    {
        int* stok = (int*)(p->ws + OFF_STOK); float* sgate = (float*)(p->ws + OFF_SGATE); int* sdst = (int*)(p->ws + OFF_SDST);
        #pragma unroll 1
        for (int i = bid * 512 + tid; i < MAXROWS; i += nb * 512) { stok[i] = ZROW; sgate[i] = 0.f; sdst[i] = -1; }
    }
    #pragma unroll 1
    for (int base = bid * 32; base < ntok; base += nb * 32) {
#pragma unroll 1
        for (int j = 0; j < 4; ++j) {
            const int tok = base + wv * 4 + j;
            float* h = hrow(p, tok);
            const float* m = modrow(p, l, tok);
            const float* r = Y + (size_t)tok * DM;
            float x[16]; float s = 0.f;
#pragma unroll
            for (int c = 0; c < 4; ++c) {
                const int d = 4 * (lane + 64 * c);
                const float4 hv = *(const float4*)(h + d), gv = *(const float4*)(m + 2 * 1024 + d), rv = *(const float4*)(r + d);
                x[4 * c] = ALPHA * hv.x + gv.x * rv.x; x[4 * c + 1] = ALPHA * hv.y + gv.y * rv.y; x[4 * c + 2] = ALPHA * hv.z + gv.z * rv.z; x[4 * c + 3] = ALPHA * hv.w + gv.w * rv.w;
                s += x[4 * c] + x[4 * c + 1] + x[4 * c + 2] + x[4 * c + 3];
            }
            const float mean = wave_sum(s) * (1.f / 1024.f);
            float q = 0.f;
#pragma unroll
            for (int i = 0; i < 16; ++i) { x[i] -= mean; q += x[i] * x[i]; }
            const float rs = rsqrtf(wave_sum(q) * (1.f / 1024.f) + LN_EPS);
#pragma unroll
            for (int c = 0; c < 4; ++c) {
                const int d = 4 * (lane + 64 * c);
                const float4 w4 = *(const float4*)(lw + d), b4 = *(const float4*)(lb + d), sh = *(const float4*)(m + 3 * 1024 + d), sc = *(const float4*)(m + 4 * 1024 + d);
                float4 y; y.x = x[4 * c] * rs * w4.x + b4.x; y.y = x[4 * c + 1] * rs * w4.y + b4.y; y.z = x[4 * c + 2] * rs * w4.z + b4.z; y.w = x[4 * c + 3] * rs * w4.w + b4.w;
                *(float4*)(h + d) = y;
                float4 v; v.x = y.x * (1.f + sc.x) + sh.x; v.y = y.y * (1.f + sc.y) + sh.y; v.z = y.z * (1.f + sc.z) + sh.z; v.w = y.w * (1.f + sc.w) + sh.w;
                *(uint2*)(U + (size_t)tok * DM + d) = make_uint2(cvt_pk_bf16(v.x, v.y), cvt_pk_bf16(v.z, v.w));
                *(float4*)(Vs + j * 1024 + d) = v;
            }
        }
        __syncthreads();
        float a[4] = {0.f, 0.f, 0.f, 0.f};
#pragma unroll 2
        for (int d = 0; d < 1024; d += 4) {
            const float w0 = rw[(d + 0) * 64 + lane], w1 = rw[(d + 1) * 64 + lane], w2 = rw[(d + 2) * 64 + lane], w3 = rw[(d + 3) * 64 + lane];
#pragma unroll
            for (int j = 0; j < 4; ++j) { const float4 v = *(const float4*)(Vs + j * 1024 + d); a[j] += v.x * w0 + v.y * w1 + v.z * w2 + v.w * w3; }
        }
#pragma unroll
        for (int j = 0; j < 4; ++j) {
            const int tok = base + wv * 4 + j;
            const float score = sigmoidf_(a[j]);
            float key = score + rb;
            float mysel = 0.f; int myidx = 0; float gsum = 0.f;
#pragma unroll
            for (int s = 0; s < TOPK; ++s) {
                float bv = key; int bi = lane;
#pragma unroll
                for (int o = 32; o > 0; o >>= 1) {
                    const float ov = __shfl_xor(bv, o, 64); const int oi = __shfl_xor(bi, o, 64);
                    if (ov > bv || (ov == bv && oi < bi)) { bv = ov; bi = oi; }
                }
                const float sc = __shfl(score, bi, 64);
                gsum += sc;
                if (lane == s) { mysel = sc; myidx = bi; }
                if (lane == bi) key = -1e30f;
            }
            if (lane < TOPK) {
                const int pos = atomicAdd(&cnt[myidx], 1);
                tidx[tok * 8 + lane] = myidx; tgate[tok * 8 + lane] = 2.5f * mysel / gsum; tpos[tok * 8 + lane] = pos;
            }
        }
        __syncthreads();
    }
}

__device__ __forceinline__ void moe_offsets(KP p, int l, int ntok, LAS int* offs) {
    if (threadIdx.x == 0) {
        int* cnt = (int*)(p->ws + OFF_CNT) + l * 64;
        int a = 0;
#pragma unroll 1
        for (int e = 0; e < 64; ++e) { offs[e] = a; a += (__hip_atomic_load(cnt + e, __ATOMIC_RELAXED, __HIP_MEMORY_SCOPE_AGENT) + 255) & ~255; }
        offs[64] = a; offs[65] = a + ntok;
    }
    __syncthreads();
}
__device__ __forceinline__ int moe_expert_of(const LAS int* offs, int row) { int e = 0;
#pragma unroll 1
    while (e < 64 && row >= offs[e + 1]) ++e;
    return e; }

__device__ __forceinline__ void ph_scatter(KP p, int l, int ntok, int bid, int nb, LAS unsigned char* lds) {
    LAS int* offs = (LAS int*)lds;
    moe_offsets(p, l, ntok, offs);
    const int tid = opaque_tid();
    const int* tidx = (const int*)(p->ws + OFF_TIDX); const float* tgate = (const float*)(p->ws + OFF_TGATE); const int* tpos = (const int*)(p->ws + OFF_TPOS);
    int* stok = (int*)(p->ws + OFF_STOK); float* sgate = (float*)(p->ws + OFF_SGATE); int* sdst = (int*)(p->ws + OFF_SDST);
    int* tile_e = (int*)(p->ws + OFF_TILEE);
    #pragma unroll 1
    for (int i = bid * 512 + tid; i < ntok * 9; i += nb * 512) {
        if (i < ntok * 8) { const int row = offs[tidx[i]] + tpos[i], tok = i >> 3; stok[row] = tok; sgate[row] = tgate[i]; sdst[row] = tok * 9 + (i & 7); }
        else { const int tok = i - ntok * 8, row = offs[64] + tok; stok[row] = tok; sgate[row] = 1.f; sdst[row] = tok * 9 + 8; }
    }
    const int nrt = offs[65] >> 8;
    #pragma unroll 1
    for (int rt = bid * 512 + tid; rt < nrt; rt += nb * 512) tile_e[rt] = moe_expert_of(offs, rt * 256);
    __syncthreads();
}

#define MOE_TAB (gp::STAGE_BYTES + 256)
#define MOE_MAXT 8
struct Moe1Sched {
    const char* U; const char* W; const LAS int* tabE; const LAS int* tabS; int nper, bid, nb;
    __device__ __forceinline__ bool next(int i, gp::Unit& u) const {
        const int j = i >> 1; if (j >= nper) return false;
        u.A = U; u.B = W + (size_t)tabE[j] * (512 * 1024 * 2) + (size_t)(i & 1) * (256 * 1024 * 2); u.r0 = (bid + j * nb) * 256; u.c0 = (i & 1) * 256; u.aux = j; return true;
    }
    __device__ __forceinline__ void lane_off(const gp::Unit& u, int R0, int R1, int C0, int C1, unsigned (&vo)[2][2]) const {
        const LAS int* t = tabS + u.aux * 256;
        vo[0][0] = (unsigned)t[R0] * 2048u + (unsigned)C0 * 2u; vo[0][1] = (unsigned)t[R1] * 2048u + (unsigned)C1 * 2u;
        vo[1][0] = (unsigned)t[128 + R0] * 2048u + (unsigned)C0 * 2u; vo[1][1] = (unsigned)t[128 + R1] * 2048u + (unsigned)C1 * 2u;
    }
};
struct EpiH {
    bf16_t* H;
    __device__ __forceinline__ void operator()(const gp::f32x4 (&acc)[2][2][4][2], const gp::Unit& u, int wr, int wc, int fr, int fq) const {
        const int row0 = u.r0 + wr * 64 + fr;
#pragma unroll
        for (int ai = 0; ai < 2; ++ai)
#pragma unroll
            for (int m = 0; m < 4; ++m) { bf16_t* rowp = H + (size_t)(row0 + ai * 128 + m * 16) * 256;
#pragma unroll
                for (int bj = 0; bj < 2; ++bj) {
                    const int j0 = ((u.c0 + bj * 128 + wc * 32) >> 5) * 16 + 4 * fq;
                    const gp::f32x4 a = acc[ai][bj][m][0], b = acc[ai][bj][m][1];
                    const float h0 = siluf_(a[0]) * b[0], h1 = siluf_(a[1]) * b[1], h2 = siluf_(a[2]) * b[2], h3 = siluf_(a[3]) * b[3];
                    *(uint2*)(rowp + j0) = make_uint2(cvt_pk_bf16(h0, h1), cvt_pk_bf16(h2, h3)); }
                __builtin_amdgcn_sched_barrier(0); }
    }
};
__device__ __forceinline__ void ph_moe1(KP p, int l, int ntok, int bid, int nb, LAS unsigned char* lds) {
    LAS int* offs = (LAS int*)(lds + MOE_TAB);
    LAS int* tabE = offs + 128;
    LAS int* tabS = offs + 256;
    moe_offsets(p, l, ntok, offs);
    const int tid = opaque_tid();
    const int nrt = offs[65] >> 8;
    const int nper = bid < nrt ? (nrt - bid + nb - 1) / nb : 0;
    const int* stok = (const int*)(p->ws + OFF_STOK); const int* tile_e = (const int*)(p->ws + OFF_TILEE);
    for (int i = tid; i < nper * 256; i += 512) tabS[i] = stok[(size_t)(bid + (i >> 8) * nb) * 256 + (i & 255)];
    if (tid < nper) tabE[tid] = tile_e[bid + tid * nb];
    __syncthreads();
    Moe1Sched S{(const char*)(p->ws + OFF_U), (const char*)(p->ws + OFF_W13), tabE, tabS, nper, bid, nb};
    EpiH E{(bf16_t*)(p->ws + OFF_BIG)};
    gp::gemm_phase<true, false>(lds, 1024, S, E);
}

struct Moe2Sched {
    const char* H; const char* W; const LAS int* tabE; int nper, bid, nb;
    __device__ __forceinline__ bool next(int i, gp::Unit& u) const {
        const int j = i >> 2; if (j >= nper) return false;
        u.A = H + (size_t)(bid + j * nb) * (256 * 256 * 2); u.B = W + (size_t)tabE[j] * (1024 * 256 * 2) + (size_t)(i & 3) * (256 * 256 * 2); u.r0 = j * 256; u.c0 = (i & 3) * 256; u.aux = j; return true;
    }
    __device__ __forceinline__ void lane_off(const gp::Unit&, int, int, int, int, unsigned (&)[2][2]) const {}
};
struct EpiY {
    bf16_t* Ys; const LAS int* tabD; const LAS float* tabG;
    __device__ __forceinline__ void operator()(const gp::f32x4 (&acc)[2][2][4][2], const gp::Unit& u, int wr, int wc, int fr, int fq) const {
        const int rl0 = u.r0 + wr * 64 + fr, col0 = u.c0 + wc * 32 + 8 * fq;
#pragma unroll
        for (int ai = 0; ai < 2; ++ai)
#pragma unroll
            for (int m = 0; m < 4; ++m) {
                const int rl = rl0 + ai * 128 + m * 16;
                const int dst = tabD[rl]; const float g = tabG[rl];
                if (dst >= 0) { bf16_t* rowp = Ys + (size_t)dst * 1024 + col0;
#pragma unroll
                    for (int bj = 0; bj < 2; ++bj) { const gp::f32x4 v0 = acc[ai][bj][m][0] * g, v1 = acc[ai][bj][m][1] * g;
                        gp::u32x4 w; w.x = cvt_pk_bf16(v0[0], v0[1]); w.y = cvt_pk_bf16(v0[2], v0[3]); w.z = cvt_pk_bf16(v1[0], v1[1]); w.w = cvt_pk_bf16(v1[2], v1[3]);
                        *(gp::u32x4*)(rowp + bj * 128) = w; } }
                __builtin_amdgcn_sched_barrier(0); }
    }
};
__device__ __forceinline__ void ph_moe2(KP p, int l, int ntok, int bid, int nb, LAS unsigned char* lds) {
    LAS int* offs = (LAS int*)(lds + MOE_TAB);
    LAS int* tabE = offs + 128;
    LAS int* tabD = offs + 256;
    LAS float* tabG = (LAS float*)(tabD + MOE_MAXT * 256);
    moe_offsets(p, l, ntok, offs);
    const int tid = opaque_tid();
    const int nrt = offs[65] >> 8;
    const int nper = bid < nrt ? (nrt - bid + nb - 1) / nb : 0;
    const int* sdst = (const int*)(p->ws + OFF_SDST); const float* sgate = (const float*)(p->ws + OFF_SGATE); const int* tile_e = (const int*)(p->ws + OFF_TILEE);
    for (int i = tid; i < nper * 256; i += 512) { const size_t r = (size_t)(bid + (i >> 8) * nb) * 256 + (i & 255); tabD[i] = sdst[r]; tabG[i] = sgate[r]; }
    if (tid < nper) tabE[tid] = tile_e[bid + tid * nb];
    __syncthreads();
    Moe2Sched S{(const char*)(p->ws + OFF_BIG), (const char*)(p->ws + OFF_W2), tabE, nper, bid, nb};
    EpiY E{(bf16_t*)(p->ws + OFF_YS), tabD, tabG};
    gp::gemm_phase<false, true>(lds, 256, S, E);
}

__device__ __forceinline__ void ph_combine_ln2(KP p, int l, int ntok, int bid, int nb) {
    const int tid = opaque_tid(), lane = tid & 63, wv = tid >> 6;
    const bf16_t* Ys = (const bf16_t*)(p->ws + OFF_YS);
    const float* lw = p->in[I_LNW] + (l * 2 + 1) * 1024; const float* lb = p->in[I_LNB] + (l * 2 + 1) * 1024;
    #pragma unroll 1
    for (int tok = bid * 8 + wv; tok < ntok; tok += nb * 8) {
        float* h = hrow(p, tok);
        const float* m = modrow(p, l, tok);
        float f[16];
#pragma unroll
        for (int i = 0; i < 16; ++i) f[i] = 0.f;
#pragma unroll
        for (int s = 0; s < 9; ++s)
#pragma unroll
            for (int c = 0; c < 2; ++c) {
                const uint4 w = *(const uint4*)(Ys + ((size_t)tok * 9 + s) * 1024 + 8 * (lane + 64 * c));
                f[8 * c + 0] += bflo(w.x); f[8 * c + 1] += bfhi(w.x); f[8 * c + 2] += bflo(w.y); f[8 * c + 3] += bfhi(w.y);
                f[8 * c + 4] += bflo(w.z); f[8 * c + 5] += bfhi(w.z); f[8 * c + 6] += bflo(w.w); f[8 * c + 7] += bfhi(w.w);
            }
        float x[16]; float sum = 0.f;
#pragma unroll
        for (int c = 0; c < 2; ++c)
#pragma unroll
            for (int q = 0; q < 2; ++q) {
                const int d = 8 * (lane + 64 * c) + 4 * q;
                const float4 hv = *(const float4*)(h + d), gv = *(const float4*)(m + 5 * 1024 + d);
                x[8 * c + 4 * q + 0] = ALPHA * hv.x + gv.x * f[8 * c + 4 * q + 0]; x[8 * c + 4 * q + 1] = ALPHA * hv.y + gv.y * f[8 * c + 4 * q + 1];
                x[8 * c + 4 * q + 2] = ALPHA * hv.z + gv.z * f[8 * c + 4 * q + 2]; x[8 * c + 4 * q + 3] = ALPHA * hv.w + gv.w * f[8 * c + 4 * q + 3];
                sum += x[8 * c + 4 * q] + x[8 * c + 4 * q + 1] + x[8 * c + 4 * q + 2] + x[8 * c + 4 * q + 3];
            }
        const float mean = wave_sum(sum) * (1.f / 1024.f);
        float q2 = 0.f;
#pragma unroll
        for (int i = 0; i < 16; ++i) { x[i] -= mean; q2 += x[i] * x[i]; }
        const float rs = rsqrtf(wave_sum(q2) * (1.f / 1024.f) + LN_EPS);
#pragma unroll
        for (int c = 0; c < 2; ++c)
#pragma unroll
            for (int q = 0; q < 2; ++q) {
                const int d = 8 * (lane + 64 * c) + 4 * q;
                const float4 w4 = *(const float4*)(lw + d), b4 = *(const float4*)(lb + d);
                float4 y; y.x = x[8 * c + 4 * q] * rs * w4.x + b4.x; y.y = x[8 * c + 4 * q + 1] * rs * w4.y + b4.y; y.z = x[8 * c + 4 * q + 2] * rs * w4.z + b4.z; y.w = x[8 * c + 4 * q + 3] * rs * w4.w + b4.w;
                *(float4*)(h + d) = y;
            }
    }
}

#define MEGA_LDS (131072 + 256 + 20480)
#define NBLK 256
#define BAR_LDS 131072
#define SYNC() do { XcdBarrier _b; _b.bar = (unsigned*)kparams()->ws; _b.x = xb_xcc_id(); _b.st = (volatile LAS unsigned*)((LAS unsigned char*)smraw_base() + BAR_LDS); xcd_barrier(_b); } while (0)
template <int PAR>
__device__ __forceinline__ void layer_fwd(const int l) {
    LAS unsigned char* lds = smraw_base(); float* sm = (float*)smraw_generic();
    const int bid = blockIdx.x; constexpr int nb = NBLK;
    const int ntok = (l == 3) ? NL : NT;
    ph_convert(kparams(), l, bid, nb, sm); ph_modin(kparams(), l, bid, nb); SYNC();
    ph_gemm_in(kparams(), l, bid, nb, lds); SYNC();
    if (PAR == 0) {
        ph_scan_even2(kparams(), l, bid, nb); SYNC();
        ph_normgate_even(kparams(), l, bid, nb); SYNC();
    } else {
        ph_hy_filt2(kparams(), l, bid, nb, sm); ph_hy_prep(kparams(), l, bid, nb, sm); SYNC();
        ph_mix_odd(kparams(), l, bid, nb, sm); SYNC();
        ph_hy_norm(kparams(), l, bid, nb, sm); ph_normgate_odd(kparams(), l, bid, nb); SYNC();
    }
    ph_gemm_out(kparams(), l, bid, nb, lds); SYNC();
    ph_ln1_router(kparams(), l, ntok, bid, nb, sm); SYNC();
    ph_scatter(kparams(), l, ntok, bid, nb, lds); SYNC();
    ph_moe1(kparams(), l, ntok, bid, nb, lds); SYNC();
    ph_moe2(kparams(), l, ntok, bid, nb, lds); SYNC();
    ph_combine_ln2(kparams(), l, ntok, bid, nb);
    if (l < 3) SYNC();
}
__global__ void __launch_bounds__(512, 2) mega_fwd(Params p) {
    LAS unsigned char* lds = smraw_base(); float* sm = (float*)smraw_generic();
    if (threadIdx.x < 4) ((LAS unsigned*)(lds + 131072))[threadIdx.x] = 0u;
    __syncthreads();
    (void)xcd_barrier_post((unsigned*)kparams()->ws, (volatile LAS unsigned*)(lds + BAR_LDS));
    const int bid = blockIdx.x; constexpr int nb = NBLK;
    ph_prologue(kparams(), bid, nb, sm); SYNC();
#pragma unroll 1
    for (int lp = 0; lp < 2; ++lp) {
        layer_fwd<0>(2 * lp);
        layer_fwd<1>(2 * lp + 1);
    }
    __syncthreads();
    if (blockIdx.x == 0 && threadIdx.x == 0 && xb_ld((unsigned*)kparams()->ws + XB_TMO) != 0u) kparams()->out[0] = __builtin_nanf("");
}

extern "C" void kernel_launch(void* const* d_in, const int* in_sizes, int n_in, void* d_out, int out_size, void* d_ws, size_t ws_size, hipStream_t stream) {
    static int grid = 0;
    if (grid == 0) {
        if (n_in != 38 || out_size != NL * DM || ws_size < WS_END) { fprintf(stderr, "kernel_launch: bad shapes n_in %d out %d ws %zu (need %zu)\n", n_in, out_size, ws_size, (size_t)WS_END); grid = -1; return; }
        int dev = 0, cus = 0, per_cu = 0;
        if (hipGetDevice(&dev) != hipSuccess || hipDeviceGetAttribute(&cus, hipDeviceAttributeMultiprocessorCount, dev) != hipSuccess) { grid = -1; return; }
        if (hipFuncSetAttribute((const void*)mega_fwd, hipFuncAttributeMaxDynamicSharedMemorySize, MEGA_LDS) != hipSuccess) { fprintf(stderr, "kernel_launch: hipFuncSetAttribute failed\n"); grid = -1; return; }
        if (hipOccupancyMaxActiveBlocksPerMultiprocessor(&per_cu, (const void*)mega_fwd, 512, MEGA_LDS) != hipSuccess || per_cu < 1) { fprintf(stderr, "kernel_launch: occupancy query says %d\n", per_cu); (void)hipGetLastError(); grid = -1; return; }
        if (cus != 256) { fprintf(stderr, "kernel_launch: built for 256 CUs, found %d\n", cus); grid = -1; return; }
        grid = NBLK;
    }
    if (grid < 0) return;
    if (hipMemsetAsync(d_ws, 0, OFF_LB, stream) != hipSuccess) return;
    Params p{};
    for (int i = 0; i < 38; ++i) p.in[i] = (const float*)d_in[i];
    p.out = (float*)d_out; p.ws = (unsigned char*)d_ws;
    hipLaunchKernelGGL(mega_fwd, dim3(grid), dim3(512), MEGA_LDS, stream, p);
}
```

```cpp
#include <hip/hip_runtime.h>
#include <stdint.h>
#include <stdio.h>

#define DM 1024
#define NBATCH 8
#define SEQ 4096
#define CTXL 256
#define NL (NBATCH * SEQ)
#define NC (NBATCH * CTXL)
#define NT (NL + NC)
#define ZROW NT
#define TOPK 8
#define EVEN_N 4112
#define ODD_N 3584
#define EVEN_LD 4096
#define ODD_LD 3584
#define MAXROWS (NT * 8 + 64 * 256 + NT)
#define ALPHA 1.681792830507429f
#define LN_EPS 1e-5f
#define E_MQ 0
#define E_MK 256
#define E_MV 512
#define E_MO 1024
#define E_HQ 1536
#define E_HI 2048
#define E_HFF 2560
#define E_HFB 3072
#define E_HG 3584

typedef unsigned short bf16_t;
#define LAS __attribute__((address_space(3)))
#define BAR_LDS_ 131072

#define MiB ((size_t)1 << 20)
#define OFF_CNT   ((size_t)64 << 10)
#define OFF_LB    ((size_t)96 << 10)
#define OFF_MOD   ((size_t)128 << 10)
#define OFF_ROPE  ((size_t)1536 << 10)
#define OFF_TILEE (2 * MiB)
#define OFF_HCTX  (4 * MiB)
#define OFF_TIDX  (12 * MiB)
#define OFF_TGATE (14 * MiB)
#define OFF_TPOS  (16 * MiB)
#define OFF_STOK  (18 * MiB)
#define OFF_SGATE (20 * MiB)
#define OFF_SDST  (22 * MiB)
#define OFF_G     (24 * MiB)
#define OFF_U     (28 * MiB)
#define OFF_W     (98 * MiB)
#define OFF_WIN   (OFF_W)
#define OFF_WOUT  (OFF_W + 8 * MiB)
#define OFF_W13   (OFF_W + 10 * MiB)
#define OFF_W2    (OFF_W + 75 * MiB)
#define OFF_BIG   (208 * MiB)
#define OFF_AUX   (480 * MiB)
#define OFF_Z1    (OFF_AUX + 136 * MiB)
#define OFF_Z2    (OFF_Z1 + 68 * MiB)
#define OFF_FILT  (OFF_Z2 + 68 * MiB)
#define OFF_YS    (370 * MiB)
#define WS_END    (984 * MiB)

struct Params {
    const float* in[38];
    float* out;
    unsigned char* ws;
};

enum { I_X = 0, I_C, I_CTX, I_CCTX, I_ADAW, I_ADAB, I_LNW, I_LNB, I_EWIN, I_MGB, I_MNW, I_HLB, I_HNW, I_EWOUT, I_OWIN, I_HCW, I_HCB,
       I_HW1, I_HB1, I_HW2, I_HB2, I_HW3, I_HB3, I_HFREQ, I_HWOUT, I_HSKIP, I_HNORM, I_RLD, I_RNW, I_OWOUT, I_RW, I_RB, I_W1, I_W3, I_W2, I_SW1, I_SW3, I_SW2 };

typedef const __attribute__((address_space(4))) Params* KP;
__device__ __forceinline__ KP kparams() { KP k = (KP)__builtin_amdgcn_kernarg_segment_ptr(); asm volatile("" : "+s"(k)); return k; }
extern __shared__ __attribute__((aligned(16))) unsigned char smraw_all[];
__device__ __forceinline__ LAS unsigned char* smraw_base() { return (LAS unsigned char*)smraw_all; }
__device__ __forceinline__ unsigned char* smraw_generic() { return smraw_all; }
__device__ __forceinline__ int opaque_tid() { int t = threadIdx.x; asm volatile("" : "+v"(t)); return t; }
typedef __bf16 bf16x2_n __attribute__((ext_vector_type(2)));
typedef float f32x2_n __attribute__((ext_vector_type(2)));
__device__ __forceinline__ unsigned cvt_pk_bf16(float lo, float hi) { const f32x2_n v = {lo, hi}; return __builtin_bit_cast(unsigned, __builtin_convertvector(v, bf16x2_n)); }
__device__ __forceinline__ float bf2f(bf16_t b) { return __uint_as_float(((unsigned)b) << 16); }
__device__ __forceinline__ float bflo(unsigned w) { return __uint_as_float(w << 16); }
__device__ __forceinline__ float bfhi(unsigned w) { return __uint_as_float(w & 0xffff0000u); }
__device__ __forceinline__ float ldf(const float* p) { return *p; }
__device__ __forceinline__ float ldf(const bf16_t* p) { return bf2f(*p); }
__device__ __forceinline__ void stf(float* p, float v) { *p = v; }
__device__ __forceinline__ void stf(bf16_t* p, float v) { *p = (bf16_t)(cvt_pk_bf16(v, 0.f) & 0xffffu); }
__device__ __forceinline__ float sigmoidf_(float x) { return 1.f / (1.f + expf(-x)); }
__device__ __forceinline__ float siluf_(float x) { return x / (1.f + expf(-x)); }
__device__ __forceinline__ float fexp(float x) { return __builtin_amdgcn_exp2f(x * 1.4426950408889634f); }
__device__ __forceinline__ float flog(float x) { return __builtin_amdgcn_logf(x) * 0.6931471805599453f; }
__device__ __forceinline__ float frcp(float x) { return __builtin_amdgcn_rcpf(x); }
__device__ __forceinline__ float fsigmoid(float x) { return frcp(1.f + fexp(-x)); }
__device__ __forceinline__ float fsilu(float x) { return x * frcp(1.f + fexp(-x)); }
__device__ __forceinline__ float wave_sum(float v) {
#pragma unroll
    for (int o = 32; o > 0; o >>= 1) v += __shfl_xor(v, o, 64);
    return v;
}
__device__ __forceinline__ float* hrow(KP p, int tok) {
    return tok < NL ? p->out + (size_t)tok * DM : (float*)(p->ws + OFF_HCTX) + (size_t)(tok - NL) * DM;
}
__device__ __forceinline__ const float* modrow(KP p, int l, int tok) {
    const int r = tok < NL ? (tok >> 12) : 8;
    return (const float*)(p->ws + OFF_MOD) + ((size_t)l * 9 + r) * 6144;
}
__device__ __forceinline__ int scan_tok(int b, int i, int dir) {
    return i < CTXL ? NL + b * CTXL + (dir ? CTXL - 1 - i : i) : b * SEQ + (dir ? SEQ - 1 - (i - CTXL) : (i - CTXL));
}

#define XB_TMO      128
#define XB_XCNT(j)  (256  + 64 * (j))
#define XB_XSUB(j)  (1280 + 64 * (j))
#define XB_XGEN(j)  (2304 + 64 * (j))
#define XB_TOP      3328
#define XB_TOPGEN   3392
#define XCD_BAR_WORDS 3456
#define XB_SPIN_CAP (1u << 24)
__device__ __forceinline__ unsigned xb_ld(unsigned* p)              { return __hip_atomic_load(p, __ATOMIC_RELAXED, __HIP_MEMORY_SCOPE_AGENT); }
__device__ __forceinline__ unsigned xb_add(unsigned* p, unsigned v) { return __hip_atomic_fetch_add(p, v, __ATOMIC_RELAXED, __HIP_MEMORY_SCOPE_AGENT); }
__device__ __forceinline__ unsigned xb_xcc_id() { return (unsigned)__builtin_amdgcn_s_getreg((3 << 11) | 20) & 0xFu; }
#define XB_SPIN(cond, bar) do { unsigned _sp = 0; while (cond) { __builtin_amdgcn_s_sleep(1); \
    if ((++_sp & 255u) == 0u) { if (xb_ld(&(bar)[XB_TMO])) break; if (_sp > XB_SPIN_CAP) { atomicAdd(&(bar)[XB_TMO], 1u); break; } } } } while (0)
struct XcdBarrier { unsigned* bar; unsigned x; volatile LAS unsigned* st; };
__device__ __forceinline__ XcdBarrier xcd_barrier_post(unsigned* bar, volatile LAS unsigned* st) {
    XcdBarrier b; b.bar = bar; b.x = xb_xcc_id(); b.st = st;
    if (threadIdx.x == 0) (void)xb_add(&bar[XB_XCNT(b.x)], 1u);
    return b;
}
__device__ __forceinline__ void xcd_barrier_complete(unsigned* bar, unsigned x, unsigned& nloc, unsigned& nx) {
    const unsigned G = gridDim.x * gridDim.y * gridDim.z;
    unsigned sum, cnt, mine, sp = 0u;
    for (;;) {
        sum = 0u; cnt = 0u; mine = 0u;
#pragma unroll
        for (unsigned j = 0; j < 16; ++j) { const unsigned c = xb_ld(&bar[XB_XCNT(j)]); sum += c; cnt += (c > 0u) ? 1u : 0u; mine = (j == x) ? c : mine; }
        if (sum == G) break;
        __builtin_amdgcn_s_sleep(1);
        if ((++sp & 255u) == 0u) { if (xb_ld(&bar[XB_TMO])) break; if (sp > XB_SPIN_CAP) { atomicAdd(&bar[XB_TMO], 1u); break; } }
    }
    nloc = mine > 0u ? mine : 1u; nx = cnt > 0u ? cnt : 1u;
}
__device__ __forceinline__ void xcd_barrier(const XcdBarrier& b) {
    asm volatile("s_waitcnt vmcnt(0)" ::: "memory");
    __syncthreads();
    if (threadIdx.x == 0) {
        unsigned* bar = b.bar;
        __builtin_amdgcn_s_waitcnt(0);
        unsigned nloc = b.st[0], nx = b.st[1];
        if (nloc == 0u) { xcd_barrier_complete(bar, b.x, nloc, nx); b.st[0] = nloc; b.st[1] = nx; }
        const unsigned old = xb_add(&bar[XB_XSUB(b.x)], 1u);
        const unsigned gen = old / nloc;
        if (old + 1u == (gen + 1u) * nloc) {
            __builtin_amdgcn_fence(__ATOMIC_RELEASE, "agent");
            asm volatile("s_waitcnt vmcnt(0)" ::: "memory");
            const unsigned og = xb_add(&bar[XB_TOP], 1u);
            const unsigned tg = og / nx;
            if (og + 1u == (tg + 1u) * nx) xb_add(&bar[XB_TOPGEN], 1u);
            else XB_SPIN(xb_ld(&bar[XB_TOPGEN]) == tg, bar);
            __builtin_amdgcn_fence(__ATOMIC_ACQUIRE, "agent");
            xb_add(&bar[XB_XGEN(b.x)], 1u);
            asm volatile("s_waitcnt vmcnt(0)" ::: "memory");
        } else {
            XB_SPIN(xb_ld(&bar[XB_XGEN(b.x)]) == gen, bar);
            __builtin_amdgcn_fence(__ATOMIC_ACQUIRE, "agent");
            asm volatile("s_waitcnt vmcnt(0)" ::: "memory");
        }
    }
    __syncthreads();
}

__device__ __forceinline__ void ph_prologue(KP p, int bid, int nb, float* sm) {
    const int tid = opaque_tid();
    {
        const float4* x4 = (const float4*)p->in[I_X]; float4* o4 = (float4*)p->out;
        #pragma unroll 1
        for (size_t i = (size_t)bid * 512 + tid; i < (size_t)NL * 256; i += (size_t)nb * 512) o4[i] = x4[i];
        const float4* c4 = (const float4*)p->in[I_CTX]; float4* h4 = (float4*)(p->ws + OFF_HCTX);
        #pragma unroll 1
        for (size_t i = (size_t)bid * 512 + tid; i < (size_t)NC * 256; i += (size_t)nb * 512) h4[i] = c4[i];
    }
    if (bid == 0) {
        bf16_t* z = (bf16_t*)(p->ws + OFF_U) + (size_t)ZROW * DM;
        for (int i = tid; i < DM; i += 512) z[i] = 0;
    }
    if (bid == 1 % nb) {
        float* lb = (float*)(p->ws + OFF_LB);
        const float* hl = p->in[I_HLB];
        for (int j = tid; j < 512; j += 512) {
            const float a = hl[j], b = hl[512 + j], mx = fmaxf(a, b);
            const float ea = expf(a - mx), eb = expf(b - mx);
            lb[j] = 0.f; lb[512 + j] = eb / (ea + eb);
        }
    }
    if (bid == 2 % nb) {
        float2* rt = (float2*)(p->ws + OFF_ROPE);
        for (int i = tid; i < 64 * 32; i += 512) { const float ang = (float)(i >> 5) * powf(10000.f, -(float)(2 * (i & 31)) / 64.f); rt[i] = make_float2(cosf(ang), sinf(ang)); }
    }
    {
        float* act = sm;
        bool filled = false;
        #pragma unroll 1
        for (int item = bid; item < 48; item += nb) {
            if (!filled) {
                for (int i = tid; i < 9 * 1024; i += 512) {
                    const int r = i >> 10, k = i & 1023;
                    const float v = r < 8 ? p->in[I_C][r * 1024 + k] : p->in[I_CCTX][k];
                    act[i] = siluf_(v);
                }
                __syncthreads(); filled = true;
            }
            const int l = item / 12, j = (item % 12) * 512 + tid;
            const float* w = p->in[I_ADAW] + (size_t)l * 1024 * 6144 + j;
            float acc[9];
#pragma unroll
            for (int r = 0; r < 9; ++r) acc[r] = 0.f;
            for (int k = 0; k < 1024; ++k) {
                const float wv = w[(size_t)k * 6144];
#pragma unroll
                for (int r = 0; r < 9; ++r) acc[r] += act[r * 1024 + k] * wv;
            }
            const float bv = p->in[I_ADAB][l * 6144 + j];
            float* mod = (float*)(p->ws + OFF_MOD);
#pragma unroll
            for (int r = 0; r < 9; ++r) mod[((size_t)l * 9 + r) * 6144 + j] = acc[r] + bv;
        }
    }
}


template <class Src>
__device__ __forceinline__ void cvt_tile(float* sm, Src src, int srcld, int k0, bf16_t* dst, int dstld, int n0) {
    const int tid = opaque_tid();
    const float* sp = src(n0 + (tid & 127));
#pragma unroll
    for (int j = 0; j < 16; ++j) { const int k = (tid >> 7) + 4 * j; sm[k * 129 + (tid & 127)] = sp[(size_t)(k0 + k) * srcld]; }
    __syncthreads();
    const int n = tid >> 2, kc = (tid & 3) * 16;
    unsigned w[8];
#pragma unroll
    for (int q = 0; q < 8; ++q) w[q] = cvt_pk_bf16(sm[(kc + 2 * q) * 129 + n], sm[(kc + 2 * q + 1) * 129 + n]);
    uint4* d4 = (uint4*)(dst + (size_t)(n0 + n) * dstld + k0 + kc);
    d4[0] = make_uint4(w[0], w[1], w[2], w[3]); d4[1] = make_uint4(w[4], w[5], w[6], w[7]);
    __syncthreads();
}

__device__ __forceinline__ void ph_convert(KP p, int l, int bid, int nb, float* sm) {
    const bool even = (l & 1) == 0;
    const int NP = even ? EVEN_LD : ODD_LD;
    const int t_in = 16 * (NP / 128), t_out = 16 * 8, t_13 = 65 * 16 * 4, t_2 = 65 * 4 * 8;
    const int total = t_in + t_out + t_13 + t_2;
    #pragma unroll 1
    for (int t = bid; t < total; t += nb) {
        if (t < t_in) {
            const int kt = t & 15, nt = t >> 4;
            const float* W = even ? p->in[I_EWIN] + (size_t)(l >> 1) * 1024 * EVEN_N : p->in[I_OWIN] + (size_t)(l >> 1) * 1024 * ODD_N;
            cvt_tile(sm, [&](int n) { return W + ((even && n >= 1536) ? n + 16 : n); }, even ? EVEN_N : ODD_N, kt * 64, (bf16_t*)(p->ws + OFF_WIN), 1024, nt * 128);
        } else if (t < t_in + t_out) {
            const int u = t - t_in, kt = u & 15, nt = u >> 4;
            const float* W = (even ? p->in[I_EWOUT] : p->in[I_OWOUT]) + (size_t)(l >> 1) * 1024 * 1024;
            cvt_tile(sm, [&](int n) { return W + n; }, 1024, kt * 64, (bf16_t*)(p->ws + OFF_WOUT), 1024, nt * 128);
        } else if (t < t_in + t_out + t_13) {
            const int u = t - t_in - t_out, e = u >> 6, kt = u & 15, nt = (u >> 4) & 3;
            const float* w1 = e < 64 ? p->in[I_W1] + ((size_t)l * 64 + e) * 1024 * 256 : p->in[I_SW1] + (size_t)l * 1024 * 256;
            const float* w3 = e < 64 ? p->in[I_W3] + ((size_t)l * 64 + e) * 1024 * 256 : p->in[I_SW3] + (size_t)l * 1024 * 256;
            cvt_tile(sm, [&](int n) { const int g = n >> 5, w = n & 31; return w < 16 ? w1 + 16 * g + w : w3 + 16 * g + w - 16; }, 256, kt * 64,
                     (bf16_t*)(p->ws + OFF_W13) + (size_t)e * 512 * 1024, 1024, nt * 128);
        } else {
            const int u = t - t_in - t_out - t_13, e = u >> 5, kt = u & 3, nt = (u >> 2) & 7;
            const float* w2 = e < 64 ? p->in[I_W2] + ((size_t)l * 64 + e) * 256 * 1024 : p->in[I_SW2] + (size_t)l * 256 * 1024;
            cvt_tile(sm, [&](int n) { return w2 + n; }, 1024, kt * 64, (bf16_t*)(p->ws + OFF_W2) + (size_t)e * 1024 * 256, 256, nt * 128);
        }
    }
}

namespace gp {
typedef short bf16x8 __attribute__((ext_vector_type(8)));
typedef float f32x4 __attribute__((ext_vector_type(4)));
typedef unsigned u32x4 __attribute__((ext_vector_type(4)));
typedef unsigned u32x2 __attribute__((ext_vector_type(2)));
constexpr int BM = 256, BK = 64, HALF = 128, HTB = HALF * BK * 2, STAGE_BYTES = 8 * HTB, NXCD = 8, WGM = 8;
__device__ __forceinline__ int lds_byte(int r, int c) { const int st = (r >> 4) * 2 + (c >> 5), rr = r & 15, cc = c & 31, ob = rr * 64 + cc * 2; return st * 1024 + (ob ^ (((ob >> 9) & 1) << 5)); }
__device__ __forceinline__ void stage_rc(int b, int& R, int& C) { const int st = b / 1024, sb = b % 1024, swz = sb ^ (((sb >> 9) & 1) << 5); R = (st >> 1) * 16 + swz / 64; C = (st & 1) * 32 + (swz % 64) / 2; }
__device__ __forceinline__ int perm32(int rho) { const int n = rho >> 4, i = rho & 15; return 8 * (i >> 2) + 4 * n + (i & 3); }

struct Unit { const char* A; const char* B; int r0, c0, aux; };

struct DenseSched {
    const char* A; const char* B; int nM, nN, nwg, G, c; size_t tstep;
    __device__ __forceinline__ void init(const void* A_, const void* B_, int M, int N, int K, int G_, int c_) { A = (const char*)A_; B = (const char*)B_; nM = M / BM; nN = N / BM; nwg = nM * nN; G = G_; c = c_; tstep = (size_t)BM * K * 2; }
    __device__ __forceinline__ bool next(int i, Unit& u) const {
        const long L = (long)i * G + c; if (L >= nwg) return false;
        int wgid = (int)L; { const int q = nwg / NXCD, r = nwg % NXCD, xcd = wgid % NXCD, off = wgid / NXCD; wgid = (xcd < r ? xcd * (q + 1) : r * (q + 1) + (xcd - r) * q) + off; }
        const int nig = WGM * nN, gid = wgid / nig, fm = gid * WGM, gsz = (nM - fm) < WGM ? (nM - fm) : WGM;
        const int pm = fm + ((wgid % nig) % gsz), pn = (wgid % nig) / gsz;
        u.A = A + (size_t)pm * tstep; u.B = B + (size_t)pn * tstep; u.r0 = pm * BM; u.c0 = pn * BM; u.aux = 0; return true;
    }
    __device__ __forceinline__ void lane_off(const Unit&, int, int, int, int, unsigned (&)[2][2]) const {}
};

template <bool GATHER, bool PERM, class Sched, class Epi>
__device__ __forceinline__ void gemm_phase(LAS unsigned char* lds, const int K_, const Sched& S, const Epi& E) {
    int K = K_; asm volatile("" : "+s"(K));
    const int tid = opaque_tid(), wid = __builtin_amdgcn_readfirstlane(tid >> 6), lane = tid & 63, wr = wid >> 2, wc = wid & 3, fr = lane & 15, fq = lane >> 4;
    const int nt = K / BK;
    unsigned voffA[2], voffB[2]; int sR[2], sC[2];
#pragma unroll
    for (int i = 0; i < 2; ++i) { int R, C; stage_rc(tid * 16 + i * 8192, R, C); const int Rb = PERM ? ((R & ~31) + perm32(R & 31)) : R;
        voffA[i] = (unsigned)(R * K + C) * 2u; voffB[i] = (unsigned)(Rb * K + C) * 2u; sR[i] = R; sC[i] = C; }
    const size_t kstep = (size_t)(BK * 2);
    const size_t hstep = (size_t)HALF * K * 2;
    const unsigned ldsw = (unsigned)wid * 1024u;
    const int aoff = lds_byte(wr * 64 + fr, fq * 8), boff = lds_byte(wc * 32 + fr, fq * 8);
    unsigned cvo[2][2] = {{0u, 0u}, {0u, 0u}}, nvo[2][2] = {{0u, 0u}, {0u, 0u}};
#define GP_SA(b, h) (((b) * 2 + (h)) * HTB)
#define GP_SB(b, h) ((4 + (b) * 2 + (h)) * HTB)
#define GP_GLDS(gp_, lp_) __builtin_amdgcn_global_load_lds((const unsigned*)(gp_), (LAS unsigned*)(lp_), 16, 0, 0)
#define GP_STAGE_B(bufoff, gbase, h) do { const char* _g = (gbase) + (size_t)(h) * hstep; \
        GP_GLDS(_g + voffB[0], lds + (bufoff) + ldsw); GP_GLDS(_g + voffB[1], lds + (bufoff) + ldsw + 8192); } while (0)
#define GP_STAGE_A(bufoff, gbase, h, usenext) do { \
        if (GATHER) { const unsigned _o0 = (usenext) ? nvo[h][0] : cvo[h][0], _o1 = (usenext) ? nvo[h][1] : cvo[h][1]; \
            GP_GLDS((gbase) + _o0, lds + (bufoff) + ldsw); GP_GLDS((gbase) + _o1, lds + (bufoff) + ldsw + 8192); } \
        else { const char* _g = (gbase) + (size_t)(h) * hstep; GP_GLDS(_g + voffA[0], lds + (bufoff) + ldsw); GP_GLDS(_g + voffA[1], lds + (bufoff) + ldsw + 8192); } } while (0)
#define GP_LDA(dst, b, h) do { _Pragma("unroll") for (int m = 0; m < 4; ++m) _Pragma("unroll") for (int k = 0; k < 2; ++k) dst[m][k] = *(const LAS bf16x8*)(lds + GP_SA(b, h) + aoff + m * 2048 + k * 1024); } while (0)
#define GP_LDB(dst, b, h) do { _Pragma("unroll") for (int n = 0; n < 2; ++n) _Pragma("unroll") for (int k = 0; k < 2; ++k) dst[n][k] = *(const LAS bf16x8*)(lds + GP_SB(b, h) + boff + n * 2048 + k * 1024); } while (0)
#define GP_MMA(ai, bj, At, Bt) do { __builtin_amdgcn_s_setprio(1); _Pragma("unroll") for (int m = 0; m < 4; ++m) _Pragma("unroll") for (int n = 0; n < 2; ++n) _Pragma("unroll") for (int k = 0; k < 2; ++k) \
        acc[ai][bj][m][n] = __builtin_amdgcn_mfma_f32_16x16x32_bf16(Bt[n][k], At[m][k], acc[ai][bj][m][n], 0, 0, 0); __builtin_amdgcn_s_setprio(0); } while (0)
#define GP_WAIT_V(n) asm volatile("s_waitcnt vmcnt(" #n ")" ::: "memory")
#define GP_WAIT_L(n) asm volatile("s_waitcnt lgkmcnt(" #n ")" ::: "memory")
#define GP_BAR __builtin_amdgcn_s_barrier()
#define GP_SCHED __builtin_amdgcn_sched_barrier(0)
    Unit cur, nxt; int ui = 0;
    if (!S.next(0, cur)) return;
    f32x4 acc[2][2][4][2];
#pragma unroll
    for (int a = 0; a < 2; ++a)
#pragma unroll
        for (int b = 0; b < 2; ++b)
#pragma unroll
            for (int m = 0; m < 4; ++m)
#pragma unroll
                for (int n = 0; n < 2; ++n) acc[a][b][m][n] = (f32x4){0.f, 0.f, 0.f, 0.f};
    bf16x8 At[4][2], B0[2][2], B1[2][2];
    if (GATHER) S.lane_off(cur, sR[0], sR[1], sC[0], sC[1], cvo);
    const char* cA = cur.A; const char* cB = cur.B;
    GP_STAGE_B(GP_SB(0, 0), cB, 0); GP_STAGE_A(GP_SA(0, 0), cA, 0, false); GP_STAGE_B(GP_SB(0, 1), cB, 1); GP_STAGE_A(GP_SA(0, 1), cA, 1, false);
    if (wr == 1) GP_BAR;
    GP_WAIT_V(4); GP_BAR;
    GP_STAGE_B(GP_SB(1, 0), cB + kstep, 0); GP_STAGE_A(GP_SA(1, 0), cA + kstep, 0, false); GP_STAGE_B(GP_SB(1, 1), cB + kstep, 1);
    GP_WAIT_V(6); GP_BAR;
    for (;;) {
        const bool has_next = S.next(ui + 1, nxt);
        if (GATHER && has_next) S.lane_off(nxt, sR[0], sR[1], sC[0], sC[1], nvo);
        const char* nA = has_next ? nxt.A : cA; const char* nB = has_next ? nxt.B : cB;
        for (int t = 0; t < nt; t += 2) {
            const bool last = (t == nt - 2);
            const bool un = last && has_next;
            const char* a1 = cA + (size_t)(t + 1) * kstep;
            const char* a2 = last ? nA : cA + (size_t)(t + 2) * kstep; const char* b2 = last ? nB : cB + (size_t)(t + 2) * kstep;
            const char* a3 = a2 + kstep; const char* b3 = b2 + kstep;
            GP_LDB(B0, 0, 0); GP_SCHED; GP_LDA(At, 0, 0); GP_STAGE_A(GP_SA(1, 1), a1, 1, false);
            GP_WAIT_L(8); GP_BAR; GP_WAIT_L(0); GP_MMA(0, 0, At, B0); GP_BAR; GP_SCHED;
            GP_LDB(B1, 0, 1); GP_STAGE_B(GP_SB(0, 0), b2, 0);
            GP_BAR; GP_WAIT_L(0); GP_MMA(0, 1, At, B1); GP_BAR;
            GP_LDA(At, 0, 1); GP_STAGE_A(GP_SA(0, 0), a2, 0, un);
            GP_BAR; GP_WAIT_L(0); GP_MMA(1, 0, At, B0); GP_BAR; GP_SCHED;
            GP_STAGE_B(GP_SB(0, 1), b2, 1);
            GP_WAIT_V(6); GP_BAR; GP_MMA(1, 1, At, B1); GP_BAR;
            GP_LDB(B0, 1, 0); GP_SCHED; GP_LDA(At, 1, 0); GP_STAGE_A(GP_SA(0, 1), a2, 1, un);
            GP_WAIT_L(8); GP_BAR; GP_WAIT_L(0); GP_MMA(0, 0, At, B0); GP_BAR; GP_SCHED;
            GP_LDB(B1, 1, 1); GP_STAGE_B(GP_SB(1, 0), b3, 0);
            GP_BAR; GP_WAIT_L(0); GP_MMA(0, 1, At, B1); GP_BAR;
            GP_LDA(At, 1, 1); GP_STAGE_A(GP_SA(1, 0), a3, 0, un);
            GP_BAR; GP_WAIT_L(0); GP_MMA(1, 0, At, B0); GP_BAR; GP_SCHED;
            GP_STAGE_B(GP_SB(1, 1), b3, 1);
            GP_WAIT_V(6); GP_BAR; GP_MMA(1, 1, At, B1); GP_BAR;
        }
        E(acc, cur, wr, wc, fr, fq);
        if (!has_next) break;
#pragma unroll
        for (int a = 0; a < 2; ++a)
#pragma unroll
            for (int b = 0; b < 2; ++b)
#pragma unroll
                for (int m = 0; m < 4; ++m)
#pragma unroll
                    for (int n = 0; n < 2; ++n) acc[a][b][m][n] = (f32x4){0.f, 0.f, 0.f, 0.f};
        cur = nxt; cA = nA; cB = nB; ++ui;
        if (GATHER) { cvo[0][0] = nvo[0][0]; cvo[0][1] = nvo[0][1]; cvo[1][0] = nvo[1][0]; cvo[1][1] = nvo[1][1]; }
    }
    GP_WAIT_V(0);
    if (wr == 0) GP_BAR;
    GP_BAR;
#undef GP_SA
#undef GP_SB
#undef GP_GLDS
#undef GP_STAGE_A
#undef GP_STAGE_B
#undef GP_LDA
#undef GP_LDB
#undef GP_MMA
#undef GP_WAIT_V
#undef GP_WAIT_L
#undef GP_BAR
#undef GP_SCHED
}

struct EpiF32 {
    float* C; int ldc;
    __device__ __forceinline__ void operator()(const f32x4 (&acc)[2][2][4][2], const Unit& u, int wr, int wc, int fr, int fq) const {
        const int row0 = u.r0 + wr * 64 + fr, col0 = u.c0 + wc * 32 + 4 * fq;
#pragma unroll
        for (int ai = 0; ai < 2; ++ai)
#pragma unroll
            for (int m = 0; m < 4; ++m) { float* rowp = C + (size_t)(row0 + ai * HALF + m * 16) * ldc + col0;
#pragma unroll
                for (int bj = 0; bj < 2; ++bj)
#pragma unroll
                    for (int n = 0; n < 2; ++n) *(f32x4*)(rowp + bj * HALF + n * 16) = acc[ai][bj][m][n];
                __builtin_amdgcn_sched_barrier(0); }
    }
};
struct EpiBf16 {
    bf16_t* O; int ldc;
    __device__ __forceinline__ void operator()(const f32x4 (&acc)[2][2][4][2], const Unit& u, int wr, int wc, int fr, int fq) const {
        const int row0 = u.r0 + wr * 64 + fr, col0 = u.c0 + wc * 32 + 8 * fq;
#pragma unroll
        for (int ai = 0; ai < 2; ++ai)
#pragma unroll
            for (int m = 0; m < 4; ++m) { bf16_t* rowp = O + (size_t)(row0 + ai * HALF + m * 16) * ldc + col0;
#pragma unroll
                for (int bj = 0; bj < 2; ++bj) { const f32x4 v0 = acc[ai][bj][m][0], v1 = acc[ai][bj][m][1];
                    u32x4 w; w.x = cvt_pk_bf16(v0[0], v0[1]); w.y = cvt_pk_bf16(v0[2], v0[3]); w.z = cvt_pk_bf16(v1[0], v1[1]); w.w = cvt_pk_bf16(v1[2], v1[3]);
                    *(u32x4*)(rowp + bj * HALF) = w; }
                __builtin_amdgcn_sched_barrier(0); }
    }
};
}

__device__ __forceinline__ void ph_modin(KP p, int l, int bid, int nb) {
    const int tid = opaque_tid(), lane = tid & 63, wv = tid >> 6;
    const bool even = (l & 1) == 0;
    bf16_t* U = (bf16_t*)(p->ws + OFF_U);
    float* G = (float*)(p->ws + OFF_G);
    const float* wg = p->in[I_EWIN] + (size_t)(l >> 1) * 1024 * EVEN_N + 1536;
    #pragma unroll 1
    for (int tok = bid * 8 + wv; tok < NT; tok += nb * 8) {
        const float* h = hrow(p, tok);
        const float* m = modrow(p, l, tok);
        float ga[16];
#pragma unroll
        for (int j = 0; j < 16; ++j) ga[j] = 0.f;
#pragma unroll
        for (int c = 0; c < 4; ++c) {
            const int d = 4 * (lane + 64 * c);
            const float4 hv = *(const float4*)(h + d), sh = *(const float4*)(m + d), sc = *(const float4*)(m + 1024 + d);
            const float u0 = hv.x * (1.f + sc.x) + sh.x, u1 = hv.y * (1.f + sc.y) + sh.y, u2 = hv.z * (1.f + sc.z) + sh.z, u3 = hv.w * (1.f + sc.w) + sh.w;
            *(uint2*)(U + (size_t)tok * DM + d) = make_uint2(cvt_pk_bf16(u0, u1), cvt_pk_bf16(u2, u3));
            if (even) {
                const float uu[4] = {u0, u1, u2, u3};
#pragma unroll
                for (int q = 0; q < 4; ++q) {
                    const float4* wr = (const float4*)(wg + (size_t)(d + q) * EVEN_N);
#pragma unroll
                    for (int j4 = 0; j4 < 4; ++j4) { const float4 w = wr[j4]; ga[4 * j4] += uu[q] * w.x; ga[4 * j4 + 1] += uu[q] * w.y; ga[4 * j4 + 2] += uu[q] * w.z; ga[4 * j4 + 3] += uu[q] * w.w; }
                }
            }
        }
        if (even) {
            float mine = 0.f;
#pragma unroll
            for (int j = 0; j < 16; ++j) { const float s = wave_sum(ga[j]); if (lane == j) mine = s; }
            if (lane < 16) G[(size_t)tok * 16 + lane] = mine;
        }
    }
}

__device__ __forceinline__ void ph_gemm_in(KP p, int l, int bid, int nb, LAS unsigned char* lds) {
    const int N = ((l & 1) == 0) ? EVEN_LD : ODD_LD;
    gp::DenseSched S; S.init(p->ws + OFF_U, p->ws + OFF_WIN, NT, N, 1024, nb, bid);
    gp::EpiBf16 E{(bf16_t*)(p->ws + OFF_BIG), N};
    gp::gemm_phase<false, true>(lds, 1024, S, E);
}
__device__ __forceinline__ void ph_gemm_out(KP p, int l, int bid, int nb, LAS unsigned char* lds) {
    gp::DenseSched S; S.init(p->ws + OFF_U, p->ws + OFF_WOUT, NT, 1024, 1024, nb, bid);
    gp::EpiF32 E{(float*)(p->ws + OFF_BIG), 1024};
    gp::gemm_phase<false, false>(lds, 1024, S, E);
}


namespace sc {
typedef short bf16x8 __attribute__((ext_vector_type(8)));
typedef short bf16x4 __attribute__((ext_vector_type(4)));
typedef float f32x4 __attribute__((ext_vector_type(4)));
#define SC_MFMA(a, b, c) __builtin_amdgcn_mfma_f32_16x16x32_bf16(a, b, c, 0, 0, 0)
__device__ __forceinline__ bf16x8 rd_row(unsigned img, int row, int stride, int k0) { return *(const LAS bf16x8*)(size_t)(img + (unsigned)(row * stride + k0 * 2)); }
__device__ __forceinline__ bf16x8 rd_tr(unsigned img, int k0, int n0, int stride, int lane) {
    const int g = lane >> 4, i = lane & 15;
    const unsigned a0 = img + (unsigned)((k0 + 8 * g + (i >> 2)) * stride + (n0 + 4 * (i & 3)) * 2), a1 = a0 + 4u * (unsigned)stride;
    bf16x4 lo, hi;
    asm volatile("ds_read_b64_tr_b16 %0, %2\n\tds_read_b64_tr_b16 %1, %3\n\ts_waitcnt lgkmcnt(0)" : "=&v"(lo), "=&v"(hi) : "v"(a0), "v"(a1) : "memory");
    return (bf16x8){lo[0], lo[1], lo[2], lo[3], hi[0], hi[1], hi[2], hi[3]};
}
typedef unsigned u32x2_ __attribute__((ext_vector_type(2)));
typedef unsigned u32x4_ __attribute__((ext_vector_type(4)));
__device__ __forceinline__ void st8(unsigned addr, uint2 v) { *(LAS u32x2_*)(size_t)addr = (u32x2_){v.x, v.y}; }
__device__ __forceinline__ void st16(unsigned addr, uint4 v) { *(LAS u32x4_*)(size_t)addr = (u32x4_){v.x, v.y, v.z, v.w}; }
__device__ __forceinline__ float scan_add64(float v, int lane) {
#pragma unroll
    for (int o = 1; o < 64; o <<= 1) { const float t = __shfl_up(v, o, 64); if (lane >= o) v += t; }
    return v;
}
__device__ __forceinline__ float scan_max64(float v, int lane) {
#pragma unroll
    for (int o = 1; o < 64; o <<= 1) { const float t = __shfl_up(v, o, 64); if (lane >= o) v = fmaxf(v, t); }
    return v;
}

template <int MODE>
__device__ __forceinline__ void scan_item(KP p, int l, int b, int h, int dir, int vs) {
    constexpr int CS = (MODE == 1) ? 32 : 64, DK = (MODE == 0) ? 64 : 128, EXT = (MODE == 0) ? 1 : 0;
    constexpr int QS = (DK + 8) * 2, VS = (64 + 16 * EXT + 8) * 2, SS = (CS + 8) * 2, NVR = 64 + 16 * EXT;
    constexpr int NCH = (CTXL + SEQ) / CS;
    constexpr int LD = (MODE == 2) ? ODD_LD : EVEN_LD;
    constexpr unsigned O_QA = 0, O_KA = O_QA + CS * QS, O_QB = O_KA + CS * QS, O_KW = O_QB + (MODE == 1 ? CS * QS : 0), O_V = O_KW + CS * QS,
                       O_SSC = O_V + CS * VS, O_ST = O_SSC + CS * SS, O_DKV = O_ST + 2 * NVR * QS, O_END = O_DKV + 512;
    static_assert(O_END <= 131072, "scan LDS");
    const int tid = opaque_tid(), lane = tid & 63, wv = __builtin_amdgcn_readfirstlane(tid >> 6), r16 = lane & 15, q4 = lane >> 4;
    const unsigned L0 = (unsigned)(size_t)smraw_base();
    const bf16_t* P = (const bf16_t*)(p->ws + OFF_BIG);
    bf16_t* HXo = (bf16_t*)(p->ws + OFF_AUX) + (size_t)dir * NT * 1024;
    const int e2 = l >> 1;
    const int cQ = (MODE == 0) ? E_MQ + h * 64 : (MODE == 1) ? E_HQ + h * 128 : 1536 + h * 128;
    const int cK = (MODE == 0) ? E_MK + h * 64 : (MODE == 1) ? (dir ? E_HFB : E_HFF) + h * 128 : 2048 + h * 128;
    const int cV = (MODE == 0) ? E_MV + h * 128 + vs * 64 : (MODE == 1) ? E_HI + h * 128 + vs * 64 : 2560 + h * 128 + vs * 64;
    const int cO = (MODE == 0) ? h * 128 + vs * 64 : 512 + h * 128 + vs * 64;
    const int lt = (MODE == 1) ? (tid & 31) : (tid >> 3);
    const int lj = (MODE == 0) ? (tid & 7) : (MODE == 1) ? (tid >> 5) : ((tid >> 2) & 1) * 8 + (tid & 3);
    const int vt_ = tid >> 3, vj = tid & 7;
    float lbv[8]; float gbi = 0.f, gbf = 0.f, lg = 0.f;
    if (MODE == 1) {
        const float* lbp = (const float*)(p->ws + OFF_LB) + e2 * 512 + h * 128 + lj * 8;
#pragma unroll
        for (int i = 0; i < 8; ++i) lbv[i] = lbp[i];
    } else {
#pragma unroll
        for (int i = 0; i < 8; ++i) lbv[i] = 0.f;
    }
    if (MODE == 0) { const float* gb = p->in[I_MGB] + e2 * 16; gbi = gb[(dir ? 2 : 0) * 4 + h]; gbf = gb[(dir ? 3 : 1) * 4 + h]; }
    if (MODE == 2) lg = p->in[I_RLD][e2 * 8 + dir * 4 + h];
    const float* G = (const float*)(p->ws + OFF_G);
    const float* ropet = (const float*)(p->ws + OFF_ROPE);
    unsigned oz = 0u; asm volatile("" : "+v"(oz));
    for (unsigned o = tid * 16; o < 2u * NVR * QS; o += 512 * 16) st16(L0 + O_ST + o, make_uint4(oz, oz, oz, oz));
    if (EXT) { if (tid < CS) { st16(L0 + O_V + tid * VS + 128, make_uint4(0x3f80u | oz, oz, oz, oz)); st16(L0 + O_V + tid * VS + 144, make_uint4(oz, oz, oz, oz)); } }
    f32x4 sacc[4];
#pragma unroll
    for (int i = 0; i < 4; ++i) sacc[i] = (f32x4){0.f, 0.f, 0.f, 0.f};
    float m_in = -1e30f;
    uint4 rq0, rq1, rk0, rk1, rv; float rg0 = 0.f, rg1 = 0.f;
    rq1 = make_uint4(0u, 0u, 0u, 0u); rk1 = rq1;
    auto load_chunk = [&](int c) {
        const int i0 = c * CS;
        const int tq = scan_tok(b, i0 + lt, dir);
        const bf16_t* pr = P + (size_t)tq * LD;
        rq0 = *(const uint4*)(pr + cQ + lj * 8); rk0 = *(const uint4*)(pr + cK + lj * 8);
        if (MODE == 2) { rq1 = *(const uint4*)(pr + cQ + lj * 8 + 32); rk1 = *(const uint4*)(pr + cK + lj * 8 + 32); }
        if (MODE != 1 || tid < 256) { const int tv = scan_tok(b, i0 + vt_, dir); rv = *(const uint4*)(P + (size_t)tv * LD + cV + vj * 8); }
        if (MODE == 0) { const int tg = scan_tok(b, i0 + lane, dir); rg0 = G[(size_t)tg * 16 + (dir ? 8 : 0) + h]; rg1 = G[(size_t)tg * 16 + (dir ? 12 : 4) + h]; }
    };
    load_chunk(0);
#pragma unroll 1
    for (int c = 0; c < NCH; ++c) {
        const unsigned ST_R = L0 + O_ST + (unsigned)(c & 1) * NVR * QS, ST_W = L0 + O_ST + (unsigned)((c + 1) & 1) * NVR * QS;
        float sp = 1.f;
        float v_u = 0.f, v_M = 0.f, v_e = 1.f, v_low = 0.f, v_w = 1.f;
        if (MODE == 0) {
            const float ig = rg0 + gbi, fg = rg1 + gbf;
            const float lf = fminf(fg, 0.f) - flog(1.f + fexp(-fabsf(fg)));
            const float bb = scan_add64(lf, lane);
            const float g = __shfl(bb, 63, 64);
            v_u = ig - bb;
            const float cu = scan_max64(v_u, lane);
            v_M = fmaxf(m_in, cu);
            const float m_new = fmaxf(g + m_in, g + __shfl(cu, 63, 64));
            sp = fexp(g + m_in - m_new);
            v_w = fexp(g + v_u - m_new);
            v_e = fexp(m_in - v_M);
            v_low = fexp(-(bb + v_M));
            m_in = m_new;
            st16(L0 + O_QA + lt * QS + lj * 16, rq0);
            st16(L0 + O_KA + lt * QS + lj * 16, rk0);
            const float wr = __shfl(v_w, lt, 64);
            uint4 kw; kw.x = cvt_pk_bf16(bflo(rk0.x) * wr, bfhi(rk0.x) * wr); kw.y = cvt_pk_bf16(bflo(rk0.y) * wr, bfhi(rk0.y) * wr);
            kw.z = cvt_pk_bf16(bflo(rk0.z) * wr, bfhi(rk0.z) * wr); kw.w = cvt_pk_bf16(bflo(rk0.w) * wr, bfhi(rk0.w) * wr);
            st16(L0 + O_KW + lt * QS + lj * 16, kw);
            st16(L0 + O_V + vt_ * VS + vj * 16, rv);
        } else if (MODE == 2) {
            sp = fexp(64.f * lg);
            const bool lat = c >= CTXL / CS;
            float q[16], k[16];
            const unsigned qa[8] = {rq0.x, rq0.y, rq0.z, rq0.w, rq1.x, rq1.y, rq1.z, rq1.w}, ka[8] = {rk0.x, rk0.y, rk0.z, rk0.w, rk1.x, rk1.y, rk1.z, rk1.w};
#pragma unroll
            for (int i = 0; i < 8; ++i) { q[2 * i] = bflo(qa[i]); q[2 * i + 1] = bfhi(qa[i]); k[2 * i] = bflo(ka[i]); k[2 * i + 1] = bfhi(ka[i]); }
            if (lat) {
                const int tq = scan_tok(b, c * CS + lt, dir), tt = tq & (SEQ - 1);
                const int pos = ((tid >> 2) & 1) ? (tt & 63) : (tt >> 6);
                const float2* rt = (const float2*)ropet + pos * 32 + (tid & 3) * 8;
#pragma unroll
                for (int i = 0; i < 8; ++i) {
                    const float2 cs2 = rt[i];
                    const float q1 = q[i], q2 = q[8 + i], k1 = k[i], k2 = k[8 + i];
                    q[i] = q1 * cs2.x - q2 * cs2.y; q[8 + i] = q1 * cs2.y + q2 * cs2.x;
                    k[i] = k1 * cs2.x - k2 * cs2.y; k[8 + i] = k1 * cs2.y + k2 * cs2.x;
                }
            }
            const float wr = 0.08838834764831845f * fexp((float)(63 - lt) * lg);
            uint4 o0, o1, w0, w1, x0, x1;
            o0.x = cvt_pk_bf16(q[0], q[1]); o0.y = cvt_pk_bf16(q[2], q[3]); o0.z = cvt_pk_bf16(q[4], q[5]); o0.w = cvt_pk_bf16(q[6], q[7]);
            o1.x = cvt_pk_bf16(q[8], q[9]); o1.y = cvt_pk_bf16(q[10], q[11]); o1.z = cvt_pk_bf16(q[12], q[13]); o1.w = cvt_pk_bf16(q[14], q[15]);
            w0.x = cvt_pk_bf16(k[0], k[1]); w0.y = cvt_pk_bf16(k[2], k[3]); w0.z = cvt_pk_bf16(k[4], k[5]); w0.w = cvt_pk_bf16(k[6], k[7]);
            w1.x = cvt_pk_bf16(k[8], k[9]); w1.y = cvt_pk_bf16(k[10], k[11]); w1.z = cvt_pk_bf16(k[12], k[13]); w1.w = cvt_pk_bf16(k[14], k[15]);
            x0.x = cvt_pk_bf16(k[0] * wr, k[1] * wr); x0.y = cvt_pk_bf16(k[2] * wr, k[3] * wr); x0.z = cvt_pk_bf16(k[4] * wr, k[5] * wr); x0.w = cvt_pk_bf16(k[6] * wr, k[7] * wr);
            x1.x = cvt_pk_bf16(k[8] * wr, k[9] * wr); x1.y = cvt_pk_bf16(k[10] * wr, k[11] * wr); x1.z = cvt_pk_bf16(k[12] * wr, k[13] * wr); x1.w = cvt_pk_bf16(k[14] * wr, k[15] * wr);
            st16(L0 + O_QA + lt * QS + lj * 16, o0); st16(L0 + O_QA + lt * QS + lj * 16 + 64, o1);
            st16(L0 + O_KA + lt * QS + lj * 16, w0); st16(L0 + O_KA + lt * QS + lj * 16 + 64, w1);
            st16(L0 + O_KW + lt * QS + lj * 16, x0); st16(L0 + O_KW + lt * QS + lj * 16 + 64, x1);
            st16(L0 + O_V + vt_ * VS + vj * 16, rv);
        } else {
            const unsigned qa[4] = {rq0.x, rq0.y, rq0.z, rq0.w}, fa[4] = {rk0.x, rk0.y, rk0.z, rk0.w};
            float qv[8], kk[8], A[8];
#pragma unroll
            for (int i = 0; i < 8; ++i) {
                const float qr = (i & 1) ? bfhi(qa[i >> 1]) : bflo(qa[i >> 1]), fr = (i & 1) ? bfhi(fa[i >> 1]) : bflo(fa[i >> 1]);
                const float f = lbv[i] + (1.f - lbv[i]) * fsigmoid(fr);
                qv[i] = fsilu(qr); kk[i] = 1.f - f; A[i] = flog(f);
            }
#pragma unroll
            for (int o = 1; o < 32; o <<= 1)
#pragma unroll
                for (int i = 0; i < 8; ++i) { const float t = __shfl_up(A[i], o, 32); if (lt >= o) A[i] += t; }
            float qa_[8], qb_[8], ka_[8], kw_[8];
#pragma unroll
            for (int i = 0; i < 8; ++i) {
                const float am = __shfl(A[i], 15, 32), ae = __shfl(A[i], 31, 32);
                qa_[i] = qv[i] * fexp(A[i] - am); qb_[i] = qv[i] * fexp(A[i]); ka_[i] = kk[i] * fexp(am - A[i]); kw_[i] = kk[i] * fexp(ae - A[i]);
                if (lt == 31) *(LAS float*)(size_t)(L0 + O_DKV + (lj * 8 + i) * 4) = fexp(ae);
            }
            uint4 w;
            w.x = cvt_pk_bf16(qa_[0], qa_[1]); w.y = cvt_pk_bf16(qa_[2], qa_[3]); w.z = cvt_pk_bf16(qa_[4], qa_[5]); w.w = cvt_pk_bf16(qa_[6], qa_[7]); st16(L0 + O_QA + lt * QS + lj * 16, w);
            w.x = cvt_pk_bf16(qb_[0], qb_[1]); w.y = cvt_pk_bf16(qb_[2], qb_[3]); w.z = cvt_pk_bf16(qb_[4], qb_[5]); w.w = cvt_pk_bf16(qb_[6], qb_[7]); st16(L0 + O_QB + lt * QS + lj * 16, w);
            w.x = cvt_pk_bf16(ka_[0], ka_[1]); w.y = cvt_pk_bf16(ka_[2], ka_[3]); w.z = cvt_pk_bf16(ka_[4], ka_[5]); w.w = cvt_pk_bf16(ka_[6], ka_[7]); st16(L0 + O_KA + lt * QS + lj * 16, w);
            w.x = cvt_pk_bf16(kw_[0], kw_[1]); w.y = cvt_pk_bf16(kw_[2], kw_[3]); w.z = cvt_pk_bf16(kw_[4], kw_[5]); w.w = cvt_pk_bf16(kw_[6], kw_[7]); st16(L0 + O_KW + lt * QS + lj * 16, w);
            if (tid < 256) st16(L0 + O_V + vt_ * VS + vj * 16, rv);
        }
        __syncthreads();
        if (c + 1 < NCH) load_chunk(c + 1);
        {
            constexpr int NT1 = CS / 16;
            const bool act = (MODE == 1) ? (wv < 4) : true;
            const int tb = (MODE == 1) ? (wv & 1) : (wv & 3);
#pragma unroll
            for (int u2 = 0; u2 < ((MODE == 1) ? 1 : 2); ++u2) {
                const int sb = (MODE == 1) ? (wv >> 1) : 2 * (wv >> 2) + u2;
                if (act) {
                    f32x4 d = (f32x4){0.f, 0.f, 0.f, 0.f};
                    if (sb <= tb) {
#pragma unroll
                        for (int kk2 = 0; kk2 < DK / 32; ++kk2)
                            d = SC_MFMA(rd_row(L0 + O_KA, sb * 16 + r16, QS, kk2 * 32 + q4 * 8), rd_row(L0 + O_QA, tb * 16 + r16, QS, kk2 * 32 + q4 * 8), d);
                        const int t = tb * 16 + r16, s0 = sb * 16 + q4 * 4;
                        if (MODE == 0) {
                            const float Mt = __shfl(v_M, t, 64);
#pragma unroll
                            for (int jj = 0; jj < 4; ++jj) { const float us = __shfl(v_u, s0 + jj, 64); d[jj] = (s0 + jj <= t) ? d[jj] * 0.125f * fexp(us - Mt) : 0.f; }
                        } else if (MODE == 2) {
#pragma unroll
                            for (int jj = 0; jj < 4; ++jj) d[jj] = (s0 + jj <= t) ? d[jj] * 0.08838834764831845f * fexp((float)(t - s0 - jj) * lg) : 0.f;
                        } else {
#pragma unroll
                            for (int jj = 0; jj < 4; ++jj) d[jj] = (s0 + jj <= t) ? d[jj] : 0.f;
                        }
                    }
                    st8(L0 + O_SSC + (tb * 16 + r16) * SS + (sb * 16 + q4 * 4) * 2, make_uint2(cvt_pk_bf16(d[0], d[1]), cvt_pk_bf16(d[2], d[3])));
                }
            }
            (void)NT1;
        }
        __syncthreads();
        {
            const int tb = (MODE == 1) ? (wv & 1) : (wv & 3);
            const int t = tb * 16 + r16;
            const int tok = scan_tok(b, c * CS + t, dir);
            constexpr int NV = (MODE == 1) ? 1 : 2;
            f32x4 oi[NV + EXT], oo[NV + EXT];
#pragma unroll
            for (int u2 = 0; u2 < NV + EXT; ++u2) {
                const int vt = (u2 == NV) ? 4 : ((MODE == 1) ? (wv >> 1) : 2 * (wv >> 2) + u2);
                f32x4 a1 = (f32x4){0.f, 0.f, 0.f, 0.f}, a2 = a1;
#pragma unroll
                for (int sb2 = 0; sb2 < CS / 32; ++sb2)
                    a1 = SC_MFMA(rd_tr(L0 + O_V, sb2 * 32, vt * 16, VS, lane), rd_row(L0 + O_SSC, t, SS, sb2 * 32 + q4 * 8), a1);
#pragma unroll
                for (int kk2 = 0; kk2 < DK / 32; ++kk2)
                    a2 = SC_MFMA(rd_row(ST_R, vt * 16 + r16, QS, kk2 * 32 + q4 * 8), rd_row(L0 + ((MODE == 1) ? O_QB : O_QA), t, QS, kk2 * 32 + q4 * 8), a2);
                oi[u2] = a1; oo[u2] = a2;
            }
            float den = 1.f, ei = 1.f;
            if (MODE == 0) {
                ei = 0.125f * __shfl(v_e, t, 64);
                const float dsum = oi[NV][0] + ei * oo[NV][0];
                const float dd = __shfl(dsum, r16, 64);
                den = 1.f / fmaxf(fabsf(dd), __shfl(v_low, t, 64));
            } else if (MODE == 2) {
                ei = fexp((float)(t + 1) * lg);
            }
#pragma unroll
            for (int u2 = 0; u2 < NV; ++u2) {
                const int vt = (MODE == 1) ? (wv >> 1) : 2 * (wv >> 2) + u2;
                float o[4];
#pragma unroll
                for (int jj = 0; jj < 4; ++jj) o[jj] = (oi[u2][jj] + ei * oo[u2][jj]) * den;
                *(uint2*)(HXo + (size_t)tok * 1024 + cO + vt * 16 + q4 * 4) = make_uint2(cvt_pk_bf16(o[0], o[1]), cvt_pk_bf16(o[2], o[3]));
            }
        }
        {
            constexpr int NS = (MODE == 0) ? 3 : 4;
            const int kt = (MODE == 0) ? (wv & 3) : wv;
            float dk[4] = {sp, sp, sp, sp};
            if (MODE == 1) { const f32x4 dv = *(const LAS f32x4*)(size_t)(L0 + O_DKV + (kt * 16 + q4 * 4) * 4); dk[0] = dv[0]; dk[1] = dv[1]; dk[2] = dv[2]; dk[3] = dv[3]; }
#pragma unroll
            for (int u2 = 0; u2 < NS; ++u2) {
                const int vt = (MODE == 0) ? ((u2 == 2) ? 4 : 2 * (wv >> 2) + u2) : u2;
                f32x4 a = sacc[u2];
#pragma unroll
                for (int jj = 0; jj < 4; ++jj) a[jj] *= dk[jj];
#pragma unroll
                for (int sb2 = 0; sb2 < CS / 32; ++sb2)
                    a = SC_MFMA(rd_tr(L0 + O_KW, sb2 * 32, kt * 16, QS, lane), rd_tr(L0 + O_V, sb2 * 32, vt * 16, VS, lane), a);
                sacc[u2] = a;
                st8(ST_W + (vt * 16 + r16) * QS + (kt * 16 + q4 * 4) * 2, make_uint2(cvt_pk_bf16(a[0], a[1]), cvt_pk_bf16(a[2], a[3])));
            }
        }
        __syncthreads();
    }
}
}

__device__ __forceinline__ void ph_scan_even2(KP p, int l, int bid, int nb) {
#pragma unroll 1
    for (int item = bid; item < 256; item += nb) {
        const int kind = item >> 7, b = (item >> 4) & 7, h = (item >> 2) & 3, dir = (item >> 1) & 1, vs = item & 1;
        if (kind == 0) sc::scan_item<0>(p, l, b, h, dir, vs); else sc::scan_item<1>(p, l, b, h, dir, vs);
        __syncthreads();
    }
}
__device__ __forceinline__ void ph_scan_odd2(KP p, int l, int bid, int nb) {
#pragma unroll 1
    for (int item = bid; item < 128; item += nb) {
        const int b = (item >> 4) & 7, h = (item >> 2) & 3, dir = (item >> 1) & 1, vs = item & 1;
        sc::scan_item<2>(p, l, b, h, dir, vs);
        __syncthreads();
    }
}

__device__ __forceinline__ void ph_normgate_even(KP p, int l, int bid, int nb) {
    const int tid = opaque_tid(), lane = tid & 63, wv = tid >> 6;
    const bf16_t* P = (const bf16_t*)(p->ws + OFF_BIG);
    const bf16_t* HX = (const bf16_t*)(p->ws + OFF_AUX);
    const bf16_t* HX1 = HX + (size_t)NT * 1024;
    bf16_t* MIX = (bf16_t*)(p->ws + OFF_U);
    const int e = l >> 1;
    #pragma unroll 1
    for (int it = bid * 8 + wv; it < NT * 8; it += nb * 8) {
        const int tok = it >> 3, g = it & 7;
        const size_t hxo = (size_t)tok * 1024 + g * 128;
        float x0 = bf2f(HX[hxo + lane]) + bf2f(HX1[hxo + lane]), x1 = bf2f(HX[hxo + lane + 64]) + bf2f(HX1[hxo + lane + 64]);
        const bf16_t* pr = P + (size_t)tok * EVEN_LD;
        if (g < 4) {
            const float mean = wave_sum(x0 + x1) * (1.f / 128.f);
            x0 -= mean; x1 -= mean;
            const float var = wave_sum(x0 * x0 + x1 * x1) * (1.f / 128.f);
            const float r = rsqrtf(var + LN_EPS);
            const float* nw = p->in[I_MNW] + e * 512 + g * 128;
            const float o0 = ldf(pr + E_MO + g * 128 + lane), o1 = ldf(pr + E_MO + g * 128 + lane + 64);
            stf(MIX + (size_t)tok * DM + g * 128 + lane, x0 * r * nw[lane] * sigmoidf_(o0));
            stf(MIX + (size_t)tok * DM + g * 128 + lane + 64, x1 * r * nw[lane + 64] * sigmoidf_(o1));
        } else {
            const int h = g - 4;
            const float ms = wave_sum(x0 * x0 + x1 * x1) * (1.f / 128.f);
            const float r = rsqrtf(ms + LN_EPS);
            const float* nw = p->in[I_HNW] + e * 512 + h * 128;
            const float g0 = ldf(pr + E_HG + h * 128 + lane), g1 = ldf(pr + E_HG + h * 128 + lane + 64);
            stf(MIX + (size_t)tok * DM + 512 + h * 128 + lane, x0 * r * nw[lane] * siluf_(g0));
            stf(MIX + (size_t)tok * DM + 512 + h * 128 + lane + 64, x1 * r * nw[lane + 64] * siluf_(g1));
        }
    }
}


#define OFF_UT   (OFF_AUX + 136 * MiB)
#define OFF_FK   (OFF_UT + 102 * MiB)
#define OFF_FKC  (OFF_FK + 32 * MiB)
#define OFF_ZOT  (OFF_FKC + 2 * MiB)

__device__ __forceinline__ void ph_hy_filt2(KP p, int l, int bid, int nb, float* sm) {
    const int tid = opaque_tid(), o = l >> 1;
    float* zf = sm;
    float* h1 = sm + 1024;
    float* h2 = sm + 2048;
    float* h3 = sm + 3072;
    const float* fw1 = p->in[I_HW1] + o * 33 * 64; const float* fb1 = p->in[I_HB1] + o * 64;
    const float* fw2 = p->in[I_HW2] + o * 64 * 64; const float* fb2 = p->in[I_HB2] + o * 64;
    const float* fw3 = p->in[I_HW3] + o * 64 * 64; const float* fb3 = p->in[I_HB3] + o * 64;
    const float* freq = p->in[I_HFREQ] + o * 64;
    const float* wout = p->in[I_HWOUT] + (size_t)o * 64 * 2048;
    float* FK = (float*)(p->ws + OFF_FK); float* FKC = (float*)(p->ws + OFF_FKC);
#pragma unroll 1
    for (int item = bid; item < (SEQ + CTXL) / 16; item += nb) {
        const bool isctx = item >= SEQ / 16;
        const int L = isctx ? CTXL : SEQ, pos0 = (isctx ? item - SEQ / 16 : item) * 16;
        __syncthreads();
        if (tid < 16 * 17) {
            const int pp = tid / 17, j = tid % 17, pos = pos0 + pp;
            if (j == 16) zf[pp * 36] = (float)pos / (float)(L - 1);
            else { const float f = 1e-4f + (float)j * ((15.0f - 1e-4f) / 15.0f); const float w = 2.0f * 3.14159265358979323846f * (float)pos / (float)L * f; zf[pp * 36 + 1 + j] = cosf(w); zf[pp * 36 + 17 + j] = sinf(w); }
        }
        __syncthreads();
        const int pp = tid >> 5, u0 = (tid & 31) * 2;
        { float a0 = fb1[u0], a1 = fb1[u0 + 1];
#pragma unroll 1
          for (int k = 0; k < 33; ++k) { const float z = zf[pp * 36 + k]; a0 += z * fw1[k * 64 + u0]; a1 += z * fw1[k * 64 + u0 + 1]; }
          h1[pp * 64 + u0] = sinf(freq[u0] * a0); h1[pp * 64 + u0 + 1] = sinf(freq[u0 + 1] * a1); }
        __syncthreads();
        { float a0 = fb2[u0], a1 = fb2[u0 + 1];
#pragma unroll 4
          for (int k = 0; k < 64; ++k) { const float z = h1[pp * 64 + k]; a0 += z * fw2[k * 64 + u0]; a1 += z * fw2[k * 64 + u0 + 1]; }
          h2[pp * 64 + u0] = sinf(freq[u0] * a0); h2[pp * 64 + u0 + 1] = sinf(freq[u0 + 1] * a1); }
        __syncthreads();
        { float a0 = fb3[u0], a1 = fb3[u0 + 1];
#pragma unroll 4
          for (int k = 0; k < 64; ++k) { const float z = h2[pp * 64 + k]; a0 += z * fw3[k * 64 + u0]; a1 += z * fw3[k * 64 + u0 + 1]; }
          h3[pp * 64 + u0] = sinf(freq[u0] * a0); h3[pp * 64 + u0 + 1] = sinf(freq[u0 + 1] * a1); }
        __syncthreads();
#pragma unroll 1
        for (int r = 0; r < 4; ++r) {
            const int col = tid + 512 * r, c = col & 511, od = col >> 9, order = od >> 1, dirn = od & 1;
            float a[16];
#pragma unroll
            for (int i = 0; i < 16; ++i) a[i] = 0.f;
#pragma unroll 2
            for (int k = 0; k < 64; ++k) { const float w = wout[k * 2048 + col];
#pragma unroll
                for (int i = 0; i < 16; ++i) a[i] += h3[i * 64 + k] * w; }
            const float delta = 3.0701134573253944f + (float)c * ((15.350567286626972f - 3.0701134573253944f) / 511.0f);
#pragma unroll
            for (int i = 0; i < 16; ++i) a[i] *= expf(-((float)(pos0 + i) / (float)(L - 1)) * delta);
            float* dst = isctx ? FKC + ((size_t)order * 512 + c) * 512 + 256 : FK + ((size_t)order * 512 + c) * 8192 + 4096;
            if (dirn == 0) {
#pragma unroll
                for (int i = 0; i < 16; i += 4) *(float4*)(dst + pos0 + i) = make_float4(a[i], a[i + 1], a[i + 2], a[i + 3]);
            } else {
#pragma unroll
                for (int i = 0; i < 16; ++i) if (pos0 + i > 0) dst[-(pos0 + i)] = a[i];
                if (pos0 == 0) dst[-L] = 0.f;
            }
        }
    }
}

__device__ __forceinline__ void ph_hy_prep(KP p, int l, int bid, int nb, float* sm) {
    const int tid = opaque_tid(), o = l >> 1;
    const bf16_t* P = (const bf16_t*)(p->ws + OFF_BIG);
    bf16_t* UT = (bf16_t*)(p->ws + OFF_UT);
    const float* cw = p->in[I_HCW] + o * 3 * 1536; const float* cb = p->in[I_HCB] + o * 1536;
    float* tile = sm;
#pragma unroll 1
    for (int item = bid; item < (NT / 256) * 96; item += nb) {
        const int tt = item / 96, ct = item % 96, tok0 = tt * 256, col0 = ct * 16;
        const bool lat = tok0 < NL;
        const int L = lat ? SEQ : CTXL, t0 = lat ? (tok0 & (SEQ - 1)) : ((tok0 - NL) & (CTXL - 1));
        __syncthreads();
        for (int i = tid; i < 258 * 2; i += 512) {
            const int rr = i >> 1, hf = i & 1, t = t0 + rr - 1;
            uint4 v = make_uint4(0u, 0u, 0u, 0u);
            if (t >= 0 && t < L) v = *(const uint4*)(P + (size_t)(tok0 + rr - 1) * ODD_LD + col0 + hf * 8);
            float* d = tile + rr * 17 + hf * 8;
            d[0] = bflo(v.x); d[1] = bfhi(v.x); d[2] = bflo(v.y); d[3] = bfhi(v.y); d[4] = bflo(v.z); d[5] = bfhi(v.z); d[6] = bflo(v.w); d[7] = bfhi(v.w);
        }
        __syncthreads();
        const int cc = tid >> 5, tc = (tid & 31) * 8, col = col0 + cc;
        const float w0 = cw[col], w1 = cw[1536 + col], w2 = cw[3072 + col], bb = cb[col];
        float y[8];
#pragma unroll
        for (int i = 0; i < 8; ++i) y[i] = tile[(tc + i) * 17 + cc] * w0 + tile[(tc + i + 1) * 17 + cc] * w1 + tile[(tc + i + 2) * 17 + cc] * w2 + bb;
        *(uint4*)(UT + (size_t)col * NT + tok0 + tc) = make_uint4(cvt_pk_bf16(y[0], y[1]), cvt_pk_bf16(y[2], y[3]), cvt_pk_bf16(y[4], y[5]), cvt_pk_bf16(y[6], y[7]));
    }
}

__device__ __forceinline__ void hy_item_lat(KP p, int l, int c) {
    constexpr int ZSB = (SEQ + 8) * 2;
    constexpr unsigned O_Z = 0, O_KF = O_Z + 8 * ZSB, O_T = O_KF + 8192 * 4, O_END = O_T + 2 * 64 * 144;
    static_assert(O_END <= 131072, "hyena LDS");
    const int tid = opaque_tid(), lane = tid & 63, wv = __builtin_amdgcn_readfirstlane(tid >> 6), r16 = lane & 15, q4 = lane >> 4, o = l >> 1;
    const unsigned L0 = (unsigned)(size_t)smraw_base();
    const bf16_t* UT = (const bf16_t*)(p->ws + OFF_UT);
    bf16_t* ZOT = (bf16_t*)(p->ws + OFF_ZOT);
    const float* FK = (const float*)(p->ws + OFF_FK);
    for (int i = tid; i < 8 * 512; i += 512) { const int b = i >> 9, ch = i & 511; sc::st16(L0 + O_Z + b * ZSB + ch * 16, *(const uint4*)(UT + (size_t)(1024 + c) * NT + b * SEQ + ch * 8)); }
#pragma unroll 1
    for (int order = 0; order < 2; ++order) {
        const float* fk = FK + ((size_t)order * 512 + c) * 8192;
        for (int i = tid; i < 2048; i += 512) { const float4 v = *(const float4*)(fk + i * 4); *(LAS sc::f32x4*)(size_t)(L0 + O_KF + i * 16) = (sc::f32x4){v.x, v.y, v.z, v.w}; }
        __syncthreads();
        sc::f32x4 acc[4][4];
#pragma unroll
        for (int a = 0; a < 4; ++a)
#pragma unroll
            for (int b2 = 0; b2 < 4; ++b2) acc[a][b2] = (sc::f32x4){0.f, 0.f, 0.f, 0.f};
        auto build_T = [&](int D, int buf) {
            const int t2 = tid >> 3, ch = tid & 7;
            const unsigned base = L0 + O_KF + (unsigned)(4096 + 64 * D + t2 - 8 * ch) * 4u;
            float v[8];
#pragma unroll
            for (int j = 0; j < 8; ++j) v[j] = *(const LAS float*)(size_t)(base - 4u * j);
            sc::st16(L0 + O_T + buf * 9216 + t2 * 144 + ch * 16, make_uint4(cvt_pk_bf16(v[0], v[1]), cvt_pk_bf16(v[2], v[3]), cvt_pk_bf16(v[4], v[5]), cvt_pk_bf16(v[6], v[7])));
        };
        build_T(-63, 1);
        __syncthreads();
#pragma unroll 1
        for (int D = -63; D <= 63; ++D) {
            const int buf = D & 1;
            if (D < 63) build_T(D + 1, buf ^ 1);
            const unsigned TB = L0 + O_T + buf * 9216;
            sc::bf16x8 af[4][2];
#pragma unroll
            for (int it = 0; it < 4; ++it)
#pragma unroll
                for (int kk = 0; kk < 2; ++kk) af[it][kk] = sc::rd_row(TB, it * 16 + r16, 144, kk * 32 + q4 * 8);
#pragma unroll
            for (int cg = 0; cg < 4; ++cg) {
                const int tA = wv + 8 * cg, sA = tA - D, sB = tA + 32 - D;
                const bool vA = (unsigned)sA < 64u, vB = (unsigned)sB < 64u;
                if (vA || vB) {
                    const int s1 = (r16 < 8) ? sA : sB;
                    const bool ok = (unsigned)s1 < 64u;
                    const unsigned za = L0 + O_Z + (unsigned)((r16 & 7) * ZSB + ((ok ? s1 : 0) * 64 + q4 * 8) * 2);
                    sc::bf16x8 b0 = *(const LAS sc::bf16x8*)(size_t)za, b1 = *(const LAS sc::bf16x8*)(size_t)(za + 64);
                    if (!ok) { b0 = (sc::bf16x8){0, 0, 0, 0, 0, 0, 0, 0}; b1 = b0; }
#pragma unroll
                    for (int it = 0; it < 4; ++it) { acc[cg][it] = SC_MFMA(af[it][0], b0, acc[cg][it]); acc[cg][it] = SC_MFMA(af[it][1], b1, acc[cg][it]); }
                }
            }
            __syncthreads();
        }
        const float sk = p->in[I_HSKIP][o * 1024 + order * 512 + c];
        const bf16_t* gt = UT + (size_t)(order * 512 + c) * NT;
        const int bb = r16 & 7;
#pragma unroll
        for (int cg = 0; cg < 4; ++cg) {
            const int t1 = wv + 8 * cg + ((r16 < 8) ? 0 : 32);
#pragma unroll
            for (int it = 0; it < 4; ++it) {
                const int t = t1 * 64 + it * 16 + q4 * 4;
                const sc::u32x2_ zo_ = *(const LAS sc::u32x2_*)(size_t)(L0 + O_Z + bb * ZSB + t * 2); const uint2 zo = make_uint2(zo_[0], zo_[1]);
                const uint2 gv = *(const uint2*)(gt + bb * SEQ + t);
                const float y0 = bflo(gv.x) * (acc[cg][it][0] + sk * bflo(zo.x)), y1 = bfhi(gv.x) * (acc[cg][it][1] + sk * bfhi(zo.x));
                const float y2 = bflo(gv.y) * (acc[cg][it][2] + sk * bflo(zo.y)), y3 = bfhi(gv.y) * (acc[cg][it][3] + sk * bfhi(zo.y));
                const uint2 w = make_uint2(cvt_pk_bf16(y0, y1), cvt_pk_bf16(y2, y3));
                if (order == 0) sc::st8(L0 + O_Z + bb * ZSB + t * 2, w);
                else *(uint2*)(ZOT + (size_t)c * NT + bb * SEQ + t) = w;
            }
        }
        __syncthreads();
    }
}

__device__ __forceinline__ void hy_item_ctx(KP p, int l, int c, float* sm) {
    const int tid = opaque_tid(), o = l >> 1;
    const bf16_t* UT = (const bf16_t*)(p->ws + OFF_UT);
    bf16_t* ZOT = (bf16_t*)(p->ws + OFF_ZOT);
    const float* FKC = (const float*)(p->ws + OFF_FKC);
    float* Kc = sm;
    float* zb = sm + 1024;
    for (int i = tid; i < 1024; i += 512) Kc[i] = FKC[((size_t)(i >> 9) * 512 + c) * 512 + (i & 511)];
    for (int i = tid; i < 8 * CTXL; i += 512) zb[i] = bf2f(UT[(size_t)(1024 + c) * NT + NL + i]);
    __syncthreads();
    const int bb = tid >> 6, tl = tid & 63;
#pragma unroll 1
    for (int order = 0; order < 2; ++order) {
        float acc[4] = {0.f, 0.f, 0.f, 0.f};
#pragma unroll 4
        for (int s = 0; s < CTXL; ++s) {
            const float zv = zb[bb * CTXL + s];
#pragma unroll
            for (int i = 0; i < 4; ++i) acc[i] += Kc[order * 512 + tl + 64 * i - s + 256] * zv;
        }
        const float sk = p->in[I_HSKIP][o * 1024 + order * 512 + c];
        float zn[4];
#pragma unroll
        for (int i = 0; i < 4; ++i) { const int t = tl + 64 * i; zn[i] = bf2f(UT[(size_t)(order * 512 + c) * NT + NL + bb * CTXL + t]) * (acc[i] + zb[bb * CTXL + t] * sk); }
        __syncthreads();
#pragma unroll
        for (int i = 0; i < 4; ++i) { const int t = tl + 64 * i; if (order == 0) zb[bb * CTXL + t] = bf2f((bf16_t)(cvt_pk_bf16(zn[i], 0.f) & 0xffffu)); else stf(ZOT + (size_t)c * NT + NL + bb * CTXL + t, zn[i]); }
        __syncthreads();
    }
}

__device__ __forceinline__ void ph_mix_odd(KP p, int l, int bid, int nb, float* sm) {
    int* head = (int*)(p->ws + OFF_CNT) + 1024 + (l >> 1) * 64;
    LAS int* slot = (LAS int*)(smraw_base() + BAR_LDS_ + 64);
#pragma unroll 1
    for (;;) {
        if (threadIdx.x == 0) *slot = atomicAdd(head, 1);
        __syncthreads();
        const int item = *slot;
        __syncthreads();
        if (item >= 128 + 512) break;
        if (item < 128) { const int b = (item >> 4) & 7, h = (item >> 2) & 3, dir = (item >> 1) & 1, vs = item & 1; sc::scan_item<2>(p, l, b, h, dir, vs); }
        else { const int c = item - 128; hy_item_lat(p, l, c); __syncthreads(); hy_item_ctx(p, l, c, sm); }
        __syncthreads();
    }
}

__device__ __forceinline__ void ph_hy_norm(KP p, int l, int bid, int nb, float* sm) {
    const int tid = opaque_tid(), o = l >> 1;
    const bf16_t* ZOT = (const bf16_t*)(p->ws + OFF_ZOT);
    bf16_t* MIX = (bf16_t*)(p->ws + OFF_U);
    const float* nw = p->in[I_HNORM] + o * 512;
    float* tile = sm;
    float* part = sm + 64 * 65;
#pragma unroll 1
    for (int item = bid; item < (NT / 64) * 8; item += nb) {
        const int tt = item >> 3, g = item & 7, tok0 = tt * 64;
        __syncthreads();
        { const int cc = tid >> 3, ch = tid & 7;
          const uint4 v = *(const uint4*)(ZOT + (size_t)(g * 64 + cc) * NT + tok0 + ch * 8);
          float* d = tile + cc * 65 + ch * 8;
          d[0] = bflo(v.x); d[1] = bfhi(v.x); d[2] = bflo(v.y); d[3] = bfhi(v.y); d[4] = bflo(v.z); d[5] = bfhi(v.z); d[6] = bflo(v.w); d[7] = bfhi(v.w); }
        __syncthreads();
        { const int tk = tid & 63, pt = tid >> 6; float s = 0.f;
#pragma unroll
          for (int i = 0; i < 8; ++i) { const float x = tile[(pt * 8 + i) * 65 + tk]; s += x * x; }
          part[pt * 64 + tk] = s; }
        __syncthreads();
        { const int tk = tid >> 3, ch = tid & 7; float s = 0.f;
#pragma unroll
          for (int i = 0; i < 8; ++i) s += part[i * 64 + tk];
          const float rs = rsqrtf(s * (1.f / 64.f) + LN_EPS);
          float y[8];
#pragma unroll
          for (int i = 0; i < 8; ++i) y[i] = tile[(ch * 8 + i) * 65 + tk] * rs * nw[g * 64 + ch * 8 + i];
          *(uint4*)(MIX + (size_t)(tok0 + tk) * DM + g * 64 + ch * 8) = make_uint4(cvt_pk_bf16(y[0], y[1]), cvt_pk_bf16(y[2], y[3]), cvt_pk_bf16(y[4], y[5]), cvt_pk_bf16(y[6], y[7])); }
    }
}

__device__ __forceinline__ void ph_normgate_odd(KP p, int l, int bid, int nb) {
    const int tid = opaque_tid(), lane = tid & 63, wv = tid >> 6, o = l >> 1;
    const bf16_t* P = (const bf16_t*)(p->ws + OFF_BIG);
    const bf16_t* HX = (const bf16_t*)(p->ws + OFF_AUX);
    const bf16_t* HX1 = HX + (size_t)NT * 1024;
    bf16_t* MIX = (bf16_t*)(p->ws + OFF_U);
    #pragma unroll 1
    for (int tok = bid * 8 + wv; tok < NT; tok += nb * 8) {
        const bf16_t* pr = P + (size_t)tok * ODD_N;
#pragma unroll
        for (int h = 0; h < 4; ++h) {
            const size_t hxo = (size_t)tok * 1024 + 512 + h * 128;
            float x0 = bf2f(HX[hxo + lane]) + bf2f(HX1[hxo + lane]), x1 = bf2f(HX[hxo + lane + 64]) + bf2f(HX1[hxo + lane + 64]);
            const float mean = wave_sum(x0 + x1) * (1.f / 128.f);
            x0 -= mean; x1 -= mean;
            const float var = wave_sum(x0 * x0 + x1 * x1) * (1.f / 128.f);
            const float r = rsqrtf(var + LN_EPS);
            const float* nw = p->in[I_RNW] + o * 512 + h * 128;
            const float g0 = ldf(pr + 3072 + h * 128 + lane), g1 = ldf(pr + 3072 + h * 128 + lane + 64);
            stf(MIX + (size_t)tok * DM + 512 + h * 128 + lane, x0 * r * nw[lane] * siluf_(g0));
            stf(MIX + (size_t)tok * DM + 512 + h * 128 + lane + 64, x1 * r * nw[lane + 64] * siluf_(g1));
        }
    }
}


__device__ __forceinline__ void ph_ln1_router(KP p, int l, int ntok, int bid, int nb, float* sm) {
    const int tid = opaque_tid(), lane = tid & 63, wv = tid >> 6;
    const float* Y = (const float*)(p->ws + OFF_BIG);
    bf16_t* U = (bf16_t*)(p->ws + OFF_U);
    const float* lw = p->in[I_LNW] + (l * 2) * 1024; const float* lb = p->in[I_LNB] + (l * 2) * 1024;
    const float* rw = p->in[I_RW] + (size_t)l * 1024 * 64;
    const float rb = p->in[I_RB][l * 64 + lane];
    int* cnt = (int*)(p->ws + OFF_CNT) + l * 64;
    int* tidx = (int*)(p->ws + OFF_TIDX); float* tgate = (float*)(p->ws + OFF_TGATE); int* tpos = (int*)(p->ws + OFF_TPOS);
    LAS float* Vs = (LAS float*)smraw_base() + wv * 4096;
    {
        int* stok = (int*)(p->ws + OFF_STOK); float* sgate = (float*)(p->ws + OFF_SGATE); int* sdst = (int*)(p->ws + OFF_SDST);
        #pragma unroll 1
        for (int i = bid * 512 + tid; i < MAXROWS; i += nb * 512) { stok[i] = ZROW; sgate[i] = 0.f; sdst[i] = -1; }
    }
    #pragma unroll 1
    for (int base = bid * 32; base < ntok; base += nb * 32) {
#pragma unroll 1
        for (int j = 0; j < 4; ++j) {
            const int tok = base + wv * 4 + j;
            float* h = hrow(p, tok);
            const float* m = modrow(p, l, tok);
            const float* r = Y + (size_t)tok * DM;
            float x[16]; float s = 0.f;
#pragma unroll
            for (int c = 0; c < 4; ++c) {
                const int d = 4 * (lane + 64 * c);
                const float4 hv = *(const float4*)(h + d), gv = *(const float4*)(m + 2 * 1024 + d), rv = *(const float4*)(r + d);
                x[4 * c] = ALPHA * hv.x + gv.x * rv.x; x[4 * c + 1] = ALPHA * hv.y + gv.y * rv.y; x[4 * c + 2] = ALPHA * hv.z + gv.z * rv.z; x[4 * c + 3] = ALPHA * hv.w + gv.w * rv.w;
                s += x[4 * c] + x[4 * c + 1] + x[4 * c + 2] + x[4 * c + 3];
            }
            const float mean = wave_sum(s) * (1.f / 1024.f);
            float q = 0.f;
#pragma unroll
            for (int i = 0; i < 16; ++i) { x[i] -= mean; q += x[i] * x[i]; }
            const float rs = rsqrtf(wave_sum(q) * (1.f / 1024.f) + LN_EPS);
#pragma unroll
            for (int c = 0; c < 4; ++c) {
                const int d = 4 * (lane + 64 * c);
                const float4 w4 = *(const float4*)(lw + d), b4 = *(const float4*)(lb + d), sh = *(const float4*)(m + 3 * 1024 + d), sc = *(const float4*)(m + 4 * 1024 + d);
                float4 y; y.x = x[4 * c] * rs * w4.x + b4.x; y.y = x[4 * c + 1] * rs * w4.y + b4.y; y.z = x[4 * c + 2] * rs * w4.z + b4.z; y.w = x[4 * c + 3] * rs * w4.w + b4.w;
                *(float4*)(h + d) = y;
                float4 v; v.x = y.x * (1.f + sc.x) + sh.x; v.y = y.y * (1.f + sc.y) + sh.y; v.z = y.z * (1.f + sc.z) + sh.z; v.w = y.w * (1.f + sc.w) + sh.w;
                *(uint2*)(U + (size_t)tok * DM + d) = make_uint2(cvt_pk_bf16(v.x, v.y), cvt_pk_bf16(v.z, v.w));
                *(LAS sc::f32x4*)(Vs + j * 1024 + d) = (sc::f32x4){v.x, v.y, v.z, v.w};
            }
        }
        __syncthreads();
        float a[4] = {0.f, 0.f, 0.f, 0.f};
#pragma unroll 4
        for (int d = 0; d < 1024; d += 4) {
            const float w0 = rw[(d + 0) * 64 + lane], w1 = rw[(d + 1) * 64 + lane], w2 = rw[(d + 2) * 64 + lane], w3 = rw[(d + 3) * 64 + lane];
#pragma unroll
            for (int j = 0; j < 4; ++j) { const sc::f32x4 v = *(const LAS sc::f32x4*)(Vs + j * 1024 + d); a[j] += v[0] * w0 + v[1] * w1 + v[2] * w2 + v[3] * w3; }
        }
#pragma unroll
        for (int j = 0; j < 4; ++j) {
            const int tok = base + wv * 4 + j;
            const float score = sigmoidf_(a[j]);
            float key = score + rb;
            float mysel = 0.f; int myidx = 0; float gsum = 0.f;
#pragma unroll
            for (int s = 0; s < TOPK; ++s) {
                float bv = key; int bi = lane;
#pragma unroll
                for (int o = 32; o > 0; o >>= 1) {
                    const float ov = __shfl_xor(bv, o, 64); const int oi = __shfl_xor(bi, o, 64);
                    if (ov > bv || (ov == bv && oi < bi)) { bv = ov; bi = oi; }
                }
                const float sc = __shfl(score, bi, 64);
                gsum += sc;
                if (lane == s) { mysel = sc; myidx = bi; }
                if (lane == bi) key = -1e30f;
            }
            if (lane < TOPK) {
                const int pos = atomicAdd(&cnt[myidx], 1);
                tidx[tok * 8 + lane] = myidx; tgate[tok * 8 + lane] = 2.5f * mysel / gsum; tpos[tok * 8 + lane] = pos;
            }
        }
        __syncthreads();
    }
}

__device__ __forceinline__ void moe_offsets(KP p, int l, int ntok, LAS int* offs) {
    const int lane = opaque_tid();
    if (lane < 64) {
        int* cnt = (int*)(p->ws + OFF_CNT) + l * 64;
        const int pc = (__hip_atomic_load(cnt + lane, __ATOMIC_RELAXED, __HIP_MEMORY_SCOPE_AGENT) + 255) & ~255;
        int incl = pc;
#pragma unroll
        for (int o = 1; o < 64; o <<= 1) { const int t = __shfl_up(incl, o, 64); if (lane >= o) incl += t; }
        offs[lane] = incl - pc;
        if (lane == 63) { offs[64] = incl; offs[65] = incl + ntok; }
    }
    __syncthreads();
}
__device__ __forceinline__ int moe_expert_of(const LAS int* offs, int row) { int e = 0;
#pragma unroll 1
    while (e < 64 && row >= offs[e + 1]) ++e;
    return e; }

__device__ __forceinline__ void ph_scatter(KP p, int l, int ntok, int bid, int nb, LAS unsigned char* lds) {
    LAS int* offs = (LAS int*)lds;
    moe_offsets(p, l, ntok, offs);
    const int tid = opaque_tid();
    const int* tidx = (const int*)(p->ws + OFF_TIDX); const float* tgate = (const float*)(p->ws + OFF_TGATE); const int* tpos = (const int*)(p->ws + OFF_TPOS);
    int* stok = (int*)(p->ws + OFF_STOK); float* sgate = (float*)(p->ws + OFF_SGATE); int* sdst = (int*)(p->ws + OFF_SDST);
    int* tile_e = (int*)(p->ws + OFF_TILEE);
    #pragma unroll 1
    for (int i = bid * 512 + tid; i < ntok * 9; i += nb * 512) {
        if (i < ntok * 8) { const int row = offs[tidx[i]] + tpos[i], tok = i >> 3; stok[row] = tok; sgate[row] = tgate[i]; sdst[row] = tok * 9 + (i & 7); }
        else { const int tok = i - ntok * 8, row = offs[64] + tok; stok[row] = tok; sgate[row] = 1.f; sdst[row] = tok * 9 + 8; }
    }
    const int nrt = offs[65] >> 8;
    #pragma unroll 1
    for (int rt = bid * 512 + tid; rt < nrt; rt += nb * 512) tile_e[rt] = moe_expert_of(offs, rt * 256);
    __syncthreads();
}

#define MOE_TAB (gp::STAGE_BYTES + 256)
#define MOE_MAXT 8
struct Moe1Sched {
    const char* U; const char* W; const LAS int* tabE; const LAS int* tabS; int nper, bid, nb;
    __device__ __forceinline__ bool next(int i, gp::Unit& u) const {
        const int j = i >> 1; if (j >= nper) return false;
        u.A = U; u.B = W + (size_t)tabE[j] * (512 * 1024 * 2) + (size_t)(i & 1) * (256 * 1024 * 2); u.r0 = (bid + j * nb) * 256; u.c0 = (i & 1) * 256; u.aux = j; return true;
    }
    __device__ __forceinline__ void lane_off(const gp::Unit& u, int R0, int R1, int C0, int C1, unsigned (&vo)[2][2]) const {
        const LAS int* t = tabS + u.aux * 256;
        vo[0][0] = (unsigned)t[R0] * 2048u + (unsigned)C0 * 2u; vo[0][1] = (unsigned)t[R1] * 2048u + (unsigned)C1 * 2u;
        vo[1][0] = (unsigned)t[128 + R0] * 2048u + (unsigned)C0 * 2u; vo[1][1] = (unsigned)t[128 + R1] * 2048u + (unsigned)C1 * 2u;
    }
};
struct EpiH {
    bf16_t* H;
    __device__ __forceinline__ void operator()(const gp::f32x4 (&acc)[2][2][4][2], const gp::Unit& u, int wr, int wc, int fr, int fq) const {
        const int row0 = u.r0 + wr * 64 + fr;
#pragma unroll
        for (int ai = 0; ai < 2; ++ai)
#pragma unroll
            for (int m = 0; m < 4; ++m) { bf16_t* rowp = H + (size_t)(row0 + ai * 128 + m * 16) * 256;
#pragma unroll
                for (int bj = 0; bj < 2; ++bj) {
                    const int j0 = ((u.c0 + bj * 128 + wc * 32) >> 5) * 16 + 4 * fq;
                    const gp::f32x4 a = acc[ai][bj][m][0], b = acc[ai][bj][m][1];
                    const float h0 = siluf_(a[0]) * b[0], h1 = siluf_(a[1]) * b[1], h2 = siluf_(a[2]) * b[2], h3 = siluf_(a[3]) * b[3];
                    *(uint2*)(rowp + j0) = make_uint2(cvt_pk_bf16(h0, h1), cvt_pk_bf16(h2, h3)); }
                __builtin_amdgcn_sched_barrier(0); }
    }
};
__device__ __forceinline__ void ph_moe1(KP p, int l, int ntok, int bid, int nb, LAS unsigned char* lds) {
    LAS int* offs = (LAS int*)(lds + MOE_TAB);
    LAS int* tabE = offs + 128;
    LAS int* tabS = offs + 256;
    moe_offsets(p, l, ntok, offs);
    const int tid = opaque_tid();
    const int nrt = offs[65] >> 8;
    const int nper = bid < nrt ? (nrt - bid + nb - 1) / nb : 0;
    const int* stok = (const int*)(p->ws + OFF_STOK); const int* tile_e = (const int*)(p->ws + OFF_TILEE);
    for (int i = tid; i < nper * 256; i += 512) tabS[i] = stok[(size_t)(bid + (i >> 8) * nb) * 256 + (i & 255)];
    if (tid < nper) tabE[tid] = tile_e[bid + tid * nb];
    __syncthreads();
    Moe1Sched S{(const char*)(p->ws + OFF_U), (const char*)(p->ws + OFF_W13), tabE, tabS, nper, bid, nb};
    EpiH E{(bf16_t*)(p->ws + OFF_BIG)};
    gp::gemm_phase<true, false>(lds, 1024, S, E);
}

struct Moe2Sched {
    const char* H; const char* W; const LAS int* tabE; int nper, bid, nb;
    __device__ __forceinline__ bool next(int i, gp::Unit& u) const {
        const int j = i >> 2; if (j >= nper) return false;
        u.A = H + (size_t)(bid + j * nb) * (256 * 256 * 2); u.B = W + (size_t)tabE[j] * (1024 * 256 * 2) + (size_t)(i & 3) * (256 * 256 * 2); u.r0 = j * 256; u.c0 = (i & 3) * 256; u.aux = j; return true;
    }
    __device__ __forceinline__ void lane_off(const gp::Unit&, int, int, int, int, unsigned (&)[2][2]) const {}
};
struct EpiY {
    bf16_t* Ys; const LAS int* tabD; const LAS float* tabG;
    __device__ __forceinline__ void operator()(const gp::f32x4 (&acc)[2][2][4][2], const gp::Unit& u, int wr, int wc, int fr, int fq) const {
        const int rl0 = u.r0 + wr * 64 + fr, col0 = u.c0 + wc * 32 + 8 * fq;
#pragma unroll
        for (int ai = 0; ai < 2; ++ai)
#pragma unroll
            for (int m = 0; m < 4; ++m) {
                const int rl = rl0 + ai * 128 + m * 16;
                const int dst = tabD[rl]; const float g = tabG[rl];
                if (dst >= 0) { bf16_t* rowp = Ys + (size_t)dst * 1024 + col0;
#pragma unroll
                    for (int bj = 0; bj < 2; ++bj) { const gp::f32x4 v0 = acc[ai][bj][m][0] * g, v1 = acc[ai][bj][m][1] * g;
                        gp::u32x4 w; w.x = cvt_pk_bf16(v0[0], v0[1]); w.y = cvt_pk_bf16(v0[2], v0[3]); w.z = cvt_pk_bf16(v1[0], v1[1]); w.w = cvt_pk_bf16(v1[2], v1[3]);
                        *(gp::u32x4*)(rowp + bj * 128) = w; } }
                __builtin_amdgcn_sched_barrier(0); }
    }
};
__device__ __forceinline__ void ph_moe2(KP p, int l, int ntok, int bid, int nb, LAS unsigned char* lds) {
    LAS int* offs = (LAS int*)(lds + MOE_TAB);
    LAS int* tabE = offs + 128;
    LAS int* tabD = offs + 256;
    LAS float* tabG = (LAS float*)(tabD + MOE_MAXT * 256);
    moe_offsets(p, l, ntok, offs);
    const int tid = opaque_tid();
    const int nrt = offs[65] >> 8;
    const int nper = bid < nrt ? (nrt - bid + nb - 1) / nb : 0;
    const int* sdst = (const int*)(p->ws + OFF_SDST); const float* sgate = (const float*)(p->ws + OFF_SGATE); const int* tile_e = (const int*)(p->ws + OFF_TILEE);
    for (int i = tid; i < nper * 256; i += 512) { const size_t r = (size_t)(bid + (i >> 8) * nb) * 256 + (i & 255); tabD[i] = sdst[r]; tabG[i] = sgate[r]; }
    if (tid < nper) tabE[tid] = tile_e[bid + tid * nb];
    __syncthreads();
    Moe2Sched S{(const char*)(p->ws + OFF_BIG), (const char*)(p->ws + OFF_W2), tabE, nper, bid, nb};
    EpiY E{(bf16_t*)(p->ws + OFF_YS), tabD, tabG};
    gp::gemm_phase<false, true>(lds, 256, S, E);
}

__device__ __forceinline__ void ph_combine_ln2(KP p, int l, int ntok, int bid, int nb) {
    const int tid = opaque_tid(), lane = tid & 63, wv = tid >> 6;
    const bf16_t* Ys = (const bf16_t*)(p->ws + OFF_YS);
    const float* lw = p->in[I_LNW] + (l * 2 + 1) * 1024; const float* lb = p->in[I_LNB] + (l * 2 + 1) * 1024;
    #pragma unroll 1
    for (int tok = bid * 8 + wv; tok < ntok; tok += nb * 8) {
        float* h = hrow(p, tok);
        const float* m = modrow(p, l, tok);
        float f[16];
#pragma unroll
        for (int i = 0; i < 16; ++i) f[i] = 0.f;
#pragma unroll
        for (int s = 0; s < 9; ++s)
#pragma unroll
            for (int c = 0; c < 2; ++c) {
                const uint4 w = *(const uint4*)(Ys + ((size_t)tok * 9 + s) * 1024 + 8 * (lane + 64 * c));
                f[8 * c + 0] += bflo(w.x); f[8 * c + 1] += bfhi(w.x); f[8 * c + 2] += bflo(w.y); f[8 * c + 3] += bfhi(w.y);
                f[8 * c + 4] += bflo(w.z); f[8 * c + 5] += bfhi(w.z); f[8 * c + 6] += bflo(w.w); f[8 * c + 7] += bfhi(w.w);
            }
        float x[16]; float sum = 0.f;
#pragma unroll
        for (int c = 0; c < 2; ++c)
#pragma unroll
            for (int q = 0; q < 2; ++q) {
                const int d = 8 * (lane + 64 * c) + 4 * q;
                const float4 hv = *(const float4*)(h + d), gv = *(const float4*)(m + 5 * 1024 + d);
                x[8 * c + 4 * q + 0] = ALPHA * hv.x + gv.x * f[8 * c + 4 * q + 0]; x[8 * c + 4 * q + 1] = ALPHA * hv.y + gv.y * f[8 * c + 4 * q + 1];
                x[8 * c + 4 * q + 2] = ALPHA * hv.z + gv.z * f[8 * c + 4 * q + 2]; x[8 * c + 4 * q + 3] = ALPHA * hv.w + gv.w * f[8 * c + 4 * q + 3];
                sum += x[8 * c + 4 * q] + x[8 * c + 4 * q + 1] + x[8 * c + 4 * q + 2] + x[8 * c + 4 * q + 3];
            }
        const float mean = wave_sum(sum) * (1.f / 1024.f);
        float q2 = 0.f;
#pragma unroll
        for (int i = 0; i < 16; ++i) { x[i] -= mean; q2 += x[i] * x[i]; }
        const float rs = rsqrtf(wave_sum(q2) * (1.f / 1024.f) + LN_EPS);
#pragma unroll
        for (int c = 0; c < 2; ++c)
#pragma unroll
            for (int q = 0; q < 2; ++q) {
                const int d = 8 * (lane + 64 * c) + 4 * q;
                const float4 w4 = *(const float4*)(lw + d), b4 = *(const float4*)(lb + d);
                float4 y; y.x = x[8 * c + 4 * q] * rs * w4.x + b4.x; y.y = x[8 * c + 4 * q + 1] * rs * w4.y + b4.y; y.z = x[8 * c + 4 * q + 2] * rs * w4.z + b4.z; y.w = x[8 * c + 4 * q + 3] * rs * w4.w + b4.w;
                *(float4*)(h + d) = y;
            }
    }
}

#define MEGA_LDS (131072 + 256 + 20480)
#define NBLK 256
#define BAR_LDS 131072
#define SYNC() do { XcdBarrier _b; _b.bar = (unsigned*)kparams()->ws; _b.x = xb_xcc_id(); _b.st = (volatile LAS unsigned*)((LAS unsigned char*)smraw_base() + BAR_LDS); xcd_barrier(_b); } while (0)
template <int PAR>
__device__ __forceinline__ void layer_fwd(const int l) {
    LAS unsigned char* lds = smraw_base(); float* sm = (float*)smraw_generic();
    const int bid = blockIdx.x; constexpr int nb = NBLK;
    const int ntok = (l == 3) ? NL : NT;
    ph_convert(kparams(), l, bid, nb, sm); ph_modin(kparams(), l, bid, nb); SYNC();
    ph_gemm_in(kparams(), l, bid, nb, lds); SYNC();
    if (PAR == 0) {
        ph_scan_even2(kparams(), l, bid, nb); SYNC();
        ph_normgate_even(kparams(), l, bid, nb); SYNC();
    } else {
        ph_hy_filt2(kparams(), l, bid, nb, sm); ph_hy_prep(kparams(), l, bid, nb, sm); SYNC();
        ph_mix_odd(kparams(), l, bid, nb, sm); SYNC();
        ph_hy_norm(kparams(), l, bid, nb, sm); ph_normgate_odd(kparams(), l, bid, nb); SYNC();
    }
    ph_gemm_out(kparams(), l, bid, nb, lds); SYNC();
    ph_ln1_router(kparams(), l, ntok, bid, nb, sm); SYNC();
    ph_scatter(kparams(), l, ntok, bid, nb, lds); SYNC();
    ph_moe1(kparams(), l, ntok, bid, nb, lds); SYNC();
    ph_moe2(kparams(), l, ntok, bid, nb, lds); SYNC();
    ph_combine_ln2(kparams(), l, ntok, bid, nb);
    if (l < 3) SYNC();
}
__global__ void __launch_bounds__(512, 2) mega_fwd(Params p) {
    LAS unsigned char* lds = smraw_base(); float* sm = (float*)smraw_generic();
    if (threadIdx.x < 4) ((LAS unsigned*)(lds + 131072))[threadIdx.x] = 0u;
    __syncthreads();
    (void)xcd_barrier_post((unsigned*)kparams()->ws, (volatile LAS unsigned*)(lds + BAR_LDS));
    const int bid = blockIdx.x; constexpr int nb = NBLK;
    ph_prologue(kparams(), bid, nb, sm); SYNC();
#pragma unroll 1
    for (int lp = 0; lp < 2; ++lp) {
        layer_fwd<0>(2 * lp);
        layer_fwd<1>(2 * lp + 1);
    }
    __syncthreads();
    if (blockIdx.x == 0 && threadIdx.x == 0 && xb_ld((unsigned*)kparams()->ws + XB_TMO) != 0u) kparams()->out[0] = __builtin_nanf("");
}

extern "C" void kernel_launch(void* const* d_in, const int* in_sizes, int n_in, void* d_out, int out_size, void* d_ws, size_t ws_size, hipStream_t stream) {
    static int grid = 0;
    if (grid == 0) {
        if (n_in != 38 || out_size != NL * DM || ws_size < WS_END) { fprintf(stderr, "kernel_launch: bad shapes n_in %d out %d ws %zu (need %zu)\n", n_in, out_size, ws_size, (size_t)WS_END); grid = -1; return; }
        int dev = 0, cus = 0, per_cu = 0;
        if (hipGetDevice(&dev) != hipSuccess || hipDeviceGetAttribute(&cus, hipDeviceAttributeMultiprocessorCount, dev) != hipSuccess) { grid = -1; return; }
        if (hipFuncSetAttribute((const void*)mega_fwd, hipFuncAttributeMaxDynamicSharedMemorySize, MEGA_LDS) != hipSuccess) { fprintf(stderr, "kernel_launch: hipFuncSetAttribute failed\n"); grid = -1; return; }
        if (hipOccupancyMaxActiveBlocksPerMultiprocessor(&per_cu, (const void*)mega_fwd, 512, MEGA_LDS) != hipSuccess || per_cu < 1) { fprintf(stderr, "kernel_launch: occupancy query says %d\n", per_cu); (void)hipGetLastError(); grid = -1; return; }
        if (cus != 256) { fprintf(stderr, "kernel_launch: built for 256 CUs, found %d\n", cus); grid = -1; return; }
        grid = NBLK;
    }
    if (grid < 0) return;
    if (hipMemsetAsync(d_ws, 0, OFF_LB, stream) != hipSuccess) return;
    Params p{};
    for (int i = 0; i < 38; ++i) p.in[i] = (const float*)d_in[i];
    p.out = (float*)d_out; p.ws = (unsigned char*)d_ws;
    hipLaunchKernelGGL(mega_fwd, dim3(grid), dim3(512), MEGA_LDS, stream, p);
}
```

```cpp
#include <hip/hip_runtime.h>
#include <stdint.h>
#include <stdio.h>

#define DM 1024
#define NBATCH 8
#define SEQ 4096
#define CTXL 256
#define NL (NBATCH * SEQ)
#define NC (NBATCH * CTXL)
#define NT (NL + NC)
#define ZROW NT
#define TOPK 8
#define EVEN_N 4112
#define ODD_N 3584
#define EVEN_LD 4096
#define ODD_LD 3584
#define MAXROWS (NT * 8 + 64 * 256 + NT)
#define ALPHA 1.681792830507429f
#define LN_EPS 1e-5f
#define E_MQ 0
#define E_MK 256
#define E_MV 512
#define E_MO 1024
#define E_HQ 1536
#define E_HI 2048
#define E_HFF 2560
#define E_HFB 3072
#define E_HG 3584

typedef unsigned short bf16_t;
#define LAS __attribute__((address_space(3)))
#define BAR_LDS_ 131072

#define MiB ((size_t)1 << 20)
#define OFF_CNT   ((size_t)64 << 10)
#define OFF_LB    ((size_t)96 << 10)
#define OFF_MOD   ((size_t)128 << 10)
#define OFF_ROPE  ((size_t)1536 << 10)
#define OFF_BCNT  ((size_t)1600 << 10)
#define OFF_GOFFS ((size_t)1700 << 10)
#define OFF_TILEE (2 * MiB)
#define OFF_HCTX  (4 * MiB)
#define OFF_TIDX  (12 * MiB)
#define OFF_TGATE (14 * MiB)
#define OFF_TPOS  (16 * MiB)
#define OFF_STOK  (18 * MiB)
#define OFF_SGATE (20 * MiB)
#define OFF_SDST  (22 * MiB)
#define OFF_G     (24 * MiB)
#define OFF_U     (28 * MiB)
#define OFF_W     (98 * MiB)
#define OFF_WIN   (OFF_W)
#define OFF_WOUT  (OFF_W + 8 * MiB)
#define OFF_W13   (OFF_W + 10 * MiB)
#define OFF_W2    (OFF_W + 75 * MiB)
#define OFF_BIG   (208 * MiB)
#define OFF_AUX   (480 * MiB)
#define OFF_Z1    (OFF_AUX + 136 * MiB)
#define OFF_Z2    (OFF_Z1 + 68 * MiB)
#define OFF_FILT  (OFF_Z2 + 68 * MiB)
#define OFF_YS    (370 * MiB)
#define WS_END    (984 * MiB)

struct Params {
    const float* in[38];
    float* out;
    unsigned char* ws;
};

enum { I_X = 0, I_C, I_CTX, I_CCTX, I_ADAW, I_ADAB, I_LNW, I_LNB, I_EWIN, I_MGB, I_MNW, I_HLB, I_HNW, I_EWOUT, I_OWIN, I_HCW, I_HCB,
       I_HW1, I_HB1, I_HW2, I_HB2, I_HW3, I_HB3, I_HFREQ, I_HWOUT, I_HSKIP, I_HNORM, I_RLD, I_RNW, I_OWOUT, I_RW, I_RB, I_W1, I_W3, I_W2, I_SW1, I_SW3, I_SW2 };

typedef const __attribute__((address_space(4))) Params* KP;
__device__ __forceinline__ KP kparams() { KP k = (KP)__builtin_amdgcn_kernarg_segment_ptr(); asm volatile("" : "+s"(k)); return k; }
extern __shared__ __attribute__((aligned(16))) unsigned char smraw_all[];
__device__ __forceinline__ LAS unsigned char* smraw_base() { return (LAS unsigned char*)smraw_all; }
__device__ __forceinline__ unsigned char* smraw_generic() { return smraw_all; }
__device__ __forceinline__ int opaque_tid() { int t = threadIdx.x; asm volatile("" : "+v"(t)); return t; }
typedef __bf16 bf16x2_n __attribute__((ext_vector_type(2)));
typedef float f32x2_n __attribute__((ext_vector_type(2)));
__device__ __forceinline__ unsigned cvt_pk_bf16(float lo, float hi) { const f32x2_n v = {lo, hi}; return __builtin_bit_cast(unsigned, __builtin_convertvector(v, bf16x2_n)); }
__device__ __forceinline__ float bf2f(bf16_t b) { return __uint_as_float(((unsigned)b) << 16); }
__device__ __forceinline__ float bflo(unsigned w) { return __uint_as_float(w << 16); }
__device__ __forceinline__ float bfhi(unsigned w) { return __uint_as_float(w & 0xffff0000u); }
__device__ __forceinline__ float ldf(const float* p) { return *p; }
__device__ __forceinline__ float ldf(const bf16_t* p) { return bf2f(*p); }
__device__ __forceinline__ void stf(float* p, float v) { *p = v; }
__device__ __forceinline__ void stf(bf16_t* p, float v) { *p = (bf16_t)(cvt_pk_bf16(v, 0.f) & 0xffffu); }
__device__ __forceinline__ float sigmoidf_(float x) { return 1.f / (1.f + expf(-x)); }
__device__ __forceinline__ float siluf_(float x) { return x / (1.f + expf(-x)); }
__device__ __forceinline__ float fexp(float x) { return __builtin_amdgcn_exp2f(x * 1.4426950408889634f); }
__device__ __forceinline__ float flog(float x) { return __builtin_amdgcn_logf(x) * 0.6931471805599453f; }
__device__ __forceinline__ float frcp(float x) { return __builtin_amdgcn_rcpf(x); }
__device__ __forceinline__ float fsigmoid(float x) { return frcp(1.f + fexp(-x)); }
__device__ __forceinline__ float fsilu(float x) { return x * frcp(1.f + fexp(-x)); }
__device__ __forceinline__ float wave_sum(float v) {
#pragma unroll
    for (int o = 32; o > 0; o >>= 1) v += __shfl_xor(v, o, 64);
    return v;
}
__device__ __forceinline__ float* hrow(KP p, int tok) {
    return tok < NL ? p->out + (size_t)tok * DM : (float*)(p->ws + OFF_HCTX) + (size_t)(tok - NL) * DM;
}
__device__ __forceinline__ const float* modrow(KP p, int l, int tok) {
    const int r = tok < NL ? (tok >> 12) : 8;
    return (const float*)(p->ws + OFF_MOD) + ((size_t)l * 9 + r) * 6144;
}
__device__ __forceinline__ int scan_tok(int b, int i, int dir) {
    return i < CTXL ? NL + b * CTXL + (dir ? CTXL - 1 - i : i) : b * SEQ + (dir ? SEQ - 1 - (i - CTXL) : (i - CTXL));
}

#define XB_TMO      128
#define XB_XCNT(j)  (256  + 64 * (j))
#define XB_XSUB(j)  (1280 + 64 * (j))
#define XB_XGEN(j)  (2304 + 64 * (j))
#define XB_TOP      3328
#define XB_TOPGEN   3392
#define XCD_BAR_WORDS 3456
#define XB_SPIN_CAP (1u << 24)
__device__ __forceinline__ unsigned xb_ld(unsigned* p)              { return __hip_atomic_load(p, __ATOMIC_RELAXED, __HIP_MEMORY_SCOPE_AGENT); }
__device__ __forceinline__ unsigned xb_add(unsigned* p, unsigned v) { return __hip_atomic_fetch_add(p, v, __ATOMIC_RELAXED, __HIP_MEMORY_SCOPE_AGENT); }
__device__ __forceinline__ unsigned xb_xcc_id() { return (unsigned)__builtin_amdgcn_s_getreg((3 << 11) | 20) & 0xFu; }
#define XB_SPIN(cond, bar) do { unsigned _sp = 0; while (cond) { __builtin_amdgcn_s_sleep(1); \
    if ((++_sp & 255u) == 0u) { if (xb_ld(&(bar)[XB_TMO])) break; if (_sp > XB_SPIN_CAP) { atomicAdd(&(bar)[XB_TMO], 1u); break; } } } } while (0)
struct XcdBarrier { unsigned* bar; unsigned x; volatile LAS unsigned* st; };
__device__ __forceinline__ XcdBarrier xcd_barrier_post(unsigned* bar, volatile LAS unsigned* st) {
    XcdBarrier b; b.bar = bar; b.x = xb_xcc_id(); b.st = st;
    if (threadIdx.x == 0) (void)xb_add(&bar[XB_XCNT(b.x)], 1u);
    return b;
}
__device__ __forceinline__ void xcd_barrier_complete(unsigned* bar, unsigned x, unsigned& nloc, unsigned& nx) {
    const unsigned G = gridDim.x * gridDim.y * gridDim.z;
    unsigned sum, cnt, mine, sp = 0u;
    for (;;) {
        sum = 0u; cnt = 0u; mine = 0u;
#pragma unroll
        for (unsigned j = 0; j < 16; ++j) { const unsigned c = xb_ld(&bar[XB_XCNT(j)]); sum += c; cnt += (c > 0u) ? 1u : 0u; mine = (j == x) ? c : mine; }
        if (sum == G) break;
        __builtin_amdgcn_s_sleep(1);
        if ((++sp & 255u) == 0u) { if (xb_ld(&bar[XB_TMO])) break; if (sp > XB_SPIN_CAP) { atomicAdd(&bar[XB_TMO], 1u); break; } }
    }
    nloc = mine > 0u ? mine : 1u; nx = cnt > 0u ? cnt : 1u;
}
__device__ __forceinline__ void xcd_barrier(const XcdBarrier& b) {
    asm volatile("s_waitcnt vmcnt(0)" ::: "memory");
    __syncthreads();
    if (threadIdx.x == 0) {
        unsigned* bar = b.bar;
        __builtin_amdgcn_s_waitcnt(0);
        unsigned nloc = b.st[0], nx = b.st[1];
        if (nloc == 0u) { xcd_barrier_complete(bar, b.x, nloc, nx); b.st[0] = nloc; b.st[1] = nx; }
        const unsigned old = xb_add(&bar[XB_XSUB(b.x)], 1u);
        const unsigned gen = old / nloc;
        if (old + 1u == (gen + 1u) * nloc) {
            __builtin_amdgcn_fence(__ATOMIC_RELEASE, "agent");
            asm volatile("s_waitcnt vmcnt(0)" ::: "memory");
            const unsigned og = xb_add(&bar[XB_TOP], 1u);
            const unsigned tg = og / nx;
            if (og + 1u == (tg + 1u) * nx) xb_add(&bar[XB_TOPGEN], 1u);
            else XB_SPIN(xb_ld(&bar[XB_TOPGEN]) == tg, bar);
            __builtin_amdgcn_fence(__ATOMIC_ACQUIRE, "agent");
            xb_add(&bar[XB_XGEN(b.x)], 1u);
            asm volatile("s_waitcnt vmcnt(0)" ::: "memory");
        } else {
            XB_SPIN(xb_ld(&bar[XB_XGEN(b.x)]) == gen, bar);
            __builtin_amdgcn_fence(__ATOMIC_ACQUIRE, "agent");
            asm volatile("s_waitcnt vmcnt(0)" ::: "memory");
        }
    }
    __syncthreads();
}

__device__ __forceinline__ void ph_prologue(KP p, int bid, int nb, float* sm) {
    const int tid = opaque_tid();
    {
        const float4* x4 = (const float4*)p->in[I_X]; float4* o4 = (float4*)p->out;
        #pragma unroll 1
        for (size_t i = (size_t)bid * 512 + tid; i < (size_t)NL * 256; i += (size_t)nb * 512) o4[i] = x4[i];
        const float4* c4 = (const float4*)p->in[I_CTX]; float4* h4 = (float4*)(p->ws + OFF_HCTX);
        #pragma unroll 1
        for (size_t i = (size_t)bid * 512 + tid; i < (size_t)NC * 256; i += (size_t)nb * 512) h4[i] = c4[i];
    }
    if (bid == 0) {
        bf16_t* z = (bf16_t*)(p->ws + OFF_U) + (size_t)ZROW * DM;
        for (int i = tid; i < DM; i += 512) z[i] = 0;
    }
    if (bid == 1 % nb) {
        float* lb = (float*)(p->ws + OFF_LB);
        const float* hl = p->in[I_HLB];
        for (int j = tid; j < 512; j += 512) {
            const float a = hl[j], b = hl[512 + j], mx = fmaxf(a, b);
            const float ea = expf(a - mx), eb = expf(b - mx);
            lb[j] = 0.f; lb[512 + j] = eb / (ea + eb);
        }
    }
    if (bid == 2 % nb) {
        float2* rt = (float2*)(p->ws + OFF_ROPE);
        for (int i = tid; i < 64 * 32; i += 512) { const float ang = (float)(i >> 5) * powf(10000.f, -(float)(2 * (i & 31)) / 64.f); rt[i] = make_float2(cosf(ang), sinf(ang)); }
    }
    {
        float* act = sm;
        bool filled = false;
        #pragma unroll 1
        for (int item = bid; item < 48; item += nb) {
            if (!filled) {
                for (int i = tid; i < 9 * 1024; i += 512) {
                    const int r = i >> 10, k = i & 1023;
                    const float v = r < 8 ? p->in[I_C][r * 1024 + k] : p->in[I_CCTX][k];
                    act[i] = siluf_(v);
                }
                __syncthreads(); filled = true;
            }
            const int l = item / 12, j = (item % 12) * 512 + tid;
            const float* w = p->in[I_ADAW] + (size_t)l * 1024 * 6144 + j;
            float acc[9];
#pragma unroll
            for (int r = 0; r < 9; ++r) acc[r] = 0.f;
            for (int k = 0; k < 1024; ++k) {
                const float wv = w[(size_t)k * 6144];
#pragma unroll
                for (int r = 0; r < 9; ++r) acc[r] += act[r * 1024 + k] * wv;
            }
            const float bv = p->in[I_ADAB][l * 6144 + j];
            float* mod = (float*)(p->ws + OFF_MOD);
#pragma unroll
            for (int r = 0; r < 9; ++r) mod[((size_t)l * 9 + r) * 6144 + j] = acc[r] + bv;
        }
    }
}


template <class Src>
__device__ __forceinline__ void cvt_tile(float* sm, Src src, int srcld, int k0, bf16_t* dst, int dstld, int n0) {
    const int tid = opaque_tid();
    const float* sp = src(n0 + (tid & 127));
#pragma unroll
    for (int j = 0; j < 16; ++j) { const int k = (tid >> 7) + 4 * j; sm[k * 129 + (tid & 127)] = sp[(size_t)(k0 + k) * srcld]; }
    __syncthreads();
    const int n = tid >> 2, kc = (tid & 3) * 16;
    unsigned w[8];
#pragma unroll
    for (int q = 0; q < 8; ++q) w[q] = cvt_pk_bf16(sm[(kc + 2 * q) * 129 + n], sm[(kc + 2 * q + 1) * 129 + n]);
    uint4* d4 = (uint4*)(dst + (size_t)(n0 + n) * dstld + k0 + kc);
    d4[0] = make_uint4(w[0], w[1], w[2], w[3]); d4[1] = make_uint4(w[4], w[5], w[6], w[7]);
    __syncthreads();
}

__device__ __forceinline__ void ph_convert(KP p, int l, int bid, int nb, float* sm) {
    const bool even = (l & 1) == 0;
    const int NP = even ? EVEN_LD : ODD_LD;
    const int t_in = 16 * (NP / 128), t_out = 16 * 8, t_13 = 65 * 16 * 4, t_2 = 65 * 4 * 8;
    const int total = t_in + t_out + t_13 + t_2;
    #pragma unroll 1
    for (int t = bid; t < total; t += nb) {
        if (t < t_in) {
            const int kt = t & 15, nt = t >> 4;
            const float* W = even ? p->in[I_EWIN] + (size_t)(l >> 1) * 1024 * EVEN_N : p->in[I_OWIN] + (size_t)(l >> 1) * 1024 * ODD_N;
            cvt_tile(sm, [&](int n) { return W + ((even && n >= 1536) ? n + 16 : n); }, even ? EVEN_N : ODD_N, kt * 64, (bf16_t*)(p->ws + OFF_WIN), 1024, nt * 128);
        } else if (t < t_in + t_out) {
            const int u = t - t_in, kt = u & 15, nt = u >> 4;
            const float* W = (even ? p->in[I_EWOUT] : p->in[I_OWOUT]) + (size_t)(l >> 1) * 1024 * 1024;
            cvt_tile(sm, [&](int n) { return W + n; }, 1024, kt * 64, (bf16_t*)(p->ws + OFF_WOUT), 1024, nt * 128);
        } else if (t < t_in + t_out + t_13) {
            const int u = t - t_in - t_out, e = u >> 6, kt = u & 15, nt = (u >> 4) & 3;
            const float* w1 = e < 64 ? p->in[I_W1] + ((size_t)l * 64 + e) * 1024 * 256 : p->in[I_SW1] + (size_t)l * 1024 * 256;
            const float* w3 = e < 64 ? p->in[I_W3] + ((size_t)l * 64 + e) * 1024 * 256 : p->in[I_SW3] + (size_t)l * 1024 * 256;
            cvt_tile(sm, [&](int n) { const int g = n >> 5, w = n & 31; return w < 16 ? w1 + 16 * g + w : w3 + 16 * g + w - 16; }, 256, kt * 64,
                     (bf16_t*)(p->ws + OFF_W13) + (size_t)e * 512 * 1024, 1024, nt * 128);
        } else {
            const int u = t - t_in - t_out - t_13, e = u >> 5, kt = u & 3, nt = (u >> 2) & 7;
            const float* w2 = e < 64 ? p->in[I_W2] + ((size_t)l * 64 + e) * 256 * 1024 : p->in[I_SW2] + (size_t)l * 256 * 1024;
            cvt_tile(sm, [&](int n) { return w2 + n; }, 1024, kt * 64, (bf16_t*)(p->ws + OFF_W2) + (size_t)e * 1024 * 256, 256, nt * 128);
        }
    }
}

namespace gp {
typedef short bf16x8 __attribute__((ext_vector_type(8)));
typedef float f32x4 __attribute__((ext_vector_type(4)));
typedef unsigned u32x4 __attribute__((ext_vector_type(4)));
typedef unsigned u32x2 __attribute__((ext_vector_type(2)));
constexpr int BM = 256, BK = 64, HALF = 128, HTB = HALF * BK * 2, STAGE_BYTES = 8 * HTB, NXCD = 8, WGM = 8;
__device__ __forceinline__ int lds_byte(int r, int c) { const int st = (r >> 4) * 2 + (c >> 5), rr = r & 15, cc = c & 31, ob = rr * 64 + cc * 2; return st * 1024 + (ob ^ (((ob >> 9) & 1) << 5)); }
__device__ __forceinline__ void stage_rc(int b, int& R, int& C) { const int st = b / 1024, sb = b % 1024, swz = sb ^ (((sb >> 9) & 1) << 5); R = (st >> 1) * 16 + swz / 64; C = (st & 1) * 32 + (swz % 64) / 2; }
__device__ __forceinline__ int perm32(int rho) { const int n = rho >> 4, i = rho & 15; return 8 * (i >> 2) + 4 * n + (i & 3); }

struct Unit { const char* A; const char* B; int r0, c0, aux; };

struct DenseSched {
    const char* A; const char* B; int nM, nN, nwg, G, c; size_t tstep;
    __device__ __forceinline__ void init(const void* A_, const void* B_, int M, int N, int K, int G_, int c_) { A = (const char*)A_; B = (const char*)B_; nM = M / BM; nN = N / BM; nwg = nM * nN; G = G_; c = c_; tstep = (size_t)BM * K * 2; }
    __device__ __forceinline__ bool next(int i, Unit& u) const {
        const long L = (long)i * G + c; if (L >= nwg) return false;
        int wgid = (int)L; { const int q = nwg / NXCD, r = nwg % NXCD, xcd = wgid % NXCD, off = wgid / NXCD; wgid = (xcd < r ? xcd * (q + 1) : r * (q + 1) + (xcd - r) * q) + off; }
        const int nig = WGM * nN, gid = wgid / nig, fm = gid * WGM, gsz = (nM - fm) < WGM ? (nM - fm) : WGM;
        const int pm = fm + ((wgid % nig) % gsz), pn = (wgid % nig) / gsz;
        u.A = A + (size_t)pm * tstep; u.B = B + (size_t)pn * tstep; u.r0 = pm * BM; u.c0 = pn * BM; u.aux = 0; return true;
    }
    __device__ __forceinline__ void lane_off(const Unit&, int, int, int, int, unsigned (&)[2][2]) const {}
};

template <bool GATHER, bool PERM, class Sched, class Epi>
__device__ __forceinline__ void gemm_phase(LAS unsigned char* lds, const int K_, const Sched& S, const Epi& E) {
    int K = K_; asm volatile("" : "+s"(K));
    const int tid = opaque_tid(), wid = __builtin_amdgcn_readfirstlane(tid >> 6), lane = tid & 63, wr = wid >> 2, wc = wid & 3, fr = lane & 15, fq = lane >> 4;
    const int nt = K / BK;
    unsigned voffA[2], voffB[2]; int sR[2], sC[2];
#pragma unroll
    for (int i = 0; i < 2; ++i) { int R, C; stage_rc(tid * 16 + i * 8192, R, C); const int Rb = PERM ? ((R & ~31) + perm32(R & 31)) : R;
        voffA[i] = (unsigned)(R * K + C) * 2u; voffB[i] = (unsigned)(Rb * K + C) * 2u; sR[i] = R; sC[i] = C; }
    const size_t kstep = (size_t)(BK * 2);
    const size_t hstep = (size_t)HALF * K * 2;
    const unsigned ldsw = (unsigned)wid * 1024u;
    const int aoff = lds_byte(wr * 64 + fr, fq * 8), boff = lds_byte(wc * 32 + fr, fq * 8);
    unsigned cvo[2][2] = {{0u, 0u}, {0u, 0u}}, nvo[2][2] = {{0u, 0u}, {0u, 0u}};
#define GP_SA(b, h) (((b) * 2 + (h)) * HTB)
#define GP_SB(b, h) ((4 + (b) * 2 + (h)) * HTB)
#define GP_GLDS(gp_, lp_) __builtin_amdgcn_global_load_lds((const unsigned*)(gp_), (LAS unsigned*)(lp_), 16, 0, 0)
#define GP_STAGE_B(bufoff, gbase, h) do { const char* _g = (gbase) + (size_t)(h) * hstep; \
        GP_GLDS(_g + voffB[0], lds + (bufoff) + ldsw); GP_GLDS(_g + voffB[1], lds + (bufoff) + ldsw + 8192); } while (0)
#define GP_STAGE_A(bufoff, gbase, h, usenext) do { \
        if (GATHER) { const unsigned _o0 = (usenext) ? nvo[h][0] : cvo[h][0], _o1 = (usenext) ? nvo[h][1] : cvo[h][1]; \
            GP_GLDS((gbase) + _o0, lds + (bufoff) + ldsw); GP_GLDS((gbase) + _o1, lds + (bufoff) + ldsw + 8192); } \
        else { const char* _g = (gbase) + (size_t)(h) * hstep; GP_GLDS(_g + voffA[0], lds + (bufoff) + ldsw); GP_GLDS(_g + voffA[1], lds + (bufoff) + ldsw + 8192); } } while (0)
#define GP_LDA(dst, b, h) do { _Pragma("unroll") for (int m = 0; m < 4; ++m) _Pragma("unroll") for (int k = 0; k < 2; ++k) dst[m][k] = *(const LAS bf16x8*)(lds + GP_SA(b, h) + aoff + m * 2048 + k * 1024); } while (0)
#define GP_LDB(dst, b, h) do { _Pragma("unroll") for (int n = 0; n < 2; ++n) _Pragma("unroll") for (int k = 0; k < 2; ++k) dst[n][k] = *(const LAS bf16x8*)(lds + GP_SB(b, h) + boff + n * 2048 + k * 1024); } while (0)
#define GP_MMA(ai, bj, At, Bt) do { __builtin_amdgcn_s_setprio(1); _Pragma("unroll") for (int m = 0; m < 4; ++m) _Pragma("unroll") for (int n = 0; n < 2; ++n) _Pragma("unroll") for (int k = 0; k < 2; ++k) \
        acc[ai][bj][m][n] = __builtin_amdgcn_mfma_f32_16x16x32_bf16(Bt[n][k], At[m][k], acc[ai][bj][m][n], 0, 0, 0); __builtin_amdgcn_s_setprio(0); } while (0)
#define GP_WAIT_V(n) asm volatile("s_waitcnt vmcnt(" #n ")" ::: "memory")
#define GP_WAIT_L(n) asm volatile("s_waitcnt lgkmcnt(" #n ")" ::: "memory")
#define GP_BAR __builtin_amdgcn_s_barrier()
#define GP_SCHED __builtin_amdgcn_sched_barrier(0)
    Unit cur, nxt; int ui = 0;
    if (!S.next(0, cur)) return;
    f32x4 acc[2][2][4][2];
#pragma unroll
    for (int a = 0; a < 2; ++a)
#pragma unroll
        for (int b = 0; b < 2; ++b)
#pragma unroll
            for (int m = 0; m < 4; ++m)
#pragma unroll
                for (int n = 0; n < 2; ++n) acc[a][b][m][n] = (f32x4){0.f, 0.f, 0.f, 0.f};
    bf16x8 At[4][2], B0[2][2], B1[2][2];
    if (GATHER) S.lane_off(cur, sR[0], sR[1], sC[0], sC[1], cvo);
    const char* cA = cur.A; const char* cB = cur.B;
    GP_STAGE_B(GP_SB(0, 0), cB, 0); GP_STAGE_A(GP_SA(0, 0), cA, 0, false); GP_STAGE_B(GP_SB(0, 1), cB, 1); GP_STAGE_A(GP_SA(0, 1), cA, 1, false);
    if (wr == 1) GP_BAR;
    GP_WAIT_V(4); GP_BAR;
    GP_STAGE_B(GP_SB(1, 0), cB + kstep, 0); GP_STAGE_A(GP_SA(1, 0), cA + kstep, 0, false); GP_STAGE_B(GP_SB(1, 1), cB + kstep, 1);
    GP_WAIT_V(6); GP_BAR;
    for (;;) {
        const bool has_next = S.next(ui + 1, nxt);
        if (GATHER && has_next) S.lane_off(nxt, sR[0], sR[1], sC[0], sC[1], nvo);
        const char* nA = has_next ? nxt.A : cA; const char* nB = has_next ? nxt.B : cB;
        for (int t = 0; t < nt; t += 2) {
            const bool last = (t == nt - 2);
            const bool un = last && has_next;
            const char* a1 = cA + (size_t)(t + 1) * kstep;
            const char* a2 = last ? nA : cA + (size_t)(t + 2) * kstep; const char* b2 = last ? nB : cB + (size_t)(t + 2) * kstep;
            const char* a3 = a2 + kstep; const char* b3 = b2 + kstep;
            GP_LDB(B0, 0, 0); GP_SCHED; GP_LDA(At, 0, 0); GP_STAGE_A(GP_SA(1, 1), a1, 1, false);
            GP_WAIT_L(8); GP_BAR; GP_WAIT_L(0); GP_MMA(0, 0, At, B0); GP_BAR; GP_SCHED;
            GP_LDB(B1, 0, 1); GP_STAGE_B(GP_SB(0, 0), b2, 0);
            GP_BAR; GP_WAIT_L(0); GP_MMA(0, 1, At, B1); GP_BAR;
            GP_LDA(At, 0, 1); GP_STAGE_A(GP_SA(0, 0), a2, 0, un);
            GP_BAR; GP_WAIT_L(0); GP_MMA(1, 0, At, B0); GP_BAR; GP_SCHED;
            GP_STAGE_B(GP_SB(0, 1), b2, 1);
            GP_WAIT_V(6); GP_BAR; GP_MMA(1, 1, At, B1); GP_BAR;
            GP_LDB(B0, 1, 0); GP_SCHED; GP_LDA(At, 1, 0); GP_STAGE_A(GP_SA(0, 1), a2, 1, un);
            GP_WAIT_L(8); GP_BAR; GP_WAIT_L(0); GP_MMA(0, 0, At, B0); GP_BAR; GP_SCHED;
            GP_LDB(B1, 1, 1); GP_STAGE_B(GP_SB(1, 0), b3, 0);
            GP_BAR; GP_WAIT_L(0); GP_MMA(0, 1, At, B1); GP_BAR;
            GP_LDA(At, 1, 1); GP_STAGE_A(GP_SA(1, 0), a3, 0, un);
            GP_BAR; GP_WAIT_L(0); GP_MMA(1, 0, At, B0); GP_BAR; GP_SCHED;
            GP_STAGE_B(GP_SB(1, 1), b3, 1);
            GP_WAIT_V(6); GP_BAR; GP_MMA(1, 1, At, B1); GP_BAR;
        }
        E(acc, cur, wr, wc, fr, fq);
        if (!has_next) break;
#pragma unroll
        for (int a = 0; a < 2; ++a)
#pragma unroll
            for (int b = 0; b < 2; ++b)
#pragma unroll
                for (int m = 0; m < 4; ++m)
#pragma unroll
                    for (int n = 0; n < 2; ++n) acc[a][b][m][n] = (f32x4){0.f, 0.f, 0.f, 0.f};
        cur = nxt; cA = nA; cB = nB; ++ui;
        if (GATHER) { cvo[0][0] = nvo[0][0]; cvo[0][1] = nvo[0][1]; cvo[1][0] = nvo[1][0]; cvo[1][1] = nvo[1][1]; }
    }
    GP_WAIT_V(0);
    if (wr == 0) GP_BAR;
    GP_BAR;
#undef GP_SA
#undef GP_SB
#undef GP_GLDS
#undef GP_STAGE_A
#undef GP_STAGE_B
#undef GP_LDA
#undef GP_LDB
#undef GP_MMA
#undef GP_WAIT_V
#undef GP_WAIT_L
#undef GP_BAR
#undef GP_SCHED
}

struct EpiF32 {
    float* C; int ldc;
    __device__ __forceinline__ void operator()(const f32x4 (&acc)[2][2][4][2], const Unit& u, int wr, int wc, int fr, int fq) const {
        const int row0 = u.r0 + wr * 64 + fr, col0 = u.c0 + wc * 32 + 4 * fq;
#pragma unroll
        for (int ai = 0; ai < 2; ++ai)
#pragma unroll
            for (int m = 0; m < 4; ++m) { float* rowp = C + (size_t)(row0 + ai * HALF + m * 16) * ldc + col0;
#pragma unroll
                for (int bj = 0; bj < 2; ++bj)
#pragma unroll
                    for (int n = 0; n < 2; ++n) *(f32x4*)(rowp + bj * HALF + n * 16) = acc[ai][bj][m][n];
                __builtin_amdgcn_sched_barrier(0); }
    }
};
struct EpiBf16 {
    bf16_t* O; int ldc;
    __device__ __forceinline__ void operator()(const f32x4 (&acc)[2][2][4][2], const Unit& u, int wr, int wc, int fr, int fq) const {
        const int row0 = u.r0 + wr * 64 + fr, col0 = u.c0 + wc * 32 + 8 * fq;
#pragma unroll
        for (int ai = 0; ai < 2; ++ai)
#pragma unroll
            for (int m = 0; m < 4; ++m) { bf16_t* rowp = O + (size_t)(row0 + ai * HALF + m * 16) * ldc + col0;
#pragma unroll
                for (int bj = 0; bj < 2; ++bj) { const f32x4 v0 = acc[ai][bj][m][0], v1 = acc[ai][bj][m][1];
                    u32x4 w; w.x = cvt_pk_bf16(v0[0], v0[1]); w.y = cvt_pk_bf16(v0[2], v0[3]); w.z = cvt_pk_bf16(v1[0], v1[1]); w.w = cvt_pk_bf16(v1[2], v1[3]);
                    *(u32x4*)(rowp + bj * HALF) = w; }
                __builtin_amdgcn_sched_barrier(0); }
    }
};
}

__device__ __forceinline__ void ph_modin(KP p, int l, int bid, int nb) {
    const int tid = opaque_tid(), lane = tid & 63, wv = tid >> 6;
    const bool even = (l & 1) == 0;
    bf16_t* U = (bf16_t*)(p->ws + OFF_U);
    float* G = (float*)(p->ws + OFF_G);
    const float* wg = p->in[I_EWIN] + (size_t)(l >> 1) * 1024 * EVEN_N + 1536;
    #pragma unroll 1
    for (int tok = bid * 8 + wv; tok < NT; tok += nb * 8) {
        const float* h = hrow(p, tok);
        const float* m = modrow(p, l, tok);
        float ga[16];
#pragma unroll
        for (int j = 0; j < 16; ++j) ga[j] = 0.f;
#pragma unroll
        for (int c = 0; c < 4; ++c) {
            const int d = 4 * (lane + 64 * c);
            const float4 hv = *(const float4*)(h + d), sh = *(const float4*)(m + d), sc = *(const float4*)(m + 1024 + d);
            const float u0 = hv.x * (1.f + sc.x) + sh.x, u1 = hv.y * (1.f + sc.y) + sh.y, u2 = hv.z * (1.f + sc.z) + sh.z, u3 = hv.w * (1.f + sc.w) + sh.w;
            *(uint2*)(U + (size_t)tok * DM + d) = make_uint2(cvt_pk_bf16(u0, u1), cvt_pk_bf16(u2, u3));
            if (even) {
                const float uu[4] = {u0, u1, u2, u3};
#pragma unroll
                for (int q = 0; q < 4; ++q) {
                    const float4* wr = (const float4*)(wg + (size_t)(d + q) * EVEN_N);
#pragma unroll
                    for (int j4 = 0; j4 < 4; ++j4) { const float4 w = wr[j4]; ga[4 * j4] += uu[q] * w.x; ga[4 * j4 + 1] += uu[q] * w.y; ga[4 * j4 + 2] += uu[q] * w.z; ga[4 * j4 + 3] += uu[q] * w.w; }
                }
            }
        }
        if (even) {
            float mine = 0.f;
#pragma unroll
            for (int j = 0; j < 16; ++j) { const float s = wave_sum(ga[j]); if (lane == j) mine = s; }
            if (lane < 16) G[(size_t)tok * 16 + lane] = mine;
        }
    }
}

__device__ __forceinline__ void ph_gemm_in(KP p, int l, int bid, int nb, LAS unsigned char* lds) {
    const int N = ((l & 1) == 0) ? EVEN_LD : ODD_LD;
    gp::DenseSched S; S.init(p->ws + OFF_U, p->ws + OFF_WIN, NT, N, 1024, nb, bid);
    gp::EpiBf16 E{(bf16_t*)(p->ws + OFF_BIG), N};
    gp::gemm_phase<false, true>(lds, 1024, S, E);
}
__device__ __forceinline__ void ph_gemm_out(KP p, int l, int bid, int nb, LAS unsigned char* lds) {
    gp::DenseSched S; S.init(p->ws + OFF_U, p->ws + OFF_WOUT, NT, 1024, 1024, nb, bid);
    gp::EpiF32 E{(float*)(p->ws + OFF_BIG), 1024};
    gp::gemm_phase<false, false>(lds, 1024, S, E);
}


namespace sc {
typedef short bf16x8 __attribute__((ext_vector_type(8)));
typedef short bf16x4 __attribute__((ext_vector_type(4)));
typedef float f32x4 __attribute__((ext_vector_type(4)));
#define SC_MFMA(a, b, c) __builtin_amdgcn_mfma_f32_16x16x32_bf16(a, b, c, 0, 0, 0)
__device__ __forceinline__ bf16x8 rd_row(unsigned img, int row, int stride, int k0) { return *(const LAS bf16x8*)(size_t)(img + (unsigned)(row * stride + k0 * 2)); }
__device__ __forceinline__ bf16x8 rd_tr(unsigned img, int k0, int n0, int stride, int lane) {
    const int g = lane >> 4, i = lane & 15;
    const unsigned a0 = img + (unsigned)((k0 + 8 * g + (i >> 2)) * stride + (n0 + 4 * (i & 3)) * 2), a1 = a0 + 4u * (unsigned)stride;
    bf16x4 lo, hi;
    asm volatile("ds_read_b64_tr_b16 %0, %2\n\tds_read_b64_tr_b16 %1, %3\n\ts_waitcnt lgkmcnt(0)" : "=&v"(lo), "=&v"(hi) : "v"(a0), "v"(a1) : "memory");
    return (bf16x8){lo[0], lo[1], lo[2], lo[3], hi[0], hi[1], hi[2], hi[3]};
}
typedef unsigned u32x2_ __attribute__((ext_vector_type(2)));
typedef unsigned u32x4_ __attribute__((ext_vector_type(4)));
__device__ __forceinline__ void st8(unsigned addr, uint2 v) { *(LAS u32x2_*)(size_t)addr = (u32x2_){v.x, v.y}; }
__device__ __forceinline__ void st16(unsigned addr, uint4 v) { *(LAS u32x4_*)(size_t)addr = (u32x4_){v.x, v.y, v.z, v.w}; }
__device__ __forceinline__ float scan_add64(float v, int lane) {
#pragma unroll
    for (int o = 1; o < 64; o <<= 1) { const float t = __shfl_up(v, o, 64); if (lane >= o) v += t; }
    return v;
}
__device__ __forceinline__ float scan_max64(float v, int lane) {
#pragma unroll
    for (int o = 1; o < 64; o <<= 1) { const float t = __shfl_up(v, o, 64); if (lane >= o) v = fmaxf(v, t); }
    return v;
}

template <int MODE>
__device__ __forceinline__ void scan_item(KP p, int l, int b, int h, int dir, int vs) {
    constexpr int CS = (MODE == 1) ? 32 : 64, DK = (MODE == 0) ? 64 : 128, EXT = (MODE == 0) ? 1 : 0;
    constexpr int QS = (DK + 8) * 2, VS = (64 + 16 * EXT + 8) * 2, SS = (CS + 8) * 2, NVR = 64 + 16 * EXT;
    constexpr int NCH = (CTXL + SEQ) / CS;
    constexpr int LD = (MODE == 2) ? ODD_LD : EVEN_LD;
    constexpr unsigned O_QA = 0, O_KA = O_QA + CS * QS, O_QB = O_KA + CS * QS, O_KW = O_QB + (MODE == 1 ? CS * QS : 0), O_V = O_KW + CS * QS,
                       O_SSC = O_V + CS * VS, O_ST = O_SSC + CS * SS, O_DKV = O_ST + 2 * NVR * QS, O_END = O_DKV + 512;
    static_assert(O_END <= 131072, "scan LDS");
    const int tid = opaque_tid(), lane = tid & 63, wv = __builtin_amdgcn_readfirstlane(tid >> 6), r16 = lane & 15, q4 = lane >> 4;
    const unsigned L0 = (unsigned)(size_t)smraw_base();
    const bf16_t* P = (const bf16_t*)(p->ws + OFF_BIG);
    bf16_t* HXo = (bf16_t*)(p->ws + OFF_AUX) + (size_t)dir * NT * 1024;
    const int e2 = l >> 1;
    const int cQ = (MODE == 0) ? E_MQ + h * 64 : (MODE == 1) ? E_HQ + h * 128 : 1536 + h * 128;
    const int cK = (MODE == 0) ? E_MK + h * 64 : (MODE == 1) ? (dir ? E_HFB : E_HFF) + h * 128 : 2048 + h * 128;
    const int cV = (MODE == 0) ? E_MV + h * 128 + vs * 64 : (MODE == 1) ? E_HI + h * 128 + vs * 64 : 2560 + h * 128 + vs * 64;
    const int cO = (MODE == 0) ? h * 128 + vs * 64 : 512 + h * 128 + vs * 64;
    const int lt = (MODE == 1) ? (tid & 31) : (tid >> 3);
    const int lj = (MODE == 0) ? (tid & 7) : (MODE == 1) ? (tid >> 5) : ((tid >> 2) & 1) * 8 + (tid & 3);
    const int vt_ = tid >> 3, vj = tid & 7;
    float lbv[8]; float gbi = 0.f, gbf = 0.f, lg = 0.f;
    if (MODE == 1) {
        const float* lbp = (const float*)(p->ws + OFF_LB) + e2 * 512 + h * 128 + lj * 8;
#pragma unroll
        for (int i = 0; i < 8; ++i) lbv[i] = lbp[i];
    } else {
#pragma unroll
        for (int i = 0; i < 8; ++i) lbv[i] = 0.f;
    }
    if (MODE == 0) { const float* gb = p->in[I_MGB] + e2 * 16; gbi = gb[(dir ? 2 : 0) * 4 + h]; gbf = gb[(dir ? 3 : 1) * 4 + h]; }
    if (MODE == 2) lg = p->in[I_RLD][e2 * 8 + dir * 4 + h];
    const float* G = (const float*)(p->ws + OFF_G);
    const float* ropet = (const float*)(p->ws + OFF_ROPE);
    unsigned oz = 0u; asm volatile("" : "+v"(oz));
    for (unsigned o = tid * 16; o < 2u * NVR * QS; o += 512 * 16) st16(L0 + O_ST + o, make_uint4(oz, oz, oz, oz));
    if (EXT) { if (tid < CS) { st16(L0 + O_V + tid * VS + 128, make_uint4(0x3f80u | oz, oz, oz, oz)); st16(L0 + O_V + tid * VS + 144, make_uint4(oz, oz, oz, oz)); } }
    f32x4 sacc[4];
#pragma unroll
    for (int i = 0; i < 4; ++i) sacc[i] = (f32x4){0.f, 0.f, 0.f, 0.f};
    float m_in = -1e30f;
    uint4 rq0, rq1, rk0, rk1, rv; float rg0 = 0.f, rg1 = 0.f;
    rq1 = make_uint4(0u, 0u, 0u, 0u); rk1 = rq1;
    auto load_chunk = [&](int c) {
        const int i0 = c * CS;
        const int tq = scan_tok(b, i0 + lt, dir);
        const bf16_t* pr = P + (size_t)tq * LD;
        rq0 = *(const uint4*)(pr + cQ + lj * 8); rk0 = *(const uint4*)(pr + cK + lj * 8);
        if (MODE == 2) { rq1 = *(const uint4*)(pr + cQ + lj * 8 + 32); rk1 = *(const uint4*)(pr + cK + lj * 8 + 32); }
        if (MODE != 1 || tid < 256) { const int tv = scan_tok(b, i0 + vt_, dir); rv = *(const uint4*)(P + (size_t)tv * LD + cV + vj * 8); }
        if (MODE == 0) { const int tg = scan_tok(b, i0 + lane, dir); rg0 = G[(size_t)tg * 16 + (dir ? 8 : 0) + h]; rg1 = G[(size_t)tg * 16 + (dir ? 12 : 4) + h]; }
    };
    load_chunk(0);
#pragma unroll 1
    for (int c = 0; c < NCH; ++c) {
        const unsigned ST_R = L0 + O_ST + (unsigned)(c & 1) * NVR * QS, ST_W = L0 + O_ST + (unsigned)((c + 1) & 1) * NVR * QS;
        float sp = 1.f;
        float v_u = 0.f, v_M = 0.f, v_e = 1.f, v_low = 0.f, v_w = 1.f;
        if (MODE == 0) {
            const float ig = rg0 + gbi, fg = rg1 + gbf;
            const float lf = fminf(fg, 0.f) - flog(1.f + fexp(-fabsf(fg)));
            const float bb = scan_add64(lf, lane);
            const float g = __shfl(bb, 63, 64);
            v_u = ig - bb;
            const float cu = scan_max64(v_u, lane);
            v_M = fmaxf(m_in, cu);
            const float m_new = fmaxf(g + m_in, g + __shfl(cu, 63, 64));
            sp = fexp(g + m_in - m_new);
            v_w = fexp(g + v_u - m_new);
            v_e = fexp(m_in - v_M);
            v_low = fexp(-(bb + v_M));
            m_in = m_new;
            st16(L0 + O_QA + lt * QS + lj * 16, rq0);
            st16(L0 + O_KA + lt * QS + lj * 16, rk0);
            const float wr = __shfl(v_w, lt, 64);
            uint4 kw; kw.x = cvt_pk_bf16(bflo(rk0.x) * wr, bfhi(rk0.x) * wr); kw.y = cvt_pk_bf16(bflo(rk0.y) * wr, bfhi(rk0.y) * wr);
            kw.z = cvt_pk_bf16(bflo(rk0.z) * wr, bfhi(rk0.z) * wr); kw.w = cvt_pk_bf16(bflo(rk0.w) * wr, bfhi(rk0.w) * wr);
            st16(L0 + O_KW + lt * QS + lj * 16, kw);
            st16(L0 + O_V + vt_ * VS + vj * 16, rv);
        } else if (MODE == 2) {
            sp = fexp(64.f * lg);
            const bool lat = c >= CTXL / CS;
            float q[16], k[16];
            const unsigned qa[8] = {rq0.x, rq0.y, rq0.z, rq0.w, rq1.x, rq1.y, rq1.z, rq1.w}, ka[8] = {rk0.x, rk0.y, rk0.z, rk0.w, rk1.x, rk1.y, rk1.z, rk1.w};
#pragma unroll
            for (int i = 0; i < 8; ++i) { q[2 * i] = bflo(qa[i]); q[2 * i + 1] = bfhi(qa[i]); k[2 * i] = bflo(ka[i]); k[2 * i + 1] = bfhi(ka[i]); }
            if (lat) {
                const int tq = scan_tok(b, c * CS + lt, dir), tt = tq & (SEQ - 1);
                const int pos = ((tid >> 2) & 1) ? (tt & 63) : (tt >> 6);
                const float2* rt = (const float2*)ropet + pos * 32 + (tid & 3) * 8;
#pragma unroll
                for (int i = 0; i < 8; ++i) {
                    const float2 cs2 = rt[i];
                    const float q1 = q[i], q2 = q[8 + i], k1 = k[i], k2 = k[8 + i];
                    q[i] = q1 * cs2.x - q2 * cs2.y; q[8 + i] = q1 * cs2.y + q2 * cs2.x;
                    k[i] = k1 * cs2.x - k2 * cs2.y; k[8 + i] = k1 * cs2.y + k2 * cs2.x;
                }
            }
            const float wr = 0.08838834764831845f * fexp((float)(63 - lt) * lg);
            uint4 o0, o1, w0, w1, x0, x1;
            o0.x = cvt_pk_bf16(q[0], q[1]); o0.y = cvt_pk_bf16(q[2], q[3]); o0.z = cvt_pk_bf16(q[4], q[5]); o0.w = cvt_pk_bf16(q[6], q[7]);
            o1.x = cvt_pk_bf16(q[8], q[9]); o1.y = cvt_pk_bf16(q[10], q[11]); o1.z = cvt_pk_bf16(q[12], q[13]); o1.w = cvt_pk_bf16(q[14], q[15]);
            w0.x = cvt_pk_bf16(k[0], k[1]); w0.y = cvt_pk_bf16(k[2], k[3]); w0.z = cvt_pk_bf16(k[4], k[5]); w0.w = cvt_pk_bf16(k[6], k[7]);
            w1.x = cvt_pk_bf16(k[8], k[9]); w1.y = cvt_pk_bf16(k[10], k[11]); w1.z = cvt_pk_bf16(k[12], k[13]); w1.w = cvt_pk_bf16(k[14], k[15]);
            x0.x = cvt_pk_bf16(k[0] * wr, k[1] * wr); x0.y = cvt_pk_bf16(k[2] * wr, k[3] * wr); x0.z = cvt_pk_bf16(k[4] * wr, k[5] * wr); x0.w = cvt_pk_bf16(k[6] * wr, k[7] * wr);
            x1.x = cvt_pk_bf16(k[8] * wr, k[9] * wr); x1.y = cvt_pk_bf16(k[10] * wr, k[11] * wr); x1.z = cvt_pk_bf16(k[12] * wr, k[13] * wr); x1.w = cvt_pk_bf16(k[14] * wr, k[15] * wr);
            st16(L0 + O_QA + lt * QS + lj * 16, o0); st16(L0 + O_QA + lt * QS + lj * 16 + 64, o1);
            st16(L0 + O_KA + lt * QS + lj * 16, w0); st16(L0 + O_KA + lt * QS + lj * 16 + 64, w1);
            st16(L0 + O_KW + lt * QS + lj * 16, x0); st16(L0 + O_KW + lt * QS + lj * 16 + 64, x1);
            st16(L0 + O_V + vt_ * VS + vj * 16, rv);
        } else {
            const unsigned qa[4] = {rq0.x, rq0.y, rq0.z, rq0.w}, fa[4] = {rk0.x, rk0.y, rk0.z, rk0.w};
            float qv[8], kk[8], A[8];
#pragma unroll
            for (int i = 0; i < 8; ++i) {
                const float qr = (i & 1) ? bfhi(qa[i >> 1]) : bflo(qa[i >> 1]), fr = (i & 1) ? bfhi(fa[i >> 1]) : bflo(fa[i >> 1]);
                const float f = lbv[i] + (1.f - lbv[i]) * fsigmoid(fr);
                qv[i] = fsilu(qr); kk[i] = 1.f - f; A[i] = flog(f);
            }
#pragma unroll
            for (int o = 1; o < 32; o <<= 1)
#pragma unroll
                for (int i = 0; i < 8; ++i) { const float t = __shfl_up(A[i], o, 32); if (lt >= o) A[i] += t; }
            float qa_[8], qb_[8], ka_[8], kw_[8];
#pragma unroll
            for (int i = 0; i < 8; ++i) {
                const float am = __shfl(A[i], 15, 32), ae = __shfl(A[i], 31, 32);
                qa_[i] = qv[i] * fexp(A[i] - am); qb_[i] = qv[i] * fexp(A[i]); ka_[i] = kk[i] * fexp(am - A[i]); kw_[i] = kk[i] * fexp(ae - A[i]);
                if (lt == 31) *(LAS float*)(size_t)(L0 + O_DKV + (lj * 8 + i) * 4) = fexp(ae);
            }
            uint4 w;
            w.x = cvt_pk_bf16(qa_[0], qa_[1]); w.y = cvt_pk_bf16(qa_[2], qa_[3]); w.z = cvt_pk_bf16(qa_[4], qa_[5]); w.w = cvt_pk_bf16(qa_[6], qa_[7]); st16(L0 + O_QA + lt * QS + lj * 16, w);
            w.x = cvt_pk_bf16(qb_[0], qb_[1]); w.y = cvt_pk_bf16(qb_[2], qb_[3]); w.z = cvt_pk_bf16(qb_[4], qb_[5]); w.w = cvt_pk_bf16(qb_[6], qb_[7]); st16(L0 + O_QB + lt * QS + lj * 16, w);
            w.x = cvt_pk_bf16(ka_[0], ka_[1]); w.y = cvt_pk_bf16(ka_[2], ka_[3]); w.z = cvt_pk_bf16(ka_[4], ka_[5]); w.w = cvt_pk_bf16(ka_[6], ka_[7]); st16(L0 + O_KA + lt * QS + lj * 16, w);
            w.x = cvt_pk_bf16(kw_[0], kw_[1]); w.y = cvt_pk_bf16(kw_[2], kw_[3]); w.z = cvt_pk_bf16(kw_[4], kw_[5]); w.w = cvt_pk_bf16(kw_[6], kw_[7]); st16(L0 + O_KW + lt * QS + lj * 16, w);
            if (tid < 256) st16(L0 + O_V + vt_ * VS + vj * 16, rv);
        }
        __syncthreads();
        if (c + 1 < NCH) load_chunk(c + 1);
        {
            constexpr int NT1 = CS / 16;
            const bool act = (MODE == 1) ? (wv < 4) : true;
            const int tb = (MODE == 1) ? (wv & 1) : (wv & 3);
#pragma unroll
            for (int u2 = 0; u2 < ((MODE == 1) ? 1 : 2); ++u2) {
                const int sb = (MODE == 1) ? (wv >> 1) : 2 * (wv >> 2) + u2;
                if (act) {
                    f32x4 d = (f32x4){0.f, 0.f, 0.f, 0.f};
                    if (sb <= tb) {
#pragma unroll
                        for (int kk2 = 0; kk2 < DK / 32; ++kk2)
                            d = SC_MFMA(rd_row(L0 + O_KA, sb * 16 + r16, QS, kk2 * 32 + q4 * 8), rd_row(L0 + O_QA, tb * 16 + r16, QS, kk2 * 32 + q4 * 8), d);
                        const int t = tb * 16 + r16, s0 = sb * 16 + q4 * 4;
                        if (MODE == 0) {
                            const float Mt = __shfl(v_M, t, 64);
#pragma unroll
                            for (int jj = 0; jj < 4; ++jj) { const float us = __shfl(v_u, s0 + jj, 64); d[jj] = (s0 + jj <= t) ? d[jj] * 0.125f * fexp(us - Mt) : 0.f; }
                        } else if (MODE == 2) {
#pragma unroll
                            for (int jj = 0; jj < 4; ++jj) d[jj] = (s0 + jj <= t) ? d[jj] * 0.08838834764831845f * fexp((float)(t - s0 - jj) * lg) : 0.f;
                        } else {
#pragma unroll
                            for (int jj = 0; jj < 4; ++jj) d[jj] = (s0 + jj <= t) ? d[jj] : 0.f;
                        }
                    }
                    st8(L0 + O_SSC + (tb * 16 + r16) * SS + (sb * 16 + q4 * 4) * 2, make_uint2(cvt_pk_bf16(d[0], d[1]), cvt_pk_bf16(d[2], d[3])));
                }
            }
            (void)NT1;
        }
        __syncthreads();
        {
            const int tb = (MODE == 1) ? (wv & 1) : (wv & 3);
            const int t = tb * 16 + r16;
            const int tok = scan_tok(b, c * CS + t, dir);
            constexpr int NV = (MODE == 1) ? 1 : 2;
            f32x4 oi[NV + EXT], oo[NV + EXT];
#pragma unroll
            for (int u2 = 0; u2 < NV + EXT; ++u2) {
                const int vt = (u2 == NV) ? 4 : ((MODE == 1) ? (wv >> 1) : 2 * (wv >> 2) + u2);
                f32x4 a1 = (f32x4){0.f, 0.f, 0.f, 0.f}, a2 = a1;
#pragma unroll
                for (int sb2 = 0; sb2 < CS / 32; ++sb2)
                    a1 = SC_MFMA(rd_tr(L0 + O_V, sb2 * 32, vt * 16, VS, lane), rd_row(L0 + O_SSC, t, SS, sb2 * 32 + q4 * 8), a1);
#pragma unroll
                for (int kk2 = 0; kk2 < DK / 32; ++kk2)
                    a2 = SC_MFMA(rd_row(ST_R, vt * 16 + r16, QS, kk2 * 32 + q4 * 8), rd_row(L0 + ((MODE == 1) ? O_QB : O_QA), t, QS, kk2 * 32 + q4 * 8), a2);
                oi[u2] = a1; oo[u2] = a2;
            }
            float den = 1.f, ei = 1.f;
            if (MODE == 0) {
                ei = 0.125f * __shfl(v_e, t, 64);
                const float dsum = oi[NV][0] + ei * oo[NV][0];
                const float dd = __shfl(dsum, r16, 64);
                den = 1.f / fmaxf(fabsf(dd), __shfl(v_low, t, 64));
            } else if (MODE == 2) {
                ei = fexp((float)(t + 1) * lg);
            }
#pragma unroll
            for (int u2 = 0; u2 < NV; ++u2) {
                const int vt = (MODE == 1) ? (wv >> 1) : 2 * (wv >> 2) + u2;
                float o[4];
#pragma unroll
                for (int jj = 0; jj < 4; ++jj) o[jj] = (oi[u2][jj] + ei * oo[u2][jj]) * den;
                *(uint2*)(HXo + (size_t)tok * 1024 + cO + vt * 16 + q4 * 4) = make_uint2(cvt_pk_bf16(o[0], o[1]), cvt_pk_bf16(o[2], o[3]));
            }
        }
        {
            constexpr int NS = (MODE == 0) ? 3 : 4;
            const int kt = (MODE == 0) ? (wv & 3) : wv;
            float dk[4] = {sp, sp, sp, sp};
            if (MODE == 1) { const f32x4 dv = *(const LAS f32x4*)(size_t)(L0 + O_DKV + (kt * 16 + q4 * 4) * 4); dk[0] = dv[0]; dk[1] = dv[1]; dk[2] = dv[2]; dk[3] = dv[3]; }
#pragma unroll
            for (int u2 = 0; u2 < NS; ++u2) {
                const int vt = (MODE == 0) ? ((u2 == 2) ? 4 : 2 * (wv >> 2) + u2) : u2;
                f32x4 a = sacc[u2];
#pragma unroll
                for (int jj = 0; jj < 4; ++jj) a[jj] *= dk[jj];
#pragma unroll
                for (int sb2 = 0; sb2 < CS / 32; ++sb2)
                    a = SC_MFMA(rd_tr(L0 + O_KW, sb2 * 32, kt * 16, QS, lane), rd_tr(L0 + O_V, sb2 * 32, vt * 16, VS, lane), a);
                sacc[u2] = a;
                st8(ST_W + (vt * 16 + r16) * QS + (kt * 16 + q4 * 4) * 2, make_uint2(cvt_pk_bf16(a[0], a[1]), cvt_pk_bf16(a[2], a[3])));
            }
        }
        __syncthreads();
    }
}
}

__device__ __forceinline__ void ph_scan_even2(KP p, int l, int bid, int nb) {
#pragma unroll 1
    for (int item = bid; item < 256; item += nb) {
        const int kind = item >> 7, b = (item >> 4) & 7, h = (item >> 2) & 3, dir = (item >> 1) & 1, vs = item & 1;
        if (kind == 0) sc::scan_item<0>(p, l, b, h, dir, vs); else sc::scan_item<1>(p, l, b, h, dir, vs);
        __syncthreads();
    }
}
__device__ __forceinline__ void ph_scan_odd2(KP p, int l, int bid, int nb) {
#pragma unroll 1
    for (int item = bid; item < 128; item += nb) {
        const int b = (item >> 4) & 7, h = (item >> 2) & 3, dir = (item >> 1) & 1, vs = item & 1;
        sc::scan_item<2>(p, l, b, h, dir, vs);
        __syncthreads();
    }
}

__device__ __forceinline__ void ph_normgate_even(KP p, int l, int bid, int nb) {
    const int tid = opaque_tid(), lane = tid & 63, wv = tid >> 6;
    const bf16_t* P = (const bf16_t*)(p->ws + OFF_BIG);
    const bf16_t* HX = (const bf16_t*)(p->ws + OFF_AUX);
    const bf16_t* HX1 = HX + (size_t)NT * 1024;
    bf16_t* MIX = (bf16_t*)(p->ws + OFF_U);
    const int e = l >> 1;
    #pragma unroll 1
    for (int it = bid * 8 + wv; it < NT * 8; it += nb * 8) {
        const int tok = it >> 3, g = it & 7;
        const size_t hxo = (size_t)tok * 1024 + g * 128;
        float x0 = bf2f(HX[hxo + lane]) + bf2f(HX1[hxo + lane]), x1 = bf2f(HX[hxo + lane + 64]) + bf2f(HX1[hxo + lane + 64]);
        const bf16_t* pr = P + (size_t)tok * EVEN_LD;
        if (g < 4) {
            const float mean = wave_sum(x0 + x1) * (1.f / 128.f);
            x0 -= mean; x1 -= mean;
            const float var = wave_sum(x0 * x0 + x1 * x1) * (1.f / 128.f);
            const float r = rsqrtf(var + LN_EPS);
            const float* nw = p->in[I_MNW] + e * 512 + g * 128;
            const float o0 = ldf(pr + E_MO + g * 128 + lane), o1 = ldf(pr + E_MO + g * 128 + lane + 64);
            stf(MIX + (size_t)tok * DM + g * 128 + lane, x0 * r * nw[lane] * sigmoidf_(o0));
            stf(MIX + (size_t)tok * DM + g * 128 + lane + 64, x1 * r * nw[lane + 64] * sigmoidf_(o1));
        } else {
            const int h = g - 4;
            const float ms = wave_sum(x0 * x0 + x1 * x1) * (1.f / 128.f);
            const float r = rsqrtf(ms + LN_EPS);
            const float* nw = p->in[I_HNW] + e * 512 + h * 128;
            const float g0 = ldf(pr + E_HG + h * 128 + lane), g1 = ldf(pr + E_HG + h * 128 + lane + 64);
            stf(MIX + (size_t)tok * DM + 512 + h * 128 + lane, x0 * r * nw[lane] * siluf_(g0));
            stf(MIX + (size_t)tok * DM + 512 + h * 128 + lane + 64, x1 * r * nw[lane + 64] * siluf_(g1));
        }
    }
}


#define OFF_UT   (OFF_AUX + 136 * MiB)
#define OFF_FK   (OFF_UT + 102 * MiB)
#define OFF_FKC  (OFF_FK + 32 * MiB)
#define OFF_ZOT  (OFF_FKC + 2 * MiB)

__device__ __forceinline__ void ph_hy_filt2(KP p, int l, int bid, int nb, float* sm) {
    const int tid = opaque_tid(), o = l >> 1;
    float* zf = sm;
    float* h1 = sm + 1024;
    float* h2 = sm + 2048;
    float* h3 = sm + 3072;
    const float* fw1 = p->in[I_HW1] + o * 33 * 64; const float* fb1 = p->in[I_HB1] + o * 64;
    const float* fw2 = p->in[I_HW2] + o * 64 * 64; const float* fb2 = p->in[I_HB2] + o * 64;
    const float* fw3 = p->in[I_HW3] + o * 64 * 64; const float* fb3 = p->in[I_HB3] + o * 64;
    const float* freq = p->in[I_HFREQ] + o * 64;
    const float* wout = p->in[I_HWOUT] + (size_t)o * 64 * 2048;
    float* FK = (float*)(p->ws + OFF_FK); float* FKC = (float*)(p->ws + OFF_FKC);
#pragma unroll 1
    for (int item = bid; item < (SEQ + CTXL) / 16; item += nb) {
        const bool isctx = item >= SEQ / 16;
        const int L = isctx ? CTXL : SEQ, pos0 = (isctx ? item - SEQ / 16 : item) * 16;
        __syncthreads();
        if (tid < 16 * 17) {
            const int pp = tid / 17, j = tid % 17, pos = pos0 + pp;
            if (j == 16) zf[pp * 36] = (float)pos / (float)(L - 1);
            else { const float f = 1e-4f + (float)j * ((15.0f - 1e-4f) / 15.0f); const float w = 2.0f * 3.14159265358979323846f * (float)pos / (float)L * f; zf[pp * 36 + 1 + j] = cosf(w); zf[pp * 36 + 17 + j] = sinf(w); }
        }
        __syncthreads();
        const int pp = tid >> 5, u0 = (tid & 31) * 2;
        { float a0 = fb1[u0], a1 = fb1[u0 + 1];
#pragma unroll 1
          for (int k = 0; k < 33; ++k) { const float z = zf[pp * 36 + k]; a0 += z * fw1[k * 64 + u0]; a1 += z * fw1[k * 64 + u0 + 1]; }
          h1[pp * 64 + u0] = sinf(freq[u0] * a0); h1[pp * 64 + u0 + 1] = sinf(freq[u0 + 1] * a1); }
        __syncthreads();
        { float a0 = fb2[u0], a1 = fb2[u0 + 1];
#pragma unroll 4
          for (int k = 0; k < 64; ++k) { const float z = h1[pp * 64 + k]; a0 += z * fw2[k * 64 + u0]; a1 += z * fw2[k * 64 + u0 + 1]; }
          h2[pp * 64 + u0] = sinf(freq[u0] * a0); h2[pp * 64 + u0 + 1] = sinf(freq[u0 + 1] * a1); }
        __syncthreads();
        { float a0 = fb3[u0], a1 = fb3[u0 + 1];
#pragma unroll 4
          for (int k = 0; k < 64; ++k) { const float z = h2[pp * 64 + k]; a0 += z * fw3[k * 64 + u0]; a1 += z * fw3[k * 64 + u0 + 1]; }
          h3[pp * 64 + u0] = sinf(freq[u0] * a0); h3[pp * 64 + u0 + 1] = sinf(freq[u0 + 1] * a1); }
        __syncthreads();
#pragma unroll 1
        for (int r = 0; r < 4; ++r) {
            const int col = tid + 512 * r, c = col & 511, od = col >> 9, order = od >> 1, dirn = od & 1;
            float a[16];
#pragma unroll
            for (int i = 0; i < 16; ++i) a[i] = 0.f;
#pragma unroll 2
            for (int k = 0; k < 64; ++k) { const float w = wout[k * 2048 + col];
#pragma unroll
                for (int i = 0; i < 16; ++i) a[i] += h3[i * 64 + k] * w; }
            const float delta = 3.0701134573253944f + (float)c * ((15.350567286626972f - 3.0701134573253944f) / 511.0f);
#pragma unroll
            for (int i = 0; i < 16; ++i) a[i] *= expf(-((float)(pos0 + i) / (float)(L - 1)) * delta);
            float* dst = isctx ? FKC + ((size_t)order * 512 + c) * 512 + 256 : FK + ((size_t)order * 512 + c) * 8192 + 4096;
            if (dirn == 0) {
#pragma unroll
                for (int i = 0; i < 16; i += 4) *(float4*)(dst + pos0 + i) = make_float4(a[i], a[i + 1], a[i + 2], a[i + 3]);
            } else {
#pragma unroll
                for (int i = 0; i < 16; ++i) if (pos0 + i > 0) dst[-(pos0 + i)] = a[i];
                if (pos0 == 0) dst[-L] = 0.f;
            }
        }
    }
}

__device__ __forceinline__ void ph_hy_prep(KP p, int l, int bid, int nb, float* sm) {
    const int tid = opaque_tid(), o = l >> 1;
    const bf16_t* P = (const bf16_t*)(p->ws + OFF_BIG);
    bf16_t* UT = (bf16_t*)(p->ws + OFF_UT);
    const float* cw = p->in[I_HCW] + o * 3 * 1536; const float* cb = p->in[I_HCB] + o * 1536;
    float* tile = sm;
#pragma unroll 1
    for (int item = bid; item < (NT / 256) * 96; item += nb) {
        const int tt = item / 96, ct = item % 96, tok0 = tt * 256, col0 = ct * 16;
        const bool lat = tok0 < NL;
        const int L = lat ? SEQ : CTXL, t0 = lat ? (tok0 & (SEQ - 1)) : ((tok0 - NL) & (CTXL - 1));
        __syncthreads();
        for (int i = tid; i < 258 * 2; i += 512) {
            const int rr = i >> 1, hf = i & 1, t = t0 + rr - 1;
            uint4 v = make_uint4(0u, 0u, 0u, 0u);
            if (t >= 0 && t < L) v = *(const uint4*)(P + (size_t)(tok0 + rr - 1) * ODD_LD + col0 + hf * 8);
            float* d = tile + rr * 17 + hf * 8;
            d[0] = bflo(v.x); d[1] = bfhi(v.x); d[2] = bflo(v.y); d[3] = bfhi(v.y); d[4] = bflo(v.z); d[5] = bfhi(v.z); d[6] = bflo(v.w); d[7] = bfhi(v.w);
        }
        __syncthreads();
        const int cc = tid >> 5, tc = (tid & 31) * 8, col = col0 + cc;
        const float w0 = cw[col], w1 = cw[1536 + col], w2 = cw[3072 + col], bb = cb[col];
        float y[8];
#pragma unroll
        for (int i = 0; i < 8; ++i) y[i] = tile[(tc + i) * 17 + cc] * w0 + tile[(tc + i + 1) * 17 + cc] * w1 + tile[(tc + i + 2) * 17 + cc] * w2 + bb;
        *(uint4*)(UT + (size_t)col * NT + tok0 + tc) = make_uint4(cvt_pk_bf16(y[0], y[1]), cvt_pk_bf16(y[2], y[3]), cvt_pk_bf16(y[4], y[5]), cvt_pk_bf16(y[6], y[7]));
    }
}

__device__ __forceinline__ void hy_item_lat(KP p, int l, int c) {
    constexpr int ZSB = (SEQ + 8) * 2;
    constexpr unsigned O_Z = 0, O_KF = O_Z + 8 * ZSB, O_T = O_KF + 8192 * 4, O_END = O_T + 2 * 64 * 144;
    static_assert(O_END <= 131072, "hyena LDS");
    const int tid = opaque_tid(), lane = tid & 63, wv = __builtin_amdgcn_readfirstlane(tid >> 6), r16 = lane & 15, q4 = lane >> 4, o = l >> 1;
    const unsigned L0 = (unsigned)(size_t)smraw_base();
    const bf16_t* UT = (const bf16_t*)(p->ws + OFF_UT);
    bf16_t* ZOT = (bf16_t*)(p->ws + OFF_ZOT);
    const float* FK = (const float*)(p->ws + OFF_FK);
    for (int i = tid; i < 8 * 512; i += 512) { const int b = i >> 9, ch = i & 511; sc::st16(L0 + O_Z + b * ZSB + ch * 16, *(const uint4*)(UT + (size_t)(1024 + c) * NT + b * SEQ + ch * 8)); }
#pragma unroll 1
    for (int order = 0; order < 2; ++order) {
        const float* fk = FK + ((size_t)order * 512 + c) * 8192;
        for (int i = tid; i < 2048; i += 512) { const float4 v = *(const float4*)(fk + i * 4); *(LAS sc::f32x4*)(size_t)(L0 + O_KF + i * 16) = (sc::f32x4){v.x, v.y, v.z, v.w}; }
        __syncthreads();
        sc::f32x4 acc[4][4];
#pragma unroll
        for (int a = 0; a < 4; ++a)
#pragma unroll
            for (int b2 = 0; b2 < 4; ++b2) acc[a][b2] = (sc::f32x4){0.f, 0.f, 0.f, 0.f};
        auto build_T = [&](int D, int buf) {
            const int t2 = tid >> 3, ch = tid & 7;
            const unsigned base = L0 + O_KF + (unsigned)(4096 + 64 * D + t2 - 8 * ch) * 4u;
            float v[8];
#pragma unroll
            for (int j = 0; j < 8; ++j) v[j] = *(const LAS float*)(size_t)(base - 4u * j);
            sc::st16(L0 + O_T + buf * 9216 + t2 * 144 + ch * 16, make_uint4(cvt_pk_bf16(v[0], v[1]), cvt_pk_bf16(v[2], v[3]), cvt_pk_bf16(v[4], v[5]), cvt_pk_bf16(v[6], v[7])));
        };
        build_T(-63, 1);
        __syncthreads();
#pragma unroll 1
        for (int D = -63; D <= 63; ++D) {
            const int buf = D & 1;
            if (D < 63) build_T(D + 1, buf ^ 1);
            const unsigned TB = L0 + O_T + buf * 9216;
            sc::bf16x8 af[4][2];
#pragma unroll
            for (int it = 0; it < 4; ++it)
#pragma unroll
                for (int kk = 0; kk < 2; ++kk) af[it][kk] = sc::rd_row(TB, it * 16 + r16, 144, kk * 32 + q4 * 8);
#pragma unroll
            for (int cg = 0; cg < 4; ++cg) {
                const int tA = wv + 8 * cg, sA = tA - D, sB = tA + 32 - D;
                const bool vA = (unsigned)sA < 64u, vB = (unsigned)sB < 64u;
                if (vA || vB) {
                    const int s1 = (r16 < 8) ? sA : sB;
                    const bool ok = (unsigned)s1 < 64u;
                    const unsigned za = L0 + O_Z + (unsigned)((r16 & 7) * ZSB + ((ok ? s1 : 0) * 64 + q4 * 8) * 2);
                    sc::bf16x8 b0 = *(const LAS sc::bf16x8*)(size_t)za, b1 = *(const LAS sc::bf16x8*)(size_t)(za + 64);
                    if (!ok) { b0 = (sc::bf16x8){0, 0, 0, 0, 0, 0, 0, 0}; b1 = b0; }
#pragma unroll
                    for (int it = 0; it < 4; ++it) { acc[cg][it] = SC_MFMA(af[it][0], b0, acc[cg][it]); acc[cg][it] = SC_MFMA(af[it][1], b1, acc[cg][it]); }
                }
            }
            __syncthreads();
        }
        const float sk = p->in[I_HSKIP][o * 1024 + order * 512 + c];
        const bf16_t* gt = UT + (size_t)(order * 512 + c) * NT;
        const int bb = r16 & 7;
#pragma unroll
        for (int cg = 0; cg < 4; ++cg) {
            const int t1 = wv + 8 * cg + ((r16 < 8) ? 0 : 32);
#pragma unroll
            for (int it = 0; it < 4; ++it) {
                const int t = t1 * 64 + it * 16 + q4 * 4;
                const sc::u32x2_ zo_ = *(const LAS sc::u32x2_*)(size_t)(L0 + O_Z + bb * ZSB + t * 2); const uint2 zo = make_uint2(zo_[0], zo_[1]);
                const uint2 gv = *(const uint2*)(gt + bb * SEQ + t);
                const float y0 = bflo(gv.x) * (acc[cg][it][0] + sk * bflo(zo.x)), y1 = bfhi(gv.x) * (acc[cg][it][1] + sk * bfhi(zo.x));
                const float y2 = bflo(gv.y) * (acc[cg][it][2] + sk * bflo(zo.y)), y3 = bfhi(gv.y) * (acc[cg][it][3] + sk * bfhi(zo.y));
                const uint2 w = make_uint2(cvt_pk_bf16(y0, y1), cvt_pk_bf16(y2, y3));
                if (order == 0) sc::st8(L0 + O_Z + bb * ZSB + t * 2, w);
                else *(uint2*)(ZOT + (size_t)c * NT + bb * SEQ + t) = w;
            }
        }
        __syncthreads();
    }
}

__device__ __forceinline__ void hy_item_ctx(KP p, int l, int c, float* sm) {
    const int tid = opaque_tid(), o = l >> 1;
    const bf16_t* UT = (const bf16_t*)(p->ws + OFF_UT);
    bf16_t* ZOT = (bf16_t*)(p->ws + OFF_ZOT);
    const float* FKC = (const float*)(p->ws + OFF_FKC);
    float* Kc = sm;
    float* zb = sm + 1024;
    for (int i = tid; i < 1024; i += 512) Kc[i] = FKC[((size_t)(i >> 9) * 512 + c) * 512 + (i & 511)];
    for (int i = tid; i < 8 * CTXL; i += 512) zb[i] = bf2f(UT[(size_t)(1024 + c) * NT + NL + i]);
    __syncthreads();
    const int bb = tid >> 6, tl = tid & 63;
#pragma unroll 1
    for (int order = 0; order < 2; ++order) {
        float acc[4] = {0.f, 0.f, 0.f, 0.f};
#pragma unroll 4
        for (int s = 0; s < CTXL; ++s) {
            const float zv = zb[bb * CTXL + s];
#pragma unroll
            for (int i = 0; i < 4; ++i) acc[i] += Kc[order * 512 + tl + 64 * i - s + 256] * zv;
        }
        const float sk = p->in[I_HSKIP][o * 1024 + order * 512 + c];
        float zn[4];
#pragma unroll
        for (int i = 0; i < 4; ++i) { const int t = tl + 64 * i; zn[i] = bf2f(UT[(size_t)(order * 512 + c) * NT + NL + bb * CTXL + t]) * (acc[i] + zb[bb * CTXL + t] * sk); }
        __syncthreads();
#pragma unroll
        for (int i = 0; i < 4; ++i) { const int t = tl + 64 * i; if (order == 0) zb[bb * CTXL + t] = bf2f((bf16_t)(cvt_pk_bf16(zn[i], 0.f) & 0xffffu)); else stf(ZOT + (size_t)c * NT + NL + bb * CTXL + t, zn[i]); }
        __syncthreads();
    }
}

__device__ __forceinline__ void ph_mix_odd(KP p, int l, int bid, int nb, float* sm) {
    int* head = (int*)(p->ws + OFF_CNT) + 1024 + (l >> 1) * 64;
    LAS int* slot = (LAS int*)(smraw_base() + BAR_LDS_ + 64);
#pragma unroll 1
    for (;;) {
        if (threadIdx.x == 0) *slot = atomicAdd(head, 1);
        __syncthreads();
        const int item = *slot;
        __syncthreads();
        if (item >= 128 + 512) break;
        if (item < 128) { const int b = (item >> 4) & 7, h = (item >> 2) & 3, dir = (item >> 1) & 1, vs = item & 1; sc::scan_item<2>(p, l, b, h, dir, vs); }
        else { const int c = item - 128; hy_item_lat(p, l, c); __syncthreads(); hy_item_ctx(p, l, c, sm); }
        __syncthreads();
    }
}

__device__ __forceinline__ void ph_hy_norm(KP p, int l, int bid, int nb, float* sm) {
    const int tid = opaque_tid(), o = l >> 1;
    const bf16_t* ZOT = (const bf16_t*)(p->ws + OFF_ZOT);
    bf16_t* MIX = (bf16_t*)(p->ws + OFF_U);
    const float* nw = p->in[I_HNORM] + o * 512;
    float* tile = sm;
    float* part = sm + 64 * 65;
#pragma unroll 1
    for (int item = bid; item < (NT / 64) * 8; item += nb) {
        const int tt = item >> 3, g = item & 7, tok0 = tt * 64;
        __syncthreads();
        { const int cc = tid >> 3, ch = tid & 7;
          const uint4 v = *(const uint4*)(ZOT + (size_t)(g * 64 + cc) * NT + tok0 + ch * 8);
          float* d = tile + cc * 65 + ch * 8;
          d[0] = bflo(v.x); d[1] = bfhi(v.x); d[2] = bflo(v.y); d[3] = bfhi(v.y); d[4] = bflo(v.z); d[5] = bfhi(v.z); d[6] = bflo(v.w); d[7] = bfhi(v.w); }
        __syncthreads();
        { const int tk = tid & 63, pt = tid >> 6; float s = 0.f;
#pragma unroll
          for (int i = 0; i < 8; ++i) { const float x = tile[(pt * 8 + i) * 65 + tk]; s += x * x; }
          part[pt * 64 + tk] = s; }
        __syncthreads();
        { const int tk = tid >> 3, ch = tid & 7; float s = 0.f;
#pragma unroll
          for (int i = 0; i < 8; ++i) s += part[i * 64 + tk];
          const float rs = rsqrtf(s * (1.f / 64.f) + LN_EPS);
          float y[8];
#pragma unroll
          for (int i = 0; i < 8; ++i) y[i] = tile[(ch * 8 + i) * 65 + tk] * rs * nw[g * 64 + ch * 8 + i];
          *(uint4*)(MIX + (size_t)(tok0 + tk) * DM + g * 64 + ch * 8) = make_uint4(cvt_pk_bf16(y[0], y[1]), cvt_pk_bf16(y[2], y[3]), cvt_pk_bf16(y[4], y[5]), cvt_pk_bf16(y[6], y[7])); }
    }
}

__device__ __forceinline__ void ph_normgate_odd(KP p, int l, int bid, int nb) {
    const int tid = opaque_tid(), lane = tid & 63, wv = tid >> 6, o = l >> 1;
    const bf16_t* P = (const bf16_t*)(p->ws + OFF_BIG);
    const bf16_t* HX = (const bf16_t*)(p->ws + OFF_AUX);
    const bf16_t* HX1 = HX + (size_t)NT * 1024;
    bf16_t* MIX = (bf16_t*)(p->ws + OFF_U);
    #pragma unroll 1
    for (int tok = bid * 8 + wv; tok < NT; tok += nb * 8) {
        const bf16_t* pr = P + (size_t)tok * ODD_N;
#pragma unroll
        for (int h = 0; h < 4; ++h) {
            const size_t hxo = (size_t)tok * 1024 + 512 + h * 128;
            float x0 = bf2f(HX[hxo + lane]) + bf2f(HX1[hxo + lane]), x1 = bf2f(HX[hxo + lane + 64]) + bf2f(HX1[hxo + lane + 64]);
            const float mean = wave_sum(x0 + x1) * (1.f / 128.f);
            x0 -= mean; x1 -= mean;
            const float var = wave_sum(x0 * x0 + x1 * x1) * (1.f / 128.f);
            const float r = rsqrtf(var + LN_EPS);
            const float* nw = p->in[I_RNW] + o * 512 + h * 128;
            const float g0 = ldf(pr + 3072 + h * 128 + lane), g1 = ldf(pr + 3072 + h * 128 + lane + 64);
            stf(MIX + (size_t)tok * DM + 512 + h * 128 + lane, x0 * r * nw[lane] * siluf_(g0));
            stf(MIX + (size_t)tok * DM + 512 + h * 128 + lane + 64, x1 * r * nw[lane + 64] * siluf_(g1));
        }
    }
}


__device__ __forceinline__ void ph_ln1_router(KP p, int l, int ntok, int bid, int nb, float* sm) {
    const int tid = opaque_tid(), lane = tid & 63, wv = __builtin_amdgcn_readfirstlane(tid >> 6);
    const float* Y = (const float*)(p->ws + OFF_BIG);
    bf16_t* U = (bf16_t*)(p->ws + OFF_U);
    const float* lw = p->in[I_LNW] + (l * 2) * 1024; const float* lb = p->in[I_LNB] + (l * 2) * 1024;
    const float* rw = p->in[I_RW] + (size_t)l * 1024 * 64;
    const float rb = p->in[I_RB][l * 64 + lane];
    LAS int* lcnt = (LAS int*)(smraw_base() + BAR_LDS_ + 256);
    if (tid < 64) lcnt[tid] = 0;
    __syncthreads();
    int* tidx = (int*)(p->ws + OFF_TIDX); float* tgate = (float*)(p->ws + OFF_TGATE); int* tpos = (int*)(p->ws + OFF_TPOS);
    LAS float* Vall = (LAS float*)smraw_base();
    {
        int* stok = (int*)(p->ws + OFF_STOK); float* sgate = (float*)(p->ws + OFF_SGATE); int* sdst = (int*)(p->ws + OFF_SDST);
#pragma unroll 1
        for (int i = bid * 512 + tid; i < MAXROWS; i += nb * 512) { stok[i] = ZROW; sgate[i] = 0.f; sdst[i] = -1; }
    }
#pragma unroll 1
    for (int base = bid * 32; base < ntok; base += nb * 32) {
#pragma unroll 2
        for (int j = 0; j < 4; ++j) {
            const int tok = base + wv * 4 + j;
            float* h = hrow(p, tok);
            const float* m = modrow(p, l, tok);
            const float* r = Y + (size_t)tok * DM;
            float x[16]; float s = 0.f;
#pragma unroll
            for (int c = 0; c < 4; ++c) {
                const int d = 4 * (lane + 64 * c);
                const float4 hv = *(const float4*)(h + d), gv = *(const float4*)(m + 2 * 1024 + d), rv = *(const float4*)(r + d);
                x[4 * c] = ALPHA * hv.x + gv.x * rv.x; x[4 * c + 1] = ALPHA * hv.y + gv.y * rv.y; x[4 * c + 2] = ALPHA * hv.z + gv.z * rv.z; x[4 * c + 3] = ALPHA * hv.w + gv.w * rv.w;
                s += x[4 * c] + x[4 * c + 1] + x[4 * c + 2] + x[4 * c + 3];
            }
            const float mean = wave_sum(s) * (1.f / 1024.f);
            float q = 0.f;
#pragma unroll
            for (int i = 0; i < 16; ++i) { x[i] -= mean; q += x[i] * x[i]; }
            const float rs = rsqrtf(wave_sum(q) * (1.f / 1024.f) + LN_EPS);
#pragma unroll
            for (int c = 0; c < 4; ++c) {
                const int d = 4 * (lane + 64 * c);
                const float4 w4 = *(const float4*)(lw + d), b4 = *(const float4*)(lb + d), sh = *(const float4*)(m + 3 * 1024 + d), sc = *(const float4*)(m + 4 * 1024 + d);
                float4 y; y.x = x[4 * c] * rs * w4.x + b4.x; y.y = x[4 * c + 1] * rs * w4.y + b4.y; y.z = x[4 * c + 2] * rs * w4.z + b4.z; y.w = x[4 * c + 3] * rs * w4.w + b4.w;
                *(float4*)(h + d) = y;
                float4 v; v.x = y.x * (1.f + sc.x) + sh.x; v.y = y.y * (1.f + sc.y) + sh.y; v.z = y.z * (1.f + sc.z) + sh.z; v.w = y.w * (1.f + sc.w) + sh.w;
                *(uint2*)(U + (size_t)tok * DM + d) = make_uint2(cvt_pk_bf16(v.x, v.y), cvt_pk_bf16(v.z, v.w));
                *(LAS sc::f32x4*)(Vall + (wv * 4 + j) * 1024 + d) = (sc::f32x4){v.x, v.y, v.z, v.w};
            }
        }
        __syncthreads();
        float a[32];
#pragma unroll
        for (int t = 0; t < 32; ++t) a[t] = 0.f;
#pragma unroll 1
        for (int d = wv * 128; d < wv * 128 + 128; d += 4) {
            const float w0 = rw[(d + 0) * 64 + lane], w1 = rw[(d + 1) * 64 + lane], w2 = rw[(d + 2) * 64 + lane], w3 = rw[(d + 3) * 64 + lane];
#pragma unroll
            for (int t = 0; t < 32; ++t) { const sc::f32x4 v = *(const LAS sc::f32x4*)(Vall + t * 1024 + d); a[t] += v[0] * w0 + v[1] * w1 + v[2] * w2 + v[3] * w3; }
        }
        __syncthreads();
#pragma unroll
        for (int t = 0; t < 32; ++t) Vall[(wv * 32 + t) * 64 + lane] = a[t];
        __syncthreads();
#pragma unroll 1
        for (int j = 0; j < 4; ++j) {
            const int tl = wv * 4 + j, tok = base + tl;
            float lg = 0.f;
#pragma unroll
            for (int w = 0; w < 8; ++w) lg += Vall[(w * 32 + tl) * 64 + lane];
            const float score = sigmoidf_(lg);
            const float key = score + rb;
            int rank = 0;
#pragma unroll
            for (int e = 0; e < 64; ++e) { const float ke = __builtin_bit_cast(float, __builtin_amdgcn_readlane(__builtin_bit_cast(int, key), e)); rank += (ke > key || (ke == key && e < lane)) ? 1 : 0; }
            const bool sel = rank < TOPK;
            const float gsum = wave_sum(sel ? score : 0.f);
            if (sel) {
                const int pos = __hip_atomic_fetch_add(lcnt + lane, 1, __ATOMIC_RELAXED, __HIP_MEMORY_SCOPE_WORKGROUP);
                tidx[tok * 8 + rank] = lane; tgate[tok * 8 + rank] = 2.5f * score / gsum; tpos[tok * 8 + rank] = pos;
            }
        }
        __syncthreads();
    }
    __syncthreads();
    if (tid < 64) ((int*)(p->ws + OFF_BCNT))[bid * 64 + tid] = lcnt[tid];
}

__device__ __forceinline__ void moe_offsets(KP p, int l, int ntok, LAS int* offs) {
    const int t = opaque_tid();
    if (t < 66) offs[t] = ((const int*)(p->ws + OFF_GOFFS))[t];
    __syncthreads();
}
__device__ __forceinline__ int moe_expert_of(const LAS int* offs, int row) { int e = 0;
#pragma unroll 1
    while (e < 64 && row >= offs[e + 1]) ++e;
    return e; }

__device__ __forceinline__ void ph_scatter(KP p, int l, int ntok, int bid, int nb, LAS unsigned char* lds) {
    LAS int* offs = (LAS int*)lds;
    LAS int* myb = offs + 128;
    LAS int* part = offs + 256;
    const int tid = opaque_tid();
    const int* bcnt = (const int*)(p->ws + OFF_BCNT);
    { const int e = tid & 63, pt = tid >> 6; int tot = 0, mine = 0;
#pragma unroll 4
      for (int b = pt; b < nb; b += 8) { const int c = bcnt[b * 64 + e]; tot += c; mine += (b < bid) ? c : 0; }
      part[pt * 64 + e] = tot; part[512 + pt * 64 + e] = mine; }
    __syncthreads();
    if (tid < 64) {
        int tot = 0, mine = 0;
#pragma unroll
        for (int i = 0; i < 8; ++i) { tot += part[i * 64 + tid]; mine += part[512 + i * 64 + tid]; }
        const int pc = (tot + 255) & ~255;
        int incl = pc;
#pragma unroll
        for (int o = 1; o < 64; o <<= 1) { const int t = __shfl_up(incl, o, 64); if (tid >= o) incl += t; }
        offs[tid] = incl - pc; myb[tid] = mine;
        if (tid == 63) { offs[64] = incl; offs[65] = incl + ntok; }
    }
    __syncthreads();
    if (bid == 0 && tid < 66) ((int*)(p->ws + OFF_GOFFS))[tid] = offs[tid];
    const int* tidx = (const int*)(p->ws + OFF_TIDX); const float* tgate = (const float*)(p->ws + OFF_TGATE); const int* tpos = (const int*)(p->ws + OFF_TPOS);
    int* stok = (int*)(p->ws + OFF_STOK); float* sgate = (float*)(p->ws + OFF_SGATE); int* sdst = (int*)(p->ws + OFF_SDST);
    int* tile_e = (int*)(p->ws + OFF_TILEE);
#pragma unroll 1
    for (int base = bid * 32; base < ntok; base += nb * 32) {
        if (tid < 32 * 9) {
            const int tok = base + tid / 9, sl = tid % 9;
            if (sl < 8) { const int i = tok * 8 + sl, e = tidx[i], row = offs[e] + myb[e] + tpos[i]; stok[row] = tok; sgate[row] = tgate[i]; sdst[row] = tok * 9 + sl; }
            else { const int row = offs[64] + tok; stok[row] = tok; sgate[row] = 1.f; sdst[row] = tok * 9 + 8; }
        }
    }
    const int nrt = offs[65] >> 8;
#pragma unroll 1
    for (int rt = bid * 512 + tid; rt < nrt; rt += nb * 512) tile_e[rt] = moe_expert_of(offs, rt * 256);
    __syncthreads();
}

#define MOE_TAB (gp::STAGE_BYTES + 256)
#define MOE_MAXT 8
struct Moe1Sched {
    const char* U; const char* W; const LAS int* tabE; const LAS int* tabS; int nper, bid, nb;
    __device__ __forceinline__ bool next(int i, gp::Unit& u) const {
        const int j = i >> 1; if (j >= nper) return false;
        u.A = U; u.B = W + (size_t)tabE[j] * (512 * 1024 * 2) + (size_t)(i & 1) * (256 * 1024 * 2); u.r0 = (bid + j * nb) * 256; u.c0 = (i & 1) * 256; u.aux = j; return true;
    }
    __device__ __forceinline__ void lane_off(const gp::Unit& u, int R0, int R1, int C0, int C1, unsigned (&vo)[2][2]) const {
        const LAS int* t = tabS + u.aux * 256;
        vo[0][0] = (unsigned)t[R0] * 2048u + (unsigned)C0 * 2u; vo[0][1] = (unsigned)t[R1] * 2048u + (unsigned)C1 * 2u;
        vo[1][0] = (unsigned)t[128 + R0] * 2048u + (unsigned)C0 * 2u; vo[1][1] = (unsigned)t[128 + R1] * 2048u + (unsigned)C1 * 2u;
    }
};
struct EpiH {
    bf16_t* H;
    __device__ __forceinline__ void operator()(const gp::f32x4 (&acc)[2][2][4][2], const gp::Unit& u, int wr, int wc, int fr, int fq) const {
        const int row0 = u.r0 + wr * 64 + fr;
#pragma unroll
        for (int ai = 0; ai < 2; ++ai)
#pragma unroll
            for (int m = 0; m < 4; ++m) { bf16_t* rowp = H + (size_t)(row0 + ai * 128 + m * 16) * 256;
#pragma unroll
                for (int bj = 0; bj < 2; ++bj) {
                    const int j0 = ((u.c0 + bj * 128 + wc * 32) >> 5) * 16 + 4 * fq;
                    const gp::f32x4 a = acc[ai][bj][m][0], b = acc[ai][bj][m][1];
                    const float h0 = siluf_(a[0]) * b[0], h1 = siluf_(a[1]) * b[1], h2 = siluf_(a[2]) * b[2], h3 = siluf_(a[3]) * b[3];
                    *(uint2*)(rowp + j0) = make_uint2(cvt_pk_bf16(h0, h1), cvt_pk_bf16(h2, h3)); }
                __builtin_amdgcn_sched_barrier(0); }
    }
};
__device__ __forceinline__ void ph_moe1(KP p, int l, int ntok, int bid, int nb, LAS unsigned char* lds) {
    LAS int* offs = (LAS int*)(lds + MOE_TAB);
    LAS int* tabE = offs + 128;
    LAS int* tabS = offs + 256;
    moe_offsets(p, l, ntok, offs);
    const int tid = opaque_tid();
    const int nrt = offs[65] >> 8;
    const int nper = bid < nrt ? (nrt - bid + nb - 1) / nb : 0;
    const int* stok = (const int*)(p->ws + OFF_STOK); const int* tile_e = (const int*)(p->ws + OFF_TILEE);
    for (int i = tid; i < nper * 256; i += 512) tabS[i] = stok[(size_t)(bid + (i >> 8) * nb) * 256 + (i & 255)];
    if (tid < nper) tabE[tid] = tile_e[bid + tid * nb];
    __syncthreads();
    Moe1Sched S{(const char*)(p->ws + OFF_U), (const char*)(p->ws + OFF_W13), tabE, tabS, nper, bid, nb};
    EpiH E{(bf16_t*)(p->ws + OFF_BIG)};
    gp::gemm_phase<true, false>(lds, 1024, S, E);
}

struct Moe2Sched {
    const char* H; const char* W; const LAS int* tabE; int nper, bid, nb;
    __device__ __forceinline__ bool next(int i, gp::Unit& u) const {
        const int j = i >> 2; if (j >= nper) return false;
        u.A = H + (size_t)(bid + j * nb) * (256 * 256 * 2); u.B = W + (size_t)tabE[j] * (1024 * 256 * 2) + (size_t)(i & 3) * (256 * 256 * 2); u.r0 = j * 256; u.c0 = (i & 3) * 256; u.aux = j; return true;
    }
    __device__ __forceinline__ void lane_off(const gp::Unit&, int, int, int, int, unsigned (&)[2][2]) const {}
};
struct EpiY {
    bf16_t* Ys; const LAS int* tabD; const LAS float* tabG;
    __device__ __forceinline__ void operator()(const gp::f32x4 (&acc)[2][2][4][2], const gp::Unit& u, int wr, int wc, int fr, int fq) const {
        const int rl0 = u.r0 + wr * 64 + fr, col0 = u.c0 + wc * 32 + 8 * fq;
#pragma unroll
        for (int ai = 0; ai < 2; ++ai)
#pragma unroll
            for (int m = 0; m < 4; ++m) {
                const int rl = rl0 + ai * 128 + m * 16;
                const int dst = tabD[rl]; const float g = tabG[rl];
                if (dst >= 0) { bf16_t* rowp = Ys + (size_t)dst * 1024 + col0;
#pragma unroll
                    for (int bj = 0; bj < 2; ++bj) { const gp::f32x4 v0 = acc[ai][bj][m][0] * g, v1 = acc[ai][bj][m][1] * g;
                        gp::u32x4 w; w.x = cvt_pk_bf16(v0[0], v0[1]); w.y = cvt_pk_bf16(v0[2], v0[3]); w.z = cvt_pk_bf16(v1[0], v1[1]); w.w = cvt_pk_bf16(v1[2], v1[3]);
                        *(gp::u32x4*)(rowp + bj * 128) = w; } }
                __builtin_amdgcn_sched_barrier(0); }
    }
};
__device__ __forceinline__ void ph_moe2(KP p, int l, int ntok, int bid, int nb, LAS unsigned char* lds) {
    LAS int* offs = (LAS int*)(lds + MOE_TAB);
    LAS int* tabE = offs + 128;
    LAS int* tabD = offs + 256;
    LAS float* tabG = (LAS float*)(tabD + MOE_MAXT * 256);
    moe_offsets(p, l, ntok, offs);
    const int tid = opaque_tid();
    const int nrt = offs[65] >> 8;
    const int nper = bid < nrt ? (nrt - bid + nb - 1) / nb : 0;
    const int* sdst = (const int*)(p->ws + OFF_SDST); const float* sgate = (const float*)(p->ws + OFF_SGATE); const int* tile_e = (const int*)(p->ws + OFF_TILEE);
    for (int i = tid; i < nper * 256; i += 512) { const size_t r = (size_t)(bid + (i >> 8) * nb) * 256 + (i & 255); tabD[i] = sdst[r]; tabG[i] = sgate[r]; }
    if (tid < nper) tabE[tid] = tile_e[bid + tid * nb];
    __syncthreads();
    Moe2Sched S{(const char*)(p->ws + OFF_BIG), (const char*)(p->ws + OFF_W2), tabE, nper, bid, nb};
    EpiY E{(bf16_t*)(p->ws + OFF_YS), tabD, tabG};
    gp::gemm_phase<false, true>(lds, 256, S, E);
}

__device__ __forceinline__ void ph_combine_ln2(KP p, int l, int ntok, int bid, int nb) {
    const int tid = opaque_tid(), lane = tid & 63, wv = tid >> 6;
    const bf16_t* Ys = (const bf16_t*)(p->ws + OFF_YS);
    const float* lw = p->in[I_LNW] + (l * 2 + 1) * 1024; const float* lb = p->in[I_LNB] + (l * 2 + 1) * 1024;
    #pragma unroll 1
    for (int tok = bid * 8 + wv; tok < ntok; tok += nb * 8) {
        float* h = hrow(p, tok);
        const float* m = modrow(p, l, tok);
        float f[16];
#pragma unroll
        for (int i = 0; i < 16; ++i) f[i] = 0.f;
#pragma unroll
        for (int s = 0; s < 9; ++s)
#pragma unroll
            for (int c = 0; c < 2; ++c) {
                const uint4 w = *(const uint4*)(Ys + ((size_t)tok * 9 + s) * 1024 + 8 * (lane + 64 * c));
                f[8 * c + 0] += bflo(w.x); f[8 * c + 1] += bfhi(w.x); f[8 * c + 2] += bflo(w.y); f[8 * c + 3] += bfhi(w.y);
                f[8 * c + 4] += bflo(w.z); f[8 * c + 5] += bfhi(w.z); f[8 * c + 6] += bflo(w.w); f[8 * c + 7] += bfhi(w.w);
            }
        float x[16]; float sum = 0.f;
#pragma unroll
        for (int c = 0; c < 2; ++c)
#pragma unroll
            for (int q = 0; q < 2; ++q) {
                const int d = 8 * (lane + 64 * c) + 4 * q;
                const float4 hv = *(const float4*)(h + d), gv = *(const float4*)(m + 5 * 1024 + d);
                x[8 * c + 4 * q + 0] = ALPHA * hv.x + gv.x * f[8 * c + 4 * q + 0]; x[8 * c + 4 * q + 1] = ALPHA * hv.y + gv.y * f[8 * c + 4 * q + 1];
                x[8 * c + 4 * q + 2] = ALPHA * hv.z + gv.z * f[8 * c + 4 * q + 2]; x[8 * c + 4 * q + 3] = ALPHA * hv.w + gv.w * f[8 * c + 4 * q + 3];
                sum += x[8 * c + 4 * q] + x[8 * c + 4 * q + 1] + x[8 * c + 4 * q + 2] + x[8 * c + 4 * q + 3];
            }
        const float mean = wave_sum(sum) * (1.f / 1024.f);
        float q2 = 0.f;
#pragma unroll
        for (int i = 0; i < 16; ++i) { x[i] -= mean; q2 += x[i] * x[i]; }
        const float rs = rsqrtf(wave_sum(q2) * (1.f / 1024.f) + LN_EPS);
#pragma unroll
        for (int c = 0; c < 2; ++c)
#pragma unroll
            for (int q = 0; q < 2; ++q) {
                const int d = 8 * (lane + 64 * c) + 4 * q;
                const float4 w4 = *(const float4*)(lw + d), b4 = *(const float4*)(lb + d);
                float4 y; y.x = x[8 * c + 4 * q] * rs * w4.x + b4.x; y.y = x[8 * c + 4 * q + 1] * rs * w4.y + b4.y; y.z = x[8 * c + 4 * q + 2] * rs * w4.z + b4.z; y.w = x[8 * c + 4 * q + 3] * rs * w4.w + b4.w;
                *(float4*)(h + d) = y;
            }
    }
}

#define MEGA_LDS (131072 + 256 + 20480)
#define NBLK 256
#define BAR_LDS 131072
#define SYNC() do { XcdBarrier _b; _b.bar = (unsigned*)kparams()->ws; _b.x = xb_xcc_id(); _b.st = (volatile LAS unsigned*)((LAS unsigned char*)smraw_base() + BAR_LDS); xcd_barrier(_b); } while (0)
template <int PAR>
__device__ __forceinline__ void layer_fwd(const int l) {
    LAS unsigned char* lds = smraw_base(); float* sm = (float*)smraw_generic();
    const int bid = blockIdx.x; constexpr int nb = NBLK;
    const int ntok = (l == 3) ? NL : NT;
    ph_convert(kparams(), l, bid, nb, sm); ph_modin(kparams(), l, bid, nb); SYNC();
    ph_gemm_in(kparams(), l, bid, nb, lds); SYNC();
    if (PAR == 0) {
        ph_scan_even2(kparams(), l, bid, nb); SYNC();
        ph_normgate_even(kparams(), l, bid, nb); SYNC();
    } else {
        ph_hy_filt2(kparams(), l, bid, nb, sm); ph_hy_prep(kparams(), l, bid, nb, sm); SYNC();
        ph_mix_odd(kparams(), l, bid, nb, sm); SYNC();
        ph_hy_norm(kparams(), l, bid, nb, sm); ph_normgate_odd(kparams(), l, bid, nb); SYNC();
    }
    ph_gemm_out(kparams(), l, bid, nb, lds); SYNC();
    ph_ln1_router(kparams(), l, ntok, bid, nb, sm); SYNC();
    ph_scatter(kparams(), l, ntok, bid, nb, lds); SYNC();
    ph_moe1(kparams(), l, ntok, bid, nb, lds); SYNC();
    ph_moe2(kparams(), l, ntok, bid, nb, lds); SYNC();
    ph_combine_ln2(kparams(), l, ntok, bid, nb);
    if (l < 3) SYNC();
}
__global__ void __launch_bounds__(512, 2) mega_fwd(Params p) {
    LAS unsigned char* lds = smraw_base(); float* sm = (float*)smraw_generic();
    if (threadIdx.x < 4) ((LAS unsigned*)(lds + 131072))[threadIdx.x] = 0u;
    __syncthreads();
    (void)xcd_barrier_post((unsigned*)kparams()->ws, (volatile LAS unsigned*)(lds + BAR_LDS));
    const int bid = blockIdx.x; constexpr int nb = NBLK;
    ph_prologue(kparams(), bid, nb, sm); SYNC();
#pragma unroll 1
    for (int lp = 0; lp < 2; ++lp) {
        layer_fwd<0>(2 * lp);
        layer_fwd<1>(2 * lp + 1);
    }
    __syncthreads();
    if (blockIdx.x == 0 && threadIdx.x == 0 && xb_ld((unsigned*)kparams()->ws + XB_TMO) != 0u) kparams()->out[0] = __builtin_nanf("");
}

extern "C" void kernel_launch(void* const* d_in, const int* in_sizes, int n_in, void* d_out, int out_size, void* d_ws, size_t ws_size, hipStream_t stream) {
    static int grid = 0;
    if (grid == 0) {
        if (n_in != 38 || out_size != NL * DM || ws_size < WS_END) { fprintf(stderr, "kernel_launch: bad shapes n_in %d out %d ws %zu (need %zu)\n", n_in, out_size, ws_size, (size_t)WS_END); grid = -1; return; }
        int dev = 0, cus = 0, per_cu = 0;
        if (hipGetDevice(&dev) != hipSuccess || hipDeviceGetAttribute(&cus, hipDeviceAttributeMultiprocessorCount, dev) != hipSuccess) { grid = -1; return; }
        if (hipFuncSetAttribute((const void*)mega_fwd, hipFuncAttributeMaxDynamicSharedMemorySize, MEGA_LDS) != hipSuccess) { fprintf(stderr, "kernel_launch: hipFuncSetAttribute failed\n"); grid = -1; return; }
        if (hipOccupancyMaxActiveBlocksPerMultiprocessor(&per_cu, (const void*)mega_fwd, 512, MEGA_LDS) != hipSuccess || per_cu < 1) { fprintf(stderr, "kernel_launch: occupancy query says %d\n", per_cu); (void)hipGetLastError(); grid = -1; return; }
        if (cus != 256) { fprintf(stderr, "kernel_launch: built for 256 CUs, found %d\n", cus); grid = -1; return; }
        grid = NBLK;
    }
    if (grid < 0) return;
    if (hipMemsetAsync(d_ws, 0, OFF_LB, stream) != hipSuccess) return;
    Params p{};
    for (int i = 0; i < 38; ++i) p.in[i] = (const float*)d_in[i];
    p.out = (float*)d_out; p.ws = (unsigned char*)d_ws;
    hipLaunchKernelGGL(mega_fwd, dim3(grid), dim3(512), MEGA_LDS, stream, p);
}
```

```cpp
#include <hip/hip_runtime.h>
#include <stdint.h>
#include <stdio.h>

#define DM 1024
#define NBATCH 8
#define SEQ 4096
#define CTXL 256
#define NL (NBATCH * SEQ)
#define NC (NBATCH * CTXL)
#define NT (NL + NC)
#define ZROW NT
#define TOPK 8
#define EVEN_N 4112
#define ODD_N 3584
#define EVEN_LD 4096
#define ODD_LD 3584
#define MAXROWS (NT * 8 + 64 * 256 + NT)
#define ALPHA 1.681792830507429f
#define LN_EPS 1e-5f
#define E_MQ 0
#define E_MK 256
#define E_MV 512
#define E_MO 1024
#define E_HQ 1536
#define E_HI 2048
#define E_HFF 2560
#define E_HFB 3072
#define E_HG 3584

typedef unsigned short bf16_t;
#define LAS __attribute__((address_space(3)))
#define BAR_LDS_ 150528

#define MiB ((size_t)1 << 20)
#define OFF_CNT   ((size_t)64 << 10)
#define OFF_LB    ((size_t)96 << 10)
#define OFF_MOD   ((size_t)128 << 10)
#define OFF_ROPE  ((size_t)1536 << 10)
#define OFF_BCNT  ((size_t)1600 << 10)
#define OFF_GOFFS ((size_t)1700 << 10)
#define OFF_TILEE (2 * MiB)
#define OFF_HCTX  (4 * MiB)
#define OFF_TIDX  (12 * MiB)
#define OFF_TGATE (14 * MiB)
#define OFF_TPOS  (16 * MiB)
#define OFF_STOK  (18 * MiB)
#define OFF_SGATE (20 * MiB)
#define OFF_SDST  (22 * MiB)
#define OFF_G     (24 * MiB)
#define OFF_U     (28 * MiB)
#define OFF_W     (98 * MiB)
#define OFF_WIN   (OFF_W)
#define OFF_WOUT  (OFF_W + 8 * MiB)
#define OFF_W13   (OFF_W + 10 * MiB)
#define OFF_W2    (OFF_W + 75 * MiB)
#define OFF_BIG   (208 * MiB)
#define OFF_AUX   (480 * MiB)
#define OFF_Z1    (OFF_AUX + 136 * MiB)
#define OFF_Z2    (OFF_Z1 + 68 * MiB)
#define OFF_FILT  (OFF_Z2 + 68 * MiB)
#define OFF_YS    (370 * MiB)
#define WS_END    (984 * MiB)

struct Params {
    const float* in[38];
    float* out;
    unsigned char* ws;
};

enum { I_X = 0, I_C, I_CTX, I_CCTX, I_ADAW, I_ADAB, I_LNW, I_LNB, I_EWIN, I_MGB, I_MNW, I_HLB, I_HNW, I_EWOUT, I_OWIN, I_HCW, I_HCB,
       I_HW1, I_HB1, I_HW2, I_HB2, I_HW3, I_HB3, I_HFREQ, I_HWOUT, I_HSKIP, I_HNORM, I_RLD, I_RNW, I_OWOUT, I_RW, I_RB, I_W1, I_W3, I_W2, I_SW1, I_SW3, I_SW2 };

typedef const __attribute__((address_space(4))) Params* KP;
__device__ __forceinline__ KP kparams() { KP k = (KP)__builtin_amdgcn_kernarg_segment_ptr(); asm volatile("" : "+s"(k)); return k; }
extern __shared__ __attribute__((aligned(16))) unsigned char smraw_all[];
__device__ __forceinline__ LAS unsigned char* smraw_base() { return (LAS unsigned char*)smraw_all; }
__device__ __forceinline__ unsigned char* smraw_generic() { return smraw_all; }
__device__ __forceinline__ int opaque_tid() { int t = threadIdx.x; asm volatile("" : "+v"(t)); return t; }
typedef __bf16 bf16x2_n __attribute__((ext_vector_type(2)));
typedef float f32x2_n __attribute__((ext_vector_type(2)));
__device__ __forceinline__ unsigned cvt_pk_bf16(float lo, float hi) { const f32x2_n v = {lo, hi}; return __builtin_bit_cast(unsigned, __builtin_convertvector(v, bf16x2_n)); }
__device__ __forceinline__ float bf2f(bf16_t b) { return __uint_as_float(((unsigned)b) << 16); }
__device__ __forceinline__ float bflo(unsigned w) { return __uint_as_float(w << 16); }
__device__ __forceinline__ float bfhi(unsigned w) { return __uint_as_float(w & 0xffff0000u); }
__device__ __forceinline__ float ldf(const float* p) { return *p; }
__device__ __forceinline__ float ldf(const bf16_t* p) { return bf2f(*p); }
__device__ __forceinline__ void stf(float* p, float v) { *p = v; }
__device__ __forceinline__ void stf(bf16_t* p, float v) { *p = (bf16_t)(cvt_pk_bf16(v, 0.f) & 0xffffu); }
__device__ __forceinline__ float sigmoidf_(float x) { return 1.f / (1.f + expf(-x)); }
__device__ __forceinline__ float siluf_(float x) { return x / (1.f + expf(-x)); }
__device__ __forceinline__ float fexp(float x) { return __builtin_amdgcn_exp2f(x * 1.4426950408889634f); }
__device__ __forceinline__ float flog(float x) { return __builtin_amdgcn_logf(x) * 0.6931471805599453f; }
__device__ __forceinline__ float frcp(float x) { return __builtin_amdgcn_rcpf(x); }
__device__ __forceinline__ float fsigmoid(float x) { return frcp(1.f + fexp(-x)); }
__device__ __forceinline__ float fsilu(float x) { return x * frcp(1.f + fexp(-x)); }
__device__ __forceinline__ float wave_sum(float v) {
#pragma unroll
    for (int o = 32; o > 0; o >>= 1) v += __shfl_xor(v, o, 64);
    return v;
}
__device__ __forceinline__ float* hrow(KP p, int tok) {
    return tok < NL ? p->out + (size_t)tok * DM : (float*)(p->ws + OFF_HCTX) + (size_t)(tok - NL) * DM;
}
__device__ __forceinline__ const float* modrow(KP p, int l, int tok) {
    const int r = tok < NL ? (tok >> 12) : 8;
    return (const float*)(p->ws + OFF_MOD) + ((size_t)l * 9 + r) * 6144;
}
__device__ __forceinline__ int scan_tok(int b, int i, int dir) {
    return i < CTXL ? NL + b * CTXL + (dir ? CTXL - 1 - i : i) : b * SEQ + (dir ? SEQ - 1 - (i - CTXL) : (i - CTXL));
}

#define XB_TMO      128
#define XB_XCNT(j)  (256  + 64 * (j))
#define XB_XSUB(j)  (1280 + 64 * (j))
#define XB_XGEN(j)  (2304 + 64 * (j))
#define XB_TOP      3328
#define XB_TOPGEN   3392
#define XCD_BAR_WORDS 3456
#define XB_SPIN_CAP (1u << 24)
__device__ __forceinline__ unsigned xb_ld(unsigned* p)              { return __hip_atomic_load(p, __ATOMIC_RELAXED, __HIP_MEMORY_SCOPE_AGENT); }
__device__ __forceinline__ unsigned xb_add(unsigned* p, unsigned v) { return __hip_atomic_fetch_add(p, v, __ATOMIC_RELAXED, __HIP_MEMORY_SCOPE_AGENT); }
__device__ __forceinline__ unsigned xb_xcc_id() { return (unsigned)__builtin_amdgcn_s_getreg((3 << 11) | 20) & 0xFu; }
#define XB_SPIN(cond, bar) do { unsigned _sp = 0; while (cond) { __builtin_amdgcn_s_sleep(1); \
    if ((++_sp & 255u) == 0u) { if (xb_ld(&(bar)[XB_TMO])) break; if (_sp > XB_SPIN_CAP) { atomicAdd(&(bar)[XB_TMO], 1u); break; } } } } while (0)
struct XcdBarrier { unsigned* bar; unsigned x; volatile LAS unsigned* st; };
__device__ __forceinline__ XcdBarrier xcd_barrier_post(unsigned* bar, volatile LAS unsigned* st) {
    XcdBarrier b; b.bar = bar; b.x = xb_xcc_id(); b.st = st;
    if (threadIdx.x == 0) (void)xb_add(&bar[XB_XCNT(b.x)], 1u);
    return b;
}
__device__ __forceinline__ void xcd_barrier_complete(unsigned* bar, unsigned x, unsigned& nloc, unsigned& nx) {
    const unsigned G = gridDim.x * gridDim.y * gridDim.z;
    unsigned sum, cnt, mine, sp = 0u;
    for (;;) {
        sum = 0u; cnt = 0u; mine = 0u;
#pragma unroll
        for (unsigned j = 0; j < 16; ++j) { const unsigned c = xb_ld(&bar[XB_XCNT(j)]); sum += c; cnt += (c > 0u) ? 1u : 0u; mine = (j == x) ? c : mine; }
        if (sum == G) break;
        __builtin_amdgcn_s_sleep(1);
        if ((++sp & 255u) == 0u) { if (xb_ld(&bar[XB_TMO])) break; if (sp > XB_SPIN_CAP) { atomicAdd(&bar[XB_TMO], 1u); break; } }
    }
    nloc = mine > 0u ? mine : 1u; nx = cnt > 0u ? cnt : 1u;
}
__device__ __forceinline__ void xcd_barrier(const XcdBarrier& b) {
    asm volatile("s_waitcnt vmcnt(0)" ::: "memory");
    __syncthreads();
    if (threadIdx.x == 0) {
        unsigned* bar = b.bar;
        __builtin_amdgcn_s_waitcnt(0);
        unsigned nloc = b.st[0], nx = b.st[1];
        if (nloc == 0u) { xcd_barrier_complete(bar, b.x, nloc, nx); b.st[0] = nloc; b.st[1] = nx; }
        const unsigned old = xb_add(&bar[XB_XSUB(b.x)], 1u);
        const unsigned gen = old / nloc;
        if (old + 1u == (gen + 1u) * nloc) {
            __builtin_amdgcn_fence(__ATOMIC_RELEASE, "agent");
            asm volatile("s_waitcnt vmcnt(0)" ::: "memory");
            const unsigned og = xb_add(&bar[XB_TOP], 1u);
            const unsigned tg = og / nx;
            if (og + 1u == (tg + 1u) * nx) xb_add(&bar[XB_TOPGEN], 1u);
            else XB_SPIN(xb_ld(&bar[XB_TOPGEN]) == tg, bar);
            __builtin_amdgcn_fence(__ATOMIC_ACQUIRE, "agent");
            xb_add(&bar[XB_XGEN(b.x)], 1u);
            asm volatile("s_waitcnt vmcnt(0)" ::: "memory");
        } else {
            XB_SPIN(xb_ld(&bar[XB_XGEN(b.x)]) == gen, bar);
            __builtin_amdgcn_fence(__ATOMIC_ACQUIRE, "agent");
            asm volatile("s_waitcnt vmcnt(0)" ::: "memory");
        }
    }
    __syncthreads();
}

__device__ __forceinline__ void ph_prologue(KP p, int bid, int nb, float* sm) {
    const int tid = opaque_tid();
    {
        const float4* x4 = (const float4*)p->in[I_X]; float4* o4 = (float4*)p->out;
        #pragma unroll 1
        for (size_t i = (size_t)bid * 512 + tid; i < (size_t)NL * 256; i += (size_t)nb * 512) o4[i] = x4[i];
        const float4* c4 = (const float4*)p->in[I_CTX]; float4* h4 = (float4*)(p->ws + OFF_HCTX);
        #pragma unroll 1
        for (size_t i = (size_t)bid * 512 + tid; i < (size_t)NC * 256; i += (size_t)nb * 512) h4[i] = c4[i];
    }
    if (bid == 0) {
        bf16_t* z = (bf16_t*)(p->ws + OFF_U) + (size_t)ZROW * DM;
        for (int i = tid; i < DM; i += 512) z[i] = 0;
    }
    if (bid == 1 % nb) {
        float* lb = (float*)(p->ws + OFF_LB);
        const float* hl = p->in[I_HLB];
        for (int j = tid; j < 512; j += 512) {
            const float a = hl[j], b = hl[512 + j], mx = fmaxf(a, b);
            const float ea = expf(a - mx), eb = expf(b - mx);
            lb[j] = 0.f; lb[512 + j] = eb / (ea + eb);
        }
    }
    if (bid == 2 % nb) {
        float2* rt = (float2*)(p->ws + OFF_ROPE);
        for (int i = tid; i < 64 * 32; i += 512) { const float ang = (float)(i >> 5) * powf(10000.f, -(float)(2 * (i & 31)) / 64.f); rt[i] = make_float2(cosf(ang), sinf(ang)); }
    }
    {
        float* act = sm;
        bool filled = false;
        #pragma unroll 1
        for (int item = bid; item < 48; item += nb) {
            if (!filled) {
                for (int i = tid; i < 9 * 1024; i += 512) {
                    const int r = i >> 10, k = i & 1023;
                    const float v = r < 8 ? p->in[I_C][r * 1024 + k] : p->in[I_CCTX][k];
                    act[i] = siluf_(v);
                }
                __syncthreads(); filled = true;
            }
            const int l = item / 12, j = (item % 12) * 512 + tid;
            const float* w = p->in[I_ADAW] + (size_t)l * 1024 * 6144 + j;
            float acc[9];
#pragma unroll
            for (int r = 0; r < 9; ++r) acc[r] = 0.f;
            for (int k = 0; k < 1024; ++k) {
                const float wv = w[(size_t)k * 6144];
#pragma unroll
                for (int r = 0; r < 9; ++r) acc[r] += act[r * 1024 + k] * wv;
            }
            const float bv = p->in[I_ADAB][l * 6144 + j];
            float* mod = (float*)(p->ws + OFF_MOD);
#pragma unroll
            for (int r = 0; r < 9; ++r) mod[((size_t)l * 9 + r) * 6144 + j] = acc[r] + bv;
        }
    }
}


template <class Src>
__device__ __forceinline__ void cvt_tile(float* sm, Src src, int srcld, int k0, bf16_t* dst, int dstld, int n0) {
    const int tid = opaque_tid();
    const float* sp = src(n0 + (tid & 127));
#pragma unroll
    for (int j = 0; j < 16; ++j) { const int k = (tid >> 7) + 4 * j; sm[k * 129 + (tid & 127)] = sp[(size_t)(k0 + k) * srcld]; }
    __syncthreads();
    const int n = tid >> 2, kc = (tid & 3) * 16;
    unsigned w[8];
#pragma unroll
    for (int q = 0; q < 8; ++q) w[q] = cvt_pk_bf16(sm[(kc + 2 * q) * 129 + n], sm[(kc + 2 * q + 1) * 129 + n]);
    uint4* d4 = (uint4*)(dst + (size_t)(n0 + n) * dstld + k0 + kc);
    d4[0] = make_uint4(w[0], w[1], w[2], w[3]); d4[1] = make_uint4(w[4], w[5], w[6], w[7]);
    __syncthreads();
}

__device__ __forceinline__ void ph_convert(KP p, int l, int bid, int nb, float* sm) {
    const bool even = (l & 1) == 0;
    const int NP = even ? EVEN_LD : ODD_LD;
    const int t_in = 16 * (NP / 128), t_out = 16 * 8, t_13 = 65 * 16 * 4, t_2 = 65 * 4 * 8;
    const int total = t_in + t_out + t_13 + t_2;
    #pragma unroll 1
    for (int t = bid; t < total; t += nb) {
        if (t < t_in) {
            const int kt = t & 15, nt = t >> 4;
            const float* W = even ? p->in[I_EWIN] + (size_t)(l >> 1) * 1024 * EVEN_N : p->in[I_OWIN] + (size_t)(l >> 1) * 1024 * ODD_N;
            cvt_tile(sm, [&](int n) { return W + ((even && n >= 1536) ? n + 16 : n); }, even ? EVEN_N : ODD_N, kt * 64, (bf16_t*)(p->ws + OFF_WIN), 1024, nt * 128);
        } else if (t < t_in + t_out) {
            const int u = t - t_in, kt = u & 15, nt = u >> 4;
            const float* W = (even ? p->in[I_EWOUT] : p->in[I_OWOUT]) + (size_t)(l >> 1) * 1024 * 1024;
            cvt_tile(sm, [&](int n) { return W + n; }, 1024, kt * 64, (bf16_t*)(p->ws + OFF_WOUT), 1024, nt * 128);
        } else if (t < t_in + t_out + t_13) {
            const int u = t - t_in - t_out, e = u >> 6, kt = u & 15, nt = (u >> 4) & 3;
            const float* w1 = e < 64 ? p->in[I_W1] + ((size_t)l * 64 + e) * 1024 * 256 : p->in[I_SW1] + (size_t)l * 1024 * 256;
            const float* w3 = e < 64 ? p->in[I_W3] + ((size_t)l * 64 + e) * 1024 * 256 : p->in[I_SW3] + (size_t)l * 1024 * 256;
            cvt_tile(sm, [&](int n) { const int g = n >> 5, w = n & 31; return w < 16 ? w1 + 16 * g + w : w3 + 16 * g + w - 16; }, 256, kt * 64,
                     (bf16_t*)(p->ws + OFF_W13) + (size_t)e * 512 * 1024, 1024, nt * 128);
        } else {
            const int u = t - t_in - t_out - t_13, e = u >> 5, kt = u & 3, nt = (u >> 2) & 7;
            const float* w2 = e < 64 ? p->in[I_W2] + ((size_t)l * 64 + e) * 256 * 1024 : p->in[I_SW2] + (size_t)l * 256 * 1024;
            cvt_tile(sm, [&](int n) { return w2 + n; }, 1024, kt * 64, (bf16_t*)(p->ws + OFF_W2) + (size_t)e * 1024 * 256, 256, nt * 128);
        }
    }
}

namespace gp {
typedef short bf16x8 __attribute__((ext_vector_type(8)));
typedef float f32x4 __attribute__((ext_vector_type(4)));
typedef unsigned u32x4 __attribute__((ext_vector_type(4)));
typedef unsigned u32x2 __attribute__((ext_vector_type(2)));
constexpr int BM = 256, BK = 64, HALF = 128, HTB = HALF * BK * 2, STAGE_BYTES = 8 * HTB, NXCD = 8, WGM = 8;
__device__ __forceinline__ int lds_byte(int r, int c) { const int st = (r >> 4) * 2 + (c >> 5), rr = r & 15, cc = c & 31, ob = rr * 64 + cc * 2; return st * 1024 + (ob ^ (((ob >> 9) & 1) << 5)); }
__device__ __forceinline__ void stage_rc(int b, int& R, int& C) { const int st = b / 1024, sb = b % 1024, swz = sb ^ (((sb >> 9) & 1) << 5); R = (st >> 1) * 16 + swz / 64; C = (st & 1) * 32 + (swz % 64) / 2; }
__device__ __forceinline__ int perm32(int rho) { const int n = rho >> 4, i = rho & 15; return 8 * (i >> 2) + 4 * n + (i & 3); }

struct Unit { const char* A; const char* B; int r0, c0, aux; };

struct DenseSched {
    const char* A; const char* B; int nM, nN, nwg, G, c; size_t tstep;
    __device__ __forceinline__ void init(const void* A_, const void* B_, int M, int N, int K, int G_, int c_) { A = (const char*)A_; B = (const char*)B_; nM = M / BM; nN = N / BM; nwg = nM * nN; G = G_; c = c_; tstep = (size_t)BM * K * 2; }
    __device__ __forceinline__ bool next(int i, Unit& u) const {
        const long L = (long)i * G + c; if (L >= nwg) return false;
        int wgid = (int)L; { const int q = nwg / NXCD, r = nwg % NXCD, xcd = wgid % NXCD, off = wgid / NXCD; wgid = (xcd < r ? xcd * (q + 1) : r * (q + 1) + (xcd - r) * q) + off; }
        const int nig = WGM * nN, gid = wgid / nig, fm = gid * WGM, gsz = (nM - fm) < WGM ? (nM - fm) : WGM;
        const int pm = fm + ((wgid % nig) % gsz), pn = (wgid % nig) / gsz;
        u.A = A + (size_t)pm * tstep; u.B = B + (size_t)pn * tstep; u.r0 = pm * BM; u.c0 = pn * BM; u.aux = 0; return true;
    }
    __device__ __forceinline__ void lane_off(const Unit&, int, int, int, int, unsigned (&)[2][2]) const {}
};

template <bool GATHER, bool PERM, class Sched, class Epi>
__device__ __forceinline__ void gemm_phase(LAS unsigned char* lds, const int K_, const Sched& S, const Epi& E) {
    int K = K_; asm volatile("" : "+s"(K));
    const int tid = opaque_tid(), wid = __builtin_amdgcn_readfirstlane(tid >> 6), lane = tid & 63, wr = wid >> 2, wc = wid & 3, fr = lane & 15, fq = lane >> 4;
    const int nt = K / BK;
    unsigned voffA[2], voffB[2]; int sR[2], sC[2];
#pragma unroll
    for (int i = 0; i < 2; ++i) { int R, C; stage_rc(tid * 16 + i * 8192, R, C); const int Rb = PERM ? ((R & ~31) + perm32(R & 31)) : R;
        voffA[i] = (unsigned)(R * K + C) * 2u; voffB[i] = (unsigned)(Rb * K + C) * 2u; sR[i] = R; sC[i] = C; }
    const size_t kstep = (size_t)(BK * 2);
    const size_t hstep = (size_t)HALF * K * 2;
    const unsigned ldsw = (unsigned)wid * 1024u;
    const int aoff = lds_byte(wr * 64 + fr, fq * 8), boff = lds_byte(wc * 32 + fr, fq * 8);
    unsigned cvo[2][2] = {{0u, 0u}, {0u, 0u}}, nvo[2][2] = {{0u, 0u}, {0u, 0u}};
#define GP_SA(b, h) (((b) * 2 + (h)) * HTB)
#define GP_SB(b, h) ((4 + (b) * 2 + (h)) * HTB)
#define GP_GLDS(gp_, lp_) __builtin_amdgcn_global_load_lds((const unsigned*)(gp_), (LAS unsigned*)(lp_), 16, 0, 0)
#define GP_STAGE_B(bufoff, gbase, h) do { const char* _g = (gbase) + (size_t)(h) * hstep; \
        GP_GLDS(_g + voffB[0], lds + (bufoff) + ldsw); GP_GLDS(_g + voffB[1], lds + (bufoff) + ldsw + 8192); } while (0)
#define GP_STAGE_A(bufoff, gbase, h, usenext) do { \
        if (GATHER) { const unsigned _o0 = (usenext) ? nvo[h][0] : cvo[h][0], _o1 = (usenext) ? nvo[h][1] : cvo[h][1]; \
            GP_GLDS((gbase) + _o0, lds + (bufoff) + ldsw); GP_GLDS((gbase) + _o1, lds + (bufoff) + ldsw + 8192); } \
        else { const char* _g = (gbase) + (size_t)(h) * hstep; GP_GLDS(_g + voffA[0], lds + (bufoff) + ldsw); GP_GLDS(_g + voffA[1], lds + (bufoff) + ldsw + 8192); } } while (0)
#define GP_LDA(dst, b, h) do { _Pragma("unroll") for (int m = 0; m < 4; ++m) _Pragma("unroll") for (int k = 0; k < 2; ++k) dst[m][k] = *(const LAS bf16x8*)(lds + GP_SA(b, h) + aoff + m * 2048 + k * 1024); } while (0)
#define GP_LDB(dst, b, h) do { _Pragma("unroll") for (int n = 0; n < 2; ++n) _Pragma("unroll") for (int k = 0; k < 2; ++k) dst[n][k] = *(const LAS bf16x8*)(lds + GP_SB(b, h) + boff + n * 2048 + k * 1024); } while (0)
#define GP_MMA(ai, bj, At, Bt) do { __builtin_amdgcn_s_setprio(1); _Pragma("unroll") for (int m = 0; m < 4; ++m) _Pragma("unroll") for (int n = 0; n < 2; ++n) _Pragma("unroll") for (int k = 0; k < 2; ++k) \
        acc[ai][bj][m][n] = __builtin_amdgcn_mfma_f32_16x16x32_bf16(Bt[n][k], At[m][k], acc[ai][bj][m][n], 0, 0, 0); __builtin_amdgcn_s_setprio(0); } while (0)
#define GP_WAIT_V(n) asm volatile("s_waitcnt vmcnt(" #n ")" ::: "memory")
#define GP_WAIT_L(n) asm volatile("s_waitcnt lgkmcnt(" #n ")" ::: "memory")
#define GP_BAR __builtin_amdgcn_s_barrier()
#define GP_SCHED __builtin_amdgcn_sched_barrier(0)
    Unit cur, nxt; int ui = 0;
    if (!S.next(0, cur)) return;
    f32x4 acc[2][2][4][2];
#pragma unroll
    for (int a = 0; a < 2; ++a)
#pragma unroll
        for (int b = 0; b < 2; ++b)
#pragma unroll
            for (int m = 0; m < 4; ++m)
#pragma unroll
                for (int n = 0; n < 2; ++n) acc[a][b][m][n] = (f32x4){0.f, 0.f, 0.f, 0.f};
    bf16x8 At[4][2], B0[2][2], B1[2][2];
    if (GATHER) S.lane_off(cur, sR[0], sR[1], sC[0], sC[1], cvo);
    const char* cA = cur.A; const char* cB = cur.B;
    GP_STAGE_B(GP_SB(0, 0), cB, 0); GP_STAGE_A(GP_SA(0, 0), cA, 0, false); GP_STAGE_B(GP_SB(0, 1), cB, 1); GP_STAGE_A(GP_SA(0, 1), cA, 1, false);
    if (wr == 1) GP_BAR;
    GP_WAIT_V(4); GP_BAR;
    GP_STAGE_B(GP_SB(1, 0), cB + kstep, 0); GP_STAGE_A(GP_SA(1, 0), cA + kstep, 0, false); GP_STAGE_B(GP_SB(1, 1), cB + kstep, 1);
    GP_WAIT_V(6); GP_BAR;
    for (;;) {
        const bool has_next = S.next(ui + 1, nxt);
        if (GATHER && has_next) S.lane_off(nxt, sR[0], sR[1], sC[0], sC[1], nvo);
        const char* nA = has_next ? nxt.A : cA; const char* nB = has_next ? nxt.B : cB;
        for (int t = 0; t < nt; t += 2) {
            const bool last = (t == nt - 2);
            const bool un = last && has_next;
            const char* a1 = cA + (size_t)(t + 1) * kstep;
            const char* a2 = last ? nA : cA + (size_t)(t + 2) * kstep; const char* b2 = last ? nB : cB + (size_t)(t + 2) * kstep;
            const char* a3 = a2 + kstep; const char* b3 = b2 + kstep;
            GP_LDB(B0, 0, 0); GP_SCHED; GP_LDA(At, 0, 0); GP_STAGE_A(GP_SA(1, 1), a1, 1, false);
            GP_WAIT_L(8); GP_BAR; GP_WAIT_L(0); GP_MMA(0, 0, At, B0); GP_BAR; GP_SCHED;
            GP_LDB(B1, 0, 1); GP_STAGE_B(GP_SB(0, 0), b2, 0);
            GP_BAR; GP_WAIT_L(0); GP_MMA(0, 1, At, B1); GP_BAR;
            GP_LDA(At, 0, 1); GP_STAGE_A(GP_SA(0, 0), a2, 0, un);
            GP_BAR; GP_WAIT_L(0); GP_MMA(1, 0, At, B0); GP_BAR; GP_SCHED;
            GP_STAGE_B(GP_SB(0, 1), b2, 1);
            GP_WAIT_V(6); GP_BAR; GP_MMA(1, 1, At, B1); GP_BAR;
            GP_LDB(B0, 1, 0); GP_SCHED; GP_LDA(At, 1, 0); GP_STAGE_A(GP_SA(0, 1), a2, 1, un);
            GP_WAIT_L(8); GP_BAR; GP_WAIT_L(0); GP_MMA(0, 0, At, B0); GP_BAR; GP_SCHED;
            GP_LDB(B1, 1, 1); GP_STAGE_B(GP_SB(1, 0), b3, 0);
            GP_BAR; GP_WAIT_L(0); GP_MMA(0, 1, At, B1); GP_BAR;
            GP_LDA(At, 1, 1); GP_STAGE_A(GP_SA(1, 0), a3, 0, un);
            GP_BAR; GP_WAIT_L(0); GP_MMA(1, 0, At, B0); GP_BAR; GP_SCHED;
            GP_STAGE_B(GP_SB(1, 1), b3, 1);
            GP_WAIT_V(6); GP_BAR; GP_MMA(1, 1, At, B1); GP_BAR;
        }
        E(acc, cur, wr, wc, fr, fq);
        if (!has_next) break;
#pragma unroll
        for (int a = 0; a < 2; ++a)
#pragma unroll
            for (int b = 0; b < 2; ++b)
#pragma unroll
                for (int m = 0; m < 4; ++m)
#pragma unroll
                    for (int n = 0; n < 2; ++n) acc[a][b][m][n] = (f32x4){0.f, 0.f, 0.f, 0.f};
        cur = nxt; cA = nA; cB = nB; ++ui;
        if (GATHER) { cvo[0][0] = nvo[0][0]; cvo[0][1] = nvo[0][1]; cvo[1][0] = nvo[1][0]; cvo[1][1] = nvo[1][1]; }
    }
    GP_WAIT_V(0);
    if (wr == 0) GP_BAR;
    GP_BAR;
#undef GP_SA
#undef GP_SB
#undef GP_GLDS
#undef GP_STAGE_A
#undef GP_STAGE_B
#undef GP_LDA
#undef GP_LDB
#undef GP_MMA
#undef GP_WAIT_V
#undef GP_WAIT_L
#undef GP_BAR
#undef GP_SCHED
}

struct EpiF32 {
    float* C; int ldc;
    __device__ __forceinline__ void operator()(const f32x4 (&acc)[2][2][4][2], const Unit& u, int wr, int wc, int fr, int fq) const {
        const int row0 = u.r0 + wr * 64 + fr, col0 = u.c0 + wc * 32 + 4 * fq;
#pragma unroll
        for (int ai = 0; ai < 2; ++ai)
#pragma unroll
            for (int m = 0; m < 4; ++m) { float* rowp = C + (size_t)(row0 + ai * HALF + m * 16) * ldc + col0;
#pragma unroll
                for (int bj = 0; bj < 2; ++bj)
#pragma unroll
                    for (int n = 0; n < 2; ++n) *(f32x4*)(rowp + bj * HALF + n * 16) = acc[ai][bj][m][n];
                __builtin_amdgcn_sched_barrier(0); }
    }
};
struct EpiBf16 {
    bf16_t* O; int ldc;
    __device__ __forceinline__ void operator()(const f32x4 (&acc)[2][2][4][2], const Unit& u, int wr, int wc, int fr, int fq) const {
        const int row0 = u.r0 + wr * 64 + fr, col0 = u.c0 + wc * 32 + 8 * fq;
#pragma unroll
        for (int ai = 0; ai < 2; ++ai)
#pragma unroll
            for (int m = 0; m < 4; ++m) { bf16_t* rowp = O + (size_t)(row0 + ai * HALF + m * 16) * ldc + col0;
#pragma unroll
                for (int bj = 0; bj < 2; ++bj) { const f32x4 v0 = acc[ai][bj][m][0], v1 = acc[ai][bj][m][1];
                    u32x4 w; w.x = cvt_pk_bf16(v0[0], v0[1]); w.y = cvt_pk_bf16(v0[2], v0[3]); w.z = cvt_pk_bf16(v1[0], v1[1]); w.w = cvt_pk_bf16(v1[2], v1[3]);
                    *(u32x4*)(rowp + bj * HALF) = w; }
                __builtin_amdgcn_sched_barrier(0); }
    }
};
}

__device__ __forceinline__ void ph_modin(KP p, int l, int bid, int nb) {
    const int tid = opaque_tid(), lane = tid & 63, wv = tid >> 6;
    const bool even = (l & 1) == 0;
    bf16_t* U = (bf16_t*)(p->ws + OFF_U);
    float* G = (float*)(p->ws + OFF_G);
    const float* wg = p->in[I_EWIN] + (size_t)(l >> 1) * 1024 * EVEN_N + 1536;
    #pragma unroll 1
    for (int tok = bid * 8 + wv; tok < NT; tok += nb * 8) {
        const float* h = hrow(p, tok);
        const float* m = modrow(p, l, tok);
        float ga[16];
#pragma unroll
        for (int j = 0; j < 16; ++j) ga[j] = 0.f;
#pragma unroll
        for (int c = 0; c < 4; ++c) {
            const int d = 4 * (lane + 64 * c);
            const float4 hv = *(const float4*)(h + d), sh = *(const float4*)(m + d), sc = *(const float4*)(m + 1024 + d);
            const float u0 = hv.x * (1.f + sc.x) + sh.x, u1 = hv.y * (1.f + sc.y) + sh.y, u2 = hv.z * (1.f + sc.z) + sh.z, u3 = hv.w * (1.f + sc.w) + sh.w;
            *(uint2*)(U + (size_t)tok * DM + d) = make_uint2(cvt_pk_bf16(u0, u1), cvt_pk_bf16(u2, u3));
            if (even) {
                const float uu[4] = {u0, u1, u2, u3};
#pragma unroll
                for (int q = 0; q < 4; ++q) {
                    const float4* wr = (const float4*)(wg + (size_t)(d + q) * EVEN_N);
#pragma unroll
                    for (int j4 = 0; j4 < 4; ++j4) { const float4 w = wr[j4]; ga[4 * j4] += uu[q] * w.x; ga[4 * j4 + 1] += uu[q] * w.y; ga[4 * j4 + 2] += uu[q] * w.z; ga[4 * j4 + 3] += uu[q] * w.w; }
                }
            }
        }
        if (even) {
            float mine = 0.f;
#pragma unroll
            for (int j = 0; j < 16; ++j) { const float s = wave_sum(ga[j]); if (lane == j) mine = s; }
            if (lane < 16) G[(size_t)tok * 16 + lane] = mine;
        }
    }
}

__device__ __forceinline__ void ph_gemm_in(KP p, int l, int bid, int nb, LAS unsigned char* lds) {
    const int N = ((l & 1) == 0) ? EVEN_LD : ODD_LD;
    gp::DenseSched S; S.init(p->ws + OFF_U, p->ws + OFF_WIN, NT, N, 1024, nb, bid);
    gp::EpiBf16 E{(bf16_t*)(p->ws + OFF_BIG), N};
    gp::gemm_phase<false, true>(lds, 1024, S, E);
}
__device__ __forceinline__ void ph_gemm_out(KP p, int l, int bid, int nb, LAS unsigned char* lds) {
    gp::DenseSched S; S.init(p->ws + OFF_U, p->ws + OFF_WOUT, NT, 1024, 1024, nb, bid);
    gp::EpiF32 E{(float*)(p->ws + OFF_BIG), 1024};
    gp::gemm_phase<false, false>(lds, 1024, S, E);
}


namespace sc {
typedef short bf16x8 __attribute__((ext_vector_type(8)));
typedef short bf16x4 __attribute__((ext_vector_type(4)));
typedef float f32x4 __attribute__((ext_vector_type(4)));
#define SC_MFMA(a, b, c) __builtin_amdgcn_mfma_f32_16x16x32_bf16(a, b, c, 0, 0, 0)
__device__ __forceinline__ bf16x8 rd_row(unsigned img, int row, int stride, int k0) { return *(const LAS bf16x8*)(size_t)(img + (unsigned)(row * stride + k0 * 2)); }
__device__ __forceinline__ bf16x8 rd_tr(unsigned img, int k0, int n0, int stride, int lane) {
    const int g = lane >> 4, i = lane & 15;
    const unsigned a0 = img + (unsigned)((k0 + 8 * g + (i >> 2)) * stride + (n0 + 4 * (i & 3)) * 2), a1 = a0 + 4u * (unsigned)stride;
    bf16x4 lo, hi;
    asm volatile("ds_read_b64_tr_b16 %0, %2\n\tds_read_b64_tr_b16 %1, %3\n\ts_waitcnt lgkmcnt(0)" : "=&v"(lo), "=&v"(hi) : "v"(a0), "v"(a1) : "memory");
    return (bf16x8){lo[0], lo[1], lo[2], lo[3], hi[0], hi[1], hi[2], hi[3]};
}
typedef unsigned u32x2_ __attribute__((ext_vector_type(2)));
typedef unsigned u32x4_ __attribute__((ext_vector_type(4)));
__device__ __forceinline__ void st8(unsigned addr, uint2 v) { *(LAS u32x2_*)(size_t)addr = (u32x2_){v.x, v.y}; }
__device__ __forceinline__ void st16(unsigned addr, uint4 v) { *(LAS u32x4_*)(size_t)addr = (u32x4_){v.x, v.y, v.z, v.w}; }
__device__ __forceinline__ float scan_add64(float v, int lane) {
#pragma unroll
    for (int o = 1; o < 64; o <<= 1) { const float t = __shfl_up(v, o, 64); if (lane >= o) v += t; }
    return v;
}
__device__ __forceinline__ float scan_max64(float v, int lane) {
#pragma unroll
    for (int o = 1; o < 64; o <<= 1) { const float t = __shfl_up(v, o, 64); if (lane >= o) v = fmaxf(v, t); }
    return v;
}

template <int MODE>
__device__ __forceinline__ void scan_item(KP p, int l, int b, int h, int dir, int vs) {
    constexpr int CS = (MODE == 1) ? 32 : 64, DK = (MODE == 0) ? 64 : 128, EXT = (MODE == 0) ? 1 : 0;
    constexpr int QS = (DK + 8) * 2, VS = (64 + 16 * EXT + 8) * 2, SS = (CS + 8) * 2, NVR = 64 + 16 * EXT;
    constexpr int NCH = (CTXL + SEQ) / CS;
    constexpr int LD = (MODE == 2) ? ODD_LD : EVEN_LD;
    constexpr unsigned O_QA = 0, O_KA = O_QA + CS * QS, O_QB = O_KA + CS * QS, O_KW = O_QB + (MODE == 1 ? CS * QS : 0), O_V = O_KW + CS * QS,
                       O_SSC = O_V + CS * VS, O_ST = O_SSC + CS * SS, O_DKV = O_ST + 2 * NVR * QS, O_END = O_DKV + 512;
    static_assert(O_END <= 131072, "scan LDS");
    const int tid = opaque_tid(), lane = tid & 63, wv = __builtin_amdgcn_readfirstlane(tid >> 6), r16 = lane & 15, q4 = lane >> 4;
    const unsigned L0 = (unsigned)(size_t)smraw_base();
    const bf16_t* P = (const bf16_t*)(p->ws + OFF_BIG);
    bf16_t* HXo = (bf16_t*)(p->ws + OFF_AUX) + (size_t)dir * NT * 1024;
    const int e2 = l >> 1;
    const int cQ = (MODE == 0) ? E_MQ + h * 64 : (MODE == 1) ? E_HQ + h * 128 : 1536 + h * 128;
    const int cK = (MODE == 0) ? E_MK + h * 64 : (MODE == 1) ? (dir ? E_HFB : E_HFF) + h * 128 : 2048 + h * 128;
    const int cV = (MODE == 0) ? E_MV + h * 128 + vs * 64 : (MODE == 1) ? E_HI + h * 128 + vs * 64 : 2560 + h * 128 + vs * 64;
    const int cO = (MODE == 0) ? h * 128 + vs * 64 : 512 + h * 128 + vs * 64;
    const int lt = (MODE == 1) ? (tid & 31) : (tid >> 3);
    const int lj = (MODE == 0) ? (tid & 7) : (MODE == 1) ? (tid >> 5) : ((tid >> 2) & 1) * 8 + (tid & 3);
    const int vt_ = tid >> 3, vj = tid & 7;
    float lbv[8]; float gbi = 0.f, gbf = 0.f, lg = 0.f;
    if (MODE == 1) {
        const float* lbp = (const float*)(p->ws + OFF_LB) + e2 * 512 + h * 128 + lj * 8;
#pragma unroll
        for (int i = 0; i < 8; ++i) lbv[i] = lbp[i];
    } else {
#pragma unroll
        for (int i = 0; i < 8; ++i) lbv[i] = 0.f;
    }
    if (MODE == 0) { const float* gb = p->in[I_MGB] + e2 * 16; gbi = gb[(dir ? 2 : 0) * 4 + h]; gbf = gb[(dir ? 3 : 1) * 4 + h]; }
    if (MODE == 2) lg = p->in[I_RLD][e2 * 8 + dir * 4 + h];
    const float* G = (const float*)(p->ws + OFF_G);
    const float* ropet = (const float*)(p->ws + OFF_ROPE);
    unsigned oz = 0u; asm volatile("" : "+v"(oz));
    for (unsigned o = tid * 16; o < 2u * NVR * QS; o += 512 * 16) st16(L0 + O_ST + o, make_uint4(oz, oz, oz, oz));
    if (EXT) { if (tid < CS) { st16(L0 + O_V + tid * VS + 128, make_uint4(0x3f80u | oz, oz, oz, oz)); st16(L0 + O_V + tid * VS + 144, make_uint4(oz, oz, oz, oz)); } }
    f32x4 sacc[4];
#pragma unroll
    for (int i = 0; i < 4; ++i) sacc[i] = (f32x4){0.f, 0.f, 0.f, 0.f};
    float m_in = -1e30f;
    uint4 rq0, rq1, rk0, rk1, rv; float rg0 = 0.f, rg1 = 0.f;
    rq1 = make_uint4(0u, 0u, 0u, 0u); rk1 = rq1;
    auto load_chunk = [&](int c) {
        const int i0 = c * CS;
        const int tq = scan_tok(b, i0 + lt, dir);
        const bf16_t* pr = P + (size_t)tq * LD;
        rq0 = *(const uint4*)(pr + cQ + lj * 8); rk0 = *(const uint4*)(pr + cK + lj * 8);
        if (MODE == 2) { rq1 = *(const uint4*)(pr + cQ + lj * 8 + 32); rk1 = *(const uint4*)(pr + cK + lj * 8 + 32); }
        if (MODE != 1 || tid < 256) { const int tv = scan_tok(b, i0 + vt_, dir); rv = *(const uint4*)(P + (size_t)tv * LD + cV + vj * 8); }
        if (MODE == 0) { const int tg = scan_tok(b, i0 + lane, dir); rg0 = G[(size_t)tg * 16 + (dir ? 8 : 0) + h]; rg1 = G[(size_t)tg * 16 + (dir ? 12 : 4) + h]; }
    };
    load_chunk(0);
#pragma unroll 1
    for (int c = 0; c < NCH; ++c) {
        const unsigned ST_R = L0 + O_ST + (unsigned)(c & 1) * NVR * QS, ST_W = L0 + O_ST + (unsigned)((c + 1) & 1) * NVR * QS;
        float sp = 1.f;
        float v_u = 0.f, v_M = 0.f, v_e = 1.f, v_low = 0.f, v_w = 1.f;
        if (MODE == 0) {
            const float ig = rg0 + gbi, fg = rg1 + gbf;
            const float lf = fminf(fg, 0.f) - flog(1.f + fexp(-fabsf(fg)));
            const float bb = scan_add64(lf, lane);
            const float g = __shfl(bb, 63, 64);
            v_u = ig - bb;
            const float cu = scan_max64(v_u, lane);
            v_M = fmaxf(m_in, cu);
            const float m_new = fmaxf(g + m_in, g + __shfl(cu, 63, 64));
            sp = fexp(g + m_in - m_new);
            v_w = fexp(g + v_u - m_new);
            v_e = fexp(m_in - v_M);
            v_low = fexp(-(bb + v_M));
            m_in = m_new;
            st16(L0 + O_QA + lt * QS + lj * 16, rq0);
            st16(L0 + O_KA + lt * QS + lj * 16, rk0);
            const float wr = __shfl(v_w, lt, 64);
            uint4 kw; kw.x = cvt_pk_bf16(bflo(rk0.x) * wr, bfhi(rk0.x) * wr); kw.y = cvt_pk_bf16(bflo(rk0.y) * wr, bfhi(rk0.y) * wr);
            kw.z = cvt_pk_bf16(bflo(rk0.z) * wr, bfhi(rk0.z) * wr); kw.w = cvt_pk_bf16(bflo(rk0.w) * wr, bfhi(rk0.w) * wr);
            st16(L0 + O_KW + lt * QS + lj * 16, kw);
            st16(L0 + O_V + vt_ * VS + vj * 16, rv);
        } else if (MODE == 2) {
            sp = fexp(64.f * lg);
            const bool lat = c >= CTXL / CS;
            float q[16], k[16];
            const unsigned qa[8] = {rq0.x, rq0.y, rq0.z, rq0.w, rq1.x, rq1.y, rq1.z, rq1.w}, ka[8] = {rk0.x, rk0.y, rk0.z, rk0.w, rk1.x, rk1.y, rk1.z, rk1.w};
#pragma unroll
            for (int i = 0; i < 8; ++i) { q[2 * i] = bflo(qa[i]); q[2 * i + 1] = bfhi(qa[i]); k[2 * i] = bflo(ka[i]); k[2 * i + 1] = bfhi(ka[i]); }
            if (lat) {
                const int tq = scan_tok(b, c * CS + lt, dir), tt = tq & (SEQ - 1);
                const int pos = ((tid >> 2) & 1) ? (tt & 63) : (tt >> 6);
                const float2* rt = (const float2*)ropet + pos * 32 + (tid & 3) * 8;
#pragma unroll
                for (int i = 0; i < 8; ++i) {
                    const float2 cs2 = rt[i];
                    const float q1 = q[i], q2 = q[8 + i], k1 = k[i], k2 = k[8 + i];
                    q[i] = q1 * cs2.x - q2 * cs2.y; q[8 + i] = q1 * cs2.y + q2 * cs2.x;
                    k[i] = k1 * cs2.x - k2 * cs2.y; k[8 + i] = k1 * cs2.y + k2 * cs2.x;
                }
            }
            const float wr = 0.08838834764831845f * fexp((float)(63 - lt) * lg);
            uint4 o0, o1, w0, w1, x0, x1;
            o0.x = cvt_pk_bf16(q[0], q[1]); o0.y = cvt_pk_bf16(q[2], q[3]); o0.z = cvt_pk_bf16(q[4], q[5]); o0.w = cvt_pk_bf16(q[6], q[7]);
            o1.x = cvt_pk_bf16(q[8], q[9]); o1.y = cvt_pk_bf16(q[10], q[11]); o1.z = cvt_pk_bf16(q[12], q[13]); o1.w = cvt_pk_bf16(q[14], q[15]);
            w0.x = cvt_pk_bf16(k[0], k[1]); w0.y = cvt_pk_bf16(k[2], k[3]); w0.z = cvt_pk_bf16(k[4], k[5]); w0.w = cvt_pk_bf16(k[6], k[7]);
            w1.x = cvt_pk_bf16(k[8], k[9]); w1.y = cvt_pk_bf16(k[10], k[11]); w1.z = cvt_pk_bf16(k[12], k[13]); w1.w = cvt_pk_bf16(k[14], k[15]);
            x0.x = cvt_pk_bf16(k[0] * wr, k[1] * wr); x0.y = cvt_pk_bf16(k[2] * wr, k[3] * wr); x0.z = cvt_pk_bf16(k[4] * wr, k[5] * wr); x0.w = cvt_pk_bf16(k[6] * wr, k[7] * wr);
            x1.x = cvt_pk_bf16(k[8] * wr, k[9] * wr); x1.y = cvt_pk_bf16(k[10] * wr, k[11] * wr); x1.z = cvt_pk_bf16(k[12] * wr, k[13] * wr); x1.w = cvt_pk_bf16(k[14] * wr, k[15] * wr);
            st16(L0 + O_QA + lt * QS + lj * 16, o0); st16(L0 + O_QA + lt * QS + lj * 16 + 64, o1);
            st16(L0 + O_KA + lt * QS + lj * 16, w0); st16(L0 + O_KA + lt * QS + lj * 16 + 64, w1);
            st16(L0 + O_KW + lt * QS + lj * 16, x0); st16(L0 + O_KW + lt * QS + lj * 16 + 64, x1);
            st16(L0 + O_V + vt_ * VS + vj * 16, rv);
        } else {
            const unsigned qa[4] = {rq0.x, rq0.y, rq0.z, rq0.w}, fa[4] = {rk0.x, rk0.y, rk0.z, rk0.w};
            float qv[8], kk[8], A[8];
#pragma unroll
            for (int i = 0; i < 8; ++i) {
                const float qr = (i & 1) ? bfhi(qa[i >> 1]) : bflo(qa[i >> 1]), fr = (i & 1) ? bfhi(fa[i >> 1]) : bflo(fa[i >> 1]);
                const float f = lbv[i] + (1.f - lbv[i]) * fsigmoid(fr);
                qv[i] = fsilu(qr); kk[i] = 1.f - f; A[i] = flog(f);
            }
#pragma unroll
            for (int o = 1; o < 32; o <<= 1)
#pragma unroll
                for (int i = 0; i < 8; ++i) { const float t = __shfl_up(A[i], o, 32); if (lt >= o) A[i] += t; }
            float qa_[8], qb_[8], ka_[8], kw_[8];
#pragma unroll
            for (int i = 0; i < 8; ++i) {
                const float am = __shfl(A[i], 15, 32), ae = __shfl(A[i], 31, 32);
                qa_[i] = qv[i] * fexp(A[i] - am); qb_[i] = qv[i] * fexp(A[i]); ka_[i] = kk[i] * fexp(am - A[i]); kw_[i] = kk[i] * fexp(ae - A[i]);
                if (lt == 31) *(LAS float*)(size_t)(L0 + O_DKV + (lj * 8 + i) * 4) = fexp(ae);
            }
            uint4 w;
            w.x = cvt_pk_bf16(qa_[0], qa_[1]); w.y = cvt_pk_bf16(qa_[2], qa_[3]); w.z = cvt_pk_bf16(qa_[4], qa_[5]); w.w = cvt_pk_bf16(qa_[6], qa_[7]); st16(L0 + O_QA + lt * QS + lj * 16, w);
            w.x = cvt_pk_bf16(qb_[0], qb_[1]); w.y = cvt_pk_bf16(qb_[2], qb_[3]); w.z = cvt_pk_bf16(qb_[4], qb_[5]); w.w = cvt_pk_bf16(qb_[6], qb_[7]); st16(L0 + O_QB + lt * QS + lj * 16, w);
            w.x = cvt_pk_bf16(ka_[0], ka_[1]); w.y = cvt_pk_bf16(ka_[2], ka_[3]); w.z = cvt_pk_bf16(ka_[4], ka_[5]); w.w = cvt_pk_bf16(ka_[6], ka_[7]); st16(L0 + O_KA + lt * QS + lj * 16, w);
            w.x = cvt_pk_bf16(kw_[0], kw_[1]); w.y = cvt_pk_bf16(kw_[2], kw_[3]); w.z = cvt_pk_bf16(kw_[4], kw_[5]); w.w = cvt_pk_bf16(kw_[6], kw_[7]); st16(L0 + O_KW + lt * QS + lj * 16, w);
            if (tid < 256) st16(L0 + O_V + vt_ * VS + vj * 16, rv);
        }
        __syncthreads();
        if (c + 1 < NCH) load_chunk(c + 1);
        {
            constexpr int NT1 = CS / 16;
            const bool act = (MODE == 1) ? (wv < 4) : true;
            const int tb = (MODE == 1) ? (wv & 1) : (wv & 3);
#pragma unroll
            for (int u2 = 0; u2 < ((MODE == 1) ? 1 : 2); ++u2) {
                const int sb = (MODE == 1) ? (wv >> 1) : 2 * (wv >> 2) + u2;
                if (act) {
                    f32x4 d = (f32x4){0.f, 0.f, 0.f, 0.f};
                    if (sb <= tb) {
#pragma unroll
                        for (int kk2 = 0; kk2 < DK / 32; ++kk2)
                            d = SC_MFMA(rd_row(L0 + O_KA, sb * 16 + r16, QS, kk2 * 32 + q4 * 8), rd_row(L0 + O_QA, tb * 16 + r16, QS, kk2 * 32 + q4 * 8), d);
                        const int t = tb * 16 + r16, s0 = sb * 16 + q4 * 4;
                        if (MODE == 0) {
                            const float Mt = __shfl(v_M, t, 64);
#pragma unroll
                            for (int jj = 0; jj < 4; ++jj) { const float us = __shfl(v_u, s0 + jj, 64); d[jj] = (s0 + jj <= t) ? d[jj] * 0.125f * fexp(us - Mt) : 0.f; }
                        } else if (MODE == 2) {
#pragma unroll
                            for (int jj = 0; jj < 4; ++jj) d[jj] = (s0 + jj <= t) ? d[jj] * 0.08838834764831845f * fexp((float)(t - s0 - jj) * lg) : 0.f;
                        } else {
#pragma unroll
                            for (int jj = 0; jj < 4; ++jj) d[jj] = (s0 + jj <= t) ? d[jj] : 0.f;
                        }
                    }
                    st8(L0 + O_SSC + (tb * 16 + r16) * SS + (sb * 16 + q4 * 4) * 2, make_uint2(cvt_pk_bf16(d[0], d[1]), cvt_pk_bf16(d[2], d[3])));
                }
            }
            (void)NT1;
        }
        __syncthreads();
        {
            const int tb = (MODE == 1) ? (wv & 1) : (wv & 3);
            const int t = tb * 16 + r16;
            const int tok = scan_tok(b, c * CS + t, dir);
            constexpr int NV = (MODE == 1) ? 1 : 2;
            f32x4 oi[NV + EXT], oo[NV + EXT];
#pragma unroll
            for (int u2 = 0; u2 < NV + EXT; ++u2) {
                const int vt = (u2 == NV) ? 4 : ((MODE == 1) ? (wv >> 1) : 2 * (wv >> 2) + u2);
                f32x4 a1 = (f32x4){0.f, 0.f, 0.f, 0.f}, a2 = a1;
#pragma unroll
                for (int sb2 = 0; sb2 < CS / 32; ++sb2)
                    a1 = SC_MFMA(rd_tr(L0 + O_V, sb2 * 32, vt * 16, VS, lane), rd_row(L0 + O_SSC, t, SS, sb2 * 32 + q4 * 8), a1);
#pragma unroll
                for (int kk2 = 0; kk2 < DK / 32; ++kk2)
                    a2 = SC_MFMA(rd_row(ST_R, vt * 16 + r16, QS, kk2 * 32 + q4 * 8), rd_row(L0 + ((MODE == 1) ? O_QB : O_QA), t, QS, kk2 * 32 + q4 * 8), a2);
                oi[u2] = a1; oo[u2] = a2;
            }
            float den = 1.f, ei = 1.f;
            if (MODE == 0) {
                ei = 0.125f * __shfl(v_e, t, 64);
                const float dsum = oi[NV][0] + ei * oo[NV][0];
                const float dd = __shfl(dsum, r16, 64);
                den = 1.f / fmaxf(fabsf(dd), __shfl(v_low, t, 64));
            } else if (MODE == 2) {
                ei = fexp((float)(t + 1) * lg);
            }
#pragma unroll
            for (int u2 = 0; u2 < NV; ++u2) {
                const int vt = (MODE == 1) ? (wv >> 1) : 2 * (wv >> 2) + u2;
                float o[4];
#pragma unroll
                for (int jj = 0; jj < 4; ++jj) o[jj] = (oi[u2][jj] + ei * oo[u2][jj]) * den;
                *(uint2*)(HXo + (size_t)tok * 1024 + cO + vt * 16 + q4 * 4) = make_uint2(cvt_pk_bf16(o[0], o[1]), cvt_pk_bf16(o[2], o[3]));
            }
        }
        {
            constexpr int NS = (MODE == 0) ? 3 : 4;
            const int kt = (MODE == 0) ? (wv & 3) : wv;
            float dk[4] = {sp, sp, sp, sp};
            if (MODE == 1) { const f32x4 dv = *(const LAS f32x4*)(size_t)(L0 + O_DKV + (kt * 16 + q4 * 4) * 4); dk[0] = dv[0]; dk[1] = dv[1]; dk[2] = dv[2]; dk[3] = dv[3]; }
#pragma unroll
            for (int u2 = 0; u2 < NS; ++u2) {
                const int vt = (MODE == 0) ? ((u2 == 2) ? 4 : 2 * (wv >> 2) + u2) : u2;
                f32x4 a = sacc[u2];
#pragma unroll
                for (int jj = 0; jj < 4; ++jj) a[jj] *= dk[jj];
#pragma unroll
                for (int sb2 = 0; sb2 < CS / 32; ++sb2)
                    a = SC_MFMA(rd_tr(L0 + O_KW, sb2 * 32, kt * 16, QS, lane), rd_tr(L0 + O_V, sb2 * 32, vt * 16, VS, lane), a);
                sacc[u2] = a;
                st8(ST_W + (vt * 16 + r16) * QS + (kt * 16 + q4 * 4) * 2, make_uint2(cvt_pk_bf16(a[0], a[1]), cvt_pk_bf16(a[2], a[3])));
            }
        }
        __syncthreads();
    }
}
}

__device__ __forceinline__ void ph_scan_even2(KP p, int l, int bid, int nb) {
#pragma unroll 1
    for (int item = bid; item < 256; item += nb) {
        const int kind = item >> 7, b = (item >> 4) & 7, h = (item >> 2) & 3, dir = (item >> 1) & 1, vs = item & 1;
        if (kind == 0) sc::scan_item<0>(p, l, b, h, dir, vs); else sc::scan_item<1>(p, l, b, h, dir, vs);
        __syncthreads();
    }
}
__device__ __forceinline__ void ph_scan_odd2(KP p, int l, int bid, int nb) {
#pragma unroll 1
    for (int item = bid; item < 128; item += nb) {
        const int b = (item >> 4) & 7, h = (item >> 2) & 3, dir = (item >> 1) & 1, vs = item & 1;
        sc::scan_item<2>(p, l, b, h, dir, vs);
        __syncthreads();
    }
}

__device__ __forceinline__ void unpack16(const uint4 a, const uint4 b, float (&x)[16]) {
    x[0] = bflo(a.x); x[1] = bfhi(a.x); x[2] = bflo(a.y); x[3] = bfhi(a.y); x[4] = bflo(a.z); x[5] = bfhi(a.z); x[6] = bflo(a.w); x[7] = bfhi(a.w);
    x[8] = bflo(b.x); x[9] = bfhi(b.x); x[10] = bflo(b.y); x[11] = bfhi(b.y); x[12] = bflo(b.z); x[13] = bfhi(b.z); x[14] = bflo(b.w); x[15] = bfhi(b.w);
}
__device__ __forceinline__ float sum8(float v) { v += __shfl_xor(v, 1, 64); v += __shfl_xor(v, 2, 64); v += __shfl_xor(v, 4, 64); return v; }
template <bool MEANSUB, bool SIG>
__device__ __forceinline__ void head_norm_gate16(const bf16_t* h0, const bf16_t* h1, const bf16_t* gp, const float* nw, bf16_t* out) {
    float a[16], b[16], g[16];
    unpack16(*(const uint4*)h0, *(const uint4*)(h0 + 8), a); unpack16(*(const uint4*)h1, *(const uint4*)(h1 + 8), b); unpack16(*(const uint4*)gp, *(const uint4*)(gp + 8), g);
    float s = 0.f;
#pragma unroll
    for (int i = 0; i < 16; ++i) { a[i] += b[i]; s += a[i]; }
    if (MEANSUB) { const float mean = sum8(s) * (1.f / 128.f);
#pragma unroll
        for (int i = 0; i < 16; ++i) a[i] -= mean; }
    float q = 0.f;
#pragma unroll
    for (int i = 0; i < 16; ++i) q += a[i] * a[i];
    const float r = rsqrtf(sum8(q) * (1.f / 128.f) + LN_EPS);
    unsigned w[8];
#pragma unroll
    for (int i = 0; i < 16; i += 2) {
        const float y0 = a[i] * r * nw[i] * (SIG ? sigmoidf_(g[i]) : siluf_(g[i])), y1 = a[i + 1] * r * nw[i + 1] * (SIG ? sigmoidf_(g[i + 1]) : siluf_(g[i + 1]));
        w[i >> 1] = cvt_pk_bf16(y0, y1);
    }
    *(uint4*)out = make_uint4(w[0], w[1], w[2], w[3]); *(uint4*)(out + 8) = make_uint4(w[4], w[5], w[6], w[7]);
}
__device__ __forceinline__ void ph_normgate_even(KP p, int l, int bid, int nb) {
    const int tid = opaque_tid(), lane = tid & 63, wv = tid >> 6;
    const bf16_t* P = (const bf16_t*)(p->ws + OFF_BIG);
    const bf16_t* HX = (const bf16_t*)(p->ws + OFF_AUX);
    const bf16_t* HX1 = HX + (size_t)NT * 1024;
    bf16_t* MIX = (bf16_t*)(p->ws + OFF_U);
    const int e = l >> 1;
    const bool ml = lane < 32;
    const float* nw = ml ? p->in[I_MNW] + e * 512 + 16 * lane : p->in[I_HNW] + e * 512 + 16 * (lane - 32);
    const int gcol = ml ? E_MO + 16 * lane : E_HG + 16 * (lane - 32);
#pragma unroll 1
    for (int tok = bid * 8 + wv; tok < NT; tok += nb * 8) {
        const size_t o = (size_t)tok * 1024 + 16 * lane;
        if (ml) head_norm_gate16<true, true>(HX + o, HX1 + o, P + (size_t)tok * EVEN_LD + gcol, nw, MIX + o);
        else head_norm_gate16<false, false>(HX + o, HX1 + o, P + (size_t)tok * EVEN_LD + gcol, nw, MIX + o);
    }
}

#define OFF_UT   (OFF_AUX + 136 * MiB)
#define OFF_FK   (OFF_UT + 102 * MiB)
#define OFF_FKC  (OFF_FK + 32 * MiB)
#define OFF_ZOT  (OFF_FKC + 2 * MiB)

__device__ __forceinline__ void ph_hy_filt2(KP p, int l, int bid, int nb, float* sm) {
    const int tid = opaque_tid(), o = l >> 1;
    float* zf = sm;
    float* h1 = sm + 1024;
    float* h2 = sm + 2048;
    float* h3 = sm + 3072;
    const float* fw1 = p->in[I_HW1] + o * 33 * 64; const float* fb1 = p->in[I_HB1] + o * 64;
    const float* fw2 = p->in[I_HW2] + o * 64 * 64; const float* fb2 = p->in[I_HB2] + o * 64;
    const float* fw3 = p->in[I_HW3] + o * 64 * 64; const float* fb3 = p->in[I_HB3] + o * 64;
    const float* freq = p->in[I_HFREQ] + o * 64;
    const float* wout = p->in[I_HWOUT] + (size_t)o * 64 * 2048;
    float* FK = (float*)(p->ws + OFF_FK); float* FKC = (float*)(p->ws + OFF_FKC);
#pragma unroll 1
    for (int item = bid; item < (SEQ + CTXL) / 16; item += nb) {
        const bool isctx = item >= SEQ / 16;
        const int L = isctx ? CTXL : SEQ, pos0 = (isctx ? item - SEQ / 16 : item) * 16;
        __syncthreads();
        if (tid < 16 * 17) {
            const int pp = tid / 17, j = tid % 17, pos = pos0 + pp;
            if (j == 16) zf[pp * 36] = (float)pos / (float)(L - 1);
            else { const float f = 1e-4f + (float)j * ((15.0f - 1e-4f) / 15.0f); const float w = 2.0f * 3.14159265358979323846f * (float)pos / (float)L * f; zf[pp * 36 + 1 + j] = cosf(w); zf[pp * 36 + 17 + j] = sinf(w); }
        }
        __syncthreads();
        const int pp = tid >> 5, u0 = (tid & 31) * 2;
        { float a0 = fb1[u0], a1 = fb1[u0 + 1];
#pragma unroll 1
          for (int k = 0; k < 33; ++k) { const float z = zf[pp * 36 + k]; a0 += z * fw1[k * 64 + u0]; a1 += z * fw1[k * 64 + u0 + 1]; }
          h1[pp * 64 + u0] = sinf(freq[u0] * a0); h1[pp * 64 + u0 + 1] = sinf(freq[u0 + 1] * a1); }
        __syncthreads();
        { float a0 = fb2[u0], a1 = fb2[u0 + 1];
#pragma unroll 4
          for (int k = 0; k < 64; ++k) { const float z = h1[pp * 64 + k]; a0 += z * fw2[k * 64 + u0]; a1 += z * fw2[k * 64 + u0 + 1]; }
          h2[pp * 64 + u0] = sinf(freq[u0] * a0); h2[pp * 64 + u0 + 1] = sinf(freq[u0 + 1] * a1); }
        __syncthreads();
        { float a0 = fb3[u0], a1 = fb3[u0 + 1];
#pragma unroll 4
          for (int k = 0; k < 64; ++k) { const float z = h2[pp * 64 + k]; a0 += z * fw3[k * 64 + u0]; a1 += z * fw3[k * 64 + u0 + 1]; }
          h3[pp * 64 + u0] = sinf(freq[u0] * a0); h3[pp * 64 + u0 + 1] = sinf(freq[u0 + 1] * a1); }
        __syncthreads();
#pragma unroll 1
        for (int r = 0; r < 4; ++r) {
            const int col = tid + 512 * r, c = col & 511, od = col >> 9, order = od >> 1, dirn = od & 1;
            float a[16];
#pragma unroll
            for (int i = 0; i < 16; ++i) a[i] = 0.f;
#pragma unroll 2
            for (int k = 0; k < 64; ++k) { const float w = wout[k * 2048 + col];
#pragma unroll
                for (int i = 0; i < 16; ++i) a[i] += h3[i * 64 + k] * w; }
            const float delta = 3.0701134573253944f + (float)c * ((15.350567286626972f - 3.0701134573253944f) / 511.0f);
#pragma unroll
            for (int i = 0; i < 16; ++i) a[i] *= expf(-((float)(pos0 + i) / (float)(L - 1)) * delta);
            float* dst = isctx ? FKC + ((size_t)order * 512 + c) * 512 + 256 : FK + ((size_t)order * 512 + c) * 8192 + 4096;
            if (dirn == 0) {
#pragma unroll
                for (int i = 0; i < 16; i += 4) *(float4*)(dst + pos0 + i) = make_float4(a[i], a[i + 1], a[i + 2], a[i + 3]);
            } else {
#pragma unroll
                for (int i = 0; i < 16; ++i) if (pos0 + i > 0) dst[-(pos0 + i)] = a[i];
                if (pos0 == 0) dst[-L] = 0.f;
            }
        }
    }
}

__device__ __forceinline__ void ph_hy_prep(KP p, int l, int bid, int nb, float* sm) {
    const int tid = opaque_tid(), o = l >> 1;
    const bf16_t* P = (const bf16_t*)(p->ws + OFF_BIG);
    bf16_t* UT = (bf16_t*)(p->ws + OFF_UT);
    const float* cw = p->in[I_HCW] + o * 3 * 1536; const float* cb = p->in[I_HCB] + o * 1536;
    float* tile = sm;
#pragma unroll 1
    for (int item = bid; item < (NT / 256) * 96; item += nb) {
        const int tt = item / 96, ct = item % 96, tok0 = tt * 256, col0 = ct * 16;
        const bool lat = tok0 < NL;
        const int L = lat ? SEQ : CTXL, t0 = lat ? (tok0 & (SEQ - 1)) : ((tok0 - NL) & (CTXL - 1));
        __syncthreads();
        for (int i = tid; i < 258 * 2; i += 512) {
            const int rr = i >> 1, hf = i & 1, t = t0 + rr - 1;
            uint4 v = make_uint4(0u, 0u, 0u, 0u);
            if (t >= 0 && t < L) v = *(const uint4*)(P + (size_t)(tok0 + rr - 1) * ODD_LD + col0 + hf * 8);
            float* d = tile + rr * 17 + hf * 8;
            d[0] = bflo(v.x); d[1] = bfhi(v.x); d[2] = bflo(v.y); d[3] = bfhi(v.y); d[4] = bflo(v.z); d[5] = bfhi(v.z); d[6] = bflo(v.w); d[7] = bfhi(v.w);
        }
        __syncthreads();
        const int cc = tid >> 5, tc = (tid & 31) * 8, col = col0 + cc;
        const float w0 = cw[col], w1 = cw[1536 + col], w2 = cw[3072 + col], bb = cb[col];
        float y[8];
#pragma unroll
        for (int i = 0; i < 8; ++i) y[i] = tile[(tc + i) * 17 + cc] * w0 + tile[(tc + i + 1) * 17 + cc] * w1 + tile[(tc + i + 2) * 17 + cc] * w2 + bb;
        *(uint4*)(UT + (size_t)col * NT + tok0 + tc) = make_uint4(cvt_pk_bf16(y[0], y[1]), cvt_pk_bf16(y[2], y[3]), cvt_pk_bf16(y[4], y[5]), cvt_pk_bf16(y[6], y[7]));
    }
}

__device__ __forceinline__ void hy_item_lat(KP p, int l, int c) {
    constexpr int ZSB = (SEQ + 8) * 2;
    constexpr unsigned O_Z = 0, O_KF = O_Z + 8 * ZSB, O_END = O_KF + 8192 * 4;
    static_assert(O_END <= BAR_LDS_, "hyena LDS");
    const int tid = opaque_tid(), lane = tid & 63, wv = __builtin_amdgcn_readfirstlane(tid >> 6), r16 = lane & 15, q4 = lane >> 4, o = l >> 1;
    const unsigned L0 = (unsigned)(size_t)smraw_base();
    const bf16_t* UT = (const bf16_t*)(p->ws + OFF_UT);
    bf16_t* ZOT = (bf16_t*)(p->ws + OFF_ZOT);
    const float* FK = (const float*)(p->ws + OFF_FK);
    for (int i = tid; i < 8 * 512; i += 512) { const int b = i >> 9, ch = i & 511; sc::st16(L0 + O_Z + b * ZSB + ch * 16, *(const uint4*)(UT + (size_t)(1024 + c) * NT + b * SEQ + ch * 8)); }
#pragma unroll 1
    for (int order = 0; order < 2; ++order) {
        const float* fk = FK + ((size_t)order * 512 + c) * 8192;
        for (int i = tid; i < 2048; i += 512) { const float4 v = *(const float4*)(fk + i * 4); *(LAS sc::f32x4*)(size_t)(L0 + O_KF + i * 16) = (sc::f32x4){v.x, v.y, v.z, v.w}; }
        __syncthreads();
        sc::f32x4 acc[4][4];
#pragma unroll
        for (int a = 0; a < 4; ++a)
#pragma unroll
            for (int b2 = 0; b2 < 4; ++b2) acc[a][b2] = (sc::f32x4){0.f, 0.f, 0.f, 0.f};
        auto ldG = [&](int g) {
            const unsigned a0 = L0 + O_KF + (unsigned)(4096 + 16 * g + r16 - 8 * q4) * 4u;
            float v[8];
#pragma unroll
            for (int j = 0; j < 8; ++j) v[j] = *(const LAS float*)(size_t)(a0 - 4u * j);
            const unsigned w0 = cvt_pk_bf16(v[0], v[1]), w1 = cvt_pk_bf16(v[2], v[3]), w2 = cvt_pk_bf16(v[4], v[5]), w3 = cvt_pk_bf16(v[6], v[7]);
            return __builtin_bit_cast(sc::bf16x8, (sc::u32x4_){w0, w1, w2, w3});
        };
        sc::bf16x8 bq[4][2], W[6];
#pragma unroll
        for (int i = 0; i < 4; ++i) { bq[i][0] = (sc::bf16x8){0, 0, 0, 0, 0, 0, 0, 0}; bq[i][1] = bq[i][0]; }
        const int D0 = 8 * wv - 63, D1 = (8 * wv + 7 < 63) ? 8 * wv + 7 : 63;
        W[4] = ldG(4 * D0 - 6 + 4); W[5] = ldG(4 * D0 - 6 + 5);
#pragma unroll 1
        for (int D = D0; D <= D1; ++D) {
            W[0] = W[4]; W[1] = W[5];
#pragma unroll
            for (int i = 0; i < 4; ++i) W[2 + i] = ldG(4 * D + i);
            bq[3][0] = bq[2][0]; bq[3][1] = bq[2][1]; bq[2][0] = bq[1][0]; bq[2][1] = bq[1][1]; bq[1][0] = bq[0][0]; bq[1][1] = bq[0][1];
            {
                const int s1 = 8 * wv - D + ((r16 < 8) ? 0 : 4);
                const bool ok = (unsigned)s1 < 64u;
                const unsigned za = L0 + O_Z + (unsigned)((r16 & 7) * ZSB + ((ok ? s1 : 0) * 64 + q4 * 8) * 2);
                sc::bf16x8 b0 = *(const LAS sc::bf16x8*)(size_t)za, b1 = *(const LAS sc::bf16x8*)(size_t)(za + 64);
                if (!ok) { b0 = (sc::bf16x8){0, 0, 0, 0, 0, 0, 0, 0}; b1 = b0; }
                bq[0][0] = b0; bq[0][1] = b1;
            }
#pragma unroll
            for (int cg = 0; cg < 4; ++cg) {
                const int sA = 8 * wv + cg - D;
                if ((unsigned)sA < 64u || (unsigned)(sA + 4) < 64u) {
#pragma unroll
                    for (int it = 0; it < 4; ++it) { acc[cg][it] = SC_MFMA(W[it + 2], bq[cg][0], acc[cg][it]); acc[cg][it] = SC_MFMA(W[it], bq[cg][1], acc[cg][it]); }
                }
            }
        }
        __syncthreads();
        const float sk = p->in[I_HSKIP][o * 1024 + order * 512 + c];
        const bf16_t* gt = UT + (size_t)(order * 512 + c) * NT;
        const int bb = r16 & 7;
#pragma unroll
        for (int cg = 0; cg < 4; ++cg) {
            const int t1 = 8 * wv + cg + ((r16 < 8) ? 0 : 4);
#pragma unroll
            for (int it = 0; it < 4; ++it) {
                const int t = t1 * 64 + it * 16 + q4 * 4;
                const sc::u32x2_ zo_ = *(const LAS sc::u32x2_*)(size_t)(L0 + O_Z + bb * ZSB + t * 2); const uint2 zo = make_uint2(zo_[0], zo_[1]);
                const uint2 gv = *(const uint2*)(gt + bb * SEQ + t);
                const float y0 = bflo(gv.x) * (acc[cg][it][0] + sk * bflo(zo.x)), y1 = bfhi(gv.x) * (acc[cg][it][1] + sk * bfhi(zo.x));
                const float y2 = bflo(gv.y) * (acc[cg][it][2] + sk * bflo(zo.y)), y3 = bfhi(gv.y) * (acc[cg][it][3] + sk * bfhi(zo.y));
                const uint2 w = make_uint2(cvt_pk_bf16(y0, y1), cvt_pk_bf16(y2, y3));
                if (order == 0) sc::st8(L0 + O_Z + bb * ZSB + t * 2, w);
                else *(uint2*)(ZOT + (size_t)c * NT + bb * SEQ + t) = w;
            }
        }
        __syncthreads();
    }
}

__device__ __forceinline__ void hy_item_ctx(KP p, int l, int c, float* sm) {
    const int tid = opaque_tid(), o = l >> 1;
    const bf16_t* UT = (const bf16_t*)(p->ws + OFF_UT);
    bf16_t* ZOT = (bf16_t*)(p->ws + OFF_ZOT);
    const float* FKC = (const float*)(p->ws + OFF_FKC);
    float* Kc = sm;
    float* zb = sm + 1024;
    for (int i = tid; i < 1024; i += 512) Kc[i] = FKC[((size_t)(i >> 9) * 512 + c) * 512 + (i & 511)];
    for (int i = tid; i < 8 * CTXL; i += 512) zb[i] = bf2f(UT[(size_t)(1024 + c) * NT + NL + i]);
    __syncthreads();
    const int bb = tid >> 6, tl = tid & 63;
#pragma unroll 1
    for (int order = 0; order < 2; ++order) {
        float acc[4] = {0.f, 0.f, 0.f, 0.f};
#pragma unroll 4
        for (int s = 0; s < CTXL; ++s) {
            const float zv = zb[bb * CTXL + s];
#pragma unroll
            for (int i = 0; i < 4; ++i) acc[i] += Kc[order * 512 + tl + 64 * i - s + 256] * zv;
        }
        const float sk = p->in[I_HSKIP][o * 1024 + order * 512 + c];
        float zn[4];
#pragma unroll
        for (int i = 0; i < 4; ++i) { const int t = tl + 64 * i; zn[i] = bf2f(UT[(size_t)(order * 512 + c) * NT + NL + bb * CTXL + t]) * (acc[i] + zb[bb * CTXL + t] * sk); }
        __syncthreads();
#pragma unroll
        for (int i = 0; i < 4; ++i) { const int t = tl + 64 * i; if (order == 0) zb[bb * CTXL + t] = bf2f((bf16_t)(cvt_pk_bf16(zn[i], 0.f) & 0xffffu)); else stf(ZOT + (size_t)c * NT + NL + bb * CTXL + t, zn[i]); }
        __syncthreads();
    }
}

__device__ __forceinline__ void ph_mix_odd(KP p, int l, int bid, int nb, float* sm) {
    int* head = (int*)(p->ws + OFF_CNT) + 1024 + (l >> 1) * 64;
    LAS int* slot = (LAS int*)(smraw_base() + BAR_LDS_ + 64);
#pragma unroll 1
    for (;;) {
        if (threadIdx.x == 0) *slot = atomicAdd(head, 1);
        __syncthreads();
        const int item = *slot;
        __syncthreads();
        if (item >= 128 + 512) break;
        if (item < 128) { const int b = (item >> 4) & 7, h = (item >> 2) & 3, dir = (item >> 1) & 1, vs = item & 1; sc::scan_item<2>(p, l, b, h, dir, vs); }
        else { const int c = item - 128; hy_item_lat(p, l, c); __syncthreads(); hy_item_ctx(p, l, c, sm); }
        __syncthreads();
    }
}

__device__ __forceinline__ void ph_hy_norm(KP p, int l, int bid, int nb, float* sm) {
    const int tid = opaque_tid(), o = l >> 1;
    const bf16_t* ZOT = (const bf16_t*)(p->ws + OFF_ZOT);
    bf16_t* MIX = (bf16_t*)(p->ws + OFF_U);
    const float* nw = p->in[I_HNORM] + o * 512;
    float* tile = sm;
    float* part = sm + 64 * 65;
#pragma unroll 1
    for (int item = bid; item < (NT / 64) * 8; item += nb) {
        const int tt = item >> 3, g = item & 7, tok0 = tt * 64;
        __syncthreads();
        { const int cc = tid >> 3, ch = tid & 7;
          const uint4 v = *(const uint4*)(ZOT + (size_t)(g * 64 + cc) * NT + tok0 + ch * 8);
          float* d = tile + cc * 65 + ch * 8;
          d[0] = bflo(v.x); d[1] = bfhi(v.x); d[2] = bflo(v.y); d[3] = bfhi(v.y); d[4] = bflo(v.z); d[5] = bfhi(v.z); d[6] = bflo(v.w); d[7] = bfhi(v.w); }
        __syncthreads();
        { const int tk = tid & 63, pt = tid >> 6; float s = 0.f;
#pragma unroll
          for (int i = 0; i < 8; ++i) { const float x = tile[(pt * 8 + i) * 65 + tk]; s += x * x; }
          part[pt * 64 + tk] = s; }
        __syncthreads();
        { const int tk = tid >> 3, ch = tid & 7; float s = 0.f;
#pragma unroll
          for (int i = 0; i < 8; ++i) s += part[i * 64 + tk];
          const float rs = rsqrtf(s * (1.f / 64.f) + LN_EPS);
          float y[8];
#pragma unroll
          for (int i = 0; i < 8; ++i) y[i] = tile[(ch * 8 + i) * 65 + tk] * rs * nw[g * 64 + ch * 8 + i];
          *(uint4*)(MIX + (size_t)(tok0 + tk) * DM + g * 64 + ch * 8) = make_uint4(cvt_pk_bf16(y[0], y[1]), cvt_pk_bf16(y[2], y[3]), cvt_pk_bf16(y[4], y[5]), cvt_pk_bf16(y[6], y[7])); }
    }
}

__device__ __forceinline__ void ph_normgate_odd(KP p, int l, int bid, int nb) {
    const int tid = opaque_tid(), lane = tid & 63, wv = tid >> 6, o2 = l >> 1;
    const bf16_t* P = (const bf16_t*)(p->ws + OFF_BIG);
    const bf16_t* HX = (const bf16_t*)(p->ws + OFF_AUX);
    const bf16_t* HX1 = HX + (size_t)NT * 1024;
    bf16_t* MIX = (bf16_t*)(p->ws + OFF_U);
    const int c16 = 16 * (lane & 31);
    const float* nw = p->in[I_RNW] + o2 * 512 + c16;
#pragma unroll 1
    for (int t2 = bid * 8 + wv; t2 < NT / 2; t2 += nb * 8) {
        const int tok = t2 * 2 + (lane >> 5);
        const size_t o = (size_t)tok * 1024 + 512 + c16;
        head_norm_gate16<true, false>(HX + o, HX1 + o, P + (size_t)tok * ODD_LD + 3072 + c16, nw, MIX + o);
    }
}

__device__ __forceinline__ void ph_ln1_router(KP p, int l, int ntok, int bid, int nb, float* sm) {
    const int tid = opaque_tid(), lane = tid & 63, wv = __builtin_amdgcn_readfirstlane(tid >> 6);
    const float* Y = (const float*)(p->ws + OFF_BIG);
    bf16_t* U = (bf16_t*)(p->ws + OFF_U);
    const float* lw = p->in[I_LNW] + (l * 2) * 1024; const float* lb = p->in[I_LNB] + (l * 2) * 1024;
    const float* rw = p->in[I_RW] + (size_t)l * 1024 * 64;
    const float rb = p->in[I_RB][l * 64 + lane];
    LAS int* lcnt = (LAS int*)(smraw_base() + BAR_LDS_ + 256);
    if (tid < 64) lcnt[tid] = 0;
    __syncthreads();
    int* tidx = (int*)(p->ws + OFF_TIDX); float* tgate = (float*)(p->ws + OFF_TGATE); int* tpos = (int*)(p->ws + OFF_TPOS);
    LAS float* Vall = (LAS float*)smraw_base();
    {
        int* stok = (int*)(p->ws + OFF_STOK); float* sgate = (float*)(p->ws + OFF_SGATE); int* sdst = (int*)(p->ws + OFF_SDST);
#pragma unroll 1
        for (int i = bid * 512 + tid; i < MAXROWS; i += nb * 512) { stok[i] = ZROW; sgate[i] = 0.f; sdst[i] = -1; }
    }
#pragma unroll 1
    for (int base = bid * 32; base < ntok; base += nb * 32) {
#pragma unroll 2
        for (int j = 0; j < 4; ++j) {
            const int tok = base + wv * 4 + j;
            float* h = hrow(p, tok);
            const float* m = modrow(p, l, tok);
            const float* r = Y + (size_t)tok * DM;
            float x[16]; float s = 0.f;
#pragma unroll
            for (int c = 0; c < 4; ++c) {
                const int d = 4 * (lane + 64 * c);
                const float4 hv = *(const float4*)(h + d), gv = *(const float4*)(m + 2 * 1024 + d), rv = *(const float4*)(r + d);
                x[4 * c] = ALPHA * hv.x + gv.x * rv.x; x[4 * c + 1] = ALPHA * hv.y + gv.y * rv.y; x[4 * c + 2] = ALPHA * hv.z + gv.z * rv.z; x[4 * c + 3] = ALPHA * hv.w + gv.w * rv.w;
                s += x[4 * c] + x[4 * c + 1] + x[4 * c + 2] + x[4 * c + 3];
            }
            const float mean = wave_sum(s) * (1.f / 1024.f);
            float q = 0.f;
#pragma unroll
            for (int i = 0; i < 16; ++i) { x[i] -= mean; q += x[i] * x[i]; }
            const float rs = rsqrtf(wave_sum(q) * (1.f / 1024.f) + LN_EPS);
#pragma unroll
            for (int c = 0; c < 4; ++c) {
                const int d = 4 * (lane + 64 * c);
                const float4 w4 = *(const float4*)(lw + d), b4 = *(const float4*)(lb + d), sh = *(const float4*)(m + 3 * 1024 + d), sc = *(const float4*)(m + 4 * 1024 + d);
                float4 y; y.x = x[4 * c] * rs * w4.x + b4.x; y.y = x[4 * c + 1] * rs * w4.y + b4.y; y.z = x[4 * c + 2] * rs * w4.z + b4.z; y.w = x[4 * c + 3] * rs * w4.w + b4.w;
                *(float4*)(h + d) = y;
                float4 v; v.x = y.x * (1.f + sc.x) + sh.x; v.y = y.y * (1.f + sc.y) + sh.y; v.z = y.z * (1.f + sc.z) + sh.z; v.w = y.w * (1.f + sc.w) + sh.w;
                *(uint2*)(U + (size_t)tok * DM + d) = make_uint2(cvt_pk_bf16(v.x, v.y), cvt_pk_bf16(v.z, v.w));
                *(LAS sc::f32x4*)(Vall + (wv * 4 + j) * 1024 + d) = (sc::f32x4){v.x, v.y, v.z, v.w};
            }
        }
        __syncthreads();
        float a[32];
#pragma unroll
        for (int t = 0; t < 32; ++t) a[t] = 0.f;
#pragma unroll 1
        for (int d = wv * 128; d < wv * 128 + 128; d += 4) {
            const float w0 = rw[(d + 0) * 64 + lane], w1 = rw[(d + 1) * 64 + lane], w2 = rw[(d + 2) * 64 + lane], w3 = rw[(d + 3) * 64 + lane];
#pragma unroll
            for (int t = 0; t < 32; ++t) { const sc::f32x4 v = *(const LAS sc::f32x4*)(Vall + t * 1024 + d); a[t] += v[0] * w0 + v[1] * w1 + v[2] * w2 + v[3] * w3; }
        }
        __syncthreads();
#pragma unroll
        for (int t = 0; t < 32; ++t) Vall[(wv * 32 + t) * 64 + lane] = a[t];
        __syncthreads();
#pragma unroll 1
        for (int j = 0; j < 4; ++j) {
            const int tl = wv * 4 + j, tok = base + tl;
            float lg = 0.f;
#pragma unroll
            for (int w = 0; w < 8; ++w) lg += Vall[(w * 32 + tl) * 64 + lane];
            const float score = sigmoidf_(lg);
            const float key = score + rb;
            int rank = 0;
#pragma unroll
            for (int e = 0; e < 64; ++e) { const float ke = __builtin_bit_cast(float, __builtin_amdgcn_readlane(__builtin_bit_cast(int, key), e)); rank += (ke > key || (ke == key && e < lane)) ? 1 : 0; }
            const bool sel = rank < TOPK;
            const float gsum = wave_sum(sel ? score : 0.f);
            if (sel) {
                const int pos = __hip_atomic_fetch_add(lcnt + lane, 1, __ATOMIC_RELAXED, __HIP_MEMORY_SCOPE_WORKGROUP);
                tidx[tok * 8 + rank] = lane; tgate[tok * 8 + rank] = 2.5f * score / gsum; tpos[tok * 8 + rank] = pos;
            }
        }
        __syncthreads();
    }
    __syncthreads();
    if (tid < 64) ((int*)(p->ws + OFF_BCNT))[bid * 64 + tid] = lcnt[tid];
}

__device__ __forceinline__ void moe_offsets(KP p, int l, int ntok, LAS int* offs) {
    const int t = opaque_tid();
    if (t < 66) offs[t] = ((const int*)(p->ws + OFF_GOFFS))[t];
    __syncthreads();
}
__device__ __forceinline__ int moe_expert_of(const LAS int* offs, int row) { int e = 0;
#pragma unroll 1
    while (e < 64 && row >= offs[e + 1]) ++e;
    return e; }

__device__ __forceinline__ void ph_scatter(KP p, int l, int ntok, int bid, int nb, LAS unsigned char* lds) {
    LAS int* offs = (LAS int*)lds;
    LAS int* myb = offs + 128;
    LAS int* part = offs + 256;
    const int tid = opaque_tid();
    const int* bcnt = (const int*)(p->ws + OFF_BCNT);
    { const int e = tid & 63, pt = tid >> 6; int tot = 0, mine = 0;
#pragma unroll 4
      for (int b = pt; b < nb; b += 8) { const int c = bcnt[b * 64 + e]; tot += c; mine += (b < bid) ? c : 0; }
      part[pt * 64 + e] = tot; part[512 + pt * 64 + e] = mine; }
    __syncthreads();
    if (tid < 64) {
        int tot = 0, mine = 0;
#pragma unroll
        for (int i = 0; i < 8; ++i) { tot += part[i * 64 + tid]; mine += part[512 + i * 64 + tid]; }
        const int pc = (tot + 255) & ~255;
        int incl = pc;
#pragma unroll
        for (int o = 1; o < 64; o <<= 1) { const int t = __shfl_up(incl, o, 64); if (tid >= o) incl += t; }
        offs[tid] = incl - pc; myb[tid] = mine;
        if (tid == 63) { offs[64] = incl; offs[65] = incl + ntok; }
    }
    __syncthreads();
    if (bid == 0 && tid < 66) ((int*)(p->ws + OFF_GOFFS))[tid] = offs[tid];
    const int* tidx = (const int*)(p->ws + OFF_TIDX); const float* tgate = (const float*)(p->ws + OFF_TGATE); const int* tpos = (const int*)(p->ws + OFF_TPOS);
    int* stok = (int*)(p->ws + OFF_STOK); float* sgate = (float*)(p->ws + OFF_SGATE); int* sdst = (int*)(p->ws + OFF_SDST);
    int* tile_e = (int*)(p->ws + OFF_TILEE);
#pragma unroll 1
    for (int base = bid * 32; base < ntok; base += nb * 32) {
        if (tid < 32 * 9) {
            const int tok = base + tid / 9, sl = tid % 9;
            if (sl < 8) { const int i = tok * 8 + sl, e = tidx[i], row = offs[e] + myb[e] + tpos[i]; stok[row] = tok; sgate[row] = tgate[i]; sdst[row] = tok * 9 + sl; }
            else { const int row = offs[64] + tok; stok[row] = tok; sgate[row] = 1.f; sdst[row] = tok * 9 + 8; }
        }
    }
    const int nrt = offs[65] >> 8;
#pragma unroll 1
    for (int rt = bid * 512 + tid; rt < nrt; rt += nb * 512) tile_e[rt] = moe_expert_of(offs, rt * 256);
    __syncthreads();
}

#define MOE_TAB (gp::STAGE_BYTES + 256)
#define MOE_MAXT 8
struct Moe1Sched {
    const char* U; const char* W; const LAS int* tabE; const LAS int* tabS; int u0, u1, rt0;
    __device__ __forceinline__ bool next(int i, gp::Unit& u) const {
        const int uu = u0 + i; if (uu >= u1) return false;
        const int rt = uu >> 1, j = rt - rt0;
        u.A = U; u.B = W + (size_t)tabE[j] * (512 * 1024 * 2) + (size_t)(uu & 1) * (256 * 1024 * 2); u.r0 = rt * 256; u.c0 = (uu & 1) * 256; u.aux = j; return true;
    }
    __device__ __forceinline__ void lane_off(const gp::Unit& u, int R0, int R1, int C0, int C1, unsigned (&vo)[2][2]) const {
        const LAS int* t = tabS + u.aux * 256;
        vo[0][0] = (unsigned)t[R0] * 2048u + (unsigned)C0 * 2u; vo[0][1] = (unsigned)t[R1] * 2048u + (unsigned)C1 * 2u;
        vo[1][0] = (unsigned)t[128 + R0] * 2048u + (unsigned)C0 * 2u; vo[1][1] = (unsigned)t[128 + R1] * 2048u + (unsigned)C1 * 2u;
    }
};
struct EpiH {
    bf16_t* H;
    __device__ __forceinline__ void operator()(const gp::f32x4 (&acc)[2][2][4][2], const gp::Unit& u, int wr, int wc, int fr, int fq) const {
        const int row0 = u.r0 + wr * 64 + fr;
#pragma unroll
        for (int ai = 0; ai < 2; ++ai)
#pragma unroll
            for (int m = 0; m < 4; ++m) { bf16_t* rowp = H + (size_t)(row0 + ai * 128 + m * 16) * 256;
#pragma unroll
                for (int bj = 0; bj < 2; ++bj) {
                    const int j0 = ((u.c0 + bj * 128 + wc * 32) >> 5) * 16 + 4 * fq;
                    const gp::f32x4 a = acc[ai][bj][m][0], b = acc[ai][bj][m][1];
                    const float h0 = siluf_(a[0]) * b[0], h1 = siluf_(a[1]) * b[1], h2 = siluf_(a[2]) * b[2], h3 = siluf_(a[3]) * b[3];
                    *(uint2*)(rowp + j0) = make_uint2(cvt_pk_bf16(h0, h1), cvt_pk_bf16(h2, h3)); }
                __builtin_amdgcn_sched_barrier(0); }
    }
};
__device__ __forceinline__ void ph_moe1(KP p, int l, int ntok, int bid, int nb, LAS unsigned char* lds) {
    LAS int* offs = (LAS int*)(lds + MOE_TAB);
    LAS int* tabE = offs + 128;
    LAS int* tabS = offs + 256;
    moe_offsets(p, l, ntok, offs);
    const int tid = opaque_tid();
    const int nrt = offs[65] >> 8, total = nrt * 2;
    const int u0 = (int)(((long)bid * total) / nb), u1 = (int)(((long)(bid + 1) * total) / nb);
    const int rt0 = u0 >> 1, nper = (u1 > u0) ? (((u1 - 1) >> 1) - rt0 + 1) : 0;
    const int* stok = (const int*)(p->ws + OFF_STOK); const int* tile_e = (const int*)(p->ws + OFF_TILEE);
    for (int i = tid; i < nper * 256; i += 512) tabS[i] = stok[(size_t)(rt0 + (i >> 8)) * 256 + (i & 255)];
    if (tid < nper) tabE[tid] = tile_e[rt0 + tid];
    __syncthreads();
    Moe1Sched S{(const char*)(p->ws + OFF_U), (const char*)(p->ws + OFF_W13), tabE, tabS, u0, u1, rt0};
    EpiH E{(bf16_t*)(p->ws + OFF_BIG)};
    gp::gemm_phase<true, false>(lds, 1024, S, E);
}

struct Moe2Sched {
    const char* H; const char* W; const LAS int* tabE; int u0, u1, rt0;
    __device__ __forceinline__ bool next(int i, gp::Unit& u) const {
        const int uu = u0 + i; if (uu >= u1) return false;
        const int rt = uu >> 2, j = rt - rt0;
        u.A = H + (size_t)rt * (256 * 256 * 2); u.B = W + (size_t)tabE[j] * (1024 * 256 * 2) + (size_t)(uu & 3) * (256 * 256 * 2); u.r0 = j * 256; u.c0 = (uu & 3) * 256; u.aux = j; return true;
    }
    __device__ __forceinline__ void lane_off(const gp::Unit&, int, int, int, int, unsigned (&)[2][2]) const {}
};
struct EpiY {
    bf16_t* Ys; const LAS int* tabD; const LAS float* tabG;
    __device__ __forceinline__ void operator()(const gp::f32x4 (&acc)[2][2][4][2], const gp::Unit& u, int wr, int wc, int fr, int fq) const {
        const int rl0 = u.r0 + wr * 64 + fr, col0 = u.c0 + wc * 32 + 8 * fq;
#pragma unroll
        for (int ai = 0; ai < 2; ++ai)
#pragma unroll
            for (int m = 0; m < 4; ++m) {
                const int rl = rl0 + ai * 128 + m * 16;
                const int dst = tabD[rl]; const float g = tabG[rl];
                if (dst >= 0) { bf16_t* rowp = Ys + (size_t)dst * 1024 + col0;
#pragma unroll
                    for (int bj = 0; bj < 2; ++bj) { const gp::f32x4 v0 = acc[ai][bj][m][0] * g, v1 = acc[ai][bj][m][1] * g;
                        gp::u32x4 w; w.x = cvt_pk_bf16(v0[0], v0[1]); w.y = cvt_pk_bf16(v0[2], v0[3]); w.z = cvt_pk_bf16(v1[0], v1[1]); w.w = cvt_pk_bf16(v1[2], v1[3]);
                        *(gp::u32x4*)(rowp + bj * 128) = w; } }
                __builtin_amdgcn_sched_barrier(0); }
    }
};
__device__ __forceinline__ void ph_moe2(KP p, int l, int ntok, int bid, int nb, LAS unsigned char* lds) {
    LAS int* offs = (LAS int*)(lds + MOE_TAB);
    LAS int* tabE = offs + 128;
    LAS int* tabD = offs + 256;
    LAS float* tabG = (LAS float*)(tabD + MOE_MAXT * 256);
    moe_offsets(p, l, ntok, offs);
    const int tid = opaque_tid();
    const int nrt = offs[65] >> 8, total = nrt * 4;
    const int u0 = (int)(((long)bid * total) / nb), u1 = (int)(((long)(bid + 1) * total) / nb);
    const int rt0 = u0 >> 2, nper = (u1 > u0) ? (((u1 - 1) >> 2) - rt0 + 1) : 0;
    const int* sdst = (const int*)(p->ws + OFF_SDST); const float* sgate = (const float*)(p->ws + OFF_SGATE); const int* tile_e = (const int*)(p->ws + OFF_TILEE);
    for (int i = tid; i < nper * 256; i += 512) { const size_t r = (size_t)(rt0 + (i >> 8)) * 256 + (i & 255); tabD[i] = sdst[r]; tabG[i] = sgate[r]; }
    if (tid < nper) tabE[tid] = tile_e[rt0 + tid];
    __syncthreads();
    Moe2Sched S{(const char*)(p->ws + OFF_BIG), (const char*)(p->ws + OFF_W2), tabE, u0, u1, rt0};
    EpiY E{(bf16_t*)(p->ws + OFF_YS), tabD, tabG};
    gp::gemm_phase<false, true>(lds, 256, S, E);
}

__device__ __forceinline__ void ph_combine_ln2(KP p, int l, int ntok, int bid, int nb) {
    const int tid = opaque_tid(), lane = tid & 63, wv = tid >> 6;
    const bf16_t* Ys = (const bf16_t*)(p->ws + OFF_YS);
    const float* lw = p->in[I_LNW] + (l * 2 + 1) * 1024; const float* lb = p->in[I_LNB] + (l * 2 + 1) * 1024;
    #pragma unroll 1
    for (int tok = bid * 8 + wv; tok < ntok; tok += nb * 8) {
        float* h = hrow(p, tok);
        const float* m = modrow(p, l, tok);
        float f[16];
#pragma unroll
        for (int i = 0; i < 16; ++i) f[i] = 0.f;
#pragma unroll
        for (int s = 0; s < 9; ++s)
#pragma unroll
            for (int c = 0; c < 2; ++c) {
                const uint4 w = *(const uint4*)(Ys + ((size_t)tok * 9 + s) * 1024 + 8 * (lane + 64 * c));
                f[8 * c + 0] += bflo(w.x); f[8 * c + 1] += bfhi(w.x); f[8 * c + 2] += bflo(w.y); f[8 * c + 3] += bfhi(w.y);
                f[8 * c + 4] += bflo(w.z); f[8 * c + 5] += bfhi(w.z); f[8 * c + 6] += bflo(w.w); f[8 * c + 7] += bfhi(w.w);
            }
        float x[16]; float sum = 0.f;
#pragma unroll
        for (int c = 0; c < 2; ++c)
#pragma unroll
            for (int q = 0; q < 2; ++q) {
                const int d = 8 * (lane + 64 * c) + 4 * q;
                const float4 hv = *(const float4*)(h + d), gv = *(const float4*)(m + 5 * 1024 + d);
                x[8 * c + 4 * q + 0] = ALPHA * hv.x + gv.x * f[8 * c + 4 * q + 0]; x[8 * c + 4 * q + 1] = ALPHA * hv.y + gv.y * f[8 * c + 4 * q + 1];
                x[8 * c + 4 * q + 2] = ALPHA * hv.z + gv.z * f[8 * c + 4 * q + 2]; x[8 * c + 4 * q + 3] = ALPHA * hv.w + gv.w * f[8 * c + 4 * q + 3];
                sum += x[8 * c + 4 * q] + x[8 * c + 4 * q + 1] + x[8 * c + 4 * q + 2] + x[8 * c + 4 * q + 3];
            }
        const float mean = wave_sum(sum) * (1.f / 1024.f);
        float q2 = 0.f;
#pragma unroll
        for (int i = 0; i < 16; ++i) { x[i] -= mean; q2 += x[i] * x[i]; }
        const float rs = rsqrtf(wave_sum(q2) * (1.f / 1024.f) + LN_EPS);
#pragma unroll
        for (int c = 0; c < 2; ++c)
#pragma unroll
            for (int q = 0; q < 2; ++q) {
                const int d = 8 * (lane + 64 * c) + 4 * q;
                const float4 w4 = *(const float4*)(lw + d), b4 = *(const float4*)(lb + d);
                float4 y; y.x = x[8 * c + 4 * q] * rs * w4.x + b4.x; y.y = x[8 * c + 4 * q + 1] * rs * w4.y + b4.y; y.z = x[8 * c + 4 * q + 2] * rs * w4.z + b4.z; y.w = x[8 * c + 4 * q + 3] * rs * w4.w + b4.w;
                *(float4*)(h + d) = y;
            }
    }
}

#define MEGA_LDS (131072 + 256 + 20480)
#define NBLK 256
#define BAR_LDS BAR_LDS_
#define SYNC() do { XcdBarrier _b; _b.bar = (unsigned*)kparams()->ws; _b.x = xb_xcc_id(); _b.st = (volatile LAS unsigned*)((LAS unsigned char*)smraw_base() + BAR_LDS); xcd_barrier(_b); } while (0)
template <int PAR>
__device__ __forceinline__ void layer_fwd(const int l) {
    LAS unsigned char* lds = smraw_base(); float* sm = (float*)smraw_generic();
    const int bid = blockIdx.x; constexpr int nb = NBLK;
    const int ntok = (l == 3) ? NL : NT;
    ph_convert(kparams(), l, bid, nb, sm); ph_modin(kparams(), l, bid, nb); SYNC();
    ph_gemm_in(kparams(), l, bid, nb, lds); SYNC();
    if (PAR == 0) {
        ph_scan_even2(kparams(), l, bid, nb); SYNC();
        ph_normgate_even(kparams(), l, bid, nb); SYNC();
    } else {
        ph_hy_filt2(kparams(), l, bid, nb, sm); ph_hy_prep(kparams(), l, bid, nb, sm); SYNC();
        ph_mix_odd(kparams(), l, bid, nb, sm); SYNC();
        ph_hy_norm(kparams(), l, bid, nb, sm); ph_normgate_odd(kparams(), l, bid, nb); SYNC();
    }
    ph_gemm_out(kparams(), l, bid, nb, lds); SYNC();
    ph_ln1_router(kparams(), l, ntok, bid, nb, sm); SYNC();
    ph_scatter(kparams(), l, ntok, bid, nb, lds); SYNC();
    ph_moe1(kparams(), l, ntok, bid, nb, lds); SYNC();
    ph_moe2(kparams(), l, ntok, bid, nb, lds); SYNC();
    ph_combine_ln2(kparams(), l, ntok, bid, nb);
    if (l < 3) SYNC();
}
__global__ void __launch_bounds__(512, 2) mega_fwd(Params p) {
    LAS unsigned char* lds = smraw_base(); float* sm = (float*)smraw_generic();
    if (threadIdx.x < 4) ((LAS unsigned*)(lds + BAR_LDS))[threadIdx.x] = 0u;
    __syncthreads();
    (void)xcd_barrier_post((unsigned*)kparams()->ws, (volatile LAS unsigned*)(lds + BAR_LDS));
    const int bid = blockIdx.x; constexpr int nb = NBLK;
    ph_prologue(kparams(), bid, nb, sm); SYNC();
#pragma unroll 1
    for (int lp = 0; lp < 2; ++lp) {
        layer_fwd<0>(2 * lp);
        layer_fwd<1>(2 * lp + 1);
    }
    __syncthreads();
    if (blockIdx.x == 0 && threadIdx.x == 0 && xb_ld((unsigned*)kparams()->ws + XB_TMO) != 0u) kparams()->out[0] = __builtin_nanf("");
}

extern "C" void kernel_launch(void* const* d_in, const int* in_sizes, int n_in, void* d_out, int out_size, void* d_ws, size_t ws_size, hipStream_t stream) {
    static int grid = 0;
    if (grid == 0) {
        if (n_in != 38 || out_size != NL * DM || ws_size < WS_END) { fprintf(stderr, "kernel_launch: bad shapes n_in %d out %d ws %zu (need %zu)\n", n_in, out_size, ws_size, (size_t)WS_END); grid = -1; return; }
        int dev = 0, cus = 0, per_cu = 0;
        if (hipGetDevice(&dev) != hipSuccess || hipDeviceGetAttribute(&cus, hipDeviceAttributeMultiprocessorCount, dev) != hipSuccess) { grid = -1; return; }
        if (hipFuncSetAttribute((const void*)mega_fwd, hipFuncAttributeMaxDynamicSharedMemorySize, MEGA_LDS) != hipSuccess) { fprintf(stderr, "kernel_launch: hipFuncSetAttribute failed\n"); grid = -1; return; }
        if (hipOccupancyMaxActiveBlocksPerMultiprocessor(&per_cu, (const void*)mega_fwd, 512, MEGA_LDS) != hipSuccess || per_cu < 1) { fprintf(stderr, "kernel_launch: occupancy query says %d\n", per_cu); (void)hipGetLastError(); grid = -1; return; }
        if (cus != 256) { fprintf(stderr, "kernel_launch: built for 256 CUs, found %d\n", cus); grid = -1; return; }
        grid = NBLK;
    }
    if (grid < 0) return;
    if (hipMemsetAsync(d_ws, 0, OFF_LB, stream) != hipSuccess) return;
    Params p{};
    for (int i = 0; i < 38; ++i) p.in[i] = (const float*)d_in[i];
    p.out = (float*)d_out; p.ws = (unsigned char*)d_ws;
    hipLaunchKernelGGL(mega_fwd, dim3(grid), dim3(512), MEGA_LDS, stream, p);
}
```

```cpp
#include <hip/hip_runtime.h>
#include <stdint.h>
#include <stdio.h>

#define DM 1024
#define NBATCH 8
#define SEQ 4096
#define CTXL 256
#define NL (NBATCH * SEQ)
#define NC (NBATCH * CTXL)
#define NT (NL + NC)
#define ZROW NT
#define TOPK 8
#define EVEN_N 4112
#define ODD_N 3584
#define EVEN_LD 4096
#define ODD_LD 3584
#define MAXROWS (NT * 8 + 64 * 256 + NT)
#define ALPHA 1.681792830507429f
#define LN_EPS 1e-5f
#define E_MQ 0
#define E_MK 256
#define E_MV 512
#define E_MO 1024
#define E_HQ 1536
#define E_HI 2048
#define E_HFF 2560
#define E_HFB 3072
#define E_HG 3584

typedef unsigned short bf16_t;
#define LAS __attribute__((address_space(3)))
#define BAR_LDS_ 150528

#define MiB ((size_t)1 << 20)
#define OFF_CNT   ((size_t)64 << 10)
#define OFF_LB    ((size_t)96 << 10)
#define OFF_MOD   ((size_t)128 << 10)
#define OFF_ROPE  ((size_t)1536 << 10)
#define OFF_BCNT  ((size_t)1600 << 10)
#define OFF_GOFFS ((size_t)1700 << 10)
#define OFF_TILEE (2 * MiB)
#define OFF_HCTX  (4 * MiB)
#define OFF_TIDX  (12 * MiB)
#define OFF_TGATE (14 * MiB)
#define OFF_TPOS  (16 * MiB)
#define OFF_STOK  (18 * MiB)
#define OFF_SGATE (20 * MiB)
#define OFF_SDST  (22 * MiB)
#define OFF_G     (24 * MiB)
#define OFF_U     (28 * MiB)
#define OFF_W     (98 * MiB)
#define OFF_WIN   (OFF_W)
#define OFF_WOUT  (OFF_W + 8 * MiB)
#define OFF_W13   (OFF_W + 10 * MiB)
#define OFF_W2    (OFF_W + 75 * MiB)
#define OFF_BIG   (208 * MiB)
#define OFF_AUX   (480 * MiB)
#define OFF_Z1    (OFF_AUX + 136 * MiB)
#define OFF_Z2    (OFF_Z1 + 68 * MiB)
#define OFF_FILT  (OFF_Z2 + 68 * MiB)
#define OFF_YS    (370 * MiB)
#define WS_END    (984 * MiB)

struct Params {
    const float* in[38];
    float* out;
    unsigned char* ws;
};

enum { I_X = 0, I_C, I_CTX, I_CCTX, I_ADAW, I_ADAB, I_LNW, I_LNB, I_EWIN, I_MGB, I_MNW, I_HLB, I_HNW, I_EWOUT, I_OWIN, I_HCW, I_HCB,
       I_HW1, I_HB1, I_HW2, I_HB2, I_HW3, I_HB3, I_HFREQ, I_HWOUT, I_HSKIP, I_HNORM, I_RLD, I_RNW, I_OWOUT, I_RW, I_RB, I_W1, I_W3, I_W2, I_SW1, I_SW3, I_SW2 };

typedef const __attribute__((address_space(4))) Params* KP;
__device__ __forceinline__ KP kparams() { KP k = (KP)__builtin_amdgcn_kernarg_segment_ptr(); asm volatile("" : "+s"(k)); return k; }
extern __shared__ __attribute__((aligned(16))) unsigned char smraw_all[];
__device__ __forceinline__ LAS unsigned char* smraw_base() { return (LAS unsigned char*)smraw_all; }
__device__ __forceinline__ unsigned char* smraw_generic() { return smraw_all; }
#define WTAB_LDS (BAR_LDS_ + 512)
__device__ __forceinline__ int opaque_tid() {
    unsigned h; asm volatile("s_getreg_b32 %0, hwreg(HW_REG_HW_ID, 0, 6)" : "=s"(h));
    const int wid = *(volatile LAS int*)(size_t)(WTAB_LDS + (h & 63u) * 4u);
    unsigned m = ~0u; asm volatile("" : "+s"(m));
    const int lane = (int)__builtin_amdgcn_mbcnt_hi(m, __builtin_amdgcn_mbcnt_lo(m, 0u));
    return __builtin_amdgcn_readfirstlane(wid) * 64 + lane;
}
typedef __bf16 bf16x2_n __attribute__((ext_vector_type(2)));
typedef float f32x2_n __attribute__((ext_vector_type(2)));
__device__ __forceinline__ unsigned cvt_pk_bf16(float lo, float hi) { const f32x2_n v = {lo, hi}; return __builtin_bit_cast(unsigned, __builtin_convertvector(v, bf16x2_n)); }
__device__ __forceinline__ float bf2f(bf16_t b) { return __uint_as_float(((unsigned)b) << 16); }
__device__ __forceinline__ float bflo(unsigned w) { return __uint_as_float(w << 16); }
__device__ __forceinline__ float bfhi(unsigned w) { return __uint_as_float(w & 0xffff0000u); }
__device__ __forceinline__ float ldf(const float* p) { return *p; }
__device__ __forceinline__ float ldf(const bf16_t* p) { return bf2f(*p); }
__device__ __forceinline__ void stf(float* p, float v) { *p = v; }
__device__ __forceinline__ void stf(bf16_t* p, float v) { *p = (bf16_t)(cvt_pk_bf16(v, 0.f) & 0xffffu); }
__device__ __forceinline__ float sigmoidf_(float x) { return 1.f / (1.f + expf(-x)); }
__device__ __forceinline__ float siluf_(float x) { return x / (1.f + expf(-x)); }
__device__ __forceinline__ float fexp(float x) { return __builtin_amdgcn_exp2f(x * 1.4426950408889634f); }
__device__ __forceinline__ float flog(float x) { return __builtin_amdgcn_logf(x) * 0.6931471805599453f; }
__device__ __forceinline__ float frcp(float x) { return __builtin_amdgcn_rcpf(x); }
__device__ __forceinline__ float fsigmoid(float x) { return frcp(1.f + fexp(-x)); }
__device__ __forceinline__ float fsilu(float x) { return x * frcp(1.f + fexp(-x)); }
__device__ __forceinline__ float wave_sum(float v) {
#pragma unroll
    for (int o = 32; o > 0; o >>= 1) v += __shfl_xor(v, o, 64);
    return v;
}
__device__ __forceinline__ float* hrow(KP p, int tok) {
    return tok < NL ? p->out + (size_t)tok * DM : (float*)(p->ws + OFF_HCTX) + (size_t)(tok - NL) * DM;
}
__device__ __forceinline__ const float* modrow(KP p, int l, int tok) {
    const int r = tok < NL ? (tok >> 12) : 8;
    return (const float*)(p->ws + OFF_MOD) + ((size_t)l * 9 + r) * 6144;
}
__device__ __forceinline__ int scan_tok(int b, int i, int dir) {
    return i < CTXL ? NL + b * CTXL + (dir ? CTXL - 1 - i : i) : b * SEQ + (dir ? SEQ - 1 - (i - CTXL) : (i - CTXL));
}

#define XB_TMO      128
#define XB_XCNT(j)  (256  + 64 * (j))
#define XB_XSUB(j)  (1280 + 64 * (j))
#define XB_XGEN(j)  (2304 + 64 * (j))
#define XB_TOP      3328
#define XB_TOPGEN   3392
#define XCD_BAR_WORDS 3456
#define XB_SPIN_CAP (1u << 24)
__device__ __forceinline__ unsigned xb_ld(unsigned* p)              { return __hip_atomic_load(p, __ATOMIC_RELAXED, __HIP_MEMORY_SCOPE_AGENT); }
__device__ __forceinline__ unsigned xb_add(unsigned* p, unsigned v) { return __hip_atomic_fetch_add(p, v, __ATOMIC_RELAXED, __HIP_MEMORY_SCOPE_AGENT); }
__device__ __forceinline__ unsigned xb_xcc_id() { return (unsigned)__builtin_amdgcn_s_getreg((3 << 11) | 20) & 0xFu; }
#define XB_SPIN(cond, bar) do { unsigned _sp = 0; while (cond) { __builtin_amdgcn_s_sleep(1); \
    if ((++_sp & 255u) == 0u) { if (xb_ld(&(bar)[XB_TMO])) break; if (_sp > XB_SPIN_CAP) { atomicAdd(&(bar)[XB_TMO], 1u); break; } } } } while (0)
struct XcdBarrier { unsigned* bar; unsigned x; volatile LAS unsigned* st; };
__device__ __forceinline__ XcdBarrier xcd_barrier_post(unsigned* bar, volatile LAS unsigned* st) {
    XcdBarrier b; b.bar = bar; b.x = xb_xcc_id(); b.st = st;
    if (opaque_tid() == 0) (void)xb_add(&bar[XB_XCNT(b.x)], 1u);
    return b;
}
__device__ __forceinline__ void xcd_barrier_complete(unsigned* bar, unsigned x, unsigned& nloc, unsigned& nx) {
    const unsigned G = gridDim.x * gridDim.y * gridDim.z;
    unsigned sum, cnt, mine, sp = 0u;
    for (;;) {
        sum = 0u; cnt = 0u; mine = 0u;
#pragma unroll
        for (unsigned j = 0; j < 16; ++j) { const unsigned c = xb_ld(&bar[XB_XCNT(j)]); sum += c; cnt += (c > 0u) ? 1u : 0u; mine = (j == x) ? c : mine; }
        if (sum == G) break;
        __builtin_amdgcn_s_sleep(1);
        if ((++sp & 255u) == 0u) { if (xb_ld(&bar[XB_TMO])) break; if (sp > XB_SPIN_CAP) { atomicAdd(&bar[XB_TMO], 1u); break; } }
    }
    nloc = mine > 0u ? mine : 1u; nx = cnt > 0u ? cnt : 1u;
}
__device__ __forceinline__ void xcd_barrier(const XcdBarrier& b) {
    asm volatile("s_waitcnt vmcnt(0)" ::: "memory");
    __syncthreads();
    if (opaque_tid() == 0) {
        unsigned* bar = b.bar;
        __builtin_amdgcn_s_waitcnt(0);
        unsigned nloc = b.st[0], nx = b.st[1];
        if (nloc == 0u) { xcd_barrier_complete(bar, b.x, nloc, nx); b.st[0] = nloc; b.st[1] = nx; }
        const unsigned old = xb_add(&bar[XB_XSUB(b.x)], 1u);
        const unsigned gen = old / nloc;
        if (old + 1u == (gen + 1u) * nloc) {
            __builtin_amdgcn_fence(__ATOMIC_RELEASE, "agent");
            asm volatile("s_waitcnt vmcnt(0)" ::: "memory");
            const unsigned og = xb_add(&bar[XB_TOP], 1u);
            const unsigned tg = og / nx;
            if (og + 1u == (tg + 1u) * nx) xb_add(&bar[XB_TOPGEN], 1u);
            else XB_SPIN(xb_ld(&bar[XB_TOPGEN]) == tg, bar);
            __builtin_amdgcn_fence(__ATOMIC_ACQUIRE, "agent");
            xb_add(&bar[XB_XGEN(b.x)], 1u);
            asm volatile("s_waitcnt vmcnt(0)" ::: "memory");
        } else {
            XB_SPIN(xb_ld(&bar[XB_XGEN(b.x)]) == gen, bar);
            __builtin_amdgcn_fence(__ATOMIC_ACQUIRE, "agent");
            asm volatile("s_waitcnt vmcnt(0)" ::: "memory");
        }
    }
    __syncthreads();
}

__device__ __forceinline__ void ph_prologue(KP p, int bid, int nb, float* sm) {
    const int tid = opaque_tid();
    {
        const float4* x4 = (const float4*)p->in[I_X]; float4* o4 = (float4*)p->out;
        #pragma unroll 1
        for (size_t i = (size_t)bid * 512 + tid; i < (size_t)NL * 256; i += (size_t)nb * 512) o4[i] = x4[i];
        const float4* c4 = (const float4*)p->in[I_CTX]; float4* h4 = (float4*)(p->ws + OFF_HCTX);
        #pragma unroll 1
        for (size_t i = (size_t)bid * 512 + tid; i < (size_t)NC * 256; i += (size_t)nb * 512) h4[i] = c4[i];
    }
    if (bid == 0) {
        bf16_t* z = (bf16_t*)(p->ws + OFF_U) + (size_t)ZROW * DM;
        for (int i = tid; i < DM; i += 512) z[i] = 0;
    }
    if (bid == 1 % nb) {
        float* lb = (float*)(p->ws + OFF_LB);
        const float* hl = p->in[I_HLB];
        for (int j = tid; j < 512; j += 512) {
            const float a = hl[j], b = hl[512 + j], mx = fmaxf(a, b);
            const float ea = expf(a - mx), eb = expf(b - mx);
            lb[j] = 0.f; lb[512 + j] = eb / (ea + eb);
        }
    }
    if (bid == 2 % nb) {
        float2* rt = (float2*)(p->ws + OFF_ROPE);
        for (int i = tid; i < 64 * 32; i += 512) { const float ang = (float)(i >> 5) * powf(10000.f, -(float)(2 * (i & 31)) / 64.f); rt[i] = make_float2(cosf(ang), sinf(ang)); }
    }
    {
        float* act = sm;
        bool filled = false;
        #pragma unroll 1
        for (int item = bid; item < 48; item += nb) {
            if (!filled) {
                for (int i = tid; i < 9 * 1024; i += 512) {
                    const int r = i >> 10, k = i & 1023;
                    const float v = r < 8 ? p->in[I_C][r * 1024 + k] : p->in[I_CCTX][k];
                    act[i] = siluf_(v);
                }
                __syncthreads(); filled = true;
            }
            const int l = item / 12, j = (item % 12) * 512 + tid;
            const float* w = p->in[I_ADAW] + (size_t)l * 1024 * 6144 + j;
            float acc[9];
#pragma unroll
            for (int r = 0; r < 9; ++r) acc[r] = 0.f;
            for (int k = 0; k < 1024; ++k) {
                const float wv = w[(size_t)k * 6144];
#pragma unroll
                for (int r = 0; r < 9; ++r) acc[r] += act[r * 1024 + k] * wv;
            }
            const float bv = p->in[I_ADAB][l * 6144 + j];
            float* mod = (float*)(p->ws + OFF_MOD);
#pragma unroll
            for (int r = 0; r < 9; ++r) mod[((size_t)l * 9 + r) * 6144 + j] = acc[r] + bv;
        }
    }
}


template <class Src>
__device__ __forceinline__ void cvt_tile(float* sm, Src src, int srcld, int k0, bf16_t* dst, int dstld, int n0) {
    const int tid = opaque_tid();
    const float* sp = src(n0 + (tid & 127));
#pragma unroll
    for (int j = 0; j < 16; ++j) { const int k = (tid >> 7) + 4 * j; sm[k * 129 + (tid & 127)] = sp[(size_t)(k0 + k) * srcld]; }
    __syncthreads();
    const int n = tid >> 2, kc = (tid & 3) * 16;
    unsigned w[8];
#pragma unroll
    for (int q = 0; q < 8; ++q) w[q] = cvt_pk_bf16(sm[(kc + 2 * q) * 129 + n], sm[(kc + 2 * q + 1) * 129 + n]);
    uint4* d4 = (uint4*)(dst + (size_t)(n0 + n) * dstld + k0 + kc);
    d4[0] = make_uint4(w[0], w[1], w[2], w[3]); d4[1] = make_uint4(w[4], w[5], w[6], w[7]);
    __syncthreads();
}

__device__ __forceinline__ void ph_convert(KP p, int l, int bid, int nb, float* sm) {
    const bool even = (l & 1) == 0;
    const int NP = even ? EVEN_LD : ODD_LD;
    const int t_in = 16 * (NP / 128), t_out = 16 * 8, t_13 = 65 * 16 * 4, t_2 = 65 * 4 * 8;
    const int total = t_in + t_out + t_13 + t_2;
    #pragma unroll 1
    for (int t = bid; t < total; t += nb) {
        if (t < t_in) {
            const int kt = t & 15, nt = t >> 4;
            const float* W = even ? p->in[I_EWIN] + (size_t)(l >> 1) * 1024 * EVEN_N : p->in[I_OWIN] + (size_t)(l >> 1) * 1024 * ODD_N;
            cvt_tile(sm, [&](int n) { return W + ((even && n >= 1536) ? n + 16 : n); }, even ? EVEN_N : ODD_N, kt * 64, (bf16_t*)(p->ws + OFF_WIN), 1024, nt * 128);
        } else if (t < t_in + t_out) {
            const int u = t - t_in, kt = u & 15, nt = u >> 4;
            const float* W = (even ? p->in[I_EWOUT] : p->in[I_OWOUT]) + (size_t)(l >> 1) * 1024 * 1024;
            cvt_tile(sm, [&](int n) { return W + n; }, 1024, kt * 64, (bf16_t*)(p->ws + OFF_WOUT), 1024, nt * 128);
        } else if (t < t_in + t_out + t_13) {
            const int u = t - t_in - t_out, e = u >> 6, kt = u & 15, nt = (u >> 4) & 3;
            const float* w1 = e < 64 ? p->in[I_W1] + ((size_t)l * 64 + e) * 1024 * 256 : p->in[I_SW1] + (size_t)l * 1024 * 256;
            const float* w3 = e < 64 ? p->in[I_W3] + ((size_t)l * 64 + e) * 1024 * 256 : p->in[I_SW3] + (size_t)l * 1024 * 256;
            cvt_tile(sm, [&](int n) { const int g = n >> 5, w = n & 31; return w < 16 ? w1 + 16 * g + w : w3 + 16 * g + w - 16; }, 256, kt * 64,
                     (bf16_t*)(p->ws + OFF_W13) + (size_t)e * 512 * 1024, 1024, nt * 128);
        } else {
            const int u = t - t_in - t_out - t_13, e = u >> 5, kt = u & 3, nt = (u >> 2) & 7;
            const float* w2 = e < 64 ? p->in[I_W2] + ((size_t)l * 64 + e) * 256 * 1024 : p->in[I_SW2] + (size_t)l * 256 * 1024;
            cvt_tile(sm, [&](int n) { return w2 + n; }, 1024, kt * 64, (bf16_t*)(p->ws + OFF_W2) + (size_t)e * 1024 * 256, 256, nt * 128);
        }
    }
}

namespace gp {
typedef short bf16x8 __attribute__((ext_vector_type(8)));
typedef float f32x4 __attribute__((ext_vector_type(4)));
typedef unsigned u32x4 __attribute__((ext_vector_type(4)));
typedef unsigned u32x2 __attribute__((ext_vector_type(2)));
constexpr int BM = 256, BK = 64, HALF = 128, HTB = HALF * BK * 2, STAGE_BYTES = 8 * HTB, NXCD = 8, WGM = 8;
__device__ __forceinline__ int lds_byte(int r, int c) { const int st = (r >> 4) * 2 + (c >> 5), rr = r & 15, cc = c & 31, ob = rr * 64 + cc * 2; return st * 1024 + (ob ^ (((ob >> 9) & 1) << 5)); }
__device__ __forceinline__ void stage_rc(int b, int& R, int& C) { const int st = b / 1024, sb = b % 1024, swz = sb ^ (((sb >> 9) & 1) << 5); R = (st >> 1) * 16 + swz / 64; C = (st & 1) * 32 + (swz % 64) / 2; }
__device__ __forceinline__ int perm32(int rho) { const int n = rho >> 4, i = rho & 15; return 8 * (i >> 2) + 4 * n + (i & 3); }

struct Unit { const char* A; const char* B; int r0, c0, aux; };

struct DenseSched {
    const char* A; const char* B; int nM, nN, nwg, G, c; size_t tstep;
    __device__ __forceinline__ void init(const void* A_, const void* B_, int M, int N, int K, int G_, int c_) { A = (const char*)A_; B = (const char*)B_; nM = M / BM; nN = N / BM; nwg = nM * nN; G = G_; c = c_; tstep = (size_t)BM * K * 2; }
    __device__ __forceinline__ bool next(int i, Unit& u) const {
        const long L = (long)i * G + c; if (L >= nwg) return false;
        int wgid = (int)L; { const int q = nwg / NXCD, r = nwg % NXCD, xcd = wgid % NXCD, off = wgid / NXCD; wgid = (xcd < r ? xcd * (q + 1) : r * (q + 1) + (xcd - r) * q) + off; }
        const int nig = WGM * nN, gid = wgid / nig, fm = gid * WGM, gsz = (nM - fm) < WGM ? (nM - fm) : WGM;
        const int pm = fm + ((wgid % nig) % gsz), pn = (wgid % nig) / gsz;
        u.A = A + (size_t)pm * tstep; u.B = B + (size_t)pn * tstep; u.r0 = pm * BM; u.c0 = pn * BM; u.aux = 0; return true;
    }
    __device__ __forceinline__ void lane_off(const Unit&, unsigned (&)[2][2]) const {}
};

template <bool GATHER, bool PERM, class Sched, class Epi>
__device__ __forceinline__ void gemm_phase(LAS unsigned char* lds, const int K_, const Sched& S, const Epi& E) {
    int K = K_; asm volatile("" : "+s"(K));
    const int tid = opaque_tid(), wid = __builtin_amdgcn_readfirstlane(tid >> 6), lane = tid & 63, wr = wid >> 2, wc = wid & 3, fr = lane & 15, fq = lane >> 4;
    const int nt = K / BK;
    unsigned voffA[2], voffB[2];
#pragma unroll
    for (int i = 0; i < 2; ++i) { int R, C; stage_rc(tid * 16 + i * 8192, R, C); const int Rb = PERM ? ((R & ~31) + perm32(R & 31)) : R;
        voffA[i] = (unsigned)(R * K + C) * 2u; voffB[i] = (unsigned)(Rb * K + C) * 2u; }
    const size_t kstep = (size_t)(BK * 2);
    const size_t hstep = (size_t)HALF * K * 2;
    const unsigned ldsw = (unsigned)wid * 1024u;
    const int aoff = lds_byte(wr * 64 + fr, fq * 8), boff = lds_byte(wc * 32 + fr, fq * 8);
    unsigned cvo[2][2] = {{0u, 0u}, {0u, 0u}}, nvo[2][2] = {{0u, 0u}, {0u, 0u}};
#define GP_SA(b, h) (((b) * 2 + (h)) * HTB)
#define GP_SB(b, h) ((4 + (b) * 2 + (h)) * HTB)
#define GP_GLDS(gp_, lp_) __builtin_amdgcn_global_load_lds((const unsigned*)(gp_), (LAS unsigned*)(lp_), 16, 0, 0)
#define GP_STAGE_B(bufoff, gbase, h) do { const char* _g = (gbase) + (size_t)(h) * hstep; \
        GP_GLDS(_g + voffB[0], lds + (bufoff) + ldsw); GP_GLDS(_g + voffB[1], lds + (bufoff) + ldsw + 8192); } while (0)
#define GP_STAGE_A(bufoff, gbase, h, usenext) do { \
        if (GATHER) { const unsigned _o0 = (usenext) ? nvo[h][0] : cvo[h][0], _o1 = (usenext) ? nvo[h][1] : cvo[h][1]; \
            GP_GLDS((gbase) + _o0, lds + (bufoff) + ldsw); GP_GLDS((gbase) + _o1, lds + (bufoff) + ldsw + 8192); } \
        else { const char* _g = (gbase) + (size_t)(h) * hstep; GP_GLDS(_g + voffA[0], lds + (bufoff) + ldsw); GP_GLDS(_g + voffA[1], lds + (bufoff) + ldsw + 8192); } } while (0)
#define GP_LDA(dst, b, h) do { _Pragma("unroll") for (int m = 0; m < 4; ++m) _Pragma("unroll") for (int k = 0; k < 2; ++k) dst[m][k] = *(const LAS bf16x8*)(lds + GP_SA(b, h) + aoff + m * 2048 + k * 1024); } while (0)
#define GP_LDB(dst, b, h) do { _Pragma("unroll") for (int n = 0; n < 2; ++n) _Pragma("unroll") for (int k = 0; k < 2; ++k) dst[n][k] = *(const LAS bf16x8*)(lds + GP_SB(b, h) + boff + n * 2048 + k * 1024); } while (0)
#define GP_MMA(ai, bj, At, Bt) do { __builtin_amdgcn_s_setprio(1); _Pragma("unroll") for (int m = 0; m < 4; ++m) _Pragma("unroll") for (int n = 0; n < 2; ++n) _Pragma("unroll") for (int k = 0; k < 2; ++k) \
        acc[ai][bj][m][n] = __builtin_amdgcn_mfma_f32_16x16x32_bf16(Bt[n][k], At[m][k], acc[ai][bj][m][n], 0, 0, 0); __builtin_amdgcn_s_setprio(0); } while (0)
#define GP_WAIT_V(n) asm volatile("s_waitcnt vmcnt(" #n ")" ::: "memory")
#define GP_WAIT_L(n) asm volatile("s_waitcnt lgkmcnt(" #n ")" ::: "memory")
#define GP_BAR __builtin_amdgcn_s_barrier()
#define GP_SCHED __builtin_amdgcn_sched_barrier(0)
    Unit cur, nxt; int ui = 0;
    if (!S.next(0, cur)) return;
    f32x4 acc[2][2][4][2];
#pragma unroll
    for (int a = 0; a < 2; ++a)
#pragma unroll
        for (int b = 0; b < 2; ++b)
#pragma unroll
            for (int m = 0; m < 4; ++m)
#pragma unroll
                for (int n = 0; n < 2; ++n) acc[a][b][m][n] = (f32x4){0.f, 0.f, 0.f, 0.f};
    bf16x8 At[4][2], B0[2][2], B1[2][2];
    if (GATHER) S.lane_off(cur, cvo);
    const char* cA = cur.A; const char* cB = cur.B;
    GP_STAGE_B(GP_SB(0, 0), cB, 0); GP_STAGE_A(GP_SA(0, 0), cA, 0, false); GP_STAGE_B(GP_SB(0, 1), cB, 1); GP_STAGE_A(GP_SA(0, 1), cA, 1, false);
    if (wr == 1) GP_BAR;
    GP_WAIT_V(4); GP_BAR;
    GP_STAGE_B(GP_SB(1, 0), cB + kstep, 0); GP_STAGE_A(GP_SA(1, 0), cA + kstep, 0, false); GP_STAGE_B(GP_SB(1, 1), cB + kstep, 1);
    GP_WAIT_V(6); GP_BAR;
    for (;;) {
        const bool has_next = S.next(ui + 1, nxt);
        if (GATHER && has_next) S.lane_off(nxt, nvo);
        const char* nA = has_next ? nxt.A : cA; const char* nB = has_next ? nxt.B : cB;
        for (int t = 0; t < nt; t += 2) {
            const bool last = (t == nt - 2);
            const bool un = last && has_next;
            const char* a1 = cA + (size_t)(t + 1) * kstep;
            const char* a2 = last ? nA : cA + (size_t)(t + 2) * kstep; const char* b2 = last ? nB : cB + (size_t)(t + 2) * kstep;
            const char* a3 = a2 + kstep; const char* b3 = b2 + kstep;
            GP_LDB(B0, 0, 0); GP_SCHED; GP_LDA(At, 0, 0); GP_STAGE_A(GP_SA(1, 1), a1, 1, false);
            GP_WAIT_L(8); GP_BAR; GP_WAIT_L(0); GP_MMA(0, 0, At, B0); GP_BAR; GP_SCHED;
            GP_LDB(B1, 0, 1); GP_STAGE_B(GP_SB(0, 0), b2, 0);
            GP_BAR; GP_WAIT_L(0); GP_MMA(0, 1, At, B1); GP_BAR;
            GP_LDA(At, 0, 1); GP_STAGE_A(GP_SA(0, 0), a2, 0, un);
            GP_BAR; GP_WAIT_L(0); GP_MMA(1, 0, At, B0); GP_BAR; GP_SCHED;
            GP_STAGE_B(GP_SB(0, 1), b2, 1);
            GP_WAIT_V(6); GP_BAR; GP_MMA(1, 1, At, B1); GP_BAR;
            GP_LDB(B0, 1, 0); GP_SCHED; GP_LDA(At, 1, 0); GP_STAGE_A(GP_SA(0, 1), a2, 1, un);
            GP_WAIT_L(8); GP_BAR; GP_WAIT_L(0); GP_MMA(0, 0, At, B0); GP_BAR; GP_SCHED;
            GP_LDB(B1, 1, 1); GP_STAGE_B(GP_SB(1, 0), b3, 0);
            GP_BAR; GP_WAIT_L(0); GP_MMA(0, 1, At, B1); GP_BAR;
            GP_LDA(At, 1, 1); GP_STAGE_A(GP_SA(1, 0), a3, 0, un);
            GP_BAR; GP_WAIT_L(0); GP_MMA(1, 0, At, B0); GP_BAR; GP_SCHED;
            GP_STAGE_B(GP_SB(1, 1), b3, 1);
            GP_WAIT_V(6); GP_BAR; GP_MMA(1, 1, At, B1); GP_BAR;
        }
        E(acc, cur, wr, wc, fr, fq);
        if (!has_next) break;
#pragma unroll
        for (int a = 0; a < 2; ++a)
#pragma unroll
            for (int b = 0; b < 2; ++b)
#pragma unroll
                for (int m = 0; m < 4; ++m)
#pragma unroll
                    for (int n = 0; n < 2; ++n) acc[a][b][m][n] = (f32x4){0.f, 0.f, 0.f, 0.f};
        cur = nxt; cA = nA; cB = nB; ++ui;
        if (GATHER) { cvo[0][0] = nvo[0][0]; cvo[0][1] = nvo[0][1]; cvo[1][0] = nvo[1][0]; cvo[1][1] = nvo[1][1]; }
    }
    GP_WAIT_V(0);
    if (wr == 0) GP_BAR;
    GP_BAR;
#undef GP_SA
#undef GP_SB
#undef GP_GLDS
#undef GP_STAGE_A
#undef GP_STAGE_B
#undef GP_LDA
#undef GP_LDB
#undef GP_MMA
#undef GP_WAIT_V
#undef GP_WAIT_L
#undef GP_BAR
#undef GP_SCHED
}

struct EpiF32 {
    float* C; int ldc;
    __device__ __forceinline__ void operator()(const f32x4 (&acc)[2][2][4][2], const Unit& u, int wr, int wc, int fr, int fq) const {
        const int row0 = u.r0 + wr * 64 + fr, col0 = u.c0 + wc * 32 + 4 * fq;
#pragma unroll
        for (int ai = 0; ai < 2; ++ai)
#pragma unroll
            for (int m = 0; m < 4; ++m) { float* rowp = C + (size_t)(row0 + ai * HALF + m * 16) * ldc + col0;
#pragma unroll
                for (int bj = 0; bj < 2; ++bj)
#pragma unroll
                    for (int n = 0; n < 2; ++n) *(f32x4*)(rowp + bj * HALF + n * 16) = acc[ai][bj][m][n];
                __builtin_amdgcn_sched_barrier(0); }
    }
};
struct EpiBf16 {
    bf16_t* O; int ldc;
    __device__ __forceinline__ void operator()(const f32x4 (&acc)[2][2][4][2], const Unit& u, int wr, int wc, int fr, int fq) const {
        const int row0 = u.r0 + wr * 64 + fr, col0 = u.c0 + wc * 32 + 8 * fq;
#pragma unroll
        for (int ai = 0; ai < 2; ++ai)
#pragma unroll
            for (int m = 0; m < 4; ++m) { bf16_t* rowp = O + (size_t)(row0 + ai * HALF + m * 16) * ldc + col0;
#pragma unroll
                for (int bj = 0; bj < 2; ++bj) { const f32x4 v0 = acc[ai][bj][m][0], v1 = acc[ai][bj][m][1];
                    u32x4 w; w.x = cvt_pk_bf16(v0[0], v0[1]); w.y = cvt_pk_bf16(v0[2], v0[3]); w.z = cvt_pk_bf16(v1[0], v1[1]); w.w = cvt_pk_bf16(v1[2], v1[3]);
                    *(u32x4*)(rowp + bj * HALF) = w; }
                __builtin_amdgcn_sched_barrier(0); }
    }
};
}


typedef float f32x4_l __attribute__((ext_vector_type(4)));
__device__ __forceinline__ void stage_gate_w(KP p, int e, LAS float* wl) {
    const int tid = opaque_tid();
    const float* wg = p->in[I_EWIN] + (size_t)e * 1024 * EVEN_N + 1536;
#pragma unroll
    for (int i = 0; i < 8; ++i) { const int idx = tid + 512 * i, d = idx >> 2, j4 = idx & 3; const float4 w = *(const float4*)(wg + (size_t)d * EVEN_N + j4 * 4); *(LAS f32x4_l*)(wl + d * 16 + j4 * 4) = (f32x4_l){w.x, w.y, w.z, w.w}; }
    __syncthreads();
}
__device__ __forceinline__ void ph_modin(KP p, int l, int bid, int nb) {
    const int tid = opaque_tid(), lane = tid & 63, wv = tid >> 6;
    const bool even = (l & 1) == 0;
    bf16_t* U = (bf16_t*)(p->ws + OFF_U);
    float* G = (float*)(p->ws + OFF_G);
    LAS float* wl = (LAS float*)smraw_base();
    if (even) stage_gate_w(p, l >> 1, wl);
    #pragma unroll 1
    for (int tok = bid * 8 + wv; tok < NT; tok += nb * 8) {
        const float* h = hrow(p, tok);
        const float* m = modrow(p, l, tok);
        float ga[16];
#pragma unroll
        for (int j = 0; j < 16; ++j) ga[j] = 0.f;
#pragma unroll
        for (int c = 0; c < 4; ++c) {
            const int d = 4 * (lane + 64 * c);
            const float4 hv = *(const float4*)(h + d), sh = *(const float4*)(m + d), sc = *(const float4*)(m + 1024 + d);
            const float u0 = hv.x * (1.f + sc.x) + sh.x, u1 = hv.y * (1.f + sc.y) + sh.y, u2 = hv.z * (1.f + sc.z) + sh.z, u3 = hv.w * (1.f + sc.w) + sh.w;
            *(uint2*)(U + (size_t)tok * DM + d) = make_uint2(cvt_pk_bf16(u0, u1), cvt_pk_bf16(u2, u3));
            if (even) {
                const float uu[4] = {u0, u1, u2, u3};
#pragma unroll
                for (int q = 0; q < 4; ++q) {
#pragma unroll
                    for (int j4 = 0; j4 < 4; ++j4) { const f32x4_l w = *(const LAS f32x4_l*)(wl + (d + q) * 16 + j4 * 4); ga[4 * j4] += uu[q] * w[0]; ga[4 * j4 + 1] += uu[q] * w[1]; ga[4 * j4 + 2] += uu[q] * w[2]; ga[4 * j4 + 3] += uu[q] * w[3]; }
                }
                __builtin_amdgcn_sched_barrier(0);
            }
        }
        if (even) {
            float mine = 0.f;
#pragma unroll
            for (int j = 0; j < 16; ++j) { const float s = wave_sum(ga[j]); if (lane == j) mine = s; }
            if (lane < 16) G[(size_t)tok * 16 + lane] = mine;
        }
    }
}

__device__ __forceinline__ void ph_gemm_in(KP p, int l, int bid, int nb, LAS unsigned char* lds) {
    const int N = ((l & 1) == 0) ? EVEN_LD : ODD_LD;
    gp::DenseSched S; S.init(p->ws + OFF_U, p->ws + OFF_WIN, NT, N, 1024, nb, bid);
    gp::EpiBf16 E{(bf16_t*)(p->ws + OFF_BIG), N};
    gp::gemm_phase<false, true>(lds, 1024, S, E);
}
__device__ __forceinline__ void ph_gemm_out(KP p, int l, int bid, int nb, LAS unsigned char* lds) {
    gp::DenseSched S; S.init(p->ws + OFF_U, p->ws + OFF_WOUT, NT, 1024, 1024, nb, bid);
    gp::EpiF32 E{(float*)(p->ws + OFF_BIG), 1024};
    gp::gemm_phase<false, false>(lds, 1024, S, E);
}


namespace sc {
typedef short bf16x8 __attribute__((ext_vector_type(8)));
typedef short bf16x4 __attribute__((ext_vector_type(4)));
typedef float f32x4 __attribute__((ext_vector_type(4)));
#define SC_MFMA(a, b, c) __builtin_amdgcn_mfma_f32_16x16x32_bf16(a, b, c, 0, 0, 0)
__device__ __forceinline__ bf16x8 rd_row(unsigned img, int row, int stride, int k0) { return *(const LAS bf16x8*)(size_t)(img + (unsigned)(row * stride + k0 * 2)); }
__device__ __forceinline__ bf16x8 rd_tr(unsigned img, int k0, int n0, int stride, int lane) {
    const int g = lane >> 4, i = lane & 15;
    const unsigned a0 = img + (unsigned)((k0 + 8 * g + (i >> 2)) * stride + (n0 + 4 * (i & 3)) * 2), a1 = a0 + 4u * (unsigned)stride;
    bf16x4 lo, hi;
    asm volatile("ds_read_b64_tr_b16 %0, %2\n\tds_read_b64_tr_b16 %1, %3\n\ts_waitcnt lgkmcnt(0)" : "=&v"(lo), "=&v"(hi) : "v"(a0), "v"(a1) : "memory");
    return (bf16x8){lo[0], lo[1], lo[2], lo[3], hi[0], hi[1], hi[2], hi[3]};
}
typedef unsigned u32x2_ __attribute__((ext_vector_type(2)));
typedef unsigned u32x4_ __attribute__((ext_vector_type(4)));
__device__ __forceinline__ void st8(unsigned addr, uint2 v) { *(LAS u32x2_*)(size_t)addr = (u32x2_){v.x, v.y}; }
__device__ __forceinline__ void st16(unsigned addr, uint4 v) { *(LAS u32x4_*)(size_t)addr = (u32x4_){v.x, v.y, v.z, v.w}; }
__device__ __forceinline__ float scan_add64(float v, int lane) {
#pragma unroll
    for (int o = 1; o < 64; o <<= 1) { const float t = __shfl_up(v, o, 64); if (lane >= o) v += t; }
    return v;
}
__device__ __forceinline__ float scan_max64(float v, int lane) {
#pragma unroll
    for (int o = 1; o < 64; o <<= 1) { const float t = __shfl_up(v, o, 64); if (lane >= o) v = fmaxf(v, t); }
    return v;
}

template <int MODE>
__device__ __forceinline__ void scan_item(KP p, int l, int b, int h, int dir, int vs) {
    constexpr int CS = (MODE == 1) ? 32 : 64, DK = (MODE == 0) ? 64 : 128, EXT = (MODE == 0) ? 1 : 0;
    constexpr int QS = (DK + 8) * 2, VS = (64 + 16 * EXT + 8) * 2, SS = (CS + 8) * 2, NVR = 64 + 16 * EXT;
    constexpr int NCH = (CTXL + SEQ) / CS;
    constexpr int LD = (MODE == 2) ? ODD_LD : EVEN_LD;
    constexpr unsigned O_QA = 0, O_KA = O_QA + CS * QS, O_QB = O_KA + CS * QS, O_KW = O_QB + (MODE == 1 ? CS * QS : 0), O_V = O_KW + CS * QS,
                       O_SSC = O_V + CS * VS, O_ST = O_SSC + CS * SS, O_DKV = O_ST + 2 * NVR * QS, O_END = O_DKV + 512;
    static_assert(O_END <= 131072, "scan LDS");
    const int tid = opaque_tid(), lane = tid & 63, wv = __builtin_amdgcn_readfirstlane(tid >> 6), r16 = lane & 15, q4 = lane >> 4;
    const unsigned L0 = (unsigned)(size_t)smraw_base();
    const bf16_t* P = (const bf16_t*)(p->ws + OFF_BIG);
    bf16_t* HXo = (bf16_t*)(p->ws + OFF_AUX) + (size_t)dir * NT * 1024;
    const int e2 = l >> 1;
    const int cQ = (MODE == 0) ? E_MQ + h * 64 : (MODE == 1) ? E_HQ + h * 128 : 1536 + h * 128;
    const int cK = (MODE == 0) ? E_MK + h * 64 : (MODE == 1) ? (dir ? E_HFB : E_HFF) + h * 128 : 2048 + h * 128;
    const int cV = (MODE == 0) ? E_MV + h * 128 + vs * 64 : (MODE == 1) ? E_HI + h * 128 + vs * 64 : 2560 + h * 128 + vs * 64;
    const int cO = (MODE == 0) ? h * 128 + vs * 64 : 512 + h * 128 + vs * 64;
    const int lt = (MODE == 1) ? (tid & 31) : (tid >> 3);
    const int lj = (MODE == 0) ? (tid & 7) : (MODE == 1) ? (tid >> 5) : ((tid >> 2) & 1) * 8 + (tid & 3);
    const int vt_ = tid >> 3, vj = tid & 7;
    float lbv[8]; float gbi = 0.f, gbf = 0.f, lg = 0.f;
    if (MODE == 1) {
        const float* lbp = (const float*)(p->ws + OFF_LB) + e2 * 512 + h * 128 + lj * 8;
#pragma unroll
        for (int i = 0; i < 8; ++i) lbv[i] = lbp[i];
    } else {
#pragma unroll
        for (int i = 0; i < 8; ++i) lbv[i] = 0.f;
    }
    if (MODE == 0) { const float* gb = p->in[I_MGB] + e2 * 16; gbi = gb[(dir ? 2 : 0) * 4 + h]; gbf = gb[(dir ? 3 : 1) * 4 + h]; }
    if (MODE == 2) lg = p->in[I_RLD][e2 * 8 + dir * 4 + h];
    const float* G = (const float*)(p->ws + OFF_G);
    const float* ropet = (const float*)(p->ws + OFF_ROPE);
    unsigned oz = 0u; asm volatile("" : "+v"(oz));
    for (unsigned o = tid * 16; o < 2u * NVR * QS; o += 512 * 16) st16(L0 + O_ST + o, make_uint4(oz, oz, oz, oz));
    if (EXT) { if (tid < CS) { st16(L0 + O_V + tid * VS + 128, make_uint4(0x3f80u | oz, oz, oz, oz)); st16(L0 + O_V + tid * VS + 144, make_uint4(oz, oz, oz, oz)); } }
    f32x4 sacc[4];
#pragma unroll
    for (int i = 0; i < 4; ++i) sacc[i] = (f32x4){0.f, 0.f, 0.f, 0.f};
    float m_in = -1e30f;
    uint4 rq0, rq1, rk0, rk1, rv; float rg0 = 0.f, rg1 = 0.f;
    rq1 = make_uint4(0u, 0u, 0u, 0u); rk1 = rq1;
    auto load_chunk = [&](int c) {
        const int i0 = c * CS;
        const int tq = scan_tok(b, i0 + lt, dir);
        const bf16_t* pr = P + (size_t)tq * LD;
        rq0 = *(const uint4*)(pr + cQ + lj * 8); rk0 = *(const uint4*)(pr + cK + lj * 8);
        if (MODE == 2) { rq1 = *(const uint4*)(pr + cQ + lj * 8 + 32); rk1 = *(const uint4*)(pr + cK + lj * 8 + 32); }
        if (MODE != 1 || tid < 256) { const int tv = scan_tok(b, i0 + vt_, dir); rv = *(const uint4*)(P + (size_t)tv * LD + cV + vj * 8); }
        if (MODE == 0) { const int tg = scan_tok(b, i0 + lane, dir); rg0 = G[(size_t)tg * 16 + (dir ? 8 : 0) + h]; rg1 = G[(size_t)tg * 16 + (dir ? 12 : 4) + h]; }
    };
    load_chunk(0);
#pragma unroll 1
    for (int c = 0; c < NCH; ++c) {
        const unsigned ST_R = L0 + O_ST + (unsigned)(c & 1) * NVR * QS, ST_W = L0 + O_ST + (unsigned)((c + 1) & 1) * NVR * QS;
        float sp = 1.f;
        float v_u = 0.f, v_M = 0.f, v_e = 1.f, v_low = 0.f, v_w = 1.f;
        if (MODE == 0) {
            const float ig = rg0 + gbi, fg = rg1 + gbf;
            const float lf = fminf(fg, 0.f) - flog(1.f + fexp(-fabsf(fg)));
            const float bb = scan_add64(lf, lane);
            const float g = __shfl(bb, 63, 64);
            v_u = ig - bb;
            const float cu = scan_max64(v_u, lane);
            v_M = fmaxf(m_in, cu);
            const float m_new = fmaxf(g + m_in, g + __shfl(cu, 63, 64));
            sp = fexp(g + m_in - m_new);
            v_w = fexp(g + v_u - m_new);
            v_e = fexp(m_in - v_M);
            v_low = fexp(-(bb + v_M));
            m_in = m_new;
            st16(L0 + O_QA + lt * QS + lj * 16, rq0);
            st16(L0 + O_KA + lt * QS + lj * 16, rk0);
            const float wr = __shfl(v_w, lt, 64);
            uint4 kw; kw.x = cvt_pk_bf16(bflo(rk0.x) * wr, bfhi(rk0.x) * wr); kw.y = cvt_pk_bf16(bflo(rk0.y) * wr, bfhi(rk0.y) * wr);
            kw.z = cvt_pk_bf16(bflo(rk0.z) * wr, bfhi(rk0.z) * wr); kw.w = cvt_pk_bf16(bflo(rk0.w) * wr, bfhi(rk0.w) * wr);
            st16(L0 + O_KW + lt * QS + lj * 16, kw);
            st16(L0 + O_V + vt_ * VS + vj * 16, rv);
        } else if (MODE == 2) {
            sp = fexp(64.f * lg);
            const bool lat = c >= CTXL / CS;
            float q[16], k[16];
            const unsigned qa[8] = {rq0.x, rq0.y, rq0.z, rq0.w, rq1.x, rq1.y, rq1.z, rq1.w}, ka[8] = {rk0.x, rk0.y, rk0.z, rk0.w, rk1.x, rk1.y, rk1.z, rk1.w};
#pragma unroll
            for (int i = 0; i < 8; ++i) { q[2 * i] = bflo(qa[i]); q[2 * i + 1] = bfhi(qa[i]); k[2 * i] = bflo(ka[i]); k[2 * i + 1] = bfhi(ka[i]); }
            if (lat) {
                const int tq = scan_tok(b, c * CS + lt, dir), tt = tq & (SEQ - 1);
                const int pos = ((tid >> 2) & 1) ? (tt & 63) : (tt >> 6);
                const float2* rt = (const float2*)ropet + pos * 32 + (tid & 3) * 8;
#pragma unroll
                for (int i = 0; i < 8; ++i) {
                    const float2 cs2 = rt[i];
                    const float q1 = q[i], q2 = q[8 + i], k1 = k[i], k2 = k[8 + i];
                    q[i] = q1 * cs2.x - q2 * cs2.y; q[8 + i] = q1 * cs2.y + q2 * cs2.x;
                    k[i] = k1 * cs2.x - k2 * cs2.y; k[8 + i] = k1 * cs2.y + k2 * cs2.x;
                }
            }
            const float wr = 0.08838834764831845f * fexp((float)(63 - lt) * lg);
            uint4 o0, o1, w0, w1, x0, x1;
            o0.x = cvt_pk_bf16(q[0], q[1]); o0.y = cvt_pk_bf16(q[2], q[3]); o0.z = cvt_pk_bf16(q[4], q[5]); o0.w = cvt_pk_bf16(q[6], q[7]);
            o1.x = cvt_pk_bf16(q[8], q[9]); o1.y = cvt_pk_bf16(q[10], q[11]); o1.z = cvt_pk_bf16(q[12], q[13]); o1.w = cvt_pk_bf16(q[14], q[15]);
            w0.x = cvt_pk_bf16(k[0], k[1]); w0.y = cvt_pk_bf16(k[2], k[3]); w0.z = cvt_pk_bf16(k[4], k[5]); w0.w = cvt_pk_bf16(k[6], k[7]);
            w1.x = cvt_pk_bf16(k[8], k[9]); w1.y = cvt_pk_bf16(k[10], k[11]); w1.z = cvt_pk_bf16(k[12], k[13]); w1.w = cvt_pk_bf16(k[14], k[15]);
            x0.x = cvt_pk_bf16(k[0] * wr, k[1] * wr); x0.y = cvt_pk_bf16(k[2] * wr, k[3] * wr); x0.z = cvt_pk_bf16(k[4] * wr, k[5] * wr); x0.w = cvt_pk_bf16(k[6] * wr, k[7] * wr);
            x1.x = cvt_pk_bf16(k[8] * wr, k[9] * wr); x1.y = cvt_pk_bf16(k[10] * wr, k[11] * wr); x1.z = cvt_pk_bf16(k[12] * wr, k[13] * wr); x1.w = cvt_pk_bf16(k[14] * wr, k[15] * wr);
            st16(L0 + O_QA + lt * QS + lj * 16, o0); st16(L0 + O_QA + lt * QS + lj * 16 + 64, o1);
            st16(L0 + O_KA + lt * QS + lj * 16, w0); st16(L0 + O_KA + lt * QS + lj * 16 + 64, w1);
            st16(L0 + O_KW + lt * QS + lj * 16, x0); st16(L0 + O_KW + lt * QS + lj * 16 + 64, x1);
            st16(L0 + O_V + vt_ * VS + vj * 16, rv);
        } else {
            const unsigned qa[4] = {rq0.x, rq0.y, rq0.z, rq0.w}, fa[4] = {rk0.x, rk0.y, rk0.z, rk0.w};
            float qv[8], kk[8], A[8];
#pragma unroll
            for (int i = 0; i < 8; ++i) {
                const float qr = (i & 1) ? bfhi(qa[i >> 1]) : bflo(qa[i >> 1]), fr = (i & 1) ? bfhi(fa[i >> 1]) : bflo(fa[i >> 1]);
                const float f = lbv[i] + (1.f - lbv[i]) * fsigmoid(fr);
                qv[i] = fsilu(qr); kk[i] = 1.f - f; A[i] = flog(f);
            }
#pragma unroll
            for (int o = 1; o < 32; o <<= 1)
#pragma unroll
                for (int i = 0; i < 8; ++i) { const float t = __shfl_up(A[i], o, 32); if (lt >= o) A[i] += t; }
            float qa_[8], qb_[8], ka_[8], kw_[8];
#pragma unroll
            for (int i = 0; i < 8; ++i) {
                const float am = __shfl(A[i], 15, 32), ae = __shfl(A[i], 31, 32);
                qa_[i] = qv[i] * fexp(A[i] - am); qb_[i] = qv[i] * fexp(A[i]); ka_[i] = kk[i] * fexp(am - A[i]); kw_[i] = kk[i] * fexp(ae - A[i]);
                if (lt == 31) *(LAS float*)(size_t)(L0 + O_DKV + (lj * 8 + i) * 4) = fexp(ae);
            }
            uint4 w;
            w.x = cvt_pk_bf16(qa_[0], qa_[1]); w.y = cvt_pk_bf16(qa_[2], qa_[3]); w.z = cvt_pk_bf16(qa_[4], qa_[5]); w.w = cvt_pk_bf16(qa_[6], qa_[7]); st16(L0 + O_QA + lt * QS + lj * 16, w);
            w.x = cvt_pk_bf16(qb_[0], qb_[1]); w.y = cvt_pk_bf16(qb_[2], qb_[3]); w.z = cvt_pk_bf16(qb_[4], qb_[5]); w.w = cvt_pk_bf16(qb_[6], qb_[7]); st16(L0 + O_QB + lt * QS + lj * 16, w);
            w.x = cvt_pk_bf16(ka_[0], ka_[1]); w.y = cvt_pk_bf16(ka_[2], ka_[3]); w.z = cvt_pk_bf16(ka_[4], ka_[5]); w.w = cvt_pk_bf16(ka_[6], ka_[7]); st16(L0 + O_KA + lt * QS + lj * 16, w);
            w.x = cvt_pk_bf16(kw_[0], kw_[1]); w.y = cvt_pk_bf16(kw_[2], kw_[3]); w.z = cvt_pk_bf16(kw_[4], kw_[5]); w.w = cvt_pk_bf16(kw_[6], kw_[7]); st16(L0 + O_KW + lt * QS + lj * 16, w);
            if (tid < 256) st16(L0 + O_V + vt_ * VS + vj * 16, rv);
        }
        __syncthreads();
        if (c + 1 < NCH) load_chunk(c + 1);
        {
            constexpr int NT1 = CS / 16;
            const bool act = (MODE == 1) ? (wv < 4) : true;
            const int tb = (MODE == 1) ? (wv & 1) : (wv & 3);
#pragma unroll
            for (int u2 = 0; u2 < ((MODE == 1) ? 1 : 2); ++u2) {
                const int sb = (MODE == 1) ? (wv >> 1) : 2 * (wv >> 2) + u2;
                if (act) {
                    f32x4 d = (f32x4){0.f, 0.f, 0.f, 0.f};
                    if (sb <= tb) {
#pragma unroll
                        for (int kk2 = 0; kk2 < DK / 32; ++kk2)
                            d = SC_MFMA(rd_row(L0 + O_KA, sb * 16 + r16, QS, kk2 * 32 + q4 * 8), rd_row(L0 + O_QA, tb * 16 + r16, QS, kk2 * 32 + q4 * 8), d);
                        const int t = tb * 16 + r16, s0 = sb * 16 + q4 * 4;
                        if (MODE == 0) {
                            const float Mt = __shfl(v_M, t, 64);
#pragma unroll
                            for (int jj = 0; jj < 4; ++jj) { const float us = __shfl(v_u, s0 + jj, 64); d[jj] = (s0 + jj <= t) ? d[jj] * 0.125f * fexp(us - Mt) : 0.f; }
                        } else if (MODE == 2) {
#pragma unroll
                            for (int jj = 0; jj < 4; ++jj) d[jj] = (s0 + jj <= t) ? d[jj] * 0.08838834764831845f * fexp((float)(t - s0 - jj) * lg) : 0.f;
                        } else {
#pragma unroll
                            for (int jj = 0; jj < 4; ++jj) d[jj] = (s0 + jj <= t) ? d[jj] : 0.f;
                        }
                    }
                    st8(L0 + O_SSC + (tb * 16 + r16) * SS + (sb * 16 + q4 * 4) * 2, make_uint2(cvt_pk_bf16(d[0], d[1]), cvt_pk_bf16(d[2], d[3])));
                }
            }
            (void)NT1;
        }
        __syncthreads();
        {
            const int tb = (MODE == 1) ? (wv & 1) : (wv & 3);
            const int t = tb * 16 + r16;
            const int tok = scan_tok(b, c * CS + t, dir);
            constexpr int NV = (MODE == 1) ? 1 : 2;
            f32x4 oi[NV + EXT], oo[NV + EXT];
#pragma unroll
            for (int u2 = 0; u2 < NV + EXT; ++u2) {
                const int vt = (u2 == NV) ? 4 : ((MODE == 1) ? (wv >> 1) : 2 * (wv >> 2) + u2);
                f32x4 a1 = (f32x4){0.f, 0.f, 0.f, 0.f}, a2 = a1;
#pragma unroll
                for (int sb2 = 0; sb2 < CS / 32; ++sb2)
                    a1 = SC_MFMA(rd_tr(L0 + O_V, sb2 * 32, vt * 16, VS, lane), rd_row(L0 + O_SSC, t, SS, sb2 * 32 + q4 * 8), a1);
#pragma unroll
                for (int kk2 = 0; kk2 < DK / 32; ++kk2)
                    a2 = SC_MFMA(rd_row(ST_R, vt * 16 + r16, QS, kk2 * 32 + q4 * 8), rd_row(L0 + ((MODE == 1) ? O_QB : O_QA), t, QS, kk2 * 32 + q4 * 8), a2);
                oi[u2] = a1; oo[u2] = a2;
            }
            float den = 1.f, ei = 1.f;
            if (MODE == 0) {
                ei = 0.125f * __shfl(v_e, t, 64);
                const float dsum = oi[NV][0] + ei * oo[NV][0];
                const float dd = __shfl(dsum, r16, 64);
                den = 1.f / fmaxf(fabsf(dd), __shfl(v_low, t, 64));
            } else if (MODE == 2) {
                ei = fexp((float)(t + 1) * lg);
            }
#pragma unroll
            for (int u2 = 0; u2 < NV; ++u2) {
                const int vt = (MODE == 1) ? (wv >> 1) : 2 * (wv >> 2) + u2;
                float o[4];
#pragma unroll
                for (int jj = 0; jj < 4; ++jj) o[jj] = (oi[u2][jj] + ei * oo[u2][jj]) * den;
                *(uint2*)(HXo + (size_t)tok * 1024 + cO + vt * 16 + q4 * 4) = make_uint2(cvt_pk_bf16(o[0], o[1]), cvt_pk_bf16(o[2], o[3]));
            }
        }
        {
            constexpr int NS = (MODE == 0) ? 3 : 4;
            const int kt = (MODE == 0) ? (wv & 3) : wv;
            float dk[4] = {sp, sp, sp, sp};
            if (MODE == 1) { const f32x4 dv = *(const LAS f32x4*)(size_t)(L0 + O_DKV + (kt * 16 + q4 * 4) * 4); dk[0] = dv[0]; dk[1] = dv[1]; dk[2] = dv[2]; dk[3] = dv[3]; }
#pragma unroll
            for (int u2 = 0; u2 < NS; ++u2) {
                const int vt = (MODE == 0) ? ((u2 == 2) ? 4 : 2 * (wv >> 2) + u2) : u2;
                f32x4 a = sacc[u2];
#pragma unroll
                for (int jj = 0; jj < 4; ++jj) a[jj] *= dk[jj];
#pragma unroll
                for (int sb2 = 0; sb2 < CS / 32; ++sb2)
                    a = SC_MFMA(rd_tr(L0 + O_KW, sb2 * 32, kt * 16, QS, lane), rd_tr(L0 + O_V, sb2 * 32, vt * 16, VS, lane), a);
                sacc[u2] = a;
                st8(ST_W + (vt * 16 + r16) * QS + (kt * 16 + q4 * 4) * 2, make_uint2(cvt_pk_bf16(a[0], a[1]), cvt_pk_bf16(a[2], a[3])));
            }
        }
        __syncthreads();
    }
}
}

__device__ __forceinline__ void ph_scan_even2(KP p, int l, int bid, int nb) {
#pragma unroll 1
    for (int item = bid; item < 256; item += nb) {
        const int kind = item >> 7, b = (item >> 4) & 7, h = (item >> 2) & 3, dir = (item >> 1) & 1, vs = item & 1;
        if (kind == 0) sc::scan_item<0>(p, l, b, h, dir, vs); else sc::scan_item<1>(p, l, b, h, dir, vs);
        __syncthreads();
    }
}
__device__ __forceinline__ void ph_scan_odd2(KP p, int l, int bid, int nb) {
#pragma unroll 1
    for (int item = bid; item < 128; item += nb) {
        const int b = (item >> 4) & 7, h = (item >> 2) & 3, dir = (item >> 1) & 1, vs = item & 1;
        sc::scan_item<2>(p, l, b, h, dir, vs);
        __syncthreads();
    }
}

__device__ __forceinline__ void unpack16(const uint4 a, const uint4 b, float (&x)[16]) {
    x[0] = bflo(a.x); x[1] = bfhi(a.x); x[2] = bflo(a.y); x[3] = bfhi(a.y); x[4] = bflo(a.z); x[5] = bfhi(a.z); x[6] = bflo(a.w); x[7] = bfhi(a.w);
    x[8] = bflo(b.x); x[9] = bfhi(b.x); x[10] = bflo(b.y); x[11] = bfhi(b.y); x[12] = bflo(b.z); x[13] = bfhi(b.z); x[14] = bflo(b.w); x[15] = bfhi(b.w);
}
__device__ __forceinline__ float sum8(float v) { v += __shfl_xor(v, 1, 64); v += __shfl_xor(v, 2, 64); v += __shfl_xor(v, 4, 64); return v; }
template <bool MEANSUB, bool SIG>
__device__ __forceinline__ void head_norm_gate16(const bf16_t* h0, const bf16_t* h1, const bf16_t* gp, const float* nw, bf16_t* out) {
    float a[16], b[16], g[16];
    unpack16(*(const uint4*)h0, *(const uint4*)(h0 + 8), a); unpack16(*(const uint4*)h1, *(const uint4*)(h1 + 8), b); unpack16(*(const uint4*)gp, *(const uint4*)(gp + 8), g);
    float s = 0.f;
#pragma unroll
    for (int i = 0; i < 16; ++i) { a[i] += b[i]; s += a[i]; }
    if (MEANSUB) { const float mean = sum8(s) * (1.f / 128.f);
#pragma unroll
        for (int i = 0; i < 16; ++i) a[i] -= mean; }
    float q = 0.f;
#pragma unroll
    for (int i = 0; i < 16; ++i) q += a[i] * a[i];
    const float r = rsqrtf(sum8(q) * (1.f / 128.f) + LN_EPS);
    unsigned w[8];
#pragma unroll
    for (int i = 0; i < 16; i += 2) {
        const float y0 = a[i] * r * nw[i] * (SIG ? sigmoidf_(g[i]) : siluf_(g[i])), y1 = a[i + 1] * r * nw[i + 1] * (SIG ? sigmoidf_(g[i + 1]) : siluf_(g[i + 1]));
        w[i >> 1] = cvt_pk_bf16(y0, y1);
    }
    *(uint4*)out = make_uint4(w[0], w[1], w[2], w[3]); *(uint4*)(out + 8) = make_uint4(w[4], w[5], w[6], w[7]);
}
__device__ __forceinline__ void ph_normgate_even(KP p, int l, int bid, int nb) {
    const int tid = opaque_tid(), lane = tid & 63, wv = tid >> 6;
    const bf16_t* P = (const bf16_t*)(p->ws + OFF_BIG);
    const bf16_t* HX = (const bf16_t*)(p->ws + OFF_AUX);
    const bf16_t* HX1 = HX + (size_t)NT * 1024;
    bf16_t* MIX = (bf16_t*)(p->ws + OFF_U);
    const int e = l >> 1;
    const bool ml = lane < 32;
    const float* nw = ml ? p->in[I_MNW] + e * 512 + 16 * lane : p->in[I_HNW] + e * 512 + 16 * (lane - 32);
    const int gcol = ml ? E_MO + 16 * lane : E_HG + 16 * (lane - 32);
#pragma unroll 1
    for (int tok = bid * 8 + wv; tok < NT; tok += nb * 8) {
        const size_t o = (size_t)tok * 1024 + 16 * lane;
        if (ml) head_norm_gate16<true, true>(HX + o, HX1 + o, P + (size_t)tok * EVEN_LD + gcol, nw, MIX + o);
        else head_norm_gate16<false, false>(HX + o, HX1 + o, P + (size_t)tok * EVEN_LD + gcol, nw, MIX + o);
    }
}

#define OFF_UT   (OFF_AUX + 136 * MiB)
#define OFF_FK   (OFF_UT + 102 * MiB)
#define OFF_FKC  (OFF_FK + 32 * MiB)
#define OFF_ZOT  (OFF_FKC + 2 * MiB)

__device__ __forceinline__ void ph_hy_filt2(KP p, int l, int bid, int nb, float* sm) {
    const int tid = opaque_tid(), o = l >> 1;
    float* zf = sm;
    float* h1 = sm + 1024;
    float* h2 = sm + 2048;
    float* h3 = sm + 3072;
    const float* fw1 = p->in[I_HW1] + o * 33 * 64; const float* fb1 = p->in[I_HB1] + o * 64;
    const float* fw2 = p->in[I_HW2] + o * 64 * 64; const float* fb2 = p->in[I_HB2] + o * 64;
    const float* fw3 = p->in[I_HW3] + o * 64 * 64; const float* fb3 = p->in[I_HB3] + o * 64;
    const float* freq = p->in[I_HFREQ] + o * 64;
    const float* wout = p->in[I_HWOUT] + (size_t)o * 64 * 2048;
    float* FK = (float*)(p->ws + OFF_FK); float* FKC = (float*)(p->ws + OFF_FKC);
#pragma unroll 1
    for (int item = bid; item < (SEQ + CTXL) / 16; item += nb) {
        const bool isctx = item >= SEQ / 16;
        const int L = isctx ? CTXL : SEQ, pos0 = (isctx ? item - SEQ / 16 : item) * 16;
        __syncthreads();
        if (tid < 16 * 17) {
            const int pp = tid / 17, j = tid % 17, pos = pos0 + pp;
            if (j == 16) zf[pp * 36] = (float)pos / (float)(L - 1);
            else { const float f = 1e-4f + (float)j * ((15.0f - 1e-4f) / 15.0f); const float w = 2.0f * 3.14159265358979323846f * (float)pos / (float)L * f; zf[pp * 36 + 1 + j] = cosf(w); zf[pp * 36 + 17 + j] = sinf(w); }
        }
        __syncthreads();
        const int pp = tid >> 5, u0 = (tid & 31) * 2;
        { float a0 = fb1[u0], a1 = fb1[u0 + 1];
#pragma unroll 1
          for (int k = 0; k < 33; ++k) { const float z = zf[pp * 36 + k]; a0 += z * fw1[k * 64 + u0]; a1 += z * fw1[k * 64 + u0 + 1]; }
          h1[pp * 64 + u0] = sinf(freq[u0] * a0); h1[pp * 64 + u0 + 1] = sinf(freq[u0 + 1] * a1); }
        __syncthreads();
        { float a0 = fb2[u0], a1 = fb2[u0 + 1];
#pragma unroll 4
          for (int k = 0; k < 64; ++k) { const float z = h1[pp * 64 + k]; a0 += z * fw2[k * 64 + u0]; a1 += z * fw2[k * 64 + u0 + 1]; }
          h2[pp * 64 + u0] = sinf(freq[u0] * a0); h2[pp * 64 + u0 + 1] = sinf(freq[u0 + 1] * a1); }
        __syncthreads();
        { float a0 = fb3[u0], a1 = fb3[u0 + 1];
#pragma unroll 4
          for (int k = 0; k < 64; ++k) { const float z = h2[pp * 64 + k]; a0 += z * fw3[k * 64 + u0]; a1 += z * fw3[k * 64 + u0 + 1]; }
          h3[pp * 64 + u0] = sinf(freq[u0] * a0); h3[pp * 64 + u0 + 1] = sinf(freq[u0 + 1] * a1); }
        __syncthreads();
#pragma unroll 1
        for (int r = 0; r < 4; ++r) {
            const int col = tid + 512 * r, c = col & 511, od = col >> 9, order = od >> 1, dirn = od & 1;
            float a[16];
#pragma unroll
            for (int i = 0; i < 16; ++i) a[i] = 0.f;
#pragma unroll 2
            for (int k = 0; k < 64; ++k) { const float w = wout[k * 2048 + col];
#pragma unroll
                for (int i = 0; i < 16; ++i) a[i] += h3[i * 64 + k] * w; }
            const float delta = 3.0701134573253944f + (float)c * ((15.350567286626972f - 3.0701134573253944f) / 511.0f);
#pragma unroll
            for (int i = 0; i < 16; ++i) a[i] *= expf(-((float)(pos0 + i) / (float)(L - 1)) * delta);
            float* dst = isctx ? FKC + ((size_t)order * 512 + c) * 512 + 256 : FK + ((size_t)order * 512 + c) * 8192 + 4096;
            if (dirn == 0) {
#pragma unroll
                for (int i = 0; i < 16; i += 4) *(float4*)(dst + pos0 + i) = make_float4(a[i], a[i + 1], a[i + 2], a[i + 3]);
            } else {
#pragma unroll
                for (int i = 0; i < 16; ++i) if (pos0 + i > 0) dst[-(pos0 + i)] = a[i];
                if (pos0 == 0) dst[-L] = 0.f;
            }
        }
    }
}

__device__ __forceinline__ void ph_hy_prep(KP p, int l, int bid, int nb, float* sm) {
    const int tid = opaque_tid(), o = l >> 1;
    const bf16_t* P = (const bf16_t*)(p->ws + OFF_BIG);
    bf16_t* UT = (bf16_t*)(p->ws + OFF_UT);
    const float* cw = p->in[I_HCW] + o * 3 * 1536; const float* cb = p->in[I_HCB] + o * 1536;
    float* tile = sm;
#pragma unroll 1
    for (int item = bid; item < (NT / 256) * 24; item += nb) {
        const int tt = item / 24, ct = item % 24, tok0 = tt * 256, col0 = ct * 64;
        const bool lat = tok0 < NL;
        const int L = lat ? SEQ : CTXL, t0 = lat ? (tok0 & (SEQ - 1)) : ((tok0 - NL) & (CTXL - 1));
        __syncthreads();
#pragma unroll 1
        for (int i = tid; i < 258 * 8; i += 512) {
            const int rr = i >> 3, hf = i & 7, t = t0 + rr - 1;
            uint4 v = make_uint4(0u, 0u, 0u, 0u);
            if (t >= 0 && t < L) v = *(const uint4*)(P + (size_t)(tok0 + rr - 1) * ODD_LD + col0 + hf * 8);
            float* d = tile + rr * 65 + hf * 8;
            d[0] = bflo(v.x); d[1] = bfhi(v.x); d[2] = bflo(v.y); d[3] = bfhi(v.y); d[4] = bflo(v.z); d[5] = bfhi(v.z); d[6] = bflo(v.w); d[7] = bfhi(v.w);
        }
        __syncthreads();
#pragma unroll 1
        for (int r = 0; r < 4; ++r) {
            const int cc = (tid >> 5) + 16 * r, tc = (tid & 31) * 8, col = col0 + cc;
            const float w0 = cw[col], w1 = cw[1536 + col], w2 = cw[3072 + col], bb = cb[col];
            float y[8];
#pragma unroll
            for (int i = 0; i < 8; ++i) y[i] = tile[(tc + i) * 65 + cc] * w0 + tile[(tc + i + 1) * 65 + cc] * w1 + tile[(tc + i + 2) * 65 + cc] * w2 + bb;
            *(uint4*)(UT + (size_t)col * NT + tok0 + tc) = make_uint4(cvt_pk_bf16(y[0], y[1]), cvt_pk_bf16(y[2], y[3]), cvt_pk_bf16(y[4], y[5]), cvt_pk_bf16(y[6], y[7]));
        }
    }
}

__device__ __forceinline__ void hy_item_lat(KP p, int l, int c) {
    constexpr int ZSB = (SEQ + 8) * 2;
    constexpr unsigned O_Z = 0, O_KF = O_Z + 8 * ZSB, O_END = O_KF + 8192 * 4;
    static_assert(O_END <= BAR_LDS_, "hyena LDS");
    const int tid = opaque_tid(), lane = tid & 63, wv = __builtin_amdgcn_readfirstlane(tid >> 6), r16 = lane & 15, q4 = lane >> 4, o = l >> 1;
    const unsigned L0 = (unsigned)(size_t)smraw_base();
    const bf16_t* UT = (const bf16_t*)(p->ws + OFF_UT);
    bf16_t* ZOT = (bf16_t*)(p->ws + OFF_ZOT);
    const float* FK = (const float*)(p->ws + OFF_FK);
    for (int i = tid; i < 8 * 512; i += 512) { const int b = i >> 9, ch = i & 511; sc::st16(L0 + O_Z + b * ZSB + ch * 16, *(const uint4*)(UT + (size_t)(1024 + c) * NT + b * SEQ + ch * 8)); }
#pragma unroll 1
    for (int order = 0; order < 2; ++order) {
        const float* fk = FK + ((size_t)order * 512 + c) * 8192;
        for (int i = tid; i < 2048; i += 512) { const float4 v = *(const float4*)(fk + i * 4); *(LAS sc::f32x4*)(size_t)(L0 + O_KF + i * 16) = (sc::f32x4){v.x, v.y, v.z, v.w}; }
        __syncthreads();
        sc::f32x4 acc[4][4];
#pragma unroll
        for (int a = 0; a < 4; ++a)
#pragma unroll
            for (int b2 = 0; b2 < 4; ++b2) acc[a][b2] = (sc::f32x4){0.f, 0.f, 0.f, 0.f};
        auto ldG = [&](int g) {
            const unsigned a0 = L0 + O_KF + (unsigned)(4096 + 16 * g + r16 - 8 * q4) * 4u;
            float v[8];
#pragma unroll
            for (int j = 0; j < 8; ++j) v[j] = *(const LAS float*)(size_t)(a0 - 4u * j);
            const unsigned w0 = cvt_pk_bf16(v[0], v[1]), w1 = cvt_pk_bf16(v[2], v[3]), w2 = cvt_pk_bf16(v[4], v[5]), w3 = cvt_pk_bf16(v[6], v[7]);
            return __builtin_bit_cast(sc::bf16x8, (sc::u32x4_){w0, w1, w2, w3});
        };
        sc::bf16x8 bq[4][2], W[6];
#pragma unroll
        for (int i = 0; i < 4; ++i) { bq[i][0] = (sc::bf16x8){0, 0, 0, 0, 0, 0, 0, 0}; bq[i][1] = bq[i][0]; }
        const int D0 = 8 * wv - 63, D1 = (8 * wv + 7 < 63) ? 8 * wv + 7 : 63;
        W[4] = ldG(4 * D0 - 6 + 4); W[5] = ldG(4 * D0 - 6 + 5);
#pragma unroll 1
        for (int D = D0; D <= D1; ++D) {
            W[0] = W[4]; W[1] = W[5];
#pragma unroll
            for (int i = 0; i < 4; ++i) W[2 + i] = ldG(4 * D + i);
            bq[3][0] = bq[2][0]; bq[3][1] = bq[2][1]; bq[2][0] = bq[1][0]; bq[2][1] = bq[1][1]; bq[1][0] = bq[0][0]; bq[1][1] = bq[0][1];
            {
                const int s1 = 8 * wv - D + ((r16 < 8) ? 0 : 4);
                const bool ok = (unsigned)s1 < 64u;
                const unsigned za = L0 + O_Z + (unsigned)((r16 & 7) * ZSB + ((ok ? s1 : 0) * 64 + q4 * 8) * 2);
                sc::bf16x8 b0 = *(const LAS sc::bf16x8*)(size_t)za, b1 = *(const LAS sc::bf16x8*)(size_t)(za + 64);
                if (!ok) { b0 = (sc::bf16x8){0, 0, 0, 0, 0, 0, 0, 0}; b1 = b0; }
                bq[0][0] = b0; bq[0][1] = b1;
            }
#pragma unroll
            for (int cg = 0; cg < 4; ++cg) {
                const int sA = 8 * wv + cg - D;
                if ((unsigned)sA < 64u || (unsigned)(sA + 4) < 64u) {
#pragma unroll
                    for (int it = 0; it < 4; ++it) { acc[cg][it] = SC_MFMA(W[it + 2], bq[cg][0], acc[cg][it]); acc[cg][it] = SC_MFMA(W[it], bq[cg][1], acc[cg][it]); }
                }
            }
        }
        __syncthreads();
        const float sk = p->in[I_HSKIP][o * 1024 + order * 512 + c];
        const bf16_t* gt = UT + (size_t)(order * 512 + c) * NT;
        const int bb = r16 & 7;
#pragma unroll
        for (int cg = 0; cg < 4; ++cg) {
            const int t1 = 8 * wv + cg + ((r16 < 8) ? 0 : 4);
#pragma unroll
            for (int it = 0; it < 4; ++it) {
                const int t = t1 * 64 + it * 16 + q4 * 4;
                const sc::u32x2_ zo_ = *(const LAS sc::u32x2_*)(size_t)(L0 + O_Z + bb * ZSB + t * 2); const uint2 zo = make_uint2(zo_[0], zo_[1]);
                const uint2 gv = *(const uint2*)(gt + bb * SEQ + t);
                const float y0 = bflo(gv.x) * (acc[cg][it][0] + sk * bflo(zo.x)), y1 = bfhi(gv.x) * (acc[cg][it][1] + sk * bfhi(zo.x));
                const float y2 = bflo(gv.y) * (acc[cg][it][2] + sk * bflo(zo.y)), y3 = bfhi(gv.y) * (acc[cg][it][3] + sk * bfhi(zo.y));
                const uint2 w = make_uint2(cvt_pk_bf16(y0, y1), cvt_pk_bf16(y2, y3));
                if (order == 0) sc::st8(L0 + O_Z + bb * ZSB + t * 2, w);
                else *(uint2*)(ZOT + (size_t)c * NT + bb * SEQ + t) = w;
            }
        }
        __syncthreads();
    }
}

__device__ __forceinline__ void hy_item_ctx(KP p, int l, int c, float* sm) {
    const int tid = opaque_tid(), o = l >> 1;
    const bf16_t* UT = (const bf16_t*)(p->ws + OFF_UT);
    bf16_t* ZOT = (bf16_t*)(p->ws + OFF_ZOT);
    const float* FKC = (const float*)(p->ws + OFF_FKC);
    float* Kc = sm;
    float* zb = sm + 1024;
    for (int i = tid; i < 1024; i += 512) Kc[i] = FKC[((size_t)(i >> 9) * 512 + c) * 512 + (i & 511)];
    for (int i = tid; i < 8 * CTXL; i += 512) zb[i] = bf2f(UT[(size_t)(1024 + c) * NT + NL + i]);
    __syncthreads();
    const int bb = tid >> 6, tl = tid & 63;
#pragma unroll 1
    for (int order = 0; order < 2; ++order) {
        float acc[4] = {0.f, 0.f, 0.f, 0.f};
#pragma unroll 4
        for (int s = 0; s < CTXL; ++s) {
            const float zv = zb[bb * CTXL + s];
#pragma unroll
            for (int i = 0; i < 4; ++i) acc[i] += Kc[order * 512 + tl + 64 * i - s + 256] * zv;
        }
        const float sk = p->in[I_HSKIP][o * 1024 + order * 512 + c];
        float zn[4];
#pragma unroll
        for (int i = 0; i < 4; ++i) { const int t = tl + 64 * i; zn[i] = bf2f(UT[(size_t)(order * 512 + c) * NT + NL + bb * CTXL + t]) * (acc[i] + zb[bb * CTXL + t] * sk); }
        __syncthreads();
#pragma unroll
        for (int i = 0; i < 4; ++i) { const int t = tl + 64 * i; if (order == 0) zb[bb * CTXL + t] = bf2f((bf16_t)(cvt_pk_bf16(zn[i], 0.f) & 0xffffu)); else stf(ZOT + (size_t)c * NT + NL + bb * CTXL + t, zn[i]); }
        __syncthreads();
    }
}

__device__ __forceinline__ void ph_mix_odd(KP p, int l, int bid, int nb, float* sm) {
    int* head = (int*)(p->ws + OFF_CNT) + 1024 + (l >> 1) * 64;
    LAS int* slot = (LAS int*)(smraw_base() + BAR_LDS_ + 64);
#pragma unroll 1
    for (;;) {
        if (opaque_tid() == 0) *slot = atomicAdd(head, 1);
        __syncthreads();
        const int item = *slot;
        __syncthreads();
        if (item >= 128 + 512) break;
        if (item < 128) { const int b = (item >> 4) & 7, h = (item >> 2) & 3, dir = (item >> 1) & 1, vs = item & 1; sc::scan_item<2>(p, l, b, h, dir, vs); }
        else { const int c = item - 128; hy_item_lat(p, l, c); __syncthreads(); hy_item_ctx(p, l, c, sm); }
        __syncthreads();
    }
}

__device__ __forceinline__ void ph_hy_norm(KP p, int l, int bid, int nb, float* sm) {
    const int tid = opaque_tid(), o = l >> 1;
    const bf16_t* ZOT = (const bf16_t*)(p->ws + OFF_ZOT);
    bf16_t* MIX = (bf16_t*)(p->ws + OFF_U);
    const float* nw = p->in[I_HNORM] + o * 512;
    float* tile = sm;
    float* part = sm + 64 * 65;
#pragma unroll 1
    for (int item = bid; item < (NT / 64) * 8; item += nb) {
        const int tt = item >> 3, g = item & 7, tok0 = tt * 64;
        __syncthreads();
        { const int cc = tid >> 3, ch = tid & 7;
          const uint4 v = *(const uint4*)(ZOT + (size_t)(g * 64 + cc) * NT + tok0 + ch * 8);
          float* d = tile + cc * 65 + ch * 8;
          d[0] = bflo(v.x); d[1] = bfhi(v.x); d[2] = bflo(v.y); d[3] = bfhi(v.y); d[4] = bflo(v.z); d[5] = bfhi(v.z); d[6] = bflo(v.w); d[7] = bfhi(v.w); }
        __syncthreads();
        { const int tk = tid & 63, pt = tid >> 6; float s = 0.f;
#pragma unroll
          for (int i = 0; i < 8; ++i) { const float x = tile[(pt * 8 + i) * 65 + tk]; s += x * x; }
          part[pt * 64 + tk] = s; }
        __syncthreads();
        { const int tk = tid >> 3, ch = tid & 7; float s = 0.f;
#pragma unroll
          for (int i = 0; i < 8; ++i) s += part[i * 64 + tk];
          const float rs = rsqrtf(s * (1.f / 64.f) + LN_EPS);
          float y[8];
#pragma unroll
          for (int i = 0; i < 8; ++i) y[i] = tile[(ch * 8 + i) * 65 + tk] * rs * nw[g * 64 + ch * 8 + i];
          *(uint4*)(MIX + (size_t)(tok0 + tk) * DM + g * 64 + ch * 8) = make_uint4(cvt_pk_bf16(y[0], y[1]), cvt_pk_bf16(y[2], y[3]), cvt_pk_bf16(y[4], y[5]), cvt_pk_bf16(y[6], y[7])); }
    }
}

__device__ __forceinline__ void ph_normgate_odd(KP p, int l, int bid, int nb) {
    const int tid = opaque_tid(), lane = tid & 63, wv = tid >> 6, o2 = l >> 1;
    const bf16_t* P = (const bf16_t*)(p->ws + OFF_BIG);
    const bf16_t* HX = (const bf16_t*)(p->ws + OFF_AUX);
    const bf16_t* HX1 = HX + (size_t)NT * 1024;
    bf16_t* MIX = (bf16_t*)(p->ws + OFF_U);
    const int c16 = 16 * (lane & 31);
    const float* nw = p->in[I_RNW] + o2 * 512 + c16;
#pragma unroll 1
    for (int t2 = bid * 8 + wv; t2 < NT / 2; t2 += nb * 8) {
        const int tok = t2 * 2 + (lane >> 5);
        const size_t o = (size_t)tok * 1024 + 512 + c16;
        head_norm_gate16<true, false>(HX + o, HX1 + o, P + (size_t)tok * ODD_LD + 3072 + c16, nw, MIX + o);
    }
}

__device__ __forceinline__ void ph_ln1_router(KP p, int l, int ntok, int bid, int nb, float* sm) {
    const int tid = opaque_tid(), lane = tid & 63, wv = __builtin_amdgcn_readfirstlane(tid >> 6);
    const float* Y = (const float*)(p->ws + OFF_BIG);
    bf16_t* U = (bf16_t*)(p->ws + OFF_U);
    const float* lw = p->in[I_LNW] + (l * 2) * 1024; const float* lb = p->in[I_LNB] + (l * 2) * 1024;
    const float* rw = p->in[I_RW] + (size_t)l * 1024 * 64;
    const float rb = p->in[I_RB][l * 64 + lane];
    LAS int* lcnt = (LAS int*)(smraw_base() + BAR_LDS_ + 256);
    if (tid < 64) lcnt[tid] = 0;
    __syncthreads();
    int* tidx = (int*)(p->ws + OFF_TIDX); float* tgate = (float*)(p->ws + OFF_TGATE); int* tpos = (int*)(p->ws + OFF_TPOS);
    LAS float* Vall = (LAS float*)smraw_base();
    {
        int* stok = (int*)(p->ws + OFF_STOK); float* sgate = (float*)(p->ws + OFF_SGATE); int* sdst = (int*)(p->ws + OFF_SDST);
#pragma unroll 1
        for (int i = bid * 512 + tid; i < MAXROWS; i += nb * 512) { stok[i] = ZROW; sgate[i] = 0.f; sdst[i] = -1; }
    }
#pragma unroll 1
    for (int base = bid * 32; base < ntok; base += nb * 32) {
#pragma unroll 2
        for (int j = 0; j < 4; ++j) {
            const int tok = base + wv * 4 + j;
            float* h = hrow(p, tok);
            const float* m = modrow(p, l, tok);
            const float* r = Y + (size_t)tok * DM;
            float x[16]; float s = 0.f;
#pragma unroll
            for (int c = 0; c < 4; ++c) {
                const int d = 4 * (lane + 64 * c);
                const float4 hv = *(const float4*)(h + d), gv = *(const float4*)(m + 2 * 1024 + d), rv = *(const float4*)(r + d);
                x[4 * c] = ALPHA * hv.x + gv.x * rv.x; x[4 * c + 1] = ALPHA * hv.y + gv.y * rv.y; x[4 * c + 2] = ALPHA * hv.z + gv.z * rv.z; x[4 * c + 3] = ALPHA * hv.w + gv.w * rv.w;
                s += x[4 * c] + x[4 * c + 1] + x[4 * c + 2] + x[4 * c + 3];
            }
            const float mean = wave_sum(s) * (1.f / 1024.f);
            float q = 0.f;
#pragma unroll
            for (int i = 0; i < 16; ++i) { x[i] -= mean; q += x[i] * x[i]; }
            const float rs = rsqrtf(wave_sum(q) * (1.f / 1024.f) + LN_EPS);
#pragma unroll
            for (int c = 0; c < 4; ++c) {
                const int d = 4 * (lane + 64 * c);
                const float4 w4 = *(const float4*)(lw + d), b4 = *(const float4*)(lb + d), sh = *(const float4*)(m + 3 * 1024 + d), sc = *(const float4*)(m + 4 * 1024 + d);
                float4 y; y.x = x[4 * c] * rs * w4.x + b4.x; y.y = x[4 * c + 1] * rs * w4.y + b4.y; y.z = x[4 * c + 2] * rs * w4.z + b4.z; y.w = x[4 * c + 3] * rs * w4.w + b4.w;
                *(float4*)(h + d) = y;
                float4 v; v.x = y.x * (1.f + sc.x) + sh.x; v.y = y.y * (1.f + sc.y) + sh.y; v.z = y.z * (1.f + sc.z) + sh.z; v.w = y.w * (1.f + sc.w) + sh.w;
                *(uint2*)(U + (size_t)tok * DM + d) = make_uint2(cvt_pk_bf16(v.x, v.y), cvt_pk_bf16(v.z, v.w));
                *(LAS sc::f32x4*)(Vall + (wv * 4 + j) * 1024 + d) = (sc::f32x4){v.x, v.y, v.z, v.w};
            }
        }
        __syncthreads();
        float a[32];
#pragma unroll
        for (int t = 0; t < 32; ++t) a[t] = 0.f;
#pragma unroll 1
        for (int d = wv * 128; d < wv * 128 + 128; d += 4) {
            const float w0 = rw[(d + 0) * 64 + lane], w1 = rw[(d + 1) * 64 + lane], w2 = rw[(d + 2) * 64 + lane], w3 = rw[(d + 3) * 64 + lane];
#pragma unroll
            for (int t = 0; t < 32; ++t) { const sc::f32x4 v = *(const LAS sc::f32x4*)(Vall + t * 1024 + d); a[t] += v[0] * w0 + v[1] * w1 + v[2] * w2 + v[3] * w3; }
        }
        __syncthreads();
#pragma unroll
        for (int t = 0; t < 32; ++t) Vall[(wv * 32 + t) * 64 + lane] = a[t];
        __syncthreads();
#pragma unroll 1
        for (int j = 0; j < 4; ++j) {
            const int tl = wv * 4 + j, tok = base + tl;
            float lg = 0.f;
#pragma unroll
            for (int w = 0; w < 8; ++w) lg += Vall[(w * 32 + tl) * 64 + lane];
            const float score = sigmoidf_(lg);
            const float key = score + rb;
            int rank = 0;
#pragma unroll
            for (int e = 0; e < 64; ++e) { const float ke = __builtin_bit_cast(float, __builtin_amdgcn_readlane(__builtin_bit_cast(int, key), e)); rank += (ke > key || (ke == key && e < lane)) ? 1 : 0; }
            const bool sel = rank < TOPK;
            const float gsum = wave_sum(sel ? score : 0.f);
            if (sel) {
                const int pos = __hip_atomic_fetch_add(lcnt + lane, 1, __ATOMIC_RELAXED, __HIP_MEMORY_SCOPE_WORKGROUP);
                tidx[tok * 8 + rank] = lane; tgate[tok * 8 + rank] = 2.5f * score / gsum; tpos[tok * 8 + rank] = pos;
            }
        }
        __syncthreads();
    }
    __syncthreads();
    if (tid < 64) ((int*)(p->ws + OFF_BCNT))[bid * 64 + tid] = lcnt[tid];
}

__device__ __forceinline__ void moe_offsets(KP p, int l, int ntok, LAS int* offs) {
    const int t = opaque_tid();
    if (t < 66) offs[t] = ((const int*)(p->ws + OFF_GOFFS))[t];
    __syncthreads();
}
__device__ __forceinline__ int moe_expert_of(const LAS int* offs, int row) { int e = 0;
#pragma unroll 1
    while (e < 64 && row >= offs[e + 1]) ++e;
    return e; }

__device__ __forceinline__ void ph_scatter(KP p, int l, int ntok, int bid, int nb, LAS unsigned char* lds) {
    LAS int* offs = (LAS int*)lds;
    LAS int* myb = offs + 128;
    LAS int* part = offs + 256;
    const int tid = opaque_tid();
    const int* bcnt = (const int*)(p->ws + OFF_BCNT);
    { const int e = tid & 63, pt = tid >> 6; int tot = 0, mine = 0;
#pragma unroll 4
      for (int b = pt; b < nb; b += 8) { const int c = bcnt[b * 64 + e]; tot += c; mine += (b < bid) ? c : 0; }
      part[pt * 64 + e] = tot; part[512 + pt * 64 + e] = mine; }
    __syncthreads();
    if (tid < 64) {
        int tot = 0, mine = 0;
#pragma unroll
        for (int i = 0; i < 8; ++i) { tot += part[i * 64 + tid]; mine += part[512 + i * 64 + tid]; }
        const int pc = (tot + 255) & ~255;
        int incl = pc;
#pragma unroll
        for (int o = 1; o < 64; o <<= 1) { const int t = __shfl_up(incl, o, 64); if (tid >= o) incl += t; }
        offs[tid] = incl - pc; myb[tid] = mine;
        if (tid == 63) { offs[64] = incl; offs[65] = incl + ntok; }
    }
    __syncthreads();
    if (bid == 0 && tid < 66) ((int*)(p->ws + OFF_GOFFS))[tid] = offs[tid];
    const int* tidx = (const int*)(p->ws + OFF_TIDX); const float* tgate = (const float*)(p->ws + OFF_TGATE); const int* tpos = (const int*)(p->ws + OFF_TPOS);
    int* stok = (int*)(p->ws + OFF_STOK); float* sgate = (float*)(p->ws + OFF_SGATE); int* sdst = (int*)(p->ws + OFF_SDST);
    int* tile_e = (int*)(p->ws + OFF_TILEE);
#pragma unroll 1
    for (int base = bid * 32; base < ntok; base += nb * 32) {
        if (tid < 32 * 9) {
            const int tok = base + tid / 9, sl = tid % 9;
            if (sl < 8) { const int i = tok * 8 + sl, e = tidx[i], row = offs[e] + myb[e] + tpos[i]; stok[row] = tok; sgate[row] = tgate[i]; sdst[row] = tok * 9 + sl; }
            else { const int row = offs[64] + tok; stok[row] = tok; sgate[row] = 1.f; sdst[row] = tok * 9 + 8; }
        }
    }
    const int nrt = offs[65] >> 8;
#pragma unroll 1
    for (int rt = bid * 512 + tid; rt < nrt; rt += nb * 512) tile_e[rt] = moe_expert_of(offs, rt * 256);
    __syncthreads();
}

#define MOE_TAB (gp::STAGE_BYTES + 256)
#define MOE_MAXT 8
struct Moe1Sched {
    const char* U; const char* W; const LAS int* tabE; const LAS int* tabS; int u0, u1, rt0;
    __device__ __forceinline__ bool next(int i, gp::Unit& u) const {
        const int uu = u0 + i; if (uu >= u1) return false;
        const int rt = uu >> 1, j = rt - rt0;
        u.A = U; u.B = W + (size_t)tabE[j] * (512 * 1024 * 2) + (size_t)(uu & 1) * (256 * 1024 * 2); u.r0 = rt * 256; u.c0 = (uu & 1) * 256; u.aux = j; return true;
    }
    __device__ __forceinline__ void lane_off(const gp::Unit& u, unsigned (&vo)[2][2]) const {
        const int tid = opaque_tid(); int R0, C0, R1, C1; gp::stage_rc(tid * 16, R0, C0); gp::stage_rc(tid * 16 + 8192, R1, C1);
        const LAS int* t = tabS + u.aux * 256;
        vo[0][0] = (unsigned)t[R0] * 2048u + (unsigned)C0 * 2u; vo[0][1] = (unsigned)t[R1] * 2048u + (unsigned)C1 * 2u;
        vo[1][0] = (unsigned)t[128 + R0] * 2048u + (unsigned)C0 * 2u; vo[1][1] = (unsigned)t[128 + R1] * 2048u + (unsigned)C1 * 2u;
    }
};
struct EpiH {
    bf16_t* H;
    __device__ __forceinline__ void operator()(const gp::f32x4 (&acc)[2][2][4][2], const gp::Unit& u, int wr, int wc, int fr, int fq) const {
        const int row0 = u.r0 + wr * 64 + fr;
#pragma unroll
        for (int ai = 0; ai < 2; ++ai)
#pragma unroll
            for (int m = 0; m < 4; ++m) { bf16_t* rowp = H + (size_t)(row0 + ai * 128 + m * 16) * 256;
#pragma unroll
                for (int bj = 0; bj < 2; ++bj) {
                    const int j0 = ((u.c0 + bj * 128 + wc * 32) >> 5) * 16 + 4 * fq;
                    const gp::f32x4 a = acc[ai][bj][m][0], b = acc[ai][bj][m][1];
                    const float h0 = siluf_(a[0]) * b[0], h1 = siluf_(a[1]) * b[1], h2 = siluf_(a[2]) * b[2], h3 = siluf_(a[3]) * b[3];
                    *(uint2*)(rowp + j0) = make_uint2(cvt_pk_bf16(h0, h1), cvt_pk_bf16(h2, h3)); }
                __builtin_amdgcn_sched_barrier(0); }
    }
};
__device__ __forceinline__ void ph_moe1(KP p, int l, int ntok, int bid, int nb, LAS unsigned char* lds) {
    LAS int* offs = (LAS int*)(lds + MOE_TAB);
    LAS int* tabE = offs + 128;
    LAS int* tabS = offs + 256;
    moe_offsets(p, l, ntok, offs);
    const int tid = opaque_tid();
    const int nrt = offs[65] >> 8, total = nrt * 2;
    const int u0 = (int)(((long)bid * total) / nb), u1 = (int)(((long)(bid + 1) * total) / nb);
    const int rt0 = u0 >> 1, nper = (u1 > u0) ? (((u1 - 1) >> 1) - rt0 + 1) : 0;
    const int* stok = (const int*)(p->ws + OFF_STOK); const int* tile_e = (const int*)(p->ws + OFF_TILEE);
    for (int i = tid; i < nper * 256; i += 512) tabS[i] = stok[(size_t)(rt0 + (i >> 8)) * 256 + (i & 255)];
    if (tid < nper) tabE[tid] = tile_e[rt0 + tid];
    __syncthreads();
    Moe1Sched S{(const char*)(p->ws + OFF_U), (const char*)(p->ws + OFF_W13), tabE, tabS, u0, u1, rt0};
    EpiH E{(bf16_t*)(p->ws + OFF_BIG)};
    gp::gemm_phase<true, false>(lds, 1024, S, E);
}

struct Moe2Sched {
    const char* H; const char* W; const LAS int* tabE; int u0, u1, rt0;
    __device__ __forceinline__ bool next(int i, gp::Unit& u) const {
        const int uu = u0 + i; if (uu >= u1) return false;
        const int rt = uu >> 2, j = rt - rt0;
        u.A = H + (size_t)rt * (256 * 256 * 2); u.B = W + (size_t)tabE[j] * (1024 * 256 * 2) + (size_t)(uu & 3) * (256 * 256 * 2); u.r0 = j * 256; u.c0 = (uu & 3) * 256; u.aux = j; return true;
    }
    __device__ __forceinline__ void lane_off(const gp::Unit&, unsigned (&)[2][2]) const {}
};
struct EpiY {
    bf16_t* Ys; const LAS int* tabD; const LAS float* tabG;
    __device__ __forceinline__ void operator()(const gp::f32x4 (&acc)[2][2][4][2], const gp::Unit& u, int wr, int wc, int fr, int fq) const {
        const int rl0 = u.r0 + wr * 64 + fr, col0 = u.c0 + wc * 32 + 8 * fq;
#pragma unroll
        for (int ai = 0; ai < 2; ++ai)
#pragma unroll
            for (int m = 0; m < 4; ++m) {
                const int rl = rl0 + ai * 128 + m * 16;
                const int dst = tabD[rl]; const float g = tabG[rl];
                if (dst >= 0) { bf16_t* rowp = Ys + (size_t)dst * 1024 + col0;
#pragma unroll
                    for (int bj = 0; bj < 2; ++bj) { const gp::f32x4 v0 = acc[ai][bj][m][0] * g, v1 = acc[ai][bj][m][1] * g;
                        gp::u32x4 w; w.x = cvt_pk_bf16(v0[0], v0[1]); w.y = cvt_pk_bf16(v0[2], v0[3]); w.z = cvt_pk_bf16(v1[0], v1[1]); w.w = cvt_pk_bf16(v1[2], v1[3]);
                        *(gp::u32x4*)(rowp + bj * 128) = w; } }
                __builtin_amdgcn_sched_barrier(0); }
    }
};
__device__ __forceinline__ void ph_moe2(KP p, int l, int ntok, int bid, int nb, LAS unsigned char* lds) {
    LAS int* offs = (LAS int*)(lds + MOE_TAB);
    LAS int* tabE = offs + 128;
    LAS int* tabD = offs + 256;
    LAS float* tabG = (LAS float*)(tabD + MOE_MAXT * 256);
    moe_offsets(p, l, ntok, offs);
    const int tid = opaque_tid();
    const int nrt = offs[65] >> 8, total = nrt * 4;
    const int u0 = (int)(((long)bid * total) / nb), u1 = (int)(((long)(bid + 1) * total) / nb);
    const int rt0 = u0 >> 2, nper = (u1 > u0) ? (((u1 - 1) >> 2) - rt0 + 1) : 0;
    const int* sdst = (const int*)(p->ws + OFF_SDST); const float* sgate = (const float*)(p->ws + OFF_SGATE); const int* tile_e = (const int*)(p->ws + OFF_TILEE);
    for (int i = tid; i < nper * 256; i += 512) { const size_t r = (size_t)(rt0 + (i >> 8)) * 256 + (i & 255); tabD[i] = sdst[r]; tabG[i] = sgate[r]; }
    if (tid < nper) tabE[tid] = tile_e[rt0 + tid];
    __syncthreads();
    Moe2Sched S{(const char*)(p->ws + OFF_BIG), (const char*)(p->ws + OFF_W2), tabE, u0, u1, rt0};
    EpiY E{(bf16_t*)(p->ws + OFF_YS), tabD, tabG};
    gp::gemm_phase<false, true>(lds, 256, S, E);
}

template <bool NEXT>
__device__ __forceinline__ void ph_combine_ln2(KP p, int l, int ntok, int bid, int nb) {
    bf16_t* U = (bf16_t*)(p->ws + OFF_U);
    float* G = (float*)(p->ws + OFF_G);
    const bool gates = NEXT && ((l + 1) & 1) == 0;
    LAS float* wl = (LAS float*)smraw_base();
    if (gates) stage_gate_w(p, (l + 1) >> 1, wl);
    const int tid = opaque_tid(), lane = tid & 63, wv = tid >> 6;
    const bf16_t* Ys = (const bf16_t*)(p->ws + OFF_YS);
    const float* lw = p->in[I_LNW] + (l * 2 + 1) * 1024; const float* lb = p->in[I_LNB] + (l * 2 + 1) * 1024;
    #pragma unroll 1
    for (int tok = bid * 8 + wv; tok < ntok; tok += nb * 8) {
        float* h = hrow(p, tok);
        const float* m = modrow(p, l, tok);
        const float* m2 = modrow(p, NEXT ? l + 1 : l, tok);
        float ga[16], u16[16];
#pragma unroll
        for (int j = 0; j < 16; ++j) { ga[j] = 0.f; u16[j] = 0.f; }
        float f[16];
#pragma unroll
        for (int i = 0; i < 16; ++i) f[i] = 0.f;
#pragma unroll
        for (int s = 0; s < 9; ++s)
#pragma unroll
            for (int c = 0; c < 2; ++c) {
                const uint4 w = *(const uint4*)(Ys + ((size_t)tok * 9 + s) * 1024 + 8 * (lane + 64 * c));
                f[8 * c + 0] += bflo(w.x); f[8 * c + 1] += bfhi(w.x); f[8 * c + 2] += bflo(w.y); f[8 * c + 3] += bfhi(w.y);
                f[8 * c + 4] += bflo(w.z); f[8 * c + 5] += bfhi(w.z); f[8 * c + 6] += bflo(w.w); f[8 * c + 7] += bfhi(w.w);
            }
        float x[16]; float sum = 0.f;
#pragma unroll
        for (int c = 0; c < 2; ++c)
#pragma unroll
            for (int q = 0; q < 2; ++q) {
                const int d = 8 * (lane + 64 * c) + 4 * q;
                const float4 hv = *(const float4*)(h + d), gv = *(const float4*)(m + 5 * 1024 + d);
                x[8 * c + 4 * q + 0] = ALPHA * hv.x + gv.x * f[8 * c + 4 * q + 0]; x[8 * c + 4 * q + 1] = ALPHA * hv.y + gv.y * f[8 * c + 4 * q + 1];
                x[8 * c + 4 * q + 2] = ALPHA * hv.z + gv.z * f[8 * c + 4 * q + 2]; x[8 * c + 4 * q + 3] = ALPHA * hv.w + gv.w * f[8 * c + 4 * q + 3];
                sum += x[8 * c + 4 * q] + x[8 * c + 4 * q + 1] + x[8 * c + 4 * q + 2] + x[8 * c + 4 * q + 3];
            }
        const float mean = wave_sum(sum) * (1.f / 1024.f);
        float q2 = 0.f;
#pragma unroll
        for (int i = 0; i < 16; ++i) { x[i] -= mean; q2 += x[i] * x[i]; }
        const float rs = rsqrtf(wave_sum(q2) * (1.f / 1024.f) + LN_EPS);
#pragma unroll
        for (int c = 0; c < 2; ++c)
#pragma unroll
            for (int q = 0; q < 2; ++q) {
                const int d = 8 * (lane + 64 * c) + 4 * q;
                const float4 w4 = *(const float4*)(lw + d), b4 = *(const float4*)(lb + d);
                float4 y; y.x = x[8 * c + 4 * q] * rs * w4.x + b4.x; y.y = x[8 * c + 4 * q + 1] * rs * w4.y + b4.y; y.z = x[8 * c + 4 * q + 2] * rs * w4.z + b4.z; y.w = x[8 * c + 4 * q + 3] * rs * w4.w + b4.w;
                *(float4*)(h + d) = y;
                if (NEXT) {
                    const float4 sh = *(const float4*)(m2 + d), sc = *(const float4*)(m2 + 1024 + d);
                    const float uu[4] = {y.x * (1.f + sc.x) + sh.x, y.y * (1.f + sc.y) + sh.y, y.z * (1.f + sc.z) + sh.z, y.w * (1.f + sc.w) + sh.w};
                    *(uint2*)(U + (size_t)tok * DM + d) = make_uint2(cvt_pk_bf16(uu[0], uu[1]), cvt_pk_bf16(uu[2], uu[3]));
                    u16[8 * c + 4 * q] = uu[0]; u16[8 * c + 4 * q + 1] = uu[1]; u16[8 * c + 4 * q + 2] = uu[2]; u16[8 * c + 4 * q + 3] = uu[3];
                }
            }
        if (gates) {
#pragma unroll
            for (int g4 = 0; g4 < 4; ++g4) {
                const int d = 8 * (lane + 64 * (g4 >> 1)) + 4 * (g4 & 1);
#pragma unroll
                for (int qq = 0; qq < 4; ++qq) {
#pragma unroll
                    for (int j4 = 0; j4 < 4; ++j4) { const f32x4_l w = *(const LAS f32x4_l*)(wl + (d + qq) * 16 + j4 * 4); const float uv = u16[4 * g4 + qq]; ga[4 * j4] += uv * w[0]; ga[4 * j4 + 1] += uv * w[1]; ga[4 * j4 + 2] += uv * w[2]; ga[4 * j4 + 3] += uv * w[3]; }
                }
                __builtin_amdgcn_sched_barrier(0);
            }
            float mine = 0.f;
#pragma unroll
            for (int j = 0; j < 16; ++j) { const float sg = wave_sum(ga[j]); if (lane == j) mine = sg; }
            if (lane < 16) G[(size_t)tok * 16 + lane] = mine;
        }
    }
}

#define MEGA_LDS (131072 + 256 + 20480)
#define NBLK 256
#define BAR_LDS BAR_LDS_
#define SYNC() do { XcdBarrier _b; _b.bar = (unsigned*)kparams()->ws; _b.x = xb_xcc_id(); _b.st = (volatile LAS unsigned*)((LAS unsigned char*)smraw_base() + BAR_LDS); xcd_barrier(_b); } while (0)
template <int PAR>
__device__ __forceinline__ void layer_fwd(const int l) {
    LAS unsigned char* lds = smraw_base(); float* sm = (float*)smraw_generic();
    const int bid = blockIdx.x; constexpr int nb = NBLK;
    const int ntok = (l == 3) ? NL : NT;
    ph_gemm_in(kparams(), l, bid, nb, lds); SYNC();
    if (PAR == 0) {
        ph_scan_even2(kparams(), l, bid, nb); SYNC();
        ph_normgate_even(kparams(), l, bid, nb); SYNC();
    } else {
        ph_hy_filt2(kparams(), l, bid, nb, sm); ph_hy_prep(kparams(), l, bid, nb, sm); SYNC();
        ph_mix_odd(kparams(), l, bid, nb, sm); SYNC();
        ph_hy_norm(kparams(), l, bid, nb, sm); ph_normgate_odd(kparams(), l, bid, nb); SYNC();
    }
    ph_gemm_out(kparams(), l, bid, nb, lds); SYNC();
    ph_ln1_router(kparams(), l, ntok, bid, nb, sm); SYNC();
    ph_scatter(kparams(), l, ntok, bid, nb, lds); SYNC();
    ph_moe1(kparams(), l, ntok, bid, nb, lds); SYNC();
    ph_moe2(kparams(), l, ntok, bid, nb, lds); SYNC();
    if (l < 3) { ph_combine_ln2<true>(kparams(), l, ntok, bid, nb); ph_convert(kparams(), l + 1, bid, nb, sm); SYNC(); }
    else ph_combine_ln2<false>(kparams(), l, ntok, bid, nb);
}
__global__ void __launch_bounds__(512, 2) mega_fwd(Params p) {
    LAS unsigned char* lds = smraw_base(); float* sm = (float*)smraw_generic();
    {
        const int t0 = threadIdx.x;
        if ((t0 & 63) == 0) { unsigned h; asm volatile("s_getreg_b32 %0, hwreg(HW_REG_HW_ID, 0, 6)" : "=s"(h)); *(LAS int*)(size_t)(WTAB_LDS + (h & 63u) * 4u) = t0 >> 6; }
        if (t0 < 4) ((LAS unsigned*)(lds + BAR_LDS))[t0] = 0u;
    }
    __syncthreads();
    (void)xcd_barrier_post((unsigned*)kparams()->ws, (volatile LAS unsigned*)(lds + BAR_LDS));
    const int bid = blockIdx.x; constexpr int nb = NBLK;
    ph_prologue(kparams(), bid, nb, sm); SYNC();
    ph_convert(kparams(), 0, bid, nb, sm); ph_modin(kparams(), 0, bid, nb); SYNC();
#pragma unroll 1
    for (int lp = 0; lp < 2; ++lp) {
        layer_fwd<0>(2 * lp);
        layer_fwd<1>(2 * lp + 1);
    }
    __syncthreads();
    if (blockIdx.x == 0 && opaque_tid() == 0 && xb_ld((unsigned*)kparams()->ws + XB_TMO) != 0u) kparams()->out[0] = __builtin_nanf("");
}

extern "C" void kernel_launch(void* const* d_in, const int* in_sizes, int n_in, void* d_out, int out_size, void* d_ws, size_t ws_size, hipStream_t stream) {
    static int grid = 0;
    if (grid == 0) {
        if (n_in != 38 || out_size != NL * DM || ws_size < WS_END) { fprintf(stderr, "kernel_launch: bad shapes n_in %d out %d ws %zu (need %zu)\n", n_in, out_size, ws_size, (size_t)WS_END); grid = -1; return; }
        int dev = 0, cus = 0, per_cu = 0;
        if (hipGetDevice(&dev) != hipSuccess || hipDeviceGetAttribute(&cus, hipDeviceAttributeMultiprocessorCount, dev) != hipSuccess) { grid = -1; return; }
        if (hipFuncSetAttribute((const void*)mega_fwd, hipFuncAttributeMaxDynamicSharedMemorySize, MEGA_LDS) != hipSuccess) { fprintf(stderr, "kernel_launch: hipFuncSetAttribute failed\n"); grid = -1; return; }
        if (hipOccupancyMaxActiveBlocksPerMultiprocessor(&per_cu, (const void*)mega_fwd, 512, MEGA_LDS) != hipSuccess || per_cu < 1) { fprintf(stderr, "kernel_launch: occupancy query says %d\n", per_cu); (void)hipGetLastError(); grid = -1; return; }
        if (cus != 256) { fprintf(stderr, "kernel_launch: built for 256 CUs, found %d\n", cus); grid = -1; return; }
        grid = NBLK;
    }
    if (grid < 0) return;
    if (hipMemsetAsync(d_ws, 0, OFF_LB, stream) != hipSuccess) return;
    Params p{};
    for (int i = 0; i < 38; ++i) p.in[i] = (const float*)d_in[i];
    p.out = (float*)d_out; p.ws = (unsigned char*)d_ws;
    hipLaunchKernelGGL(mega_fwd, dim3(grid), dim3(512), MEGA_LDS, stream, p);
}
```

```cpp
#include <hip/hip_runtime.h>
#include <stdint.h>
#include <stdio.h>

#define DM 1024
#define NBATCH 8
#define SEQ 4096
#define CTXL 256
#define NL (NBATCH * SEQ)
#define NC (NBATCH * CTXL)
#define NT (NL + NC)
#define ZROW NT
#define TOPK 8
#define EVEN_N 4112
#define ODD_N 3584
#define EVEN_LD 4096
#define ODD_LD 3584
#define MAXROWS (NT * 8 + 64 * 256 + NT)
#define ALPHA 1.681792830507429f
#define LN_EPS 1e-5f
#define E_MQ 0
#define E_MK 256
#define E_MV 512
#define E_MO 1024
#define E_HQ 1536
#define E_HI 2048
#define E_HFF 2560
#define E_HFB 3072
#define E_HG 3584

typedef unsigned short bf16_t;
#define LAS __attribute__((address_space(3)))
#define BAR_LDS_ 150528

#define MiB ((size_t)1 << 20)
#define OFF_CNT   ((size_t)64 << 10)
#define OFF_LB    ((size_t)96 << 10)
#define OFF_MOD   ((size_t)128 << 10)
#define OFF_ROPE  ((size_t)1536 << 10)
#define OFF_BCNT  ((size_t)1600 << 10)
#define OFF_GOFFS ((size_t)1700 << 10)
#define OFF_TILEE (2 * MiB)
#define OFF_HCTX  (4 * MiB)
#define OFF_TIDX  (12 * MiB)
#define OFF_TGATE (14 * MiB)
#define OFF_TPOS  (16 * MiB)
#define OFF_STOK  (18 * MiB)
#define OFF_SGATE (20 * MiB)
#define OFF_SDST  (22 * MiB)
#define OFF_G     (24 * MiB)
#define OFF_U     (28 * MiB)
#define OFF_W     (98 * MiB)
#define OFF_WIN   (OFF_W)
#define OFF_WOUT  (OFF_W + 8 * MiB)
#define OFF_W13   (OFF_W + 10 * MiB)
#define OFF_W2    (OFF_W + 75 * MiB)
#define OFF_BIG   (208 * MiB)
#define OFF_AUX   (480 * MiB)
#define OFF_Z1    (OFF_AUX + 136 * MiB)
#define OFF_Z2    (OFF_Z1 + 68 * MiB)
#define OFF_FILT  (OFF_Z2 + 68 * MiB)
#define OFF_YS    (370 * MiB)
#define WS_END    (1052 * MiB)

struct Params {
    const float* in[38];
    float* out;
    unsigned char* ws;
};

enum { I_X = 0, I_C, I_CTX, I_CCTX, I_ADAW, I_ADAB, I_LNW, I_LNB, I_EWIN, I_MGB, I_MNW, I_HLB, I_HNW, I_EWOUT, I_OWIN, I_HCW, I_HCB,
       I_HW1, I_HB1, I_HW2, I_HB2, I_HW3, I_HB3, I_HFREQ, I_HWOUT, I_HSKIP, I_HNORM, I_RLD, I_RNW, I_OWOUT, I_RW, I_RB, I_W1, I_W3, I_W2, I_SW1, I_SW3, I_SW2 };

typedef const __attribute__((address_space(4))) Params* KP;
__device__ __forceinline__ KP kparams() { KP k = (KP)__builtin_amdgcn_kernarg_segment_ptr(); asm volatile("" : "+s"(k)); return k; }
extern __shared__ __attribute__((aligned(16))) unsigned char smraw_all[];
__device__ __forceinline__ LAS unsigned char* smraw_base() { return (LAS unsigned char*)smraw_all; }
__device__ __forceinline__ unsigned char* smraw_generic() { return smraw_all; }
#define WTAB_LDS (BAR_LDS_ + 512)
__device__ __forceinline__ int opaque_tid() {
    unsigned h; asm volatile("s_getreg_b32 %0, hwreg(HW_REG_HW_ID, 0, 6)" : "=s"(h));
    const int wid = *(volatile LAS int*)(size_t)(WTAB_LDS + (h & 63u) * 4u);
    unsigned m = ~0u; asm volatile("" : "+s"(m));
    const int lane = (int)__builtin_amdgcn_mbcnt_hi(m, __builtin_amdgcn_mbcnt_lo(m, 0u));
    return __builtin_amdgcn_readfirstlane(wid) * 64 + lane;
}
typedef __bf16 bf16x2_n __attribute__((ext_vector_type(2)));
typedef float f32x2_n __attribute__((ext_vector_type(2)));
__device__ __forceinline__ unsigned cvt_pk_bf16(float lo, float hi) { const f32x2_n v = {lo, hi}; return __builtin_bit_cast(unsigned, __builtin_convertvector(v, bf16x2_n)); }
__device__ __forceinline__ float bf2f(bf16_t b) { return __uint_as_float(((unsigned)b) << 16); }
__device__ __forceinline__ float bflo(unsigned w) { return __uint_as_float(w << 16); }
__device__ __forceinline__ float bfhi(unsigned w) { return __uint_as_float(w & 0xffff0000u); }
__device__ __forceinline__ float ldf(const float* p) { return *p; }
__device__ __forceinline__ float ldf(const bf16_t* p) { return bf2f(*p); }
__device__ __forceinline__ void stf(float* p, float v) { *p = v; }
__device__ __forceinline__ void stf(bf16_t* p, float v) { *p = (bf16_t)(cvt_pk_bf16(v, 0.f) & 0xffffu); }
__device__ __forceinline__ float sigmoidf_(float x) { return 1.f / (1.f + expf(-x)); }
__device__ __forceinline__ float siluf_(float x) { return x / (1.f + expf(-x)); }
__device__ __forceinline__ float fexp(float x) { return __builtin_amdgcn_exp2f(x * 1.4426950408889634f); }
__device__ __forceinline__ float flog(float x) { return __builtin_amdgcn_logf(x) * 0.6931471805599453f; }
__device__ __forceinline__ float frcp(float x) { return __builtin_amdgcn_rcpf(x); }
__device__ __forceinline__ float fsigmoid(float x) { return frcp(1.f + fexp(-x)); }
__device__ __forceinline__ float fsilu(float x) { return x * frcp(1.f + fexp(-x)); }
__device__ __forceinline__ float wave_sum(float v) {
#pragma unroll
    for (int o = 32; o > 0; o >>= 1) v += __shfl_xor(v, o, 64);
    return v;
}
__device__ __forceinline__ float* hrow(KP p, int tok) {
    return tok < NL ? p->out + (size_t)tok * DM : (float*)(p->ws + OFF_HCTX) + (size_t)(tok - NL) * DM;
}
__device__ __forceinline__ const float* modrow(KP p, int l, int tok) {
    const int r = tok < NL ? (tok >> 12) : 8;
    return (const float*)(p->ws + OFF_MOD) + ((size_t)l * 9 + r) * 6144;
}
__device__ __forceinline__ int scan_tok(int b, int i, int dir) {
    return i < CTXL ? NL + b * CTXL + (dir ? CTXL - 1 - i : i) : b * SEQ + (dir ? SEQ - 1 - (i - CTXL) : (i - CTXL));
}

#define XB_TMO      128
#define XB_XCNT(j)  (256  + 64 * (j))
#define XB_XSUB(j)  (1280 + 64 * (j))
#define XB_XGEN(j)  (2304 + 64 * (j))
#define XB_TOP      3328
#define XB_TOPGEN   3392
#define XCD_BAR_WORDS 3456
#define XB_SPIN_CAP (1u << 24)
__device__ __forceinline__ unsigned xb_ld(unsigned* p)              { return __hip_atomic_load(p, __ATOMIC_RELAXED, __HIP_MEMORY_SCOPE_AGENT); }
__device__ __forceinline__ unsigned xb_add(unsigned* p, unsigned v) { return __hip_atomic_fetch_add(p, v, __ATOMIC_RELAXED, __HIP_MEMORY_SCOPE_AGENT); }
__device__ __forceinline__ unsigned xb_xcc_id() { return (unsigned)__builtin_amdgcn_s_getreg((3 << 11) | 20) & 0xFu; }
#define XB_SPIN(cond, bar) do { unsigned _sp = 0; while (cond) { __builtin_amdgcn_s_sleep(1); \
    if ((++_sp & 255u) == 0u) { if (xb_ld(&(bar)[XB_TMO])) break; if (_sp > XB_SPIN_CAP) { atomicAdd(&(bar)[XB_TMO], 1u); break; } } } } while (0)
struct XcdBarrier { unsigned* bar; unsigned x; volatile LAS unsigned* st; };
__device__ __forceinline__ XcdBarrier xcd_barrier_post(unsigned* bar, volatile LAS unsigned* st) {
    XcdBarrier b; b.bar = bar; b.x = xb_xcc_id(); b.st = st;
    if (opaque_tid() == 0) (void)xb_add(&bar[XB_XCNT(b.x)], 1u);
    return b;
}
__device__ __forceinline__ void xcd_barrier_complete(unsigned* bar, unsigned x, unsigned& nloc, unsigned& nx) {
    const unsigned G = gridDim.x * gridDim.y * gridDim.z;
    unsigned sum, cnt, mine, sp = 0u;
    for (;;) {
        sum = 0u; cnt = 0u; mine = 0u;
#pragma unroll
        for (unsigned j = 0; j < 16; ++j) { const unsigned c = xb_ld(&bar[XB_XCNT(j)]); sum += c; cnt += (c > 0u) ? 1u : 0u; mine = (j == x) ? c : mine; }
        if (sum == G) break;
        __builtin_amdgcn_s_sleep(1);
        if ((++sp & 255u) == 0u) { if (xb_ld(&bar[XB_TMO])) break; if (sp > XB_SPIN_CAP) { atomicAdd(&bar[XB_TMO], 1u); break; } }
    }
    nloc = mine > 0u ? mine : 1u; nx = cnt > 0u ? cnt : 1u;
}
__device__ __forceinline__ void xcd_barrier(const XcdBarrier& b) {
    asm volatile("s_waitcnt vmcnt(0)" ::: "memory");
    __syncthreads();
    if (opaque_tid() == 0) {
        unsigned* bar = b.bar;
        __builtin_amdgcn_s_waitcnt(0);
        unsigned nloc = b.st[0], nx = b.st[1];
        if (nloc == 0u) { xcd_barrier_complete(bar, b.x, nloc, nx); b.st[0] = nloc; b.st[1] = nx; }
        const unsigned old = xb_add(&bar[XB_XSUB(b.x)], 1u);
        const unsigned gen = old / nloc;
        if (old + 1u == (gen + 1u) * nloc) {
            __builtin_amdgcn_fence(__ATOMIC_RELEASE, "agent");
            asm volatile("s_waitcnt vmcnt(0)" ::: "memory");
            const unsigned og = xb_add(&bar[XB_TOP], 1u);
            const unsigned tg = og / nx;
            if (og + 1u == (tg + 1u) * nx) xb_add(&bar[XB_TOPGEN], 1u);
            else XB_SPIN(xb_ld(&bar[XB_TOPGEN]) == tg, bar);
            __builtin_amdgcn_fence(__ATOMIC_ACQUIRE, "agent");
            xb_add(&bar[XB_XGEN(b.x)], 1u);
            asm volatile("s_waitcnt vmcnt(0)" ::: "memory");
        } else {
            XB_SPIN(xb_ld(&bar[XB_XGEN(b.x)]) == gen, bar);
            __builtin_amdgcn_fence(__ATOMIC_ACQUIRE, "agent");
            asm volatile("s_waitcnt vmcnt(0)" ::: "memory");
        }
    }
    __syncthreads();
}

__device__ __forceinline__ void ph_prologue(KP p, int bid, int nb, float* sm) {
    const int tid = opaque_tid();
    {
        const float4* x4 = (const float4*)p->in[I_X]; float4* o4 = (float4*)p->out;
        #pragma unroll 1
        for (size_t i = (size_t)bid * 512 + tid; i < (size_t)NL * 256; i += (size_t)nb * 512) o4[i] = x4[i];
        const float4* c4 = (const float4*)p->in[I_CTX]; float4* h4 = (float4*)(p->ws + OFF_HCTX);
        #pragma unroll 1
        for (size_t i = (size_t)bid * 512 + tid; i < (size_t)NC * 256; i += (size_t)nb * 512) h4[i] = c4[i];
    }
    if (bid == 0) {
        bf16_t* z = (bf16_t*)(p->ws + OFF_U) + (size_t)ZROW * DM;
        for (int i = tid; i < DM; i += 512) z[i] = 0;
    }
    if (bid == 1 % nb) {
        float* lb = (float*)(p->ws + OFF_LB);
        const float* hl = p->in[I_HLB];
        for (int j = tid; j < 512; j += 512) {
            const float a = hl[j], b = hl[512 + j], mx = fmaxf(a, b);
            const float ea = expf(a - mx), eb = expf(b - mx);
            lb[j] = 0.f; lb[512 + j] = eb / (ea + eb);
        }
    }
    if (bid == 2 % nb) {
        float2* rt = (float2*)(p->ws + OFF_ROPE);
        for (int i = tid; i < 64 * 32; i += 512) { const float ang = (float)(i >> 5) * powf(10000.f, -(float)(2 * (i & 31)) / 64.f); rt[i] = make_float2(cosf(ang), sinf(ang)); }
    }
    {
        float* act = sm;
        bool filled = false;
        #pragma unroll 1
        for (int item = bid; item < 48; item += nb) {
            if (!filled) {
                for (int i = tid; i < 9 * 1024; i += 512) {
                    const int r = i >> 10, k = i & 1023;
                    const float v = r < 8 ? p->in[I_C][r * 1024 + k] : p->in[I_CCTX][k];
                    act[i] = siluf_(v);
                }
                __syncthreads(); filled = true;
            }
            const int l = item / 12, j = (item % 12) * 512 + tid;
            const float* w = p->in[I_ADAW] + (size_t)l * 1024 * 6144 + j;
            float acc[9];
#pragma unroll
            for (int r = 0; r < 9; ++r) acc[r] = 0.f;
            for (int k = 0; k < 1024; ++k) {
                const float wv = w[(size_t)k * 6144];
#pragma unroll
                for (int r = 0; r < 9; ++r) acc[r] += act[r * 1024 + k] * wv;
            }
            const float bv = p->in[I_ADAB][l * 6144 + j];
            float* mod = (float*)(p->ws + OFF_MOD);
#pragma unroll
            for (int r = 0; r < 9; ++r) mod[((size_t)l * 9 + r) * 6144 + j] = acc[r] + bv;
        }
    }
}


struct CvtTile { const float* src; int srcld; bf16_t* dst; int dstld; int k0, n0; };
__device__ __forceinline__ CvtTile cvt_tile_of(KP p, int l, int t, int np4  ) {
    const bool even = (l & 1) == 0;
    const int NP = even ? EVEN_LD : ODD_LD;
    const int t_in = 16 * (NP / 128), t_out = 16 * 8, t_13 = 65 * 16 * 4;
    CvtTile c;
    if (t < t_in) {
        const int kt = t & 15, nt = t >> 4, n = nt * 128 + np4;
        const float* W = even ? p->in[I_EWIN] + (size_t)(l >> 1) * 1024 * EVEN_N : p->in[I_OWIN] + (size_t)(l >> 1) * 1024 * ODD_N;
        c.src = W + ((even && n >= 1536) ? n + 16 : n); c.srcld = even ? EVEN_N : ODD_N; c.dst = (bf16_t*)(p->ws + OFF_WIN); c.dstld = 1024; c.k0 = kt * 64; c.n0 = nt * 128;
    } else if (t < t_in + t_out) {
        const int u = t - t_in, kt = u & 15, nt = u >> 4;
        c.src = (even ? p->in[I_EWOUT] : p->in[I_OWOUT]) + (size_t)(l >> 1) * 1024 * 1024 + nt * 128 + np4; c.srcld = 1024; c.dst = (bf16_t*)(p->ws + OFF_WOUT); c.dstld = 1024; c.k0 = kt * 64; c.n0 = nt * 128;
    } else if (t < t_in + t_out + t_13) {
        const int u = t - t_in - t_out, e = u >> 6, kt = u & 15, nt = (u >> 4) & 3, n = nt * 128 + np4, g = n >> 5, w = n & 31;
        const float* w1 = e < 64 ? p->in[I_W1] + ((size_t)l * 64 + e) * 1024 * 256 : p->in[I_SW1] + (size_t)l * 1024 * 256;
        const float* w3 = e < 64 ? p->in[I_W3] + ((size_t)l * 64 + e) * 1024 * 256 : p->in[I_SW3] + (size_t)l * 1024 * 256;
        c.src = w < 16 ? w1 + 16 * g + w : w3 + 16 * g + w - 16; c.srcld = 256; c.dst = (bf16_t*)(p->ws + OFF_W13) + (size_t)e * 512 * 1024; c.dstld = 1024; c.k0 = kt * 64; c.n0 = nt * 128;
    } else {
        const int u = t - t_in - t_out - t_13, e = u >> 5, kt = u & 3, nt = (u >> 2) & 7;
        const float* w2 = e < 64 ? p->in[I_W2] + ((size_t)l * 64 + e) * 256 * 1024 : p->in[I_SW2] + (size_t)l * 256 * 1024;
        c.src = w2 + nt * 128 + np4; c.srcld = 1024; c.dst = (bf16_t*)(p->ws + OFF_W2) + (size_t)e * 1024 * 256; c.dstld = 256; c.k0 = kt * 64; c.n0 = nt * 128;
    }
    return c;
}
__device__ __forceinline__ void ph_convert(KP p, int l, int bid, int nb, float* sm) {
    const int tid = opaque_tid();
    const int NP = ((l & 1) == 0) ? EVEN_LD : ODD_LD;
    const int total = 16 * (NP / 128) + 16 * 8 + 65 * 16 * 4 + 65 * 4 * 8;
    const int kr = tid >> 5, np4 = (tid & 31) * 4;
    float4 v[4];
    int t = bid;
    CvtTile c = cvt_tile_of(p, l, t < total ? t : 0, np4);
    if (t < total) {
#pragma unroll
        for (int j = 0; j < 4; ++j) v[j] = *(const float4*)(c.src + (size_t)(c.k0 + kr + 16 * j) * c.srcld);
    }
#pragma unroll 1
    for (; t < total; t += nb) {
        __syncthreads();
#pragma unroll
        for (int j = 0; j < 4; ++j) { float* d = sm + (np4) * 65 + kr + 16 * j; d[0] = v[j].x; d[65] = v[j].y; d[130] = v[j].z; d[195] = v[j].w; }
        const CvtTile cur = c;
        const int tn = t + nb;
        if (tn < total) {
            c = cvt_tile_of(p, l, tn, np4);
#pragma unroll
            for (int j = 0; j < 4; ++j) v[j] = *(const float4*)(c.src + (size_t)(c.k0 + kr + 16 * j) * c.srcld);
        }
        __syncthreads();
        const int n = tid >> 2, kc = (tid & 3) * 16;
        unsigned w[8];
#pragma unroll
        for (int q = 0; q < 8; ++q) w[q] = cvt_pk_bf16(sm[n * 65 + kc + 2 * q], sm[n * 65 + kc + 2 * q + 1]);
        uint4* d4 = (uint4*)(cur.dst + (size_t)(cur.n0 + n) * cur.dstld + cur.k0 + kc);
        d4[0] = make_uint4(w[0], w[1], w[2], w[3]); d4[1] = make_uint4(w[4], w[5], w[6], w[7]);
    }
    __syncthreads();
}

namespace gp {
typedef short bf16x8 __attribute__((ext_vector_type(8)));
typedef float f32x4 __attribute__((ext_vector_type(4)));
typedef unsigned u32x4 __attribute__((ext_vector_type(4)));
typedef unsigned u32x2 __attribute__((ext_vector_type(2)));
constexpr int BM = 256, BK = 64, HALF = 128, HTB = HALF * BK * 2, STAGE_BYTES = 8 * HTB, NXCD = 8, WGM = 8;
__device__ __forceinline__ int lds_byte(int r, int c) { const int st = (r >> 4) * 2 + (c >> 5), rr = r & 15, cc = c & 31, ob = rr * 64 + cc * 2; return st * 1024 + (ob ^ (((ob >> 9) & 1) << 5)); }
__device__ __forceinline__ void stage_rc(int b, int& R, int& C) { const int st = b / 1024, sb = b % 1024, swz = sb ^ (((sb >> 9) & 1) << 5); R = (st >> 1) * 16 + swz / 64; C = (st & 1) * 32 + (swz % 64) / 2; }
__device__ __forceinline__ int perm32(int rho) { const int n = rho >> 4, i = rho & 15; return 8 * (i >> 2) + 4 * n + (i & 3); }

struct Unit { const char* A; const char* B; int r0, c0, aux; };

struct DenseSched {
    const char* A; const char* B; int nM, nN, nwg, G, c; size_t tstep;
    __device__ __forceinline__ void init(const void* A_, const void* B_, int M, int N, int K, int G_, int c_) { A = (const char*)A_; B = (const char*)B_; nM = M / BM; nN = N / BM; nwg = nM * nN; G = G_; c = c_; tstep = (size_t)BM * K * 2; }
    __device__ __forceinline__ bool next(int i, Unit& u) const {
        const long L = (long)i * G + c; if (L >= nwg) return false;
        int wgid = (int)L; { const int q = nwg / NXCD, r = nwg % NXCD, xcd = wgid % NXCD, off = wgid / NXCD; wgid = (xcd < r ? xcd * (q + 1) : r * (q + 1) + (xcd - r) * q) + off; }
        const int nig = WGM * nN, gid = wgid / nig, fm = gid * WGM, gsz = (nM - fm) < WGM ? (nM - fm) : WGM;
        const int pm = fm + ((wgid % nig) % gsz), pn = (wgid % nig) / gsz;
        u.A = A + (size_t)pm * tstep; u.B = B + (size_t)pn * tstep; u.r0 = pm * BM; u.c0 = pn * BM; u.aux = 0; return true;
    }
    __device__ __forceinline__ void lane_off(const Unit&, unsigned (&)[2][2]) const {}
};

template <bool GATHER, bool PERM, class Sched, class Epi>
__device__ __forceinline__ void gemm_phase(LAS unsigned char* lds, const int K_, const Sched& S, const Epi& E) {
    int K = K_; asm volatile("" : "+s"(K));
    const int tid = opaque_tid(), wid = __builtin_amdgcn_readfirstlane(tid >> 6), lane = tid & 63, wr = wid >> 2, wc = wid & 3, fr = lane & 15, fq = lane >> 4;
    const int nt = K / BK;
    unsigned voffA[2], voffB[2];
#pragma unroll
    for (int i = 0; i < 2; ++i) { int R, C; stage_rc(tid * 16 + i * 8192, R, C); const int Rb = PERM ? ((R & ~31) + perm32(R & 31)) : R;
        voffA[i] = (unsigned)(R * K + C) * 2u; voffB[i] = (unsigned)(Rb * K + C) * 2u; }
    const size_t kstep = (size_t)(BK * 2);
    const size_t hstep = (size_t)HALF * K * 2;
    const unsigned ldsw = (unsigned)wid * 1024u;
    const int aoff = lds_byte(wr * 64 + fr, fq * 8), boff = lds_byte(wc * 32 + fr, fq * 8);
    unsigned cvo[2][2] = {{0u, 0u}, {0u, 0u}}, nvo[2][2] = {{0u, 0u}, {0u, 0u}};
#define GP_SA(b, h) (((b) * 2 + (h)) * HTB)
#define GP_SB(b, h) ((4 + (b) * 2 + (h)) * HTB)
#define GP_GLDS(gp_, lp_) __builtin_amdgcn_global_load_lds((const unsigned*)(gp_), (LAS unsigned*)(lp_), 16, 0, 0)
#define GP_STAGE_B(bufoff, gbase, h) do { const char* _g = (gbase) + (size_t)(h) * hstep; \
        GP_GLDS(_g + voffB[0], lds + (bufoff) + ldsw); GP_GLDS(_g + voffB[1], lds + (bufoff) + ldsw + 8192); } while (0)
#define GP_STAGE_A(bufoff, gbase, h, usenext) do { \
        if (GATHER) { const unsigned _o0 = (usenext) ? nvo[h][0] : cvo[h][0], _o1 = (usenext) ? nvo[h][1] : cvo[h][1]; \
            GP_GLDS((gbase) + _o0, lds + (bufoff) + ldsw); GP_GLDS((gbase) + _o1, lds + (bufoff) + ldsw + 8192); } \
        else { const char* _g = (gbase) + (size_t)(h) * hstep; GP_GLDS(_g + voffA[0], lds + (bufoff) + ldsw); GP_GLDS(_g + voffA[1], lds + (bufoff) + ldsw + 8192); } } while (0)
#define GP_LDA(dst, b, h) do { _Pragma("unroll") for (int m = 0; m < 4; ++m) _Pragma("unroll") for (int k = 0; k < 2; ++k) dst[m][k] = *(const LAS bf16x8*)(lds + GP_SA(b, h) + aoff + m * 2048 + k * 1024); } while (0)
#define GP_LDB(dst, b, h) do { _Pragma("unroll") for (int n = 0; n < 2; ++n) _Pragma("unroll") for (int k = 0; k < 2; ++k) dst[n][k] = *(const LAS bf16x8*)(lds + GP_SB(b, h) + boff + n * 2048 + k * 1024); } while (0)
#define GP_MMA(ai, bj, At, Bt) do { __builtin_amdgcn_s_setprio(1); _Pragma("unroll") for (int m = 0; m < 4; ++m) _Pragma("unroll") for (int n = 0; n < 2; ++n) _Pragma("unroll") for (int k = 0; k < 2; ++k) \
        acc[ai][bj][m][n] = __builtin_amdgcn_mfma_f32_16x16x32_bf16(Bt[n][k], At[m][k], acc[ai][bj][m][n], 0, 0, 0); __builtin_amdgcn_s_setprio(0); } while (0)
#define GP_WAIT_V(n) asm volatile("s_waitcnt vmcnt(" #n ")" ::: "memory")
#define GP_WAIT_L(n) asm volatile("s_waitcnt lgkmcnt(" #n ")" ::: "memory")
#define GP_BAR __builtin_amdgcn_s_barrier()
#define GP_SCHED __builtin_amdgcn_sched_barrier(0)
    Unit cur, nxt; int ui = 0;
    if (!S.next(0, cur)) return;
    f32x4 acc[2][2][4][2];
#pragma unroll
    for (int a = 0; a < 2; ++a)
#pragma unroll
        for (int b = 0; b < 2; ++b)
#pragma unroll
            for (int m = 0; m < 4; ++m)
#pragma unroll
                for (int n = 0; n < 2; ++n) acc[a][b][m][n] = (f32x4){0.f, 0.f, 0.f, 0.f};
    bf16x8 At[4][2], B0[2][2], B1[2][2];
    if (GATHER) S.lane_off(cur, cvo);
    const char* cA = cur.A; const char* cB = cur.B;
    GP_STAGE_B(GP_SB(0, 0), cB, 0); GP_STAGE_A(GP_SA(0, 0), cA, 0, false); GP_STAGE_B(GP_SB(0, 1), cB, 1); GP_STAGE_A(GP_SA(0, 1), cA, 1, false);
    if (wr == 1) GP_BAR;
    GP_WAIT_V(4); GP_BAR;
    GP_STAGE_B(GP_SB(1, 0), cB + kstep, 0); GP_STAGE_A(GP_SA(1, 0), cA + kstep, 0, false); GP_STAGE_B(GP_SB(1, 1), cB + kstep, 1);
    GP_WAIT_V(6); GP_BAR;
    for (;;) {
        const bool has_next = S.next(ui + 1, nxt);
        if (GATHER && has_next) S.lane_off(nxt, nvo);
        const char* nA = has_next ? nxt.A : cA; const char* nB = has_next ? nxt.B : cB;
        for (int t = 0; t < nt; t += 2) {
            const bool last = (t == nt - 2);
            const bool un = last && has_next;
            const char* a1 = cA + (size_t)(t + 1) * kstep;
            const char* a2 = last ? nA : cA + (size_t)(t + 2) * kstep; const char* b2 = last ? nB : cB + (size_t)(t + 2) * kstep;
            const char* a3 = a2 + kstep; const char* b3 = b2 + kstep;
            GP_LDB(B0, 0, 0); GP_SCHED; GP_LDA(At, 0, 0); GP_STAGE_A(GP_SA(1, 1), a1, 1, false);
            GP_WAIT_L(8); GP_BAR; GP_WAIT_L(0); GP_MMA(0, 0, At, B0); GP_BAR; GP_SCHED;
            GP_LDB(B1, 0, 1); GP_STAGE_B(GP_SB(0, 0), b2, 0);
            GP_BAR; GP_WAIT_L(0); GP_MMA(0, 1, At, B1); GP_BAR;
            GP_LDA(At, 0, 1); GP_STAGE_A(GP_SA(0, 0), a2, 0, un);
            GP_BAR; GP_WAIT_L(0); GP_MMA(1, 0, At, B0); GP_BAR; GP_SCHED;
            GP_STAGE_B(GP_SB(0, 1), b2, 1);
            GP_WAIT_V(6); GP_BAR; GP_MMA(1, 1, At, B1); GP_BAR;
            GP_LDB(B0, 1, 0); GP_SCHED; GP_LDA(At, 1, 0); GP_STAGE_A(GP_SA(0, 1), a2, 1, un);
            GP_WAIT_L(8); GP_BAR; GP_WAIT_L(0); GP_MMA(0, 0, At, B0); GP_BAR; GP_SCHED;
            GP_LDB(B1, 1, 1); GP_STAGE_B(GP_SB(1, 0), b3, 0);
            GP_BAR; GP_WAIT_L(0); GP_MMA(0, 1, At, B1); GP_BAR;
            GP_LDA(At, 1, 1); GP_STAGE_A(GP_SA(1, 0), a3, 0, un);
            GP_BAR; GP_WAIT_L(0); GP_MMA(1, 0, At, B0); GP_BAR; GP_SCHED;
            GP_STAGE_B(GP_SB(1, 1), b3, 1);
            GP_WAIT_V(6); GP_BAR; GP_MMA(1, 1, At, B1); GP_BAR;
        }
        E(acc, cur, wr, wc, fr, fq);
        if (!has_next) break;
#pragma unroll
        for (int a = 0; a < 2; ++a)
#pragma unroll
            for (int b = 0; b < 2; ++b)
#pragma unroll
                for (int m = 0; m < 4; ++m)
#pragma unroll
                    for (int n = 0; n < 2; ++n) acc[a][b][m][n] = (f32x4){0.f, 0.f, 0.f, 0.f};
        cur = nxt; cA = nA; cB = nB; ++ui;
        if (GATHER) { cvo[0][0] = nvo[0][0]; cvo[0][1] = nvo[0][1]; cvo[1][0] = nvo[1][0]; cvo[1][1] = nvo[1][1]; }
    }
    GP_WAIT_V(0);
    if (wr == 0) GP_BAR;
    GP_BAR;
#undef GP_SA
#undef GP_SB
#undef GP_GLDS
#undef GP_STAGE_A
#undef GP_STAGE_B
#undef GP_LDA
#undef GP_LDB
#undef GP_MMA
#undef GP_WAIT_V
#undef GP_WAIT_L
#undef GP_BAR
#undef GP_SCHED
}

struct EpiF32 {
    float* C; int ldc;
    __device__ __forceinline__ void operator()(const f32x4 (&acc)[2][2][4][2], const Unit& u, int wr, int wc, int fr, int fq) const {
        const int row0 = u.r0 + wr * 64 + fr, col0 = u.c0 + wc * 32 + 4 * fq;
#pragma unroll
        for (int ai = 0; ai < 2; ++ai)
#pragma unroll
            for (int m = 0; m < 4; ++m) { float* rowp = C + (size_t)(row0 + ai * HALF + m * 16) * ldc + col0;
#pragma unroll
                for (int bj = 0; bj < 2; ++bj)
#pragma unroll
                    for (int n = 0; n < 2; ++n) *(f32x4*)(rowp + bj * HALF + n * 16) = acc[ai][bj][m][n];
                __builtin_amdgcn_sched_barrier(0); }
    }
};
struct EpiBf16 {
    bf16_t* O; int ldc;
    __device__ __forceinline__ void operator()(const f32x4 (&acc)[2][2][4][2], const Unit& u, int wr, int wc, int fr, int fq) const {
        const int row0 = u.r0 + wr * 64 + fr, col0 = u.c0 + wc * 32 + 8 * fq;
#pragma unroll
        for (int ai = 0; ai < 2; ++ai)
#pragma unroll
            for (int m = 0; m < 4; ++m) { bf16_t* rowp = O + (size_t)(row0 + ai * HALF + m * 16) * ldc + col0;
#pragma unroll
                for (int bj = 0; bj < 2; ++bj) { const f32x4 v0 = acc[ai][bj][m][0], v1 = acc[ai][bj][m][1];
                    u32x4 w; w.x = cvt_pk_bf16(v0[0], v0[1]); w.y = cvt_pk_bf16(v0[2], v0[3]); w.z = cvt_pk_bf16(v1[0], v1[1]); w.w = cvt_pk_bf16(v1[2], v1[3]);
                    *(u32x4*)(rowp + bj * HALF) = w; }
                __builtin_amdgcn_sched_barrier(0); }
    }
};
}


typedef float f32x4_l __attribute__((ext_vector_type(4)));
__device__ __forceinline__ void stage_gate_w(KP p, int e, LAS float* wl) {
    const int tid = opaque_tid();
    const float* wg = p->in[I_EWIN] + (size_t)e * 1024 * EVEN_N + 1536;
#pragma unroll
    for (int i = 0; i < 8; ++i) { const int idx = tid + 512 * i, d = idx >> 2, j4 = idx & 3; const float4 w = *(const float4*)(wg + (size_t)d * EVEN_N + j4 * 4); *(LAS f32x4_l*)(wl + d * 16 + j4 * 4) = (f32x4_l){w.x, w.y, w.z, w.w}; }
    __syncthreads();
}
__device__ __forceinline__ void ph_modin(KP p, int l, int bid, int nb) {
    const int tid = opaque_tid(), lane = tid & 63, wv = tid >> 6;
    const bool even = (l & 1) == 0;
    bf16_t* U = (bf16_t*)(p->ws + OFF_U);
    float* G = (float*)(p->ws + OFF_G);
    LAS float* wl = (LAS float*)smraw_base();
    if (even) stage_gate_w(p, l >> 1, wl);
    #pragma unroll 1
    for (int tok = bid * 8 + wv; tok < NT; tok += nb * 8) {
        const float* h = hrow(p, tok);
        const float* m = modrow(p, l, tok);
        float ga[16];
#pragma unroll
        for (int j = 0; j < 16; ++j) ga[j] = 0.f;
#pragma unroll
        for (int c = 0; c < 4; ++c) {
            const int d = 4 * (lane + 64 * c);
            const float4 hv = *(const float4*)(h + d), sh = *(const float4*)(m + d), sc = *(const float4*)(m + 1024 + d);
            const float u0 = hv.x * (1.f + sc.x) + sh.x, u1 = hv.y * (1.f + sc.y) + sh.y, u2 = hv.z * (1.f + sc.z) + sh.z, u3 = hv.w * (1.f + sc.w) + sh.w;
            *(uint2*)(U + (size_t)tok * DM + d) = make_uint2(cvt_pk_bf16(u0, u1), cvt_pk_bf16(u2, u3));
            if (even) {
                const float uu[4] = {u0, u1, u2, u3};
#pragma unroll
                for (int q = 0; q < 4; ++q) {
#pragma unroll
                    for (int j4 = 0; j4 < 4; ++j4) { const f32x4_l w = *(const LAS f32x4_l*)(wl + (d + q) * 16 + j4 * 4); ga[4 * j4] += uu[q] * w[0]; ga[4 * j4 + 1] += uu[q] * w[1]; ga[4 * j4 + 2] += uu[q] * w[2]; ga[4 * j4 + 3] += uu[q] * w[3]; }
                }
                __builtin_amdgcn_sched_barrier(0);
            }
        }
        if (even) {
            float mine = 0.f;
#pragma unroll
            for (int j = 0; j < 16; ++j) { const float s = wave_sum(ga[j]); if (lane == j) mine = s; }
            if (lane < 16) G[(size_t)tok * 16 + lane] = mine;
        }
    }
}

__device__ __forceinline__ void ph_gemm_in(KP p, int l, int bid, int nb, LAS unsigned char* lds) {
    const int N = ((l & 1) == 0) ? EVEN_LD : ODD_LD;
    gp::DenseSched S; S.init(p->ws + OFF_U, p->ws + OFF_WIN, NT, N, 1024, nb, bid);
    gp::EpiBf16 E{(bf16_t*)(p->ws + OFF_BIG), N};
    gp::gemm_phase<false, true>(lds, 1024, S, E);
}
__device__ __forceinline__ void ph_gemm_out(KP p, int l, int bid, int nb, LAS unsigned char* lds) {
    gp::DenseSched S; S.init(p->ws + OFF_U, p->ws + OFF_WOUT, NT, 1024, 1024, nb, bid);
    gp::EpiF32 E{(float*)(p->ws + OFF_BIG), 1024};
    gp::gemm_phase<false, false>(lds, 1024, S, E);
}


namespace sc {
typedef short bf16x8 __attribute__((ext_vector_type(8)));
typedef short bf16x4 __attribute__((ext_vector_type(4)));
typedef float f32x4 __attribute__((ext_vector_type(4)));
#define SC_MFMA(a, b, c) __builtin_amdgcn_mfma_f32_16x16x32_bf16(a, b, c, 0, 0, 0)
__device__ __forceinline__ bf16x8 rd_row(unsigned img, int row, int stride, int k0) { return *(const LAS bf16x8*)(size_t)(img + (unsigned)(row * stride + k0 * 2)); }
__device__ __forceinline__ bf16x8 rd_tr(unsigned img, int k0, int n0, int stride, int lane) {
    const int g = lane >> 4, i = lane & 15;
    const unsigned a0 = img + (unsigned)((k0 + 8 * g + (i >> 2)) * stride + (n0 + 4 * (i & 3)) * 2), a1 = a0 + 4u * (unsigned)stride;
    bf16x4 lo, hi;
    asm volatile("ds_read_b64_tr_b16 %0, %2\n\tds_read_b64_tr_b16 %1, %3\n\ts_waitcnt lgkmcnt(0)" : "=&v"(lo), "=&v"(hi) : "v"(a0), "v"(a1) : "memory");
    return (bf16x8){lo[0], lo[1], lo[2], lo[3], hi[0], hi[1], hi[2], hi[3]};
}
typedef unsigned u32x2_ __attribute__((ext_vector_type(2)));
typedef unsigned u32x4_ __attribute__((ext_vector_type(4)));
__device__ __forceinline__ void st8(unsigned addr, uint2 v) { *(LAS u32x2_*)(size_t)addr = (u32x2_){v.x, v.y}; }
__device__ __forceinline__ void st16(unsigned addr, uint4 v) { *(LAS u32x4_*)(size_t)addr = (u32x4_){v.x, v.y, v.z, v.w}; }
__device__ __forceinline__ float scan_add64(float v, int lane) {
#pragma unroll
    for (int o = 1; o < 64; o <<= 1) { const float t = __shfl_up(v, o, 64); if (lane >= o) v += t; }
    return v;
}
__device__ __forceinline__ float scan_max64(float v, int lane) {
#pragma unroll
    for (int o = 1; o < 64; o <<= 1) { const float t = __shfl_up(v, o, 64); if (lane >= o) v = fmaxf(v, t); }
    return v;
}

template <int MODE>
__device__ __forceinline__ void scan_item(KP p, int l, int b, int h, int dir, int vs) {
    constexpr int CS = (MODE == 1) ? 32 : 64, DK = (MODE == 0) ? 64 : 128, EXT = (MODE == 0) ? 1 : 0;
    constexpr int QS = (DK + 8) * 2, VS = (64 + 16 * EXT + 8) * 2, SS = (CS + 8) * 2, NVR = 64 + 16 * EXT;
    constexpr int NCH = (CTXL + SEQ) / CS;
    constexpr int LD = (MODE == 2) ? ODD_LD : EVEN_LD;
    constexpr unsigned O_QA = 0, O_KA = O_QA + CS * QS, O_QB = O_KA + CS * QS, O_KW = O_QB + (MODE == 1 ? CS * QS : 0), O_V = O_KW + CS * QS,
                       O_SSC = O_V + CS * VS, O_ST = O_SSC + CS * SS, O_DKV = O_ST + 2 * NVR * QS, O_END = O_DKV + 512;
    static_assert(O_END <= 131072, "scan LDS");
    const int tid = opaque_tid(), lane = tid & 63, wv = __builtin_amdgcn_readfirstlane(tid >> 6), r16 = lane & 15, q4 = lane >> 4;
    const unsigned L0 = (unsigned)(size_t)smraw_base();
    const bf16_t* P = (const bf16_t*)(p->ws + OFF_BIG);
    bf16_t* HXo = (bf16_t*)(p->ws + OFF_AUX) + (size_t)dir * NT * 1024;
    const int e2 = l >> 1;
    const int cQ = (MODE == 0) ? E_MQ + h * 64 : (MODE == 1) ? E_HQ + h * 128 : 1536 + h * 128;
    const int cK = (MODE == 0) ? E_MK + h * 64 : (MODE == 1) ? (dir ? E_HFB : E_HFF) + h * 128 : 2048 + h * 128;
    const int cV = (MODE == 0) ? E_MV + h * 128 + vs * 64 : (MODE == 1) ? E_HI + h * 128 + vs * 64 : 2560 + h * 128 + vs * 64;
    const int cO = (MODE == 0) ? h * 128 + vs * 64 : 512 + h * 128 + vs * 64;
    const int lt = (MODE == 1) ? (tid & 31) : (tid >> 3);
    const int lj = (MODE == 0) ? (tid & 7) : (MODE == 1) ? (tid >> 5) : ((tid >> 2) & 1) * 8 + (tid & 3);
    const int vt_ = tid >> 3, vj = tid & 7;
    float lbv[8]; float gbi = 0.f, gbf = 0.f, lg = 0.f;
    if (MODE == 1) {
        const float* lbp = (const float*)(p->ws + OFF_LB) + e2 * 512 + h * 128 + lj * 8;
#pragma unroll
        for (int i = 0; i < 8; ++i) lbv[i] = lbp[i];
    } else {
#pragma unroll
        for (int i = 0; i < 8; ++i) lbv[i] = 0.f;
    }
    if (MODE == 0) { const float* gb = p->in[I_MGB] + e2 * 16; gbi = gb[(dir ? 2 : 0) * 4 + h]; gbf = gb[(dir ? 3 : 1) * 4 + h]; }
    if (MODE == 2) lg = p->in[I_RLD][e2 * 8 + dir * 4 + h];
    const float* G = (const float*)(p->ws + OFF_G);
    const float* ropet = (const float*)(p->ws + OFF_ROPE);
    unsigned oz = 0u; asm volatile("" : "+v"(oz));
    for (unsigned o = tid * 16; o < 2u * NVR * QS; o += 512 * 16) st16(L0 + O_ST + o, make_uint4(oz, oz, oz, oz));
    if (EXT) { if (tid < CS) { st16(L0 + O_V + tid * VS + 128, make_uint4(0x3f80u | oz, oz, oz, oz)); st16(L0 + O_V + tid * VS + 144, make_uint4(oz, oz, oz, oz)); } }
    f32x4 sacc[4];
#pragma unroll
    for (int i = 0; i < 4; ++i) sacc[i] = (f32x4){0.f, 0.f, 0.f, 0.f};
    float m_in = -1e30f;
    uint4 rq0, rq1, rk0, rk1, rv; float rg0 = 0.f, rg1 = 0.f;
    rq1 = make_uint4(0u, 0u, 0u, 0u); rk1 = rq1;
    auto load_chunk = [&](int c) {
        const int i0 = c * CS;
        const int tq = scan_tok(b, i0 + lt, dir);
        const bf16_t* pr = P + (size_t)tq * LD;
        rq0 = *(const uint4*)(pr + cQ + lj * 8); rk0 = *(const uint4*)(pr + cK + lj * 8);
        if (MODE == 2) { rq1 = *(const uint4*)(pr + cQ + lj * 8 + 32); rk1 = *(const uint4*)(pr + cK + lj * 8 + 32); }
        if (MODE != 1 || tid < 256) { const int tv = scan_tok(b, i0 + vt_, dir); rv = *(const uint4*)(P + (size_t)tv * LD + cV + vj * 8); }
        if (MODE == 0) { const int tg = scan_tok(b, i0 + lane, dir); rg0 = G[(size_t)tg * 16 + (dir ? 8 : 0) + h]; rg1 = G[(size_t)tg * 16 + (dir ? 12 : 4) + h]; }
    };
    load_chunk(0);
#pragma unroll 1
    for (int c = 0; c < NCH; ++c) {
        const unsigned ST_R = L0 + O_ST + (unsigned)(c & 1) * NVR * QS, ST_W = L0 + O_ST + (unsigned)((c + 1) & 1) * NVR * QS;
        float sp = 1.f;
        float v_u = 0.f, v_M = 0.f, v_e = 1.f, v_low = 0.f, v_w = 1.f;
        if (MODE == 0) {
            const float ig = rg0 + gbi, fg = rg1 + gbf;
            const float lf = fminf(fg, 0.f) - flog(1.f + fexp(-fabsf(fg)));
            const float bb = scan_add64(lf, lane);
            const float g = __shfl(bb, 63, 64);
            v_u = ig - bb;
            const float cu = scan_max64(v_u, lane);
            v_M = fmaxf(m_in, cu);
            const float m_new = fmaxf(g + m_in, g + __shfl(cu, 63, 64));
            sp = fexp(g + m_in - m_new);
            v_w = fexp(g + v_u - m_new);
            v_e = fexp(m_in - v_M);
            v_low = fexp(-(bb + v_M));
            m_in = m_new;
            st16(L0 + O_QA + lt * QS + lj * 16, rq0);
            st16(L0 + O_KA + lt * QS + lj * 16, rk0);
            const float wr = __shfl(v_w, lt, 64);
            uint4 kw; kw.x = cvt_pk_bf16(bflo(rk0.x) * wr, bfhi(rk0.x) * wr); kw.y = cvt_pk_bf16(bflo(rk0.y) * wr, bfhi(rk0.y) * wr);
            kw.z = cvt_pk_bf16(bflo(rk0.z) * wr, bfhi(rk0.z) * wr); kw.w = cvt_pk_bf16(bflo(rk0.w) * wr, bfhi(rk0.w) * wr);
            st16(L0 + O_KW + lt * QS + lj * 16, kw);
            st16(L0 + O_V + vt_ * VS + vj * 16, rv);
        } else if (MODE == 2) {
            sp = fexp(64.f * lg);
            const bool lat = c >= CTXL / CS;
            float q[16], k[16];
            const unsigned qa[8] = {rq0.x, rq0.y, rq0.z, rq0.w, rq1.x, rq1.y, rq1.z, rq1.w}, ka[8] = {rk0.x, rk0.y, rk0.z, rk0.w, rk1.x, rk1.y, rk1.z, rk1.w};
#pragma unroll
            for (int i = 0; i < 8; ++i) { q[2 * i] = bflo(qa[i]); q[2 * i + 1] = bfhi(qa[i]); k[2 * i] = bflo(ka[i]); k[2 * i + 1] = bfhi(ka[i]); }
            if (lat) {
                const int tq = scan_tok(b, c * CS + lt, dir), tt = tq & (SEQ - 1);
                const int pos = ((tid >> 2) & 1) ? (tt & 63) : (tt >> 6);
                const float2* rt = (const float2*)ropet + pos * 32 + (tid & 3) * 8;
#pragma unroll
                for (int i = 0; i < 8; ++i) {
                    const float2 cs2 = rt[i];
                    const float q1 = q[i], q2 = q[8 + i], k1 = k[i], k2 = k[8 + i];
                    q[i] = q1 * cs2.x - q2 * cs2.y; q[8 + i] = q1 * cs2.y + q2 * cs2.x;
                    k[i] = k1 * cs2.x - k2 * cs2.y; k[8 + i] = k1 * cs2.y + k2 * cs2.x;
                }
            }
            const float wr = 0.08838834764831845f * fexp((float)(63 - lt) * lg);
            uint4 o0, o1, w0, w1, x0, x1;
            o0.x = cvt_pk_bf16(q[0], q[1]); o0.y = cvt_pk_bf16(q[2], q[3]); o0.z = cvt_pk_bf16(q[4], q[5]); o0.w = cvt_pk_bf16(q[6], q[7]);
            o1.x = cvt_pk_bf16(q[8], q[9]); o1.y = cvt_pk_bf16(q[10], q[11]); o1.z = cvt_pk_bf16(q[12], q[13]); o1.w = cvt_pk_bf16(q[14], q[15]);
            w0.x = cvt_pk_bf16(k[0], k[1]); w0.y = cvt_pk_bf16(k[2], k[3]); w0.z = cvt_pk_bf16(k[4], k[5]); w0.w = cvt_pk_bf16(k[6], k[7]);
            w1.x = cvt_pk_bf16(k[8], k[9]); w1.y = cvt_pk_bf16(k[10], k[11]); w1.z = cvt_pk_bf16(k[12], k[13]); w1.w = cvt_pk_bf16(k[14], k[15]);
            x0.x = cvt_pk_bf16(k[0] * wr, k[1] * wr); x0.y = cvt_pk_bf16(k[2] * wr, k[3] * wr); x0.z = cvt_pk_bf16(k[4] * wr, k[5] * wr); x0.w = cvt_pk_bf16(k[6] * wr, k[7] * wr);
            x1.x = cvt_pk_bf16(k[8] * wr, k[9] * wr); x1.y = cvt_pk_bf16(k[10] * wr, k[11] * wr); x1.z = cvt_pk_bf16(k[12] * wr, k[13] * wr); x1.w = cvt_pk_bf16(k[14] * wr, k[15] * wr);
            st16(L0 + O_QA + lt * QS + lj * 16, o0); st16(L0 + O_QA + lt * QS + lj * 16 + 64, o1);
            st16(L0 + O_KA + lt * QS + lj * 16, w0); st16(L0 + O_KA + lt * QS + lj * 16 + 64, w1);
            st16(L0 + O_KW + lt * QS + lj * 16, x0); st16(L0 + O_KW + lt * QS + lj * 16 + 64, x1);
            st16(L0 + O_V + vt_ * VS + vj * 16, rv);
        } else {
            const unsigned qa[4] = {rq0.x, rq0.y, rq0.z, rq0.w}, fa[4] = {rk0.x, rk0.y, rk0.z, rk0.w};
            float qv[8], kk[8], A[8];
#pragma unroll
            for (int i = 0; i < 8; ++i) {
                const float qr = (i & 1) ? bfhi(qa[i >> 1]) : bflo(qa[i >> 1]), fr = (i & 1) ? bfhi(fa[i >> 1]) : bflo(fa[i >> 1]);
                const float f = lbv[i] + (1.f - lbv[i]) * fsigmoid(fr);
                qv[i] = fsilu(qr); kk[i] = 1.f - f; A[i] = flog(f);
            }
#pragma unroll
            for (int o = 1; o < 32; o <<= 1)
#pragma unroll
                for (int i = 0; i < 8; ++i) { const float t = __shfl_up(A[i], o, 32); if (lt >= o) A[i] += t; }
            float qa_[8], qb_[8], ka_[8], kw_[8];
#pragma unroll
            for (int i = 0; i < 8; ++i) {
                const float am = __shfl(A[i], 15, 32), ae = __shfl(A[i], 31, 32);
                qa_[i] = qv[i] * fexp(A[i] - am); qb_[i] = qv[i] * fexp(A[i]); ka_[i] = kk[i] * fexp(am - A[i]); kw_[i] = kk[i] * fexp(ae - A[i]);
                if (lt == 31) *(LAS float*)(size_t)(L0 + O_DKV + (lj * 8 + i) * 4) = fexp(ae);
            }
            uint4 w;
            w.x = cvt_pk_bf16(qa_[0], qa_[1]); w.y = cvt_pk_bf16(qa_[2], qa_[3]); w.z = cvt_pk_bf16(qa_[4], qa_[5]); w.w = cvt_pk_bf16(qa_[6], qa_[7]); st16(L0 + O_QA + lt * QS + lj * 16, w);
            w.x = cvt_pk_bf16(qb_[0], qb_[1]); w.y = cvt_pk_bf16(qb_[2], qb_[3]); w.z = cvt_pk_bf16(qb_[4], qb_[5]); w.w = cvt_pk_bf16(qb_[6], qb_[7]); st16(L0 + O_QB + lt * QS + lj * 16, w);
            w.x = cvt_pk_bf16(ka_[0], ka_[1]); w.y = cvt_pk_bf16(ka_[2], ka_[3]); w.z = cvt_pk_bf16(ka_[4], ka_[5]); w.w = cvt_pk_bf16(ka_[6], ka_[7]); st16(L0 + O_KA + lt * QS + lj * 16, w);
            w.x = cvt_pk_bf16(kw_[0], kw_[1]); w.y = cvt_pk_bf16(kw_[2], kw_[3]); w.z = cvt_pk_bf16(kw_[4], kw_[5]); w.w = cvt_pk_bf16(kw_[6], kw_[7]); st16(L0 + O_KW + lt * QS + lj * 16, w);
            if (tid < 256) st16(L0 + O_V + vt_ * VS + vj * 16, rv);
        }
        __syncthreads();
        if (c + 1 < NCH) load_chunk(c + 1);
        {
            constexpr int NT1 = CS / 16;
            const bool act = (MODE == 1) ? (wv < 4) : true;
            const int tb = (MODE == 1) ? (wv & 1) : (wv & 3);
#pragma unroll
            for (int u2 = 0; u2 < ((MODE == 1) ? 1 : 2); ++u2) {
                const int sb = (MODE == 1) ? (wv >> 1) : 2 * (wv >> 2) + u2;
                if (act) {
                    f32x4 d = (f32x4){0.f, 0.f, 0.f, 0.f};
                    if (sb <= tb) {
#pragma unroll
                        for (int kk2 = 0; kk2 < DK / 32; ++kk2)
                            d = SC_MFMA(rd_row(L0 + O_KA, sb * 16 + r16, QS, kk2 * 32 + q4 * 8), rd_row(L0 + O_QA, tb * 16 + r16, QS, kk2 * 32 + q4 * 8), d);
                        const int t = tb * 16 + r16, s0 = sb * 16 + q4 * 4;
                        if (MODE == 0) {
                            const float Mt = __shfl(v_M, t, 64);
#pragma unroll
                            for (int jj = 0; jj < 4; ++jj) { const float us = __shfl(v_u, s0 + jj, 64); d[jj] = (s0 + jj <= t) ? d[jj] * 0.125f * fexp(us - Mt) : 0.f; }
                        } else if (MODE == 2) {
#pragma unroll
                            for (int jj = 0; jj < 4; ++jj) d[jj] = (s0 + jj <= t) ? d[jj] * 0.08838834764831845f * fexp((float)(t - s0 - jj) * lg) : 0.f;
                        } else {
#pragma unroll
                            for (int jj = 0; jj < 4; ++jj) d[jj] = (s0 + jj <= t) ? d[jj] : 0.f;
                        }
                    }
                    st8(L0 + O_SSC + (tb * 16 + r16) * SS + (sb * 16 + q4 * 4) * 2, make_uint2(cvt_pk_bf16(d[0], d[1]), cvt_pk_bf16(d[2], d[3])));
                }
            }
            (void)NT1;
        }
        __syncthreads();
        {
            const int tb = (MODE == 1) ? (wv & 1) : (wv & 3);
            const int t = tb * 16 + r16;
            const int tok = scan_tok(b, c * CS + t, dir);
            constexpr int NV = (MODE == 1) ? 1 : 2;
            f32x4 oi[NV + EXT], oo[NV + EXT];
#pragma unroll
            for (int u2 = 0; u2 < NV + EXT; ++u2) {
                const int vt = (u2 == NV) ? 4 : ((MODE == 1) ? (wv >> 1) : 2 * (wv >> 2) + u2);
                f32x4 a1 = (f32x4){0.f, 0.f, 0.f, 0.f}, a2 = a1;
#pragma unroll
                for (int sb2 = 0; sb2 < CS / 32; ++sb2)
                    a1 = SC_MFMA(rd_tr(L0 + O_V, sb2 * 32, vt * 16, VS, lane), rd_row(L0 + O_SSC, t, SS, sb2 * 32 + q4 * 8), a1);
#pragma unroll
                for (int kk2 = 0; kk2 < DK / 32; ++kk2)
                    a2 = SC_MFMA(rd_row(ST_R, vt * 16 + r16, QS, kk2 * 32 + q4 * 8), rd_row(L0 + ((MODE == 1) ? O_QB : O_QA), t, QS, kk2 * 32 + q4 * 8), a2);
                oi[u2] = a1; oo[u2] = a2;
            }
            float den = 1.f, ei = 1.f;
            if (MODE == 0) {
                ei = 0.125f * __shfl(v_e, t, 64);
                const float dsum = oi[NV][0] + ei * oo[NV][0];
                const float dd = __shfl(dsum, r16, 64);
                den = 1.f / fmaxf(fabsf(dd), __shfl(v_low, t, 64));
            } else if (MODE == 2) {
                ei = fexp((float)(t + 1) * lg);
            }
#pragma unroll
            for (int u2 = 0; u2 < NV; ++u2) {
                const int vt = (MODE == 1) ? (wv >> 1) : 2 * (wv >> 2) + u2;
                float o[4];
#pragma unroll
                for (int jj = 0; jj < 4; ++jj) o[jj] = (oi[u2][jj] + ei * oo[u2][jj]) * den;
                *(uint2*)(HXo + (size_t)tok * 1024 + cO + vt * 16 + q4 * 4) = make_uint2(cvt_pk_bf16(o[0], o[1]), cvt_pk_bf16(o[2], o[3]));
            }
        }
        {
            constexpr int NS = (MODE == 0) ? 3 : 4;
            const int kt = (MODE == 0) ? (wv & 3) : wv;
            float dk[4] = {sp, sp, sp, sp};
            if (MODE == 1) { const f32x4 dv = *(const LAS f32x4*)(size_t)(L0 + O_DKV + (kt * 16 + q4 * 4) * 4); dk[0] = dv[0]; dk[1] = dv[1]; dk[2] = dv[2]; dk[3] = dv[3]; }
#pragma unroll
            for (int u2 = 0; u2 < NS; ++u2) {
                const int vt = (MODE == 0) ? ((u2 == 2) ? 4 : 2 * (wv >> 2) + u2) : u2;
                f32x4 a = sacc[u2];
#pragma unroll
                for (int jj = 0; jj < 4; ++jj) a[jj] *= dk[jj];
#pragma unroll
                for (int sb2 = 0; sb2 < CS / 32; ++sb2)
                    a = SC_MFMA(rd_tr(L0 + O_KW, sb2 * 32, kt * 16, QS, lane), rd_tr(L0 + O_V, sb2 * 32, vt * 16, VS, lane), a);
                sacc[u2] = a;
                st8(ST_W + (vt * 16 + r16) * QS + (kt * 16 + q4 * 4) * 2, make_uint2(cvt_pk_bf16(a[0], a[1]), cvt_pk_bf16(a[2], a[3])));
            }
        }
        __syncthreads();
    }
}
}

__device__ __forceinline__ void ph_scan_even2(KP p, int l, int bid, int nb) {
#pragma unroll 1
    for (int item = bid; item < 256; item += nb) {
        const int kind = item >> 7, b = (item >> 4) & 7, h = (item >> 2) & 3, dir = (item >> 1) & 1, vs = item & 1;
        if (kind == 0) sc::scan_item<0>(p, l, b, h, dir, vs); else sc::scan_item<1>(p, l, b, h, dir, vs);
        __syncthreads();
    }
}
__device__ __forceinline__ void ph_scan_odd2(KP p, int l, int bid, int nb) {
#pragma unroll 1
    for (int item = bid; item < 128; item += nb) {
        const int b = (item >> 4) & 7, h = (item >> 2) & 3, dir = (item >> 1) & 1, vs = item & 1;
        sc::scan_item<2>(p, l, b, h, dir, vs);
        __syncthreads();
    }
}

__device__ __forceinline__ void unpack16(const uint4 a, const uint4 b, float (&x)[16]) {
    x[0] = bflo(a.x); x[1] = bfhi(a.x); x[2] = bflo(a.y); x[3] = bfhi(a.y); x[4] = bflo(a.z); x[5] = bfhi(a.z); x[6] = bflo(a.w); x[7] = bfhi(a.w);
    x[8] = bflo(b.x); x[9] = bfhi(b.x); x[10] = bflo(b.y); x[11] = bfhi(b.y); x[12] = bflo(b.z); x[13] = bfhi(b.z); x[14] = bflo(b.w); x[15] = bfhi(b.w);
}
__device__ __forceinline__ float sum8(float v) { v += __shfl_xor(v, 1, 64); v += __shfl_xor(v, 2, 64); v += __shfl_xor(v, 4, 64); return v; }
template <bool MEANSUB, bool SIG>
__device__ __forceinline__ void head_norm_gate16(const bf16_t* h0, const bf16_t* h1, const bf16_t* gp, const float* nw, bf16_t* out) {
    float a[16], b[16], g[16];
    unpack16(*(const uint4*)h0, *(const uint4*)(h0 + 8), a); unpack16(*(const uint4*)h1, *(const uint4*)(h1 + 8), b); unpack16(*(const uint4*)gp, *(const uint4*)(gp + 8), g);
    float s = 0.f;
#pragma unroll
    for (int i = 0; i < 16; ++i) { a[i] += b[i]; s += a[i]; }
    if (MEANSUB) { const float mean = sum8(s) * (1.f / 128.f);
#pragma unroll
        for (int i = 0; i < 16; ++i) a[i] -= mean; }
    float q = 0.f;
#pragma unroll
    for (int i = 0; i < 16; ++i) q += a[i] * a[i];
    const float r = rsqrtf(sum8(q) * (1.f / 128.f) + LN_EPS);
    unsigned w[8];
#pragma unroll
    for (int i = 0; i < 16; i += 2) {
        const float y0 = a[i] * r * nw[i] * (SIG ? sigmoidf_(g[i]) : siluf_(g[i])), y1 = a[i + 1] * r * nw[i + 1] * (SIG ? sigmoidf_(g[i + 1]) : siluf_(g[i + 1]));
        w[i >> 1] = cvt_pk_bf16(y0, y1);
    }
    *(uint4*)out = make_uint4(w[0], w[1], w[2], w[3]); *(uint4*)(out + 8) = make_uint4(w[4], w[5], w[6], w[7]);
}
__device__ __forceinline__ void ph_normgate_even(KP p, int l, int bid, int nb) {
    const int tid = opaque_tid(), lane = tid & 63, wv = tid >> 6;
    const bf16_t* P = (const bf16_t*)(p->ws + OFF_BIG);
    const bf16_t* HX = (const bf16_t*)(p->ws + OFF_AUX);
    const bf16_t* HX1 = HX + (size_t)NT * 1024;
    bf16_t* MIX = (bf16_t*)(p->ws + OFF_U);
    const int e = l >> 1;
    const bool ml = lane < 32;
    const float* nw = ml ? p->in[I_MNW] + e * 512 + 16 * lane : p->in[I_HNW] + e * 512 + 16 * (lane - 32);
    const int gcol = ml ? E_MO + 16 * lane : E_HG + 16 * (lane - 32);
#pragma unroll 1
    for (int tok = bid * 8 + wv; tok < NT; tok += nb * 8) {
        const size_t o = (size_t)tok * 1024 + 16 * lane;
        if (ml) head_norm_gate16<true, true>(HX + o, HX1 + o, P + (size_t)tok * EVEN_LD + gcol, nw, MIX + o);
        else head_norm_gate16<false, false>(HX + o, HX1 + o, P + (size_t)tok * EVEN_LD + gcol, nw, MIX + o);
    }
}

#define OFF_UT   (OFF_AUX + 136 * MiB)
#define OFF_FKS(o) (984 * MiB + (size_t)(o) * 34 * MiB)
#define OFF_ZOT  (OFF_UT + 102 * MiB)

__device__ __forceinline__ void ph_hy_filt2(KP p, int l, int bid, int nb, float* sm, int skip) {
    const int tid = opaque_tid(), o = l >> 1;
    float* zf = sm;
    float* h1 = sm + 1024;
    float* h2 = sm + 2048;
    float* h3 = sm + 3072;
    const float* fw1 = p->in[I_HW1] + o * 33 * 64; const float* fb1 = p->in[I_HB1] + o * 64;
    const float* fw2 = p->in[I_HW2] + o * 64 * 64; const float* fb2 = p->in[I_HB2] + o * 64;
    const float* fw3 = p->in[I_HW3] + o * 64 * 64; const float* fb3 = p->in[I_HB3] + o * 64;
    const float* freq = p->in[I_HFREQ] + o * 64;
    const float* wout = p->in[I_HWOUT] + (size_t)o * 64 * 2048;
    float* FK = (float*)(p->ws + OFF_FKS(o)); float* FKC = FK + (size_t)2 * 512 * 8192;
#pragma unroll 1
    for (int item = bid - skip; item < (SEQ + CTXL) / 16; item += nb - skip) {
        if (item < 0) break;
        const bool isctx = item >= SEQ / 16;
        const int L = isctx ? CTXL : SEQ, pos0 = (isctx ? item - SEQ / 16 : item) * 16;
        __syncthreads();
        if (tid < 16 * 17) {
            const int pp = tid / 17, j = tid % 17, pos = pos0 + pp;
            if (j == 16) zf[pp * 36] = (float)pos / (float)(L - 1);
            else { const float f = 1e-4f + (float)j * ((15.0f - 1e-4f) / 15.0f); const float w = 2.0f * 3.14159265358979323846f * (float)pos / (float)L * f; zf[pp * 36 + 1 + j] = cosf(w); zf[pp * 36 + 17 + j] = sinf(w); }
        }
        __syncthreads();
        const int pp = tid >> 5, u0 = (tid & 31) * 2;
        { float a0 = fb1[u0], a1 = fb1[u0 + 1];
#pragma unroll 1
          for (int k = 0; k < 33; ++k) { const float z = zf[pp * 36 + k]; a0 += z * fw1[k * 64 + u0]; a1 += z * fw1[k * 64 + u0 + 1]; }
          h1[pp * 64 + u0] = sinf(freq[u0] * a0); h1[pp * 64 + u0 + 1] = sinf(freq[u0 + 1] * a1); }
        __syncthreads();
        { float a0 = fb2[u0], a1 = fb2[u0 + 1];
#pragma unroll 4
          for (int k = 0; k < 64; ++k) { const float z = h1[pp * 64 + k]; a0 += z * fw2[k * 64 + u0]; a1 += z * fw2[k * 64 + u0 + 1]; }
          h2[pp * 64 + u0] = sinf(freq[u0] * a0); h2[pp * 64 + u0 + 1] = sinf(freq[u0 + 1] * a1); }
        __syncthreads();
        { float a0 = fb3[u0], a1 = fb3[u0 + 1];
#pragma unroll 4
          for (int k = 0; k < 64; ++k) { const float z = h2[pp * 64 + k]; a0 += z * fw3[k * 64 + u0]; a1 += z * fw3[k * 64 + u0 + 1]; }
          h3[pp * 64 + u0] = sinf(freq[u0] * a0); h3[pp * 64 + u0 + 1] = sinf(freq[u0 + 1] * a1); }
        __syncthreads();
#pragma unroll 1
        for (int r = 0; r < 4; ++r) {
            const int col = tid + 512 * r, c = col & 511, od = col >> 9, order = od >> 1, dirn = od & 1;
            float a[16];
#pragma unroll
            for (int i = 0; i < 16; ++i) a[i] = 0.f;
#pragma unroll 2
            for (int k = 0; k < 64; ++k) { const float w = wout[k * 2048 + col];
#pragma unroll
                for (int i = 0; i < 16; ++i) a[i] += h3[i * 64 + k] * w; }
            const float delta = 3.0701134573253944f + (float)c * ((15.350567286626972f - 3.0701134573253944f) / 511.0f);
#pragma unroll
            for (int i = 0; i < 16; ++i) a[i] *= expf(-((float)(pos0 + i) / (float)(L - 1)) * delta);
            float* dst = isctx ? FKC + ((size_t)order * 512 + c) * 512 + 256 : FK + ((size_t)order * 512 + c) * 8192 + 4096;
            if (dirn == 0) {
#pragma unroll
                for (int i = 0; i < 16; i += 4) *(float4*)(dst + pos0 + i) = make_float4(a[i], a[i + 1], a[i + 2], a[i + 3]);
            } else {
#pragma unroll
                for (int i = 0; i < 16; ++i) if (pos0 + i > 0) dst[-(pos0 + i)] = a[i];
                if (pos0 == 0) dst[-L] = 0.f;
            }
        }
    }
}

__device__ __forceinline__ void ph_hy_prep(KP p, int l, int bid, int nb, float* sm) {
    const int tid = opaque_tid(), o = l >> 1;
    const bf16_t* P = (const bf16_t*)(p->ws + OFF_BIG);
    bf16_t* UT = (bf16_t*)(p->ws + OFF_UT);
    const float* cw = p->in[I_HCW] + o * 3 * 1536; const float* cb = p->in[I_HCB] + o * 1536;
    float* tile = sm;
#pragma unroll 1
    for (int item = bid; item < (NT / 256) * 24; item += nb) {
        const int tt = item / 24, ct = item % 24, tok0 = tt * 256, col0 = ct * 64;
        const bool lat = tok0 < NL;
        const int L = lat ? SEQ : CTXL, t0 = lat ? (tok0 & (SEQ - 1)) : ((tok0 - NL) & (CTXL - 1));
        __syncthreads();
#pragma unroll 1
        for (int i = tid; i < 258 * 8; i += 512) {
            const int rr = i >> 3, hf = i & 7, t = t0 + rr - 1;
            uint4 v = make_uint4(0u, 0u, 0u, 0u);
            if (t >= 0 && t < L) v = *(const uint4*)(P + (size_t)(tok0 + rr - 1) * ODD_LD + col0 + hf * 8);
            float* d = tile + rr * 65 + hf * 8;
            d[0] = bflo(v.x); d[1] = bfhi(v.x); d[2] = bflo(v.y); d[3] = bfhi(v.y); d[4] = bflo(v.z); d[5] = bfhi(v.z); d[6] = bflo(v.w); d[7] = bfhi(v.w);
        }
        __syncthreads();
#pragma unroll 1
        for (int r = 0; r < 4; ++r) {
            const int cc = (tid >> 5) + 16 * r, tc = (tid & 31) * 8, col = col0 + cc;
            const float w0 = cw[col], w1 = cw[1536 + col], w2 = cw[3072 + col], bb = cb[col];
            float y[8];
#pragma unroll
            for (int i = 0; i < 8; ++i) y[i] = tile[(tc + i) * 65 + cc] * w0 + tile[(tc + i + 1) * 65 + cc] * w1 + tile[(tc + i + 2) * 65 + cc] * w2 + bb;
            *(uint4*)(UT + (size_t)col * NT + tok0 + tc) = make_uint4(cvt_pk_bf16(y[0], y[1]), cvt_pk_bf16(y[2], y[3]), cvt_pk_bf16(y[4], y[5]), cvt_pk_bf16(y[6], y[7]));
        }
    }
}

__device__ __forceinline__ void hy_item_lat(KP p, int l, int c) {
    constexpr int ZSB = (SEQ + 8) * 2;
    constexpr unsigned O_Z = 0, O_KF = O_Z + 8 * ZSB, O_END = O_KF + 8192 * 4;
    static_assert(O_END <= BAR_LDS_, "hyena LDS");
    const int tid = opaque_tid(), lane = tid & 63, wv = __builtin_amdgcn_readfirstlane(tid >> 6), r16 = lane & 15, q4 = lane >> 4, o = l >> 1;
    const unsigned L0 = (unsigned)(size_t)smraw_base();
    const bf16_t* UT = (const bf16_t*)(p->ws + OFF_UT);
    bf16_t* ZOT = (bf16_t*)(p->ws + OFF_ZOT);
    const float* FK = (const float*)(p->ws + OFF_FKS(o));
    for (int i = tid; i < 8 * 512; i += 512) { const int b = i >> 9, ch = i & 511; sc::st16(L0 + O_Z + b * ZSB + ch * 16, *(const uint4*)(UT + (size_t)(1024 + c) * NT + b * SEQ + ch * 8)); }
#pragma unroll 1
    for (int order = 0; order < 2; ++order) {
        const float* fk = FK + ((size_t)order * 512 + c) * 8192;
        for (int i = tid; i < 2048; i += 512) { const float4 v = *(const float4*)(fk + i * 4); *(LAS sc::f32x4*)(size_t)(L0 + O_KF + i * 16) = (sc::f32x4){v.x, v.y, v.z, v.w}; }
        __syncthreads();
        sc::f32x4 acc[4][4];
#pragma unroll
        for (int a = 0; a < 4; ++a)
#pragma unroll
            for (int b2 = 0; b2 < 4; ++b2) acc[a][b2] = (sc::f32x4){0.f, 0.f, 0.f, 0.f};
        auto ldG = [&](int g) {
            const unsigned a0 = L0 + O_KF + (unsigned)(4096 + 16 * g + r16 - 8 * q4) * 4u;
            float v[8];
#pragma unroll
            for (int j = 0; j < 8; ++j) v[j] = *(const LAS float*)(size_t)(a0 - 4u * j);
            const unsigned w0 = cvt_pk_bf16(v[0], v[1]), w1 = cvt_pk_bf16(v[2], v[3]), w2 = cvt_pk_bf16(v[4], v[5]), w3 = cvt_pk_bf16(v[6], v[7]);
            return __builtin_bit_cast(sc::bf16x8, (sc::u32x4_){w0, w1, w2, w3});
        };
        sc::bf16x8 bq[4][2], W[6];
#pragma unroll
        for (int i = 0; i < 4; ++i) { bq[i][0] = (sc::bf16x8){0, 0, 0, 0, 0, 0, 0, 0}; bq[i][1] = bq[i][0]; }
        const int D0 = 8 * wv - 63, D1 = (8 * wv + 7 < 63) ? 8 * wv + 7 : 63;
        W[4] = ldG(4 * D0 - 6 + 4); W[5] = ldG(4 * D0 - 6 + 5);
#pragma unroll 1
        for (int D = D0; D <= D1; ++D) {
            W[0] = W[4]; W[1] = W[5];
#pragma unroll
            for (int i = 0; i < 4; ++i) W[2 + i] = ldG(4 * D + i);
            bq[3][0] = bq[2][0]; bq[3][1] = bq[2][1]; bq[2][0] = bq[1][0]; bq[2][1] = bq[1][1]; bq[1][0] = bq[0][0]; bq[1][1] = bq[0][1];
            {
                const int s1 = 8 * wv - D + ((r16 < 8) ? 0 : 4);
                const bool ok = (unsigned)s1 < 64u;
                const unsigned za = L0 + O_Z + (unsigned)((r16 & 7) * ZSB + ((ok ? s1 : 0) * 64 + q4 * 8) * 2);
                sc::bf16x8 b0 = *(const LAS sc::bf16x8*)(size_t)za, b1 = *(const LAS sc::bf16x8*)(size_t)(za + 64);
                if (!ok) { b0 = (sc::bf16x8){0, 0, 0, 0, 0, 0, 0, 0}; b1 = b0; }
                bq[0][0] = b0; bq[0][1] = b1;
            }
#pragma unroll
            for (int cg = 0; cg < 4; ++cg) {
                const int sA = 8 * wv + cg - D;
                if ((unsigned)sA < 64u || (unsigned)(sA + 4) < 64u) {
#pragma unroll
                    for (int it = 0; it < 4; ++it) { acc[cg][it] = SC_MFMA(W[it + 2], bq[cg][0], acc[cg][it]); acc[cg][it] = SC_MFMA(W[it], bq[cg][1], acc[cg][it]); }
                }
            }
        }
        __syncthreads();
        const float sk = p->in[I_HSKIP][o * 1024 + order * 512 + c];
        const bf16_t* gt = UT + (size_t)(order * 512 + c) * NT;
        const int bb = r16 & 7;
#pragma unroll
        for (int cg = 0; cg < 4; ++cg) {
            const int t1 = 8 * wv + cg + ((r16 < 8) ? 0 : 4);
#pragma unroll
            for (int it = 0; it < 4; ++it) {
                const int t = t1 * 64 + it * 16 + q4 * 4;
                const sc::u32x2_ zo_ = *(const LAS sc::u32x2_*)(size_t)(L0 + O_Z + bb * ZSB + t * 2); const uint2 zo = make_uint2(zo_[0], zo_[1]);
                const uint2 gv = *(const uint2*)(gt + bb * SEQ + t);
                const float y0 = bflo(gv.x) * (acc[cg][it][0] + sk * bflo(zo.x)), y1 = bfhi(gv.x) * (acc[cg][it][1] + sk * bfhi(zo.x));
                const float y2 = bflo(gv.y) * (acc[cg][it][2] + sk * bflo(zo.y)), y3 = bfhi(gv.y) * (acc[cg][it][3] + sk * bfhi(zo.y));
                const uint2 w = make_uint2(cvt_pk_bf16(y0, y1), cvt_pk_bf16(y2, y3));
                if (order == 0) sc::st8(L0 + O_Z + bb * ZSB + t * 2, w);
                else *(uint2*)(ZOT + (size_t)c * NT + bb * SEQ + t) = w;
            }
        }
        __syncthreads();
    }
}

__device__ __forceinline__ void hy_item_ctx(KP p, int l, int c, float* sm) {
    const int tid = opaque_tid(), o = l >> 1;
    const bf16_t* UT = (const bf16_t*)(p->ws + OFF_UT);
    bf16_t* ZOT = (bf16_t*)(p->ws + OFF_ZOT);
    const float* FKC = (const float*)(p->ws + OFF_FKS(o)) + (size_t)2 * 512 * 8192;
    float* Kc = sm;
    float* zb = sm + 1024;
    for (int i = tid; i < 1024; i += 512) Kc[i] = FKC[((size_t)(i >> 9) * 512 + c) * 512 + (i & 511)];
    for (int i = tid; i < 8 * CTXL; i += 512) zb[i] = bf2f(UT[(size_t)(1024 + c) * NT + NL + i]);
    __syncthreads();
    const int bb = tid >> 6, tl = tid & 63;
#pragma unroll 1
    for (int order = 0; order < 2; ++order) {
        float acc[4] = {0.f, 0.f, 0.f, 0.f};
#pragma unroll 4
        for (int s = 0; s < CTXL; ++s) {
            const float zv = zb[bb * CTXL + s];
#pragma unroll
            for (int i = 0; i < 4; ++i) acc[i] += Kc[order * 512 + tl + 64 * i - s + 256] * zv;
        }
        const float sk = p->in[I_HSKIP][o * 1024 + order * 512 + c];
        float zn[4];
#pragma unroll
        for (int i = 0; i < 4; ++i) { const int t = tl + 64 * i; zn[i] = bf2f(UT[(size_t)(order * 512 + c) * NT + NL + bb * CTXL + t]) * (acc[i] + zb[bb * CTXL + t] * sk); }
        __syncthreads();
#pragma unroll
        for (int i = 0; i < 4; ++i) { const int t = tl + 64 * i; if (order == 0) zb[bb * CTXL + t] = bf2f((bf16_t)(cvt_pk_bf16(zn[i], 0.f) & 0xffffu)); else stf(ZOT + (size_t)c * NT + NL + bb * CTXL + t, zn[i]); }
        __syncthreads();
    }
}

__device__ __forceinline__ void ph_mix_odd(KP p, int l, int bid, int nb, float* sm) {
    int* head = (int*)(p->ws + OFF_CNT) + 1024 + (l >> 1) * 64;
    LAS int* slot = (LAS int*)(smraw_base() + BAR_LDS_ + 64);
#pragma unroll 1
    for (;;) {
        if (opaque_tid() == 0) *slot = atomicAdd(head, 1);
        __syncthreads();
        const int item = *slot;
        __syncthreads();
        if (item >= 128 + 512) break;
        if (item < 128) { const int b = (item >> 4) & 7, h = (item >> 2) & 3, dir = (item >> 1) & 1, vs = item & 1; sc::scan_item<2>(p, l, b, h, dir, vs); }
        else { const int c = item - 128; hy_item_lat(p, l, c); __syncthreads(); hy_item_ctx(p, l, c, sm); }
        __syncthreads();
    }
}

__device__ __forceinline__ void ph_hy_norm(KP p, int l, int bid, int nb, float* sm) {
    const int tid = opaque_tid(), o = l >> 1;
    const bf16_t* ZOT = (const bf16_t*)(p->ws + OFF_ZOT);
    bf16_t* MIX = (bf16_t*)(p->ws + OFF_U);
    const float* nw = p->in[I_HNORM] + o * 512;
    float* tile = sm;
    float* part = sm + 64 * 65;
#pragma unroll 1
    for (int item = bid; item < (NT / 64) * 8; item += nb) {
        const int tt = item >> 3, g = item & 7, tok0 = tt * 64;
        __syncthreads();
        { const int cc = tid >> 3, ch = tid & 7;
          const uint4 v = *(const uint4*)(ZOT + (size_t)(g * 64 + cc) * NT + tok0 + ch * 8);
          float* d = tile + cc * 65 + ch * 8;
          d[0] = bflo(v.x); d[1] = bfhi(v.x); d[2] = bflo(v.y); d[3] = bfhi(v.y); d[4] = bflo(v.z); d[5] = bfhi(v.z); d[6] = bflo(v.w); d[7] = bfhi(v.w); }
        __syncthreads();
        { const int tk = tid & 63, pt = tid >> 6; float s = 0.f;
#pragma unroll
          for (int i = 0; i < 8; ++i) { const float x = tile[(pt * 8 + i) * 65 + tk]; s += x * x; }
          part[pt * 64 + tk] = s; }
        __syncthreads();
        { const int tk = tid >> 3, ch = tid & 7; float s = 0.f;
#pragma unroll
          for (int i = 0; i < 8; ++i) s += part[i * 64 + tk];
          const float rs = rsqrtf(s * (1.f / 64.f) + LN_EPS);
          float y[8];
#pragma unroll
          for (int i = 0; i < 8; ++i) y[i] = tile[(ch * 8 + i) * 65 + tk] * rs * nw[g * 64 + ch * 8 + i];
          *(uint4*)(MIX + (size_t)(tok0 + tk) * DM + g * 64 + ch * 8) = make_uint4(cvt_pk_bf16(y[0], y[1]), cvt_pk_bf16(y[2], y[3]), cvt_pk_bf16(y[4], y[5]), cvt_pk_bf16(y[6], y[7])); }
    }
}

__device__ __forceinline__ void ph_normgate_odd(KP p, int l, int bid, int nb) {
    const int tid = opaque_tid(), lane = tid & 63, wv = tid >> 6, o2 = l >> 1;
    const bf16_t* P = (const bf16_t*)(p->ws + OFF_BIG);
    const bf16_t* HX = (const bf16_t*)(p->ws + OFF_AUX);
    const bf16_t* HX1 = HX + (size_t)NT * 1024;
    bf16_t* MIX = (bf16_t*)(p->ws + OFF_U);
    const int c16 = 16 * (lane & 31);
    const float* nw = p->in[I_RNW] + o2 * 512 + c16;
#pragma unroll 1
    for (int t2 = bid * 8 + wv; t2 < NT / 2; t2 += nb * 8) {
        const int tok = t2 * 2 + (lane >> 5);
        const size_t o = (size_t)tok * 1024 + 512 + c16;
        head_norm_gate16<true, false>(HX + o, HX1 + o, P + (size_t)tok * ODD_LD + 3072 + c16, nw, MIX + o);
    }
}

__device__ __forceinline__ void ph_ln1_router(KP p, int l, int ntok, int bid, int nb, float* sm) {
    const int tid = opaque_tid(), lane = tid & 63, wv = __builtin_amdgcn_readfirstlane(tid >> 6);
    const float* Y = (const float*)(p->ws + OFF_BIG);
    bf16_t* U = (bf16_t*)(p->ws + OFF_U);
    const float* lw = p->in[I_LNW] + (l * 2) * 1024; const float* lb = p->in[I_LNB] + (l * 2) * 1024;
    const float* rw = p->in[I_RW] + (size_t)l * 1024 * 64;
    const float rb = p->in[I_RB][l * 64 + lane];
    LAS int* lcnt = (LAS int*)(smraw_base() + BAR_LDS_ + 256);
    if (tid < 64) lcnt[tid] = 0;
    __syncthreads();
    int* tidx = (int*)(p->ws + OFF_TIDX); float* tgate = (float*)(p->ws + OFF_TGATE); int* tpos = (int*)(p->ws + OFF_TPOS);
    LAS float* Vall = (LAS float*)smraw_base();
    {
        int* stok = (int*)(p->ws + OFF_STOK); float* sgate = (float*)(p->ws + OFF_SGATE); int* sdst = (int*)(p->ws + OFF_SDST);
#pragma unroll 1
        for (int i = bid * 512 + tid; i < MAXROWS; i += nb * 512) { stok[i] = ZROW; sgate[i] = 0.f; sdst[i] = -1; }
    }
#pragma unroll 1
    for (int base = bid * 32; base < ntok; base += nb * 32) {
#pragma unroll 2
        for (int j = 0; j < 4; ++j) {
            const int tok = base + wv * 4 + j;
            float* h = hrow(p, tok);
            const float* m = modrow(p, l, tok);
            const float* r = Y + (size_t)tok * DM;
            float x[16]; float s = 0.f;
#pragma unroll
            for (int c = 0; c < 4; ++c) {
                const int d = 4 * (lane + 64 * c);
                const float4 hv = *(const float4*)(h + d), gv = *(const float4*)(m + 2 * 1024 + d), rv = *(const float4*)(r + d);
                x[4 * c] = ALPHA * hv.x + gv.x * rv.x; x[4 * c + 1] = ALPHA * hv.y + gv.y * rv.y; x[4 * c + 2] = ALPHA * hv.z + gv.z * rv.z; x[4 * c + 3] = ALPHA * hv.w + gv.w * rv.w;
                s += x[4 * c] + x[4 * c + 1] + x[4 * c + 2] + x[4 * c + 3];
            }
            const float mean = wave_sum(s) * (1.f / 1024.f);
            float q = 0.f;
#pragma unroll
            for (int i = 0; i < 16; ++i) { x[i] -= mean; q += x[i] * x[i]; }
            const float rs = rsqrtf(wave_sum(q) * (1.f / 1024.f) + LN_EPS);
#pragma unroll
            for (int c = 0; c < 4; ++c) {
                const int d = 4 * (lane + 64 * c);
                const float4 w4 = *(const float4*)(lw + d), b4 = *(const float4*)(lb + d), sh = *(const float4*)(m + 3 * 1024 + d), sc = *(const float4*)(m + 4 * 1024 + d);
                float4 y; y.x = x[4 * c] * rs * w4.x + b4.x; y.y = x[4 * c + 1] * rs * w4.y + b4.y; y.z = x[4 * c + 2] * rs * w4.z + b4.z; y.w = x[4 * c + 3] * rs * w4.w + b4.w;
                *(float4*)(h + d) = y;
                float4 v; v.x = y.x * (1.f + sc.x) + sh.x; v.y = y.y * (1.f + sc.y) + sh.y; v.z = y.z * (1.f + sc.z) + sh.z; v.w = y.w * (1.f + sc.w) + sh.w;
                *(uint2*)(U + (size_t)tok * DM + d) = make_uint2(cvt_pk_bf16(v.x, v.y), cvt_pk_bf16(v.z, v.w));
                *(LAS sc::f32x4*)(Vall + (wv * 4 + j) * 1024 + d) = (sc::f32x4){v.x, v.y, v.z, v.w};
            }
        }
        __syncthreads();
        float a[32];
#pragma unroll
        for (int t = 0; t < 32; ++t) a[t] = 0.f;
#pragma unroll 1
        for (int d = wv * 128; d < wv * 128 + 128; d += 4) {
            const float w0 = rw[(d + 0) * 64 + lane], w1 = rw[(d + 1) * 64 + lane], w2 = rw[(d + 2) * 64 + lane], w3 = rw[(d + 3) * 64 + lane];
#pragma unroll
            for (int t = 0; t < 32; ++t) { const sc::f32x4 v = *(const LAS sc::f32x4*)(Vall + t * 1024 + d); a[t] += v[0] * w0 + v[1] * w1 + v[2] * w2 + v[3] * w3; }
        }
        __syncthreads();
#pragma unroll
        for (int t = 0; t < 32; ++t) Vall[(wv * 32 + t) * 64 + lane] = a[t];
        __syncthreads();
#pragma unroll 1
        for (int j = 0; j < 4; ++j) {
            const int tl = wv * 4 + j, tok = base + tl;
            float lg = 0.f;
#pragma unroll
            for (int w = 0; w < 8; ++w) lg += Vall[(w * 32 + tl) * 64 + lane];
            const float score = sigmoidf_(lg);
            const float key = score + rb;
            int rank = 0;
#pragma unroll
            for (int e = 0; e < 64; ++e) { const float ke = __builtin_bit_cast(float, __builtin_amdgcn_readlane(__builtin_bit_cast(int, key), e)); rank += (ke > key || (ke == key && e < lane)) ? 1 : 0; }
            const bool sel = rank < TOPK;
            const float gsum = wave_sum(sel ? score : 0.f);
            if (sel) {
                const int pos = __hip_atomic_fetch_add(lcnt + lane, 1, __ATOMIC_RELAXED, __HIP_MEMORY_SCOPE_WORKGROUP);
                tidx[tok * 8 + rank] = lane; tgate[tok * 8 + rank] = 2.5f * score / gsum; tpos[tok * 8 + rank] = pos;
            }
        }
        __syncthreads();
    }
    __syncthreads();
    if (tid < 64) ((int*)(p->ws + OFF_BCNT))[bid * 64 + tid] = lcnt[tid];
}

__device__ __forceinline__ void moe_offsets(KP p, int l, int ntok, LAS int* offs) {
    const int t = opaque_tid();
    if (t < 66) offs[t] = ((const int*)(p->ws + OFF_GOFFS))[t];
    __syncthreads();
}
__device__ __forceinline__ int moe_expert_of(const LAS int* offs, int row) { int e = 0;
#pragma unroll 1
    while (e < 64 && row >= offs[e + 1]) ++e;
    return e; }

__device__ __forceinline__ void ph_scatter(KP p, int l, int ntok, int bid, int nb, LAS unsigned char* lds) {
    LAS int* offs = (LAS int*)lds;
    LAS int* myb = offs + 128;
    LAS int* part = offs + 256;
    const int tid = opaque_tid();
    const int* bcnt = (const int*)(p->ws + OFF_BCNT);
    { const int e = tid & 63, pt = tid >> 6; int tot = 0, mine = 0;
#pragma unroll 4
      for (int b = pt; b < nb; b += 8) { const int c = bcnt[b * 64 + e]; tot += c; mine += (b < bid) ? c : 0; }
      part[pt * 64 + e] = tot; part[512 + pt * 64 + e] = mine; }
    __syncthreads();
    if (tid < 64) {
        int tot = 0, mine = 0;
#pragma unroll
        for (int i = 0; i < 8; ++i) { tot += part[i * 64 + tid]; mine += part[512 + i * 64 + tid]; }
        const int pc = (tot + 255) & ~255;
        int incl = pc;
#pragma unroll
        for (int o = 1; o < 64; o <<= 1) { const int t = __shfl_up(incl, o, 64); if (tid >= o) incl += t; }
        offs[tid] = incl - pc; myb[tid] = mine;
        if (tid == 63) { offs[64] = incl; offs[65] = incl + ntok; }
    }
    __syncthreads();
    if (bid == 0 && tid < 66) ((int*)(p->ws + OFF_GOFFS))[tid] = offs[tid];
    const int* tidx = (const int*)(p->ws + OFF_TIDX); const float* tgate = (const float*)(p->ws + OFF_TGATE); const int* tpos = (const int*)(p->ws + OFF_TPOS);
    int* stok = (int*)(p->ws + OFF_STOK); float* sgate = (float*)(p->ws + OFF_SGATE); int* sdst = (int*)(p->ws + OFF_SDST);
    int* tile_e = (int*)(p->ws + OFF_TILEE);
#pragma unroll 1
    for (int base = bid * 32; base < ntok; base += nb * 32) {
        if (tid < 32 * 9) {
            const int tok = base + tid / 9, sl = tid % 9;
            if (sl < 8) { const int i = tok * 8 + sl, e = tidx[i], row = offs[e] + myb[e] + tpos[i]; stok[row] = tok; sgate[row] = tgate[i]; sdst[row] = tok * 9 + sl; }
            else { const int row = offs[64] + tok; stok[row] = tok; sgate[row] = 1.f; sdst[row] = tok * 9 + 8; }
        }
    }
    const int nrt = offs[65] >> 8;
#pragma unroll 1
    for (int rt = bid * 512 + tid; rt < nrt; rt += nb * 512) tile_e[rt] = moe_expert_of(offs, rt * 256);
    __syncthreads();
}

#define MOE_TAB (gp::STAGE_BYTES + 256)
#define MOE_MAXT 9
static_assert(131072 + 256 + 256 + MOE_MAXT * 2048 <= BAR_LDS_, "MoE tables");
struct MoeDeal {
    int nfull, rem, c, G;
    __device__ __forceinline__ void init(int nrt, int c_, int G_) { nfull = nrt / G_; rem = nrt % G_; c = c_; G = G_; }
    __device__ __forceinline__ int nleft(int NPN) const { const int tot = rem * NPN; return c < tot ? (tot - c + G - 1) / G : 0; }
    __device__ __forceinline__ int ntiles(int NPN) const { return nfull + nleft(NPN); }
    __device__ __forceinline__ int tile_of(int j, int NPN) const { return j < nfull ? c + j * G : nfull * G + (c + (j - nfull) * G) / NPN; }
    __device__ __forceinline__ bool unit(int i, int NPN, int& j, int& pn) const {
        if (i < nfull * NPN) { j = i / NPN; pn = i % NPN; return true; }
        const int k = i - nfull * NPN, lu = c + k * G;
        if (lu < rem * NPN) { j = nfull + k; pn = lu % NPN; return true; }
        return false;
    }
};
struct Moe1Sched {
    const char* U; const char* W; const LAS int* tabE; const LAS int* tabS; MoeDeal d;
    __device__ __forceinline__ bool next(int i, gp::Unit& u) const {
        int j, pn; if (!d.unit(i, 2, j, pn)) return false;
        u.A = U; u.B = W + (size_t)tabE[j] * (512 * 1024 * 2) + (size_t)pn * (256 * 1024 * 2); u.r0 = d.tile_of(j, 2) * 256; u.c0 = pn * 256; u.aux = j; return true;
    }
    __device__ __forceinline__ void lane_off(const gp::Unit& u, unsigned (&vo)[2][2]) const {
        const int tid = opaque_tid(); int R0, C0, R1, C1; gp::stage_rc(tid * 16, R0, C0); gp::stage_rc(tid * 16 + 8192, R1, C1);
        const LAS int* t = tabS + u.aux * 256;
        vo[0][0] = (unsigned)t[R0] * 2048u + (unsigned)C0 * 2u; vo[0][1] = (unsigned)t[R1] * 2048u + (unsigned)C1 * 2u;
        vo[1][0] = (unsigned)t[128 + R0] * 2048u + (unsigned)C0 * 2u; vo[1][1] = (unsigned)t[128 + R1] * 2048u + (unsigned)C1 * 2u;
    }
};
struct EpiH {
    bf16_t* H;
    __device__ __forceinline__ void operator()(const gp::f32x4 (&acc)[2][2][4][2], const gp::Unit& u, int wr, int wc, int fr, int fq) const {
        const int row0 = u.r0 + wr * 64 + fr;
#pragma unroll
        for (int ai = 0; ai < 2; ++ai)
#pragma unroll
            for (int m = 0; m < 4; ++m) { bf16_t* rowp = H + (size_t)(row0 + ai * 128 + m * 16) * 256;
#pragma unroll
                for (int bj = 0; bj < 2; ++bj) {
                    const int j0 = ((u.c0 + bj * 128 + wc * 32) >> 5) * 16 + 4 * fq;
                    const gp::f32x4 a = acc[ai][bj][m][0], b = acc[ai][bj][m][1];
                    const float h0 = siluf_(a[0]) * b[0], h1 = siluf_(a[1]) * b[1], h2 = siluf_(a[2]) * b[2], h3 = siluf_(a[3]) * b[3];
                    *(uint2*)(rowp + j0) = make_uint2(cvt_pk_bf16(h0, h1), cvt_pk_bf16(h2, h3)); }
                __builtin_amdgcn_sched_barrier(0); }
    }
};
__device__ __forceinline__ void ph_moe1(KP p, int l, int ntok, int bid, int nb, LAS unsigned char* lds) {
    LAS int* tabE = (LAS int*)(lds + MOE_TAB);
    LAS int* tabS = tabE + 64;
    const int tid = opaque_tid();
    MoeDeal d; d.init(((const int*)(p->ws + OFF_GOFFS))[65] >> 8, bid, nb);
    const int nper = d.ntiles(2);
    const int* stok = (const int*)(p->ws + OFF_STOK); const int* tile_e = (const int*)(p->ws + OFF_TILEE);
    for (int i = tid; i < nper * 256; i += 512) tabS[i] = stok[(size_t)d.tile_of(i >> 8, 2) * 256 + (i & 255)];
    if (tid < nper) tabE[tid] = tile_e[d.tile_of(tid, 2)];
    __syncthreads();
    Moe1Sched S{(const char*)(p->ws + OFF_U), (const char*)(p->ws + OFF_W13), tabE, tabS, d};
    EpiH E{(bf16_t*)(p->ws + OFF_BIG)};
    gp::gemm_phase<true, false>(lds, 1024, S, E);
}

struct Moe2Sched {
    const char* H; const char* W; const LAS int* tabE; MoeDeal d;
    __device__ __forceinline__ bool next(int i, gp::Unit& u) const {
        int j, pn; if (!d.unit(i, 4, j, pn)) return false;
        u.A = H + (size_t)d.tile_of(j, 4) * (256 * 256 * 2); u.B = W + (size_t)tabE[j] * (1024 * 256 * 2) + (size_t)pn * (256 * 256 * 2); u.r0 = j * 256; u.c0 = pn * 256; u.aux = j; return true;
    }
    __device__ __forceinline__ void lane_off(const gp::Unit&, unsigned (&)[2][2]) const {}
};
struct EpiY {
    bf16_t* Ys; const LAS int* tabD; const LAS float* tabG;
    __device__ __forceinline__ void operator()(const gp::f32x4 (&acc)[2][2][4][2], const gp::Unit& u, int wr, int wc, int fr, int fq) const {
        const int rl0 = u.r0 + wr * 64 + fr, col0 = u.c0 + wc * 32 + 8 * fq;
#pragma unroll
        for (int ai = 0; ai < 2; ++ai)
#pragma unroll
            for (int m = 0; m < 4; ++m) {
                const int rl = rl0 + ai * 128 + m * 16;
                const int dst = tabD[rl]; const float g = tabG[rl];
                if (dst >= 0) { bf16_t* rowp = Ys + (size_t)dst * 1024 + col0;
#pragma unroll
                    for (int bj = 0; bj < 2; ++bj) { const gp::f32x4 v0 = acc[ai][bj][m][0] * g, v1 = acc[ai][bj][m][1] * g;
                        gp::u32x4 w; w.x = cvt_pk_bf16(v0[0], v0[1]); w.y = cvt_pk_bf16(v0[2], v0[3]); w.z = cvt_pk_bf16(v1[0], v1[1]); w.w = cvt_pk_bf16(v1[2], v1[3]);
                        *(gp::u32x4*)(rowp + bj * 128) = w; } }
                __builtin_amdgcn_sched_barrier(0); }
    }
};
__device__ __forceinline__ void ph_moe2(KP p, int l, int ntok, int bid, int nb, LAS unsigned char* lds) {
    LAS int* tabE = (LAS int*)(lds + MOE_TAB);
    LAS int* tabD = tabE + 64;
    LAS float* tabG = (LAS float*)(tabD + MOE_MAXT * 256);
    const int tid = opaque_tid();
    MoeDeal d; d.init(((const int*)(p->ws + OFF_GOFFS))[65] >> 8, bid, nb);
    const int nper = d.ntiles(4);
    const int* sdst = (const int*)(p->ws + OFF_SDST); const float* sgate = (const float*)(p->ws + OFF_SGATE); const int* tile_e = (const int*)(p->ws + OFF_TILEE);
    for (int i = tid; i < nper * 256; i += 512) { const size_t r = (size_t)d.tile_of(i >> 8, 4) * 256 + (i & 255); tabD[i] = sdst[r]; tabG[i] = sgate[r]; }
    if (tid < nper) tabE[tid] = tile_e[d.tile_of(tid, 4)];
    __syncthreads();
    Moe2Sched S{(const char*)(p->ws + OFF_BIG), (const char*)(p->ws + OFF_W2), tabE, d};
    EpiY E{(bf16_t*)(p->ws + OFF_YS), tabD, tabG};
    gp::gemm_phase<false, true>(lds, 256, S, E);
}

template <bool NEXT>
__device__ __forceinline__ void ph_combine_ln2(KP p, int l, int ntok, int bid, int nb) {
    bf16_t* U = (bf16_t*)(p->ws + OFF_U);
    float* G = (float*)(p->ws + OFF_G);
    const bool gates = NEXT && ((l + 1) & 1) == 0;
    LAS float* wl = (LAS float*)smraw_base();
    if (gates) stage_gate_w(p, (l + 1) >> 1, wl);
    const int tid = opaque_tid(), lane = tid & 63, wv = tid >> 6;
    const bf16_t* Ys = (const bf16_t*)(p->ws + OFF_YS);
    const float* lw = p->in[I_LNW] + (l * 2 + 1) * 1024; const float* lb = p->in[I_LNB] + (l * 2 + 1) * 1024;
    #pragma unroll 1
    for (int tok = bid * 8 + wv; tok < ntok; tok += nb * 8) {
        float* h = hrow(p, tok);
        const float* m = modrow(p, l, tok);
        const float* m2 = modrow(p, NEXT ? l + 1 : l, tok);
        float ga[16], u16[16];
#pragma unroll
        for (int j = 0; j < 16; ++j) { ga[j] = 0.f; u16[j] = 0.f; }
        float f[16];
#pragma unroll
        for (int i = 0; i < 16; ++i) f[i] = 0.f;
#pragma unroll
        for (int s = 0; s < 9; ++s)
#pragma unroll
            for (int c = 0; c < 2; ++c) {
                const uint4 w = *(const uint4*)(Ys + ((size_t)tok * 9 + s) * 1024 + 8 * (lane + 64 * c));
                f[8 * c + 0] += bflo(w.x); f[8 * c + 1] += bfhi(w.x); f[8 * c + 2] += bflo(w.y); f[8 * c + 3] += bfhi(w.y);
                f[8 * c + 4] += bflo(w.z); f[8 * c + 5] += bfhi(w.z); f[8 * c + 6] += bflo(w.w); f[8 * c + 7] += bfhi(w.w);
            }
        float x[16]; float sum = 0.f;
#pragma unroll
        for (int c = 0; c < 2; ++c)
#pragma unroll
            for (int q = 0; q < 2; ++q) {
                const int d = 8 * (lane + 64 * c) + 4 * q;
                const float4 hv = *(const float4*)(h + d), gv = *(const float4*)(m + 5 * 1024 + d);
                x[8 * c + 4 * q + 0] = ALPHA * hv.x + gv.x * f[8 * c + 4 * q + 0]; x[8 * c + 4 * q + 1] = ALPHA * hv.y + gv.y * f[8 * c + 4 * q + 1];
                x[8 * c + 4 * q + 2] = ALPHA * hv.z + gv.z * f[8 * c + 4 * q + 2]; x[8 * c + 4 * q + 3] = ALPHA * hv.w + gv.w * f[8 * c + 4 * q + 3];
                sum += x[8 * c + 4 * q] + x[8 * c + 4 * q + 1] + x[8 * c + 4 * q + 2] + x[8 * c + 4 * q + 3];
            }
        const float mean = wave_sum(sum) * (1.f / 1024.f);
        float q2 = 0.f;
#pragma unroll
        for (int i = 0; i < 16; ++i) { x[i] -= mean; q2 += x[i] * x[i]; }
        const float rs = rsqrtf(wave_sum(q2) * (1.f / 1024.f) + LN_EPS);
#pragma unroll
        for (int c = 0; c < 2; ++c)
#pragma unroll
            for (int q = 0; q < 2; ++q) {
                const int d = 8 * (lane + 64 * c) + 4 * q;
                const float4 w4 = *(const float4*)(lw + d), b4 = *(const float4*)(lb + d);
                float4 y; y.x = x[8 * c + 4 * q] * rs * w4.x + b4.x; y.y = x[8 * c + 4 * q + 1] * rs * w4.y + b4.y; y.z = x[8 * c + 4 * q + 2] * rs * w4.z + b4.z; y.w = x[8 * c + 4 * q + 3] * rs * w4.w + b4.w;
                *(float4*)(h + d) = y;
                if (NEXT) {
                    const float4 sh = *(const float4*)(m2 + d), sc = *(const float4*)(m2 + 1024 + d);
                    const float uu[4] = {y.x * (1.f + sc.x) + sh.x, y.y * (1.f + sc.y) + sh.y, y.z * (1.f + sc.z) + sh.z, y.w * (1.f + sc.w) + sh.w};
                    *(uint2*)(U + (size_t)tok * DM + d) = make_uint2(cvt_pk_bf16(uu[0], uu[1]), cvt_pk_bf16(uu[2], uu[3]));
                    u16[8 * c + 4 * q] = uu[0]; u16[8 * c + 4 * q + 1] = uu[1]; u16[8 * c + 4 * q + 2] = uu[2]; u16[8 * c + 4 * q + 3] = uu[3];
                }
            }
        if (gates) {
#pragma unroll
            for (int g4 = 0; g4 < 4; ++g4) {
                const int d = 8 * (lane + 64 * (g4 >> 1)) + 4 * (g4 & 1);
#pragma unroll
                for (int qq = 0; qq < 4; ++qq) {
#pragma unroll
                    for (int j4 = 0; j4 < 4; ++j4) { const f32x4_l w = *(const LAS f32x4_l*)(wl + (d + qq) * 16 + j4 * 4); const float uv = u16[4 * g4 + qq]; ga[4 * j4] += uv * w[0]; ga[4 * j4 + 1] += uv * w[1]; ga[4 * j4 + 2] += uv * w[2]; ga[4 * j4 + 3] += uv * w[3]; }
                }
                __builtin_amdgcn_sched_barrier(0);
            }
            float mine = 0.f;
#pragma unroll
            for (int j = 0; j < 16; ++j) { const float sg = wave_sum(ga[j]); if (lane == j) mine = sg; }
            if (lane < 16) G[(size_t)tok * 16 + lane] = mine;
        }
    }
}

#define MEGA_LDS (131072 + 256 + 20480)
#define NBLK 256
#define BAR_LDS BAR_LDS_
#define SYNC() do { XcdBarrier _b; _b.bar = (unsigned*)kparams()->ws; _b.x = xb_xcc_id(); _b.st = (volatile LAS unsigned*)((LAS unsigned char*)smraw_base() + BAR_LDS); xcd_barrier(_b); } while (0)
template <int PAR>
__device__ __forceinline__ void layer_fwd(const int l) {
    LAS unsigned char* lds = smraw_base(); float* sm = (float*)smraw_generic();
    const int bid = blockIdx.x; constexpr int nb = NBLK;
    const int ntok = (l == 3) ? NL : NT;
    ph_gemm_in(kparams(), l, bid, nb, lds); SYNC();
    if (PAR == 0) {
        ph_scan_even2(kparams(), l, bid, nb); SYNC();
        ph_normgate_even(kparams(), l, bid, nb); SYNC();
    } else {
        ph_hy_prep(kparams(), l, bid, nb, sm); SYNC();
        ph_mix_odd(kparams(), l, bid, nb, sm); SYNC();
        ph_hy_norm(kparams(), l, bid, nb, sm); ph_normgate_odd(kparams(), l, bid, nb); SYNC();
    }
    ph_gemm_out(kparams(), l, bid, nb, lds); SYNC();
    ph_ln1_router(kparams(), l, ntok, bid, nb, sm); SYNC();
    ph_scatter(kparams(), l, ntok, bid, nb, lds); SYNC();
    ph_moe1(kparams(), l, ntok, bid, nb, lds); SYNC();
    ph_moe2(kparams(), l, ntok, bid, nb, lds); SYNC();
    if (l < 3) { ph_combine_ln2<true>(kparams(), l, ntok, bid, nb); ph_convert(kparams(), l + 1, bid, nb, sm); SYNC(); }
    else ph_combine_ln2<false>(kparams(), l, ntok, bid, nb);
}
__global__ void __launch_bounds__(512, 2) mega_fwd(Params p) {
    LAS unsigned char* lds = smraw_base(); float* sm = (float*)smraw_generic();
    {
        const int t0 = threadIdx.x;
        if ((t0 & 63) == 0) { unsigned h; asm volatile("s_getreg_b32 %0, hwreg(HW_REG_HW_ID, 0, 6)" : "=s"(h)); *(LAS int*)(size_t)(WTAB_LDS + (h & 63u) * 4u) = t0 >> 6; }
        if (t0 < 4) ((LAS unsigned*)(lds + BAR_LDS))[t0] = 0u;
    }
    __syncthreads();
    (void)xcd_barrier_post((unsigned*)kparams()->ws, (volatile LAS unsigned*)(lds + BAR_LDS));
    const int bid = blockIdx.x; constexpr int nb = NBLK;
    ph_prologue(kparams(), bid, nb, sm);
    __syncthreads();
    ph_hy_filt2(kparams(), 1, bid, nb, sm, 48); __syncthreads(); ph_hy_filt2(kparams(), 3, bid, nb, sm, 48);
    SYNC();
    ph_convert(kparams(), 0, bid, nb, sm); ph_modin(kparams(), 0, bid, nb); SYNC();
#pragma unroll 1
    for (int lp = 0; lp < 2; ++lp) {
        layer_fwd<0>(2 * lp);
        layer_fwd<1>(2 * lp + 1);
    }
    __syncthreads();
    if (blockIdx.x == 0 && opaque_tid() == 0 && xb_ld((unsigned*)kparams()->ws + XB_TMO) != 0u) kparams()->out[0] = __builtin_nanf("");
}

extern "C" void kernel_launch(void* const* d_in, const int* in_sizes, int n_in, void* d_out, int out_size, void* d_ws, size_t ws_size, hipStream_t stream) {
    static int grid = 0;
    if (grid == 0) {
        if (n_in != 38 || out_size != NL * DM || ws_size < WS_END) { fprintf(stderr, "kernel_launch: bad shapes n_in %d out %d ws %zu (need %zu)\n", n_in, out_size, ws_size, (size_t)WS_END); grid = -1; return; }
        int dev = 0, cus = 0, per_cu = 0;
        if (hipGetDevice(&dev) != hipSuccess || hipDeviceGetAttribute(&cus, hipDeviceAttributeMultiprocessorCount, dev) != hipSuccess) { grid = -1; return; }
        if (hipFuncSetAttribute((const void*)mega_fwd, hipFuncAttributeMaxDynamicSharedMemorySize, MEGA_LDS) != hipSuccess) { fprintf(stderr, "kernel_launch: hipFuncSetAttribute failed\n"); grid = -1; return; }
        if (hipOccupancyMaxActiveBlocksPerMultiprocessor(&per_cu, (const void*)mega_fwd, 512, MEGA_LDS) != hipSuccess || per_cu < 1) { fprintf(stderr, "kernel_launch: occupancy query says %d\n", per_cu); (void)hipGetLastError(); grid = -1; return; }
        if (cus != 256) { fprintf(stderr, "kernel_launch: built for 256 CUs, found %d\n", cus); grid = -1; return; }
        grid = NBLK;
    }
    if (grid < 0) return;
    if (hipMemsetAsync(d_ws, 0, OFF_LB, stream) != hipSuccess) return;
    Params p{};
    for (int i = 0; i < 38; ++i) p.in[i] = (const float*)d_in[i];
    p.out = (float*)d_out; p.ws = (unsigned char*)d_ws;
    hipLaunchKernelGGL(mega_fwd, dim3(grid), dim3(512), MEGA_LDS, stream, p);
}
```

```cpp
#include <hip/hip_runtime.h>
#include <stdint.h>
#include <stdio.h>

#define DM 1024
#define NBATCH 8
#define SEQ 4096
#define CTXL 256
#define NL (NBATCH * SEQ)
#define NC (NBATCH * CTXL)
#define NT (NL + NC)
#define ZROW NT
#define TOPK 8
#define EVEN_N 4112
#define ODD_N 3584
#define EVEN_LD 4096
#define ODD_LD 3584
#define MAXROWS (NT * 8 + 64 * 256 + NT)
#define ALPHA 1.681792830507429f
#define LN_EPS 1e-5f
#define E_MQ 0
#define E_MK 256
#define E_MV 512
#define E_MO 1024
#define E_HQ 1536
#define E_HI 2048
#define E_HFF 2560
#define E_HFB 3072
#define E_HG 3584

typedef unsigned short bf16_t;
#define LAS __attribute__((address_space(3)))
#define BAR_LDS_ 150528

#define MiB ((size_t)1 << 20)
#define OFF_CNT   ((size_t)64 << 10)
#define OFF_LB    ((size_t)96 << 10)
#define OFF_MOD   ((size_t)128 << 10)
#define OFF_ROPE  ((size_t)1536 << 10)
#define OFF_BCNT  ((size_t)1600 << 10)
#define OFF_GOFFS ((size_t)1700 << 10)
#define OFF_RWH   ((size_t)2560 << 10)
#define OFF_TILEE (2 * MiB)
#define OFF_HCTX  (4 * MiB)
#define OFF_TIDX  (12 * MiB)
#define OFF_TGATE (14 * MiB)
#define OFF_TPOS  (16 * MiB)
#define OFF_STOK  (18 * MiB)
#define OFF_SGATE (20 * MiB)
#define OFF_SDST  (22 * MiB)
#define OFF_G     (24 * MiB)
#define OFF_U     (28 * MiB)
#define OFF_W     (98 * MiB)
#define OFF_WIN   (OFF_W)
#define OFF_WOUT  (OFF_W + 8 * MiB)
#define OFF_W13   (OFF_W + 10 * MiB)
#define OFF_W2    (OFF_W + 75 * MiB)
#define OFF_BIG   (208 * MiB)
#define OFF_AUX   (480 * MiB)
#define OFF_Z1    (OFF_AUX + 136 * MiB)
#define OFF_Z2    (OFF_Z1 + 68 * MiB)
#define OFF_FILT  (OFF_Z2 + 68 * MiB)
#define OFF_YS    (370 * MiB)
#define WS_END    (1052 * MiB)

struct Params {
    const float* in[38];
    float* out;
    unsigned char* ws;
};

enum { I_X = 0, I_C, I_CTX, I_CCTX, I_ADAW, I_ADAB, I_LNW, I_LNB, I_EWIN, I_MGB, I_MNW, I_HLB, I_HNW, I_EWOUT, I_OWIN, I_HCW, I_HCB,
       I_HW1, I_HB1, I_HW2, I_HB2, I_HW3, I_HB3, I_HFREQ, I_HWOUT, I_HSKIP, I_HNORM, I_RLD, I_RNW, I_OWOUT, I_RW, I_RB, I_W1, I_W3, I_W2, I_SW1, I_SW3, I_SW2 };

typedef const __attribute__((address_space(4))) Params* KP;
__device__ __forceinline__ KP kparams() { KP k = (KP)__builtin_amdgcn_kernarg_segment_ptr(); asm volatile("" : "+s"(k)); return k; }
extern __shared__ __attribute__((aligned(16))) unsigned char smraw_all[];
__device__ __forceinline__ LAS unsigned char* smraw_base() { return (LAS unsigned char*)smraw_all; }
__device__ __forceinline__ unsigned char* smraw_generic() { return smraw_all; }
#define WTAB_LDS (BAR_LDS_ + 512)
__device__ __forceinline__ int opaque_tid() {
    unsigned h; asm volatile("s_getreg_b32 %0, hwreg(HW_REG_HW_ID, 0, 6)" : "=s"(h));
    const int wid = *(volatile LAS int*)(size_t)(WTAB_LDS + (h & 63u) * 4u);
    unsigned m = ~0u; asm volatile("" : "+s"(m));
    const int lane = (int)__builtin_amdgcn_mbcnt_hi(m, __builtin_amdgcn_mbcnt_lo(m, 0u));
    return __builtin_amdgcn_readfirstlane(wid) * 64 + lane;
}
typedef __bf16 bf16x2_n __attribute__((ext_vector_type(2)));
typedef float f32x2_n __attribute__((ext_vector_type(2)));
__device__ __forceinline__ unsigned cvt_pk_bf16(float lo, float hi) { const f32x2_n v = {lo, hi}; return __builtin_bit_cast(unsigned, __builtin_convertvector(v, bf16x2_n)); }
__device__ __forceinline__ float bf2f(bf16_t b) { return __uint_as_float(((unsigned)b) << 16); }
__device__ __forceinline__ float bflo(unsigned w) { return __uint_as_float(w << 16); }
__device__ __forceinline__ float bfhi(unsigned w) { return __uint_as_float(w & 0xffff0000u); }
__device__ __forceinline__ float ldf(const float* p) { return *p; }
__device__ __forceinline__ float ldf(const bf16_t* p) { return bf2f(*p); }
__device__ __forceinline__ void stf(float* p, float v) { *p = v; }
__device__ __forceinline__ void stf(bf16_t* p, float v) { *p = (bf16_t)(cvt_pk_bf16(v, 0.f) & 0xffffu); }
__device__ __forceinline__ float sigmoidf_(float x) { return 1.f / (1.f + expf(-x)); }
__device__ __forceinline__ float siluf_(float x) { return x / (1.f + expf(-x)); }
__device__ __forceinline__ int olane() { unsigned m = ~0u; asm volatile("" : "+s"(m)); return (int)__builtin_amdgcn_mbcnt_hi(m, __builtin_amdgcn_mbcnt_lo(m, 0u)); }
template <class T> __device__ __forceinline__ T shfl_idx(T v, int idx) { return __builtin_bit_cast(T, __builtin_amdgcn_ds_bpermute(idx << 2, __builtin_bit_cast(int, v))); }
#define SHX(v, o) shfl_idx(v, olane() ^ (o))
#define SHI(v, i) shfl_idx(v, (i))
#define SHI32(v, i) shfl_idx(v, (olane() & 32) | ((i) & 31))
#define SHU(v, o) shfl_idx(v, olane() - (o))
__device__ __forceinline__ float fexp(float x) { return __builtin_amdgcn_exp2f(x * 1.4426950408889634f); }
__device__ __forceinline__ float flog(float x) { return __builtin_amdgcn_logf(x) * 0.6931471805599453f; }
__device__ __forceinline__ float frcp(float x) { return __builtin_amdgcn_rcpf(x); }
__device__ __forceinline__ float fsigmoid(float x) { return frcp(1.f + fexp(-x)); }
__device__ __forceinline__ float fsilu(float x) { return x * frcp(1.f + fexp(-x)); }
__device__ __forceinline__ float wave_sum(float v) {
#pragma unroll
    for (int o = 32; o > 0; o >>= 1) v += SHX(v, o);
    return v;
}
__device__ __forceinline__ float* hrow(KP p, int tok) {
    return tok < NL ? p->out + (size_t)tok * DM : (float*)(p->ws + OFF_HCTX) + (size_t)(tok - NL) * DM;
}
__device__ __forceinline__ const float* modrow(KP p, int l, int tok) {
    const int r = tok < NL ? (tok >> 12) : 8;
    return (const float*)(p->ws + OFF_MOD) + ((size_t)l * 9 + r) * 6144;
}
__device__ __forceinline__ int scan_tok(int b, int i, int dir) {
    return i < CTXL ? NL + b * CTXL + (dir ? CTXL - 1 - i : i) : b * SEQ + (dir ? SEQ - 1 - (i - CTXL) : (i - CTXL));
}

#define XB_TMO      128
#define XB_XCNT(j)  (256  + 64 * (j))
#define XB_XSUB(j)  (1280 + 64 * (j))
#define XB_XGEN(j)  (2304 + 64 * (j))
#define XB_TOP      3328
#define XB_TOPGEN   3392
#define XCD_BAR_WORDS 3456
#define XB_SPIN_CAP (1u << 24)
__device__ __forceinline__ unsigned xb_ld(unsigned* p)              { return __hip_atomic_load(p, __ATOMIC_RELAXED, __HIP_MEMORY_SCOPE_AGENT); }
__device__ __forceinline__ unsigned xb_add(unsigned* p, unsigned v) { return __hip_atomic_fetch_add(p, v, __ATOMIC_RELAXED, __HIP_MEMORY_SCOPE_AGENT); }
__device__ __forceinline__ unsigned xb_xcc_id() { return (unsigned)__builtin_amdgcn_s_getreg((3 << 11) | 20) & 0xFu; }
#define XB_SPIN(cond, bar) do { unsigned _sp = 0; while (cond) { __builtin_amdgcn_s_sleep(1); \
    if ((++_sp & 255u) == 0u) { if (xb_ld(&(bar)[XB_TMO])) break; if (_sp > XB_SPIN_CAP) { atomicAdd(&(bar)[XB_TMO], 1u); break; } } } } while (0)
struct XcdBarrier { unsigned* bar; unsigned x; volatile LAS unsigned* st; };
__device__ __forceinline__ XcdBarrier xcd_barrier_post(unsigned* bar, volatile LAS unsigned* st) {
    XcdBarrier b; b.bar = bar; b.x = xb_xcc_id(); b.st = st;
    if (opaque_tid() == 0) (void)xb_add(&bar[XB_XCNT(b.x)], 1u);
    return b;
}
__device__ __forceinline__ void xcd_barrier_complete(unsigned* bar, unsigned x, unsigned& nloc, unsigned& nx) {
    const unsigned G = gridDim.x * gridDim.y * gridDim.z;
    unsigned sum, cnt, mine, sp = 0u;
    for (;;) {
        sum = 0u; cnt = 0u; mine = 0u;
#pragma unroll
        for (unsigned j = 0; j < 16; ++j) { const unsigned c = xb_ld(&bar[XB_XCNT(j)]); sum += c; cnt += (c > 0u) ? 1u : 0u; mine = (j == x) ? c : mine; }
        if (sum == G) break;
        __builtin_amdgcn_s_sleep(1);
        if ((++sp & 255u) == 0u) { if (xb_ld(&bar[XB_TMO])) break; if (sp > XB_SPIN_CAP) { atomicAdd(&bar[XB_TMO], 1u); break; } }
    }
    nloc = mine > 0u ? mine : 1u; nx = cnt > 0u ? cnt : 1u;
}
__device__ __forceinline__ void xcd_barrier(const XcdBarrier& b) {
    asm volatile("s_waitcnt vmcnt(0)" ::: "memory");
    __syncthreads();
    if (opaque_tid() == 0) {
        unsigned* bar = b.bar;
        __builtin_amdgcn_s_waitcnt(0);
        unsigned nloc = b.st[0], nx = b.st[1];
        if (nloc == 0u) { xcd_barrier_complete(bar, b.x, nloc, nx); b.st[0] = nloc; b.st[1] = nx; }
        const unsigned old = xb_add(&bar[XB_XSUB(b.x)], 1u);
        const unsigned gen = old / nloc;
        if (old + 1u == (gen + 1u) * nloc) {
            __builtin_amdgcn_fence(__ATOMIC_RELEASE, "agent");
            asm volatile("s_waitcnt vmcnt(0)" ::: "memory");
            const unsigned og = xb_add(&bar[XB_TOP], 1u);
            const unsigned tg = og / nx;
            if (og + 1u == (tg + 1u) * nx) xb_add(&bar[XB_TOPGEN], 1u);
            else XB_SPIN(xb_ld(&bar[XB_TOPGEN]) == tg, bar);
            __builtin_amdgcn_fence(__ATOMIC_ACQUIRE, "agent");
            xb_add(&bar[XB_XGEN(b.x)], 1u);
            asm volatile("s_waitcnt vmcnt(0)" ::: "memory");
        } else {
            XB_SPIN(xb_ld(&bar[XB_XGEN(b.x)]) == gen, bar);
            __builtin_amdgcn_fence(__ATOMIC_ACQUIRE, "agent");
            asm volatile("s_waitcnt vmcnt(0)" ::: "memory");
        }
    }
    __syncthreads();
}

__device__ __forceinline__ void ph_prologue(KP p, int bid, int nb, float* sm) {
    const int tid = opaque_tid();
    {
        const float4* x4 = (const float4*)p->in[I_X]; float4* o4 = (float4*)p->out;
        #pragma unroll 1
        for (size_t i = (size_t)bid * 512 + tid; i < (size_t)NL * 256; i += (size_t)nb * 512) o4[i] = x4[i];
        const float4* c4 = (const float4*)p->in[I_CTX]; float4* h4 = (float4*)(p->ws + OFF_HCTX);
        #pragma unroll 1
        for (size_t i = (size_t)bid * 512 + tid; i < (size_t)NC * 256; i += (size_t)nb * 512) h4[i] = c4[i];
    }
    if (bid == 0) {
        bf16_t* z = (bf16_t*)(p->ws + OFF_U) + (size_t)ZROW * DM;
        for (int i = tid; i < DM; i += 512) z[i] = 0;
    }
    if (bid == 1 % nb) {
        float* lb = (float*)(p->ws + OFF_LB);
        const float* hl = p->in[I_HLB];
        for (int j = tid; j < 512; j += 512) {
            const float a = hl[j], b = hl[512 + j], mx = fmaxf(a, b);
            const float ea = expf(a - mx), eb = expf(b - mx);
            lb[j] = 0.f; lb[512 + j] = eb / (ea + eb);
        }
    }
    if (bid == 2 % nb) {
        float2* rt = (float2*)(p->ws + OFF_ROPE);
        for (int i = tid; i < 64 * 32; i += 512) { const float ang = (float)(i >> 5) * powf(10000.f, -(float)(2 * (i & 31)) / 64.f); rt[i] = make_float2(cosf(ang), sinf(ang)); }
    }
    {
        float* act = sm;
        bool filled = false;
        #pragma unroll 1
        for (int item = bid; item < 48; item += nb) {
            if (!filled) {
                for (int i = tid; i < 9 * 1024; i += 512) {
                    const int r = i >> 10, k = i & 1023;
                    const float v = r < 8 ? p->in[I_C][r * 1024 + k] : p->in[I_CCTX][k];
                    act[i] = siluf_(v);
                }
                __syncthreads(); filled = true;
            }
            const int l = item / 12, j = (item % 12) * 512 + tid;
            const float* w = p->in[I_ADAW] + (size_t)l * 1024 * 6144 + j;
            float acc[9];
#pragma unroll
            for (int r = 0; r < 9; ++r) acc[r] = 0.f;
            for (int k = 0; k < 1024; ++k) {
                const float wv = w[(size_t)k * 6144];
#pragma unroll
                for (int r = 0; r < 9; ++r) acc[r] += act[r * 1024 + k] * wv;
            }
            const float bv = p->in[I_ADAB][l * 6144 + j];
            float* mod = (float*)(p->ws + OFF_MOD);
#pragma unroll
            for (int r = 0; r < 9; ++r) mod[((size_t)l * 9 + r) * 6144 + j] = acc[r] + bv;
        }
    }
}


struct CvtTile { const float* src; int srcld; bf16_t* dst; int dstld; int k0, n0; };
__device__ __forceinline__ CvtTile cvt_tile_of(KP p, int l, int t, int np4  ) {
    const bool even = (l & 1) == 0;
    const int NP = even ? EVEN_LD : ODD_LD;
    const int t_in = 16 * (NP / 128), t_out = 16 * 8, t_13 = 65 * 16 * 4;
    CvtTile c;
    if (t < t_in) {
        const int kt = t & 15, nt = t >> 4, n = nt * 128 + np4;
        const float* W = even ? p->in[I_EWIN] + (size_t)(l >> 1) * 1024 * EVEN_N : p->in[I_OWIN] + (size_t)(l >> 1) * 1024 * ODD_N;
        c.src = W + ((even && n >= 1536) ? n + 16 : n); c.srcld = even ? EVEN_N : ODD_N; c.dst = (bf16_t*)(p->ws + OFF_WIN); c.dstld = 1024; c.k0 = kt * 64; c.n0 = nt * 128;
    } else if (t < t_in + t_out) {
        const int u = t - t_in, kt = u & 15, nt = u >> 4;
        c.src = (even ? p->in[I_EWOUT] : p->in[I_OWOUT]) + (size_t)(l >> 1) * 1024 * 1024 + nt * 128 + np4; c.srcld = 1024; c.dst = (bf16_t*)(p->ws + OFF_WOUT); c.dstld = 1024; c.k0 = kt * 64; c.n0 = nt * 128;
    } else if (t < t_in + t_out + t_13) {
        const int u = t - t_in - t_out, e = u >> 6, kt = u & 15, nt = (u >> 4) & 3, n = nt * 128 + np4, g = n >> 5, w = n & 31;
        const float* w1 = e < 64 ? p->in[I_W1] + ((size_t)l * 64 + e) * 1024 * 256 : p->in[I_SW1] + (size_t)l * 1024 * 256;
        const float* w3 = e < 64 ? p->in[I_W3] + ((size_t)l * 64 + e) * 1024 * 256 : p->in[I_SW3] + (size_t)l * 1024 * 256;
        c.src = w < 16 ? w1 + 16 * g + w : w3 + 16 * g + w - 16; c.srcld = 256; c.dst = (bf16_t*)(p->ws + OFF_W13) + (size_t)e * 512 * 1024; c.dstld = 1024; c.k0 = kt * 64; c.n0 = nt * 128;
    } else {
        const int u = t - t_in - t_out - t_13, e = u >> 5, kt = u & 3, nt = (u >> 2) & 7;
        const float* w2 = e < 64 ? p->in[I_W2] + ((size_t)l * 64 + e) * 256 * 1024 : p->in[I_SW2] + (size_t)l * 256 * 1024;
        c.src = w2 + nt * 128 + np4; c.srcld = 1024; c.dst = (bf16_t*)(p->ws + OFF_W2) + (size_t)e * 1024 * 256; c.dstld = 256; c.k0 = kt * 64; c.n0 = nt * 128;
    }
    return c;
}
__device__ __forceinline__ void ph_convert(KP p, int l, int bid, int nb, float* sm) {
    const int tid = opaque_tid();
    const int NP = ((l & 1) == 0) ? EVEN_LD : ODD_LD;
    const int total = 16 * (NP / 128) + 16 * 8 + 65 * 16 * 4 + 65 * 4 * 8;
    const int kr = tid >> 5, np4 = (tid & 31) * 4;
    float4 v[4];
    int t = bid;
    CvtTile c = cvt_tile_of(p, l, t < total ? t : 0, np4);
    if (t < total) {
#pragma unroll
        for (int j = 0; j < 4; ++j) v[j] = *(const float4*)(c.src + (size_t)(c.k0 + kr + 16 * j) * c.srcld);
    }
#pragma unroll 1
    for (; t < total; t += nb) {
        __syncthreads();
#pragma unroll
        for (int j = 0; j < 4; ++j) { float* d = sm + (np4) * 65 + kr + 16 * j; d[0] = v[j].x; d[65] = v[j].y; d[130] = v[j].z; d[195] = v[j].w; }
        const CvtTile cur = c;
        const int tn = t + nb;
        if (tn < total) {
            c = cvt_tile_of(p, l, tn, np4);
#pragma unroll
            for (int j = 0; j < 4; ++j) v[j] = *(const float4*)(c.src + (size_t)(c.k0 + kr + 16 * j) * c.srcld);
        }
        __syncthreads();
        const int n = tid >> 2, kc = (tid & 3) * 16;
        unsigned w[8];
#pragma unroll
        for (int q = 0; q < 8; ++q) w[q] = cvt_pk_bf16(sm[n * 65 + kc + 2 * q], sm[n * 65 + kc + 2 * q + 1]);
        uint4* d4 = (uint4*)(cur.dst + (size_t)(cur.n0 + n) * cur.dstld + cur.k0 + kc);
        d4[0] = make_uint4(w[0], w[1], w[2], w[3]); d4[1] = make_uint4(w[4], w[5], w[6], w[7]);
    }
    __syncthreads();
    if (bid < 8) {
        const float* rw = p->in[I_RW] + (size_t)l * 1024 * 64;
        bf16_t* hi = (bf16_t*)(p->ws + OFF_RWH); bf16_t* lo = hi + 64 * 1024;
        const int e = tid & 63, kb = bid * 128 + (tid >> 6) * 16;
#pragma unroll
        for (int i = 0; i < 16; i += 2) {
            const float x0 = rw[(size_t)(kb + i) * 64 + e], x1 = rw[(size_t)(kb + i + 1) * 64 + e];
            const unsigned h = cvt_pk_bf16(x0, x1);
            const unsigned lw = cvt_pk_bf16(x0 - bflo(h), x1 - bfhi(h));
            *(unsigned*)(hi + (size_t)e * 1024 + kb + i) = h; *(unsigned*)(lo + (size_t)e * 1024 + kb + i) = lw;
        }
    }
}

namespace gp {
typedef short bf16x8 __attribute__((ext_vector_type(8)));
typedef float f32x4 __attribute__((ext_vector_type(4)));
typedef unsigned u32x4 __attribute__((ext_vector_type(4)));
typedef unsigned u32x2 __attribute__((ext_vector_type(2)));
constexpr int BM = 256, BK = 64, HALF = 128, HTB = HALF * BK * 2, STAGE_BYTES = 8 * HTB, NXCD = 8, WGM = 8;
__device__ __forceinline__ int lds_byte(int r, int c) { const int st = (r >> 4) * 2 + (c >> 5), rr = r & 15, cc = c & 31, ob = rr * 64 + cc * 2; return st * 1024 + (ob ^ (((ob >> 9) & 1) << 5)); }
__device__ __forceinline__ void stage_rc(int b, int& R, int& C) { const int st = b / 1024, sb = b % 1024, swz = sb ^ (((sb >> 9) & 1) << 5); R = (st >> 1) * 16 + swz / 64; C = (st & 1) * 32 + (swz % 64) / 2; }
__device__ __forceinline__ int perm32(int rho) { const int n = rho >> 4, i = rho & 15; return 8 * (i >> 2) + 4 * n + (i & 3); }

struct Unit { const char* A; const char* B; int r0, c0, aux; };

struct DenseSched {
    const char* A; const char* B; int nM, nN, nwg, G, c; size_t tstep;
    __device__ __forceinline__ void init(const void* A_, const void* B_, int M, int N, int K, int G_, int c_) { A = (const char*)A_; B = (const char*)B_; nM = M / BM; nN = N / BM; nwg = nM * nN; G = G_; c = c_; tstep = (size_t)BM * K * 2; }
    __device__ __forceinline__ bool next(int i, Unit& u) const {
        const long L = (long)i * G + c; if (L >= nwg) return false;
        int wgid = (int)L; { const int q = nwg / NXCD, r = nwg % NXCD, xcd = wgid % NXCD, off = wgid / NXCD; wgid = (xcd < r ? xcd * (q + 1) : r * (q + 1) + (xcd - r) * q) + off; }
        const int nig = WGM * nN, gid = wgid / nig, fm = gid * WGM, gsz = (nM - fm) < WGM ? (nM - fm) : WGM;
        const int pm = fm + ((wgid % nig) % gsz), pn = (wgid % nig) / gsz;
        u.A = A + (size_t)pm * tstep; u.B = B + (size_t)pn * tstep; u.r0 = pm * BM; u.c0 = pn * BM; u.aux = 0; return true;
    }
    __device__ __forceinline__ void lane_off(const Unit&, unsigned (&)[2][2]) const {}
};

template <bool GATHER, bool PERM, class Sched, class Epi>
__device__ __forceinline__ void gemm_phase(LAS unsigned char* lds, const int K_, const Sched& S, const Epi& E) {
    int K = K_; asm volatile("" : "+s"(K));
    const int tid = opaque_tid(), wid = __builtin_amdgcn_readfirstlane(tid >> 6), lane = tid & 63, wr = wid >> 2, wc = wid & 3, fr = lane & 15, fq = lane >> 4;
    const int nt = K / BK;
    unsigned voffA[2], voffB[2];
#pragma unroll
    for (int i = 0; i < 2; ++i) { int R, C; stage_rc(tid * 16 + i * 8192, R, C); const int Rb = PERM ? ((R & ~31) + perm32(R & 31)) : R;
        voffA[i] = (unsigned)(R * K + C) * 2u; voffB[i] = (unsigned)(Rb * K + C) * 2u; }
    const size_t kstep = (size_t)(BK * 2);
    const size_t hstep = (size_t)HALF * K * 2;
    const unsigned ldsw = (unsigned)wid * 1024u;
    const int aoff = lds_byte(wr * 64 + fr, fq * 8), boff = lds_byte(wc * 32 + fr, fq * 8);
    unsigned cvo[2][2] = {{0u, 0u}, {0u, 0u}}, nvo[2][2] = {{0u, 0u}, {0u, 0u}};
#define GP_SA(b, h) (((b) * 2 + (h)) * HTB)
#define GP_SB(b, h) ((4 + (b) * 2 + (h)) * HTB)
#define GP_GLDS(gp_, lp_) __builtin_amdgcn_global_load_lds((const unsigned*)(gp_), (LAS unsigned*)(lp_), 16, 0, 0)
#define GP_STAGE_B(bufoff, gbase, h) do { const char* _g = (gbase) + (size_t)(h) * hstep; \
        GP_GLDS(_g + voffB[0], lds + (bufoff) + ldsw); GP_GLDS(_g + voffB[1], lds + (bufoff) + ldsw + 8192); } while (0)
#define GP_STAGE_A(bufoff, gbase, h, usenext) do { \
        if (GATHER) { const unsigned _o0 = (usenext) ? nvo[h][0] : cvo[h][0], _o1 = (usenext) ? nvo[h][1] : cvo[h][1]; \
            GP_GLDS((gbase) + _o0, lds + (bufoff) + ldsw); GP_GLDS((gbase) + _o1, lds + (bufoff) + ldsw + 8192); } \
        else { const char* _g = (gbase) + (size_t)(h) * hstep; GP_GLDS(_g + voffA[0], lds + (bufoff) + ldsw); GP_GLDS(_g + voffA[1], lds + (bufoff) + ldsw + 8192); } } while (0)
#define GP_LDA(dst, b, h) do { _Pragma("unroll") for (int m = 0; m < 4; ++m) _Pragma("unroll") for (int k = 0; k < 2; ++k) dst[m][k] = *(const LAS bf16x8*)(lds + GP_SA(b, h) + aoff + m * 2048 + k * 1024); } while (0)
#define GP_LDB(dst, b, h) do { _Pragma("unroll") for (int n = 0; n < 2; ++n) _Pragma("unroll") for (int k = 0; k < 2; ++k) dst[n][k] = *(const LAS bf16x8*)(lds + GP_SB(b, h) + boff + n * 2048 + k * 1024); } while (0)
#define GP_MMA(ai, bj, At, Bt) do { __builtin_amdgcn_s_setprio(1); _Pragma("unroll") for (int m = 0; m < 4; ++m) _Pragma("unroll") for (int n = 0; n < 2; ++n) _Pragma("unroll") for (int k = 0; k < 2; ++k) \
        acc[ai][bj][m][n] = __builtin_amdgcn_mfma_f32_16x16x32_bf16(Bt[n][k], At[m][k], acc[ai][bj][m][n], 0, 0, 0); __builtin_amdgcn_s_setprio(0); } while (0)
#define GP_WAIT_V(n) asm volatile("s_waitcnt vmcnt(" #n ")" ::: "memory")
#define GP_WAIT_L(n) asm volatile("s_waitcnt lgkmcnt(" #n ")" ::: "memory")
#define GP_BAR __builtin_amdgcn_s_barrier()
#define GP_SCHED __builtin_amdgcn_sched_barrier(0)
    Unit cur, nxt; int ui = 0;
    if (!S.next(0, cur)) return;
    f32x4 acc[2][2][4][2];
#pragma unroll
    for (int a = 0; a < 2; ++a)
#pragma unroll
        for (int b = 0; b < 2; ++b)
#pragma unroll
            for (int m = 0; m < 4; ++m)
#pragma unroll
                for (int n = 0; n < 2; ++n) acc[a][b][m][n] = (f32x4){0.f, 0.f, 0.f, 0.f};
    bf16x8 At[4][2], B0[2][2], B1[2][2];
    if (GATHER) S.lane_off(cur, cvo);
    const char* cA = cur.A; const char* cB = cur.B;
    GP_STAGE_B(GP_SB(0, 0), cB, 0); GP_STAGE_A(GP_SA(0, 0), cA, 0, false); GP_STAGE_B(GP_SB(0, 1), cB, 1); GP_STAGE_A(GP_SA(0, 1), cA, 1, false);
    if (wr == 1) GP_BAR;
    GP_WAIT_V(4); GP_BAR;
    GP_STAGE_B(GP_SB(1, 0), cB + kstep, 0); GP_STAGE_A(GP_SA(1, 0), cA + kstep, 0, false); GP_STAGE_B(GP_SB(1, 1), cB + kstep, 1);
    GP_WAIT_V(6); GP_BAR;
    for (;;) {
        const bool has_next = S.next(ui + 1, nxt);
        if (GATHER && has_next) S.lane_off(nxt, nvo);
        const char* nA = has_next ? nxt.A : cA; const char* nB = has_next ? nxt.B : cB;
        for (int t = 0; t < nt; t += 2) {
            const bool last = (t == nt - 2);
            const bool un = last && has_next;
            const char* a1 = cA + (size_t)(t + 1) * kstep;
            const char* a2 = last ? nA : cA + (size_t)(t + 2) * kstep; const char* b2 = last ? nB : cB + (size_t)(t + 2) * kstep;
            const char* a3 = a2 + kstep; const char* b3 = b2 + kstep;
            GP_LDB(B0, 0, 0); GP_SCHED; GP_LDA(At, 0, 0); GP_STAGE_A(GP_SA(1, 1), a1, 1, false);
            GP_WAIT_L(8); GP_BAR; GP_WAIT_L(0); GP_MMA(0, 0, At, B0); GP_BAR; GP_SCHED;
            GP_LDB(B1, 0, 1); GP_STAGE_B(GP_SB(0, 0), b2, 0);
            GP_BAR; GP_WAIT_L(0); GP_MMA(0, 1, At, B1); GP_BAR;
            GP_LDA(At, 0, 1); GP_STAGE_A(GP_SA(0, 0), a2, 0, un);
            GP_BAR; GP_WAIT_L(0); GP_MMA(1, 0, At, B0); GP_BAR; GP_SCHED;
            GP_STAGE_B(GP_SB(0, 1), b2, 1);
            GP_WAIT_V(6); GP_BAR; GP_MMA(1, 1, At, B1); GP_BAR;
            GP_LDB(B0, 1, 0); GP_SCHED; GP_LDA(At, 1, 0); GP_STAGE_A(GP_SA(0, 1), a2, 1, un);
            GP_WAIT_L(8); GP_BAR; GP_WAIT_L(0); GP_MMA(0, 0, At, B0); GP_BAR; GP_SCHED;
            GP_LDB(B1, 1, 1); GP_STAGE_B(GP_SB(1, 0), b3, 0);
            GP_BAR; GP_WAIT_L(0); GP_MMA(0, 1, At, B1); GP_BAR;
            GP_LDA(At, 1, 1); GP_STAGE_A(GP_SA(1, 0), a3, 0, un);
            GP_BAR; GP_WAIT_L(0); GP_MMA(1, 0, At, B0); GP_BAR; GP_SCHED;
            GP_STAGE_B(GP_SB(1, 1), b3, 1);
            GP_WAIT_V(6); GP_BAR; GP_MMA(1, 1, At, B1); GP_BAR;
        }
        E(acc, cur, wr, wc, fr, fq);
        if (!has_next) break;
#pragma unroll
        for (int a = 0; a < 2; ++a)
#pragma unroll
            for (int b = 0; b < 2; ++b)
#pragma unroll
                for (int m = 0; m < 4; ++m)
#pragma unroll
                    for (int n = 0; n < 2; ++n) acc[a][b][m][n] = (f32x4){0.f, 0.f, 0.f, 0.f};
        cur = nxt; cA = nA; cB = nB; ++ui;
        if (GATHER) { cvo[0][0] = nvo[0][0]; cvo[0][1] = nvo[0][1]; cvo[1][0] = nvo[1][0]; cvo[1][1] = nvo[1][1]; }
    }
    GP_WAIT_V(0);
    if (wr == 0) GP_BAR;
    GP_BAR;
#undef GP_SA
#undef GP_SB
#undef GP_GLDS
#undef GP_STAGE_A
#undef GP_STAGE_B
#undef GP_LDA
#undef GP_LDB
#undef GP_MMA
#undef GP_WAIT_V
#undef GP_WAIT_L
#undef GP_BAR
#undef GP_SCHED
}

struct EpiF32 {
    float* C; int ldc;
    __device__ __forceinline__ void operator()(const f32x4 (&acc)[2][2][4][2], const Unit& u, int wr, int wc, int fr, int fq) const {
        const int row0 = u.r0 + wr * 64 + fr, col0 = u.c0 + wc * 32 + 4 * fq;
#pragma unroll
        for (int ai = 0; ai < 2; ++ai)
#pragma unroll
            for (int m = 0; m < 4; ++m) { float* rowp = C + (size_t)(row0 + ai * HALF + m * 16) * ldc + col0;
#pragma unroll
                for (int bj = 0; bj < 2; ++bj)
#pragma unroll
                    for (int n = 0; n < 2; ++n) *(f32x4*)(rowp + bj * HALF + n * 16) = acc[ai][bj][m][n];
                __builtin_amdgcn_sched_barrier(0); }
    }
};
struct EpiBf16 {
    bf16_t* O; int ldc;
    __device__ __forceinline__ void operator()(const f32x4 (&acc)[2][2][4][2], const Unit& u, int wr, int wc, int fr, int fq) const {
        const int row0 = u.r0 + wr * 64 + fr, col0 = u.c0 + wc * 32 + 8 * fq;
#pragma unroll
        for (int ai = 0; ai < 2; ++ai)
#pragma unroll
            for (int m = 0; m < 4; ++m) { bf16_t* rowp = O + (size_t)(row0 + ai * HALF + m * 16) * ldc + col0;
#pragma unroll
                for (int bj = 0; bj < 2; ++bj) { const f32x4 v0 = acc[ai][bj][m][0], v1 = acc[ai][bj][m][1];
                    u32x4 w; w.x = cvt_pk_bf16(v0[0], v0[1]); w.y = cvt_pk_bf16(v0[2], v0[3]); w.z = cvt_pk_bf16(v1[0], v1[1]); w.w = cvt_pk_bf16(v1[2], v1[3]);
                    *(u32x4*)(rowp + bj * HALF) = w; }
                __builtin_amdgcn_sched_barrier(0); }
    }
};
}


typedef float f32x4_l __attribute__((ext_vector_type(4)));
__device__ __forceinline__ void stage_gate_w(KP p, int e, LAS float* wl) {
    const int tid = opaque_tid();
    const float* wg = p->in[I_EWIN] + (size_t)e * 1024 * EVEN_N + 1536;
#pragma unroll
    for (int i = 0; i < 8; ++i) { const int idx = tid + 512 * i, d = idx >> 2, j4 = idx & 3; const float4 w = *(const float4*)(wg + (size_t)d * EVEN_N + j4 * 4); *(LAS f32x4_l*)(wl + d * 16 + j4 * 4) = (f32x4_l){w.x, w.y, w.z, w.w}; }
    __syncthreads();
}
__device__ __forceinline__ void ph_modin(KP p, int l, int bid, int nb) {
    const int tid = opaque_tid(), lane = tid & 63, wv = tid >> 6;
    const bool even = (l & 1) == 0;
    bf16_t* U = (bf16_t*)(p->ws + OFF_U);
    float* G = (float*)(p->ws + OFF_G);
    LAS float* wl = (LAS float*)smraw_base();
    if (even) stage_gate_w(p, l >> 1, wl);
    #pragma unroll 1
    for (int tok = bid * 8 + wv; tok < NT; tok += nb * 8) {
        const float* h = hrow(p, tok);
        const float* m = modrow(p, l, tok);
        float ga[16];
#pragma unroll
        for (int j = 0; j < 16; ++j) ga[j] = 0.f;
#pragma unroll
        for (int c = 0; c < 4; ++c) {
            const int d = 4 * (lane + 64 * c);
            const float4 hv = *(const float4*)(h + d), sh = *(const float4*)(m + d), sc = *(const float4*)(m + 1024 + d);
            const float u0 = hv.x * (1.f + sc.x) + sh.x, u1 = hv.y * (1.f + sc.y) + sh.y, u2 = hv.z * (1.f + sc.z) + sh.z, u3 = hv.w * (1.f + sc.w) + sh.w;
            *(uint2*)(U + (size_t)tok * DM + d) = make_uint2(cvt_pk_bf16(u0, u1), cvt_pk_bf16(u2, u3));
            if (even) {
                const float uu[4] = {u0, u1, u2, u3};
#pragma unroll
                for (int q = 0; q < 4; ++q) {
#pragma unroll
                    for (int j4 = 0; j4 < 4; ++j4) { const f32x4_l w = *(const LAS f32x4_l*)(wl + (d + q) * 16 + j4 * 4); ga[4 * j4] += uu[q] * w[0]; ga[4 * j4 + 1] += uu[q] * w[1]; ga[4 * j4 + 2] += uu[q] * w[2]; ga[4 * j4 + 3] += uu[q] * w[3]; }
                }
                __builtin_amdgcn_sched_barrier(0);
            }
        }
        if (even) {
            float mine = 0.f;
#pragma unroll
            for (int j = 0; j < 16; ++j) { const float s = wave_sum(ga[j]); if (lane == j) mine = s; }
            if (lane < 16) G[(size_t)tok * 16 + lane] = mine;
        }
    }
}

__device__ __forceinline__ void ph_gemm_in(KP p, int l, int bid, int nb, LAS unsigned char* lds) {
    const int N = ((l & 1) == 0) ? EVEN_LD : ODD_LD;
    gp::DenseSched S; S.init(p->ws + OFF_U, p->ws + OFF_WIN, NT, N, 1024, nb, bid);
    gp::EpiBf16 E{(bf16_t*)(p->ws + OFF_BIG), N};
    gp::gemm_phase<false, true>(lds, 1024, S, E);
}
__device__ __forceinline__ void ph_gemm_out(KP p, int l, int bid, int nb, LAS unsigned char* lds) {
    gp::DenseSched S; S.init(p->ws + OFF_U, p->ws + OFF_WOUT, NT, 1024, 1024, nb, bid);
    gp::EpiF32 E{(float*)(p->ws + OFF_BIG), 1024};
    gp::gemm_phase<false, false>(lds, 1024, S, E);
}


namespace sc {
typedef short bf16x8 __attribute__((ext_vector_type(8)));
typedef short bf16x4 __attribute__((ext_vector_type(4)));
typedef float f32x4 __attribute__((ext_vector_type(4)));
#define SC_MFMA(a, b, c) __builtin_amdgcn_mfma_f32_16x16x32_bf16(a, b, c, 0, 0, 0)
__device__ __forceinline__ bf16x8 rd_row(unsigned img, int row, int stride, int k0) { return *(const LAS bf16x8*)(size_t)(img + (unsigned)(row * stride + k0 * 2)); }
__device__ __forceinline__ bf16x8 rd_tr(unsigned img, int k0, int n0, int stride, int lane) {
    const int g = lane >> 4, i = lane & 15;
    const unsigned a0 = img + (unsigned)((k0 + 8 * g + (i >> 2)) * stride + (n0 + 4 * (i & 3)) * 2), a1 = a0 + 4u * (unsigned)stride;
    bf16x4 lo, hi;
    asm volatile("ds_read_b64_tr_b16 %0, %2\n\tds_read_b64_tr_b16 %1, %3\n\ts_waitcnt lgkmcnt(0)" : "=&v"(lo), "=&v"(hi) : "v"(a0), "v"(a1) : "memory");
    return (bf16x8){lo[0], lo[1], lo[2], lo[3], hi[0], hi[1], hi[2], hi[3]};
}
typedef unsigned u32x2_ __attribute__((ext_vector_type(2)));
typedef unsigned u32x4_ __attribute__((ext_vector_type(4)));
__device__ __forceinline__ unsigned tr_addr(unsigned img, int k0, int n0, int stride, int lane) { const int g = lane >> 4, i = lane & 15; return img + (unsigned)((k0 + 8 * g + (i >> 2)) * stride + (n0 + 4 * (i & 3)) * 2); }
__device__ __forceinline__ void rd_tr5(const unsigned (&a0)[5], const unsigned (&s4)[5], bf16x8 (&o)[5]) {
    bf16x4 l0, h0, l1, h1, l2, h2, l3, h3, l4, h4;
    asm volatile("ds_read_b64_tr_b16 %0, %10\n\tds_read_b64_tr_b16 %1, %11\n\tds_read_b64_tr_b16 %2, %12\n\tds_read_b64_tr_b16 %3, %13\n\tds_read_b64_tr_b16 %4, %14\n\t"
                 "ds_read_b64_tr_b16 %5, %15\n\tds_read_b64_tr_b16 %6, %16\n\tds_read_b64_tr_b16 %7, %17\n\tds_read_b64_tr_b16 %8, %18\n\tds_read_b64_tr_b16 %9, %19\n\ts_waitcnt lgkmcnt(0)"
                 : "=&v"(l0), "=&v"(h0), "=&v"(l1), "=&v"(h1), "=&v"(l2), "=&v"(h2), "=&v"(l3), "=&v"(h3), "=&v"(l4), "=&v"(h4)
                 : "v"(a0[0]), "v"(a0[0] + s4[0]), "v"(a0[1]), "v"(a0[1] + s4[1]), "v"(a0[2]), "v"(a0[2] + s4[2]), "v"(a0[3]), "v"(a0[3] + s4[3]), "v"(a0[4]), "v"(a0[4] + s4[4]) : "memory");
    o[0] = (bf16x8){l0[0], l0[1], l0[2], l0[3], h0[0], h0[1], h0[2], h0[3]}; o[1] = (bf16x8){l1[0], l1[1], l1[2], l1[3], h1[0], h1[1], h1[2], h1[3]};
    o[2] = (bf16x8){l2[0], l2[1], l2[2], l2[3], h2[0], h2[1], h2[2], h2[3]}; o[3] = (bf16x8){l3[0], l3[1], l3[2], l3[3], h3[0], h3[1], h3[2], h3[3]};
    o[4] = (bf16x8){l4[0], l4[1], l4[2], l4[3], h4[0], h4[1], h4[2], h4[3]};
}
__device__ __forceinline__ void st8(unsigned addr, uint2 v) { *(LAS u32x2_*)(size_t)addr = (u32x2_){v.x, v.y}; }
__device__ __forceinline__ void st16(unsigned addr, uint4 v) { *(LAS u32x4_*)(size_t)addr = (u32x4_){v.x, v.y, v.z, v.w}; }
__device__ __forceinline__ float scan_add64(float v, int lane) {
#pragma unroll
    for (int o = 1; o < 64; o <<= 1) { const float t = SHU(v, o); if (lane >= o) v += t; }
    return v;
}
__device__ __forceinline__ float scan_max64(float v, int lane) {
#pragma unroll
    for (int o = 1; o < 64; o <<= 1) { const float t = SHU(v, o); if (lane >= o) v = fmaxf(v, t); }
    return v;
}

template <int MODE>
__device__ __forceinline__ void scan_item(KP p, int l, int b, int h, int dir, int vs) {
    constexpr int CS = (MODE == 1) ? 32 : 64, DK = (MODE == 0) ? 64 : 128, EXT = (MODE == 0) ? 1 : 0;
    constexpr int QS = (DK + 8) * 2, VS = (64 + 16 * EXT + 8) * 2, SS = (CS + 8) * 2, NVR = 64 + 16 * EXT;
    constexpr int NCH = (CTXL + SEQ) / CS;
    constexpr int LD = (MODE == 2) ? ODD_LD : EVEN_LD;
    constexpr unsigned O_QA = 0, O_KA = O_QA + CS * QS, O_QB = O_KA + CS * QS, O_KW = O_QB + (MODE == 1 ? CS * QS : 0), O_V = O_KW + CS * QS,
                       O_SSC = O_V + CS * VS, O_ST = O_SSC + CS * SS, O_DKV = O_ST + 2 * NVR * QS, O_END = O_DKV + 512;
    static_assert(O_END <= 131072, "scan LDS");
    const int tid = opaque_tid(), lane = tid & 63, wv = __builtin_amdgcn_readfirstlane(tid >> 6), r16 = lane & 15, q4 = lane >> 4;
    const unsigned L0 = (unsigned)(size_t)smraw_base();
    const bf16_t* P = (const bf16_t*)(p->ws + OFF_BIG);
    bf16_t* HXo = (bf16_t*)(p->ws + OFF_AUX) + (size_t)dir * NT * 1024;
    const int e2 = l >> 1;
    const int cQ = (MODE == 0) ? E_MQ + h * 64 : (MODE == 1) ? E_HQ + h * 128 : 1536 + h * 128;
    const int cK = (MODE == 0) ? E_MK + h * 64 : (MODE == 1) ? (dir ? E_HFB : E_HFF) + h * 128 : 2048 + h * 128;
    const int cV = (MODE == 0) ? E_MV + h * 128 + vs * 64 : (MODE == 1) ? E_HI + h * 128 + vs * 64 : 2560 + h * 128 + vs * 64;
    const int cO = (MODE == 0) ? h * 128 + vs * 64 : 512 + h * 128 + vs * 64;
    const int lt = (MODE == 1) ? (tid & 31) : (tid >> 3);
    const int lj = (MODE == 0) ? (tid & 7) : (MODE == 1) ? (tid >> 5) : ((tid >> 2) & 1) * 8 + (tid & 3);
    const int vt_ = tid >> 3, vj = tid & 7;
    float lbv[8]; float gbi = 0.f, gbf = 0.f, lg = 0.f;
    if (MODE == 1) {
        const float* lbp = (const float*)(p->ws + OFF_LB) + e2 * 512 + h * 128 + lj * 8;
#pragma unroll
        for (int i = 0; i < 8; ++i) lbv[i] = lbp[i];
    } else {
#pragma unroll
        for (int i = 0; i < 8; ++i) lbv[i] = 0.f;
    }
    if (MODE == 0) { const float* gb = p->in[I_MGB] + e2 * 16; gbi = gb[(dir ? 2 : 0) * 4 + h]; gbf = gb[(dir ? 3 : 1) * 4 + h]; }
    if (MODE == 2) lg = p->in[I_RLD][e2 * 8 + dir * 4 + h];
    const float* G = (const float*)(p->ws + OFF_G);
    const float* ropet = (const float*)(p->ws + OFF_ROPE);
    unsigned oz = 0u; asm volatile("" : "+v"(oz));
    for (unsigned o = tid * 16; o < 2u * NVR * QS; o += 512 * 16) st16(L0 + O_ST + o, make_uint4(oz, oz, oz, oz));
    if (EXT) { if (tid < CS) { st16(L0 + O_V + tid * VS + 128, make_uint4(0x3f80u | oz, oz, oz, oz)); st16(L0 + O_V + tid * VS + 144, make_uint4(oz, oz, oz, oz)); } }
    f32x4 sacc[4];
#pragma unroll
    for (int i = 0; i < 4; ++i) sacc[i] = (f32x4){0.f, 0.f, 0.f, 0.f};
    float m_in = -1e30f;
    struct Raw { uint4 rq0, rq1, rk0, rk1, rv; float rg0, rg1; };
    Raw RA, RB;
    RA.rq1 = make_uint4(0u, 0u, 0u, 0u); RA.rk1 = RA.rq1; RA.rv = RA.rq1; RA.rg0 = 0.f; RA.rg1 = 0.f; RB = RA;
    auto load_chunk = [&](Raw& R, int c) {
        const int i0 = c * CS;
        const int tq = scan_tok(b, i0 + lt, dir);
        const bf16_t* pr = P + (size_t)tq * LD;
        R.rq0 = *(const uint4*)(pr + cQ + lj * 8); R.rk0 = *(const uint4*)(pr + cK + lj * 8);
        if (MODE == 2) { R.rq1 = *(const uint4*)(pr + cQ + lj * 8 + 32); R.rk1 = *(const uint4*)(pr + cK + lj * 8 + 32); }
        if (MODE != 1 || tid < 256) { const int tv = scan_tok(b, i0 + vt_, dir); R.rv = *(const uint4*)(P + (size_t)tv * LD + cV + vj * 8); }
        if (MODE == 0) { const int tg = scan_tok(b, i0 + lane, dir); R.rg0 = G[(size_t)tg * 16 + (dir ? 8 : 0) + h]; R.rg1 = G[(size_t)tg * 16 + (dir ? 12 : 4) + h]; }
    };
    constexpr int PD = (MODE == 2) ? 1 : 2;
    load_chunk(RA, 0); if (PD == 2) load_chunk(RB, 1);
    auto chunk = [&](const int c, Raw& R) {
        const uint4 rq0 = R.rq0, rq1 = R.rq1, rk0 = R.rk0, rk1 = R.rk1, rv = R.rv; const float rg0 = R.rg0, rg1 = R.rg1;
        const unsigned ST_R = L0 + O_ST + (unsigned)(c & 1) * NVR * QS, ST_W = L0 + O_ST + (unsigned)((c + 1) & 1) * NVR * QS;
        float sp = 1.f;
        float v_u = 0.f, v_M = 0.f, v_e = 1.f, v_low = 0.f, v_w = 1.f;
        if (MODE == 0) {
            const float ig = rg0 + gbi, fg = rg1 + gbf;
            const float lf = fminf(fg, 0.f) - flog(1.f + fexp(-fabsf(fg)));
            const float bb = scan_add64(lf, lane);
            const float g = SHI(bb, 63);
            v_u = ig - bb;
            const float cu = scan_max64(v_u, lane);
            v_M = fmaxf(m_in, cu);
            const float m_new = fmaxf(g + m_in, g + SHI(cu, 63));
            sp = fexp(g + m_in - m_new);
            v_w = fexp(g + v_u - m_new);
            v_e = fexp(m_in - v_M);
            v_low = fexp(-(bb + v_M));
            m_in = m_new;
            st16(L0 + O_QA + lt * QS + lj * 16, rq0);
            st16(L0 + O_KA + lt * QS + lj * 16, rk0);
            const float wr = SHI(v_w, lt);
            uint4 kw; kw.x = cvt_pk_bf16(bflo(rk0.x) * wr, bfhi(rk0.x) * wr); kw.y = cvt_pk_bf16(bflo(rk0.y) * wr, bfhi(rk0.y) * wr);
            kw.z = cvt_pk_bf16(bflo(rk0.z) * wr, bfhi(rk0.z) * wr); kw.w = cvt_pk_bf16(bflo(rk0.w) * wr, bfhi(rk0.w) * wr);
            st16(L0 + O_KW + lt * QS + lj * 16, kw);
            st16(L0 + O_V + vt_ * VS + vj * 16, rv);
        } else if (MODE == 2) {
            sp = fexp(64.f * lg);
            const bool lat = c >= CTXL / CS;
            float q[16], k[16];
            const unsigned qa[8] = {rq0.x, rq0.y, rq0.z, rq0.w, rq1.x, rq1.y, rq1.z, rq1.w}, ka[8] = {rk0.x, rk0.y, rk0.z, rk0.w, rk1.x, rk1.y, rk1.z, rk1.w};
#pragma unroll
            for (int i = 0; i < 8; ++i) { q[2 * i] = bflo(qa[i]); q[2 * i + 1] = bfhi(qa[i]); k[2 * i] = bflo(ka[i]); k[2 * i + 1] = bfhi(ka[i]); }
            if (lat) {
                const int tq = scan_tok(b, c * CS + lt, dir), tt = tq & (SEQ - 1);
                const int pos = ((tid >> 2) & 1) ? (tt & 63) : (tt >> 6);
                const float2* rt = (const float2*)ropet + pos * 32 + (tid & 3) * 8;
#pragma unroll
                for (int i = 0; i < 8; ++i) {
                    const float2 cs2 = rt[i];
                    const float q1 = q[i], q2 = q[8 + i], k1 = k[i], k2 = k[8 + i];
                    q[i] = q1 * cs2.x - q2 * cs2.y; q[8 + i] = q1 * cs2.y + q2 * cs2.x;
                    k[i] = k1 * cs2.x - k2 * cs2.y; k[8 + i] = k1 * cs2.y + k2 * cs2.x;
                }
            }
            const float wr = 0.08838834764831845f * fexp((float)(63 - lt) * lg);
            uint4 o0, o1, w0, w1, x0, x1;
            o0.x = cvt_pk_bf16(q[0], q[1]); o0.y = cvt_pk_bf16(q[2], q[3]); o0.z = cvt_pk_bf16(q[4], q[5]); o0.w = cvt_pk_bf16(q[6], q[7]);
            o1.x = cvt_pk_bf16(q[8], q[9]); o1.y = cvt_pk_bf16(q[10], q[11]); o1.z = cvt_pk_bf16(q[12], q[13]); o1.w = cvt_pk_bf16(q[14], q[15]);
            w0.x = cvt_pk_bf16(k[0], k[1]); w0.y = cvt_pk_bf16(k[2], k[3]); w0.z = cvt_pk_bf16(k[4], k[5]); w0.w = cvt_pk_bf16(k[6], k[7]);
            w1.x = cvt_pk_bf16(k[8], k[9]); w1.y = cvt_pk_bf16(k[10], k[11]); w1.z = cvt_pk_bf16(k[12], k[13]); w1.w = cvt_pk_bf16(k[14], k[15]);
            x0.x = cvt_pk_bf16(k[0] * wr, k[1] * wr); x0.y = cvt_pk_bf16(k[2] * wr, k[3] * wr); x0.z = cvt_pk_bf16(k[4] * wr, k[5] * wr); x0.w = cvt_pk_bf16(k[6] * wr, k[7] * wr);
            x1.x = cvt_pk_bf16(k[8] * wr, k[9] * wr); x1.y = cvt_pk_bf16(k[10] * wr, k[11] * wr); x1.z = cvt_pk_bf16(k[12] * wr, k[13] * wr); x1.w = cvt_pk_bf16(k[14] * wr, k[15] * wr);
            st16(L0 + O_QA + lt * QS + lj * 16, o0); st16(L0 + O_QA + lt * QS + lj * 16 + 64, o1);
            st16(L0 + O_KA + lt * QS + lj * 16, w0); st16(L0 + O_KA + lt * QS + lj * 16 + 64, w1);
            st16(L0 + O_KW + lt * QS + lj * 16, x0); st16(L0 + O_KW + lt * QS + lj * 16 + 64, x1);
            st16(L0 + O_V + vt_ * VS + vj * 16, rv);
        } else {
            const unsigned qa[4] = {rq0.x, rq0.y, rq0.z, rq0.w}, fa[4] = {rk0.x, rk0.y, rk0.z, rk0.w};
            float qv[8], kk[8], A[8];
#pragma unroll
            for (int i = 0; i < 8; ++i) {
                const float qr = (i & 1) ? bfhi(qa[i >> 1]) : bflo(qa[i >> 1]), fr = (i & 1) ? bfhi(fa[i >> 1]) : bflo(fa[i >> 1]);
                const float f = lbv[i] + (1.f - lbv[i]) * fsigmoid(fr);
                qv[i] = fsilu(qr); kk[i] = 1.f - f; A[i] = flog(f);
            }
#pragma unroll
            for (int o = 1; o < 32; o <<= 1)
#pragma unroll
                for (int i = 0; i < 8; ++i) { const float t = SHU(A[i], o); if (lt >= o) A[i] += t; }
            float qa_[8], qb_[8], ka_[8], kw_[8];
#pragma unroll
            for (int i = 0; i < 8; ++i) {
                const float am = SHI32(A[i], 15), ae = SHI32(A[i], 31);
                qa_[i] = qv[i] * fexp(A[i] - am); qb_[i] = qv[i] * fexp(A[i]); ka_[i] = kk[i] * fexp(am - A[i]); kw_[i] = kk[i] * fexp(ae - A[i]);
                if (lt == 31) *(LAS float*)(size_t)(L0 + O_DKV + (lj * 8 + i) * 4) = fexp(ae);
            }
            uint4 w;
            w.x = cvt_pk_bf16(qa_[0], qa_[1]); w.y = cvt_pk_bf16(qa_[2], qa_[3]); w.z = cvt_pk_bf16(qa_[4], qa_[5]); w.w = cvt_pk_bf16(qa_[6], qa_[7]); st16(L0 + O_QA + lt * QS + lj * 16, w);
            w.x = cvt_pk_bf16(qb_[0], qb_[1]); w.y = cvt_pk_bf16(qb_[2], qb_[3]); w.z = cvt_pk_bf16(qb_[4], qb_[5]); w.w = cvt_pk_bf16(qb_[6], qb_[7]); st16(L0 + O_QB + lt * QS + lj * 16, w);
            w.x = cvt_pk_bf16(ka_[0], ka_[1]); w.y = cvt_pk_bf16(ka_[2], ka_[3]); w.z = cvt_pk_bf16(ka_[4], ka_[5]); w.w = cvt_pk_bf16(ka_[6], ka_[7]); st16(L0 + O_KA + lt * QS + lj * 16, w);
            w.x = cvt_pk_bf16(kw_[0], kw_[1]); w.y = cvt_pk_bf16(kw_[2], kw_[3]); w.z = cvt_pk_bf16(kw_[4], kw_[5]); w.w = cvt_pk_bf16(kw_[6], kw_[7]); st16(L0 + O_KW + lt * QS + lj * 16, w);
            if (tid < 256) st16(L0 + O_V + vt_ * VS + vj * 16, rv);
        }
        __syncthreads();
        if (c + PD < NCH) load_chunk(R, c + PD);
        {
            constexpr int NT1 = CS / 16;
            const bool act = (MODE == 1) ? (wv < 4) : true;
            const int tb = (MODE == 1) ? (wv & 1) : (wv & 3);
#pragma unroll
            for (int u2 = 0; u2 < ((MODE == 1) ? 1 : 2); ++u2) {
                const int sb = (MODE == 1) ? (wv >> 1) : 2 * (wv >> 2) + u2;
                if (act) {
                    f32x4 d = (f32x4){0.f, 0.f, 0.f, 0.f};
                    if (sb <= tb) {
#pragma unroll
                        for (int kk2 = 0; kk2 < DK / 32; ++kk2)
                            d = SC_MFMA(rd_row(L0 + O_KA, sb * 16 + r16, QS, kk2 * 32 + q4 * 8), rd_row(L0 + O_QA, tb * 16 + r16, QS, kk2 * 32 + q4 * 8), d);
                        const int t = tb * 16 + r16, s0 = sb * 16 + q4 * 4;
                        if (MODE == 0) {
                            const float Mt = SHI(v_M, t);
#pragma unroll
                            for (int jj = 0; jj < 4; ++jj) { const float us = SHI(v_u, s0 + jj); d[jj] = (s0 + jj <= t) ? d[jj] * 0.125f * fexp(us - Mt) : 0.f; }
                        } else if (MODE == 2) {
#pragma unroll
                            for (int jj = 0; jj < 4; ++jj) d[jj] = (s0 + jj <= t) ? d[jj] * 0.08838834764831845f * fexp((float)(t - s0 - jj) * lg) : 0.f;
                        } else {
#pragma unroll
                            for (int jj = 0; jj < 4; ++jj) d[jj] = (s0 + jj <= t) ? d[jj] : 0.f;
                        }
                    }
                    st8(L0 + O_SSC + (tb * 16 + r16) * SS + (sb * 16 + q4 * 4) * 2, make_uint2(cvt_pk_bf16(d[0], d[1]), cvt_pk_bf16(d[2], d[3])));
                }
            }
            (void)NT1;
        }
        __syncthreads();
        {
            const int tb = (MODE == 1) ? (wv & 1) : (wv & 3);
            const int t = tb * 16 + r16;
            const int tok = scan_tok(b, c * CS + t, dir);
            constexpr int NV = (MODE == 1) ? 1 : 2;
            f32x4 oi[NV + EXT], oo[NV + EXT];
#pragma unroll
            for (int u2 = 0; u2 < NV + EXT; ++u2) {
                const int vt = (u2 == NV) ? 4 : ((MODE == 1) ? (wv >> 1) : 2 * (wv >> 2) + u2);
                f32x4 a1 = (f32x4){0.f, 0.f, 0.f, 0.f}, a2 = a1;
#pragma unroll
                for (int sb2 = 0; sb2 < CS / 32; ++sb2)
                    a1 = SC_MFMA(rd_tr(L0 + O_V, sb2 * 32, vt * 16, VS, lane), rd_row(L0 + O_SSC, t, SS, sb2 * 32 + q4 * 8), a1);
#pragma unroll
                for (int kk2 = 0; kk2 < DK / 32; ++kk2)
                    a2 = SC_MFMA(rd_row(ST_R, vt * 16 + r16, QS, kk2 * 32 + q4 * 8), rd_row(L0 + ((MODE == 1) ? O_QB : O_QA), t, QS, kk2 * 32 + q4 * 8), a2);
                oi[u2] = a1; oo[u2] = a2;
            }
            float den = 1.f, ei = 1.f;
            if (MODE == 0) {
                ei = 0.125f * SHI(v_e, t);
                const float dsum = oi[NV][0] + ei * oo[NV][0];
                const float dd = SHI(dsum, r16);
                den = 1.f / fmaxf(fabsf(dd), SHI(v_low, t));
            } else if (MODE == 2) {
                ei = fexp((float)(t + 1) * lg);
            }
#pragma unroll
            for (int u2 = 0; u2 < NV; ++u2) {
                const int vt = (MODE == 1) ? (wv >> 1) : 2 * (wv >> 2) + u2;
                float o[4];
#pragma unroll
                for (int jj = 0; jj < 4; ++jj) o[jj] = (oi[u2][jj] + ei * oo[u2][jj]) * den;
                *(uint2*)(HXo + (size_t)tok * 1024 + cO + vt * 16 + q4 * 4) = make_uint2(cvt_pk_bf16(o[0], o[1]), cvt_pk_bf16(o[2], o[3]));
            }
        }
        {
            constexpr int NS = (MODE == 0) ? 3 : 4;
            const int kt = (MODE == 0) ? (wv & 3) : wv;
            float dk[4] = {sp, sp, sp, sp};
            if (MODE == 1) { const f32x4 dv = *(const LAS f32x4*)(size_t)(L0 + O_DKV + (kt * 16 + q4 * 4) * 4); dk[0] = dv[0]; dk[1] = dv[1]; dk[2] = dv[2]; dk[3] = dv[3]; }
            f32x4 a[NS];
#pragma unroll
            for (int u2 = 0; u2 < NS; ++u2) { a[u2] = sacc[u2];
#pragma unroll
                for (int jj = 0; jj < 4; ++jj) a[u2][jj] *= dk[jj]; }
#pragma unroll
            for (int sb2 = 0; sb2 < CS / 32; ++sb2) {
                unsigned ta[5], ts[5]; bf16x8 ops[5];
                ta[0] = tr_addr(L0 + O_KW, sb2 * 32, kt * 16, QS, lane); ts[0] = 4u * QS;
#pragma unroll
                for (int u2 = 0; u2 < 4; ++u2) {
                    const int vt = (MODE == 0) ? ((u2 >= 2) ? 4 : 2 * (wv >> 2) + u2) : u2;
                    ta[1 + u2] = tr_addr(L0 + O_V, sb2 * 32, vt * 16, VS, lane); ts[1 + u2] = 4u * VS;
                }
                rd_tr5(ta, ts, ops);
#pragma unroll
                for (int u2 = 0; u2 < NS; ++u2) a[u2] = SC_MFMA(ops[0], ops[1 + u2], a[u2]);
            }
#pragma unroll
            for (int u2 = 0; u2 < NS; ++u2) {
                const int vt = (MODE == 0) ? ((u2 == 2) ? 4 : 2 * (wv >> 2) + u2) : u2;
                sacc[u2] = a[u2];
                st8(ST_W + (vt * 16 + r16) * QS + (kt * 16 + q4 * 4) * 2, make_uint2(cvt_pk_bf16(a[u2][0], a[u2][1]), cvt_pk_bf16(a[u2][2], a[u2][3])));
            }
        }
        __syncthreads();
    };
#pragma unroll 1
    for (int c = 0; c < NCH; c += 2) { chunk(c, RA); if (PD == 2) chunk(c + 1, RB); else chunk(c + 1, RA); }
}
}

__device__ __forceinline__ void ph_scan_even2(KP p, int l, int bid, int nb) {
#pragma unroll 1
    for (int item = bid; item < 256; item += nb) {
        const int kind = item >> 7, b = (item >> 4) & 7, h = (item >> 2) & 3, dir = (item >> 1) & 1, vs = item & 1;
        if (kind == 0) sc::scan_item<0>(p, l, b, h, dir, vs); else sc::scan_item<1>(p, l, b, h, dir, vs);
        __syncthreads();
    }
}
__device__ __forceinline__ void ph_scan_odd2(KP p, int l, int bid, int nb) {
#pragma unroll 1
    for (int item = bid; item < 128; item += nb) {
        const int b = (item >> 4) & 7, h = (item >> 2) & 3, dir = (item >> 1) & 1, vs = item & 1;
        sc::scan_item<2>(p, l, b, h, dir, vs);
        __syncthreads();
    }
}

__device__ __forceinline__ void unpack16(const uint4 a, const uint4 b, float (&x)[16]) {
    x[0] = bflo(a.x); x[1] = bfhi(a.x); x[2] = bflo(a.y); x[3] = bfhi(a.y); x[4] = bflo(a.z); x[5] = bfhi(a.z); x[6] = bflo(a.w); x[7] = bfhi(a.w);
    x[8] = bflo(b.x); x[9] = bfhi(b.x); x[10] = bflo(b.y); x[11] = bfhi(b.y); x[12] = bflo(b.z); x[13] = bfhi(b.z); x[14] = bflo(b.w); x[15] = bfhi(b.w);
}
__device__ __forceinline__ float sum8(float v) { v += SHX(v, 1); v += SHX(v, 2); v += SHX(v, 4); return v; }
template <bool MEANSUB, bool SIG>
__device__ __forceinline__ void head_norm_gate16(const bf16_t* h0, const bf16_t* h1, const bf16_t* gp, const float* nw, bf16_t* out) {
    float a[16], b[16], g[16];
    unpack16(*(const uint4*)h0, *(const uint4*)(h0 + 8), a); unpack16(*(const uint4*)h1, *(const uint4*)(h1 + 8), b); unpack16(*(const uint4*)gp, *(const uint4*)(gp + 8), g);
    float s = 0.f;
#pragma unroll
    for (int i = 0; i < 16; ++i) { a[i] += b[i]; s += a[i]; }
    if (MEANSUB) { const float mean = sum8(s) * (1.f / 128.f);
#pragma unroll
        for (int i = 0; i < 16; ++i) a[i] -= mean; }
    float q = 0.f;
#pragma unroll
    for (int i = 0; i < 16; ++i) q += a[i] * a[i];
    const float r = rsqrtf(sum8(q) * (1.f / 128.f) + LN_EPS);
    unsigned w[8];
#pragma unroll
    for (int i = 0; i < 16; i += 2) {
        const float y0 = a[i] * r * nw[i] * (SIG ? sigmoidf_(g[i]) : siluf_(g[i])), y1 = a[i + 1] * r * nw[i + 1] * (SIG ? sigmoidf_(g[i + 1]) : siluf_(g[i + 1]));
        w[i >> 1] = cvt_pk_bf16(y0, y1);
    }
    *(uint4*)out = make_uint4(w[0], w[1], w[2], w[3]); *(uint4*)(out + 8) = make_uint4(w[4], w[5], w[6], w[7]);
}
__device__ __forceinline__ void ph_normgate_even(KP p, int l, int bid, int nb) {
    const int tid = opaque_tid(), lane = tid & 63, wv = tid >> 6;
    const bf16_t* P = (const bf16_t*)(p->ws + OFF_BIG);
    const bf16_t* HX = (const bf16_t*)(p->ws + OFF_AUX);
    const bf16_t* HX1 = HX + (size_t)NT * 1024;
    bf16_t* MIX = (bf16_t*)(p->ws + OFF_U);
    const int e = l >> 1;
    const bool ml = lane < 32;
    const float* nw = ml ? p->in[I_MNW] + e * 512 + 16 * lane : p->in[I_HNW] + e * 512 + 16 * (lane - 32);
    const int gcol = ml ? E_MO + 16 * lane : E_HG + 16 * (lane - 32);
#pragma unroll 1
    for (int tok = bid * 8 + wv; tok < NT; tok += nb * 8) {
        const size_t o = (size_t)tok * 1024 + 16 * lane;
        if (ml) head_norm_gate16<true, true>(HX + o, HX1 + o, P + (size_t)tok * EVEN_LD + gcol, nw, MIX + o);
        else head_norm_gate16<false, false>(HX + o, HX1 + o, P + (size_t)tok * EVEN_LD + gcol, nw, MIX + o);
    }
}

#define OFF_UT   (OFF_AUX + 136 * MiB)
#define OFF_FKS(o) (984 * MiB + (size_t)(o) * 34 * MiB)
#define OFF_ZOT  (OFF_UT + 102 * MiB)

__device__ __forceinline__ void ph_hy_filt2(KP p, int l, int bid, int nb, float* sm, int skip) {
    const int tid = opaque_tid(), o = l >> 1;
    float* zf = sm;
    float* h1 = sm + 1024;
    float* h2 = sm + 2048;
    float* h3 = sm + 3072;
    const float* fw1 = p->in[I_HW1] + o * 33 * 64; const float* fb1 = p->in[I_HB1] + o * 64;
    const float* fw2 = p->in[I_HW2] + o * 64 * 64; const float* fb2 = p->in[I_HB2] + o * 64;
    const float* fw3 = p->in[I_HW3] + o * 64 * 64; const float* fb3 = p->in[I_HB3] + o * 64;
    const float* freq = p->in[I_HFREQ] + o * 64;
    const float* wout = p->in[I_HWOUT] + (size_t)o * 64 * 2048;
    float* FK = (float*)(p->ws + OFF_FKS(o)); float* FKC = FK + (size_t)2 * 512 * 8192;
#pragma unroll 1
    for (int item = bid - skip; item < (SEQ + CTXL) / 16; item += nb - skip) {
        if (item < 0) break;
        const bool isctx = item >= SEQ / 16;
        const int L = isctx ? CTXL : SEQ, pos0 = (isctx ? item - SEQ / 16 : item) * 16;
        __syncthreads();
        if (tid < 16 * 17) {
            const int pp = tid / 17, j = tid % 17, pos = pos0 + pp;
            if (j == 16) zf[pp * 36] = (float)pos / (float)(L - 1);
            else { const float f = 1e-4f + (float)j * ((15.0f - 1e-4f) / 15.0f); const float w = 2.0f * 3.14159265358979323846f * (float)pos / (float)L * f; zf[pp * 36 + 1 + j] = cosf(w); zf[pp * 36 + 17 + j] = sinf(w); }
        }
        __syncthreads();
        const int pp = tid >> 5, u0 = (tid & 31) * 2;
        { float a0 = fb1[u0], a1 = fb1[u0 + 1];
#pragma unroll 1
          for (int k = 0; k < 33; ++k) { const float z = zf[pp * 36 + k]; a0 += z * fw1[k * 64 + u0]; a1 += z * fw1[k * 64 + u0 + 1]; }
          h1[pp * 64 + u0] = sinf(freq[u0] * a0); h1[pp * 64 + u0 + 1] = sinf(freq[u0 + 1] * a1); }
        __syncthreads();
        { float a0 = fb2[u0], a1 = fb2[u0 + 1];
#pragma unroll 4
          for (int k = 0; k < 64; ++k) { const float z = h1[pp * 64 + k]; a0 += z * fw2[k * 64 + u0]; a1 += z * fw2[k * 64 + u0 + 1]; }
          h2[pp * 64 + u0] = sinf(freq[u0] * a0); h2[pp * 64 + u0 + 1] = sinf(freq[u0 + 1] * a1); }
        __syncthreads();
        { float a0 = fb3[u0], a1 = fb3[u0 + 1];
#pragma unroll 4
          for (int k = 0; k < 64; ++k) { const float z = h2[pp * 64 + k]; a0 += z * fw3[k * 64 + u0]; a1 += z * fw3[k * 64 + u0 + 1]; }
          h3[pp * 64 + u0] = sinf(freq[u0] * a0); h3[pp * 64 + u0 + 1] = sinf(freq[u0 + 1] * a1); }
        __syncthreads();
#pragma unroll 1
        for (int r = 0; r < 4; ++r) {
            const int col = tid + 512 * r, c = col & 511, od = col >> 9, order = od >> 1, dirn = od & 1;
            float a[16];
#pragma unroll
            for (int i = 0; i < 16; ++i) a[i] = 0.f;
#pragma unroll 2
            for (int k = 0; k < 64; ++k) { const float w = wout[k * 2048 + col];
#pragma unroll
                for (int i = 0; i < 16; ++i) a[i] += h3[i * 64 + k] * w; }
            const float delta = 3.0701134573253944f + (float)c * ((15.350567286626972f - 3.0701134573253944f) / 511.0f);
#pragma unroll
            for (int i = 0; i < 16; ++i) a[i] *= expf(-((float)(pos0 + i) / (float)(L - 1)) * delta);
            float* dst = isctx ? FKC + ((size_t)order * 512 + c) * 512 + 256 : FK + ((size_t)order * 512 + c) * 8192 + 4096;
            if (dirn == 0) {
#pragma unroll
                for (int i = 0; i < 16; i += 4) *(float4*)(dst + pos0 + i) = make_float4(a[i], a[i + 1], a[i + 2], a[i + 3]);
            } else {
#pragma unroll
                for (int i = 0; i < 16; ++i) if (pos0 + i > 0) dst[-(pos0 + i)] = a[i];
                if (pos0 == 0) dst[-L] = 0.f;
            }
        }
    }
}

__device__ __forceinline__ void ph_hy_prep(KP p, int l, int bid, int nb, float* sm) {
    const int tid = opaque_tid(), o = l >> 1;
    const bf16_t* P = (const bf16_t*)(p->ws + OFF_BIG);
    bf16_t* UT = (bf16_t*)(p->ws + OFF_UT);
    const float* cw = p->in[I_HCW] + o * 3 * 1536; const float* cb = p->in[I_HCB] + o * 1536;
    float* tile = sm;
#pragma unroll 1
    for (int item = bid; item < (NT / 256) * 24; item += nb) {
        const int tt = item / 24, ct = item % 24, tok0 = tt * 256, col0 = ct * 64;
        const bool lat = tok0 < NL;
        const int L = lat ? SEQ : CTXL, t0 = lat ? (tok0 & (SEQ - 1)) : ((tok0 - NL) & (CTXL - 1));
        __syncthreads();
#pragma unroll 1
        for (int i = tid; i < 258 * 8; i += 512) {
            const int rr = i >> 3, hf = i & 7, t = t0 + rr - 1;
            uint4 v = make_uint4(0u, 0u, 0u, 0u);
            if (t >= 0 && t < L) v = *(const uint4*)(P + (size_t)(tok0 + rr - 1) * ODD_LD + col0 + hf * 8);
            float* d = tile + rr * 65 + hf * 8;
            d[0] = bflo(v.x); d[1] = bfhi(v.x); d[2] = bflo(v.y); d[3] = bfhi(v.y); d[4] = bflo(v.z); d[5] = bfhi(v.z); d[6] = bflo(v.w); d[7] = bfhi(v.w);
        }
        __syncthreads();
#pragma unroll 1
        for (int r = 0; r < 4; ++r) {
            const int cc = (tid >> 5) + 16 * r, tc = (tid & 31) * 8, col = col0 + cc;
            const float w0 = cw[col], w1 = cw[1536 + col], w2 = cw[3072 + col], bb = cb[col];
            float y[8];
#pragma unroll
            for (int i = 0; i < 8; ++i) y[i] = tile[(tc + i) * 65 + cc] * w0 + tile[(tc + i + 1) * 65 + cc] * w1 + tile[(tc + i + 2) * 65 + cc] * w2 + bb;
            *(uint4*)(UT + (size_t)col * NT + tok0 + tc) = make_uint4(cvt_pk_bf16(y[0], y[1]), cvt_pk_bf16(y[2], y[3]), cvt_pk_bf16(y[4], y[5]), cvt_pk_bf16(y[6], y[7]));
        }
    }
}

__device__ __forceinline__ void hy_item_lat(KP p, int l, int c) {
    constexpr int ZSB = (SEQ + 8) * 2;
    constexpr unsigned O_Z = 0, O_KF = O_Z + 8 * ZSB, O_END = O_KF + 8192 * 4;
    static_assert(O_END <= BAR_LDS_, "hyena LDS");
    const int tid = opaque_tid(), lane = tid & 63, wv = __builtin_amdgcn_readfirstlane(tid >> 6), r16 = lane & 15, q4 = lane >> 4, o = l >> 1;
    const unsigned L0 = (unsigned)(size_t)smraw_base();
    const bf16_t* UT = (const bf16_t*)(p->ws + OFF_UT);
    bf16_t* ZOT = (bf16_t*)(p->ws + OFF_ZOT);
    const float* FK = (const float*)(p->ws + OFF_FKS(o));
    for (int i = tid; i < 8 * 512; i += 512) { const int b = i >> 9, ch = i & 511; sc::st16(L0 + O_Z + b * ZSB + ch * 16, *(const uint4*)(UT + (size_t)(1024 + c) * NT + b * SEQ + ch * 8)); }
#pragma unroll 1
    for (int order = 0; order < 2; ++order) {
        const float* fk = FK + ((size_t)order * 512 + c) * 8192;
        for (int i = tid; i < 2048; i += 512) { const float4 v = *(const float4*)(fk + i * 4); *(LAS sc::f32x4*)(size_t)(L0 + O_KF + i * 16) = (sc::f32x4){v.x, v.y, v.z, v.w}; }
        __syncthreads();
        sc::f32x4 acc[4][4];
#pragma unroll
        for (int a = 0; a < 4; ++a)
#pragma unroll
            for (int b2 = 0; b2 < 4; ++b2) acc[a][b2] = (sc::f32x4){0.f, 0.f, 0.f, 0.f};
        auto ldG = [&](int g) {
            const unsigned a0 = L0 + O_KF + (unsigned)(4096 + 16 * g + r16 - 8 * q4) * 4u;
            float v[8];
#pragma unroll
            for (int j = 0; j < 8; ++j) v[j] = *(const LAS float*)(size_t)(a0 - 4u * j);
            const unsigned w0 = cvt_pk_bf16(v[0], v[1]), w1 = cvt_pk_bf16(v[2], v[3]), w2 = cvt_pk_bf16(v[4], v[5]), w3 = cvt_pk_bf16(v[6], v[7]);
            return __builtin_bit_cast(sc::bf16x8, (sc::u32x4_){w0, w1, w2, w3});
        };
        sc::bf16x8 bq[4][2], W[6];
#pragma unroll
        for (int i = 0; i < 4; ++i) { bq[i][0] = (sc::bf16x8){0, 0, 0, 0, 0, 0, 0, 0}; bq[i][1] = bq[i][0]; }
        const int D0 = 8 * wv - 63, D1 = (8 * wv + 7 < 63) ? 8 * wv + 7 : 63;
        W[4] = ldG(4 * D0 - 6 + 4); W[5] = ldG(4 * D0 - 6 + 5);
#pragma unroll 1
        for (int D = D0; D <= D1; ++D) {
            W[0] = W[4]; W[1] = W[5];
#pragma unroll
            for (int i = 0; i < 4; ++i) W[2 + i] = ldG(4 * D + i);
            bq[3][0] = bq[2][0]; bq[3][1] = bq[2][1]; bq[2][0] = bq[1][0]; bq[2][1] = bq[1][1]; bq[1][0] = bq[0][0]; bq[1][1] = bq[0][1];
            {
                const int s1 = 8 * wv - D + ((r16 < 8) ? 0 : 4);
                const bool ok = (unsigned)s1 < 64u;
                const unsigned za = L0 + O_Z + (unsigned)((r16 & 7) * ZSB + ((ok ? s1 : 0) * 64 + q4 * 8) * 2);
                sc::bf16x8 b0 = *(const LAS sc::bf16x8*)(size_t)za, b1 = *(const LAS sc::bf16x8*)(size_t)(za + 64);
                if (!ok) { b0 = (sc::bf16x8){0, 0, 0, 0, 0, 0, 0, 0}; b1 = b0; }
                bq[0][0] = b0; bq[0][1] = b1;
            }
#pragma unroll
            for (int cg = 0; cg < 4; ++cg) {
                const int sA = 8 * wv + cg - D;
                if ((unsigned)sA < 64u || (unsigned)(sA + 4) < 64u) {
#pragma unroll
                    for (int it = 0; it < 4; ++it) { acc[cg][it] = SC_MFMA(W[it + 2], bq[cg][0], acc[cg][it]); acc[cg][it] = SC_MFMA(W[it], bq[cg][1], acc[cg][it]); }
                }
            }
        }
        __syncthreads();
        const float sk = p->in[I_HSKIP][o * 1024 + order * 512 + c];
        const bf16_t* gt = UT + (size_t)(order * 512 + c) * NT;
        const int bb = r16 & 7;
#pragma unroll
        for (int cg = 0; cg < 4; ++cg) {
            const int t1 = 8 * wv + cg + ((r16 < 8) ? 0 : 4);
#pragma unroll
            for (int it = 0; it < 4; ++it) {
                const int t = t1 * 64 + it * 16 + q4 * 4;
                const sc::u32x2_ zo_ = *(const LAS sc::u32x2_*)(size_t)(L0 + O_Z + bb * ZSB + t * 2); const uint2 zo = make_uint2(zo_[0], zo_[1]);
                const uint2 gv = *(const uint2*)(gt + bb * SEQ + t);
                const float y0 = bflo(gv.x) * (acc[cg][it][0] + sk * bflo(zo.x)), y1 = bfhi(gv.x) * (acc[cg][it][1] + sk * bfhi(zo.x));
                const float y2 = bflo(gv.y) * (acc[cg][it][2] + sk * bflo(zo.y)), y3 = bfhi(gv.y) * (acc[cg][it][3] + sk * bfhi(zo.y));
                const uint2 w = make_uint2(cvt_pk_bf16(y0, y1), cvt_pk_bf16(y2, y3));
                if (order == 0) sc::st8(L0 + O_Z + bb * ZSB + t * 2, w);
                else *(uint2*)(ZOT + (size_t)c * NT + bb * SEQ + t) = w;
            }
        }
        __syncthreads();
    }
}

__device__ __forceinline__ void hy_item_ctx(KP p, int l, int c, float* sm) {
    const int tid = opaque_tid(), o = l >> 1;
    const bf16_t* UT = (const bf16_t*)(p->ws + OFF_UT);
    bf16_t* ZOT = (bf16_t*)(p->ws + OFF_ZOT);
    const float* FKC = (const float*)(p->ws + OFF_FKS(o)) + (size_t)2 * 512 * 8192;
    float* Kc = sm;
    float* zb = sm + 1024;
    for (int i = tid; i < 1024; i += 512) Kc[i] = FKC[((size_t)(i >> 9) * 512 + c) * 512 + (i & 511)];
    for (int i = tid; i < 8 * CTXL; i += 512) zb[i] = bf2f(UT[(size_t)(1024 + c) * NT + NL + i]);
    __syncthreads();
    const int bb = tid >> 6, tl = tid & 63;
#pragma unroll 1
    for (int order = 0; order < 2; ++order) {
        float acc[4] = {0.f, 0.f, 0.f, 0.f};
#pragma unroll 4
        for (int s = 0; s < CTXL; ++s) {
            const float zv = zb[bb * CTXL + s];
#pragma unroll
            for (int i = 0; i < 4; ++i) acc[i] += Kc[order * 512 + tl + 64 * i - s + 256] * zv;
        }
        const float sk = p->in[I_HSKIP][o * 1024 + order * 512 + c];
        float zn[4];
#pragma unroll
        for (int i = 0; i < 4; ++i) { const int t = tl + 64 * i; zn[i] = bf2f(UT[(size_t)(order * 512 + c) * NT + NL + bb * CTXL + t]) * (acc[i] + zb[bb * CTXL + t] * sk); }
        __syncthreads();
#pragma unroll
        for (int i = 0; i < 4; ++i) { const int t = tl + 64 * i; if (order == 0) zb[bb * CTXL + t] = bf2f((bf16_t)(cvt_pk_bf16(zn[i], 0.f) & 0xffffu)); else stf(ZOT + (size_t)c * NT + NL + bb * CTXL + t, zn[i]); }
        __syncthreads();
    }
}

__device__ __forceinline__ void ph_mix_odd(KP p, int l, int bid, int nb, float* sm) {
    int* head = (int*)(p->ws + OFF_CNT) + 1024 + (l >> 1) * 64;
    LAS int* slot = (LAS int*)(smraw_base() + BAR_LDS_ + 64);
#pragma unroll 1
    for (;;) {
        if (opaque_tid() == 0) *slot = atomicAdd(head, 1);
        __syncthreads();
        const int item = *slot;
        __syncthreads();
        if (item >= 128 + 512) break;
        if (item < 128) { const int b = (item >> 4) & 7, h = (item >> 2) & 3, dir = (item >> 1) & 1, vs = item & 1; sc::scan_item<2>(p, l, b, h, dir, vs); }
        else { const int c = item - 128; hy_item_lat(p, l, c); __syncthreads(); hy_item_ctx(p, l, c, sm); }
        __syncthreads();
    }
}

__device__ __forceinline__ void ph_hy_norm(KP p, int l, int bid, int nb, float* sm) {
    const int tid = opaque_tid(), o = l >> 1;
    const bf16_t* ZOT = (const bf16_t*)(p->ws + OFF_ZOT);
    bf16_t* MIX = (bf16_t*)(p->ws + OFF_U);
    const float* nw = p->in[I_HNORM] + o * 512;
    float* tile = sm;
    float* part = sm + 64 * 65;
#pragma unroll 1
    for (int item = bid; item < (NT / 64) * 8; item += nb) {
        const int tt = item >> 3, g = item & 7, tok0 = tt * 64;
        __syncthreads();
        { const int cc = tid >> 3, ch = tid & 7;
          const uint4 v = *(const uint4*)(ZOT + (size_t)(g * 64 + cc) * NT + tok0 + ch * 8);
          float* d = tile + cc * 65 + ch * 8;
          d[0] = bflo(v.x); d[1] = bfhi(v.x); d[2] = bflo(v.y); d[3] = bfhi(v.y); d[4] = bflo(v.z); d[5] = bfhi(v.z); d[6] = bflo(v.w); d[7] = bfhi(v.w); }
        __syncthreads();
        { const int tk = tid & 63, pt = tid >> 6; float s = 0.f;
#pragma unroll
          for (int i = 0; i < 8; ++i) { const float x = tile[(pt * 8 + i) * 65 + tk]; s += x * x; }
          part[pt * 64 + tk] = s; }
        __syncthreads();
        { const int tk = tid >> 3, ch = tid & 7; float s = 0.f;
#pragma unroll
          for (int i = 0; i < 8; ++i) s += part[i * 64 + tk];
          const float rs = rsqrtf(s * (1.f / 64.f) + LN_EPS);
          float y[8];
#pragma unroll
          for (int i = 0; i < 8; ++i) y[i] = tile[(ch * 8 + i) * 65 + tk] * rs * nw[g * 64 + ch * 8 + i];
          *(uint4*)(MIX + (size_t)(tok0 + tk) * DM + g * 64 + ch * 8) = make_uint4(cvt_pk_bf16(y[0], y[1]), cvt_pk_bf16(y[2], y[3]), cvt_pk_bf16(y[4], y[5]), cvt_pk_bf16(y[6], y[7])); }
    }
}

__device__ __forceinline__ void ph_normgate_odd(KP p, int l, int bid, int nb) {
    const int tid = opaque_tid(), lane = tid & 63, wv = tid >> 6, o2 = l >> 1;
    const bf16_t* P = (const bf16_t*)(p->ws + OFF_BIG);
    const bf16_t* HX = (const bf16_t*)(p->ws + OFF_AUX);
    const bf16_t* HX1 = HX + (size_t)NT * 1024;
    bf16_t* MIX = (bf16_t*)(p->ws + OFF_U);
    const int c16 = 16 * (lane & 31);
    const float* nw = p->in[I_RNW] + o2 * 512 + c16;
#pragma unroll 1
    for (int t2 = bid * 8 + wv; t2 < NT / 2; t2 += nb * 8) {
        const int tok = t2 * 2 + (lane >> 5);
        const size_t o = (size_t)tok * 1024 + 512 + c16;
        head_norm_gate16<true, false>(HX + o, HX1 + o, P + (size_t)tok * ODD_LD + 3072 + c16, nw, MIX + o);
    }
}

__device__ __forceinline__ void ph_ln1_router(KP p, int l, int ntok, int bid, int nb, float* sm) {
    constexpr int VP = (1024 + 8) * 2;
    constexpr unsigned O_VH = 0, O_VL = 32 * VP, O_LG = 64 * VP;
    static_assert(O_LG + 32 * 64 * 4 <= BAR_LDS_, "router LDS");
    const int tid = opaque_tid(), lane = tid & 63, wv = __builtin_amdgcn_readfirstlane(tid >> 6), r16 = lane & 15, q4 = lane >> 4;
    const unsigned L0 = (unsigned)(size_t)smraw_base();
    const float* Y = (const float*)(p->ws + OFF_BIG);
    bf16_t* U = (bf16_t*)(p->ws + OFF_U);
    const float* lw = p->in[I_LNW] + (l * 2) * 1024; const float* lb = p->in[I_LNB] + (l * 2) * 1024;
    const bf16_t* RWH = (const bf16_t*)(p->ws + OFF_RWH); const bf16_t* RWL = RWH + 64 * 1024;
    const float rb = p->in[I_RB][l * 64 + lane];
    LAS int* lcnt = (LAS int*)(smraw_base() + BAR_LDS_ + 256);
    if (tid < 64) lcnt[tid] = 0;
    __syncthreads();
    int* tidx = (int*)(p->ws + OFF_TIDX); float* tgate = (float*)(p->ws + OFF_TGATE); int* tpos = (int*)(p->ws + OFF_TPOS);
    {
        int* stok = (int*)(p->ws + OFF_STOK); float* sgate = (float*)(p->ws + OFF_SGATE); int* sdst = (int*)(p->ws + OFF_SDST);
#pragma unroll 1
        for (int i = bid * 512 + tid; i < MAXROWS; i += nb * 512) { stok[i] = ZROW; sgate[i] = 0.f; sdst[i] = -1; }
    }
#pragma unroll 1
    for (int base = bid * 32; base < ntok; base += nb * 32) {
#pragma unroll 2
        for (int j = 0; j < 4; ++j) {
            const int tl = wv * 4 + j, tok = base + tl;
            float* h = hrow(p, tok);
            const float* m = modrow(p, l, tok);
            const float* r = Y + (size_t)tok * DM;
            float x[16]; float s = 0.f;
#pragma unroll
            for (int c = 0; c < 4; ++c) {
                const int d = 4 * (lane + 64 * c);
                const float4 hv = *(const float4*)(h + d), gv = *(const float4*)(m + 2 * 1024 + d), rv = *(const float4*)(r + d);
                x[4 * c] = ALPHA * hv.x + gv.x * rv.x; x[4 * c + 1] = ALPHA * hv.y + gv.y * rv.y; x[4 * c + 2] = ALPHA * hv.z + gv.z * rv.z; x[4 * c + 3] = ALPHA * hv.w + gv.w * rv.w;
                s += x[4 * c] + x[4 * c + 1] + x[4 * c + 2] + x[4 * c + 3];
            }
            const float mean = wave_sum(s) * (1.f / 1024.f);
            float q = 0.f;
#pragma unroll
            for (int i = 0; i < 16; ++i) { x[i] -= mean; q += x[i] * x[i]; }
            const float rs = rsqrtf(wave_sum(q) * (1.f / 1024.f) + LN_EPS);
#pragma unroll
            for (int c = 0; c < 4; ++c) {
                const int d = 4 * (lane + 64 * c);
                const float4 w4 = *(const float4*)(lw + d), b4 = *(const float4*)(lb + d), sh = *(const float4*)(m + 3 * 1024 + d), sc = *(const float4*)(m + 4 * 1024 + d);
                float4 y; y.x = x[4 * c] * rs * w4.x + b4.x; y.y = x[4 * c + 1] * rs * w4.y + b4.y; y.z = x[4 * c + 2] * rs * w4.z + b4.z; y.w = x[4 * c + 3] * rs * w4.w + b4.w;
                *(float4*)(h + d) = y;
                float4 v; v.x = y.x * (1.f + sc.x) + sh.x; v.y = y.y * (1.f + sc.y) + sh.y; v.z = y.z * (1.f + sc.z) + sh.z; v.w = y.w * (1.f + sc.w) + sh.w;
                const unsigned h0 = cvt_pk_bf16(v.x, v.y), h1 = cvt_pk_bf16(v.z, v.w);
                *(uint2*)(U + (size_t)tok * DM + d) = make_uint2(h0, h1);
                sc::st8(L0 + O_VH + tl * VP + d * 2, make_uint2(h0, h1));
                sc::st8(L0 + O_VL + tl * VP + d * 2, make_uint2(cvt_pk_bf16(v.x - bflo(h0), v.y - bfhi(h0)), cvt_pk_bf16(v.z - bflo(h1), v.w - bfhi(h1))));
            }
        }
        __syncthreads();
        {
            const int tt = wv & 1, et = wv >> 1;
            sc::f32x4 acc = (sc::f32x4){0.f, 0.f, 0.f, 0.f};
            const bf16_t* bh = RWH + (size_t)(et * 16 + r16) * 1024 + q4 * 8; const bf16_t* bl = RWL + (size_t)(et * 16 + r16) * 1024 + q4 * 8;
#pragma unroll 4
            for (int ks = 0; ks < 32; ++ks) {
                const sc::bf16x8 ah = sc::rd_row(L0 + O_VH, tt * 16 + r16, VP, ks * 32 + q4 * 8), al = sc::rd_row(L0 + O_VL, tt * 16 + r16, VP, ks * 32 + q4 * 8);
                const sc::bf16x8 wh = *(const sc::bf16x8*)(bh + ks * 32), wl = *(const sc::bf16x8*)(bl + ks * 32);
                acc = SC_MFMA(ah, wh, acc); acc = SC_MFMA(ah, wl, acc); acc = SC_MFMA(al, wh, acc);
            }
#pragma unroll
            for (int jj = 0; jj < 4; ++jj) *(LAS float*)(size_t)(L0 + O_LG + ((tt * 16 + q4 * 4 + jj) * 64 + et * 16 + r16) * 4) = acc[jj];
        }
        __syncthreads();
#pragma unroll 1
        for (int j = 0; j < 4; ++j) {
            const int tl = wv * 4 + j, tok = base + tl;
            const float lg = *(const LAS float*)(size_t)(L0 + O_LG + (tl * 64 + lane) * 4);
            const float score = sigmoidf_(lg);
            const float key = score + rb;
            int rank = 0;
#pragma unroll
            for (int e = 0; e < 64; ++e) { const float ke = __builtin_bit_cast(float, __builtin_amdgcn_readlane(__builtin_bit_cast(int, key), e)); rank += (ke > key || (ke == key && e < lane)) ? 1 : 0; }
            const bool sel = rank < TOPK;
            const float gsum = wave_sum(sel ? score : 0.f);
            if (sel) {
                const int pos = __hip_atomic_fetch_add(lcnt + lane, 1, __ATOMIC_RELAXED, __HIP_MEMORY_SCOPE_WORKGROUP);
                tidx[tok * 8 + rank] = lane; tgate[tok * 8 + rank] = 2.5f * score / gsum; tpos[tok * 8 + rank] = pos;
            }
        }
        __syncthreads();
    }
    __syncthreads();
    if (tid < 64) ((int*)(p->ws + OFF_BCNT))[bid * 64 + tid] = lcnt[tid];
}

__device__ __forceinline__ void moe_offsets(KP p, int l, int ntok, LAS int* offs) {
    const int t = opaque_tid();
    if (t < 66) offs[t] = ((const int*)(p->ws + OFF_GOFFS))[t];
    __syncthreads();
}
__device__ __forceinline__ int moe_expert_of(const LAS int* offs, int row) { int e = 0;
#pragma unroll 1
    while (e < 64 && row >= offs[e + 1]) ++e;
    return e; }

__device__ __forceinline__ void ph_scatter(KP p, int l, int ntok, int bid, int nb, LAS unsigned char* lds) {
    LAS int* offs = (LAS int*)lds;
    LAS int* myb = offs + 128;
    LAS int* part = offs + 256;
    const int tid = opaque_tid();
    const int* bcnt = (const int*)(p->ws + OFF_BCNT);
    { const int e = tid & 63, pt = tid >> 6; int tot = 0, mine = 0;
#pragma unroll 4
      for (int b = pt; b < nb; b += 8) { const int c = bcnt[b * 64 + e]; tot += c; mine += (b < bid) ? c : 0; }
      part[pt * 64 + e] = tot; part[512 + pt * 64 + e] = mine; }
    __syncthreads();
    if (tid < 64) {
        int tot = 0, mine = 0;
#pragma unroll
        for (int i = 0; i < 8; ++i) { tot += part[i * 64 + tid]; mine += part[512 + i * 64 + tid]; }
        const int pc = (tot + 255) & ~255;
        int incl = pc;
#pragma unroll
        for (int o = 1; o < 64; o <<= 1) { const int t = SHU(incl, o); if (tid >= o) incl += t; }
        offs[tid] = incl - pc; myb[tid] = mine;
        if (tid == 63) { offs[64] = incl; offs[65] = incl + ntok; }
    }
    __syncthreads();
    if (bid == 0 && tid < 66) ((int*)(p->ws + OFF_GOFFS))[tid] = offs[tid];
    const int* tidx = (const int*)(p->ws + OFF_TIDX); const float* tgate = (const float*)(p->ws + OFF_TGATE); const int* tpos = (const int*)(p->ws + OFF_TPOS);
    int* stok = (int*)(p->ws + OFF_STOK); float* sgate = (float*)(p->ws + OFF_SGATE); int* sdst = (int*)(p->ws + OFF_SDST);
    int* tile_e = (int*)(p->ws + OFF_TILEE);
#pragma unroll 1
    for (int base = bid * 32; base < ntok; base += nb * 32) {
        if (tid < 32 * 9) {
            const int tok = base + tid / 9, sl = tid % 9;
            if (sl < 8) { const int i = tok * 8 + sl, e = tidx[i], row = offs[e] + myb[e] + tpos[i]; stok[row] = tok; sgate[row] = tgate[i]; sdst[row] = tok * 9 + sl; }
            else { const int row = offs[64] + tok; stok[row] = tok; sgate[row] = 1.f; sdst[row] = tok * 9 + 8; }
        }
    }
    const int nrt = offs[65] >> 8;
#pragma unroll 1
    for (int rt = bid * 512 + tid; rt < nrt; rt += nb * 512) tile_e[rt] = moe_expert_of(offs, rt * 256);
    __syncthreads();
}

#define MOE_TAB (gp::STAGE_BYTES + 256)
#define MOE_MAXT 9
static_assert(131072 + 256 + 256 + MOE_MAXT * 2048 <= BAR_LDS_, "MoE tables");
struct MoeDeal {
    int nfull, rem, c, G;
    __device__ __forceinline__ void init(int nrt, int c_, int G_) { nfull = nrt / G_; rem = nrt % G_; c = c_; G = G_; }
    __device__ __forceinline__ int nleft(int NPN) const { const int tot = rem * NPN; return c < tot ? (tot - c + G - 1) / G : 0; }
    __device__ __forceinline__ int ntiles(int NPN) const { return nfull + nleft(NPN); }
    __device__ __forceinline__ int tile_of(int j, int NPN) const { return j < nfull ? c + j * G : nfull * G + (c + (j - nfull) * G) / NPN; }
    __device__ __forceinline__ bool unit(int i, int NPN, int& j, int& pn) const {
        if (i < nfull * NPN) { j = i / NPN; pn = i % NPN; return true; }
        const int k = i - nfull * NPN, lu = c + k * G;
        if (lu < rem * NPN) { j = nfull + k; pn = lu % NPN; return true; }
        return false;
    }
};
struct Moe1Sched {
    const char* U; const char* W; const LAS int* tabE; const LAS int* tabS; MoeDeal d;
    __device__ __forceinline__ bool next(int i, gp::Unit& u) const {
        int j, pn; if (!d.unit(i, 2, j, pn)) return false;
        u.A = U; u.B = W + (size_t)tabE[j] * (512 * 1024 * 2) + (size_t)pn * (256 * 1024 * 2); u.r0 = d.tile_of(j, 2) * 256; u.c0 = pn * 256; u.aux = j; return true;
    }
    __device__ __forceinline__ void lane_off(const gp::Unit& u, unsigned (&vo)[2][2]) const {
        const int tid = opaque_tid(); int R0, C0, R1, C1; gp::stage_rc(tid * 16, R0, C0); gp::stage_rc(tid * 16 + 8192, R1, C1);
        const LAS int* t = tabS + u.aux * 256;
        vo[0][0] = (unsigned)t[R0] * 2048u + (unsigned)C0 * 2u; vo[0][1] = (unsigned)t[R1] * 2048u + (unsigned)C1 * 2u;
        vo[1][0] = (unsigned)t[128 + R0] * 2048u + (unsigned)C0 * 2u; vo[1][1] = (unsigned)t[128 + R1] * 2048u + (unsigned)C1 * 2u;
    }
};
struct EpiH {
    bf16_t* H;
    __device__ __forceinline__ void operator()(const gp::f32x4 (&acc)[2][2][4][2], const gp::Unit& u, int wr, int wc, int fr, int fq) const {
        const int row0 = u.r0 + wr * 64 + fr;
#pragma unroll
        for (int ai = 0; ai < 2; ++ai)
#pragma unroll
            for (int m = 0; m < 4; ++m) { bf16_t* rowp = H + (size_t)(row0 + ai * 128 + m * 16) * 256;
#pragma unroll
                for (int bj = 0; bj < 2; ++bj) {
                    const int j0 = ((u.c0 + bj * 128 + wc * 32) >> 5) * 16 + 4 * fq;
                    const gp::f32x4 a = acc[ai][bj][m][0], b = acc[ai][bj][m][1];
                    const float h0 = siluf_(a[0]) * b[0], h1 = siluf_(a[1]) * b[1], h2 = siluf_(a[2]) * b[2], h3 = siluf_(a[3]) * b[3];
                    *(uint2*)(rowp + j0) = make_uint2(cvt_pk_bf16(h0, h1), cvt_pk_bf16(h2, h3)); }
                __builtin_amdgcn_sched_barrier(0); }
    }
};
__device__ __forceinline__ void ph_moe1(KP p, int l, int ntok, int bid, int nb, LAS unsigned char* lds) {
    LAS int* tabE = (LAS int*)(lds + MOE_TAB);
    LAS int* tabS = tabE + 64;
    const int tid = opaque_tid();
    MoeDeal d; d.init(((const int*)(p->ws + OFF_GOFFS))[65] >> 8, bid, nb);
    const int nper = d.ntiles(2);
    const int* stok = (const int*)(p->ws + OFF_STOK); const int* tile_e = (const int*)(p->ws + OFF_TILEE);
    for (int i = tid; i < nper * 256; i += 512) tabS[i] = stok[(size_t)d.tile_of(i >> 8, 2) * 256 + (i & 255)];
    if (tid < nper) tabE[tid] = tile_e[d.tile_of(tid, 2)];
    __syncthreads();
    Moe1Sched S{(const char*)(p->ws + OFF_U), (const char*)(p->ws + OFF_W13), tabE, tabS, d};
    EpiH E{(bf16_t*)(p->ws + OFF_BIG)};
    gp::gemm_phase<true, false>(lds, 1024, S, E);
}

struct Moe2Sched {
    const char* H; const char* W; const LAS int* tabE; MoeDeal d;
    __device__ __forceinline__ bool next(int i, gp::Unit& u) const {
        int j, pn; if (!d.unit(i, 4, j, pn)) return false;
        u.A = H + (size_t)d.tile_of(j, 4) * (256 * 256 * 2); u.B = W + (size_t)tabE[j] * (1024 * 256 * 2) + (size_t)pn * (256 * 256 * 2); u.r0 = j * 256; u.c0 = pn * 256; u.aux = j; return true;
    }
    __device__ __forceinline__ void lane_off(const gp::Unit&, unsigned (&)[2][2]) const {}
};
struct EpiY {
    bf16_t* Ys; const LAS int* tabD; const LAS float* tabG;
    __device__ __forceinline__ void operator()(const gp::f32x4 (&acc)[2][2][4][2], const gp::Unit& u, int wr, int wc, int fr, int fq) const {
        const int rl0 = u.r0 + wr * 64 + fr, col0 = u.c0 + wc * 32 + 8 * fq;
#pragma unroll
        for (int ai = 0; ai < 2; ++ai)
#pragma unroll
            for (int m = 0; m < 4; ++m) {
                const int rl = rl0 + ai * 128 + m * 16;
                const int dst = tabD[rl]; const float g = tabG[rl];
                if (dst >= 0) { bf16_t* rowp = Ys + (size_t)dst * 1024 + col0;
#pragma unroll
                    for (int bj = 0; bj < 2; ++bj) { const gp::f32x4 v0 = acc[ai][bj][m][0] * g, v1 = acc[ai][bj][m][1] * g;
                        gp::u32x4 w; w.x = cvt_pk_bf16(v0[0], v0[1]); w.y = cvt_pk_bf16(v0[2], v0[3]); w.z = cvt_pk_bf16(v1[0], v1[1]); w.w = cvt_pk_bf16(v1[2], v1[3]);
                        *(gp::u32x4*)(rowp + bj * 128) = w; } }
                __builtin_amdgcn_sched_barrier(0); }
    }
};
__device__ __forceinline__ void ph_moe2(KP p, int l, int ntok, int bid, int nb, LAS unsigned char* lds) {
    LAS int* tabE = (LAS int*)(lds + MOE_TAB);
    LAS int* tabD = tabE + 64;
    LAS float* tabG = (LAS float*)(tabD + MOE_MAXT * 256);
    const int tid = opaque_tid();
    MoeDeal d; d.init(((const int*)(p->ws + OFF_GOFFS))[65] >> 8, bid, nb);
    const int nper = d.ntiles(4);
    const int* sdst = (const int*)(p->ws + OFF_SDST); const float* sgate = (const float*)(p->ws + OFF_SGATE); const int* tile_e = (const int*)(p->ws + OFF_TILEE);
    for (int i = tid; i < nper * 256; i += 512) { const size_t r = (size_t)d.tile_of(i >> 8, 4) * 256 + (i & 255); tabD[i] = sdst[r]; tabG[i] = sgate[r]; }
    if (tid < nper) tabE[tid] = tile_e[d.tile_of(tid, 4)];
    __syncthreads();
    Moe2Sched S{(const char*)(p->ws + OFF_BIG), (const char*)(p->ws + OFF_W2), tabE, d};
    EpiY E{(bf16_t*)(p->ws + OFF_YS), tabD, tabG};
    gp::gemm_phase<false, true>(lds, 256, S, E);
}

template <bool NEXT>
__device__ __forceinline__ void ph_combine_ln2(KP p, int l, int ntok, int bid, int nb) {
    bf16_t* U = (bf16_t*)(p->ws + OFF_U);
    float* G = (float*)(p->ws + OFF_G);
    const bool gates = NEXT && ((l + 1) & 1) == 0;
    LAS float* wl = (LAS float*)smraw_base();
    if (gates) stage_gate_w(p, (l + 1) >> 1, wl);
    const int tid = opaque_tid(), lane = tid & 63, wv = tid >> 6;
    const bf16_t* Ys = (const bf16_t*)(p->ws + OFF_YS);
    const float* lw = p->in[I_LNW] + (l * 2 + 1) * 1024; const float* lb = p->in[I_LNB] + (l * 2 + 1) * 1024;
    #pragma unroll 1
    for (int tok = bid * 8 + wv; tok < ntok; tok += nb * 8) {
        float* h = hrow(p, tok);
        const float* m = modrow(p, l, tok);
        const float* m2 = modrow(p, NEXT ? l + 1 : l, tok);
        float ga[16], u16[16];
#pragma unroll
        for (int j = 0; j < 16; ++j) { ga[j] = 0.f; u16[j] = 0.f; }
        float f[16];
#pragma unroll
        for (int i = 0; i < 16; ++i) f[i] = 0.f;
#pragma unroll
        for (int s = 0; s < 9; ++s)
#pragma unroll
            for (int c = 0; c < 2; ++c) {
                const uint4 w = *(const uint4*)(Ys + ((size_t)tok * 9 + s) * 1024 + 8 * (lane + 64 * c));
                f[8 * c + 0] += bflo(w.x); f[8 * c + 1] += bfhi(w.x); f[8 * c + 2] += bflo(w.y); f[8 * c + 3] += bfhi(w.y);
                f[8 * c + 4] += bflo(w.z); f[8 * c + 5] += bfhi(w.z); f[8 * c + 6] += bflo(w.w); f[8 * c + 7] += bfhi(w.w);
            }
        float x[16]; float sum = 0.f;
#pragma unroll
        for (int c = 0; c < 2; ++c)
#pragma unroll
            for (int q = 0; q < 2; ++q) {
                const int d = 8 * (lane + 64 * c) + 4 * q;
                const float4 hv = *(const float4*)(h + d), gv = *(const float4*)(m + 5 * 1024 + d);
                x[8 * c + 4 * q + 0] = ALPHA * hv.x + gv.x * f[8 * c + 4 * q + 0]; x[8 * c + 4 * q + 1] = ALPHA * hv.y + gv.y * f[8 * c + 4 * q + 1];
                x[8 * c + 4 * q + 2] = ALPHA * hv.z + gv.z * f[8 * c + 4 * q + 2]; x[8 * c + 4 * q + 3] = ALPHA * hv.w + gv.w * f[8 * c + 4 * q + 3];
                sum += x[8 * c + 4 * q] + x[8 * c + 4 * q + 1] + x[8 * c + 4 * q + 2] + x[8 * c + 4 * q + 3];
            }
        const float mean = wave_sum(sum) * (1.f / 1024.f);
        float q2 = 0.f;
#pragma unroll
        for (int i = 0; i < 16; ++i) { x[i] -= mean; q2 += x[i] * x[i]; }
        const float rs = rsqrtf(wave_sum(q2) * (1.f / 1024.f) + LN_EPS);
#pragma unroll
        for (int c = 0; c < 2; ++c)
#pragma unroll
            for (int q = 0; q < 2; ++q) {
                const int d = 8 * (lane + 64 * c) + 4 * q;
                const float4 w4 = *(const float4*)(lw + d), b4 = *(const float4*)(lb + d);
                float4 y; y.x = x[8 * c + 4 * q] * rs * w4.x + b4.x; y.y = x[8 * c + 4 * q + 1] * rs * w4.y + b4.y; y.z = x[8 * c + 4 * q + 2] * rs * w4.z + b4.z; y.w = x[8 * c + 4 * q + 3] * rs * w4.w + b4.w;
                *(float4*)(h + d) = y;
                if (NEXT) {
                    const float4 sh = *(const float4*)(m2 + d), sc = *(const float4*)(m2 + 1024 + d);
                    const float uu[4] = {y.x * (1.f + sc.x) + sh.x, y.y * (1.f + sc.y) + sh.y, y.z * (1.f + sc.z) + sh.z, y.w * (1.f + sc.w) + sh.w};
                    *(uint2*)(U + (size_t)tok * DM + d) = make_uint2(cvt_pk_bf16(uu[0], uu[1]), cvt_pk_bf16(uu[2], uu[3]));
                    u16[8 * c + 4 * q] = uu[0]; u16[8 * c + 4 * q + 1] = uu[1]; u16[8 * c + 4 * q + 2] = uu[2]; u16[8 * c + 4 * q + 3] = uu[3];
                }
            }
        if (gates) {
#pragma unroll
            for (int g4 = 0; g4 < 4; ++g4) {
                const int d = 8 * (lane + 64 * (g4 >> 1)) + 4 * (g4 & 1);
#pragma unroll
                for (int qq = 0; qq < 4; ++qq) {
#pragma unroll
                    for (int j4 = 0; j4 < 4; ++j4) { const f32x4_l w = *(const LAS f32x4_l*)(wl + (d + qq) * 16 + j4 * 4); const float uv = u16[4 * g4 + qq]; ga[4 * j4] += uv * w[0]; ga[4 * j4 + 1] += uv * w[1]; ga[4 * j4 + 2] += uv * w[2]; ga[4 * j4 + 3] += uv * w[3]; }
                }
                __builtin_amdgcn_sched_barrier(0);
            }
            float mine = 0.f;
#pragma unroll
            for (int j = 0; j < 16; ++j) { const float sg = wave_sum(ga[j]); if (lane == j) mine = sg; }
            if (lane < 16) G[(size_t)tok * 16 + lane] = mine;
        }
    }
}

#define MEGA_LDS (131072 + 256 + 20480)
#define NBLK 256
#define BAR_LDS BAR_LDS_
#define SYNC() do { XcdBarrier _b; _b.bar = (unsigned*)kparams()->ws; _b.x = xb_xcc_id(); _b.st = (volatile LAS unsigned*)((LAS unsigned char*)smraw_base() + BAR_LDS); xcd_barrier(_b); } while (0)
template <int PAR>
__device__ __forceinline__ void layer_fwd(const int l) {
    LAS unsigned char* lds = smraw_base(); float* sm = (float*)smraw_generic();
    const int bid = blockIdx.x; constexpr int nb = NBLK;
    const int ntok = (l == 3) ? NL : NT;
    ph_gemm_in(kparams(), l, bid, nb, lds); SYNC();
    if (PAR == 0) {
        ph_scan_even2(kparams(), l, bid, nb); SYNC();
        ph_normgate_even(kparams(), l, bid, nb); SYNC();
    } else {
        ph_hy_prep(kparams(), l, bid, nb, sm); SYNC();
        ph_mix_odd(kparams(), l, bid, nb, sm); SYNC();
        ph_hy_norm(kparams(), l, bid, nb, sm); ph_normgate_odd(kparams(), l, bid, nb); SYNC();
    }
    ph_gemm_out(kparams(), l, bid, nb, lds); SYNC();
    ph_ln1_router(kparams(), l, ntok, bid, nb, sm); SYNC();
    ph_scatter(kparams(), l, ntok, bid, nb, lds); SYNC();
    ph_moe1(kparams(), l, ntok, bid, nb, lds); SYNC();
    ph_moe2(kparams(), l, ntok, bid, nb, lds); SYNC();
    if (l < 3) { ph_combine_ln2<true>(kparams(), l, ntok, bid, nb); ph_convert(kparams(), l + 1, bid, nb, sm); SYNC(); }
    else ph_combine_ln2<false>(kparams(), l, ntok, bid, nb);
}
__global__ void __launch_bounds__(512, 2) mega_fwd(Params p) {
    LAS unsigned char* lds = smraw_base(); float* sm = (float*)smraw_generic();
    {
        const int t0 = threadIdx.x;
        if ((t0 & 63) == 0) { unsigned h; asm volatile("s_getreg_b32 %0, hwreg(HW_REG_HW_ID, 0, 6)" : "=s"(h)); *(LAS int*)(size_t)(WTAB_LDS + (h & 63u) * 4u) = t0 >> 6; }
        if (t0 < 4) ((LAS unsigned*)(lds + BAR_LDS))[t0] = 0u;
    }
    __syncthreads();
    (void)xcd_barrier_post((unsigned*)kparams()->ws, (volatile LAS unsigned*)(lds + BAR_LDS));
    const int bid = blockIdx.x; constexpr int nb = NBLK;
    ph_prologue(kparams(), bid, nb, sm);
    __syncthreads();
    ph_hy_filt2(kparams(), 1, bid, nb, sm, 48); __syncthreads(); ph_hy_filt2(kparams(), 3, bid, nb, sm, 48);
    SYNC();
    ph_convert(kparams(), 0, bid, nb, sm); ph_modin(kparams(), 0, bid, nb); SYNC();
#pragma unroll 1
    for (int lp = 0; lp < 2; ++lp) {
        layer_fwd<0>(2 * lp);
        layer_fwd<1>(2 * lp + 1);
    }
    __syncthreads();
    if (blockIdx.x == 0 && opaque_tid() == 0 && xb_ld((unsigned*)kparams()->ws + XB_TMO) != 0u) kparams()->out[0] = __builtin_nanf("");
}

extern "C" void kernel_launch(void* const* d_in, const int* in_sizes, int n_in, void* d_out, int out_size, void* d_ws, size_t ws_size, hipStream_t stream) {
    static int grid = 0;
    if (grid == 0) {
        if (n_in != 38 || out_size != NL * DM || ws_size < WS_END) { fprintf(stderr, "kernel_launch: bad shapes n_in %d out %d ws %zu (need %zu)\n", n_in, out_size, ws_size, (size_t)WS_END); grid = -1; return; }
        int dev = 0, cus = 0, per_cu = 0;
        if (hipGetDevice(&dev) != hipSuccess || hipDeviceGetAttribute(&cus, hipDeviceAttributeMultiprocessorCount, dev) != hipSuccess) { grid = -1; return; }
        if (hipFuncSetAttribute((const void*)mega_fwd, hipFuncAttributeMaxDynamicSharedMemorySize, MEGA_LDS) != hipSuccess) { fprintf(stderr, "kernel_launch: hipFuncSetAttribute failed\n"); grid = -1; return; }
        if (hipOccupancyMaxActiveBlocksPerMultiprocessor(&per_cu, (const void*)mega_fwd, 512, MEGA_LDS) != hipSuccess || per_cu < 1) { fprintf(stderr, "kernel_launch: occupancy query says %d\n", per_cu); (void)hipGetLastError(); grid = -1; return; }
        if (cus != 256) { fprintf(stderr, "kernel_launch: built for 256 CUs, found %d\n", cus); grid = -1; return; }
        grid = NBLK;
    }
    if (grid < 0) return;
    if (hipMemsetAsync(d_ws, 0, OFF_LB, stream) != hipSuccess) return;
    Params p{};
    for (int i = 0; i < 38; ++i) p.in[i] = (const float*)d_in[i];
    p.out = (float*)d_out; p.ws = (unsigned char*)d_ws;
    hipLaunchKernelGGL(mega_fwd, dim3(grid), dim3(512), MEGA_LDS, stream, p);
}
```

```cpp
#include <hip/hip_runtime.h>
#include <stdint.h>
#include <stdio.h>

#define DM 1024
#define NBATCH 8
#define SEQ 4096
#define CTXL 256
#define NL (NBATCH * SEQ)
#define NC (NBATCH * CTXL)
#define NT (NL + NC)
#define ZROW NT
#define TOPK 8
#define EVEN_N 4112
#define ODD_N 3584
#define EVEN_LD 4096
#define ODD_LD 3584
#define MAXROWS (NT * 8 + 64 * 256 + NT)
#define ALPHA 1.681792830507429f
#define LN_EPS 1e-5f
#define E_MQ 0
#define E_MK 256
#define E_MV 512
#define E_MO 1024
#define E_HQ 1536
#define E_HI 2048
#define E_HFF 2560
#define E_HFB 3072
#define E_HG 3584

typedef unsigned short bf16_t;
#define LAS __attribute__((address_space(3)))
#define BAR_LDS_ 150528

#define MiB ((size_t)1 << 20)
#define OFF_CNT   ((size_t)64 << 10)
#define OFF_LB    ((size_t)96 << 10)
#define OFF_MOD   ((size_t)128 << 10)
#define OFF_ROPE  ((size_t)1536 << 10)
#define OFF_BCNT  ((size_t)1600 << 10)
#define OFF_GOFFS ((size_t)1700 << 10)
#define OFF_RWH   ((size_t)2560 << 10)
#define OFF_TILEE (2 * MiB)
#define OFF_HCTX  (4 * MiB)
#define OFF_TIDX  (12 * MiB)
#define OFF_TGATE (14 * MiB)
#define OFF_TPOS  (16 * MiB)
#define OFF_STOK  (18 * MiB)
#define OFF_SGATE (20 * MiB)
#define OFF_SDST  (22 * MiB)
#define OFF_G     (24 * MiB)
#define OFF_U     (28 * MiB)
#define OFF_W     (98 * MiB)
#define OFF_WIN   (OFF_W)
#define OFF_WOUT  (OFF_W + 8 * MiB)
#define OFF_W13   (OFF_W + 10 * MiB)
#define OFF_W2    (OFF_W + 75 * MiB)
#define OFF_BIG   (208 * MiB)
#define OFF_AUX   (480 * MiB)
#define OFF_Z1    (OFF_AUX + 136 * MiB)
#define OFF_Z2    (OFF_Z1 + 68 * MiB)
#define OFF_FILT  (OFF_Z2 + 68 * MiB)
#define OFF_YS    (370 * MiB)
#define WS_END    (1052 * MiB)

struct Params {
    const float* in[38];
    float* out;
    unsigned char* ws;
};

enum { I_X = 0, I_C, I_CTX, I_CCTX, I_ADAW, I_ADAB, I_LNW, I_LNB, I_EWIN, I_MGB, I_MNW, I_HLB, I_HNW, I_EWOUT, I_OWIN, I_HCW, I_HCB,
       I_HW1, I_HB1, I_HW2, I_HB2, I_HW3, I_HB3, I_HFREQ, I_HWOUT, I_HSKIP, I_HNORM, I_RLD, I_RNW, I_OWOUT, I_RW, I_RB, I_W1, I_W3, I_W2, I_SW1, I_SW3, I_SW2 };

typedef const __attribute__((address_space(4))) Params* KP;
__device__ __forceinline__ KP kparams() { KP k = (KP)__builtin_amdgcn_kernarg_segment_ptr(); asm volatile("" : "+s"(k)); return k; }
extern __shared__ __attribute__((aligned(16))) unsigned char smraw_all[];
__device__ __forceinline__ LAS unsigned char* smraw_base() { return (LAS unsigned char*)smraw_all; }
__device__ __forceinline__ unsigned char* smraw_generic() { return smraw_all; }
#define WTAB_LDS (BAR_LDS_ + 512)
__device__ __forceinline__ int opaque_tid() {
    unsigned h; asm volatile("s_getreg_b32 %0, hwreg(HW_REG_HW_ID, 0, 6)" : "=s"(h));
    const int wid = *(volatile LAS int*)(size_t)(WTAB_LDS + (h & 63u) * 4u);
    unsigned m = ~0u; asm volatile("" : "+s"(m));
    const int lane = (int)__builtin_amdgcn_mbcnt_hi(m, __builtin_amdgcn_mbcnt_lo(m, 0u));
    return __builtin_amdgcn_readfirstlane(wid) * 64 + lane;
}
typedef __bf16 bf16x2_n __attribute__((ext_vector_type(2)));
typedef float f32x2_n __attribute__((ext_vector_type(2)));
__device__ __forceinline__ unsigned cvt_pk_bf16(float lo, float hi) { const f32x2_n v = {lo, hi}; return __builtin_bit_cast(unsigned, __builtin_convertvector(v, bf16x2_n)); }
__device__ __forceinline__ float bf2f(bf16_t b) { return __uint_as_float(((unsigned)b) << 16); }
__device__ __forceinline__ float bflo(unsigned w) { return __uint_as_float(w << 16); }
__device__ __forceinline__ float bfhi(unsigned w) { return __uint_as_float(w & 0xffff0000u); }
__device__ __forceinline__ float ldf(const float* p) { return *p; }
__device__ __forceinline__ float ldf(const bf16_t* p) { return bf2f(*p); }
__device__ __forceinline__ void stf(float* p, float v) { *p = v; }
__device__ __forceinline__ void stf(bf16_t* p, float v) { *p = (bf16_t)(cvt_pk_bf16(v, 0.f) & 0xffffu); }
__device__ __forceinline__ float sigmoidf_(float x) { return 1.f / (1.f + expf(-x)); }
__device__ __forceinline__ float siluf_(float x) { return x / (1.f + expf(-x)); }
__device__ __forceinline__ int olane() { unsigned m = ~0u; asm volatile("" : "+s"(m)); return (int)__builtin_amdgcn_mbcnt_hi(m, __builtin_amdgcn_mbcnt_lo(m, 0u)); }
template <class T> __device__ __forceinline__ T shfl_idx(T v, int idx) { return __builtin_bit_cast(T, __builtin_amdgcn_ds_bpermute(idx << 2, __builtin_bit_cast(int, v))); }
#define SHX(v, o) shfl_idx(v, olane() ^ (o))
#define SHI(v, i) shfl_idx(v, (i))
#define SHI32(v, i) shfl_idx(v, (olane() & 32) | ((i) & 31))
#define SHU(v, o) shfl_idx(v, olane() - (o))
__device__ __forceinline__ float fexp(float x) { return __builtin_amdgcn_exp2f(x * 1.4426950408889634f); }
__device__ __forceinline__ float flog(float x) { return __builtin_amdgcn_logf(x) * 0.6931471805599453f; }
__device__ __forceinline__ float frcp(float x) { return __builtin_amdgcn_rcpf(x); }
__device__ __forceinline__ float fsigmoid(float x) { return frcp(1.f + fexp(-x)); }
__device__ __forceinline__ float fsilu(float x) { return x * frcp(1.f + fexp(-x)); }
__device__ __forceinline__ float wave_sum(float v) {
#pragma unroll
    for (int o = 32; o > 0; o >>= 1) v += SHX(v, o);
    return v;
}
__device__ __forceinline__ float* hrow(KP p, int tok) {
    return tok < NL ? p->out + (size_t)tok * DM : (float*)(p->ws + OFF_HCTX) + (size_t)(tok - NL) * DM;
}
__device__ __forceinline__ const float* modrow(KP p, int l, int tok) {
    const int r = tok < NL ? (tok >> 12) : 8;
    return (const float*)(p->ws + OFF_MOD) + ((size_t)l * 9 + r) * 6144;
}
__device__ __forceinline__ int scan_tok(int b, int i, int dir) {
    return i < CTXL ? NL + b * CTXL + (dir ? CTXL - 1 - i : i) : b * SEQ + (dir ? SEQ - 1 - (i - CTXL) : (i - CTXL));
}

#define XB_TMO      128
#define XB_XCNT(j)  (256  + 64 * (j))
#define XB_XSUB(j)  (1280 + 64 * (j))
#define XB_XGEN(j)  (2304 + 64 * (j))
#define XB_TOP      3328
#define XB_TOPGEN   3392
#define XCD_BAR_WORDS 3456
#define XB_SPIN_CAP (1u << 24)
__device__ __forceinline__ unsigned xb_ld(unsigned* p)              { return __hip_atomic_load(p, __ATOMIC_RELAXED, __HIP_MEMORY_SCOPE_AGENT); }
__device__ __forceinline__ unsigned xb_add(unsigned* p, unsigned v) { return __hip_atomic_fetch_add(p, v, __ATOMIC_RELAXED, __HIP_MEMORY_SCOPE_AGENT); }
__device__ __forceinline__ unsigned xb_xcc_id() { return (unsigned)__builtin_amdgcn_s_getreg((3 << 11) | 20) & 0xFu; }
#define XB_SPIN(cond, bar) do { unsigned _sp = 0; while (cond) { __builtin_amdgcn_s_sleep(1); \
    if ((++_sp & 255u) == 0u) { if (xb_ld(&(bar)[XB_TMO])) break; if (_sp > XB_SPIN_CAP) { atomicAdd(&(bar)[XB_TMO], 1u); break; } } } } while (0)
struct XcdBarrier { unsigned* bar; unsigned x; volatile LAS unsigned* st; };
__device__ __forceinline__ XcdBarrier xcd_barrier_post(unsigned* bar, volatile LAS unsigned* st) {
    XcdBarrier b; b.bar = bar; b.x = xb_xcc_id(); b.st = st;
    if (opaque_tid() == 0) (void)xb_add(&bar[XB_XCNT(b.x)], 1u);
    return b;
}
__device__ __forceinline__ void xcd_barrier_complete(unsigned* bar, unsigned x, unsigned& nloc, unsigned& nx) {
    const unsigned G = gridDim.x * gridDim.y * gridDim.z;
    unsigned sum, cnt, mine, sp = 0u;
    for (;;) {
        sum = 0u; cnt = 0u; mine = 0u;
#pragma unroll
        for (unsigned j = 0; j < 16; ++j) { const unsigned c = xb_ld(&bar[XB_XCNT(j)]); sum += c; cnt += (c > 0u) ? 1u : 0u; mine = (j == x) ? c : mine; }
        if (sum == G) break;
        __builtin_amdgcn_s_sleep(1);
        if ((++sp & 255u) == 0u) { if (xb_ld(&bar[XB_TMO])) break; if (sp > XB_SPIN_CAP) { atomicAdd(&bar[XB_TMO], 1u); break; } }
    }
    nloc = mine > 0u ? mine : 1u; nx = cnt > 0u ? cnt : 1u;
}
__device__ __forceinline__ void xcd_barrier(const XcdBarrier& b) {
    asm volatile("s_waitcnt vmcnt(0)" ::: "memory");
    __syncthreads();
    if (opaque_tid() == 0) {
        unsigned* bar = b.bar;
        __builtin_amdgcn_s_waitcnt(0);
        unsigned nloc = b.st[0], nx = b.st[1];
        if (nloc == 0u) { xcd_barrier_complete(bar, b.x, nloc, nx); b.st[0] = nloc; b.st[1] = nx; }
        const unsigned old = xb_add(&bar[XB_XSUB(b.x)], 1u);
        const unsigned gen = old / nloc;
        if (old + 1u == (gen + 1u) * nloc) {
            __builtin_amdgcn_fence(__ATOMIC_RELEASE, "agent");
            asm volatile("s_waitcnt vmcnt(0)" ::: "memory");
            const unsigned og = xb_add(&bar[XB_TOP], 1u);
            const unsigned tg = og / nx;
            if (og + 1u == (tg + 1u) * nx) xb_add(&bar[XB_TOPGEN], 1u);
            else XB_SPIN(xb_ld(&bar[XB_TOPGEN]) == tg, bar);
            __builtin_amdgcn_fence(__ATOMIC_ACQUIRE, "agent");
            xb_add(&bar[XB_XGEN(b.x)], 1u);
            asm volatile("s_waitcnt vmcnt(0)" ::: "memory");
        } else {
            XB_SPIN(xb_ld(&bar[XB_XGEN(b.x)]) == gen, bar);
            __builtin_amdgcn_fence(__ATOMIC_ACQUIRE, "agent");
            asm volatile("s_waitcnt vmcnt(0)" ::: "memory");
        }
    }
    __syncthreads();
}

__device__ __forceinline__ void ph_prologue(KP p, int bid, int nb, float* sm) {
    const int tid = opaque_tid();
    {
        const float4* x4 = (const float4*)p->in[I_X]; float4* o4 = (float4*)p->out;
        #pragma unroll 1
        for (size_t i = (size_t)bid * 512 + tid; i < (size_t)NL * 256; i += (size_t)nb * 512) o4[i] = x4[i];
        const float4* c4 = (const float4*)p->in[I_CTX]; float4* h4 = (float4*)(p->ws + OFF_HCTX);
        #pragma unroll 1
        for (size_t i = (size_t)bid * 512 + tid; i < (size_t)NC * 256; i += (size_t)nb * 512) h4[i] = c4[i];
    }
    if (bid == 0) {
        bf16_t* z = (bf16_t*)(p->ws + OFF_U) + (size_t)ZROW * DM;
        for (int i = tid; i < DM; i += 512) z[i] = 0;
    }
    if (bid == 1 % nb) {
        float* lb = (float*)(p->ws + OFF_LB);
        const float* hl = p->in[I_HLB];
        for (int j = tid; j < 512; j += 512) {
            const float a = hl[j], b = hl[512 + j], mx = fmaxf(a, b);
            const float ea = expf(a - mx), eb = expf(b - mx);
            lb[j] = 0.f; lb[512 + j] = eb / (ea + eb);
        }
    }
    if (bid == 2 % nb) {
        float2* rt = (float2*)(p->ws + OFF_ROPE);
        for (int i = tid; i < 64 * 32; i += 512) { const float ang = (float)(i >> 5) * powf(10000.f, -(float)(2 * (i & 31)) / 64.f); rt[i] = make_float2(cosf(ang), sinf(ang)); }
    }
    {
        float* act = sm;
        bool filled = false;
        #pragma unroll 1
        for (int item = bid; item < 48; item += nb) {
            if (!filled) {
                for (int i = tid; i < 9 * 1024; i += 512) {
                    const int r = i >> 10, k = i & 1023;
                    const float v = r < 8 ? p->in[I_C][r * 1024 + k] : p->in[I_CCTX][k];
                    act[i] = siluf_(v);
                }
                __syncthreads(); filled = true;
            }
            const int l = item / 12, j = (item % 12) * 512 + tid;
            const float* w = p->in[I_ADAW] + (size_t)l * 1024 * 6144 + j;
            float acc[9];
#pragma unroll
            for (int r = 0; r < 9; ++r) acc[r] = 0.f;
            for (int k = 0; k < 1024; ++k) {
                const float wv = w[(size_t)k * 6144];
#pragma unroll
                for (int r = 0; r < 9; ++r) acc[r] += act[r * 1024 + k] * wv;
            }
            const float bv = p->in[I_ADAB][l * 6144 + j];
            float* mod = (float*)(p->ws + OFF_MOD);
#pragma unroll
            for (int r = 0; r < 9; ++r) mod[((size_t)l * 9 + r) * 6144 + j] = acc[r] + bv;
        }
    }
}


struct CvtTile { const float* src; int srcld; bf16_t* dst; int dstld; int k0, n0; };
__device__ __forceinline__ CvtTile cvt_tile_of(KP p, int l, int t, int np4  ) {
    const bool even = (l & 1) == 0;
    const int NP = even ? EVEN_LD : ODD_LD;
    const int t_in = 16 * (NP / 128), t_out = 16 * 8, t_13 = 65 * 16 * 4;
    CvtTile c;
    if (t < t_in) {
        const int kt = t & 15, nt = t >> 4, n = nt * 128 + np4;
        const float* W = even ? p->in[I_EWIN] + (size_t)(l >> 1) * 1024 * EVEN_N : p->in[I_OWIN] + (size_t)(l >> 1) * 1024 * ODD_N;
        c.src = W + ((even && n >= 1536) ? n + 16 : n); c.srcld = even ? EVEN_N : ODD_N; c.dst = (bf16_t*)(p->ws + OFF_WIN); c.dstld = 1024; c.k0 = kt * 64; c.n0 = nt * 128;
    } else if (t < t_in + t_out) {
        const int u = t - t_in, kt = u & 15, nt = u >> 4;
        c.src = (even ? p->in[I_EWOUT] : p->in[I_OWOUT]) + (size_t)(l >> 1) * 1024 * 1024 + nt * 128 + np4; c.srcld = 1024; c.dst = (bf16_t*)(p->ws + OFF_WOUT); c.dstld = 1024; c.k0 = kt * 64; c.n0 = nt * 128;
    } else if (t < t_in + t_out + t_13) {
        const int u = t - t_in - t_out, e = u >> 6, kt = u & 15, nt = (u >> 4) & 3, n = nt * 128 + np4, g = n >> 5, w = n & 31;
        const float* w1 = e < 64 ? p->in[I_W1] + ((size_t)l * 64 + e) * 1024 * 256 : p->in[I_SW1] + (size_t)l * 1024 * 256;
        const float* w3 = e < 64 ? p->in[I_W3] + ((size_t)l * 64 + e) * 1024 * 256 : p->in[I_SW3] + (size_t)l * 1024 * 256;
        c.src = w < 16 ? w1 + 16 * g + w : w3 + 16 * g + w - 16; c.srcld = 256; c.dst = (bf16_t*)(p->ws + OFF_W13) + (size_t)e * 512 * 1024; c.dstld = 1024; c.k0 = kt * 64; c.n0 = nt * 128;
    } else {
        const int u = t - t_in - t_out - t_13, e = u >> 5, kt = u & 3, nt = (u >> 2) & 7;
        const float* w2 = e < 64 ? p->in[I_W2] + ((size_t)l * 64 + e) * 256 * 1024 : p->in[I_SW2] + (size_t)l * 256 * 1024;
        c.src = w2 + nt * 128 + np4; c.srcld = 1024; c.dst = (bf16_t*)(p->ws + OFF_W2) + (size_t)e * 1024 * 256; c.dstld = 256; c.k0 = kt * 64; c.n0 = nt * 128;
    }
    return c;
}
__device__ __forceinline__ void ph_convert(KP p, int l, int bid, int nb, float* sm) {
    const int tid = opaque_tid();
    const int NP = ((l & 1) == 0) ? EVEN_LD : ODD_LD;
    const int total = 16 * (NP / 128) + 16 * 8 + 65 * 16 * 4 + 65 * 4 * 8;
    const int kr = tid >> 5, np4 = (tid & 31) * 4;
    float4 v[4];
    int t = bid;
    CvtTile c = cvt_tile_of(p, l, t < total ? t : 0, np4);
    if (t < total) {
#pragma unroll
        for (int j = 0; j < 4; ++j) v[j] = *(const float4*)(c.src + (size_t)(c.k0 + kr + 16 * j) * c.srcld);
    }
#pragma unroll 1
    for (; t < total; t += nb) {
        __syncthreads();
#pragma unroll
        for (int j = 0; j < 4; ++j) { float* d = sm + (np4) * 65 + kr + 16 * j; d[0] = v[j].x; d[65] = v[j].y; d[130] = v[j].z; d[195] = v[j].w; }
        const CvtTile cur = c;
        const int tn = t + nb;
        if (tn < total) {
            c = cvt_tile_of(p, l, tn, np4);
#pragma unroll
            for (int j = 0; j < 4; ++j) v[j] = *(const float4*)(c.src + (size_t)(c.k0 + kr + 16 * j) * c.srcld);
        }
        __syncthreads();
        const int n = tid >> 2, kc = (tid & 3) * 16;
        unsigned w[8];
#pragma unroll
        for (int q = 0; q < 8; ++q) w[q] = cvt_pk_bf16(sm[n * 65 + kc + 2 * q], sm[n * 65 + kc + 2 * q + 1]);
        uint4* d4 = (uint4*)(cur.dst + (size_t)(cur.n0 + n) * cur.dstld + cur.k0 + kc);
        d4[0] = make_uint4(w[0], w[1], w[2], w[3]); d4[1] = make_uint4(w[4], w[5], w[6], w[7]);
    }
    __syncthreads();
    if (bid < 8) {
        const float* rw = p->in[I_RW] + (size_t)l * 1024 * 64;
        bf16_t* hi = (bf16_t*)(p->ws + OFF_RWH); bf16_t* lo = hi + 64 * 1024;
        const int e = tid & 63, kb = bid * 128 + (tid >> 6) * 16;
#pragma unroll
        for (int i = 0; i < 16; i += 2) {
            const float x0 = rw[(size_t)(kb + i) * 64 + e], x1 = rw[(size_t)(kb + i + 1) * 64 + e];
            const unsigned h = cvt_pk_bf16(x0, x1);
            const unsigned lw = cvt_pk_bf16(x0 - bflo(h), x1 - bfhi(h));
            *(unsigned*)(hi + (size_t)e * 1024 + kb + i) = h; *(unsigned*)(lo + (size_t)e * 1024 + kb + i) = lw;
        }
    }
}

namespace gp {
typedef short bf16x8 __attribute__((ext_vector_type(8)));
typedef float f32x4 __attribute__((ext_vector_type(4)));
typedef unsigned u32x4 __attribute__((ext_vector_type(4)));
typedef unsigned u32x2 __attribute__((ext_vector_type(2)));
constexpr int BM = 256, BK = 64, HALF = 128, HTB = HALF * BK * 2, STAGE_BYTES = 8 * HTB, NXCD = 8, WGM = 8;
__device__ __forceinline__ int lds_byte(int r, int c) { const int st = (r >> 4) * 2 + (c >> 5), rr = r & 15, cc = c & 31, ob = rr * 64 + cc * 2; return st * 1024 + (ob ^ (((ob >> 9) & 1) << 5)); }
__device__ __forceinline__ void stage_rc(int b, int& R, int& C) { const int st = b / 1024, sb = b % 1024, swz = sb ^ (((sb >> 9) & 1) << 5); R = (st >> 1) * 16 + swz / 64; C = (st & 1) * 32 + (swz % 64) / 2; }
__device__ __forceinline__ int perm32(int rho) { const int n = rho >> 4, i = rho & 15; return 8 * (i >> 2) + 4 * n + (i & 3); }

struct Unit { const char* A; const char* B; int r0, c0, aux; };

struct DenseSched {
    const char* A; const char* B; int nM, nN, nwg, G, c; size_t tstep;
    __device__ __forceinline__ void init(const void* A_, const void* B_, int M, int N, int K, int G_, int c_) { A = (const char*)A_; B = (const char*)B_; nM = M / BM; nN = N / BM; nwg = nM * nN; G = G_; c = c_; tstep = (size_t)BM * K * 2; }
    __device__ __forceinline__ bool next(int i, Unit& u) const {
        const long L = (long)i * G + c; if (L >= nwg) return false;
        int wgid = (int)L; { const int q = nwg / NXCD, r = nwg % NXCD, xcd = wgid % NXCD, off = wgid / NXCD; wgid = (xcd < r ? xcd * (q + 1) : r * (q + 1) + (xcd - r) * q) + off; }
        const int nig = WGM * nN, gid = wgid / nig, fm = gid * WGM, gsz = (nM - fm) < WGM ? (nM - fm) : WGM;
        const int pm = fm + ((wgid % nig) % gsz), pn = (wgid % nig) / gsz;
        u.A = A + (size_t)pm * tstep; u.B = B + (size_t)pn * tstep; u.r0 = pm * BM; u.c0 = pn * BM; u.aux = 0; return true;
    }
    __device__ __forceinline__ void lane_off(const Unit&, unsigned (&)[2][2]) const {}
};

template <bool GATHER, bool PERM, class Sched, class Epi>
__device__ __forceinline__ void gemm_phase(LAS unsigned char* lds, const int K_, const Sched& S, const Epi& E) {
    int K = K_; asm volatile("" : "+s"(K));
    const int tid = opaque_tid(), wid = __builtin_amdgcn_readfirstlane(tid >> 6), lane = tid & 63, wr = wid >> 2, wc = wid & 3, fr = lane & 15, fq = lane >> 4;
    const int nt = K / BK;
    unsigned voffA[2], voffB[2];
#pragma unroll
    for (int i = 0; i < 2; ++i) { int R, C; stage_rc(tid * 16 + i * 8192, R, C); const int Rb = PERM ? ((R & ~31) + perm32(R & 31)) : R;
        voffA[i] = (unsigned)(R * K + C) * 2u; voffB[i] = (unsigned)(Rb * K + C) * 2u; }
    const size_t kstep = (size_t)(BK * 2);
    const size_t hstep = (size_t)HALF * K * 2;
    const unsigned ldsw = (unsigned)wid * 1024u;
    const int aoff = lds_byte(wr * 64 + fr, fq * 8), boff = lds_byte(wc * 32 + fr, fq * 8);
    unsigned cvo[2][2] = {{0u, 0u}, {0u, 0u}}, nvo[2][2] = {{0u, 0u}, {0u, 0u}};
#define GP_SA(b, h) (((b) * 2 + (h)) * HTB)
#define GP_SB(b, h) ((4 + (b) * 2 + (h)) * HTB)
#define GP_GLDS(gp_, lp_) __builtin_amdgcn_global_load_lds((const unsigned*)(gp_), (LAS unsigned*)(lp_), 16, 0, 0)
#define GP_STAGE_B(bufoff, gbase, h) do { const char* _g = (gbase) + (size_t)(h) * hstep; \
        GP_GLDS(_g + voffB[0], lds + (bufoff) + ldsw); GP_GLDS(_g + voffB[1], lds + (bufoff) + ldsw + 8192); } while (0)
#define GP_STAGE_A(bufoff, gbase, h, usenext) do { \
        if (GATHER) { const unsigned _o0 = (usenext) ? nvo[h][0] : cvo[h][0], _o1 = (usenext) ? nvo[h][1] : cvo[h][1]; \
            GP_GLDS((gbase) + _o0, lds + (bufoff) + ldsw); GP_GLDS((gbase) + _o1, lds + (bufoff) + ldsw + 8192); } \
        else { const char* _g = (gbase) + (size_t)(h) * hstep; GP_GLDS(_g + voffA[0], lds + (bufoff) + ldsw); GP_GLDS(_g + voffA[1], lds + (bufoff) + ldsw + 8192); } } while (0)
#define GP_LDA(dst, b, h) do { _Pragma("unroll") for (int m = 0; m < 4; ++m) _Pragma("unroll") for (int k = 0; k < 2; ++k) dst[m][k] = *(const LAS bf16x8*)(lds + GP_SA(b, h) + aoff + m * 2048 + k * 1024); } while (0)
#define GP_LDB(dst, b, h) do { _Pragma("unroll") for (int n = 0; n < 2; ++n) _Pragma("unroll") for (int k = 0; k < 2; ++k) dst[n][k] = *(const LAS bf16x8*)(lds + GP_SB(b, h) + boff + n * 2048 + k * 1024); } while (0)
#define GP_MMA(ai, bj, At, Bt) do { __builtin_amdgcn_s_setprio(1); _Pragma("unroll") for (int m = 0; m < 4; ++m) _Pragma("unroll") for (int n = 0; n < 2; ++n) _Pragma("unroll") for (int k = 0; k < 2; ++k) \
        acc[ai][bj][m][n] = __builtin_amdgcn_mfma_f32_16x16x32_bf16(Bt[n][k], At[m][k], acc[ai][bj][m][n], 0, 0, 0); __builtin_amdgcn_s_setprio(0); } while (0)
#define GP_WAIT_V(n) asm volatile("s_waitcnt vmcnt(" #n ")" ::: "memory")
#define GP_WAIT_L(n) asm volatile("s_waitcnt lgkmcnt(" #n ")" ::: "memory")
#define GP_BAR __builtin_amdgcn_s_barrier()
#define GP_SCHED __builtin_amdgcn_sched_barrier(0)
    Unit cur, nxt; int ui = 0;
    if (!S.next(0, cur)) return;
    f32x4 acc[2][2][4][2];
#pragma unroll
    for (int a = 0; a < 2; ++a)
#pragma unroll
        for (int b = 0; b < 2; ++b)
#pragma unroll
            for (int m = 0; m < 4; ++m)
#pragma unroll
                for (int n = 0; n < 2; ++n) acc[a][b][m][n] = (f32x4){0.f, 0.f, 0.f, 0.f};
    bf16x8 At[4][2], B0[2][2], B1[2][2];
    if (GATHER) S.lane_off(cur, cvo);
    const char* cA = cur.A; const char* cB = cur.B;
    GP_STAGE_B(GP_SB(0, 0), cB, 0); GP_STAGE_A(GP_SA(0, 0), cA, 0, false); GP_STAGE_B(GP_SB(0, 1), cB, 1); GP_STAGE_A(GP_SA(0, 1), cA, 1, false);
    if (wr == 1) GP_BAR;
    GP_WAIT_V(4); GP_BAR;
    GP_STAGE_B(GP_SB(1, 0), cB + kstep, 0); GP_STAGE_A(GP_SA(1, 0), cA + kstep, 0, false); GP_STAGE_B(GP_SB(1, 1), cB + kstep, 1);
    GP_WAIT_V(6); GP_BAR;
    for (;;) {
        const bool has_next = S.next(ui + 1, nxt);
        if (GATHER && has_next) S.lane_off(nxt, nvo);
        const char* nA = has_next ? nxt.A : cA; const char* nB = has_next ? nxt.B : cB;
        for (int t = 0; t < nt; t += 2) {
            const bool last = (t == nt - 2);
            const bool un = last && has_next;
            const char* a1 = cA + (size_t)(t + 1) * kstep;
            const char* a2 = last ? nA : cA + (size_t)(t + 2) * kstep; const char* b2 = last ? nB : cB + (size_t)(t + 2) * kstep;
            const char* a3 = a2 + kstep; const char* b3 = b2 + kstep;
            GP_LDB(B0, 0, 0); GP_SCHED; GP_LDA(At, 0, 0); GP_STAGE_A(GP_SA(1, 1), a1, 1, false);
            GP_WAIT_L(8); GP_BAR; GP_WAIT_L(0); GP_MMA(0, 0, At, B0); GP_BAR; GP_SCHED;
            GP_LDB(B1, 0, 1); GP_STAGE_B(GP_SB(0, 0), b2, 0);
            GP_BAR; GP_WAIT_L(0); GP_MMA(0, 1, At, B1); GP_BAR;
            GP_LDA(At, 0, 1); GP_STAGE_A(GP_SA(0, 0), a2, 0, un);
            GP_BAR; GP_WAIT_L(0); GP_MMA(1, 0, At, B0); GP_BAR; GP_SCHED;
            GP_STAGE_B(GP_SB(0, 1), b2, 1);
            GP_WAIT_V(6); GP_BAR; GP_MMA(1, 1, At, B1); GP_BAR;
            GP_LDB(B0, 1, 0); GP_SCHED; GP_LDA(At, 1, 0); GP_STAGE_A(GP_SA(0, 1), a2, 1, un);
            GP_WAIT_L(8); GP_BAR; GP_WAIT_L(0); GP_MMA(0, 0, At, B0); GP_BAR; GP_SCHED;
            GP_LDB(B1, 1, 1); GP_STAGE_B(GP_SB(1, 0), b3, 0);
            GP_BAR; GP_WAIT_L(0); GP_MMA(0, 1, At, B1); GP_BAR;
            GP_LDA(At, 1, 1); GP_STAGE_A(GP_SA(1, 0), a3, 0, un);
            GP_BAR; GP_WAIT_L(0); GP_MMA(1, 0, At, B0); GP_BAR; GP_SCHED;
            GP_STAGE_B(GP_SB(1, 1), b3, 1);
            GP_WAIT_V(6); GP_BAR; GP_MMA(1, 1, At, B1); GP_BAR;
        }
        E(acc, cur, wr, wc, fr, fq);
        if (!has_next) break;
#pragma unroll
        for (int a = 0; a < 2; ++a)
#pragma unroll
            for (int b = 0; b < 2; ++b)
#pragma unroll
                for (int m = 0; m < 4; ++m)
#pragma unroll
                    for (int n = 0; n < 2; ++n) acc[a][b][m][n] = (f32x4){0.f, 0.f, 0.f, 0.f};
        cur = nxt; cA = nA; cB = nB; ++ui;
        if (GATHER) { cvo[0][0] = nvo[0][0]; cvo[0][1] = nvo[0][1]; cvo[1][0] = nvo[1][0]; cvo[1][1] = nvo[1][1]; }
    }
    GP_WAIT_V(0);
    if (wr == 0) GP_BAR;
    GP_BAR;
#undef GP_SA
#undef GP_SB
#undef GP_GLDS
#undef GP_STAGE_A
#undef GP_STAGE_B
#undef GP_LDA
#undef GP_LDB
#undef GP_MMA
#undef GP_WAIT_V
#undef GP_WAIT_L
#undef GP_BAR
#undef GP_SCHED
}

struct EpiF32 {
    float* C; int ldc;
    __device__ __forceinline__ void operator()(const f32x4 (&acc)[2][2][4][2], const Unit& u, int wr, int wc, int fr, int fq) const {
        const int row0 = u.r0 + wr * 64 + fr, col0 = u.c0 + wc * 32 + 4 * fq;
#pragma unroll
        for (int ai = 0; ai < 2; ++ai)
#pragma unroll
            for (int m = 0; m < 4; ++m) { float* rowp = C + (size_t)(row0 + ai * HALF + m * 16) * ldc + col0;
#pragma unroll
                for (int bj = 0; bj < 2; ++bj)
#pragma unroll
                    for (int n = 0; n < 2; ++n) *(f32x4*)(rowp + bj * HALF + n * 16) = acc[ai][bj][m][n];
                __builtin_amdgcn_sched_barrier(0); }
    }
};
struct EpiBf16 {
    bf16_t* O; int ldc;
    __device__ __forceinline__ void operator()(const f32x4 (&acc)[2][2][4][2], const Unit& u, int wr, int wc, int fr, int fq) const {
        const int row0 = u.r0 + wr * 64 + fr, col0 = u.c0 + wc * 32 + 8 * fq;
#pragma unroll
        for (int ai = 0; ai < 2; ++ai)
#pragma unroll
            for (int m = 0; m < 4; ++m) { bf16_t* rowp = O + (size_t)(row0 + ai * HALF + m * 16) * ldc + col0;
#pragma unroll
                for (int bj = 0; bj < 2; ++bj) { const f32x4 v0 = acc[ai][bj][m][0], v1 = acc[ai][bj][m][1];
                    u32x4 w; w.x = cvt_pk_bf16(v0[0], v0[1]); w.y = cvt_pk_bf16(v0[2], v0[3]); w.z = cvt_pk_bf16(v1[0], v1[1]); w.w = cvt_pk_bf16(v1[2], v1[3]);
                    *(u32x4*)(rowp + bj * HALF) = w; }
                __builtin_amdgcn_sched_barrier(0); }
    }
};
}


typedef float f32x4_l __attribute__((ext_vector_type(4)));
__device__ __forceinline__ void stage_gate_w(KP p, int e, LAS float* wl) {
    const int tid = opaque_tid();
    const float* wg = p->in[I_EWIN] + (size_t)e * 1024 * EVEN_N + 1536;
#pragma unroll
    for (int i = 0; i < 8; ++i) { const int idx = tid + 512 * i, d = idx >> 2, j4 = idx & 3; const float4 w = *(const float4*)(wg + (size_t)d * EVEN_N + j4 * 4); *(LAS f32x4_l*)(wl + d * 16 + j4 * 4) = (f32x4_l){w.x, w.y, w.z, w.w}; }
    __syncthreads();
}
__device__ __forceinline__ void ph_modin(KP p, int l, int bid, int nb) {
    const int tid = opaque_tid(), lane = tid & 63, wv = tid >> 6;
    const bool even = (l & 1) == 0;
    bf16_t* U = (bf16_t*)(p->ws + OFF_U);
    float* G = (float*)(p->ws + OFF_G);
    LAS float* wl = (LAS float*)smraw_base();
    if (even) stage_gate_w(p, l >> 1, wl);
    #pragma unroll 1
    for (int tok = bid * 8 + wv; tok < NT; tok += nb * 8) {
        const float* h = hrow(p, tok);
        const float* m = modrow(p, l, tok);
        float ga[16];
#pragma unroll
        for (int j = 0; j < 16; ++j) ga[j] = 0.f;
#pragma unroll
        for (int c = 0; c < 4; ++c) {
            const int d = 4 * (lane + 64 * c);
            const float4 hv = *(const float4*)(h + d), sh = *(const float4*)(m + d), sc = *(const float4*)(m + 1024 + d);
            const float u0 = hv.x * (1.f + sc.x) + sh.x, u1 = hv.y * (1.f + sc.y) + sh.y, u2 = hv.z * (1.f + sc.z) + sh.z, u3 = hv.w * (1.f + sc.w) + sh.w;
            *(uint2*)(U + (size_t)tok * DM + d) = make_uint2(cvt_pk_bf16(u0, u1), cvt_pk_bf16(u2, u3));
            if (even) {
                const float uu[4] = {u0, u1, u2, u3};
#pragma unroll
                for (int q = 0; q < 4; ++q) {
#pragma unroll
                    for (int j4 = 0; j4 < 4; ++j4) { const f32x4_l w = *(const LAS f32x4_l*)(wl + (d + q) * 16 + j4 * 4); ga[4 * j4] += uu[q] * w[0]; ga[4 * j4 + 1] += uu[q] * w[1]; ga[4 * j4 + 2] += uu[q] * w[2]; ga[4 * j4 + 3] += uu[q] * w[3]; }
                }
                __builtin_amdgcn_sched_barrier(0);
            }
        }
        if (even) {
            float mine = 0.f;
#pragma unroll
            for (int j = 0; j < 16; ++j) { const float s = wave_sum(ga[j]); if (lane == j) mine = s; }
            if (lane < 16) G[(size_t)tok * 16 + lane] = mine;
        }
    }
}

__device__ __forceinline__ void ph_gemm_in(KP p, int l, int bid, int nb, LAS unsigned char* lds) {
    const int N = ((l & 1) == 0) ? EVEN_LD : ODD_LD;
    gp::DenseSched S; S.init(p->ws + OFF_U, p->ws + OFF_WIN, NT, N, 1024, nb, bid);
    gp::EpiBf16 E{(bf16_t*)(p->ws + OFF_BIG), N};
    gp::gemm_phase<false, true>(lds, 1024, S, E);
}
__device__ __forceinline__ void ph_gemm_out(KP p, int l, int bid, int nb, LAS unsigned char* lds) {
    gp::DenseSched S; S.init(p->ws + OFF_U, p->ws + OFF_WOUT, NT, 1024, 1024, nb, bid);
    gp::EpiBf16 E{(bf16_t*)(p->ws + OFF_BIG), 1024};
    gp::gemm_phase<false, true>(lds, 1024, S, E);
}


namespace sc {
typedef short bf16x8 __attribute__((ext_vector_type(8)));
typedef short bf16x4 __attribute__((ext_vector_type(4)));
typedef float f32x4 __attribute__((ext_vector_type(4)));
#define SC_MFMA(a, b, c) __builtin_amdgcn_mfma_f32_16x16x32_bf16(a, b, c, 0, 0, 0)
__device__ __forceinline__ bf16x8 rd_row(unsigned img, int row, int stride, int k0) { return *(const LAS bf16x8*)(size_t)(img + (unsigned)(row * stride + k0 * 2)); }
__device__ __forceinline__ bf16x8 rd_tr(unsigned img, int k0, int n0, int stride, int lane) {
    const int g = lane >> 4, i = lane & 15;
    const unsigned a0 = img + (unsigned)((k0 + 8 * g + (i >> 2)) * stride + (n0 + 4 * (i & 3)) * 2), a1 = a0 + 4u * (unsigned)stride;
    bf16x4 lo, hi;
    asm volatile("ds_read_b64_tr_b16 %0, %2\n\tds_read_b64_tr_b16 %1, %3\n\ts_waitcnt lgkmcnt(0)" : "=&v"(lo), "=&v"(hi) : "v"(a0), "v"(a1) : "memory");
    return (bf16x8){lo[0], lo[1], lo[2], lo[3], hi[0], hi[1], hi[2], hi[3]};
}
typedef unsigned u32x2_ __attribute__((ext_vector_type(2)));
typedef unsigned u32x4_ __attribute__((ext_vector_type(4)));
__device__ __forceinline__ unsigned tr_addr(unsigned img, int k0, int n0, int stride, int lane) { const int g = lane >> 4, i = lane & 15; return img + (unsigned)((k0 + 8 * g + (i >> 2)) * stride + (n0 + 4 * (i & 3)) * 2); }
__device__ __forceinline__ void rd_tr5(const unsigned (&a0)[5], const unsigned (&s4)[5], bf16x8 (&o)[5]) {
    bf16x4 l0, h0, l1, h1, l2, h2, l3, h3, l4, h4;
    asm volatile("ds_read_b64_tr_b16 %0, %10\n\tds_read_b64_tr_b16 %1, %11\n\tds_read_b64_tr_b16 %2, %12\n\tds_read_b64_tr_b16 %3, %13\n\tds_read_b64_tr_b16 %4, %14\n\t"
                 "ds_read_b64_tr_b16 %5, %15\n\tds_read_b64_tr_b16 %6, %16\n\tds_read_b64_tr_b16 %7, %17\n\tds_read_b64_tr_b16 %8, %18\n\tds_read_b64_tr_b16 %9, %19\n\ts_waitcnt lgkmcnt(0)"
                 : "=&v"(l0), "=&v"(h0), "=&v"(l1), "=&v"(h1), "=&v"(l2), "=&v"(h2), "=&v"(l3), "=&v"(h3), "=&v"(l4), "=&v"(h4)
                 : "v"(a0[0]), "v"(a0[0] + s4[0]), "v"(a0[1]), "v"(a0[1] + s4[1]), "v"(a0[2]), "v"(a0[2] + s4[2]), "v"(a0[3]), "v"(a0[3] + s4[3]), "v"(a0[4]), "v"(a0[4] + s4[4]) : "memory");
    o[0] = (bf16x8){l0[0], l0[1], l0[2], l0[3], h0[0], h0[1], h0[2], h0[3]}; o[1] = (bf16x8){l1[0], l1[1], l1[2], l1[3], h1[0], h1[1], h1[2], h1[3]};
    o[2] = (bf16x8){l2[0], l2[1], l2[2], l2[3], h2[0], h2[1], h2[2], h2[3]}; o[3] = (bf16x8){l3[0], l3[1], l3[2], l3[3], h3[0], h3[1], h3[2], h3[3]};
    o[4] = (bf16x8){l4[0], l4[1], l4[2], l4[3], h4[0], h4[1], h4[2], h4[3]};
}
__device__ __forceinline__ void st8(unsigned addr, uint2 v) { *(LAS u32x2_*)(size_t)addr = (u32x2_){v.x, v.y}; }
__device__ __forceinline__ void st16(unsigned addr, uint4 v) { *(LAS u32x4_*)(size_t)addr = (u32x4_){v.x, v.y, v.z, v.w}; }
__device__ __forceinline__ float scan_add64(float v, int lane) {
#pragma unroll
    for (int o = 1; o < 64; o <<= 1) { const float t = SHU(v, o); if (lane >= o) v += t; }
    return v;
}
__device__ __forceinline__ float scan_max64(float v, int lane) {
#pragma unroll
    for (int o = 1; o < 64; o <<= 1) { const float t = SHU(v, o); if (lane >= o) v = fmaxf(v, t); }
    return v;
}

template <int MODE>
__device__ __forceinline__ void scan_item(KP p, int l, int b, int h, int dir, int vs) {
    constexpr int CS = (MODE == 1) ? 32 : 64, DK = (MODE == 0) ? 64 : 128, EXT = (MODE == 0) ? 1 : 0;
    constexpr int QS = (DK + 8) * 2, VS = (64 + 16 * EXT + 8) * 2, SS = (CS + 8) * 2, NVR = 64 + 16 * EXT;
    constexpr int NCH = (CTXL + SEQ) / CS;
    constexpr int LD = (MODE == 2) ? ODD_LD : EVEN_LD;
    constexpr unsigned O_QA = 0, O_KA = O_QA + CS * QS, O_QB = O_KA + CS * QS, O_KW = O_QB + (MODE == 1 ? CS * QS : 0), O_V = O_KW + CS * QS,
                       O_SSC = O_V + CS * VS, O_ST = O_SSC + CS * SS, O_DKV = O_ST + 2 * NVR * QS, O_END = O_DKV + 512;
    static_assert(O_END <= 131072, "scan LDS");
    const int tid = opaque_tid(), lane = tid & 63, wv = __builtin_amdgcn_readfirstlane(tid >> 6), r16 = lane & 15, q4 = lane >> 4;
    const unsigned L0 = (unsigned)(size_t)smraw_base();
    const bf16_t* P = (const bf16_t*)(p->ws + OFF_BIG);
    bf16_t* HXo = (bf16_t*)(p->ws + OFF_AUX) + (size_t)dir * NT * 1024;
    const int e2 = l >> 1;
    const int cQ = (MODE == 0) ? E_MQ + h * 64 : (MODE == 1) ? E_HQ + h * 128 : 1536 + h * 128;
    const int cK = (MODE == 0) ? E_MK + h * 64 : (MODE == 1) ? (dir ? E_HFB : E_HFF) + h * 128 : 2048 + h * 128;
    const int cV = (MODE == 0) ? E_MV + h * 128 + vs * 64 : (MODE == 1) ? E_HI + h * 128 + vs * 64 : 2560 + h * 128 + vs * 64;
    const int cO = (MODE == 0) ? h * 128 + vs * 64 : 512 + h * 128 + vs * 64;
    const int lt = (MODE == 1) ? (tid & 31) : (tid >> 3);
    const int lj = (MODE == 0) ? (tid & 7) : (MODE == 1) ? (tid >> 5) : ((tid >> 2) & 1) * 8 + (tid & 3);
    const int vt_ = tid >> 3, vj = tid & 7;
    float lbv[8]; float gbi = 0.f, gbf = 0.f, lg = 0.f;
    if (MODE == 1) {
        const float* lbp = (const float*)(p->ws + OFF_LB) + e2 * 512 + h * 128 + lj * 8;
#pragma unroll
        for (int i = 0; i < 8; ++i) lbv[i] = lbp[i];
    } else {
#pragma unroll
        for (int i = 0; i < 8; ++i) lbv[i] = 0.f;
    }
    if (MODE == 0) { const float* gb = p->in[I_MGB] + e2 * 16; gbi = gb[(dir ? 2 : 0) * 4 + h]; gbf = gb[(dir ? 3 : 1) * 4 + h]; }
    if (MODE == 2) lg = p->in[I_RLD][e2 * 8 + dir * 4 + h];
    const float* G = (const float*)(p->ws + OFF_G);
    const float* ropet = (const float*)(p->ws + OFF_ROPE);
    unsigned oz = 0u; asm volatile("" : "+v"(oz));
    for (unsigned o = tid * 16; o < 2u * NVR * QS; o += 512 * 16) st16(L0 + O_ST + o, make_uint4(oz, oz, oz, oz));
    if (EXT) { if (tid < CS) { st16(L0 + O_V + tid * VS + 128, make_uint4(0x3f80u | oz, oz, oz, oz)); st16(L0 + O_V + tid * VS + 144, make_uint4(oz, oz, oz, oz)); } }
    f32x4 sacc[4];
#pragma unroll
    for (int i = 0; i < 4; ++i) sacc[i] = (f32x4){0.f, 0.f, 0.f, 0.f};
    float m_in = -1e30f;
    struct Raw { uint4 rq0, rq1, rk0, rk1, rv; float rg0, rg1; };
    Raw RA, RB;
    RA.rq1 = make_uint4(0u, 0u, 0u, 0u); RA.rk1 = RA.rq1; RA.rv = RA.rq1; RA.rg0 = 0.f; RA.rg1 = 0.f; RB = RA;
    auto load_chunk = [&](Raw& R, int c) {
        const int i0 = c * CS;
        const int tq = scan_tok(b, i0 + lt, dir);
        const bf16_t* pr = P + (size_t)tq * LD;
        R.rq0 = *(const uint4*)(pr + cQ + lj * 8); R.rk0 = *(const uint4*)(pr + cK + lj * 8);
        if (MODE == 2) { R.rq1 = *(const uint4*)(pr + cQ + lj * 8 + 32); R.rk1 = *(const uint4*)(pr + cK + lj * 8 + 32); }
        if (MODE != 1 || tid < 256) { const int tv = scan_tok(b, i0 + vt_, dir); R.rv = *(const uint4*)(P + (size_t)tv * LD + cV + vj * 8); }
        if (MODE == 0) { const int tg = scan_tok(b, i0 + lane, dir); R.rg0 = G[(size_t)tg * 16 + (dir ? 8 : 0) + h]; R.rg1 = G[(size_t)tg * 16 + (dir ? 12 : 4) + h]; }
    };
    constexpr int PD = (MODE == 2) ? 1 : 2;
    load_chunk(RA, 0); if (PD == 2) load_chunk(RB, 1);
    auto chunk = [&](const int c, Raw& R) {
        const uint4 rq0 = R.rq0, rq1 = R.rq1, rk0 = R.rk0, rk1 = R.rk1, rv = R.rv; const float rg0 = R.rg0, rg1 = R.rg1;
        const unsigned ST_R = L0 + O_ST + (unsigned)(c & 1) * NVR * QS, ST_W = L0 + O_ST + (unsigned)((c + 1) & 1) * NVR * QS;
        float sp = 1.f;
        float v_u = 0.f, v_M = 0.f, v_e = 1.f, v_low = 0.f, v_w = 1.f;
        if (MODE == 0) {
            const float ig = rg0 + gbi, fg = rg1 + gbf;
            const float lf = fminf(fg, 0.f) - flog(1.f + fexp(-fabsf(fg)));
            const float bb = scan_add64(lf, lane);
            const float g = SHI(bb, 63);
            v_u = ig - bb;
            const float cu = scan_max64(v_u, lane);
            v_M = fmaxf(m_in, cu);
            const float m_new = fmaxf(g + m_in, g + SHI(cu, 63));
            sp = fexp(g + m_in - m_new);
            v_w = fexp(g + v_u - m_new);
            v_e = fexp(m_in - v_M);
            v_low = fexp(-(bb + v_M));
            m_in = m_new;
            st16(L0 + O_QA + lt * QS + lj * 16, rq0);
            st16(L0 + O_KA + lt * QS + lj * 16, rk0);
            const float wr = SHI(v_w, lt);
            uint4 kw; kw.x = cvt_pk_bf16(bflo(rk0.x) * wr, bfhi(rk0.x) * wr); kw.y = cvt_pk_bf16(bflo(rk0.y) * wr, bfhi(rk0.y) * wr);
            kw.z = cvt_pk_bf16(bflo(rk0.z) * wr, bfhi(rk0.z) * wr); kw.w = cvt_pk_bf16(bflo(rk0.w) * wr, bfhi(rk0.w) * wr);
            st16(L0 + O_KW + lt * QS + lj * 16, kw);
            st16(L0 + O_V + vt_ * VS + vj * 16, rv);
        } else if (MODE == 2) {
            sp = fexp(64.f * lg);
            const bool lat = c >= CTXL / CS;
            float q[16], k[16];
            const unsigned qa[8] = {rq0.x, rq0.y, rq0.z, rq0.w, rq1.x, rq1.y, rq1.z, rq1.w}, ka[8] = {rk0.x, rk0.y, rk0.z, rk0.w, rk1.x, rk1.y, rk1.z, rk1.w};
#pragma unroll
            for (int i = 0; i < 8; ++i) { q[2 * i] = bflo(qa[i]); q[2 * i + 1] = bfhi(qa[i]); k[2 * i] = bflo(ka[i]); k[2 * i + 1] = bfhi(ka[i]); }
            if (lat) {
                const int tq = scan_tok(b, c * CS + lt, dir), tt = tq & (SEQ - 1);
                const int pos = ((tid >> 2) & 1) ? (tt & 63) : (tt >> 6);
                const float2* rt = (const float2*)ropet + pos * 32 + (tid & 3) * 8;
#pragma unroll
                for (int i = 0; i < 8; ++i) {
                    const float2 cs2 = rt[i];
                    const float q1 = q[i], q2 = q[8 + i], k1 = k[i], k2 = k[8 + i];
                    q[i] = q1 * cs2.x - q2 * cs2.y; q[8 + i] = q1 * cs2.y + q2 * cs2.x;
                    k[i] = k1 * cs2.x - k2 * cs2.y; k[8 + i] = k1 * cs2.y + k2 * cs2.x;
                }
            }
            const float wr = 0.08838834764831845f * fexp((float)(63 - lt) * lg);
            uint4 o0, o1, w0, w1, x0, x1;
            o0.x = cvt_pk_bf16(q[0], q[1]); o0.y = cvt_pk_bf16(q[2], q[3]); o0.z = cvt_pk_bf16(q[4], q[5]); o0.w = cvt_pk_bf16(q[6], q[7]);
            o1.x = cvt_pk_bf16(q[8], q[9]); o1.y = cvt_pk_bf16(q[10], q[11]); o1.z = cvt_pk_bf16(q[12], q[13]); o1.w = cvt_pk_bf16(q[14], q[15]);
            w0.x = cvt_pk_bf16(k[0], k[1]); w0.y = cvt_pk_bf16(k[2], k[3]); w0.z = cvt_pk_bf16(k[4], k[5]); w0.w = cvt_pk_bf16(k[6], k[7]);
            w1.x = cvt_pk_bf16(k[8], k[9]); w1.y = cvt_pk_bf16(k[10], k[11]); w1.z = cvt_pk_bf16(k[12], k[13]); w1.w = cvt_pk_bf16(k[14], k[15]);
            x0.x = cvt_pk_bf16(k[0] * wr, k[1] * wr); x0.y = cvt_pk_bf16(k[2] * wr, k[3] * wr); x0.z = cvt_pk_bf16(k[4] * wr, k[5] * wr); x0.w = cvt_pk_bf16(k[6] * wr, k[7] * wr);
            x1.x = cvt_pk_bf16(k[8] * wr, k[9] * wr); x1.y = cvt_pk_bf16(k[10] * wr, k[11] * wr); x1.z = cvt_pk_bf16(k[12] * wr, k[13] * wr); x1.w = cvt_pk_bf16(k[14] * wr, k[15] * wr);
            st16(L0 + O_QA + lt * QS + lj * 16, o0); st16(L0 + O_QA + lt * QS + lj * 16 + 64, o1);
            st16(L0 + O_KA + lt * QS + lj * 16, w0); st16(L0 + O_KA + lt * QS + lj * 16 + 64, w1);
            st16(L0 + O_KW + lt * QS + lj * 16, x0); st16(L0 + O_KW + lt * QS + lj * 16 + 64, x1);
            st16(L0 + O_V + vt_ * VS + vj * 16, rv);
        } else {
            const unsigned qa[4] = {rq0.x, rq0.y, rq0.z, rq0.w}, fa[4] = {rk0.x, rk0.y, rk0.z, rk0.w};
            float qv[8], kk[8], A[8];
#pragma unroll
            for (int i = 0; i < 8; ++i) {
                const float qr = (i & 1) ? bfhi(qa[i >> 1]) : bflo(qa[i >> 1]), fr = (i & 1) ? bfhi(fa[i >> 1]) : bflo(fa[i >> 1]);
                const float f = lbv[i] + (1.f - lbv[i]) * fsigmoid(fr);
                qv[i] = fsilu(qr); kk[i] = 1.f - f; A[i] = flog(f);
            }
#pragma unroll
            for (int o = 1; o < 32; o <<= 1)
#pragma unroll
                for (int i = 0; i < 8; ++i) { const float t = SHU(A[i], o); if (lt >= o) A[i] += t; }
            float qa_[8], qb_[8], ka_[8], kw_[8];
#pragma unroll
            for (int i = 0; i < 8; ++i) {
                const float am = SHI32(A[i], 15), ae = SHI32(A[i], 31);
                qa_[i] = qv[i] * fexp(A[i] - am); qb_[i] = qv[i] * fexp(A[i]); ka_[i] = kk[i] * fexp(am - A[i]); kw_[i] = kk[i] * fexp(ae - A[i]);
                if (lt == 31) *(LAS float*)(size_t)(L0 + O_DKV + (lj * 8 + i) * 4) = fexp(ae);
            }
            uint4 w;
            w.x = cvt_pk_bf16(qa_[0], qa_[1]); w.y = cvt_pk_bf16(qa_[2], qa_[3]); w.z = cvt_pk_bf16(qa_[4], qa_[5]); w.w = cvt_pk_bf16(qa_[6], qa_[7]); st16(L0 + O_QA + lt * QS + lj * 16, w);
            w.x = cvt_pk_bf16(qb_[0], qb_[1]); w.y = cvt_pk_bf16(qb_[2], qb_[3]); w.z = cvt_pk_bf16(qb_[4], qb_[5]); w.w = cvt_pk_bf16(qb_[6], qb_[7]); st16(L0 + O_QB + lt * QS + lj * 16, w);
            w.x = cvt_pk_bf16(ka_[0], ka_[1]); w.y = cvt_pk_bf16(ka_[2], ka_[3]); w.z = cvt_pk_bf16(ka_[4], ka_[5]); w.w = cvt_pk_bf16(ka_[6], ka_[7]); st16(L0 + O_KA + lt * QS + lj * 16, w);
            w.x = cvt_pk_bf16(kw_[0], kw_[1]); w.y = cvt_pk_bf16(kw_[2], kw_[3]); w.z = cvt_pk_bf16(kw_[4], kw_[5]); w.w = cvt_pk_bf16(kw_[6], kw_[7]); st16(L0 + O_KW + lt * QS + lj * 16, w);
            if (tid < 256) st16(L0 + O_V + vt_ * VS + vj * 16, rv);
        }
        __syncthreads();
        if (c + PD < NCH) load_chunk(R, c + PD);
        {
            constexpr int NT1 = CS / 16;
            const bool act = (MODE == 1) ? (wv < 4) : true;
            const int tb = (MODE == 1) ? (wv & 1) : (wv & 3);
#pragma unroll
            for (int u2 = 0; u2 < ((MODE == 1) ? 1 : 2); ++u2) {
                const int sb = (MODE == 1) ? (wv >> 1) : 2 * (wv >> 2) + u2;
                if (act) {
                    f32x4 d = (f32x4){0.f, 0.f, 0.f, 0.f};
                    if (sb <= tb) {
#pragma unroll
                        for (int kk2 = 0; kk2 < DK / 32; ++kk2)
                            d = SC_MFMA(rd_row(L0 + O_KA, sb * 16 + r16, QS, kk2 * 32 + q4 * 8), rd_row(L0 + O_QA, tb * 16 + r16, QS, kk2 * 32 + q4 * 8), d);
                        const int t = tb * 16 + r16, s0 = sb * 16 + q4 * 4;
                        if (MODE == 0) {
                            const float Mt = SHI(v_M, t);
#pragma unroll
                            for (int jj = 0; jj < 4; ++jj) { const float us = SHI(v_u, s0 + jj); d[jj] = (s0 + jj <= t) ? d[jj] * 0.125f * fexp(us - Mt) : 0.f; }
                        } else if (MODE == 2) {
#pragma unroll
                            for (int jj = 0; jj < 4; ++jj) d[jj] = (s0 + jj <= t) ? d[jj] * 0.08838834764831845f * fexp((float)(t - s0 - jj) * lg) : 0.f;
                        } else {
#pragma unroll
                            for (int jj = 0; jj < 4; ++jj) d[jj] = (s0 + jj <= t) ? d[jj] : 0.f;
                        }
                    }
                    st8(L0 + O_SSC + (tb * 16 + r16) * SS + (sb * 16 + q4 * 4) * 2, make_uint2(cvt_pk_bf16(d[0], d[1]), cvt_pk_bf16(d[2], d[3])));
                }
            }
            (void)NT1;
        }
        __syncthreads();
        {
            const int tb = (MODE == 1) ? (wv & 1) : (wv & 3);
            const int t = tb * 16 + r16;
            const int tok = scan_tok(b, c * CS + t, dir);
            constexpr int NV = (MODE == 1) ? 1 : 2;
            f32x4 oi[NV + EXT], oo[NV + EXT];
#pragma unroll
            for (int u2 = 0; u2 < NV + EXT; ++u2) {
                const int vt = (u2 == NV) ? 4 : ((MODE == 1) ? (wv >> 1) : 2 * (wv >> 2) + u2);
                f32x4 a1 = (f32x4){0.f, 0.f, 0.f, 0.f}, a2 = a1;
#pragma unroll
                for (int sb2 = 0; sb2 < CS / 32; ++sb2)
                    a1 = SC_MFMA(rd_tr(L0 + O_V, sb2 * 32, vt * 16, VS, lane), rd_row(L0 + O_SSC, t, SS, sb2 * 32 + q4 * 8), a1);
#pragma unroll
                for (int kk2 = 0; kk2 < DK / 32; ++kk2)
                    a2 = SC_MFMA(rd_row(ST_R, vt * 16 + r16, QS, kk2 * 32 + q4 * 8), rd_row(L0 + ((MODE == 1) ? O_QB : O_QA), t, QS, kk2 * 32 + q4 * 8), a2);
                oi[u2] = a1; oo[u2] = a2;
            }
            float den = 1.f, ei = 1.f;
            if (MODE == 0) {
                ei = 0.125f * SHI(v_e, t);
                const float dsum = oi[NV][0] + ei * oo[NV][0];
                const float dd = SHI(dsum, r16);
                den = 1.f / fmaxf(fabsf(dd), SHI(v_low, t));
            } else if (MODE == 2) {
                ei = fexp((float)(t + 1) * lg);
            }
#pragma unroll
            for (int u2 = 0; u2 < NV; ++u2) {
                const int vt = (MODE == 1) ? (wv >> 1) : 2 * (wv >> 2) + u2;
                float o[4];
#pragma unroll
                for (int jj = 0; jj < 4; ++jj) o[jj] = (oi[u2][jj] + ei * oo[u2][jj]) * den;
                *(uint2*)(HXo + (size_t)tok * 1024 + cO + vt * 16 + q4 * 4) = make_uint2(cvt_pk_bf16(o[0], o[1]), cvt_pk_bf16(o[2], o[3]));
            }
        }
        {
            constexpr int NS = (MODE == 0) ? 3 : 4;
            const int kt = (MODE == 0) ? (wv & 3) : wv;
            float dk[4] = {sp, sp, sp, sp};
            if (MODE == 1) { const f32x4 dv = *(const LAS f32x4*)(size_t)(L0 + O_DKV + (kt * 16 + q4 * 4) * 4); dk[0] = dv[0]; dk[1] = dv[1]; dk[2] = dv[2]; dk[3] = dv[3]; }
            f32x4 a[NS];
#pragma unroll
            for (int u2 = 0; u2 < NS; ++u2) { a[u2] = sacc[u2];
#pragma unroll
                for (int jj = 0; jj < 4; ++jj) a[u2][jj] *= dk[jj]; }
#pragma unroll
            for (int sb2 = 0; sb2 < CS / 32; ++sb2) {
                unsigned ta[5], ts[5]; bf16x8 ops[5];
                ta[0] = tr_addr(L0 + O_KW, sb2 * 32, kt * 16, QS, lane); ts[0] = 4u * QS;
#pragma unroll
                for (int u2 = 0; u2 < 4; ++u2) {
                    const int vt = (MODE == 0) ? ((u2 >= 2) ? 4 : 2 * (wv >> 2) + u2) : u2;
                    ta[1 + u2] = tr_addr(L0 + O_V, sb2 * 32, vt * 16, VS, lane); ts[1 + u2] = 4u * VS;
                }
                rd_tr5(ta, ts, ops);
#pragma unroll
                for (int u2 = 0; u2 < NS; ++u2) a[u2] = SC_MFMA(ops[0], ops[1 + u2], a[u2]);
            }
#pragma unroll
            for (int u2 = 0; u2 < NS; ++u2) {
                const int vt = (MODE == 0) ? ((u2 == 2) ? 4 : 2 * (wv >> 2) + u2) : u2;
                sacc[u2] = a[u2];
                st8(ST_W + (vt * 16 + r16) * QS + (kt * 16 + q4 * 4) * 2, make_uint2(cvt_pk_bf16(a[u2][0], a[u2][1]), cvt_pk_bf16(a[u2][2], a[u2][3])));
            }
        }
        __syncthreads();
    };
#pragma unroll 1
    for (int c = 0; c < NCH; c += 2) { chunk(c, RA); if (PD == 2) chunk(c + 1, RB); else chunk(c + 1, RA); }
}
}

__device__ __forceinline__ void ph_scan_even2(KP p, int l, int bid, int nb) {
#pragma unroll 1
    for (int item = bid; item < 256; item += nb) {
        const int kind = item >> 7, b = (item >> 4) & 7, h = (item >> 2) & 3, dir = (item >> 1) & 1, vs = item & 1;
        if (kind == 0) sc::scan_item<0>(p, l, b, h, dir, vs); else sc::scan_item<1>(p, l, b, h, dir, vs);
        __syncthreads();
    }
}
__device__ __forceinline__ void ph_scan_odd2(KP p, int l, int bid, int nb) {
#pragma unroll 1
    for (int item = bid; item < 128; item += nb) {
        const int b = (item >> 4) & 7, h = (item >> 2) & 3, dir = (item >> 1) & 1, vs = item & 1;
        sc::scan_item<2>(p, l, b, h, dir, vs);
        __syncthreads();
    }
}

__device__ __forceinline__ void unpack16(const uint4 a, const uint4 b, float (&x)[16]) {
    x[0] = bflo(a.x); x[1] = bfhi(a.x); x[2] = bflo(a.y); x[3] = bfhi(a.y); x[4] = bflo(a.z); x[5] = bfhi(a.z); x[6] = bflo(a.w); x[7] = bfhi(a.w);
    x[8] = bflo(b.x); x[9] = bfhi(b.x); x[10] = bflo(b.y); x[11] = bfhi(b.y); x[12] = bflo(b.z); x[13] = bfhi(b.z); x[14] = bflo(b.w); x[15] = bfhi(b.w);
}
__device__ __forceinline__ float sum8(float v) { v += SHX(v, 1); v += SHX(v, 2); v += SHX(v, 4); return v; }
template <bool MEANSUB, bool SIG>
__device__ __forceinline__ void head_norm_gate16(const bf16_t* h0, const bf16_t* h1, const bf16_t* gp, const float* nw, bf16_t* out) {
    float a[16], b[16], g[16];
    unpack16(*(const uint4*)h0, *(const uint4*)(h0 + 8), a); unpack16(*(const uint4*)h1, *(const uint4*)(h1 + 8), b); unpack16(*(const uint4*)gp, *(const uint4*)(gp + 8), g);
    float s = 0.f;
#pragma unroll
    for (int i = 0; i < 16; ++i) { a[i] += b[i]; s += a[i]; }
    if (MEANSUB) { const float mean = sum8(s) * (1.f / 128.f);
#pragma unroll
        for (int i = 0; i < 16; ++i) a[i] -= mean; }
    float q = 0.f;
#pragma unroll
    for (int i = 0; i < 16; ++i) q += a[i] * a[i];
    const float r = rsqrtf(sum8(q) * (1.f / 128.f) + LN_EPS);
    unsigned w[8];
#pragma unroll
    for (int i = 0; i < 16; i += 2) {
        const float y0 = a[i] * r * nw[i] * (SIG ? sigmoidf_(g[i]) : siluf_(g[i])), y1 = a[i + 1] * r * nw[i + 1] * (SIG ? sigmoidf_(g[i + 1]) : siluf_(g[i + 1]));
        w[i >> 1] = cvt_pk_bf16(y0, y1);
    }
    *(uint4*)out = make_uint4(w[0], w[1], w[2], w[3]); *(uint4*)(out + 8) = make_uint4(w[4], w[5], w[6], w[7]);
}
__device__ __forceinline__ void ph_normgate_even(KP p, int l, int bid, int nb) {
    const int tid = opaque_tid(), lane = tid & 63, wv = tid >> 6;
    const bf16_t* P = (const bf16_t*)(p->ws + OFF_BIG);
    const bf16_t* HX = (const bf16_t*)(p->ws + OFF_AUX);
    const bf16_t* HX1 = HX + (size_t)NT * 1024;
    bf16_t* MIX = (bf16_t*)(p->ws + OFF_U);
    const int e = l >> 1;
    const bool ml = lane < 32;
    const float* nw = ml ? p->in[I_MNW] + e * 512 + 16 * lane : p->in[I_HNW] + e * 512 + 16 * (lane - 32);
    const int gcol = ml ? E_MO + 16 * lane : E_HG + 16 * (lane - 32);
#pragma unroll 1
    for (int tok = bid * 8 + wv; tok < NT; tok += nb * 8) {
        const size_t o = (size_t)tok * 1024 + 16 * lane;
        if (ml) head_norm_gate16<true, true>(HX + o, HX1 + o, P + (size_t)tok * EVEN_LD + gcol, nw, MIX + o);
        else head_norm_gate16<false, false>(HX + o, HX1 + o, P + (size_t)tok * EVEN_LD + gcol, nw, MIX + o);
    }
}

#define OFF_UT   (OFF_AUX + 136 * MiB)
#define OFF_FKS(o) (984 * MiB + (size_t)(o) * 34 * MiB)
#define OFF_ZOT  (OFF_UT + 102 * MiB)

__device__ __forceinline__ void ph_hy_filt2(KP p, int l, int bid, int nb, float* sm, int skip) {
    const int tid = opaque_tid(), o = l >> 1;
    float* zf = sm;
    float* h1 = sm + 1024;
    float* h2 = sm + 2048;
    float* h3 = sm + 3072;
    const float* fw1 = p->in[I_HW1] + o * 33 * 64; const float* fb1 = p->in[I_HB1] + o * 64;
    const float* fw2 = p->in[I_HW2] + o * 64 * 64; const float* fb2 = p->in[I_HB2] + o * 64;
    const float* fw3 = p->in[I_HW3] + o * 64 * 64; const float* fb3 = p->in[I_HB3] + o * 64;
    const float* freq = p->in[I_HFREQ] + o * 64;
    const float* wout = p->in[I_HWOUT] + (size_t)o * 64 * 2048;
    float* FK = (float*)(p->ws + OFF_FKS(o)); float* FKC = FK + (size_t)2 * 512 * 8192;
#pragma unroll 1
    for (int item = bid - skip; item < (SEQ + CTXL) / 16; item += nb - skip) {
        if (item < 0) break;
        const bool isctx = item >= SEQ / 16;
        const int L = isctx ? CTXL : SEQ, pos0 = (isctx ? item - SEQ / 16 : item) * 16;
        __syncthreads();
        if (tid < 16 * 17) {
            const int pp = tid / 17, j = tid % 17, pos = pos0 + pp;
            if (j == 16) zf[pp * 36] = (float)pos / (float)(L - 1);
            else { const float f = 1e-4f + (float)j * ((15.0f - 1e-4f) / 15.0f); const float w = 2.0f * 3.14159265358979323846f * (float)pos / (float)L * f; zf[pp * 36 + 1 + j] = cosf(w); zf[pp * 36 + 17 + j] = sinf(w); }
        }
        __syncthreads();
        const int pp = tid >> 5, u0 = (tid & 31) * 2;
        { float a0 = fb1[u0], a1 = fb1[u0 + 1];
#pragma unroll 1
          for (int k = 0; k < 33; ++k) { const float z = zf[pp * 36 + k]; a0 += z * fw1[k * 64 + u0]; a1 += z * fw1[k * 64 + u0 + 1]; }
          h1[pp * 64 + u0] = sinf(freq[u0] * a0); h1[pp * 64 + u0 + 1] = sinf(freq[u0 + 1] * a1); }
        __syncthreads();
        { float a0 = fb2[u0], a1 = fb2[u0 + 1];
#pragma unroll 4
          for (int k = 0; k < 64; ++k) { const float z = h1[pp * 64 + k]; a0 += z * fw2[k * 64 + u0]; a1 += z * fw2[k * 64 + u0 + 1]; }
          h2[pp * 64 + u0] = sinf(freq[u0] * a0); h2[pp * 64 + u0 + 1] = sinf(freq[u0 + 1] * a1); }
        __syncthreads();
        { float a0 = fb3[u0], a1 = fb3[u0 + 1];
#pragma unroll 4
          for (int k = 0; k < 64; ++k) { const float z = h2[pp * 64 + k]; a0 += z * fw3[k * 64 + u0]; a1 += z * fw3[k * 64 + u0 + 1]; }
          h3[pp * 64 + u0] = sinf(freq[u0] * a0); h3[pp * 64 + u0 + 1] = sinf(freq[u0 + 1] * a1); }
        __syncthreads();
#pragma unroll 1
        for (int r = 0; r < 4; ++r) {
            const int col = tid + 512 * r, c = col & 511, od = col >> 9, order = od >> 1, dirn = od & 1;
            float a[16];
#pragma unroll
            for (int i = 0; i < 16; ++i) a[i] = 0.f;
#pragma unroll 1
            for (int k = 0; k < 64; k += 4) { const float w0 = wout[k * 2048 + col], w1 = wout[(k + 1) * 2048 + col], w2 = wout[(k + 2) * 2048 + col], w3 = wout[(k + 3) * 2048 + col];
#pragma unroll
                for (int i = 0; i < 16; ++i) { const float4 hh = *(const float4*)(h3 + i * 64 + k); a[i] += hh.x * w0 + hh.y * w1 + hh.z * w2 + hh.w * w3; } }
            const float delta = 3.0701134573253944f + (float)c * ((15.350567286626972f - 3.0701134573253944f) / 511.0f);
#pragma unroll
            for (int i = 0; i < 16; ++i) a[i] *= expf(-((float)(pos0 + i) / (float)(L - 1)) * delta);
            float* dst = isctx ? FKC + ((size_t)order * 512 + c) * 512 + 256 : FK + ((size_t)order * 512 + c) * 8192 + 4096;
            if (dirn == 0) {
#pragma unroll
                for (int i = 0; i < 16; i += 4) *(float4*)(dst + pos0 + i) = make_float4(a[i], a[i + 1], a[i + 2], a[i + 3]);
            } else {
#pragma unroll
                for (int i = 0; i < 16; ++i) if (pos0 + i > 0) dst[-(pos0 + i)] = a[i];
                if (pos0 == 0) dst[-L] = 0.f;
            }
        }
    }
}

__device__ __forceinline__ void ph_hy_prep(KP p, int l, int bid, int nb, float* sm) {
    const int tid = opaque_tid(), o = l >> 1;
    const bf16_t* P = (const bf16_t*)(p->ws + OFF_BIG);
    bf16_t* UT = (bf16_t*)(p->ws + OFF_UT);
    const float* cw = p->in[I_HCW] + o * 3 * 1536; const float* cb = p->in[I_HCB] + o * 1536;
    float* tile = sm;
#pragma unroll 1
    for (int item = bid; item < (NT / 256) * 24; item += nb) {
        const int tt = item / 24, ct = item % 24, tok0 = tt * 256, col0 = ct * 64;
        const bool lat = tok0 < NL;
        const int L = lat ? SEQ : CTXL, t0 = lat ? (tok0 & (SEQ - 1)) : ((tok0 - NL) & (CTXL - 1));
        __syncthreads();
#pragma unroll 1
        for (int i = tid; i < 258 * 8; i += 512) {
            const int rr = i >> 3, hf = i & 7, t = t0 + rr - 1;
            uint4 v = make_uint4(0u, 0u, 0u, 0u);
            if (t >= 0 && t < L) v = *(const uint4*)(P + (size_t)(tok0 + rr - 1) * ODD_LD + col0 + hf * 8);
            float* d = tile + rr * 65 + hf * 8;
            d[0] = bflo(v.x); d[1] = bfhi(v.x); d[2] = bflo(v.y); d[3] = bfhi(v.y); d[4] = bflo(v.z); d[5] = bfhi(v.z); d[6] = bflo(v.w); d[7] = bfhi(v.w);
        }
        __syncthreads();
#pragma unroll 1
        for (int r = 0; r < 4; ++r) {
            const int cc = (tid >> 5) + 16 * r, tc = (tid & 31) * 8, col = col0 + cc;
            const float w0 = cw[col], w1 = cw[1536 + col], w2 = cw[3072 + col], bb = cb[col];
            float y[8];
#pragma unroll
            for (int i = 0; i < 8; ++i) y[i] = tile[(tc + i) * 65 + cc] * w0 + tile[(tc + i + 1) * 65 + cc] * w1 + tile[(tc + i + 2) * 65 + cc] * w2 + bb;
            *(uint4*)(UT + (size_t)col * NT + tok0 + tc) = make_uint4(cvt_pk_bf16(y[0], y[1]), cvt_pk_bf16(y[2], y[3]), cvt_pk_bf16(y[4], y[5]), cvt_pk_bf16(y[6], y[7]));
        }
    }
}

__device__ __forceinline__ void hy_item_lat(KP p, int l, int c) {
    constexpr int ZSB = (SEQ + 8) * 2;
    constexpr unsigned O_Z = 0, O_PE = O_Z + 8 * ZSB, O_PO = O_PE + 4096 * 4, O_END = O_PO + 4096 * 4;
    static_assert(O_END <= BAR_LDS_, "hyena LDS");
    const int tid = opaque_tid(), lane = tid & 63, wv = __builtin_amdgcn_readfirstlane(tid >> 6), r16 = lane & 15, q4 = lane >> 4, o = l >> 1;
    const unsigned L0 = (unsigned)(size_t)smraw_base();
    const bf16_t* UT = (const bf16_t*)(p->ws + OFF_UT);
    bf16_t* ZOT = (bf16_t*)(p->ws + OFF_ZOT);
    const float* FK = (const float*)(p->ws + OFF_FKS(o));
    for (int i = tid; i < 8 * 512; i += 512) { const int b = i >> 9, ch = i & 511; sc::st16(L0 + O_Z + b * ZSB + ch * 16, *(const uint4*)(UT + (size_t)(1024 + c) * NT + b * SEQ + ch * 8)); }
#pragma unroll 1
    for (int order = 0; order < 2; ++order) {
        const float* fk = FK + ((size_t)order * 512 + c) * 8192;
        for (int i = tid; i < 4096; i += 512) {
            const float r0 = (i > 0) ? fk[8192 - 2 * i] : 0.f, r1 = fk[8191 - 2 * i], r2 = (i < 4095) ? fk[8190 - 2 * i] : 0.f;
            *(LAS unsigned*)(size_t)(L0 + O_PE + i * 4) = cvt_pk_bf16(r0, r1); *(LAS unsigned*)(size_t)(L0 + O_PO + i * 4) = cvt_pk_bf16(r1, r2);
        }
        __syncthreads();
        sc::f32x4 acc[4][4];
#pragma unroll
        for (int a = 0; a < 4; ++a)
#pragma unroll
            for (int b2 = 0; b2 < 4; ++b2) acc[a][b2] = (sc::f32x4){0.f, 0.f, 0.f, 0.f};
        const unsigned gbase = L0 + ((r16 & 1) ? O_PO : O_PE) + (unsigned)(((4096 - r16 + 8 * q4 - (r16 & 1)) >> 1) * 4);
        auto ldG = [&](int g) {
            const unsigned a0 = gbase - (unsigned)(32 * g);
            const unsigned w0 = *(const LAS unsigned*)(size_t)a0, w1 = *(const LAS unsigned*)(size_t)(a0 + 4), w2 = *(const LAS unsigned*)(size_t)(a0 + 8), w3 = *(const LAS unsigned*)(size_t)(a0 + 12);
            return __builtin_bit_cast(sc::bf16x8, (sc::u32x4_){w0, w1, w2, w3});
        };
        sc::bf16x8 bq[4][2], W[6];
#pragma unroll
        for (int i = 0; i < 4; ++i) { bq[i][0] = (sc::bf16x8){0, 0, 0, 0, 0, 0, 0, 0}; bq[i][1] = bq[i][0]; }
        const int D0 = 8 * wv - 63, D1 = (8 * wv + 7 < 63) ? 8 * wv + 7 : 63;
        W[4] = ldG(4 * D0 - 6 + 4); W[5] = ldG(4 * D0 - 6 + 5);
#pragma unroll 1
        for (int D = D0; D <= D1; ++D) {
            W[0] = W[4]; W[1] = W[5];
#pragma unroll
            for (int i = 0; i < 4; ++i) W[2 + i] = ldG(4 * D + i);
            bq[3][0] = bq[2][0]; bq[3][1] = bq[2][1]; bq[2][0] = bq[1][0]; bq[2][1] = bq[1][1]; bq[1][0] = bq[0][0]; bq[1][1] = bq[0][1];
            {
                const int s1 = 8 * wv - D + ((r16 < 8) ? 0 : 4);
                const bool ok = (unsigned)s1 < 64u;
                const unsigned za = L0 + O_Z + (unsigned)((r16 & 7) * ZSB + ((ok ? s1 : 0) * 64 + q4 * 8) * 2);
                sc::bf16x8 b0 = *(const LAS sc::bf16x8*)(size_t)za, b1 = *(const LAS sc::bf16x8*)(size_t)(za + 64);
                if (!ok) { b0 = (sc::bf16x8){0, 0, 0, 0, 0, 0, 0, 0}; b1 = b0; }
                bq[0][0] = b0; bq[0][1] = b1;
            }
#pragma unroll
            for (int cg = 0; cg < 4; ++cg) {
                const int sA = 8 * wv + cg - D;
                if ((unsigned)sA < 64u || (unsigned)(sA + 4) < 64u) {
#pragma unroll
                    for (int it = 0; it < 4; ++it) { acc[cg][it] = SC_MFMA(W[it + 2], bq[cg][0], acc[cg][it]); acc[cg][it] = SC_MFMA(W[it], bq[cg][1], acc[cg][it]); }
                }
            }
        }
        __syncthreads();
        const float sk = p->in[I_HSKIP][o * 1024 + order * 512 + c];
        const bf16_t* gt = UT + (size_t)(order * 512 + c) * NT;
        const int bb = r16 & 7;
#pragma unroll
        for (int cg = 0; cg < 4; ++cg) {
            const int t1 = 8 * wv + cg + ((r16 < 8) ? 0 : 4);
#pragma unroll
            for (int it = 0; it < 4; ++it) {
                const int t = t1 * 64 + it * 16 + q4 * 4;
                const sc::u32x2_ zo_ = *(const LAS sc::u32x2_*)(size_t)(L0 + O_Z + bb * ZSB + t * 2); const uint2 zo = make_uint2(zo_[0], zo_[1]);
                const uint2 gv = *(const uint2*)(gt + bb * SEQ + t);
                const float y0 = bflo(gv.x) * (acc[cg][it][0] + sk * bflo(zo.x)), y1 = bfhi(gv.x) * (acc[cg][it][1] + sk * bfhi(zo.x));
                const float y2 = bflo(gv.y) * (acc[cg][it][2] + sk * bflo(zo.y)), y3 = bfhi(gv.y) * (acc[cg][it][3] + sk * bfhi(zo.y));
                const uint2 w = make_uint2(cvt_pk_bf16(y0, y1), cvt_pk_bf16(y2, y3));
                if (order == 0) sc::st8(L0 + O_Z + bb * ZSB + t * 2, w);
                else *(uint2*)(ZOT + (size_t)c * NT + bb * SEQ + t) = w;
            }
        }
        __syncthreads();
    }
}

__device__ __forceinline__ void hy_item_ctx(KP p, int l, int c, float* sm) {
    const int tid = opaque_tid(), o = l >> 1;
    const bf16_t* UT = (const bf16_t*)(p->ws + OFF_UT);
    bf16_t* ZOT = (bf16_t*)(p->ws + OFF_ZOT);
    const float* FKC = (const float*)(p->ws + OFF_FKS(o)) + (size_t)2 * 512 * 8192;
    float* Kc = sm;
    float* zb = sm + 1024;
    for (int i = tid; i < 1024; i += 512) Kc[i] = FKC[((size_t)(i >> 9) * 512 + c) * 512 + (i & 511)];
    for (int i = tid; i < 8 * CTXL; i += 512) zb[i] = bf2f(UT[(size_t)(1024 + c) * NT + NL + i]);
    __syncthreads();
    const int bb = tid >> 6, tl = tid & 63;
#pragma unroll 1
    for (int order = 0; order < 2; ++order) {
        float acc[4] = {0.f, 0.f, 0.f, 0.f};
#pragma unroll 4
        for (int s = 0; s < CTXL; ++s) {
            const float zv = zb[bb * CTXL + s];
#pragma unroll
            for (int i = 0; i < 4; ++i) acc[i] += Kc[order * 512 + tl + 64 * i - s + 256] * zv;
        }
        const float sk = p->in[I_HSKIP][o * 1024 + order * 512 + c];
        float zn[4];
#pragma unroll
        for (int i = 0; i < 4; ++i) { const int t = tl + 64 * i; zn[i] = bf2f(UT[(size_t)(order * 512 + c) * NT + NL + bb * CTXL + t]) * (acc[i] + zb[bb * CTXL + t] * sk); }
        __syncthreads();
#pragma unroll
        for (int i = 0; i < 4; ++i) { const int t = tl + 64 * i; if (order == 0) zb[bb * CTXL + t] = bf2f((bf16_t)(cvt_pk_bf16(zn[i], 0.f) & 0xffffu)); else stf(ZOT + (size_t)c * NT + NL + bb * CTXL + t, zn[i]); }
        __syncthreads();
    }
}

__device__ __forceinline__ void ph_mix_odd(KP p, int l, int bid, int nb, float* sm) {
    int* head = (int*)(p->ws + OFF_CNT) + 1024 + (l >> 1) * 64;
    LAS int* slot = (LAS int*)(smraw_base() + BAR_LDS_ + 64);
#pragma unroll 1
    for (;;) {
        if (opaque_tid() == 0) *slot = atomicAdd(head, 1);
        __syncthreads();
        const int item = *slot;
        __syncthreads();
        if (item >= 128 + 512) break;
        if (item < 128) { const int b = (item >> 4) & 7, h = (item >> 2) & 3, dir = (item >> 1) & 1, vs = item & 1; sc::scan_item<2>(p, l, b, h, dir, vs); }
        else { const int c = item - 128; hy_item_lat(p, l, c); __syncthreads(); hy_item_ctx(p, l, c, sm); }
        __syncthreads();
    }
}

__device__ __forceinline__ void ph_hy_norm(KP p, int l, int bid, int nb, float* sm) {
    const int tid = opaque_tid(), o = l >> 1;
    const bf16_t* ZOT = (const bf16_t*)(p->ws + OFF_ZOT);
    bf16_t* MIX = (bf16_t*)(p->ws + OFF_U);
    const float* nw = p->in[I_HNORM] + o * 512;
    float* tile = sm;
    float* part = sm + 64 * 65;
#pragma unroll 1
    for (int item = bid; item < (NT / 64) * 8; item += nb) {
        const int tt = item >> 3, g = item & 7, tok0 = tt * 64;
        __syncthreads();
        { const int cc = tid >> 3, ch = tid & 7;
          const uint4 v = *(const uint4*)(ZOT + (size_t)(g * 64 + cc) * NT + tok0 + ch * 8);
          float* d = tile + cc * 65 + ch * 8;
          d[0] = bflo(v.x); d[1] = bfhi(v.x); d[2] = bflo(v.y); d[3] = bfhi(v.y); d[4] = bflo(v.z); d[5] = bfhi(v.z); d[6] = bflo(v.w); d[7] = bfhi(v.w); }
        __syncthreads();
        { const int tk = tid & 63, pt = tid >> 6; float s = 0.f;
#pragma unroll
          for (int i = 0; i < 8; ++i) { const float x = tile[(pt * 8 + i) * 65 + tk]; s += x * x; }
          part[pt * 64 + tk] = s; }
        __syncthreads();
        { const int tk = tid >> 3, ch = tid & 7; float s = 0.f;
#pragma unroll
          for (int i = 0; i < 8; ++i) s += part[i * 64 + tk];
          const float rs = rsqrtf(s * (1.f / 64.f) + LN_EPS);
          float y[8];
#pragma unroll
          for (int i = 0; i < 8; ++i) y[i] = tile[(ch * 8 + i) * 65 + tk] * rs * nw[g * 64 + ch * 8 + i];
          *(uint4*)(MIX + (size_t)(tok0 + tk) * DM + g * 64 + ch * 8) = make_uint4(cvt_pk_bf16(y[0], y[1]), cvt_pk_bf16(y[2], y[3]), cvt_pk_bf16(y[4], y[5]), cvt_pk_bf16(y[6], y[7])); }
    }
}

__device__ __forceinline__ void ph_normgate_odd(KP p, int l, int bid, int nb) {
    const int tid = opaque_tid(), lane = tid & 63, wv = tid >> 6, o2 = l >> 1;
    const bf16_t* P = (const bf16_t*)(p->ws + OFF_BIG);
    const bf16_t* HX = (const bf16_t*)(p->ws + OFF_AUX);
    const bf16_t* HX1 = HX + (size_t)NT * 1024;
    bf16_t* MIX = (bf16_t*)(p->ws + OFF_U);
    const int c16 = 16 * (lane & 31);
    const float* nw = p->in[I_RNW] + o2 * 512 + c16;
#pragma unroll 1
    for (int t2 = bid * 8 + wv; t2 < NT / 2; t2 += nb * 8) {
        const int tok = t2 * 2 + (lane >> 5);
        const size_t o = (size_t)tok * 1024 + 512 + c16;
        head_norm_gate16<true, false>(HX + o, HX1 + o, P + (size_t)tok * ODD_LD + 3072 + c16, nw, MIX + o);
    }
}

__device__ __forceinline__ void ph_ln1_router(KP p, int l, int ntok, int bid, int nb, float* sm) {
    constexpr int VP = (1024 + 8) * 2;
    constexpr unsigned O_VH = 0, O_VL = 32 * VP, O_LG = 64 * VP;
    static_assert(O_LG + 32 * 64 * 4 <= BAR_LDS_, "router LDS");
    const int tid = opaque_tid(), lane = tid & 63, wv = __builtin_amdgcn_readfirstlane(tid >> 6), r16 = lane & 15, q4 = lane >> 4;
    const unsigned L0 = (unsigned)(size_t)smraw_base();
    const bf16_t* Y = (const bf16_t*)(p->ws + OFF_BIG);
    bf16_t* U = (bf16_t*)(p->ws + OFF_U);
    const float* lw = p->in[I_LNW] + (l * 2) * 1024; const float* lb = p->in[I_LNB] + (l * 2) * 1024;
    const bf16_t* RWH = (const bf16_t*)(p->ws + OFF_RWH); const bf16_t* RWL = RWH + 64 * 1024;
    const float rb = p->in[I_RB][l * 64 + lane];
    LAS int* lcnt = (LAS int*)(smraw_base() + BAR_LDS_ + 256);
    if (tid < 64) lcnt[tid] = 0;
    __syncthreads();
    int* tidx = (int*)(p->ws + OFF_TIDX); float* tgate = (float*)(p->ws + OFF_TGATE); int* tpos = (int*)(p->ws + OFF_TPOS);
    {
        int* stok = (int*)(p->ws + OFF_STOK); float* sgate = (float*)(p->ws + OFF_SGATE); int* sdst = (int*)(p->ws + OFF_SDST);
#pragma unroll 1
        for (int i = bid * 512 + tid; i < MAXROWS; i += nb * 512) { stok[i] = ZROW; sgate[i] = 0.f; sdst[i] = -1; }
    }
#pragma unroll 1
    for (int base = bid * 32; base < ntok; base += nb * 32) {
#pragma unroll 2
        for (int j = 0; j < 4; ++j) {
            const int tl = wv * 4 + j, tok = base + tl;
            float* h = hrow(p, tok);
            const float* m = modrow(p, l, tok);
            const bf16_t* r = Y + (size_t)tok * DM;
            float x[16]; float s = 0.f;
#pragma unroll
            for (int c = 0; c < 4; ++c) {
                const int d = 4 * (lane + 64 * c);
                const float4 hv = *(const float4*)(h + d), gv = *(const float4*)(m + 2 * 1024 + d); const uint2 rw2 = *(const uint2*)(r + d);
                const float4 rv = make_float4(bflo(rw2.x), bfhi(rw2.x), bflo(rw2.y), bfhi(rw2.y));
                x[4 * c] = ALPHA * hv.x + gv.x * rv.x; x[4 * c + 1] = ALPHA * hv.y + gv.y * rv.y; x[4 * c + 2] = ALPHA * hv.z + gv.z * rv.z; x[4 * c + 3] = ALPHA * hv.w + gv.w * rv.w;
                s += x[4 * c] + x[4 * c + 1] + x[4 * c + 2] + x[4 * c + 3];
            }
            const float mean = wave_sum(s) * (1.f / 1024.f);
            float q = 0.f;
#pragma unroll
            for (int i = 0; i < 16; ++i) { x[i] -= mean; q += x[i] * x[i]; }
            const float rs = rsqrtf(wave_sum(q) * (1.f / 1024.f) + LN_EPS);
#pragma unroll
            for (int c = 0; c < 4; ++c) {
                const int d = 4 * (lane + 64 * c);
                const float4 w4 = *(const float4*)(lw + d), b4 = *(const float4*)(lb + d), sh = *(const float4*)(m + 3 * 1024 + d), sc = *(const float4*)(m + 4 * 1024 + d);
                float4 y; y.x = x[4 * c] * rs * w4.x + b4.x; y.y = x[4 * c + 1] * rs * w4.y + b4.y; y.z = x[4 * c + 2] * rs * w4.z + b4.z; y.w = x[4 * c + 3] * rs * w4.w + b4.w;
                *(float4*)(h + d) = y;
                float4 v; v.x = y.x * (1.f + sc.x) + sh.x; v.y = y.y * (1.f + sc.y) + sh.y; v.z = y.z * (1.f + sc.z) + sh.z; v.w = y.w * (1.f + sc.w) + sh.w;
                const unsigned h0 = cvt_pk_bf16(v.x, v.y), h1 = cvt_pk_bf16(v.z, v.w);
                *(uint2*)(U + (size_t)tok * DM + d) = make_uint2(h0, h1);
                sc::st8(L0 + O_VH + tl * VP + d * 2, make_uint2(h0, h1));
                sc::st8(L0 + O_VL + tl * VP + d * 2, make_uint2(cvt_pk_bf16(v.x - bflo(h0), v.y - bfhi(h0)), cvt_pk_bf16(v.z - bflo(h1), v.w - bfhi(h1))));
            }
        }
        __syncthreads();
        {
            const int tt = wv & 1, et = wv >> 1;
            sc::f32x4 acc = (sc::f32x4){0.f, 0.f, 0.f, 0.f};
            const bf16_t* bh = RWH + (size_t)(et * 16 + r16) * 1024 + q4 * 8; const bf16_t* bl = RWL + (size_t)(et * 16 + r16) * 1024 + q4 * 8;
#pragma unroll 4
            for (int ks = 0; ks < 32; ++ks) {
                const sc::bf16x8 ah = sc::rd_row(L0 + O_VH, tt * 16 + r16, VP, ks * 32 + q4 * 8), al = sc::rd_row(L0 + O_VL, tt * 16 + r16, VP, ks * 32 + q4 * 8);
                const sc::bf16x8 wh = *(const sc::bf16x8*)(bh + ks * 32), wl = *(const sc::bf16x8*)(bl + ks * 32);
                acc = SC_MFMA(ah, wh, acc); acc = SC_MFMA(ah, wl, acc); acc = SC_MFMA(al, wh, acc);
            }
#pragma unroll
            for (int jj = 0; jj < 4; ++jj) *(LAS float*)(size_t)(L0 + O_LG + ((tt * 16 + q4 * 4 + jj) * 64 + et * 16 + r16) * 4) = acc[jj];
        }
        __syncthreads();
#pragma unroll 1
        for (int j = 0; j < 4; ++j) {
            const int tl = wv * 4 + j, tok = base + tl;
            const float lg = *(const LAS float*)(size_t)(L0 + O_LG + (tl * 64 + lane) * 4);
            const float score = sigmoidf_(lg);
            const float key = score + rb;
            int rank = 0;
#pragma unroll
            for (int e = 0; e < 64; ++e) { const float ke = __builtin_bit_cast(float, __builtin_amdgcn_readlane(__builtin_bit_cast(int, key), e)); rank += (ke > key || (ke == key && e < lane)) ? 1 : 0; }
            const bool sel = rank < TOPK;
            const float gsum = wave_sum(sel ? score : 0.f);
            if (sel) {
                const int pos = __hip_atomic_fetch_add(lcnt + lane, 1, __ATOMIC_RELAXED, __HIP_MEMORY_SCOPE_WORKGROUP);
                tidx[tok * 8 + rank] = lane; tgate[tok * 8 + rank] = 2.5f * score / gsum; tpos[tok * 8 + rank] = pos;
            }
        }
        __syncthreads();
    }
    __syncthreads();
    if (tid < 64) ((int*)(p->ws + OFF_BCNT))[bid * 64 + tid] = lcnt[tid];
}

__device__ __forceinline__ void moe_offsets(KP p, int l, int ntok, LAS int* offs) {
    const int t = opaque_tid();
    if (t < 66) offs[t] = ((const int*)(p->ws + OFF_GOFFS))[t];
    __syncthreads();
}
__device__ __forceinline__ int moe_expert_of(const LAS int* offs, int row) { int e = 0;
#pragma unroll 1
    while (e < 64 && row >= offs[e + 1]) ++e;
    return e; }

__device__ __forceinline__ void ph_scatter(KP p, int l, int ntok, int bid, int nb, LAS unsigned char* lds) {
    LAS int* offs = (LAS int*)lds;
    LAS int* myb = offs + 128;
    LAS int* part = offs + 256;
    const int tid = opaque_tid();
    const int* bcnt = (const int*)(p->ws + OFF_BCNT);
    { const int e = tid & 63, pt = tid >> 6; int tot = 0, mine = 0;
#pragma unroll 4
      for (int b = pt; b < nb; b += 8) { const int c = bcnt[b * 64 + e]; tot += c; mine += (b < bid) ? c : 0; }
      part[pt * 64 + e] = tot; part[512 + pt * 64 + e] = mine; }
    __syncthreads();
    if (tid < 64) {
        int tot = 0, mine = 0;
#pragma unroll
        for (int i = 0; i < 8; ++i) { tot += part[i * 64 + tid]; mine += part[512 + i * 64 + tid]; }
        const int pc = (tot + 255) & ~255;
        int incl = pc;
#pragma unroll
        for (int o = 1; o < 64; o <<= 1) { const int t = SHU(incl, o); if (tid >= o) incl += t; }
        offs[tid] = incl - pc; myb[tid] = mine;
        if (tid == 63) { offs[64] = incl; offs[65] = incl + ntok; }
    }
    __syncthreads();
    if (bid == 0 && tid < 66) ((int*)(p->ws + OFF_GOFFS))[tid] = offs[tid];
    const int* tidx = (const int*)(p->ws + OFF_TIDX); const float* tgate = (const float*)(p->ws + OFF_TGATE); const int* tpos = (const int*)(p->ws + OFF_TPOS);
    int* stok = (int*)(p->ws + OFF_STOK); float* sgate = (float*)(p->ws + OFF_SGATE); int* sdst = (int*)(p->ws + OFF_SDST);
    int* tile_e = (int*)(p->ws + OFF_TILEE);
#pragma unroll 1
    for (int base = bid * 32; base < ntok; base += nb * 32) {
        if (tid < 32 * 9) {
            const int tok = base + tid / 9, sl = tid % 9;
            if (sl < 8) { const int i = tok * 8 + sl, e = tidx[i], row = offs[e] + myb[e] + tpos[i]; stok[row] = tok; sgate[row] = tgate[i]; sdst[row] = tok * 9 + sl; }
            else { const int row = offs[64] + tok; stok[row] = tok; sgate[row] = 1.f; sdst[row] = tok * 9 + 8; }
        }
    }
    const int nrt = offs[65] >> 8;
#pragma unroll 1
    for (int rt = bid * 512 + tid; rt < nrt; rt += nb * 512) tile_e[rt] = moe_expert_of(offs, rt * 256);
    __syncthreads();
}

#define MOE_TAB (gp::STAGE_BYTES + 256)
#define MOE_MAXT 9
static_assert(131072 + 256 + 256 + MOE_MAXT * 2048 <= BAR_LDS_, "MoE tables");
struct MoeDeal {
    int nfull, rem, c, G;
    __device__ __forceinline__ void init(int nrt, int c_, int G_) { nfull = nrt / G_; rem = nrt % G_; c = c_; G = G_; }
    __device__ __forceinline__ int nleft(int NPN) const { const int tot = rem * NPN; return c < tot ? (tot - c + G - 1) / G : 0; }
    __device__ __forceinline__ int ntiles(int NPN) const { return nfull + nleft(NPN); }
    __device__ __forceinline__ int tile_of(int j, int NPN) const { return j < nfull ? c + j * G : nfull * G + (c + (j - nfull) * G) / NPN; }
    __device__ __forceinline__ bool unit(int i, int NPN, int& j, int& pn) const {
        if (i < nfull * NPN) { j = i / NPN; pn = i % NPN; return true; }
        const int k = i - nfull * NPN, lu = c + k * G;
        if (lu < rem * NPN) { j = nfull + k; pn = lu % NPN; return true; }
        return false;
    }
};
struct Moe1Sched {
    const char* U; const char* W; const LAS int* tabE; const LAS int* tabS; MoeDeal d;
    __device__ __forceinline__ bool next(int i, gp::Unit& u) const {
        int j, pn; if (!d.unit(i, 2, j, pn)) return false;
        u.A = U; u.B = W + (size_t)tabE[j] * (512 * 1024 * 2) + (size_t)pn * (256 * 1024 * 2); u.r0 = d.tile_of(j, 2) * 256; u.c0 = pn * 256; u.aux = j; return true;
    }
    __device__ __forceinline__ void lane_off(const gp::Unit& u, unsigned (&vo)[2][2]) const {
        const int tid = opaque_tid(); int R0, C0, R1, C1; gp::stage_rc(tid * 16, R0, C0); gp::stage_rc(tid * 16 + 8192, R1, C1);
        const LAS int* t = tabS + u.aux * 256;
        vo[0][0] = (unsigned)t[R0] * 2048u + (unsigned)C0 * 2u; vo[0][1] = (unsigned)t[R1] * 2048u + (unsigned)C1 * 2u;
        vo[1][0] = (unsigned)t[128 + R0] * 2048u + (unsigned)C0 * 2u; vo[1][1] = (unsigned)t[128 + R1] * 2048u + (unsigned)C1 * 2u;
    }
};
struct EpiH {
    bf16_t* H;
    __device__ __forceinline__ void operator()(const gp::f32x4 (&acc)[2][2][4][2], const gp::Unit& u, int wr, int wc, int fr, int fq) const {
        const int row0 = u.r0 + wr * 64 + fr;
#pragma unroll
        for (int ai = 0; ai < 2; ++ai)
#pragma unroll
            for (int m = 0; m < 4; ++m) { bf16_t* rowp = H + (size_t)(row0 + ai * 128 + m * 16) * 256;
#pragma unroll
                for (int bj = 0; bj < 2; ++bj) {
                    const int j0 = ((u.c0 + bj * 128 + wc * 32) >> 5) * 16 + 4 * fq;
                    const gp::f32x4 a = acc[ai][bj][m][0], b = acc[ai][bj][m][1];
                    const float h0 = siluf_(a[0]) * b[0], h1 = siluf_(a[1]) * b[1], h2 = siluf_(a[2]) * b[2], h3 = siluf_(a[3]) * b[3];
                    *(uint2*)(rowp + j0) = make_uint2(cvt_pk_bf16(h0, h1), cvt_pk_bf16(h2, h3)); }
                __builtin_amdgcn_sched_barrier(0); }
    }
};
__device__ __forceinline__ void ph_moe1(KP p, int l, int ntok, int bid, int nb, LAS unsigned char* lds) {
    LAS int* tabE = (LAS int*)(lds + MOE_TAB);
    LAS int* tabS = tabE + 64;
    const int tid = opaque_tid();
    MoeDeal d; d.init(((const int*)(p->ws + OFF_GOFFS))[65] >> 8, bid, nb);
    const int nper = d.ntiles(2);
    const int* stok = (const int*)(p->ws + OFF_STOK); const int* tile_e = (const int*)(p->ws + OFF_TILEE);
    for (int i = tid; i < nper * 256; i += 512) tabS[i] = stok[(size_t)d.tile_of(i >> 8, 2) * 256 + (i & 255)];
    if (tid < nper) tabE[tid] = tile_e[d.tile_of(tid, 2)];
    __syncthreads();
    Moe1Sched S{(const char*)(p->ws + OFF_U), (const char*)(p->ws + OFF_W13), tabE, tabS, d};
    EpiH E{(bf16_t*)(p->ws + OFF_BIG)};
    gp::gemm_phase<true, false>(lds, 1024, S, E);
}

struct Moe2Sched {
    const char* H; const char* W; const LAS int* tabE; MoeDeal d;
    __device__ __forceinline__ bool next(int i, gp::Unit& u) const {
        int j, pn; if (!d.unit(i, 4, j, pn)) return false;
        u.A = H + (size_t)d.tile_of(j, 4) * (256 * 256 * 2); u.B = W + (size_t)tabE[j] * (1024 * 256 * 2) + (size_t)pn * (256 * 256 * 2); u.r0 = j * 256; u.c0 = pn * 256; u.aux = j; return true;
    }
    __device__ __forceinline__ void lane_off(const gp::Unit&, unsigned (&)[2][2]) const {}
};
struct EpiY {
    bf16_t* Ys; const LAS int* tabD; const LAS float* tabG;
    __device__ __forceinline__ void operator()(const gp::f32x4 (&acc)[2][2][4][2], const gp::Unit& u, int wr, int wc, int fr, int fq) const {
        const int rl0 = u.r0 + wr * 64 + fr, col0 = u.c0 + wc * 32 + 8 * fq;
#pragma unroll
        for (int ai = 0; ai < 2; ++ai)
#pragma unroll
            for (int m = 0; m < 4; ++m) {
                const int rl = rl0 + ai * 128 + m * 16;
                const int dst = tabD[rl]; const float g = tabG[rl];
                if (dst >= 0) { bf16_t* rowp = Ys + (size_t)dst * 1024 + col0;
#pragma unroll
                    for (int bj = 0; bj < 2; ++bj) { const gp::f32x4 v0 = acc[ai][bj][m][0] * g, v1 = acc[ai][bj][m][1] * g;
                        gp::u32x4 w; w.x = cvt_pk_bf16(v0[0], v0[1]); w.y = cvt_pk_bf16(v0[2], v0[3]); w.z = cvt_pk_bf16(v1[0], v1[1]); w.w = cvt_pk_bf16(v1[2], v1[3]);
                        *(gp::u32x4*)(rowp + bj * 128) = w; } }
                __builtin_amdgcn_sched_barrier(0); }
    }
};
__device__ __forceinline__ void ph_moe2(KP p, int l, int ntok, int bid, int nb, LAS unsigned char* lds) {
    LAS int* tabE = (LAS int*)(lds + MOE_TAB);
    LAS int* tabD = tabE + 64;
    LAS float* tabG = (LAS float*)(tabD + MOE_MAXT * 256);
    const int tid = opaque_tid();
    MoeDeal d; d.init(((const int*)(p->ws + OFF_GOFFS))[65] >> 8, bid, nb);
    const int nper = d.ntiles(4);
    const int* sdst = (const int*)(p->ws + OFF_SDST); const float* sgate = (const float*)(p->ws + OFF_SGATE); const int* tile_e = (const int*)(p->ws + OFF_TILEE);
    for (int i = tid; i < nper * 256; i += 512) { const size_t r = (size_t)d.tile_of(i >> 8, 4) * 256 + (i & 255); tabD[i] = sdst[r]; tabG[i] = sgate[r]; }
    if (tid < nper) tabE[tid] = tile_e[d.tile_of(tid, 4)];
    __syncthreads();
    Moe2Sched S{(const char*)(p->ws + OFF_BIG), (const char*)(p->ws + OFF_W2), tabE, d};
    EpiY E{(bf16_t*)(p->ws + OFF_YS), tabD, tabG};
    gp::gemm_phase<false, true>(lds, 256, S, E);
}

template <bool NEXT>
__device__ __forceinline__ void ph_combine_ln2(KP p, int l, int ntok, int bid, int nb) {
    bf16_t* U = (bf16_t*)(p->ws + OFF_U);
    float* G = (float*)(p->ws + OFF_G);
    const bool gates = NEXT && ((l + 1) & 1) == 0;
    LAS float* wl = (LAS float*)smraw_base();
    if (gates) stage_gate_w(p, (l + 1) >> 1, wl);
    const int tid = opaque_tid(), lane = tid & 63, wv = tid >> 6;
    const bf16_t* Ys = (const bf16_t*)(p->ws + OFF_YS);
    const float* lw = p->in[I_LNW] + (l * 2 + 1) * 1024; const float* lb = p->in[I_LNB] + (l * 2 + 1) * 1024;
    #pragma unroll 1
    for (int tok = bid * 8 + wv; tok < ntok; tok += nb * 8) {
        float* h = hrow(p, tok);
        const float* m = modrow(p, l, tok);
        const float* m2 = modrow(p, NEXT ? l + 1 : l, tok);
        float ga[16], u16[16];
#pragma unroll
        for (int j = 0; j < 16; ++j) { ga[j] = 0.f; u16[j] = 0.f; }
        float f[16];
#pragma unroll
        for (int i = 0; i < 16; ++i) f[i] = 0.f;
#pragma unroll
        for (int s = 0; s < 9; ++s)
#pragma unroll
            for (int c = 0; c < 2; ++c) {
                const uint4 w = *(const uint4*)(Ys + ((size_t)tok * 9 + s) * 1024 + 8 * (lane + 64 * c));
                f[8 * c + 0] += bflo(w.x); f[8 * c + 1] += bfhi(w.x); f[8 * c + 2] += bflo(w.y); f[8 * c + 3] += bfhi(w.y);
                f[8 * c + 4] += bflo(w.z); f[8 * c + 5] += bfhi(w.z); f[8 * c + 6] += bflo(w.w); f[8 * c + 7] += bfhi(w.w);
            }
        float x[16]; float sum = 0.f;
#pragma unroll
        for (int c = 0; c < 2; ++c)
#pragma unroll
            for (int q = 0; q < 2; ++q) {
                const int d = 8 * (lane + 64 * c) + 4 * q;
                const float4 hv = *(const float4*)(h + d), gv = *(const float4*)(m + 5 * 1024 + d);
                x[8 * c + 4 * q + 0] = ALPHA * hv.x + gv.x * f[8 * c + 4 * q + 0]; x[8 * c + 4 * q + 1] = ALPHA * hv.y + gv.y * f[8 * c + 4 * q + 1];
                x[8 * c + 4 * q + 2] = ALPHA * hv.z + gv.z * f[8 * c + 4 * q + 2]; x[8 * c + 4 * q + 3] = ALPHA * hv.w + gv.w * f[8 * c + 4 * q + 3];
                sum += x[8 * c + 4 * q] + x[8 * c + 4 * q + 1] + x[8 * c + 4 * q + 2] + x[8 * c + 4 * q + 3];
            }
        const float mean = wave_sum(sum) * (1.f / 1024.f);
        float q2 = 0.f;
#pragma unroll
        for (int i = 0; i < 16; ++i) { x[i] -= mean; q2 += x[i] * x[i]; }
        const float rs = rsqrtf(wave_sum(q2) * (1.f / 1024.f) + LN_EPS);
#pragma unroll
        for (int c = 0; c < 2; ++c)
#pragma unroll
            for (int q = 0; q < 2; ++q) {
                const int d = 8 * (lane + 64 * c) + 4 * q;
                const float4 w4 = *(const float4*)(lw + d), b4 = *(const float4*)(lb + d);
                float4 y; y.x = x[8 * c + 4 * q] * rs * w4.x + b4.x; y.y = x[8 * c + 4 * q + 1] * rs * w4.y + b4.y; y.z = x[8 * c + 4 * q + 2] * rs * w4.z + b4.z; y.w = x[8 * c + 4 * q + 3] * rs * w4.w + b4.w;
                *(float4*)(h + d) = y;
                if (NEXT) {
                    const float4 sh = *(const float4*)(m2 + d), sc = *(const float4*)(m2 + 1024 + d);
                    const float uu[4] = {y.x * (1.f + sc.x) + sh.x, y.y * (1.f + sc.y) + sh.y, y.z * (1.f + sc.z) + sh.z, y.w * (1.f + sc.w) + sh.w};
                    *(uint2*)(U + (size_t)tok * DM + d) = make_uint2(cvt_pk_bf16(uu[0], uu[1]), cvt_pk_bf16(uu[2], uu[3]));
                    u16[8 * c + 4 * q] = uu[0]; u16[8 * c + 4 * q + 1] = uu[1]; u16[8 * c + 4 * q + 2] = uu[2]; u16[8 * c + 4 * q + 3] = uu[3];
                }
            }
        if (gates) {
#pragma unroll
            for (int g4 = 0; g4 < 4; ++g4) {
                const int d = 8 * (lane + 64 * (g4 >> 1)) + 4 * (g4 & 1);
#pragma unroll
                for (int qq = 0; qq < 4; ++qq) {
#pragma unroll
                    for (int j4 = 0; j4 < 4; ++j4) { const f32x4_l w = *(const LAS f32x4_l*)(wl + (d + qq) * 16 + j4 * 4); const float uv = u16[4 * g4 + qq]; ga[4 * j4] += uv * w[0]; ga[4 * j4 + 1] += uv * w[1]; ga[4 * j4 + 2] += uv * w[2]; ga[4 * j4 + 3] += uv * w[3]; }
                }
                __builtin_amdgcn_sched_barrier(0);
            }
            float mine = 0.f;
#pragma unroll
            for (int j = 0; j < 16; ++j) { const float sg = wave_sum(ga[j]); if (lane == j) mine = sg; }
            if (lane < 16) G[(size_t)tok * 16 + lane] = mine;
        }
    }
}

#define MEGA_LDS (131072 + 256 + 20480)
#define NBLK 256
#define BAR_LDS BAR_LDS_
#define SYNC() do { XcdBarrier _b; _b.bar = (unsigned*)kparams()->ws; _b.x = xb_xcc_id(); _b.st = (volatile LAS unsigned*)((LAS unsigned char*)smraw_base() + BAR_LDS); xcd_barrier(_b); } while (0)
template <int PAR>
__device__ __forceinline__ void layer_fwd(const int l) {
    LAS unsigned char* lds = smraw_base(); float* sm = (float*)smraw_generic();
    const int bid = blockIdx.x; constexpr int nb = NBLK;
    const int ntok = (l == 3) ? NL : NT;
    ph_gemm_in(kparams(), l, bid, nb, lds); SYNC();
    if (PAR == 0) {
        ph_scan_even2(kparams(), l, bid, nb); SYNC();
        ph_normgate_even(kparams(), l, bid, nb); SYNC();
    } else {
        ph_hy_prep(kparams(), l, bid, nb, sm); SYNC();
        ph_mix_odd(kparams(), l, bid, nb, sm); SYNC();
        ph_hy_norm(kparams(), l, bid, nb, sm); ph_normgate_odd(kparams(), l, bid, nb); SYNC();
    }
    ph_gemm_out(kparams(), l, bid, nb, lds); SYNC();
    ph_ln1_router(kparams(), l, ntok, bid, nb, sm); SYNC();
    ph_scatter(kparams(), l, ntok, bid, nb, lds); SYNC();
    ph_moe1(kparams(), l, ntok, bid, nb, lds); SYNC();
    ph_moe2(kparams(), l, ntok, bid, nb, lds); SYNC();
    if (l < 3) { ph_combine_ln2<true>(kparams(), l, ntok, bid, nb); ph_convert(kparams(), l + 1, bid, nb, sm); SYNC(); }
    else ph_combine_ln2<false>(kparams(), l, ntok, bid, nb);
}
__global__ void __launch_bounds__(512, 2) mega_fwd(Params p) {
    LAS unsigned char* lds = smraw_base(); float* sm = (float*)smraw_generic();
    {
        const int t0 = threadIdx.x;
        if ((t0 & 63) == 0) { unsigned h; asm volatile("s_getreg_b32 %0, hwreg(HW_REG_HW_ID, 0, 6)" : "=s"(h)); *(LAS int*)(size_t)(WTAB_LDS + (h & 63u) * 4u) = t0 >> 6; }
        if (t0 < 4) ((LAS unsigned*)(lds + BAR_LDS))[t0] = 0u;
    }
    __syncthreads();
    (void)xcd_barrier_post((unsigned*)kparams()->ws, (volatile LAS unsigned*)(lds + BAR_LDS));
    const int bid = blockIdx.x; constexpr int nb = NBLK;
    ph_prologue(kparams(), bid, nb, sm);
    __syncthreads();
    ph_hy_filt2(kparams(), 1, bid, nb, sm, 48); __syncthreads(); ph_hy_filt2(kparams(), 3, bid, nb, sm, 48);
    SYNC();
    ph_convert(kparams(), 0, bid, nb, sm); ph_modin(kparams(), 0, bid, nb); SYNC();
#pragma unroll 1
    for (int lp = 0; lp < 2; ++lp) {
        layer_fwd<0>(2 * lp);
        layer_fwd<1>(2 * lp + 1);
    }
    __syncthreads();
    if (blockIdx.x == 0 && opaque_tid() == 0 && xb_ld((unsigned*)kparams()->ws + XB_TMO) != 0u) kparams()->out[0] = __builtin_nanf("");
}

extern "C" void kernel_launch(void* const* d_in, const int* in_sizes, int n_in, void* d_out, int out_size, void* d_ws, size_t ws_size, hipStream_t stream) {
    static int grid = 0;
    if (grid == 0) {
        if (n_in != 38 || out_size != NL * DM || ws_size < WS_END) { fprintf(stderr, "kernel_launch: bad shapes n_in %d out %d ws %zu (need %zu)\n", n_in, out_size, ws_size, (size_t)WS_END); grid = -1; return; }
        int dev = 0, cus = 0, per_cu = 0;
        if (hipGetDevice(&dev) != hipSuccess || hipDeviceGetAttribute(&cus, hipDeviceAttributeMultiprocessorCount, dev) != hipSuccess) { grid = -1; return; }
        if (hipFuncSetAttribute((const void*)mega_fwd, hipFuncAttributeMaxDynamicSharedMemorySize, MEGA_LDS) != hipSuccess) { fprintf(stderr, "kernel_launch: hipFuncSetAttribute failed\n"); grid = -1; return; }
        if (hipOccupancyMaxActiveBlocksPerMultiprocessor(&per_cu, (const void*)mega_fwd, 512, MEGA_LDS) != hipSuccess || per_cu < 1) { fprintf(stderr, "kernel_launch: occupancy query says %d\n", per_cu); (void)hipGetLastError(); grid = -1; return; }
        if (cus != 256) { fprintf(stderr, "kernel_launch: built for 256 CUs, found %d\n", cus); grid = -1; return; }
        grid = NBLK;
    }
    if (grid < 0) return;
    if (hipMemsetAsync(d_ws, 0, OFF_LB, stream) != hipSuccess) return;
    Params p{};
    for (int i = 0; i < 38; ++i) p.in[i] = (const float*)d_in[i];
    p.out = (float*)d_out; p.ws = (unsigned char*)d_ws;
    hipLaunchKernelGGL(mega_fwd, dim3(grid), dim3(512), MEGA_LDS, stream, p);
}
```

```cpp
#include <hip/hip_runtime.h>
#include <stdint.h>
#include <stdio.h>

#define DM 1024
#define NBATCH 8
#define SEQ 4096
#define CTXL 256
#define NL (NBATCH * SEQ)
#define NC (NBATCH * CTXL)
#define NT (NL + NC)
#define ZROW NT
#define TOPK 8
#define EVEN_N 4112
#define ODD_N 3584
#define EVEN_LD 4096
#define ODD_LD 3584
#define MAXROWS (NT * 8 + 64 * 256 + NT)
#define ALPHA 1.681792830507429f
#define LN_EPS 1e-5f
#define E_MQ 0
#define E_MK 256
#define E_MV 512
#define E_MO 1024
#define E_HQ 1536
#define E_HI 2048
#define E_HFF 2560
#define E_HFB 3072
#define E_HG 3584

typedef unsigned short bf16_t;
#define LAS __attribute__((address_space(3)))
#define BAR_LDS_ 150528

#define MiB ((size_t)1 << 20)
#define OFF_CNT   ((size_t)64 << 10)
#define OFF_LB    ((size_t)96 << 10)
#define OFF_MOD   ((size_t)128 << 10)
#define OFF_ROPE  ((size_t)1536 << 10)
#define OFF_BCNT  ((size_t)1600 << 10)
#define OFF_GOFFS ((size_t)1700 << 10)
#define OFF_RWH   ((size_t)2560 << 10)
#define OFF_TILEE (2 * MiB)
#define OFF_HCTX  (4 * MiB)
#define OFF_TIDX  (12 * MiB)
#define OFF_TGATE (14 * MiB)
#define OFF_TPOS  (16 * MiB)
#define OFF_STOK  (18 * MiB)
#define OFF_SGATE (20 * MiB)
#define OFF_SDST  (22 * MiB)
#define OFF_G     (24 * MiB)
#define OFF_U     (28 * MiB)
#define OFF_W     (98 * MiB)
#define OFF_WIN   (OFF_W)
#define OFF_WOUT  (OFF_W + 8 * MiB)
#define OFF_W13   (OFF_W + 10 * MiB)
#define OFF_W2    (OFF_W + 75 * MiB)
#define OFF_BIG   (208 * MiB)
#define OFF_AUX   (480 * MiB)
#define OFF_Z1    (OFF_AUX + 136 * MiB)
#define OFF_Z2    (OFF_Z1 + 68 * MiB)
#define OFF_FILT  (OFF_Z2 + 68 * MiB)
#define OFF_YS    (370 * MiB)
#define WS_END    (1052 * MiB)

struct Params {
    const float* in[38];
    float* out;
    unsigned char* ws;
};

enum { I_X = 0, I_C, I_CTX, I_CCTX, I_ADAW, I_ADAB, I_LNW, I_LNB, I_EWIN, I_MGB, I_MNW, I_HLB, I_HNW, I_EWOUT, I_OWIN, I_HCW, I_HCB,
       I_HW1, I_HB1, I_HW2, I_HB2, I_HW3, I_HB3, I_HFREQ, I_HWOUT, I_HSKIP, I_HNORM, I_RLD, I_RNW, I_OWOUT, I_RW, I_RB, I_W1, I_W3, I_W2, I_SW1, I_SW3, I_SW2 };

typedef const __attribute__((address_space(4))) Params* KP;
__device__ __forceinline__ KP kparams() { KP k = (KP)__builtin_amdgcn_kernarg_segment_ptr(); asm volatile("" : "+s"(k)); return k; }
extern __shared__ __attribute__((aligned(16))) unsigned char smraw_all[];
__device__ __forceinline__ LAS unsigned char* smraw_base() { return (LAS unsigned char*)smraw_all; }
__device__ __forceinline__ unsigned char* smraw_generic() { return smraw_all; }
#define WTAB_LDS (BAR_LDS_ + 512)
__device__ __forceinline__ int opaque_tid() {
    unsigned h; asm volatile("s_getreg_b32 %0, hwreg(HW_REG_HW_ID, 0, 6)" : "=s"(h));
    const int wid = *(volatile LAS int*)(size_t)(WTAB_LDS + (h & 63u) * 4u);
    unsigned m = ~0u; asm volatile("" : "+s"(m));
    const int lane = (int)__builtin_amdgcn_mbcnt_hi(m, __builtin_amdgcn_mbcnt_lo(m, 0u));
    return __builtin_amdgcn_readfirstlane(wid) * 64 + lane;
}
typedef __bf16 bf16x2_n __attribute__((ext_vector_type(2)));
typedef float f32x2_n __attribute__((ext_vector_type(2)));
__device__ __forceinline__ unsigned cvt_pk_bf16(float lo, float hi) { const f32x2_n v = {lo, hi}; return __builtin_bit_cast(unsigned, __builtin_convertvector(v, bf16x2_n)); }
__device__ __forceinline__ float bf2f(bf16_t b) { return __uint_as_float(((unsigned)b) << 16); }
__device__ __forceinline__ float bflo(unsigned w) { return __uint_as_float(w << 16); }
__device__ __forceinline__ float bfhi(unsigned w) { return __uint_as_float(w & 0xffff0000u); }
__device__ __forceinline__ float ldf(const float* p) { return *p; }
__device__ __forceinline__ float ldf(const bf16_t* p) { return bf2f(*p); }
__device__ __forceinline__ void stf(float* p, float v) { *p = v; }
__device__ __forceinline__ void stf(bf16_t* p, float v) { *p = (bf16_t)(cvt_pk_bf16(v, 0.f) & 0xffffu); }
__device__ __forceinline__ float sigmoidf_(float x) { return 1.f / (1.f + expf(-x)); }
__device__ __forceinline__ float siluf_(float x) { return x / (1.f + expf(-x)); }
__device__ __forceinline__ int olane() { unsigned m = ~0u; asm volatile("" : "+s"(m)); return (int)__builtin_amdgcn_mbcnt_hi(m, __builtin_amdgcn_mbcnt_lo(m, 0u)); }
template <class T> __device__ __forceinline__ T shfl_idx(T v, int idx) { return __builtin_bit_cast(T, __builtin_amdgcn_ds_bpermute(idx << 2, __builtin_bit_cast(int, v))); }
#define SHX(v, o) shfl_idx(v, olane() ^ (o))
#define SHI(v, i) shfl_idx(v, (i))
#define SHI32(v, i) shfl_idx(v, (olane() & 32) | ((i) & 31))
#define SHU(v, o) shfl_idx(v, olane() - (o))
__device__ __forceinline__ float fexp(float x) { return __builtin_amdgcn_exp2f(x * 1.4426950408889634f); }
__device__ __forceinline__ float flog(float x) { return __builtin_amdgcn_logf(x) * 0.6931471805599453f; }
__device__ __forceinline__ float frcp(float x) { return __builtin_amdgcn_rcpf(x); }
__device__ __forceinline__ float fsigmoid(float x) { return frcp(1.f + fexp(-x)); }
__device__ __forceinline__ float fsilu(float x) { return x * frcp(1.f + fexp(-x)); }
__device__ __forceinline__ float wave_sum(float v) {
#pragma unroll
    for (int o = 32; o > 0; o >>= 1) v += SHX(v, o);
    return v;
}
__device__ __forceinline__ float* hrow(KP p, int tok) {
    return tok < NL ? p->out + (size_t)tok * DM : (float*)(p->ws + OFF_HCTX) + (size_t)(tok - NL) * DM;
}
__device__ __forceinline__ const float* modrow(KP p, int l, int tok) {
    const int r = tok < NL ? (tok >> 12) : 8;
    return (const float*)(p->ws + OFF_MOD) + ((size_t)l * 9 + r) * 6144;
}
__device__ __forceinline__ int scan_tok(int b, int i, int dir) {
    return i < CTXL ? NL + b * CTXL + (dir ? CTXL - 1 - i : i) : b * SEQ + (dir ? SEQ - 1 - (i - CTXL) : (i - CTXL));
}

#define XB_TMO      128
#define XB_XCNT(j)  (256  + 64 * (j))
#define XB_XSUB(j)  (1280 + 64 * (j))
#define XB_XGEN(j)  (2304 + 64 * (j))
#define XB_TOP      3328
#define XB_TOPGEN   3392
#define XCD_BAR_WORDS 3456
#define XB_SPIN_CAP (1u << 24)
__device__ __forceinline__ unsigned xb_ld(unsigned* p)              { return __hip_atomic_load(p, __ATOMIC_RELAXED, __HIP_MEMORY_SCOPE_AGENT); }
__device__ __forceinline__ unsigned xb_add(unsigned* p, unsigned v) { return __hip_atomic_fetch_add(p, v, __ATOMIC_RELAXED, __HIP_MEMORY_SCOPE_AGENT); }
__device__ __forceinline__ unsigned xb_xcc_id() { return (unsigned)__builtin_amdgcn_s_getreg((3 << 11) | 20) & 0xFu; }
#define XB_SPIN(cond, bar) do { unsigned _sp = 0; while (cond) { __builtin_amdgcn_s_sleep(1); \
    if ((++_sp & 255u) == 0u) { if (xb_ld(&(bar)[XB_TMO])) break; if (_sp > XB_SPIN_CAP) { atomicAdd(&(bar)[XB_TMO], 1u); break; } } } } while (0)
struct XcdBarrier { unsigned* bar; unsigned x; volatile LAS unsigned* st; };
__device__ __forceinline__ XcdBarrier xcd_barrier_post(unsigned* bar, volatile LAS unsigned* st) {
    XcdBarrier b; b.bar = bar; b.x = xb_xcc_id(); b.st = st;
    if (opaque_tid() == 0) (void)xb_add(&bar[XB_XCNT(b.x)], 1u);
    return b;
}
__device__ __forceinline__ void xcd_barrier_complete(unsigned* bar, unsigned x, unsigned& nloc, unsigned& nx) {
    const unsigned G = gridDim.x * gridDim.y * gridDim.z;
    unsigned sum, cnt, mine, sp = 0u;
    for (;;) {
        sum = 0u; cnt = 0u; mine = 0u;
#pragma unroll
        for (unsigned j = 0; j < 16; ++j) { const unsigned c = xb_ld(&bar[XB_XCNT(j)]); sum += c; cnt += (c > 0u) ? 1u : 0u; mine = (j == x) ? c : mine; }
        if (sum == G) break;
        __builtin_amdgcn_s_sleep(1);
        if ((++sp & 255u) == 0u) { if (xb_ld(&bar[XB_TMO])) break; if (sp > XB_SPIN_CAP) { atomicAdd(&bar[XB_TMO], 1u); break; } }
    }
    nloc = mine > 0u ? mine : 1u; nx = cnt > 0u ? cnt : 1u;
}
__device__ __forceinline__ void xcd_barrier(const XcdBarrier& b) {
    asm volatile("s_waitcnt vmcnt(0)" ::: "memory");
    __syncthreads();
    if (opaque_tid() == 0) {
        unsigned* bar = b.bar;
        __builtin_amdgcn_s_waitcnt(0);
        unsigned nloc = b.st[0], nx = b.st[1];
        if (nloc == 0u) { xcd_barrier_complete(bar, b.x, nloc, nx); b.st[0] = nloc; b.st[1] = nx; }
        const unsigned old = xb_add(&bar[XB_XSUB(b.x)], 1u);
        const unsigned gen = old / nloc;
        if (old + 1u == (gen + 1u) * nloc) {
            __builtin_amdgcn_fence(__ATOMIC_RELEASE, "agent");
            asm volatile("s_waitcnt vmcnt(0)" ::: "memory");
            const unsigned og = xb_add(&bar[XB_TOP], 1u);
            const unsigned tg = og / nx;
            if (og + 1u == (tg + 1u) * nx) xb_add(&bar[XB_TOPGEN], 1u);
            else XB_SPIN(xb_ld(&bar[XB_TOPGEN]) == tg, bar);
            __builtin_amdgcn_fence(__ATOMIC_ACQUIRE, "agent");
            xb_add(&bar[XB_XGEN(b.x)], 1u);
            asm volatile("s_waitcnt vmcnt(0)" ::: "memory");
        } else {
            XB_SPIN(xb_ld(&bar[XB_XGEN(b.x)]) == gen, bar);
            __builtin_amdgcn_fence(__ATOMIC_ACQUIRE, "agent");
            asm volatile("s_waitcnt vmcnt(0)" ::: "memory");
        }
    }
    __syncthreads();
}

__device__ __forceinline__ void ph_prologue(KP p, int bid, int nb, float* sm) {
    const int tid = opaque_tid();
    {
        const float4* x4 = (const float4*)p->in[I_X]; float4* o4 = (float4*)p->out;
        #pragma unroll 1
        for (size_t i = (size_t)bid * 512 + tid; i < (size_t)NL * 256; i += (size_t)nb * 512) o4[i] = x4[i];
        const float4* c4 = (const float4*)p->in[I_CTX]; float4* h4 = (float4*)(p->ws + OFF_HCTX);
        #pragma unroll 1
        for (size_t i = (size_t)bid * 512 + tid; i < (size_t)NC * 256; i += (size_t)nb * 512) h4[i] = c4[i];
    }
    if (bid == 0) {
        bf16_t* z = (bf16_t*)(p->ws + OFF_U) + (size_t)ZROW * DM;
        for (int i = tid; i < DM; i += 512) z[i] = 0;
    }
    if (bid == 1 % nb) {
        float* lb = (float*)(p->ws + OFF_LB);
        const float* hl = p->in[I_HLB];
        for (int j = tid; j < 512; j += 512) {
            const float a = hl[j], b = hl[512 + j], mx = fmaxf(a, b);
            const float ea = expf(a - mx), eb = expf(b - mx);
            lb[j] = 0.f; lb[512 + j] = eb / (ea + eb);
        }
    }
    if (bid == 2 % nb) {
        float2* rt = (float2*)(p->ws + OFF_ROPE);
        for (int i = tid; i < 64 * 32; i += 512) { const float ang = (float)(i >> 5) * powf(10000.f, -(float)(2 * (i & 31)) / 64.f); rt[i] = make_float2(cosf(ang), sinf(ang)); }
    }
    {
        float* act = sm;
        bool filled = false;
        #pragma unroll 1
        for (int item = bid; item < 48; item += nb) {
            if (!filled) {
                for (int i = tid; i < 9 * 1024; i += 512) {
                    const int r = i >> 10, k = i & 1023;
                    const float v = r < 8 ? p->in[I_C][r * 1024 + k] : p->in[I_CCTX][k];
                    act[i] = siluf_(v);
                }
                __syncthreads(); filled = true;
            }
            const int l = item / 12, j = (item % 12) * 512 + tid;
            const float* w = p->in[I_ADAW] + (size_t)l * 1024 * 6144 + j;
            float acc[9];
#pragma unroll
            for (int r = 0; r < 9; ++r) acc[r] = 0.f;
            for (int k = 0; k < 1024; ++k) {
                const float wv = w[(size_t)k * 6144];
#pragma unroll
                for (int r = 0; r < 9; ++r) acc[r] += act[r * 1024 + k] * wv;
            }
            const float bv = p->in[I_ADAB][l * 6144 + j];
            float* mod = (float*)(p->ws + OFF_MOD);
#pragma unroll
            for (int r = 0; r < 9; ++r) mod[((size_t)l * 9 + r) * 6144 + j] = acc[r] + bv;
        }
    }
}


struct CvtTile { const float* src; int srcld; bf16_t* dst; int dstld; int k0, n0; };
__device__ __forceinline__ CvtTile cvt_tile_of(KP p, int l, int t, int np4  ) {
    const bool even = (l & 1) == 0;
    const int NP = even ? EVEN_LD : ODD_LD;
    const int t_in = 16 * (NP / 128), t_out = 16 * 8, t_13 = 65 * 16 * 4;
    CvtTile c;
    if (t < t_in) {
        const int kt = t & 15, nt = t >> 4, n = nt * 128 + np4;
        const float* W = even ? p->in[I_EWIN] + (size_t)(l >> 1) * 1024 * EVEN_N : p->in[I_OWIN] + (size_t)(l >> 1) * 1024 * ODD_N;
        c.src = W + ((even && n >= 1536) ? n + 16 : n); c.srcld = even ? EVEN_N : ODD_N; c.dst = (bf16_t*)(p->ws + OFF_WIN); c.dstld = 1024; c.k0 = kt * 64; c.n0 = nt * 128;
    } else if (t < t_in + t_out) {
        const int u = t - t_in, kt = u & 15, nt = u >> 4;
        c.src = (even ? p->in[I_EWOUT] : p->in[I_OWOUT]) + (size_t)(l >> 1) * 1024 * 1024 + nt * 128 + np4; c.srcld = 1024; c.dst = (bf16_t*)(p->ws + OFF_WOUT); c.dstld = 1024; c.k0 = kt * 64; c.n0 = nt * 128;
    } else if (t < t_in + t_out + t_13) {
        const int u = t - t_in - t_out, e = u >> 6, kt = u & 15, nt = (u >> 4) & 3, n = nt * 128 + np4, g = n >> 5, w = n & 31;
        const float* w1 = e < 64 ? p->in[I_W1] + ((size_t)l * 64 + e) * 1024 * 256 : p->in[I_SW1] + (size_t)l * 1024 * 256;
        const float* w3 = e < 64 ? p->in[I_W3] + ((size_t)l * 64 + e) * 1024 * 256 : p->in[I_SW3] + (size_t)l * 1024 * 256;
        c.src = w < 16 ? w1 + 16 * g + w : w3 + 16 * g + w - 16; c.srcld = 256; c.dst = (bf16_t*)(p->ws + OFF_W13) + (size_t)e * 512 * 1024; c.dstld = 1024; c.k0 = kt * 64; c.n0 = nt * 128;
    } else {
        const int u = t - t_in - t_out - t_13, e = u >> 5, kt = u & 3, nt = (u >> 2) & 7;
        const float* w2 = e < 64 ? p->in[I_W2] + ((size_t)l * 64 + e) * 256 * 1024 : p->in[I_SW2] + (size_t)l * 256 * 1024;
        c.src = w2 + nt * 128 + np4; c.srcld = 1024; c.dst = (bf16_t*)(p->ws + OFF_W2) + (size_t)e * 1024 * 256; c.dstld = 256; c.k0 = kt * 64; c.n0 = nt * 128;
    }
    return c;
}
__device__ __forceinline__ void ph_convert(KP p, int l, int bid, int nb, float* sm) {
    const int tid = opaque_tid();
    const int NP = ((l & 1) == 0) ? EVEN_LD : ODD_LD;
    const int total = 16 * (NP / 128) + 16 * 8 + 65 * 16 * 4 + 65 * 4 * 8;
    const int kr = tid >> 5, np4 = (tid & 31) * 4;
    float4 v[4];
    int t = bid;
    CvtTile c = cvt_tile_of(p, l, t < total ? t : 0, np4);
    if (t < total) {
#pragma unroll
        for (int j = 0; j < 4; ++j) v[j] = *(const float4*)(c.src + (size_t)(c.k0 + kr + 16 * j) * c.srcld);
    }
#pragma unroll 1
    for (; t < total; t += nb) {
        __syncthreads();
#pragma unroll
        for (int j = 0; j < 4; ++j) { float* d = sm + (np4) * 65 + kr + 16 * j; d[0] = v[j].x; d[65] = v[j].y; d[130] = v[j].z; d[195] = v[j].w; }
        const CvtTile cur = c;
        const int tn = t + nb;
        if (tn < total) {
            c = cvt_tile_of(p, l, tn, np4);
#pragma unroll
            for (int j = 0; j < 4; ++j) v[j] = *(const float4*)(c.src + (size_t)(c.k0 + kr + 16 * j) * c.srcld);
        }
        __syncthreads();
        const int n = tid >> 2, kc = (tid & 3) * 16;
        unsigned w[8];
#pragma unroll
        for (int q = 0; q < 8; ++q) w[q] = cvt_pk_bf16(sm[n * 65 + kc + 2 * q], sm[n * 65 + kc + 2 * q + 1]);
        uint4* d4 = (uint4*)(cur.dst + (size_t)(cur.n0 + n) * cur.dstld + cur.k0 + kc);
        d4[0] = make_uint4(w[0], w[1], w[2], w[3]); d4[1] = make_uint4(w[4], w[5], w[6], w[7]);
    }
    __syncthreads();
    if (bid < 8) {
        const float* rw = p->in[I_RW] + (size_t)l * 1024 * 64;
        bf16_t* hi = (bf16_t*)(p->ws + OFF_RWH); bf16_t* lo = hi + 64 * 1024;
        const int e = tid & 63, kb = bid * 128 + (tid >> 6) * 16;
#pragma unroll
        for (int i = 0; i < 16; i += 2) {
            const float x0 = rw[(size_t)(kb + i) * 64 + e], x1 = rw[(size_t)(kb + i + 1) * 64 + e];
            const unsigned h = cvt_pk_bf16(x0, x1);
            const unsigned lw = cvt_pk_bf16(x0 - bflo(h), x1 - bfhi(h));
            *(unsigned*)(hi + (size_t)e * 1024 + kb + i) = h; *(unsigned*)(lo + (size_t)e * 1024 + kb + i) = lw;
        }
    }
}

namespace gp {
typedef short bf16x8 __attribute__((ext_vector_type(8)));
typedef float f32x4 __attribute__((ext_vector_type(4)));
typedef unsigned u32x4 __attribute__((ext_vector_type(4)));
typedef unsigned u32x2 __attribute__((ext_vector_type(2)));
constexpr int BM = 256, BK = 64, HALF = 128, HTB = HALF * BK * 2, STAGE_BYTES = 8 * HTB, NXCD = 8, WGM = 8;
__device__ __forceinline__ int lds_byte(int r, int c) { const int st = (r >> 4) * 2 + (c >> 5), rr = r & 15, cc = c & 31, ob = rr * 64 + cc * 2; return st * 1024 + (ob ^ (((ob >> 9) & 1) << 5)); }
__device__ __forceinline__ void stage_rc(int b, int& R, int& C) { const int st = b / 1024, sb = b % 1024, swz = sb ^ (((sb >> 9) & 1) << 5); R = (st >> 1) * 16 + swz / 64; C = (st & 1) * 32 + (swz % 64) / 2; }
__device__ __forceinline__ int perm32(int rho) { const int n = rho >> 4, i = rho & 15; return 8 * (i >> 2) + 4 * n + (i & 3); }

struct Unit { const char* A; const char* B; int r0, c0, aux; };

struct DenseSched {
    const char* A; const char* B; int nM, nN, nwg, G, c; size_t tstep;
    __device__ __forceinline__ void init(const void* A_, const void* B_, int M, int N, int K, int G_, int c_) { A = (const char*)A_; B = (const char*)B_; nM = M / BM; nN = N / BM; nwg = nM * nN; G = G_; c = c_; tstep = (size_t)BM * K * 2; }
    __device__ __forceinline__ bool next(int i, Unit& u) const {
        const long L = (long)i * G + c; if (L >= nwg) return false;
        int wgid = (int)L; { const int q = nwg / NXCD, r = nwg % NXCD, xcd = wgid % NXCD, off = wgid / NXCD; wgid = (xcd < r ? xcd * (q + 1) : r * (q + 1) + (xcd - r) * q) + off; }
        const int nig = WGM * nN, gid = wgid / nig, fm = gid * WGM, gsz = (nM - fm) < WGM ? (nM - fm) : WGM;
        const int pm = fm + ((wgid % nig) % gsz), pn = (wgid % nig) / gsz;
        u.A = A + (size_t)pm * tstep; u.B = B + (size_t)pn * tstep; u.r0 = pm * BM; u.c0 = pn * BM; u.aux = 0; return true;
    }
    __device__ __forceinline__ void lane_off(const Unit&, unsigned (&)[2][2]) const {}
};

template <bool GATHER, bool PERM, class Sched, class Epi>
__device__ __forceinline__ void gemm_phase(LAS unsigned char* lds, const int K_, const Sched& S, const Epi& E) {
    int K = K_; asm volatile("" : "+s"(K));
    const int tid = opaque_tid(), wid = __builtin_amdgcn_readfirstlane(tid >> 6), lane = tid & 63, wr = wid >> 2, wc = wid & 3, fr = lane & 15, fq = lane >> 4;
    const int nt = K / BK;
    unsigned voffA[2], voffB[2];
#pragma unroll
    for (int i = 0; i < 2; ++i) { int R, C; stage_rc(tid * 16 + i * 8192, R, C); const int Rb = PERM ? ((R & ~31) + perm32(R & 31)) : R;
        voffA[i] = (unsigned)(R * K + C) * 2u; voffB[i] = (unsigned)(Rb * K + C) * 2u; }
    const size_t kstep = (size_t)(BK * 2);
    const size_t hstep = (size_t)HALF * K * 2;
    const unsigned ldsw = (unsigned)wid * 1024u;
    const int aoff = lds_byte(wr * 64 + fr, fq * 8), boff = lds_byte(wc * 32 + fr, fq * 8);
    unsigned cvo[2][2] = {{0u, 0u}, {0u, 0u}}, nvo[2][2] = {{0u, 0u}, {0u, 0u}};
#define GP_SA(b, h) (((b) * 2 + (h)) * HTB)
#define GP_SB(b, h) ((4 + (b) * 2 + (h)) * HTB)
#define GP_GLDS(gp_, lp_) __builtin_amdgcn_global_load_lds((const unsigned*)(gp_), (LAS unsigned*)(lp_), 16, 0, 0)
#define GP_STAGE_B(bufoff, gbase, h) do { const char* _g = (gbase) + (size_t)(h) * hstep; \
        GP_GLDS(_g + voffB[0], lds + (bufoff) + ldsw); GP_GLDS(_g + voffB[1], lds + (bufoff) + ldsw + 8192); } while (0)
#define GP_STAGE_A(bufoff, gbase, h, usenext) do { \
        if (GATHER) { const unsigned _o0 = (usenext) ? nvo[h][0] : cvo[h][0], _o1 = (usenext) ? nvo[h][1] : cvo[h][1]; \
            GP_GLDS((gbase) + _o0, lds + (bufoff) + ldsw); GP_GLDS((gbase) + _o1, lds + (bufoff) + ldsw + 8192); } \
        else { const char* _g = (gbase) + (size_t)(h) * hstep; GP_GLDS(_g + voffA[0], lds + (bufoff) + ldsw); GP_GLDS(_g + voffA[1], lds + (bufoff) + ldsw + 8192); } } while (0)
#define GP_LDA(dst, b, h) do { _Pragma("unroll") for (int m = 0; m < 4; ++m) _Pragma("unroll") for (int k = 0; k < 2; ++k) dst[m][k] = *(const LAS bf16x8*)(lds + GP_SA(b, h) + aoff + m * 2048 + k * 1024); } while (0)
#define GP_LDB(dst, b, h) do { _Pragma("unroll") for (int n = 0; n < 2; ++n) _Pragma("unroll") for (int k = 0; k < 2; ++k) dst[n][k] = *(const LAS bf16x8*)(lds + GP_SB(b, h) + boff + n * 2048 + k * 1024); } while (0)
#define GP_MMA(ai, bj, At, Bt) do { __builtin_amdgcn_s_setprio(1); _Pragma("unroll") for (int m = 0; m < 4; ++m) _Pragma("unroll") for (int n = 0; n < 2; ++n) _Pragma("unroll") for (int k = 0; k < 2; ++k) \
        acc[ai][bj][m][n] = __builtin_amdgcn_mfma_f32_16x16x32_bf16(Bt[n][k], At[m][k], acc[ai][bj][m][n], 0, 0, 0); __builtin_amdgcn_s_setprio(0); } while (0)
#define GP_WAIT_V(n) asm volatile("s_waitcnt vmcnt(" #n ")" ::: "memory")
#define GP_WAIT_L(n) asm volatile("s_waitcnt lgkmcnt(" #n ")" ::: "memory")
#define GP_BAR __builtin_amdgcn_s_barrier()
#define GP_SCHED __builtin_amdgcn_sched_barrier(0)
    Unit cur, nxt; int ui = 0;
    if (!S.next(0, cur)) return;
    f32x4 acc[2][2][4][2];
#pragma unroll
    for (int a = 0; a < 2; ++a)
#pragma unroll
        for (int b = 0; b < 2; ++b)
#pragma unroll
            for (int m = 0; m < 4; ++m)
#pragma unroll
                for (int n = 0; n < 2; ++n) acc[a][b][m][n] = (f32x4){0.f, 0.f, 0.f, 0.f};
    bf16x8 At[4][2], B0[2][2], B1[2][2];
    if (GATHER) S.lane_off(cur, cvo);
    const char* cA = cur.A; const char* cB = cur.B;
    GP_STAGE_B(GP_SB(0, 0), cB, 0); GP_STAGE_A(GP_SA(0, 0), cA, 0, false); GP_STAGE_B(GP_SB(0, 1), cB, 1); GP_STAGE_A(GP_SA(0, 1), cA, 1, false);
    if (wr == 1) GP_BAR;
    GP_WAIT_V(4); GP_BAR;
    GP_STAGE_B(GP_SB(1, 0), cB + kstep, 0); GP_STAGE_A(GP_SA(1, 0), cA + kstep, 0, false); GP_STAGE_B(GP_SB(1, 1), cB + kstep, 1);
    GP_WAIT_V(6); GP_BAR;
    for (;;) {
        const bool has_next = S.next(ui + 1, nxt);
        if (GATHER && has_next) S.lane_off(nxt, nvo);
        const char* nA = has_next ? nxt.A : cA; const char* nB = has_next ? nxt.B : cB;
        for (int t = 0; t < nt; t += 2) {
            const bool last = (t == nt - 2);
            const bool un = last && has_next;
            const char* a1 = cA + (size_t)(t + 1) * kstep;
            const char* a2 = last ? nA : cA + (size_t)(t + 2) * kstep; const char* b2 = last ? nB : cB + (size_t)(t + 2) * kstep;
            const char* a3 = a2 + kstep; const char* b3 = b2 + kstep;
            GP_LDB(B0, 0, 0); GP_SCHED; GP_LDA(At, 0, 0); GP_STAGE_A(GP_SA(1, 1), a1, 1, false);
            GP_WAIT_L(8); GP_BAR; GP_WAIT_L(0); GP_MMA(0, 0, At, B0); GP_BAR; GP_SCHED;
            GP_LDB(B1, 0, 1); GP_STAGE_B(GP_SB(0, 0), b2, 0);
            GP_BAR; GP_WAIT_L(0); GP_MMA(0, 1, At, B1); GP_BAR;
            GP_LDA(At, 0, 1); GP_STAGE_A(GP_SA(0, 0), a2, 0, un);
            GP_BAR; GP_WAIT_L(0); GP_MMA(1, 0, At, B0); GP_BAR; GP_SCHED;
            GP_STAGE_B(GP_SB(0, 1), b2, 1);
            GP_WAIT_V(6); GP_BAR; GP_MMA(1, 1, At, B1); GP_BAR;
            GP_LDB(B0, 1, 0); GP_SCHED; GP_LDA(At, 1, 0); GP_STAGE_A(GP_SA(0, 1), a2, 1, un);
            GP_WAIT_L(8); GP_BAR; GP_WAIT_L(0); GP_MMA(0, 0, At, B0); GP_BAR; GP_SCHED;
            GP_LDB(B1, 1, 1); GP_STAGE_B(GP_SB(1, 0), b3, 0);
            GP_BAR; GP_WAIT_L(0); GP_MMA(0, 1, At, B1); GP_BAR;
            GP_LDA(At, 1, 1); GP_STAGE_A(GP_SA(1, 0), a3, 0, un);
            GP_BAR; GP_WAIT_L(0); GP_MMA(1, 0, At, B0); GP_BAR; GP_SCHED;
            GP_STAGE_B(GP_SB(1, 1), b3, 1);
            GP_WAIT_V(6); GP_BAR; GP_MMA(1, 1, At, B1); GP_BAR;
        }
        E(acc, cur, wr, wc, fr, fq);
        if (!has_next) break;
#pragma unroll
        for (int a = 0; a < 2; ++a)
#pragma unroll
            for (int b = 0; b < 2; ++b)
#pragma unroll
                for (int m = 0; m < 4; ++m)
#pragma unroll
                    for (int n = 0; n < 2; ++n) acc[a][b][m][n] = (f32x4){0.f, 0.f, 0.f, 0.f};
        cur = nxt; cA = nA; cB = nB; ++ui;
        if (GATHER) { cvo[0][0] = nvo[0][0]; cvo[0][1] = nvo[0][1]; cvo[1][0] = nvo[1][0]; cvo[1][1] = nvo[1][1]; }
    }
    GP_WAIT_V(0);
    if (wr == 0) GP_BAR;
    GP_BAR;
#undef GP_SA
#undef GP_SB
#undef GP_GLDS
#undef GP_STAGE_A
#undef GP_STAGE_B
#undef GP_LDA
#undef GP_LDB
#undef GP_MMA
#undef GP_WAIT_V
#undef GP_WAIT_L
#undef GP_BAR
#undef GP_SCHED
}

struct EpiF32 {
    float* C; int ldc;
    __device__ __forceinline__ void operator()(const f32x4 (&acc)[2][2][4][2], const Unit& u, int wr, int wc, int fr, int fq) const {
        const int row0 = u.r0 + wr * 64 + fr, col0 = u.c0 + wc * 32 + 4 * fq;
#pragma unroll
        for (int ai = 0; ai < 2; ++ai)
#pragma unroll
            for (int m = 0; m < 4; ++m) { float* rowp = C + (size_t)(row0 + ai * HALF + m * 16) * ldc + col0;
#pragma unroll
                for (int bj = 0; bj < 2; ++bj)
#pragma unroll
                    for (int n = 0; n < 2; ++n) *(f32x4*)(rowp + bj * HALF + n * 16) = acc[ai][bj][m][n];
                __builtin_amdgcn_sched_barrier(0); }
    }
};
struct EpiBf16 {
    bf16_t* O; int ldc;
    __device__ __forceinline__ void operator()(const f32x4 (&acc)[2][2][4][2], const Unit& u, int wr, int wc, int fr, int fq) const {
        const int row0 = u.r0 + wr * 64 + fr, col0 = u.c0 + wc * 32 + 8 * fq;
#pragma unroll
        for (int ai = 0; ai < 2; ++ai)
#pragma unroll
            for (int m = 0; m < 4; ++m) { bf16_t* rowp = O + (size_t)(row0 + ai * HALF + m * 16) * ldc + col0;
#pragma unroll
                for (int bj = 0; bj < 2; ++bj) { const f32x4 v0 = acc[ai][bj][m][0], v1 = acc[ai][bj][m][1];
                    u32x4 w; w.x = cvt_pk_bf16(v0[0], v0[1]); w.y = cvt_pk_bf16(v0[2], v0[3]); w.z = cvt_pk_bf16(v1[0], v1[1]); w.w = cvt_pk_bf16(v1[2], v1[3]);
                    *(u32x4*)(rowp + bj * HALF) = w; }
                __builtin_amdgcn_sched_barrier(0); }
    }
};
}


typedef float f32x4_l __attribute__((ext_vector_type(4)));
__device__ __forceinline__ void stage_gate_w(KP p, int e, LAS float* wl) {
    const int tid = opaque_tid();
    const float* wg = p->in[I_EWIN] + (size_t)e * 1024 * EVEN_N + 1536;
#pragma unroll
    for (int i = 0; i < 8; ++i) { const int idx = tid + 512 * i, d = idx >> 2, j4 = idx & 3; const float4 w = *(const float4*)(wg + (size_t)d * EVEN_N + j4 * 4); *(LAS f32x4_l*)(wl + d * 16 + j4 * 4) = (f32x4_l){w.x, w.y, w.z, w.w}; }
    __syncthreads();
}
__device__ __forceinline__ void ph_modin(KP p, int l, int bid, int nb) {
    const int tid = opaque_tid(), lane = tid & 63, wv = tid >> 6;
    const bool even = (l & 1) == 0;
    bf16_t* U = (bf16_t*)(p->ws + OFF_U);
    float* G = (float*)(p->ws + OFF_G);
    LAS float* wl = (LAS float*)smraw_base();
    if (even) stage_gate_w(p, l >> 1, wl);
    #pragma unroll 1
    for (int tok = bid * 8 + wv; tok < NT; tok += nb * 8) {
        const float* h = hrow(p, tok);
        const float* m = modrow(p, l, tok);
        float ga[16];
#pragma unroll
        for (int j = 0; j < 16; ++j) ga[j] = 0.f;
#pragma unroll
        for (int c = 0; c < 4; ++c) {
            const int d = 4 * (lane + 64 * c);
            const float4 hv = *(const float4*)(h + d), sh = *(const float4*)(m + d), sc = *(const float4*)(m + 1024 + d);
            const float u0 = hv.x * (1.f + sc.x) + sh.x, u1 = hv.y * (1.f + sc.y) + sh.y, u2 = hv.z * (1.f + sc.z) + sh.z, u3 = hv.w * (1.f + sc.w) + sh.w;
            *(uint2*)(U + (size_t)tok * DM + d) = make_uint2(cvt_pk_bf16(u0, u1), cvt_pk_bf16(u2, u3));
            if (even) {
                const float uu[4] = {u0, u1, u2, u3};
#pragma unroll
                for (int q = 0; q < 4; ++q) {
#pragma unroll
                    for (int j4 = 0; j4 < 4; ++j4) { const f32x4_l w = *(const LAS f32x4_l*)(wl + (d + q) * 16 + j4 * 4); ga[4 * j4] += uu[q] * w[0]; ga[4 * j4 + 1] += uu[q] * w[1]; ga[4 * j4 + 2] += uu[q] * w[2]; ga[4 * j4 + 3] += uu[q] * w[3]; }
                }
                __builtin_amdgcn_sched_barrier(0);
            }
        }
        if (even) {
            float mine = 0.f;
#pragma unroll
            for (int j = 0; j < 16; ++j) { const float s = wave_sum(ga[j]); if (lane == j) mine = s; }
            if (lane < 16) G[(size_t)tok * 16 + lane] = mine;
        }
    }
}

__device__ __forceinline__ void ph_gemm_in(KP p, int l, int bid, int nb, LAS unsigned char* lds) {
    const int N = ((l & 1) == 0) ? EVEN_LD : ODD_LD;
    gp::DenseSched S; S.init(p->ws + OFF_U, p->ws + OFF_WIN, NT, N, 1024, nb, bid);
    gp::EpiBf16 E{(bf16_t*)(p->ws + OFF_BIG), N};
    gp::gemm_phase<false, true>(lds, 1024, S, E);
}
__device__ __forceinline__ void ph_gemm_out(KP p, int l, int bid, int nb, LAS unsigned char* lds) {
    gp::DenseSched S; S.init(p->ws + OFF_U, p->ws + OFF_WOUT, NT, 1024, 1024, nb, bid);
    gp::EpiBf16 E{(bf16_t*)(p->ws + OFF_BIG), 1024};
    gp::gemm_phase<false, true>(lds, 1024, S, E);
}


namespace sc {
typedef short bf16x8 __attribute__((ext_vector_type(8)));
typedef short bf16x4 __attribute__((ext_vector_type(4)));
typedef float f32x4 __attribute__((ext_vector_type(4)));
#define SC_MFMA(a, b, c) __builtin_amdgcn_mfma_f32_16x16x32_bf16(a, b, c, 0, 0, 0)
__device__ __forceinline__ bf16x8 rd_row(unsigned img, int row, int stride, int k0) { return *(const LAS bf16x8*)(size_t)(img + (unsigned)(row * stride + k0 * 2)); }
__device__ __forceinline__ bf16x8 rd_tr(unsigned img, int k0, int n0, int stride, int lane) {
    const int g = lane >> 4, i = lane & 15;
    const unsigned a0 = img + (unsigned)((k0 + 8 * g + (i >> 2)) * stride + (n0 + 4 * (i & 3)) * 2), a1 = a0 + 4u * (unsigned)stride;
    bf16x4 lo, hi;
    asm volatile("ds_read_b64_tr_b16 %0, %2\n\tds_read_b64_tr_b16 %1, %3\n\ts_waitcnt lgkmcnt(0)" : "=&v"(lo), "=&v"(hi) : "v"(a0), "v"(a1) : "memory");
    return (bf16x8){lo[0], lo[1], lo[2], lo[3], hi[0], hi[1], hi[2], hi[3]};
}
typedef unsigned u32x2_ __attribute__((ext_vector_type(2)));
typedef unsigned u32x4_ __attribute__((ext_vector_type(4)));
__device__ __forceinline__ unsigned tr_addr(unsigned img, int k0, int n0, int stride, int lane) { const int g = lane >> 4, i = lane & 15; return img + (unsigned)((k0 + 8 * g + (i >> 2)) * stride + (n0 + 4 * (i & 3)) * 2); }
__device__ __forceinline__ void rd_tr5(const unsigned (&a0)[5], const unsigned (&s4)[5], bf16x8 (&o)[5]) {
    bf16x4 l0, h0, l1, h1, l2, h2, l3, h3, l4, h4;
    asm volatile("ds_read_b64_tr_b16 %0, %10\n\tds_read_b64_tr_b16 %1, %11\n\tds_read_b64_tr_b16 %2, %12\n\tds_read_b64_tr_b16 %3, %13\n\tds_read_b64_tr_b16 %4, %14\n\t"
                 "ds_read_b64_tr_b16 %5, %15\n\tds_read_b64_tr_b16 %6, %16\n\tds_read_b64_tr_b16 %7, %17\n\tds_read_b64_tr_b16 %8, %18\n\tds_read_b64_tr_b16 %9, %19\n\ts_waitcnt lgkmcnt(0)"
                 : "=&v"(l0), "=&v"(h0), "=&v"(l1), "=&v"(h1), "=&v"(l2), "=&v"(h2), "=&v"(l3), "=&v"(h3), "=&v"(l4), "=&v"(h4)
                 : "v"(a0[0]), "v"(a0[0] + s4[0]), "v"(a0[1]), "v"(a0[1] + s4[1]), "v"(a0[2]), "v"(a0[2] + s4[2]), "v"(a0[3]), "v"(a0[3] + s4[3]), "v"(a0[4]), "v"(a0[4] + s4[4]) : "memory");
    o[0] = (bf16x8){l0[0], l0[1], l0[2], l0[3], h0[0], h0[1], h0[2], h0[3]}; o[1] = (bf16x8){l1[0], l1[1], l1[2], l1[3], h1[0], h1[1], h1[2], h1[3]};
    o[2] = (bf16x8){l2[0], l2[1], l2[2], l2[3], h2[0], h2[1], h2[2], h2[3]}; o[3] = (bf16x8){l3[0], l3[1], l3[2], l3[3], h3[0], h3[1], h3[2], h3[3]};
    o[4] = (bf16x8){l4[0], l4[1], l4[2], l4[3], h4[0], h4[1], h4[2], h4[3]};
}
__device__ __forceinline__ void st8(unsigned addr, uint2 v) { *(LAS u32x2_*)(size_t)addr = (u32x2_){v.x, v.y}; }
__device__ __forceinline__ void st16(unsigned addr, uint4 v) { *(LAS u32x4_*)(size_t)addr = (u32x4_){v.x, v.y, v.z, v.w}; }
__device__ __forceinline__ float scan_add64(float v, int lane) {
#pragma unroll
    for (int o = 1; o < 64; o <<= 1) { const float t = SHU(v, o); if (lane >= o) v += t; }
    return v;
}
__device__ __forceinline__ float scan_max64(float v, int lane) {
#pragma unroll
    for (int o = 1; o < 64; o <<= 1) { const float t = SHU(v, o); if (lane >= o) v = fmaxf(v, t); }
    return v;
}

template <int MODE>
__device__ __forceinline__ void scan_item(KP p, int l, int b, int h, int dir, int vs) {
    constexpr int CS = (MODE == 1) ? 32 : 64, DK = (MODE == 0) ? 64 : 128, EXT = (MODE == 0) ? 1 : 0;
    constexpr int QS = (DK + 8) * 2, VS = (64 + 16 * EXT + 8) * 2, SS = (CS + 8) * 2, NVR = 64 + 16 * EXT;
    constexpr int NCH = (CTXL + SEQ) / CS;
    constexpr int LD = (MODE == 2) ? ODD_LD : EVEN_LD;
    constexpr unsigned O_QA = 0, O_KA = O_QA + CS * QS, O_QB = O_KA + CS * QS, O_KW = O_QB + (MODE == 1 ? CS * QS : 0), O_V = O_KW + CS * QS,
                       O_SSC = O_V + CS * VS, O_ST = O_SSC + CS * SS, O_DKV = O_ST + 2 * NVR * QS, O_END = O_DKV + 512;
    static_assert(O_END <= 131072, "scan LDS");
    const int tid = opaque_tid(), lane = tid & 63, wv = __builtin_amdgcn_readfirstlane(tid >> 6), r16 = lane & 15, q4 = lane >> 4;
    const unsigned L0 = (unsigned)(size_t)smraw_base();
    const bf16_t* P = (const bf16_t*)(p->ws + OFF_BIG);
    bf16_t* HXo = (bf16_t*)(p->ws + OFF_AUX) + (size_t)dir * NT * 1024;
    const int e2 = l >> 1;
    const int cQ = (MODE == 0) ? E_MQ + h * 64 : (MODE == 1) ? E_HQ + h * 128 : 1536 + h * 128;
    const int cK = (MODE == 0) ? E_MK + h * 64 : (MODE == 1) ? (dir ? E_HFB : E_HFF) + h * 128 : 2048 + h * 128;
    const int cV = (MODE == 0) ? E_MV + h * 128 + vs * 64 : (MODE == 1) ? E_HI + h * 128 + vs * 64 : 2560 + h * 128 + vs * 64;
    const int cO = (MODE == 0) ? h * 128 + vs * 64 : 512 + h * 128 + vs * 64;
    const int lt = (MODE == 1) ? (tid & 31) : (tid >> 3);
    const int lj = (MODE == 0) ? (tid & 7) : (MODE == 1) ? (tid >> 5) : ((tid >> 2) & 1) * 8 + (tid & 3);
    const int vt_ = tid >> 3, vj = tid & 7;
    float lbv[8]; float gbi = 0.f, gbf = 0.f, lg = 0.f;
    if (MODE == 1) {
        const float* lbp = (const float*)(p->ws + OFF_LB) + e2 * 512 + h * 128 + lj * 8;
#pragma unroll
        for (int i = 0; i < 8; ++i) lbv[i] = lbp[i];
    } else {
#pragma unroll
        for (int i = 0; i < 8; ++i) lbv[i] = 0.f;
    }
    if (MODE == 0) { const float* gb = p->in[I_MGB] + e2 * 16; gbi = gb[(dir ? 2 : 0) * 4 + h]; gbf = gb[(dir ? 3 : 1) * 4 + h]; }
    if (MODE == 2) lg = p->in[I_RLD][e2 * 8 + dir * 4 + h];
    const float* G = (const float*)(p->ws + OFF_G);
    const float* ropet = (const float*)(p->ws + OFF_ROPE);
    unsigned oz = 0u; asm volatile("" : "+v"(oz));
    for (unsigned o = tid * 16; o < 2u * NVR * QS; o += 512 * 16) st16(L0 + O_ST + o, make_uint4(oz, oz, oz, oz));
    if (EXT) { if (tid < CS) { st16(L0 + O_V + tid * VS + 128, make_uint4(0x3f80u | oz, oz, oz, oz)); st16(L0 + O_V + tid * VS + 144, make_uint4(oz, oz, oz, oz)); } }
    f32x4 sacc[4];
#pragma unroll
    for (int i = 0; i < 4; ++i) sacc[i] = (f32x4){0.f, 0.f, 0.f, 0.f};
    float m_in = -1e30f;
    struct Raw { uint4 rq0, rq1, rk0, rk1, rv; float rg0, rg1; };
    Raw RA, RB;
    RA.rq1 = make_uint4(0u, 0u, 0u, 0u); RA.rk1 = RA.rq1; RA.rv = RA.rq1; RA.rg0 = 0.f; RA.rg1 = 0.f; RB = RA;
    auto load_chunk = [&](Raw& R, int c) {
        const int i0 = c * CS;
        const int tq = scan_tok(b, i0 + lt, dir);
        const bf16_t* pr = P + (size_t)tq * LD;
        R.rq0 = *(const uint4*)(pr + cQ + lj * 8); R.rk0 = *(const uint4*)(pr + cK + lj * 8);
        if (MODE == 2) { R.rq1 = *(const uint4*)(pr + cQ + lj * 8 + 32); R.rk1 = *(const uint4*)(pr + cK + lj * 8 + 32); }
        if (MODE != 1 || tid < 256) { const int tv = scan_tok(b, i0 + vt_, dir); R.rv = *(const uint4*)(P + (size_t)tv * LD + cV + vj * 8); }
        if (MODE == 0) { const int tg = scan_tok(b, i0 + lane, dir); R.rg0 = G[(size_t)tg * 16 + (dir ? 8 : 0) + h]; R.rg1 = G[(size_t)tg * 16 + (dir ? 12 : 4) + h]; }
    };
    constexpr int PD = (MODE == 2) ? 1 : 2;
    load_chunk(RA, 0); if (PD == 2) load_chunk(RB, 1);
    auto chunk = [&](const int c, Raw& R) {
        const uint4 rq0 = R.rq0, rq1 = R.rq1, rk0 = R.rk0, rk1 = R.rk1, rv = R.rv; const float rg0 = R.rg0, rg1 = R.rg1;
        const unsigned ST_R = L0 + O_ST + (unsigned)(c & 1) * NVR * QS, ST_W = L0 + O_ST + (unsigned)((c + 1) & 1) * NVR * QS;
        float sp = 1.f;
        float v_u = 0.f, v_M = 0.f, v_e = 1.f, v_low = 0.f, v_w = 1.f;
        if (MODE == 0) {
            const float ig = rg0 + gbi, fg = rg1 + gbf;
            const float lf = fminf(fg, 0.f) - flog(1.f + fexp(-fabsf(fg)));
            const float bb = scan_add64(lf, lane);
            const float g = SHI(bb, 63);
            v_u = ig - bb;
            const float cu = scan_max64(v_u, lane);
            v_M = fmaxf(m_in, cu);
            const float m_new = fmaxf(g + m_in, g + SHI(cu, 63));
            sp = fexp(g + m_in - m_new);
            v_w = fexp(g + v_u - m_new);
            v_e = fexp(m_in - v_M);
            v_low = fexp(-(bb + v_M));
            m_in = m_new;
            st16(L0 + O_QA + lt * QS + lj * 16, rq0);
            st16(L0 + O_KA + lt * QS + lj * 16, rk0);
            const float wr = SHI(v_w, lt);
            uint4 kw; kw.x = cvt_pk_bf16(bflo(rk0.x) * wr, bfhi(rk0.x) * wr); kw.y = cvt_pk_bf16(bflo(rk0.y) * wr, bfhi(rk0.y) * wr);
            kw.z = cvt_pk_bf16(bflo(rk0.z) * wr, bfhi(rk0.z) * wr); kw.w = cvt_pk_bf16(bflo(rk0.w) * wr, bfhi(rk0.w) * wr);
            st16(L0 + O_KW + lt * QS + lj * 16, kw);
            st16(L0 + O_V + vt_ * VS + vj * 16, rv);
        } else if (MODE == 2) {
            sp = fexp(64.f * lg);
            const bool lat = c >= CTXL / CS;
            float q[16], k[16];
            const unsigned qa[8] = {rq0.x, rq0.y, rq0.z, rq0.w, rq1.x, rq1.y, rq1.z, rq1.w}, ka[8] = {rk0.x, rk0.y, rk0.z, rk0.w, rk1.x, rk1.y, rk1.z, rk1.w};
#pragma unroll
            for (int i = 0; i < 8; ++i) { q[2 * i] = bflo(qa[i]); q[2 * i + 1] = bfhi(qa[i]); k[2 * i] = bflo(ka[i]); k[2 * i + 1] = bfhi(ka[i]); }
            if (lat) {
                const int tq = scan_tok(b, c * CS + lt, dir), tt = tq & (SEQ - 1);
                const int pos = ((tid >> 2) & 1) ? (tt & 63) : (tt >> 6);
                const float2* rt = (const float2*)ropet + pos * 32 + (tid & 3) * 8;
#pragma unroll
                for (int i = 0; i < 8; ++i) {
                    const float2 cs2 = rt[i];
                    const float q1 = q[i], q2 = q[8 + i], k1 = k[i], k2 = k[8 + i];
                    q[i] = q1 * cs2.x - q2 * cs2.y; q[8 + i] = q1 * cs2.y + q2 * cs2.x;
                    k[i] = k1 * cs2.x - k2 * cs2.y; k[8 + i] = k1 * cs2.y + k2 * cs2.x;
                }
            }
            const float wr = 0.08838834764831845f * fexp((float)(63 - lt) * lg);
            uint4 o0, o1, w0, w1, x0, x1;
            o0.x = cvt_pk_bf16(q[0], q[1]); o0.y = cvt_pk_bf16(q[2], q[3]); o0.z = cvt_pk_bf16(q[4], q[5]); o0.w = cvt_pk_bf16(q[6], q[7]);
            o1.x = cvt_pk_bf16(q[8], q[9]); o1.y = cvt_pk_bf16(q[10], q[11]); o1.z = cvt_pk_bf16(q[12], q[13]); o1.w = cvt_pk_bf16(q[14], q[15]);
            w0.x = cvt_pk_bf16(k[0], k[1]); w0.y = cvt_pk_bf16(k[2], k[3]); w0.z = cvt_pk_bf16(k[4], k[5]); w0.w = cvt_pk_bf16(k[6], k[7]);
            w1.x = cvt_pk_bf16(k[8], k[9]); w1.y = cvt_pk_bf16(k[10], k[11]); w1.z = cvt_pk_bf16(k[12], k[13]); w1.w = cvt_pk_bf16(k[14], k[15]);
            x0.x = cvt_pk_bf16(k[0] * wr, k[1] * wr); x0.y = cvt_pk_bf16(k[2] * wr, k[3] * wr); x0.z = cvt_pk_bf16(k[4] * wr, k[5] * wr); x0.w = cvt_pk_bf16(k[6] * wr, k[7] * wr);
            x1.x = cvt_pk_bf16(k[8] * wr, k[9] * wr); x1.y = cvt_pk_bf16(k[10] * wr, k[11] * wr); x1.z = cvt_pk_bf16(k[12] * wr, k[13] * wr); x1.w = cvt_pk_bf16(k[14] * wr, k[15] * wr);
            st16(L0 + O_QA + lt * QS + lj * 16, o0); st16(L0 + O_QA + lt * QS + lj * 16 + 64, o1);
            st16(L0 + O_KA + lt * QS + lj * 16, w0); st16(L0 + O_KA + lt * QS + lj * 16 + 64, w1);
            st16(L0 + O_KW + lt * QS + lj * 16, x0); st16(L0 + O_KW + lt * QS + lj * 16 + 64, x1);
            st16(L0 + O_V + vt_ * VS + vj * 16, rv);
        } else {
            const unsigned qa[4] = {rq0.x, rq0.y, rq0.z, rq0.w}, fa[4] = {rk0.x, rk0.y, rk0.z, rk0.w};
            float qv[8], kk[8], A[8];
#pragma unroll
            for (int i = 0; i < 8; ++i) {
                const float qr = (i & 1) ? bfhi(qa[i >> 1]) : bflo(qa[i >> 1]), fr = (i & 1) ? bfhi(fa[i >> 1]) : bflo(fa[i >> 1]);
                const float f = lbv[i] + (1.f - lbv[i]) * fsigmoid(fr);
                qv[i] = fsilu(qr); kk[i] = 1.f - f; A[i] = flog(f);
            }
#pragma unroll
            for (int o = 1; o < 32; o <<= 1)
#pragma unroll
                for (int i = 0; i < 8; ++i) { const float t = SHU(A[i], o); if (lt >= o) A[i] += t; }
            float qa_[8], qb_[8], ka_[8], kw_[8];
#pragma unroll
            for (int i = 0; i < 8; ++i) {
                const float am = SHI32(A[i], 15), ae = SHI32(A[i], 31);
                qa_[i] = qv[i] * fexp(A[i] - am); qb_[i] = qv[i] * fexp(A[i]); ka_[i] = kk[i] * fexp(am - A[i]); kw_[i] = kk[i] * fexp(ae - A[i]);
                if (lt == 31) *(LAS float*)(size_t)(L0 + O_DKV + (lj * 8 + i) * 4) = fexp(ae);
            }
            uint4 w;
            w.x = cvt_pk_bf16(qa_[0], qa_[1]); w.y = cvt_pk_bf16(qa_[2], qa_[3]); w.z = cvt_pk_bf16(qa_[4], qa_[5]); w.w = cvt_pk_bf16(qa_[6], qa_[7]); st16(L0 + O_QA + lt * QS + lj * 16, w);
            w.x = cvt_pk_bf16(qb_[0], qb_[1]); w.y = cvt_pk_bf16(qb_[2], qb_[3]); w.z = cvt_pk_bf16(qb_[4], qb_[5]); w.w = cvt_pk_bf16(qb_[6], qb_[7]); st16(L0 + O_QB + lt * QS + lj * 16, w);
            w.x = cvt_pk_bf16(ka_[0], ka_[1]); w.y = cvt_pk_bf16(ka_[2], ka_[3]); w.z = cvt_pk_bf16(ka_[4], ka_[5]); w.w = cvt_pk_bf16(ka_[6], ka_[7]); st16(L0 + O_KA + lt * QS + lj * 16, w);
            w.x = cvt_pk_bf16(kw_[0], kw_[1]); w.y = cvt_pk_bf16(kw_[2], kw_[3]); w.z = cvt_pk_bf16(kw_[4], kw_[5]); w.w = cvt_pk_bf16(kw_[6], kw_[7]); st16(L0 + O_KW + lt * QS + lj * 16, w);
            if (tid < 256) st16(L0 + O_V + vt_ * VS + vj * 16, rv);
        }
        __syncthreads();
        if (c + PD < NCH) load_chunk(R, c + PD);
        {
            constexpr int NT1 = CS / 16;
            const bool act = (MODE == 1) ? (wv < 4) : true;
            const int tb = (MODE == 1) ? (wv & 1) : (wv & 3);
#pragma unroll
            for (int u2 = 0; u2 < ((MODE == 1) ? 1 : 2); ++u2) {
                const int sb = (MODE == 1) ? (wv >> 1) : 2 * (wv >> 2) + u2;
                if (act) {
                    f32x4 d = (f32x4){0.f, 0.f, 0.f, 0.f};
                    if (sb <= tb) {
#pragma unroll
                        for (int kk2 = 0; kk2 < DK / 32; ++kk2)
                            d = SC_MFMA(rd_row(L0 + O_KA, sb * 16 + r16, QS, kk2 * 32 + q4 * 8), rd_row(L0 + O_QA, tb * 16 + r16, QS, kk2 * 32 + q4 * 8), d);
                        const int t = tb * 16 + r16, s0 = sb * 16 + q4 * 4;
                        if (MODE == 0) {
                            const float Mt = SHI(v_M, t);
#pragma unroll
                            for (int jj = 0; jj < 4; ++jj) { const float us = SHI(v_u, s0 + jj); d[jj] = (s0 + jj <= t) ? d[jj] * 0.125f * fexp(us - Mt) : 0.f; }
                        } else if (MODE == 2) {
#pragma unroll
                            for (int jj = 0; jj < 4; ++jj) d[jj] = (s0 + jj <= t) ? d[jj] * 0.08838834764831845f * fexp((float)(t - s0 - jj) * lg) : 0.f;
                        } else {
#pragma unroll
                            for (int jj = 0; jj < 4; ++jj) d[jj] = (s0 + jj <= t) ? d[jj] : 0.f;
                        }
                    }
                    st8(L0 + O_SSC + (tb * 16 + r16) * SS + (sb * 16 + q4 * 4) * 2, make_uint2(cvt_pk_bf16(d[0], d[1]), cvt_pk_bf16(d[2], d[3])));
                }
            }
            (void)NT1;
        }
        __syncthreads();
        {
            const int tb = (MODE == 1) ? (wv & 1) : (wv & 3);
            const int t = tb * 16 + r16;
            const int tok = scan_tok(b, c * CS + t, dir);
            constexpr int NV = (MODE == 1) ? 1 : 2;
            f32x4 oi[NV + EXT], oo[NV + EXT];
#pragma unroll
            for (int u2 = 0; u2 < NV + EXT; ++u2) {
                const int vt = (u2 == NV) ? 4 : ((MODE == 1) ? (wv >> 1) : 2 * (wv >> 2) + u2);
                f32x4 a1 = (f32x4){0.f, 0.f, 0.f, 0.f}, a2 = a1;
#pragma unroll
                for (int sb2 = 0; sb2 < CS / 32; ++sb2)
                    a1 = SC_MFMA(rd_tr(L0 + O_V, sb2 * 32, vt * 16, VS, lane), rd_row(L0 + O_SSC, t, SS, sb2 * 32 + q4 * 8), a1);
#pragma unroll
                for (int kk2 = 0; kk2 < DK / 32; ++kk2)
                    a2 = SC_MFMA(rd_row(ST_R, vt * 16 + r16, QS, kk2 * 32 + q4 * 8), rd_row(L0 + ((MODE == 1) ? O_QB : O_QA), t, QS, kk2 * 32 + q4 * 8), a2);
                oi[u2] = a1; oo[u2] = a2;
            }
            float den = 1.f, ei = 1.f;
            if (MODE == 0) {
                ei = 0.125f * SHI(v_e, t);
                const float dsum = oi[NV][0] + ei * oo[NV][0];
                const float dd = SHI(dsum, r16);
                den = 1.f / fmaxf(fabsf(dd), SHI(v_low, t));
            } else if (MODE == 2) {
                ei = fexp((float)(t + 1) * lg);
            }
#pragma unroll
            for (int u2 = 0; u2 < NV; ++u2) {
                const int vt = (MODE == 1) ? (wv >> 1) : 2 * (wv >> 2) + u2;
                float o[4];
#pragma unroll
                for (int jj = 0; jj < 4; ++jj) o[jj] = (oi[u2][jj] + ei * oo[u2][jj]) * den;
                *(uint2*)(HXo + (size_t)tok * 1024 + cO + vt * 16 + q4 * 4) = make_uint2(cvt_pk_bf16(o[0], o[1]), cvt_pk_bf16(o[2], o[3]));
            }
        }
        {
            constexpr int NS = (MODE == 0) ? 3 : 4;
            const int kt = (MODE == 0) ? (wv & 3) : wv;
            float dk[4] = {sp, sp, sp, sp};
            if (MODE == 1) { const f32x4 dv = *(const LAS f32x4*)(size_t)(L0 + O_DKV + (kt * 16 + q4 * 4) * 4); dk[0] = dv[0]; dk[1] = dv[1]; dk[2] = dv[2]; dk[3] = dv[3]; }
            f32x4 a[NS];
#pragma unroll
            for (int u2 = 0; u2 < NS; ++u2) { a[u2] = sacc[u2];
#pragma unroll
                for (int jj = 0; jj < 4; ++jj) a[u2][jj] *= dk[jj]; }
#pragma unroll
            for (int sb2 = 0; sb2 < CS / 32; ++sb2) {
                unsigned ta[5], ts[5]; bf16x8 ops[5];
                ta[0] = tr_addr(L0 + O_KW, sb2 * 32, kt * 16, QS, lane); ts[0] = 4u * QS;
#pragma unroll
                for (int u2 = 0; u2 < 4; ++u2) {
                    const int vt = (MODE == 0) ? ((u2 >= 2) ? 4 : 2 * (wv >> 2) + u2) : u2;
                    ta[1 + u2] = tr_addr(L0 + O_V, sb2 * 32, vt * 16, VS, lane); ts[1 + u2] = 4u * VS;
                }
                rd_tr5(ta, ts, ops);
#pragma unroll
                for (int u2 = 0; u2 < NS; ++u2) a[u2] = SC_MFMA(ops[0], ops[1 + u2], a[u2]);
            }
#pragma unroll
            for (int u2 = 0; u2 < NS; ++u2) {
                const int vt = (MODE == 0) ? ((u2 == 2) ? 4 : 2 * (wv >> 2) + u2) : u2;
                sacc[u2] = a[u2];
                st8(ST_W + (vt * 16 + r16) * QS + (kt * 16 + q4 * 4) * 2, make_uint2(cvt_pk_bf16(a[u2][0], a[u2][1]), cvt_pk_bf16(a[u2][2], a[u2][3])));
            }
        }
        __syncthreads();
    };
#pragma unroll 1
    for (int c = 0; c < NCH; c += 2) { chunk(c, RA); if (PD == 2) chunk(c + 1, RB); else chunk(c + 1, RA); }
}
}

__device__ __forceinline__ void ph_scan_even2(KP p, int l, int bid, int nb) {
#pragma unroll 1
    for (int item = bid; item < 256; item += nb) {
        const int kind = item >> 7, b = (item >> 4) & 7, h = (item >> 2) & 3, dir = (item >> 1) & 1, vs = item & 1;
        if (kind == 0) sc::scan_item<0>(p, l, b, h, dir, vs); else sc::scan_item<1>(p, l, b, h, dir, vs);
        __syncthreads();
    }
}
__device__ __forceinline__ void ph_scan_odd2(KP p, int l, int bid, int nb) {
#pragma unroll 1
    for (int item = bid; item < 128; item += nb) {
        const int b = (item >> 4) & 7, h = (item >> 2) & 3, dir = (item >> 1) & 1, vs = item & 1;
        sc::scan_item<2>(p, l, b, h, dir, vs);
        __syncthreads();
    }
}

__device__ __forceinline__ void unpack16(const uint4 a, const uint4 b, float (&x)[16]) {
    x[0] = bflo(a.x); x[1] = bfhi(a.x); x[2] = bflo(a.y); x[3] = bfhi(a.y); x[4] = bflo(a.z); x[5] = bfhi(a.z); x[6] = bflo(a.w); x[7] = bfhi(a.w);
    x[8] = bflo(b.x); x[9] = bfhi(b.x); x[10] = bflo(b.y); x[11] = bfhi(b.y); x[12] = bflo(b.z); x[13] = bfhi(b.z); x[14] = bflo(b.w); x[15] = bfhi(b.w);
}
__device__ __forceinline__ float sum8(float v) { v += SHX(v, 1); v += SHX(v, 2); v += SHX(v, 4); return v; }
template <bool MEANSUB, bool SIG>
__device__ __forceinline__ void head_norm_gate16(const bf16_t* h0, const bf16_t* h1, const bf16_t* gp, const float* nw, bf16_t* out) {
    float a[16], b[16], g[16];
    unpack16(*(const uint4*)h0, *(const uint4*)(h0 + 8), a); unpack16(*(const uint4*)h1, *(const uint4*)(h1 + 8), b); unpack16(*(const uint4*)gp, *(const uint4*)(gp + 8), g);
    float s = 0.f;
#pragma unroll
    for (int i = 0; i < 16; ++i) { a[i] += b[i]; s += a[i]; }
    if (MEANSUB) { const float mean = sum8(s) * (1.f / 128.f);
#pragma unroll
        for (int i = 0; i < 16; ++i) a[i] -= mean; }
    float q = 0.f;
#pragma unroll
    for (int i = 0; i < 16; ++i) q += a[i] * a[i];
    const float r = rsqrtf(sum8(q) * (1.f / 128.f) + LN_EPS);
    unsigned w[8];
#pragma unroll
    for (int i = 0; i < 16; i += 2) {
        const float y0 = a[i] * r * nw[i] * (SIG ? sigmoidf_(g[i]) : siluf_(g[i])), y1 = a[i + 1] * r * nw[i + 1] * (SIG ? sigmoidf_(g[i + 1]) : siluf_(g[i + 1]));
        w[i >> 1] = cvt_pk_bf16(y0, y1);
    }
    *(uint4*)out = make_uint4(w[0], w[1], w[2], w[3]); *(uint4*)(out + 8) = make_uint4(w[4], w[5], w[6], w[7]);
}
__device__ __forceinline__ void ph_normgate_even(KP p, int l, int bid, int nb) {
    const int tid = opaque_tid(), lane = tid & 63, wv = tid >> 6;
    const bf16_t* P = (const bf16_t*)(p->ws + OFF_BIG);
    const bf16_t* HX = (const bf16_t*)(p->ws + OFF_AUX);
    const bf16_t* HX1 = HX + (size_t)NT * 1024;
    bf16_t* MIX = (bf16_t*)(p->ws + OFF_U);
    const int e = l >> 1;
    const bool ml = lane < 32;
    const float* nw = ml ? p->in[I_MNW] + e * 512 + 16 * lane : p->in[I_HNW] + e * 512 + 16 * (lane - 32);
    const int gcol = ml ? E_MO + 16 * lane : E_HG + 16 * (lane - 32);
#pragma unroll 1
    for (int tok = bid * 8 + wv; tok < NT; tok += nb * 8) {
        const size_t o = (size_t)tok * 1024 + 16 * lane;
        if (ml) head_norm_gate16<true, true>(HX + o, HX1 + o, P + (size_t)tok * EVEN_LD + gcol, nw, MIX + o);
        else head_norm_gate16<false, false>(HX + o, HX1 + o, P + (size_t)tok * EVEN_LD + gcol, nw, MIX + o);
    }
}

#define OFF_UT   (OFF_AUX + 136 * MiB)
#define OFF_FKS(o) (984 * MiB + (size_t)(o) * 34 * MiB)
#define OFF_ZOT  (OFF_UT + 102 * MiB)

__device__ __forceinline__ void ph_hy_filt2(KP p, int l, int bid, int nb, float* sm, int skip) {
    const int tid = opaque_tid(), o = l >> 1;
    float* zf = sm;
    float* h1 = sm + 1024;
    float* h2 = sm + 2048;
    float* h3 = sm + 3072;
    const float* fw1 = p->in[I_HW1] + o * 33 * 64; const float* fb1 = p->in[I_HB1] + o * 64;
    const float* fw2 = p->in[I_HW2] + o * 64 * 64; const float* fb2 = p->in[I_HB2] + o * 64;
    const float* fw3 = p->in[I_HW3] + o * 64 * 64; const float* fb3 = p->in[I_HB3] + o * 64;
    const float* freq = p->in[I_HFREQ] + o * 64;
    const float* wout = p->in[I_HWOUT] + (size_t)o * 64 * 2048;
    float* FK = (float*)(p->ws + OFF_FKS(o)); float* FKC = FK + (size_t)2 * 512 * 8192;
#pragma unroll 1
    for (int item = bid - skip; item < (SEQ + CTXL) / 16; item += nb - skip) {
        if (item < 0) break;
        const bool isctx = item >= SEQ / 16;
        const int L = isctx ? CTXL : SEQ, pos0 = (isctx ? item - SEQ / 16 : item) * 16;
        __syncthreads();
        if (tid < 16 * 17) {
            const int pp = tid / 17, j = tid % 17, pos = pos0 + pp;
            if (j == 16) zf[pp * 36] = (float)pos / (float)(L - 1);
            else { const float f = 1e-4f + (float)j * ((15.0f - 1e-4f) / 15.0f); const float w = 2.0f * 3.14159265358979323846f * (float)pos / (float)L * f; zf[pp * 36 + 1 + j] = cosf(w); zf[pp * 36 + 17 + j] = sinf(w); }
        }
        __syncthreads();
        const int pp = tid >> 5, u0 = (tid & 31) * 2;
        { float a0 = fb1[u0], a1 = fb1[u0 + 1];
#pragma unroll 1
          for (int k = 0; k < 33; ++k) { const float z = zf[pp * 36 + k]; a0 += z * fw1[k * 64 + u0]; a1 += z * fw1[k * 64 + u0 + 1]; }
          h1[pp * 64 + u0] = sinf(freq[u0] * a0); h1[pp * 64 + u0 + 1] = sinf(freq[u0 + 1] * a1); }
        __syncthreads();
        { float a0 = fb2[u0], a1 = fb2[u0 + 1];
#pragma unroll 4
          for (int k = 0; k < 64; ++k) { const float z = h1[pp * 64 + k]; a0 += z * fw2[k * 64 + u0]; a1 += z * fw2[k * 64 + u0 + 1]; }
          h2[pp * 64 + u0] = sinf(freq[u0] * a0); h2[pp * 64 + u0 + 1] = sinf(freq[u0 + 1] * a1); }
        __syncthreads();
        { float a0 = fb3[u0], a1 = fb3[u0 + 1];
#pragma unroll 4
          for (int k = 0; k < 64; ++k) { const float z = h2[pp * 64 + k]; a0 += z * fw3[k * 64 + u0]; a1 += z * fw3[k * 64 + u0 + 1]; }
          h3[pp * 64 + u0] = sinf(freq[u0] * a0); h3[pp * 64 + u0 + 1] = sinf(freq[u0 + 1] * a1); }
        __syncthreads();
#pragma unroll 1
        for (int r = 0; r < 4; ++r) {
            const int col = tid + 512 * r, c = col & 511, od = col >> 9, order = od >> 1, dirn = od & 1;
            float a[16];
#pragma unroll
            for (int i = 0; i < 16; ++i) a[i] = 0.f;
#pragma unroll 1
            for (int k = 0; k < 64; k += 4) { const float w0 = wout[k * 2048 + col], w1 = wout[(k + 1) * 2048 + col], w2 = wout[(k + 2) * 2048 + col], w3 = wout[(k + 3) * 2048 + col];
#pragma unroll
                for (int i = 0; i < 16; ++i) { const float4 hh = *(const float4*)(h3 + i * 64 + k); a[i] += hh.x * w0 + hh.y * w1 + hh.z * w2 + hh.w * w3; } }
            const float delta = 3.0701134573253944f + (float)c * ((15.350567286626972f - 3.0701134573253944f) / 511.0f);
#pragma unroll
            for (int i = 0; i < 16; ++i) a[i] *= expf(-((float)(pos0 + i) / (float)(L - 1)) * delta);
            float* dst = isctx ? FKC + ((size_t)order * 512 + c) * 512 + 256 : FK + ((size_t)order * 512 + c) * 8192 + 4096;
            if (dirn == 0) {
#pragma unroll
                for (int i = 0; i < 16; i += 4) *(float4*)(dst + pos0 + i) = make_float4(a[i], a[i + 1], a[i + 2], a[i + 3]);
            } else {
#pragma unroll
                for (int i = 0; i < 16; ++i) if (pos0 + i > 0) dst[-(pos0 + i)] = a[i];
                if (pos0 == 0) dst[-L] = 0.f;
            }
        }
    }
}

__device__ __forceinline__ void ph_hy_prep(KP p, int l, int bid, int nb, float* sm) {
    const int tid = opaque_tid(), o = l >> 1;
    const bf16_t* P = (const bf16_t*)(p->ws + OFF_BIG);
    bf16_t* UT = (bf16_t*)(p->ws + OFF_UT);
    const float* cw = p->in[I_HCW] + o * 3 * 1536; const float* cb = p->in[I_HCB] + o * 1536;
    float* tile = sm;
#pragma unroll 1
    for (int item = bid; item < (NT / 256) * 24; item += nb) {
        const int tt = item / 24, ct = item % 24, tok0 = tt * 256, col0 = ct * 64;
        const bool lat = tok0 < NL;
        const int L = lat ? SEQ : CTXL, t0 = lat ? (tok0 & (SEQ - 1)) : ((tok0 - NL) & (CTXL - 1));
        __syncthreads();
#pragma unroll 1
        for (int i = tid; i < 258 * 8; i += 512) {
            const int rr = i >> 3, hf = i & 7, t = t0 + rr - 1;
            uint4 v = make_uint4(0u, 0u, 0u, 0u);
            if (t >= 0 && t < L) v = *(const uint4*)(P + (size_t)(tok0 + rr - 1) * ODD_LD + col0 + hf * 8);
            float* d = tile + rr * 65 + hf * 8;
            d[0] = bflo(v.x); d[1] = bfhi(v.x); d[2] = bflo(v.y); d[3] = bfhi(v.y); d[4] = bflo(v.z); d[5] = bfhi(v.z); d[6] = bflo(v.w); d[7] = bfhi(v.w);
        }
        __syncthreads();
#pragma unroll 1
        for (int r = 0; r < 4; ++r) {
            const int cc = (tid >> 5) + 16 * r, tc = (tid & 31) * 8, col = col0 + cc;
            const float w0 = cw[col], w1 = cw[1536 + col], w2 = cw[3072 + col], bb = cb[col];
            float y[8];
#pragma unroll
            for (int i = 0; i < 8; ++i) y[i] = tile[(tc + i) * 65 + cc] * w0 + tile[(tc + i + 1) * 65 + cc] * w1 + tile[(tc + i + 2) * 65 + cc] * w2 + bb;
            *(uint4*)(UT + (size_t)col * NT + tok0 + tc) = make_uint4(cvt_pk_bf16(y[0], y[1]), cvt_pk_bf16(y[2], y[3]), cvt_pk_bf16(y[4], y[5]), cvt_pk_bf16(y[6], y[7]));
        }
    }
}

__device__ __forceinline__ void hy_item_lat(KP p, int l, int c) {
    constexpr int ZSB = (SEQ + 8) * 2;
    constexpr unsigned O_Z = 0, O_PE = O_Z + 8 * ZSB, O_PO = O_PE + 4096 * 4, O_END = O_PO + 4096 * 4;
    static_assert(O_END <= BAR_LDS_, "hyena LDS");
    const int tid = opaque_tid(), lane = tid & 63, wv = __builtin_amdgcn_readfirstlane(tid >> 6), r16 = lane & 15, q4 = lane >> 4, o = l >> 1;
    const unsigned L0 = (unsigned)(size_t)smraw_base();
    const bf16_t* UT = (const bf16_t*)(p->ws + OFF_UT);
    bf16_t* ZOT = (bf16_t*)(p->ws + OFF_ZOT);
    const float* FK = (const float*)(p->ws + OFF_FKS(o));
    for (int i = tid; i < 8 * 512; i += 512) { const int b = i >> 9, ch = i & 511; sc::st16(L0 + O_Z + b * ZSB + ch * 16, *(const uint4*)(UT + (size_t)(1024 + c) * NT + b * SEQ + ch * 8)); }
#pragma unroll 1
    for (int order = 0; order < 2; ++order) {
        const float* fk = FK + ((size_t)order * 512 + c) * 8192;
        for (int i = tid; i < 4096; i += 512) {
            const float r0 = (i > 0) ? fk[8192 - 2 * i] : 0.f, r1 = fk[8191 - 2 * i], r2 = (i < 4095) ? fk[8190 - 2 * i] : 0.f;
            *(LAS unsigned*)(size_t)(L0 + O_PE + i * 4) = cvt_pk_bf16(r0, r1); *(LAS unsigned*)(size_t)(L0 + O_PO + i * 4) = cvt_pk_bf16(r1, r2);
        }
        __syncthreads();
        sc::f32x4 acc[4][4];
#pragma unroll
        for (int a = 0; a < 4; ++a)
#pragma unroll
            for (int b2 = 0; b2 < 4; ++b2) acc[a][b2] = (sc::f32x4){0.f, 0.f, 0.f, 0.f};
        const unsigned gbase = L0 + ((r16 & 1) ? O_PO : O_PE) + (unsigned)(((4096 - r16 + 8 * q4 - (r16 & 1)) >> 1) * 4);
        auto ldG = [&](int g) {
            const unsigned a0 = gbase - (unsigned)(32 * g);
            const unsigned w0 = *(const LAS unsigned*)(size_t)a0, w1 = *(const LAS unsigned*)(size_t)(a0 + 4), w2 = *(const LAS unsigned*)(size_t)(a0 + 8), w3 = *(const LAS unsigned*)(size_t)(a0 + 12);
            return __builtin_bit_cast(sc::bf16x8, (sc::u32x4_){w0, w1, w2, w3});
        };
        sc::bf16x8 bq[4][2], W[6];
#pragma unroll
        for (int i = 0; i < 4; ++i) { bq[i][0] = (sc::bf16x8){0, 0, 0, 0, 0, 0, 0, 0}; bq[i][1] = bq[i][0]; }
        const int D0 = 8 * wv - 63, D1 = (8 * wv + 7 < 63) ? 8 * wv + 7 : 63;
        W[4] = ldG(4 * D0 - 6 + 4); W[5] = ldG(4 * D0 - 6 + 5);
#pragma unroll 1
        for (int D = D0; D <= D1; ++D) {
            W[0] = W[4]; W[1] = W[5];
#pragma unroll
            for (int i = 0; i < 4; ++i) W[2 + i] = ldG(4 * D + i);
            bq[3][0] = bq[2][0]; bq[3][1] = bq[2][1]; bq[2][0] = bq[1][0]; bq[2][1] = bq[1][1]; bq[1][0] = bq[0][0]; bq[1][1] = bq[0][1];
            {
                const int s1 = 8 * wv - D + ((r16 < 8) ? 0 : 4);
                const bool ok = (unsigned)s1 < 64u;
                const unsigned za = L0 + O_Z + (unsigned)((r16 & 7) * ZSB + ((ok ? s1 : 0) * 64 + q4 * 8) * 2);
                sc::bf16x8 b0 = *(const LAS sc::bf16x8*)(size_t)za, b1 = *(const LAS sc::bf16x8*)(size_t)(za + 64);
                if (!ok) { b0 = (sc::bf16x8){0, 0, 0, 0, 0, 0, 0, 0}; b1 = b0; }
                bq[0][0] = b0; bq[0][1] = b1;
            }
#pragma unroll
            for (int cg = 0; cg < 4; ++cg) {
                const int sA = 8 * wv + cg - D;
                if ((unsigned)sA < 64u || (unsigned)(sA + 4) < 64u) {
#pragma unroll
                    for (int it = 0; it < 4; ++it) { acc[cg][it] = SC_MFMA(W[it + 2], bq[cg][0], acc[cg][it]); acc[cg][it] = SC_MFMA(W[it], bq[cg][1], acc[cg][it]); }
                }
            }
        }
        __syncthreads();
        const float sk = p->in[I_HSKIP][o * 1024 + order * 512 + c];
        const bf16_t* gt = UT + (size_t)(order * 512 + c) * NT;
        const int bb = r16 & 7;
#pragma unroll
        for (int cg = 0; cg < 4; ++cg) {
            const int t1 = 8 * wv + cg + ((r16 < 8) ? 0 : 4);
#pragma unroll
            for (int it = 0; it < 4; ++it) {
                const int t = t1 * 64 + it * 16 + q4 * 4;
                const sc::u32x2_ zo_ = *(const LAS sc::u32x2_*)(size_t)(L0 + O_Z + bb * ZSB + t * 2); const uint2 zo = make_uint2(zo_[0], zo_[1]);
                const uint2 gv = *(const uint2*)(gt + bb * SEQ + t);
                const float y0 = bflo(gv.x) * (acc[cg][it][0] + sk * bflo(zo.x)), y1 = bfhi(gv.x) * (acc[cg][it][1] + sk * bfhi(zo.x));
                const float y2 = bflo(gv.y) * (acc[cg][it][2] + sk * bflo(zo.y)), y3 = bfhi(gv.y) * (acc[cg][it][3] + sk * bfhi(zo.y));
                const uint2 w = make_uint2(cvt_pk_bf16(y0, y1), cvt_pk_bf16(y2, y3));
                if (order == 0) sc::st8(L0 + O_Z + bb * ZSB + t * 2, w);
                else *(uint2*)(ZOT + (size_t)c * NT + bb * SEQ + t) = w;
            }
        }
        __syncthreads();
    }
}

__device__ __forceinline__ void hy_item_ctx(KP p, int l, int c, float* sm) {
    const int tid = opaque_tid(), o = l >> 1;
    const bf16_t* UT = (const bf16_t*)(p->ws + OFF_UT);
    bf16_t* ZOT = (bf16_t*)(p->ws + OFF_ZOT);
    const float* FKC = (const float*)(p->ws + OFF_FKS(o)) + (size_t)2 * 512 * 8192;
    float* Kc = sm;
    float* zb = sm + 1024;
    for (int i = tid; i < 1024; i += 512) Kc[i] = FKC[((size_t)(i >> 9) * 512 + c) * 512 + (i & 511)];
    for (int i = tid; i < 8 * CTXL; i += 512) zb[i] = bf2f(UT[(size_t)(1024 + c) * NT + NL + i]);
    __syncthreads();
    const int bb = tid >> 6, tl = tid & 63;
#pragma unroll 1
    for (int order = 0; order < 2; ++order) {
        float acc[4] = {0.f, 0.f, 0.f, 0.f};
#pragma unroll 4
        for (int s = 0; s < CTXL; ++s) {
            const float zv = zb[bb * CTXL + s];
#pragma unroll
            for (int i = 0; i < 4; ++i) acc[i] += Kc[order * 512 + tl + 64 * i - s + 256] * zv;
        }
        const float sk = p->in[I_HSKIP][o * 1024 + order * 512 + c];
        float zn[4];
#pragma unroll
        for (int i = 0; i < 4; ++i) { const int t = tl + 64 * i; zn[i] = bf2f(UT[(size_t)(order * 512 + c) * NT + NL + bb * CTXL + t]) * (acc[i] + zb[bb * CTXL + t] * sk); }
        __syncthreads();
#pragma unroll
        for (int i = 0; i < 4; ++i) { const int t = tl + 64 * i; if (order == 0) zb[bb * CTXL + t] = bf2f((bf16_t)(cvt_pk_bf16(zn[i], 0.f) & 0xffffu)); else stf(ZOT + (size_t)c * NT + NL + bb * CTXL + t, zn[i]); }
        __syncthreads();
    }
}

__device__ __forceinline__ void ph_mix_odd(KP p, int l, int bid, int nb, float* sm) {
    int* head = (int*)(p->ws + OFF_CNT) + 1024 + (l >> 1) * 64;
    LAS int* slot = (LAS int*)(smraw_base() + BAR_LDS_ + 64);
#pragma unroll 1
    for (;;) {
        if (opaque_tid() == 0) *slot = atomicAdd(head, 1);
        __syncthreads();
        const int item = *slot;
        __syncthreads();
        if (item >= 128 + 512) break;
        if (item < 128) { const int b = (item >> 4) & 7, h = (item >> 2) & 3, dir = (item >> 1) & 1, vs = item & 1; sc::scan_item<2>(p, l, b, h, dir, vs); }
        else { const int c = item - 128; hy_item_lat(p, l, c); __syncthreads(); hy_item_ctx(p, l, c, sm); }
        __syncthreads();
    }
}

__device__ __forceinline__ void ph_hy_norm(KP p, int l, int bid, int nb, float* sm) {
    const int tid = opaque_tid(), o = l >> 1;
    const bf16_t* ZOT = (const bf16_t*)(p->ws + OFF_ZOT);
    bf16_t* MIX = (bf16_t*)(p->ws + OFF_U);
    const float* nw = p->in[I_HNORM] + o * 512;
    float* tile = sm;
    float* part = sm + 64 * 65;
#pragma unroll 1
    for (int item = bid; item < (NT / 64) * 8; item += nb) {
        const int tt = item >> 3, g = item & 7, tok0 = tt * 64;
        __syncthreads();
        { const int cc = tid >> 3, ch = tid & 7;
          const uint4 v = *(const uint4*)(ZOT + (size_t)(g * 64 + cc) * NT + tok0 + ch * 8);
          float* d = tile + cc * 65 + ch * 8;
          d[0] = bflo(v.x); d[1] = bfhi(v.x); d[2] = bflo(v.y); d[3] = bfhi(v.y); d[4] = bflo(v.z); d[5] = bfhi(v.z); d[6] = bflo(v.w); d[7] = bfhi(v.w); }
        __syncthreads();
        { const int tk = tid & 63, pt = tid >> 6; float s = 0.f;
#pragma unroll
          for (int i = 0; i < 8; ++i) { const float x = tile[(pt * 8 + i) * 65 + tk]; s += x * x; }
          part[pt * 64 + tk] = s; }
        __syncthreads();
        { const int tk = tid >> 3, ch = tid & 7; float s = 0.f;
#pragma unroll
          for (int i = 0; i < 8; ++i) s += part[i * 64 + tk];
          const float rs = rsqrtf(s * (1.f / 64.f) + LN_EPS);
          float y[8];
#pragma unroll
          for (int i = 0; i < 8; ++i) y[i] = tile[(ch * 8 + i) * 65 + tk] * rs * nw[g * 64 + ch * 8 + i];
          *(uint4*)(MIX + (size_t)(tok0 + tk) * DM + g * 64 + ch * 8) = make_uint4(cvt_pk_bf16(y[0], y[1]), cvt_pk_bf16(y[2], y[3]), cvt_pk_bf16(y[4], y[5]), cvt_pk_bf16(y[6], y[7])); }
    }
}

__device__ __forceinline__ void ph_normgate_odd(KP p, int l, int bid, int nb) {
    const int tid = opaque_tid(), lane = tid & 63, wv = tid >> 6, o2 = l >> 1;
    const bf16_t* P = (const bf16_t*)(p->ws + OFF_BIG);
    const bf16_t* HX = (const bf16_t*)(p->ws + OFF_AUX);
    const bf16_t* HX1 = HX + (size_t)NT * 1024;
    bf16_t* MIX = (bf16_t*)(p->ws + OFF_U);
    const int c16 = 16 * (lane & 31);
    const float* nw = p->in[I_RNW] + o2 * 512 + c16;
#pragma unroll 1
    for (int t2 = bid * 8 + wv; t2 < NT / 2; t2 += nb * 8) {
        const int tok = t2 * 2 + (lane >> 5);
        const size_t o = (size_t)tok * 1024 + 512 + c16;
        head_norm_gate16<true, false>(HX + o, HX1 + o, P + (size_t)tok * ODD_LD + 3072 + c16, nw, MIX + o);
    }
}

__device__ __forceinline__ void ph_ln1_router(KP p, int l, int ntok, int bid, int nb, float* sm) {
    constexpr int VP = (1024 + 8) * 2;
    constexpr unsigned O_VH = 0, O_VL = 32 * VP, O_LG = 64 * VP;
    static_assert(O_LG + 32 * 64 * 4 <= BAR_LDS_, "router LDS");
    const int tid = opaque_tid(), lane = tid & 63, wv = __builtin_amdgcn_readfirstlane(tid >> 6), r16 = lane & 15, q4 = lane >> 4;
    const unsigned L0 = (unsigned)(size_t)smraw_base();
    const bf16_t* Y = (const bf16_t*)(p->ws + OFF_BIG);
    bf16_t* U = (bf16_t*)(p->ws + OFF_U);
    const float* lw = p->in[I_LNW] + (l * 2) * 1024; const float* lb = p->in[I_LNB] + (l * 2) * 1024;
    const bf16_t* RWH = (const bf16_t*)(p->ws + OFF_RWH); const bf16_t* RWL = RWH + 64 * 1024;
    const float rb = p->in[I_RB][l * 64 + lane];
    LAS int* lcnt = (LAS int*)(smraw_base() + BAR_LDS_ + 256);
    if (tid < 64) lcnt[tid] = 0;
    __syncthreads();
    int* tidx = (int*)(p->ws + OFF_TIDX); float* tgate = (float*)(p->ws + OFF_TGATE); int* tpos = (int*)(p->ws + OFF_TPOS);
    {
        int* stok = (int*)(p->ws + OFF_STOK); float* sgate = (float*)(p->ws + OFF_SGATE); int* sdst = (int*)(p->ws + OFF_SDST);
#pragma unroll 1
        for (int i = bid * 512 + tid; i < MAXROWS; i += nb * 512) { stok[i] = ZROW; sgate[i] = 0.f; sdst[i] = -1; }
    }
#pragma unroll 1
    for (int base = bid * 32; base < ntok; base += nb * 32) {
#pragma unroll 2
        for (int j = 0; j < 4; ++j) {
            const int tl = wv * 4 + j, tok = base + tl;
            float* h = hrow(p, tok);
            const float* m = modrow(p, l, tok);
            const bf16_t* r = Y + (size_t)tok * DM;
            float x[16]; float s = 0.f;
#pragma unroll
            for (int c = 0; c < 4; ++c) {
                const int d = 4 * (lane + 64 * c);
                const float4 hv = *(const float4*)(h + d), gv = *(const float4*)(m + 2 * 1024 + d); const uint2 rw2 = *(const uint2*)(r + d);
                const float4 rv = make_float4(bflo(rw2.x), bfhi(rw2.x), bflo(rw2.y), bfhi(rw2.y));
                x[4 * c] = ALPHA * hv.x + gv.x * rv.x; x[4 * c + 1] = ALPHA * hv.y + gv.y * rv.y; x[4 * c + 2] = ALPHA * hv.z + gv.z * rv.z; x[4 * c + 3] = ALPHA * hv.w + gv.w * rv.w;
                s += x[4 * c] + x[4 * c + 1] + x[4 * c + 2] + x[4 * c + 3];
            }
            const float mean = wave_sum(s) * (1.f / 1024.f);
            float q = 0.f;
#pragma unroll
            for (int i = 0; i < 16; ++i) { x[i] -= mean; q += x[i] * x[i]; }
            const float rs = rsqrtf(wave_sum(q) * (1.f / 1024.f) + LN_EPS);
#pragma unroll
            for (int c = 0; c < 4; ++c) {
                const int d = 4 * (lane + 64 * c);
                const float4 w4 = *(const float4*)(lw + d), b4 = *(const float4*)(lb + d), sh = *(const float4*)(m + 3 * 1024 + d), sc = *(const float4*)(m + 4 * 1024 + d);
                float4 y; y.x = x[4 * c] * rs * w4.x + b4.x; y.y = x[4 * c + 1] * rs * w4.y + b4.y; y.z = x[4 * c + 2] * rs * w4.z + b4.z; y.w = x[4 * c + 3] * rs * w4.w + b4.w;
                *(float4*)(h + d) = y;
                float4 v; v.x = y.x * (1.f + sc.x) + sh.x; v.y = y.y * (1.f + sc.y) + sh.y; v.z = y.z * (1.f + sc.z) + sh.z; v.w = y.w * (1.f + sc.w) + sh.w;
                const unsigned h0 = cvt_pk_bf16(v.x, v.y), h1 = cvt_pk_bf16(v.z, v.w);
                *(uint2*)(U + (size_t)tok * DM + d) = make_uint2(h0, h1);
                sc::st8(L0 + O_VH + tl * VP + d * 2, make_uint2(h0, h1));
                sc::st8(L0 + O_VL + tl * VP + d * 2, make_uint2(cvt_pk_bf16(v.x - bflo(h0), v.y - bfhi(h0)), cvt_pk_bf16(v.z - bflo(h1), v.w - bfhi(h1))));
            }
        }
        __syncthreads();
        {
            const int tt = wv & 1, et = wv >> 1;
            sc::f32x4 acc = (sc::f32x4){0.f, 0.f, 0.f, 0.f};
            const bf16_t* bh = RWH + (size_t)(et * 16 + r16) * 1024 + q4 * 8; const bf16_t* bl = RWL + (size_t)(et * 16 + r16) * 1024 + q4 * 8;
#pragma unroll 4
            for (int ks = 0; ks < 32; ++ks) {
                const sc::bf16x8 ah = sc::rd_row(L0 + O_VH, tt * 16 + r16, VP, ks * 32 + q4 * 8), al = sc::rd_row(L0 + O_VL, tt * 16 + r16, VP, ks * 32 + q4 * 8);
                const sc::bf16x8 wh = *(const sc::bf16x8*)(bh + ks * 32), wl = *(const sc::bf16x8*)(bl + ks * 32);
                acc = SC_MFMA(ah, wh, acc); acc = SC_MFMA(ah, wl, acc); acc = SC_MFMA(al, wh, acc);
            }
#pragma unroll
            for (int jj = 0; jj < 4; ++jj) *(LAS float*)(size_t)(L0 + O_LG + ((tt * 16 + q4 * 4 + jj) * 64 + et * 16 + r16) * 4) = acc[jj];
        }
        __syncthreads();
#pragma unroll 1
        for (int j = 0; j < 4; ++j) {
            const int tl = wv * 4 + j, tok = base + tl;
            const float lg = *(const LAS float*)(size_t)(L0 + O_LG + (tl * 64 + lane) * 4);
            const float score = sigmoidf_(lg);
            const float key = score + rb;
            int rank = 0;
#pragma unroll
            for (int e = 0; e < 64; ++e) { const float ke = __builtin_bit_cast(float, __builtin_amdgcn_readlane(__builtin_bit_cast(int, key), e)); rank += (ke > key || (ke == key && e < lane)) ? 1 : 0; }
            const bool sel = rank < TOPK;
            const float gsum = wave_sum(sel ? score : 0.f);
            if (sel) {
                const int pos = __hip_atomic_fetch_add(lcnt + lane, 1, __ATOMIC_RELAXED, __HIP_MEMORY_SCOPE_WORKGROUP);
                tidx[tok * 8 + rank] = lane; tgate[tok * 8 + rank] = 2.5f * score / gsum; tpos[tok * 8 + rank] = pos;
            }
        }
        __syncthreads();
    }
    __syncthreads();
    if (tid < 64) ((int*)(p->ws + OFF_BCNT))[bid * 64 + tid] = lcnt[tid];
}

__device__ __forceinline__ void moe_offsets(KP p, int l, int ntok, LAS int* offs) {
    const int t = opaque_tid();
    if (t < 66) offs[t] = ((const int*)(p->ws + OFF_GOFFS))[t];
    __syncthreads();
}
__device__ __forceinline__ int moe_expert_of(const LAS int* offs, int row) { int e = 0;
#pragma unroll 1
    while (e < 64 && row >= offs[e + 1]) ++e;
    return e; }

__device__ __forceinline__ void ph_scatter(KP p, int l, int ntok, int bid, int nb, LAS unsigned char* lds) {
    LAS int* offs = (LAS int*)lds;
    LAS int* myb = offs + 128;
    LAS int* part = offs + 256;
    const int tid = opaque_tid();
    const int* bcnt = (const int*)(p->ws + OFF_BCNT);
    { const int e = tid & 63, pt = tid >> 6; int tot = 0, mine = 0;
#pragma unroll 4
      for (int b = pt; b < nb; b += 8) { const int c = bcnt[b * 64 + e]; tot += c; mine += (b < bid) ? c : 0; }
      part[pt * 64 + e] = tot; part[512 + pt * 64 + e] = mine; }
    __syncthreads();
    if (tid < 64) {
        int tot = 0, mine = 0;
#pragma unroll
        for (int i = 0; i < 8; ++i) { tot += part[i * 64 + tid]; mine += part[512 + i * 64 + tid]; }
        const int pc = (tot + 255) & ~255;
        int incl = pc;
#pragma unroll
        for (int o = 1; o < 64; o <<= 1) { const int t = SHU(incl, o); if (tid >= o) incl += t; }
        offs[tid] = incl - pc; myb[tid] = mine;
        if (tid == 63) { offs[64] = incl; offs[65] = incl + ntok; }
    }
    __syncthreads();
    if (bid == 0 && tid < 66) ((int*)(p->ws + OFF_GOFFS))[tid] = offs[tid];
    const int* tidx = (const int*)(p->ws + OFF_TIDX); const float* tgate = (const float*)(p->ws + OFF_TGATE); const int* tpos = (const int*)(p->ws + OFF_TPOS);
    int* stok = (int*)(p->ws + OFF_STOK); float* sgate = (float*)(p->ws + OFF_SGATE); int* sdst = (int*)(p->ws + OFF_SDST);
    int* tile_e = (int*)(p->ws + OFF_TILEE);
#pragma unroll 1
    for (int base = bid * 32; base < ntok; base += nb * 32) {
        if (tid < 32 * 9) {
            const int tok = base + tid / 9, sl = tid % 9;
            if (sl < 8) { const int i = tok * 8 + sl, e = tidx[i], row = offs[e] + myb[e] + tpos[i]; stok[row] = tok; sgate[row] = tgate[i]; sdst[row] = tok * 9 + sl; }
            else { const int row = offs[64] + tok; stok[row] = tok; sgate[row] = 1.f; sdst[row] = tok * 9 + 8; }
        }
    }
    const int nrt = offs[65] >> 8;
#pragma unroll 1
    for (int rt = bid * 512 + tid; rt < nrt; rt += nb * 512) tile_e[rt] = moe_expert_of(offs, rt * 256);
    __syncthreads();
}

#define MOE_TAB (gp::STAGE_BYTES + 256)
#define MOE_MAXT 9
static_assert(131072 + 256 + 256 + MOE_MAXT * 2048 <= BAR_LDS_, "MoE tables");
struct MoeDeal {
    int nfull, rem, c, G;
    __device__ __forceinline__ void init(int nrt, int c_, int G_) { nfull = nrt / G_; rem = nrt % G_; c = c_; G = G_; }
    __device__ __forceinline__ int nleft(int NPN) const { const int tot = rem * NPN; return c < tot ? (tot - c + G - 1) / G : 0; }
    __device__ __forceinline__ int ntiles(int NPN) const { return nfull + nleft(NPN); }
    __device__ __forceinline__ int tile_of(int j, int NPN) const { return j < nfull ? c + j * G : nfull * G + (c + (j - nfull) * G) / NPN; }
    __device__ __forceinline__ bool unit(int i, int NPN, int& j, int& pn) const {
        if (i < nfull * NPN) { j = i / NPN; pn = i % NPN; return true; }
        const int k = i - nfull * NPN, lu = c + k * G;
        if (lu < rem * NPN) { j = nfull + k; pn = lu % NPN; return true; }
        return false;
    }
};
struct Moe1Sched {
    const char* U; const char* W; const LAS int* tabE; const LAS int* tabS; MoeDeal d;
    __device__ __forceinline__ bool next(int i, gp::Unit& u) const {
        int j, pn; if (!d.unit(i, 2, j, pn)) return false;
        u.A = U; u.B = W + (size_t)tabE[j] * (512 * 1024 * 2) + (size_t)pn * (256 * 1024 * 2); u.r0 = d.tile_of(j, 2) * 256; u.c0 = pn * 256; u.aux = j; return true;
    }
    __device__ __forceinline__ void lane_off(const gp::Unit& u, unsigned (&vo)[2][2]) const {
        const int tid = opaque_tid(); int R0, C0, R1, C1; gp::stage_rc(tid * 16, R0, C0); gp::stage_rc(tid * 16 + 8192, R1, C1);
        const LAS int* t = tabS + u.aux * 256;
        vo[0][0] = (unsigned)t[R0] * 2048u + (unsigned)C0 * 2u; vo[0][1] = (unsigned)t[R1] * 2048u + (unsigned)C1 * 2u;
        vo[1][0] = (unsigned)t[128 + R0] * 2048u + (unsigned)C0 * 2u; vo[1][1] = (unsigned)t[128 + R1] * 2048u + (unsigned)C1 * 2u;
    }
};
struct EpiH {
    bf16_t* H;
    __device__ __forceinline__ void operator()(const gp::f32x4 (&acc)[2][2][4][2], const gp::Unit& u, int wr, int wc, int fr, int fq) const {
        const int row0 = u.r0 + wr * 64 + fr;
#pragma unroll
        for (int ai = 0; ai < 2; ++ai)
#pragma unroll
            for (int m = 0; m < 4; ++m) { bf16_t* rowp = H + (size_t)(row0 + ai * 128 + m * 16) * 256;
#pragma unroll
                for (int bj = 0; bj < 2; ++bj) {
                    const int j0 = ((u.c0 + bj * 128 + wc * 32) >> 5) * 16 + 4 * fq;
                    const gp::f32x4 a = acc[ai][bj][m][0], b = acc[ai][bj][m][1];
                    const float h0 = siluf_(a[0]) * b[0], h1 = siluf_(a[1]) * b[1], h2 = siluf_(a[2]) * b[2], h3 = siluf_(a[3]) * b[3];
                    *(uint2*)(rowp + j0) = make_uint2(cvt_pk_bf16(h0, h1), cvt_pk_bf16(h2, h3)); }
                __builtin_amdgcn_sched_barrier(0); }
    }
};
__device__ __forceinline__ void ph_moe1(KP p, int l, int ntok, int bid, int nb, LAS unsigned char* lds) {
    LAS int* tabE = (LAS int*)(lds + MOE_TAB);
    LAS int* tabS = tabE + 64;
    const int tid = opaque_tid();
    MoeDeal d; d.init(((const int*)(p->ws + OFF_GOFFS))[65] >> 8, bid, nb);
    const int nper = d.ntiles(2);
    const int* stok = (const int*)(p->ws + OFF_STOK); const int* tile_e = (const int*)(p->ws + OFF_TILEE);
    for (int i = tid; i < nper * 256; i += 512) tabS[i] = stok[(size_t)d.tile_of(i >> 8, 2) * 256 + (i & 255)];
    if (tid < nper) tabE[tid] = tile_e[d.tile_of(tid, 2)];
    __syncthreads();
    Moe1Sched S{(const char*)(p->ws + OFF_U), (const char*)(p->ws + OFF_W13), tabE, tabS, d};
    EpiH E{(bf16_t*)(p->ws + OFF_BIG)};
    gp::gemm_phase<true, false>(lds, 1024, S, E);
}

struct Moe2Sched {
    const char* H; const char* W; const LAS int* tabE; MoeDeal d;
    __device__ __forceinline__ bool next(int i, gp::Unit& u) const {
        int j, pn; if (!d.unit(i, 4, j, pn)) return false;
        u.A = H + (size_t)d.tile_of(j, 4) * (256 * 256 * 2); u.B = W + (size_t)tabE[j] * (1024 * 256 * 2) + (size_t)pn * (256 * 256 * 2); u.r0 = j * 256; u.c0 = pn * 256; u.aux = j; return true;
    }
    __device__ __forceinline__ void lane_off(const gp::Unit&, unsigned (&)[2][2]) const {}
};
__device__ __forceinline__ unsigned pk_fp8x4(float a, float b, float c, float d) { int w = __builtin_amdgcn_cvt_pk_fp8_f32(a, b, 0, false); w = __builtin_amdgcn_cvt_pk_fp8_f32(c, d, w, true); return (unsigned)w; }
struct EpiY {
    unsigned char* Ys; const LAS int* tabD; const LAS float* tabG;
    __device__ __forceinline__ void operator()(const gp::f32x4 (&acc)[2][2][4][2], const gp::Unit& u, int wr, int wc, int fr, int fq) const {
        const int rl0 = u.r0 + wr * 64 + fr, col0 = u.c0 + wc * 32 + 8 * fq;
#pragma unroll
        for (int ai = 0; ai < 2; ++ai)
#pragma unroll
            for (int m = 0; m < 4; ++m) {
                const int rl = rl0 + ai * 128 + m * 16;
                const int dst = tabD[rl]; const float g = tabG[rl];
                if (dst >= 0) { unsigned char* rowp = Ys + (size_t)dst * 1024 + col0;
#pragma unroll
                    for (int bj = 0; bj < 2; ++bj) { const gp::f32x4 v0 = acc[ai][bj][m][0] * g, v1 = acc[ai][bj][m][1] * g;
                        *(uint2*)(rowp + bj * 128) = make_uint2(pk_fp8x4(v0[0], v0[1], v0[2], v0[3]), pk_fp8x4(v1[0], v1[1], v1[2], v1[3])); } }
                __builtin_amdgcn_sched_barrier(0); }
    }
};
__device__ __forceinline__ void ph_moe2(KP p, int l, int ntok, int bid, int nb, LAS unsigned char* lds) {
    LAS int* tabE = (LAS int*)(lds + MOE_TAB);
    LAS int* tabD = tabE + 64;
    LAS float* tabG = (LAS float*)(tabD + MOE_MAXT * 256);
    const int tid = opaque_tid();
    MoeDeal d; d.init(((const int*)(p->ws + OFF_GOFFS))[65] >> 8, bid, nb);
    const int nper = d.ntiles(4);
    const int* sdst = (const int*)(p->ws + OFF_SDST); const float* sgate = (const float*)(p->ws + OFF_SGATE); const int* tile_e = (const int*)(p->ws + OFF_TILEE);
    for (int i = tid; i < nper * 256; i += 512) { const size_t r = (size_t)d.tile_of(i >> 8, 4) * 256 + (i & 255); tabD[i] = sdst[r]; tabG[i] = sgate[r]; }
    if (tid < nper) tabE[tid] = tile_e[d.tile_of(tid, 4)];
    __syncthreads();
    Moe2Sched S{(const char*)(p->ws + OFF_BIG), (const char*)(p->ws + OFF_W2), tabE, d};
    EpiY E{(unsigned char*)(p->ws + OFF_YS), tabD, tabG};
    gp::gemm_phase<false, true>(lds, 256, S, E);
}

template <bool NEXT>
__device__ __forceinline__ void ph_combine_ln2(KP p, int l, int ntok, int bid, int nb) {
    bf16_t* U = (bf16_t*)(p->ws + OFF_U);
    float* G = (float*)(p->ws + OFF_G);
    const bool gates = NEXT && ((l + 1) & 1) == 0;
    LAS float* wl = (LAS float*)smraw_base();
    if (gates) stage_gate_w(p, (l + 1) >> 1, wl);
    const int tid = opaque_tid(), lane = tid & 63, wv = tid >> 6;
    const unsigned char* Ys = (const unsigned char*)(p->ws + OFF_YS);
    const float* lw = p->in[I_LNW] + (l * 2 + 1) * 1024 + 16 * lane; const float* lb = p->in[I_LNB] + (l * 2 + 1) * 1024 + 16 * lane;
#pragma unroll 1
    for (int tok = bid * 8 + wv; tok < ntok; tok += nb * 8) {
        float* h = hrow(p, tok) + 16 * lane;
        const float* m = modrow(p, l, tok) + 16 * lane;
        const float* m2 = modrow(p, NEXT ? l + 1 : l, tok) + 16 * lane;
        float f[16];
#pragma unroll
        for (int i = 0; i < 16; ++i) f[i] = 0.f;
#pragma unroll
        for (int s9 = 0; s9 < 9; ++s9) {
            const uint4 w = *(const uint4*)(Ys + ((size_t)tok * 9 + s9) * 1024 + 16 * lane);
            const unsigned ww[4] = {w.x, w.y, w.z, w.w};
#pragma unroll
            for (int q = 0; q < 4; ++q) { const f32x2_n lo = __builtin_amdgcn_cvt_pk_f32_fp8((int)ww[q], false), hi = __builtin_amdgcn_cvt_pk_f32_fp8((int)ww[q], true);
                f[4 * q] += lo[0]; f[4 * q + 1] += lo[1]; f[4 * q + 2] += hi[0]; f[4 * q + 3] += hi[1]; }
        }
        float x[16]; float sum = 0.f;
#pragma unroll
        for (int q = 0; q < 4; ++q) {
            const float4 hv = *(const float4*)(h + 4 * q), gv = *(const float4*)(m + 5 * 1024 + 4 * q);
            x[4 * q] = ALPHA * hv.x + gv.x * f[4 * q]; x[4 * q + 1] = ALPHA * hv.y + gv.y * f[4 * q + 1]; x[4 * q + 2] = ALPHA * hv.z + gv.z * f[4 * q + 2]; x[4 * q + 3] = ALPHA * hv.w + gv.w * f[4 * q + 3];
            sum += x[4 * q] + x[4 * q + 1] + x[4 * q + 2] + x[4 * q + 3];
        }
        const float mean = wave_sum(sum) * (1.f / 1024.f);
        float q2 = 0.f;
#pragma unroll
        for (int i = 0; i < 16; ++i) { x[i] -= mean; q2 += x[i] * x[i]; }
        const float rs = rsqrtf(wave_sum(q2) * (1.f / 1024.f) + LN_EPS);
        float u16[16];
#pragma unroll
        for (int q = 0; q < 4; ++q) {
            const float4 w4 = *(const float4*)(lw + 4 * q), b4 = *(const float4*)(lb + 4 * q);
            float4 y; y.x = x[4 * q] * rs * w4.x + b4.x; y.y = x[4 * q + 1] * rs * w4.y + b4.y; y.z = x[4 * q + 2] * rs * w4.z + b4.z; y.w = x[4 * q + 3] * rs * w4.w + b4.w;
            *(float4*)(h + 4 * q) = y;
            if (NEXT) {
                const float4 sh = *(const float4*)(m2 + 4 * q), sc = *(const float4*)(m2 + 1024 + 4 * q);
                u16[4 * q] = y.x * (1.f + sc.x) + sh.x; u16[4 * q + 1] = y.y * (1.f + sc.y) + sh.y; u16[4 * q + 2] = y.z * (1.f + sc.z) + sh.z; u16[4 * q + 3] = y.w * (1.f + sc.w) + sh.w;
            }
        }
        if (NEXT) {
            uint4* up = (uint4*)(U + (size_t)tok * DM + 16 * lane);
            up[0] = make_uint4(cvt_pk_bf16(u16[0], u16[1]), cvt_pk_bf16(u16[2], u16[3]), cvt_pk_bf16(u16[4], u16[5]), cvt_pk_bf16(u16[6], u16[7]));
            up[1] = make_uint4(cvt_pk_bf16(u16[8], u16[9]), cvt_pk_bf16(u16[10], u16[11]), cvt_pk_bf16(u16[12], u16[13]), cvt_pk_bf16(u16[14], u16[15]));
        }
        if (gates) {
            float ga[16];
#pragma unroll
            for (int j = 0; j < 16; ++j) ga[j] = 0.f;
#pragma unroll
            for (int g4 = 0; g4 < 4; ++g4) {
#pragma unroll
                for (int qq = 0; qq < 4; ++qq) {
                    const float uv = u16[4 * g4 + qq];
#pragma unroll
                    for (int j4 = 0; j4 < 4; ++j4) { const f32x4_l w = *(const LAS f32x4_l*)(wl + (16 * lane + 4 * g4 + qq) * 16 + j4 * 4); ga[4 * j4] += uv * w[0]; ga[4 * j4 + 1] += uv * w[1]; ga[4 * j4 + 2] += uv * w[2]; ga[4 * j4 + 3] += uv * w[3]; }
                }
                __builtin_amdgcn_sched_barrier(0);
            }
            float mine = 0.f;
#pragma unroll
            for (int j = 0; j < 16; ++j) { const float sg = wave_sum(ga[j]); if (lane == j) mine = sg; }
            if (lane < 16) G[(size_t)tok * 16 + lane] = mine;
        }
    }
}

#define MEGA_LDS (131072 + 256 + 20480)
#define NBLK 256
#define BAR_LDS BAR_LDS_
#define SYNC() do { XcdBarrier _b; _b.bar = (unsigned*)kparams()->ws; _b.x = xb_xcc_id(); _b.st = (volatile LAS unsigned*)((LAS unsigned char*)smraw_base() + BAR_LDS); xcd_barrier(_b); } while (0)
template <int PAR>
__device__ __forceinline__ void layer_fwd(const int l) {
    LAS unsigned char* lds = smraw_base(); float* sm = (float*)smraw_generic();
    const int bid = blockIdx.x; constexpr int nb = NBLK;
    const int ntok = (l == 3) ? NL : NT;
    ph_gemm_in(kparams(), l, bid, nb, lds); SYNC();
    if (PAR == 0) {
        ph_scan_even2(kparams(), l, bid, nb); SYNC();
        ph_normgate_even(kparams(), l, bid, nb); SYNC();
    } else {
        ph_hy_prep(kparams(), l, bid, nb, sm); SYNC();
        ph_mix_odd(kparams(), l, bid, nb, sm); SYNC();
        ph_hy_norm(kparams(), l, bid, nb, sm); ph_normgate_odd(kparams(), l, bid, nb); SYNC();
    }
    ph_gemm_out(kparams(), l, bid, nb, lds); SYNC();
    ph_ln1_router(kparams(), l, ntok, bid, nb, sm); SYNC();
    ph_scatter(kparams(), l, ntok, bid, nb, lds); SYNC();
    ph_moe1(kparams(), l, ntok, bid, nb, lds); SYNC();
    ph_moe2(kparams(), l, ntok, bid, nb, lds); SYNC();
    if (l < 3) { ph_combine_ln2<true>(kparams(), l, ntok, bid, nb); ph_convert(kparams(), l + 1, bid, nb, sm); SYNC(); }
    else ph_combine_ln2<false>(kparams(), l, ntok, bid, nb);
}
__global__ void __launch_bounds__(512, 2) mega_fwd(Params p) {
    LAS unsigned char* lds = smraw_base(); float* sm = (float*)smraw_generic();
    {
        const int t0 = threadIdx.x;
        if ((t0 & 63) == 0) { unsigned h; asm volatile("s_getreg_b32 %0, hwreg(HW_REG_HW_ID, 0, 6)" : "=s"(h)); *(LAS int*)(size_t)(WTAB_LDS + (h & 63u) * 4u) = t0 >> 6; }
        if (t0 < 4) ((LAS unsigned*)(lds + BAR_LDS))[t0] = 0u;
    }
    __syncthreads();
    (void)xcd_barrier_post((unsigned*)kparams()->ws, (volatile LAS unsigned*)(lds + BAR_LDS));
    const int bid = blockIdx.x; constexpr int nb = NBLK;
    ph_prologue(kparams(), bid, nb, sm);
    __syncthreads();
    ph_hy_filt2(kparams(), 1, bid, nb, sm, 48); __syncthreads(); ph_hy_filt2(kparams(), 3, bid, nb, sm, 48);
    SYNC();
    ph_convert(kparams(), 0, bid, nb, sm); ph_modin(kparams(), 0, bid, nb); SYNC();
#pragma unroll 1
    for (int lp = 0; lp < 2; ++lp) {
        layer_fwd<0>(2 * lp);
        layer_fwd<1>(2 * lp + 1);
    }
    __syncthreads();
    if (blockIdx.x == 0 && opaque_tid() == 0 && xb_ld((unsigned*)kparams()->ws + XB_TMO) != 0u) kparams()->out[0] = __builtin_nanf("");
}

extern "C" void kernel_launch(void* const* d_in, const int* in_sizes, int n_in, void* d_out, int out_size, void* d_ws, size_t ws_size, hipStream_t stream) {
    static int grid = 0;
    if (grid == 0) {
        if (n_in != 38 || out_size != NL * DM || ws_size < WS_END) { fprintf(stderr, "kernel_launch: bad shapes n_in %d out %d ws %zu (need %zu)\n", n_in, out_size, ws_size, (size_t)WS_END); grid = -1; return; }
        int dev = 0, cus = 0, per_cu = 0;
        if (hipGetDevice(&dev) != hipSuccess || hipDeviceGetAttribute(&cus, hipDeviceAttributeMultiprocessorCount, dev) != hipSuccess) { grid = -1; return; }
        if (hipFuncSetAttribute((const void*)mega_fwd, hipFuncAttributeMaxDynamicSharedMemorySize, MEGA_LDS) != hipSuccess) { fprintf(stderr, "kernel_launch: hipFuncSetAttribute failed\n"); grid = -1; return; }
        if (hipOccupancyMaxActiveBlocksPerMultiprocessor(&per_cu, (const void*)mega_fwd, 512, MEGA_LDS) != hipSuccess || per_cu < 1) { fprintf(stderr, "kernel_launch: occupancy query says %d\n", per_cu); (void)hipGetLastError(); grid = -1; return; }
        if (cus != 256) { fprintf(stderr, "kernel_launch: built for 256 CUs, found %d\n", cus); grid = -1; return; }
        grid = NBLK;
    }
    if (grid < 0) return;
    if (hipMemsetAsync(d_ws, 0, OFF_LB, stream) != hipSuccess) return;
    Params p{};
    for (int i = 0; i < 38; ++i) p.in[i] = (const float*)d_in[i];
    p.out = (float*)d_out; p.ws = (unsigned char*)d_ws;
    hipLaunchKernelGGL(mega_fwd, dim3(grid), dim3(512), MEGA_LDS, stream, p);
}
```

```cpp
#include <hip/hip_runtime.h>
#include <stdint.h>
#include <stdio.h>

#define DM 1024
#define NBATCH 8
#define SEQ 4096
#define CTXL 256
#define NL (NBATCH * SEQ)
#define NC (NBATCH * CTXL)
#define NT (NL + NC)
#define ZROW NT
#define TOPK 8
#define EVEN_N 4112
#define ODD_N 3584
#define EVEN_LD 4096
#define ODD_LD 3584
#define MAXROWS (NT * 8 + 64 * 256 + NT)
#define ALPHA 1.681792830507429f
#define LN_EPS 1e-5f
#define E_MQ 0
#define E_MK 256
#define E_MV 512
#define E_MO 1024
#define E_HQ 1536
#define E_HI 2048
#define E_HFF 2560
#define E_HFB 3072
#define E_HG 3584

typedef unsigned short bf16_t;
#define LAS __attribute__((address_space(3)))
#define BAR_LDS_ 150528

#define MiB ((size_t)1 << 20)
#define OFF_CNT   ((size_t)64 << 10)
#define OFF_LB    ((size_t)96 << 10)
#define OFF_MOD   ((size_t)128 << 10)
#define OFF_ROPE  ((size_t)1536 << 10)
#define OFF_BCNT  ((size_t)1600 << 10)
#define OFF_GOFFS ((size_t)1700 << 10)
#define OFF_RWH   ((size_t)2560 << 10)
#define OFF_TILEE (2 * MiB)
#define OFF_HCTX  (4 * MiB)
#define OFF_TIDX  (12 * MiB)
#define OFF_TGATE (14 * MiB)
#define OFF_TPOS  (16 * MiB)
#define OFF_STOK  (18 * MiB)
#define OFF_SGATE (20 * MiB)
#define OFF_SDST  (22 * MiB)
#define OFF_G     (24 * MiB)
#define OFF_U     (28 * MiB)
#define OFF_W     (98 * MiB)
#define OFF_WIN   (OFF_W)
#define OFF_WOUT  (OFF_W + 8 * MiB)
#define OFF_W13   (OFF_W + 10 * MiB)
#define OFF_W2    (OFF_W + 75 * MiB)
#define OFF_BIG   (208 * MiB)
#define OFF_AUX   (480 * MiB)
#define OFF_Z1    (OFF_AUX + 136 * MiB)
#define OFF_Z2    (OFF_Z1 + 68 * MiB)
#define OFF_FILT  (OFF_Z2 + 68 * MiB)
#define OFF_YS    (370 * MiB)
#define WS_END    (1052 * MiB)

struct Params {
    const float* in[38];
    float* out;
    unsigned char* ws;
};

enum { I_X = 0, I_C, I_CTX, I_CCTX, I_ADAW, I_ADAB, I_LNW, I_LNB, I_EWIN, I_MGB, I_MNW, I_HLB, I_HNW, I_EWOUT, I_OWIN, I_HCW, I_HCB,
       I_HW1, I_HB1, I_HW2, I_HB2, I_HW3, I_HB3, I_HFREQ, I_HWOUT, I_HSKIP, I_HNORM, I_RLD, I_RNW, I_OWOUT, I_RW, I_RB, I_W1, I_W3, I_W2, I_SW1, I_SW3, I_SW2 };

typedef const __attribute__((address_space(4))) Params* KP;
__device__ __forceinline__ KP kparams() { KP k = (KP)__builtin_amdgcn_kernarg_segment_ptr(); asm volatile("" : "+s"(k)); return k; }
extern __shared__ __attribute__((aligned(16))) unsigned char smraw_all[];
__device__ __forceinline__ LAS unsigned char* smraw_base() { return (LAS unsigned char*)smraw_all; }
__device__ __forceinline__ unsigned char* smraw_generic() { return smraw_all; }
#define WTAB_LDS (BAR_LDS_ + 512)
__device__ __forceinline__ int opaque_tid() {
    unsigned h; asm volatile("s_getreg_b32 %0, hwreg(HW_REG_HW_ID, 0, 6)" : "=s"(h));
    const int wid = *(volatile LAS int*)(size_t)(WTAB_LDS + (h & 63u) * 4u);
    unsigned m = ~0u; asm volatile("" : "+s"(m));
    const int lane = (int)__builtin_amdgcn_mbcnt_hi(m, __builtin_amdgcn_mbcnt_lo(m, 0u));
    return __builtin_amdgcn_readfirstlane(wid) * 64 + lane;
}
typedef __bf16 bf16x2_n __attribute__((ext_vector_type(2)));
typedef float f32x2_n __attribute__((ext_vector_type(2)));
__device__ __forceinline__ unsigned cvt_pk_bf16(float lo, float hi) { const f32x2_n v = {lo, hi}; return __builtin_bit_cast(unsigned, __builtin_convertvector(v, bf16x2_n)); }
__device__ __forceinline__ float bf2f(bf16_t b) { return __uint_as_float(((unsigned)b) << 16); }
__device__ __forceinline__ float bflo(unsigned w) { return __uint_as_float(w << 16); }
__device__ __forceinline__ float bfhi(unsigned w) { return __uint_as_float(w & 0xffff0000u); }
__device__ __forceinline__ float ldf(const float* p) { return *p; }
__device__ __forceinline__ float ldf(const bf16_t* p) { return bf2f(*p); }
__device__ __forceinline__ void stf(float* p, float v) { *p = v; }
__device__ __forceinline__ void stf(bf16_t* p, float v) { *p = (bf16_t)(cvt_pk_bf16(v, 0.f) & 0xffffu); }
__device__ __forceinline__ float sigmoidf_(float x) { return 1.f / (1.f + expf(-x)); }
__device__ __forceinline__ float siluf_(float x) { return x / (1.f + expf(-x)); }
__device__ __forceinline__ int olane() { unsigned m = ~0u; asm volatile("" : "+s"(m)); return (int)__builtin_amdgcn_mbcnt_hi(m, __builtin_amdgcn_mbcnt_lo(m, 0u)); }
template <class T> __device__ __forceinline__ T shfl_idx(T v, int idx) { return __builtin_bit_cast(T, __builtin_amdgcn_ds_bpermute(idx << 2, __builtin_bit_cast(int, v))); }
#define SHX(v, o) shfl_idx(v, olane() ^ (o))
#define SHI(v, i) shfl_idx(v, (i))
#define SHI32(v, i) shfl_idx(v, (olane() & 32) | ((i) & 31))
#define SHU(v, o) shfl_idx(v, olane() - (o))
__device__ __forceinline__ float fexp(float x) { return __builtin_amdgcn_exp2f(x * 1.4426950408889634f); }
__device__ __forceinline__ float flog(float x) { return __builtin_amdgcn_logf(x) * 0.6931471805599453f; }
__device__ __forceinline__ float frcp(float x) { return __builtin_amdgcn_rcpf(x); }
__device__ __forceinline__ float fsigmoid(float x) { return frcp(1.f + fexp(-x)); }
__device__ __forceinline__ float fsilu(float x) { return x * frcp(1.f + fexp(-x)); }
__device__ __forceinline__ float wave_sum(float v) {
#pragma unroll
    for (int o = 32; o > 0; o >>= 1) v += SHX(v, o);
    return v;
}
__device__ __forceinline__ float* hrow(KP p, int tok) {
    return tok < NL ? p->out + (size_t)tok * DM : (float*)(p->ws + OFF_HCTX) + (size_t)(tok - NL) * DM;
}
__device__ __forceinline__ const float* modrow(KP p, int l, int tok) {
    const int r = tok < NL ? (tok >> 12) : 8;
    return (const float*)(p->ws + OFF_MOD) + ((size_t)l * 9 + r) * 6144;
}
__device__ __forceinline__ int scan_tok(int b, int i, int dir) {
    return i < CTXL ? NL + b * CTXL + (dir ? CTXL - 1 - i : i) : b * SEQ + (dir ? SEQ - 1 - (i - CTXL) : (i - CTXL));
}

#define XB_TMO      128
#define XB_XCNT(j)  (256  + 64 * (j))
#define XB_XSUB(j)  (1280 + 64 * (j))
#define XB_XGEN(j)  (2304 + 64 * (j))
#define XB_TOP      3328
#define XB_TOPGEN   3392
#define XCD_BAR_WORDS 3456
#define XB_SPIN_CAP (1u << 24)
__device__ __forceinline__ unsigned xb_ld(unsigned* p)              { return __hip_atomic_load(p, __ATOMIC_RELAXED, __HIP_MEMORY_SCOPE_AGENT); }
__device__ __forceinline__ unsigned xb_add(unsigned* p, unsigned v) { return __hip_atomic_fetch_add(p, v, __ATOMIC_RELAXED, __HIP_MEMORY_SCOPE_AGENT); }
__device__ __forceinline__ unsigned xb_xcc_id() { return (unsigned)__builtin_amdgcn_s_getreg((3 << 11) | 20) & 0xFu; }
#define XB_SPIN(cond, bar) do { unsigned _sp = 0; while (cond) { __builtin_amdgcn_s_sleep(1); \
    if ((++_sp & 255u) == 0u) { if (xb_ld(&(bar)[XB_TMO])) break; if (_sp > XB_SPIN_CAP) { atomicAdd(&(bar)[XB_TMO], 1u); break; } } } } while (0)
struct XcdBarrier { unsigned* bar; unsigned x; volatile LAS unsigned* st; };
__device__ __forceinline__ XcdBarrier xcd_barrier_post(unsigned* bar, volatile LAS unsigned* st) {
    XcdBarrier b; b.bar = bar; b.x = xb_xcc_id(); b.st = st;
    if (opaque_tid() == 0) (void)xb_add(&bar[XB_XCNT(b.x)], 1u);
    return b;
}
__device__ __forceinline__ void xcd_barrier_complete(unsigned* bar, unsigned x, unsigned& nloc, unsigned& nx) {
    const unsigned G = gridDim.x * gridDim.y * gridDim.z;
    unsigned sum, cnt, mine, sp = 0u;
    for (;;) {
        sum = 0u; cnt = 0u; mine = 0u;
#pragma unroll
        for (unsigned j = 0; j < 16; ++j) { const unsigned c = xb_ld(&bar[XB_XCNT(j)]); sum += c; cnt += (c > 0u) ? 1u : 0u; mine = (j == x) ? c : mine; }
        if (sum == G) break;
        __builtin_amdgcn_s_sleep(1);
        if ((++sp & 255u) == 0u) { if (xb_ld(&bar[XB_TMO])) break; if (sp > XB_SPIN_CAP) { atomicAdd(&bar[XB_TMO], 1u); break; } }
    }
    nloc = mine > 0u ? mine : 1u; nx = cnt > 0u ? cnt : 1u;
}
__device__ __forceinline__ void xcd_barrier(const XcdBarrier& b) {
    asm volatile("s_waitcnt vmcnt(0)" ::: "memory");
    __syncthreads();
    if (opaque_tid() == 0) {
        unsigned* bar = b.bar;
        __builtin_amdgcn_s_waitcnt(0);
        unsigned nloc = b.st[0], nx = b.st[1];
        if (nloc == 0u) { xcd_barrier_complete(bar, b.x, nloc, nx); b.st[0] = nloc; b.st[1] = nx; }
        const unsigned old = xb_add(&bar[XB_XSUB(b.x)], 1u);
        const unsigned gen = old / nloc;
        if (old + 1u == (gen + 1u) * nloc) {
            __builtin_amdgcn_fence(__ATOMIC_RELEASE, "agent");
            asm volatile("s_waitcnt vmcnt(0)" ::: "memory");
            const unsigned og = xb_add(&bar[XB_TOP], 1u);
            const unsigned tg = og / nx;
            if (og + 1u == (tg + 1u) * nx) xb_add(&bar[XB_TOPGEN], 1u);
            else XB_SPIN(xb_ld(&bar[XB_TOPGEN]) == tg, bar);
            __builtin_amdgcn_fence(__ATOMIC_ACQUIRE, "agent");
            xb_add(&bar[XB_XGEN(b.x)], 1u);
            asm volatile("s_waitcnt vmcnt(0)" ::: "memory");
        } else {
            XB_SPIN(xb_ld(&bar[XB_XGEN(b.x)]) == gen, bar);
            __builtin_amdgcn_fence(__ATOMIC_ACQUIRE, "agent");
            asm volatile("s_waitcnt vmcnt(0)" ::: "memory");
        }
    }
    __syncthreads();
}

__device__ __forceinline__ void ph_prologue(KP p, int bid, int nb, float* sm) {
    const int tid = opaque_tid();
    {
        const float4* x4 = (const float4*)p->in[I_X]; float4* o4 = (float4*)p->out;
        #pragma unroll 1
        for (size_t i = (size_t)bid * 512 + tid; i < (size_t)NL * 256; i += (size_t)nb * 512) o4[i] = x4[i];
        const float4* c4 = (const float4*)p->in[I_CTX]; float4* h4 = (float4*)(p->ws + OFF_HCTX);
        #pragma unroll 1
        for (size_t i = (size_t)bid * 512 + tid; i < (size_t)NC * 256; i += (size_t)nb * 512) h4[i] = c4[i];
    }
    if (bid == 0) {
        bf16_t* z = (bf16_t*)(p->ws + OFF_U) + (size_t)ZROW * DM;
        for (int i = tid; i < DM; i += 512) z[i] = 0;
    }
    if (bid == 1 % nb) {
        float* lb = (float*)(p->ws + OFF_LB);
        const float* hl = p->in[I_HLB];
        for (int j = tid; j < 512; j += 512) {
            const float a = hl[j], b = hl[512 + j], mx = fmaxf(a, b);
            const float ea = expf(a - mx), eb = expf(b - mx);
            lb[j] = 0.f; lb[512 + j] = eb / (ea + eb);
        }
    }
    if (bid == 2 % nb) {
        float2* rt = (float2*)(p->ws + OFF_ROPE);
        for (int i = tid; i < 64 * 32; i += 512) { const float ang = (float)(i >> 5) * powf(10000.f, -(float)(2 * (i & 31)) / 64.f); rt[i] = make_float2(cosf(ang), sinf(ang)); }
    }
    {
        float* act = sm;
        bool filled = false;
        #pragma unroll 1
        for (int item = bid; item < 48; item += nb) {
            if (!filled) {
                for (int i = tid; i < 9 * 1024; i += 512) {
                    const int r = i >> 10, k = i & 1023;
                    const float v = r < 8 ? p->in[I_C][r * 1024 + k] : p->in[I_CCTX][k];
                    act[i] = siluf_(v);
                }
                __syncthreads(); filled = true;
            }
            const int l = item / 12, j = (item % 12) * 512 + tid;
            const float* w = p->in[I_ADAW] + (size_t)l * 1024 * 6144 + j;
            float acc[9];
#pragma unroll
            for (int r = 0; r < 9; ++r) acc[r] = 0.f;
            for (int k = 0; k < 1024; ++k) {
                const float wv = w[(size_t)k * 6144];
#pragma unroll
                for (int r = 0; r < 9; ++r) acc[r] += act[r * 1024 + k] * wv;
            }
            const float bv = p->in[I_ADAB][l * 6144 + j];
            float* mod = (float*)(p->ws + OFF_MOD);
#pragma unroll
            for (int r = 0; r < 9; ++r) mod[((size_t)l * 9 + r) * 6144 + j] = acc[r] + bv;
        }
    }
}


struct CvtTile { const float* src; int srcld; bf16_t* dst; int dstld; int k0, n0; };
__device__ __forceinline__ CvtTile cvt_tile_of(KP p, int l, int t, int np4  ) {
    const bool even = (l & 1) == 0;
    const int NP = even ? EVEN_LD : ODD_LD;
    const int t_in = 16 * (NP / 128), t_out = 16 * 8, t_13 = 65 * 16 * 4;
    CvtTile c;
    if (t < t_in) {
        const int kt = t & 15, nt = t >> 4, n = nt * 128 + np4;
        const float* W = even ? p->in[I_EWIN] + (size_t)(l >> 1) * 1024 * EVEN_N : p->in[I_OWIN] + (size_t)(l >> 1) * 1024 * ODD_N;
        c.src = W + ((even && n >= 1536) ? n + 16 : n); c.srcld = even ? EVEN_N : ODD_N; c.dst = (bf16_t*)(p->ws + OFF_WIN); c.dstld = 1024; c.k0 = kt * 64; c.n0 = nt * 128;
    } else if (t < t_in + t_out) {
        const int u = t - t_in, kt = u & 15, nt = u >> 4;
        c.src = (even ? p->in[I_EWOUT] : p->in[I_OWOUT]) + (size_t)(l >> 1) * 1024 * 1024 + nt * 128 + np4; c.srcld = 1024; c.dst = (bf16_t*)(p->ws + OFF_WOUT); c.dstld = 1024; c.k0 = kt * 64; c.n0 = nt * 128;
    } else if (t < t_in + t_out + t_13) {
        const int u = t - t_in - t_out, e = u >> 6, kt = u & 15, nt = (u >> 4) & 3, n = nt * 128 + np4, g = n >> 5, w = n & 31;
        const float* w1 = e < 64 ? p->in[I_W1] + ((size_t)l * 64 + e) * 1024 * 256 : p->in[I_SW1] + (size_t)l * 1024 * 256;
        const float* w3 = e < 64 ? p->in[I_W3] + ((size_t)l * 64 + e) * 1024 * 256 : p->in[I_SW3] + (size_t)l * 1024 * 256;
        c.src = w < 16 ? w1 + 16 * g + w : w3 + 16 * g + w - 16; c.srcld = 256; c.dst = (bf16_t*)(p->ws + OFF_W13) + (size_t)e * 512 * 1024; c.dstld = 1024; c.k0 = kt * 64; c.n0 = nt * 128;
    } else {
        const int u = t - t_in - t_out - t_13, e = u >> 5, kt = u & 3, nt = (u >> 2) & 7;
        const float* w2 = e < 64 ? p->in[I_W2] + ((size_t)l * 64 + e) * 256 * 1024 : p->in[I_SW2] + (size_t)l * 256 * 1024;
        c.src = w2 + nt * 128 + np4; c.srcld = 1024; c.dst = (bf16_t*)(p->ws + OFF_W2) + (size_t)e * 1024 * 256; c.dstld = 256; c.k0 = kt * 64; c.n0 = nt * 128;
    }
    return c;
}
__device__ __forceinline__ void ph_convert(KP p, int l, int bid, int nb, float* sm) {
    const int tid = opaque_tid();
    const int NP = ((l & 1) == 0) ? EVEN_LD : ODD_LD;
    const int total = 16 * (NP / 128) + 16 * 8 + 65 * 16 * 4 + 65 * 4 * 8;
    const int kr = tid >> 5, np4 = (tid & 31) * 4;
    float4 v[4];
    int t = bid;
    CvtTile c = cvt_tile_of(p, l, t < total ? t : 0, np4);
    if (t < total) {
#pragma unroll
        for (int j = 0; j < 4; ++j) v[j] = *(const float4*)(c.src + (size_t)(c.k0 + kr + 16 * j) * c.srcld);
    }
#pragma unroll 1
    for (; t < total; t += nb) {
        __syncthreads();
#pragma unroll
        for (int j = 0; j < 4; ++j) { float* d = sm + (np4) * 65 + kr + 16 * j; d[0] = v[j].x; d[65] = v[j].y; d[130] = v[j].z; d[195] = v[j].w; }
        const CvtTile cur = c;
        const int tn = t + nb;
        if (tn < total) {
            c = cvt_tile_of(p, l, tn, np4);
#pragma unroll
            for (int j = 0; j < 4; ++j) v[j] = *(const float4*)(c.src + (size_t)(c.k0 + kr + 16 * j) * c.srcld);
        }
        __syncthreads();
        const int n = tid >> 2, kc = (tid & 3) * 16;
        unsigned w[8];
#pragma unroll
        for (int q = 0; q < 8; ++q) w[q] = cvt_pk_bf16(sm[n * 65 + kc + 2 * q], sm[n * 65 + kc + 2 * q + 1]);
        uint4* d4 = (uint4*)(cur.dst + (size_t)(cur.n0 + n) * cur.dstld + cur.k0 + kc);
        d4[0] = make_uint4(w[0], w[1], w[2], w[3]); d4[1] = make_uint4(w[4], w[5], w[6], w[7]);
    }
    __syncthreads();
    if (bid < 8) {
        const float* rw = p->in[I_RW] + (size_t)l * 1024 * 64;
        bf16_t* hi = (bf16_t*)(p->ws + OFF_RWH); bf16_t* lo = hi + 64 * 1024;
        const int e = tid & 63, kb = bid * 128 + (tid >> 6) * 16;
#pragma unroll
        for (int i = 0; i < 16; i += 2) {
            const float x0 = rw[(size_t)(kb + i) * 64 + e], x1 = rw[(size_t)(kb + i + 1) * 64 + e];
            const unsigned h = cvt_pk_bf16(x0, x1);
            const unsigned lw = cvt_pk_bf16(x0 - bflo(h), x1 - bfhi(h));
            *(unsigned*)(hi + (size_t)e * 1024 + kb + i) = h; *(unsigned*)(lo + (size_t)e * 1024 + kb + i) = lw;
        }
    }
}

namespace gp {
typedef short bf16x8 __attribute__((ext_vector_type(8)));
typedef float f32x4 __attribute__((ext_vector_type(4)));
typedef unsigned u32x4 __attribute__((ext_vector_type(4)));
typedef unsigned u32x2 __attribute__((ext_vector_type(2)));
constexpr int BM = 256, BK = 64, HALF = 128, HTB = HALF * BK * 2, STAGE_BYTES = 8 * HTB, NXCD = 8, WGM = 8;
__device__ __forceinline__ int lds_byte(int r, int c) { const int st = (r >> 4) * 2 + (c >> 5), rr = r & 15, cc = c & 31, ob = rr * 64 + cc * 2; return st * 1024 + (ob ^ (((ob >> 9) & 1) << 5)); }
__device__ __forceinline__ void stage_rc(int b, int& R, int& C) { const int st = b / 1024, sb = b % 1024, swz = sb ^ (((sb >> 9) & 1) << 5); R = (st >> 1) * 16 + swz / 64; C = (st & 1) * 32 + (swz % 64) / 2; }
__device__ __forceinline__ int perm32(int rho) { const int n = rho >> 4, i = rho & 15; return 8 * (i >> 2) + 4 * n + (i & 3); }

struct Unit { const char* A; const char* B; int r0, c0, aux; };

struct DenseSched {
    const char* A; const char* B; int nM, nN, nwg, G, c; size_t tstep;
    __device__ __forceinline__ void init(const void* A_, const void* B_, int M, int N, int K, int G_, int c_) { A = (const char*)A_; B = (const char*)B_; nM = M / BM; nN = N / BM; nwg = nM * nN; G = G_; c = c_; tstep = (size_t)BM * K * 2; }
    __device__ __forceinline__ bool next(int i, Unit& u) const {
        const long L = (long)i * G + c; if (L >= nwg) return false;
        int wgid = (int)L; { const int q = nwg / NXCD, r = nwg % NXCD, xcd = wgid % NXCD, off = wgid / NXCD; wgid = (xcd < r ? xcd * (q + 1) : r * (q + 1) + (xcd - r) * q) + off; }
        const int nig = WGM * nN, gid = wgid / nig, fm = gid * WGM, gsz = (nM - fm) < WGM ? (nM - fm) : WGM;
        const int pm = fm + ((wgid % nig) % gsz), pn = (wgid % nig) / gsz;
        u.A = A + (size_t)pm * tstep; u.B = B + (size_t)pn * tstep; u.r0 = pm * BM; u.c0 = pn * BM; u.aux = 0; return true;
    }
    __device__ __forceinline__ void lane_off(const Unit&, unsigned (&)[2][2]) const {}
};

template <bool GATHER, bool PERM, class Sched, class Epi>
__device__ __forceinline__ void gemm_phase(LAS unsigned char* lds, const int K_, const Sched& S, const Epi& E) {
    int K = K_; asm volatile("" : "+s"(K));
    const int tid = opaque_tid(), wid = __builtin_amdgcn_readfirstlane(tid >> 6), lane = tid & 63, wr = wid >> 2, wc = wid & 3, fr = lane & 15, fq = lane >> 4;
    const int nt = K / BK;
    unsigned voffA[2], voffB[2];
#pragma unroll
    for (int i = 0; i < 2; ++i) { int R, C; stage_rc(tid * 16 + i * 8192, R, C); const int Rb = PERM ? ((R & ~31) + perm32(R & 31)) : R;
        voffA[i] = (unsigned)(R * K + C) * 2u; voffB[i] = (unsigned)(Rb * K + C) * 2u; }
    const size_t kstep = (size_t)(BK * 2);
    const size_t hstep = (size_t)HALF * K * 2;
    const unsigned ldsw = (unsigned)wid * 1024u;
    const int aoff = lds_byte(wr * 64 + fr, fq * 8), boff = lds_byte(wc * 32 + fr, fq * 8);
    unsigned cvo[2][2] = {{0u, 0u}, {0u, 0u}}, nvo[2][2] = {{0u, 0u}, {0u, 0u}};
#define GP_SA(b, h) (((b) * 2 + (h)) * HTB)
#define GP_SB(b, h) ((4 + (b) * 2 + (h)) * HTB)
#define GP_GLDS(gp_, lp_) __builtin_amdgcn_global_load_lds((const unsigned*)(gp_), (LAS unsigned*)(lp_), 16, 0, 0)
#define GP_STAGE_B(bufoff, gbase, h) do { const char* _g = (gbase) + (size_t)(h) * hstep; \
        GP_GLDS(_g + voffB[0], lds + (bufoff) + ldsw); GP_GLDS(_g + voffB[1], lds + (bufoff) + ldsw + 8192); } while (0)
#define GP_STAGE_A(bufoff, gbase, h, usenext) do { \
        if (GATHER) { const unsigned _o0 = (usenext) ? nvo[h][0] : cvo[h][0], _o1 = (usenext) ? nvo[h][1] : cvo[h][1]; \
            GP_GLDS((gbase) + _o0, lds + (bufoff) + ldsw); GP_GLDS((gbase) + _o1, lds + (bufoff) + ldsw + 8192); } \
        else { const char* _g = (gbase) + (size_t)(h) * hstep; GP_GLDS(_g + voffA[0], lds + (bufoff) + ldsw); GP_GLDS(_g + voffA[1], lds + (bufoff) + ldsw + 8192); } } while (0)
#define GP_LDA(dst, b, h) do { _Pragma("unroll") for (int m = 0; m < 4; ++m) _Pragma("unroll") for (int k = 0; k < 2; ++k) dst[m][k] = *(const LAS bf16x8*)(lds + GP_SA(b, h) + aoff + m * 2048 + k * 1024); } while (0)
#define GP_LDB(dst, b, h) do { _Pragma("unroll") for (int n = 0; n < 2; ++n) _Pragma("unroll") for (int k = 0; k < 2; ++k) dst[n][k] = *(const LAS bf16x8*)(lds + GP_SB(b, h) + boff + n * 2048 + k * 1024); } while (0)
#define GP_MMA(ai, bj, At, Bt) do { __builtin_amdgcn_s_setprio(1); _Pragma("unroll") for (int m = 0; m < 4; ++m) _Pragma("unroll") for (int n = 0; n < 2; ++n) _Pragma("unroll") for (int k = 0; k < 2; ++k) \
        acc[ai][bj][m][n] = __builtin_amdgcn_mfma_f32_16x16x32_bf16(Bt[n][k], At[m][k], acc[ai][bj][m][n], 0, 0, 0); __builtin_amdgcn_s_setprio(0); } while (0)
#define GP_WAIT_V(n) asm volatile("s_waitcnt vmcnt(" #n ")" ::: "memory")
#define GP_WAIT_L(n) asm volatile("s_waitcnt lgkmcnt(" #n ")" ::: "memory")
#define GP_BAR __builtin_amdgcn_s_barrier()
#define GP_SCHED __builtin_amdgcn_sched_barrier(0)
    Unit cur, nxt; int ui = 0;
    if (!S.next(0, cur)) return;
    f32x4 acc[2][2][4][2];
#pragma unroll
    for (int a = 0; a < 2; ++a)
#pragma unroll
        for (int b = 0; b < 2; ++b)
#pragma unroll
            for (int m = 0; m < 4; ++m)
#pragma unroll
                for (int n = 0; n < 2; ++n) acc[a][b][m][n] = (f32x4){0.f, 0.f, 0.f, 0.f};
    bf16x8 At[4][2], B0[2][2], B1[2][2];
    if (GATHER) S.lane_off(cur, cvo);
    const char* cA = cur.A; const char* cB = cur.B;
    GP_STAGE_B(GP_SB(0, 0), cB, 0); GP_STAGE_A(GP_SA(0, 0), cA, 0, false); GP_STAGE_B(GP_SB(0, 1), cB, 1); GP_STAGE_A(GP_SA(0, 1), cA, 1, false);
    if (wr == 1) GP_BAR;
    GP_WAIT_V(4); GP_BAR;
    GP_STAGE_B(GP_SB(1, 0), cB + kstep, 0); GP_STAGE_A(GP_SA(1, 0), cA + kstep, 0, false); GP_STAGE_B(GP_SB(1, 1), cB + kstep, 1);
    GP_WAIT_V(6); GP_BAR;
    for (;;) {
        const bool has_next = S.next(ui + 1, nxt);
        if (GATHER && has_next) S.lane_off(nxt, nvo);
        const char* nA = has_next ? nxt.A : cA; const char* nB = has_next ? nxt.B : cB;
        for (int t = 0; t < nt; t += 2) {
            const bool last = (t == nt - 2);
            const bool un = last && has_next;
            const char* a1 = cA + (size_t)(t + 1) * kstep;
            const char* a2 = last ? nA : cA + (size_t)(t + 2) * kstep; const char* b2 = last ? nB : cB + (size_t)(t + 2) * kstep;
            const char* a3 = a2 + kstep; const char* b3 = b2 + kstep;
            GP_LDB(B0, 0, 0); GP_SCHED; GP_LDA(At, 0, 0); GP_STAGE_A(GP_SA(1, 1), a1, 1, false);
            GP_WAIT_L(8); GP_BAR; GP_WAIT_L(0); GP_MMA(0, 0, At, B0); GP_BAR; GP_SCHED;
            GP_LDB(B1, 0, 1); GP_STAGE_B(GP_SB(0, 0), b2, 0);
            GP_BAR; GP_WAIT_L(0); GP_MMA(0, 1, At, B1); GP_BAR;
            GP_LDA(At, 0, 1); GP_STAGE_A(GP_SA(0, 0), a2, 0, un);
            GP_BAR; GP_WAIT_L(0); GP_MMA(1, 0, At, B0); GP_BAR; GP_SCHED;
            GP_STAGE_B(GP_SB(0, 1), b2, 1);
            GP_WAIT_V(6); GP_BAR; GP_MMA(1, 1, At, B1); GP_BAR;
            GP_LDB(B0, 1, 0); GP_SCHED; GP_LDA(At, 1, 0); GP_STAGE_A(GP_SA(0, 1), a2, 1, un);
            GP_WAIT_L(8); GP_BAR; GP_WAIT_L(0); GP_MMA(0, 0, At, B0); GP_BAR; GP_SCHED;
            GP_LDB(B1, 1, 1); GP_STAGE_B(GP_SB(1, 0), b3, 0);
            GP_BAR; GP_WAIT_L(0); GP_MMA(0, 1, At, B1); GP_BAR;
            GP_LDA(At, 1, 1); GP_STAGE_A(GP_SA(1, 0), a3, 0, un);
            GP_BAR; GP_WAIT_L(0); GP_MMA(1, 0, At, B0); GP_BAR; GP_SCHED;
            GP_STAGE_B(GP_SB(1, 1), b3, 1);
            GP_WAIT_V(6); GP_BAR; GP_MMA(1, 1, At, B1); GP_BAR;
        }
        E(acc, cur, wr, wc, fr, fq);
        if (!has_next) break;
#pragma unroll
        for (int a = 0; a < 2; ++a)
#pragma unroll
            for (int b = 0; b < 2; ++b)
#pragma unroll
                for (int m = 0; m < 4; ++m)
#pragma unroll
                    for (int n = 0; n < 2; ++n) acc[a][b][m][n] = (f32x4){0.f, 0.f, 0.f, 0.f};
        cur = nxt; cA = nA; cB = nB; ++ui;
        if (GATHER) { cvo[0][0] = nvo[0][0]; cvo[0][1] = nvo[0][1]; cvo[1][0] = nvo[1][0]; cvo[1][1] = nvo[1][1]; }
    }
    GP_WAIT_V(0);
    if (wr == 0) GP_BAR;
    GP_BAR;
#undef GP_SA
#undef GP_SB
#undef GP_GLDS
#undef GP_STAGE_A
#undef GP_STAGE_B
#undef GP_LDA
#undef GP_LDB
#undef GP_MMA
#undef GP_WAIT_V
#undef GP_WAIT_L
#undef GP_BAR
#undef GP_SCHED
}

struct EpiF32 {
    float* C; int ldc;
    __device__ __forceinline__ void operator()(const f32x4 (&acc)[2][2][4][2], const Unit& u, int wr, int wc, int fr, int fq) const {
        const int row0 = u.r0 + wr * 64 + fr, col0 = u.c0 + wc * 32 + 4 * fq;
#pragma unroll
        for (int ai = 0; ai < 2; ++ai)
#pragma unroll
            for (int m = 0; m < 4; ++m) { float* rowp = C + (size_t)(row0 + ai * HALF + m * 16) * ldc + col0;
#pragma unroll
                for (int bj = 0; bj < 2; ++bj)
#pragma unroll
                    for (int n = 0; n < 2; ++n) *(f32x4*)(rowp + bj * HALF + n * 16) = acc[ai][bj][m][n];
                __builtin_amdgcn_sched_barrier(0); }
    }
};
struct EpiBf16 {
    bf16_t* O; int ldc;
    __device__ __forceinline__ void operator()(const f32x4 (&acc)[2][2][4][2], const Unit& u, int wr, int wc, int fr, int fq) const {
        const int row0 = u.r0 + wr * 64 + fr, col0 = u.c0 + wc * 32 + 8 * fq;
#pragma unroll
        for (int ai = 0; ai < 2; ++ai)
#pragma unroll
            for (int m = 0; m < 4; ++m) { bf16_t* rowp = O + (size_t)(row0 + ai * HALF + m * 16) * ldc + col0;
#pragma unroll
                for (int bj = 0; bj < 2; ++bj) { const f32x4 v0 = acc[ai][bj][m][0], v1 = acc[ai][bj][m][1];
                    u32x4 w; w.x = cvt_pk_bf16(v0[0], v0[1]); w.y = cvt_pk_bf16(v0[2], v0[3]); w.z = cvt_pk_bf16(v1[0], v1[1]); w.w = cvt_pk_bf16(v1[2], v1[3]);
                    *(u32x4*)(rowp + bj * HALF) = w; }
                __builtin_amdgcn_sched_barrier(0); }
    }
};
}


typedef float f32x4_l __attribute__((ext_vector_type(4)));
__device__ __forceinline__ void stage_gate_w(KP p, int e, LAS float* wl) {
    const int tid = opaque_tid();
    const float* wg = p->in[I_EWIN] + (size_t)e * 1024 * EVEN_N + 1536;
#pragma unroll
    for (int i = 0; i < 8; ++i) { const int idx = tid + 512 * i, d = idx >> 2, j4 = idx & 3; const float4 w = *(const float4*)(wg + (size_t)d * EVEN_N + j4 * 4); *(LAS f32x4_l*)(wl + d * 16 + j4 * 4) = (f32x4_l){w.x, w.y, w.z, w.w}; }
    __syncthreads();
}
__device__ __forceinline__ void ph_modin(KP p, int l, int bid, int nb) {
    const int tid = opaque_tid(), lane = tid & 63, wv = tid >> 6;
    const bool even = (l & 1) == 0;
    bf16_t* U = (bf16_t*)(p->ws + OFF_U);
    float* G = (float*)(p->ws + OFF_G);
    LAS float* wl = (LAS float*)smraw_base();
    if (even) stage_gate_w(p, l >> 1, wl);
    #pragma unroll 1
    for (int tok = bid * 8 + wv; tok < NT; tok += nb * 8) {
        const float* h = hrow(p, tok);
        const float* m = modrow(p, l, tok);
        float ga[16];
#pragma unroll
        for (int j = 0; j < 16; ++j) ga[j] = 0.f;
#pragma unroll
        for (int c = 0; c < 4; ++c) {
            const int d = 4 * (lane + 64 * c);
            const float4 hv = *(const float4*)(h + d), sh = *(const float4*)(m + d), sc = *(const float4*)(m + 1024 + d);
            const float u0 = hv.x * (1.f + sc.x) + sh.x, u1 = hv.y * (1.f + sc.y) + sh.y, u2 = hv.z * (1.f + sc.z) + sh.z, u3 = hv.w * (1.f + sc.w) + sh.w;
            *(uint2*)(U + (size_t)tok * DM + d) = make_uint2(cvt_pk_bf16(u0, u1), cvt_pk_bf16(u2, u3));
            if (even) {
                const float uu[4] = {u0, u1, u2, u3};
#pragma unroll
                for (int q = 0; q < 4; ++q) {
#pragma unroll
                    for (int j4 = 0; j4 < 4; ++j4) { const f32x4_l w = *(const LAS f32x4_l*)(wl + (d + q) * 16 + j4 * 4); ga[4 * j4] += uu[q] * w[0]; ga[4 * j4 + 1] += uu[q] * w[1]; ga[4 * j4 + 2] += uu[q] * w[2]; ga[4 * j4 + 3] += uu[q] * w[3]; }
                }
                __builtin_amdgcn_sched_barrier(0);
            }
        }
        if (even) {
            float mine = 0.f;
#pragma unroll
            for (int j = 0; j < 16; ++j) { const float s = wave_sum(ga[j]); if (lane == j) mine = s; }
            if (lane < 16) G[(size_t)tok * 16 + lane] = mine;
        }
    }
}

__device__ __forceinline__ void ph_gemm_in(KP p, int l, int bid, int nb, LAS unsigned char* lds) {
    const int N = ((l & 1) == 0) ? EVEN_LD : ODD_LD;
    gp::DenseSched S; S.init(p->ws + OFF_U, p->ws + OFF_WIN, NT, N, 1024, nb, bid);
    gp::EpiBf16 E{(bf16_t*)(p->ws + OFF_BIG), N};
    gp::gemm_phase<false, true>(lds, 1024, S, E);
}
__device__ __forceinline__ void ph_gemm_out(KP p, int l, int bid, int nb, LAS unsigned char* lds) {
    gp::DenseSched S; S.init(p->ws + OFF_U, p->ws + OFF_WOUT, NT, 1024, 1024, nb, bid);
    gp::EpiBf16 E{(bf16_t*)(p->ws + OFF_BIG), 1024};
    gp::gemm_phase<false, true>(lds, 1024, S, E);
}


namespace sc {
typedef short bf16x8 __attribute__((ext_vector_type(8)));
typedef short bf16x4 __attribute__((ext_vector_type(4)));
typedef float f32x4 __attribute__((ext_vector_type(4)));
#define SC_MFMA(a, b, c) __builtin_amdgcn_mfma_f32_16x16x32_bf16(a, b, c, 0, 0, 0)
__device__ __forceinline__ bf16x8 rd_row(unsigned img, int row, int stride, int k0) { return *(const LAS bf16x8*)(size_t)(img + (unsigned)(row * stride + k0 * 2)); }
__device__ __forceinline__ bf16x8 rd_tr(unsigned img, int k0, int n0, int stride, int lane) {
    const int g = lane >> 4, i = lane & 15;
    const unsigned a0 = img + (unsigned)((k0 + 8 * g + (i >> 2)) * stride + (n0 + 4 * (i & 3)) * 2), a1 = a0 + 4u * (unsigned)stride;
    bf16x4 lo, hi;
    asm volatile("ds_read_b64_tr_b16 %0, %2\n\tds_read_b64_tr_b16 %1, %3\n\ts_waitcnt lgkmcnt(0)" : "=&v"(lo), "=&v"(hi) : "v"(a0), "v"(a1) : "memory");
    return (bf16x8){lo[0], lo[1], lo[2], lo[3], hi[0], hi[1], hi[2], hi[3]};
}
typedef unsigned u32x2_ __attribute__((ext_vector_type(2)));
typedef unsigned u32x4_ __attribute__((ext_vector_type(4)));
__device__ __forceinline__ unsigned tr_addr(unsigned img, int k0, int n0, int stride, int lane) { const int g = lane >> 4, i = lane & 15; return img + (unsigned)((k0 + 8 * g + (i >> 2)) * stride + (n0 + 4 * (i & 3)) * 2); }
__device__ __forceinline__ void rd_tr5(const unsigned (&a0)[5], const unsigned (&s4)[5], bf16x8 (&o)[5]) {
    bf16x4 l0, h0, l1, h1, l2, h2, l3, h3, l4, h4;
    asm volatile("ds_read_b64_tr_b16 %0, %10\n\tds_read_b64_tr_b16 %1, %11\n\tds_read_b64_tr_b16 %2, %12\n\tds_read_b64_tr_b16 %3, %13\n\tds_read_b64_tr_b16 %4, %14\n\t"
                 "ds_read_b64_tr_b16 %5, %15\n\tds_read_b64_tr_b16 %6, %16\n\tds_read_b64_tr_b16 %7, %17\n\tds_read_b64_tr_b16 %8, %18\n\tds_read_b64_tr_b16 %9, %19\n\ts_waitcnt lgkmcnt(0)"
                 : "=&v"(l0), "=&v"(h0), "=&v"(l1), "=&v"(h1), "=&v"(l2), "=&v"(h2), "=&v"(l3), "=&v"(h3), "=&v"(l4), "=&v"(h4)
                 : "v"(a0[0]), "v"(a0[0] + s4[0]), "v"(a0[1]), "v"(a0[1] + s4[1]), "v"(a0[2]), "v"(a0[2] + s4[2]), "v"(a0[3]), "v"(a0[3] + s4[3]), "v"(a0[4]), "v"(a0[4] + s4[4]) : "memory");
    o[0] = (bf16x8){l0[0], l0[1], l0[2], l0[3], h0[0], h0[1], h0[2], h0[3]}; o[1] = (bf16x8){l1[0], l1[1], l1[2], l1[3], h1[0], h1[1], h1[2], h1[3]};
    o[2] = (bf16x8){l2[0], l2[1], l2[2], l2[3], h2[0], h2[1], h2[2], h2[3]}; o[3] = (bf16x8){l3[0], l3[1], l3[2], l3[3], h3[0], h3[1], h3[2], h3[3]};
    o[4] = (bf16x8){l4[0], l4[1], l4[2], l4[3], h4[0], h4[1], h4[2], h4[3]};
}
__device__ __forceinline__ void st8(unsigned addr, uint2 v) { *(LAS u32x2_*)(size_t)addr = (u32x2_){v.x, v.y}; }
__device__ __forceinline__ void st16(unsigned addr, uint4 v) { *(LAS u32x4_*)(size_t)addr = (u32x4_){v.x, v.y, v.z, v.w}; }
__device__ __forceinline__ float scan_add64(float v, int lane) {
#pragma unroll
    for (int o = 1; o < 64; o <<= 1) { const float t = SHU(v, o); if (lane >= o) v += t; }
    return v;
}
__device__ __forceinline__ float scan_max64(float v, int lane) {
#pragma unroll
    for (int o = 1; o < 64; o <<= 1) { const float t = SHU(v, o); if (lane >= o) v = fmaxf(v, t); }
    return v;
}

template <int MODE>
__device__ __forceinline__ void scan_item(KP p, int l, int b, int h, int dir, int vs) {
    constexpr int CS = (MODE == 1) ? 32 : 64, DK = (MODE == 0) ? 64 : 128, EXT = (MODE == 0) ? 1 : 0;
    constexpr int QS = (DK + 8) * 2, VS = (64 + 16 * EXT + 8) * 2, SS = (CS + 8) * 2, NVR = 64 + 16 * EXT;
    constexpr int NCH = (CTXL + SEQ) / CS;
    constexpr int LD = (MODE == 2) ? ODD_LD : EVEN_LD;
    constexpr unsigned O_QA = 0, O_KA = O_QA + CS * QS, O_QB = O_KA + CS * QS, O_KW = O_QB + (MODE == 1 ? CS * QS : 0), O_V = O_KW + CS * QS,
                       O_SSC = O_V + CS * VS, O_ST = O_SSC + CS * SS, O_DKV = O_ST + 2 * NVR * QS, O_END = O_DKV + 512;
    static_assert(O_END <= 131072, "scan LDS");
    const int tid = opaque_tid(), lane = tid & 63, wv = __builtin_amdgcn_readfirstlane(tid >> 6), r16 = lane & 15, q4 = lane >> 4;
    const unsigned L0 = (unsigned)(size_t)smraw_base();
    const bf16_t* P = (const bf16_t*)(p->ws + OFF_BIG);
    bf16_t* HXo = (bf16_t*)(p->ws + OFF_AUX) + (size_t)dir * NT * 1024;
    const int e2 = l >> 1;
    const int cQ = (MODE == 0) ? E_MQ + h * 64 : (MODE == 1) ? E_HQ + h * 128 : 1536 + h * 128;
    const int cK = (MODE == 0) ? E_MK + h * 64 : (MODE == 1) ? (dir ? E_HFB : E_HFF) + h * 128 : 2048 + h * 128;
    const int cV = (MODE == 0) ? E_MV + h * 128 + vs * 64 : (MODE == 1) ? E_HI + h * 128 + vs * 64 : 2560 + h * 128 + vs * 64;
    const int cO = (MODE == 0) ? h * 128 + vs * 64 : 512 + h * 128 + vs * 64;
    const int lt = (MODE == 1) ? (tid & 31) : (tid >> 3);
    const int lj = (MODE == 0) ? (tid & 7) : (MODE == 1) ? (tid >> 5) : ((tid >> 2) & 1) * 8 + (tid & 3);
    const int vt_ = tid >> 3, vj = tid & 7;
    float lbv[8]; float gbi = 0.f, gbf = 0.f, lg = 0.f;
    if (MODE == 1) {
        const float* lbp = (const float*)(p->ws + OFF_LB) + e2 * 512 + h * 128 + lj * 8;
#pragma unroll
        for (int i = 0; i < 8; ++i) lbv[i] = lbp[i];
    } else {
#pragma unroll
        for (int i = 0; i < 8; ++i) lbv[i] = 0.f;
    }
    if (MODE == 0) { const float* gb = p->in[I_MGB] + e2 * 16; gbi = gb[(dir ? 2 : 0) * 4 + h]; gbf = gb[(dir ? 3 : 1) * 4 + h]; }
    if (MODE == 2) lg = p->in[I_RLD][e2 * 8 + dir * 4 + h];
    const float* G = (const float*)(p->ws + OFF_G);
    const float* ropet = (const float*)(p->ws + OFF_ROPE);
    unsigned oz = 0u; asm volatile("" : "+v"(oz));
    for (unsigned o = tid * 16; o < 2u * NVR * QS; o += 512 * 16) st16(L0 + O_ST + o, make_uint4(oz, oz, oz, oz));
    if (EXT) { if (tid < CS) { st16(L0 + O_V + tid * VS + 128, make_uint4(0x3f80u | oz, oz, oz, oz)); st16(L0 + O_V + tid * VS + 144, make_uint4(oz, oz, oz, oz)); } }
    f32x4 sacc[4];
#pragma unroll
    for (int i = 0; i < 4; ++i) sacc[i] = (f32x4){0.f, 0.f, 0.f, 0.f};
    float m_in = -1e30f;
    struct Raw { uint4 rq0, rq1, rk0, rk1, rv; float rg0, rg1; };
    Raw RA, RB;
    RA.rq1 = make_uint4(0u, 0u, 0u, 0u); RA.rk1 = RA.rq1; RA.rv = RA.rq1; RA.rg0 = 0.f; RA.rg1 = 0.f; RB = RA;
    auto load_chunk = [&](Raw& R, int c) {
        const int i0 = c * CS;
        const int tq = scan_tok(b, i0 + lt, dir);
        const bf16_t* pr = P + (size_t)tq * LD;
        R.rq0 = *(const uint4*)(pr + cQ + lj * 8); R.rk0 = *(const uint4*)(pr + cK + lj * 8);
        if (MODE == 2) { R.rq1 = *(const uint4*)(pr + cQ + lj * 8 + 32); R.rk1 = *(const uint4*)(pr + cK + lj * 8 + 32); }
        if (MODE != 1 || tid < 256) { const int tv = scan_tok(b, i0 + vt_, dir); R.rv = *(const uint4*)(P + (size_t)tv * LD + cV + vj * 8); }
        if (MODE == 0) { const int tg = scan_tok(b, i0 + lane, dir); R.rg0 = G[(size_t)tg * 16 + (dir ? 8 : 0) + h]; R.rg1 = G[(size_t)tg * 16 + (dir ? 12 : 4) + h]; }
    };
    constexpr int PD = (MODE == 2) ? 1 : 2;
    load_chunk(RA, 0); if (PD == 2) load_chunk(RB, 1);
    auto chunk = [&](const int c, Raw& R) {
        const uint4 rq0 = R.rq0, rq1 = R.rq1, rk0 = R.rk0, rk1 = R.rk1, rv = R.rv; const float rg0 = R.rg0, rg1 = R.rg1;
        const unsigned ST_R = L0 + O_ST + (unsigned)(c & 1) * NVR * QS, ST_W = L0 + O_ST + (unsigned)((c + 1) & 1) * NVR * QS;
        float sp = 1.f;
        float v_u = 0.f, v_M = 0.f, v_e = 1.f, v_low = 0.f, v_w = 1.f;
        if (MODE == 0) {
            const float ig = rg0 + gbi, fg = rg1 + gbf;
            const float lf = fminf(fg, 0.f) - flog(1.f + fexp(-fabsf(fg)));
            const float bb = scan_add64(lf, lane);
            const float g = SHI(bb, 63);
            v_u = ig - bb;
            const float cu = scan_max64(v_u, lane);
            v_M = fmaxf(m_in, cu);
            const float m_new = fmaxf(g + m_in, g + SHI(cu, 63));
            sp = fexp(g + m_in - m_new);
            v_w = fexp(g + v_u - m_new);
            v_e = fexp(m_in - v_M);
            v_low = fexp(-(bb + v_M));
            m_in = m_new;
            st16(L0 + O_QA + lt * QS + lj * 16, rq0);
            st16(L0 + O_KA + lt * QS + lj * 16, rk0);
            const float wr = SHI(v_w, lt);
            uint4 kw; kw.x = cvt_pk_bf16(bflo(rk0.x) * wr, bfhi(rk0.x) * wr); kw.y = cvt_pk_bf16(bflo(rk0.y) * wr, bfhi(rk0.y) * wr);
            kw.z = cvt_pk_bf16(bflo(rk0.z) * wr, bfhi(rk0.z) * wr); kw.w = cvt_pk_bf16(bflo(rk0.w) * wr, bfhi(rk0.w) * wr);
            st16(L0 + O_KW + lt * QS + lj * 16, kw);
            st16(L0 + O_V + vt_ * VS + vj * 16, rv);
        } else if (MODE == 2) {
            sp = fexp(64.f * lg);
            const bool lat = c >= CTXL / CS;
            float q[16], k[16];
            const unsigned qa[8] = {rq0.x, rq0.y, rq0.z, rq0.w, rq1.x, rq1.y, rq1.z, rq1.w}, ka[8] = {rk0.x, rk0.y, rk0.z, rk0.w, rk1.x, rk1.y, rk1.z, rk1.w};
#pragma unroll
            for (int i = 0; i < 8; ++i) { q[2 * i] = bflo(qa[i]); q[2 * i + 1] = bfhi(qa[i]); k[2 * i] = bflo(ka[i]); k[2 * i + 1] = bfhi(ka[i]); }
            if (lat) {
                const int tq = scan_tok(b, c * CS + lt, dir), tt = tq & (SEQ - 1);
                const int pos = ((tid >> 2) & 1) ? (tt & 63) : (tt >> 6);
                const float2* rt = (const float2*)ropet + pos * 32 + (tid & 3) * 8;
#pragma unroll
                for (int i = 0; i < 8; ++i) {
                    const float2 cs2 = rt[i];
                    const float q1 = q[i], q2 = q[8 + i], k1 = k[i], k2 = k[8 + i];
                    q[i] = q1 * cs2.x - q2 * cs2.y; q[8 + i] = q1 * cs2.y + q2 * cs2.x;
                    k[i] = k1 * cs2.x - k2 * cs2.y; k[8 + i] = k1 * cs2.y + k2 * cs2.x;
                }
            }
            const float wr = 0.08838834764831845f * fexp((float)(63 - lt) * lg);
            uint4 o0, o1, w0, w1, x0, x1;
            o0.x = cvt_pk_bf16(q[0], q[1]); o0.y = cvt_pk_bf16(q[2], q[3]); o0.z = cvt_pk_bf16(q[4], q[5]); o0.w = cvt_pk_bf16(q[6], q[7]);
            o1.x = cvt_pk_bf16(q[8], q[9]); o1.y = cvt_pk_bf16(q[10], q[11]); o1.z = cvt_pk_bf16(q[12], q[13]); o1.w = cvt_pk_bf16(q[14], q[15]);
            w0.x = cvt_pk_bf16(k[0], k[1]); w0.y = cvt_pk_bf16(k[2], k[3]); w0.z = cvt_pk_bf16(k[4], k[5]); w0.w = cvt_pk_bf16(k[6], k[7]);
            w1.x = cvt_pk_bf16(k[8], k[9]); w1.y = cvt_pk_bf16(k[10], k[11]); w1.z = cvt_pk_bf16(k[12], k[13]); w1.w = cvt_pk_bf16(k[14], k[15]);
            x0.x = cvt_pk_bf16(k[0] * wr, k[1] * wr); x0.y = cvt_pk_bf16(k[2] * wr, k[3] * wr); x0.z = cvt_pk_bf16(k[4] * wr, k[5] * wr); x0.w = cvt_pk_bf16(k[6] * wr, k[7] * wr);
            x1.x = cvt_pk_bf16(k[8] * wr, k[9] * wr); x1.y = cvt_pk_bf16(k[10] * wr, k[11] * wr); x1.z = cvt_pk_bf16(k[12] * wr, k[13] * wr); x1.w = cvt_pk_bf16(k[14] * wr, k[15] * wr);
            st16(L0 + O_QA + lt * QS + lj * 16, o0); st16(L0 + O_QA + lt * QS + lj * 16 + 64, o1);
            st16(L0 + O_KA + lt * QS + lj * 16, w0); st16(L0 + O_KA + lt * QS + lj * 16 + 64, w1);
            st16(L0 + O_KW + lt * QS + lj * 16, x0); st16(L0 + O_KW + lt * QS + lj * 16 + 64, x1);
            st16(L0 + O_V + vt_ * VS + vj * 16, rv);
        } else {
            const unsigned qa[4] = {rq0.x, rq0.y, rq0.z, rq0.w}, fa[4] = {rk0.x, rk0.y, rk0.z, rk0.w};
            float qv[8], kk[8], A[8];
#pragma unroll
            for (int i = 0; i < 8; ++i) {
                const float qr = (i & 1) ? bfhi(qa[i >> 1]) : bflo(qa[i >> 1]), fr = (i & 1) ? bfhi(fa[i >> 1]) : bflo(fa[i >> 1]);
                const float f = lbv[i] + (1.f - lbv[i]) * fsigmoid(fr);
                qv[i] = fsilu(qr); kk[i] = 1.f - f; A[i] = flog(f);
            }
#pragma unroll
            for (int o = 1; o < 32; o <<= 1)
#pragma unroll
                for (int i = 0; i < 8; ++i) { const float t = SHU(A[i], o); if (lt >= o) A[i] += t; }
            float qa_[8], qb_[8], ka_[8], kw_[8];
#pragma unroll
            for (int i = 0; i < 8; ++i) {
                const float am = SHI32(A[i], 15), ae = SHI32(A[i], 31);
                qa_[i] = qv[i] * fexp(A[i] - am); qb_[i] = qv[i] * fexp(A[i]); ka_[i] = kk[i] * fexp(am - A[i]); kw_[i] = kk[i] * fexp(ae - A[i]);
                if (lt == 31) *(LAS float*)(size_t)(L0 + O_DKV + (lj * 8 + i) * 4) = fexp(ae);
            }
            uint4 w;
            w.x = cvt_pk_bf16(qa_[0], qa_[1]); w.y = cvt_pk_bf16(qa_[2], qa_[3]); w.z = cvt_pk_bf16(qa_[4], qa_[5]); w.w = cvt_pk_bf16(qa_[6], qa_[7]); st16(L0 + O_QA + lt * QS + lj * 16, w);
            w.x = cvt_pk_bf16(qb_[0], qb_[1]); w.y = cvt_pk_bf16(qb_[2], qb_[3]); w.z = cvt_pk_bf16(qb_[4], qb_[5]); w.w = cvt_pk_bf16(qb_[6], qb_[7]); st16(L0 + O_QB + lt * QS + lj * 16, w);
            w.x = cvt_pk_bf16(ka_[0], ka_[1]); w.y = cvt_pk_bf16(ka_[2], ka_[3]); w.z = cvt_pk_bf16(ka_[4], ka_[5]); w.w = cvt_pk_bf16(ka_[6], ka_[7]); st16(L0 + O_KA + lt * QS + lj * 16, w);
            w.x = cvt_pk_bf16(kw_[0], kw_[1]); w.y = cvt_pk_bf16(kw_[2], kw_[3]); w.z = cvt_pk_bf16(kw_[4], kw_[5]); w.w = cvt_pk_bf16(kw_[6], kw_[7]); st16(L0 + O_KW + lt * QS + lj * 16, w);
            if (tid < 256) st16(L0 + O_V + vt_ * VS + vj * 16, rv);
        }
        __syncthreads();
        if (c + PD < NCH) load_chunk(R, c + PD);
        {
            constexpr int NT1 = CS / 16;
            const bool act = (MODE == 1) ? (wv < 4) : true;
            const int tb = (MODE == 1) ? (wv & 1) : (wv & 3);
#pragma unroll
            for (int u2 = 0; u2 < ((MODE == 1) ? 1 : 2); ++u2) {
                const int sb = (MODE == 1) ? (wv >> 1) : 2 * (wv >> 2) + u2;
                if (act) {
                    f32x4 d = (f32x4){0.f, 0.f, 0.f, 0.f};
                    if (sb <= tb) {
#pragma unroll
                        for (int kk2 = 0; kk2 < DK / 32; ++kk2)
                            d = SC_MFMA(rd_row(L0 + O_KA, sb * 16 + r16, QS, kk2 * 32 + q4 * 8), rd_row(L0 + O_QA, tb * 16 + r16, QS, kk2 * 32 + q4 * 8), d);
                        const int t = tb * 16 + r16, s0 = sb * 16 + q4 * 4;
                        if (MODE == 0) {
                            const float Mt = SHI(v_M, t);
#pragma unroll
                            for (int jj = 0; jj < 4; ++jj) { const float us = SHI(v_u, s0 + jj); d[jj] = (s0 + jj <= t) ? d[jj] * 0.125f * fexp(us - Mt) : 0.f; }
                        } else if (MODE == 2) {
#pragma unroll
                            for (int jj = 0; jj < 4; ++jj) d[jj] = (s0 + jj <= t) ? d[jj] * 0.08838834764831845f * fexp((float)(t - s0 - jj) * lg) : 0.f;
                        } else {
#pragma unroll
                            for (int jj = 0; jj < 4; ++jj) d[jj] = (s0 + jj <= t) ? d[jj] : 0.f;
                        }
                    }
                    st8(L0 + O_SSC + (tb * 16 + r16) * SS + (sb * 16 + q4 * 4) * 2, make_uint2(cvt_pk_bf16(d[0], d[1]), cvt_pk_bf16(d[2], d[3])));
                }
            }
            (void)NT1;
        }
        __syncthreads();
        {
            const int tb = (MODE == 1) ? (wv & 1) : (wv & 3);
            const int t = tb * 16 + r16;
            const int tok = scan_tok(b, c * CS + t, dir);
            constexpr int NV = (MODE == 1) ? 1 : 2;
            f32x4 oi[NV + EXT], oo[NV + EXT];
#pragma unroll
            for (int u2 = 0; u2 < NV + EXT; ++u2) {
                const int vt = (u2 == NV) ? 4 : ((MODE == 1) ? (wv >> 1) : 2 * (wv >> 2) + u2);
                f32x4 a1 = (f32x4){0.f, 0.f, 0.f, 0.f}, a2 = a1;
#pragma unroll
                for (int sb2 = 0; sb2 < CS / 32; ++sb2)
                    a1 = SC_MFMA(rd_tr(L0 + O_V, sb2 * 32, vt * 16, VS, lane), rd_row(L0 + O_SSC, t, SS, sb2 * 32 + q4 * 8), a1);
#pragma unroll
                for (int kk2 = 0; kk2 < DK / 32; ++kk2)
                    a2 = SC_MFMA(rd_row(ST_R, vt * 16 + r16, QS, kk2 * 32 + q4 * 8), rd_row(L0 + ((MODE == 1) ? O_QB : O_QA), t, QS, kk2 * 32 + q4 * 8), a2);
                oi[u2] = a1; oo[u2] = a2;
            }
            float den = 1.f, ei = 1.f;
            if (MODE == 0) {
                ei = 0.125f * SHI(v_e, t);
                const float dsum = oi[NV][0] + ei * oo[NV][0];
                const float dd = SHI(dsum, r16);
                den = 1.f / fmaxf(fabsf(dd), SHI(v_low, t));
            } else if (MODE == 2) {
                ei = fexp((float)(t + 1) * lg);
            }
#pragma unroll
            for (int u2 = 0; u2 < NV; ++u2) {
                const int vt = (MODE == 1) ? (wv >> 1) : 2 * (wv >> 2) + u2;
                float o[4];
#pragma unroll
                for (int jj = 0; jj < 4; ++jj) o[jj] = (oi[u2][jj] + ei * oo[u2][jj]) * den;
                *(uint2*)(HXo + (size_t)tok * 1024 + cO + vt * 16 + q4 * 4) = make_uint2(cvt_pk_bf16(o[0], o[1]), cvt_pk_bf16(o[2], o[3]));
            }
        }
        {
            constexpr int NS = (MODE == 0) ? 3 : 4;
            const int kt = (MODE == 0) ? (wv & 3) : wv;
            float dk[4] = {sp, sp, sp, sp};
            if (MODE == 1) { const f32x4 dv = *(const LAS f32x4*)(size_t)(L0 + O_DKV + (kt * 16 + q4 * 4) * 4); dk[0] = dv[0]; dk[1] = dv[1]; dk[2] = dv[2]; dk[3] = dv[3]; }
            f32x4 a[NS];
#pragma unroll
            for (int u2 = 0; u2 < NS; ++u2) { a[u2] = sacc[u2];
#pragma unroll
                for (int jj = 0; jj < 4; ++jj) a[u2][jj] *= dk[jj]; }
#pragma unroll
            for (int sb2 = 0; sb2 < CS / 32; ++sb2) {
                unsigned ta[5], ts[5]; bf16x8 ops[5];
                ta[0] = tr_addr(L0 + O_KW, sb2 * 32, kt * 16, QS, lane); ts[0] = 4u * QS;
#pragma unroll
                for (int u2 = 0; u2 < 4; ++u2) {
                    const int vt = (MODE == 0) ? ((u2 >= 2) ? 4 : 2 * (wv >> 2) + u2) : u2;
                    ta[1 + u2] = tr_addr(L0 + O_V, sb2 * 32, vt * 16, VS, lane); ts[1 + u2] = 4u * VS;
                }
                rd_tr5(ta, ts, ops);
#pragma unroll
                for (int u2 = 0; u2 < NS; ++u2) a[u2] = SC_MFMA(ops[0], ops[1 + u2], a[u2]);
            }
#pragma unroll
            for (int u2 = 0; u2 < NS; ++u2) {
                const int vt = (MODE == 0) ? ((u2 == 2) ? 4 : 2 * (wv >> 2) + u2) : u2;
                sacc[u2] = a[u2];
                st8(ST_W + (vt * 16 + r16) * QS + (kt * 16 + q4 * 4) * 2, make_uint2(cvt_pk_bf16(a[u2][0], a[u2][1]), cvt_pk_bf16(a[u2][2], a[u2][3])));
            }
        }
        __syncthreads();
    };
#pragma unroll 1
    for (int c = 0; c < NCH; c += 2) { chunk(c, RA); if (PD == 2) chunk(c + 1, RB); else chunk(c + 1, RA); }
}
}

__device__ __forceinline__ void ph_scan_even2(KP p, int l, int bid, int nb) {
#pragma unroll 1
    for (int item = bid; item < 256; item += nb) {
        const int kind = item >> 7, b = (item >> 4) & 7, h = (item >> 2) & 3, dir = (item >> 1) & 1, vs = item & 1;
        if (kind == 0) sc::scan_item<0>(p, l, b, h, dir, vs); else sc::scan_item<1>(p, l, b, h, dir, vs);
        __syncthreads();
    }
}
__device__ __forceinline__ void ph_scan_odd2(KP p, int l, int bid, int nb) {
#pragma unroll 1
    for (int item = bid; item < 128; item += nb) {
        const int b = (item >> 4) & 7, h = (item >> 2) & 3, dir = (item >> 1) & 1, vs = item & 1;
        sc::scan_item<2>(p, l, b, h, dir, vs);
        __syncthreads();
    }
}

__device__ __forceinline__ void unpack16(const uint4 a, const uint4 b, float (&x)[16]) {
    x[0] = bflo(a.x); x[1] = bfhi(a.x); x[2] = bflo(a.y); x[3] = bfhi(a.y); x[4] = bflo(a.z); x[5] = bfhi(a.z); x[6] = bflo(a.w); x[7] = bfhi(a.w);
    x[8] = bflo(b.x); x[9] = bfhi(b.x); x[10] = bflo(b.y); x[11] = bfhi(b.y); x[12] = bflo(b.z); x[13] = bfhi(b.z); x[14] = bflo(b.w); x[15] = bfhi(b.w);
}
__device__ __forceinline__ float sum8(float v) { v += SHX(v, 1); v += SHX(v, 2); v += SHX(v, 4); return v; }
template <bool MEANSUB, bool SIG>
__device__ __forceinline__ void head_norm_gate16(const bf16_t* h0, const bf16_t* h1, const bf16_t* gp, const float* nw, bf16_t* out) {
    float a[16], b[16], g[16];
    unpack16(*(const uint4*)h0, *(const uint4*)(h0 + 8), a); unpack16(*(const uint4*)h1, *(const uint4*)(h1 + 8), b); unpack16(*(const uint4*)gp, *(const uint4*)(gp + 8), g);
    float s = 0.f;
#pragma unroll
    for (int i = 0; i < 16; ++i) { a[i] += b[i]; s += a[i]; }
    if (MEANSUB) { const float mean = sum8(s) * (1.f / 128.f);
#pragma unroll
        for (int i = 0; i < 16; ++i) a[i] -= mean; }
    float q = 0.f;
#pragma unroll
    for (int i = 0; i < 16; ++i) q += a[i] * a[i];
    const float r = rsqrtf(sum8(q) * (1.f / 128.f) + LN_EPS);
    unsigned w[8];
#pragma unroll
    for (int i = 0; i < 16; i += 2) {
        const float y0 = a[i] * r * nw[i] * (SIG ? sigmoidf_(g[i]) : siluf_(g[i])), y1 = a[i + 1] * r * nw[i + 1] * (SIG ? sigmoidf_(g[i + 1]) : siluf_(g[i + 1]));
        w[i >> 1] = cvt_pk_bf16(y0, y1);
    }
    *(uint4*)out = make_uint4(w[0], w[1], w[2], w[3]); *(uint4*)(out + 8) = make_uint4(w[4], w[5], w[6], w[7]);
}
__device__ __forceinline__ void ph_normgate_even(KP p, int l, int bid, int nb) {
    const int tid = opaque_tid(), lane = tid & 63, wv = tid >> 6;
    const bf16_t* P = (const bf16_t*)(p->ws + OFF_BIG);
    const bf16_t* HX = (const bf16_t*)(p->ws + OFF_AUX);
    const bf16_t* HX1 = HX + (size_t)NT * 1024;
    bf16_t* MIX = (bf16_t*)(p->ws + OFF_U);
    const int e = l >> 1;
    const bool ml = lane < 32;
    const float* nw = ml ? p->in[I_MNW] + e * 512 + 16 * lane : p->in[I_HNW] + e * 512 + 16 * (lane - 32);
    const int gcol = ml ? E_MO + 16 * lane : E_HG + 16 * (lane - 32);
#pragma unroll 1
    for (int tok = bid * 8 + wv; tok < NT; tok += nb * 8) {
        const size_t o = (size_t)tok * 1024 + 16 * lane;
        if (ml) head_norm_gate16<true, true>(HX + o, HX1 + o, P + (size_t)tok * EVEN_LD + gcol, nw, MIX + o);
        else head_norm_gate16<false, false>(HX + o, HX1 + o, P + (size_t)tok * EVEN_LD + gcol, nw, MIX + o);
    }
}

#define OFF_UT   (OFF_AUX + 136 * MiB)
#define OFF_FKS(o) (984 * MiB + (size_t)(o) * 34 * MiB)
#define OFF_ZOT  (OFF_UT + 102 * MiB)

__device__ __forceinline__ void ph_hy_filt2(KP p, int l, int bid, int nb, float* sm, int skip) {
    const int tid = opaque_tid(), o = l >> 1;
    float* zf = sm;
    float* h1 = sm + 1024;
    float* h2 = sm + 2048;
    float* h3 = sm + 3072;
    const float* fw1 = p->in[I_HW1] + o * 33 * 64; const float* fb1 = p->in[I_HB1] + o * 64;
    const float* fw2 = p->in[I_HW2] + o * 64 * 64; const float* fb2 = p->in[I_HB2] + o * 64;
    const float* fw3 = p->in[I_HW3] + o * 64 * 64; const float* fb3 = p->in[I_HB3] + o * 64;
    const float* freq = p->in[I_HFREQ] + o * 64;
    const float* wout = p->in[I_HWOUT] + (size_t)o * 64 * 2048;
    float* FK = (float*)(p->ws + OFF_FKS(o)); float* FKC = FK + (size_t)2 * 512 * 8192;
#pragma unroll 1
    for (int item = bid - skip; item < (SEQ + CTXL) / 16; item += nb - skip) {
        if (item < 0) break;
        const bool isctx = item >= SEQ / 16;
        const int L = isctx ? CTXL : SEQ, pos0 = (isctx ? item - SEQ / 16 : item) * 16;
        __syncthreads();
        if (tid < 16 * 17) {
            const int pp = tid / 17, j = tid % 17, pos = pos0 + pp;
            if (j == 16) zf[pp * 36] = (float)pos / (float)(L - 1);
            else { const float f = 1e-4f + (float)j * ((15.0f - 1e-4f) / 15.0f); const float w = 2.0f * 3.14159265358979323846f * (float)pos / (float)L * f; zf[pp * 36 + 1 + j] = cosf(w); zf[pp * 36 + 17 + j] = sinf(w); }
        }
        __syncthreads();
        const int pp = tid >> 5, u0 = (tid & 31) * 2;
        { float a0 = fb1[u0], a1 = fb1[u0 + 1];
#pragma unroll 1
          for (int k = 0; k < 33; ++k) { const float z = zf[pp * 36 + k]; a0 += z * fw1[k * 64 + u0]; a1 += z * fw1[k * 64 + u0 + 1]; }
          h1[pp * 64 + u0] = sinf(freq[u0] * a0); h1[pp * 64 + u0 + 1] = sinf(freq[u0 + 1] * a1); }
        __syncthreads();
        { float a0 = fb2[u0], a1 = fb2[u0 + 1];
#pragma unroll 4
          for (int k = 0; k < 64; ++k) { const float z = h1[pp * 64 + k]; a0 += z * fw2[k * 64 + u0]; a1 += z * fw2[k * 64 + u0 + 1]; }
          h2[pp * 64 + u0] = sinf(freq[u0] * a0); h2[pp * 64 + u0 + 1] = sinf(freq[u0 + 1] * a1); }
        __syncthreads();
        { float a0 = fb3[u0], a1 = fb3[u0 + 1];
#pragma unroll 4
          for (int k = 0; k < 64; ++k) { const float z = h2[pp * 64 + k]; a0 += z * fw3[k * 64 + u0]; a1 += z * fw3[k * 64 + u0 + 1]; }
          h3[pp * 64 + u0] = sinf(freq[u0] * a0); h3[pp * 64 + u0 + 1] = sinf(freq[u0 + 1] * a1); }
        __syncthreads();
#pragma unroll 1
        for (int r = 0; r < 4; ++r) {
            const int col = tid + 512 * r, c = col & 511, od = col >> 9, order = od >> 1, dirn = od & 1;
            float a[16];
#pragma unroll
            for (int i = 0; i < 16; ++i) a[i] = 0.f;
#pragma unroll 1
            for (int k = 0; k < 64; k += 4) { const float w0 = wout[k * 2048 + col], w1 = wout[(k + 1) * 2048 + col], w2 = wout[(k + 2) * 2048 + col], w3 = wout[(k + 3) * 2048 + col];
#pragma unroll
                for (int i = 0; i < 16; ++i) { const float4 hh = *(const float4*)(h3 + i * 64 + k); a[i] += hh.x * w0 + hh.y * w1 + hh.z * w2 + hh.w * w3; } }
            const float delta = 3.0701134573253944f + (float)c * ((15.350567286626972f - 3.0701134573253944f) / 511.0f);
#pragma unroll
            for (int i = 0; i < 16; ++i) a[i] *= expf(-((float)(pos0 + i) / (float)(L - 1)) * delta);
            float* dst = isctx ? FKC + ((size_t)order * 512 + c) * 512 + 256 : FK + ((size_t)order * 512 + c) * 8192 + 4096;
            if (dirn == 0) {
#pragma unroll
                for (int i = 0; i < 16; i += 4) *(float4*)(dst + pos0 + i) = make_float4(a[i], a[i + 1], a[i + 2], a[i + 3]);
            } else {
#pragma unroll
                for (int i = 0; i < 16; ++i) if (pos0 + i > 0) dst[-(pos0 + i)] = a[i];
                if (pos0 == 0) dst[-L] = 0.f;
            }
        }
    }
}

__device__ __forceinline__ void ph_hy_prep(KP p, int l, int bid, int nb, float* sm) {
    const int tid = opaque_tid(), o = l >> 1;
    const bf16_t* P = (const bf16_t*)(p->ws + OFF_BIG);
    bf16_t* UT = (bf16_t*)(p->ws + OFF_UT);
    const float* cw = p->in[I_HCW] + o * 3 * 1536; const float* cb = p->in[I_HCB] + o * 1536;
    float* tile = sm;
#pragma unroll 1
    for (int item = bid; item < (NT / 256) * 24; item += nb) {
        const int tt = item / 24, ct = item % 24, tok0 = tt * 256, col0 = ct * 64;
        const bool lat = tok0 < NL;
        const int L = lat ? SEQ : CTXL, t0 = lat ? (tok0 & (SEQ - 1)) : ((tok0 - NL) & (CTXL - 1));
        __syncthreads();
#pragma unroll 1
        for (int i = tid; i < 258 * 8; i += 512) {
            const int rr = i >> 3, hf = i & 7, t = t0 + rr - 1;
            uint4 v = make_uint4(0u, 0u, 0u, 0u);
            if (t >= 0 && t < L) v = *(const uint4*)(P + (size_t)(tok0 + rr - 1) * ODD_LD + col0 + hf * 8);
            float* d = tile + rr * 65 + hf * 8;
            d[0] = bflo(v.x); d[1] = bfhi(v.x); d[2] = bflo(v.y); d[3] = bfhi(v.y); d[4] = bflo(v.z); d[5] = bfhi(v.z); d[6] = bflo(v.w); d[7] = bfhi(v.w);
        }
        __syncthreads();
#pragma unroll 1
        for (int r = 0; r < 4; ++r) {
            const int cc = (tid >> 5) + 16 * r, tc = (tid & 31) * 8, col = col0 + cc;
            const float w0 = cw[col], w1 = cw[1536 + col], w2 = cw[3072 + col], bb = cb[col];
            float y[8];
#pragma unroll
            for (int i = 0; i < 8; ++i) y[i] = tile[(tc + i) * 65 + cc] * w0 + tile[(tc + i + 1) * 65 + cc] * w1 + tile[(tc + i + 2) * 65 + cc] * w2 + bb;
            *(uint4*)(UT + (size_t)col * NT + tok0 + tc) = make_uint4(cvt_pk_bf16(y[0], y[1]), cvt_pk_bf16(y[2], y[3]), cvt_pk_bf16(y[4], y[5]), cvt_pk_bf16(y[6], y[7]));
        }
    }
}

__device__ __forceinline__ void hy_item_lat(KP p, int l, int c) {
    constexpr int ZSB = (SEQ + 8) * 2;
    constexpr unsigned O_Z = 0, O_PE = O_Z + 8 * ZSB, O_PO = O_PE + 4096 * 4, O_END = O_PO + 4096 * 4;
    static_assert(O_END <= BAR_LDS_, "hyena LDS");
    const int tid = opaque_tid(), lane = tid & 63, wv = __builtin_amdgcn_readfirstlane(tid >> 6), r16 = lane & 15, q4 = lane >> 4, o = l >> 1;
    const unsigned L0 = (unsigned)(size_t)smraw_base();
    const bf16_t* UT = (const bf16_t*)(p->ws + OFF_UT);
    bf16_t* ZOT = (bf16_t*)(p->ws + OFF_ZOT);
    const float* FK = (const float*)(p->ws + OFF_FKS(o));
    for (int i = tid; i < 8 * 512; i += 512) { const int b = i >> 9, ch = i & 511; sc::st16(L0 + O_Z + b * ZSB + ch * 16, *(const uint4*)(UT + (size_t)(1024 + c) * NT + b * SEQ + ch * 8)); }
#pragma unroll 1
    for (int order = 0; order < 2; ++order) {
        const float* fk = FK + ((size_t)order * 512 + c) * 8192;
        for (int i = tid; i < 4096; i += 512) {
            const float r0 = (i > 0) ? fk[8192 - 2 * i] : 0.f, r1 = fk[8191 - 2 * i], r2 = (i < 4095) ? fk[8190 - 2 * i] : 0.f;
            *(LAS unsigned*)(size_t)(L0 + O_PE + i * 4) = cvt_pk_bf16(r0, r1); *(LAS unsigned*)(size_t)(L0 + O_PO + i * 4) = cvt_pk_bf16(r1, r2);
        }
        __syncthreads();
        sc::f32x4 acc[4][4];
#pragma unroll
        for (int a = 0; a < 4; ++a)
#pragma unroll
            for (int b2 = 0; b2 < 4; ++b2) acc[a][b2] = (sc::f32x4){0.f, 0.f, 0.f, 0.f};
        const unsigned gbase = L0 + ((r16 & 1) ? O_PO : O_PE) + (unsigned)(((4096 - r16 + 8 * q4 - (r16 & 1)) >> 1) * 4);
        auto ldG = [&](int g) {
            const unsigned a0 = gbase - (unsigned)(32 * g);
            const unsigned w0 = *(const LAS unsigned*)(size_t)a0, w1 = *(const LAS unsigned*)(size_t)(a0 + 4), w2 = *(const LAS unsigned*)(size_t)(a0 + 8), w3 = *(const LAS unsigned*)(size_t)(a0 + 12);
            return __builtin_bit_cast(sc::bf16x8, (sc::u32x4_){w0, w1, w2, w3});
        };
        sc::bf16x8 bq[4][2], W[6];
#pragma unroll
        for (int i = 0; i < 4; ++i) { bq[i][0] = (sc::bf16x8){0, 0, 0, 0, 0, 0, 0, 0}; bq[i][1] = bq[i][0]; }
        const int D0 = 8 * wv - 63, D1 = (8 * wv + 7 < 63) ? 8 * wv + 7 : 63;
        W[4] = ldG(4 * D0 - 6 + 4); W[5] = ldG(4 * D0 - 6 + 5);
#pragma unroll 1
        for (int D = D0; D <= D1; ++D) {
            W[0] = W[4]; W[1] = W[5];
#pragma unroll
            for (int i = 0; i < 4; ++i) W[2 + i] = ldG(4 * D + i);
            bq[3][0] = bq[2][0]; bq[3][1] = bq[2][1]; bq[2][0] = bq[1][0]; bq[2][1] = bq[1][1]; bq[1][0] = bq[0][0]; bq[1][1] = bq[0][1];
            {
                const int s1 = 8 * wv - D + ((r16 < 8) ? 0 : 4);
                const bool ok = (unsigned)s1 < 64u;
                const unsigned za = L0 + O_Z + (unsigned)((r16 & 7) * ZSB + ((ok ? s1 : 0) * 64 + q4 * 8) * 2);
                sc::bf16x8 b0 = *(const LAS sc::bf16x8*)(size_t)za, b1 = *(const LAS sc::bf16x8*)(size_t)(za + 64);
                if (!ok) { b0 = (sc::bf16x8){0, 0, 0, 0, 0, 0, 0, 0}; b1 = b0; }
                bq[0][0] = b0; bq[0][1] = b1;
            }
#pragma unroll
            for (int cg = 0; cg < 4; ++cg) {
                const int sA = 8 * wv + cg - D;
                if ((unsigned)sA < 64u || (unsigned)(sA + 4) < 64u) {
#pragma unroll
                    for (int it = 0; it < 4; ++it) { acc[cg][it] = SC_MFMA(W[it + 2], bq[cg][0], acc[cg][it]); acc[cg][it] = SC_MFMA(W[it], bq[cg][1], acc[cg][it]); }
                }
            }
        }
        __syncthreads();
        const float sk = p->in[I_HSKIP][o * 1024 + order * 512 + c];
        const bf16_t* gt = UT + (size_t)(order * 512 + c) * NT;
        const int bb = r16 & 7;
#pragma unroll
        for (int cg = 0; cg < 4; ++cg) {
            const int t1 = 8 * wv + cg + ((r16 < 8) ? 0 : 4);
#pragma unroll
            for (int it = 0; it < 4; ++it) {
                const int t = t1 * 64 + it * 16 + q4 * 4;
                const sc::u32x2_ zo_ = *(const LAS sc::u32x2_*)(size_t)(L0 + O_Z + bb * ZSB + t * 2); const uint2 zo = make_uint2(zo_[0], zo_[1]);
                const uint2 gv = *(const uint2*)(gt + bb * SEQ + t);
                const float y0 = bflo(gv.x) * (acc[cg][it][0] + sk * bflo(zo.x)), y1 = bfhi(gv.x) * (acc[cg][it][1] + sk * bfhi(zo.x));
                const float y2 = bflo(gv.y) * (acc[cg][it][2] + sk * bflo(zo.y)), y3 = bfhi(gv.y) * (acc[cg][it][3] + sk * bfhi(zo.y));
                const uint2 w = make_uint2(cvt_pk_bf16(y0, y1), cvt_pk_bf16(y2, y3));
                if (order == 0) sc::st8(L0 + O_Z + bb * ZSB + t * 2, w);
                else *(uint2*)(ZOT + (size_t)c * NT + bb * SEQ + t) = w;
            }
        }
        __syncthreads();
    }
}

__device__ __forceinline__ void hy_item_ctx(KP p, int l, int c, float* sm) {
    const int tid = opaque_tid(), o = l >> 1;
    const bf16_t* UT = (const bf16_t*)(p->ws + OFF_UT);
    bf16_t* ZOT = (bf16_t*)(p->ws + OFF_ZOT);
    const float* FKC = (const float*)(p->ws + OFF_FKS(o)) + (size_t)2 * 512 * 8192;
    float* Kc = sm;
    float* zb = sm + 1024;
    for (int i = tid; i < 1024; i += 512) Kc[i] = FKC[((size_t)(i >> 9) * 512 + c) * 512 + (i & 511)];
    for (int i = tid; i < 8 * CTXL; i += 512) zb[i] = bf2f(UT[(size_t)(1024 + c) * NT + NL + i]);
    __syncthreads();
    const int bb = tid >> 6, tl = tid & 63;
#pragma unroll 1
    for (int order = 0; order < 2; ++order) {
        float acc[4] = {0.f, 0.f, 0.f, 0.f};
#pragma unroll 4
        for (int s = 0; s < CTXL; ++s) {
            const float zv = zb[bb * CTXL + s];
#pragma unroll
            for (int i = 0; i < 4; ++i) acc[i] += Kc[order * 512 + tl + 64 * i - s + 256] * zv;
        }
        const float sk = p->in[I_HSKIP][o * 1024 + order * 512 + c];
        float zn[4];
#pragma unroll
        for (int i = 0; i < 4; ++i) { const int t = tl + 64 * i; zn[i] = bf2f(UT[(size_t)(order * 512 + c) * NT + NL + bb * CTXL + t]) * (acc[i] + zb[bb * CTXL + t] * sk); }
        __syncthreads();
#pragma unroll
        for (int i = 0; i < 4; ++i) { const int t = tl + 64 * i; if (order == 0) zb[bb * CTXL + t] = bf2f((bf16_t)(cvt_pk_bf16(zn[i], 0.f) & 0xffffu)); else stf(ZOT + (size_t)c * NT + NL + bb * CTXL + t, zn[i]); }
        __syncthreads();
    }
}

__device__ __forceinline__ void ph_mix_odd(KP p, int l, int bid, int nb, float* sm) {
    int* head = (int*)(p->ws + OFF_CNT) + 1024 + (l >> 1) * 64;
    LAS int* slot = (LAS int*)(smraw_base() + BAR_LDS_ + 64);
#pragma unroll 1
    for (;;) {
        if (opaque_tid() == 0) *slot = atomicAdd(head, 1);
        __syncthreads();
        const int item = *slot;
        __syncthreads();
        if (item >= 128 + 512) break;
        if (item < 128) { const int b = (item >> 4) & 7, h = (item >> 2) & 3, dir = (item >> 1) & 1, vs = item & 1; sc::scan_item<2>(p, l, b, h, dir, vs); }
        else { const int c = item - 128; hy_item_lat(p, l, c); __syncthreads(); hy_item_ctx(p, l, c, sm); }
        __syncthreads();
    }
}

__device__ __forceinline__ void ph_hy_norm(KP p, int l, int bid, int nb, float* sm) {
    const int tid = opaque_tid(), o = l >> 1;
    const bf16_t* ZOT = (const bf16_t*)(p->ws + OFF_ZOT);
    bf16_t* MIX = (bf16_t*)(p->ws + OFF_U);
    const float* nw = p->in[I_HNORM] + o * 512;
    float* tile = sm;
    float* part = sm + 64 * 65;
#pragma unroll 1
    for (int item = bid; item < (NT / 64) * 8; item += nb) {
        const int tt = item >> 3, g = item & 7, tok0 = tt * 64;
        __syncthreads();
        { const int cc = tid >> 3, ch = tid & 7;
          const uint4 v = *(const uint4*)(ZOT + (size_t)(g * 64 + cc) * NT + tok0 + ch * 8);
          float* d = tile + cc * 65 + ch * 8;
          d[0] = bflo(v.x); d[1] = bfhi(v.x); d[2] = bflo(v.y); d[3] = bfhi(v.y); d[4] = bflo(v.z); d[5] = bfhi(v.z); d[6] = bflo(v.w); d[7] = bfhi(v.w); }
        __syncthreads();
        { const int tk = tid & 63, pt = tid >> 6; float s = 0.f;
#pragma unroll
          for (int i = 0; i < 8; ++i) { const float x = tile[(pt * 8 + i) * 65 + tk]; s += x * x; }
          part[pt * 64 + tk] = s; }
        __syncthreads();
        { const int tk = tid >> 3, ch = tid & 7; float s = 0.f;
#pragma unroll
          for (int i = 0; i < 8; ++i) s += part[i * 64 + tk];
          const float rs = rsqrtf(s * (1.f / 64.f) + LN_EPS);
          float y[8];
#pragma unroll
          for (int i = 0; i < 8; ++i) y[i] = tile[(ch * 8 + i) * 65 + tk] * rs * nw[g * 64 + ch * 8 + i];
          *(uint4*)(MIX + (size_t)(tok0 + tk) * DM + g * 64 + ch * 8) = make_uint4(cvt_pk_bf16(y[0], y[1]), cvt_pk_bf16(y[2], y[3]), cvt_pk_bf16(y[4], y[5]), cvt_pk_bf16(y[6], y[7])); }
    }
}

__device__ __forceinline__ void ph_normgate_odd(KP p, int l, int bid, int nb) {
    const int tid = opaque_tid(), lane = tid & 63, wv = tid >> 6, o2 = l >> 1;
    const bf16_t* P = (const bf16_t*)(p->ws + OFF_BIG);
    const bf16_t* HX = (const bf16_t*)(p->ws + OFF_AUX);
    const bf16_t* HX1 = HX + (size_t)NT * 1024;
    bf16_t* MIX = (bf16_t*)(p->ws + OFF_U);
    const int c16 = 16 * (lane & 31);
    const float* nw = p->in[I_RNW] + o2 * 512 + c16;
#pragma unroll 1
    for (int t2 = bid * 8 + wv; t2 < NT / 2; t2 += nb * 8) {
        const int tok = t2 * 2 + (lane >> 5);
        const size_t o = (size_t)tok * 1024 + 512 + c16;
        head_norm_gate16<true, false>(HX + o, HX1 + o, P + (size_t)tok * ODD_LD + 3072 + c16, nw, MIX + o);
    }
}

__device__ __forceinline__ void ph_ln1_router(KP p, int l, int ntok, int bid, int nb, float* sm) {
    constexpr int VP = (1024 + 8) * 2;
    constexpr unsigned O_VH = 0, O_VL = 32 * VP, O_LG = 64 * VP;
    static_assert(O_LG + 32 * 64 * 4 <= BAR_LDS_, "router LDS");
    const int tid = opaque_tid(), lane = tid & 63, wv = __builtin_amdgcn_readfirstlane(tid >> 6), r16 = lane & 15, q4 = lane >> 4;
    const unsigned L0 = (unsigned)(size_t)smraw_base();
    const bf16_t* Y = (const bf16_t*)(p->ws + OFF_BIG);
    bf16_t* U = (bf16_t*)(p->ws + OFF_U);
    const float* lw = p->in[I_LNW] + (l * 2) * 1024; const float* lb = p->in[I_LNB] + (l * 2) * 1024;
    const bf16_t* RWH = (const bf16_t*)(p->ws + OFF_RWH); const bf16_t* RWL = RWH + 64 * 1024;
    const float rb = p->in[I_RB][l * 64 + lane];
    LAS int* lcnt = (LAS int*)(smraw_base() + BAR_LDS_ + 256);
    if (tid < 64) lcnt[tid] = 0;
    __syncthreads();
    int* tidx = (int*)(p->ws + OFF_TIDX); float* tgate = (float*)(p->ws + OFF_TGATE); int* tpos = (int*)(p->ws + OFF_TPOS);
    {
        int* stok = (int*)(p->ws + OFF_STOK); float* sgate = (float*)(p->ws + OFF_SGATE); int* sdst = (int*)(p->ws + OFF_SDST);
#pragma unroll 1
        for (int i = bid * 512 + tid; i < MAXROWS; i += nb * 512) { stok[i] = ZROW; sgate[i] = 0.f; sdst[i] = -1; }
    }
#pragma unroll 1
    for (int base = bid * 32; base < ntok; base += nb * 32) {
#pragma unroll 2
        for (int j = 0; j < 4; ++j) {
            const int tl = wv * 4 + j, tok = base + tl;
            float* h = hrow(p, tok);
            const float* m = modrow(p, l, tok);
            const bf16_t* r = Y + (size_t)tok * DM;
            float x[16]; float s = 0.f;
#pragma unroll
            for (int c = 0; c < 4; ++c) {
                const int d = 4 * (lane + 64 * c);
                const float4 hv = *(const float4*)(h + d), gv = *(const float4*)(m + 2 * 1024 + d); const uint2 rw2 = *(const uint2*)(r + d);
                const float4 rv = make_float4(bflo(rw2.x), bfhi(rw2.x), bflo(rw2.y), bfhi(rw2.y));
                x[4 * c] = ALPHA * hv.x + gv.x * rv.x; x[4 * c + 1] = ALPHA * hv.y + gv.y * rv.y; x[4 * c + 2] = ALPHA * hv.z + gv.z * rv.z; x[4 * c + 3] = ALPHA * hv.w + gv.w * rv.w;
                s += x[4 * c] + x[4 * c + 1] + x[4 * c + 2] + x[4 * c + 3];
            }
            const float mean = wave_sum(s) * (1.f / 1024.f);
            float q = 0.f;
#pragma unroll
            for (int i = 0; i < 16; ++i) { x[i] -= mean; q += x[i] * x[i]; }
            const float rs = rsqrtf(wave_sum(q) * (1.f / 1024.f) + LN_EPS);
#pragma unroll
            for (int c = 0; c < 4; ++c) {
                const int d = 4 * (lane + 64 * c);
                const float4 w4 = *(const float4*)(lw + d), b4 = *(const float4*)(lb + d), sh = *(const float4*)(m + 3 * 1024 + d), sc = *(const float4*)(m + 4 * 1024 + d);
                float4 y; y.x = x[4 * c] * rs * w4.x + b4.x; y.y = x[4 * c + 1] * rs * w4.y + b4.y; y.z = x[4 * c + 2] * rs * w4.z + b4.z; y.w = x[4 * c + 3] * rs * w4.w + b4.w;
                *(float4*)(h + d) = y;
                float4 v; v.x = y.x * (1.f + sc.x) + sh.x; v.y = y.y * (1.f + sc.y) + sh.y; v.z = y.z * (1.f + sc.z) + sh.z; v.w = y.w * (1.f + sc.w) + sh.w;
                const unsigned h0 = cvt_pk_bf16(v.x, v.y), h1 = cvt_pk_bf16(v.z, v.w);
                *(uint2*)(U + (size_t)tok * DM + d) = make_uint2(h0, h1);
                sc::st8(L0 + O_VH + tl * VP + d * 2, make_uint2(h0, h1));
                sc::st8(L0 + O_VL + tl * VP + d * 2, make_uint2(cvt_pk_bf16(v.x - bflo(h0), v.y - bfhi(h0)), cvt_pk_bf16(v.z - bflo(h1), v.w - bfhi(h1))));
            }
        }
        __syncthreads();
        {
            const int tt = wv & 1, et = wv >> 1;
            sc::f32x4 acc = (sc::f32x4){0.f, 0.f, 0.f, 0.f};
            const bf16_t* bh = RWH + (size_t)(et * 16 + r16) * 1024 + q4 * 8; const bf16_t* bl = RWL + (size_t)(et * 16 + r16) * 1024 + q4 * 8;
#pragma unroll 4
            for (int ks = 0; ks < 32; ++ks) {
                const sc::bf16x8 ah = sc::rd_row(L0 + O_VH, tt * 16 + r16, VP, ks * 32 + q4 * 8), al = sc::rd_row(L0 + O_VL, tt * 16 + r16, VP, ks * 32 + q4 * 8);
                const sc::bf16x8 wh = *(const sc::bf16x8*)(bh + ks * 32), wl = *(const sc::bf16x8*)(bl + ks * 32);
                acc = SC_MFMA(ah, wh, acc); acc = SC_MFMA(ah, wl, acc); acc = SC_MFMA(al, wh, acc);
            }
#pragma unroll
            for (int jj = 0; jj < 4; ++jj) *(LAS float*)(size_t)(L0 + O_LG + ((tt * 16 + q4 * 4 + jj) * 64 + et * 16 + r16) * 4) = acc[jj];
        }
        __syncthreads();
#pragma unroll 1
        for (int j = 0; j < 4; ++j) {
            const int tl = wv * 4 + j, tok = base + tl;
            const float lg = *(const LAS float*)(size_t)(L0 + O_LG + (tl * 64 + lane) * 4);
            const float score = sigmoidf_(lg);
            const float key = score + rb;
            int rank = 0;
#pragma unroll
            for (int e = 0; e < 64; ++e) { const float ke = __builtin_bit_cast(float, __builtin_amdgcn_readlane(__builtin_bit_cast(int, key), e)); rank += (ke > key || (ke == key && e < lane)) ? 1 : 0; }
            const bool sel = rank < TOPK;
            const float gsum = wave_sum(sel ? score : 0.f);
            if (sel) {
                const int pos = __hip_atomic_fetch_add(lcnt + lane, 1, __ATOMIC_RELAXED, __HIP_MEMORY_SCOPE_WORKGROUP);
                tidx[tok * 8 + rank] = lane; tgate[tok * 8 + rank] = 2.5f * score / gsum; tpos[tok * 8 + rank] = pos;
            }
        }
        __syncthreads();
    }
    __syncthreads();
    if (tid < 64) ((int*)(p->ws + OFF_BCNT))[bid * 64 + tid] = lcnt[tid];
}

__device__ __forceinline__ void moe_offsets(KP p, int l, int ntok, LAS int* offs) {
    const int t = opaque_tid();
    if (t < 66) offs[t] = ((const int*)(p->ws + OFF_GOFFS))[t];
    __syncthreads();
}
__device__ __forceinline__ int moe_expert_of(const LAS int* offs, int row) { int e = 0;
#pragma unroll 1
    while (e < 64 && row >= offs[e + 1]) ++e;
    return e; }

__device__ __forceinline__ void ph_scatter(KP p, int l, int ntok, int bid, int nb, LAS unsigned char* lds) {
    LAS int* offs = (LAS int*)lds;
    LAS int* myb = offs + 128;
    LAS int* part = offs + 256;
    const int tid = opaque_tid();
    const int* bcnt = (const int*)(p->ws + OFF_BCNT);
    { const int e = tid & 63, pt = tid >> 6; int tot = 0, mine = 0;
#pragma unroll 4
      for (int b = pt; b < nb; b += 8) { const int c = bcnt[b * 64 + e]; tot += c; mine += (b < bid) ? c : 0; }
      part[pt * 64 + e] = tot; part[512 + pt * 64 + e] = mine; }
    __syncthreads();
    if (tid < 64) {
        int tot = 0, mine = 0;
#pragma unroll
        for (int i = 0; i < 8; ++i) { tot += part[i * 64 + tid]; mine += part[512 + i * 64 + tid]; }
        const int pc = (tot + 255) & ~255;
        int incl = pc;
#pragma unroll
        for (int o = 1; o < 64; o <<= 1) { const int t = SHU(incl, o); if (tid >= o) incl += t; }
        offs[tid] = incl - pc; myb[tid] = mine;
        if (tid == 63) { offs[64] = incl; offs[65] = incl + ntok; }
    }
    __syncthreads();
    if (bid == 0 && tid < 66) ((int*)(p->ws + OFF_GOFFS))[tid] = offs[tid];
    const int* tidx = (const int*)(p->ws + OFF_TIDX); const float* tgate = (const float*)(p->ws + OFF_TGATE); const int* tpos = (const int*)(p->ws + OFF_TPOS);
    int* stok = (int*)(p->ws + OFF_STOK); float* sgate = (float*)(p->ws + OFF_SGATE); int* sdst = (int*)(p->ws + OFF_SDST);
    int* tile_e = (int*)(p->ws + OFF_TILEE);
#pragma unroll 1
    for (int base = bid * 32; base < ntok; base += nb * 32) {
        if (tid < 32 * 9) {
            const int tok = base + tid / 9, sl = tid % 9;
            if (sl < 8) { const int i = tok * 8 + sl, e = tidx[i], row = offs[e] + myb[e] + tpos[i]; stok[row] = tok; sgate[row] = tgate[i]; sdst[row] = tok * 9 + sl; }
            else { const int row = offs[64] + tok; stok[row] = tok; sgate[row] = 1.f; sdst[row] = tok * 9 + 8; }
        }
    }
    const int nrt = offs[65] >> 8;
#pragma unroll 1
    for (int rt = bid * 512 + tid; rt < nrt; rt += nb * 512) tile_e[rt] = moe_expert_of(offs, rt * 256);
    __syncthreads();
}

#define MOE_TAB (gp::STAGE_BYTES + 256)
#define MOE_MAXT 9
static_assert(131072 + 256 + 256 + MOE_MAXT * 2048 <= BAR_LDS_, "MoE tables");
struct MoeDeal {
    int nfull, rem, c, G;
    __device__ __forceinline__ void init(int nrt, int c_, int G_) { nfull = nrt / G_; rem = nrt % G_; c = ((c_ & 7) << 5) | (c_ >> 3); G = G_; }
    __device__ __forceinline__ int nleft(int NPN) const { const int tot = rem * NPN; return c < tot ? (tot - c + G - 1) / G : 0; }
    __device__ __forceinline__ int ntiles(int NPN) const { return nfull + nleft(NPN); }
    __device__ __forceinline__ int tile_of(int j, int NPN) const { return j < nfull ? c + j * G : nfull * G + (c + (j - nfull) * G) / NPN; }
    __device__ __forceinline__ bool unit(int i, int NPN, int& j, int& pn) const {
        if (i < nfull * NPN) { j = i / NPN; pn = i % NPN; return true; }
        const int k = i - nfull * NPN, lu = c + k * G;
        if (lu < rem * NPN) { j = nfull + k; pn = lu % NPN; return true; }
        return false;
    }
};
struct Moe1Sched {
    const char* U; const char* W; const LAS int* tabE; const LAS int* tabS; MoeDeal d;
    __device__ __forceinline__ bool next(int i, gp::Unit& u) const {
        int j, pn; if (!d.unit(i, 2, j, pn)) return false;
        u.A = U; u.B = W + (size_t)tabE[j] * (512 * 1024 * 2) + (size_t)pn * (256 * 1024 * 2); u.r0 = d.tile_of(j, 2) * 256; u.c0 = pn * 256; u.aux = j; return true;
    }
    __device__ __forceinline__ void lane_off(const gp::Unit& u, unsigned (&vo)[2][2]) const {
        const int tid = opaque_tid(); int R0, C0, R1, C1; gp::stage_rc(tid * 16, R0, C0); gp::stage_rc(tid * 16 + 8192, R1, C1);
        const LAS int* t = tabS + u.aux * 256;
        vo[0][0] = (unsigned)t[R0] * 2048u + (unsigned)C0 * 2u; vo[0][1] = (unsigned)t[R1] * 2048u + (unsigned)C1 * 2u;
        vo[1][0] = (unsigned)t[128 + R0] * 2048u + (unsigned)C0 * 2u; vo[1][1] = (unsigned)t[128 + R1] * 2048u + (unsigned)C1 * 2u;
    }
};
struct EpiH {
    bf16_t* H;
    __device__ __forceinline__ void operator()(const gp::f32x4 (&acc)[2][2][4][2], const gp::Unit& u, int wr, int wc, int fr, int fq) const {
        const int row0 = u.r0 + wr * 64 + fr;
#pragma unroll
        for (int ai = 0; ai < 2; ++ai)
#pragma unroll
            for (int m = 0; m < 4; ++m) { bf16_t* rowp = H + (size_t)(row0 + ai * 128 + m * 16) * 256;
#pragma unroll
                for (int bj = 0; bj < 2; ++bj) {
                    const int j0 = ((u.c0 + bj * 128 + wc * 32) >> 5) * 16 + 4 * fq;
                    const gp::f32x4 a = acc[ai][bj][m][0], b = acc[ai][bj][m][1];
                    const float h0 = siluf_(a[0]) * b[0], h1 = siluf_(a[1]) * b[1], h2 = siluf_(a[2]) * b[2], h3 = siluf_(a[3]) * b[3];
                    *(uint2*)(rowp + j0) = make_uint2(cvt_pk_bf16(h0, h1), cvt_pk_bf16(h2, h3)); }
                __builtin_amdgcn_sched_barrier(0); }
    }
};
__device__ __forceinline__ void ph_moe1(KP p, int l, int ntok, int bid, int nb, LAS unsigned char* lds) {
    LAS int* tabE = (LAS int*)(lds + MOE_TAB);
    LAS int* tabS = tabE + 64;
    const int tid = opaque_tid();
    MoeDeal d; d.init(((const int*)(p->ws + OFF_GOFFS))[65] >> 8, bid, nb);
    const int nper = d.ntiles(2);
    const int* stok = (const int*)(p->ws + OFF_STOK); const int* tile_e = (const int*)(p->ws + OFF_TILEE);
    for (int i = tid; i < nper * 256; i += 512) tabS[i] = stok[(size_t)d.tile_of(i >> 8, 2) * 256 + (i & 255)];
    if (tid < nper) tabE[tid] = tile_e[d.tile_of(tid, 2)];
    __syncthreads();
    Moe1Sched S{(const char*)(p->ws + OFF_U), (const char*)(p->ws + OFF_W13), tabE, tabS, d};
    EpiH E{(bf16_t*)(p->ws + OFF_BIG)};
    gp::gemm_phase<true, false>(lds, 1024, S, E);
}

struct Moe2Sched {
    const char* H; const char* W; const LAS int* tabE; MoeDeal d;
    __device__ __forceinline__ bool next(int i, gp::Unit& u) const {
        int j, pn; if (!d.unit(i, 4, j, pn)) return false;
        u.A = H + (size_t)d.tile_of(j, 4) * (256 * 256 * 2); u.B = W + (size_t)tabE[j] * (1024 * 256 * 2) + (size_t)pn * (256 * 256 * 2); u.r0 = j * 256; u.c0 = pn * 256; u.aux = j; return true;
    }
    __device__ __forceinline__ void lane_off(const gp::Unit&, unsigned (&)[2][2]) const {}
};
__device__ __forceinline__ unsigned pk_fp8x4(float a, float b, float c, float d) { int w = __builtin_amdgcn_cvt_pk_fp8_f32(a, b, 0, false); w = __builtin_amdgcn_cvt_pk_fp8_f32(c, d, w, true); return (unsigned)w; }
struct EpiY {
    unsigned char* Ys; const LAS int* tabD; const LAS float* tabG;
    __device__ __forceinline__ void operator()(const gp::f32x4 (&acc)[2][2][4][2], const gp::Unit& u, int wr, int wc, int fr, int fq) const {
        const int rl0 = u.r0 + wr * 64 + fr, col0 = u.c0 + wc * 32 + 8 * fq;
#pragma unroll
        for (int ai = 0; ai < 2; ++ai)
#pragma unroll
            for (int m = 0; m < 4; ++m) {
                const int rl = rl0 + ai * 128 + m * 16;
                const int dst = tabD[rl]; const float g = tabG[rl];
                if (dst >= 0) { unsigned char* rowp = Ys + (size_t)dst * 1024 + col0;
#pragma unroll
                    for (int bj = 0; bj < 2; ++bj) { const gp::f32x4 v0 = acc[ai][bj][m][0] * g, v1 = acc[ai][bj][m][1] * g;
                        *(uint2*)(rowp + bj * 128) = make_uint2(pk_fp8x4(v0[0], v0[1], v0[2], v0[3]), pk_fp8x4(v1[0], v1[1], v1[2], v1[3])); } }
                __builtin_amdgcn_sched_barrier(0); }
    }
};
__device__ __forceinline__ void ph_moe2(KP p, int l, int ntok, int bid, int nb, LAS unsigned char* lds) {
    LAS int* tabE = (LAS int*)(lds + MOE_TAB);
    LAS int* tabD = tabE + 64;
    LAS float* tabG = (LAS float*)(tabD + MOE_MAXT * 256);
    const int tid = opaque_tid();
    MoeDeal d; d.init(((const int*)(p->ws + OFF_GOFFS))[65] >> 8, bid, nb);
    const int nper = d.ntiles(4);
    const int* sdst = (const int*)(p->ws + OFF_SDST); const float* sgate = (const float*)(p->ws + OFF_SGATE); const int* tile_e = (const int*)(p->ws + OFF_TILEE);
    for (int i = tid; i < nper * 256; i += 512) { const size_t r = (size_t)d.tile_of(i >> 8, 4) * 256 + (i & 255); tabD[i] = sdst[r]; tabG[i] = sgate[r]; }
    if (tid < nper) tabE[tid] = tile_e[d.tile_of(tid, 4)];
    __syncthreads();
    Moe2Sched S{(const char*)(p->ws + OFF_BIG), (const char*)(p->ws + OFF_W2), tabE, d};
    EpiY E{(unsigned char*)(p->ws + OFF_YS), tabD, tabG};
    gp::gemm_phase<false, true>(lds, 256, S, E);
}

template <bool NEXT>
__device__ __forceinline__ void ph_combine_ln2(KP p, int l, int ntok, int bid, int nb) {
    bf16_t* U = (bf16_t*)(p->ws + OFF_U);
    float* G = (float*)(p->ws + OFF_G);
    const bool gates = NEXT && ((l + 1) & 1) == 0;
    LAS float* wl = (LAS float*)smraw_base();
    if (gates) stage_gate_w(p, (l + 1) >> 1, wl);
    const int tid = opaque_tid(), lane = tid & 63, wv = tid >> 6;
    const unsigned char* Ys = (const unsigned char*)(p->ws + OFF_YS);
    const float* lw = p->in[I_LNW] + (l * 2 + 1) * 1024 + 16 * lane; const float* lb = p->in[I_LNB] + (l * 2 + 1) * 1024 + 16 * lane;
#pragma unroll 1
    for (int tok = bid * 8 + wv; tok < ntok; tok += nb * 8) {
        float* h = hrow(p, tok) + 16 * lane;
        const float* m = modrow(p, l, tok) + 16 * lane;
        const float* m2 = modrow(p, NEXT ? l + 1 : l, tok) + 16 * lane;
        float f[16];
#pragma unroll
        for (int i = 0; i < 16; ++i) f[i] = 0.f;
#pragma unroll
        for (int s9 = 0; s9 < 9; ++s9) {
            const uint4 w = *(const uint4*)(Ys + ((size_t)tok * 9 + s9) * 1024 + 16 * lane);
            const unsigned ww[4] = {w.x, w.y, w.z, w.w};
#pragma unroll
            for (int q = 0; q < 4; ++q) { const f32x2_n lo = __builtin_amdgcn_cvt_pk_f32_fp8((int)ww[q], false), hi = __builtin_amdgcn_cvt_pk_f32_fp8((int)ww[q], true);
                f[4 * q] += lo[0]; f[4 * q + 1] += lo[1]; f[4 * q + 2] += hi[0]; f[4 * q + 3] += hi[1]; }
        }
        float x[16]; float sum = 0.f;
#pragma unroll
        for (int q = 0; q < 4; ++q) {
            const float4 hv = *(const float4*)(h + 4 * q), gv = *(const float4*)(m + 5 * 1024 + 4 * q);
            x[4 * q] = ALPHA * hv.x + gv.x * f[4 * q]; x[4 * q + 1] = ALPHA * hv.y + gv.y * f[4 * q + 1]; x[4 * q + 2] = ALPHA * hv.z + gv.z * f[4 * q + 2]; x[4 * q + 3] = ALPHA * hv.w + gv.w * f[4 * q + 3];
            sum += x[4 * q] + x[4 * q + 1] + x[4 * q + 2] + x[4 * q + 3];
        }
        const float mean = wave_sum(sum) * (1.f / 1024.f);
        float q2 = 0.f;
#pragma unroll
        for (int i = 0; i < 16; ++i) { x[i] -= mean; q2 += x[i] * x[i]; }
        const float rs = rsqrtf(wave_sum(q2) * (1.f / 1024.f) + LN_EPS);
        float u16[16];
#pragma unroll
        for (int q = 0; q < 4; ++q) {
            const float4 w4 = *(const float4*)(lw + 4 * q), b4 = *(const float4*)(lb + 4 * q);
            float4 y; y.x = x[4 * q] * rs * w4.x + b4.x; y.y = x[4 * q + 1] * rs * w4.y + b4.y; y.z = x[4 * q + 2] * rs * w4.z + b4.z; y.w = x[4 * q + 3] * rs * w4.w + b4.w;
            *(float4*)(h + 4 * q) = y;
            if (NEXT) {
                const float4 sh = *(const float4*)(m2 + 4 * q), sc = *(const float4*)(m2 + 1024 + 4 * q);
                u16[4 * q] = y.x * (1.f + sc.x) + sh.x; u16[4 * q + 1] = y.y * (1.f + sc.y) + sh.y; u16[4 * q + 2] = y.z * (1.f + sc.z) + sh.z; u16[4 * q + 3] = y.w * (1.f + sc.w) + sh.w;
            }
        }
        if (NEXT) {
            uint4* up = (uint4*)(U + (size_t)tok * DM + 16 * lane);
            up[0] = make_uint4(cvt_pk_bf16(u16[0], u16[1]), cvt_pk_bf16(u16[2], u16[3]), cvt_pk_bf16(u16[4], u16[5]), cvt_pk_bf16(u16[6], u16[7]));
            up[1] = make_uint4(cvt_pk_bf16(u16[8], u16[9]), cvt_pk_bf16(u16[10], u16[11]), cvt_pk_bf16(u16[12], u16[13]), cvt_pk_bf16(u16[14], u16[15]));
        }
        if (gates) {
            float ga[16];
#pragma unroll
            for (int j = 0; j < 16; ++j) ga[j] = 0.f;
#pragma unroll
            for (int g4 = 0; g4 < 4; ++g4) {
#pragma unroll
                for (int qq = 0; qq < 4; ++qq) {
                    const float uv = u16[4 * g4 + qq];
#pragma unroll
                    for (int j4 = 0; j4 < 4; ++j4) { const f32x4_l w = *(const LAS f32x4_l*)(wl + (16 * lane + 4 * g4 + qq) * 16 + j4 * 4); ga[4 * j4] += uv * w[0]; ga[4 * j4 + 1] += uv * w[1]; ga[4 * j4 + 2] += uv * w[2]; ga[4 * j4 + 3] += uv * w[3]; }
                }
                __builtin_amdgcn_sched_barrier(0);
            }
            float mine = 0.f;
#pragma unroll
            for (int j = 0; j < 16; ++j) { const float sg = wave_sum(ga[j]); if (lane == j) mine = sg; }
            if (lane < 16) G[(size_t)tok * 16 + lane] = mine;
        }
    }
}

#define MEGA_LDS (131072 + 256 + 20480)
#define NBLK 256
#define BAR_LDS BAR_LDS_
#define SYNC() do { XcdBarrier _b; _b.bar = (unsigned*)kparams()->ws; _b.x = xb_xcc_id(); _b.st = (volatile LAS unsigned*)((LAS unsigned char*)smraw_base() + BAR_LDS); xcd_barrier(_b); } while (0)
template <int PAR>
__device__ __forceinline__ void layer_fwd(const int l) {
    LAS unsigned char* lds = smraw_base(); float* sm = (float*)smraw_generic();
    const int bid = blockIdx.x; constexpr int nb = NBLK;
    const int ntok = (l == 3) ? NL : NT;
    ph_gemm_in(kparams(), l, bid, nb, lds); SYNC();
    if (PAR == 0) {
        ph_scan_even2(kparams(), l, bid, nb); SYNC();
        ph_normgate_even(kparams(), l, bid, nb); SYNC();
    } else {
        ph_hy_prep(kparams(), l, bid, nb, sm); SYNC();
        ph_mix_odd(kparams(), l, bid, nb, sm); SYNC();
        ph_hy_norm(kparams(), l, bid, nb, sm); ph_normgate_odd(kparams(), l, bid, nb); SYNC();
    }
    ph_gemm_out(kparams(), l, bid, nb, lds); SYNC();
    ph_ln1_router(kparams(), l, ntok, bid, nb, sm); SYNC();
    ph_scatter(kparams(), l, ntok, bid, nb, lds); SYNC();
    ph_moe1(kparams(), l, ntok, bid, nb, lds); SYNC();
    ph_moe2(kparams(), l, ntok, bid, nb, lds); SYNC();
    if (l < 3) { ph_combine_ln2<true>(kparams(), l, ntok, bid, nb); ph_convert(kparams(), l + 1, bid, nb, sm); SYNC(); }
    else ph_combine_ln2<false>(kparams(), l, ntok, bid, nb);
}
__global__ void __launch_bounds__(512, 2) mega_fwd(Params p) {
    LAS unsigned char* lds = smraw_base(); float* sm = (float*)smraw_generic();
    {
        const int t0 = threadIdx.x;
        if ((t0 & 63) == 0) { unsigned h; asm volatile("s_getreg_b32 %0, hwreg(HW_REG_HW_ID, 0, 6)" : "=s"(h)); *(LAS int*)(size_t)(WTAB_LDS + (h & 63u) * 4u) = t0 >> 6; }
        if (t0 < 4) ((LAS unsigned*)(lds + BAR_LDS))[t0] = 0u;
    }
    __syncthreads();
    (void)xcd_barrier_post((unsigned*)kparams()->ws, (volatile LAS unsigned*)(lds + BAR_LDS));
    const int bid = blockIdx.x; constexpr int nb = NBLK;
    ph_prologue(kparams(), bid, nb, sm);
    __syncthreads();
    ph_hy_filt2(kparams(), 1, bid, nb, sm, 48); __syncthreads(); ph_hy_filt2(kparams(), 3, bid, nb, sm, 48);
    SYNC();
    ph_convert(kparams(), 0, bid, nb, sm); ph_modin(kparams(), 0, bid, nb); SYNC();
#pragma unroll 1
    for (int lp = 0; lp < 2; ++lp) {
        layer_fwd<0>(2 * lp);
        layer_fwd<1>(2 * lp + 1);
    }
    __syncthreads();
    if (blockIdx.x == 0 && opaque_tid() == 0 && xb_ld((unsigned*)kparams()->ws + XB_TMO) != 0u) kparams()->out[0] = __builtin_nanf("");
}

extern "C" void kernel_launch(void* const* d_in, const int* in_sizes, int n_in, void* d_out, int out_size, void* d_ws, size_t ws_size, hipStream_t stream) {
    static int grid = 0;
    if (grid == 0) {
        if (n_in != 38 || out_size != NL * DM || ws_size < WS_END) { fprintf(stderr, "kernel_launch: bad shapes n_in %d out %d ws %zu (need %zu)\n", n_in, out_size, ws_size, (size_t)WS_END); grid = -1; return; }
        int dev = 0, cus = 0, per_cu = 0;
        if (hipGetDevice(&dev) != hipSuccess || hipDeviceGetAttribute(&cus, hipDeviceAttributeMultiprocessorCount, dev) != hipSuccess) { grid = -1; return; }
        if (hipFuncSetAttribute((const void*)mega_fwd, hipFuncAttributeMaxDynamicSharedMemorySize, MEGA_LDS) != hipSuccess) { fprintf(stderr, "kernel_launch: hipFuncSetAttribute failed\n"); grid = -1; return; }
        if (hipOccupancyMaxActiveBlocksPerMultiprocessor(&per_cu, (const void*)mega_fwd, 512, MEGA_LDS) != hipSuccess || per_cu < 1) { fprintf(stderr, "kernel_launch: occupancy query says %d\n", per_cu); (void)hipGetLastError(); grid = -1; return; }
        if (cus != 256) { fprintf(stderr, "kernel_launch: built for 256 CUs, found %d\n", cus); grid = -1; return; }
        grid = NBLK;
    }
    if (grid < 0) return;
    if (hipMemsetAsync(d_ws, 0, OFF_LB, stream) != hipSuccess) return;
    Params p{};
    for (int i = 0; i < 38; ++i) p.in[i] = (const float*)d_in[i];
    p.out = (float*)d_out; p.ws = (unsigned char*)d_ws;
    hipLaunchKernelGGL(mega_fwd, dim3(grid), dim3(512), MEGA_LDS, stream, p);
}
```

```cpp
#include <hip/hip_runtime.h>
#include <stdint.h>
#include <stdio.h>

#define DM 1024
#define NBATCH 8
#define SEQ 4096
#define CTXL 256
#define NL (NBATCH * SEQ)
#define NC (NBATCH * CTXL)
#define NT (NL + NC)
#define ZROW NT
#define TOPK 8
#define EVEN_N 4112
#define ODD_N 3584
#define EVEN_LD 4096
#define ODD_LD 3584
#define MAXROWS (NT * 8 + 64 * 256 + NT)
#define ALPHA 1.681792830507429f
#define LN_EPS 1e-5f
#define E_MQ 0
#define E_MK 256
#define E_MV 512
#define E_MO 1024
#define E_HQ 1536
#define E_HI 2048
#define E_HFF 2560
#define E_HFB 3072
#define E_HG 3584

typedef unsigned short bf16_t;
#define LAS __attribute__((address_space(3)))
#define BAR_LDS_ 150528

#define MiB ((size_t)1 << 20)
#define OFF_CNT   ((size_t)64 << 10)
#define OFF_LB    ((size_t)96 << 10)
#define OFF_MOD   ((size_t)128 << 10)
#define OFF_ROPE  ((size_t)1536 << 10)
#define OFF_BCNT  ((size_t)1600 << 10)
#define OFF_GOFFS ((size_t)1700 << 10)
#define OFF_RWH   ((size_t)2560 << 10)
#define OFF_TILEE (2 * MiB)
#define OFF_HCTX  (4 * MiB)
#define OFF_TIDX  (12 * MiB)
#define OFF_TGATE (14 * MiB)
#define OFF_TPOS  (16 * MiB)
#define OFF_STOK  (18 * MiB)
#define OFF_SGATE (20 * MiB)
#define OFF_SDST  (22 * MiB)
#define OFF_G     (24 * MiB)
#define OFF_U     (28 * MiB)
#define OFF_W     (98 * MiB)
#define OFF_WIN   (OFF_W)
#define OFF_WOUT  (OFF_W + 8 * MiB)
#define OFF_W13   (OFF_W + 10 * MiB)
#define OFF_W2    (OFF_W + 75 * MiB)
#define OFF_BIG   (208 * MiB)
#define OFF_AUX   (480 * MiB)
#define OFF_Z1    (OFF_AUX + 136 * MiB)
#define OFF_Z2    (OFF_Z1 + 68 * MiB)
#define OFF_FILT  (OFF_Z2 + 68 * MiB)
#define OFF_YS    (370 * MiB)
#define WS_END    (1052 * MiB)

struct Params {
    const float* in[38];
    float* out;
    unsigned char* ws;
};

enum { I_X = 0, I_C, I_CTX, I_CCTX, I_ADAW, I_ADAB, I_LNW, I_LNB, I_EWIN, I_MGB, I_MNW, I_HLB, I_HNW, I_EWOUT, I_OWIN, I_HCW, I_HCB,
       I_HW1, I_HB1, I_HW2, I_HB2, I_HW3, I_HB3, I_HFREQ, I_HWOUT, I_HSKIP, I_HNORM, I_RLD, I_RNW, I_OWOUT, I_RW, I_RB, I_W1, I_W3, I_W2, I_SW1, I_SW3, I_SW2 };

typedef const __attribute__((address_space(4))) Params* KP;
__device__ __forceinline__ KP kparams() { KP k = (KP)__builtin_amdgcn_kernarg_segment_ptr(); asm volatile("" : "+s"(k)); return k; }
extern __shared__ __attribute__((aligned(16))) unsigned char smraw_all[];
__device__ __forceinline__ LAS unsigned char* smraw_base() { return (LAS unsigned char*)smraw_all; }
__device__ __forceinline__ unsigned char* smraw_generic() { return smraw_all; }
#define WTAB_LDS (BAR_LDS_ + 512)
__device__ __forceinline__ int opaque_tid() {
    unsigned h; asm volatile("s_getreg_b32 %0, hwreg(HW_REG_HW_ID, 0, 6)" : "=s"(h));
    const int wid = *(volatile LAS int*)(size_t)(WTAB_LDS + (h & 63u) * 4u);
    unsigned m = ~0u; asm volatile("" : "+s"(m));
    const int lane = (int)__builtin_amdgcn_mbcnt_hi(m, __builtin_amdgcn_mbcnt_lo(m, 0u));
    return __builtin_amdgcn_readfirstlane(wid) * 64 + lane;
}
typedef __bf16 bf16x2_n __attribute__((ext_vector_type(2)));
typedef float f32x2_n __attribute__((ext_vector_type(2)));
__device__ __forceinline__ unsigned cvt_pk_bf16(float lo, float hi) { const f32x2_n v = {lo, hi}; return __builtin_bit_cast(unsigned, __builtin_convertvector(v, bf16x2_n)); }
__device__ __forceinline__ float bf2f(bf16_t b) { return __uint_as_float(((unsigned)b) << 16); }
__device__ __forceinline__ float bflo(unsigned w) { return __uint_as_float(w << 16); }
__device__ __forceinline__ float bfhi(unsigned w) { return __uint_as_float(w & 0xffff0000u); }
__device__ __forceinline__ float ldf(const float* p) { return *p; }
__device__ __forceinline__ float ldf(const bf16_t* p) { return bf2f(*p); }
__device__ __forceinline__ void stf(float* p, float v) { *p = v; }
__device__ __forceinline__ void stf(bf16_t* p, float v) { *p = (bf16_t)(cvt_pk_bf16(v, 0.f) & 0xffffu); }
__device__ __forceinline__ float sigmoidf_(float x) { return 1.f / (1.f + expf(-x)); }
__device__ __forceinline__ float siluf_(float x) { return x / (1.f + expf(-x)); }
__device__ __forceinline__ int olane() { unsigned m = ~0u; asm volatile("" : "+s"(m)); return (int)__builtin_amdgcn_mbcnt_hi(m, __builtin_amdgcn_mbcnt_lo(m, 0u)); }
template <class T> __device__ __forceinline__ T shfl_idx(T v, int idx) { return __builtin_bit_cast(T, __builtin_amdgcn_ds_bpermute(idx << 2, __builtin_bit_cast(int, v))); }
#define SHX(v, o) shfl_idx(v, olane() ^ (o))
#define SHI(v, i) shfl_idx(v, (i))
#define SHI32(v, i) shfl_idx(v, (olane() & 32) | ((i) & 31))
#define SHU(v, o) shfl_idx(v, olane() - (o))
__device__ __forceinline__ float fexp(float x) { return __builtin_amdgcn_exp2f(x * 1.4426950408889634f); }
__device__ __forceinline__ float flog(float x) { return __builtin_amdgcn_logf(x) * 0.6931471805599453f; }
__device__ __forceinline__ float frcp(float x) { return __builtin_amdgcn_rcpf(x); }
__device__ __forceinline__ float fsigmoid(float x) { return frcp(1.f + fexp(-x)); }
__device__ __forceinline__ float fsilu(float x) { return x * frcp(1.f + fexp(-x)); }
__device__ __forceinline__ float wave_sum(float v) {
#pragma unroll
    for (int o = 32; o > 0; o >>= 1) v += SHX(v, o);
    return v;
}
__device__ __forceinline__ float* hrow(KP p, int tok) {
    return tok < NL ? p->out + (size_t)tok * DM : (float*)(p->ws + OFF_HCTX) + (size_t)(tok - NL) * DM;
}
__device__ __forceinline__ const float* modrow(KP p, int l, int tok) {
    const int r = tok < NL ? (tok >> 12) : 8;
    return (const float*)(p->ws + OFF_MOD) + ((size_t)l * 9 + r) * 6144;
}
__device__ __forceinline__ int scan_tok(int b, int i, int dir) {
    return i < CTXL ? NL + b * CTXL + (dir ? CTXL - 1 - i : i) : b * SEQ + (dir ? SEQ - 1 - (i - CTXL) : (i - CTXL));
}

#define XB_TMO      128
#define XB_XCNT(j)  (256  + 64 * (j))
#define XB_XSUB(j)  (1280 + 64 * (j))
#define XB_XGEN(j)  (2304 + 64 * (j))
#define XB_TOP      3328
#define XB_TOPGEN   3392
#define XCD_BAR_WORDS 3456
#define XB_SPIN_CAP (1u << 24)
__device__ __forceinline__ unsigned xb_ld(unsigned* p)              { return __hip_atomic_load(p, __ATOMIC_RELAXED, __HIP_MEMORY_SCOPE_AGENT); }
__device__ __forceinline__ unsigned xb_add(unsigned* p, unsigned v) { return __hip_atomic_fetch_add(p, v, __ATOMIC_RELAXED, __HIP_MEMORY_SCOPE_AGENT); }
__device__ __forceinline__ unsigned xb_xcc_id() { return (unsigned)__builtin_amdgcn_s_getreg((3 << 11) | 20) & 0xFu; }
#define XB_SPIN(cond, bar) do { unsigned _sp = 0; while (cond) { __builtin_amdgcn_s_sleep(1); \
    if ((++_sp & 255u) == 0u) { if (xb_ld(&(bar)[XB_TMO])) break; if (_sp > XB_SPIN_CAP) { atomicAdd(&(bar)[XB_TMO], 1u); break; } } } } while (0)
struct XcdBarrier { unsigned* bar; unsigned x; volatile LAS unsigned* st; };
__device__ __forceinline__ XcdBarrier xcd_barrier_post(unsigned* bar, volatile LAS unsigned* st) {
    XcdBarrier b; b.bar = bar; b.x = xb_xcc_id(); b.st = st;
    if (opaque_tid() == 0) (void)xb_add(&bar[XB_XCNT(b.x)], 1u);
    return b;
}
__device__ __forceinline__ void xcd_barrier_complete(unsigned* bar, unsigned x, unsigned& nloc, unsigned& nx) {
    const unsigned G = gridDim.x * gridDim.y * gridDim.z;
    unsigned sum, cnt, mine, sp = 0u;
    for (;;) {
        sum = 0u; cnt = 0u; mine = 0u;
#pragma unroll
        for (unsigned j = 0; j < 16; ++j) { const unsigned c = xb_ld(&bar[XB_XCNT(j)]); sum += c; cnt += (c > 0u) ? 1u : 0u; mine = (j == x) ? c : mine; }
        if (sum == G) break;
        __builtin_amdgcn_s_sleep(1);
        if ((++sp & 255u) == 0u) { if (xb_ld(&bar[XB_TMO])) break; if (sp > XB_SPIN_CAP) { atomicAdd(&bar[XB_TMO], 1u); break; } }
    }
    nloc = mine > 0u ? mine : 1u; nx = cnt > 0u ? cnt : 1u;
}
__device__ __forceinline__ void xcd_barrier(const XcdBarrier& b) {
    asm volatile("s_waitcnt vmcnt(0)" ::: "memory");
    __syncthreads();
    if (opaque_tid() == 0) {
        unsigned* bar = b.bar;
        __builtin_amdgcn_s_waitcnt(0);
        unsigned nloc = b.st[0], nx = b.st[1];
        if (nloc == 0u) { xcd_barrier_complete(bar, b.x, nloc, nx); b.st[0] = nloc; b.st[1] = nx; }
        const unsigned old = xb_add(&bar[XB_XSUB(b.x)], 1u);
        const unsigned gen = old / nloc;
        if (old + 1u == (gen + 1u) * nloc) {
            __builtin_amdgcn_fence(__ATOMIC_RELEASE, "agent");
            asm volatile("s_waitcnt vmcnt(0)" ::: "memory");
            const unsigned og = xb_add(&bar[XB_TOP], 1u);
            const unsigned tg = og / nx;
            if (og + 1u == (tg + 1u) * nx) xb_add(&bar[XB_TOPGEN], 1u);
            else XB_SPIN(xb_ld(&bar[XB_TOPGEN]) == tg, bar);
            __builtin_amdgcn_fence(__ATOMIC_ACQUIRE, "agent");
            xb_add(&bar[XB_XGEN(b.x)], 1u);
            asm volatile("s_waitcnt vmcnt(0)" ::: "memory");
        } else {
            XB_SPIN(xb_ld(&bar[XB_XGEN(b.x)]) == gen, bar);
            __builtin_amdgcn_fence(__ATOMIC_ACQUIRE, "agent");
            asm volatile("s_waitcnt vmcnt(0)" ::: "memory");
        }
    }
    __syncthreads();
}

__device__ __forceinline__ void ph_prologue(KP p, int bid, int nb, float* sm) {
    const int tid = opaque_tid();
    {
        const float4* x4 = (const float4*)p->in[I_X]; float4* o4 = (float4*)p->out;
        #pragma unroll 1
        for (size_t i = (size_t)bid * 512 + tid; i < (size_t)NL * 256; i += (size_t)nb * 512) o4[i] = x4[i];
        const float4* c4 = (const float4*)p->in[I_CTX]; float4* h4 = (float4*)(p->ws + OFF_HCTX);
        #pragma unroll 1
        for (size_t i = (size_t)bid * 512 + tid; i < (size_t)NC * 256; i += (size_t)nb * 512) h4[i] = c4[i];
    }
    if (bid == 0) {
        bf16_t* z = (bf16_t*)(p->ws + OFF_U) + (size_t)ZROW * DM;
        for (int i = tid; i < DM; i += 512) z[i] = 0;
    }
    if (bid == 1 % nb) {
        float* lb = (float*)(p->ws + OFF_LB);
        const float* hl = p->in[I_HLB];
        for (int j = tid; j < 512; j += 512) {
            const float a = hl[j], b = hl[512 + j], mx = fmaxf(a, b);
            const float ea = expf(a - mx), eb = expf(b - mx);
            lb[j] = 0.f; lb[512 + j] = eb / (ea + eb);
        }
    }
    if (bid == 2 % nb) {
        float2* rt = (float2*)(p->ws + OFF_ROPE);
        for (int i = tid; i < 64 * 32; i += 512) { const float ang = (float)(i >> 5) * powf(10000.f, -(float)(2 * (i & 31)) / 64.f); rt[i] = make_float2(cosf(ang), sinf(ang)); }
    }
    {
        float* act = sm;
        bool filled = false;
        #pragma unroll 1
        for (int item = bid; item < 48; item += nb) {
            if (!filled) {
                for (int i = tid; i < 9 * 1024; i += 512) {
                    const int r = i >> 10, k = i & 1023;
                    const float v = r < 8 ? p->in[I_C][r * 1024 + k] : p->in[I_CCTX][k];
                    act[i] = siluf_(v);
                }
                __syncthreads(); filled = true;
            }
            const int l = item / 12, j = (item % 12) * 512 + tid;
            const float* w = p->in[I_ADAW] + (size_t)l * 1024 * 6144 + j;
            float acc[9];
#pragma unroll
            for (int r = 0; r < 9; ++r) acc[r] = 0.f;
            for (int k = 0; k < 1024; ++k) {
                const float wv = w[(size_t)k * 6144];
#pragma unroll
                for (int r = 0; r < 9; ++r) acc[r] += act[r * 1024 + k] * wv;
            }
            const float bv = p->in[I_ADAB][l * 6144 + j];
            float* mod = (float*)(p->ws + OFF_MOD);
#pragma unroll
            for (int r = 0; r < 9; ++r) mod[((size_t)l * 9 + r) * 6144 + j] = acc[r] + bv;
        }
    }
}


struct CvtTile { const float* src; int srcld; bf16_t* dst; int dstld; int k0, n0; };
__device__ __forceinline__ CvtTile cvt_tile_of(KP p, int l, int t, int np4  ) {
    const bool even = (l & 1) == 0;
    const int NP = even ? EVEN_LD : ODD_LD;
    const int t_in = 16 * (NP / 128), t_out = 16 * 8, t_13 = 65 * 16 * 4;
    CvtTile c;
    if (t < t_in) {
        const int kt = t & 15, nt = t >> 4, n = nt * 128 + np4;
        const float* W = even ? p->in[I_EWIN] + (size_t)(l >> 1) * 1024 * EVEN_N : p->in[I_OWIN] + (size_t)(l >> 1) * 1024 * ODD_N;
        c.src = W + ((even && n >= 1536) ? n + 16 : n); c.srcld = even ? EVEN_N : ODD_N; c.dst = (bf16_t*)(p->ws + OFF_WIN); c.dstld = 1024; c.k0 = kt * 64; c.n0 = nt * 128;
    } else if (t < t_in + t_out) {
        const int u = t - t_in, kt = u & 15, nt = u >> 4;
        c.src = (even ? p->in[I_EWOUT] : p->in[I_OWOUT]) + (size_t)(l >> 1) * 1024 * 1024 + nt * 128 + np4; c.srcld = 1024; c.dst = (bf16_t*)(p->ws + OFF_WOUT); c.dstld = 1024; c.k0 = kt * 64; c.n0 = nt * 128;
    } else if (t < t_in + t_out + t_13) {
        const int u = t - t_in - t_out, e = u >> 6, kt = u & 15, nt = (u >> 4) & 3, n = nt * 128 + np4, g = n >> 5, w = n & 31;
        const float* w1 = e < 64 ? p->in[I_W1] + ((size_t)l * 64 + e) * 1024 * 256 : p->in[I_SW1] + (size_t)l * 1024 * 256;
        const float* w3 = e < 64 ? p->in[I_W3] + ((size_t)l * 64 + e) * 1024 * 256 : p->in[I_SW3] + (size_t)l * 1024 * 256;
        c.src = w < 16 ? w1 + 16 * g + w : w3 + 16 * g + w - 16; c.srcld = 256; c.dst = (bf16_t*)(p->ws + OFF_W13) + (size_t)e * 512 * 1024; c.dstld = 1024; c.k0 = kt * 64; c.n0 = nt * 128;
    } else {
        const int u = t - t_in - t_out - t_13, e = u >> 5, kt = u & 3, nt = (u >> 2) & 7;
        const float* w2 = e < 64 ? p->in[I_W2] + ((size_t)l * 64 + e) * 256 * 1024 : p->in[I_SW2] + (size_t)l * 256 * 1024;
        c.src = w2 + nt * 128 + np4; c.srcld = 1024; c.dst = (bf16_t*)(p->ws + OFF_W2) + (size_t)e * 1024 * 256; c.dstld = 256; c.k0 = kt * 64; c.n0 = nt * 128;
    }
    return c;
}
__device__ __forceinline__ void ph_convert(KP p, int l, int bid, int nb, float* sm) {
    const int tid = opaque_tid();
    const int NP = ((l & 1) == 0) ? EVEN_LD : ODD_LD;
    const int total = 16 * (NP / 128) + 16 * 8 + 65 * 16 * 4 + 65 * 4 * 8;
    const int kr = tid >> 5, np4 = (tid & 31) * 4;
    float4 v[4];
    int t = bid;
    CvtTile c = cvt_tile_of(p, l, t < total ? t : 0, np4);
    if (t < total) {
#pragma unroll
        for (int j = 0; j < 4; ++j) v[j] = *(const float4*)(c.src + (size_t)(c.k0 + kr + 16 * j) * c.srcld);
    }
#pragma unroll 1
    for (; t < total; t += nb) {
        __syncthreads();
#pragma unroll
        for (int j = 0; j < 4; ++j) { float* d = sm + (np4) * 65 + kr + 16 * j; d[0] = v[j].x; d[65] = v[j].y; d[130] = v[j].z; d[195] = v[j].w; }
        const CvtTile cur = c;
        const int tn = t + nb;
        if (tn < total) {
            c = cvt_tile_of(p, l, tn, np4);
#pragma unroll
            for (int j = 0; j < 4; ++j) v[j] = *(const float4*)(c.src + (size_t)(c.k0 + kr + 16 * j) * c.srcld);
        }
        __syncthreads();
        const int n = tid >> 2, kc = (tid & 3) * 16;
        unsigned w[8];
#pragma unroll
        for (int q = 0; q < 8; ++q) w[q] = cvt_pk_bf16(sm[n * 65 + kc + 2 * q], sm[n * 65 + kc + 2 * q + 1]);
        uint4* d4 = (uint4*)(cur.dst + (size_t)(cur.n0 + n) * cur.dstld + cur.k0 + kc);
        d4[0] = make_uint4(w[0], w[1], w[2], w[3]); d4[1] = make_uint4(w[4], w[5], w[6], w[7]);
    }
    __syncthreads();
    if (bid < 8) {
        const float* rw = p->in[I_RW] + (size_t)l * 1024 * 64;
        bf16_t* hi = (bf16_t*)(p->ws + OFF_RWH); bf16_t* lo = hi + 64 * 1024;
        const int e = tid & 63, kb = bid * 128 + (tid >> 6) * 16;
#pragma unroll
        for (int i = 0; i < 16; i += 2) {
            const float x0 = rw[(size_t)(kb + i) * 64 + e], x1 = rw[(size_t)(kb + i + 1) * 64 + e];
            const unsigned h = cvt_pk_bf16(x0, x1);
            const unsigned lw = cvt_pk_bf16(x0 - bflo(h), x1 - bfhi(h));
            *(unsigned*)(hi + (size_t)e * 1024 + kb + i) = h; *(unsigned*)(lo + (size_t)e * 1024 + kb + i) = lw;
        }
    }
}

namespace gp {
typedef short bf16x8 __attribute__((ext_vector_type(8)));
typedef float f32x4 __attribute__((ext_vector_type(4)));
typedef unsigned u32x4 __attribute__((ext_vector_type(4)));
typedef unsigned u32x2 __attribute__((ext_vector_type(2)));
constexpr int BM = 256, BK = 64, HALF = 128, HTB = HALF * BK * 2, STAGE_BYTES = 8 * HTB, NXCD = 8, WGM = 8;
__device__ __forceinline__ int lds_byte(int r, int c) { const int st = (r >> 4) * 2 + (c >> 5), rr = r & 15, cc = c & 31, ob = rr * 64 + cc * 2; return st * 1024 + (ob ^ (((ob >> 9) & 1) << 5)); }
__device__ __forceinline__ void stage_rc(int b, int& R, int& C) { const int st = b / 1024, sb = b % 1024, swz = sb ^ (((sb >> 9) & 1) << 5); R = (st >> 1) * 16 + swz / 64; C = (st & 1) * 32 + (swz % 64) / 2; }
__device__ __forceinline__ int perm32(int rho) { const int n = rho >> 4, i = rho & 15; return 8 * (i >> 2) + 4 * n + (i & 3); }

struct Unit { const char* A; const char* B; int r0, c0, aux; };

struct DenseSched {
    const char* A; const char* B; int nM, nN, nwg, G, c; size_t tstep;
    __device__ __forceinline__ void init(const void* A_, const void* B_, int M, int N, int K, int G_, int c_) { A = (const char*)A_; B = (const char*)B_; nM = M / BM; nN = N / BM; nwg = nM * nN; G = G_; c = c_; tstep = (size_t)BM * K * 2; }
    __device__ __forceinline__ bool next(int i, Unit& u) const {
        const long L = (long)i * G + c; if (L >= nwg) return false;
        int wgid = (int)L; { const int q = nwg / NXCD, r = nwg % NXCD, xcd = wgid % NXCD, off = wgid / NXCD; wgid = (xcd < r ? xcd * (q + 1) : r * (q + 1) + (xcd - r) * q) + off; }
        const int nig = WGM * nN, gid = wgid / nig, fm = gid * WGM, gsz = (nM - fm) < WGM ? (nM - fm) : WGM;
        const int pm = fm + ((wgid % nig) % gsz), pn = (wgid % nig) / gsz;
        u.A = A + (size_t)pm * tstep; u.B = B + (size_t)pn * tstep; u.r0 = pm * BM; u.c0 = pn * BM; u.aux = 0; return true;
    }
    __device__ __forceinline__ void lane_off(const Unit&, unsigned (&)[2][2]) const {}
};

template <bool GATHER, bool PERM, class Sched, class Epi>
__device__ __forceinline__ void gemm_phase(LAS unsigned char* lds, const int K_, const Sched& S, const Epi& E) {
    int K = K_; asm volatile("" : "+s"(K));
    const int tid = opaque_tid(), wid = __builtin_amdgcn_readfirstlane(tid >> 6), lane = tid & 63, wr = wid >> 2, wc = wid & 3, fr = lane & 15, fq = lane >> 4;
    const int nt = K / BK;
    unsigned voffA[2], voffB[2];
#pragma unroll
    for (int i = 0; i < 2; ++i) { int R, C; stage_rc(tid * 16 + i * 8192, R, C); const int Rb = PERM ? ((R & ~31) + perm32(R & 31)) : R;
        voffA[i] = (unsigned)(R * K + C) * 2u; voffB[i] = (unsigned)(Rb * K + C) * 2u; }
    const size_t kstep = (size_t)(BK * 2);
    const size_t hstep = (size_t)HALF * K * 2;
    const unsigned ldsw = (unsigned)wid * 1024u;
    const int aoff = lds_byte(wr * 64 + fr, fq * 8), boff = lds_byte(wc * 32 + fr, fq * 8);
    unsigned cvo[2][2] = {{0u, 0u}, {0u, 0u}}, nvo[2][2] = {{0u, 0u}, {0u, 0u}};
#define GP_SA(b, h) (((b) * 2 + (h)) * HTB)
#define GP_SB(b, h) ((4 + (b) * 2 + (h)) * HTB)
#define GP_GLDS(gp_, lp_) __builtin_amdgcn_global_load_lds((const unsigned*)(gp_), (LAS unsigned*)(lp_), 16, 0, 0)
#define GP_STAGE_B(bufoff, gbase, h) do { const char* _g = (gbase) + (size_t)(h) * hstep; \
        GP_GLDS(_g + voffB[0], lds + (bufoff) + ldsw); GP_GLDS(_g + voffB[1], lds + (bufoff) + ldsw + 8192); } while (0)
#define GP_STAGE_A(bufoff, gbase, h, usenext) do { \
        if (GATHER) { const unsigned _o0 = (usenext) ? nvo[h][0] : cvo[h][0], _o1 = (usenext) ? nvo[h][1] : cvo[h][1]; \
            GP_GLDS((gbase) + _o0, lds + (bufoff) + ldsw); GP_GLDS((gbase) + _o1, lds + (bufoff) + ldsw + 8192); } \
        else { const char* _g = (gbase) + (size_t)(h) * hstep; GP_GLDS(_g + voffA[0], lds + (bufoff) + ldsw); GP_GLDS(_g + voffA[1], lds + (bufoff) + ldsw + 8192); } } while (0)
#define GP_LDA(dst, b, h) do { _Pragma("unroll") for (int m = 0; m < 4; ++m) _Pragma("unroll") for (int k = 0; k < 2; ++k) dst[m][k] = *(const LAS bf16x8*)(lds + GP_SA(b, h) + aoff + m * 2048 + k * 1024); } while (0)
#define GP_LDB(dst, b, h) do { _Pragma("unroll") for (int n = 0; n < 2; ++n) _Pragma("unroll") for (int k = 0; k < 2; ++k) dst[n][k] = *(const LAS bf16x8*)(lds + GP_SB(b, h) + boff + n * 2048 + k * 1024); } while (0)
#define GP_MMA(ai, bj, At, Bt) do { __builtin_amdgcn_s_setprio(1); _Pragma("unroll") for (int m = 0; m < 4; ++m) _Pragma("unroll") for (int n = 0; n < 2; ++n) _Pragma("unroll") for (int k = 0; k < 2; ++k) \
        acc[ai][bj][m][n] = __builtin_amdgcn_mfma_f32_16x16x32_bf16(Bt[n][k], At[m][k], acc[ai][bj][m][n], 0, 0, 0); __builtin_amdgcn_s_setprio(0); } while (0)
#define GP_WAIT_V(n) asm volatile("s_waitcnt vmcnt(" #n ")" ::: "memory")
#define GP_WAIT_L(n) asm volatile("s_waitcnt lgkmcnt(" #n ")" ::: "memory")
#define GP_BAR __builtin_amdgcn_s_barrier()
#define GP_SCHED __builtin_amdgcn_sched_barrier(0)
    Unit cur, nxt; int ui = 0;
    if (!S.next(0, cur)) return;
    f32x4 acc[2][2][4][2];
#pragma unroll
    for (int a = 0; a < 2; ++a)
#pragma unroll
        for (int b = 0; b < 2; ++b)
#pragma unroll
            for (int m = 0; m < 4; ++m)
#pragma unroll
                for (int n = 0; n < 2; ++n) acc[a][b][m][n] = (f32x4){0.f, 0.f, 0.f, 0.f};
    bf16x8 At[4][2], B0[2][2], B1[2][2];
    if (GATHER) S.lane_off(cur, cvo);
    const char* cA = cur.A; const char* cB = cur.B;
    GP_STAGE_B(GP_SB(0, 0), cB, 0); GP_STAGE_A(GP_SA(0, 0), cA, 0, false); GP_STAGE_B(GP_SB(0, 1), cB, 1); GP_STAGE_A(GP_SA(0, 1), cA, 1, false);
    if (wr == 1) GP_BAR;
    GP_WAIT_V(4); GP_BAR;
    GP_STAGE_B(GP_SB(1, 0), cB + kstep, 0); GP_STAGE_A(GP_SA(1, 0), cA + kstep, 0, false); GP_STAGE_B(GP_SB(1, 1), cB + kstep, 1);
    GP_WAIT_V(6); GP_BAR;
    for (;;) {
        const bool has_next = S.next(ui + 1, nxt);
        if (GATHER && has_next) S.lane_off(nxt, nvo);
        const char* nA = has_next ? nxt.A : cA; const char* nB = has_next ? nxt.B : cB;
        for (int t = 0; t < nt; t += 2) {
            const bool last = (t == nt - 2);
            const bool un = last && has_next;
            const char* a1 = cA + (size_t)(t + 1) * kstep;
            const char* a2 = last ? nA : cA + (size_t)(t + 2) * kstep; const char* b2 = last ? nB : cB + (size_t)(t + 2) * kstep;
            const char* a3 = a2 + kstep; const char* b3 = b2 + kstep;
            GP_LDB(B0, 0, 0); GP_SCHED; GP_LDA(At, 0, 0); GP_STAGE_A(GP_SA(1, 1), a1, 1, false);
            GP_WAIT_L(8); GP_BAR; GP_WAIT_L(0); GP_MMA(0, 0, At, B0); GP_BAR; GP_SCHED;
            GP_LDB(B1, 0, 1); GP_STAGE_B(GP_SB(0, 0), b2, 0);
            GP_BAR; GP_WAIT_L(0); GP_MMA(0, 1, At, B1); GP_BAR;
            GP_LDA(At, 0, 1); GP_STAGE_A(GP_SA(0, 0), a2, 0, un);
            GP_BAR; GP_WAIT_L(0); GP_MMA(1, 0, At, B0); GP_BAR; GP_SCHED;
            GP_STAGE_B(GP_SB(0, 1), b2, 1);
            GP_WAIT_V(6); GP_BAR; GP_MMA(1, 1, At, B1); GP_BAR;
            GP_LDB(B0, 1, 0); GP_SCHED; GP_LDA(At, 1, 0); GP_STAGE_A(GP_SA(0, 1), a2, 1, un);
            GP_WAIT_L(8); GP_BAR; GP_WAIT_L(0); GP_MMA(0, 0, At, B0); GP_BAR; GP_SCHED;
            GP_LDB(B1, 1, 1); GP_STAGE_B(GP_SB(1, 0), b3, 0);
            GP_BAR; GP_WAIT_L(0); GP_MMA(0, 1, At, B1); GP_BAR;
            GP_LDA(At, 1, 1); GP_STAGE_A(GP_SA(1, 0), a3, 0, un);
            GP_BAR; GP_WAIT_L(0); GP_MMA(1, 0, At, B0); GP_BAR; GP_SCHED;
            GP_STAGE_B(GP_SB(1, 1), b3, 1);
            GP_WAIT_V(6); GP_BAR; GP_MMA(1, 1, At, B1); GP_BAR;
        }
        E(acc, cur, wr, wc, fr, fq);
        if (!has_next) break;
#pragma unroll
        for (int a = 0; a < 2; ++a)
#pragma unroll
            for (int b = 0; b < 2; ++b)
#pragma unroll
                for (int m = 0; m < 4; ++m)
#pragma unroll
                    for (int n = 0; n < 2; ++n) acc[a][b][m][n] = (f32x4){0.f, 0.f, 0.f, 0.f};
        cur = nxt; cA = nA; cB = nB; ++ui;
        if (GATHER) { cvo[0][0] = nvo[0][0]; cvo[0][1] = nvo[0][1]; cvo[1][0] = nvo[1][0]; cvo[1][1] = nvo[1][1]; }
    }
    GP_WAIT_V(0);
    if (wr == 0) GP_BAR;
    GP_BAR;
#undef GP_SA
#undef GP_SB
#undef GP_GLDS
#undef GP_STAGE_A
#undef GP_STAGE_B
#undef GP_LDA
#undef GP_LDB
#undef GP_MMA
#undef GP_WAIT_V
#undef GP_WAIT_L
#undef GP_BAR
#undef GP_SCHED
}

struct EpiF32 {
    float* C; int ldc;
    __device__ __forceinline__ void operator()(const f32x4 (&acc)[2][2][4][2], const Unit& u, int wr, int wc, int fr, int fq) const {
        const int row0 = u.r0 + wr * 64 + fr, col0 = u.c0 + wc * 32 + 4 * fq;
#pragma unroll
        for (int ai = 0; ai < 2; ++ai)
#pragma unroll
            for (int m = 0; m < 4; ++m) { float* rowp = C + (size_t)(row0 + ai * HALF + m * 16) * ldc + col0;
#pragma unroll
                for (int bj = 0; bj < 2; ++bj)
#pragma unroll
                    for (int n = 0; n < 2; ++n) *(f32x4*)(rowp + bj * HALF + n * 16) = acc[ai][bj][m][n];
                __builtin_amdgcn_sched_barrier(0); }
    }
};
struct EpiBf16 {
    bf16_t* O; int ldc;
    __device__ __forceinline__ void operator()(const f32x4 (&acc)[2][2][4][2], const Unit& u, int wr, int wc, int fr, int fq) const {
        const int row0 = u.r0 + wr * 64 + fr, col0 = u.c0 + wc * 32 + 8 * fq;
#pragma unroll
        for (int ai = 0; ai < 2; ++ai)
#pragma unroll
            for (int m = 0; m < 4; ++m) { bf16_t* rowp = O + (size_t)(row0 + ai * HALF + m * 16) * ldc + col0;
#pragma unroll
                for (int bj = 0; bj < 2; ++bj) { const f32x4 v0 = acc[ai][bj][m][0], v1 = acc[ai][bj][m][1];
                    u32x4 w; w.x = cvt_pk_bf16(v0[0], v0[1]); w.y = cvt_pk_bf16(v0[2], v0[3]); w.z = cvt_pk_bf16(v1[0], v1[1]); w.w = cvt_pk_bf16(v1[2], v1[3]);
                    *(u32x4*)(rowp + bj * HALF) = w; }
                __builtin_amdgcn_sched_barrier(0); }
    }
};
}


typedef float f32x4_l __attribute__((ext_vector_type(4)));
__device__ __forceinline__ void stage_gate_w(KP p, int e, LAS float* wl) {
    const int tid = opaque_tid();
    const float* wg = p->in[I_EWIN] + (size_t)e * 1024 * EVEN_N + 1536;
#pragma unroll
    for (int i = 0; i < 8; ++i) { const int idx = tid + 512 * i, d = idx >> 2, j4 = idx & 3; const float4 w = *(const float4*)(wg + (size_t)d * EVEN_N + j4 * 4); *(LAS f32x4_l*)(wl + d * 16 + j4 * 4) = (f32x4_l){w.x, w.y, w.z, w.w}; }
    __syncthreads();
}
__device__ __forceinline__ void ph_modin(KP p, int l, int bid, int nb) {
    const int tid = opaque_tid(), lane = tid & 63, wv = tid >> 6;
    const bool even = (l & 1) == 0;
    bf16_t* U = (bf16_t*)(p->ws + OFF_U);
    float* G = (float*)(p->ws + OFF_G);
    LAS float* wl = (LAS float*)smraw_base();
    if (even) stage_gate_w(p, l >> 1, wl);
    #pragma unroll 1
    for (int tok = bid * 8 + wv; tok < NT; tok += nb * 8) {
        const float* h = hrow(p, tok);
        const float* m = modrow(p, l, tok);
        float ga[16];
#pragma unroll
        for (int j = 0; j < 16; ++j) ga[j] = 0.f;
#pragma unroll
        for (int c = 0; c < 4; ++c) {
            const int d = 4 * (lane + 64 * c);
            const float4 hv = *(const float4*)(h + d), sh = *(const float4*)(m + d), sc = *(const float4*)(m + 1024 + d);
            const float u0 = hv.x * (1.f + sc.x) + sh.x, u1 = hv.y * (1.f + sc.y) + sh.y, u2 = hv.z * (1.f + sc.z) + sh.z, u3 = hv.w * (1.f + sc.w) + sh.w;
            *(uint2*)(U + (size_t)tok * DM + d) = make_uint2(cvt_pk_bf16(u0, u1), cvt_pk_bf16(u2, u3));
            if (even) {
                const float uu[4] = {u0, u1, u2, u3};
#pragma unroll
                for (int q = 0; q < 4; ++q) {
#pragma unroll
                    for (int j4 = 0; j4 < 4; ++j4) { const f32x4_l w = *(const LAS f32x4_l*)(wl + (d + q) * 16 + j4 * 4); ga[4 * j4] += uu[q] * w[0]; ga[4 * j4 + 1] += uu[q] * w[1]; ga[4 * j4 + 2] += uu[q] * w[2]; ga[4 * j4 + 3] += uu[q] * w[3]; }
                }
                __builtin_amdgcn_sched_barrier(0);
            }
        }
        if (even) {
            float mine = 0.f;
#pragma unroll
            for (int j = 0; j < 16; ++j) { const float s = wave_sum(ga[j]); if (lane == j) mine = s; }
            if (lane < 16) G[(size_t)tok * 16 + lane] = mine;
        }
    }
}

__device__ __forceinline__ void ph_gemm_in(KP p, int l, int bid, int nb, LAS unsigned char* lds) {
    const int N = ((l & 1) == 0) ? EVEN_LD : ODD_LD;
    gp::DenseSched S; S.init(p->ws + OFF_U, p->ws + OFF_WIN, NT, N, 1024, nb, bid);
    gp::EpiBf16 E{(bf16_t*)(p->ws + OFF_BIG), N};
    gp::gemm_phase<false, true>(lds, 1024, S, E);
}
__device__ __forceinline__ void ph_gemm_out(KP p, int l, int bid, int nb, LAS unsigned char* lds) {
    gp::DenseSched S; S.init(p->ws + OFF_U, p->ws + OFF_WOUT, (l == 3) ? NL : NT, 1024, 1024, nb, bid);
    gp::EpiBf16 E{(bf16_t*)(p->ws + OFF_BIG), 1024};
    gp::gemm_phase<false, true>(lds, 1024, S, E);
}


namespace sc {
typedef short bf16x8 __attribute__((ext_vector_type(8)));
typedef short bf16x4 __attribute__((ext_vector_type(4)));
typedef float f32x4 __attribute__((ext_vector_type(4)));
#define SC_MFMA(a, b, c) __builtin_amdgcn_mfma_f32_16x16x32_bf16(a, b, c, 0, 0, 0)
__device__ __forceinline__ bf16x8 rd_row(unsigned img, int row, int stride, int k0) { return *(const LAS bf16x8*)(size_t)(img + (unsigned)(row * stride + k0 * 2)); }
__device__ __forceinline__ bf16x8 rd_tr(unsigned img, int k0, int n0, int stride, int lane) {
    const int g = lane >> 4, i = lane & 15;
    const unsigned a0 = img + (unsigned)((k0 + 8 * g + (i >> 2)) * stride + (n0 + 4 * (i & 3)) * 2), a1 = a0 + 4u * (unsigned)stride;
    bf16x4 lo, hi;
    asm volatile("ds_read_b64_tr_b16 %0, %2\n\tds_read_b64_tr_b16 %1, %3\n\ts_waitcnt lgkmcnt(0)" : "=&v"(lo), "=&v"(hi) : "v"(a0), "v"(a1) : "memory");
    return (bf16x8){lo[0], lo[1], lo[2], lo[3], hi[0], hi[1], hi[2], hi[3]};
}
typedef unsigned u32x2_ __attribute__((ext_vector_type(2)));
typedef unsigned u32x4_ __attribute__((ext_vector_type(4)));
__device__ __forceinline__ unsigned tr_addr(unsigned img, int k0, int n0, int stride, int lane) { const int g = lane >> 4, i = lane & 15; return img + (unsigned)((k0 + 8 * g + (i >> 2)) * stride + (n0 + 4 * (i & 3)) * 2); }
__device__ __forceinline__ void rd_tr5(const unsigned (&a0)[5], const unsigned (&s4)[5], bf16x8 (&o)[5]) {
    bf16x4 l0, h0, l1, h1, l2, h2, l3, h3, l4, h4;
    asm volatile("ds_read_b64_tr_b16 %0, %10\n\tds_read_b64_tr_b16 %1, %11\n\tds_read_b64_tr_b16 %2, %12\n\tds_read_b64_tr_b16 %3, %13\n\tds_read_b64_tr_b16 %4, %14\n\t"
                 "ds_read_b64_tr_b16 %5, %15\n\tds_read_b64_tr_b16 %6, %16\n\tds_read_b64_tr_b16 %7, %17\n\tds_read_b64_tr_b16 %8, %18\n\tds_read_b64_tr_b16 %9, %19\n\ts_waitcnt lgkmcnt(0)"
                 : "=&v"(l0), "=&v"(h0), "=&v"(l1), "=&v"(h1), "=&v"(l2), "=&v"(h2), "=&v"(l3), "=&v"(h3), "=&v"(l4), "=&v"(h4)
                 : "v"(a0[0]), "v"(a0[0] + s4[0]), "v"(a0[1]), "v"(a0[1] + s4[1]), "v"(a0[2]), "v"(a0[2] + s4[2]), "v"(a0[3]), "v"(a0[3] + s4[3]), "v"(a0[4]), "v"(a0[4] + s4[4]) : "memory");
    o[0] = (bf16x8){l0[0], l0[1], l0[2], l0[3], h0[0], h0[1], h0[2], h0[3]}; o[1] = (bf16x8){l1[0], l1[1], l1[2], l1[3], h1[0], h1[1], h1[2], h1[3]};
    o[2] = (bf16x8){l2[0], l2[1], l2[2], l2[3], h2[0], h2[1], h2[2], h2[3]}; o[3] = (bf16x8){l3[0], l3[1], l3[2], l3[3], h3[0], h3[1], h3[2], h3[3]};
    o[4] = (bf16x8){l4[0], l4[1], l4[2], l4[3], h4[0], h4[1], h4[2], h4[3]};
}
__device__ __forceinline__ void st8(unsigned addr, uint2 v) { *(LAS u32x2_*)(size_t)addr = (u32x2_){v.x, v.y}; }
__device__ __forceinline__ void st16(unsigned addr, uint4 v) { *(LAS u32x4_*)(size_t)addr = (u32x4_){v.x, v.y, v.z, v.w}; }
__device__ __forceinline__ float scan_add64(float v, int lane) {
#pragma unroll
    for (int o = 1; o < 64; o <<= 1) { const float t = SHU(v, o); if (lane >= o) v += t; }
    return v;
}
__device__ __forceinline__ float scan_max64(float v, int lane) {
#pragma unroll
    for (int o = 1; o < 64; o <<= 1) { const float t = SHU(v, o); if (lane >= o) v = fmaxf(v, t); }
    return v;
}

template <int MODE>
__device__ __forceinline__ void scan_item(KP p, int l, int b, int h, int dir, int vs) {
    constexpr int CS = (MODE == 1) ? 32 : 64, DK = (MODE == 0) ? 64 : 128, EXT = (MODE == 0) ? 1 : 0;
    constexpr int QS = (DK + 8) * 2, VS = (64 + 16 * EXT + 8) * 2, SS = (CS + 8) * 2, NVR = 64 + 16 * EXT;
    constexpr int NCH = (CTXL + SEQ) / CS;
    constexpr int LD = (MODE == 2) ? ODD_LD : EVEN_LD;
    constexpr unsigned O_QA = 0, O_KA = O_QA + CS * QS, O_QB = O_KA + CS * QS, O_KW = O_QB + (MODE == 1 ? CS * QS : 0), O_V = O_KW + CS * QS,
                       O_SSC = O_V + CS * VS, O_ST = O_SSC + CS * SS, O_DKV = O_ST + 2 * NVR * QS, O_END = O_DKV + 512;
    static_assert(O_END <= 131072, "scan LDS");
    const int tid = opaque_tid(), lane = tid & 63, wv = __builtin_amdgcn_readfirstlane(tid >> 6), r16 = lane & 15, q4 = lane >> 4;
    const unsigned L0 = (unsigned)(size_t)smraw_base();
    const bf16_t* P = (const bf16_t*)(p->ws + OFF_BIG);
    bf16_t* HXo = (bf16_t*)(p->ws + OFF_AUX) + (size_t)dir * NT * 1024;
    const int e2 = l >> 1;
    const int cQ = (MODE == 0) ? E_MQ + h * 64 : (MODE == 1) ? E_HQ + h * 128 : 1536 + h * 128;
    const int cK = (MODE == 0) ? E_MK + h * 64 : (MODE == 1) ? (dir ? E_HFB : E_HFF) + h * 128 : 2048 + h * 128;
    const int cV = (MODE == 0) ? E_MV + h * 128 + vs * 64 : (MODE == 1) ? E_HI + h * 128 + vs * 64 : 2560 + h * 128 + vs * 64;
    const int cO = (MODE == 0) ? h * 128 + vs * 64 : 512 + h * 128 + vs * 64;
    const int lt = (MODE == 1) ? (tid & 31) : (tid >> 3);
    const int lj = (MODE == 0) ? (tid & 7) : (MODE == 1) ? (tid >> 5) : ((tid >> 2) & 1) * 8 + (tid & 3);
    const int vt_ = tid >> 3, vj = tid & 7;
    float lbv[8]; float gbi = 0.f, gbf = 0.f, lg = 0.f;
    if (MODE == 1) {
        const float* lbp = (const float*)(p->ws + OFF_LB) + e2 * 512 + h * 128 + lj * 8;
#pragma unroll
        for (int i = 0; i < 8; ++i) lbv[i] = lbp[i];
    } else {
#pragma unroll
        for (int i = 0; i < 8; ++i) lbv[i] = 0.f;
    }
    if (MODE == 0) { const float* gb = p->in[I_MGB] + e2 * 16; gbi = gb[(dir ? 2 : 0) * 4 + h]; gbf = gb[(dir ? 3 : 1) * 4 + h]; }
    if (MODE == 2) lg = p->in[I_RLD][e2 * 8 + dir * 4 + h];
    const float* G = (const float*)(p->ws + OFF_G);
    const float* ropet = (const float*)(p->ws + OFF_ROPE);
    unsigned oz = 0u; asm volatile("" : "+v"(oz));
    for (unsigned o = tid * 16; o < 2u * NVR * QS; o += 512 * 16) st16(L0 + O_ST + o, make_uint4(oz, oz, oz, oz));
    if (EXT) { if (tid < CS) { st16(L0 + O_V + tid * VS + 128, make_uint4(0x3f80u | oz, oz, oz, oz)); st16(L0 + O_V + tid * VS + 144, make_uint4(oz, oz, oz, oz)); } }
    f32x4 sacc[4];
#pragma unroll
    for (int i = 0; i < 4; ++i) sacc[i] = (f32x4){0.f, 0.f, 0.f, 0.f};
    float m_in = -1e30f;
    struct Raw { uint4 rq0, rq1, rk0, rk1, rv; float rg0, rg1; };
    Raw RA, RB;
    RA.rq1 = make_uint4(0u, 0u, 0u, 0u); RA.rk1 = RA.rq1; RA.rv = RA.rq1; RA.rg0 = 0.f; RA.rg1 = 0.f; RB = RA;
    auto load_chunk = [&](Raw& R, int c) {
        const int i0 = c * CS;
        const int tq = scan_tok(b, i0 + lt, dir);
        const bf16_t* pr = P + (size_t)tq * LD;
        R.rq0 = *(const uint4*)(pr + cQ + lj * 8); R.rk0 = *(const uint4*)(pr + cK + lj * 8);
        if (MODE == 2) { R.rq1 = *(const uint4*)(pr + cQ + lj * 8 + 32); R.rk1 = *(const uint4*)(pr + cK + lj * 8 + 32); }
        if (MODE != 1 || tid < 256) { const int tv = scan_tok(b, i0 + vt_, dir); R.rv = *(const uint4*)(P + (size_t)tv * LD + cV + vj * 8); }
        if (MODE == 0) { const int tg = scan_tok(b, i0 + lane, dir); R.rg0 = G[(size_t)tg * 16 + (dir ? 8 : 0) + h]; R.rg1 = G[(size_t)tg * 16 + (dir ? 12 : 4) + h]; }
    };
    constexpr int PD = (MODE == 2) ? 1 : 2;
    load_chunk(RA, 0); if (PD == 2) load_chunk(RB, 1);
    auto chunk = [&](const int c, Raw& R) {
        const uint4 rq0 = R.rq0, rq1 = R.rq1, rk0 = R.rk0, rk1 = R.rk1, rv = R.rv; const float rg0 = R.rg0, rg1 = R.rg1;
        const unsigned ST_R = L0 + O_ST + (unsigned)(c & 1) * NVR * QS, ST_W = L0 + O_ST + (unsigned)((c + 1) & 1) * NVR * QS;
        float sp = 1.f;
        float v_u = 0.f, v_M = 0.f, v_e = 1.f, v_low = 0.f, v_w = 1.f;
        if (MODE == 0) {
            const float ig = rg0 + gbi, fg = rg1 + gbf;
            const float lf = fminf(fg, 0.f) - flog(1.f + fexp(-fabsf(fg)));
            const float bb = scan_add64(lf, lane);
            const float g = SHI(bb, 63);
            v_u = ig - bb;
            const float cu = scan_max64(v_u, lane);
            v_M = fmaxf(m_in, cu);
            const float m_new = fmaxf(g + m_in, g + SHI(cu, 63));
            sp = fexp(g + m_in - m_new);
            v_w = fexp(g + v_u - m_new);
            v_e = fexp(m_in - v_M);
            v_low = fexp(-(bb + v_M));
            m_in = m_new;
            st16(L0 + O_QA + lt * QS + lj * 16, rq0);
            st16(L0 + O_KA + lt * QS + lj * 16, rk0);
            const float wr = SHI(v_w, lt);
            uint4 kw; kw.x = cvt_pk_bf16(bflo(rk0.x) * wr, bfhi(rk0.x) * wr); kw.y = cvt_pk_bf16(bflo(rk0.y) * wr, bfhi(rk0.y) * wr);
            kw.z = cvt_pk_bf16(bflo(rk0.z) * wr, bfhi(rk0.z) * wr); kw.w = cvt_pk_bf16(bflo(rk0.w) * wr, bfhi(rk0.w) * wr);
            st16(L0 + O_KW + lt * QS + lj * 16, kw);
            st16(L0 + O_V + vt_ * VS + vj * 16, rv);
        } else if (MODE == 2) {
            sp = fexp(64.f * lg);
            const bool lat = c >= CTXL / CS;
            float q[16], k[16];
            const unsigned qa[8] = {rq0.x, rq0.y, rq0.z, rq0.w, rq1.x, rq1.y, rq1.z, rq1.w}, ka[8] = {rk0.x, rk0.y, rk0.z, rk0.w, rk1.x, rk1.y, rk1.z, rk1.w};
#pragma unroll
            for (int i = 0; i < 8; ++i) { q[2 * i] = bflo(qa[i]); q[2 * i + 1] = bfhi(qa[i]); k[2 * i] = bflo(ka[i]); k[2 * i + 1] = bfhi(ka[i]); }
            if (lat) {
                const int tq = scan_tok(b, c * CS + lt, dir), tt = tq & (SEQ - 1);
                const int pos = ((tid >> 2) & 1) ? (tt & 63) : (tt >> 6);
                const float2* rt = (const float2*)ropet + pos * 32 + (tid & 3) * 8;
#pragma unroll
                for (int i = 0; i < 8; ++i) {
                    const float2 cs2 = rt[i];
                    const float q1 = q[i], q2 = q[8 + i], k1 = k[i], k2 = k[8 + i];
                    q[i] = q1 * cs2.x - q2 * cs2.y; q[8 + i] = q1 * cs2.y + q2 * cs2.x;
                    k[i] = k1 * cs2.x - k2 * cs2.y; k[8 + i] = k1 * cs2.y + k2 * cs2.x;
                }
            }
            const float wr = 0.08838834764831845f * fexp((float)(63 - lt) * lg);
            uint4 o0, o1, w0, w1, x0, x1;
            o0.x = cvt_pk_bf16(q[0], q[1]); o0.y = cvt_pk_bf16(q[2], q[3]); o0.z = cvt_pk_bf16(q[4], q[5]); o0.w = cvt_pk_bf16(q[6], q[7]);
            o1.x = cvt_pk_bf16(q[8], q[9]); o1.y = cvt_pk_bf16(q[10], q[11]); o1.z = cvt_pk_bf16(q[12], q[13]); o1.w = cvt_pk_bf16(q[14], q[15]);
            w0.x = cvt_pk_bf16(k[0], k[1]); w0.y = cvt_pk_bf16(k[2], k[3]); w0.z = cvt_pk_bf16(k[4], k[5]); w0.w = cvt_pk_bf16(k[6], k[7]);
            w1.x = cvt_pk_bf16(k[8], k[9]); w1.y = cvt_pk_bf16(k[10], k[11]); w1.z = cvt_pk_bf16(k[12], k[13]); w1.w = cvt_pk_bf16(k[14], k[15]);
            x0.x = cvt_pk_bf16(k[0] * wr, k[1] * wr); x0.y = cvt_pk_bf16(k[2] * wr, k[3] * wr); x0.z = cvt_pk_bf16(k[4] * wr, k[5] * wr); x0.w = cvt_pk_bf16(k[6] * wr, k[7] * wr);
            x1.x = cvt_pk_bf16(k[8] * wr, k[9] * wr); x1.y = cvt_pk_bf16(k[10] * wr, k[11] * wr); x1.z = cvt_pk_bf16(k[12] * wr, k[13] * wr); x1.w = cvt_pk_bf16(k[14] * wr, k[15] * wr);
            st16(L0 + O_QA + lt * QS + lj * 16, o0); st16(L0 + O_QA + lt * QS + lj * 16 + 64, o1);
            st16(L0 + O_KA + lt * QS + lj * 16, w0); st16(L0 + O_KA + lt * QS + lj * 16 + 64, w1);
            st16(L0 + O_KW + lt * QS + lj * 16, x0); st16(L0 + O_KW + lt * QS + lj * 16 + 64, x1);
            st16(L0 + O_V + vt_ * VS + vj * 16, rv);
        } else {
            const unsigned qa[4] = {rq0.x, rq0.y, rq0.z, rq0.w}, fa[4] = {rk0.x, rk0.y, rk0.z, rk0.w};
            float qv[8], kk[8], A[8];
#pragma unroll
            for (int i = 0; i < 8; ++i) {
                const float qr = (i & 1) ? bfhi(qa[i >> 1]) : bflo(qa[i >> 1]), fr = (i & 1) ? bfhi(fa[i >> 1]) : bflo(fa[i >> 1]);
                const float f = lbv[i] + (1.f - lbv[i]) * fsigmoid(fr);
                qv[i] = fsilu(qr); kk[i] = 1.f - f; A[i] = flog(f);
            }
#pragma unroll
            for (int o = 1; o < 32; o <<= 1)
#pragma unroll
                for (int i = 0; i < 8; ++i) { const float t = SHU(A[i], o); if (lt >= o) A[i] += t; }
            float qa_[8], qb_[8], ka_[8], kw_[8];
#pragma unroll
            for (int i = 0; i < 8; ++i) {
                const float am = SHI32(A[i], 15), ae = SHI32(A[i], 31);
                qa_[i] = qv[i] * fexp(A[i] - am); qb_[i] = qv[i] * fexp(A[i]); ka_[i] = kk[i] * fexp(am - A[i]); kw_[i] = kk[i] * fexp(ae - A[i]);
                if (lt == 31) *(LAS float*)(size_t)(L0 + O_DKV + (lj * 8 + i) * 4) = fexp(ae);
            }
            uint4 w;
            w.x = cvt_pk_bf16(qa_[0], qa_[1]); w.y = cvt_pk_bf16(qa_[2], qa_[3]); w.z = cvt_pk_bf16(qa_[4], qa_[5]); w.w = cvt_pk_bf16(qa_[6], qa_[7]); st16(L0 + O_QA + lt * QS + lj * 16, w);
            w.x = cvt_pk_bf16(qb_[0], qb_[1]); w.y = cvt_pk_bf16(qb_[2], qb_[3]); w.z = cvt_pk_bf16(qb_[4], qb_[5]); w.w = cvt_pk_bf16(qb_[6], qb_[7]); st16(L0 + O_QB + lt * QS + lj * 16, w);
            w.x = cvt_pk_bf16(ka_[0], ka_[1]); w.y = cvt_pk_bf16(ka_[2], ka_[3]); w.z = cvt_pk_bf16(ka_[4], ka_[5]); w.w = cvt_pk_bf16(ka_[6], ka_[7]); st16(L0 + O_KA + lt * QS + lj * 16, w);
            w.x = cvt_pk_bf16(kw_[0], kw_[1]); w.y = cvt_pk_bf16(kw_[2], kw_[3]); w.z = cvt_pk_bf16(kw_[4], kw_[5]); w.w = cvt_pk_bf16(kw_[6], kw_[7]); st16(L0 + O_KW + lt * QS + lj * 16, w);
            if (tid < 256) st16(L0 + O_V + vt_ * VS + vj * 16, rv);
        }
        __syncthreads();
        if (c + PD < NCH) load_chunk(R, c + PD);
        {
            constexpr int NT1 = CS / 16;
            const bool act = (MODE == 1) ? (wv < 4) : true;
            const int tb = (MODE == 1) ? (wv & 1) : (wv & 3);
#pragma unroll
            for (int u2 = 0; u2 < ((MODE == 1) ? 1 : 2); ++u2) {
                const int sb = (MODE == 1) ? (wv >> 1) : 2 * (wv >> 2) + u2;
                if (act) {
                    f32x4 d = (f32x4){0.f, 0.f, 0.f, 0.f};
                    if (sb <= tb) {
#pragma unroll
                        for (int kk2 = 0; kk2 < DK / 32; ++kk2)
                            d = SC_MFMA(rd_row(L0 + O_KA, sb * 16 + r16, QS, kk2 * 32 + q4 * 8), rd_row(L0 + O_QA, tb * 16 + r16, QS, kk2 * 32 + q4 * 8), d);
                        const int t = tb * 16 + r16, s0 = sb * 16 + q4 * 4;
                        if (MODE == 0) {
                            const float Mt = SHI(v_M, t);
#pragma unroll
                            for (int jj = 0; jj < 4; ++jj) { const float us = SHI(v_u, s0 + jj); d[jj] = (s0 + jj <= t) ? d[jj] * 0.125f * fexp(us - Mt) : 0.f; }
                        } else if (MODE == 2) {
#pragma unroll
                            for (int jj = 0; jj < 4; ++jj) d[jj] = (s0 + jj <= t) ? d[jj] * 0.08838834764831845f * fexp((float)(t - s0 - jj) * lg) : 0.f;
                        } else {
#pragma unroll
                            for (int jj = 0; jj < 4; ++jj) d[jj] = (s0 + jj <= t) ? d[jj] : 0.f;
                        }
                    }
                    st8(L0 + O_SSC + (tb * 16 + r16) * SS + (sb * 16 + q4 * 4) * 2, make_uint2(cvt_pk_bf16(d[0], d[1]), cvt_pk_bf16(d[2], d[3])));
                }
            }
            (void)NT1;
        }
        __syncthreads();
        {
            const int tb = (MODE == 1) ? (wv & 1) : (wv & 3);
            const int t = tb * 16 + r16;
            const int tok = scan_tok(b, c * CS + t, dir);
            constexpr int NV = (MODE == 1) ? 1 : 2;
            f32x4 oi[NV + EXT], oo[NV + EXT];
#pragma unroll
            for (int u2 = 0; u2 < NV + EXT; ++u2) {
                const int vt = (u2 == NV) ? 4 : ((MODE == 1) ? (wv >> 1) : 2 * (wv >> 2) + u2);
                f32x4 a1 = (f32x4){0.f, 0.f, 0.f, 0.f}, a2 = a1;
#pragma unroll
                for (int sb2 = 0; sb2 < CS / 32; ++sb2)
                    a1 = SC_MFMA(rd_tr(L0 + O_V, sb2 * 32, vt * 16, VS, lane), rd_row(L0 + O_SSC, t, SS, sb2 * 32 + q4 * 8), a1);
#pragma unroll
                for (int kk2 = 0; kk2 < DK / 32; ++kk2)
                    a2 = SC_MFMA(rd_row(ST_R, vt * 16 + r16, QS, kk2 * 32 + q4 * 8), rd_row(L0 + ((MODE == 1) ? O_QB : O_QA), t, QS, kk2 * 32 + q4 * 8), a2);
                oi[u2] = a1; oo[u2] = a2;
            }
            float den = 1.f, ei = 1.f;
            if (MODE == 0) {
                ei = 0.125f * SHI(v_e, t);
                const float dsum = oi[NV][0] + ei * oo[NV][0];
                const float dd = SHI(dsum, r16);
                den = 1.f / fmaxf(fabsf(dd), SHI(v_low, t));
            } else if (MODE == 2) {
                ei = fexp((float)(t + 1) * lg);
            }
#pragma unroll
            for (int u2 = 0; u2 < NV; ++u2) {
                const int vt = (MODE == 1) ? (wv >> 1) : 2 * (wv >> 2) + u2;
                float o[4];
#pragma unroll
                for (int jj = 0; jj < 4; ++jj) o[jj] = (oi[u2][jj] + ei * oo[u2][jj]) * den;
                *(uint2*)(HXo + (size_t)tok * 1024 + cO + vt * 16 + q4 * 4) = make_uint2(cvt_pk_bf16(o[0], o[1]), cvt_pk_bf16(o[2], o[3]));
            }
        }
        {
            constexpr int NS = (MODE == 0) ? 3 : 4;
            const int kt = (MODE == 0) ? (wv & 3) : wv;
            float dk[4] = {sp, sp, sp, sp};
            if (MODE == 1) { const f32x4 dv = *(const LAS f32x4*)(size_t)(L0 + O_DKV + (kt * 16 + q4 * 4) * 4); dk[0] = dv[0]; dk[1] = dv[1]; dk[2] = dv[2]; dk[3] = dv[3]; }
            f32x4 a[NS];
#pragma unroll
            for (int u2 = 0; u2 < NS; ++u2) { a[u2] = sacc[u2];
#pragma unroll
                for (int jj = 0; jj < 4; ++jj) a[u2][jj] *= dk[jj]; }
#pragma unroll
            for (int sb2 = 0; sb2 < CS / 32; ++sb2) {
                unsigned ta[5], ts[5]; bf16x8 ops[5];
                ta[0] = tr_addr(L0 + O_KW, sb2 * 32, kt * 16, QS, lane); ts[0] = 4u * QS;
#pragma unroll
                for (int u2 = 0; u2 < 4; ++u2) {
                    const int vt = (MODE == 0) ? ((u2 >= 2) ? 4 : 2 * (wv >> 2) + u2) : u2;
                    ta[1 + u2] = tr_addr(L0 + O_V, sb2 * 32, vt * 16, VS, lane); ts[1 + u2] = 4u * VS;
                }
                rd_tr5(ta, ts, ops);
#pragma unroll
                for (int u2 = 0; u2 < NS; ++u2) a[u2] = SC_MFMA(ops[0], ops[1 + u2], a[u2]);
            }
#pragma unroll
            for (int u2 = 0; u2 < NS; ++u2) {
                const int vt = (MODE == 0) ? ((u2 == 2) ? 4 : 2 * (wv >> 2) + u2) : u2;
                sacc[u2] = a[u2];
                st8(ST_W + (vt * 16 + r16) * QS + (kt * 16 + q4 * 4) * 2, make_uint2(cvt_pk_bf16(a[u2][0], a[u2][1]), cvt_pk_bf16(a[u2][2], a[u2][3])));
            }
        }
        __syncthreads();
    };
#pragma unroll 1
    for (int c = 0; c < NCH; c += 2) { chunk(c, RA); if (PD == 2) chunk(c + 1, RB); else chunk(c + 1, RA); }
}
}

__device__ __forceinline__ void ph_scan_even2(KP p, int l, int bid, int nb) {
#pragma unroll 1
    for (int item = bid; item < 256; item += nb) {
        const int kind = item >> 7, b = (item >> 4) & 7, h = (item >> 2) & 3, dir = (item >> 1) & 1, vs = item & 1;
        if (kind == 0) sc::scan_item<0>(p, l, b, h, dir, vs); else sc::scan_item<1>(p, l, b, h, dir, vs);
        __syncthreads();
    }
}
__device__ __forceinline__ void ph_scan_odd2(KP p, int l, int bid, int nb) {
#pragma unroll 1
    for (int item = bid; item < 128; item += nb) {
        const int b = (item >> 4) & 7, h = (item >> 2) & 3, dir = (item >> 1) & 1, vs = item & 1;
        sc::scan_item<2>(p, l, b, h, dir, vs);
        __syncthreads();
    }
}

__device__ __forceinline__ void unpack16(const uint4 a, const uint4 b, float (&x)[16]) {
    x[0] = bflo(a.x); x[1] = bfhi(a.x); x[2] = bflo(a.y); x[3] = bfhi(a.y); x[4] = bflo(a.z); x[5] = bfhi(a.z); x[6] = bflo(a.w); x[7] = bfhi(a.w);
    x[8] = bflo(b.x); x[9] = bfhi(b.x); x[10] = bflo(b.y); x[11] = bfhi(b.y); x[12] = bflo(b.z); x[13] = bfhi(b.z); x[14] = bflo(b.w); x[15] = bfhi(b.w);
}
__device__ __forceinline__ float sum8(float v) { v += SHX(v, 1); v += SHX(v, 2); v += SHX(v, 4); return v; }
template <bool MEANSUB, bool SIG>
__device__ __forceinline__ void head_norm_gate16(const bf16_t* h0, const bf16_t* h1, const bf16_t* gp, const float* nw, bf16_t* out) {
    float a[16], b[16], g[16];
    unpack16(*(const uint4*)h0, *(const uint4*)(h0 + 8), a); unpack16(*(const uint4*)h1, *(const uint4*)(h1 + 8), b); unpack16(*(const uint4*)gp, *(const uint4*)(gp + 8), g);
    float s = 0.f;
#pragma unroll
    for (int i = 0; i < 16; ++i) { a[i] += b[i]; s += a[i]; }
    if (MEANSUB) { const float mean = sum8(s) * (1.f / 128.f);
#pragma unroll
        for (int i = 0; i < 16; ++i) a[i] -= mean; }
    float q = 0.f;
#pragma unroll
    for (int i = 0; i < 16; ++i) q += a[i] * a[i];
    const float r = rsqrtf(sum8(q) * (1.f / 128.f) + LN_EPS);
    unsigned w[8];
#pragma unroll
    for (int i = 0; i < 16; i += 2) {
        const float y0 = a[i] * r * nw[i] * (SIG ? sigmoidf_(g[i]) : siluf_(g[i])), y1 = a[i + 1] * r * nw[i + 1] * (SIG ? sigmoidf_(g[i + 1]) : siluf_(g[i + 1]));
        w[i >> 1] = cvt_pk_bf16(y0, y1);
    }
    *(uint4*)out = make_uint4(w[0], w[1], w[2], w[3]); *(uint4*)(out + 8) = make_uint4(w[4], w[5], w[6], w[7]);
}
__device__ __forceinline__ void ph_normgate_even(KP p, int l, int bid, int nb) {
    const int tid = opaque_tid(), lane = tid & 63, wv = tid >> 6;
    const bf16_t* P = (const bf16_t*)(p->ws + OFF_BIG);
    const bf16_t* HX = (const bf16_t*)(p->ws + OFF_AUX);
    const bf16_t* HX1 = HX + (size_t)NT * 1024;
    bf16_t* MIX = (bf16_t*)(p->ws + OFF_U);
    const int e = l >> 1;
    const bool ml = lane < 32;
    const float* nw = ml ? p->in[I_MNW] + e * 512 + 16 * lane : p->in[I_HNW] + e * 512 + 16 * (lane - 32);
    const int gcol = ml ? E_MO + 16 * lane : E_HG + 16 * (lane - 32);
#pragma unroll 1
    for (int tok = bid * 8 + wv; tok < NT; tok += nb * 8) {
        const size_t o = (size_t)tok * 1024 + 16 * lane;
        if (ml) head_norm_gate16<true, true>(HX + o, HX1 + o, P + (size_t)tok * EVEN_LD + gcol, nw, MIX + o);
        else head_norm_gate16<false, false>(HX + o, HX1 + o, P + (size_t)tok * EVEN_LD + gcol, nw, MIX + o);
    }
}

#define OFF_UT   (OFF_AUX + 136 * MiB)
#define OFF_FKS(o) (984 * MiB + (size_t)(o) * 34 * MiB)
#define OFF_ZOT  (OFF_UT + 102 * MiB)

__device__ __forceinline__ void ph_hy_filt2(KP p, int l, int bid, int nb, float* sm, int skip) {
    const int tid = opaque_tid(), o = l >> 1;
    float* zf = sm;
    float* h1 = sm + 1024;
    float* h2 = sm + 2048;
    float* h3 = sm + 3072;
    const float* fw1 = p->in[I_HW1] + o * 33 * 64; const float* fb1 = p->in[I_HB1] + o * 64;
    const float* fw2 = p->in[I_HW2] + o * 64 * 64; const float* fb2 = p->in[I_HB2] + o * 64;
    const float* fw3 = p->in[I_HW3] + o * 64 * 64; const float* fb3 = p->in[I_HB3] + o * 64;
    const float* freq = p->in[I_HFREQ] + o * 64;
    const float* wout = p->in[I_HWOUT] + (size_t)o * 64 * 2048;
    float* FK = (float*)(p->ws + OFF_FKS(o)); float* FKC = FK + (size_t)2 * 512 * 8192;
#pragma unroll 1
    for (int item = bid - skip; item < (SEQ + CTXL) / 16; item += nb - skip) {
        if (item < 0) break;
        const bool isctx = item >= SEQ / 16;
        const int L = isctx ? CTXL : SEQ, pos0 = (isctx ? item - SEQ / 16 : item) * 16;
        __syncthreads();
        if (tid < 16 * 17) {
            const int pp = tid / 17, j = tid % 17, pos = pos0 + pp;
            if (j == 16) zf[pp * 36] = (float)pos / (float)(L - 1);
            else { const float f = 1e-4f + (float)j * ((15.0f - 1e-4f) / 15.0f); const float w = 2.0f * 3.14159265358979323846f * (float)pos / (float)L * f; zf[pp * 36 + 1 + j] = cosf(w); zf[pp * 36 + 17 + j] = sinf(w); }
        }
        __syncthreads();
        const int pp = tid >> 5, u0 = (tid & 31) * 2;
        { float a0 = fb1[u0], a1 = fb1[u0 + 1];
#pragma unroll 1
          for (int k = 0; k < 33; ++k) { const float z = zf[pp * 36 + k]; a0 += z * fw1[k * 64 + u0]; a1 += z * fw1[k * 64 + u0 + 1]; }
          h1[pp * 64 + u0] = sinf(freq[u0] * a0); h1[pp * 64 + u0 + 1] = sinf(freq[u0 + 1] * a1); }
        __syncthreads();
        { float a0 = fb2[u0], a1 = fb2[u0 + 1];
#pragma unroll 4
          for (int k = 0; k < 64; ++k) { const float z = h1[pp * 64 + k]; a0 += z * fw2[k * 64 + u0]; a1 += z * fw2[k * 64 + u0 + 1]; }
          h2[pp * 64 + u0] = sinf(freq[u0] * a0); h2[pp * 64 + u0 + 1] = sinf(freq[u0 + 1] * a1); }
        __syncthreads();
        { float a0 = fb3[u0], a1 = fb3[u0 + 1];
#pragma unroll 4
          for (int k = 0; k < 64; ++k) { const float z = h2[pp * 64 + k]; a0 += z * fw3[k * 64 + u0]; a1 += z * fw3[k * 64 + u0 + 1]; }
          h3[pp * 64 + u0] = sinf(freq[u0] * a0); h3[pp * 64 + u0 + 1] = sinf(freq[u0 + 1] * a1); }
        __syncthreads();
#pragma unroll 1
        for (int r = 0; r < 4; ++r) {
            const int col = tid + 512 * r, c = col & 511, od = col >> 9, order = od >> 1, dirn = od & 1;
            float a[16];
#pragma unroll
            for (int i = 0; i < 16; ++i) a[i] = 0.f;
#pragma unroll 1
            for (int k = 0; k < 64; k += 4) { const float w0 = wout[k * 2048 + col], w1 = wout[(k + 1) * 2048 + col], w2 = wout[(k + 2) * 2048 + col], w3 = wout[(k + 3) * 2048 + col];
#pragma unroll
                for (int i = 0; i < 16; ++i) { const float4 hh = *(const float4*)(h3 + i * 64 + k); a[i] += hh.x * w0 + hh.y * w1 + hh.z * w2 + hh.w * w3; } }
            const float delta = 3.0701134573253944f + (float)c * ((15.350567286626972f - 3.0701134573253944f) / 511.0f);
#pragma unroll
            for (int i = 0; i < 16; ++i) a[i] *= expf(-((float)(pos0 + i) / (float)(L - 1)) * delta);
            float* dst = isctx ? FKC + ((size_t)order * 512 + c) * 512 + 256 : FK + ((size_t)order * 512 + c) * 8192 + 4096;
            if (dirn == 0) {
#pragma unroll
                for (int i = 0; i < 16; i += 4) *(float4*)(dst + pos0 + i) = make_float4(a[i], a[i + 1], a[i + 2], a[i + 3]);
            } else {
#pragma unroll
                for (int i = 0; i < 16; ++i) if (pos0 + i > 0) dst[-(pos0 + i)] = a[i];
                if (pos0 == 0) dst[-L] = 0.f;
            }
        }
    }
}

__device__ __forceinline__ void ph_hy_prep(KP p, int l, int bid, int nb, float* sm) {
    const int tid = opaque_tid(), o = l >> 1;
    const bf16_t* P = (const bf16_t*)(p->ws + OFF_BIG);
    bf16_t* UT = (bf16_t*)(p->ws + OFF_UT);
    const float* cw = p->in[I_HCW] + o * 3 * 1536; const float* cb = p->in[I_HCB] + o * 1536;
    float* tile = sm;
#pragma unroll 1
    for (int item = bid; item < (NT / 256) * 24; item += nb) {
        const int tt = item / 24, ct = item % 24, tok0 = tt * 256, col0 = ct * 64;
        const bool lat = tok0 < NL;
        const int L = lat ? SEQ : CTXL, t0 = lat ? (tok0 & (SEQ - 1)) : ((tok0 - NL) & (CTXL - 1));
        __syncthreads();
#pragma unroll 1
        for (int i = tid; i < 258 * 8; i += 512) {
            const int rr = i >> 3, hf = i & 7, t = t0 + rr - 1;
            uint4 v = make_uint4(0u, 0u, 0u, 0u);
            if (t >= 0 && t < L) v = *(const uint4*)(P + (size_t)(tok0 + rr - 1) * ODD_LD + col0 + hf * 8);
            float* d = tile + rr * 65 + hf * 8;
            d[0] = bflo(v.x); d[1] = bfhi(v.x); d[2] = bflo(v.y); d[3] = bfhi(v.y); d[4] = bflo(v.z); d[5] = bfhi(v.z); d[6] = bflo(v.w); d[7] = bfhi(v.w);
        }
        __syncthreads();
#pragma unroll 1
        for (int r = 0; r < 4; ++r) {
            const int cc = (tid >> 5) + 16 * r, tc = (tid & 31) * 8, col = col0 + cc;
            const float w0 = cw[col], w1 = cw[1536 + col], w2 = cw[3072 + col], bb = cb[col];
            float y[8];
#pragma unroll
            for (int i = 0; i < 8; ++i) y[i] = tile[(tc + i) * 65 + cc] * w0 + tile[(tc + i + 1) * 65 + cc] * w1 + tile[(tc + i + 2) * 65 + cc] * w2 + bb;
            *(uint4*)(UT + (size_t)col * NT + tok0 + tc) = make_uint4(cvt_pk_bf16(y[0], y[1]), cvt_pk_bf16(y[2], y[3]), cvt_pk_bf16(y[4], y[5]), cvt_pk_bf16(y[6], y[7]));
        }
    }
}

__device__ __forceinline__ void hy_item_lat(KP p, int l, int c) {
    constexpr int ZSB = (SEQ + 8) * 2;
    constexpr unsigned O_Z = 0, O_PE = O_Z + 8 * ZSB, O_PO = O_PE + 4096 * 4, O_END = O_PO + 4096 * 4;
    static_assert(O_END <= BAR_LDS_, "hyena LDS");
    const int tid = opaque_tid(), lane = tid & 63, wv = __builtin_amdgcn_readfirstlane(tid >> 6), r16 = lane & 15, q4 = lane >> 4, o = l >> 1;
    const unsigned L0 = (unsigned)(size_t)smraw_base();
    const bf16_t* UT = (const bf16_t*)(p->ws + OFF_UT);
    bf16_t* ZOT = (bf16_t*)(p->ws + OFF_ZOT);
    const float* FK = (const float*)(p->ws + OFF_FKS(o));
    for (int i = tid; i < 8 * 512; i += 512) { const int b = i >> 9, ch = i & 511; sc::st16(L0 + O_Z + b * ZSB + ch * 16, *(const uint4*)(UT + (size_t)(1024 + c) * NT + b * SEQ + ch * 8)); }
#pragma unroll 1
    for (int order = 0; order < 2; ++order) {
        const float* fk = FK + ((size_t)order * 512 + c) * 8192;
        for (int i = tid; i < 4096; i += 512) {
            const float r0 = (i > 0) ? fk[8192 - 2 * i] : 0.f, r1 = fk[8191 - 2 * i], r2 = (i < 4095) ? fk[8190 - 2 * i] : 0.f;
            *(LAS unsigned*)(size_t)(L0 + O_PE + i * 4) = cvt_pk_bf16(r0, r1); *(LAS unsigned*)(size_t)(L0 + O_PO + i * 4) = cvt_pk_bf16(r1, r2);
        }
        __syncthreads();
        sc::f32x4 acc[4][4];
#pragma unroll
        for (int a = 0; a < 4; ++a)
#pragma unroll
            for (int b2 = 0; b2 < 4; ++b2) acc[a][b2] = (sc::f32x4){0.f, 0.f, 0.f, 0.f};
        const unsigned gbase = L0 + ((r16 & 1) ? O_PO : O_PE) + (unsigned)(((4096 - r16 + 8 * q4 - (r16 & 1)) >> 1) * 4);
        auto ldG = [&](int g) {
            const unsigned a0 = gbase - (unsigned)(32 * g);
            const unsigned w0 = *(const LAS unsigned*)(size_t)a0, w1 = *(const LAS unsigned*)(size_t)(a0 + 4), w2 = *(const LAS unsigned*)(size_t)(a0 + 8), w3 = *(const LAS unsigned*)(size_t)(a0 + 12);
            return __builtin_bit_cast(sc::bf16x8, (sc::u32x4_){w0, w1, w2, w3});
        };
        sc::bf16x8 bq[4][2], W[6];
#pragma unroll
        for (int i = 0; i < 4; ++i) { bq[i][0] = (sc::bf16x8){0, 0, 0, 0, 0, 0, 0, 0}; bq[i][1] = bq[i][0]; }
        const int D0 = 8 * wv - 63, D1 = (8 * wv + 7 < 63) ? 8 * wv + 7 : 63;
        W[4] = ldG(4 * D0 - 6 + 4); W[5] = ldG(4 * D0 - 6 + 5);
#pragma unroll 1
        for (int D = D0; D <= D1; ++D) {
            W[0] = W[4]; W[1] = W[5];
#pragma unroll
            for (int i = 0; i < 4; ++i) W[2 + i] = ldG(4 * D + i);
            bq[3][0] = bq[2][0]; bq[3][1] = bq[2][1]; bq[2][0] = bq[1][0]; bq[2][1] = bq[1][1]; bq[1][0] = bq[0][0]; bq[1][1] = bq[0][1];
            {
                const int s1 = 8 * wv - D + ((r16 < 8) ? 0 : 4);
                const bool ok = (unsigned)s1 < 64u;
                const unsigned za = L0 + O_Z + (unsigned)((r16 & 7) * ZSB + ((ok ? s1 : 0) * 64 + q4 * 8) * 2);
                sc::bf16x8 b0 = *(const LAS sc::bf16x8*)(size_t)za, b1 = *(const LAS sc::bf16x8*)(size_t)(za + 64);
                if (!ok) { b0 = (sc::bf16x8){0, 0, 0, 0, 0, 0, 0, 0}; b1 = b0; }
                bq[0][0] = b0; bq[0][1] = b1;
            }
#pragma unroll
            for (int cg = 0; cg < 4; ++cg) {
                const int sA = 8 * wv + cg - D;
                if ((unsigned)sA < 64u || (unsigned)(sA + 4) < 64u) {
#pragma unroll
                    for (int it = 0; it < 4; ++it) { acc[cg][it] = SC_MFMA(W[it + 2], bq[cg][0], acc[cg][it]); acc[cg][it] = SC_MFMA(W[it], bq[cg][1], acc[cg][it]); }
                }
            }
        }
        __syncthreads();
        const float sk = p->in[I_HSKIP][o * 1024 + order * 512 + c];
        const bf16_t* gt = UT + (size_t)(order * 512 + c) * NT;
        const int bb = r16 & 7;
#pragma unroll
        for (int cg = 0; cg < 4; ++cg) {
            const int t1 = 8 * wv + cg + ((r16 < 8) ? 0 : 4);
#pragma unroll
            for (int it = 0; it < 4; ++it) {
                const int t = t1 * 64 + it * 16 + q4 * 4;
                const sc::u32x2_ zo_ = *(const LAS sc::u32x2_*)(size_t)(L0 + O_Z + bb * ZSB + t * 2); const uint2 zo = make_uint2(zo_[0], zo_[1]);
                const uint2 gv = *(const uint2*)(gt + bb * SEQ + t);
                const float y0 = bflo(gv.x) * (acc[cg][it][0] + sk * bflo(zo.x)), y1 = bfhi(gv.x) * (acc[cg][it][1] + sk * bfhi(zo.x));
                const float y2 = bflo(gv.y) * (acc[cg][it][2] + sk * bflo(zo.y)), y3 = bfhi(gv.y) * (acc[cg][it][3] + sk * bfhi(zo.y));
                const uint2 w = make_uint2(cvt_pk_bf16(y0, y1), cvt_pk_bf16(y2, y3));
                if (order == 0) sc::st8(L0 + O_Z + bb * ZSB + t * 2, w);
                else *(uint2*)(ZOT + (size_t)c * NT + bb * SEQ + t) = w;
            }
        }
        __syncthreads();
    }
}

__device__ __forceinline__ void hy_item_ctx(KP p, int l, int c, float* sm) {
    const int tid = opaque_tid(), o = l >> 1;
    const bf16_t* UT = (const bf16_t*)(p->ws + OFF_UT);
    bf16_t* ZOT = (bf16_t*)(p->ws + OFF_ZOT);
    const float* FKC = (const float*)(p->ws + OFF_FKS(o)) + (size_t)2 * 512 * 8192;
    float* Kc = sm;
    float* zb = sm + 1024;
    for (int i = tid; i < 1024; i += 512) Kc[i] = FKC[((size_t)(i >> 9) * 512 + c) * 512 + (i & 511)];
    for (int i = tid; i < 8 * CTXL; i += 512) zb[i] = bf2f(UT[(size_t)(1024 + c) * NT + NL + i]);
    __syncthreads();
    const int bb = tid >> 6, tl = tid & 63;
#pragma unroll 1
    for (int order = 0; order < 2; ++order) {
        float acc[4] = {0.f, 0.f, 0.f, 0.f};
#pragma unroll 4
        for (int s = 0; s < CTXL; ++s) {
            const float zv = zb[bb * CTXL + s];
#pragma unroll
            for (int i = 0; i < 4; ++i) acc[i] += Kc[order * 512 + tl + 64 * i - s + 256] * zv;
        }
        const float sk = p->in[I_HSKIP][o * 1024 + order * 512 + c];
        float zn[4];
#pragma unroll
        for (int i = 0; i < 4; ++i) { const int t = tl + 64 * i; zn[i] = bf2f(UT[(size_t)(order * 512 + c) * NT + NL + bb * CTXL + t]) * (acc[i] + zb[bb * CTXL + t] * sk); }
        __syncthreads();
#pragma unroll
        for (int i = 0; i < 4; ++i) { const int t = tl + 64 * i; if (order == 0) zb[bb * CTXL + t] = bf2f((bf16_t)(cvt_pk_bf16(zn[i], 0.f) & 0xffffu)); else stf(ZOT + (size_t)c * NT + NL + bb * CTXL + t, zn[i]); }
        __syncthreads();
    }
}

__device__ __forceinline__ void ph_mix_odd(KP p, int l, int bid, int nb, float* sm) {
    int* head = (int*)(p->ws + OFF_CNT) + 1024 + (l >> 1) * 64;
    LAS int* slot = (LAS int*)(smraw_base() + BAR_LDS_ + 64);
#pragma unroll 1
    for (;;) {
        if (opaque_tid() == 0) *slot = atomicAdd(head, 1);
        __syncthreads();
        const int item = *slot;
        __syncthreads();
        if (item >= 128 + 512) break;
        if (item < 128) { const int b = (item >> 4) & 7, h = (item >> 2) & 3, dir = (item >> 1) & 1, vs = item & 1; sc::scan_item<2>(p, l, b, h, dir, vs); }
        else { const int c = item - 128; hy_item_lat(p, l, c); __syncthreads(); hy_item_ctx(p, l, c, sm); }
        __syncthreads();
    }
}

__device__ __forceinline__ void ph_hy_norm(KP p, int l, int bid, int nb, float* sm) {
    const int tid = opaque_tid(), o = l >> 1;
    const bf16_t* ZOT = (const bf16_t*)(p->ws + OFF_ZOT);
    bf16_t* MIX = (bf16_t*)(p->ws + OFF_U);
    const float* nw = p->in[I_HNORM] + o * 512;
    float* tile = sm;
    float* part = sm + 64 * 65;
#pragma unroll 1
    for (int item = bid; item < (NT / 64) * 8; item += nb) {
        const int tt = item >> 3, g = item & 7, tok0 = tt * 64;
        __syncthreads();
        { const int cc = tid >> 3, ch = tid & 7;
          const uint4 v = *(const uint4*)(ZOT + (size_t)(g * 64 + cc) * NT + tok0 + ch * 8);
          float* d = tile + cc * 65 + ch * 8;
          d[0] = bflo(v.x); d[1] = bfhi(v.x); d[2] = bflo(v.y); d[3] = bfhi(v.y); d[4] = bflo(v.z); d[5] = bfhi(v.z); d[6] = bflo(v.w); d[7] = bfhi(v.w); }
        __syncthreads();
        { const int tk = tid & 63, pt = tid >> 6; float s = 0.f;
#pragma unroll
          for (int i = 0; i < 8; ++i) { const float x = tile[(pt * 8 + i) * 65 + tk]; s += x * x; }
          part[pt * 64 + tk] = s; }
        __syncthreads();
        { const int tk = tid >> 3, ch = tid & 7; float s = 0.f;
#pragma unroll
          for (int i = 0; i < 8; ++i) s += part[i * 64 + tk];
          const float rs = rsqrtf(s * (1.f / 64.f) + LN_EPS);
          float y[8];
#pragma unroll
          for (int i = 0; i < 8; ++i) y[i] = tile[(ch * 8 + i) * 65 + tk] * rs * nw[g * 64 + ch * 8 + i];
          *(uint4*)(MIX + (size_t)(tok0 + tk) * DM + g * 64 + ch * 8) = make_uint4(cvt_pk_bf16(y[0], y[1]), cvt_pk_bf16(y[2], y[3]), cvt_pk_bf16(y[4], y[5]), cvt_pk_bf16(y[6], y[7])); }
    }
}

__device__ __forceinline__ void ph_normgate_odd(KP p, int l, int bid, int nb) {
    const int tid = opaque_tid(), lane = tid & 63, wv = tid >> 6, o2 = l >> 1;
    const bf16_t* P = (const bf16_t*)(p->ws + OFF_BIG);
    const bf16_t* HX = (const bf16_t*)(p->ws + OFF_AUX);
    const bf16_t* HX1 = HX + (size_t)NT * 1024;
    bf16_t* MIX = (bf16_t*)(p->ws + OFF_U);
    const int c16 = 16 * (lane & 31);
    const float* nw = p->in[I_RNW] + o2 * 512 + c16;
#pragma unroll 1
    for (int t2 = bid * 8 + wv; t2 < NT / 2; t2 += nb * 8) {
        const int tok = t2 * 2 + (lane >> 5);
        const size_t o = (size_t)tok * 1024 + 512 + c16;
        head_norm_gate16<true, false>(HX + o, HX1 + o, P + (size_t)tok * ODD_LD + 3072 + c16, nw, MIX + o);
    }
}

__device__ __forceinline__ void ph_ln1_router(KP p, int l, int ntok, int bid, int nb, float* sm) {
    constexpr int VP = (1024 + 8) * 2;
    constexpr unsigned O_VH = 0, O_VL = 32 * VP, O_LG = 64 * VP;
    static_assert(O_LG + 32 * 64 * 4 <= BAR_LDS_, "router LDS");
    const int tid = opaque_tid(), lane = tid & 63, wv = __builtin_amdgcn_readfirstlane(tid >> 6), r16 = lane & 15, q4 = lane >> 4;
    const unsigned L0 = (unsigned)(size_t)smraw_base();
    const bf16_t* Y = (const bf16_t*)(p->ws + OFF_BIG);
    bf16_t* U = (bf16_t*)(p->ws + OFF_U);
    const float* lw = p->in[I_LNW] + (l * 2) * 1024; const float* lb = p->in[I_LNB] + (l * 2) * 1024;
    const bf16_t* RWH = (const bf16_t*)(p->ws + OFF_RWH); const bf16_t* RWL = RWH + 64 * 1024;
    const float rb = p->in[I_RB][l * 64 + lane];
    LAS int* lcnt = (LAS int*)(smraw_base() + BAR_LDS_ + 256);
    if (tid < 64) lcnt[tid] = 0;
    __syncthreads();
    int* tidx = (int*)(p->ws + OFF_TIDX); float* tgate = (float*)(p->ws + OFF_TGATE); int* tpos = (int*)(p->ws + OFF_TPOS);
    {
        int* stok = (int*)(p->ws + OFF_STOK); float* sgate = (float*)(p->ws + OFF_SGATE); int* sdst = (int*)(p->ws + OFF_SDST);
#pragma unroll 1
        for (int i = bid * 512 + tid; i < MAXROWS; i += nb * 512) { stok[i] = ZROW; sgate[i] = 0.f; sdst[i] = -1; }
    }
    const int nfr = (ntok >> 5) / nb, nsteps = nfr + (((ntok >> 5) % nb) ? 1 : 0);
#pragma unroll 1
    for (int step = 0; step < nsteps; ++step) {
        const bool full = step < nfr;
        const int tpw = full ? 4 : 1, base = full ? (step * nb + bid) * 32 : nfr * nb * 32 + bid * 8;
#pragma unroll 2
        for (int j = 0; j < 4; ++j) {
            if (j >= tpw) break;
            const int tl = wv * tpw + j, tok = base + tl;
            float* h = hrow(p, tok);
            const float* m = modrow(p, l, tok);
            const bf16_t* r = Y + (size_t)tok * DM;
            float x[16]; float s = 0.f;
#pragma unroll
            for (int c = 0; c < 4; ++c) {
                const int d = 4 * (lane + 64 * c);
                const float4 hv = *(const float4*)(h + d), gv = *(const float4*)(m + 2 * 1024 + d); const uint2 rw2 = *(const uint2*)(r + d);
                const float4 rv = make_float4(bflo(rw2.x), bfhi(rw2.x), bflo(rw2.y), bfhi(rw2.y));
                x[4 * c] = ALPHA * hv.x + gv.x * rv.x; x[4 * c + 1] = ALPHA * hv.y + gv.y * rv.y; x[4 * c + 2] = ALPHA * hv.z + gv.z * rv.z; x[4 * c + 3] = ALPHA * hv.w + gv.w * rv.w;
                s += x[4 * c] + x[4 * c + 1] + x[4 * c + 2] + x[4 * c + 3];
            }
            const float mean = wave_sum(s) * (1.f / 1024.f);
            float q = 0.f;
#pragma unroll
            for (int i = 0; i < 16; ++i) { x[i] -= mean; q += x[i] * x[i]; }
            const float rs = rsqrtf(wave_sum(q) * (1.f / 1024.f) + LN_EPS);
#pragma unroll
            for (int c = 0; c < 4; ++c) {
                const int d = 4 * (lane + 64 * c);
                const float4 w4 = *(const float4*)(lw + d), b4 = *(const float4*)(lb + d), sh = *(const float4*)(m + 3 * 1024 + d), sc = *(const float4*)(m + 4 * 1024 + d);
                float4 y; y.x = x[4 * c] * rs * w4.x + b4.x; y.y = x[4 * c + 1] * rs * w4.y + b4.y; y.z = x[4 * c + 2] * rs * w4.z + b4.z; y.w = x[4 * c + 3] * rs * w4.w + b4.w;
                *(float4*)(h + d) = y;
                float4 v; v.x = y.x * (1.f + sc.x) + sh.x; v.y = y.y * (1.f + sc.y) + sh.y; v.z = y.z * (1.f + sc.z) + sh.z; v.w = y.w * (1.f + sc.w) + sh.w;
                const unsigned h0 = cvt_pk_bf16(v.x, v.y), h1 = cvt_pk_bf16(v.z, v.w);
                *(uint2*)(U + (size_t)tok * DM + d) = make_uint2(h0, h1);
                sc::st8(L0 + O_VH + tl * VP + d * 2, make_uint2(h0, h1));
                sc::st8(L0 + O_VL + tl * VP + d * 2, make_uint2(cvt_pk_bf16(v.x - bflo(h0), v.y - bfhi(h0)), cvt_pk_bf16(v.z - bflo(h1), v.w - bfhi(h1))));
            }
        }
        __syncthreads();
        {
            const int tt = wv & 1, et = wv >> 1;
            sc::f32x4 acc = (sc::f32x4){0.f, 0.f, 0.f, 0.f};
            const bf16_t* bh = RWH + (size_t)(et * 16 + r16) * 1024 + q4 * 8; const bf16_t* bl = RWL + (size_t)(et * 16 + r16) * 1024 + q4 * 8;
#pragma unroll 4
            for (int ks = 0; ks < 32; ++ks) {
                const sc::bf16x8 ah = sc::rd_row(L0 + O_VH, tt * 16 + r16, VP, ks * 32 + q4 * 8), al = sc::rd_row(L0 + O_VL, tt * 16 + r16, VP, ks * 32 + q4 * 8);
                const sc::bf16x8 wh = *(const sc::bf16x8*)(bh + ks * 32), wl = *(const sc::bf16x8*)(bl + ks * 32);
                acc = SC_MFMA(ah, wh, acc); acc = SC_MFMA(ah, wl, acc); acc = SC_MFMA(al, wh, acc);
            }
#pragma unroll
            for (int jj = 0; jj < 4; ++jj) *(LAS float*)(size_t)(L0 + O_LG + ((tt * 16 + q4 * 4 + jj) * 64 + et * 16 + r16) * 4) = acc[jj];
        }
        __syncthreads();
#pragma unroll 1
        for (int j = 0; j < tpw; ++j) {
            const int tl = wv * tpw + j, tok = base + tl;
            const float lg = *(const LAS float*)(size_t)(L0 + O_LG + (tl * 64 + lane) * 4);
            const float score = sigmoidf_(lg);
            const float key = score + rb;
            int rank = 0;
#pragma unroll
            for (int e = 0; e < 64; ++e) { const float ke = __builtin_bit_cast(float, __builtin_amdgcn_readlane(__builtin_bit_cast(int, key), e)); rank += (ke > key || (ke == key && e < lane)) ? 1 : 0; }
            const bool sel = rank < TOPK;
            const float gsum = wave_sum(sel ? score : 0.f);
            if (sel) {
                const int pos = __hip_atomic_fetch_add(lcnt + lane, 1, __ATOMIC_RELAXED, __HIP_MEMORY_SCOPE_WORKGROUP);
                tidx[tok * 8 + rank] = lane; tgate[tok * 8 + rank] = 2.5f * score / gsum; tpos[tok * 8 + rank] = pos;
            }
        }
        __syncthreads();
    }
    __syncthreads();
    if (tid < 64) ((int*)(p->ws + OFF_BCNT))[bid * 64 + tid] = lcnt[tid];
}

__device__ __forceinline__ void moe_offsets(KP p, int l, int ntok, LAS int* offs) {
    const int t = opaque_tid();
    if (t < 66) offs[t] = ((const int*)(p->ws + OFF_GOFFS))[t];
    __syncthreads();
}
__device__ __forceinline__ int moe_expert_of(const LAS int* offs, int row) { int e = 0;
#pragma unroll 1
    while (e < 64 && row >= offs[e + 1]) ++e;
    return e; }

__device__ __forceinline__ void ph_scatter(KP p, int l, int ntok, int bid, int nb, LAS unsigned char* lds) {
    LAS int* offs = (LAS int*)lds;
    LAS int* myb = offs + 128;
    LAS int* part = offs + 256;
    const int tid = opaque_tid();
    const int* bcnt = (const int*)(p->ws + OFF_BCNT);
    { const int e = tid & 63, pt = tid >> 6; int tot = 0, mine = 0;
#pragma unroll 4
      for (int b = pt; b < nb; b += 8) { const int c = bcnt[b * 64 + e]; tot += c; mine += (b < bid) ? c : 0; }
      part[pt * 64 + e] = tot; part[512 + pt * 64 + e] = mine; }
    __syncthreads();
    if (tid < 64) {
        int tot = 0, mine = 0;
#pragma unroll
        for (int i = 0; i < 8; ++i) { tot += part[i * 64 + tid]; mine += part[512 + i * 64 + tid]; }
        const int pc = (tot + 255) & ~255;
        int incl = pc;
#pragma unroll
        for (int o = 1; o < 64; o <<= 1) { const int t = SHU(incl, o); if (tid >= o) incl += t; }
        offs[tid] = incl - pc; myb[tid] = mine;
        if (tid == 63) { offs[64] = incl; offs[65] = incl + ntok; }
    }
    __syncthreads();
    if (bid == 0 && tid < 66) ((int*)(p->ws + OFF_GOFFS))[tid] = offs[tid];
    const int* tidx = (const int*)(p->ws + OFF_TIDX); const float* tgate = (const float*)(p->ws + OFF_TGATE); const int* tpos = (const int*)(p->ws + OFF_TPOS);
    int* stok = (int*)(p->ws + OFF_STOK); float* sgate = (float*)(p->ws + OFF_SGATE); int* sdst = (int*)(p->ws + OFF_SDST);
    int* tile_e = (int*)(p->ws + OFF_TILEE);
    const int nfr = (ntok >> 5) / nb, nsteps = nfr + (((ntok >> 5) % nb) ? 1 : 0);
#pragma unroll 1
    for (int step = 0; step < nsteps; ++step) {
        const bool full = step < nfr;
        const int ntk = full ? 32 : 8, base = full ? (step * nb + bid) * 32 : nfr * nb * 32 + bid * 8;
        if (tid < ntk * 9) {
            const int tok = base + tid / 9, sl = tid % 9;
            if (sl < 8) { const int i = tok * 8 + sl, e = tidx[i], row = offs[e] + myb[e] + tpos[i]; stok[row] = tok; sgate[row] = tgate[i]; sdst[row] = tok * 9 + sl; }
            else { const int row = offs[64] + tok; stok[row] = tok; sgate[row] = 1.f; sdst[row] = tok * 9 + 8; }
        }
    }
    const int nrt = offs[65] >> 8;
#pragma unroll 1
    for (int rt = bid * 512 + tid; rt < nrt; rt += nb * 512) tile_e[rt] = moe_expert_of(offs, rt * 256);
    __syncthreads();
}

#define MOE_TAB (gp::STAGE_BYTES + 256)
#define MOE_MAXT 9
static_assert(131072 + 256 + 256 + MOE_MAXT * 2048 <= BAR_LDS_, "MoE tables");
struct MoeDeal {
    int nfull, rem, c, G;
    __device__ __forceinline__ void init(int nrt, int c_, int G_) { nfull = nrt / G_; rem = nrt % G_; c = ((c_ & 7) << 5) | (c_ >> 3); G = G_; }
    __device__ __forceinline__ int nleft(int NPN) const { const int tot = rem * NPN; return c < tot ? (tot - c + G - 1) / G : 0; }
    __device__ __forceinline__ int ntiles(int NPN) const { return nfull + nleft(NPN); }
    __device__ __forceinline__ int tile_of(int j, int NPN) const { return j < nfull ? c + j * G : nfull * G + (c + (j - nfull) * G) / NPN; }
    __device__ __forceinline__ bool unit(int i, int NPN, int& j, int& pn) const {
        if (i < nfull * NPN) { j = i / NPN; pn = i % NPN; return true; }
        const int k = i - nfull * NPN, lu = c + k * G;
        if (lu < rem * NPN) { j = nfull + k; pn = lu % NPN; return true; }
        return false;
    }
};
struct Moe1Sched {
    const char* U; const char* W; const LAS int* tabE; const LAS int* tabS; MoeDeal d;
    __device__ __forceinline__ bool next(int i, gp::Unit& u) const {
        int j, pn; if (!d.unit(i, 2, j, pn)) return false;
        u.A = U; u.B = W + (size_t)tabE[j] * (512 * 1024 * 2) + (size_t)pn * (256 * 1024 * 2); u.r0 = d.tile_of(j, 2) * 256; u.c0 = pn * 256; u.aux = j; return true;
    }
    __device__ __forceinline__ void lane_off(const gp::Unit& u, unsigned (&vo)[2][2]) const {
        const int tid = opaque_tid(); int R0, C0, R1, C1; gp::stage_rc(tid * 16, R0, C0); gp::stage_rc(tid * 16 + 8192, R1, C1);
        const LAS int* t = tabS + u.aux * 256;
        vo[0][0] = (unsigned)t[R0] * 2048u + (unsigned)C0 * 2u; vo[0][1] = (unsigned)t[R1] * 2048u + (unsigned)C1 * 2u;
        vo[1][0] = (unsigned)t[128 + R0] * 2048u + (unsigned)C0 * 2u; vo[1][1] = (unsigned)t[128 + R1] * 2048u + (unsigned)C1 * 2u;
    }
};
struct EpiH {
    bf16_t* H;
    __device__ __forceinline__ void operator()(const gp::f32x4 (&acc)[2][2][4][2], const gp::Unit& u, int wr, int wc, int fr, int fq) const {
        const int row0 = u.r0 + wr * 64 + fr;
#pragma unroll
        for (int ai = 0; ai < 2; ++ai)
#pragma unroll
            for (int m = 0; m < 4; ++m) { bf16_t* rowp = H + (size_t)(row0 + ai * 128 + m * 16) * 256;
#pragma unroll
                for (int bj = 0; bj < 2; ++bj) {
                    const int j0 = ((u.c0 + bj * 128 + wc * 32) >> 5) * 16 + 4 * fq;
                    const gp::f32x4 a = acc[ai][bj][m][0], b = acc[ai][bj][m][1];
                    const float h0 = siluf_(a[0]) * b[0], h1 = siluf_(a[1]) * b[1], h2 = siluf_(a[2]) * b[2], h3 = siluf_(a[3]) * b[3];
                    *(uint2*)(rowp + j0) = make_uint2(cvt_pk_bf16(h0, h1), cvt_pk_bf16(h2, h3)); }
                __builtin_amdgcn_sched_barrier(0); }
    }
};
__device__ __forceinline__ void ph_moe1(KP p, int l, int ntok, int bid, int nb, LAS unsigned char* lds) {
    LAS int* tabE = (LAS int*)(lds + MOE_TAB);
    LAS int* tabS = tabE + 64;
    const int tid = opaque_tid();
    MoeDeal d; d.init(((const int*)(p->ws + OFF_GOFFS))[65] >> 8, bid, nb);
    const int nper = d.ntiles(2);
    const int* stok = (const int*)(p->ws + OFF_STOK); const int* tile_e = (const int*)(p->ws + OFF_TILEE);
    for (int i = tid; i < nper * 256; i += 512) tabS[i] = stok[(size_t)d.tile_of(i >> 8, 2) * 256 + (i & 255)];
    if (tid < nper) tabE[tid] = tile_e[d.tile_of(tid, 2)];
    __syncthreads();
    Moe1Sched S{(const char*)(p->ws + OFF_U), (const char*)(p->ws + OFF_W13), tabE, tabS, d};
    EpiH E{(bf16_t*)(p->ws + OFF_BIG)};
    gp::gemm_phase<true, false>(lds, 1024, S, E);
}

struct Moe2Sched {
    const char* H; const char* W; const LAS int* tabE; MoeDeal d;
    __device__ __forceinline__ bool next(int i, gp::Unit& u) const {
        int j, pn; if (!d.unit(i, 4, j, pn)) return false;
        u.A = H + (size_t)d.tile_of(j, 4) * (256 * 256 * 2); u.B = W + (size_t)tabE[j] * (1024 * 256 * 2) + (size_t)pn * (256 * 256 * 2); u.r0 = j * 256; u.c0 = pn * 256; u.aux = j; return true;
    }
    __device__ __forceinline__ void lane_off(const gp::Unit&, unsigned (&)[2][2]) const {}
};
__device__ __forceinline__ unsigned pk_fp8x4(float a, float b, float c, float d) { int w = __builtin_amdgcn_cvt_pk_fp8_f32(a, b, 0, false); w = __builtin_amdgcn_cvt_pk_fp8_f32(c, d, w, true); return (unsigned)w; }
struct EpiY {
    unsigned char* Ys; const LAS int* tabD; const LAS float* tabG;
    __device__ __forceinline__ void operator()(const gp::f32x4 (&acc)[2][2][4][2], const gp::Unit& u, int wr, int wc, int fr, int fq) const {
        const int rl0 = u.r0 + wr * 64 + fr, col0 = u.c0 + wc * 32 + 8 * fq;
#pragma unroll
        for (int ai = 0; ai < 2; ++ai)
#pragma unroll
            for (int m = 0; m < 4; ++m) {
                const int rl = rl0 + ai * 128 + m * 16;
                const int dst = tabD[rl]; const float g = tabG[rl];
                if (dst >= 0) { unsigned char* rowp = Ys + (size_t)dst * 1024 + col0;
#pragma unroll
                    for (int bj = 0; bj < 2; ++bj) { const gp::f32x4 v0 = acc[ai][bj][m][0] * g, v1 = acc[ai][bj][m][1] * g;
                        *(uint2*)(rowp + bj * 128) = make_uint2(pk_fp8x4(v0[0], v0[1], v0[2], v0[3]), pk_fp8x4(v1[0], v1[1], v1[2], v1[3])); } }
                __builtin_amdgcn_sched_barrier(0); }
    }
};
__device__ __forceinline__ void ph_moe2(KP p, int l, int ntok, int bid, int nb, LAS unsigned char* lds) {
    LAS int* tabE = (LAS int*)(lds + MOE_TAB);
    LAS int* tabD = tabE + 64;
    LAS float* tabG = (LAS float*)(tabD + MOE_MAXT * 256);
    const int tid = opaque_tid();
    MoeDeal d; d.init(((const int*)(p->ws + OFF_GOFFS))[65] >> 8, bid, nb);
    const int nper = d.ntiles(4);
    const int* sdst = (const int*)(p->ws + OFF_SDST); const float* sgate = (const float*)(p->ws + OFF_SGATE); const int* tile_e = (const int*)(p->ws + OFF_TILEE);
    for (int i = tid; i < nper * 256; i += 512) { const size_t r = (size_t)d.tile_of(i >> 8, 4) * 256 + (i & 255); tabD[i] = sdst[r]; tabG[i] = sgate[r]; }
    if (tid < nper) tabE[tid] = tile_e[d.tile_of(tid, 4)];
    __syncthreads();
    Moe2Sched S{(const char*)(p->ws + OFF_BIG), (const char*)(p->ws + OFF_W2), tabE, d};
    EpiY E{(unsigned char*)(p->ws + OFF_YS), tabD, tabG};
    gp::gemm_phase<false, true>(lds, 256, S, E);
}

template <bool NEXT>
__device__ __forceinline__ void ph_combine_ln2(KP p, int l, int ntok, int bid, int nb) {
    bf16_t* U = (bf16_t*)(p->ws + OFF_U);
    float* G = (float*)(p->ws + OFF_G);
    const bool gates = NEXT && ((l + 1) & 1) == 0;
    LAS float* wl = (LAS float*)smraw_base();
    if (gates) stage_gate_w(p, (l + 1) >> 1, wl);
    const int tid = opaque_tid(), lane = tid & 63, wv = tid >> 6;
    const unsigned char* Ys = (const unsigned char*)(p->ws + OFF_YS);
    const float* lw = p->in[I_LNW] + (l * 2 + 1) * 1024 + 16 * lane; const float* lb = p->in[I_LNB] + (l * 2 + 1) * 1024 + 16 * lane;
#pragma unroll 1
    for (int tok = bid * 8 + wv; tok < ntok; tok += nb * 8) {
        float* h = hrow(p, tok) + 16 * lane;
        const float* m = modrow(p, l, tok) + 16 * lane;
        const float* m2 = modrow(p, NEXT ? l + 1 : l, tok) + 16 * lane;
        float f[16];
#pragma unroll
        for (int i = 0; i < 16; ++i) f[i] = 0.f;
#pragma unroll
        for (int s9 = 0; s9 < 9; ++s9) {
            const uint4 w = *(const uint4*)(Ys + ((size_t)tok * 9 + s9) * 1024 + 16 * lane);
            const unsigned ww[4] = {w.x, w.y, w.z, w.w};
#pragma unroll
            for (int q = 0; q < 4; ++q) { const f32x2_n lo = __builtin_amdgcn_cvt_pk_f32_fp8((int)ww[q], false), hi = __builtin_amdgcn_cvt_pk_f32_fp8((int)ww[q], true);
                f[4 * q] += lo[0]; f[4 * q + 1] += lo[1]; f[4 * q + 2] += hi[0]; f[4 * q + 3] += hi[1]; }
        }
        float x[16]; float sum = 0.f;
#pragma unroll
        for (int q = 0; q < 4; ++q) {
            const float4 hv = *(const float4*)(h + 4 * q), gv = *(const float4*)(m + 5 * 1024 + 4 * q);
            x[4 * q] = ALPHA * hv.x + gv.x * f[4 * q]; x[4 * q + 1] = ALPHA * hv.y + gv.y * f[4 * q + 1]; x[4 * q + 2] = ALPHA * hv.z + gv.z * f[4 * q + 2]; x[4 * q + 3] = ALPHA * hv.w + gv.w * f[4 * q + 3];
            sum += x[4 * q] + x[4 * q + 1] + x[4 * q + 2] + x[4 * q + 3];
        }
        const float mean = wave_sum(sum) * (1.f / 1024.f);
        float q2 = 0.f;
#pragma unroll
        for (int i = 0; i < 16; ++i) { x[i] -= mean; q2 += x[i] * x[i]; }
        const float rs = rsqrtf(wave_sum(q2) * (1.f / 1024.f) + LN_EPS);
        float u16[16];
#pragma unroll
        for (int q = 0; q < 4; ++q) {
            const float4 w4 = *(const float4*)(lw + 4 * q), b4 = *(const float4*)(lb + 4 * q);
            float4 y; y.x = x[4 * q] * rs * w4.x + b4.x; y.y = x[4 * q + 1] * rs * w4.y + b4.y; y.z = x[4 * q + 2] * rs * w4.z + b4.z; y.w = x[4 * q + 3] * rs * w4.w + b4.w;
            *(float4*)(h + 4 * q) = y;
            if (NEXT) {
                const float4 sh = *(const float4*)(m2 + 4 * q), sc = *(const float4*)(m2 + 1024 + 4 * q);
                u16[4 * q] = y.x * (1.f + sc.x) + sh.x; u16[4 * q + 1] = y.y * (1.f + sc.y) + sh.y; u16[4 * q + 2] = y.z * (1.f + sc.z) + sh.z; u16[4 * q + 3] = y.w * (1.f + sc.w) + sh.w;
            }
        }
        if (NEXT) {
            uint4* up = (uint4*)(U + (size_t)tok * DM + 16 * lane);
            up[0] = make_uint4(cvt_pk_bf16(u16[0], u16[1]), cvt_pk_bf16(u16[2], u16[3]), cvt_pk_bf16(u16[4], u16[5]), cvt_pk_bf16(u16[6], u16[7]));
            up[1] = make_uint4(cvt_pk_bf16(u16[8], u16[9]), cvt_pk_bf16(u16[10], u16[11]), cvt_pk_bf16(u16[12], u16[13]), cvt_pk_bf16(u16[14], u16[15]));
        }
        if (gates) {
            float ga[16];
#pragma unroll
            for (int j = 0; j < 16; ++j) ga[j] = 0.f;
#pragma unroll
            for (int g4 = 0; g4 < 4; ++g4) {
#pragma unroll
                for (int qq = 0; qq < 4; ++qq) {
                    const float uv = u16[4 * g4 + qq];
#pragma unroll
                    for (int j4 = 0; j4 < 4; ++j4) { const f32x4_l w = *(const LAS f32x4_l*)(wl + (16 * lane + 4 * g4 + qq) * 16 + j4 * 4); ga[4 * j4] += uv * w[0]; ga[4 * j4 + 1] += uv * w[1]; ga[4 * j4 + 2] += uv * w[2]; ga[4 * j4 + 3] += uv * w[3]; }
                }
                __builtin_amdgcn_sched_barrier(0);
            }
            float mine = 0.f;
#pragma unroll
            for (int j = 0; j < 16; ++j) { const float sg = wave_sum(ga[j]); if (lane == j) mine = sg; }
            if (lane < 16) G[(size_t)tok * 16 + lane] = mine;
        }
    }
}

#define MEGA_LDS (131072 + 256 + 20480)
#define NBLK 256
#define BAR_LDS BAR_LDS_
#define SYNC() do { XcdBarrier _b; _b.bar = (unsigned*)kparams()->ws; _b.x = xb_xcc_id(); _b.st = (volatile LAS unsigned*)((LAS unsigned char*)smraw_base() + BAR_LDS); xcd_barrier(_b); } while (0)
template <int PAR>
__device__ __forceinline__ void layer_fwd(const int l) {
    LAS unsigned char* lds = smraw_base(); float* sm = (float*)smraw_generic();
    const int bid = blockIdx.x; constexpr int nb = NBLK;
    const int ntok = (l == 3) ? NL : NT;
    ph_gemm_in(kparams(), l, bid, nb, lds); SYNC();
    if (PAR == 0) {
        ph_scan_even2(kparams(), l, bid, nb); SYNC();
        ph_normgate_even(kparams(), l, bid, nb); SYNC();
    } else {
        ph_hy_prep(kparams(), l, bid, nb, sm); SYNC();
        ph_mix_odd(kparams(), l, bid, nb, sm); SYNC();
        ph_hy_norm(kparams(), l, bid, nb, sm); ph_normgate_odd(kparams(), l, bid, nb); SYNC();
    }
    ph_gemm_out(kparams(), l, bid, nb, lds); SYNC();
    ph_ln1_router(kparams(), l, ntok, bid, nb, sm); SYNC();
    ph_scatter(kparams(), l, ntok, bid, nb, lds); SYNC();
    ph_moe1(kparams(), l, ntok, bid, nb, lds); SYNC();
    ph_moe2(kparams(), l, ntok, bid, nb, lds); SYNC();
    if (l < 3) { ph_combine_ln2<true>(kparams(), l, ntok, bid, nb); ph_convert(kparams(), l + 1, bid, nb, sm); SYNC(); }
    else ph_combine_ln2<false>(kparams(), l, ntok, bid, nb);
}
__global__ void __launch_bounds__(512, 2) mega_fwd(Params p) {
    LAS unsigned char* lds = smraw_base(); float* sm = (float*)smraw_generic();
    {
        const int t0 = threadIdx.x;
        if ((t0 & 63) == 0) { unsigned h; asm volatile("s_getreg_b32 %0, hwreg(HW_REG_HW_ID, 0, 6)" : "=s"(h)); *(LAS int*)(size_t)(WTAB_LDS + (h & 63u) * 4u) = t0 >> 6; }
        if (t0 < 4) ((LAS unsigned*)(lds + BAR_LDS))[t0] = 0u;
    }
    __syncthreads();
    (void)xcd_barrier_post((unsigned*)kparams()->ws, (volatile LAS unsigned*)(lds + BAR_LDS));
    const int bid = blockIdx.x; constexpr int nb = NBLK;
    ph_prologue(kparams(), bid, nb, sm);
    __syncthreads();
    ph_hy_filt2(kparams(), 1, bid, nb, sm, 48); __syncthreads(); ph_hy_filt2(kparams(), 3, bid, nb, sm, 48);
    SYNC();
    ph_convert(kparams(), 0, bid, nb, sm); ph_modin(kparams(), 0, bid, nb); SYNC();
#pragma unroll 1
    for (int lp = 0; lp < 2; ++lp) {
        layer_fwd<0>(2 * lp);
        layer_fwd<1>(2 * lp + 1);
    }
    __syncthreads();
    if (blockIdx.x == 0 && opaque_tid() == 0 && xb_ld((unsigned*)kparams()->ws + XB_TMO) != 0u) kparams()->out[0] = __builtin_nanf("");
}

extern "C" void kernel_launch(void* const* d_in, const int* in_sizes, int n_in, void* d_out, int out_size, void* d_ws, size_t ws_size, hipStream_t stream) {
    static int grid = 0;
    if (grid == 0) {
        if (n_in != 38 || out_size != NL * DM || ws_size < WS_END) { fprintf(stderr, "kernel_launch: bad shapes n_in %d out %d ws %zu (need %zu)\n", n_in, out_size, ws_size, (size_t)WS_END); grid = -1; return; }
        int dev = 0, cus = 0, per_cu = 0;
        if (hipGetDevice(&dev) != hipSuccess || hipDeviceGetAttribute(&cus, hipDeviceAttributeMultiprocessorCount, dev) != hipSuccess) { grid = -1; return; }
        if (hipFuncSetAttribute((const void*)mega_fwd, hipFuncAttributeMaxDynamicSharedMemorySize, MEGA_LDS) != hipSuccess) { fprintf(stderr, "kernel_launch: hipFuncSetAttribute failed\n"); grid = -1; return; }
        if (hipOccupancyMaxActiveBlocksPerMultiprocessor(&per_cu, (const void*)mega_fwd, 512, MEGA_LDS) != hipSuccess || per_cu < 1) { fprintf(stderr, "kernel_launch: occupancy query says %d\n", per_cu); (void)hipGetLastError(); grid = -1; return; }
        if (cus != 256) { fprintf(stderr, "kernel_launch: built for 256 CUs, found %d\n", cus); grid = -1; return; }
        grid = NBLK;
    }
    if (grid < 0) return;
    if (hipMemsetAsync(d_ws, 0, OFF_LB, stream) != hipSuccess) return;
    Params p{};
    for (int i = 0; i < 38; ++i) p.in[i] = (const float*)d_in[i];
    p.out = (float*)d_out; p.ws = (unsigned char*)d_ws;
    hipLaunchKernelGGL(mega_fwd, dim3(grid), dim3(512), MEGA_LDS, stream, p);
}
```

```cpp
#include <hip/hip_runtime.h>
#include <stdint.h>
#include <stdio.h>

#define DM 1024
#define NBATCH 8
#define SEQ 4096
#define CTXL 256
#define NL (NBATCH * SEQ)
#define NC (NBATCH * CTXL)
#define NT (NL + NC)
#define ZROW NT
#define TOPK 8
#define EVEN_N 4112
#define ODD_N 3584
#define EVEN_LD 4096
#define ODD_LD 3584
#define MAXROWS (NT * 8 + 64 * 256 + NT)
#define ALPHA 1.681792830507429f
#define LN_EPS 1e-5f
#define E_MQ 0
#define E_MK 256
#define E_MV 512
#define E_MO 1024
#define E_HQ 1536
#define E_HI 2048
#define E_HFF 2560
#define E_HFB 3072
#define E_HG 3584

typedef unsigned short bf16_t;
#define LAS __attribute__((address_space(3)))
#define BAR_LDS_ 150528

#define MiB ((size_t)1 << 20)
#define OFF_CNT   ((size_t)64 << 10)
#define OFF_LB    ((size_t)96 << 10)
#define OFF_MOD   ((size_t)128 << 10)
#define OFF_ROPE  ((size_t)1536 << 10)
#define OFF_BCNT  ((size_t)1600 << 10)
#define OFF_GOFFS ((size_t)1700 << 10)
#define OFF_RWH   ((size_t)2560 << 10)
#define OFF_TILEE (2 * MiB)
#define OFF_HCTX  (4 * MiB)
#define OFF_TIDX  (12 * MiB)
#define OFF_TGATE (14 * MiB)
#define OFF_TPOS  (16 * MiB)
#define OFF_STOK  (18 * MiB)
#define OFF_SGATE (20 * MiB)
#define OFF_SDST  (22 * MiB)
#define OFF_G     (24 * MiB)
#define OFF_U     (28 * MiB)
#define OFF_W     (98 * MiB)
#define OFF_WIN   (OFF_W)
#define OFF_WOUT  (OFF_W + 8 * MiB)
#define OFF_W13   (OFF_W + 10 * MiB)
#define OFF_W2    (OFF_W + 75 * MiB)
#define OFF_BIG   (208 * MiB)
#define OFF_AUX   (480 * MiB)
#define OFF_Z1    (OFF_AUX + 136 * MiB)
#define OFF_Z2    (OFF_Z1 + 68 * MiB)
#define OFF_FILT  (OFF_Z2 + 68 * MiB)
#define OFF_YS    (370 * MiB)
#define WS_END    (1052 * MiB)

struct Params {
    const float* in[38];
    float* out;
    unsigned char* ws;
};

enum { I_X = 0, I_C, I_CTX, I_CCTX, I_ADAW, I_ADAB, I_LNW, I_LNB, I_EWIN, I_MGB, I_MNW, I_HLB, I_HNW, I_EWOUT, I_OWIN, I_HCW, I_HCB,
       I_HW1, I_HB1, I_HW2, I_HB2, I_HW3, I_HB3, I_HFREQ, I_HWOUT, I_HSKIP, I_HNORM, I_RLD, I_RNW, I_OWOUT, I_RW, I_RB, I_W1, I_W3, I_W2, I_SW1, I_SW3, I_SW2 };

typedef const __attribute__((address_space(4))) Params* KP;
__device__ __forceinline__ KP kparams() { KP k = (KP)__builtin_amdgcn_kernarg_segment_ptr(); asm volatile("" : "+s"(k)); return k; }
extern __shared__ __attribute__((aligned(16))) unsigned char smraw_all[];
__device__ __forceinline__ LAS unsigned char* smraw_base() { return (LAS unsigned char*)smraw_all; }
__device__ __forceinline__ unsigned char* smraw_generic() { return smraw_all; }
#define WTAB_LDS (BAR_LDS_ + 512)
__device__ __forceinline__ int opaque_tid() {
    unsigned h; asm volatile("s_getreg_b32 %0, hwreg(HW_REG_HW_ID, 0, 6)" : "=s"(h));
    const int wid = *(volatile LAS int*)(size_t)(WTAB_LDS + (h & 63u) * 4u);
    unsigned m = ~0u; asm volatile("" : "+s"(m));
    const int lane = (int)__builtin_amdgcn_mbcnt_hi(m, __builtin_amdgcn_mbcnt_lo(m, 0u));
    return __builtin_amdgcn_readfirstlane(wid) * 64 + lane;
}
typedef __bf16 bf16x2_n __attribute__((ext_vector_type(2)));
typedef float f32x2_n __attribute__((ext_vector_type(2)));
__device__ __forceinline__ unsigned cvt_pk_bf16(float lo, float hi) { const f32x2_n v = {lo, hi}; return __builtin_bit_cast(unsigned, __builtin_convertvector(v, bf16x2_n)); }
__device__ __forceinline__ float bf2f(bf16_t b) { return __uint_as_float(((unsigned)b) << 16); }
__device__ __forceinline__ float bflo(unsigned w) { return __uint_as_float(w << 16); }
__device__ __forceinline__ float bfhi(unsigned w) { return __uint_as_float(w & 0xffff0000u); }
__device__ __forceinline__ float ldf(const float* p) { return *p; }
__device__ __forceinline__ float ldf(const bf16_t* p) { return bf2f(*p); }
__device__ __forceinline__ void stf(float* p, float v) { *p = v; }
__device__ __forceinline__ void stf(bf16_t* p, float v) { *p = (bf16_t)(cvt_pk_bf16(v, 0.f) & 0xffffu); }
__device__ __forceinline__ float sigmoidf_(float x) { return 1.f / (1.f + expf(-x)); }
__device__ __forceinline__ float siluf_(float x) { return x / (1.f + expf(-x)); }
__device__ __forceinline__ int olane() { unsigned m = ~0u; asm volatile("" : "+s"(m)); return (int)__builtin_amdgcn_mbcnt_hi(m, __builtin_amdgcn_mbcnt_lo(m, 0u)); }
template <class T> __device__ __forceinline__ T shfl_idx(T v, int idx) { return __builtin_bit_cast(T, __builtin_amdgcn_ds_bpermute(idx << 2, __builtin_bit_cast(int, v))); }
#define SHX(v, o) shfl_idx(v, olane() ^ (o))
#define SHI(v, i) shfl_idx(v, (i))
#define SHI32(v, i) shfl_idx(v, (olane() & 32) | ((i) & 31))
#define SHU(v, o) shfl_idx(v, olane() - (o))
__device__ __forceinline__ float fexp(float x) { return __builtin_amdgcn_exp2f(x * 1.4426950408889634f); }
__device__ __forceinline__ float flog(float x) { return __builtin_amdgcn_logf(x) * 0.6931471805599453f; }
__device__ __forceinline__ float frcp(float x) { return __builtin_amdgcn_rcpf(x); }
__device__ __forceinline__ float fsigmoid(float x) { return frcp(1.f + fexp(-x)); }
__device__ __forceinline__ float fsilu(float x) { return x * frcp(1.f + fexp(-x)); }
__device__ __forceinline__ float wave_sum(float v) {
#pragma unroll
    for (int o = 32; o > 0; o >>= 1) v += SHX(v, o);
    return v;
}
__device__ __forceinline__ float* hrow(KP p, int tok) {
    return tok < NL ? p->out + (size_t)tok * DM : (float*)(p->ws + OFF_HCTX) + (size_t)(tok - NL) * DM;
}
__device__ __forceinline__ const float* modrow(KP p, int l, int tok) {
    const int r = tok < NL ? (tok >> 12) : 8;
    return (const float*)(p->ws + OFF_MOD) + ((size_t)l * 9 + r) * 6144;
}
__device__ __forceinline__ int scan_tok(int b, int i, int dir) {
    return i < CTXL ? NL + b * CTXL + (dir ? CTXL - 1 - i : i) : b * SEQ + (dir ? SEQ - 1 - (i - CTXL) : (i - CTXL));
}

#define XB_TMO      128
#define XB_XCNT(j)  (256  + 64 * (j))
#define XB_XSUB(j)  (1280 + 64 * (j))
#define XB_XGEN(j)  (2304 + 64 * (j))
#define XB_TOP      3328
#define XB_TOPGEN   3392
#define XCD_BAR_WORDS 3456
#define XB_SPIN_CAP (1u << 24)
__device__ __forceinline__ unsigned xb_ld(unsigned* p)              { return __hip_atomic_load(p, __ATOMIC_RELAXED, __HIP_MEMORY_SCOPE_AGENT); }
__device__ __forceinline__ unsigned xb_add(unsigned* p, unsigned v) { return __hip_atomic_fetch_add(p, v, __ATOMIC_RELAXED, __HIP_MEMORY_SCOPE_AGENT); }
__device__ __forceinline__ unsigned xb_xcc_id() { return (unsigned)__builtin_amdgcn_s_getreg((3 << 11) | 20) & 0xFu; }
#define XB_SPIN(cond, bar) do { unsigned _sp = 0; while (cond) { __builtin_amdgcn_s_sleep(1); \
    if ((++_sp & 255u) == 0u) { if (xb_ld(&(bar)[XB_TMO])) break; if (_sp > XB_SPIN_CAP) { atomicAdd(&(bar)[XB_TMO], 1u); break; } } } } while (0)
struct XcdBarrier { unsigned* bar; unsigned x; volatile LAS unsigned* st; };
__device__ __forceinline__ XcdBarrier xcd_barrier_post(unsigned* bar, volatile LAS unsigned* st) {
    XcdBarrier b; b.bar = bar; b.x = xb_xcc_id(); b.st = st;
    if (opaque_tid() == 0) (void)xb_add(&bar[XB_XCNT(b.x)], 1u);
    return b;
}
__device__ __forceinline__ void xcd_barrier_complete(unsigned* bar, unsigned x, unsigned& nloc, unsigned& nx) {
    const unsigned G = gridDim.x * gridDim.y * gridDim.z;
    unsigned sum, cnt, mine, sp = 0u;
    for (;;) {
        sum = 0u; cnt = 0u; mine = 0u;
#pragma unroll
        for (unsigned j = 0; j < 16; ++j) { const unsigned c = xb_ld(&bar[XB_XCNT(j)]); sum += c; cnt += (c > 0u) ? 1u : 0u; mine = (j == x) ? c : mine; }
        if (sum == G) break;
        __builtin_amdgcn_s_sleep(1);
        if ((++sp & 255u) == 0u) { if (xb_ld(&bar[XB_TMO])) break; if (sp > XB_SPIN_CAP) { atomicAdd(&bar[XB_TMO], 1u); break; } }
    }
    nloc = mine > 0u ? mine : 1u; nx = cnt > 0u ? cnt : 1u;
}
__device__ __forceinline__ void xcd_barrier(const XcdBarrier& b) {
    asm volatile("s_waitcnt vmcnt(0)" ::: "memory");
    __syncthreads();
    if (opaque_tid() == 0) {
        unsigned* bar = b.bar;
        __builtin_amdgcn_s_waitcnt(0);
        unsigned nloc = b.st[0], nx = b.st[1];
        if (nloc == 0u) { xcd_barrier_complete(bar, b.x, nloc, nx); b.st[0] = nloc; b.st[1] = nx; }
        const unsigned old = xb_add(&bar[XB_XSUB(b.x)], 1u);
        const unsigned gen = old / nloc;
        if (old + 1u == (gen + 1u) * nloc) {
            __builtin_amdgcn_fence(__ATOMIC_RELEASE, "agent");
            asm volatile("s_waitcnt vmcnt(0)" ::: "memory");
            const unsigned og = xb_add(&bar[XB_TOP], 1u);
            const unsigned tg = og / nx;
            if (og + 1u == (tg + 1u) * nx) xb_add(&bar[XB_TOPGEN], 1u);
            else XB_SPIN(xb_ld(&bar[XB_TOPGEN]) == tg, bar);
            __builtin_amdgcn_fence(__ATOMIC_ACQUIRE, "agent");
            xb_add(&bar[XB_XGEN(b.x)], 1u);
            asm volatile("s_waitcnt vmcnt(0)" ::: "memory");
        } else {
            XB_SPIN(xb_ld(&bar[XB_XGEN(b.x)]) == gen, bar);
            __builtin_amdgcn_fence(__ATOMIC_ACQUIRE, "agent");
            asm volatile("s_waitcnt vmcnt(0)" ::: "memory");
        }
    }
    __syncthreads();
}

__device__ __forceinline__ void ph_prologue(KP p, int bid, int nb, float* sm) {
    const int tid = opaque_tid();
    {
        const float4* x4 = (const float4*)p->in[I_X]; float4* o4 = (float4*)p->out;
        #pragma unroll 1
        for (size_t i = (size_t)bid * 512 + tid; i < (size_t)NL * 256; i += (size_t)nb * 512) o4[i] = x4[i];
        const float4* c4 = (const float4*)p->in[I_CTX]; float4* h4 = (float4*)(p->ws + OFF_HCTX);
        #pragma unroll 1
        for (size_t i = (size_t)bid * 512 + tid; i < (size_t)NC * 256; i += (size_t)nb * 512) h4[i] = c4[i];
    }
    if (bid == 0) {
        bf16_t* z = (bf16_t*)(p->ws + OFF_U) + (size_t)ZROW * DM;
        for (int i = tid; i < DM; i += 512) z[i] = 0;
    }
    if (bid == 1 % nb) {
        float* lb = (float*)(p->ws + OFF_LB);
        const float* hl = p->in[I_HLB];
        for (int j = tid; j < 512; j += 512) {
            const float a = hl[j], b = hl[512 + j], mx = fmaxf(a, b);
            const float ea = expf(a - mx), eb = expf(b - mx);
            lb[j] = 0.f; lb[512 + j] = eb / (ea + eb);
        }
    }
    if (bid == 2 % nb) {
        float2* rt = (float2*)(p->ws + OFF_ROPE);
        for (int i = tid; i < 64 * 32; i += 512) { const float ang = (float)(i >> 5) * powf(10000.f, -(float)(2 * (i & 31)) / 64.f); rt[i] = make_float2(cosf(ang), sinf(ang)); }
    }
    {
        float* act = sm;
        bool filled = false;
        #pragma unroll 1
        for (int item = bid; item < 48; item += nb) {
            if (!filled) {
                for (int i = tid; i < 9 * 1024; i += 512) {
                    const int r = i >> 10, k = i & 1023;
                    const float v = r < 8 ? p->in[I_C][r * 1024 + k] : p->in[I_CCTX][k];
                    act[i] = siluf_(v);
                }
                __syncthreads(); filled = true;
            }
            const int l = item / 12, j = (item % 12) * 512 + tid;
            const float* w = p->in[I_ADAW] + (size_t)l * 1024 * 6144 + j;
            float acc[9];
#pragma unroll
            for (int r = 0; r < 9; ++r) acc[r] = 0.f;
            for (int k = 0; k < 1024; ++k) {
                const float wv = w[(size_t)k * 6144];
#pragma unroll
                for (int r = 0; r < 9; ++r) acc[r] += act[r * 1024 + k] * wv;
            }
            const float bv = p->in[I_ADAB][l * 6144 + j];
            float* mod = (float*)(p->ws + OFF_MOD);
#pragma unroll
            for (int r = 0; r < 9; ++r) mod[((size_t)l * 9 + r) * 6144 + j] = acc[r] + bv;
        }
    }
}


struct CvtTile { const float* src; int srcld; bf16_t* dst; int dstld; int k0, n0; };
__device__ __forceinline__ CvtTile cvt_tile_of(KP p, int l, int t, int np4  ) {
    const bool even = (l & 1) == 0;
    const int NP = even ? EVEN_LD : ODD_LD;
    const int t_in = 16 * (NP / 128), t_out = 16 * 8, t_13 = 65 * 16 * 4;
    CvtTile c;
    if (t < t_in) {
        const int kt = t & 15, nt = t >> 4, n = nt * 128 + np4;
        const float* W = even ? p->in[I_EWIN] + (size_t)(l >> 1) * 1024 * EVEN_N : p->in[I_OWIN] + (size_t)(l >> 1) * 1024 * ODD_N;
        c.src = W + ((even && n >= 1536) ? n + 16 : n); c.srcld = even ? EVEN_N : ODD_N; c.dst = (bf16_t*)(p->ws + OFF_WIN); c.dstld = 1024; c.k0 = kt * 64; c.n0 = nt * 128;
    } else if (t < t_in + t_out) {
        const int u = t - t_in, kt = u & 15, nt = u >> 4;
        c.src = (even ? p->in[I_EWOUT] : p->in[I_OWOUT]) + (size_t)(l >> 1) * 1024 * 1024 + nt * 128 + np4; c.srcld = 1024; c.dst = (bf16_t*)(p->ws + OFF_WOUT); c.dstld = 1024; c.k0 = kt * 64; c.n0 = nt * 128;
    } else if (t < t_in + t_out + t_13) {
        const int u = t - t_in - t_out, e = u >> 6, kt = u & 15, nt = (u >> 4) & 3, n = nt * 128 + np4, g = n >> 5, w = n & 31;
        const float* w1 = e < 64 ? p->in[I_W1] + ((size_t)l * 64 + e) * 1024 * 256 : p->in[I_SW1] + (size_t)l * 1024 * 256;
        const float* w3 = e < 64 ? p->in[I_W3] + ((size_t)l * 64 + e) * 1024 * 256 : p->in[I_SW3] + (size_t)l * 1024 * 256;
        c.src = w < 16 ? w1 + 16 * g + w : w3 + 16 * g + w - 16; c.srcld = 256; c.dst = (bf16_t*)(p->ws + OFF_W13) + (size_t)e * 512 * 1024; c.dstld = 1024; c.k0 = kt * 64; c.n0 = nt * 128;
    } else {
        const int u = t - t_in - t_out - t_13, e = u >> 5, kt = u & 3, nt = (u >> 2) & 7;
        const float* w2 = e < 64 ? p->in[I_W2] + ((size_t)l * 64 + e) * 256 * 1024 : p->in[I_SW2] + (size_t)l * 256 * 1024;
        c.src = w2 + nt * 128 + np4; c.srcld = 1024; c.dst = (bf16_t*)(p->ws + OFF_W2) + (size_t)e * 1024 * 256; c.dstld = 256; c.k0 = kt * 64; c.n0 = nt * 128;
    }
    return c;
}
__device__ __forceinline__ void ph_convert(KP p, int l, int bid, int nb, float* sm) {
    const int tid = opaque_tid();
    const int NP = ((l & 1) == 0) ? EVEN_LD : ODD_LD;
    const int total = 16 * (NP / 128) + 16 * 8 + 65 * 16 * 4 + 65 * 4 * 8;
    const int kr = tid >> 5, np4 = (tid & 31) * 4;
    float4 v[4];
    int t = bid;
    CvtTile c = cvt_tile_of(p, l, t < total ? t : 0, np4);
    if (t < total) {
#pragma unroll
        for (int j = 0; j < 4; ++j) v[j] = *(const float4*)(c.src + (size_t)(c.k0 + kr + 16 * j) * c.srcld);
    }
#pragma unroll 1
    for (; t < total; t += nb) {
        __syncthreads();
#pragma unroll
        for (int j = 0; j < 4; ++j) { float* d = sm + (np4) * 65 + kr + 16 * j; d[0] = v[j].x; d[65] = v[j].y; d[130] = v[j].z; d[195] = v[j].w; }
        const CvtTile cur = c;
        const int tn = t + nb;
        if (tn < total) {
            c = cvt_tile_of(p, l, tn, np4);
#pragma unroll
            for (int j = 0; j < 4; ++j) v[j] = *(const float4*)(c.src + (size_t)(c.k0 + kr + 16 * j) * c.srcld);
        }
        __syncthreads();
        const int n = tid >> 2, kc = (tid & 3) * 16;
        unsigned w[8];
#pragma unroll
        for (int q = 0; q < 8; ++q) w[q] = cvt_pk_bf16(sm[n * 65 + kc + 2 * q], sm[n * 65 + kc + 2 * q + 1]);
        uint4* d4 = (uint4*)(cur.dst + (size_t)(cur.n0 + n) * cur.dstld + cur.k0 + kc);
        d4[0] = make_uint4(w[0], w[1], w[2], w[3]); d4[1] = make_uint4(w[4], w[5], w[6], w[7]);
    }
    __syncthreads();
    if (bid < 8) {
        const float* rw = p->in[I_RW] + (size_t)l * 1024 * 64;
        bf16_t* hi = (bf16_t*)(p->ws + OFF_RWH); bf16_t* lo = hi + 64 * 1024;
        const int e = tid & 63, kb = bid * 128 + (tid >> 6) * 16;
#pragma unroll
        for (int i = 0; i < 16; i += 2) {
            const float x0 = rw[(size_t)(kb + i) * 64 + e], x1 = rw[(size_t)(kb + i + 1) * 64 + e];
            const unsigned h = cvt_pk_bf16(x0, x1);
            const unsigned lw = cvt_pk_bf16(x0 - bflo(h), x1 - bfhi(h));
            *(unsigned*)(hi + (size_t)e * 1024 + kb + i) = h; *(unsigned*)(lo + (size_t)e * 1024 + kb + i) = lw;
        }
    }
}

namespace gp {
typedef short bf16x8 __attribute__((ext_vector_type(8)));
typedef float f32x4 __attribute__((ext_vector_type(4)));
typedef unsigned u32x4 __attribute__((ext_vector_type(4)));
typedef unsigned u32x2 __attribute__((ext_vector_type(2)));
constexpr int BM = 256, BK = 64, HALF = 128, HTB = HALF * BK * 2, STAGE_BYTES = 8 * HTB, NXCD = 8, WGM = 8;
__device__ __forceinline__ int lds_byte(int r, int c) { const int st = (r >> 4) * 2 + (c >> 5), rr = r & 15, cc = c & 31, ob = rr * 64 + cc * 2; return st * 1024 + (ob ^ (((ob >> 9) & 1) << 5)); }
__device__ __forceinline__ void stage_rc(int b, int& R, int& C) { const int st = b / 1024, sb = b % 1024, swz = sb ^ (((sb >> 9) & 1) << 5); R = (st >> 1) * 16 + swz / 64; C = (st & 1) * 32 + (swz % 64) / 2; }
__device__ __forceinline__ int perm32(int rho) { const int n = rho >> 4, i = rho & 15; return 8 * (i >> 2) + 4 * n + (i & 3); }

struct Unit { const char* A; const char* B; int r0, c0, aux; };

struct DenseSched {
    const char* A; const char* B; int nM, nN, nwg, G, c; size_t tstep;
    __device__ __forceinline__ void init(const void* A_, const void* B_, int M, int N, int K, int G_, int c_) { A = (const char*)A_; B = (const char*)B_; nM = M / BM; nN = N / BM; nwg = nM * nN; G = G_; c = c_; tstep = (size_t)BM * K * 2; }
    __device__ __forceinline__ bool next(int i, Unit& u) const {
        const long L = (long)i * G + c; if (L >= nwg) return false;
        int wgid = (int)L; { const int q = nwg / NXCD, r = nwg % NXCD, xcd = wgid % NXCD, off = wgid / NXCD; wgid = (xcd < r ? xcd * (q + 1) : r * (q + 1) + (xcd - r) * q) + off; }
        const int nig = WGM * nN, gid = wgid / nig, fm = gid * WGM, gsz = (nM - fm) < WGM ? (nM - fm) : WGM;
        const int pm = fm + ((wgid % nig) % gsz), pn = (wgid % nig) / gsz;
        u.A = A + (size_t)pm * tstep; u.B = B + (size_t)pn * tstep; u.r0 = pm * BM; u.c0 = pn * BM; u.aux = 0; return true;
    }
    __device__ __forceinline__ void lane_off(const Unit&, unsigned (&)[2][2]) const {}
};

template <bool GATHER, bool PERM, class Sched, class Epi>
__device__ __forceinline__ void gemm_phase(LAS unsigned char* lds, const int K_, const Sched& S, const Epi& E) {
    int K = K_; asm volatile("" : "+s"(K));
    const int tid = opaque_tid(), wid = __builtin_amdgcn_readfirstlane(tid >> 6), lane = tid & 63, wr = wid >> 2, wc = wid & 3, fr = lane & 15, fq = lane >> 4;
    const int nt = K / BK;
    unsigned voffA[2], voffB[2];
#pragma unroll
    for (int i = 0; i < 2; ++i) { int R, C; stage_rc(tid * 16 + i * 8192, R, C); const int Rb = PERM ? ((R & ~31) + perm32(R & 31)) : R;
        voffA[i] = (unsigned)(R * K + C) * 2u; voffB[i] = (unsigned)(Rb * K + C) * 2u; }
    const size_t kstep = (size_t)(BK * 2);
    const size_t hstep = (size_t)HALF * K * 2;
    const unsigned ldsw = (unsigned)wid * 1024u;
    const int aoff = lds_byte(wr * 64 + fr, fq * 8), boff = lds_byte(wc * 32 + fr, fq * 8);
    unsigned cvo[2][2] = {{0u, 0u}, {0u, 0u}}, nvo[2][2] = {{0u, 0u}, {0u, 0u}};
#define GP_SA(b, h) (((b) * 2 + (h)) * HTB)
#define GP_SB(b, h) ((4 + (b) * 2 + (h)) * HTB)
#define GP_GLDS(gp_, lp_) __builtin_amdgcn_global_load_lds((const unsigned*)(gp_), (LAS unsigned*)(lp_), 16, 0, 0)
#define GP_STAGE_B(bufoff, gbase, h) do { const char* _g = (gbase) + (size_t)(h) * hstep; \
        GP_GLDS(_g + voffB[0], lds + (bufoff) + ldsw); GP_GLDS(_g + voffB[1], lds + (bufoff) + ldsw + 8192); } while (0)
#define GP_STAGE_A(bufoff, gbase, h, usenext) do { \
        if (GATHER) { const unsigned _o0 = (usenext) ? nvo[h][0] : cvo[h][0], _o1 = (usenext) ? nvo[h][1] : cvo[h][1]; \
            GP_GLDS((gbase) + _o0, lds + (bufoff) + ldsw); GP_GLDS((gbase) + _o1, lds + (bufoff) + ldsw + 8192); } \
        else { const char* _g = (gbase) + (size_t)(h) * hstep; GP_GLDS(_g + voffA[0], lds + (bufoff) + ldsw); GP_GLDS(_g + voffA[1], lds + (bufoff) + ldsw + 8192); } } while (0)
#define GP_LDA(dst, b, h) do { _Pragma("unroll") for (int m = 0; m < 4; ++m) _Pragma("unroll") for (int k = 0; k < 2; ++k) dst[m][k] = *(const LAS bf16x8*)(lds + GP_SA(b, h) + aoff + m * 2048 + k * 1024); } while (0)
#define GP_LDB(dst, b, h) do { _Pragma("unroll") for (int n = 0; n < 2; ++n) _Pragma("unroll") for (int k = 0; k < 2; ++k) dst[n][k] = *(const LAS bf16x8*)(lds + GP_SB(b, h) + boff + n * 2048 + k * 1024); } while (0)
#define GP_MMA(ai, bj, At, Bt) do { __builtin_amdgcn_s_setprio(1); _Pragma("unroll") for (int m = 0; m < 4; ++m) _Pragma("unroll") for (int n = 0; n < 2; ++n) _Pragma("unroll") for (int k = 0; k < 2; ++k) \
        acc[ai][bj][m][n] = __builtin_amdgcn_mfma_f32_16x16x32_bf16(Bt[n][k], At[m][k], acc[ai][bj][m][n], 0, 0, 0); __builtin_amdgcn_s_setprio(0); } while (0)
#define GP_WAIT_V(n) asm volatile("s_waitcnt vmcnt(" #n ")" ::: "memory")
#define GP_WAIT_L(n) asm volatile("s_waitcnt lgkmcnt(" #n ")" ::: "memory")
#define GP_BAR __builtin_amdgcn_s_barrier()
#define GP_SCHED __builtin_amdgcn_sched_barrier(0)
    Unit cur, nxt; int ui = 0;
    if (!S.next(0, cur)) return;
    f32x4 acc[2][2][4][2];
#pragma unroll
    for (int a = 0; a < 2; ++a)
#pragma unroll
        for (int b = 0; b < 2; ++b)
#pragma unroll
            for (int m = 0; m < 4; ++m)
#pragma unroll
                for (int n = 0; n < 2; ++n) acc[a][b][m][n] = (f32x4){0.f, 0.f, 0.f, 0.f};
    bf16x8 At[4][2], B0[2][2], B1[2][2];
    if (GATHER) S.lane_off(cur, cvo);
    const char* cA = cur.A; const char* cB = cur.B;
    GP_STAGE_B(GP_SB(0, 0), cB, 0); GP_STAGE_A(GP_SA(0, 0), cA, 0, false); GP_STAGE_B(GP_SB(0, 1), cB, 1); GP_STAGE_A(GP_SA(0, 1), cA, 1, false);
    if (wr == 1) GP_BAR;
    GP_WAIT_V(4); GP_BAR;
    GP_STAGE_B(GP_SB(1, 0), cB + kstep, 0); GP_STAGE_A(GP_SA(1, 0), cA + kstep, 0, false); GP_STAGE_B(GP_SB(1, 1), cB + kstep, 1);
    GP_WAIT_V(6); GP_BAR;
    for (;;) {
        const bool has_next = S.next(ui + 1, nxt);
        if (GATHER && has_next) S.lane_off(nxt, nvo);
        const char* nA = has_next ? nxt.A : cA; const char* nB = has_next ? nxt.B : cB;
        for (int t = 0; t < nt; t += 2) {
            const bool last = (t == nt - 2);
            const bool un = last && has_next;
            const char* a1 = cA + (size_t)(t + 1) * kstep;
            const char* a2 = last ? nA : cA + (size_t)(t + 2) * kstep; const char* b2 = last ? nB : cB + (size_t)(t + 2) * kstep;
            const char* a3 = a2 + kstep; const char* b3 = b2 + kstep;
            GP_LDB(B0, 0, 0); GP_SCHED; GP_LDA(At, 0, 0); GP_STAGE_A(GP_SA(1, 1), a1, 1, false);
            GP_WAIT_L(8); GP_BAR; GP_WAIT_L(0); GP_MMA(0, 0, At, B0); GP_BAR; GP_SCHED;
            GP_LDB(B1, 0, 1); GP_STAGE_B(GP_SB(0, 0), b2, 0);
            GP_BAR; GP_WAIT_L(0); GP_MMA(0, 1, At, B1); GP_BAR;
            GP_LDA(At, 0, 1); GP_STAGE_A(GP_SA(0, 0), a2, 0, un);
            GP_BAR; GP_WAIT_L(0); GP_MMA(1, 0, At, B0); GP_BAR; GP_SCHED;
            GP_STAGE_B(GP_SB(0, 1), b2, 1);
            GP_WAIT_V(6); GP_BAR; GP_MMA(1, 1, At, B1); GP_BAR;
            GP_LDB(B0, 1, 0); GP_SCHED; GP_LDA(At, 1, 0); GP_STAGE_A(GP_SA(0, 1), a2, 1, un);
            GP_WAIT_L(8); GP_BAR; GP_WAIT_L(0); GP_MMA(0, 0, At, B0); GP_BAR; GP_SCHED;
            GP_LDB(B1, 1, 1); GP_STAGE_B(GP_SB(1, 0), b3, 0);
            GP_BAR; GP_WAIT_L(0); GP_MMA(0, 1, At, B1); GP_BAR;
            GP_LDA(At, 1, 1); GP_STAGE_A(GP_SA(1, 0), a3, 0, un);
            GP_BAR; GP_WAIT_L(0); GP_MMA(1, 0, At, B0); GP_BAR; GP_SCHED;
            GP_STAGE_B(GP_SB(1, 1), b3, 1);
            GP_WAIT_V(6); GP_BAR; GP_MMA(1, 1, At, B1); GP_BAR;
        }
        E(acc, cur, wr, wc, fr, fq);
        if (!has_next) break;
#pragma unroll
        for (int a = 0; a < 2; ++a)
#pragma unroll
            for (int b = 0; b < 2; ++b)
#pragma unroll
                for (int m = 0; m < 4; ++m)
#pragma unroll
                    for (int n = 0; n < 2; ++n) acc[a][b][m][n] = (f32x4){0.f, 0.f, 0.f, 0.f};
        cur = nxt; cA = nA; cB = nB; ++ui;
        if (GATHER) { cvo[0][0] = nvo[0][0]; cvo[0][1] = nvo[0][1]; cvo[1][0] = nvo[1][0]; cvo[1][1] = nvo[1][1]; }
    }
    GP_WAIT_V(0);
    if (wr == 0) GP_BAR;
    GP_BAR;
#undef GP_SA
#undef GP_SB
#undef GP_GLDS
#undef GP_STAGE_A
#undef GP_STAGE_B
#undef GP_LDA
#undef GP_LDB
#undef GP_MMA
#undef GP_WAIT_V
#undef GP_WAIT_L
#undef GP_BAR
#undef GP_SCHED
}

struct EpiF32 {
    float* C; int ldc;
    __device__ __forceinline__ void operator()(const f32x4 (&acc)[2][2][4][2], const Unit& u, int wr, int wc, int fr, int fq) const {
        const int row0 = u.r0 + wr * 64 + fr, col0 = u.c0 + wc * 32 + 4 * fq;
#pragma unroll
        for (int ai = 0; ai < 2; ++ai)
#pragma unroll
            for (int m = 0; m < 4; ++m) { float* rowp = C + (size_t)(row0 + ai * HALF + m * 16) * ldc + col0;
#pragma unroll
                for (int bj = 0; bj < 2; ++bj)
#pragma unroll
                    for (int n = 0; n < 2; ++n) *(f32x4*)(rowp + bj * HALF + n * 16) = acc[ai][bj][m][n];
                __builtin_amdgcn_sched_barrier(0); }
    }
};
struct EpiBf16 {
    bf16_t* O; int ldc;
    __device__ __forceinline__ void operator()(const f32x4 (&acc)[2][2][4][2], const Unit& u, int wr, int wc, int fr, int fq) const {
        const int row0 = u.r0 + wr * 64 + fr, col0 = u.c0 + wc * 32 + 8 * fq;
#pragma unroll
        for (int ai = 0; ai < 2; ++ai)
#pragma unroll
            for (int m = 0; m < 4; ++m) { bf16_t* rowp = O + (size_t)(row0 + ai * HALF + m * 16) * ldc + col0;
#pragma unroll
                for (int bj = 0; bj < 2; ++bj) { const f32x4 v0 = acc[ai][bj][m][0], v1 = acc[ai][bj][m][1];
                    u32x4 w; w.x = cvt_pk_bf16(v0[0], v0[1]); w.y = cvt_pk_bf16(v0[2], v0[3]); w.z = cvt_pk_bf16(v1[0], v1[1]); w.w = cvt_pk_bf16(v1[2], v1[3]);
                    *(u32x4*)(rowp + bj * HALF) = w; }
                __builtin_amdgcn_sched_barrier(0); }
    }
};
}


typedef float f32x4_l __attribute__((ext_vector_type(4)));
__device__ __forceinline__ void stage_gate_w(KP p, int e, LAS float* wl) {
    const int tid = opaque_tid();
    const float* wg = p->in[I_EWIN] + (size_t)e * 1024 * EVEN_N + 1536;
#pragma unroll
    for (int i = 0; i < 8; ++i) { const int idx = tid + 512 * i, d = idx >> 2, j4 = idx & 3; const float4 w = *(const float4*)(wg + (size_t)d * EVEN_N + j4 * 4); *(LAS f32x4_l*)(wl + d * 16 + j4 * 4) = (f32x4_l){w.x, w.y, w.z, w.w}; }
    __syncthreads();
}
__device__ __forceinline__ void ph_modin(KP p, int l, int bid, int nb) {
    const int tid = opaque_tid(), lane = tid & 63, wv = tid >> 6;
    const bool even = (l & 1) == 0;
    bf16_t* U = (bf16_t*)(p->ws + OFF_U);
    float* G = (float*)(p->ws + OFF_G);
    LAS float* wl = (LAS float*)smraw_base();
    if (even) stage_gate_w(p, l >> 1, wl);
    #pragma unroll 1
    for (int tok = bid * 8 + wv; tok < NT; tok += nb * 8) {
        const float* h = hrow(p, tok);
        const float* m = modrow(p, l, tok);
        float ga[16];
#pragma unroll
        for (int j = 0; j < 16; ++j) ga[j] = 0.f;
#pragma unroll
        for (int c = 0; c < 4; ++c) {
            const int d = 4 * (lane + 64 * c);
            const float4 hv = *(const float4*)(h + d), sh = *(const float4*)(m + d), sc = *(const float4*)(m + 1024 + d);
            const float u0 = hv.x * (1.f + sc.x) + sh.x, u1 = hv.y * (1.f + sc.y) + sh.y, u2 = hv.z * (1.f + sc.z) + sh.z, u3 = hv.w * (1.f + sc.w) + sh.w;
            *(uint2*)(U + (size_t)tok * DM + d) = make_uint2(cvt_pk_bf16(u0, u1), cvt_pk_bf16(u2, u3));
            if (even) {
                const float uu[4] = {u0, u1, u2, u3};
#pragma unroll
                for (int q = 0; q < 4; ++q) {
#pragma unroll
                    for (int j4 = 0; j4 < 4; ++j4) { const f32x4_l w = *(const LAS f32x4_l*)(wl + (d + q) * 16 + j4 * 4); ga[4 * j4] += uu[q] * w[0]; ga[4 * j4 + 1] += uu[q] * w[1]; ga[4 * j4 + 2] += uu[q] * w[2]; ga[4 * j4 + 3] += uu[q] * w[3]; }
                }
                __builtin_amdgcn_sched_barrier(0);
            }
        }
        if (even) {
            float mine = 0.f;
#pragma unroll
            for (int j = 0; j < 16; ++j) { const float s = wave_sum(ga[j]); if (lane == j) mine = s; }
            if (lane < 16) G[(size_t)tok * 16 + lane] = mine;
        }
    }
}

__device__ __forceinline__ void ph_gemm_in(KP p, int l, int bid, int nb, LAS unsigned char* lds) {
    const int N = ((l & 1) == 0) ? EVEN_LD : ODD_LD;
    gp::DenseSched S; S.init(p->ws + OFF_U, p->ws + OFF_WIN, NT, N, 1024, nb, bid);
    gp::EpiBf16 E{(bf16_t*)(p->ws + OFF_BIG), N};
    gp::gemm_phase<false, true>(lds, 1024, S, E);
}
__device__ __forceinline__ void ph_gemm_out(KP p, int l, int bid, int nb, LAS unsigned char* lds) {
    gp::DenseSched S; S.init(p->ws + OFF_U, p->ws + OFF_WOUT, (l == 3) ? NL : NT, 1024, 1024, nb, bid);
    gp::EpiBf16 E{(bf16_t*)(p->ws + OFF_BIG), 1024};
    gp::gemm_phase<false, true>(lds, 1024, S, E);
}


namespace sc {
typedef short bf16x8 __attribute__((ext_vector_type(8)));
typedef short bf16x4 __attribute__((ext_vector_type(4)));
typedef float f32x4 __attribute__((ext_vector_type(4)));
#define SC_MFMA(a, b, c) __builtin_amdgcn_mfma_f32_16x16x32_bf16(a, b, c, 0, 0, 0)
__device__ __forceinline__ bf16x8 rd_row(unsigned img, int row, int stride, int k0) { return *(const LAS bf16x8*)(size_t)(img + (unsigned)(row * stride + k0 * 2)); }
__device__ __forceinline__ bf16x8 rd_tr(unsigned img, int k0, int n0, int stride, int lane) {
    const int g = lane >> 4, i = lane & 15;
    const unsigned a0 = img + (unsigned)((k0 + 8 * g + (i >> 2)) * stride + (n0 + 4 * (i & 3)) * 2), a1 = a0 + 4u * (unsigned)stride;
    bf16x4 lo, hi;
    asm volatile("ds_read_b64_tr_b16 %0, %2\n\tds_read_b64_tr_b16 %1, %3\n\ts_waitcnt lgkmcnt(0)" : "=&v"(lo), "=&v"(hi) : "v"(a0), "v"(a1) : "memory");
    return (bf16x8){lo[0], lo[1], lo[2], lo[3], hi[0], hi[1], hi[2], hi[3]};
}
typedef unsigned u32x2_ __attribute__((ext_vector_type(2)));
typedef unsigned u32x4_ __attribute__((ext_vector_type(4)));
__device__ __forceinline__ unsigned tr_addr(unsigned img, int k0, int n0, int stride, int lane) { const int g = lane >> 4, i = lane & 15; return img + (unsigned)((k0 + 8 * g + (i >> 2)) * stride + (n0 + 4 * (i & 3)) * 2); }
__device__ __forceinline__ void rd_tr5(const unsigned (&a0)[5], const unsigned (&s4)[5], bf16x8 (&o)[5]) {
    bf16x4 l0, h0, l1, h1, l2, h2, l3, h3, l4, h4;
    asm volatile("ds_read_b64_tr_b16 %0, %10\n\tds_read_b64_tr_b16 %1, %11\n\tds_read_b64_tr_b16 %2, %12\n\tds_read_b64_tr_b16 %3, %13\n\tds_read_b64_tr_b16 %4, %14\n\t"
                 "ds_read_b64_tr_b16 %5, %15\n\tds_read_b64_tr_b16 %6, %16\n\tds_read_b64_tr_b16 %7, %17\n\tds_read_b64_tr_b16 %8, %18\n\tds_read_b64_tr_b16 %9, %19\n\ts_waitcnt lgkmcnt(0)"
                 : "=&v"(l0), "=&v"(h0), "=&v"(l1), "=&v"(h1), "=&v"(l2), "=&v"(h2), "=&v"(l3), "=&v"(h3), "=&v"(l4), "=&v"(h4)
                 : "v"(a0[0]), "v"(a0[0] + s4[0]), "v"(a0[1]), "v"(a0[1] + s4[1]), "v"(a0[2]), "v"(a0[2] + s4[2]), "v"(a0[3]), "v"(a0[3] + s4[3]), "v"(a0[4]), "v"(a0[4] + s4[4]) : "memory");
    o[0] = (bf16x8){l0[0], l0[1], l0[2], l0[3], h0[0], h0[1], h0[2], h0[3]}; o[1] = (bf16x8){l1[0], l1[1], l1[2], l1[3], h1[0], h1[1], h1[2], h1[3]};
    o[2] = (bf16x8){l2[0], l2[1], l2[2], l2[3], h2[0], h2[1], h2[2], h2[3]}; o[3] = (bf16x8){l3[0], l3[1], l3[2], l3[3], h3[0], h3[1], h3[2], h3[3]};
    o[4] = (bf16x8){l4[0], l4[1], l4[2], l4[3], h4[0], h4[1], h4[2], h4[3]};
}
__device__ __forceinline__ void st8(unsigned addr, uint2 v) { *(LAS u32x2_*)(size_t)addr = (u32x2_){v.x, v.y}; }
__device__ __forceinline__ void st16(unsigned addr, uint4 v) { *(LAS u32x4_*)(size_t)addr = (u32x4_){v.x, v.y, v.z, v.w}; }
__device__ __forceinline__ float scan_add64(float v, int lane) {
#pragma unroll
    for (int o = 1; o < 64; o <<= 1) { const float t = SHU(v, o); if (lane >= o) v += t; }
    return v;
}
__device__ __forceinline__ float scan_max64(float v, int lane) {
#pragma unroll
    for (int o = 1; o < 64; o <<= 1) { const float t = SHU(v, o); if (lane >= o) v = fmaxf(v, t); }
    return v;
}

template <int MODE>
__device__ __forceinline__ void scan_item(KP p, int l, int b, int h, int dir, int vs) {
    constexpr int CS = (MODE == 1) ? 32 : 64, DK = (MODE == 0) ? 64 : 128, EXT = (MODE == 0) ? 1 : 0;
    constexpr int QS = (DK + 8) * 2, VS = (64 + 16 * EXT + 8) * 2, SS = (CS + 8) * 2, NVR = 64 + 16 * EXT;
    constexpr int NCH = (CTXL + SEQ) / CS;
    constexpr int LD = (MODE == 2) ? ODD_LD : EVEN_LD;
    constexpr unsigned O_QA = 0, O_KA = O_QA + CS * QS, O_QB = O_KA + CS * QS, O_KW = O_QB + (MODE == 1 ? CS * QS : 0), O_V = O_KW + CS * QS,
                       O_SSC = O_V + CS * VS, O_ST = O_SSC + CS * SS, O_DKV = O_ST + 2 * NVR * QS, O_END = O_DKV + 512;
    static_assert(O_END <= 131072, "scan LDS");
    const int tid = opaque_tid(), lane = tid & 63, wv = __builtin_amdgcn_readfirstlane(tid >> 6), r16 = lane & 15, q4 = lane >> 4;
    const unsigned L0 = (unsigned)(size_t)smraw_base();
    const bf16_t* P = (const bf16_t*)(p->ws + OFF_BIG);
    bf16_t* HXo = (bf16_t*)(p->ws + OFF_AUX) + (size_t)dir * NT * 1024;
    const int e2 = l >> 1;
    const int cQ = (MODE == 0) ? E_MQ + h * 64 : (MODE == 1) ? E_HQ + h * 128 : 1536 + h * 128;
    const int cK = (MODE == 0) ? E_MK + h * 64 : (MODE == 1) ? (dir ? E_HFB : E_HFF) + h * 128 : 2048 + h * 128;
    const int cV = (MODE == 0) ? E_MV + h * 128 + vs * 64 : (MODE == 1) ? E_HI + h * 128 + vs * 64 : 2560 + h * 128 + vs * 64;
    const int cO = (MODE == 0) ? h * 128 + vs * 64 : 512 + h * 128 + vs * 64;
    const int lt = (MODE == 1) ? (tid & 31) : (tid >> 3);
    const int lj = (MODE == 0) ? (tid & 7) : (MODE == 1) ? (tid >> 5) : ((tid >> 2) & 1) * 8 + (tid & 3);
    const int vt_ = tid >> 3, vj = tid & 7;
    float lbv[8]; float gbi = 0.f, gbf = 0.f, lg = 0.f;
    if (MODE == 1) {
        const float* lbp = (const float*)(p->ws + OFF_LB) + e2 * 512 + h * 128 + lj * 8;
#pragma unroll
        for (int i = 0; i < 8; ++i) lbv[i] = lbp[i];
    } else {
#pragma unroll
        for (int i = 0; i < 8; ++i) lbv[i] = 0.f;
    }
    if (MODE == 0) { const float* gb = p->in[I_MGB] + e2 * 16; gbi = gb[(dir ? 2 : 0) * 4 + h]; gbf = gb[(dir ? 3 : 1) * 4 + h]; }
    if (MODE == 2) lg = p->in[I_RLD][e2 * 8 + dir * 4 + h];
    const float* G = (const float*)(p->ws + OFF_G);
    const float* ropet = (const float*)(p->ws + OFF_ROPE);
    unsigned oz = 0u; asm volatile("" : "+v"(oz));
    for (unsigned o = tid * 16; o < 2u * NVR * QS; o += 512 * 16) st16(L0 + O_ST + o, make_uint4(oz, oz, oz, oz));
    if (EXT) { if (tid < CS) { st16(L0 + O_V + tid * VS + 128, make_uint4(0x3f80u | oz, oz, oz, oz)); st16(L0 + O_V + tid * VS + 144, make_uint4(oz, oz, oz, oz)); } }
    f32x4 sacc[4];
#pragma unroll
    for (int i = 0; i < 4; ++i) sacc[i] = (f32x4){0.f, 0.f, 0.f, 0.f};
    float m_in = -1e30f;
    struct Raw { uint4 rq0, rq1, rk0, rk1, rv; float rg0, rg1; };
    Raw RA, RB;
    RA.rq1 = make_uint4(0u, 0u, 0u, 0u); RA.rk1 = RA.rq1; RA.rv = RA.rq1; RA.rg0 = 0.f; RA.rg1 = 0.f; RB = RA;
    auto load_chunk = [&](Raw& R, int c) {
        const int i0 = c * CS;
        const int tq = scan_tok(b, i0 + lt, dir);
        const bf16_t* pr = P + (size_t)tq * LD;
        R.rq0 = *(const uint4*)(pr + cQ + lj * 8); R.rk0 = *(const uint4*)(pr + cK + lj * 8);
        if (MODE == 2) { R.rq1 = *(const uint4*)(pr + cQ + lj * 8 + 32); R.rk1 = *(const uint4*)(pr + cK + lj * 8 + 32); }
        if (MODE != 1 || tid < 256) { const int tv = scan_tok(b, i0 + vt_, dir); R.rv = *(const uint4*)(P + (size_t)tv * LD + cV + vj * 8); }
        if (MODE == 0) { const int tg = scan_tok(b, i0 + lane, dir); R.rg0 = G[(size_t)tg * 16 + (dir ? 8 : 0) + h]; R.rg1 = G[(size_t)tg * 16 + (dir ? 12 : 4) + h]; }
    };
    constexpr int PD = (MODE == 2) ? 1 : 2;
    load_chunk(RA, 0); if (PD == 2) load_chunk(RB, 1);
    auto chunk = [&](const int c, Raw& R) {
        const uint4 rq0 = R.rq0, rq1 = R.rq1, rk0 = R.rk0, rk1 = R.rk1, rv = R.rv; const float rg0 = R.rg0, rg1 = R.rg1;
        const unsigned ST_R = L0 + O_ST + (unsigned)(c & 1) * NVR * QS, ST_W = L0 + O_ST + (unsigned)((c + 1) & 1) * NVR * QS;
        float sp = 1.f;
        float v_u = 0.f, v_M = 0.f, v_e = 1.f, v_low = 0.f, v_w = 1.f;
        if (MODE == 0) {
            const float ig = rg0 + gbi, fg = rg1 + gbf;
            const float lf = fminf(fg, 0.f) - flog(1.f + fexp(-fabsf(fg)));
            const float bb = scan_add64(lf, lane);
            const float g = SHI(bb, 63);
            v_u = ig - bb;
            const float cu = scan_max64(v_u, lane);
            v_M = fmaxf(m_in, cu);
            const float m_new = fmaxf(g + m_in, g + SHI(cu, 63));
            sp = fexp(g + m_in - m_new);
            v_w = fexp(g + v_u - m_new);
            v_e = fexp(m_in - v_M);
            v_low = fexp(-(bb + v_M));
            m_in = m_new;
            st16(L0 + O_QA + lt * QS + lj * 16, rq0);
            st16(L0 + O_KA + lt * QS + lj * 16, rk0);
            const float wr = SHI(v_w, lt);
            uint4 kw; kw.x = cvt_pk_bf16(bflo(rk0.x) * wr, bfhi(rk0.x) * wr); kw.y = cvt_pk_bf16(bflo(rk0.y) * wr, bfhi(rk0.y) * wr);
            kw.z = cvt_pk_bf16(bflo(rk0.z) * wr, bfhi(rk0.z) * wr); kw.w = cvt_pk_bf16(bflo(rk0.w) * wr, bfhi(rk0.w) * wr);
            st16(L0 + O_KW + lt * QS + lj * 16, kw);
            st16(L0 + O_V + vt_ * VS + vj * 16, rv);
        } else if (MODE == 2) {
            sp = fexp(64.f * lg);
            const bool lat = c >= CTXL / CS;
            float q[16], k[16];
            const unsigned qa[8] = {rq0.x, rq0.y, rq0.z, rq0.w, rq1.x, rq1.y, rq1.z, rq1.w}, ka[8] = {rk0.x, rk0.y, rk0.z, rk0.w, rk1.x, rk1.y, rk1.z, rk1.w};
#pragma unroll
            for (int i = 0; i < 8; ++i) { q[2 * i] = bflo(qa[i]); q[2 * i + 1] = bfhi(qa[i]); k[2 * i] = bflo(ka[i]); k[2 * i + 1] = bfhi(ka[i]); }
            if (lat) {
                const int tq = scan_tok(b, c * CS + lt, dir), tt = tq & (SEQ - 1);
                const int pos = ((tid >> 2) & 1) ? (tt & 63) : (tt >> 6);
                const float2* rt = (const float2*)ropet + pos * 32 + (tid & 3) * 8;
#pragma unroll
                for (int i = 0; i < 8; ++i) {
                    const float2 cs2 = rt[i];
                    const float q1 = q[i], q2 = q[8 + i], k1 = k[i], k2 = k[8 + i];
                    q[i] = q1 * cs2.x - q2 * cs2.y; q[8 + i] = q1 * cs2.y + q2 * cs2.x;
                    k[i] = k1 * cs2.x - k2 * cs2.y; k[8 + i] = k1 * cs2.y + k2 * cs2.x;
                }
            }
            const float wr = 0.08838834764831845f * fexp((float)(63 - lt) * lg);
            uint4 o0, o1, w0, w1, x0, x1;
            o0.x = cvt_pk_bf16(q[0], q[1]); o0.y = cvt_pk_bf16(q[2], q[3]); o0.z = cvt_pk_bf16(q[4], q[5]); o0.w = cvt_pk_bf16(q[6], q[7]);
            o1.x = cvt_pk_bf16(q[8], q[9]); o1.y = cvt_pk_bf16(q[10], q[11]); o1.z = cvt_pk_bf16(q[12], q[13]); o1.w = cvt_pk_bf16(q[14], q[15]);
            w0.x = cvt_pk_bf16(k[0], k[1]); w0.y = cvt_pk_bf16(k[2], k[3]); w0.z = cvt_pk_bf16(k[4], k[5]); w0.w = cvt_pk_bf16(k[6], k[7]);
            w1.x = cvt_pk_bf16(k[8], k[9]); w1.y = cvt_pk_bf16(k[10], k[11]); w1.z = cvt_pk_bf16(k[12], k[13]); w1.w = cvt_pk_bf16(k[14], k[15]);
            x0.x = cvt_pk_bf16(k[0] * wr, k[1] * wr); x0.y = cvt_pk_bf16(k[2] * wr, k[3] * wr); x0.z = cvt_pk_bf16(k[4] * wr, k[5] * wr); x0.w = cvt_pk_bf16(k[6] * wr, k[7] * wr);
            x1.x = cvt_pk_bf16(k[8] * wr, k[9] * wr); x1.y = cvt_pk_bf16(k[10] * wr, k[11] * wr); x1.z = cvt_pk_bf16(k[12] * wr, k[13] * wr); x1.w = cvt_pk_bf16(k[14] * wr, k[15] * wr);
            st16(L0 + O_QA + lt * QS + lj * 16, o0); st16(L0 + O_QA + lt * QS + lj * 16 + 64, o1);
            st16(L0 + O_KA + lt * QS + lj * 16, w0); st16(L0 + O_KA + lt * QS + lj * 16 + 64, w1);
            st16(L0 + O_KW + lt * QS + lj * 16, x0); st16(L0 + O_KW + lt * QS + lj * 16 + 64, x1);
            st16(L0 + O_V + vt_ * VS + vj * 16, rv);
        } else {
            const unsigned qa[4] = {rq0.x, rq0.y, rq0.z, rq0.w}, fa[4] = {rk0.x, rk0.y, rk0.z, rk0.w};
            float qv[8], kk[8], A[8];
#pragma unroll
            for (int i = 0; i < 8; ++i) {
                const float qr = (i & 1) ? bfhi(qa[i >> 1]) : bflo(qa[i >> 1]), fr = (i & 1) ? bfhi(fa[i >> 1]) : bflo(fa[i >> 1]);
                const float f = lbv[i] + (1.f - lbv[i]) * fsigmoid(fr);
                qv[i] = fsilu(qr); kk[i] = 1.f - f; A[i] = flog(f);
            }
#pragma unroll
            for (int i = 0; i < 8; ++i) {
                int v = __builtin_bit_cast(int, A[i]);
                v = __builtin_bit_cast(int, __builtin_bit_cast(float, v) + __builtin_bit_cast(float, __builtin_amdgcn_update_dpp(0, v, 0x111, 0xf, 0xf, false)));
                v = __builtin_bit_cast(int, __builtin_bit_cast(float, v) + __builtin_bit_cast(float, __builtin_amdgcn_update_dpp(0, v, 0x112, 0xf, 0xf, false)));
                v = __builtin_bit_cast(int, __builtin_bit_cast(float, v) + __builtin_bit_cast(float, __builtin_amdgcn_update_dpp(0, v, 0x114, 0xf, 0xf, false)));
                v = __builtin_bit_cast(int, __builtin_bit_cast(float, v) + __builtin_bit_cast(float, __builtin_amdgcn_update_dpp(0, v, 0x118, 0xf, 0xf, false)));
                v = __builtin_bit_cast(int, __builtin_bit_cast(float, v) + __builtin_bit_cast(float, __builtin_amdgcn_update_dpp(0, v, 0x142, 0xa, 0xf, false)));
                A[i] = __builtin_bit_cast(float, v);
            }
            float qa_[8], qb_[8], ka_[8], kw_[8];
#pragma unroll
            for (int i = 0; i < 8; ++i) {
                const float am = SHI32(A[i], 15), ae = SHI32(A[i], 31);
                qa_[i] = qv[i] * fexp(A[i] - am); qb_[i] = qv[i] * fexp(A[i]); ka_[i] = kk[i] * fexp(am - A[i]); kw_[i] = kk[i] * fexp(ae - A[i]);
                if (lt == 31) *(LAS float*)(size_t)(L0 + O_DKV + (lj * 8 + i) * 4) = fexp(ae);
            }
            uint4 w;
            w.x = cvt_pk_bf16(qa_[0], qa_[1]); w.y = cvt_pk_bf16(qa_[2], qa_[3]); w.z = cvt_pk_bf16(qa_[4], qa_[5]); w.w = cvt_pk_bf16(qa_[6], qa_[7]); st16(L0 + O_QA + lt * QS + lj * 16, w);
            w.x = cvt_pk_bf16(qb_[0], qb_[1]); w.y = cvt_pk_bf16(qb_[2], qb_[3]); w.z = cvt_pk_bf16(qb_[4], qb_[5]); w.w = cvt_pk_bf16(qb_[6], qb_[7]); st16(L0 + O_QB + lt * QS + lj * 16, w);
            w.x = cvt_pk_bf16(ka_[0], ka_[1]); w.y = cvt_pk_bf16(ka_[2], ka_[3]); w.z = cvt_pk_bf16(ka_[4], ka_[5]); w.w = cvt_pk_bf16(ka_[6], ka_[7]); st16(L0 + O_KA + lt * QS + lj * 16, w);
            w.x = cvt_pk_bf16(kw_[0], kw_[1]); w.y = cvt_pk_bf16(kw_[2], kw_[3]); w.z = cvt_pk_bf16(kw_[4], kw_[5]); w.w = cvt_pk_bf16(kw_[6], kw_[7]); st16(L0 + O_KW + lt * QS + lj * 16, w);
            if (tid < 256) st16(L0 + O_V + vt_ * VS + vj * 16, rv);
        }
        __syncthreads();
        if (c + PD < NCH) load_chunk(R, c + PD);
        {
            constexpr int NT1 = CS / 16;
            const bool act = (MODE == 1) ? (wv < 4) : true;
            const int tb = (MODE == 1) ? (wv & 1) : (wv & 3);
#pragma unroll
            for (int u2 = 0; u2 < ((MODE == 1) ? 1 : 2); ++u2) {
                const int sb = (MODE == 1) ? (wv >> 1) : 2 * (wv >> 2) + u2;
                if (act) {
                    f32x4 d = (f32x4){0.f, 0.f, 0.f, 0.f};
                    if (sb <= tb) {
#pragma unroll
                        for (int kk2 = 0; kk2 < DK / 32; ++kk2)
                            d = SC_MFMA(rd_row(L0 + O_KA, sb * 16 + r16, QS, kk2 * 32 + q4 * 8), rd_row(L0 + O_QA, tb * 16 + r16, QS, kk2 * 32 + q4 * 8), d);
                        const int t = tb * 16 + r16, s0 = sb * 16 + q4 * 4;
                        if (MODE == 0) {
                            const float Mt = SHI(v_M, t);
#pragma unroll
                            for (int jj = 0; jj < 4; ++jj) { const float us = SHI(v_u, s0 + jj); d[jj] = (s0 + jj <= t) ? d[jj] * 0.125f * fexp(us - Mt) : 0.f; }
                        } else if (MODE == 2) {
#pragma unroll
                            for (int jj = 0; jj < 4; ++jj) d[jj] = (s0 + jj <= t) ? d[jj] * 0.08838834764831845f * fexp((float)(t - s0 - jj) * lg) : 0.f;
                        } else {
#pragma unroll
                            for (int jj = 0; jj < 4; ++jj) d[jj] = (s0 + jj <= t) ? d[jj] : 0.f;
                        }
                    }
                    st8(L0 + O_SSC + (tb * 16 + r16) * SS + (sb * 16 + q4 * 4) * 2, make_uint2(cvt_pk_bf16(d[0], d[1]), cvt_pk_bf16(d[2], d[3])));
                }
            }
            (void)NT1;
        }
        __syncthreads();
        {
            const int tb = (MODE == 1) ? (wv & 1) : (wv & 3);
            const int t = tb * 16 + r16;
            const int tok = scan_tok(b, c * CS + t, dir);
            constexpr int NV = (MODE == 1) ? 1 : 2;
            f32x4 oi[NV + EXT], oo[NV + EXT];
#pragma unroll
            for (int u2 = 0; u2 < NV + EXT; ++u2) {
                const int vt = (u2 == NV) ? 4 : ((MODE == 1) ? (wv >> 1) : 2 * (wv >> 2) + u2);
                f32x4 a1 = (f32x4){0.f, 0.f, 0.f, 0.f}, a2 = a1;
#pragma unroll
                for (int sb2 = 0; sb2 < CS / 32; ++sb2)
                    a1 = SC_MFMA(rd_tr(L0 + O_V, sb2 * 32, vt * 16, VS, lane), rd_row(L0 + O_SSC, t, SS, sb2 * 32 + q4 * 8), a1);
#pragma unroll
                for (int kk2 = 0; kk2 < DK / 32; ++kk2)
                    a2 = SC_MFMA(rd_row(ST_R, vt * 16 + r16, QS, kk2 * 32 + q4 * 8), rd_row(L0 + ((MODE == 1) ? O_QB : O_QA), t, QS, kk2 * 32 + q4 * 8), a2);
                oi[u2] = a1; oo[u2] = a2;
            }
            float den = 1.f, ei = 1.f;
            if (MODE == 0) {
                ei = 0.125f * SHI(v_e, t);
                const float dsum = oi[NV][0] + ei * oo[NV][0];
                const float dd = SHI(dsum, r16);
                den = 1.f / fmaxf(fabsf(dd), SHI(v_low, t));
            } else if (MODE == 2) {
                ei = fexp((float)(t + 1) * lg);
            }
#pragma unroll
            for (int u2 = 0; u2 < NV; ++u2) {
                const int vt = (MODE == 1) ? (wv >> 1) : 2 * (wv >> 2) + u2;
                float o[4];
#pragma unroll
                for (int jj = 0; jj < 4; ++jj) o[jj] = (oi[u2][jj] + ei * oo[u2][jj]) * den;
                *(uint2*)(HXo + (size_t)tok * 1024 + cO + vt * 16 + q4 * 4) = make_uint2(cvt_pk_bf16(o[0], o[1]), cvt_pk_bf16(o[2], o[3]));
            }
        }
        {
            constexpr int NS = (MODE == 0) ? 3 : 4;
            const int kt = (MODE == 0) ? (wv & 3) : wv;
            float dk[4] = {sp, sp, sp, sp};
            if (MODE == 1) { const f32x4 dv = *(const LAS f32x4*)(size_t)(L0 + O_DKV + (kt * 16 + q4 * 4) * 4); dk[0] = dv[0]; dk[1] = dv[1]; dk[2] = dv[2]; dk[3] = dv[3]; }
            f32x4 a[NS];
#pragma unroll
            for (int u2 = 0; u2 < NS; ++u2) { a[u2] = sacc[u2];
#pragma unroll
                for (int jj = 0; jj < 4; ++jj) a[u2][jj] *= dk[jj]; }
#pragma unroll
            for (int sb2 = 0; sb2 < CS / 32; ++sb2) {
                unsigned ta[5], ts[5]; bf16x8 ops[5];
                ta[0] = tr_addr(L0 + O_KW, sb2 * 32, kt * 16, QS, lane); ts[0] = 4u * QS;
#pragma unroll
                for (int u2 = 0; u2 < 4; ++u2) {
                    const int vt = (MODE == 0) ? ((u2 >= 2) ? 4 : 2 * (wv >> 2) + u2) : u2;
                    ta[1 + u2] = tr_addr(L0 + O_V, sb2 * 32, vt * 16, VS, lane); ts[1 + u2] = 4u * VS;
                }
                rd_tr5(ta, ts, ops);
#pragma unroll
                for (int u2 = 0; u2 < NS; ++u2) a[u2] = SC_MFMA(ops[0], ops[1 + u2], a[u2]);
            }
#pragma unroll
            for (int u2 = 0; u2 < NS; ++u2) {
                const int vt = (MODE == 0) ? ((u2 == 2) ? 4 : 2 * (wv >> 2) + u2) : u2;
                sacc[u2] = a[u2];
                st8(ST_W + (vt * 16 + r16) * QS + (kt * 16 + q4 * 4) * 2, make_uint2(cvt_pk_bf16(a[u2][0], a[u2][1]), cvt_pk_bf16(a[u2][2], a[u2][3])));
            }
        }
        __syncthreads();
    };
#pragma unroll 1
    for (int c = 0; c < NCH; c += 2) { chunk(c, RA); if (PD == 2) chunk(c + 1, RB); else chunk(c + 1, RA); }
}
}

__device__ __forceinline__ void ph_scan_even2(KP p, int l, int bid, int nb) {
#pragma unroll 1
    for (int item = bid; item < 256; item += nb) {
        const int kind = item >> 7, b = (item >> 4) & 7, h = (item >> 2) & 3, dir = (item >> 1) & 1, vs = item & 1;
        if (kind == 0) sc::scan_item<0>(p, l, b, h, dir, vs); else sc::scan_item<1>(p, l, b, h, dir, vs);
        __syncthreads();
    }
}
__device__ __forceinline__ void ph_scan_odd2(KP p, int l, int bid, int nb) {
#pragma unroll 1
    for (int item = bid; item < 128; item += nb) {
        const int b = (item >> 4) & 7, h = (item >> 2) & 3, dir = (item >> 1) & 1, vs = item & 1;
        sc::scan_item<2>(p, l, b, h, dir, vs);
        __syncthreads();
    }
}

__device__ __forceinline__ void unpack16(const uint4 a, const uint4 b, float (&x)[16]) {
    x[0] = bflo(a.x); x[1] = bfhi(a.x); x[2] = bflo(a.y); x[3] = bfhi(a.y); x[4] = bflo(a.z); x[5] = bfhi(a.z); x[6] = bflo(a.w); x[7] = bfhi(a.w);
    x[8] = bflo(b.x); x[9] = bfhi(b.x); x[10] = bflo(b.y); x[11] = bfhi(b.y); x[12] = bflo(b.z); x[13] = bfhi(b.z); x[14] = bflo(b.w); x[15] = bfhi(b.w);
}
__device__ __forceinline__ float sum8(float v) { v += SHX(v, 1); v += SHX(v, 2); v += SHX(v, 4); return v; }
template <bool MEANSUB, bool SIG>
__device__ __forceinline__ void head_norm_gate16(const bf16_t* h0, const bf16_t* h1, const bf16_t* gp, const float* nw, bf16_t* out) {
    float a[16], b[16], g[16];
    unpack16(*(const uint4*)h0, *(const uint4*)(h0 + 8), a); unpack16(*(const uint4*)h1, *(const uint4*)(h1 + 8), b); unpack16(*(const uint4*)gp, *(const uint4*)(gp + 8), g);
    float s = 0.f;
#pragma unroll
    for (int i = 0; i < 16; ++i) { a[i] += b[i]; s += a[i]; }
    if (MEANSUB) { const float mean = sum8(s) * (1.f / 128.f);
#pragma unroll
        for (int i = 0; i < 16; ++i) a[i] -= mean; }
    float q = 0.f;
#pragma unroll
    for (int i = 0; i < 16; ++i) q += a[i] * a[i];
    const float r = rsqrtf(sum8(q) * (1.f / 128.f) + LN_EPS);
    unsigned w[8];
#pragma unroll
    for (int i = 0; i < 16; i += 2) {
        const float y0 = a[i] * r * nw[i] * (SIG ? sigmoidf_(g[i]) : siluf_(g[i])), y1 = a[i + 1] * r * nw[i + 1] * (SIG ? sigmoidf_(g[i + 1]) : siluf_(g[i + 1]));
        w[i >> 1] = cvt_pk_bf16(y0, y1);
    }
    *(uint4*)out = make_uint4(w[0], w[1], w[2], w[3]); *(uint4*)(out + 8) = make_uint4(w[4], w[5], w[6], w[7]);
}
__device__ __forceinline__ void ph_normgate_even(KP p, int l, int bid, int nb) {
    const int tid = opaque_tid(), lane = tid & 63, wv = tid >> 6;
    const bf16_t* P = (const bf16_t*)(p->ws + OFF_BIG);
    const bf16_t* HX = (const bf16_t*)(p->ws + OFF_AUX);
    const bf16_t* HX1 = HX + (size_t)NT * 1024;
    bf16_t* MIX = (bf16_t*)(p->ws + OFF_U);
    const int e = l >> 1;
    const bool ml = lane < 32;
    const float* nw = ml ? p->in[I_MNW] + e * 512 + 16 * lane : p->in[I_HNW] + e * 512 + 16 * (lane - 32);
    const int gcol = ml ? E_MO + 16 * lane : E_HG + 16 * (lane - 32);
#pragma unroll 1
    for (int tok = bid * 8 + wv; tok < NT; tok += nb * 8) {
        const size_t o = (size_t)tok * 1024 + 16 * lane;
        if (ml) head_norm_gate16<true, true>(HX + o, HX1 + o, P + (size_t)tok * EVEN_LD + gcol, nw, MIX + o);
        else head_norm_gate16<false, false>(HX + o, HX1 + o, P + (size_t)tok * EVEN_LD + gcol, nw, MIX + o);
    }
}

#define OFF_UT   (OFF_AUX + 136 * MiB)
#define OFF_FKS(o) (984 * MiB + (size_t)(o) * 34 * MiB)
#define OFF_ZOT  (OFF_UT + 102 * MiB)

__device__ __forceinline__ void ph_hy_filt2(KP p, int l, int bid, int nb, float* sm, int skip) {
    const int tid = opaque_tid(), o = l >> 1;
    float* zf = sm;
    float* h1 = sm + 1024;
    float* h2 = sm + 2048;
    float* h3 = sm + 3072;
    const float* fw1 = p->in[I_HW1] + o * 33 * 64; const float* fb1 = p->in[I_HB1] + o * 64;
    const float* fw2 = p->in[I_HW2] + o * 64 * 64; const float* fb2 = p->in[I_HB2] + o * 64;
    const float* fw3 = p->in[I_HW3] + o * 64 * 64; const float* fb3 = p->in[I_HB3] + o * 64;
    const float* freq = p->in[I_HFREQ] + o * 64;
    const float* wout = p->in[I_HWOUT] + (size_t)o * 64 * 2048;
    float* FK = (float*)(p->ws + OFF_FKS(o)); float* FKC = FK + (size_t)2 * 512 * 8192;
#pragma unroll 1
    for (int item = bid - skip; item < (SEQ + CTXL) / 16; item += nb - skip) {
        if (item < 0) break;
        const bool isctx = item >= SEQ / 16;
        const int L = isctx ? CTXL : SEQ, pos0 = (isctx ? item - SEQ / 16 : item) * 16;
        __syncthreads();
        if (tid < 16 * 17) {
            const int pp = tid / 17, j = tid % 17, pos = pos0 + pp;
            if (j == 16) zf[pp * 36] = (float)pos / (float)(L - 1);
            else { const float f = 1e-4f + (float)j * ((15.0f - 1e-4f) / 15.0f); const float w = 2.0f * 3.14159265358979323846f * (float)pos / (float)L * f; zf[pp * 36 + 1 + j] = cosf(w); zf[pp * 36 + 17 + j] = sinf(w); }
        }
        __syncthreads();
        const int pp = tid >> 5, u0 = (tid & 31) * 2;
        { float a0 = fb1[u0], a1 = fb1[u0 + 1];
#pragma unroll 1
          for (int k = 0; k < 33; ++k) { const float z = zf[pp * 36 + k]; a0 += z * fw1[k * 64 + u0]; a1 += z * fw1[k * 64 + u0 + 1]; }
          h1[pp * 64 + u0] = sinf(freq[u0] * a0); h1[pp * 64 + u0 + 1] = sinf(freq[u0 + 1] * a1); }
        __syncthreads();
        { float a0 = fb2[u0], a1 = fb2[u0 + 1];
#pragma unroll 4
          for (int k = 0; k < 64; ++k) { const float z = h1[pp * 64 + k]; a0 += z * fw2[k * 64 + u0]; a1 += z * fw2[k * 64 + u0 + 1]; }
          h2[pp * 64 + u0] = sinf(freq[u0] * a0); h2[pp * 64 + u0 + 1] = sinf(freq[u0 + 1] * a1); }
        __syncthreads();
        { float a0 = fb3[u0], a1 = fb3[u0 + 1];
#pragma unroll 4
          for (int k = 0; k < 64; ++k) { const float z = h2[pp * 64 + k]; a0 += z * fw3[k * 64 + u0]; a1 += z * fw3[k * 64 + u0 + 1]; }
          h3[pp * 64 + u0] = sinf(freq[u0] * a0); h3[pp * 64 + u0 + 1] = sinf(freq[u0 + 1] * a1); }
        __syncthreads();
#pragma unroll 1
        for (int r = 0; r < 4; ++r) {
            const int col = tid + 512 * r, c = col & 511, od = col >> 9, order = od >> 1, dirn = od & 1;
            float a[16];
#pragma unroll
            for (int i = 0; i < 16; ++i) a[i] = 0.f;
#pragma unroll 1
            for (int k = 0; k < 64; k += 4) { const float w0 = wout[k * 2048 + col], w1 = wout[(k + 1) * 2048 + col], w2 = wout[(k + 2) * 2048 + col], w3 = wout[(k + 3) * 2048 + col];
#pragma unroll
                for (int i = 0; i < 16; ++i) { const float4 hh = *(const float4*)(h3 + i * 64 + k); a[i] += hh.x * w0 + hh.y * w1 + hh.z * w2 + hh.w * w3; } }
            const float delta = 3.0701134573253944f + (float)c * ((15.350567286626972f - 3.0701134573253944f) / 511.0f);
#pragma unroll
            for (int i = 0; i < 16; ++i) a[i] *= expf(-((float)(pos0 + i) / (float)(L - 1)) * delta);
            float* dst = isctx ? FKC + ((size_t)order * 512 + c) * 512 + 256 : FK + ((size_t)order * 512 + c) * 8192 + 4096;
            if (dirn == 0) {
#pragma unroll
                for (int i = 0; i < 16; i += 4) *(float4*)(dst + pos0 + i) = make_float4(a[i], a[i + 1], a[i + 2], a[i + 3]);
            } else {
#pragma unroll
                for (int i = 0; i < 16; ++i) if (pos0 + i > 0) dst[-(pos0 + i)] = a[i];
                if (pos0 == 0) dst[-L] = 0.f;
            }
        }
    }
}

__device__ __forceinline__ void ph_hy_prep(KP p, int l, int bid, int nb, float* sm) {
    const int tid = opaque_tid(), o = l >> 1;
    const bf16_t* P = (const bf16_t*)(p->ws + OFF_BIG);
    bf16_t* UT = (bf16_t*)(p->ws + OFF_UT);
    const float* cw = p->in[I_HCW] + o * 3 * 1536; const float* cb = p->in[I_HCB] + o * 1536;
    float* tile = sm;
#pragma unroll 1
    for (int item = bid; item < (NT / 256) * 24; item += nb) {
        const int tt = item / 24, ct = item % 24, tok0 = tt * 256, col0 = ct * 64;
        const bool lat = tok0 < NL;
        const int L = lat ? SEQ : CTXL, t0 = lat ? (tok0 & (SEQ - 1)) : ((tok0 - NL) & (CTXL - 1));
        __syncthreads();
#pragma unroll 1
        for (int i = tid; i < 258 * 8; i += 512) {
            const int rr = i >> 3, hf = i & 7, t = t0 + rr - 1;
            uint4 v = make_uint4(0u, 0u, 0u, 0u);
            if (t >= 0 && t < L) v = *(const uint4*)(P + (size_t)(tok0 + rr - 1) * ODD_LD + col0 + hf * 8);
            float* d = tile + rr * 65 + hf * 8;
            d[0] = bflo(v.x); d[1] = bfhi(v.x); d[2] = bflo(v.y); d[3] = bfhi(v.y); d[4] = bflo(v.z); d[5] = bfhi(v.z); d[6] = bflo(v.w); d[7] = bfhi(v.w);
        }
        __syncthreads();
#pragma unroll 1
        for (int r = 0; r < 4; ++r) {
            const int cc = (tid >> 5) + 16 * r, tc = (tid & 31) * 8, col = col0 + cc;
            const float w0 = cw[col], w1 = cw[1536 + col], w2 = cw[3072 + col], bb = cb[col];
            float y[8];
#pragma unroll
            for (int i = 0; i < 8; ++i) y[i] = tile[(tc + i) * 65 + cc] * w0 + tile[(tc + i + 1) * 65 + cc] * w1 + tile[(tc + i + 2) * 65 + cc] * w2 + bb;
            *(uint4*)(UT + (size_t)col * NT + tok0 + tc) = make_uint4(cvt_pk_bf16(y[0], y[1]), cvt_pk_bf16(y[2], y[3]), cvt_pk_bf16(y[4], y[5]), cvt_pk_bf16(y[6], y[7]));
        }
    }
}

__device__ __forceinline__ void hy_item_lat(KP p, int l, int c) {
    constexpr int ZSB = (SEQ + 8) * 2;
    constexpr unsigned O_Z = 0, O_PE = O_Z + 8 * ZSB, O_PO = O_PE + 4096 * 4, O_END = O_PO + 4096 * 4;
    static_assert(O_END <= BAR_LDS_, "hyena LDS");
    const int tid = opaque_tid(), lane = tid & 63, wv = __builtin_amdgcn_readfirstlane(tid >> 6), r16 = lane & 15, q4 = lane >> 4, o = l >> 1;
    const unsigned L0 = (unsigned)(size_t)smraw_base();
    const bf16_t* UT = (const bf16_t*)(p->ws + OFF_UT);
    bf16_t* ZOT = (bf16_t*)(p->ws + OFF_ZOT);
    const float* FK = (const float*)(p->ws + OFF_FKS(o));
    for (int i = tid; i < 8 * 512; i += 512) { const int b = i >> 9, ch = i & 511; sc::st16(L0 + O_Z + b * ZSB + ch * 16, *(const uint4*)(UT + (size_t)(1024 + c) * NT + b * SEQ + ch * 8)); }
#pragma unroll 1
    for (int order = 0; order < 2; ++order) {
        const float* fk = FK + ((size_t)order * 512 + c) * 8192;
        for (int i = tid; i < 4096; i += 512) {
            const float r0 = (i > 0) ? fk[8192 - 2 * i] : 0.f, r1 = fk[8191 - 2 * i], r2 = (i < 4095) ? fk[8190 - 2 * i] : 0.f;
            *(LAS unsigned*)(size_t)(L0 + O_PE + i * 4) = cvt_pk_bf16(r0, r1); *(LAS unsigned*)(size_t)(L0 + O_PO + i * 4) = cvt_pk_bf16(r1, r2);
        }
        __syncthreads();
        sc::f32x4 acc[4][4];
#pragma unroll
        for (int a = 0; a < 4; ++a)
#pragma unroll
            for (int b2 = 0; b2 < 4; ++b2) acc[a][b2] = (sc::f32x4){0.f, 0.f, 0.f, 0.f};
        const unsigned gbase = L0 + ((r16 & 1) ? O_PO : O_PE) + (unsigned)(((4096 - r16 + 8 * q4 - (r16 & 1)) >> 1) * 4);
        auto ldG = [&](int g) {
            const unsigned a0 = gbase - (unsigned)(32 * g);
            const unsigned w0 = *(const LAS unsigned*)(size_t)a0, w1 = *(const LAS unsigned*)(size_t)(a0 + 4), w2 = *(const LAS unsigned*)(size_t)(a0 + 8), w3 = *(const LAS unsigned*)(size_t)(a0 + 12);
            return __builtin_bit_cast(sc::bf16x8, (sc::u32x4_){w0, w1, w2, w3});
        };
        sc::bf16x8 bq[4][2], W[6];
#pragma unroll
        for (int i = 0; i < 4; ++i) { bq[i][0] = (sc::bf16x8){0, 0, 0, 0, 0, 0, 0, 0}; bq[i][1] = bq[i][0]; }
        const int D0 = 8 * wv - 63, D1 = (8 * wv + 7 < 63) ? 8 * wv + 7 : 63;
        W[4] = ldG(4 * D0 - 6 + 4); W[5] = ldG(4 * D0 - 6 + 5);
#pragma unroll 1
        for (int D = D0; D <= D1; ++D) {
            W[0] = W[4]; W[1] = W[5];
#pragma unroll
            for (int i = 0; i < 4; ++i) W[2 + i] = ldG(4 * D + i);
            bq[3][0] = bq[2][0]; bq[3][1] = bq[2][1]; bq[2][0] = bq[1][0]; bq[2][1] = bq[1][1]; bq[1][0] = bq[0][0]; bq[1][1] = bq[0][1];
            {
                const int s1 = 8 * wv - D + ((r16 < 8) ? 0 : 4);
                const bool ok = (unsigned)s1 < 64u;
                const unsigned za = L0 + O_Z + (unsigned)((r16 & 7) * ZSB + ((ok ? s1 : 0) * 64 + q4 * 8) * 2);
                sc::bf16x8 b0 = *(const LAS sc::bf16x8*)(size_t)za, b1 = *(const LAS sc::bf16x8*)(size_t)(za + 64);
                if (!ok) { b0 = (sc::bf16x8){0, 0, 0, 0, 0, 0, 0, 0}; b1 = b0; }
                bq[0][0] = b0; bq[0][1] = b1;
            }
#pragma unroll
            for (int cg = 0; cg < 4; ++cg) {
                const int sA = 8 * wv + cg - D;
                if ((unsigned)sA < 64u || (unsigned)(sA + 4) < 64u) {
#pragma unroll
                    for (int it = 0; it < 4; ++it) { acc[cg][it] = SC_MFMA(W[it + 2], bq[cg][0], acc[cg][it]); acc[cg][it] = SC_MFMA(W[it], bq[cg][1], acc[cg][it]); }
                }
            }
        }
        __syncthreads();
        const float sk = p->in[I_HSKIP][o * 1024 + order * 512 + c];
        const bf16_t* gt = UT + (size_t)(order * 512 + c) * NT;
        const int bb = r16 & 7;
#pragma unroll
        for (int cg = 0; cg < 4; ++cg) {
            const int t1 = 8 * wv + cg + ((r16 < 8) ? 0 : 4);
#pragma unroll
            for (int it = 0; it < 4; ++it) {
                const int t = t1 * 64 + it * 16 + q4 * 4;
                const sc::u32x2_ zo_ = *(const LAS sc::u32x2_*)(size_t)(L0 + O_Z + bb * ZSB + t * 2); const uint2 zo = make_uint2(zo_[0], zo_[1]);
                const uint2 gv = *(const uint2*)(gt + bb * SEQ + t);
                const float y0 = bflo(gv.x) * (acc[cg][it][0] + sk * bflo(zo.x)), y1 = bfhi(gv.x) * (acc[cg][it][1] + sk * bfhi(zo.x));
                const float y2 = bflo(gv.y) * (acc[cg][it][2] + sk * bflo(zo.y)), y3 = bfhi(gv.y) * (acc[cg][it][3] + sk * bfhi(zo.y));
                const uint2 w = make_uint2(cvt_pk_bf16(y0, y1), cvt_pk_bf16(y2, y3));
                if (order == 0) sc::st8(L0 + O_Z + bb * ZSB + t * 2, w);
                else *(uint2*)(ZOT + (size_t)c * NT + bb * SEQ + t) = w;
            }
        }
        __syncthreads();
    }
}

__device__ __forceinline__ void hy_item_ctx(KP p, int l, int c, float* sm) {
    const int tid = opaque_tid(), o = l >> 1;
    const bf16_t* UT = (const bf16_t*)(p->ws + OFF_UT);
    bf16_t* ZOT = (bf16_t*)(p->ws + OFF_ZOT);
    const float* FKC = (const float*)(p->ws + OFF_FKS(o)) + (size_t)2 * 512 * 8192;
    float* Kc = sm;
    float* zb = sm + 1024;
    for (int i = tid; i < 1024; i += 512) Kc[i] = FKC[((size_t)(i >> 9) * 512 + c) * 512 + (i & 511)];
    for (int i = tid; i < 8 * CTXL; i += 512) zb[i] = bf2f(UT[(size_t)(1024 + c) * NT + NL + i]);
    __syncthreads();
    const int bb = tid >> 6, tl = tid & 63;
#pragma unroll 1
    for (int order = 0; order < 2; ++order) {
        float acc[4] = {0.f, 0.f, 0.f, 0.f};
#pragma unroll 4
        for (int s = 0; s < CTXL; ++s) {
            const float zv = zb[bb * CTXL + s];
#pragma unroll
            for (int i = 0; i < 4; ++i) acc[i] += Kc[order * 512 + tl + 64 * i - s + 256] * zv;
        }
        const float sk = p->in[I_HSKIP][o * 1024 + order * 512 + c];
        float zn[4];
#pragma unroll
        for (int i = 0; i < 4; ++i) { const int t = tl + 64 * i; zn[i] = bf2f(UT[(size_t)(order * 512 + c) * NT + NL + bb * CTXL + t]) * (acc[i] + zb[bb * CTXL + t] * sk); }
        __syncthreads();
#pragma unroll
        for (int i = 0; i < 4; ++i) { const int t = tl + 64 * i; if (order == 0) zb[bb * CTXL + t] = bf2f((bf16_t)(cvt_pk_bf16(zn[i], 0.f) & 0xffffu)); else stf(ZOT + (size_t)c * NT + NL + bb * CTXL + t, zn[i]); }
        __syncthreads();
    }
}

__device__ __forceinline__ void ph_mix_odd(KP p, int l, int bid, int nb, float* sm) {
    int* head = (int*)(p->ws + OFF_CNT) + 1024 + (l >> 1) * 64;
    LAS int* slot = (LAS int*)(smraw_base() + BAR_LDS_ + 64);
#pragma unroll 1
    for (;;) {
        if (opaque_tid() == 0) *slot = atomicAdd(head, 1);
        __syncthreads();
        const int item = *slot;
        __syncthreads();
        if (item >= 128 + 512) break;
        if (item < 128) { const int b = (item >> 4) & 7, h = (item >> 2) & 3, dir = (item >> 1) & 1, vs = item & 1; sc::scan_item<2>(p, l, b, h, dir, vs); }
        else { const int c = item - 128; hy_item_lat(p, l, c); __syncthreads(); hy_item_ctx(p, l, c, sm); }
        __syncthreads();
    }
}

__device__ __forceinline__ void ph_hy_norm(KP p, int l, int bid, int nb, float* sm) {
    const int tid = opaque_tid(), o = l >> 1;
    const bf16_t* ZOT = (const bf16_t*)(p->ws + OFF_ZOT);
    bf16_t* MIX = (bf16_t*)(p->ws + OFF_U);
    const float* nw = p->in[I_HNORM] + o * 512;
    float* tile = sm;
    float* part = sm + 64 * 65;
#pragma unroll 1
    for (int item = bid; item < (NT / 64) * 8; item += nb) {
        const int tt = item >> 3, g = item & 7, tok0 = tt * 64;
        __syncthreads();
        { const int cc = tid >> 3, ch = tid & 7;
          const uint4 v = *(const uint4*)(ZOT + (size_t)(g * 64 + cc) * NT + tok0 + ch * 8);
          float* d = tile + cc * 65 + ch * 8;
          d[0] = bflo(v.x); d[1] = bfhi(v.x); d[2] = bflo(v.y); d[3] = bfhi(v.y); d[4] = bflo(v.z); d[5] = bfhi(v.z); d[6] = bflo(v.w); d[7] = bfhi(v.w); }
        __syncthreads();
        { const int tk = tid & 63, pt = tid >> 6; float s = 0.f;
#pragma unroll
          for (int i = 0; i < 8; ++i) { const float x = tile[(pt * 8 + i) * 65 + tk]; s += x * x; }
          part[pt * 64 + tk] = s; }
        __syncthreads();
        { const int tk = tid >> 3, ch = tid & 7; float s = 0.f;
#pragma unroll
          for (int i = 0; i < 8; ++i) s += part[i * 64 + tk];
          const float rs = rsqrtf(s * (1.f / 64.f) + LN_EPS);
          float y[8];
#pragma unroll
          for (int i = 0; i < 8; ++i) y[i] = tile[(ch * 8 + i) * 65 + tk] * rs * nw[g * 64 + ch * 8 + i];
          *(uint4*)(MIX + (size_t)(tok0 + tk) * DM + g * 64 + ch * 8) = make_uint4(cvt_pk_bf16(y[0], y[1]), cvt_pk_bf16(y[2], y[3]), cvt_pk_bf16(y[4], y[5]), cvt_pk_bf16(y[6], y[7])); }
    }
}

__device__ __forceinline__ void ph_normgate_odd(KP p, int l, int bid, int nb) {
    const int tid = opaque_tid(), lane = tid & 63, wv = tid >> 6, o2 = l >> 1;
    const bf16_t* P = (const bf16_t*)(p->ws + OFF_BIG);
    const bf16_t* HX = (const bf16_t*)(p->ws + OFF_AUX);
    const bf16_t* HX1 = HX + (size_t)NT * 1024;
    bf16_t* MIX = (bf16_t*)(p->ws + OFF_U);
    const int c16 = 16 * (lane & 31);
    const float* nw = p->in[I_RNW] + o2 * 512 + c16;
#pragma unroll 1
    for (int t2 = bid * 8 + wv; t2 < NT / 2; t2 += nb * 8) {
        const int tok = t2 * 2 + (lane >> 5);
        const size_t o = (size_t)tok * 1024 + 512 + c16;
        head_norm_gate16<true, false>(HX + o, HX1 + o, P + (size_t)tok * ODD_LD + 3072 + c16, nw, MIX + o);
    }
}

__device__ __forceinline__ void ph_ln1_router(KP p, int l, int ntok, int bid, int nb, float* sm) {
    constexpr int VP = (1024 + 8) * 2;
    constexpr unsigned O_VH = 0, O_VL = 32 * VP, O_LG = 64 * VP;
    static_assert(O_LG + 32 * 64 * 4 <= BAR_LDS_, "router LDS");
    const int tid = opaque_tid(), lane = tid & 63, wv = __builtin_amdgcn_readfirstlane(tid >> 6), r16 = lane & 15, q4 = lane >> 4;
    const unsigned L0 = (unsigned)(size_t)smraw_base();
    const bf16_t* Y = (const bf16_t*)(p->ws + OFF_BIG);
    bf16_t* U = (bf16_t*)(p->ws + OFF_U);
    const float* lw = p->in[I_LNW] + (l * 2) * 1024; const float* lb = p->in[I_LNB] + (l * 2) * 1024;
    const bf16_t* RWH = (const bf16_t*)(p->ws + OFF_RWH); const bf16_t* RWL = RWH + 64 * 1024;
    const float rb = p->in[I_RB][l * 64 + lane];
    LAS int* lcnt = (LAS int*)(smraw_base() + BAR_LDS_ + 256);
    if (tid < 64) lcnt[tid] = 0;
    __syncthreads();
    int* tidx = (int*)(p->ws + OFF_TIDX); float* tgate = (float*)(p->ws + OFF_TGATE); int* tpos = (int*)(p->ws + OFF_TPOS);
    {
        int* stok = (int*)(p->ws + OFF_STOK); float* sgate = (float*)(p->ws + OFF_SGATE); int* sdst = (int*)(p->ws + OFF_SDST);
#pragma unroll 1
        for (int i = bid * 512 + tid; i < MAXROWS; i += nb * 512) { stok[i] = ZROW; sgate[i] = 0.f; sdst[i] = -1; }
    }
    const int nfr = (ntok >> 5) / nb, nsteps = nfr + (((ntok >> 5) % nb) ? 1 : 0);
#pragma unroll 1
    for (int step = 0; step < nsteps; ++step) {
        const bool full = step < nfr;
        const int tpw = full ? 4 : 1, base = full ? (step * nb + bid) * 32 : nfr * nb * 32 + bid * 8;
#pragma unroll 2
        for (int j = 0; j < 4; ++j) {
            if (j >= tpw) break;
            const int tl = wv * tpw + j, tok = base + tl;
            float* h = hrow(p, tok);
            const float* m = modrow(p, l, tok);
            const bf16_t* r = Y + (size_t)tok * DM;
            float x[16]; float s = 0.f;
#pragma unroll
            for (int c = 0; c < 4; ++c) {
                const int d = 4 * (lane + 64 * c);
                const float4 hv = *(const float4*)(h + d), gv = *(const float4*)(m + 2 * 1024 + d); const uint2 rw2 = *(const uint2*)(r + d);
                const float4 rv = make_float4(bflo(rw2.x), bfhi(rw2.x), bflo(rw2.y), bfhi(rw2.y));
                x[4 * c] = ALPHA * hv.x + gv.x * rv.x; x[4 * c + 1] = ALPHA * hv.y + gv.y * rv.y; x[4 * c + 2] = ALPHA * hv.z + gv.z * rv.z; x[4 * c + 3] = ALPHA * hv.w + gv.w * rv.w;
                s += x[4 * c] + x[4 * c + 1] + x[4 * c + 2] + x[4 * c + 3];
            }
            const float mean = wave_sum(s) * (1.f / 1024.f);
            float q = 0.f;
#pragma unroll
            for (int i = 0; i < 16; ++i) { x[i] -= mean; q += x[i] * x[i]; }
            const float rs = rsqrtf(wave_sum(q) * (1.f / 1024.f) + LN_EPS);
#pragma unroll
            for (int c = 0; c < 4; ++c) {
                const int d = 4 * (lane + 64 * c);
                const float4 w4 = *(const float4*)(lw + d), b4 = *(const float4*)(lb + d), sh = *(const float4*)(m + 3 * 1024 + d), sc = *(const float4*)(m + 4 * 1024 + d);
                float4 y; y.x = x[4 * c] * rs * w4.x + b4.x; y.y = x[4 * c + 1] * rs * w4.y + b4.y; y.z = x[4 * c + 2] * rs * w4.z + b4.z; y.w = x[4 * c + 3] * rs * w4.w + b4.w;
                *(float4*)(h + d) = y;
                float4 v; v.x = y.x * (1.f + sc.x) + sh.x; v.y = y.y * (1.f + sc.y) + sh.y; v.z = y.z * (1.f + sc.z) + sh.z; v.w = y.w * (1.f + sc.w) + sh.w;
                const unsigned h0 = cvt_pk_bf16(v.x, v.y), h1 = cvt_pk_bf16(v.z, v.w);
                *(uint2*)(U + (size_t)tok * DM + d) = make_uint2(h0, h1);
                sc::st8(L0 + O_VH + tl * VP + d * 2, make_uint2(h0, h1));
                sc::st8(L0 + O_VL + tl * VP + d * 2, make_uint2(cvt_pk_bf16(v.x - bflo(h0), v.y - bfhi(h0)), cvt_pk_bf16(v.z - bflo(h1), v.w - bfhi(h1))));
            }
        }
        __syncthreads();
        {
            const int tt = wv & 1, et = wv >> 1;
            sc::f32x4 acc = (sc::f32x4){0.f, 0.f, 0.f, 0.f};
            const bf16_t* bh = RWH + (size_t)(et * 16 + r16) * 1024 + q4 * 8; const bf16_t* bl = RWL + (size_t)(et * 16 + r16) * 1024 + q4 * 8;
#pragma unroll 4
            for (int ks = 0; ks < 32; ++ks) {
                const sc::bf16x8 ah = sc::rd_row(L0 + O_VH, tt * 16 + r16, VP, ks * 32 + q4 * 8), al = sc::rd_row(L0 + O_VL, tt * 16 + r16, VP, ks * 32 + q4 * 8);
                const sc::bf16x8 wh = *(const sc::bf16x8*)(bh + ks * 32), wl = *(const sc::bf16x8*)(bl + ks * 32);
                acc = SC_MFMA(ah, wh, acc); acc = SC_MFMA(ah, wl, acc); acc = SC_MFMA(al, wh, acc);
            }
#pragma unroll
            for (int jj = 0; jj < 4; ++jj) *(LAS float*)(size_t)(L0 + O_LG + ((tt * 16 + q4 * 4 + jj) * 64 + et * 16 + r16) * 4) = acc[jj];
        }
        __syncthreads();
#pragma unroll 1
        for (int j = 0; j < tpw; ++j) {
            const int tl = wv * tpw + j, tok = base + tl;
            const float lg = *(const LAS float*)(size_t)(L0 + O_LG + (tl * 64 + lane) * 4);
            const float score = sigmoidf_(lg);
            const float key = score + rb;
            int rank = 0;
#pragma unroll
            for (int e = 0; e < 64; ++e) { const float ke = __builtin_bit_cast(float, __builtin_amdgcn_readlane(__builtin_bit_cast(int, key), e)); rank += (ke > key || (ke == key && e < lane)) ? 1 : 0; }
            const bool sel = rank < TOPK;
            const float gsum = wave_sum(sel ? score : 0.f);
            if (sel) {
                const int pos = __hip_atomic_fetch_add(lcnt + lane, 1, __ATOMIC_RELAXED, __HIP_MEMORY_SCOPE_WORKGROUP);
                tidx[tok * 8 + rank] = lane; tgate[tok * 8 + rank] = 2.5f * score / gsum; tpos[tok * 8 + rank] = pos;
            }
        }
        __syncthreads();
    }
    __syncthreads();
    if (tid < 64) ((int*)(p->ws + OFF_BCNT))[bid * 64 + tid] = lcnt[tid];
}

__device__ __forceinline__ void moe_offsets(KP p, int l, int ntok, LAS int* offs) {
    const int t = opaque_tid();
    if (t < 66) offs[t] = ((const int*)(p->ws + OFF_GOFFS))[t];
    __syncthreads();
}
__device__ __forceinline__ int moe_expert_of(const LAS int* offs, int row) { int e = 0;
#pragma unroll 1
    while (e < 64 && row >= offs[e + 1]) ++e;
    return e; }

__device__ __forceinline__ void ph_scatter(KP p, int l, int ntok, int bid, int nb, LAS unsigned char* lds) {
    LAS int* offs = (LAS int*)lds;
    LAS int* myb = offs + 128;
    LAS int* part = offs + 256;
    const int tid = opaque_tid();
    const int* bcnt = (const int*)(p->ws + OFF_BCNT);
    { const int e = tid & 63, pt = tid >> 6; int tot = 0, mine = 0;
#pragma unroll 4
      for (int b = pt; b < nb; b += 8) { const int c = bcnt[b * 64 + e]; tot += c; mine += (b < bid) ? c : 0; }
      part[pt * 64 + e] = tot; part[512 + pt * 64 + e] = mine; }
    __syncthreads();
    if (tid < 64) {
        int tot = 0, mine = 0;
#pragma unroll
        for (int i = 0; i < 8; ++i) { tot += part[i * 64 + tid]; mine += part[512 + i * 64 + tid]; }
        const int pc = (tot + 255) & ~255;
        int incl = pc;
#pragma unroll
        for (int o = 1; o < 64; o <<= 1) { const int t = SHU(incl, o); if (tid >= o) incl += t; }
        offs[tid] = incl - pc; myb[tid] = mine;
        if (tid == 63) { offs[64] = incl; offs[65] = incl + ntok; }
    }
    __syncthreads();
    if (bid == 0 && tid < 66) ((int*)(p->ws + OFF_GOFFS))[tid] = offs[tid];
    const int* tidx = (const int*)(p->ws + OFF_TIDX); const float* tgate = (const float*)(p->ws + OFF_TGATE); const int* tpos = (const int*)(p->ws + OFF_TPOS);
    int* stok = (int*)(p->ws + OFF_STOK); float* sgate = (float*)(p->ws + OFF_SGATE); int* sdst = (int*)(p->ws + OFF_SDST);
    int* tile_e = (int*)(p->ws + OFF_TILEE);
    const int nfr = (ntok >> 5) / nb, nsteps = nfr + (((ntok >> 5) % nb) ? 1 : 0);
#pragma unroll 1
    for (int step = 0; step < nsteps; ++step) {
        const bool full = step < nfr;
        const int ntk = full ? 32 : 8, base = full ? (step * nb + bid) * 32 : nfr * nb * 32 + bid * 8;
        if (tid < ntk * 9) {
            const int tok = base + tid / 9, sl = tid % 9;
            if (sl < 8) { const int i = tok * 8 + sl, e = tidx[i], row = offs[e] + myb[e] + tpos[i]; stok[row] = tok; sgate[row] = tgate[i]; sdst[row] = tok * 9 + sl; }
            else { const int row = offs[64] + tok; stok[row] = tok; sgate[row] = 1.f; sdst[row] = tok * 9 + 8; }
        }
    }
    const int nrt = offs[65] >> 8;
#pragma unroll 1
    for (int rt = bid * 512 + tid; rt < nrt; rt += nb * 512) tile_e[rt] = moe_expert_of(offs, rt * 256);
    __syncthreads();
}

#define MOE_TAB (gp::STAGE_BYTES + 256)
#define MOE_MAXT 9
static_assert(131072 + 256 + 256 + MOE_MAXT * 2048 <= BAR_LDS_, "MoE tables");
struct MoeDeal {
    int nfull, rem, c, G;
    __device__ __forceinline__ void init(int nrt, int c_, int G_) { nfull = nrt / G_; rem = nrt % G_; c = ((c_ & 7) << 5) | (c_ >> 3); G = G_; }
    __device__ __forceinline__ int nleft(int NPN) const { const int tot = rem * NPN; return c < tot ? (tot - c + G - 1) / G : 0; }
    __device__ __forceinline__ int ntiles(int NPN) const { return nfull + nleft(NPN); }
    __device__ __forceinline__ int tile_of(int j, int NPN) const { return j < nfull ? c + j * G : nfull * G + (c + (j - nfull) * G) / NPN; }
    __device__ __forceinline__ bool unit(int i, int NPN, int& j, int& pn) const {
        if (i < nfull * NPN) { j = i / NPN; pn = i % NPN; return true; }
        const int k = i - nfull * NPN, lu = c + k * G;
        if (lu < rem * NPN) { j = nfull + k; pn = lu % NPN; return true; }
        return false;
    }
};
struct Moe1Sched {
    const char* U; const char* W; const LAS int* tabE; const LAS int* tabS; MoeDeal d;
    __device__ __forceinline__ bool next(int i, gp::Unit& u) const {
        int j, pn; if (!d.unit(i, 2, j, pn)) return false;
        u.A = U; u.B = W + (size_t)tabE[j] * (512 * 1024 * 2) + (size_t)pn * (256 * 1024 * 2); u.r0 = d.tile_of(j, 2) * 256; u.c0 = pn * 256; u.aux = j; return true;
    }
    __device__ __forceinline__ void lane_off(const gp::Unit& u, unsigned (&vo)[2][2]) const {
        const int tid = opaque_tid(); int R0, C0, R1, C1; gp::stage_rc(tid * 16, R0, C0); gp::stage_rc(tid * 16 + 8192, R1, C1);
        const LAS int* t = tabS + u.aux * 256;
        vo[0][0] = (unsigned)t[R0] * 2048u + (unsigned)C0 * 2u; vo[0][1] = (unsigned)t[R1] * 2048u + (unsigned)C1 * 2u;
        vo[1][0] = (unsigned)t[128 + R0] * 2048u + (unsigned)C0 * 2u; vo[1][1] = (unsigned)t[128 + R1] * 2048u + (unsigned)C1 * 2u;
    }
};
struct EpiH {
    bf16_t* H;
    __device__ __forceinline__ void operator()(const gp::f32x4 (&acc)[2][2][4][2], const gp::Unit& u, int wr, int wc, int fr, int fq) const {
        const int row0 = u.r0 + wr * 64 + fr;
#pragma unroll
        for (int ai = 0; ai < 2; ++ai)
#pragma unroll
            for (int m = 0; m < 4; ++m) { bf16_t* rowp = H + (size_t)(row0 + ai * 128 + m * 16) * 256;
#pragma unroll
                for (int bj = 0; bj < 2; ++bj) {
                    const int j0 = ((u.c0 + bj * 128 + wc * 32) >> 5) * 16 + 4 * fq;
                    const gp::f32x4 a = acc[ai][bj][m][0], b = acc[ai][bj][m][1];
                    const float h0 = siluf_(a[0]) * b[0], h1 = siluf_(a[1]) * b[1], h2 = siluf_(a[2]) * b[2], h3 = siluf_(a[3]) * b[3];
                    *(uint2*)(rowp + j0) = make_uint2(cvt_pk_bf16(h0, h1), cvt_pk_bf16(h2, h3)); }
                __builtin_amdgcn_sched_barrier(0); }
    }
};
__device__ __forceinline__ void ph_moe1(KP p, int l, int ntok, int bid, int nb, LAS unsigned char* lds) {
    LAS int* tabE = (LAS int*)(lds + MOE_TAB);
    LAS int* tabS = tabE + 64;
    const int tid = opaque_tid();
    MoeDeal d; d.init(((const int*)(p->ws + OFF_GOFFS))[65] >> 8, bid, nb);
    const int nper = d.ntiles(2);
    const int* stok = (const int*)(p->ws + OFF_STOK); const int* tile_e = (const int*)(p->ws + OFF_TILEE);
    for (int i = tid; i < nper * 256; i += 512) tabS[i] = stok[(size_t)d.tile_of(i >> 8, 2) * 256 + (i & 255)];
    if (tid < nper) tabE[tid] = tile_e[d.tile_of(tid, 2)];
    __syncthreads();
    Moe1Sched S{(const char*)(p->ws + OFF_U), (const char*)(p->ws + OFF_W13), tabE, tabS, d};
    EpiH E{(bf16_t*)(p->ws + OFF_BIG)};
    gp::gemm_phase<true, false>(lds, 1024, S, E);
}

struct Moe2Sched {
    const char* H; const char* W; const LAS int* tabE; MoeDeal d;
    __device__ __forceinline__ bool next(int i, gp::Unit& u) const {
        int j, pn; if (!d.unit(i, 4, j, pn)) return false;
        u.A = H + (size_t)d.tile_of(j, 4) * (256 * 256 * 2); u.B = W + (size_t)tabE[j] * (1024 * 256 * 2) + (size_t)pn * (256 * 256 * 2); u.r0 = j * 256; u.c0 = pn * 256; u.aux = j; return true;
    }
    __device__ __forceinline__ void lane_off(const gp::Unit&, unsigned (&)[2][2]) const {}
};
__device__ __forceinline__ unsigned pk_fp8x4(float a, float b, float c, float d) { int w = __builtin_amdgcn_cvt_pk_fp8_f32(a, b, 0, false); w = __builtin_amdgcn_cvt_pk_fp8_f32(c, d, w, true); return (unsigned)w; }
struct EpiY {
    unsigned char* Ys; const LAS int* tabD; const LAS float* tabG;
    __device__ __forceinline__ void operator()(const gp::f32x4 (&acc)[2][2][4][2], const gp::Unit& u, int wr, int wc, int fr, int fq) const {
        const int rl0 = u.r0 + wr * 64 + fr, col0 = u.c0 + wc * 32 + 8 * fq;
#pragma unroll
        for (int ai = 0; ai < 2; ++ai)
#pragma unroll
            for (int m = 0; m < 4; ++m) {
                const int rl = rl0 + ai * 128 + m * 16;
                const int dst = tabD[rl]; const float g = tabG[rl];
                if (dst >= 0) { unsigned char* rowp = Ys + (size_t)dst * 1024 + col0;
#pragma unroll
                    for (int bj = 0; bj < 2; ++bj) { const gp::f32x4 v0 = acc[ai][bj][m][0] * g, v1 = acc[ai][bj][m][1] * g;
                        *(uint2*)(rowp + bj * 128) = make_uint2(pk_fp8x4(v0[0], v0[1], v0[2], v0[3]), pk_fp8x4(v1[0], v1[1], v1[2], v1[3])); } }
                __builtin_amdgcn_sched_barrier(0); }
    }
};
__device__ __forceinline__ void ph_moe2(KP p, int l, int ntok, int bid, int nb, LAS unsigned char* lds) {
    LAS int* tabE = (LAS int*)(lds + MOE_TAB);
    LAS int* tabD = tabE + 64;
    LAS float* tabG = (LAS float*)(tabD + MOE_MAXT * 256);
    const int tid = opaque_tid();
    MoeDeal d; d.init(((const int*)(p->ws + OFF_GOFFS))[65] >> 8, bid, nb);
    const int nper = d.ntiles(4);
    const int* sdst = (const int*)(p->ws + OFF_SDST); const float* sgate = (const float*)(p->ws + OFF_SGATE); const int* tile_e = (const int*)(p->ws + OFF_TILEE);
    for (int i = tid; i < nper * 256; i += 512) { const size_t r = (size_t)d.tile_of(i >> 8, 4) * 256 + (i & 255); tabD[i] = sdst[r]; tabG[i] = sgate[r]; }
    if (tid < nper) tabE[tid] = tile_e[d.tile_of(tid, 4)];
    __syncthreads();
    Moe2Sched S{(const char*)(p->ws + OFF_BIG), (const char*)(p->ws + OFF_W2), tabE, d};
    EpiY E{(unsigned char*)(p->ws + OFF_YS), tabD, tabG};
    gp::gemm_phase<false, true>(lds, 256, S, E);
}

template <bool NEXT>
__device__ __forceinline__ void ph_combine_ln2(KP p, int l, int ntok, int bid, int nb) {
    bf16_t* U = (bf16_t*)(p->ws + OFF_U);
    float* G = (float*)(p->ws + OFF_G);
    const bool gates = NEXT && ((l + 1) & 1) == 0;
    LAS float* wl = (LAS float*)smraw_base();
    if (gates) stage_gate_w(p, (l + 1) >> 1, wl);
    const int tid = opaque_tid(), lane = tid & 63, wv = tid >> 6;
    const unsigned char* Ys = (const unsigned char*)(p->ws + OFF_YS);
    const float* lw = p->in[I_LNW] + (l * 2 + 1) * 1024 + 16 * lane; const float* lb = p->in[I_LNB] + (l * 2 + 1) * 1024 + 16 * lane;
#pragma unroll 1
    for (int tok = bid * 8 + wv; tok < ntok; tok += nb * 8) {
        float* h = hrow(p, tok) + 16 * lane;
        const float* m = modrow(p, l, tok) + 16 * lane;
        const float* m2 = modrow(p, NEXT ? l + 1 : l, tok) + 16 * lane;
        float f[16];
#pragma unroll
        for (int i = 0; i < 16; ++i) f[i] = 0.f;
#pragma unroll
        for (int s9 = 0; s9 < 9; ++s9) {
            const uint4 w = *(const uint4*)(Ys + ((size_t)tok * 9 + s9) * 1024 + 16 * lane);
            const unsigned ww[4] = {w.x, w.y, w.z, w.w};
#pragma unroll
            for (int q = 0; q < 4; ++q) { const f32x2_n lo = __builtin_amdgcn_cvt_pk_f32_fp8((int)ww[q], false), hi = __builtin_amdgcn_cvt_pk_f32_fp8((int)ww[q], true);
                f[4 * q] += lo[0]; f[4 * q + 1] += lo[1]; f[4 * q + 2] += hi[0]; f[4 * q + 3] += hi[1]; }
        }
        float x[16]; float sum = 0.f;
#pragma unroll
        for (int q = 0; q < 4; ++q) {
            const float4 hv = *(const float4*)(h + 4 * q), gv = *(const float4*)(m + 5 * 1024 + 4 * q);
            x[4 * q] = ALPHA * hv.x + gv.x * f[4 * q]; x[4 * q + 1] = ALPHA * hv.y + gv.y * f[4 * q + 1]; x[4 * q + 2] = ALPHA * hv.z + gv.z * f[4 * q + 2]; x[4 * q + 3] = ALPHA * hv.w + gv.w * f[4 * q + 3];
            sum += x[4 * q] + x[4 * q + 1] + x[4 * q + 2] + x[4 * q + 3];
        }
        const float mean = wave_sum(sum) * (1.f / 1024.f);
        float q2 = 0.f;
#pragma unroll
        for (int i = 0; i < 16; ++i) { x[i] -= mean; q2 += x[i] * x[i]; }
        const float rs = rsqrtf(wave_sum(q2) * (1.f / 1024.f) + LN_EPS);
        float u16[16];
#pragma unroll
        for (int q = 0; q < 4; ++q) {
            const float4 w4 = *(const float4*)(lw + 4 * q), b4 = *(const float4*)(lb + 4 * q);
            float4 y; y.x = x[4 * q] * rs * w4.x + b4.x; y.y = x[4 * q + 1] * rs * w4.y + b4.y; y.z = x[4 * q + 2] * rs * w4.z + b4.z; y.w = x[4 * q + 3] * rs * w4.w + b4.w;
            *(float4*)(h + 4 * q) = y;
            if (NEXT) {
                const float4 sh = *(const float4*)(m2 + 4 * q), sc = *(const float4*)(m2 + 1024 + 4 * q);
                u16[4 * q] = y.x * (1.f + sc.x) + sh.x; u16[4 * q + 1] = y.y * (1.f + sc.y) + sh.y; u16[4 * q + 2] = y.z * (1.f + sc.z) + sh.z; u16[4 * q + 3] = y.w * (1.f + sc.w) + sh.w;
            }
        }
        if (NEXT) {
            uint4* up = (uint4*)(U + (size_t)tok * DM + 16 * lane);
            up[0] = make_uint4(cvt_pk_bf16(u16[0], u16[1]), cvt_pk_bf16(u16[2], u16[3]), cvt_pk_bf16(u16[4], u16[5]), cvt_pk_bf16(u16[6], u16[7]));
            up[1] = make_uint4(cvt_pk_bf16(u16[8], u16[9]), cvt_pk_bf16(u16[10], u16[11]), cvt_pk_bf16(u16[12], u16[13]), cvt_pk_bf16(u16[14], u16[15]));
        }
        if (gates) {
            float ga[16];
#pragma unroll
            for (int j = 0; j < 16; ++j) ga[j] = 0.f;
#pragma unroll
            for (int g4 = 0; g4 < 4; ++g4) {
#pragma unroll
                for (int qq = 0; qq < 4; ++qq) {
                    const float uv = u16[4 * g4 + qq];
#pragma unroll
                    for (int j4 = 0; j4 < 4; ++j4) { const f32x4_l w = *(const LAS f32x4_l*)(wl + (16 * lane + 4 * g4 + qq) * 16 + j4 * 4); ga[4 * j4] += uv * w[0]; ga[4 * j4 + 1] += uv * w[1]; ga[4 * j4 + 2] += uv * w[2]; ga[4 * j4 + 3] += uv * w[3]; }
                }
                __builtin_amdgcn_sched_barrier(0);
            }
            float mine = 0.f;
#pragma unroll
            for (int j = 0; j < 16; ++j) { const float sg = wave_sum(ga[j]); if (lane == j) mine = sg; }
            if (lane < 16) G[(size_t)tok * 16 + lane] = mine;
        }
    }
}

#define MEGA_LDS (131072 + 256 + 20480)
#define NBLK 256
#define BAR_LDS BAR_LDS_
#define SYNC() do { XcdBarrier _b; _b.bar = (unsigned*)kparams()->ws; _b.x = xb_xcc_id(); _b.st = (volatile LAS unsigned*)((LAS unsigned char*)smraw_base() + BAR_LDS); xcd_barrier(_b); } while (0)
template <int PAR>
__device__ __forceinline__ void layer_fwd(const int l) {
    LAS unsigned char* lds = smraw_base(); float* sm = (float*)smraw_generic();
    const int bid = blockIdx.x; constexpr int nb = NBLK;
    const int ntok = (l == 3) ? NL : NT;
    ph_gemm_in(kparams(), l, bid, nb, lds); SYNC();
    if (PAR == 0) {
        ph_scan_even2(kparams(), l, bid, nb); SYNC();
        ph_normgate_even(kparams(), l, bid, nb); SYNC();
    } else {
        ph_hy_prep(kparams(), l, bid, nb, sm); SYNC();
        ph_mix_odd(kparams(), l, bid, nb, sm); SYNC();
        ph_hy_norm(kparams(), l, bid, nb, sm); ph_normgate_odd(kparams(), l, bid, nb); SYNC();
    }
    ph_gemm_out(kparams(), l, bid, nb, lds); SYNC();
    ph_ln1_router(kparams(), l, ntok, bid, nb, sm); SYNC();
    ph_scatter(kparams(), l, ntok, bid, nb, lds); SYNC();
    ph_moe1(kparams(), l, ntok, bid, nb, lds); SYNC();
    ph_moe2(kparams(), l, ntok, bid, nb, lds); SYNC();
    if (l < 3) { ph_combine_ln2<true>(kparams(), l, ntok, bid, nb); ph_convert(kparams(), l + 1, bid, nb, sm); SYNC(); }
    else ph_combine_ln2<false>(kparams(), l, ntok, bid, nb);
}
__global__ void __launch_bounds__(512, 2) mega_fwd(Params p) {
    LAS unsigned char* lds = smraw_base(); float* sm = (float*)smraw_generic();
    {
        const int t0 = threadIdx.x;
        if ((t0 & 63) == 0) { unsigned h; asm volatile("s_getreg_b32 %0, hwreg(HW_REG_HW_ID, 0, 6)" : "=s"(h)); *(LAS int*)(size_t)(WTAB_LDS + (h & 63u) * 4u) = t0 >> 6; }
        if (t0 < 4) ((LAS unsigned*)(lds + BAR_LDS))[t0] = 0u;
    }
    __syncthreads();
    (void)xcd_barrier_post((unsigned*)kparams()->ws, (volatile LAS unsigned*)(lds + BAR_LDS));
    const int bid = blockIdx.x; constexpr int nb = NBLK;
    ph_prologue(kparams(), bid, nb, sm);
    __syncthreads();
    ph_hy_filt2(kparams(), 1, bid, nb, sm, 48); __syncthreads(); ph_hy_filt2(kparams(), 3, bid, nb, sm, 48);
    SYNC();
    ph_convert(kparams(), 0, bid, nb, sm); ph_modin(kparams(), 0, bid, nb); SYNC();
#pragma unroll 1
    for (int lp = 0; lp < 2; ++lp) {
        layer_fwd<0>(2 * lp);
        layer_fwd<1>(2 * lp + 1);
    }
    __syncthreads();
    if (blockIdx.x == 0 && opaque_tid() == 0 && xb_ld((unsigned*)kparams()->ws + XB_TMO) != 0u) kparams()->out[0] = __builtin_nanf("");
}

extern "C" void kernel_launch(void* const* d_in, const int* in_sizes, int n_in, void* d_out, int out_size, void* d_ws, size_t ws_size, hipStream_t stream) {
    static int grid = 0;
    if (grid == 0) {
        if (n_in != 38 || out_size != NL * DM || ws_size < WS_END) { fprintf(stderr, "kernel_launch: bad shapes n_in %d out %d ws %zu (need %zu)\n", n_in, out_size, ws_size, (size_t)WS_END); grid = -1; return; }
        int dev = 0, cus = 0, per_cu = 0;
        if (hipGetDevice(&dev) != hipSuccess || hipDeviceGetAttribute(&cus, hipDeviceAttributeMultiprocessorCount, dev) != hipSuccess) { grid = -1; return; }
        if (hipFuncSetAttribute((const void*)mega_fwd, hipFuncAttributeMaxDynamicSharedMemorySize, MEGA_LDS) != hipSuccess) { fprintf(stderr, "kernel_launch: hipFuncSetAttribute failed\n"); grid = -1; return; }
        if (hipOccupancyMaxActiveBlocksPerMultiprocessor(&per_cu, (const void*)mega_fwd, 512, MEGA_LDS) != hipSuccess || per_cu < 1) { fprintf(stderr, "kernel_launch: occupancy query says %d\n", per_cu); (void)hipGetLastError(); grid = -1; return; }
        if (cus != 256) { fprintf(stderr, "kernel_launch: built for 256 CUs, found %d\n", cus); grid = -1; return; }
        grid = NBLK;
    }
    if (grid < 0) return;
    if (hipMemsetAsync(d_ws, 0, OFF_LB, stream) != hipSuccess) return;
    Params p{};
    for (int i = 0; i < 38; ++i) p.in[i] = (const float*)d_in[i];
    p.out = (float*)d_out; p.ws = (unsigned char*)d_ws;
    hipLaunchKernelGGL(mega_fwd, dim3(grid), dim3(512), MEGA_LDS, stream, p);
}
```

```cpp
#include <hip/hip_runtime.h>
#include <stdint.h>
#include <stdio.h>

#define DM 1024
#define NBATCH 8
#define SEQ 4096
#define CTXL 256
#define NL (NBATCH * SEQ)
#define NC (NBATCH * CTXL)
#define NT (NL + NC)
#define ZROW NT
#define TOPK 8
#define EVEN_N 4112
#define ODD_N 3584
#define EVEN_LD 4096
#define ODD_LD 3584
#define MAXROWS (NT * 8 + 64 * 256 + NT)
#define ALPHA 1.681792830507429f
#define LN_EPS 1e-5f
#define E_MQ 0
#define E_MK 256
#define E_MV 512
#define E_MO 1024
#define E_HQ 1536
#define E_HI 2048
#define E_HFF 2560
#define E_HFB 3072
#define E_HG 3584

typedef unsigned short bf16_t;
#define LAS __attribute__((address_space(3)))
#define BAR_LDS_ 150528

#define MiB ((size_t)1 << 20)
#define OFF_CNT   ((size_t)64 << 10)
#define OFF_LB    ((size_t)96 << 10)
#define OFF_MOD   ((size_t)128 << 10)
#define OFF_ROPE  ((size_t)1536 << 10)
#define OFF_BCNT  ((size_t)1600 << 10)
#define OFF_GOFFS ((size_t)1700 << 10)
#define OFF_RWH   ((size_t)2560 << 10)
#define OFF_TILEE (2 * MiB)
#define OFF_HCTX  (4 * MiB)
#define OFF_TIDX  (12 * MiB)
#define OFF_TGATE (14 * MiB)
#define OFF_TPOS  (16 * MiB)
#define OFF_STOK  (18 * MiB)
#define OFF_SGATE (20 * MiB)
#define OFF_SDST  (22 * MiB)
#define OFF_G     (24 * MiB)
#define OFF_U     (28 * MiB)
#define OFF_W     (98 * MiB)
#define OFF_WIN   (OFF_W)
#define OFF_WOUT  (OFF_W + 8 * MiB)
#define OFF_W13   (OFF_W + 10 * MiB)
#define OFF_W2    (OFF_W + 75 * MiB)
#define OFF_BIG   (208 * MiB)
#define OFF_AUX   (480 * MiB)
#define OFF_Z1    (OFF_AUX + 136 * MiB)
#define OFF_Z2    (OFF_Z1 + 68 * MiB)
#define OFF_FILT  (OFF_Z2 + 68 * MiB)
#define OFF_YS    (370 * MiB)
#define WS_END    (1052 * MiB)

struct Params {
    const float* in[38];
    float* out;
    unsigned char* ws;
};

enum { I_X = 0, I_C, I_CTX, I_CCTX, I_ADAW, I_ADAB, I_LNW, I_LNB, I_EWIN, I_MGB, I_MNW, I_HLB, I_HNW, I_EWOUT, I_OWIN, I_HCW, I_HCB,
       I_HW1, I_HB1, I_HW2, I_HB2, I_HW3, I_HB3, I_HFREQ, I_HWOUT, I_HSKIP, I_HNORM, I_RLD, I_RNW, I_OWOUT, I_RW, I_RB, I_W1, I_W3, I_W2, I_SW1, I_SW3, I_SW2 };

typedef const __attribute__((address_space(4))) Params* KP;
__device__ __forceinline__ KP kparams() { KP k = (KP)__builtin_amdgcn_kernarg_segment_ptr(); asm volatile("" : "+s"(k)); return k; }
extern __shared__ __attribute__((aligned(16))) unsigned char smraw_all[];
__device__ __forceinline__ LAS unsigned char* smraw_base() { return (LAS unsigned char*)smraw_all; }
__device__ __forceinline__ unsigned char* smraw_generic() { return smraw_all; }
#define WTAB_LDS (BAR_LDS_ + 512)
__device__ __forceinline__ int opaque_tid() {
    unsigned h; asm volatile("s_getreg_b32 %0, hwreg(HW_REG_HW_ID, 0, 6)" : "=s"(h));
    const int wid = *(volatile LAS int*)(size_t)(WTAB_LDS + (h & 63u) * 4u);
    unsigned m = ~0u; asm volatile("" : "+s"(m));
    const int lane = (int)__builtin_amdgcn_mbcnt_hi(m, __builtin_amdgcn_mbcnt_lo(m, 0u));
    return __builtin_amdgcn_readfirstlane(wid) * 64 + lane;
}
typedef __bf16 bf16x2_n __attribute__((ext_vector_type(2)));
typedef float f32x2_n __attribute__((ext_vector_type(2)));
__device__ __forceinline__ unsigned cvt_pk_bf16(float lo, float hi) { const f32x2_n v = {lo, hi}; return __builtin_bit_cast(unsigned, __builtin_convertvector(v, bf16x2_n)); }
__device__ __forceinline__ float bf2f(bf16_t b) { return __uint_as_float(((unsigned)b) << 16); }
__device__ __forceinline__ float bflo(unsigned w) { return __uint_as_float(w << 16); }
__device__ __forceinline__ float bfhi(unsigned w) { return __uint_as_float(w & 0xffff0000u); }
__device__ __forceinline__ float ldf(const float* p) { return *p; }
__device__ __forceinline__ float ldf(const bf16_t* p) { return bf2f(*p); }
__device__ __forceinline__ void stf(float* p, float v) { *p = v; }
__device__ __forceinline__ void stf(bf16_t* p, float v) { *p = (bf16_t)(cvt_pk_bf16(v, 0.f) & 0xffffu); }
__device__ __forceinline__ float sigmoidf_(float x) { return 1.f / (1.f + expf(-x)); }
__device__ __forceinline__ float siluf_(float x) { return x / (1.f + expf(-x)); }
__device__ __forceinline__ int olane() { unsigned m = ~0u; asm volatile("" : "+s"(m)); return (int)__builtin_amdgcn_mbcnt_hi(m, __builtin_amdgcn_mbcnt_lo(m, 0u)); }
template <class T> __device__ __forceinline__ T shfl_idx(T v, int idx) { return __builtin_bit_cast(T, __builtin_amdgcn_ds_bpermute(idx << 2, __builtin_bit_cast(int, v))); }
#define SHX(v, o) shfl_idx(v, olane() ^ (o))
#define SHI(v, i) shfl_idx(v, (i))
#define SHI32(v, i) shfl_idx(v, (olane() & 32) | ((i) & 31))
#define SHU(v, o) shfl_idx(v, olane() - (o))
__device__ __forceinline__ float fexp(float x) { return __builtin_amdgcn_exp2f(x * 1.4426950408889634f); }
__device__ __forceinline__ float flog(float x) { return __builtin_amdgcn_logf(x) * 0.6931471805599453f; }
__device__ __forceinline__ float frcp(float x) { return __builtin_amdgcn_rcpf(x); }
__device__ __forceinline__ float fsigmoid(float x) { return frcp(1.f + fexp(-x)); }
__device__ __forceinline__ float fsilu(float x) { return x * frcp(1.f + fexp(-x)); }
__device__ __forceinline__ float wave_sum(float v) {
#pragma unroll
    for (int o = 32; o > 0; o >>= 1) v += SHX(v, o);
    return v;
}
__device__ __forceinline__ float* hrow(KP p, int tok) {
    return tok < NL ? p->out + (size_t)tok * DM : (float*)(p->ws + OFF_HCTX) + (size_t)(tok - NL) * DM;
}
__device__ __forceinline__ const float* modrow(KP p, int l, int tok) {
    const int r = tok < NL ? (tok >> 12) : 8;
    return (const float*)(p->ws + OFF_MOD) + ((size_t)l * 9 + r) * 6144;
}
__device__ __forceinline__ int scan_tok(int b, int i, int dir) {
    return i < CTXL ? NL + b * CTXL + (dir ? CTXL - 1 - i : i) : b * SEQ + (dir ? SEQ - 1 - (i - CTXL) : (i - CTXL));
}

#define XB_TMO      128
#define XB_XCNT(j)  (256  + 64 * (j))
#define XB_XSUB(j)  (1280 + 64 * (j))
#define XB_XGEN(j)  (2304 + 64 * (j))
#define XB_TOP      3328
#define XB_TOPGEN   3392
#define XCD_BAR_WORDS 3456
#define XB_SPIN_CAP (1u << 24)
__device__ __forceinline__ unsigned xb_ld(unsigned* p)              { return __hip_atomic_load(p, __ATOMIC_RELAXED, __HIP_MEMORY_SCOPE_AGENT); }
__device__ __forceinline__ unsigned xb_add(unsigned* p, unsigned v) { return __hip_atomic_fetch_add(p, v, __ATOMIC_RELAXED, __HIP_MEMORY_SCOPE_AGENT); }
__device__ __forceinline__ unsigned xb_xcc_id() { return (unsigned)__builtin_amdgcn_s_getreg((3 << 11) | 20) & 0xFu; }
#define XB_SPIN(cond, bar) do { unsigned _sp = 0; while (cond) { __builtin_amdgcn_s_sleep(1); \
    if ((++_sp & 255u) == 0u) { if (xb_ld(&(bar)[XB_TMO])) break; if (_sp > XB_SPIN_CAP) { atomicAdd(&(bar)[XB_TMO], 1u); break; } } } } while (0)
struct XcdBarrier { unsigned* bar; unsigned x; volatile LAS unsigned* st; };
__device__ __forceinline__ XcdBarrier xcd_barrier_post(unsigned* bar, volatile LAS unsigned* st) {
    XcdBarrier b; b.bar = bar; b.x = xb_xcc_id(); b.st = st;
    if (opaque_tid() == 0) (void)xb_add(&bar[XB_XCNT(b.x)], 1u);
    return b;
}
__device__ __forceinline__ void xcd_barrier_complete(unsigned* bar, unsigned x, unsigned& nloc, unsigned& nx) {
    const unsigned G = gridDim.x * gridDim.y * gridDim.z;
    unsigned sum, cnt, mine, sp = 0u;
    for (;;) {
        sum = 0u; cnt = 0u; mine = 0u;
#pragma unroll
        for (unsigned j = 0; j < 16; ++j) { const unsigned c = xb_ld(&bar[XB_XCNT(j)]); sum += c; cnt += (c > 0u) ? 1u : 0u; mine = (j == x) ? c : mine; }
        if (sum == G) break;
        __builtin_amdgcn_s_sleep(1);
        if ((++sp & 255u) == 0u) { if (xb_ld(&bar[XB_TMO])) break; if (sp > XB_SPIN_CAP) { atomicAdd(&bar[XB_TMO], 1u); break; } }
    }
    nloc = mine > 0u ? mine : 1u; nx = cnt > 0u ? cnt : 1u;
}
__device__ __forceinline__ void xcd_barrier(const XcdBarrier& b) {
    asm volatile("s_waitcnt vmcnt(0)" ::: "memory");
    __syncthreads();
    if (opaque_tid() == 0) {
        unsigned* bar = b.bar;
        __builtin_amdgcn_s_waitcnt(0);
        unsigned nloc = b.st[0], nx = b.st[1];
        if (nloc == 0u) { xcd_barrier_complete(bar, b.x, nloc, nx); b.st[0] = nloc; b.st[1] = nx; }
        const unsigned old = xb_add(&bar[XB_XSUB(b.x)], 1u);
        const unsigned gen = old / nloc;
        if (old + 1u == (gen + 1u) * nloc) {
            __builtin_amdgcn_fence(__ATOMIC_RELEASE, "agent");
            asm volatile("s_waitcnt vmcnt(0)" ::: "memory");
            const unsigned og = xb_add(&bar[XB_TOP], 1u);
            const unsigned tg = og / nx;
            if (og + 1u == (tg + 1u) * nx) xb_add(&bar[XB_TOPGEN], 1u);
            else XB_SPIN(xb_ld(&bar[XB_TOPGEN]) == tg, bar);
            __builtin_amdgcn_fence(__ATOMIC_ACQUIRE, "agent");
            xb_add(&bar[XB_XGEN(b.x)], 1u);
            asm volatile("s_waitcnt vmcnt(0)" ::: "memory");
        } else {
            XB_SPIN(xb_ld(&bar[XB_XGEN(b.x)]) == gen, bar);
            __builtin_amdgcn_fence(__ATOMIC_ACQUIRE, "agent");
            asm volatile("s_waitcnt vmcnt(0)" ::: "memory");
        }
    }
    __syncthreads();
}

__device__ __forceinline__ void ph_prologue(KP p, int bid, int nb, float* sm) {
    const int tid = opaque_tid();
    if (bid == 0) {
        bf16_t* z = (bf16_t*)(p->ws + OFF_U) + (size_t)ZROW * DM;
        for (int i = tid; i < DM; i += 512) z[i] = 0;
    }
    if (bid == 1 % nb) {
        float* lb = (float*)(p->ws + OFF_LB);
        const float* hl = p->in[I_HLB];
        for (int j = tid; j < 512; j += 512) {
            const float a = hl[j], b = hl[512 + j], mx = fmaxf(a, b);
            const float ea = expf(a - mx), eb = expf(b - mx);
            lb[j] = 0.f; lb[512 + j] = eb / (ea + eb);
        }
    }
    if (bid == 2 % nb) {
        float2* rt = (float2*)(p->ws + OFF_ROPE);
        for (int i = tid; i < 64 * 32; i += 512) { const float ang = (float)(i >> 5) * powf(10000.f, -(float)(2 * (i & 31)) / 64.f); rt[i] = make_float2(cosf(ang), sinf(ang)); }
    }
    {
        float* act = sm;
        bool filled = false;
        #pragma unroll 1
        for (int item = bid; item < 48; item += nb) {
            if (!filled) {
                for (int i = tid; i < 9 * 1024; i += 512) {
                    const int r = i >> 10, k = i & 1023;
                    const float v = r < 8 ? p->in[I_C][r * 1024 + k] : p->in[I_CCTX][k];
                    act[i] = siluf_(v);
                }
                __syncthreads(); filled = true;
            }
            const int l = item / 12, j = (item % 12) * 512 + tid;
            const float* w = p->in[I_ADAW] + (size_t)l * 1024 * 6144 + j;
            float acc[9];
#pragma unroll
            for (int r = 0; r < 9; ++r) acc[r] = 0.f;
            for (int k = 0; k < 1024; ++k) {
                const float wv = w[(size_t)k * 6144];
#pragma unroll
                for (int r = 0; r < 9; ++r) acc[r] += act[r * 1024 + k] * wv;
            }
            const float bv = p->in[I_ADAB][l * 6144 + j];
            float* mod = (float*)(p->ws + OFF_MOD);
#pragma unroll
            for (int r = 0; r < 9; ++r) mod[((size_t)l * 9 + r) * 6144 + j] = acc[r] + bv;
        }
    }
}


struct CvtTile { const float* src; int srcld; bf16_t* dst; int dstld; int k0, n0; };
__device__ __forceinline__ CvtTile cvt_tile_of(KP p, int l, int t, int np4  ) {
    const bool even = (l & 1) == 0;
    const int NP = even ? EVEN_LD : ODD_LD;
    const int t_in = 16 * (NP / 128), t_out = 16 * 8, t_13 = 65 * 16 * 4;
    CvtTile c;
    if (t < t_in) {
        const int kt = t & 15, nt = t >> 4, n = nt * 128 + np4;
        const float* W = even ? p->in[I_EWIN] + (size_t)(l >> 1) * 1024 * EVEN_N : p->in[I_OWIN] + (size_t)(l >> 1) * 1024 * ODD_N;
        c.src = W + ((even && n >= 1536) ? n + 16 : n); c.srcld = even ? EVEN_N : ODD_N; c.dst = (bf16_t*)(p->ws + OFF_WIN); c.dstld = 1024; c.k0 = kt * 64; c.n0 = nt * 128;
    } else if (t < t_in + t_out) {
        const int u = t - t_in, kt = u & 15, nt = u >> 4;
        c.src = (even ? p->in[I_EWOUT] : p->in[I_OWOUT]) + (size_t)(l >> 1) * 1024 * 1024 + nt * 128 + np4; c.srcld = 1024; c.dst = (bf16_t*)(p->ws + OFF_WOUT); c.dstld = 1024; c.k0 = kt * 64; c.n0 = nt * 128;
    } else if (t < t_in + t_out + t_13) {
        const int u = t - t_in - t_out, e = u >> 6, kt = u & 15, nt = (u >> 4) & 3, n = nt * 128 + np4, g = n >> 5, w = n & 31;
        const float* w1 = e < 64 ? p->in[I_W1] + ((size_t)l * 64 + e) * 1024 * 256 : p->in[I_SW1] + (size_t)l * 1024 * 256;
        const float* w3 = e < 64 ? p->in[I_W3] + ((size_t)l * 64 + e) * 1024 * 256 : p->in[I_SW3] + (size_t)l * 1024 * 256;
        c.src = w < 16 ? w1 + 16 * g + w : w3 + 16 * g + w - 16; c.srcld = 256; c.dst = (bf16_t*)(p->ws + OFF_W13) + (size_t)e * 512 * 1024; c.dstld = 1024; c.k0 = kt * 64; c.n0 = nt * 128;
    } else {
        const int u = t - t_in - t_out - t_13, e = u >> 5, kt = u & 3, nt = (u >> 2) & 7;
        const float* w2 = e < 64 ? p->in[I_W2] + ((size_t)l * 64 + e) * 256 * 1024 : p->in[I_SW2] + (size_t)l * 256 * 1024;
        c.src = w2 + nt * 128 + np4; c.srcld = 1024; c.dst = (bf16_t*)(p->ws + OFF_W2) + (size_t)e * 1024 * 256; c.dstld = 256; c.k0 = kt * 64; c.n0 = nt * 128;
    }
    return c;
}
__device__ __forceinline__ void ph_convert(KP p, int l, int bid, int nb, float* sm) {
    const int tid = opaque_tid();
    const int NP = ((l & 1) == 0) ? EVEN_LD : ODD_LD;
    const int total = 16 * (NP / 128) + 16 * 8 + 65 * 16 * 4 + 65 * 4 * 8;
    const int kr = tid >> 5, np4 = (tid & 31) * 4;
    float4 v[4];
    int t = bid;
    CvtTile c = cvt_tile_of(p, l, t < total ? t : 0, np4);
    if (t < total) {
#pragma unroll
        for (int j = 0; j < 4; ++j) v[j] = *(const float4*)(c.src + (size_t)(c.k0 + kr + 16 * j) * c.srcld);
    }
#pragma unroll 1
    for (; t < total; t += nb) {
        __syncthreads();
#pragma unroll
        for (int j = 0; j < 4; ++j) { float* d = sm + (np4) * 65 + kr + 16 * j; d[0] = v[j].x; d[65] = v[j].y; d[130] = v[j].z; d[195] = v[j].w; }
        const CvtTile cur = c;
        const int tn = t + nb;
        if (tn < total) {
            c = cvt_tile_of(p, l, tn, np4);
#pragma unroll
            for (int j = 0; j < 4; ++j) v[j] = *(const float4*)(c.src + (size_t)(c.k0 + kr + 16 * j) * c.srcld);
        }
        __syncthreads();
        const int n = tid >> 2, kc = (tid & 3) * 16;
        unsigned w[8];
#pragma unroll
        for (int q = 0; q < 8; ++q) w[q] = cvt_pk_bf16(sm[n * 65 + kc + 2 * q], sm[n * 65 + kc + 2 * q + 1]);
        uint4* d4 = (uint4*)(cur.dst + (size_t)(cur.n0 + n) * cur.dstld + cur.k0 + kc);
        d4[0] = make_uint4(w[0], w[1], w[2], w[3]); d4[1] = make_uint4(w[4], w[5], w[6], w[7]);
    }
    __syncthreads();
    if (bid < 8) {
        const float* rw = p->in[I_RW] + (size_t)l * 1024 * 64;
        bf16_t* hi = (bf16_t*)(p->ws + OFF_RWH); bf16_t* lo = hi + 64 * 1024;
        const int e = tid & 63, kb = bid * 128 + (tid >> 6) * 16;
#pragma unroll
        for (int i = 0; i < 16; i += 2) {
            const float x0 = rw[(size_t)(kb + i) * 64 + e], x1 = rw[(size_t)(kb + i + 1) * 64 + e];
            const unsigned h = cvt_pk_bf16(x0, x1);
            const unsigned lw = cvt_pk_bf16(x0 - bflo(h), x1 - bfhi(h));
            *(unsigned*)(hi + (size_t)e * 1024 + kb + i) = h; *(unsigned*)(lo + (size_t)e * 1024 + kb + i) = lw;
        }
    }
}

namespace gp {
typedef short bf16x8 __attribute__((ext_vector_type(8)));
typedef float f32x4 __attribute__((ext_vector_type(4)));
typedef unsigned u32x4 __attribute__((ext_vector_type(4)));
typedef unsigned u32x2 __attribute__((ext_vector_type(2)));
constexpr int BM = 256, BK = 64, HALF = 128, HTB = HALF * BK * 2, STAGE_BYTES = 8 * HTB, NXCD = 8, WGM = 8;
__device__ __forceinline__ int lds_byte(int r, int c) { const int st = (r >> 4) * 2 + (c >> 5), rr = r & 15, cc = c & 31, ob = rr * 64 + cc * 2; return st * 1024 + (ob ^ (((ob >> 9) & 1) << 5)); }
__device__ __forceinline__ void stage_rc(int b, int& R, int& C) { const int st = b / 1024, sb = b % 1024, swz = sb ^ (((sb >> 9) & 1) << 5); R = (st >> 1) * 16 + swz / 64; C = (st & 1) * 32 + (swz % 64) / 2; }
__device__ __forceinline__ int perm32(int rho) { const int n = rho >> 4, i = rho & 15; return 8 * (i >> 2) + 4 * n + (i & 3); }

struct Unit { const char* A; const char* B; int r0, c0, aux; };

struct DenseSched {
    const char* A; const char* B; int nM, nN, nwg, G, c; size_t tstep;
    __device__ __forceinline__ void init(const void* A_, const void* B_, int M, int N, int K, int G_, int c_) { A = (const char*)A_; B = (const char*)B_; nM = M / BM; nN = N / BM; nwg = nM * nN; G = G_; c = c_; tstep = (size_t)BM * K * 2; }
    __device__ __forceinline__ bool next(int i, Unit& u) const {
        const long L = (long)i * G + c; if (L >= nwg) return false;
        int wgid = (int)L; { const int q = nwg / NXCD, r = nwg % NXCD, xcd = wgid % NXCD, off = wgid / NXCD; wgid = (xcd < r ? xcd * (q + 1) : r * (q + 1) + (xcd - r) * q) + off; }
        const int nig = WGM * nN, gid = wgid / nig, fm = gid * WGM, gsz = (nM - fm) < WGM ? (nM - fm) : WGM;
        const int pm = fm + ((wgid % nig) % gsz), pn = (wgid % nig) / gsz;
        u.A = A + (size_t)pm * tstep; u.B = B + (size_t)pn * tstep; u.r0 = pm * BM; u.c0 = pn * BM; u.aux = 0; return true;
    }
    __device__ __forceinline__ void lane_off(const Unit&, unsigned (&)[2][2]) const {}
};

template <bool GATHER, bool PERM, class Sched, class Epi>
__device__ __forceinline__ void gemm_phase(LAS unsigned char* lds, const int K_, const Sched& S, const Epi& E) {
    int K = K_; asm volatile("" : "+s"(K));
    const int tid = opaque_tid(), wid = __builtin_amdgcn_readfirstlane(tid >> 6), lane = tid & 63, wr = wid >> 2, wc = wid & 3, fr = lane & 15, fq = lane >> 4;
    const int nt = K / BK;
    unsigned voffA[2], voffB[2];
#pragma unroll
    for (int i = 0; i < 2; ++i) { int R, C; stage_rc(tid * 16 + i * 8192, R, C); const int Rb = PERM ? ((R & ~31) + perm32(R & 31)) : R;
        voffA[i] = (unsigned)(R * K + C) * 2u; voffB[i] = (unsigned)(Rb * K + C) * 2u; }
    const size_t kstep = (size_t)(BK * 2);
    const size_t hstep = (size_t)HALF * K * 2;
    const unsigned ldsw = (unsigned)wid * 1024u;
    const int aoff = lds_byte(wr * 64 + fr, fq * 8), boff = lds_byte(wc * 32 + fr, fq * 8);
    unsigned cvo[2][2] = {{0u, 0u}, {0u, 0u}}, nvo[2][2] = {{0u, 0u}, {0u, 0u}};
#define GP_SA(b, h) (((b) * 2 + (h)) * HTB)
#define GP_SB(b, h) ((4 + (b) * 2 + (h)) * HTB)
#define GP_GLDS(gp_, lp_) __builtin_amdgcn_global_load_lds((const unsigned*)(gp_), (LAS unsigned*)(lp_), 16, 0, 0)
#define GP_STAGE_B(bufoff, gbase, h) do { const char* _g = (gbase) + (size_t)(h) * hstep; \
        GP_GLDS(_g + voffB[0], lds + (bufoff) + ldsw); GP_GLDS(_g + voffB[1], lds + (bufoff) + ldsw + 8192); } while (0)
#define GP_STAGE_A(bufoff, gbase, h, usenext) do { \
        if (GATHER) { const unsigned _o0 = (usenext) ? nvo[h][0] : cvo[h][0], _o1 = (usenext) ? nvo[h][1] : cvo[h][1]; \
            GP_GLDS((gbase) + _o0, lds + (bufoff) + ldsw); GP_GLDS((gbase) + _o1, lds + (bufoff) + ldsw + 8192); } \
        else { const char* _g = (gbase) + (size_t)(h) * hstep; GP_GLDS(_g + voffA[0], lds + (bufoff) + ldsw); GP_GLDS(_g + voffA[1], lds + (bufoff) + ldsw + 8192); } } while (0)
#define GP_LDA(dst, b, h) do { _Pragma("unroll") for (int m = 0; m < 4; ++m) _Pragma("unroll") for (int k = 0; k < 2; ++k) dst[m][k] = *(const LAS bf16x8*)(lds + GP_SA(b, h) + aoff + m * 2048 + k * 1024); } while (0)
#define GP_LDB(dst, b, h) do { _Pragma("unroll") for (int n = 0; n < 2; ++n) _Pragma("unroll") for (int k = 0; k < 2; ++k) dst[n][k] = *(const LAS bf16x8*)(lds + GP_SB(b, h) + boff + n * 2048 + k * 1024); } while (0)
#define GP_MMA(ai, bj, At, Bt) do { __builtin_amdgcn_s_setprio(1); _Pragma("unroll") for (int m = 0; m < 4; ++m) _Pragma("unroll") for (int n = 0; n < 2; ++n) _Pragma("unroll") for (int k = 0; k < 2; ++k) \
        acc[ai][bj][m][n] = __builtin_amdgcn_mfma_f32_16x16x32_bf16(Bt[n][k], At[m][k], acc[ai][bj][m][n], 0, 0, 0); __builtin_amdgcn_s_setprio(0); } while (0)
#define GP_WAIT_V(n) asm volatile("s_waitcnt vmcnt(" #n ")" ::: "memory")
#define GP_WAIT_L(n) asm volatile("s_waitcnt lgkmcnt(" #n ")" ::: "memory")
#define GP_BAR __builtin_amdgcn_s_barrier()
#define GP_SCHED __builtin_amdgcn_sched_barrier(0)
    Unit cur, nxt; int ui = 0;
    if (!S.next(0, cur)) return;
    f32x4 acc[2][2][4][2];
#pragma unroll
    for (int a = 0; a < 2; ++a)
#pragma unroll
        for (int b = 0; b < 2; ++b)
#pragma unroll
            for (int m = 0; m < 4; ++m)
#pragma unroll
                for (int n = 0; n < 2; ++n) acc[a][b][m][n] = (f32x4){0.f, 0.f, 0.f, 0.f};
    bf16x8 At[4][2], B0[2][2], B1[2][2];
    if (GATHER) S.lane_off(cur, cvo);
    const char* cA = cur.A; const char* cB = cur.B;
    GP_STAGE_B(GP_SB(0, 0), cB, 0); GP_STAGE_A(GP_SA(0, 0), cA, 0, false); GP_STAGE_B(GP_SB(0, 1), cB, 1); GP_STAGE_A(GP_SA(0, 1), cA, 1, false);
    if (wr == 1) GP_BAR;
    GP_WAIT_V(4); GP_BAR;
    GP_STAGE_B(GP_SB(1, 0), cB + kstep, 0); GP_STAGE_A(GP_SA(1, 0), cA + kstep, 0, false); GP_STAGE_B(GP_SB(1, 1), cB + kstep, 1);
    GP_WAIT_V(6); GP_BAR;
    for (;;) {
        const bool has_next = S.next(ui + 1, nxt);
        if (GATHER && has_next) S.lane_off(nxt, nvo);
        const char* nA = has_next ? nxt.A : cA; const char* nB = has_next ? nxt.B : cB;
        for (int t = 0; t < nt; t += 2) {
            const bool last = (t == nt - 2);
            const bool un = last && has_next;
            const char* a1 = cA + (size_t)(t + 1) * kstep;
            const char* a2 = last ? nA : cA + (size_t)(t + 2) * kstep; const char* b2 = last ? nB : cB + (size_t)(t + 2) * kstep;
            const char* a3 = a2 + kstep; const char* b3 = b2 + kstep;
            GP_LDB(B0, 0, 0); GP_SCHED; GP_LDA(At, 0, 0); GP_STAGE_A(GP_SA(1, 1), a1, 1, false);
            GP_WAIT_L(8); GP_BAR; GP_WAIT_L(0); GP_MMA(0, 0, At, B0); GP_BAR; GP_SCHED;
            GP_LDB(B1, 0, 1); GP_STAGE_B(GP_SB(0, 0), b2, 0);
            GP_BAR; GP_WAIT_L(0); GP_MMA(0, 1, At, B1); GP_BAR;
            GP_LDA(At, 0, 1); GP_STAGE_A(GP_SA(0, 0), a2, 0, un);
            GP_BAR; GP_WAIT_L(0); GP_MMA(1, 0, At, B0); GP_BAR; GP_SCHED;
            GP_STAGE_B(GP_SB(0, 1), b2, 1);
            GP_WAIT_V(6); GP_BAR; GP_MMA(1, 1, At, B1); GP_BAR;
            GP_LDB(B0, 1, 0); GP_SCHED; GP_LDA(At, 1, 0); GP_STAGE_A(GP_SA(0, 1), a2, 1, un);
            GP_WAIT_L(8); GP_BAR; GP_WAIT_L(0); GP_MMA(0, 0, At, B0); GP_BAR; GP_SCHED;
            GP_LDB(B1, 1, 1); GP_STAGE_B(GP_SB(1, 0), b3, 0);
            GP_BAR; GP_WAIT_L(0); GP_MMA(0, 1, At, B1); GP_BAR;
            GP_LDA(At, 1, 1); GP_STAGE_A(GP_SA(1, 0), a3, 0, un);
            GP_BAR; GP_WAIT_L(0); GP_MMA(1, 0, At, B0); GP_BAR; GP_SCHED;
            GP_STAGE_B(GP_SB(1, 1), b3, 1);
            GP_WAIT_V(6); GP_BAR; GP_MMA(1, 1, At, B1); GP_BAR;
        }
        E(acc, cur, wr, wc, fr, fq);
        if (!has_next) break;
#pragma unroll
        for (int a = 0; a < 2; ++a)
#pragma unroll
            for (int b = 0; b < 2; ++b)
#pragma unroll
                for (int m = 0; m < 4; ++m)
#pragma unroll
                    for (int n = 0; n < 2; ++n) acc[a][b][m][n] = (f32x4){0.f, 0.f, 0.f, 0.f};
        cur = nxt; cA = nA; cB = nB; ++ui;
        if (GATHER) { cvo[0][0] = nvo[0][0]; cvo[0][1] = nvo[0][1]; cvo[1][0] = nvo[1][0]; cvo[1][1] = nvo[1][1]; }
    }
    GP_WAIT_V(0);
    if (wr == 0) GP_BAR;
    GP_BAR;
#undef GP_SA
#undef GP_SB
#undef GP_GLDS
#undef GP_STAGE_A
#undef GP_STAGE_B
#undef GP_LDA
#undef GP_LDB
#undef GP_MMA
#undef GP_WAIT_V
#undef GP_WAIT_L
#undef GP_BAR
#undef GP_SCHED
}

struct EpiF32 {
    float* C; int ldc;
    __device__ __forceinline__ void operator()(const f32x4 (&acc)[2][2][4][2], const Unit& u, int wr, int wc, int fr, int fq) const {
        const int row0 = u.r0 + wr * 64 + fr, col0 = u.c0 + wc * 32 + 4 * fq;
#pragma unroll
        for (int ai = 0; ai < 2; ++ai)
#pragma unroll
            for (int m = 0; m < 4; ++m) { float* rowp = C + (size_t)(row0 + ai * HALF + m * 16) * ldc + col0;
#pragma unroll
                for (int bj = 0; bj < 2; ++bj)
#pragma unroll
                    for (int n = 0; n < 2; ++n) *(f32x4*)(rowp + bj * HALF + n * 16) = acc[ai][bj][m][n];
                __builtin_amdgcn_sched_barrier(0); }
    }
};
struct EpiBf16 {
    bf16_t* O; int ldc;
    __device__ __forceinline__ void operator()(const f32x4 (&acc)[2][2][4][2], const Unit& u, int wr, int wc, int fr, int fq) const {
        const int row0 = u.r0 + wr * 64 + fr, col0 = u.c0 + wc * 32 + 8 * fq;
#pragma unroll
        for (int ai = 0; ai < 2; ++ai)
#pragma unroll
            for (int m = 0; m < 4; ++m) { bf16_t* rowp = O + (size_t)(row0 + ai * HALF + m * 16) * ldc + col0;
#pragma unroll
                for (int bj = 0; bj < 2; ++bj) { const f32x4 v0 = acc[ai][bj][m][0], v1 = acc[ai][bj][m][1];
                    u32x4 w; w.x = cvt_pk_bf16(v0[0], v0[1]); w.y = cvt_pk_bf16(v0[2], v0[3]); w.z = cvt_pk_bf16(v1[0], v1[1]); w.w = cvt_pk_bf16(v1[2], v1[3]);
                    *(u32x4*)(rowp + bj * HALF) = w; }
                __builtin_amdgcn_sched_barrier(0); }
    }
};
}


typedef float f32x4_l __attribute__((ext_vector_type(4)));
__device__ __forceinline__ void stage_gate_w(KP p, int e, LAS float* wl) {
    const int tid = opaque_tid();
    const float* wg = p->in[I_EWIN] + (size_t)e * 1024 * EVEN_N + 1536;
#pragma unroll
    for (int i = 0; i < 8; ++i) { const int idx = tid + 512 * i, d = idx >> 2, j4 = idx & 3; const float4 w = *(const float4*)(wg + (size_t)d * EVEN_N + j4 * 4); *(LAS f32x4_l*)(wl + d * 16 + j4 * 4) = (f32x4_l){w.x, w.y, w.z, w.w}; }
    __syncthreads();
}
template <bool FIRST>
__device__ __forceinline__ void ph_modin(KP p, int l, int bid, int nb) {
    const int tid = opaque_tid(), lane = tid & 63, wv = tid >> 6;
    const bool even = (l & 1) == 0;
    bf16_t* U = (bf16_t*)(p->ws + OFF_U);
    float* G = (float*)(p->ws + OFF_G);
    LAS float* wl = (LAS float*)smraw_base();
    if (even) stage_gate_w(p, l >> 1, wl);
    #pragma unroll 1
    for (int tok = bid * 8 + wv; tok < NT; tok += nb * 8) {
        float* hw = hrow(p, tok);
        const float* h = FIRST ? (tok < NL ? p->in[I_X] + (size_t)tok * DM : p->in[I_CTX] + (size_t)(tok - NL) * DM) : hw;
        const float* m = modrow(p, l, tok);
        float ga[16];
#pragma unroll
        for (int j = 0; j < 16; ++j) ga[j] = 0.f;
#pragma unroll
        for (int c = 0; c < 4; ++c) {
            const int d = 4 * (lane + 64 * c);
            const float4 hv = *(const float4*)(h + d), sh = *(const float4*)(m + d), sc = *(const float4*)(m + 1024 + d);
            if (FIRST) *(float4*)(hw + d) = hv;
            const float u0 = hv.x * (1.f + sc.x) + sh.x, u1 = hv.y * (1.f + sc.y) + sh.y, u2 = hv.z * (1.f + sc.z) + sh.z, u3 = hv.w * (1.f + sc.w) + sh.w;
            *(uint2*)(U + (size_t)tok * DM + d) = make_uint2(cvt_pk_bf16(u0, u1), cvt_pk_bf16(u2, u3));
            if (even) {
                const float uu[4] = {u0, u1, u2, u3};
#pragma unroll
                for (int q = 0; q < 4; ++q) {
#pragma unroll
                    for (int j4 = 0; j4 < 4; ++j4) { const f32x4_l w = *(const LAS f32x4_l*)(wl + (d + q) * 16 + j4 * 4); ga[4 * j4] += uu[q] * w[0]; ga[4 * j4 + 1] += uu[q] * w[1]; ga[4 * j4 + 2] += uu[q] * w[2]; ga[4 * j4 + 3] += uu[q] * w[3]; }
                }
                __builtin_amdgcn_sched_barrier(0);
            }
        }
        if (even) {
            float mine = 0.f;
#pragma unroll
            for (int j = 0; j < 16; ++j) { const float s = wave_sum(ga[j]); if (lane == j) mine = s; }
            if (lane < 16) G[(size_t)tok * 16 + lane] = mine;
        }
    }
}

__device__ __forceinline__ void ph_gemm_in(KP p, int l, int bid, int nb, LAS unsigned char* lds) {
    const int N = ((l & 1) == 0) ? EVEN_LD : ODD_LD;
    gp::DenseSched S; S.init(p->ws + OFF_U, p->ws + OFF_WIN, NT, N, 1024, nb, bid);
    gp::EpiBf16 E{(bf16_t*)(p->ws + OFF_BIG), N};
    gp::gemm_phase<false, true>(lds, 1024, S, E);
}
__device__ __forceinline__ void ph_gemm_out(KP p, int l, int bid, int nb, LAS unsigned char* lds) {
    gp::DenseSched S; S.init(p->ws + OFF_U, p->ws + OFF_WOUT, (l == 3) ? NL : NT, 1024, 1024, nb, bid);
    gp::EpiBf16 E{(bf16_t*)(p->ws + OFF_BIG), 1024};
    gp::gemm_phase<false, true>(lds, 1024, S, E);
}


namespace sc {
typedef short bf16x8 __attribute__((ext_vector_type(8)));
typedef short bf16x4 __attribute__((ext_vector_type(4)));
typedef float f32x4 __attribute__((ext_vector_type(4)));
#define SC_MFMA(a, b, c) __builtin_amdgcn_mfma_f32_16x16x32_bf16(a, b, c, 0, 0, 0)
__device__ __forceinline__ bf16x8 rd_row(unsigned img, int row, int stride, int k0) { return *(const LAS bf16x8*)(size_t)(img + (unsigned)(row * stride + k0 * 2)); }
__device__ __forceinline__ bf16x8 rd_tr(unsigned img, int k0, int n0, int stride, int lane) {
    const int g = lane >> 4, i = lane & 15;
    const unsigned a0 = img + (unsigned)((k0 + 8 * g + (i >> 2)) * stride + (n0 + 4 * (i & 3)) * 2), a1 = a0 + 4u * (unsigned)stride;
    bf16x4 lo, hi;
    asm volatile("ds_read_b64_tr_b16 %0, %2\n\tds_read_b64_tr_b16 %1, %3\n\ts_waitcnt lgkmcnt(0)" : "=&v"(lo), "=&v"(hi) : "v"(a0), "v"(a1) : "memory");
    return (bf16x8){lo[0], lo[1], lo[2], lo[3], hi[0], hi[1], hi[2], hi[3]};
}
typedef unsigned u32x2_ __attribute__((ext_vector_type(2)));
typedef unsigned u32x4_ __attribute__((ext_vector_type(4)));
__device__ __forceinline__ unsigned tr_addr(unsigned img, int k0, int n0, int stride, int lane) { const int g = lane >> 4, i = lane & 15; return img + (unsigned)((k0 + 8 * g + (i >> 2)) * stride + (n0 + 4 * (i & 3)) * 2); }
__device__ __forceinline__ void rd_tr5(const unsigned (&a0)[5], const unsigned (&s4)[5], bf16x8 (&o)[5]) {
    bf16x4 l0, h0, l1, h1, l2, h2, l3, h3, l4, h4;
    asm volatile("ds_read_b64_tr_b16 %0, %10\n\tds_read_b64_tr_b16 %1, %11\n\tds_read_b64_tr_b16 %2, %12\n\tds_read_b64_tr_b16 %3, %13\n\tds_read_b64_tr_b16 %4, %14\n\t"
                 "ds_read_b64_tr_b16 %5, %15\n\tds_read_b64_tr_b16 %6, %16\n\tds_read_b64_tr_b16 %7, %17\n\tds_read_b64_tr_b16 %8, %18\n\tds_read_b64_tr_b16 %9, %19\n\ts_waitcnt lgkmcnt(0)"
                 : "=&v"(l0), "=&v"(h0), "=&v"(l1), "=&v"(h1), "=&v"(l2), "=&v"(h2), "=&v"(l3), "=&v"(h3), "=&v"(l4), "=&v"(h4)
                 : "v"(a0[0]), "v"(a0[0] + s4[0]), "v"(a0[1]), "v"(a0[1] + s4[1]), "v"(a0[2]), "v"(a0[2] + s4[2]), "v"(a0[3]), "v"(a0[3] + s4[3]), "v"(a0[4]), "v"(a0[4] + s4[4]) : "memory");
    o[0] = (bf16x8){l0[0], l0[1], l0[2], l0[3], h0[0], h0[1], h0[2], h0[3]}; o[1] = (bf16x8){l1[0], l1[1], l1[2], l1[3], h1[0], h1[1], h1[2], h1[3]};
    o[2] = (bf16x8){l2[0], l2[1], l2[2], l2[3], h2[0], h2[1], h2[2], h2[3]}; o[3] = (bf16x8){l3[0], l3[1], l3[2], l3[3], h3[0], h3[1], h3[2], h3[3]};
    o[4] = (bf16x8){l4[0], l4[1], l4[2], l4[3], h4[0], h4[1], h4[2], h4[3]};
}
__device__ __forceinline__ void st8(unsigned addr, uint2 v) { *(LAS u32x2_*)(size_t)addr = (u32x2_){v.x, v.y}; }
__device__ __forceinline__ void st16(unsigned addr, uint4 v) { *(LAS u32x4_*)(size_t)addr = (u32x4_){v.x, v.y, v.z, v.w}; }
#define SC_DPP(v, ident, ctrl, rmask) __builtin_bit_cast(float, __builtin_amdgcn_update_dpp(__builtin_bit_cast(int, (float)(ident)), __builtin_bit_cast(int, v), ctrl, rmask, 0xf, false))
__device__ __forceinline__ float scan_add64(float v, int) {
    v += SC_DPP(v, 0.f, 0x111, 0xf); v += SC_DPP(v, 0.f, 0x112, 0xf); v += SC_DPP(v, 0.f, 0x114, 0xf); v += SC_DPP(v, 0.f, 0x118, 0xf);
    v += SC_DPP(v, 0.f, 0x142, 0xa); v += SC_DPP(v, 0.f, 0x143, 0xc);
    return v;
}
__device__ __forceinline__ float scan_max64(float v, int) {
    const float ni = -__builtin_inff();
    v = fmaxf(v, SC_DPP(v, ni, 0x111, 0xf)); v = fmaxf(v, SC_DPP(v, ni, 0x112, 0xf)); v = fmaxf(v, SC_DPP(v, ni, 0x114, 0xf)); v = fmaxf(v, SC_DPP(v, ni, 0x118, 0xf));
    v = fmaxf(v, SC_DPP(v, ni, 0x142, 0xa)); v = fmaxf(v, SC_DPP(v, ni, 0x143, 0xc));
    return v;
}

template <int MODE>
__device__ __forceinline__ void scan_item(KP p, int l, int b, int h, int dir, int vs) {
    constexpr int CS = (MODE == 1) ? 32 : 64, DK = (MODE == 0) ? 64 : 128, EXT = (MODE == 0) ? 1 : 0;
    constexpr int QS = (DK + 8) * 2, VS = (64 + 16 * EXT + 8) * 2, SS = (CS + 8) * 2, NVR = 64 + 16 * EXT;
    constexpr int NCH = (CTXL + SEQ) / CS;
    constexpr int LD = (MODE == 2) ? ODD_LD : EVEN_LD;
    constexpr unsigned O_QA = 0, O_KA = O_QA + CS * QS, O_QB = O_KA + CS * QS, O_KW = O_QB + (MODE == 1 ? CS * QS : 0), O_V = O_KW + CS * QS,
                       O_SSC = O_V + CS * VS, O_ST = O_SSC + CS * SS, O_DKV = O_ST + 2 * NVR * QS, O_END = O_DKV + 512;
    static_assert(O_END <= 131072, "scan LDS");
    const int tid = opaque_tid(), lane = tid & 63, wv = __builtin_amdgcn_readfirstlane(tid >> 6), r16 = lane & 15, q4 = lane >> 4;
    const unsigned L0 = (unsigned)(size_t)smraw_base();
    const bf16_t* P = (const bf16_t*)(p->ws + OFF_BIG);
    bf16_t* HXo = (bf16_t*)(p->ws + OFF_AUX) + (size_t)dir * NT * 1024;
    const int e2 = l >> 1;
    const int cQ = (MODE == 0) ? E_MQ + h * 64 : (MODE == 1) ? E_HQ + h * 128 : 1536 + h * 128;
    const int cK = (MODE == 0) ? E_MK + h * 64 : (MODE == 1) ? (dir ? E_HFB : E_HFF) + h * 128 : 2048 + h * 128;
    const int cV = (MODE == 0) ? E_MV + h * 128 + vs * 64 : (MODE == 1) ? E_HI + h * 128 + vs * 64 : 2560 + h * 128 + vs * 64;
    const int cO = (MODE == 0) ? h * 128 + vs * 64 : 512 + h * 128 + vs * 64;
    const int lt = (MODE == 1) ? (tid & 31) : (tid >> 3);
    const int lj = (MODE == 0) ? (tid & 7) : (MODE == 1) ? (tid >> 5) : ((tid >> 2) & 1) * 8 + (tid & 3);
    const int vt_ = tid >> 3, vj = tid & 7;
    float lbv[8]; float gbi = 0.f, gbf = 0.f, lg = 0.f;
    if (MODE == 1) {
        const float* lbp = (const float*)(p->ws + OFF_LB) + e2 * 512 + h * 128 + lj * 8;
#pragma unroll
        for (int i = 0; i < 8; ++i) lbv[i] = lbp[i];
    } else {
#pragma unroll
        for (int i = 0; i < 8; ++i) lbv[i] = 0.f;
    }
    if (MODE == 0) { const float* gb = p->in[I_MGB] + e2 * 16; gbi = gb[(dir ? 2 : 0) * 4 + h]; gbf = gb[(dir ? 3 : 1) * 4 + h]; }
    if (MODE == 2) lg = p->in[I_RLD][e2 * 8 + dir * 4 + h];
    const float* G = (const float*)(p->ws + OFF_G);
    const float* ropet = (const float*)(p->ws + OFF_ROPE);
    unsigned oz = 0u; asm volatile("" : "+v"(oz));
    for (unsigned o = tid * 16; o < 2u * NVR * QS; o += 512 * 16) st16(L0 + O_ST + o, make_uint4(oz, oz, oz, oz));
    if (EXT) { if (tid < CS) { st16(L0 + O_V + tid * VS + 128, make_uint4(0x3f80u | oz, oz, oz, oz)); st16(L0 + O_V + tid * VS + 144, make_uint4(oz, oz, oz, oz)); } }
    f32x4 sacc[4];
#pragma unroll
    for (int i = 0; i < 4; ++i) sacc[i] = (f32x4){0.f, 0.f, 0.f, 0.f};
    float m_in = -1e30f;
    struct Raw { uint4 rq0, rq1, rk0, rk1, rv; float rg0, rg1; };
    Raw RA, RB;
    RA.rq1 = make_uint4(0u, 0u, 0u, 0u); RA.rk1 = RA.rq1; RA.rv = RA.rq1; RA.rg0 = 0.f; RA.rg1 = 0.f; RB = RA;
    auto load_chunk = [&](Raw& R, int c) {
        const int i0 = c * CS;
        const int tq = scan_tok(b, i0 + lt, dir);
        const bf16_t* pr = P + (size_t)tq * LD;
        R.rq0 = *(const uint4*)(pr + cQ + lj * 8); R.rk0 = *(const uint4*)(pr + cK + lj * 8);
        if (MODE == 2) { R.rq1 = *(const uint4*)(pr + cQ + lj * 8 + 32); R.rk1 = *(const uint4*)(pr + cK + lj * 8 + 32); }
        if (MODE != 1 || tid < 256) { const int tv = scan_tok(b, i0 + vt_, dir); R.rv = *(const uint4*)(P + (size_t)tv * LD + cV + vj * 8); }
        if (MODE == 0) { const int tg = scan_tok(b, i0 + lane, dir); R.rg0 = G[(size_t)tg * 16 + (dir ? 8 : 0) + h]; R.rg1 = G[(size_t)tg * 16 + (dir ? 12 : 4) + h]; }
    };
    constexpr int PD = (MODE == 2) ? 1 : 2;
    load_chunk(RA, 0); if (PD == 2) load_chunk(RB, 1);
    auto chunk = [&](const int c, Raw& R) {
        const uint4 rq0 = R.rq0, rq1 = R.rq1, rk0 = R.rk0, rk1 = R.rk1, rv = R.rv; const float rg0 = R.rg0, rg1 = R.rg1;
        const unsigned ST_R = L0 + O_ST + (unsigned)(c & 1) * NVR * QS, ST_W = L0 + O_ST + (unsigned)((c + 1) & 1) * NVR * QS;
        float sp = 1.f;
        float v_u = 0.f, v_M = 0.f, v_e = 1.f, v_low = 0.f, v_w = 1.f;
        if (MODE == 0) {
            const float ig = rg0 + gbi, fg = rg1 + gbf;
            const float lf = fminf(fg, 0.f) - flog(1.f + fexp(-fabsf(fg)));
            const float bb = scan_add64(lf, lane);
            const float g = SHI(bb, 63);
            v_u = ig - bb;
            const float cu = scan_max64(v_u, lane);
            v_M = fmaxf(m_in, cu);
            const float m_new = fmaxf(g + m_in, g + SHI(cu, 63));
            sp = fexp(g + m_in - m_new);
            v_w = fexp(g + v_u - m_new);
            v_e = fexp(m_in - v_M);
            v_low = fexp(-(bb + v_M));
            m_in = m_new;
            st16(L0 + O_QA + lt * QS + lj * 16, rq0);
            st16(L0 + O_KA + lt * QS + lj * 16, rk0);
            const float wr = SHI(v_w, lt);
            uint4 kw; kw.x = cvt_pk_bf16(bflo(rk0.x) * wr, bfhi(rk0.x) * wr); kw.y = cvt_pk_bf16(bflo(rk0.y) * wr, bfhi(rk0.y) * wr);
            kw.z = cvt_pk_bf16(bflo(rk0.z) * wr, bfhi(rk0.z) * wr); kw.w = cvt_pk_bf16(bflo(rk0.w) * wr, bfhi(rk0.w) * wr);
            st16(L0 + O_KW + lt * QS + lj * 16, kw);
            st16(L0 + O_V + vt_ * VS + vj * 16, rv);
        } else if (MODE == 2) {
            sp = fexp(64.f * lg);
            const bool lat = c >= CTXL / CS;
            float q[16], k[16];
            const unsigned qa[8] = {rq0.x, rq0.y, rq0.z, rq0.w, rq1.x, rq1.y, rq1.z, rq1.w}, ka[8] = {rk0.x, rk0.y, rk0.z, rk0.w, rk1.x, rk1.y, rk1.z, rk1.w};
#pragma unroll
            for (int i = 0; i < 8; ++i) { q[2 * i] = bflo(qa[i]); q[2 * i + 1] = bfhi(qa[i]); k[2 * i] = bflo(ka[i]); k[2 * i + 1] = bfhi(ka[i]); }
            if (lat) {
                const int tq = scan_tok(b, c * CS + lt, dir), tt = tq & (SEQ - 1);
                const int pos = ((tid >> 2) & 1) ? (tt & 63) : (tt >> 6);
                const float2* rt = (const float2*)ropet + pos * 32 + (tid & 3) * 8;
#pragma unroll
                for (int i = 0; i < 8; ++i) {
                    const float2 cs2 = rt[i];
                    const float q1 = q[i], q2 = q[8 + i], k1 = k[i], k2 = k[8 + i];
                    q[i] = q1 * cs2.x - q2 * cs2.y; q[8 + i] = q1 * cs2.y + q2 * cs2.x;
                    k[i] = k1 * cs2.x - k2 * cs2.y; k[8 + i] = k1 * cs2.y + k2 * cs2.x;
                }
            }
            const float wr = 0.08838834764831845f * fexp((float)(63 - lt) * lg);
            uint4 o0, o1, w0, w1, x0, x1;
            o0.x = cvt_pk_bf16(q[0], q[1]); o0.y = cvt_pk_bf16(q[2], q[3]); o0.z = cvt_pk_bf16(q[4], q[5]); o0.w = cvt_pk_bf16(q[6], q[7]);
            o1.x = cvt_pk_bf16(q[8], q[9]); o1.y = cvt_pk_bf16(q[10], q[11]); o1.z = cvt_pk_bf16(q[12], q[13]); o1.w = cvt_pk_bf16(q[14], q[15]);
            w0.x = cvt_pk_bf16(k[0], k[1]); w0.y = cvt_pk_bf16(k[2], k[3]); w0.z = cvt_pk_bf16(k[4], k[5]); w0.w = cvt_pk_bf16(k[6], k[7]);
            w1.x = cvt_pk_bf16(k[8], k[9]); w1.y = cvt_pk_bf16(k[10], k[11]); w1.z = cvt_pk_bf16(k[12], k[13]); w1.w = cvt_pk_bf16(k[14], k[15]);
            x0.x = cvt_pk_bf16(k[0] * wr, k[1] * wr); x0.y = cvt_pk_bf16(k[2] * wr, k[3] * wr); x0.z = cvt_pk_bf16(k[4] * wr, k[5] * wr); x0.w = cvt_pk_bf16(k[6] * wr, k[7] * wr);
            x1.x = cvt_pk_bf16(k[8] * wr, k[9] * wr); x1.y = cvt_pk_bf16(k[10] * wr, k[11] * wr); x1.z = cvt_pk_bf16(k[12] * wr, k[13] * wr); x1.w = cvt_pk_bf16(k[14] * wr, k[15] * wr);
            st16(L0 + O_QA + lt * QS + lj * 16, o0); st16(L0 + O_QA + lt * QS + lj * 16 + 64, o1);
            st16(L0 + O_KA + lt * QS + lj * 16, w0); st16(L0 + O_KA + lt * QS + lj * 16 + 64, w1);
            st16(L0 + O_KW + lt * QS + lj * 16, x0); st16(L0 + O_KW + lt * QS + lj * 16 + 64, x1);
            st16(L0 + O_V + vt_ * VS + vj * 16, rv);
        } else {
            const unsigned qa[4] = {rq0.x, rq0.y, rq0.z, rq0.w}, fa[4] = {rk0.x, rk0.y, rk0.z, rk0.w};
            float qv[8], kk[8], A[8];
#pragma unroll
            for (int i = 0; i < 8; ++i) {
                const float qr = (i & 1) ? bfhi(qa[i >> 1]) : bflo(qa[i >> 1]), fr = (i & 1) ? bfhi(fa[i >> 1]) : bflo(fa[i >> 1]);
                const float f = lbv[i] + (1.f - lbv[i]) * fsigmoid(fr);
                qv[i] = fsilu(qr); kk[i] = 1.f - f; A[i] = flog(f);
            }
#pragma unroll
            for (int i = 0; i < 8; ++i) {
                int v = __builtin_bit_cast(int, A[i]);
                v = __builtin_bit_cast(int, __builtin_bit_cast(float, v) + __builtin_bit_cast(float, __builtin_amdgcn_update_dpp(0, v, 0x111, 0xf, 0xf, false)));
                v = __builtin_bit_cast(int, __builtin_bit_cast(float, v) + __builtin_bit_cast(float, __builtin_amdgcn_update_dpp(0, v, 0x112, 0xf, 0xf, false)));
                v = __builtin_bit_cast(int, __builtin_bit_cast(float, v) + __builtin_bit_cast(float, __builtin_amdgcn_update_dpp(0, v, 0x114, 0xf, 0xf, false)));
                v = __builtin_bit_cast(int, __builtin_bit_cast(float, v) + __builtin_bit_cast(float, __builtin_amdgcn_update_dpp(0, v, 0x118, 0xf, 0xf, false)));
                v = __builtin_bit_cast(int, __builtin_bit_cast(float, v) + __builtin_bit_cast(float, __builtin_amdgcn_update_dpp(0, v, 0x142, 0xa, 0xf, false)));
                A[i] = __builtin_bit_cast(float, v);
            }
            float qa_[8], qb_[8], ka_[8], kw_[8];
#pragma unroll
            for (int i = 0; i < 8; ++i) {
                const float am = SHI32(A[i], 15), ae = SHI32(A[i], 31);
                qa_[i] = qv[i] * fexp(A[i] - am); qb_[i] = qv[i] * fexp(A[i]); ka_[i] = kk[i] * fexp(am - A[i]); kw_[i] = kk[i] * fexp(ae - A[i]);
                if (lt == 31) *(LAS float*)(size_t)(L0 + O_DKV + (lj * 8 + i) * 4) = fexp(ae);
            }
            uint4 w;
            w.x = cvt_pk_bf16(qa_[0], qa_[1]); w.y = cvt_pk_bf16(qa_[2], qa_[3]); w.z = cvt_pk_bf16(qa_[4], qa_[5]); w.w = cvt_pk_bf16(qa_[6], qa_[7]); st16(L0 + O_QA + lt * QS + lj * 16, w);
            w.x = cvt_pk_bf16(qb_[0], qb_[1]); w.y = cvt_pk_bf16(qb_[2], qb_[3]); w.z = cvt_pk_bf16(qb_[4], qb_[5]); w.w = cvt_pk_bf16(qb_[6], qb_[7]); st16(L0 + O_QB + lt * QS + lj * 16, w);
            w.x = cvt_pk_bf16(ka_[0], ka_[1]); w.y = cvt_pk_bf16(ka_[2], ka_[3]); w.z = cvt_pk_bf16(ka_[4], ka_[5]); w.w = cvt_pk_bf16(ka_[6], ka_[7]); st16(L0 + O_KA + lt * QS + lj * 16, w);
            w.x = cvt_pk_bf16(kw_[0], kw_[1]); w.y = cvt_pk_bf16(kw_[2], kw_[3]); w.z = cvt_pk_bf16(kw_[4], kw_[5]); w.w = cvt_pk_bf16(kw_[6], kw_[7]); st16(L0 + O_KW + lt * QS + lj * 16, w);
            if (tid < 256) st16(L0 + O_V + vt_ * VS + vj * 16, rv);
        }
        __syncthreads();
        if (c + PD < NCH) load_chunk(R, c + PD);
        {
            constexpr int NT1 = CS / 16;
            const bool act = (MODE == 1) ? (wv < 4) : true;
            const int tb = (MODE == 1) ? (wv & 1) : (wv & 3);
#pragma unroll
            for (int u2 = 0; u2 < ((MODE == 1) ? 1 : 2); ++u2) {
                const int sb = (MODE == 1) ? (wv >> 1) : 2 * (wv >> 2) + u2;
                if (act) {
                    f32x4 d = (f32x4){0.f, 0.f, 0.f, 0.f};
                    if (sb <= tb) {
#pragma unroll
                        for (int kk2 = 0; kk2 < DK / 32; ++kk2)
                            d = SC_MFMA(rd_row(L0 + O_KA, sb * 16 + r16, QS, kk2 * 32 + q4 * 8), rd_row(L0 + O_QA, tb * 16 + r16, QS, kk2 * 32 + q4 * 8), d);
                        const int t = tb * 16 + r16, s0 = sb * 16 + q4 * 4;
                        if (MODE == 0) {
                            const float Mt = SHI(v_M, t);
#pragma unroll
                            for (int jj = 0; jj < 4; ++jj) { const float us = SHI(v_u, s0 + jj); d[jj] = (s0 + jj <= t) ? d[jj] * 0.125f * fexp(us - Mt) : 0.f; }
                        } else if (MODE == 2) {
#pragma unroll
                            for (int jj = 0; jj < 4; ++jj) d[jj] = (s0 + jj <= t) ? d[jj] * 0.08838834764831845f * fexp((float)(t - s0 - jj) * lg) : 0.f;
                        } else {
#pragma unroll
                            for (int jj = 0; jj < 4; ++jj) d[jj] = (s0 + jj <= t) ? d[jj] : 0.f;
                        }
                    }
                    st8(L0 + O_SSC + (tb * 16 + r16) * SS + (sb * 16 + q4 * 4) * 2, make_uint2(cvt_pk_bf16(d[0], d[1]), cvt_pk_bf16(d[2], d[3])));
                }
            }
            (void)NT1;
        }
        __syncthreads();
        {
            const int tb = (MODE == 1) ? (wv & 1) : (wv & 3);
            const int t = tb * 16 + r16;
            const int tok = scan_tok(b, c * CS + t, dir);
            constexpr int NV = (MODE == 1) ? 1 : 2;
            f32x4 oi[NV + EXT], oo[NV + EXT];
#pragma unroll
            for (int u2 = 0; u2 < NV + EXT; ++u2) {
                const int vt = (u2 == NV) ? 4 : ((MODE == 1) ? (wv >> 1) : 2 * (wv >> 2) + u2);
                f32x4 a1 = (f32x4){0.f, 0.f, 0.f, 0.f}, a2 = a1;
#pragma unroll
                for (int sb2 = 0; sb2 < CS / 32; ++sb2)
                    a1 = SC_MFMA(rd_tr(L0 + O_V, sb2 * 32, vt * 16, VS, lane), rd_row(L0 + O_SSC, t, SS, sb2 * 32 + q4 * 8), a1);
#pragma unroll
                for (int kk2 = 0; kk2 < DK / 32; ++kk2)
                    a2 = SC_MFMA(rd_row(ST_R, vt * 16 + r16, QS, kk2 * 32 + q4 * 8), rd_row(L0 + ((MODE == 1) ? O_QB : O_QA), t, QS, kk2 * 32 + q4 * 8), a2);
                oi[u2] = a1; oo[u2] = a2;
            }
            float den = 1.f, ei = 1.f;
            if (MODE == 0) {
                ei = 0.125f * SHI(v_e, t);
                const float dsum = oi[NV][0] + ei * oo[NV][0];
                const float dd = SHI(dsum, r16);
                den = 1.f / fmaxf(fabsf(dd), SHI(v_low, t));
            } else if (MODE == 2) {
                ei = fexp((float)(t + 1) * lg);
            }
#pragma unroll
            for (int u2 = 0; u2 < NV; ++u2) {
                const int vt = (MODE == 1) ? (wv >> 1) : 2 * (wv >> 2) + u2;
                float o[4];
#pragma unroll
                for (int jj = 0; jj < 4; ++jj) o[jj] = (oi[u2][jj] + ei * oo[u2][jj]) * den;
                *(uint2*)(HXo + (size_t)tok * 1024 + cO + vt * 16 + q4 * 4) = make_uint2(cvt_pk_bf16(o[0], o[1]), cvt_pk_bf16(o[2], o[3]));
            }
        }
        {
            constexpr int NS = (MODE == 0) ? 3 : 4;
            const int kt = (MODE == 0) ? (wv & 3) : wv;
            float dk[4] = {sp, sp, sp, sp};
            if (MODE == 1) { const f32x4 dv = *(const LAS f32x4*)(size_t)(L0 + O_DKV + (kt * 16 + q4 * 4) * 4); dk[0] = dv[0]; dk[1] = dv[1]; dk[2] = dv[2]; dk[3] = dv[3]; }
            f32x4 a[NS];
#pragma unroll
            for (int u2 = 0; u2 < NS; ++u2) { a[u2] = sacc[u2];
#pragma unroll
                for (int jj = 0; jj < 4; ++jj) a[u2][jj] *= dk[jj]; }
#pragma unroll
            for (int sb2 = 0; sb2 < CS / 32; ++sb2) {
                unsigned ta[5], ts[5]; bf16x8 ops[5];
                ta[0] = tr_addr(L0 + O_KW, sb2 * 32, kt * 16, QS, lane); ts[0] = 4u * QS;
#pragma unroll
                for (int u2 = 0; u2 < 4; ++u2) {
                    const int vt = (MODE == 0) ? ((u2 >= 2) ? 4 : 2 * (wv >> 2) + u2) : u2;
                    ta[1 + u2] = tr_addr(L0 + O_V, sb2 * 32, vt * 16, VS, lane); ts[1 + u2] = 4u * VS;
                }
                rd_tr5(ta, ts, ops);
#pragma unroll
                for (int u2 = 0; u2 < NS; ++u2) a[u2] = SC_MFMA(ops[0], ops[1 + u2], a[u2]);
            }
#pragma unroll
            for (int u2 = 0; u2 < NS; ++u2) {
                const int vt = (MODE == 0) ? ((u2 == 2) ? 4 : 2 * (wv >> 2) + u2) : u2;
                sacc[u2] = a[u2];
                st8(ST_W + (vt * 16 + r16) * QS + (kt * 16 + q4 * 4) * 2, make_uint2(cvt_pk_bf16(a[u2][0], a[u2][1]), cvt_pk_bf16(a[u2][2], a[u2][3])));
            }
        }
        __syncthreads();
    };
#pragma unroll 1
    for (int c = 0; c < NCH; c += 2) { chunk(c, RA); if (PD == 2) chunk(c + 1, RB); else chunk(c + 1, RA); }
}

}

__device__ __forceinline__ void ph_scan_even2(KP p, int l, int bid, int nb) {
#pragma unroll 1
    for (int item = bid; item < 256; item += nb) {
        const int kind = item >> 7, b = (item >> 4) & 7, h = (item >> 2) & 3, dir = (item >> 1) & 1, vs = item & 1;
        if (kind == 0) sc::scan_item<0>(p, l, b, h, dir, vs); else sc::scan_item<1>(p, l, b, h, dir, vs);
        __syncthreads();
    }
}
__device__ __forceinline__ void ph_scan_odd2(KP p, int l, int bid, int nb) {
#pragma unroll 1
    for (int item = bid; item < 128; item += nb) {
        const int b = (item >> 4) & 7, h = (item >> 2) & 3, dir = (item >> 1) & 1, vs = item & 1;
        sc::scan_item<2>(p, l, b, h, dir, vs);
        __syncthreads();
    }
}

__device__ __forceinline__ void unpack16(const uint4 a, const uint4 b, float (&x)[16]) {
    x[0] = bflo(a.x); x[1] = bfhi(a.x); x[2] = bflo(a.y); x[3] = bfhi(a.y); x[4] = bflo(a.z); x[5] = bfhi(a.z); x[6] = bflo(a.w); x[7] = bfhi(a.w);
    x[8] = bflo(b.x); x[9] = bfhi(b.x); x[10] = bflo(b.y); x[11] = bfhi(b.y); x[12] = bflo(b.z); x[13] = bfhi(b.z); x[14] = bflo(b.w); x[15] = bfhi(b.w);
}
__device__ __forceinline__ float sum8(float v) { v += SHX(v, 1); v += SHX(v, 2); v += SHX(v, 4); return v; }
template <bool MEANSUB, bool SIG>
__device__ __forceinline__ void head_norm_gate16(const bf16_t* h0, const bf16_t* h1, const bf16_t* gp, const float* nw, bf16_t* out) {
    float a[16], b[16], g[16];
    unpack16(*(const uint4*)h0, *(const uint4*)(h0 + 8), a); unpack16(*(const uint4*)h1, *(const uint4*)(h1 + 8), b); unpack16(*(const uint4*)gp, *(const uint4*)(gp + 8), g);
    float s = 0.f;
#pragma unroll
    for (int i = 0; i < 16; ++i) { a[i] += b[i]; s += a[i]; }
    if (MEANSUB) { const float mean = sum8(s) * (1.f / 128.f);
#pragma unroll
        for (int i = 0; i < 16; ++i) a[i] -= mean; }
    float q = 0.f;
#pragma unroll
    for (int i = 0; i < 16; ++i) q += a[i] * a[i];
    const float r = rsqrtf(sum8(q) * (1.f / 128.f) + LN_EPS);
    unsigned w[8];
#pragma unroll
    for (int i = 0; i < 16; i += 2) {
        const float y0 = a[i] * r * nw[i] * (SIG ? sigmoidf_(g[i]) : siluf_(g[i])), y1 = a[i + 1] * r * nw[i + 1] * (SIG ? sigmoidf_(g[i + 1]) : siluf_(g[i + 1]));
        w[i >> 1] = cvt_pk_bf16(y0, y1);
    }
    *(uint4*)out = make_uint4(w[0], w[1], w[2], w[3]); *(uint4*)(out + 8) = make_uint4(w[4], w[5], w[6], w[7]);
}
__device__ __forceinline__ void ph_normgate_even(KP p, int l, int bid, int nb) {
    const int tid = opaque_tid(), lane = tid & 63, wv = tid >> 6;
    const bf16_t* P = (const bf16_t*)(p->ws + OFF_BIG);
    const bf16_t* HX = (const bf16_t*)(p->ws + OFF_AUX);
    const bf16_t* HX1 = HX + (size_t)NT * 1024;
    bf16_t* MIX = (bf16_t*)(p->ws + OFF_U);
    const int e = l >> 1;
    const bool ml = lane < 32;
    const float* nw = ml ? p->in[I_MNW] + e * 512 + 16 * lane : p->in[I_HNW] + e * 512 + 16 * (lane - 32);
    const int gcol = ml ? E_MO + 16 * lane : E_HG + 16 * (lane - 32);
#pragma unroll 1
    for (int tok = bid * 8 + wv; tok < NT; tok += nb * 8) {
        const size_t o = (size_t)tok * 1024 + 16 * lane;
        if (ml) head_norm_gate16<true, true>(HX + o, HX1 + o, P + (size_t)tok * EVEN_LD + gcol, nw, MIX + o);
        else head_norm_gate16<false, false>(HX + o, HX1 + o, P + (size_t)tok * EVEN_LD + gcol, nw, MIX + o);
    }
}

#define OFF_UT   (OFF_AUX + 136 * MiB)
#define OFF_FKS(o) (984 * MiB + (size_t)(o) * 34 * MiB)
#define OFF_ZOT  (OFF_UT + 102 * MiB)

__device__ __forceinline__ void ph_hy_filt2(KP p, int l, int bid, int nb, float* sm, int skip) {
    const int tid = opaque_tid(), o = l >> 1;
    float* zf = sm;
    float* h1 = sm + 1024;
    float* h2 = sm + 2048;
    float* h3 = sm + 3072;
    const float* fw1 = p->in[I_HW1] + o * 33 * 64; const float* fb1 = p->in[I_HB1] + o * 64;
    const float* fw2 = p->in[I_HW2] + o * 64 * 64; const float* fb2 = p->in[I_HB2] + o * 64;
    const float* fw3 = p->in[I_HW3] + o * 64 * 64; const float* fb3 = p->in[I_HB3] + o * 64;
    const float* freq = p->in[I_HFREQ] + o * 64;
    const float* wout = p->in[I_HWOUT] + (size_t)o * 64 * 2048;
    float* FK = (float*)(p->ws + OFF_FKS(o)); float* FKC = FK + (size_t)2 * 512 * 8192;
#pragma unroll 1
    for (int item = bid - skip; item < (SEQ + CTXL) / 16; item += nb - skip) {
        if (item < 0) break;
        const bool isctx = item >= SEQ / 16;
        const int L = isctx ? CTXL : SEQ, pos0 = (isctx ? item - SEQ / 16 : item) * 16;
        __syncthreads();
        if (tid < 16 * 17) {
            const int pp = tid / 17, j = tid % 17, pos = pos0 + pp;
            if (j == 16) zf[pp * 36] = (float)pos / (float)(L - 1);
            else { const float f = 1e-4f + (float)j * ((15.0f - 1e-4f) / 15.0f); const float w = 2.0f * 3.14159265358979323846f * (float)pos / (float)L * f; zf[pp * 36 + 1 + j] = cosf(w); zf[pp * 36 + 17 + j] = sinf(w); }
        }
        __syncthreads();
        const int pp = tid >> 5, u0 = (tid & 31) * 2;
        { float a0 = fb1[u0], a1 = fb1[u0 + 1];
#pragma unroll 1
          for (int k = 0; k < 33; ++k) { const float z = zf[pp * 36 + k]; a0 += z * fw1[k * 64 + u0]; a1 += z * fw1[k * 64 + u0 + 1]; }
          h1[pp * 64 + u0] = sinf(freq[u0] * a0); h1[pp * 64 + u0 + 1] = sinf(freq[u0 + 1] * a1); }
        __syncthreads();
        { float a0 = fb2[u0], a1 = fb2[u0 + 1];
#pragma unroll 4
          for (int k = 0; k < 64; ++k) { const float z = h1[pp * 64 + k]; a0 += z * fw2[k * 64 + u0]; a1 += z * fw2[k * 64 + u0 + 1]; }
          h2[pp * 64 + u0] = sinf(freq[u0] * a0); h2[pp * 64 + u0 + 1] = sinf(freq[u0 + 1] * a1); }
        __syncthreads();
        { float a0 = fb3[u0], a1 = fb3[u0 + 1];
#pragma unroll 4
          for (int k = 0; k < 64; ++k) { const float z = h2[pp * 64 + k]; a0 += z * fw3[k * 64 + u0]; a1 += z * fw3[k * 64 + u0 + 1]; }
          h3[pp * 64 + u0] = sinf(freq[u0] * a0); h3[pp * 64 + u0 + 1] = sinf(freq[u0 + 1] * a1); }
        __syncthreads();
#pragma unroll 1
        for (int r = 0; r < 4; ++r) {
            const int col = tid + 512 * r, c = col & 511, od = col >> 9, order = od >> 1, dirn = od & 1;
            float a[16];
#pragma unroll
            for (int i = 0; i < 16; ++i) a[i] = 0.f;
#pragma unroll 1
            for (int k = 0; k < 64; k += 4) { const float w0 = wout[k * 2048 + col], w1 = wout[(k + 1) * 2048 + col], w2 = wout[(k + 2) * 2048 + col], w3 = wout[(k + 3) * 2048 + col];
#pragma unroll
                for (int i = 0; i < 16; ++i) { const float4 hh = *(const float4*)(h3 + i * 64 + k); a[i] += hh.x * w0 + hh.y * w1 + hh.z * w2 + hh.w * w3; } }
            const float delta = 3.0701134573253944f + (float)c * ((15.350567286626972f - 3.0701134573253944f) / 511.0f);
#pragma unroll
            for (int i = 0; i < 16; ++i) a[i] *= expf(-((float)(pos0 + i) / (float)(L - 1)) * delta);
            float* dst = isctx ? FKC + ((size_t)order * 512 + c) * 512 + 256 : FK + ((size_t)order * 512 + c) * 8192 + 4096;
            if (dirn == 0) {
#pragma unroll
                for (int i = 0; i < 16; i += 4) *(float4*)(dst + pos0 + i) = make_float4(a[i], a[i + 1], a[i + 2], a[i + 3]);
            } else {
#pragma unroll
                for (int i = 0; i < 16; ++i) if (pos0 + i > 0) dst[-(pos0 + i)] = a[i];
                if (pos0 == 0) dst[-L] = 0.f;
            }
        }
    }
}

__device__ __forceinline__ void ph_hy_prep(KP p, int l, int bid, int nb, float* sm) {
    const int tid = opaque_tid(), o = l >> 1;
    const bf16_t* P = (const bf16_t*)(p->ws + OFF_BIG);
    bf16_t* UT = (bf16_t*)(p->ws + OFF_UT);
    const float* cw = p->in[I_HCW] + o * 3 * 1536; const float* cb = p->in[I_HCB] + o * 1536;
    float* tile = sm;
#pragma unroll 1
    for (int item = bid; item < (NT / 256) * 24; item += nb) {
        const int tt = item / 24, ct = item % 24, tok0 = tt * 256, col0 = ct * 64;
        const bool lat = tok0 < NL;
        const int L = lat ? SEQ : CTXL, t0 = lat ? (tok0 & (SEQ - 1)) : ((tok0 - NL) & (CTXL - 1));
        __syncthreads();
#pragma unroll 1
        for (int i = tid; i < 258 * 8; i += 512) {
            const int rr = i >> 3, hf = i & 7, t = t0 + rr - 1;
            uint4 v = make_uint4(0u, 0u, 0u, 0u);
            if (t >= 0 && t < L) v = *(const uint4*)(P + (size_t)(tok0 + rr - 1) * ODD_LD + col0 + hf * 8);
            float* d = tile + rr * 65 + hf * 8;
            d[0] = bflo(v.x); d[1] = bfhi(v.x); d[2] = bflo(v.y); d[3] = bfhi(v.y); d[4] = bflo(v.z); d[5] = bfhi(v.z); d[6] = bflo(v.w); d[7] = bfhi(v.w);
        }
        __syncthreads();
#pragma unroll 1
        for (int r = 0; r < 4; ++r) {
            const int cc = (tid >> 5) + 16 * r, tc = (tid & 31) * 8, col = col0 + cc;
            const float w0 = cw[col], w1 = cw[1536 + col], w2 = cw[3072 + col], bb = cb[col];
            float y[8];
#pragma unroll
            for (int i = 0; i < 8; ++i) y[i] = tile[(tc + i) * 65 + cc] * w0 + tile[(tc + i + 1) * 65 + cc] * w1 + tile[(tc + i + 2) * 65 + cc] * w2 + bb;
            *(uint4*)(UT + (size_t)col * NT + tok0 + tc) = make_uint4(cvt_pk_bf16(y[0], y[1]), cvt_pk_bf16(y[2], y[3]), cvt_pk_bf16(y[4], y[5]), cvt_pk_bf16(y[6], y[7]));
        }
    }
}

__device__ __forceinline__ void hy_item_lat(KP p, int l, int c) {
    constexpr int ZSB = (SEQ + 8) * 2;
    constexpr unsigned O_Z = 0, O_PE = O_Z + 8 * ZSB, O_PO = O_PE + 4096 * 4, O_END = O_PO + 4096 * 4;
    static_assert(O_END <= BAR_LDS_, "hyena LDS");
    const int tid = opaque_tid(), lane = tid & 63, wv = __builtin_amdgcn_readfirstlane(tid >> 6), r16 = lane & 15, q4 = lane >> 4, o = l >> 1;
    const unsigned L0 = (unsigned)(size_t)smraw_base();
    const bf16_t* UT = (const bf16_t*)(p->ws + OFF_UT);
    bf16_t* ZOT = (bf16_t*)(p->ws + OFF_ZOT);
    const float* FK = (const float*)(p->ws + OFF_FKS(o));
    for (int i = tid; i < 8 * 512; i += 512) { const int b = i >> 9, ch = i & 511; sc::st16(L0 + O_Z + b * ZSB + ch * 16, *(const uint4*)(UT + (size_t)(1024 + c) * NT + b * SEQ + ch * 8)); }
#pragma unroll 1
    for (int order = 0; order < 2; ++order) {
        const float* fk = FK + ((size_t)order * 512 + c) * 8192;
        for (int i = tid; i < 4096; i += 512) {
            const float r0 = (i > 0) ? fk[8192 - 2 * i] : 0.f, r1 = fk[8191 - 2 * i], r2 = (i < 4095) ? fk[8190 - 2 * i] : 0.f;
            *(LAS unsigned*)(size_t)(L0 + O_PE + i * 4) = cvt_pk_bf16(r0, r1); *(LAS unsigned*)(size_t)(L0 + O_PO + i * 4) = cvt_pk_bf16(r1, r2);
        }
        __syncthreads();
        sc::f32x4 acc[4][4];
#pragma unroll
        for (int a = 0; a < 4; ++a)
#pragma unroll
            for (int b2 = 0; b2 < 4; ++b2) acc[a][b2] = (sc::f32x4){0.f, 0.f, 0.f, 0.f};
        const unsigned gbase = L0 + ((r16 & 1) ? O_PO : O_PE) + (unsigned)(((4096 - r16 + 8 * q4 - (r16 & 1)) >> 1) * 4);
        auto ldG = [&](int g) {
            const unsigned a0 = gbase - (unsigned)(32 * g);
            const unsigned w0 = *(const LAS unsigned*)(size_t)a0, w1 = *(const LAS unsigned*)(size_t)(a0 + 4), w2 = *(const LAS unsigned*)(size_t)(a0 + 8), w3 = *(const LAS unsigned*)(size_t)(a0 + 12);
            return __builtin_bit_cast(sc::bf16x8, (sc::u32x4_){w0, w1, w2, w3});
        };
        sc::bf16x8 bq[4][2], W[6];
#pragma unroll
        for (int i = 0; i < 4; ++i) { bq[i][0] = (sc::bf16x8){0, 0, 0, 0, 0, 0, 0, 0}; bq[i][1] = bq[i][0]; }
        const int D0 = 8 * wv - 63, D1 = (8 * wv + 7 < 63) ? 8 * wv + 7 : 63;
        W[4] = ldG(4 * D0 - 6 + 4); W[5] = ldG(4 * D0 - 6 + 5);
#pragma unroll 1
        for (int D = D0; D <= D1; ++D) {
            W[0] = W[4]; W[1] = W[5];
#pragma unroll
            for (int i = 0; i < 4; ++i) W[2 + i] = ldG(4 * D + i);
            bq[3][0] = bq[2][0]; bq[3][1] = bq[2][1]; bq[2][0] = bq[1][0]; bq[2][1] = bq[1][1]; bq[1][0] = bq[0][0]; bq[1][1] = bq[0][1];
            {
                const int s1 = 8 * wv - D + ((r16 < 8) ? 0 : 4);
                const bool ok = (unsigned)s1 < 64u;
                const unsigned za = L0 + O_Z + (unsigned)((r16 & 7) * ZSB + ((ok ? s1 : 0) * 64 + q4 * 8) * 2);
                sc::bf16x8 b0 = *(const LAS sc::bf16x8*)(size_t)za, b1 = *(const LAS sc::bf16x8*)(size_t)(za + 64);
                if (!ok) { b0 = (sc::bf16x8){0, 0, 0, 0, 0, 0, 0, 0}; b1 = b0; }
                bq[0][0] = b0; bq[0][1] = b1;
            }
#pragma unroll
            for (int cg = 0; cg < 4; ++cg) {
                const int sA = 8 * wv + cg - D;
                if ((unsigned)sA < 64u || (unsigned)(sA + 4) < 64u) {
#pragma unroll
                    for (int it = 0; it < 4; ++it) { acc[cg][it] = SC_MFMA(W[it + 2], bq[cg][0], acc[cg][it]); acc[cg][it] = SC_MFMA(W[it], bq[cg][1], acc[cg][it]); }
                }
            }
        }
        __syncthreads();
        const float sk = p->in[I_HSKIP][o * 1024 + order * 512 + c];
        const bf16_t* gt = UT + (size_t)(order * 512 + c) * NT;
        const int bb = r16 & 7;
#pragma unroll
        for (int cg = 0; cg < 4; ++cg) {
            const int t1 = 8 * wv + cg + ((r16 < 8) ? 0 : 4);
#pragma unroll
            for (int it = 0; it < 4; ++it) {
                const int t = t1 * 64 + it * 16 + q4 * 4;
                const sc::u32x2_ zo_ = *(const LAS sc::u32x2_*)(size_t)(L0 + O_Z + bb * ZSB + t * 2); const uint2 zo = make_uint2(zo_[0], zo_[1]);
                const uint2 gv = *(const uint2*)(gt + bb * SEQ + t);
                const float y0 = bflo(gv.x) * (acc[cg][it][0] + sk * bflo(zo.x)), y1 = bfhi(gv.x) * (acc[cg][it][1] + sk * bfhi(zo.x));
                const float y2 = bflo(gv.y) * (acc[cg][it][2] + sk * bflo(zo.y)), y3 = bfhi(gv.y) * (acc[cg][it][3] + sk * bfhi(zo.y));
                const uint2 w = make_uint2(cvt_pk_bf16(y0, y1), cvt_pk_bf16(y2, y3));
                if (order == 0) sc::st8(L0 + O_Z + bb * ZSB + t * 2, w);
                else *(uint2*)(ZOT + (size_t)c * NT + bb * SEQ + t) = w;
            }
        }
        __syncthreads();
    }
}

__device__ __forceinline__ void hy_item_ctx(KP p, int l, int c, float* sm) {
    const int tid = opaque_tid(), o = l >> 1;
    const bf16_t* UT = (const bf16_t*)(p->ws + OFF_UT);
    bf16_t* ZOT = (bf16_t*)(p->ws + OFF_ZOT);
    const float* FKC = (const float*)(p->ws + OFF_FKS(o)) + (size_t)2 * 512 * 8192;
    float* Kc = sm;
    float* zb = sm + 1024;
    for (int i = tid; i < 1024; i += 512) Kc[i] = FKC[((size_t)(i >> 9) * 512 + c) * 512 + (i & 511)];
    for (int i = tid; i < 8 * CTXL; i += 512) zb[i] = bf2f(UT[(size_t)(1024 + c) * NT + NL + i]);
    __syncthreads();
    const int bb = tid >> 6, tl = tid & 63;
#pragma unroll 1
    for (int order = 0; order < 2; ++order) {
        float acc[4] = {0.f, 0.f, 0.f, 0.f};
#pragma unroll 4
        for (int s = 0; s < CTXL; ++s) {
            const float zv = zb[bb * CTXL + s];
#pragma unroll
            for (int i = 0; i < 4; ++i) acc[i] += Kc[order * 512 + tl + 64 * i - s + 256] * zv;
        }
        const float sk = p->in[I_HSKIP][o * 1024 + order * 512 + c];
        float zn[4];
#pragma unroll
        for (int i = 0; i < 4; ++i) { const int t = tl + 64 * i; zn[i] = bf2f(UT[(size_t)(order * 512 + c) * NT + NL + bb * CTXL + t]) * (acc[i] + zb[bb * CTXL + t] * sk); }
        __syncthreads();
#pragma unroll
        for (int i = 0; i < 4; ++i) { const int t = tl + 64 * i; if (order == 0) zb[bb * CTXL + t] = bf2f((bf16_t)(cvt_pk_bf16(zn[i], 0.f) & 0xffffu)); else stf(ZOT + (size_t)c * NT + NL + bb * CTXL + t, zn[i]); }
        __syncthreads();
    }
}

__device__ __forceinline__ void ph_mix_odd(KP p, int l, int bid, int nb, float* sm) {
    int* head = (int*)(p->ws + OFF_CNT) + 1024 + (l >> 1) * 64;
    LAS int* slot = (LAS int*)(smraw_base() + BAR_LDS_ + 64);
#pragma unroll 1
    for (;;) {
        if (opaque_tid() == 0) *slot = atomicAdd(head, 1);
        __syncthreads();
        const int item = *slot;
        __syncthreads();
        if (item >= 128 + 512) break;
        if (item < 128) { const int b = (item >> 4) & 7, h = (item >> 2) & 3, dir = (item >> 1) & 1, vs = item & 1; sc::scan_item<2>(p, l, b, h, dir, vs); }
        else { const int c = item - 128; hy_item_lat(p, l, c); __syncthreads(); hy_item_ctx(p, l, c, sm); }
        __syncthreads();
    }
}

__device__ __forceinline__ void ph_hy_norm(KP p, int l, int bid, int nb, float* sm) {
    const int tid = opaque_tid(), o = l >> 1;
    const bf16_t* ZOT = (const bf16_t*)(p->ws + OFF_ZOT);
    bf16_t* MIX = (bf16_t*)(p->ws + OFF_U);
    const float* nw = p->in[I_HNORM] + o * 512;
    float* tile = sm;
    float* part = sm + 64 * 65;
#pragma unroll 1
    for (int item = bid; item < (NT / 64) * 8; item += nb) {
        const int tt = item >> 3, g = item & 7, tok0 = tt * 64;
        __syncthreads();
        { const int cc = tid >> 3, ch = tid & 7;
          const uint4 v = *(const uint4*)(ZOT + (size_t)(g * 64 + cc) * NT + tok0 + ch * 8);
          float* d = tile + cc * 65 + ch * 8;
          d[0] = bflo(v.x); d[1] = bfhi(v.x); d[2] = bflo(v.y); d[3] = bfhi(v.y); d[4] = bflo(v.z); d[5] = bfhi(v.z); d[6] = bflo(v.w); d[7] = bfhi(v.w); }
        __syncthreads();
        { const int tk = tid & 63, pt = tid >> 6; float s = 0.f;
#pragma unroll
          for (int i = 0; i < 8; ++i) { const float x = tile[(pt * 8 + i) * 65 + tk]; s += x * x; }
          part[pt * 64 + tk] = s; }
        __syncthreads();
        { const int tk = tid >> 3, ch = tid & 7; float s = 0.f;
#pragma unroll
          for (int i = 0; i < 8; ++i) s += part[i * 64 + tk];
          const float rs = rsqrtf(s * (1.f / 64.f) + LN_EPS);
          float y[8];
#pragma unroll
          for (int i = 0; i < 8; ++i) y[i] = tile[(ch * 8 + i) * 65 + tk] * rs * nw[g * 64 + ch * 8 + i];
          *(uint4*)(MIX + (size_t)(tok0 + tk) * DM + g * 64 + ch * 8) = make_uint4(cvt_pk_bf16(y[0], y[1]), cvt_pk_bf16(y[2], y[3]), cvt_pk_bf16(y[4], y[5]), cvt_pk_bf16(y[6], y[7])); }
    }
}

__device__ __forceinline__ void ph_normgate_odd(KP p, int l, int bid, int nb) {
    const int tid = opaque_tid(), lane = tid & 63, wv = tid >> 6, o2 = l >> 1;
    const bf16_t* P = (const bf16_t*)(p->ws + OFF_BIG);
    const bf16_t* HX = (const bf16_t*)(p->ws + OFF_AUX);
    const bf16_t* HX1 = HX + (size_t)NT * 1024;
    bf16_t* MIX = (bf16_t*)(p->ws + OFF_U);
    const int c16 = 16 * (lane & 31);
    const float* nw = p->in[I_RNW] + o2 * 512 + c16;
#pragma unroll 1
    for (int t2 = bid * 8 + wv; t2 < NT / 2; t2 += nb * 8) {
        const int tok = t2 * 2 + (lane >> 5);
        const size_t o = (size_t)tok * 1024 + 512 + c16;
        head_norm_gate16<true, false>(HX + o, HX1 + o, P + (size_t)tok * ODD_LD + 3072 + c16, nw, MIX + o);
    }
}

__device__ __forceinline__ void ph_ln1_router(KP p, int l, int ntok, int bid, int nb, float* sm) {
    constexpr int VP = (1024 + 8) * 2;
    constexpr unsigned O_VH = 0, O_VL = 32 * VP, O_LG = 64 * VP;
    static_assert(O_LG + 32 * 64 * 4 <= BAR_LDS_, "router LDS");
    const int tid = opaque_tid(), lane = tid & 63, wv = __builtin_amdgcn_readfirstlane(tid >> 6), r16 = lane & 15, q4 = lane >> 4;
    const unsigned L0 = (unsigned)(size_t)smraw_base();
    const bf16_t* Y = (const bf16_t*)(p->ws + OFF_BIG);
    bf16_t* U = (bf16_t*)(p->ws + OFF_U);
    const float* lw = p->in[I_LNW] + (l * 2) * 1024; const float* lb = p->in[I_LNB] + (l * 2) * 1024;
    const bf16_t* RWH = (const bf16_t*)(p->ws + OFF_RWH); const bf16_t* RWL = RWH + 64 * 1024;
    const float rb = p->in[I_RB][l * 64 + lane];
    LAS int* lcnt = (LAS int*)(smraw_base() + BAR_LDS_ + 256);
    if (tid < 64) lcnt[tid] = 0;
    __syncthreads();
    int* tidx = (int*)(p->ws + OFF_TIDX); float* tgate = (float*)(p->ws + OFF_TGATE); int* tpos = (int*)(p->ws + OFF_TPOS);
    {
        int* stok = (int*)(p->ws + OFF_STOK); float* sgate = (float*)(p->ws + OFF_SGATE); int* sdst = (int*)(p->ws + OFF_SDST);
#pragma unroll 1
        for (int i = bid * 512 + tid; i < MAXROWS; i += nb * 512) { stok[i] = ZROW; sgate[i] = 0.f; sdst[i] = -1; }
    }
    const int nfr = (ntok >> 5) / nb, nsteps = nfr + (((ntok >> 5) % nb) ? 1 : 0);
#pragma unroll 1
    for (int step = 0; step < nsteps; ++step) {
        const bool full = step < nfr;
        const int tpw = full ? 4 : 1, base = full ? (step * nb + bid) * 32 : nfr * nb * 32 + bid * 8;
#pragma unroll 2
        for (int j = 0; j < 4; ++j) {
            if (j >= tpw) break;
            const int tl = wv * tpw + j, tok = base + tl;
            float* h = hrow(p, tok);
            const float* m = modrow(p, l, tok);
            const bf16_t* r = Y + (size_t)tok * DM;
            float x[16]; float s = 0.f;
#pragma unroll
            for (int c = 0; c < 4; ++c) {
                const int d = 4 * (lane + 64 * c);
                const float4 hv = *(const float4*)(h + d), gv = *(const float4*)(m + 2 * 1024 + d); const uint2 rw2 = *(const uint2*)(r + d);
                const float4 rv = make_float4(bflo(rw2.x), bfhi(rw2.x), bflo(rw2.y), bfhi(rw2.y));
                x[4 * c] = ALPHA * hv.x + gv.x * rv.x; x[4 * c + 1] = ALPHA * hv.y + gv.y * rv.y; x[4 * c + 2] = ALPHA * hv.z + gv.z * rv.z; x[4 * c + 3] = ALPHA * hv.w + gv.w * rv.w;
                s += x[4 * c] + x[4 * c + 1] + x[4 * c + 2] + x[4 * c + 3];
            }
            const float mean = wave_sum(s) * (1.f / 1024.f);
            float q = 0.f;
#pragma unroll
            for (int i = 0; i < 16; ++i) { x[i] -= mean; q += x[i] * x[i]; }
            const float rs = rsqrtf(wave_sum(q) * (1.f / 1024.f) + LN_EPS);
#pragma unroll
            for (int c = 0; c < 4; ++c) {
                const int d = 4 * (lane + 64 * c);
                const float4 w4 = *(const float4*)(lw + d), b4 = *(const float4*)(lb + d), sh = *(const float4*)(m + 3 * 1024 + d), sc = *(const float4*)(m + 4 * 1024 + d);
                float4 y; y.x = x[4 * c] * rs * w4.x + b4.x; y.y = x[4 * c + 1] * rs * w4.y + b4.y; y.z = x[4 * c + 2] * rs * w4.z + b4.z; y.w = x[4 * c + 3] * rs * w4.w + b4.w;
                *(float4*)(h + d) = y;
                float4 v; v.x = y.x * (1.f + sc.x) + sh.x; v.y = y.y * (1.f + sc.y) + sh.y; v.z = y.z * (1.f + sc.z) + sh.z; v.w = y.w * (1.f + sc.w) + sh.w;
                const unsigned h0 = cvt_pk_bf16(v.x, v.y), h1 = cvt_pk_bf16(v.z, v.w);
                *(uint2*)(U + (size_t)tok * DM + d) = make_uint2(h0, h1);
                sc::st8(L0 + O_VH + tl * VP + d * 2, make_uint2(h0, h1));
                sc::st8(L0 + O_VL + tl * VP + d * 2, make_uint2(cvt_pk_bf16(v.x - bflo(h0), v.y - bfhi(h0)), cvt_pk_bf16(v.z - bflo(h1), v.w - bfhi(h1))));
            }
        }
        __syncthreads();
        {
            const int tt = wv & 1, et = wv >> 1;
            sc::f32x4 acc = (sc::f32x4){0.f, 0.f, 0.f, 0.f};
            const bf16_t* bh = RWH + (size_t)(et * 16 + r16) * 1024 + q4 * 8; const bf16_t* bl = RWL + (size_t)(et * 16 + r16) * 1024 + q4 * 8;
#pragma unroll 4
            for (int ks = 0; ks < 32; ++ks) {
                const sc::bf16x8 ah = sc::rd_row(L0 + O_VH, tt * 16 + r16, VP, ks * 32 + q4 * 8), al = sc::rd_row(L0 + O_VL, tt * 16 + r16, VP, ks * 32 + q4 * 8);
                const sc::bf16x8 wh = *(const sc::bf16x8*)(bh + ks * 32), wl = *(const sc::bf16x8*)(bl + ks * 32);
                acc = SC_MFMA(ah, wh, acc); acc = SC_MFMA(ah, wl, acc); acc = SC_MFMA(al, wh, acc);
            }
#pragma unroll
            for (int jj = 0; jj < 4; ++jj) *(LAS float*)(size_t)(L0 + O_LG + ((tt * 16 + q4 * 4 + jj) * 64 + et * 16 + r16) * 4) = acc[jj];
        }
        __syncthreads();
#pragma unroll 1
        for (int j = 0; j < tpw; ++j) {
            const int tl = wv * tpw + j, tok = base + tl;
            const float lg = *(const LAS float*)(size_t)(L0 + O_LG + (tl * 64 + lane) * 4);
            const float score = sigmoidf_(lg);
            const float key = score + rb;
            int rank = 0;
#pragma unroll
            for (int e = 0; e < 64; ++e) { const float ke = __builtin_bit_cast(float, __builtin_amdgcn_readlane(__builtin_bit_cast(int, key), e)); rank += (ke > key || (ke == key && e < lane)) ? 1 : 0; }
            const bool sel = rank < TOPK;
            const float gsum = wave_sum(sel ? score : 0.f);
            if (sel) {
                const int pos = __hip_atomic_fetch_add(lcnt + lane, 1, __ATOMIC_RELAXED, __HIP_MEMORY_SCOPE_WORKGROUP);
                tidx[tok * 8 + rank] = lane; tgate[tok * 8 + rank] = 2.5f * score / gsum; tpos[tok * 8 + rank] = pos;
            }
        }
        __syncthreads();
    }
    __syncthreads();
    if (tid < 64) ((int*)(p->ws + OFF_BCNT))[bid * 64 + tid] = lcnt[tid];
}

__device__ __forceinline__ void moe_offsets(KP p, int l, int ntok, LAS int* offs) {
    const int t = opaque_tid();
    if (t < 66) offs[t] = ((const int*)(p->ws + OFF_GOFFS))[t];
    __syncthreads();
}
__device__ __forceinline__ int moe_expert_of(const LAS int* offs, int row) { int e = 0;
#pragma unroll 1
    while (e < 64 && row >= offs[e + 1]) ++e;
    return e; }

__device__ __forceinline__ void ph_scatter(KP p, int l, int ntok, int bid, int nb, LAS unsigned char* lds) {
    LAS int* offs = (LAS int*)lds;
    LAS int* myb = offs + 128;
    LAS int* part = offs + 256;
    const int tid = opaque_tid();
    const int* bcnt = (const int*)(p->ws + OFF_BCNT);
    { const int e = tid & 63, pt = tid >> 6; int tot = 0, mine = 0;
#pragma unroll 4
      for (int b = pt; b < nb; b += 8) { const int c = bcnt[b * 64 + e]; tot += c; mine += (b < bid) ? c : 0; }
      part[pt * 64 + e] = tot; part[512 + pt * 64 + e] = mine; }
    __syncthreads();
    if (tid < 64) {
        int tot = 0, mine = 0;
#pragma unroll
        for (int i = 0; i < 8; ++i) { tot += part[i * 64 + tid]; mine += part[512 + i * 64 + tid]; }
        const int pc = (tot + 255) & ~255;
        int incl = pc;
#pragma unroll
        for (int o = 1; o < 64; o <<= 1) { const int t = SHU(incl, o); if (tid >= o) incl += t; }
        offs[tid] = incl - pc; myb[tid] = mine;
        if (tid == 63) { offs[64] = incl; offs[65] = incl + ntok; }
    }
    __syncthreads();
    if (bid == 0 && tid < 66) ((int*)(p->ws + OFF_GOFFS))[tid] = offs[tid];
    const int* tidx = (const int*)(p->ws + OFF_TIDX); const float* tgate = (const float*)(p->ws + OFF_TGATE); const int* tpos = (const int*)(p->ws + OFF_TPOS);
    int* stok = (int*)(p->ws + OFF_STOK); float* sgate = (float*)(p->ws + OFF_SGATE); int* sdst = (int*)(p->ws + OFF_SDST);
    int* tile_e = (int*)(p->ws + OFF_TILEE);
    const int nfr = (ntok >> 5) / nb, nsteps = nfr + (((ntok >> 5) % nb) ? 1 : 0);
#pragma unroll 1
    for (int step = 0; step < nsteps; ++step) {
        const bool full = step < nfr;
        const int ntk = full ? 32 : 8, base = full ? (step * nb + bid) * 32 : nfr * nb * 32 + bid * 8;
        if (tid < ntk * 9) {
            const int tok = base + tid / 9, sl = tid % 9;
            if (sl < 8) { const int i = tok * 8 + sl, e = tidx[i], row = offs[e] + myb[e] + tpos[i]; stok[row] = tok; sgate[row] = tgate[i]; sdst[row] = tok * 9 + sl; }
            else { const int row = offs[64] + tok; stok[row] = tok; sgate[row] = 1.f; sdst[row] = tok * 9 + 8; }
        }
    }
    const int nrt = offs[65] >> 8;
#pragma unroll 1
    for (int rt = bid * 512 + tid; rt < nrt; rt += nb * 512) tile_e[rt] = moe_expert_of(offs, rt * 256);
    __syncthreads();
}

#define MOE_TAB (gp::STAGE_BYTES + 256)
#define MOE_MAXT 9
static_assert(131072 + 256 + 256 + MOE_MAXT * 2048 <= BAR_LDS_, "MoE tables");
struct MoeDeal {
    int nfull, rem, c, G;
    __device__ __forceinline__ void init(int nrt, int c_, int G_) { nfull = nrt / G_; rem = nrt % G_; c = ((c_ & 7) << 5) | (c_ >> 3); G = G_; }
    __device__ __forceinline__ int nleft(int NPN) const { const int tot = rem * NPN; return c < tot ? (tot - c + G - 1) / G : 0; }
    __device__ __forceinline__ int ntiles(int NPN) const { return nfull + nleft(NPN); }
    __device__ __forceinline__ int tile_of(int j, int NPN) const { return j < nfull ? c + j * G : nfull * G + (c + (j - nfull) * G) / NPN; }
    __device__ __forceinline__ bool unit(int i, int NPN, int& j, int& pn) const {
        if (i < nfull * NPN) { j = i / NPN; pn = i % NPN; return true; }
        const int k = i - nfull * NPN, lu = c + k * G;
        if (lu < rem * NPN) { j = nfull + k; pn = lu % NPN; return true; }
        return false;
    }
};
struct Moe1Sched {
    const char* U; const char* W; const LAS int* tabE; const LAS int* tabS; MoeDeal d;
    __device__ __forceinline__ bool next(int i, gp::Unit& u) const {
        int j, pn; if (!d.unit(i, 2, j, pn)) return false;
        u.A = U; u.B = W + (size_t)tabE[j] * (512 * 1024 * 2) + (size_t)pn * (256 * 1024 * 2); u.r0 = d.tile_of(j, 2) * 256; u.c0 = pn * 256; u.aux = j; return true;
    }
    __device__ __forceinline__ void lane_off(const gp::Unit& u, unsigned (&vo)[2][2]) const {
        const int tid = opaque_tid(); int R0, C0, R1, C1; gp::stage_rc(tid * 16, R0, C0); gp::stage_rc(tid * 16 + 8192, R1, C1);
        const LAS int* t = tabS + u.aux * 256;
        vo[0][0] = (unsigned)t[R0] * 2048u + (unsigned)C0 * 2u; vo[0][1] = (unsigned)t[R1] * 2048u + (unsigned)C1 * 2u;
        vo[1][0] = (unsigned)t[128 + R0] * 2048u + (unsigned)C0 * 2u; vo[1][1] = (unsigned)t[128 + R1] * 2048u + (unsigned)C1 * 2u;
    }
};
struct EpiH {
    bf16_t* H;
    __device__ __forceinline__ void operator()(const gp::f32x4 (&acc)[2][2][4][2], const gp::Unit& u, int wr, int wc, int fr, int fq) const {
        const int row0 = u.r0 + wr * 64 + fr;
#pragma unroll
        for (int ai = 0; ai < 2; ++ai)
#pragma unroll
            for (int m = 0; m < 4; ++m) { bf16_t* rowp = H + (size_t)(row0 + ai * 128 + m * 16) * 256;
#pragma unroll
                for (int bj = 0; bj < 2; ++bj) {
                    const int j0 = ((u.c0 + bj * 128 + wc * 32) >> 5) * 16 + 4 * fq;
                    const gp::f32x4 a = acc[ai][bj][m][0], b = acc[ai][bj][m][1];
                    const float h0 = siluf_(a[0]) * b[0], h1 = siluf_(a[1]) * b[1], h2 = siluf_(a[2]) * b[2], h3 = siluf_(a[3]) * b[3];
                    *(uint2*)(rowp + j0) = make_uint2(cvt_pk_bf16(h0, h1), cvt_pk_bf16(h2, h3)); }
                __builtin_amdgcn_sched_barrier(0); }
    }
};
__device__ __forceinline__ void ph_moe1(KP p, int l, int ntok, int bid, int nb, LAS unsigned char* lds) {
    LAS int* tabE = (LAS int*)(lds + MOE_TAB);
    LAS int* tabS = tabE + 64;
    const int tid = opaque_tid();
    MoeDeal d; d.init(((const int*)(p->ws + OFF_GOFFS))[65] >> 8, bid, nb);
    const int nper = d.ntiles(2);
    const int* stok = (const int*)(p->ws + OFF_STOK); const int* tile_e = (const int*)(p->ws + OFF_TILEE);
    for (int i = tid; i < nper * 256; i += 512) tabS[i] = stok[(size_t)d.tile_of(i >> 8, 2) * 256 + (i & 255)];
    if (tid < nper) tabE[tid] = tile_e[d.tile_of(tid, 2)];
    __syncthreads();
    Moe1Sched S{(const char*)(p->ws + OFF_U), (const char*)(p->ws + OFF_W13), tabE, tabS, d};
    EpiH E{(bf16_t*)(p->ws + OFF_BIG)};
    gp::gemm_phase<true, false>(lds, 1024, S, E);
}

struct Moe2Sched {
    const char* H; const char* W; const LAS int* tabE; MoeDeal d;
    __device__ __forceinline__ bool next(int i, gp::Unit& u) const {
        int j, pn; if (!d.unit(i, 4, j, pn)) return false;
        u.A = H + (size_t)d.tile_of(j, 4) * (256 * 256 * 2); u.B = W + (size_t)tabE[j] * (1024 * 256 * 2) + (size_t)pn * (256 * 256 * 2); u.r0 = j * 256; u.c0 = pn * 256; u.aux = j; return true;
    }
    __device__ __forceinline__ void lane_off(const gp::Unit&, unsigned (&)[2][2]) const {}
};
__device__ __forceinline__ unsigned pk_fp8x4(float a, float b, float c, float d) { int w = __builtin_amdgcn_cvt_pk_fp8_f32(a, b, 0, false); w = __builtin_amdgcn_cvt_pk_fp8_f32(c, d, w, true); return (unsigned)w; }
struct EpiY {
    unsigned char* Ys; const LAS int* tabD; const LAS float* tabG;
    __device__ __forceinline__ void operator()(const gp::f32x4 (&acc)[2][2][4][2], const gp::Unit& u, int wr, int wc, int fr, int fq) const {
        const int rl0 = u.r0 + wr * 64 + fr, col0 = u.c0 + wc * 32 + 8 * fq;
#pragma unroll
        for (int ai = 0; ai < 2; ++ai)
#pragma unroll
            for (int m = 0; m < 4; ++m) {
                const int rl = rl0 + ai * 128 + m * 16;
                const int dst = tabD[rl]; const float g = tabG[rl];
                if (dst >= 0) { unsigned char* rowp = Ys + (size_t)dst * 1024 + col0;
#pragma unroll
                    for (int bj = 0; bj < 2; ++bj) { const gp::f32x4 v0 = acc[ai][bj][m][0] * g, v1 = acc[ai][bj][m][1] * g;
                        *(uint2*)(rowp + bj * 128) = make_uint2(pk_fp8x4(v0[0], v0[1], v0[2], v0[3]), pk_fp8x4(v1[0], v1[1], v1[2], v1[3])); } }
                __builtin_amdgcn_sched_barrier(0); }
    }
};
__device__ __forceinline__ void ph_moe2(KP p, int l, int ntok, int bid, int nb, LAS unsigned char* lds) {
    LAS int* tabE = (LAS int*)(lds + MOE_TAB);
    LAS int* tabD = tabE + 64;
    LAS float* tabG = (LAS float*)(tabD + MOE_MAXT * 256);
    const int tid = opaque_tid();
    MoeDeal d; d.init(((const int*)(p->ws + OFF_GOFFS))[65] >> 8, bid, nb);
    const int nper = d.ntiles(4);
    const int* sdst = (const int*)(p->ws + OFF_SDST); const float* sgate = (const float*)(p->ws + OFF_SGATE); const int* tile_e = (const int*)(p->ws + OFF_TILEE);
    for (int i = tid; i < nper * 256; i += 512) { const size_t r = (size_t)d.tile_of(i >> 8, 4) * 256 + (i & 255); tabD[i] = sdst[r]; tabG[i] = sgate[r]; }
    if (tid < nper) tabE[tid] = tile_e[d.tile_of(tid, 4)];
    __syncthreads();
    Moe2Sched S{(const char*)(p->ws + OFF_BIG), (const char*)(p->ws + OFF_W2), tabE, d};
    EpiY E{(unsigned char*)(p->ws + OFF_YS), tabD, tabG};
    gp::gemm_phase<false, true>(lds, 256, S, E);
}

template <bool NEXT>
__device__ __forceinline__ void ph_combine_ln2(KP p, int l, int ntok, int bid, int nb) {
    bf16_t* U = (bf16_t*)(p->ws + OFF_U);
    float* G = (float*)(p->ws + OFF_G);
    const bool gates = NEXT && ((l + 1) & 1) == 0;
    LAS float* wl = (LAS float*)smraw_base();
    if (gates) stage_gate_w(p, (l + 1) >> 1, wl);
    const int tid = opaque_tid(), lane = tid & 63, wv = tid >> 6;
    const unsigned char* Ys = (const unsigned char*)(p->ws + OFF_YS);
    const float* lw = p->in[I_LNW] + (l * 2 + 1) * 1024 + 16 * lane; const float* lb = p->in[I_LNB] + (l * 2 + 1) * 1024 + 16 * lane;
#pragma unroll 1
    for (int tok = bid * 8 + wv; tok < ntok; tok += nb * 8) {
        float* h = hrow(p, tok) + 16 * lane;
        const float* m = modrow(p, l, tok) + 16 * lane;
        const float* m2 = modrow(p, NEXT ? l + 1 : l, tok) + 16 * lane;
        float f[16];
#pragma unroll
        for (int i = 0; i < 16; ++i) f[i] = 0.f;
#pragma unroll
        for (int s9 = 0; s9 < 9; ++s9) {
            const uint4 w = *(const uint4*)(Ys + ((size_t)tok * 9 + s9) * 1024 + 16 * lane);
            const unsigned ww[4] = {w.x, w.y, w.z, w.w};
#pragma unroll
            for (int q = 0; q < 4; ++q) { const f32x2_n lo = __builtin_amdgcn_cvt_pk_f32_fp8((int)ww[q], false), hi = __builtin_amdgcn_cvt_pk_f32_fp8((int)ww[q], true);
                f[4 * q] += lo[0]; f[4 * q + 1] += lo[1]; f[4 * q + 2] += hi[0]; f[4 * q + 3] += hi[1]; }
        }
        float x[16]; float sum = 0.f;
#pragma unroll
        for (int q = 0; q < 4; ++q) {
            const float4 hv = *(const float4*)(h + 4 * q), gv = *(const float4*)(m + 5 * 1024 + 4 * q);
            x[4 * q] = ALPHA * hv.x + gv.x * f[4 * q]; x[4 * q + 1] = ALPHA * hv.y + gv.y * f[4 * q + 1]; x[4 * q + 2] = ALPHA * hv.z + gv.z * f[4 * q + 2]; x[4 * q + 3] = ALPHA * hv.w + gv.w * f[4 * q + 3];
            sum += x[4 * q] + x[4 * q + 1] + x[4 * q + 2] + x[4 * q + 3];
        }
        const float mean = wave_sum(sum) * (1.f / 1024.f);
        float q2 = 0.f;
#pragma unroll
        for (int i = 0; i < 16; ++i) { x[i] -= mean; q2 += x[i] * x[i]; }
        const float rs = rsqrtf(wave_sum(q2) * (1.f / 1024.f) + LN_EPS);
        float u16[16];
#pragma unroll
        for (int q = 0; q < 4; ++q) {
            const float4 w4 = *(const float4*)(lw + 4 * q), b4 = *(const float4*)(lb + 4 * q);
            float4 y; y.x = x[4 * q] * rs * w4.x + b4.x; y.y = x[4 * q + 1] * rs * w4.y + b4.y; y.z = x[4 * q + 2] * rs * w4.z + b4.z; y.w = x[4 * q + 3] * rs * w4.w + b4.w;
            *(float4*)(h + 4 * q) = y;
            if (NEXT) {
                const float4 sh = *(const float4*)(m2 + 4 * q), sc = *(const float4*)(m2 + 1024 + 4 * q);
                u16[4 * q] = y.x * (1.f + sc.x) + sh.x; u16[4 * q + 1] = y.y * (1.f + sc.y) + sh.y; u16[4 * q + 2] = y.z * (1.f + sc.z) + sh.z; u16[4 * q + 3] = y.w * (1.f + sc.w) + sh.w;
            }
        }
        if (NEXT) {
            uint4* up = (uint4*)(U + (size_t)tok * DM + 16 * lane);
            up[0] = make_uint4(cvt_pk_bf16(u16[0], u16[1]), cvt_pk_bf16(u16[2], u16[3]), cvt_pk_bf16(u16[4], u16[5]), cvt_pk_bf16(u16[6], u16[7]));
            up[1] = make_uint4(cvt_pk_bf16(u16[8], u16[9]), cvt_pk_bf16(u16[10], u16[11]), cvt_pk_bf16(u16[12], u16[13]), cvt_pk_bf16(u16[14], u16[15]));
        }
        if (gates) {
            float ga[16];
#pragma unroll
            for (int j = 0; j < 16; ++j) ga[j] = 0.f;
#pragma unroll
            for (int g4 = 0; g4 < 4; ++g4) {
#pragma unroll
                for (int qq = 0; qq < 4; ++qq) {
                    const float uv = u16[4 * g4 + qq];
#pragma unroll
                    for (int j4 = 0; j4 < 4; ++j4) { const f32x4_l w = *(const LAS f32x4_l*)(wl + (16 * lane + 4 * g4 + qq) * 16 + j4 * 4); ga[4 * j4] += uv * w[0]; ga[4 * j4 + 1] += uv * w[1]; ga[4 * j4 + 2] += uv * w[2]; ga[4 * j4 + 3] += uv * w[3]; }
                }
                __builtin_amdgcn_sched_barrier(0);
            }
            float mine = 0.f;
#pragma unroll
            for (int j = 0; j < 16; ++j) { const float sg = wave_sum(ga[j]); if (lane == j) mine = sg; }
            if (lane < 16) G[(size_t)tok * 16 + lane] = mine;
        }
    }
}

#define MEGA_LDS (131072 + 256 + 20480)
#define NBLK 256
#define BAR_LDS BAR_LDS_
#define SYNC() do { XcdBarrier _b; _b.bar = (unsigned*)kparams()->ws; _b.x = xb_xcc_id(); _b.st = (volatile LAS unsigned*)((LAS unsigned char*)smraw_base() + BAR_LDS); xcd_barrier(_b); } while (0)
template <int PAR>
__device__ __forceinline__ void layer_fwd(const int l) {
    LAS unsigned char* lds = smraw_base(); float* sm = (float*)smraw_generic();
    const int bid = blockIdx.x; constexpr int nb = NBLK;
    const int ntok = (l == 3) ? NL : NT;
    ph_gemm_in(kparams(), l, bid, nb, lds); SYNC();
    if (PAR == 0) {
        ph_scan_even2(kparams(), l, bid, nb); SYNC();
        ph_normgate_even(kparams(), l, bid, nb); SYNC();
    } else {
        ph_hy_prep(kparams(), l, bid, nb, sm); SYNC();
        ph_mix_odd(kparams(), l, bid, nb, sm); SYNC();
        ph_hy_norm(kparams(), l, bid, nb, sm); ph_normgate_odd(kparams(), l, bid, nb); SYNC();
    }
    ph_gemm_out(kparams(), l, bid, nb, lds); SYNC();
    ph_ln1_router(kparams(), l, ntok, bid, nb, sm); SYNC();
    ph_scatter(kparams(), l, ntok, bid, nb, lds); SYNC();
    ph_moe1(kparams(), l, ntok, bid, nb, lds); SYNC();
    ph_moe2(kparams(), l, ntok, bid, nb, lds); SYNC();
    if (l < 3) { ph_combine_ln2<true>(kparams(), l, ntok, bid, nb); ph_convert(kparams(), l + 1, bid, nb, sm); SYNC(); }
    else ph_combine_ln2<false>(kparams(), l, ntok, bid, nb);
}
__global__ void __launch_bounds__(512, 2) mega_fwd(Params p) {
    LAS unsigned char* lds = smraw_base(); float* sm = (float*)smraw_generic();
    {
        const int t0 = threadIdx.x;
        if ((t0 & 63) == 0) { unsigned h; asm volatile("s_getreg_b32 %0, hwreg(HW_REG_HW_ID, 0, 6)" : "=s"(h)); *(LAS int*)(size_t)(WTAB_LDS + (h & 63u) * 4u) = t0 >> 6; }
        if (t0 < 4) ((LAS unsigned*)(lds + BAR_LDS))[t0] = 0u;
    }
    __syncthreads();
    (void)xcd_barrier_post((unsigned*)kparams()->ws, (volatile LAS unsigned*)(lds + BAR_LDS));
    const int bid = blockIdx.x; constexpr int nb = NBLK;
    ph_prologue(kparams(), bid, nb, sm);
    __syncthreads();
    ph_hy_filt2(kparams(), 1, bid, nb, sm, 48); __syncthreads(); ph_hy_filt2(kparams(), 3, bid, nb, sm, 48); __syncthreads(); ph_convert(kparams(), 0, bid, nb, sm);
    SYNC();
    ph_modin<true>(kparams(), 0, bid, nb); SYNC();
#pragma unroll 1
    for (int lp = 0; lp < 2; ++lp) {
        layer_fwd<0>(2 * lp);
        layer_fwd<1>(2 * lp + 1);
    }
    __syncthreads();
    if (blockIdx.x == 0 && opaque_tid() == 0 && xb_ld((unsigned*)kparams()->ws + XB_TMO) != 0u) kparams()->out[0] = __builtin_nanf("");
}

extern "C" void kernel_launch(void* const* d_in, const int* in_sizes, int n_in, void* d_out, int out_size, void* d_ws, size_t ws_size, hipStream_t stream) {
    static int grid = 0;
    if (grid == 0) {
        if (n_in != 38 || out_size != NL * DM || ws_size < WS_END) { fprintf(stderr, "kernel_launch: bad shapes n_in %d out %d ws %zu (need %zu)\n", n_in, out_size, ws_size, (size_t)WS_END); grid = -1; return; }
        int dev = 0, cus = 0, per_cu = 0;
        if (hipGetDevice(&dev) != hipSuccess || hipDeviceGetAttribute(&cus, hipDeviceAttributeMultiprocessorCount, dev) != hipSuccess) { grid = -1; return; }
        if (hipFuncSetAttribute((const void*)mega_fwd, hipFuncAttributeMaxDynamicSharedMemorySize, MEGA_LDS) != hipSuccess) { fprintf(stderr, "kernel_launch: hipFuncSetAttribute failed\n"); grid = -1; return; }
        if (hipOccupancyMaxActiveBlocksPerMultiprocessor(&per_cu, (const void*)mega_fwd, 512, MEGA_LDS) != hipSuccess || per_cu < 1) { fprintf(stderr, "kernel_launch: occupancy query says %d\n", per_cu); (void)hipGetLastError(); grid = -1; return; }
        if (cus != 256) { fprintf(stderr, "kernel_launch: built for 256 CUs, found %d\n", cus); grid = -1; return; }
        grid = NBLK;
    }
    if (grid < 0) return;
    if (hipMemsetAsync(d_ws, 0, OFF_LB, stream) != hipSuccess) return;
    Params p{};
    for (int i = 0; i < 38; ++i) p.in[i] = (const float*)d_in[i];
    p.out = (float*)d_out; p.ws = (unsigned char*)d_ws;
    hipLaunchKernelGGL(mega_fwd, dim3(grid), dim3(512), MEGA_LDS, stream, p);
}
```

```cpp
#include <hip/hip_runtime.h>
#include <stdint.h>
#include <stdio.h>

#define DM 1024
#define NBATCH 8
#define SEQ 4096
#define CTXL 256
#define NL (NBATCH * SEQ)
#define NC (NBATCH * CTXL)
#define NT (NL + NC)
#define ZROW NT
#define TOPK 8
#define EVEN_N 4112
#define ODD_N 3584
#define EVEN_LD 4096
#define ODD_LD 3584
#define MAXROWS (NT * 8 + 64 * 256 + NT)
#define ALPHA 1.681792830507429f
#define LN_EPS 1e-5f
#define E_MQ 0
#define E_MK 256
#define E_MV 512
#define E_MO 1024
#define E_HQ 1536
#define E_HI 2048
#define E_HFF 2560
#define E_HFB 3072
#define E_HG 3584

typedef unsigned short bf16_t;
#define LAS __attribute__((address_space(3)))
#define BAR_LDS_ 150528

#define MiB ((size_t)1 << 20)
#define OFF_CNT   ((size_t)64 << 10)
#define OFF_LB    ((size_t)96 << 10)
#define OFF_MOD   ((size_t)128 << 10)
#define OFF_ROPE  ((size_t)1536 << 10)
#define OFF_BCNT  ((size_t)1600 << 10)
#define OFF_GOFFS ((size_t)1700 << 10)
#define OFF_RWH   ((size_t)2560 << 10)
#define OFF_TILEE (2 * MiB)
#define OFF_HCTX  (4 * MiB)
#define OFF_TIDX  (12 * MiB)
#define OFF_TGATE (14 * MiB)
#define OFF_TPOS  (16 * MiB)
#define OFF_STOK  (18 * MiB)
#define OFF_SGATE (20 * MiB)
#define OFF_SDST  (22 * MiB)
#define OFF_G     (24 * MiB)
#define OFF_U     (28 * MiB)
#define OFF_W     (98 * MiB)
#define OFF_WIN   (OFF_W)
#define OFF_WOUT  (OFF_W + 8 * MiB)
#define OFF_W13   (OFF_W + 10 * MiB)
#define OFF_W2    (OFF_W + 75 * MiB)
#define OFF_BIG   (208 * MiB)
#define OFF_AUX   (480 * MiB)
#define OFF_Z1    (OFF_AUX + 136 * MiB)
#define OFF_Z2    (OFF_Z1 + 68 * MiB)
#define OFF_FILT  (OFF_Z2 + 68 * MiB)
#define OFF_YS    (370 * MiB)
#define OFF_W13X  (822 * MiB)
#define OFF_W13L(l) (((l) & 1) ? OFF_W13X : OFF_W13)
#define OFF_HB    (900 * MiB)
#define WS_END    (1052 * MiB)

struct Params {
    const float* in[38];
    float* out;
    unsigned char* ws;
};

enum { I_X = 0, I_C, I_CTX, I_CCTX, I_ADAW, I_ADAB, I_LNW, I_LNB, I_EWIN, I_MGB, I_MNW, I_HLB, I_HNW, I_EWOUT, I_OWIN, I_HCW, I_HCB,
       I_HW1, I_HB1, I_HW2, I_HB2, I_HW3, I_HB3, I_HFREQ, I_HWOUT, I_HSKIP, I_HNORM, I_RLD, I_RNW, I_OWOUT, I_RW, I_RB, I_W1, I_W3, I_W2, I_SW1, I_SW3, I_SW2 };

typedef const __attribute__((address_space(4))) Params* KP;
__device__ __forceinline__ KP kparams() { KP k = (KP)__builtin_amdgcn_kernarg_segment_ptr(); asm volatile("" : "+s"(k)); return k; }
extern __shared__ __attribute__((aligned(16))) unsigned char smraw_all[];
__device__ __forceinline__ LAS unsigned char* smraw_base() { return (LAS unsigned char*)smraw_all; }
__device__ __forceinline__ unsigned char* smraw_generic() { return smraw_all; }
#define WTAB_LDS (BAR_LDS_ + 512)
__device__ __forceinline__ int opaque_tid() {
    unsigned h; asm volatile("s_getreg_b32 %0, hwreg(HW_REG_HW_ID, 0, 6)" : "=s"(h));
    const int wid = *(volatile LAS int*)(size_t)(WTAB_LDS + (h & 63u) * 4u);
    unsigned m = ~0u; asm volatile("" : "+s"(m));
    const int lane = (int)__builtin_amdgcn_mbcnt_hi(m, __builtin_amdgcn_mbcnt_lo(m, 0u));
    return __builtin_amdgcn_readfirstlane(wid) * 64 + lane;
}
typedef __bf16 bf16x2_n __attribute__((ext_vector_type(2)));
typedef float f32x2_n __attribute__((ext_vector_type(2)));
__device__ __forceinline__ unsigned cvt_pk_bf16(float lo, float hi) { const f32x2_n v = {lo, hi}; return __builtin_bit_cast(unsigned, __builtin_convertvector(v, bf16x2_n)); }
__device__ __forceinline__ float bf2f(bf16_t b) { return __uint_as_float(((unsigned)b) << 16); }
__device__ __forceinline__ float bflo(unsigned w) { return __uint_as_float(w << 16); }
__device__ __forceinline__ float bfhi(unsigned w) { return __uint_as_float(w & 0xffff0000u); }
__device__ __forceinline__ float ldf(const float* p) { return *p; }
__device__ __forceinline__ float ldf(const bf16_t* p) { return bf2f(*p); }
__device__ __forceinline__ void stf(float* p, float v) { *p = v; }
__device__ __forceinline__ void stf(bf16_t* p, float v) { *p = (bf16_t)(cvt_pk_bf16(v, 0.f) & 0xffffu); }
__device__ __forceinline__ float sigmoidf_(float x) { return 1.f / (1.f + expf(-x)); }
__device__ __forceinline__ float siluf_(float x) { return x / (1.f + expf(-x)); }
__device__ __forceinline__ int olane() { unsigned m = ~0u; asm volatile("" : "+s"(m)); return (int)__builtin_amdgcn_mbcnt_hi(m, __builtin_amdgcn_mbcnt_lo(m, 0u)); }
template <class T> __device__ __forceinline__ T shfl_idx(T v, int idx) { return __builtin_bit_cast(T, __builtin_amdgcn_ds_bpermute(idx << 2, __builtin_bit_cast(int, v))); }
#define SHX(v, o) shfl_idx(v, olane() ^ (o))
#define SHI(v, i) shfl_idx(v, (i))
#define SHI32(v, i) shfl_idx(v, (olane() & 32) | ((i) & 31))
#define SHU(v, o) shfl_idx(v, olane() - (o))
__device__ __forceinline__ float fexp(float x) { return __builtin_amdgcn_exp2f(x * 1.4426950408889634f); }
__device__ __forceinline__ float flog(float x) { return __builtin_amdgcn_logf(x) * 0.6931471805599453f; }
__device__ __forceinline__ float frcp(float x) { return __builtin_amdgcn_rcpf(x); }
__device__ __forceinline__ float fsigmoid(float x) { return frcp(1.f + fexp(-x)); }
__device__ __forceinline__ float fsilu(float x) { return x * frcp(1.f + fexp(-x)); }
#define WS_DPP(v, ctrl, rmask) __builtin_bit_cast(float, __builtin_amdgcn_update_dpp(0, __builtin_bit_cast(int, v), ctrl, rmask, 0xf, false))
#define WS_DPPI(v, ident, ctrl, rmask) __builtin_bit_cast(float, __builtin_amdgcn_update_dpp(__builtin_bit_cast(int, (float)(ident)), __builtin_bit_cast(int, v), ctrl, rmask, 0xf, false))
__device__ __forceinline__ float wave_sum(float v) {
    v += WS_DPP(v, 0x111, 0xf); v += WS_DPP(v, 0x112, 0xf); v += WS_DPP(v, 0x114, 0xf); v += WS_DPP(v, 0x118, 0xf);
    v += WS_DPP(v, 0x142, 0xa); v += WS_DPP(v, 0x143, 0xc);
    return __builtin_bit_cast(float, __builtin_amdgcn_readlane(__builtin_bit_cast(int, v), 63));
}
__device__ __forceinline__ bf16_t* hrow(KP p, int tok) { return (bf16_t*)(p->ws + OFF_HB) + (size_t)tok * DM; }
__device__ __forceinline__ const float* modrow(KP p, int l, int tok) {
    const int r = tok < NL ? (tok >> 12) : 8;
    return (const float*)(p->ws + OFF_MOD) + ((size_t)l * 9 + r) * 6144;
}
__device__ __forceinline__ int scan_tok(int b, int i, int dir) {
    return i < CTXL ? NL + b * CTXL + (dir ? CTXL - 1 - i : i) : b * SEQ + (dir ? SEQ - 1 - (i - CTXL) : (i - CTXL));
}

#define XB_TMO      128
#define XB_XCNT(j)  (256  + 64 * (j))
#define XB_XSUB(j)  (1280 + 64 * (j))
#define XB_XGEN(j)  (2304 + 64 * (j))
#define XB_TOP      3328
#define XB_TOPGEN   3392
#define XCD_BAR_WORDS 3456
#define XB_SPIN_CAP (1u << 24)
__device__ __forceinline__ unsigned xb_ld(unsigned* p)              { return __hip_atomic_load(p, __ATOMIC_RELAXED, __HIP_MEMORY_SCOPE_AGENT); }
__device__ __forceinline__ unsigned xb_add(unsigned* p, unsigned v) { return __hip_atomic_fetch_add(p, v, __ATOMIC_RELAXED, __HIP_MEMORY_SCOPE_AGENT); }
__device__ __forceinline__ unsigned xb_xcc_id() { return (unsigned)__builtin_amdgcn_s_getreg((3 << 11) | 20) & 0xFu; }
#define XB_SPIN(cond, bar) do { unsigned _sp = 0; while (cond) { __builtin_amdgcn_s_sleep(1); \
    if ((++_sp & 255u) == 0u) { if (xb_ld(&(bar)[XB_TMO])) break; if (_sp > XB_SPIN_CAP) { atomicAdd(&(bar)[XB_TMO], 1u); break; } } } } while (0)
struct XcdBarrier { unsigned* bar; unsigned x; volatile LAS unsigned* st; };
__device__ __forceinline__ XcdBarrier xcd_barrier_post(unsigned* bar, volatile LAS unsigned* st) {
    XcdBarrier b; b.bar = bar; b.x = xb_xcc_id(); b.st = st;
    if (opaque_tid() == 0) (void)xb_add(&bar[XB_XCNT(b.x)], 1u);
    return b;
}
__device__ __forceinline__ void xcd_barrier_complete(unsigned* bar, unsigned x, unsigned& nloc, unsigned& nx) {
    const unsigned G = gridDim.x * gridDim.y * gridDim.z;
    unsigned sum, cnt, mine, sp = 0u;
    for (;;) {
        sum = 0u; cnt = 0u; mine = 0u;
#pragma unroll
        for (unsigned j = 0; j < 16; ++j) { const unsigned c = xb_ld(&bar[XB_XCNT(j)]); sum += c; cnt += (c > 0u) ? 1u : 0u; mine = (j == x) ? c : mine; }
        if (sum == G) break;
        __builtin_amdgcn_s_sleep(1);
        if ((++sp & 255u) == 0u) { if (xb_ld(&bar[XB_TMO])) break; if (sp > XB_SPIN_CAP) { atomicAdd(&bar[XB_TMO], 1u); break; } }
    }
    nloc = mine > 0u ? mine : 1u; nx = cnt > 0u ? cnt : 1u;
}
__device__ __forceinline__ void xcd_barrier(const XcdBarrier& b) {
    asm volatile("s_waitcnt vmcnt(0)" ::: "memory");
    __syncthreads();
    if (opaque_tid() == 0) {
        unsigned* bar = b.bar;
        __builtin_amdgcn_s_waitcnt(0);
        unsigned nloc = b.st[0], nx = b.st[1];
        if (nloc == 0u) { xcd_barrier_complete(bar, b.x, nloc, nx); b.st[0] = nloc; b.st[1] = nx; }
        const unsigned old = xb_add(&bar[XB_XSUB(b.x)], 1u);
        const unsigned gen = old / nloc;
        if (old + 1u == (gen + 1u) * nloc) {
            __builtin_amdgcn_fence(__ATOMIC_RELEASE, "agent");
            asm volatile("s_waitcnt vmcnt(0)" ::: "memory");
            const unsigned og = xb_add(&bar[XB_TOP], 1u);
            const unsigned tg = og / nx;
            if (og + 1u == (tg + 1u) * nx) xb_add(&bar[XB_TOPGEN], 1u);
            else XB_SPIN(xb_ld(&bar[XB_TOPGEN]) == tg, bar);
            __builtin_amdgcn_fence(__ATOMIC_ACQUIRE, "agent");
            xb_add(&bar[XB_XGEN(b.x)], 1u);
            asm volatile("s_waitcnt vmcnt(0)" ::: "memory");
        } else {
            XB_SPIN(xb_ld(&bar[XB_XGEN(b.x)]) == gen, bar);
            __builtin_amdgcn_fence(__ATOMIC_ACQUIRE, "agent");
            asm volatile("s_waitcnt vmcnt(0)" ::: "memory");
        }
    }
    __syncthreads();
}

__device__ __forceinline__ void ph_prologue(KP p, int bid, int nb, float* sm) {
    const int tid = opaque_tid();
    if (bid == 0) {
        bf16_t* z = (bf16_t*)(p->ws + OFF_U) + (size_t)ZROW * DM;
        for (int i = tid; i < DM; i += 512) z[i] = 0;
    }
    if (bid == 1 % nb) {
        float* lb = (float*)(p->ws + OFF_LB);
        const float* hl = p->in[I_HLB];
        for (int j = tid; j < 512; j += 512) {
            const float a = hl[j], b = hl[512 + j], mx = fmaxf(a, b);
            const float ea = expf(a - mx), eb = expf(b - mx);
            lb[j] = 0.f; lb[512 + j] = eb / (ea + eb);
        }
    }
    if (bid == 2 % nb) {
        float2* rt = (float2*)(p->ws + OFF_ROPE);
        for (int i = tid; i < 64 * 32; i += 512) { const float ang = (float)(i >> 5) * powf(10000.f, -(float)(2 * (i & 31)) / 64.f); rt[i] = make_float2(cosf(ang), sinf(ang)); }
    }
    {
        float* act = sm;
        float* part = sm + 9 * 1024;
        bool filled = false;
        #pragma unroll 1
        for (int item = bid; item < 192; item += nb) {
            if (!filled) {
                for (int i = tid; i < 9 * 1024; i += 512) {
                    const int r = i >> 10, k = i & 1023;
                    const float v = r < 8 ? p->in[I_C][r * 1024 + k] : p->in[I_CCTX][k];
                    act[i] = siluf_(v);
                }
                filled = true;
            }
            __syncthreads();
            const int l = item / 48, jj = tid & 127, kq = tid >> 7, j = (item % 48) * 128 + jj;
            const float* w = p->in[I_ADAW] + (size_t)l * 1024 * 6144 + j;
            float acc[9];
#pragma unroll
            for (int r = 0; r < 9; ++r) acc[r] = 0.f;
#pragma unroll 8
            for (int k = kq * 256; k < kq * 256 + 256; ++k) {
                const float wv = w[(size_t)k * 6144];
#pragma unroll
                for (int r = 0; r < 9; ++r) acc[r] += act[r * 1024 + k] * wv;
            }
#pragma unroll
            for (int r = 0; r < 9; ++r) part[(kq * 9 + r) * 128 + jj] = acc[r];
            __syncthreads();
            float* mod = (float*)(p->ws + OFF_MOD);
            for (int i = tid; i < 9 * 128; i += 512) {
                const int r = i >> 7, c = i & 127;
                mod[((size_t)l * 9 + r) * 6144 + (item % 48) * 128 + c] = part[(0 * 9 + r) * 128 + c] + part[(1 * 9 + r) * 128 + c] + part[(2 * 9 + r) * 128 + c] + part[(3 * 9 + r) * 128 + c] + p->in[I_ADAB][l * 6144 + (item % 48) * 128 + c];
            }
        }
    }
}


struct CvtTile { const float* src; int srcld; bf16_t* dst; int dstld; int k0, n0; };
__device__ __forceinline__ CvtTile cvt_tile_of(KP p, int l, int t, int np4  ) {
    const bool even = (l & 1) == 0;
    const int NP = even ? EVEN_LD : ODD_LD;
    const int t_in = 16 * (NP / 128), t_out = 16 * 8, t_13 = 65 * 16 * 4;
    CvtTile c;
    if (t < t_in) {
        const int kt = t & 15, nt = t >> 4, n = nt * 128 + np4;
        const float* W = even ? p->in[I_EWIN] + (size_t)(l >> 1) * 1024 * EVEN_N : p->in[I_OWIN] + (size_t)(l >> 1) * 1024 * ODD_N;
        c.src = W + ((even && n >= 1536) ? n + 16 : n); c.srcld = even ? EVEN_N : ODD_N; c.dst = (bf16_t*)(p->ws + OFF_WIN); c.dstld = 1024; c.k0 = kt * 64; c.n0 = nt * 128;
    } else if (t < t_in + t_out) {
        const int u = t - t_in, kt = u & 15, nt = u >> 4;
        c.src = (even ? p->in[I_EWOUT] : p->in[I_OWOUT]) + (size_t)(l >> 1) * 1024 * 1024 + nt * 128 + np4; c.srcld = 1024; c.dst = (bf16_t*)(p->ws + OFF_WOUT); c.dstld = 1024; c.k0 = kt * 64; c.n0 = nt * 128;
    } else if (t < t_in + t_out + t_13) {
        const int u = t - t_in - t_out, e = u >> 6, kt = u & 15, nt = (u >> 4) & 3, n = nt * 128 + np4, g = n >> 5, w = n & 31;
        const float* w1 = e < 64 ? p->in[I_W1] + ((size_t)l * 64 + e) * 1024 * 256 : p->in[I_SW1] + (size_t)l * 1024 * 256;
        const float* w3 = e < 64 ? p->in[I_W3] + ((size_t)l * 64 + e) * 1024 * 256 : p->in[I_SW3] + (size_t)l * 1024 * 256;
        c.src = w < 16 ? w1 + 16 * g + w : w3 + 16 * g + w - 16; c.srcld = 256; c.dst = (bf16_t*)(p->ws + OFF_W13L(l)) + (size_t)e * 512 * 1024; c.dstld = 1024; c.k0 = kt * 64; c.n0 = nt * 128;
    } else {
        const int u = t - t_in - t_out - t_13, e = u >> 5, kt = u & 3, nt = (u >> 2) & 7;
        const float* w2 = e < 64 ? p->in[I_W2] + ((size_t)l * 64 + e) * 256 * 1024 : p->in[I_SW2] + (size_t)l * 256 * 1024;
        c.src = w2 + nt * 128 + np4; c.srcld = 1024; c.dst = (bf16_t*)(p->ws + OFF_W2) + (size_t)e * 1024 * 256; c.dstld = 256; c.k0 = kt * 64; c.n0 = nt * 128;
    }
    return c;
}
__device__ __forceinline__ void ph_convert(KP p, int l, int bid, int nb, float* sm, const int part = 0) {
    const int tid = opaque_tid();
    const int NP = ((l & 1) == 0) ? EVEN_LD : ODD_LD;
    const int t_io = 16 * (NP / 128) + 16 * 8, t_13_ = 65 * 16 * 4;
    const int total = (part == 1) ? t_13_ : (part == 2) ? t_io + 65 * 4 * 8 : t_io + t_13_ + 65 * 4 * 8;
    auto tmap = [&](int t) { return (part == 1) ? t + t_io : (part == 2 && t >= t_io) ? t + t_13_ : t; };
    const int kr = tid >> 5, np4 = (tid & 31) * 4;
    float4 v[4];
    int t = bid;
    CvtTile c = cvt_tile_of(p, l, tmap(t < total ? t : 0), np4);
    if (t < total) {
#pragma unroll
        for (int j = 0; j < 4; ++j) v[j] = *(const float4*)(c.src + (size_t)(c.k0 + kr + 16 * j) * c.srcld);
    }
#pragma unroll 1
    for (; t < total; t += nb) {
        __syncthreads();
#pragma unroll
        for (int j = 0; j < 4; ++j) { float* d = sm + (np4) * 65 + kr + 16 * j; d[0] = v[j].x; d[65] = v[j].y; d[130] = v[j].z; d[195] = v[j].w; }
        const CvtTile cur = c;
        const int tn = t + nb;
        if (tn < total) {
            c = cvt_tile_of(p, l, tmap(tn), np4);
#pragma unroll
            for (int j = 0; j < 4; ++j) v[j] = *(const float4*)(c.src + (size_t)(c.k0 + kr + 16 * j) * c.srcld);
        }
        __syncthreads();
        const int n = tid >> 2, kc = (tid & 3) * 16;
        unsigned w[8];
#pragma unroll
        for (int q = 0; q < 8; ++q) w[q] = cvt_pk_bf16(sm[n * 65 + kc + 2 * q], sm[n * 65 + kc + 2 * q + 1]);
        uint4* d4 = (uint4*)(cur.dst + (size_t)(cur.n0 + n) * cur.dstld + cur.k0 + kc);
        d4[0] = make_uint4(w[0], w[1], w[2], w[3]); d4[1] = make_uint4(w[4], w[5], w[6], w[7]);
    }
    __syncthreads();
    if (bid < 8 && part != 1) {
        const float* rw = p->in[I_RW] + (size_t)l * 1024 * 64;
        bf16_t* hi = (bf16_t*)(p->ws + OFF_RWH); bf16_t* lo = hi + 64 * 1024;
        const int e = tid & 63, kb = bid * 128 + (tid >> 6) * 16;
#pragma unroll
        for (int i = 0; i < 16; i += 2) {
            const float x0 = rw[(size_t)(kb + i) * 64 + e], x1 = rw[(size_t)(kb + i + 1) * 64 + e];
            const unsigned h = cvt_pk_bf16(x0, x1);
            const unsigned lw = cvt_pk_bf16(x0 - bflo(h), x1 - bfhi(h));
            *(unsigned*)(hi + (size_t)e * 1024 + kb + i) = h; *(unsigned*)(lo + (size_t)e * 1024 + kb + i) = lw;
        }
    }
}

namespace gp {
typedef short bf16x8 __attribute__((ext_vector_type(8)));
typedef float f32x4 __attribute__((ext_vector_type(4)));
typedef unsigned u32x4 __attribute__((ext_vector_type(4)));
typedef unsigned u32x2 __attribute__((ext_vector_type(2)));
constexpr int BM = 256, BK = 64, HALF = 128, HTB = HALF * BK * 2, STAGE_BYTES = 8 * HTB, NXCD = 8, WGM = 8;
__device__ __forceinline__ int lds_byte(int r, int c) { const int st = (r >> 4) * 2 + (c >> 5), rr = r & 15, cc = c & 31, ob = rr * 64 + cc * 2; return st * 1024 + (ob ^ (((ob >> 9) & 1) << 5)); }
__device__ __forceinline__ void stage_rc(int b, int& R, int& C) { const int st = b / 1024, sb = b % 1024, swz = sb ^ (((sb >> 9) & 1) << 5); R = (st >> 1) * 16 + swz / 64; C = (st & 1) * 32 + (swz % 64) / 2; }
__device__ __forceinline__ int perm32(int rho) { const int n = rho >> 4, i = rho & 15; return 8 * (i >> 2) + 4 * n + (i & 3); }

struct Unit { const char* A; const char* B; int r0, c0, aux; };

struct DenseSched {
    const char* A; const char* B; int nM, nN, nwg, G, c; size_t tstep;
    __device__ __forceinline__ void init(const void* A_, const void* B_, int M, int N, int K, int G_, int c_) { A = (const char*)A_; B = (const char*)B_; nM = M / BM; nN = N / BM; nwg = nM * nN; G = G_; c = c_; tstep = (size_t)BM * K * 2; }
    __device__ __forceinline__ bool next(int i, Unit& u) const {
        const long L = (long)i * G + c; if (L >= nwg) return false;
        int wgid = (int)L; { const int q = nwg / NXCD, r = nwg % NXCD, xcd = wgid % NXCD, off = wgid / NXCD; wgid = (xcd < r ? xcd * (q + 1) : r * (q + 1) + (xcd - r) * q) + off; }
        const int nig = WGM * nN, gid = wgid / nig, fm = gid * WGM, gsz = (nM - fm) < WGM ? (nM - fm) : WGM;
        const int pm = fm + ((wgid % nig) % gsz), pn = (wgid % nig) / gsz;
        u.A = A + (size_t)pm * tstep; u.B = B + (size_t)pn * tstep; u.r0 = pm * BM; u.c0 = pn * BM; u.aux = 0; return true;
    }
    __device__ __forceinline__ void lane_off(const Unit&, unsigned (&)[2][2]) const {}
};

template <bool GATHER, bool PERM, bool DEFER, class Sched, class Epi>
__device__ __forceinline__ void gemm_phase(LAS unsigned char* lds, const int K_, const Sched& S, const Epi& E) {
    int K = K_; asm volatile("" : "+s"(K));
    const int tid = opaque_tid(), wid = __builtin_amdgcn_readfirstlane(tid >> 6), lane = tid & 63, wr = wid >> 2, wc = wid & 3, fr = lane & 15, fq = lane >> 4;
    const int nt = K / BK;
    unsigned voffA[2], voffB[2];
#pragma unroll
    for (int i = 0; i < 2; ++i) { int R, C; stage_rc(tid * 16 + i * 8192, R, C); const int Rb = PERM ? ((R & ~31) + perm32(R & 31)) : R;
        voffA[i] = (unsigned)(R * K + C) * 2u; voffB[i] = (unsigned)(Rb * K + C) * 2u; }
    const size_t kstep = (size_t)(BK * 2);
    const size_t hstep = (size_t)HALF * K * 2;
    const unsigned ldsw = (unsigned)wid * 1024u;
    const int aoff = lds_byte(wr * 64 + fr, fq * 8), boff = lds_byte(wc * 32 + fr, fq * 8);
    unsigned cvo[2][2] = {{0u, 0u}, {0u, 0u}};
#define GP_SA(b, h) (((b) * 2 + (h)) * HTB)
#define GP_SB(b, h) ((4 + (b) * 2 + (h)) * HTB)
#define GP_GLDS(gp_, lp_) __builtin_amdgcn_global_load_lds((const unsigned*)(gp_), (LAS unsigned*)(lp_), 16, 0, 0)
#define GP_STAGE_B(bufoff, gbase, h) do { const char* _g = (gbase) + (size_t)(h) * hstep; \
        GP_GLDS(_g + voffB[0], lds + (bufoff) + ldsw); GP_GLDS(_g + voffB[1], lds + (bufoff) + ldsw + 8192); } while (0)
#define GP_STAGE_A(bufoff, gbase, h, usenext) do { \
        if (GATHER) { GP_GLDS((gbase) + cvo[h][0], lds + (bufoff) + ldsw); GP_GLDS((gbase) + cvo[h][1], lds + (bufoff) + ldsw + 8192); } \
        else { const char* _g = (gbase) + (size_t)(h) * hstep; GP_GLDS(_g + voffA[0], lds + (bufoff) + ldsw); GP_GLDS(_g + voffA[1], lds + (bufoff) + ldsw + 8192); } } while (0)
#define GP_LDA(dst, b, h) do { _Pragma("unroll") for (int m = 0; m < 4; ++m) _Pragma("unroll") for (int k = 0; k < 2; ++k) dst[m][k] = *(const LAS bf16x8*)(lds + GP_SA(b, h) + aoff + m * 2048 + k * 1024); } while (0)
#define GP_LDB(dst, b, h) do { _Pragma("unroll") for (int n = 0; n < 2; ++n) _Pragma("unroll") for (int k = 0; k < 2; ++k) dst[n][k] = *(const LAS bf16x8*)(lds + GP_SB(b, h) + boff + n * 2048 + k * 1024); } while (0)
#define GP_MMA(ai, bj, At, Bt) do { __builtin_amdgcn_s_setprio(1); _Pragma("unroll") for (int m = 0; m < 4; ++m) _Pragma("unroll") for (int n = 0; n < 2; ++n) _Pragma("unroll") for (int k = 0; k < 2; ++k) \
        acc[ai][bj][m][n] = __builtin_amdgcn_mfma_f32_16x16x32_bf16(Bt[n][k], At[m][k], acc[ai][bj][m][n], 0, 0, 0); __builtin_amdgcn_s_setprio(0); } while (0)
#define GP_WAIT_V(n) asm volatile("s_waitcnt vmcnt(" #n ")" ::: "memory")
#define GP_WAIT_L(n) asm volatile("s_waitcnt lgkmcnt(" #n ")" ::: "memory")
#define GP_BAR __builtin_amdgcn_s_barrier()
#define GP_SCHED __builtin_amdgcn_sched_barrier(0)
    Unit cur, nxt; int ui = 0;
    if (!S.next(0, cur)) return;
    f32x4 acc[2][2][4][2];
#pragma unroll
    for (int a = 0; a < 2; ++a)
#pragma unroll
        for (int b = 0; b < 2; ++b)
#pragma unroll
            for (int m = 0; m < 4; ++m)
#pragma unroll
                for (int n = 0; n < 2; ++n) acc[a][b][m][n] = (f32x4){0.f, 0.f, 0.f, 0.f};
    bf16x8 At[4][2], B0[2][2], B1[2][2];
    if (GATHER) S.lane_off(cur, cvo);
    const char* cA = cur.A; const char* cB = cur.B;
    GP_STAGE_B(GP_SB(0, 0), cB, 0); GP_STAGE_A(GP_SA(0, 0), cA, 0, false); GP_STAGE_B(GP_SB(0, 1), cB, 1); GP_STAGE_A(GP_SA(0, 1), cA, 1, false);
    if (wr == 1) GP_BAR;
    GP_WAIT_V(4); GP_BAR;
    GP_STAGE_B(GP_SB(1, 0), cB + kstep, 0); GP_STAGE_A(GP_SA(1, 0), cA + kstep, 0, false); GP_STAGE_B(GP_SB(1, 1), cB + kstep, 1);
    GP_WAIT_V(6); GP_BAR;
    bool pend = false; Unit pu = cur; unsigned keep[4][2] = {{0u, 0u}, {0u, 0u}, {0u, 0u}, {0u, 0u}};
#define GP_ZQ(ai, bj) do { _Pragma("unroll") for (int m = 0; m < 4; ++m) _Pragma("unroll") for (int n = 0; n < 2; ++n) acc[ai][bj][m][n] = (f32x4){0.f, 0.f, 0.f, 0.f}; } while (0)
#define GP_EQ(ai, bj) do { if (pe) { const int l_ = olane(); E.quad(acc, pu, ai, bj, wr, wc, l_ & 15, l_ >> 4, keep); GP_ZQ(ai, bj); } } while (0)
    for (;;) {
        const bool has_next = S.next(ui + 1, nxt);
        const char* nA = has_next ? nxt.A : cA; const char* nB = has_next ? nxt.B : cB;
        for (int t = 0; t < nt; t += 2) {
            const bool last = (t == nt - 2);
            const bool un = last && has_next;
            const char* a1 = cA + (size_t)(t + 1) * kstep;
            const char* a2 = last ? nA : cA + (size_t)(t + 2) * kstep; const char* b2 = last ? nB : cB + (size_t)(t + 2) * kstep;
            const char* a3 = a2 + kstep; const char* b3 = b2 + kstep;
            const bool pe = DEFER && pend && (t == 0);
            GP_LDB(B0, 0, 0); GP_SCHED; GP_LDA(At, 0, 0); GP_STAGE_A(GP_SA(1, 1), a1, 1, false);
            GP_EQ(0, 0);
            GP_WAIT_L(8); GP_BAR; GP_WAIT_L(0); GP_MMA(0, 0, At, B0); GP_BAR; GP_SCHED;
            GP_LDB(B1, 0, 1); GP_STAGE_B(GP_SB(0, 0), b2, 0);
            if (GATHER && un) S.lane_off(nxt, cvo);
            GP_EQ(0, 1);
            GP_BAR; GP_WAIT_L(0); GP_MMA(0, 1, At, B1); GP_BAR;
            GP_LDA(At, 0, 1); GP_STAGE_A(GP_SA(0, 0), a2, 0, un);
            GP_EQ(1, 0);
            GP_BAR; GP_WAIT_L(0); GP_MMA(1, 0, At, B0); GP_BAR; GP_SCHED;
            GP_EQ(1, 1);
            GP_STAGE_B(GP_SB(0, 1), b2, 1);
            if (pe) { if (Epi::NSTQ == 12) GP_WAIT_V(18); else GP_WAIT_V(14); } else GP_WAIT_V(6);
            GP_BAR; GP_MMA(1, 1, At, B1); GP_BAR;
            GP_LDB(B0, 1, 0); GP_SCHED; GP_LDA(At, 1, 0); GP_STAGE_A(GP_SA(0, 1), a2, 1, un);
            GP_WAIT_L(8); GP_BAR; GP_WAIT_L(0); GP_MMA(0, 0, At, B0); GP_BAR; GP_SCHED;
            GP_LDB(B1, 1, 1); GP_STAGE_B(GP_SB(1, 0), b3, 0);
            GP_BAR; GP_WAIT_L(0); GP_MMA(0, 1, At, B1); GP_BAR;
            GP_LDA(At, 1, 1); GP_STAGE_A(GP_SA(1, 0), a3, 0, un);
            GP_BAR; GP_WAIT_L(0); GP_MMA(1, 0, At, B0); GP_BAR; GP_SCHED;
            GP_STAGE_B(GP_SB(1, 1), b3, 1);
            GP_WAIT_V(6); GP_BAR; GP_MMA(1, 1, At, B1); GP_BAR;
        }
        if (!has_next) { E(acc, cur, wr, wc, fr, fq); break; }
        if (DEFER) { pend = true; pu = cur; }
        else { E(acc, cur, wr, wc, fr, fq); GP_ZQ(0, 0); GP_ZQ(0, 1); GP_ZQ(1, 0); GP_ZQ(1, 1); }
        cur = nxt; cA = nA; cB = nB; ++ui;
    }
    GP_WAIT_V(0);
    if (wr == 0) GP_BAR;
    GP_BAR;
#undef GP_ZQ
#undef GP_EQ
#undef GP_SA
#undef GP_SB
#undef GP_GLDS
#undef GP_STAGE_A
#undef GP_STAGE_B
#undef GP_LDA
#undef GP_LDB
#undef GP_MMA
#undef GP_WAIT_V
#undef GP_WAIT_L
#undef GP_BAR
#undef GP_SCHED
}

struct EpiF32 {
    float* C; int ldc;
    static constexpr int NSTQ = 12;
    __device__ __forceinline__ void quad(const f32x4 (&)[2][2][4][2], const Unit&, int, int, int, int, int, int, unsigned (&)[4][2]) const {}
    __device__ __forceinline__ void operator()(const f32x4 (&acc)[2][2][4][2], const Unit& u, int wr, int wc, int fr, int fq) const {
        const int row0 = u.r0 + wr * 64 + fr, col0 = u.c0 + wc * 32 + 4 * fq;
#pragma unroll
        for (int ai = 0; ai < 2; ++ai)
#pragma unroll
            for (int m = 0; m < 4; ++m) { float* rowp = C + (size_t)(row0 + ai * HALF + m * 16) * ldc + col0;
#pragma unroll
                for (int bj = 0; bj < 2; ++bj)
#pragma unroll
                    for (int n = 0; n < 2; ++n) *(f32x4*)(rowp + bj * HALF + n * 16) = acc[ai][bj][m][n];
                __builtin_amdgcn_sched_barrier(0); }
    }
};
struct EpiBf16 {
    bf16_t* O; int ldc;
    static constexpr int NSTQ = 12;
    __device__ __forceinline__ void quad(const f32x4 (&acc)[2][2][4][2], const Unit& u, int ai, int bj, int wr, int wc, int fr, int fq, unsigned (&)[4][2]) const {
        const int row0 = u.r0 + wr * 64 + fr + ai * HALF, col0 = u.c0 + wc * 32 + 8 * fq + bj * HALF;
#pragma unroll
        for (int m = 0; m < 4; ++m) { const f32x4 v0 = acc[ai][bj][m][0], v1 = acc[ai][bj][m][1];
            u32x4 w; w.x = cvt_pk_bf16(v0[0], v0[1]); w.y = cvt_pk_bf16(v0[2], v0[3]); w.z = cvt_pk_bf16(v1[0], v1[1]); w.w = cvt_pk_bf16(v1[2], v1[3]);
            *(u32x4*)(O + (size_t)(row0 + m * 16) * ldc + col0) = w; }
    }
    __device__ __forceinline__ void operator()(const f32x4 (&acc)[2][2][4][2], const Unit& u, int wr, int wc, int fr, int fq) const {
        const int row0 = u.r0 + wr * 64 + fr, col0 = u.c0 + wc * 32 + 8 * fq;
#pragma unroll
        for (int ai = 0; ai < 2; ++ai)
#pragma unroll
            for (int m = 0; m < 4; ++m) { bf16_t* rowp = O + (size_t)(row0 + ai * HALF + m * 16) * ldc + col0;
#pragma unroll
                for (int bj = 0; bj < 2; ++bj) { const f32x4 v0 = acc[ai][bj][m][0], v1 = acc[ai][bj][m][1];
                    u32x4 w; w.x = cvt_pk_bf16(v0[0], v0[1]); w.y = cvt_pk_bf16(v0[2], v0[3]); w.z = cvt_pk_bf16(v1[0], v1[1]); w.w = cvt_pk_bf16(v1[2], v1[3]);
                    *(u32x4*)(rowp + bj * HALF) = w; }
                __builtin_amdgcn_sched_barrier(0); }
    }
};
}


typedef float f32x4_l __attribute__((ext_vector_type(4)));
__device__ __forceinline__ void stage_gate_w(KP p, int e, LAS float* wl) {
    const int tid = opaque_tid();
    const float* wg = p->in[I_EWIN] + (size_t)e * 1024 * EVEN_N + 1536;
#pragma unroll
    for (int i = 0; i < 8; ++i) { const int idx = tid + 512 * i, d = idx >> 2, j4 = idx & 3; const float4 w = *(const float4*)(wg + (size_t)d * EVEN_N + j4 * 4); *(LAS f32x4_l*)(wl + d * 16 + j4 * 4) = (f32x4_l){w.x, w.y, w.z, w.w}; }
    __syncthreads();
}
template <bool FIRST>
__device__ __forceinline__ void ph_modin(KP p, int l, int bid, int nb) {
    const int tid = opaque_tid(), lane = tid & 63, wv = tid >> 6;
    const bool even = (l & 1) == 0;
    bf16_t* U = (bf16_t*)(p->ws + OFF_U);
    float* G = (float*)(p->ws + OFF_G);
    LAS float* wl = (LAS float*)smraw_base();
    if (even) stage_gate_w(p, l >> 1, wl);
    #pragma unroll 1
    for (int tok = bid * 8 + wv; tok < NT; tok += nb * 8) {
        bf16_t* hw = hrow(p, tok);
        const float* h = (tok < NL ? p->in[I_X] + (size_t)tok * DM : p->in[I_CTX] + (size_t)(tok - NL) * DM);
        static_assert(FIRST, "ph_modin is layer 0's only");
        const float* m = modrow(p, l, tok);
        float ga[16];
#pragma unroll
        for (int j = 0; j < 16; ++j) ga[j] = 0.f;
#pragma unroll
        for (int c = 0; c < 4; ++c) {
            const int d = 4 * (lane + 64 * c);
            const float4 hv = *(const float4*)(h + d), sh = *(const float4*)(m + d), sc = *(const float4*)(m + 1024 + d);
            *(uint2*)(hw + d) = make_uint2(cvt_pk_bf16(hv.x, hv.y), cvt_pk_bf16(hv.z, hv.w));
            const float u0 = hv.x * (1.f + sc.x) + sh.x, u1 = hv.y * (1.f + sc.y) + sh.y, u2 = hv.z * (1.f + sc.z) + sh.z, u3 = hv.w * (1.f + sc.w) + sh.w;
            *(uint2*)(U + (size_t)tok * DM + d) = make_uint2(cvt_pk_bf16(u0, u1), cvt_pk_bf16(u2, u3));
            if (even) {
                const float uu[4] = {u0, u1, u2, u3};
#pragma unroll
                for (int q = 0; q < 4; ++q) {
#pragma unroll
                    for (int j4 = 0; j4 < 4; ++j4) { const f32x4_l w = *(const LAS f32x4_l*)(wl + (d + q) * 16 + j4 * 4); ga[4 * j4] += uu[q] * w[0]; ga[4 * j4 + 1] += uu[q] * w[1]; ga[4 * j4 + 2] += uu[q] * w[2]; ga[4 * j4 + 3] += uu[q] * w[3]; }
                }
                __builtin_amdgcn_sched_barrier(0);
            }
        }
        if (even) {
            float mine = 0.f;
#pragma unroll
            for (int j = 0; j < 16; ++j) { const float s = wave_sum(ga[j]); if (lane == j) mine = s; }
            if (lane < 16) G[(size_t)tok * 16 + lane] = mine;
        }
    }
}

__device__ __forceinline__ void ph_gemm_in(KP p, int l, int bid, int nb, LAS unsigned char* lds) {
    const int N = ((l & 1) == 0) ? EVEN_LD : ODD_LD;
    gp::DenseSched S; S.init(p->ws + OFF_U, p->ws + OFF_WIN, NT, N, 1024, nb, bid);
    gp::EpiBf16 E{(bf16_t*)(p->ws + OFF_BIG), N};
    gp::gemm_phase<false, true, true>(lds, 1024, S, E);
}
__device__ __forceinline__ void ph_gemm_out(KP p, int l, int bid, int nb, LAS unsigned char* lds) {
    gp::DenseSched S; S.init(p->ws + OFF_U, p->ws + OFF_WOUT, (l == 3) ? NL : NT, 1024, 1024, nb, bid);
    gp::EpiBf16 E{(bf16_t*)(p->ws + OFF_BIG), 1024};
    gp::gemm_phase<false, true, true>(lds, 1024, S, E);
}


namespace sc {
typedef short bf16x8 __attribute__((ext_vector_type(8)));
typedef short bf16x4 __attribute__((ext_vector_type(4)));
typedef float f32x4 __attribute__((ext_vector_type(4)));
#define SC_MFMA(a, b, c) __builtin_amdgcn_mfma_f32_16x16x32_bf16(a, b, c, 0, 0, 0)
__device__ __forceinline__ bf16x8 rd_row(unsigned img, int row, int stride, int k0) { return *(const LAS bf16x8*)(size_t)(img + (unsigned)(row * stride + k0 * 2)); }
__device__ __forceinline__ bf16x8 rd_tr(unsigned img, int k0, int n0, int stride, int lane) {
    const int g = lane >> 4, i = lane & 15;
    const unsigned a0 = img + (unsigned)((k0 + 8 * g + (i >> 2)) * stride + (n0 + 4 * (i & 3)) * 2), a1 = a0 + 4u * (unsigned)stride;
    bf16x4 lo, hi;
    asm volatile("ds_read_b64_tr_b16 %0, %2\n\tds_read_b64_tr_b16 %1, %3\n\ts_waitcnt lgkmcnt(0)" : "=&v"(lo), "=&v"(hi) : "v"(a0), "v"(a1) : "memory");
    return (bf16x8){lo[0], lo[1], lo[2], lo[3], hi[0], hi[1], hi[2], hi[3]};
}
typedef unsigned u32x2_ __attribute__((ext_vector_type(2)));
typedef unsigned u32x4_ __attribute__((ext_vector_type(4)));
__device__ __forceinline__ unsigned tr_addr(unsigned img, int k0, int n0, int stride, int lane) { const int g = lane >> 4, i = lane & 15; return img + (unsigned)((k0 + 8 * g + (i >> 2)) * stride + (n0 + 4 * (i & 3)) * 2); }
__device__ __forceinline__ void rd_tr5(const unsigned (&a0)[5], const unsigned (&s4)[5], bf16x8 (&o)[5]) {
    bf16x4 l0, h0, l1, h1, l2, h2, l3, h3, l4, h4;
    asm volatile("ds_read_b64_tr_b16 %0, %10\n\tds_read_b64_tr_b16 %1, %11\n\tds_read_b64_tr_b16 %2, %12\n\tds_read_b64_tr_b16 %3, %13\n\tds_read_b64_tr_b16 %4, %14\n\t"
                 "ds_read_b64_tr_b16 %5, %15\n\tds_read_b64_tr_b16 %6, %16\n\tds_read_b64_tr_b16 %7, %17\n\tds_read_b64_tr_b16 %8, %18\n\tds_read_b64_tr_b16 %9, %19\n\ts_waitcnt lgkmcnt(0)"
                 : "=&v"(l0), "=&v"(h0), "=&v"(l1), "=&v"(h1), "=&v"(l2), "=&v"(h2), "=&v"(l3), "=&v"(h3), "=&v"(l4), "=&v"(h4)
                 : "v"(a0[0]), "v"(a0[0] + s4[0]), "v"(a0[1]), "v"(a0[1] + s4[1]), "v"(a0[2]), "v"(a0[2] + s4[2]), "v"(a0[3]), "v"(a0[3] + s4[3]), "v"(a0[4]), "v"(a0[4] + s4[4]) : "memory");
    o[0] = (bf16x8){l0[0], l0[1], l0[2], l0[3], h0[0], h0[1], h0[2], h0[3]}; o[1] = (bf16x8){l1[0], l1[1], l1[2], l1[3], h1[0], h1[1], h1[2], h1[3]};
    o[2] = (bf16x8){l2[0], l2[1], l2[2], l2[3], h2[0], h2[1], h2[2], h2[3]}; o[3] = (bf16x8){l3[0], l3[1], l3[2], l3[3], h3[0], h3[1], h3[2], h3[3]};
    o[4] = (bf16x8){l4[0], l4[1], l4[2], l4[3], h4[0], h4[1], h4[2], h4[3]};
}
__device__ __forceinline__ void st8(unsigned addr, uint2 v) { *(LAS u32x2_*)(size_t)addr = (u32x2_){v.x, v.y}; }
__device__ __forceinline__ void st16(unsigned addr, uint4 v) { *(LAS u32x4_*)(size_t)addr = (u32x4_){v.x, v.y, v.z, v.w}; }
#define SC_DPP(v, ident, ctrl, rmask) __builtin_bit_cast(float, __builtin_amdgcn_update_dpp(__builtin_bit_cast(int, (float)(ident)), __builtin_bit_cast(int, v), ctrl, rmask, 0xf, false))
__device__ __forceinline__ float scan_add64(float v, int) {
    v += SC_DPP(v, 0.f, 0x111, 0xf); v += SC_DPP(v, 0.f, 0x112, 0xf); v += SC_DPP(v, 0.f, 0x114, 0xf); v += SC_DPP(v, 0.f, 0x118, 0xf);
    v += SC_DPP(v, 0.f, 0x142, 0xa); v += SC_DPP(v, 0.f, 0x143, 0xc);
    return v;
}
__device__ __forceinline__ float scan_max64(float v, int) {
    const float ni = -__builtin_inff();
    v = fmaxf(v, SC_DPP(v, ni, 0x111, 0xf)); v = fmaxf(v, SC_DPP(v, ni, 0x112, 0xf)); v = fmaxf(v, SC_DPP(v, ni, 0x114, 0xf)); v = fmaxf(v, SC_DPP(v, ni, 0x118, 0xf));
    v = fmaxf(v, SC_DPP(v, ni, 0x142, 0xa)); v = fmaxf(v, SC_DPP(v, ni, 0x143, 0xc));
    return v;
}

template <int MODE>
__device__ __forceinline__ void scan_item(KP p, int l, int b, int h, int dir, int vs) {
    constexpr int CS = (MODE == 1) ? 32 : 64, DK = (MODE == 0) ? 64 : 128, EXT = (MODE == 0) ? 1 : 0;
    constexpr int QS = (DK + 8) * 2, VS = (64 + 16 * EXT + 8) * 2, SS = (CS + 8) * 2, NVR = 64 + 16 * EXT;
    constexpr int NCH = (CTXL + SEQ) / CS;
    constexpr int LD = (MODE == 2) ? ODD_LD : EVEN_LD;
    constexpr unsigned O_QA = 0, O_KA = O_QA + CS * QS, O_QB = O_KA + CS * QS, O_KW = O_QB + (MODE == 1 ? CS * QS : 0), O_V = O_KW + CS * QS,
                       O_SSC = O_V + CS * VS, O_ST = O_SSC + CS * SS, O_DKV = O_ST + 2 * NVR * QS, O_END = O_DKV + 512;
    static_assert(O_END <= 131072, "scan LDS");
    const int tid = opaque_tid(), lane = tid & 63, wv = __builtin_amdgcn_readfirstlane(tid >> 6), r16 = lane & 15, q4 = lane >> 4;
    const unsigned L0 = (unsigned)(size_t)smraw_base();
    const bf16_t* P = (const bf16_t*)(p->ws + OFF_BIG);
    bf16_t* HXo = (bf16_t*)(p->ws + OFF_AUX) + (size_t)dir * NT * 1024;
    const int e2 = l >> 1;
    const int cQ = (MODE == 0) ? E_MQ + h * 64 : (MODE == 1) ? E_HQ + h * 128 : 1536 + h * 128;
    const int cK = (MODE == 0) ? E_MK + h * 64 : (MODE == 1) ? (dir ? E_HFB : E_HFF) + h * 128 : 2048 + h * 128;
    const int cV = (MODE == 0) ? E_MV + h * 128 + vs * 64 : (MODE == 1) ? E_HI + h * 128 + vs * 64 : 2560 + h * 128 + vs * 64;
    const int cO = (MODE == 0) ? h * 128 + vs * 64 : 512 + h * 128 + vs * 64;
    const int lt = (MODE == 1) ? (tid & 31) : (tid >> 3);
    const int lj = (MODE == 0) ? (tid & 7) : (MODE == 1) ? (tid >> 5) : ((tid >> 2) & 1) * 8 + (tid & 3);
    const int vt_ = tid >> 3, vj = tid & 7;
    float lbv[8]; float gbi = 0.f, gbf = 0.f, lg = 0.f;
    if (MODE == 1) {
        const float* lbp = (const float*)(p->ws + OFF_LB) + e2 * 512 + h * 128 + lj * 8;
#pragma unroll
        for (int i = 0; i < 8; ++i) lbv[i] = lbp[i];
    } else {
#pragma unroll
        for (int i = 0; i < 8; ++i) lbv[i] = 0.f;
    }
    if (MODE == 0) { const float* gb = p->in[I_MGB] + e2 * 16; gbi = gb[(dir ? 2 : 0) * 4 + h]; gbf = gb[(dir ? 3 : 1) * 4 + h]; }
    if (MODE == 2) lg = p->in[I_RLD][e2 * 8 + dir * 4 + h];
    const float* G = (const float*)(p->ws + OFF_G);
    const float* ropet = (const float*)(p->ws + OFF_ROPE);
    unsigned oz = 0u; asm volatile("" : "+v"(oz));
    for (unsigned o = tid * 16; o < 2u * NVR * QS; o += 512 * 16) st16(L0 + O_ST + o, make_uint4(oz, oz, oz, oz));
    if (EXT) { if (tid < CS) { st16(L0 + O_V + tid * VS + 128, make_uint4(0x3f80u | oz, oz, oz, oz)); st16(L0 + O_V + tid * VS + 144, make_uint4(oz, oz, oz, oz)); } }
    f32x4 sacc[4];
#pragma unroll
    for (int i = 0; i < 4; ++i) sacc[i] = (f32x4){0.f, 0.f, 0.f, 0.f};
    float m_in = -1e30f;
    struct Raw { uint4 rq0, rq1, rk0, rk1, rv; float rg0, rg1; };
    Raw RA, RB;
    RA.rq1 = make_uint4(0u, 0u, 0u, 0u); RA.rk1 = RA.rq1; RA.rv = RA.rq1; RA.rg0 = 0.f; RA.rg1 = 0.f; RB = RA;
    auto load_chunk = [&](Raw& R, int c) {
        const int i0 = c * CS;
        const int tq = scan_tok(b, i0 + lt, dir);
        const bf16_t* pr = P + (size_t)tq * LD;
        R.rq0 = *(const uint4*)(pr + cQ + lj * 8); R.rk0 = *(const uint4*)(pr + cK + lj * 8);
        if (MODE == 2) { R.rq1 = *(const uint4*)(pr + cQ + lj * 8 + 32); R.rk1 = *(const uint4*)(pr + cK + lj * 8 + 32); }
        if (MODE != 1 || tid < 256) { const int tv = scan_tok(b, i0 + vt_, dir); R.rv = *(const uint4*)(P + (size_t)tv * LD + cV + vj * 8); }
        if (MODE == 0) { const int tg = scan_tok(b, i0 + lane, dir); R.rg0 = G[(size_t)tg * 16 + (dir ? 8 : 0) + h]; R.rg1 = G[(size_t)tg * 16 + (dir ? 12 : 4) + h]; }
    };
    constexpr int PD = (MODE == 2) ? 1 : 2;
    load_chunk(RA, 0); if (PD == 2) load_chunk(RB, 1);
    auto chunk = [&](const int c, Raw& R) {
        const uint4 rq0 = R.rq0, rq1 = R.rq1, rk0 = R.rk0, rk1 = R.rk1, rv = R.rv; const float rg0 = R.rg0, rg1 = R.rg1;
        const unsigned ST_R = L0 + O_ST + (unsigned)(c & 1) * NVR * QS, ST_W = L0 + O_ST + (unsigned)((c + 1) & 1) * NVR * QS;
        float sp = 1.f;
        float v_u = 0.f, v_M = 0.f, v_e = 1.f, v_low = 0.f, v_w = 1.f;
        if (MODE == 0) {
            const float ig = rg0 + gbi, fg = rg1 + gbf;
            const float lf = fminf(fg, 0.f) - flog(1.f + fexp(-fabsf(fg)));
            const float bb = scan_add64(lf, lane);
            const float g = SHI(bb, 63);
            v_u = ig - bb;
            const float cu = scan_max64(v_u, lane);
            v_M = fmaxf(m_in, cu);
            const float m_new = fmaxf(g + m_in, g + SHI(cu, 63));
            sp = fexp(g + m_in - m_new);
            v_w = fexp(g + v_u - m_new);
            v_e = fexp(m_in - v_M);
            v_low = fexp(-(bb + v_M));
            m_in = m_new;
            st16(L0 + O_QA + lt * QS + lj * 16, rq0);
            st16(L0 + O_KA + lt * QS + lj * 16, rk0);
            const float wr = SHI(v_w, lt);
            uint4 kw; kw.x = cvt_pk_bf16(bflo(rk0.x) * wr, bfhi(rk0.x) * wr); kw.y = cvt_pk_bf16(bflo(rk0.y) * wr, bfhi(rk0.y) * wr);
            kw.z = cvt_pk_bf16(bflo(rk0.z) * wr, bfhi(rk0.z) * wr); kw.w = cvt_pk_bf16(bflo(rk0.w) * wr, bfhi(rk0.w) * wr);
            st16(L0 + O_KW + lt * QS + lj * 16, kw);
            st16(L0 + O_V + vt_ * VS + vj * 16, rv);
        } else if (MODE == 2) {
            sp = fexp(64.f * lg);
            const bool lat = c >= CTXL / CS;
            float q[16], k[16];
            const unsigned qa[8] = {rq0.x, rq0.y, rq0.z, rq0.w, rq1.x, rq1.y, rq1.z, rq1.w}, ka[8] = {rk0.x, rk0.y, rk0.z, rk0.w, rk1.x, rk1.y, rk1.z, rk1.w};
#pragma unroll
            for (int i = 0; i < 8; ++i) { q[2 * i] = bflo(qa[i]); q[2 * i + 1] = bfhi(qa[i]); k[2 * i] = bflo(ka[i]); k[2 * i + 1] = bfhi(ka[i]); }
            if (lat) {
                const int tq = scan_tok(b, c * CS + lt, dir), tt = tq & (SEQ - 1);
                const int pos = ((tid >> 2) & 1) ? (tt & 63) : (tt >> 6);
                const float2* rt = (const float2*)ropet + pos * 32 + (tid & 3) * 8;
#pragma unroll
                for (int i = 0; i < 8; ++i) {
                    const float2 cs2 = rt[i];
                    const float q1 = q[i], q2 = q[8 + i], k1 = k[i], k2 = k[8 + i];
                    q[i] = q1 * cs2.x - q2 * cs2.y; q[8 + i] = q1 * cs2.y + q2 * cs2.x;
                    k[i] = k1 * cs2.x - k2 * cs2.y; k[8 + i] = k1 * cs2.y + k2 * cs2.x;
                }
            }
            const float wr = 0.08838834764831845f * fexp((float)(63 - lt) * lg);
            uint4 o0, o1, w0, w1, x0, x1;
            o0.x = cvt_pk_bf16(q[0], q[1]); o0.y = cvt_pk_bf16(q[2], q[3]); o0.z = cvt_pk_bf16(q[4], q[5]); o0.w = cvt_pk_bf16(q[6], q[7]);
            o1.x = cvt_pk_bf16(q[8], q[9]); o1.y = cvt_pk_bf16(q[10], q[11]); o1.z = cvt_pk_bf16(q[12], q[13]); o1.w = cvt_pk_bf16(q[14], q[15]);
            w0.x = cvt_pk_bf16(k[0], k[1]); w0.y = cvt_pk_bf16(k[2], k[3]); w0.z = cvt_pk_bf16(k[4], k[5]); w0.w = cvt_pk_bf16(k[6], k[7]);
            w1.x = cvt_pk_bf16(k[8], k[9]); w1.y = cvt_pk_bf16(k[10], k[11]); w1.z = cvt_pk_bf16(k[12], k[13]); w1.w = cvt_pk_bf16(k[14], k[15]);
            x0.x = cvt_pk_bf16(k[0] * wr, k[1] * wr); x0.y = cvt_pk_bf16(k[2] * wr, k[3] * wr); x0.z = cvt_pk_bf16(k[4] * wr, k[5] * wr); x0.w = cvt_pk_bf16(k[6] * wr, k[7] * wr);
            x1.x = cvt_pk_bf16(k[8] * wr, k[9] * wr); x1.y = cvt_pk_bf16(k[10] * wr, k[11] * wr); x1.z = cvt_pk_bf16(k[12] * wr, k[13] * wr); x1.w = cvt_pk_bf16(k[14] * wr, k[15] * wr);
            st16(L0 + O_QA + lt * QS + lj * 16, o0); st16(L0 + O_QA + lt * QS + lj * 16 + 64, o1);
            st16(L0 + O_KA + lt * QS + lj * 16, w0); st16(L0 + O_KA + lt * QS + lj * 16 + 64, w1);
            st16(L0 + O_KW + lt * QS + lj * 16, x0); st16(L0 + O_KW + lt * QS + lj * 16 + 64, x1);
            st16(L0 + O_V + vt_ * VS + vj * 16, rv);
        } else {
            const unsigned qa[4] = {rq0.x, rq0.y, rq0.z, rq0.w}, fa[4] = {rk0.x, rk0.y, rk0.z, rk0.w};
            float qv[8], kk[8], A[8];
#pragma unroll
            for (int i = 0; i < 8; ++i) {
                const float qr = (i & 1) ? bfhi(qa[i >> 1]) : bflo(qa[i >> 1]), fr = (i & 1) ? bfhi(fa[i >> 1]) : bflo(fa[i >> 1]);
                const float f = lbv[i] + (1.f - lbv[i]) * fsigmoid(fr);
                qv[i] = fsilu(qr); kk[i] = 1.f - f; A[i] = flog(f);
            }
#pragma unroll
            for (int i = 0; i < 8; ++i) {
                int v = __builtin_bit_cast(int, A[i]);
                v = __builtin_bit_cast(int, __builtin_bit_cast(float, v) + __builtin_bit_cast(float, __builtin_amdgcn_update_dpp(0, v, 0x111, 0xf, 0xf, false)));
                v = __builtin_bit_cast(int, __builtin_bit_cast(float, v) + __builtin_bit_cast(float, __builtin_amdgcn_update_dpp(0, v, 0x112, 0xf, 0xf, false)));
                v = __builtin_bit_cast(int, __builtin_bit_cast(float, v) + __builtin_bit_cast(float, __builtin_amdgcn_update_dpp(0, v, 0x114, 0xf, 0xf, false)));
                v = __builtin_bit_cast(int, __builtin_bit_cast(float, v) + __builtin_bit_cast(float, __builtin_amdgcn_update_dpp(0, v, 0x118, 0xf, 0xf, false)));
                v = __builtin_bit_cast(int, __builtin_bit_cast(float, v) + __builtin_bit_cast(float, __builtin_amdgcn_update_dpp(0, v, 0x142, 0xa, 0xf, false)));
                A[i] = __builtin_bit_cast(float, v);
            }
            float qa_[8], qb_[8], ka_[8], kw_[8];
            const int half = olane() & 32;
#pragma unroll
            for (int i = 0; i < 8; ++i) {
                const float am = shfl_idx(A[i], half | 15), ae = shfl_idx(A[i], half | 31);
                const float eA = fexp(A[i]);
                qa_[i] = qv[i] * fexp(A[i] - am); qb_[i] = qv[i] * eA; ka_[i] = kk[i] * fexp(am - A[i]); kw_[i] = kk[i] * fexp(ae - A[i]);
                if (lt == 31) *(LAS float*)(size_t)(L0 + O_DKV + (lj * 8 + i) * 4) = eA;
            }
            uint4 w;
            w.x = cvt_pk_bf16(qa_[0], qa_[1]); w.y = cvt_pk_bf16(qa_[2], qa_[3]); w.z = cvt_pk_bf16(qa_[4], qa_[5]); w.w = cvt_pk_bf16(qa_[6], qa_[7]); st16(L0 + O_QA + lt * QS + lj * 16, w);
            w.x = cvt_pk_bf16(qb_[0], qb_[1]); w.y = cvt_pk_bf16(qb_[2], qb_[3]); w.z = cvt_pk_bf16(qb_[4], qb_[5]); w.w = cvt_pk_bf16(qb_[6], qb_[7]); st16(L0 + O_QB + lt * QS + lj * 16, w);
            w.x = cvt_pk_bf16(ka_[0], ka_[1]); w.y = cvt_pk_bf16(ka_[2], ka_[3]); w.z = cvt_pk_bf16(ka_[4], ka_[5]); w.w = cvt_pk_bf16(ka_[6], ka_[7]); st16(L0 + O_KA + lt * QS + lj * 16, w);
            w.x = cvt_pk_bf16(kw_[0], kw_[1]); w.y = cvt_pk_bf16(kw_[2], kw_[3]); w.z = cvt_pk_bf16(kw_[4], kw_[5]); w.w = cvt_pk_bf16(kw_[6], kw_[7]); st16(L0 + O_KW + lt * QS + lj * 16, w);
            if (tid < 256) st16(L0 + O_V + vt_ * VS + vj * 16, rv);
        }
        __syncthreads();
        if (c + PD < NCH) load_chunk(R, c + PD);
        {
            constexpr int NT1 = CS / 16;
            const bool act = (MODE == 1) ? (wv < 4) : true;
            const int tb = (MODE == 1) ? (wv & 1) : (wv & 3);
#pragma unroll
            for (int u2 = 0; u2 < ((MODE == 1) ? 1 : 2); ++u2) {
                const int sb = (MODE == 1) ? (wv >> 1) : 2 * (wv >> 2) + u2;
                if (act) {
                    f32x4 d = (f32x4){0.f, 0.f, 0.f, 0.f};
                    if (sb <= tb) {
#pragma unroll
                        for (int kk2 = 0; kk2 < DK / 32; ++kk2)
                            d = SC_MFMA(rd_row(L0 + O_KA, sb * 16 + r16, QS, kk2 * 32 + q4 * 8), rd_row(L0 + O_QA, tb * 16 + r16, QS, kk2 * 32 + q4 * 8), d);
                        const int t = tb * 16 + r16, s0 = sb * 16 + q4 * 4;
                        if (MODE == 0) {
                            const float Mt = SHI(v_M, t);
#pragma unroll
                            for (int jj = 0; jj < 4; ++jj) { const float us = SHI(v_u, s0 + jj); d[jj] = (s0 + jj <= t) ? d[jj] * 0.125f * fexp(us - Mt) : 0.f; }
                        } else if (MODE == 2) {
#pragma unroll
                            for (int jj = 0; jj < 4; ++jj) d[jj] = (s0 + jj <= t) ? d[jj] * 0.08838834764831845f * fexp((float)(t - s0 - jj) * lg) : 0.f;
                        } else {
#pragma unroll
                            for (int jj = 0; jj < 4; ++jj) d[jj] = (s0 + jj <= t) ? d[jj] : 0.f;
                        }
                    }
                    st8(L0 + O_SSC + (tb * 16 + r16) * SS + (sb * 16 + q4 * 4) * 2, make_uint2(cvt_pk_bf16(d[0], d[1]), cvt_pk_bf16(d[2], d[3])));
                }
            }
            (void)NT1;
        }
        __syncthreads();
        {
            const int tb = (MODE == 1) ? (wv & 1) : (wv & 3);
            const int t = tb * 16 + r16;
            const int tok = scan_tok(b, c * CS + t, dir);
            constexpr int NV = (MODE == 1) ? 1 : 2;
            f32x4 oi[NV + EXT], oo[NV + EXT];
#pragma unroll
            for (int u2 = 0; u2 < NV + EXT; ++u2) {
                const int vt = (u2 == NV) ? 4 : ((MODE == 1) ? (wv >> 1) : 2 * (wv >> 2) + u2);
                f32x4 a1 = (f32x4){0.f, 0.f, 0.f, 0.f}, a2 = a1;
#pragma unroll
                for (int sb2 = 0; sb2 < CS / 32; ++sb2)
                    a1 = SC_MFMA(rd_tr(L0 + O_V, sb2 * 32, vt * 16, VS, lane), rd_row(L0 + O_SSC, t, SS, sb2 * 32 + q4 * 8), a1);
#pragma unroll
                for (int kk2 = 0; kk2 < DK / 32; ++kk2)
                    a2 = SC_MFMA(rd_row(ST_R, vt * 16 + r16, QS, kk2 * 32 + q4 * 8), rd_row(L0 + ((MODE == 1) ? O_QB : O_QA), t, QS, kk2 * 32 + q4 * 8), a2);
                oi[u2] = a1; oo[u2] = a2;
            }
            float den = 1.f, ei = 1.f;
            if (MODE == 0) {
                ei = 0.125f * SHI(v_e, t);
                const float dsum = oi[NV][0] + ei * oo[NV][0];
                const float dd = SHI(dsum, r16);
                den = frcp(fmaxf(fabsf(dd), SHI(v_low, t)));
            } else if (MODE == 2) {
                ei = fexp((float)(t + 1) * lg);
            }
#pragma unroll
            for (int u2 = 0; u2 < NV; ++u2) {
                const int vt = (MODE == 1) ? (wv >> 1) : 2 * (wv >> 2) + u2;
                float o[4];
#pragma unroll
                for (int jj = 0; jj < 4; ++jj) o[jj] = (oi[u2][jj] + ei * oo[u2][jj]) * den;
                *(uint2*)(HXo + (size_t)tok * 1024 + cO + vt * 16 + q4 * 4) = make_uint2(cvt_pk_bf16(o[0], o[1]), cvt_pk_bf16(o[2], o[3]));
            }
        }
        {
            constexpr int NS = (MODE == 0) ? 3 : 4;
            const int kt = (MODE == 0) ? (wv & 3) : wv;
            float dk[4] = {sp, sp, sp, sp};
            if (MODE == 1) { const f32x4 dv = *(const LAS f32x4*)(size_t)(L0 + O_DKV + (kt * 16 + q4 * 4) * 4); dk[0] = dv[0]; dk[1] = dv[1]; dk[2] = dv[2]; dk[3] = dv[3]; }
            f32x4 a[NS];
#pragma unroll
            for (int u2 = 0; u2 < NS; ++u2) { a[u2] = sacc[u2];
#pragma unroll
                for (int jj = 0; jj < 4; ++jj) a[u2][jj] *= dk[jj]; }
#pragma unroll
            for (int sb2 = 0; sb2 < CS / 32; ++sb2) {
                unsigned ta[5], ts[5]; bf16x8 ops[5];
                ta[0] = tr_addr(L0 + O_KW, sb2 * 32, kt * 16, QS, lane); ts[0] = 4u * QS;
#pragma unroll
                for (int u2 = 0; u2 < 4; ++u2) {
                    const int vt = (MODE == 0) ? ((u2 >= 2) ? 4 : 2 * (wv >> 2) + u2) : u2;
                    ta[1 + u2] = tr_addr(L0 + O_V, sb2 * 32, vt * 16, VS, lane); ts[1 + u2] = 4u * VS;
                }
                rd_tr5(ta, ts, ops);
#pragma unroll
                for (int u2 = 0; u2 < NS; ++u2) a[u2] = SC_MFMA(ops[0], ops[1 + u2], a[u2]);
            }
#pragma unroll
            for (int u2 = 0; u2 < NS; ++u2) {
                const int vt = (MODE == 0) ? ((u2 == 2) ? 4 : 2 * (wv >> 2) + u2) : u2;
                sacc[u2] = a[u2];
                st8(ST_W + (vt * 16 + r16) * QS + (kt * 16 + q4 * 4) * 2, make_uint2(cvt_pk_bf16(a[u2][0], a[u2][1]), cvt_pk_bf16(a[u2][2], a[u2][3])));
            }
        }
        __syncthreads();
    };
#pragma unroll 1
    for (int c = 0; c < NCH; c += 2) { chunk(c, RA); if (PD == 2) chunk(c + 1, RB); else chunk(c + 1, RA); }
}

}

__device__ __forceinline__ void ph_hy_filt2(KP p, int l, int bid, int nb, float* sm, int skip);
__device__ __forceinline__ void ph_scan_even2(KP p, int l, int bid, int nb, float* sm) {
#pragma unroll 1
    for (int item = bid; item < 256; item += nb) {
        const int kind = item >> 7, b = (item >> 4) & 7, h = (item >> 2) & 3, dir = (item >> 1) & 1, vs = item & 1;
        if (kind == 0) sc::scan_item<0>(p, l, b, h, dir, vs); else sc::scan_item<1>(p, l, b, h, dir, vs);
        __syncthreads();
    }
    if (bid < 128) { ph_hy_filt2(p, l + 1, bid, 128, sm, 0); __syncthreads(); ph_convert(p, l + 1, bid, 128, sm, 1); }
}
__device__ __forceinline__ void ph_scan_odd2(KP p, int l, int bid, int nb) {
#pragma unroll 1
    for (int item = bid; item < 128; item += nb) {
        const int b = (item >> 4) & 7, h = (item >> 2) & 3, dir = (item >> 1) & 1, vs = item & 1;
        sc::scan_item<2>(p, l, b, h, dir, vs);
        __syncthreads();
    }
}

__device__ __forceinline__ void unpack16(const uint4 a, const uint4 b, float (&x)[16]) {
    x[0] = bflo(a.x); x[1] = bfhi(a.x); x[2] = bflo(a.y); x[3] = bfhi(a.y); x[4] = bflo(a.z); x[5] = bfhi(a.z); x[6] = bflo(a.w); x[7] = bfhi(a.w);
    x[8] = bflo(b.x); x[9] = bfhi(b.x); x[10] = bflo(b.y); x[11] = bfhi(b.y); x[12] = bflo(b.z); x[13] = bfhi(b.z); x[14] = bflo(b.w); x[15] = bfhi(b.w);
}
__device__ __forceinline__ float sum8(float v) { v += WS_DPP(v, 0xB1, 0xf); v += WS_DPP(v, 0x4E, 0xf); v += WS_DPP(v, 0x141, 0xf); return v; }
struct Hng6 { uint4 a0, a1, b0, b1, g0, g1; };
__device__ __forceinline__ Hng6 hng_load(const bf16_t* h0, const bf16_t* h1, const bf16_t* gp) {
    Hng6 r; r.a0 = *(const uint4*)h0; r.a1 = *(const uint4*)(h0 + 8); r.b0 = *(const uint4*)h1; r.b1 = *(const uint4*)(h1 + 8); r.g0 = *(const uint4*)gp; r.g1 = *(const uint4*)(gp + 8); return r;
}
template <bool MEANSUB, bool SIG>
__device__ __forceinline__ void hng_compute(const Hng6& in, const float* nw, bf16_t* out) {
    float a[16], b[16], g[16];
    unpack16(in.a0, in.a1, a); unpack16(in.b0, in.b1, b); unpack16(in.g0, in.g1, g);
    float s = 0.f;
#pragma unroll
    for (int i = 0; i < 16; ++i) { a[i] += b[i]; s += a[i]; }
    if (MEANSUB) { const float mean = sum8(s) * (1.f / 128.f);
#pragma unroll
        for (int i = 0; i < 16; ++i) a[i] -= mean; }
    float q = 0.f;
#pragma unroll
    for (int i = 0; i < 16; ++i) q += a[i] * a[i];
    const float r = rsqrtf(sum8(q) * (1.f / 128.f) + LN_EPS);
    unsigned w[8];
#pragma unroll
    for (int i = 0; i < 16; i += 2) {
        const float y0 = a[i] * r * nw[i] * (SIG ? fsigmoid(g[i]) : fsilu(g[i])), y1 = a[i + 1] * r * nw[i + 1] * (SIG ? fsigmoid(g[i + 1]) : fsilu(g[i + 1]));
        w[i >> 1] = cvt_pk_bf16(y0, y1);
    }
    *(uint4*)out = make_uint4(w[0], w[1], w[2], w[3]); *(uint4*)(out + 8) = make_uint4(w[4], w[5], w[6], w[7]);
}
__device__ __forceinline__ void ph_normgate_even(KP p, int l, int bid, int nb) {
    const int tid = opaque_tid(), lane = tid & 63, wv = tid >> 6;
    const bf16_t* P = (const bf16_t*)(p->ws + OFF_BIG);
    const bf16_t* HX = (const bf16_t*)(p->ws + OFF_AUX);
    const bf16_t* HX1 = HX + (size_t)NT * 1024;
    bf16_t* MIX = (bf16_t*)(p->ws + OFF_U);
    const int e = l >> 1;
    const bool ml = lane < 32;
    const float* nw = ml ? p->in[I_MNW] + e * 512 + 16 * lane : p->in[I_HNW] + e * 512 + 16 * (lane - 32);
    const int gcol = ml ? E_MO + 16 * lane : E_HG + 16 * (lane - 32);
    int tok = bid * 8 + wv;
    Hng6 nx = hng_load(HX + (size_t)tok * 1024 + 16 * lane, HX1 + (size_t)tok * 1024 + 16 * lane, P + (size_t)tok * EVEN_LD + gcol);
#pragma unroll 1
    for (; tok < NT; tok += nb * 8) {
        const Hng6 cur = nx;
        const int tn = tok + nb * 8;
        const int tc = tn < NT ? tn : tok;
        nx = hng_load(HX + (size_t)tc * 1024 + 16 * lane, HX1 + (size_t)tc * 1024 + 16 * lane, P + (size_t)tc * EVEN_LD + gcol);
        bf16_t* o = MIX + (size_t)tok * 1024 + 16 * lane;
        if (ml) hng_compute<true, true>(cur, nw, o); else hng_compute<false, false>(cur, nw, o);
    }
}

#define OFF_UT   (OFF_AUX + 136 * MiB)
#define OFF_FKS(o) (984 * MiB + (size_t)(o) * 34 * MiB)
#define OFF_ZOT  (OFF_UT + 102 * MiB)

__device__ __forceinline__ void ph_hy_filt2(KP p, int l, int bid, int nb, float* sm, int skip) {
    const int tid = opaque_tid(), o = l >> 1;
    float* zf = sm;
    float* h1 = sm + 1024;
    float* h2 = sm + 2048;
    float* h3 = sm + 3072;
    const float* fw1 = p->in[I_HW1] + o * 33 * 64; const float* fb1 = p->in[I_HB1] + o * 64;
    const float* fw2 = p->in[I_HW2] + o * 64 * 64; const float* fb2 = p->in[I_HB2] + o * 64;
    const float* fw3 = p->in[I_HW3] + o * 64 * 64; const float* fb3 = p->in[I_HB3] + o * 64;
    const float* freq = p->in[I_HFREQ] + o * 64;
    const float* wout = p->in[I_HWOUT] + (size_t)o * 64 * 2048;
    float* FK = (float*)(p->ws + OFF_FKS(o)); float* FKC = FK + (size_t)2 * 512 * 8192;
#pragma unroll 1
    for (int item = bid - skip; item < (SEQ + CTXL) / 16; item += nb - skip) {
        if (item < 0) break;
        const bool isctx = item >= SEQ / 16;
        const int L = isctx ? CTXL : SEQ, pos0 = (isctx ? item - SEQ / 16 : item) * 16;
        __syncthreads();
        if (tid < 16 * 17) {
            const int pp = tid / 17, j = tid % 17, pos = pos0 + pp;
            if (j == 16) zf[pp * 36] = (float)pos / (float)(L - 1);
            else { const float f = 1e-4f + (float)j * ((15.0f - 1e-4f) / 15.0f); const float w = 2.0f * 3.14159265358979323846f * (float)pos / (float)L * f; zf[pp * 36 + 1 + j] = cosf(w); zf[pp * 36 + 17 + j] = sinf(w); }
        }
        __syncthreads();
        const int pp = tid >> 5, u0 = (tid & 31) * 2;
        { float a0 = fb1[u0], a1 = fb1[u0 + 1];
#pragma unroll 1
          for (int k = 0; k < 33; ++k) { const float z = zf[pp * 36 + k]; a0 += z * fw1[k * 64 + u0]; a1 += z * fw1[k * 64 + u0 + 1]; }
          h1[pp * 64 + u0] = sinf(freq[u0] * a0); h1[pp * 64 + u0 + 1] = sinf(freq[u0 + 1] * a1); }
        __syncthreads();
        { float a0 = fb2[u0], a1 = fb2[u0 + 1];
#pragma unroll 4
          for (int k = 0; k < 64; ++k) { const float z = h1[pp * 64 + k]; a0 += z * fw2[k * 64 + u0]; a1 += z * fw2[k * 64 + u0 + 1]; }
          h2[pp * 64 + u0] = sinf(freq[u0] * a0); h2[pp * 64 + u0 + 1] = sinf(freq[u0 + 1] * a1); }
        __syncthreads();
        { float a0 = fb3[u0], a1 = fb3[u0 + 1];
#pragma unroll 4
          for (int k = 0; k < 64; ++k) { const float z = h2[pp * 64 + k]; a0 += z * fw3[k * 64 + u0]; a1 += z * fw3[k * 64 + u0 + 1]; }
          h3[pp * 64 + u0] = sinf(freq[u0] * a0); h3[pp * 64 + u0 + 1] = sinf(freq[u0 + 1] * a1); }
        __syncthreads();
#pragma unroll 1
        for (int r = 0; r < 4; ++r) {
            const int col = tid + 512 * r, c = col & 511, od = col >> 9, order = od >> 1, dirn = od & 1;
            float a[16];
#pragma unroll
            for (int i = 0; i < 16; ++i) a[i] = 0.f;
#pragma unroll 1
            for (int k = 0; k < 64; k += 4) { const float w0 = wout[k * 2048 + col], w1 = wout[(k + 1) * 2048 + col], w2 = wout[(k + 2) * 2048 + col], w3 = wout[(k + 3) * 2048 + col];
#pragma unroll
                for (int i = 0; i < 16; ++i) { const float4 hh = *(const float4*)(h3 + i * 64 + k); a[i] += hh.x * w0 + hh.y * w1 + hh.z * w2 + hh.w * w3; } }
            const float delta = 3.0701134573253944f + (float)c * ((15.350567286626972f - 3.0701134573253944f) / 511.0f);
#pragma unroll
            for (int i = 0; i < 16; ++i) a[i] *= expf(-((float)(pos0 + i) / (float)(L - 1)) * delta);
            float* dst = isctx ? FKC + ((size_t)order * 512 + c) * 512 + 256 : FK + ((size_t)order * 512 + c) * 8192 + 4096;
            if (dirn == 0) {
#pragma unroll
                for (int i = 0; i < 16; i += 4) *(float4*)(dst + pos0 + i) = make_float4(a[i], a[i + 1], a[i + 2], a[i + 3]);
            } else {
#pragma unroll
                for (int i = 0; i < 16; ++i) if (pos0 + i > 0) dst[-(pos0 + i)] = a[i];
                if (pos0 == 0) dst[-L] = 0.f;
            }
        }
    }
}

__device__ __forceinline__ void ph_hy_prep(KP p, int l, int bid, int nb, float* sm) {
    const int tid = opaque_tid(), o = l >> 1;
    const bf16_t* P = (const bf16_t*)(p->ws + OFF_BIG);
    bf16_t* UT = (bf16_t*)(p->ws + OFF_UT);
    const float* cw = p->in[I_HCW] + o * 3 * 1536; const float* cb = p->in[I_HCB] + o * 1536;
    float* tile = sm;
#pragma unroll 1
    for (int item = bid; item < (NT / 256) * 24; item += nb) {
        const int tt = item / 24, ct = item % 24, tok0 = tt * 256, col0 = ct * 64;
        const bool lat = tok0 < NL;
        const int L = lat ? SEQ : CTXL, t0 = lat ? (tok0 & (SEQ - 1)) : ((tok0 - NL) & (CTXL - 1));
        __syncthreads();
#pragma unroll 1
        for (int i = tid; i < 258 * 8; i += 512) {
            const int rr = i >> 3, hf = i & 7, t = t0 + rr - 1;
            uint4 v = make_uint4(0u, 0u, 0u, 0u);
            if (t >= 0 && t < L) v = *(const uint4*)(P + (size_t)(tok0 + rr - 1) * ODD_LD + col0 + hf * 8);
            float* d = tile + rr * 65 + hf * 8;
            d[0] = bflo(v.x); d[1] = bfhi(v.x); d[2] = bflo(v.y); d[3] = bfhi(v.y); d[4] = bflo(v.z); d[5] = bfhi(v.z); d[6] = bflo(v.w); d[7] = bfhi(v.w);
        }
        __syncthreads();
#pragma unroll 1
        for (int r = 0; r < 4; ++r) {
            const int cc = (tid >> 5) + 16 * r, tc = (tid & 31) * 8, col = col0 + cc;
            const float w0 = cw[col], w1 = cw[1536 + col], w2 = cw[3072 + col], bb = cb[col];
            float y[8];
#pragma unroll
            for (int i = 0; i < 8; ++i) y[i] = tile[(tc + i) * 65 + cc] * w0 + tile[(tc + i + 1) * 65 + cc] * w1 + tile[(tc + i + 2) * 65 + cc] * w2 + bb;
            *(uint4*)(UT + (size_t)col * NT + tok0 + tc) = make_uint4(cvt_pk_bf16(y[0], y[1]), cvt_pk_bf16(y[2], y[3]), cvt_pk_bf16(y[4], y[5]), cvt_pk_bf16(y[6], y[7]));
        }
    }
}

__device__ __forceinline__ void hy_item_lat(KP p, int l, int c) {
    constexpr int ZSB = (SEQ + 8) * 2;
    constexpr unsigned O_Z = 0, O_PE = O_Z + 8 * ZSB, O_PO = O_PE + 4096 * 4, O_END = O_PO + 4096 * 4;
    static_assert(O_END <= BAR_LDS_, "hyena LDS");
    const int tid = opaque_tid(), lane = tid & 63, wv = __builtin_amdgcn_readfirstlane(tid >> 6), r16 = lane & 15, q4 = lane >> 4, o = l >> 1;
    const unsigned L0 = (unsigned)(size_t)smraw_base();
    const bf16_t* UT = (const bf16_t*)(p->ws + OFF_UT);
    bf16_t* ZOT = (bf16_t*)(p->ws + OFF_ZOT);
    const float* FK = (const float*)(p->ws + OFF_FKS(o));
    for (int i = tid; i < 8 * 512; i += 512) { const int b = i >> 9, ch = i & 511; sc::st16(L0 + O_Z + b * ZSB + ch * 16, *(const uint4*)(UT + (size_t)(1024 + c) * NT + b * SEQ + ch * 8)); }
#pragma unroll 1
    for (int order = 0; order < 2; ++order) {
        const float* fk = FK + ((size_t)order * 512 + c) * 8192;
        for (int i = tid; i < 4096; i += 512) {
            const float r0 = (i > 0) ? fk[8192 - 2 * i] : 0.f, r1 = fk[8191 - 2 * i], r2 = (i < 4095) ? fk[8190 - 2 * i] : 0.f;
            *(LAS unsigned*)(size_t)(L0 + O_PE + i * 4) = cvt_pk_bf16(r0, r1); *(LAS unsigned*)(size_t)(L0 + O_PO + i * 4) = cvt_pk_bf16(r1, r2);
        }
        __syncthreads();
        sc::f32x4 acc[4][4];
#pragma unroll
        for (int a = 0; a < 4; ++a)
#pragma unroll
            for (int b2 = 0; b2 < 4; ++b2) acc[a][b2] = (sc::f32x4){0.f, 0.f, 0.f, 0.f};
        const unsigned gbase = L0 + ((r16 & 1) ? O_PO : O_PE) + (unsigned)(((4096 - r16 + 8 * q4 - (r16 & 1)) >> 1) * 4);
        auto ldG = [&](int g) {
            const unsigned a0 = gbase - (unsigned)(32 * g);
            const unsigned w0 = *(const LAS unsigned*)(size_t)a0, w1 = *(const LAS unsigned*)(size_t)(a0 + 4), w2 = *(const LAS unsigned*)(size_t)(a0 + 8), w3 = *(const LAS unsigned*)(size_t)(a0 + 12);
            return __builtin_bit_cast(sc::bf16x8, (sc::u32x4_){w0, w1, w2, w3});
        };
        sc::bf16x8 bq[4][2], W[6];
#pragma unroll
        for (int i = 0; i < 4; ++i) { bq[i][0] = (sc::bf16x8){0, 0, 0, 0, 0, 0, 0, 0}; bq[i][1] = bq[i][0]; }
        const int D0 = 8 * wv - 63, D1 = (8 * wv + 7 < 63) ? 8 * wv + 7 : 63;
        W[4] = ldG(4 * D0 - 6 + 4); W[5] = ldG(4 * D0 - 6 + 5);
#pragma unroll 1
        for (int D = D0; D <= D1; ++D) {
            W[0] = W[4]; W[1] = W[5];
#pragma unroll
            for (int i = 0; i < 4; ++i) W[2 + i] = ldG(4 * D + i);
            bq[3][0] = bq[2][0]; bq[3][1] = bq[2][1]; bq[2][0] = bq[1][0]; bq[2][1] = bq[1][1]; bq[1][0] = bq[0][0]; bq[1][1] = bq[0][1];
            {
                const int s1 = 8 * wv - D + ((r16 < 8) ? 0 : 4);
                const bool ok = (unsigned)s1 < 64u;
                const unsigned za = L0 + O_Z + (unsigned)((r16 & 7) * ZSB + ((ok ? s1 : 0) * 64 + q4 * 8) * 2);
                sc::bf16x8 b0 = *(const LAS sc::bf16x8*)(size_t)za, b1 = *(const LAS sc::bf16x8*)(size_t)(za + 64);
                if (!ok) { b0 = (sc::bf16x8){0, 0, 0, 0, 0, 0, 0, 0}; b1 = b0; }
                bq[0][0] = b0; bq[0][1] = b1;
            }
#pragma unroll
            for (int cg = 0; cg < 4; ++cg) {
                const int sA = 8 * wv + cg - D;
                if ((unsigned)sA < 64u || (unsigned)(sA + 4) < 64u) {
#pragma unroll
                    for (int it = 0; it < 4; ++it) { acc[cg][it] = SC_MFMA(W[it + 2], bq[cg][0], acc[cg][it]); acc[cg][it] = SC_MFMA(W[it], bq[cg][1], acc[cg][it]); }
                }
            }
        }
        __syncthreads();
        const float sk = p->in[I_HSKIP][o * 1024 + order * 512 + c];
        const bf16_t* gt = UT + (size_t)(order * 512 + c) * NT;
        const int bb = r16 & 7;
#pragma unroll
        for (int cg = 0; cg < 4; ++cg) {
            const int t1 = 8 * wv + cg + ((r16 < 8) ? 0 : 4);
#pragma unroll
            for (int it = 0; it < 4; ++it) {
                const int t = t1 * 64 + it * 16 + q4 * 4;
                const sc::u32x2_ zo_ = *(const LAS sc::u32x2_*)(size_t)(L0 + O_Z + bb * ZSB + t * 2); const uint2 zo = make_uint2(zo_[0], zo_[1]);
                const uint2 gv = *(const uint2*)(gt + bb * SEQ + t);
                const float y0 = bflo(gv.x) * (acc[cg][it][0] + sk * bflo(zo.x)), y1 = bfhi(gv.x) * (acc[cg][it][1] + sk * bfhi(zo.x));
                const float y2 = bflo(gv.y) * (acc[cg][it][2] + sk * bflo(zo.y)), y3 = bfhi(gv.y) * (acc[cg][it][3] + sk * bfhi(zo.y));
                const uint2 w = make_uint2(cvt_pk_bf16(y0, y1), cvt_pk_bf16(y2, y3));
                if (order == 0) sc::st8(L0 + O_Z + bb * ZSB + t * 2, w);
                else *(uint2*)(ZOT + (size_t)c * NT + bb * SEQ + t) = w;
            }
        }
        __syncthreads();
    }
}

__device__ __forceinline__ void hy_item_ctx(KP p, int l, int c, float* sm) {
    const int tid = opaque_tid(), o = l >> 1;
    const bf16_t* UT = (const bf16_t*)(p->ws + OFF_UT);
    bf16_t* ZOT = (bf16_t*)(p->ws + OFF_ZOT);
    const float* FKC = (const float*)(p->ws + OFF_FKS(o)) + (size_t)2 * 512 * 8192;
    float* Kc = sm;
    float* zb = sm + 1024;
    for (int i = tid; i < 1024; i += 512) Kc[i] = FKC[((size_t)(i >> 9) * 512 + c) * 512 + (i & 511)];
    for (int i = tid; i < 8 * CTXL; i += 512) zb[i] = bf2f(UT[(size_t)(1024 + c) * NT + NL + i]);
    __syncthreads();
    const int bb = tid >> 6, tl = tid & 63;
#pragma unroll 1
    for (int order = 0; order < 2; ++order) {
        float acc[4] = {0.f, 0.f, 0.f, 0.f};
#pragma unroll 4
        for (int s = 0; s < CTXL; ++s) {
            const float zv = zb[bb * CTXL + s];
#pragma unroll
            for (int i = 0; i < 4; ++i) acc[i] += Kc[order * 512 + tl + 64 * i - s + 256] * zv;
        }
        const float sk = p->in[I_HSKIP][o * 1024 + order * 512 + c];
        float zn[4];
#pragma unroll
        for (int i = 0; i < 4; ++i) { const int t = tl + 64 * i; zn[i] = bf2f(UT[(size_t)(order * 512 + c) * NT + NL + bb * CTXL + t]) * (acc[i] + zb[bb * CTXL + t] * sk); }
        __syncthreads();
#pragma unroll
        for (int i = 0; i < 4; ++i) { const int t = tl + 64 * i; if (order == 0) zb[bb * CTXL + t] = bf2f((bf16_t)(cvt_pk_bf16(zn[i], 0.f) & 0xffffu)); else stf(ZOT + (size_t)c * NT + NL + bb * CTXL + t, zn[i]); }
        __syncthreads();
    }
}

__device__ __forceinline__ void ph_mix_odd(KP p, int l, int bid, int nb, float* sm) {
    int* head = (int*)(p->ws + OFF_CNT) + 1024 + (l >> 1) * 64;
    LAS int* slot = (LAS int*)(smraw_base() + BAR_LDS_ + 64);
#pragma unroll 1
    for (;;) {
        if (opaque_tid() == 0) *slot = atomicAdd(head, 1);
        __syncthreads();
        const int item = *slot;
        __syncthreads();
        if (item >= 128 + 512) break;
        if (item < 128) { const int b = (item >> 4) & 7, h = (item >> 2) & 3, dir = (item >> 1) & 1, vs = item & 1; sc::scan_item<2>(p, l, b, h, dir, vs); }
        else { const int c = item - 128; hy_item_lat(p, l, c); __syncthreads(); hy_item_ctx(p, l, c, sm); }
        __syncthreads();
    }
}

__device__ __forceinline__ void ph_hy_norm(KP p, int l, int bid, int nb, float* sm) {
    const int tid = opaque_tid(), o = l >> 1;
    const bf16_t* ZOT = (const bf16_t*)(p->ws + OFF_ZOT);
    bf16_t* MIX = (bf16_t*)(p->ws + OFF_U);
    const float* nw = p->in[I_HNORM] + o * 512;
    float* tile = sm;
    float* part = sm + 64 * 65;
#pragma unroll 1
    for (int item = bid; item < (NT / 64) * 8; item += nb) {
        const int tt = item >> 3, g = item & 7, tok0 = tt * 64;
        __syncthreads();
        { const int cc = tid >> 3, ch = tid & 7;
          const uint4 v = *(const uint4*)(ZOT + (size_t)(g * 64 + cc) * NT + tok0 + ch * 8);
          float* d = tile + cc * 65 + ch * 8;
          d[0] = bflo(v.x); d[1] = bfhi(v.x); d[2] = bflo(v.y); d[3] = bfhi(v.y); d[4] = bflo(v.z); d[5] = bfhi(v.z); d[6] = bflo(v.w); d[7] = bfhi(v.w); }
        __syncthreads();
        { const int tk = tid & 63, pt = tid >> 6; float s = 0.f;
#pragma unroll
          for (int i = 0; i < 8; ++i) { const float x = tile[(pt * 8 + i) * 65 + tk]; s += x * x; }
          part[pt * 64 + tk] = s; }
        __syncthreads();
        { const int tk = tid >> 3, ch = tid & 7; float s = 0.f;
#pragma unroll
          for (int i = 0; i < 8; ++i) s += part[i * 64 + tk];
          const float rs = rsqrtf(s * (1.f / 64.f) + LN_EPS);
          float y[8];
#pragma unroll
          for (int i = 0; i < 8; ++i) y[i] = tile[(ch * 8 + i) * 65 + tk] * rs * nw[g * 64 + ch * 8 + i];
          *(uint4*)(MIX + (size_t)(tok0 + tk) * DM + g * 64 + ch * 8) = make_uint4(cvt_pk_bf16(y[0], y[1]), cvt_pk_bf16(y[2], y[3]), cvt_pk_bf16(y[4], y[5]), cvt_pk_bf16(y[6], y[7])); }
    }
}

__device__ __forceinline__ void ph_normgate_odd(KP p, int l, int bid, int nb) {
    const int tid = opaque_tid(), lane = tid & 63, wv = tid >> 6, o2 = l >> 1;
    const bf16_t* P = (const bf16_t*)(p->ws + OFF_BIG);
    const bf16_t* HX = (const bf16_t*)(p->ws + OFF_AUX);
    const bf16_t* HX1 = HX + (size_t)NT * 1024;
    bf16_t* MIX = (bf16_t*)(p->ws + OFF_U);
    const int c16 = 16 * (lane & 31);
    const float* nw = p->in[I_RNW] + o2 * 512 + c16;
    int t2 = bid * 8 + wv;
    auto ld = [&](int t2_) { const int tok = t2_ * 2 + (lane >> 5); const size_t o = (size_t)tok * 1024 + 512 + c16; return hng_load(HX + o, HX1 + o, P + (size_t)tok * ODD_LD + 3072 + c16); };
    Hng6 nx = ld(t2);
#pragma unroll 1
    for (; t2 < NT / 2; t2 += nb * 8) {
        const Hng6 cur = nx;
        nx = ld(t2 + nb * 8 < NT / 2 ? t2 + nb * 8 : t2);
        const int tok = t2 * 2 + (lane >> 5);
        hng_compute<true, false>(cur, nw, MIX + (size_t)tok * 1024 + 512 + c16);
    }
}

__device__ __forceinline__ void ph_ln1_router(KP p, int l, int ntok, int bid, int nb, float* sm) {
    constexpr int VP = (1024 + 8) * 2;
    constexpr unsigned O_VH = 0, O_VL = 32 * VP, O_LG = 64 * VP;
    static_assert(O_LG + 2 * 32 * 64 * 4 <= BAR_LDS_, "router LDS");
    const int tid = opaque_tid(), lane = tid & 63, wv = __builtin_amdgcn_readfirstlane(tid >> 6), r16 = lane & 15, q4 = lane >> 4;
    const unsigned L0 = (unsigned)(size_t)smraw_base();
    const bf16_t* Y = (const bf16_t*)(p->ws + OFF_BIG);
    bf16_t* U = (bf16_t*)(p->ws + OFF_U);
    const float* lw = p->in[I_LNW] + (l * 2) * 1024; const float* lb = p->in[I_LNB] + (l * 2) * 1024;
    const bf16_t* RWH = (const bf16_t*)(p->ws + OFF_RWH); const bf16_t* RWL = RWH + 64 * 1024;
    const float rb = p->in[I_RB][l * 64 + lane];
    LAS int* lcnt = (LAS int*)(smraw_base() + BAR_LDS_ + 256);
    if (tid < 64) lcnt[tid] = 0;
    __syncthreads();
    int* tidx = (int*)(p->ws + OFF_TIDX); float* tgate = (float*)(p->ws + OFF_TGATE); int* tpos = (int*)(p->ws + OFF_TPOS);
    {
        int* stok = (int*)(p->ws + OFF_STOK); float* sgate = (float*)(p->ws + OFF_SGATE); int* sdst = (int*)(p->ws + OFF_SDST);
#pragma unroll 1
        for (int i = bid * 512 + tid; i < MAXROWS; i += nb * 512) { stok[i] = ZROW; sgate[i] = 0.f; sdst[i] = NT * 9; }
    }
    const int nfr = (ntok >> 5) / nb, nsteps = nfr + (((ntok >> 5) % nb) ? 1 : 0);
    uint2 ph_[4][4]; uint2 pr_[4][4];
    auto step_geom = [&](int step, int& tpw, int& base) { const bool full = step < nfr; tpw = full ? 4 : 1; base = full ? (step * nb + bid) * 32 : nfr * nb * 32 + bid * 8; };
    auto preload = [&](int step) {
        int tpw, base; step_geom(step, tpw, base);
#pragma unroll
        for (int j = 0; j < 4; ++j) {
            if (j < tpw) {
                const int tok = base + wv * tpw + j;
                const bf16_t* h = hrow(p, tok); const bf16_t* r = Y + (size_t)tok * DM;
#pragma unroll
                for (int c = 0; c < 4; ++c) { const int d = 4 * (lane + 64 * c); ph_[j][c] = *(const uint2*)(h + d); pr_[j][c] = *(const uint2*)(r + d); }
            }
        }
    };
    preload(0);
#pragma unroll 1
    for (int step = 0; step < nsteps; ++step) {
        int tpw, base; step_geom(step, tpw, base);
        float4 cg[4], cw[4], cb[4], csh[4], csc[4];
        {
            const float* m = modrow(p, l, base);
#pragma unroll
            for (int c = 0; c < 4; ++c) { const int d = 4 * (lane + 64 * c);
                cg[c] = *(const float4*)(m + 2 * 1024 + d); cw[c] = *(const float4*)(lw + d); cb[c] = *(const float4*)(lb + d); csh[c] = *(const float4*)(m + 3 * 1024 + d); csc[c] = *(const float4*)(m + 4 * 1024 + d); }
        }
#pragma unroll
        for (int j = 0; j < 4; ++j) {
            if (j >= tpw) break;
            const int tl = wv * tpw + j, tok = base + tl;
            bf16_t* h = hrow(p, tok);
            float x[16]; float s = 0.f;
#pragma unroll
            for (int c = 0; c < 4; ++c) {
                const uint2 hw2 = ph_[j][c]; const float4 hv = make_float4(bflo(hw2.x), bfhi(hw2.x), bflo(hw2.y), bfhi(hw2.y)), gv = cg[c]; const uint2 rw2 = pr_[j][c];
                const float4 rv = make_float4(bflo(rw2.x), bfhi(rw2.x), bflo(rw2.y), bfhi(rw2.y));
                x[4 * c] = ALPHA * hv.x + gv.x * rv.x; x[4 * c + 1] = ALPHA * hv.y + gv.y * rv.y; x[4 * c + 2] = ALPHA * hv.z + gv.z * rv.z; x[4 * c + 3] = ALPHA * hv.w + gv.w * rv.w;
                s += x[4 * c] + x[4 * c + 1] + x[4 * c + 2] + x[4 * c + 3];
            }
            const float mean = wave_sum(s) * (1.f / 1024.f);
            float q = 0.f;
#pragma unroll
            for (int i = 0; i < 16; ++i) { x[i] -= mean; q += x[i] * x[i]; }
            const float rs = rsqrtf(wave_sum(q) * (1.f / 1024.f) + LN_EPS);
#pragma unroll
            for (int c = 0; c < 4; ++c) {
                const int d = 4 * (lane + 64 * c);
                const float4 w4 = cw[c], b4 = cb[c], sh = csh[c], sc = csc[c];
                float4 y; y.x = x[4 * c] * rs * w4.x + b4.x; y.y = x[4 * c + 1] * rs * w4.y + b4.y; y.z = x[4 * c + 2] * rs * w4.z + b4.z; y.w = x[4 * c + 3] * rs * w4.w + b4.w;
                *(uint2*)(h + d) = make_uint2(cvt_pk_bf16(y.x, y.y), cvt_pk_bf16(y.z, y.w));
                float4 v; v.x = y.x * (1.f + sc.x) + sh.x; v.y = y.y * (1.f + sc.y) + sh.y; v.z = y.z * (1.f + sc.z) + sh.z; v.w = y.w * (1.f + sc.w) + sh.w;
                const unsigned h0 = cvt_pk_bf16(v.x, v.y), h1 = cvt_pk_bf16(v.z, v.w);
                *(uint2*)(U + (size_t)tok * DM + d) = make_uint2(h0, h1);
                sc::st8(L0 + O_VH + tl * VP + d * 2, make_uint2(h0, h1));
                sc::st8(L0 + O_VL + tl * VP + d * 2, make_uint2(cvt_pk_bf16(v.x - bflo(h0), v.y - bfhi(h0)), cvt_pk_bf16(v.z - bflo(h1), v.w - bfhi(h1))));
            }
        }
        __syncthreads();
        {
            const int et = wv & 3, kh = wv >> 2;
            sc::f32x4 acc0 = (sc::f32x4){0.f, 0.f, 0.f, 0.f}, acc1 = acc0;
            const bf16_t* bh = RWH + (size_t)(et * 16 + r16) * 1024 + kh * 512 + q4 * 8; const bf16_t* bl = RWL + (size_t)(et * 16 + r16) * 1024 + kh * 512 + q4 * 8;
#pragma unroll 4
            for (int ks = 0; ks < 16; ++ks) {
                const int kk = kh * 512 + ks * 32 + q4 * 8;
                const sc::bf16x8 wh = *(const sc::bf16x8*)(bh + ks * 32), wl = *(const sc::bf16x8*)(bl + ks * 32);
                const sc::bf16x8 a0h = sc::rd_row(L0 + O_VH, r16, VP, kk), a0l = sc::rd_row(L0 + O_VL, r16, VP, kk);
                const sc::bf16x8 a1h = sc::rd_row(L0 + O_VH, 16 + r16, VP, kk), a1l = sc::rd_row(L0 + O_VL, 16 + r16, VP, kk);
                acc0 = SC_MFMA(a0h, wh, acc0); acc1 = SC_MFMA(a1h, wh, acc1); acc0 = SC_MFMA(a0h, wl, acc0); acc1 = SC_MFMA(a1h, wl, acc1); acc0 = SC_MFMA(a0l, wh, acc0); acc1 = SC_MFMA(a1l, wh, acc1);
            }
#pragma unroll
            for (int jj = 0; jj < 4; ++jj) {
                *(LAS float*)(size_t)(L0 + O_LG + kh * 8192 + ((q4 * 4 + jj) * 64 + et * 16 + r16) * 4) = acc0[jj];
                *(LAS float*)(size_t)(L0 + O_LG + kh * 8192 + ((16 + q4 * 4 + jj) * 64 + et * 16 + r16) * 4) = acc1[jj]; }
        }
        preload(step + 1 < nsteps ? step + 1 : step);
        __syncthreads();
#pragma unroll 1
        for (int j = 0; j < tpw; ++j) {
            const int tl = wv * tpw + j, tok = base + tl;
            const float lg = *(const LAS float*)(size_t)(L0 + O_LG + (tl * 64 + lane) * 4) + *(const LAS float*)(size_t)(L0 + O_LG + 8192 + (tl * 64 + lane) * 4);
            const float score = sigmoidf_(lg);
            const float key = score + rb;
            int rank = 64; float kk = key;
#pragma unroll
            for (int r = 0; r < TOPK; ++r) {
                float m = kk; const float ni = -__builtin_inff();
                m = fmaxf(m, WS_DPPI(m, ni, 0x111, 0xf)); m = fmaxf(m, WS_DPPI(m, ni, 0x112, 0xf)); m = fmaxf(m, WS_DPPI(m, ni, 0x114, 0xf)); m = fmaxf(m, WS_DPPI(m, ni, 0x118, 0xf));
                m = fmaxf(m, WS_DPPI(m, ni, 0x142, 0xa)); m = fmaxf(m, WS_DPPI(m, ni, 0x143, 0xc));
                const float mx = __builtin_bit_cast(float, __builtin_amdgcn_readlane(__builtin_bit_cast(int, m), 63));
                const unsigned long long bal = __builtin_amdgcn_ballot_w64(kk == mx);
                const int first = (int)__builtin_ctzll(bal);
                if (lane == first) { rank = r; kk = ni; }
            }
            const bool sel = rank < TOPK;
            const float gsum = wave_sum(sel ? score : 0.f);
            if (sel) {
                const int pos = __hip_atomic_fetch_add(lcnt + lane, 1, __ATOMIC_RELAXED, __HIP_MEMORY_SCOPE_WORKGROUP);
                tidx[tok * 8 + rank] = lane; tgate[tok * 8 + rank] = 2.5f * score / gsum; tpos[tok * 8 + rank] = pos;
            }
        }
        __syncthreads();
    }
    __syncthreads();
    if (tid < 64) ((int*)(p->ws + OFF_BCNT))[bid * 64 + tid] = lcnt[tid];
}

__device__ __forceinline__ void moe_offsets(KP p, int l, int ntok, LAS int* offs) {
    const int t = opaque_tid();
    if (t < 66) offs[t] = ((const int*)(p->ws + OFF_GOFFS))[t];
    __syncthreads();
}
__device__ __forceinline__ int moe_expert_of(const LAS int* offs, int row) { int e = 0;
#pragma unroll 1
    while (e < 64 && row >= offs[e + 1]) ++e;
    return e; }

__device__ __forceinline__ void ph_scatter(KP p, int l, int ntok, int bid, int nb, LAS unsigned char* lds) {
    LAS int* offs = (LAS int*)lds;
    LAS int* myb = offs + 128;
    LAS int* part = offs + 256;
    const int tid = opaque_tid();
    const int* bcnt = (const int*)(p->ws + OFF_BCNT);
    { const int e = tid & 63, pt = tid >> 6; int tot = 0, mine = 0;
#pragma unroll 4
      for (int b = pt; b < nb; b += 8) { const int c = bcnt[b * 64 + e]; tot += c; mine += (b < bid) ? c : 0; }
      part[pt * 64 + e] = tot; part[512 + pt * 64 + e] = mine; }
    __syncthreads();
    if (tid < 64) {
        int tot = 0, mine = 0;
#pragma unroll
        for (int i = 0; i < 8; ++i) { tot += part[i * 64 + tid]; mine += part[512 + i * 64 + tid]; }
        const int pc = (tot + 255) & ~255;
        int incl = pc;
#pragma unroll
        for (int o = 1; o < 64; o <<= 1) { const int t = SHU(incl, o); if (tid >= o) incl += t; }
        offs[tid] = incl - pc; myb[tid] = mine;
        if (tid == 63) { offs[64] = incl; offs[65] = incl + ntok; }
    }
    __syncthreads();
    if (bid == 0 && tid < 66) ((int*)(p->ws + OFF_GOFFS))[tid] = offs[tid];
    const int* tidx = (const int*)(p->ws + OFF_TIDX); const float* tgate = (const float*)(p->ws + OFF_TGATE); const int* tpos = (const int*)(p->ws + OFF_TPOS);
    int* stok = (int*)(p->ws + OFF_STOK); float* sgate = (float*)(p->ws + OFF_SGATE); int* sdst = (int*)(p->ws + OFF_SDST);
    int* tile_e = (int*)(p->ws + OFF_TILEE);
    const int nfr = (ntok >> 5) / nb, nsteps = nfr + (((ntok >> 5) % nb) ? 1 : 0);
#pragma unroll 1
    for (int step = 0; step < nsteps; ++step) {
        const bool full = step < nfr;
        const int ntk = full ? 32 : 8, base = full ? (step * nb + bid) * 32 : nfr * nb * 32 + bid * 8;
        if (tid < ntk * 9) {
            const int tok = base + tid / 9, sl = tid % 9;
            if (sl < 8) { const int i = tok * 8 + sl, e = tidx[i], row = offs[e] + myb[e] + tpos[i]; stok[row] = tok; sgate[row] = tgate[i]; sdst[row] = tok * 9 + sl; }
            else { const int row = offs[64] + tok; stok[row] = tok; sgate[row] = 1.f; sdst[row] = tok * 9 + 8; }
        }
    }
    const int nrt = offs[65] >> 8;
#pragma unroll 1
    for (int rt = bid * 512 + tid; rt < nrt; rt += nb * 512) tile_e[rt] = moe_expert_of(offs, rt * 256);
    __syncthreads();
}

#define MOE_TAB (gp::STAGE_BYTES + 256)
#define MOE_MAXT 9
static_assert(131072 + 256 + 256 + MOE_MAXT * 2048 <= BAR_LDS_, "MoE tables");
struct MoeDeal {
    int nfull, rem, c, G;
    __device__ __forceinline__ void init(int nrt, int c_, int G_) { nfull = nrt / G_; rem = nrt % G_; c = ((c_ & 7) << 5) | (c_ >> 3); G = G_; }
    __device__ __forceinline__ int nleft(int NPN) const { const int tot = rem * NPN; return c < tot ? (tot - c + G - 1) / G : 0; }
    __device__ __forceinline__ int ntiles(int NPN) const { return nfull + nleft(NPN); }
    __device__ __forceinline__ int tile_of(int j, int NPN) const { return j < nfull ? c + j * G : nfull * G + (c + (j - nfull) * G) / NPN; }
    __device__ __forceinline__ bool unit(int i, int NPN, int& j, int& pn) const {
        if (i < nfull * NPN) { j = i / NPN; pn = i % NPN; return true; }
        const int k = i - nfull * NPN, lu = c + k * G;
        if (lu < rem * NPN) { j = nfull + k; pn = lu % NPN; return true; }
        return false;
    }
};
struct Moe1Sched {
    const char* U; const char* W; const LAS int* tabE; const LAS int* tabS; MoeDeal d;
    __device__ __forceinline__ bool next(int i, gp::Unit& u) const {
        int j, pn; if (!d.unit(i, 2, j, pn)) return false;
        u.A = U; u.B = W + (size_t)__builtin_amdgcn_readfirstlane(tabE[j]) * (512 * 1024 * 2) + (size_t)pn * (256 * 1024 * 2); u.r0 = d.tile_of(j, 2) * 256; u.c0 = pn * 256; u.aux = j; return true;
    }
    __device__ __forceinline__ void lane_off(const gp::Unit& u, unsigned (&vo)[2][2]) const {
        const int tid = opaque_tid(); int R0, C0, R1, C1; gp::stage_rc(tid * 16, R0, C0); gp::stage_rc(tid * 16 + 8192, R1, C1);
        const LAS int* t = tabS + u.aux * 256;
        vo[0][0] = (unsigned)t[R0] * 2048u + (unsigned)C0 * 2u; vo[0][1] = (unsigned)t[R1] * 2048u + (unsigned)C1 * 2u;
        vo[1][0] = (unsigned)t[128 + R0] * 2048u + (unsigned)C0 * 2u; vo[1][1] = (unsigned)t[128 + R1] * 2048u + (unsigned)C1 * 2u;
    }
};
struct EpiH {
    bf16_t* H;
    static constexpr int NSTQ = 12;
    __device__ __forceinline__ void quad(const gp::f32x4 (&acc)[2][2][4][2], const gp::Unit& u, int ai, int bj, int wr, int wc, int fr, int fq, unsigned (&)[4][2]) const {
        const int row0 = u.r0 + wr * 64 + fr + ai * 128, j0 = ((u.c0 + bj * 128 + wc * 32) >> 5) * 16 + 4 * fq;
#pragma unroll
        for (int m = 0; m < 4; ++m) {
            const gp::f32x4 a = acc[ai][bj][m][0], b = acc[ai][bj][m][1];
            const float h0 = fsilu(a[0]) * b[0], h1 = fsilu(a[1]) * b[1], h2 = fsilu(a[2]) * b[2], h3 = fsilu(a[3]) * b[3];
            *(uint2*)(H + (size_t)(row0 + m * 16) * 256 + j0) = make_uint2(cvt_pk_bf16(h0, h1), cvt_pk_bf16(h2, h3)); }
    }
    __device__ __forceinline__ void operator()(const gp::f32x4 (&acc)[2][2][4][2], const gp::Unit& u, int wr, int wc, int fr, int fq) const {
        const int row0 = u.r0 + wr * 64 + fr;
#pragma unroll
        for (int ai = 0; ai < 2; ++ai)
#pragma unroll
            for (int m = 0; m < 4; ++m) { bf16_t* rowp = H + (size_t)(row0 + ai * 128 + m * 16) * 256;
#pragma unroll
                for (int bj = 0; bj < 2; ++bj) {
                    const int j0 = ((u.c0 + bj * 128 + wc * 32) >> 5) * 16 + 4 * fq;
                    const gp::f32x4 a = acc[ai][bj][m][0], b = acc[ai][bj][m][1];
                    const float h0 = fsilu(a[0]) * b[0], h1 = fsilu(a[1]) * b[1], h2 = fsilu(a[2]) * b[2], h3 = fsilu(a[3]) * b[3];
                    *(uint2*)(rowp + j0) = make_uint2(cvt_pk_bf16(h0, h1), cvt_pk_bf16(h2, h3)); }
                __builtin_amdgcn_sched_barrier(0); }
    }
};
__device__ __forceinline__ void ph_moe1(KP p, int l, int ntok, int bid, int nb, LAS unsigned char* lds) {
    LAS int* tabE = (LAS int*)(lds + MOE_TAB);
    LAS int* tabS = tabE + 64;
    const int tid = opaque_tid();
    MoeDeal d; d.init(((const int*)(p->ws + OFF_GOFFS))[65] >> 8, bid, nb);
    const int nper = d.ntiles(2);
    const int* stok = (const int*)(p->ws + OFF_STOK); const int* tile_e = (const int*)(p->ws + OFF_TILEE);
    for (int i = tid; i < nper * 256; i += 512) tabS[i] = stok[(size_t)d.tile_of(i >> 8, 2) * 256 + (i & 255)];
    if (tid < nper) tabE[tid] = tile_e[d.tile_of(tid, 2)];
    __syncthreads();
    Moe1Sched S{(const char*)(p->ws + OFF_U), (const char*)(p->ws + OFF_W13L(l)), tabE, tabS, d};
    EpiH E{(bf16_t*)(p->ws + OFF_BIG)};
    gp::gemm_phase<true, false, true>(lds, 1024, S, E);
}

struct Moe2Sched {
    const char* H; const char* W; const LAS int* tabE; MoeDeal d;
    __device__ __forceinline__ bool next(int i, gp::Unit& u) const {
        int j, pn; if (!d.unit(i, 4, j, pn)) return false;
        u.A = H + (size_t)d.tile_of(j, 4) * (256 * 256 * 2); u.B = W + (size_t)__builtin_amdgcn_readfirstlane(tabE[j]) * (1024 * 256 * 2) + (size_t)pn * (256 * 256 * 2); u.r0 = j * 256; u.c0 = pn * 256; u.aux = j; return true;
    }
    __device__ __forceinline__ void lane_off(const gp::Unit&, unsigned (&)[2][2]) const {}
};
__device__ __forceinline__ unsigned pk_fp8x4(float a, float b, float c, float d) { int w = __builtin_amdgcn_cvt_pk_fp8_f32(a, b, 0, false); w = __builtin_amdgcn_cvt_pk_fp8_f32(c, d, w, true); return (unsigned)w; }
struct EpiY {
    unsigned char* Ys; const LAS int* tabD; const LAS float* tabG;
    static constexpr int NSTQ = 8;
    __device__ __forceinline__ void quad(const gp::f32x4 (&acc)[2][2][4][2], const gp::Unit& u, int ai, int bj, int wr, int wc, int fr, int fq, unsigned (&keep)[4][2]) const {
        const int rl0 = u.r0 + wr * 64 + fr + ai * 128, pos0 = u.c0 + wc * 64 + 16 * fq;
#pragma unroll
        for (int m = 0; m < 4; ++m) {
            const float g = tabG[rl0 + m * 16];
            const gp::f32x4 v0 = acc[ai][bj][m][0] * g, v1 = acc[ai][bj][m][1] * g;
            const unsigned p0 = pk_fp8x4(v0[0], v0[1], v0[2], v0[3]), p1 = pk_fp8x4(v1[0], v1[1], v1[2], v1[3]);
            if (bj == 0) { keep[m][0] = p0; keep[m][1] = p1; }
            else *(gp::u32x4*)(Ys + (size_t)tabD[rl0 + m * 16] * 1024 + pos0) = (gp::u32x4){keep[m][0], keep[m][1], p0, p1};
        }
    }
    __device__ __forceinline__ void operator()(const gp::f32x4 (&acc)[2][2][4][2], const gp::Unit& u, int wr, int wc, int fr, int fq) const {
        const int rl0 = u.r0 + wr * 64 + fr, pos0 = u.c0 + wc * 64 + 16 * fq;
#pragma unroll
        for (int ai = 0; ai < 2; ++ai)
#pragma unroll
            for (int m = 0; m < 4; ++m) {
                const int rl = rl0 + ai * 128 + m * 16;
                const int dst = tabD[rl]; const float g = tabG[rl];
                const gp::f32x4 a0 = acc[ai][0][m][0] * g, a1 = acc[ai][0][m][1] * g, b0 = acc[ai][1][m][0] * g, b1 = acc[ai][1][m][1] * g;
                *(gp::u32x4*)(Ys + (size_t)dst * 1024 + pos0) = (gp::u32x4){pk_fp8x4(a0[0], a0[1], a0[2], a0[3]), pk_fp8x4(a1[0], a1[1], a1[2], a1[3]), pk_fp8x4(b0[0], b0[1], b0[2], b0[3]), pk_fp8x4(b1[0], b1[1], b1[2], b1[3])};
                __builtin_amdgcn_sched_barrier(0); }
    }
};
__device__ __forceinline__ void ph_moe2(KP p, int l, int ntok, int bid, int nb, LAS unsigned char* lds) {
    LAS int* tabE = (LAS int*)(lds + MOE_TAB);
    LAS int* tabD = tabE + 64;
    LAS float* tabG = (LAS float*)(tabD + MOE_MAXT * 256);
    const int tid = opaque_tid();
    MoeDeal d; d.init(((const int*)(p->ws + OFF_GOFFS))[65] >> 8, bid, nb);
    const int nper = d.ntiles(4);
    const int* sdst = (const int*)(p->ws + OFF_SDST); const float* sgate = (const float*)(p->ws + OFF_SGATE); const int* tile_e = (const int*)(p->ws + OFF_TILEE);
    for (int i = tid; i < nper * 256; i += 512) { const size_t r = (size_t)d.tile_of(i >> 8, 4) * 256 + (i & 255); tabD[i] = sdst[r]; tabG[i] = sgate[r]; }
    if (tid < nper) tabE[tid] = tile_e[d.tile_of(tid, 4)];
    __syncthreads();
    Moe2Sched S{(const char*)(p->ws + OFF_BIG), (const char*)(p->ws + OFF_W2), tabE, d};
    EpiY E{(unsigned char*)(p->ws + OFF_YS), tabD, tabG};
    gp::gemm_phase<false, true, true>(lds, 256, S, E);
}

template <bool NEXT>
__device__ __forceinline__ void ph_combine_ln2(KP p, int l, int ntok, int bid, int nb) {
    bf16_t* U = (bf16_t*)(p->ws + OFF_U);
    float* G = (float*)(p->ws + OFF_G);
    const bool gates = NEXT && ((l + 1) & 1) == 0;
    LAS float* wl = (LAS float*)smraw_base();
    if (gates) stage_gate_w(p, (l + 1) >> 1, wl);
    const int tid = opaque_tid(), lane = tid & 63, wv = tid >> 6;
    const int cA = 256 * (lane >> 4) + 32 * ((lane >> 2) & 3) + 8 * (lane & 3);
    const unsigned char* Ys = (const unsigned char*)(p->ws + OFF_YS);
    const float* lw = p->in[I_LNW] + (l * 2 + 1) * 1024; const float* lb = p->in[I_LNB] + (l * 2 + 1) * 1024;
    uint4 yq[9]; uint4 hq[2];
    auto preload = [&](int tok) {
#pragma unroll
        for (int s9 = 0; s9 < 9; ++s9) yq[s9] = *(const uint4*)(Ys + ((size_t)tok * 9 + s9) * 1024 + 16 * lane);
        const bf16_t* h = hrow(p, tok);
        hq[0] = *(const uint4*)(h + cA); hq[1] = *(const uint4*)(h + cA + 128);
    };
    const int tpw = ntok >> 11, t0 = (bid * 8 + wv) * tpw;
    float4 cg[4], cw[4], cb[4], csh[4], csc[4];
    int rcur = -1;
    preload(t0);
#pragma unroll 1
    for (int k = 0; k < tpw; ++k) {
        const int tok = t0 + k;
        bf16_t* h = hrow(p, tok);
        const int rr = tok < NL ? (tok >> 12) : 8;
        if (rr != rcur) {
            rcur = rr;
            const float* m = modrow(p, l, tok);
            const float* m2 = modrow(p, NEXT ? l + 1 : l, tok);
#pragma unroll
            for (int q = 0; q < 4; ++q) {
                const int c = cA + (q >> 1) * 128 + (q & 1) * 4;
                cg[q] = *(const float4*)(m + 5 * 1024 + c); cw[q] = *(const float4*)(lw + c); cb[q] = *(const float4*)(lb + c);
                if (NEXT) { csh[q] = *(const float4*)(m2 + c); csc[q] = *(const float4*)(m2 + 1024 + c); }
            }
        }
        float f[16];
#pragma unroll
        for (int i = 0; i < 16; ++i) f[i] = 0.f;
#pragma unroll
        for (int s9 = 0; s9 < 9; ++s9) {
            const unsigned ww[4] = {yq[s9].x, yq[s9].y, yq[s9].z, yq[s9].w};
#pragma unroll
            for (int q = 0; q < 4; ++q) { const f32x2_n lo = __builtin_amdgcn_cvt_pk_f32_fp8((int)ww[q], false), hi = __builtin_amdgcn_cvt_pk_f32_fp8((int)ww[q], true);
                f[4 * q] += lo[0]; f[4 * q + 1] += lo[1]; f[4 * q + 2] += hi[0]; f[4 * q + 3] += hi[1]; }
        }
        float4 hc[4];
        hc[0] = make_float4(bflo(hq[0].x), bfhi(hq[0].x), bflo(hq[0].y), bfhi(hq[0].y)); hc[1] = make_float4(bflo(hq[0].z), bfhi(hq[0].z), bflo(hq[0].w), bfhi(hq[0].w));
        hc[2] = make_float4(bflo(hq[1].x), bfhi(hq[1].x), bflo(hq[1].y), bfhi(hq[1].y)); hc[3] = make_float4(bflo(hq[1].z), bfhi(hq[1].z), bflo(hq[1].w), bfhi(hq[1].w));
#pragma unroll
        for (int q = 0; q < 4; ++q) asm volatile("" : "+v"(hc[q].x), "+v"(hc[q].y), "+v"(hc[q].z), "+v"(hc[q].w), "+v"(f[4 * q]), "+v"(f[4 * q + 1]), "+v"(f[4 * q + 2]), "+v"(f[4 * q + 3]) :: "memory");
        preload(k + 1 < tpw ? tok + 1 : tok);
        float x[16]; float sum = 0.f;
#pragma unroll
        for (int q = 0; q < 4; ++q) {
            const float4 hv = hc[q], gv = cg[q];
            x[4 * q] = ALPHA * hv.x + gv.x * f[4 * q]; x[4 * q + 1] = ALPHA * hv.y + gv.y * f[4 * q + 1]; x[4 * q + 2] = ALPHA * hv.z + gv.z * f[4 * q + 2]; x[4 * q + 3] = ALPHA * hv.w + gv.w * f[4 * q + 3];
            sum += x[4 * q] + x[4 * q + 1] + x[4 * q + 2] + x[4 * q + 3];
        }
        const float mean = wave_sum(sum) * (1.f / 1024.f);
        float q2 = 0.f;
#pragma unroll
        for (int i = 0; i < 16; ++i) { x[i] -= mean; q2 += x[i] * x[i]; }
        const float rs = rsqrtf(wave_sum(q2) * (1.f / 1024.f) + LN_EPS);
        float u16[16]; unsigned yb[8];
#pragma unroll
        for (int q = 0; q < 4; ++q) {
            const int c = cA + (q >> 1) * 128 + (q & 1) * 4;
            const float4 w4 = cw[q], b4 = cb[q];
            float4 y; y.x = x[4 * q] * rs * w4.x + b4.x; y.y = x[4 * q + 1] * rs * w4.y + b4.y; y.z = x[4 * q + 2] * rs * w4.z + b4.z; y.w = x[4 * q + 3] * rs * w4.w + b4.w;
            if (NEXT) { yb[2 * q] = cvt_pk_bf16(y.x, y.y); yb[2 * q + 1] = cvt_pk_bf16(y.z, y.w); }
            else *(float4*)(p->out + (size_t)tok * DM + c) = y;
            if (NEXT) {
                const float4 sh = csh[q], sc = csc[q];
                u16[4 * q] = y.x * (1.f + sc.x) + sh.x; u16[4 * q + 1] = y.y * (1.f + sc.y) + sh.y; u16[4 * q + 2] = y.z * (1.f + sc.z) + sh.z; u16[4 * q + 3] = y.w * (1.f + sc.w) + sh.w;
            }
        }
        if (NEXT) {
            *(uint4*)(h + cA) = make_uint4(yb[0], yb[1], yb[2], yb[3]); *(uint4*)(h + cA + 128) = make_uint4(yb[4], yb[5], yb[6], yb[7]);
            *(uint4*)(U + (size_t)tok * DM + cA) = make_uint4(cvt_pk_bf16(u16[0], u16[1]), cvt_pk_bf16(u16[2], u16[3]), cvt_pk_bf16(u16[4], u16[5]), cvt_pk_bf16(u16[6], u16[7]));
            *(uint4*)(U + (size_t)tok * DM + cA + 128) = make_uint4(cvt_pk_bf16(u16[8], u16[9]), cvt_pk_bf16(u16[10], u16[11]), cvt_pk_bf16(u16[12], u16[13]), cvt_pk_bf16(u16[14], u16[15]));
        }
        if (gates) {
            float ga[16];
#pragma unroll
            for (int j = 0; j < 16; ++j) ga[j] = 0.f;
#pragma unroll
            for (int g4 = 0; g4 < 4; ++g4) {
                const int c = cA + (g4 >> 1) * 128 + (g4 & 1) * 4;
#pragma unroll
                for (int qq = 0; qq < 4; ++qq) {
                    const float uv = u16[4 * g4 + qq];
#pragma unroll
                    for (int j4 = 0; j4 < 4; ++j4) { const f32x4_l w = *(const LAS f32x4_l*)(wl + (c + qq) * 16 + j4 * 4); ga[4 * j4] += uv * w[0]; ga[4 * j4 + 1] += uv * w[1]; ga[4 * j4 + 2] += uv * w[2]; ga[4 * j4 + 3] += uv * w[3]; }
                }
                __builtin_amdgcn_sched_barrier(0);
            }
            float mine = 0.f;
#pragma unroll
            for (int j = 0; j < 16; ++j) { const float sg = wave_sum(ga[j]); if (lane == j) mine = sg; }
            if (lane < 16) G[(size_t)tok * 16 + lane] = mine;
        }
    }
}

#define MEGA_LDS (131072 + 256 + 20480)
#define NBLK 256
#define BAR_LDS BAR_LDS_
#define SYNC() do { XcdBarrier _b; _b.bar = (unsigned*)kparams()->ws; _b.x = xb_xcc_id(); _b.st = (volatile LAS unsigned*)((LAS unsigned char*)smraw_base() + BAR_LDS); xcd_barrier(_b); } while (0)
template <int PAR>
__device__ __forceinline__ void layer_fwd(const int l) {
    LAS unsigned char* lds = smraw_base(); float* sm = (float*)smraw_generic();
    const int bid = blockIdx.x; constexpr int nb = NBLK;
    const int ntok = (l == 3) ? NL : NT;
    ph_gemm_in(kparams(), l, bid, nb, lds); SYNC();
    if (PAR == 0) {
        ph_scan_even2(kparams(), l, bid, nb, sm); SYNC();
        ph_normgate_even(kparams(), l, bid, nb); SYNC();
    } else {
        ph_hy_prep(kparams(), l, bid, nb, sm); SYNC();
        ph_mix_odd(kparams(), l, bid, nb, sm); SYNC();
        ph_hy_norm(kparams(), l, bid, nb, sm); ph_normgate_odd(kparams(), l, bid, nb); SYNC();
    }
    ph_gemm_out(kparams(), l, bid, nb, lds); SYNC();
    ph_ln1_router(kparams(), l, ntok, bid, nb, sm); SYNC();
    ph_scatter(kparams(), l, ntok, bid, nb, lds); SYNC();
    ph_moe1(kparams(), l, ntok, bid, nb, lds); SYNC();
    ph_moe2(kparams(), l, ntok, bid, nb, lds); SYNC();
    if (l < 3) { ph_combine_ln2<true>(kparams(), l, ntok, bid, nb); ph_convert(kparams(), l + 1, bid, nb, sm, PAR == 0 ? 2 : 0); SYNC(); }
    else ph_combine_ln2<false>(kparams(), l, ntok, bid, nb);
}
__global__ void __launch_bounds__(512, 2) mega_fwd(Params p) {
    LAS unsigned char* lds = smraw_base(); float* sm = (float*)smraw_generic();
    {
        const int t0 = threadIdx.x;
        if ((t0 & 63) == 0) { unsigned h; asm volatile("s_getreg_b32 %0, hwreg(HW_REG_HW_ID, 0, 6)" : "=s"(h)); *(LAS int*)(size_t)(WTAB_LDS + (h & 63u) * 4u) = t0 >> 6; }
        if (t0 < 4) ((LAS unsigned*)(lds + BAR_LDS))[t0] = 0u;
    }
    __syncthreads();
    (void)xcd_barrier_post((unsigned*)kparams()->ws, (volatile LAS unsigned*)(lds + BAR_LDS));
    const int bid = blockIdx.x; constexpr int nb = NBLK;
    ph_prologue(kparams(), bid, nb, sm);
    __syncthreads();
    ph_convert(kparams(), 0, bid, nb, sm);
    SYNC();
    ph_modin<true>(kparams(), 0, bid, nb); SYNC();
#pragma unroll 1
    for (int lp = 0; lp < 2; ++lp) {
        layer_fwd<0>(2 * lp);
        layer_fwd<1>(2 * lp + 1);
    }
    __syncthreads();
    if (blockIdx.x == 0 && opaque_tid() == 0 && xb_ld((unsigned*)kparams()->ws + XB_TMO) != 0u) kparams()->out[0] = __builtin_nanf("");
}

extern "C" void kernel_launch(void* const* d_in, const int* in_sizes, int n_in, void* d_out, int out_size, void* d_ws, size_t ws_size, hipStream_t stream) {
    static int grid = 0;
    if (grid == 0) {
        if (n_in != 38 || out_size != NL * DM || ws_size < WS_END) { fprintf(stderr, "kernel_launch: bad shapes n_in %d out %d ws %zu (need %zu)\n", n_in, out_size, ws_size, (size_t)WS_END); grid = -1; return; }
        int dev = 0, cus = 0, per_cu = 0;
        if (hipGetDevice(&dev) != hipSuccess || hipDeviceGetAttribute(&cus, hipDeviceAttributeMultiprocessorCount, dev) != hipSuccess) { grid = -1; return; }
        if (hipFuncSetAttribute((const void*)mega_fwd, hipFuncAttributeMaxDynamicSharedMemorySize, MEGA_LDS) != hipSuccess) { fprintf(stderr, "kernel_launch: hipFuncSetAttribute failed\n"); grid = -1; return; }
        if (hipOccupancyMaxActiveBlocksPerMultiprocessor(&per_cu, (const void*)mega_fwd, 512, MEGA_LDS) != hipSuccess || per_cu < 1) { fprintf(stderr, "kernel_launch: occupancy query says %d\n", per_cu); (void)hipGetLastError(); grid = -1; return; }
        if (cus != 256) { fprintf(stderr, "kernel_launch: built for 256 CUs, found %d\n", cus); grid = -1; return; }
        grid = NBLK;
    }
    if (grid < 0) return;
    if (hipMemsetAsync(d_ws, 0, OFF_LB, stream) != hipSuccess) return;
    Params p{};
    for (int i = 0; i < 38; ++i) p.in[i] = (const float*)d_in[i];
    p.out = (float*)d_out; p.ws = (unsigned char*)d_ws;
    hipLaunchKernelGGL(mega_fwd, dim3(grid), dim3(512), MEGA_LDS, stream, p);
}
```

```cpp
#include <hip/hip_runtime.h>
#include <stdint.h>
#include <stdio.h>

#define DM 1024
#define NBATCH 8
#define SEQ 4096
#define CTXL 256
#define NL (NBATCH * SEQ)
#define NC (NBATCH * CTXL)
#define NT (NL + NC)
#define ZROW NT
#define TOPK 8
#define EVEN_N 4112
#define ODD_N 3584
#define EVEN_LD 4096
#define ODD_LD 3584
#define MAXROWS (NT * 8 + 64 * 256 + NT)
#define ALPHA 1.681792830507429f
#define LN_EPS 1e-5f
#define E_MQ 0
#define E_MK 256
#define E_MV 512
#define E_MO 1024
#define E_HQ 1536
#define E_HI 2048
#define E_HFF 2560
#define E_HFB 3072
#define E_HG 3584

typedef unsigned short bf16_t;
#define LAS __attribute__((address_space(3)))
#define BAR_LDS_ 150528

#define MiB ((size_t)1 << 20)
#define OFF_CNT   ((size_t)64 << 10)
#define OFF_LB    ((size_t)96 << 10)
#define OFF_MOD   ((size_t)128 << 10)
#define OFF_ROPE  ((size_t)1536 << 10)
#define OFF_BCNT  ((size_t)1600 << 10)
#define OFF_GOFFS ((size_t)1700 << 10)
#define OFF_RWH   ((size_t)2560 << 10)
#define OFF_TILEE (2 * MiB)
#define OFF_HCTX  (4 * MiB)
#define OFF_TIDX  (12 * MiB)
#define OFF_TGATE (14 * MiB)
#define OFF_TPOS  (16 * MiB)
#define OFF_STOK  (18 * MiB)
#define OFF_SGATE (20 * MiB)
#define OFF_SDST  (22 * MiB)
#define OFF_G     (24 * MiB)
#define OFF_U     (28 * MiB)
#define OFF_W     (98 * MiB)
#define OFF_WIN   (OFF_W)
#define OFF_WOUT  (OFF_W + 8 * MiB)
#define OFF_W13   (OFF_W + 10 * MiB)
#define OFF_W2    (OFF_W + 75 * MiB)
#define OFF_BIG   (208 * MiB)
#define OFF_AUX   (480 * MiB)
#define OFF_Z1    (OFF_AUX + 136 * MiB)
#define OFF_Z2    (OFF_Z1 + 68 * MiB)
#define OFF_FILT  (OFF_Z2 + 68 * MiB)
#define OFF_YS    (370 * MiB)
#define OFF_W13X  (822 * MiB)
#define OFF_W13L(l) (((l) & 1) ? OFF_W13X : OFF_W13)
#define OFF_HB    (900 * MiB)
#define WS_END    (1052 * MiB)

struct Params {
    const float* in[38];
    float* out;
    unsigned char* ws;
};

enum { I_X = 0, I_C, I_CTX, I_CCTX, I_ADAW, I_ADAB, I_LNW, I_LNB, I_EWIN, I_MGB, I_MNW, I_HLB, I_HNW, I_EWOUT, I_OWIN, I_HCW, I_HCB,
       I_HW1, I_HB1, I_HW2, I_HB2, I_HW3, I_HB3, I_HFREQ, I_HWOUT, I_HSKIP, I_HNORM, I_RLD, I_RNW, I_OWOUT, I_RW, I_RB, I_W1, I_W3, I_W2, I_SW1, I_SW3, I_SW2 };

typedef const __attribute__((address_space(4))) Params* KP;
__device__ __forceinline__ KP kparams() { KP k = (KP)__builtin_amdgcn_kernarg_segment_ptr(); asm volatile("" : "+s"(k)); return k; }
extern __shared__ __attribute__((aligned(16))) unsigned char smraw_all[];
__device__ __forceinline__ LAS unsigned char* smraw_base() { return (LAS unsigned char*)smraw_all; }
__device__ __forceinline__ unsigned char* smraw_generic() { return smraw_all; }
#define WTAB_LDS (BAR_LDS_ + 512)
__device__ __forceinline__ int opaque_tid() {
    unsigned h; asm volatile("s_getreg_b32 %0, hwreg(HW_REG_HW_ID, 0, 6)" : "=s"(h));
    const int wid = *(volatile LAS int*)(size_t)(WTAB_LDS + (h & 63u) * 4u);
    unsigned m = ~0u; asm volatile("" : "+s"(m));
    const int lane = (int)__builtin_amdgcn_mbcnt_hi(m, __builtin_amdgcn_mbcnt_lo(m, 0u));
    return __builtin_amdgcn_readfirstlane(wid) * 64 + lane;
}
typedef __bf16 bf16x2_n __attribute__((ext_vector_type(2)));
typedef float f32x2_n __attribute__((ext_vector_type(2)));
__device__ __forceinline__ unsigned cvt_pk_bf16(float lo, float hi) { const f32x2_n v = {lo, hi}; return __builtin_bit_cast(unsigned, __builtin_convertvector(v, bf16x2_n)); }
__device__ __forceinline__ float bf2f(bf16_t b) { return __uint_as_float(((unsigned)b) << 16); }
__device__ __forceinline__ float bflo(unsigned w) { return __uint_as_float(w << 16); }
__device__ __forceinline__ float bfhi(unsigned w) { return __uint_as_float(w & 0xffff0000u); }
__device__ __forceinline__ float ldf(const float* p) { return *p; }
__device__ __forceinline__ float ldf(const bf16_t* p) { return bf2f(*p); }
__device__ __forceinline__ void stf(float* p, float v) { *p = v; }
__device__ __forceinline__ void stf(bf16_t* p, float v) { *p = (bf16_t)(cvt_pk_bf16(v, 0.f) & 0xffffu); }
__device__ __forceinline__ float sigmoidf_(float x) { return 1.f / (1.f + expf(-x)); }
__device__ __forceinline__ float siluf_(float x) { return x / (1.f + expf(-x)); }
__device__ __forceinline__ int olane() { unsigned m = ~0u; asm volatile("" : "+s"(m)); return (int)__builtin_amdgcn_mbcnt_hi(m, __builtin_amdgcn_mbcnt_lo(m, 0u)); }
template <class T> __device__ __forceinline__ T shfl_idx(T v, int idx) { return __builtin_bit_cast(T, __builtin_amdgcn_ds_bpermute(idx << 2, __builtin_bit_cast(int, v))); }
#define SHX(v, o) shfl_idx(v, olane() ^ (o))
#define SHI(v, i) shfl_idx(v, (i))
#define SHI32(v, i) shfl_idx(v, (olane() & 32) | ((i) & 31))
#define SHU(v, o) shfl_idx(v, olane() - (o))
__device__ __forceinline__ float fexp(float x) { return __builtin_amdgcn_exp2f(x * 1.4426950408889634f); }
__device__ __forceinline__ float flog(float x) { return __builtin_amdgcn_logf(x) * 0.6931471805599453f; }
__device__ __forceinline__ float frcp(float x) { return __builtin_amdgcn_rcpf(x); }
__device__ __forceinline__ float fsigmoid(float x) { return frcp(1.f + fexp(-x)); }
__device__ __forceinline__ float fsilu(float x) { return x * frcp(1.f + fexp(-x)); }
#define WS_DPP(v, ctrl, rmask) __builtin_bit_cast(float, __builtin_amdgcn_update_dpp(0, __builtin_bit_cast(int, v), ctrl, rmask, 0xf, false))
#define WS_DPPI(v, ident, ctrl, rmask) __builtin_bit_cast(float, __builtin_amdgcn_update_dpp(__builtin_bit_cast(int, (float)(ident)), __builtin_bit_cast(int, v), ctrl, rmask, 0xf, false))
__device__ __forceinline__ float wave_sum(float v) {
    v += WS_DPP(v, 0x111, 0xf); v += WS_DPP(v, 0x112, 0xf); v += WS_DPP(v, 0x114, 0xf); v += WS_DPP(v, 0x118, 0xf);
    v += WS_DPP(v, 0x142, 0xa); v += WS_DPP(v, 0x143, 0xc);
    return __builtin_bit_cast(float, __builtin_amdgcn_readlane(__builtin_bit_cast(int, v), 63));
}
__device__ __forceinline__ bf16_t* hrow(KP p, int tok) { return (bf16_t*)(p->ws + OFF_HB) + (size_t)tok * DM; }
__device__ __forceinline__ const float* modrow(KP p, int l, int tok) {
    const int r = tok < NL ? (tok >> 12) : 8;
    return (const float*)(p->ws + OFF_MOD) + ((size_t)l * 9 + r) * 6144;
}
__device__ __forceinline__ int scan_tok(int b, int i, int dir) {
    return i < CTXL ? NL + b * CTXL + (dir ? CTXL - 1 - i : i) : b * SEQ + (dir ? SEQ - 1 - (i - CTXL) : (i - CTXL));
}

#define XB_TMO      128
#define XB_XCNT(j)  (256  + 64 * (j))
#define XB_XSUB(j)  (1280 + 64 * (j))
#define XB_XGEN(j)  (2304 + 64 * (j))
#define XB_TOP      3328
#define XB_TOPGEN   3392
#define XCD_BAR_WORDS 3456
#define XB_SPIN_CAP (1u << 24)
__device__ __forceinline__ unsigned xb_ld(unsigned* p)              { return __hip_atomic_load(p, __ATOMIC_RELAXED, __HIP_MEMORY_SCOPE_AGENT); }
__device__ __forceinline__ unsigned xb_add(unsigned* p, unsigned v) { return __hip_atomic_fetch_add(p, v, __ATOMIC_RELAXED, __HIP_MEMORY_SCOPE_AGENT); }
__device__ __forceinline__ unsigned xb_xcc_id() { return (unsigned)__builtin_amdgcn_s_getreg((3 << 11) | 20) & 0xFu; }
#define XB_SPIN(cond, bar) do { unsigned _sp = 0; while (cond) { __builtin_amdgcn_s_sleep(1); \
    if ((++_sp & 255u) == 0u) { if (xb_ld(&(bar)[XB_TMO])) break; if (_sp > XB_SPIN_CAP) { atomicAdd(&(bar)[XB_TMO], 1u); break; } } } } while (0)
struct XcdBarrier { unsigned* bar; unsigned x; volatile LAS unsigned* st; };
__device__ __forceinline__ XcdBarrier xcd_barrier_post(unsigned* bar, volatile LAS unsigned* st) {
    XcdBarrier b; b.bar = bar; b.x = xb_xcc_id(); b.st = st;
    if (opaque_tid() == 0) (void)xb_add(&bar[XB_XCNT(b.x)], 1u);
    return b;
}
__device__ __forceinline__ void xcd_barrier_complete(unsigned* bar, unsigned x, unsigned& nloc, unsigned& nx) {
    const unsigned G = gridDim.x * gridDim.y * gridDim.z;
    unsigned sum, cnt, mine, sp = 0u;
    for (;;) {
        sum = 0u; cnt = 0u; mine = 0u;
#pragma unroll
        for (unsigned j = 0; j < 16; ++j) { const unsigned c = xb_ld(&bar[XB_XCNT(j)]); sum += c; cnt += (c > 0u) ? 1u : 0u; mine = (j == x) ? c : mine; }
        if (sum == G) break;
        __builtin_amdgcn_s_sleep(1);
        if ((++sp & 255u) == 0u) { if (xb_ld(&bar[XB_TMO])) break; if (sp > XB_SPIN_CAP) { atomicAdd(&bar[XB_TMO], 1u); break; } }
    }
    nloc = mine > 0u ? mine : 1u; nx = cnt > 0u ? cnt : 1u;
}
__device__ __forceinline__ void xcd_barrier(const XcdBarrier& b) {
    asm volatile("s_waitcnt vmcnt(0)" ::: "memory");
    __syncthreads();
    if (opaque_tid() == 0) {
        unsigned* bar = b.bar;
        __builtin_amdgcn_s_waitcnt(0);
        unsigned nloc = b.st[0], nx = b.st[1];
        if (nloc == 0u) { xcd_barrier_complete(bar, b.x, nloc, nx); b.st[0] = nloc; b.st[1] = nx; }
        const unsigned old = xb_add(&bar[XB_XSUB(b.x)], 1u);
        const unsigned gen = old / nloc;
        if (old + 1u == (gen + 1u) * nloc) {
            __builtin_amdgcn_fence(__ATOMIC_RELEASE, "agent");
            asm volatile("s_waitcnt vmcnt(0)" ::: "memory");
            const unsigned og = xb_add(&bar[XB_TOP], 1u);
            const unsigned tg = og / nx;
            if (og + 1u == (tg + 1u) * nx) xb_add(&bar[XB_TOPGEN], 1u);
            else XB_SPIN(xb_ld(&bar[XB_TOPGEN]) == tg, bar);
            __builtin_amdgcn_fence(__ATOMIC_ACQUIRE, "agent");
            xb_add(&bar[XB_XGEN(b.x)], 1u);
            asm volatile("s_waitcnt vmcnt(0)" ::: "memory");
        } else {
            XB_SPIN(xb_ld(&bar[XB_XGEN(b.x)]) == gen, bar);
            __builtin_amdgcn_fence(__ATOMIC_ACQUIRE, "agent");
            asm volatile("s_waitcnt vmcnt(0)" ::: "memory");
        }
    }
    __syncthreads();
}

__device__ __forceinline__ void ph_prologue(KP p, int bid, int nb, float* sm) {
    const int tid = opaque_tid();
    if (bid == 0) {
        bf16_t* z = (bf16_t*)(p->ws + OFF_U) + (size_t)ZROW * DM;
        for (int i = tid; i < DM; i += 512) z[i] = 0;
    }
    if (bid == 1 % nb) {
        float* lb = (float*)(p->ws + OFF_LB);
        const float* hl = p->in[I_HLB];
        for (int j = tid; j < 512; j += 512) {
            const float a = hl[j], b = hl[512 + j], mx = fmaxf(a, b);
            const float ea = expf(a - mx), eb = expf(b - mx);
            lb[j] = 0.f; lb[512 + j] = eb / (ea + eb);
        }
    }
    if (bid == 2 % nb) {
        float2* rt = (float2*)(p->ws + OFF_ROPE);
        for (int i = tid; i < 64 * 32; i += 512) { const float ang = (float)(i >> 5) * powf(10000.f, -(float)(2 * (i & 31)) / 64.f); rt[i] = make_float2(cosf(ang), sinf(ang)); }
    }
    {
        float* act = sm;
        float* part = sm + 9 * 1024;
        bool filled = false;
        #pragma unroll 1
        for (int item = bid; item < 192; item += nb) {
            if (!filled) {
                for (int i = tid; i < 9 * 1024; i += 512) {
                    const int r = i >> 10, k = i & 1023;
                    const float v = r < 8 ? p->in[I_C][r * 1024 + k] : p->in[I_CCTX][k];
                    act[i] = siluf_(v);
                }
                filled = true;
            }
            __syncthreads();
            const int l = item / 48, jj = tid & 127, kq = tid >> 7, j = (item % 48) * 128 + jj;
            const float* w = p->in[I_ADAW] + (size_t)l * 1024 * 6144 + j;
            float acc[9];
#pragma unroll
            for (int r = 0; r < 9; ++r) acc[r] = 0.f;
#pragma unroll 8
            for (int k = kq * 256; k < kq * 256 + 256; ++k) {
                const float wv = w[(size_t)k * 6144];
#pragma unroll
                for (int r = 0; r < 9; ++r) acc[r] += act[r * 1024 + k] * wv;
            }
#pragma unroll
            for (int r = 0; r < 9; ++r) part[(kq * 9 + r) * 128 + jj] = acc[r];
            __syncthreads();
            float* mod = (float*)(p->ws + OFF_MOD);
            for (int i = tid; i < 9 * 128; i += 512) {
                const int r = i >> 7, c = i & 127;
                mod[((size_t)l * 9 + r) * 6144 + (item % 48) * 128 + c] = part[(0 * 9 + r) * 128 + c] + part[(1 * 9 + r) * 128 + c] + part[(2 * 9 + r) * 128 + c] + part[(3 * 9 + r) * 128 + c] + p->in[I_ADAB][l * 6144 + (item % 48) * 128 + c];
            }
        }
    }
}


struct CvtTile { const float* src; int srcld; bf16_t* dst; int dstld; int k0, n0; };
__device__ __forceinline__ CvtTile cvt_tile_of(KP p, int l, int t, int np4  ) {
    const bool even = (l & 1) == 0;
    const int NP = even ? EVEN_LD : ODD_LD;
    const int t_in = 16 * (NP / 128), t_out = 16 * 8, t_13 = 65 * 16 * 4;
    CvtTile c;
    if (t < t_in) {
        const int kt = t & 15, nt = t >> 4, n = nt * 128 + np4;
        const float* W = even ? p->in[I_EWIN] + (size_t)(l >> 1) * 1024 * EVEN_N : p->in[I_OWIN] + (size_t)(l >> 1) * 1024 * ODD_N;
        c.src = W + ((even && n >= 1536) ? n + 16 : n); c.srcld = even ? EVEN_N : ODD_N; c.dst = (bf16_t*)(p->ws + OFF_WIN); c.dstld = 1024; c.k0 = kt * 64; c.n0 = nt * 128;
    } else if (t < t_in + t_out) {
        const int u = t - t_in, kt = u & 15, nt = u >> 4;
        c.src = (even ? p->in[I_EWOUT] : p->in[I_OWOUT]) + (size_t)(l >> 1) * 1024 * 1024 + nt * 128 + np4; c.srcld = 1024; c.dst = (bf16_t*)(p->ws + OFF_WOUT); c.dstld = 1024; c.k0 = kt * 64; c.n0 = nt * 128;
    } else if (t < t_in + t_out + t_13) {
        const int u = t - t_in - t_out, e = u >> 6, kt = u & 15, nt = (u >> 4) & 3, n = nt * 128 + np4, g = n >> 5, w = n & 31;
        const float* w1 = e < 64 ? p->in[I_W1] + ((size_t)l * 64 + e) * 1024 * 256 : p->in[I_SW1] + (size_t)l * 1024 * 256;
        const float* w3 = e < 64 ? p->in[I_W3] + ((size_t)l * 64 + e) * 1024 * 256 : p->in[I_SW3] + (size_t)l * 1024 * 256;
        c.src = w < 16 ? w1 + 16 * g + w : w3 + 16 * g + w - 16; c.srcld = 256; c.dst = (bf16_t*)(p->ws + OFF_W13L(l)) + (size_t)e * 512 * 1024; c.dstld = 1024; c.k0 = kt * 64; c.n0 = nt * 128;
    } else {
        const int u = t - t_in - t_out - t_13, e = u >> 5, kt = u & 3, nt = (u >> 2) & 7;
        const float* w2 = e < 64 ? p->in[I_W2] + ((size_t)l * 64 + e) * 256 * 1024 : p->in[I_SW2] + (size_t)l * 256 * 1024;
        c.src = w2 + nt * 128 + np4; c.srcld = 1024; c.dst = (bf16_t*)(p->ws + OFF_W2) + (size_t)e * 1024 * 256; c.dstld = 256; c.k0 = kt * 64; c.n0 = nt * 128;
    }
    return c;
}
__device__ __forceinline__ void ph_convert(KP p, int l, int bid, int nb, float* sm, const int part = 0) {
    const int tid = opaque_tid();
    const int NP = ((l & 1) == 0) ? EVEN_LD : ODD_LD;
    const int t_io = 16 * (NP / 128) + 16 * 8, t_13_ = 65 * 16 * 4;
    const int total = (part == 1) ? t_13_ : (part == 2) ? t_io + 65 * 4 * 8 : t_io + t_13_ + 65 * 4 * 8;
    auto tmap = [&](int t) { return (part == 1) ? t + t_io : (part == 2 && t >= t_io) ? t + t_13_ : t; };
    const int kr = tid >> 5, np4 = (tid & 31) * 4;
    float4 v[4];
    int t = bid;
    CvtTile c = cvt_tile_of(p, l, tmap(t < total ? t : 0), np4);
    if (t < total) {
#pragma unroll
        for (int j = 0; j < 4; ++j) v[j] = *(const float4*)(c.src + (size_t)(c.k0 + kr + 16 * j) * c.srcld);
    }
#pragma unroll 1
    for (; t < total; t += nb) {
        __syncthreads();
#pragma unroll
        for (int j = 0; j < 4; ++j) { float* d = sm + (np4) * 65 + kr + 16 * j; d[0] = v[j].x; d[65] = v[j].y; d[130] = v[j].z; d[195] = v[j].w; }
        const CvtTile cur = c;
        const int tn = t + nb;
        if (tn < total) {
            c = cvt_tile_of(p, l, tmap(tn), np4);
#pragma unroll
            for (int j = 0; j < 4; ++j) v[j] = *(const float4*)(c.src + (size_t)(c.k0 + kr + 16 * j) * c.srcld);
        }
        __syncthreads();
        const int n = tid >> 2, kc = (tid & 3) * 16;
        unsigned w[8];
#pragma unroll
        for (int q = 0; q < 8; ++q) w[q] = cvt_pk_bf16(sm[n * 65 + kc + 2 * q], sm[n * 65 + kc + 2 * q + 1]);
        uint4* d4 = (uint4*)(cur.dst + (size_t)(cur.n0 + n) * cur.dstld + cur.k0 + kc);
        d4[0] = make_uint4(w[0], w[1], w[2], w[3]); d4[1] = make_uint4(w[4], w[5], w[6], w[7]);
    }
    __syncthreads();
    if (bid < 8 && part != 1) {
        const float* rw = p->in[I_RW] + (size_t)l * 1024 * 64;
        bf16_t* hi = (bf16_t*)(p->ws + OFF_RWH); bf16_t* lo = hi + 64 * 1024;
        const int e = tid & 63, kb = bid * 128 + (tid >> 6) * 16;
#pragma unroll
        for (int i = 0; i < 16; i += 2) {
            const float x0 = rw[(size_t)(kb + i) * 64 + e], x1 = rw[(size_t)(kb + i + 1) * 64 + e];
            const unsigned h = cvt_pk_bf16(x0, x1);
            const unsigned lw = cvt_pk_bf16(x0 - bflo(h), x1 - bfhi(h));
            *(unsigned*)(hi + (size_t)e * 1024 + kb + i) = h; *(unsigned*)(lo + (size_t)e * 1024 + kb + i) = lw;
        }
    }
}

namespace gp {
typedef short bf16x8 __attribute__((ext_vector_type(8)));
typedef float f32x4 __attribute__((ext_vector_type(4)));
typedef unsigned u32x4 __attribute__((ext_vector_type(4)));
typedef unsigned u32x2 __attribute__((ext_vector_type(2)));
constexpr int BM = 256, BK = 64, HALF = 128, HTB = HALF * BK * 2, STAGE_BYTES = 8 * HTB, NXCD = 8, WGM = 8;
__device__ __forceinline__ int lds_byte(int r, int c) { const int st = (r >> 4) * 2 + (c >> 5), rr = r & 15, cc = c & 31, ob = rr * 64 + cc * 2; return st * 1024 + (ob ^ (((ob >> 9) & 1) << 5)); }
__device__ __forceinline__ void stage_rc(int b, int& R, int& C) { const int st = b / 1024, sb = b % 1024, swz = sb ^ (((sb >> 9) & 1) << 5); R = (st >> 1) * 16 + swz / 64; C = (st & 1) * 32 + (swz % 64) / 2; }
__device__ __forceinline__ int perm32(int rho) { const int n = rho >> 4, i = rho & 15; return 8 * (i >> 2) + 4 * n + (i & 3); }

struct Unit { const char* A; const char* B; int r0, c0, aux; };

struct DenseSched {
    const char* A; const char* B; int nM, nN, nwg, G, c; size_t tstep;
    __device__ __forceinline__ void init(const void* A_, const void* B_, int M, int N, int K, int G_, int c_) { A = (const char*)A_; B = (const char*)B_; nM = M / BM; nN = N / BM; nwg = nM * nN; G = G_; c = c_; tstep = (size_t)BM * K * 2; }
    __device__ __forceinline__ bool next(int i, Unit& u) const {
        const long L = (long)i * G + c; if (L >= nwg) return false;
        int wgid = (int)L; { const int q = nwg / NXCD, r = nwg % NXCD, xcd = wgid % NXCD, off = wgid / NXCD; wgid = (xcd < r ? xcd * (q + 1) : r * (q + 1) + (xcd - r) * q) + off; }
        const int nig = WGM * nN, gid = wgid / nig, fm = gid * WGM, gsz = (nM - fm) < WGM ? (nM - fm) : WGM;
        const int pm = fm + ((wgid % nig) % gsz), pn = (wgid % nig) / gsz;
        u.A = A + (size_t)pm * tstep; u.B = B + (size_t)pn * tstep; u.r0 = pm * BM; u.c0 = pn * BM; u.aux = 0; return true;
    }
    __device__ __forceinline__ void lane_off(const Unit&, unsigned (&)[2][2]) const {}
};

template <bool GATHER, bool PERM, bool DEFER, class Sched, class Epi>
__device__ __forceinline__ void gemm_phase(LAS unsigned char* lds, const int K_, const Sched& S, const Epi& E) {
    int K = K_; asm volatile("" : "+s"(K));
    const int tid = opaque_tid(), wid = __builtin_amdgcn_readfirstlane(tid >> 6), lane = tid & 63, wr = wid >> 2, wc = wid & 3, fr = lane & 15, fq = lane >> 4;
    const int nt = K / BK;
    unsigned voffA[2], voffB[2];
#pragma unroll
    for (int i = 0; i < 2; ++i) { int R, C; stage_rc(tid * 16 + i * 8192, R, C); const int Rb = PERM ? ((R & ~31) + perm32(R & 31)) : R;
        voffA[i] = (unsigned)(R * K + C) * 2u; voffB[i] = (unsigned)(Rb * K + C) * 2u; }
    const size_t kstep = (size_t)(BK * 2);
    const size_t hstep = (size_t)HALF * K * 2;
    const unsigned ldsw = (unsigned)wid * 1024u;
    const int aoff = lds_byte(wr * 64 + fr, fq * 8), boff = lds_byte(wc * 32 + fr, fq * 8);
    unsigned cvo[2][2] = {{0u, 0u}, {0u, 0u}};
#define GP_SA(b, h) (((b) * 2 + (h)) * HTB)
#define GP_SB(b, h) ((4 + (b) * 2 + (h)) * HTB)
#define GP_GLDS(gp_, lp_) __builtin_amdgcn_global_load_lds((const unsigned*)(gp_), (LAS unsigned*)(lp_), 16, 0, 0)
#define GP_STAGE_B(bufoff, gbase, h) do { const char* _g = (gbase) + (size_t)(h) * hstep; \
        GP_GLDS(_g + voffB[0], lds + (bufoff) + ldsw); GP_GLDS(_g + voffB[1], lds + (bufoff) + ldsw + 8192); } while (0)
#define GP_STAGE_A(bufoff, gbase, h, usenext) do { \
        if (GATHER) { GP_GLDS((gbase) + cvo[h][0], lds + (bufoff) + ldsw); GP_GLDS((gbase) + cvo[h][1], lds + (bufoff) + ldsw + 8192); } \
        else { const char* _g = (gbase) + (size_t)(h) * hstep; GP_GLDS(_g + voffA[0], lds + (bufoff) + ldsw); GP_GLDS(_g + voffA[1], lds + (bufoff) + ldsw + 8192); } } while (0)
#define GP_LDA(dst, b, h) do { _Pragma("unroll") for (int m = 0; m < 4; ++m) _Pragma("unroll") for (int k = 0; k < 2; ++k) dst[m][k] = *(const LAS bf16x8*)(lds + GP_SA(b, h) + aoff + m * 2048 + k * 1024); } while (0)
#define GP_LDB(dst, b, h) do { _Pragma("unroll") for (int n = 0; n < 2; ++n) _Pragma("unroll") for (int k = 0; k < 2; ++k) dst[n][k] = *(const LAS bf16x8*)(lds + GP_SB(b, h) + boff + n * 2048 + k * 1024); } while (0)
#define GP_MMA(ai, bj, At, Bt) do { __builtin_amdgcn_s_setprio(1); _Pragma("unroll") for (int m = 0; m < 4; ++m) _Pragma("unroll") for (int n = 0; n < 2; ++n) _Pragma("unroll") for (int k = 0; k < 2; ++k) \
        acc[ai][bj][m][n] = __builtin_amdgcn_mfma_f32_16x16x32_bf16(Bt[n][k], At[m][k], acc[ai][bj][m][n], 0, 0, 0); __builtin_amdgcn_s_setprio(0); } while (0)
#define GP_WAIT_V(n) asm volatile("s_waitcnt vmcnt(" #n ")" ::: "memory")
#define GP_WAIT_L(n) asm volatile("s_waitcnt lgkmcnt(" #n ")" ::: "memory")
#define GP_BAR __builtin_amdgcn_s_barrier()
#define GP_SCHED __builtin_amdgcn_sched_barrier(0)
    Unit cur, nxt; int ui = 0;
    if (!S.next(0, cur)) return;
    f32x4 acc[2][2][4][2];
#pragma unroll
    for (int a = 0; a < 2; ++a)
#pragma unroll
        for (int b = 0; b < 2; ++b)
#pragma unroll
            for (int m = 0; m < 4; ++m)
#pragma unroll
                for (int n = 0; n < 2; ++n) acc[a][b][m][n] = (f32x4){0.f, 0.f, 0.f, 0.f};
    bf16x8 At[4][2], B0[2][2], B1[2][2];
    if (GATHER) S.lane_off(cur, cvo);
    const char* cA = cur.A; const char* cB = cur.B;
    GP_STAGE_B(GP_SB(0, 0), cB, 0); GP_STAGE_A(GP_SA(0, 0), cA, 0, false); GP_STAGE_B(GP_SB(0, 1), cB, 1); GP_STAGE_A(GP_SA(0, 1), cA, 1, false);
    if (wr == 1) GP_BAR;
    GP_WAIT_V(4); GP_BAR;
    GP_STAGE_B(GP_SB(1, 0), cB + kstep, 0); GP_STAGE_A(GP_SA(1, 0), cA + kstep, 0, false); GP_STAGE_B(GP_SB(1, 1), cB + kstep, 1);
    GP_WAIT_V(6); GP_BAR;
    bool pend = false; Unit pu = cur; unsigned keep[4][2] = {{0u, 0u}, {0u, 0u}, {0u, 0u}, {0u, 0u}};
#define GP_ZQ(ai, bj) do { _Pragma("unroll") for (int m = 0; m < 4; ++m) _Pragma("unroll") for (int n = 0; n < 2; ++n) acc[ai][bj][m][n] = (f32x4){0.f, 0.f, 0.f, 0.f}; } while (0)
#define GP_EQ(ai, bj) do { if (pe) { const int l_ = olane(); E.quad(acc, pu, ai, bj, wr, wc, l_ & 15, l_ >> 4, keep); GP_ZQ(ai, bj); } } while (0)
    for (;;) {
        const bool has_next = S.next(ui + 1, nxt);
        const char* nA = has_next ? nxt.A : cA; const char* nB = has_next ? nxt.B : cB;
        for (int t = 0; t < nt; t += 2) {
            const bool last = (t == nt - 2);
            const bool un = last && has_next;
            const char* a1 = cA + (size_t)(t + 1) * kstep;
            const char* a2 = last ? nA : cA + (size_t)(t + 2) * kstep; const char* b2 = last ? nB : cB + (size_t)(t + 2) * kstep;
            const char* a3 = a2 + kstep; const char* b3 = b2 + kstep;
            const bool pe = DEFER && pend && (t == 0);
            GP_LDB(B0, 0, 0); GP_SCHED; GP_LDA(At, 0, 0); GP_STAGE_A(GP_SA(1, 1), a1, 1, false);
            GP_EQ(0, 0);
            GP_WAIT_L(8); GP_BAR; GP_WAIT_L(0); GP_MMA(0, 0, At, B0); GP_BAR; GP_SCHED;
            GP_LDB(B1, 0, 1); GP_STAGE_B(GP_SB(0, 0), b2, 0);
            if (GATHER && un) S.lane_off(nxt, cvo);
            GP_EQ(0, 1);
            GP_BAR; GP_WAIT_L(0); GP_MMA(0, 1, At, B1); GP_BAR;
            GP_LDA(At, 0, 1); GP_STAGE_A(GP_SA(0, 0), a2, 0, un);
            GP_EQ(1, 0);
            GP_BAR; GP_WAIT_L(0); GP_MMA(1, 0, At, B0); GP_BAR; GP_SCHED;
            GP_EQ(1, 1);
            GP_STAGE_B(GP_SB(0, 1), b2, 1);
            if (pe) { if (Epi::NSTQ == 12) GP_WAIT_V(18); else GP_WAIT_V(14); } else GP_WAIT_V(6);
            GP_BAR; GP_MMA(1, 1, At, B1); GP_BAR;
            GP_LDB(B0, 1, 0); GP_SCHED; GP_LDA(At, 1, 0); GP_STAGE_A(GP_SA(0, 1), a2, 1, un);
            GP_WAIT_L(8); GP_BAR; GP_WAIT_L(0); GP_MMA(0, 0, At, B0); GP_BAR; GP_SCHED;
            GP_LDB(B1, 1, 1); GP_STAGE_B(GP_SB(1, 0), b3, 0);
            GP_BAR; GP_WAIT_L(0); GP_MMA(0, 1, At, B1); GP_BAR;
            GP_LDA(At, 1, 1); GP_STAGE_A(GP_SA(1, 0), a3, 0, un);
            GP_BAR; GP_WAIT_L(0); GP_MMA(1, 0, At, B0); GP_BAR; GP_SCHED;
            GP_STAGE_B(GP_SB(1, 1), b3, 1);
            GP_WAIT_V(6); GP_BAR; GP_MMA(1, 1, At, B1); GP_BAR;
        }
        if (!has_next) { E(acc, cur, wr, wc, fr, fq); break; }
        if (DEFER) { pend = true; pu = cur; }
        else { E(acc, cur, wr, wc, fr, fq); GP_ZQ(0, 0); GP_ZQ(0, 1); GP_ZQ(1, 0); GP_ZQ(1, 1); }
        cur = nxt; cA = nA; cB = nB; ++ui;
    }
    GP_WAIT_V(0);
    if (wr == 0) GP_BAR;
    GP_BAR;
#undef GP_ZQ
#undef GP_EQ
#undef GP_SA
#undef GP_SB
#undef GP_GLDS
#undef GP_STAGE_A
#undef GP_STAGE_B
#undef GP_LDA
#undef GP_LDB
#undef GP_MMA
#undef GP_WAIT_V
#undef GP_WAIT_L
#undef GP_BAR
#undef GP_SCHED
}

struct EpiF32 {
    float* C; int ldc;
    static constexpr int NSTQ = 12;
    __device__ __forceinline__ void quad(const f32x4 (&)[2][2][4][2], const Unit&, int, int, int, int, int, int, unsigned (&)[4][2]) const {}
    __device__ __forceinline__ void operator()(const f32x4 (&acc)[2][2][4][2], const Unit& u, int wr, int wc, int fr, int fq) const {
        const int row0 = u.r0 + wr * 64 + fr, col0 = u.c0 + wc * 32 + 4 * fq;
#pragma unroll
        for (int ai = 0; ai < 2; ++ai)
#pragma unroll
            for (int m = 0; m < 4; ++m) { float* rowp = C + (size_t)(row0 + ai * HALF + m * 16) * ldc + col0;
#pragma unroll
                for (int bj = 0; bj < 2; ++bj)
#pragma unroll
                    for (int n = 0; n < 2; ++n) *(f32x4*)(rowp + bj * HALF + n * 16) = acc[ai][bj][m][n];
                __builtin_amdgcn_sched_barrier(0); }
    }
};
struct EpiBf16 {
    bf16_t* O; int ldc;
    static constexpr int NSTQ = 12;
    __device__ __forceinline__ void quad(const f32x4 (&acc)[2][2][4][2], const Unit& u, int ai, int bj, int wr, int wc, int fr, int fq, unsigned (&)[4][2]) const {
        const int row0 = u.r0 + wr * 64 + fr + ai * HALF, col0 = u.c0 + wc * 32 + 8 * fq + bj * HALF;
#pragma unroll
        for (int m = 0; m < 4; ++m) { const f32x4 v0 = acc[ai][bj][m][0], v1 = acc[ai][bj][m][1];
            u32x4 w; w.x = cvt_pk_bf16(v0[0], v0[1]); w.y = cvt_pk_bf16(v0[2], v0[3]); w.z = cvt_pk_bf16(v1[0], v1[1]); w.w = cvt_pk_bf16(v1[2], v1[3]);
            *(u32x4*)(O + (size_t)(row0 + m * 16) * ldc + col0) = w; }
    }
    __device__ __forceinline__ void operator()(const f32x4 (&acc)[2][2][4][2], const Unit& u, int wr, int wc, int fr, int fq) const {
        const int row0 = u.r0 + wr * 64 + fr, col0 = u.c0 + wc * 32 + 8 * fq;
#pragma unroll
        for (int ai = 0; ai < 2; ++ai)
#pragma unroll
            for (int m = 0; m < 4; ++m) { bf16_t* rowp = O + (size_t)(row0 + ai * HALF + m * 16) * ldc + col0;
#pragma unroll
                for (int bj = 0; bj < 2; ++bj) { const f32x4 v0 = acc[ai][bj][m][0], v1 = acc[ai][bj][m][1];
                    u32x4 w; w.x = cvt_pk_bf16(v0[0], v0[1]); w.y = cvt_pk_bf16(v0[2], v0[3]); w.z = cvt_pk_bf16(v1[0], v1[1]); w.w = cvt_pk_bf16(v1[2], v1[3]);
                    *(u32x4*)(rowp + bj * HALF) = w; }
                __builtin_amdgcn_sched_barrier(0); }
    }
};
}


typedef float f32x4_l __attribute__((ext_vector_type(4)));
__device__ __forceinline__ void stage_gate_w(KP p, int e, LAS float* wl) {
    const int tid = opaque_tid();
    const float* wg = p->in[I_EWIN] + (size_t)e * 1024 * EVEN_N + 1536;
#pragma unroll
    for (int i = 0; i < 8; ++i) { const int idx = tid + 512 * i, d = idx >> 2, j4 = idx & 3; const float4 w = *(const float4*)(wg + (size_t)d * EVEN_N + j4 * 4); *(LAS f32x4_l*)(wl + d * 16 + j4 * 4) = (f32x4_l){w.x, w.y, w.z, w.w}; }
    __syncthreads();
}
template <bool FIRST>
__device__ __forceinline__ void ph_modin(KP p, int l, int bid, int nb) {
    const int tid = opaque_tid(), lane = tid & 63, wv = tid >> 6;
    const bool even = (l & 1) == 0;
    bf16_t* U = (bf16_t*)(p->ws + OFF_U);
    float* G = (float*)(p->ws + OFF_G);
    LAS float* wl = (LAS float*)smraw_base();
    if (even) stage_gate_w(p, l >> 1, wl);
    #pragma unroll 1
    for (int tok = bid * 8 + wv; tok < NT; tok += nb * 8) {
        bf16_t* hw = hrow(p, tok);
        const float* h = (tok < NL ? p->in[I_X] + (size_t)tok * DM : p->in[I_CTX] + (size_t)(tok - NL) * DM);
        static_assert(FIRST, "ph_modin is layer 0's only");
        const float* m = modrow(p, l, tok);
        float ga[16];
#pragma unroll
        for (int j = 0; j < 16; ++j) ga[j] = 0.f;
#pragma unroll
        for (int c = 0; c < 4; ++c) {
            const int d = 4 * (lane + 64 * c);
            const float4 hv = *(const float4*)(h + d), sh = *(const float4*)(m + d), sc = *(const float4*)(m + 1024 + d);
            *(uint2*)(hw + d) = make_uint2(cvt_pk_bf16(hv.x, hv.y), cvt_pk_bf16(hv.z, hv.w));
            const float u0 = hv.x * (1.f + sc.x) + sh.x, u1 = hv.y * (1.f + sc.y) + sh.y, u2 = hv.z * (1.f + sc.z) + sh.z, u3 = hv.w * (1.f + sc.w) + sh.w;
            *(uint2*)(U + (size_t)tok * DM + d) = make_uint2(cvt_pk_bf16(u0, u1), cvt_pk_bf16(u2, u3));
            if (even) {
                const float uu[4] = {u0, u1, u2, u3};
#pragma unroll
                for (int q = 0; q < 4; ++q) {
#pragma unroll
                    for (int j4 = 0; j4 < 4; ++j4) { const f32x4_l w = *(const LAS f32x4_l*)(wl + (d + q) * 16 + j4 * 4); ga[4 * j4] += uu[q] * w[0]; ga[4 * j4 + 1] += uu[q] * w[1]; ga[4 * j4 + 2] += uu[q] * w[2]; ga[4 * j4 + 3] += uu[q] * w[3]; }
                }
                __builtin_amdgcn_sched_barrier(0);
            }
        }
        if (even) {
            float mine = 0.f;
#pragma unroll
            for (int j = 0; j < 16; ++j) { const float s = wave_sum(ga[j]); if (lane == j) mine = s; }
            if (lane < 16) G[(size_t)tok * 16 + lane] = mine;
        }
    }
}

__device__ __forceinline__ void ph_gemm_in(KP p, int l, int bid, int nb, LAS unsigned char* lds) {
    const int N = ((l & 1) == 0) ? EVEN_LD : ODD_LD;
    gp::DenseSched S; S.init(p->ws + OFF_U, p->ws + OFF_WIN, NT, N, 1024, nb, bid);
    gp::EpiBf16 E{(bf16_t*)(p->ws + OFF_BIG), N};
    gp::gemm_phase<false, true, true>(lds, 1024, S, E);
}
__device__ __forceinline__ void ph_gemm_out(KP p, int l, int bid, int nb, LAS unsigned char* lds) {
    gp::DenseSched S; S.init(p->ws + OFF_U, p->ws + OFF_WOUT, (l == 3) ? NL : NT, 1024, 1024, nb, bid);
    gp::EpiBf16 E{(bf16_t*)(p->ws + OFF_BIG), 1024};
    gp::gemm_phase<false, true, true>(lds, 1024, S, E);
}


namespace sc {
typedef short bf16x8 __attribute__((ext_vector_type(8)));
typedef short bf16x4 __attribute__((ext_vector_type(4)));
typedef float f32x4 __attribute__((ext_vector_type(4)));
#define SC_MFMA(a, b, c) __builtin_amdgcn_mfma_f32_16x16x32_bf16(a, b, c, 0, 0, 0)
__device__ __forceinline__ bf16x8 rd_row(unsigned img, int row, int stride, int k0) { return *(const LAS bf16x8*)(size_t)(img + (unsigned)(row * stride + k0 * 2)); }
__device__ __forceinline__ bf16x8 rd_tr(unsigned img, int k0, int n0, int stride, int lane) {
    const int g = lane >> 4, i = lane & 15;
    const unsigned a0 = img + (unsigned)((k0 + 8 * g + (i >> 2)) * stride + (n0 + 4 * (i & 3)) * 2), a1 = a0 + 4u * (unsigned)stride;
    bf16x4 lo, hi;
    asm volatile("ds_read_b64_tr_b16 %0, %2\n\tds_read_b64_tr_b16 %1, %3\n\ts_waitcnt lgkmcnt(0)" : "=&v"(lo), "=&v"(hi) : "v"(a0), "v"(a1) : "memory");
    return (bf16x8){lo[0], lo[1], lo[2], lo[3], hi[0], hi[1], hi[2], hi[3]};
}
typedef unsigned u32x2_ __attribute__((ext_vector_type(2)));
typedef unsigned u32x4_ __attribute__((ext_vector_type(4)));
__device__ __forceinline__ unsigned tr_addr(unsigned img, int k0, int n0, int stride, int lane) { const int g = lane >> 4, i = lane & 15; return img + (unsigned)((k0 + 8 * g + (i >> 2)) * stride + (n0 + 4 * (i & 3)) * 2); }
__device__ __forceinline__ void rd_tr5(const unsigned (&a0)[5], const unsigned (&s4)[5], bf16x8 (&o)[5]) {
    bf16x4 l0, h0, l1, h1, l2, h2, l3, h3, l4, h4;
    asm volatile("ds_read_b64_tr_b16 %0, %10\n\tds_read_b64_tr_b16 %1, %11\n\tds_read_b64_tr_b16 %2, %12\n\tds_read_b64_tr_b16 %3, %13\n\tds_read_b64_tr_b16 %4, %14\n\t"
                 "ds_read_b64_tr_b16 %5, %15\n\tds_read_b64_tr_b16 %6, %16\n\tds_read_b64_tr_b16 %7, %17\n\tds_read_b64_tr_b16 %8, %18\n\tds_read_b64_tr_b16 %9, %19\n\ts_waitcnt lgkmcnt(0)"
                 : "=&v"(l0), "=&v"(h0), "=&v"(l1), "=&v"(h1), "=&v"(l2), "=&v"(h2), "=&v"(l3), "=&v"(h3), "=&v"(l4), "=&v"(h4)
                 : "v"(a0[0]), "v"(a0[0] + s4[0]), "v"(a0[1]), "v"(a0[1] + s4[1]), "v"(a0[2]), "v"(a0[2] + s4[2]), "v"(a0[3]), "v"(a0[3] + s4[3]), "v"(a0[4]), "v"(a0[4] + s4[4]) : "memory");
    o[0] = (bf16x8){l0[0], l0[1], l0[2], l0[3], h0[0], h0[1], h0[2], h0[3]}; o[1] = (bf16x8){l1[0], l1[1], l1[2], l1[3], h1[0], h1[1], h1[2], h1[3]};
    o[2] = (bf16x8){l2[0], l2[1], l2[2], l2[3], h2[0], h2[1], h2[2], h2[3]}; o[3] = (bf16x8){l3[0], l3[1], l3[2], l3[3], h3[0], h3[1], h3[2], h3[3]};
    o[4] = (bf16x8){l4[0], l4[1], l4[2], l4[3], h4[0], h4[1], h4[2], h4[3]};
}
__device__ __forceinline__ void st8(unsigned addr, uint2 v) { *(LAS u32x2_*)(size_t)addr = (u32x2_){v.x, v.y}; }
__device__ __forceinline__ void st16(unsigned addr, uint4 v) { *(LAS u32x4_*)(size_t)addr = (u32x4_){v.x, v.y, v.z, v.w}; }
#define SC_DPP(v, ident, ctrl, rmask) __builtin_bit_cast(float, __builtin_amdgcn_update_dpp(__builtin_bit_cast(int, (float)(ident)), __builtin_bit_cast(int, v), ctrl, rmask, 0xf, false))
__device__ __forceinline__ float scan_add64(float v, int) {
    v += SC_DPP(v, 0.f, 0x111, 0xf); v += SC_DPP(v, 0.f, 0x112, 0xf); v += SC_DPP(v, 0.f, 0x114, 0xf); v += SC_DPP(v, 0.f, 0x118, 0xf);
    v += SC_DPP(v, 0.f, 0x142, 0xa); v += SC_DPP(v, 0.f, 0x143, 0xc);
    return v;
}
__device__ __forceinline__ float scan_max64(float v, int) {
    const float ni = -__builtin_inff();
    v = fmaxf(v, SC_DPP(v, ni, 0x111, 0xf)); v = fmaxf(v, SC_DPP(v, ni, 0x112, 0xf)); v = fmaxf(v, SC_DPP(v, ni, 0x114, 0xf)); v = fmaxf(v, SC_DPP(v, ni, 0x118, 0xf));
    v = fmaxf(v, SC_DPP(v, ni, 0x142, 0xa)); v = fmaxf(v, SC_DPP(v, ni, 0x143, 0xc));
    return v;
}

template <int MODE>
__device__ __forceinline__ void scan_item(KP p, int l, int b, int h, int dir, int vs) {
    constexpr int CS = (MODE == 1) ? 32 : 64, DK = (MODE == 0) ? 64 : 128, EXT = (MODE == 0) ? 1 : 0;
    constexpr int QS = (DK + 8) * 2, VS = (64 + 16 * EXT + 8) * 2, SS = (CS + 8) * 2, NVR = 64 + 16 * EXT;
    constexpr int NCH = (CTXL + SEQ) / CS;
    constexpr int LD = (MODE == 2) ? ODD_LD : EVEN_LD;
    constexpr unsigned O_QA = 0, O_KA = O_QA + CS * QS, O_QB = O_KA + CS * QS, O_KW = O_QB + (MODE == 1 ? CS * QS : 0), O_V = O_KW + CS * QS,
                       O_SSC = O_V + CS * VS, O_ST = O_SSC + CS * SS, O_DKV = O_ST + 2 * NVR * QS, O_END = O_DKV + 512;
    static_assert(O_END <= 131072, "scan LDS");
    const int tid = opaque_tid(), lane = tid & 63, wv = __builtin_amdgcn_readfirstlane(tid >> 6), r16 = lane & 15, q4 = lane >> 4;
    const unsigned L0 = (unsigned)(size_t)smraw_base();
    const bf16_t* P = (const bf16_t*)(p->ws + OFF_BIG);
    bf16_t* HXo = (bf16_t*)(p->ws + OFF_AUX) + (size_t)dir * NT * 1024;
    const int e2 = l >> 1;
    const int cQ = (MODE == 0) ? E_MQ + h * 64 : (MODE == 1) ? E_HQ + h * 128 : 1536 + h * 128;
    const int cK = (MODE == 0) ? E_MK + h * 64 : (MODE == 1) ? (dir ? E_HFB : E_HFF) + h * 128 : 2048 + h * 128;
    const int cV = (MODE == 0) ? E_MV + h * 128 + vs * 64 : (MODE == 1) ? E_HI + h * 128 + vs * 64 : 2560 + h * 128 + vs * 64;
    const int cO = (MODE == 0) ? h * 128 + vs * 64 : 512 + h * 128 + vs * 64;
    const int lt = (MODE == 1) ? (tid & 31) : (tid >> 3);
    const int lj = (MODE == 0) ? (tid & 7) : (MODE == 1) ? (tid >> 5) : ((tid >> 2) & 1) * 8 + (tid & 3);
    const int vt_ = tid >> 3, vj = tid & 7;
    float lbv[8]; float gbi = 0.f, gbf = 0.f, lg = 0.f;
    if (MODE == 1) {
        const float* lbp = (const float*)(p->ws + OFF_LB) + e2 * 512 + h * 128 + lj * 8;
#pragma unroll
        for (int i = 0; i < 8; ++i) lbv[i] = lbp[i];
    } else {
#pragma unroll
        for (int i = 0; i < 8; ++i) lbv[i] = 0.f;
    }
    if (MODE == 0) { const float* gb = p->in[I_MGB] + e2 * 16; gbi = gb[(dir ? 2 : 0) * 4 + h]; gbf = gb[(dir ? 3 : 1) * 4 + h]; }
    if (MODE == 2) lg = p->in[I_RLD][e2 * 8 + dir * 4 + h];
    const float* G = (const float*)(p->ws + OFF_G);
    const float* ropet = (const float*)(p->ws + OFF_ROPE);
    unsigned oz = 0u; asm volatile("" : "+v"(oz));
    for (unsigned o = tid * 16; o < 2u * NVR * QS; o += 512 * 16) st16(L0 + O_ST + o, make_uint4(oz, oz, oz, oz));
    if (EXT) { if (tid < CS) { st16(L0 + O_V + tid * VS + 128, make_uint4(0x3f80u | oz, oz, oz, oz)); st16(L0 + O_V + tid * VS + 144, make_uint4(oz, oz, oz, oz)); } }
    f32x4 sacc[4];
#pragma unroll
    for (int i = 0; i < 4; ++i) sacc[i] = (f32x4){0.f, 0.f, 0.f, 0.f};
    float m_in = -1e30f;
    struct Raw { uint4 rq0, rq1, rk0, rk1, rv; float rg0, rg1; };
    Raw RA, RB;
    RA.rq1 = make_uint4(0u, 0u, 0u, 0u); RA.rk1 = RA.rq1; RA.rv = RA.rq1; RA.rg0 = 0.f; RA.rg1 = 0.f; RB = RA;
    auto load_chunk = [&](Raw& R, int c) {
        const int i0 = c * CS;
        const int tq = scan_tok(b, i0 + lt, dir);
        const bf16_t* pr = P + (size_t)tq * LD;
        R.rq0 = *(const uint4*)(pr + cQ + lj * 8); R.rk0 = *(const uint4*)(pr + cK + lj * 8);
        if (MODE == 2) { R.rq1 = *(const uint4*)(pr + cQ + lj * 8 + 32); R.rk1 = *(const uint4*)(pr + cK + lj * 8 + 32); }
        if (MODE != 1 || tid < 256) { const int tv = scan_tok(b, i0 + vt_, dir); R.rv = *(const uint4*)(P + (size_t)tv * LD + cV + vj * 8); }
        if (MODE == 0) { const int tg = scan_tok(b, i0 + lane, dir); R.rg0 = G[(size_t)tg * 16 + (dir ? 8 : 0) + h]; R.rg1 = G[(size_t)tg * 16 + (dir ? 12 : 4) + h]; }
    };
    constexpr int PD = (MODE == 2) ? 1 : 2;
    load_chunk(RA, 0); if (PD == 2) load_chunk(RB, 1);
    auto chunk = [&](const int c, Raw& R) {
        const uint4 rq0 = R.rq0, rq1 = R.rq1, rk0 = R.rk0, rk1 = R.rk1, rv = R.rv; const float rg0 = R.rg0, rg1 = R.rg1;
        const unsigned ST_R = L0 + O_ST + (unsigned)(c & 1) * NVR * QS, ST_W = L0 + O_ST + (unsigned)((c + 1) & 1) * NVR * QS;
        float sp = 1.f;
        float v_u = 0.f, v_M = 0.f, v_e = 1.f, v_low = 0.f, v_w = 1.f;
        if (MODE == 0) {
            const float ig = rg0 + gbi, fg = rg1 + gbf;
            const float lf = fminf(fg, 0.f) - flog(1.f + fexp(-fabsf(fg)));
            const float bb = scan_add64(lf, lane);
            const float g = SHI(bb, 63);
            v_u = ig - bb;
            const float cu = scan_max64(v_u, lane);
            v_M = fmaxf(m_in, cu);
            const float m_new = fmaxf(g + m_in, g + SHI(cu, 63));
            sp = fexp(g + m_in - m_new);
            v_w = fexp(g + v_u - m_new);
            v_e = fexp(m_in - v_M);
            v_low = fexp(-(bb + v_M));
            m_in = m_new;
            st16(L0 + O_QA + lt * QS + lj * 16, rq0);
            st16(L0 + O_KA + lt * QS + lj * 16, rk0);
            const float wr = SHI(v_w, lt);
            uint4 kw; kw.x = cvt_pk_bf16(bflo(rk0.x) * wr, bfhi(rk0.x) * wr); kw.y = cvt_pk_bf16(bflo(rk0.y) * wr, bfhi(rk0.y) * wr);
            kw.z = cvt_pk_bf16(bflo(rk0.z) * wr, bfhi(rk0.z) * wr); kw.w = cvt_pk_bf16(bflo(rk0.w) * wr, bfhi(rk0.w) * wr);
            st16(L0 + O_KW + lt * QS + lj * 16, kw);
            st16(L0 + O_V + vt_ * VS + vj * 16, rv);
        } else if (MODE == 2) {
            sp = fexp(64.f * lg);
            const bool lat = c >= CTXL / CS;
            float q[16], k[16];
            const unsigned qa[8] = {rq0.x, rq0.y, rq0.z, rq0.w, rq1.x, rq1.y, rq1.z, rq1.w}, ka[8] = {rk0.x, rk0.y, rk0.z, rk0.w, rk1.x, rk1.y, rk1.z, rk1.w};
#pragma unroll
            for (int i = 0; i < 8; ++i) { q[2 * i] = bflo(qa[i]); q[2 * i + 1] = bfhi(qa[i]); k[2 * i] = bflo(ka[i]); k[2 * i + 1] = bfhi(ka[i]); }
            if (lat) {
                const int tq = scan_tok(b, c * CS + lt, dir), tt = tq & (SEQ - 1);
                const int pos = ((tid >> 2) & 1) ? (tt & 63) : (tt >> 6);
                const float2* rt = (const float2*)ropet + pos * 32 + (tid & 3) * 8;
#pragma unroll
                for (int i = 0; i < 8; ++i) {
                    const float2 cs2 = rt[i];
                    const float q1 = q[i], q2 = q[8 + i], k1 = k[i], k2 = k[8 + i];
                    q[i] = q1 * cs2.x - q2 * cs2.y; q[8 + i] = q1 * cs2.y + q2 * cs2.x;
                    k[i] = k1 * cs2.x - k2 * cs2.y; k[8 + i] = k1 * cs2.y + k2 * cs2.x;
                }
            }
            const float wr = 0.08838834764831845f * fexp((float)(63 - lt) * lg);
            uint4 o0, o1, w0, w1, x0, x1;
            o0.x = cvt_pk_bf16(q[0], q[1]); o0.y = cvt_pk_bf16(q[2], q[3]); o0.z = cvt_pk_bf16(q[4], q[5]); o0.w = cvt_pk_bf16(q[6], q[7]);
            o1.x = cvt_pk_bf16(q[8], q[9]); o1.y = cvt_pk_bf16(q[10], q[11]); o1.z = cvt_pk_bf16(q[12], q[13]); o1.w = cvt_pk_bf16(q[14], q[15]);
            w0.x = cvt_pk_bf16(k[0], k[1]); w0.y = cvt_pk_bf16(k[2], k[3]); w0.z = cvt_pk_bf16(k[4], k[5]); w0.w = cvt_pk_bf16(k[6], k[7]);
            w1.x = cvt_pk_bf16(k[8], k[9]); w1.y = cvt_pk_bf16(k[10], k[11]); w1.z = cvt_pk_bf16(k[12], k[13]); w1.w = cvt_pk_bf16(k[14], k[15]);
            x0.x = cvt_pk_bf16(k[0] * wr, k[1] * wr); x0.y = cvt_pk_bf16(k[2] * wr, k[3] * wr); x0.z = cvt_pk_bf16(k[4] * wr, k[5] * wr); x0.w = cvt_pk_bf16(k[6] * wr, k[7] * wr);
            x1.x = cvt_pk_bf16(k[8] * wr, k[9] * wr); x1.y = cvt_pk_bf16(k[10] * wr, k[11] * wr); x1.z = cvt_pk_bf16(k[12] * wr, k[13] * wr); x1.w = cvt_pk_bf16(k[14] * wr, k[15] * wr);
            st16(L0 + O_QA + lt * QS + lj * 16, o0); st16(L0 + O_QA + lt * QS + lj * 16 + 64, o1);
            st16(L0 + O_KA + lt * QS + lj * 16, w0); st16(L0 + O_KA + lt * QS + lj * 16 + 64, w1);
            st16(L0 + O_KW + lt * QS + lj * 16, x0); st16(L0 + O_KW + lt * QS + lj * 16 + 64, x1);
            st16(L0 + O_V + vt_ * VS + vj * 16, rv);
        } else {
            const unsigned qa[4] = {rq0.x, rq0.y, rq0.z, rq0.w}, fa[4] = {rk0.x, rk0.y, rk0.z, rk0.w};
            float qv[8], kk[8], A[8];
#pragma unroll
            for (int i = 0; i < 8; ++i) {
                const float qr = (i & 1) ? bfhi(qa[i >> 1]) : bflo(qa[i >> 1]), fr = (i & 1) ? bfhi(fa[i >> 1]) : bflo(fa[i >> 1]);
                const float f = lbv[i] + (1.f - lbv[i]) * fsigmoid(fr);
                qv[i] = fsilu(qr); kk[i] = 1.f - f; A[i] = flog(f);
            }
#pragma unroll
            for (int i = 0; i < 8; ++i) {
                int v = __builtin_bit_cast(int, A[i]);
                v = __builtin_bit_cast(int, __builtin_bit_cast(float, v) + __builtin_bit_cast(float, __builtin_amdgcn_update_dpp(0, v, 0x111, 0xf, 0xf, false)));
                v = __builtin_bit_cast(int, __builtin_bit_cast(float, v) + __builtin_bit_cast(float, __builtin_amdgcn_update_dpp(0, v, 0x112, 0xf, 0xf, false)));
                v = __builtin_bit_cast(int, __builtin_bit_cast(float, v) + __builtin_bit_cast(float, __builtin_amdgcn_update_dpp(0, v, 0x114, 0xf, 0xf, false)));
                v = __builtin_bit_cast(int, __builtin_bit_cast(float, v) + __builtin_bit_cast(float, __builtin_amdgcn_update_dpp(0, v, 0x118, 0xf, 0xf, false)));
                v = __builtin_bit_cast(int, __builtin_bit_cast(float, v) + __builtin_bit_cast(float, __builtin_amdgcn_update_dpp(0, v, 0x142, 0xa, 0xf, false)));
                A[i] = __builtin_bit_cast(float, v);
            }
            float qa_[8], qb_[8], ka_[8], kw_[8];
#pragma unroll
            for (int i = 0; i < 8; ++i) {
                const float am = SHI32(A[i], 15), ae = SHI32(A[i], 31);
                qa_[i] = qv[i] * fexp(A[i] - am); qb_[i] = qv[i] * fexp(A[i]); ka_[i] = kk[i] * fexp(am - A[i]); kw_[i] = kk[i] * fexp(ae - A[i]);
                if (lt == 31) *(LAS float*)(size_t)(L0 + O_DKV + (lj * 8 + i) * 4) = fexp(ae);
            }
            uint4 w;
            w.x = cvt_pk_bf16(qa_[0], qa_[1]); w.y = cvt_pk_bf16(qa_[2], qa_[3]); w.z = cvt_pk_bf16(qa_[4], qa_[5]); w.w = cvt_pk_bf16(qa_[6], qa_[7]); st16(L0 + O_QA + lt * QS + lj * 16, w);
            w.x = cvt_pk_bf16(qb_[0], qb_[1]); w.y = cvt_pk_bf16(qb_[2], qb_[3]); w.z = cvt_pk_bf16(qb_[4], qb_[5]); w.w = cvt_pk_bf16(qb_[6], qb_[7]); st16(L0 + O_QB + lt * QS + lj * 16, w);
            w.x = cvt_pk_bf16(ka_[0], ka_[1]); w.y = cvt_pk_bf16(ka_[2], ka_[3]); w.z = cvt_pk_bf16(ka_[4], ka_[5]); w.w = cvt_pk_bf16(ka_[6], ka_[7]); st16(L0 + O_KA + lt * QS + lj * 16, w);
            w.x = cvt_pk_bf16(kw_[0], kw_[1]); w.y = cvt_pk_bf16(kw_[2], kw_[3]); w.z = cvt_pk_bf16(kw_[4], kw_[5]); w.w = cvt_pk_bf16(kw_[6], kw_[7]); st16(L0 + O_KW + lt * QS + lj * 16, w);
            if (tid < 256) st16(L0 + O_V + vt_ * VS + vj * 16, rv);
        }
        __syncthreads();
        if (c + PD < NCH) load_chunk(R, c + PD);
        {
            constexpr int NT1 = CS / 16;
            const bool act = (MODE == 1) ? (wv < 4) : true;
            const int tb = (MODE == 1) ? (wv & 1) : (wv & 3);
#pragma unroll
            for (int u2 = 0; u2 < ((MODE == 1) ? 1 : 2); ++u2) {
                const int sb = (MODE == 1) ? (wv >> 1) : 2 * (wv >> 2) + u2;
                if (act) {
                    f32x4 d = (f32x4){0.f, 0.f, 0.f, 0.f};
                    if (sb <= tb) {
#pragma unroll
                        for (int kk2 = 0; kk2 < DK / 32; ++kk2)
                            d = SC_MFMA(rd_row(L0 + O_KA, sb * 16 + r16, QS, kk2 * 32 + q4 * 8), rd_row(L0 + O_QA, tb * 16 + r16, QS, kk2 * 32 + q4 * 8), d);
                        const int t = tb * 16 + r16, s0 = sb * 16 + q4 * 4;
                        if (MODE == 0) {
                            const float Mt = SHI(v_M, t);
#pragma unroll
                            for (int jj = 0; jj < 4; ++jj) { const float us = SHI(v_u, s0 + jj); d[jj] = (s0 + jj <= t) ? d[jj] * 0.125f * fexp(us - Mt) : 0.f; }
                        } else if (MODE == 2) {
#pragma unroll
                            for (int jj = 0; jj < 4; ++jj) d[jj] = (s0 + jj <= t) ? d[jj] * 0.08838834764831845f * fexp((float)(t - s0 - jj) * lg) : 0.f;
                        } else {
#pragma unroll
                            for (int jj = 0; jj < 4; ++jj) d[jj] = (s0 + jj <= t) ? d[jj] : 0.f;
                        }
                    }
                    st8(L0 + O_SSC + (tb * 16 + r16) * SS + (sb * 16 + q4 * 4) * 2, make_uint2(cvt_pk_bf16(d[0], d[1]), cvt_pk_bf16(d[2], d[3])));
                }
            }
            (void)NT1;
        }
        __syncthreads();
        {
            const int tb = (MODE == 1) ? (wv & 1) : (wv & 3);
            const int t = tb * 16 + r16;
            const int tok = scan_tok(b, c * CS + t, dir);
            constexpr int NV = (MODE == 1) ? 1 : 2;
            f32x4 oi[NV + EXT], oo[NV + EXT];
#pragma unroll
            for (int u2 = 0; u2 < NV + EXT; ++u2) {
                const int vt = (u2 == NV) ? 4 : ((MODE == 1) ? (wv >> 1) : 2 * (wv >> 2) + u2);
                f32x4 a1 = (f32x4){0.f, 0.f, 0.f, 0.f}, a2 = a1;
#pragma unroll
                for (int sb2 = 0; sb2 < CS / 32; ++sb2)
                    a1 = SC_MFMA(rd_tr(L0 + O_V, sb2 * 32, vt * 16, VS, lane), rd_row(L0 + O_SSC, t, SS, sb2 * 32 + q4 * 8), a1);
#pragma unroll
                for (int kk2 = 0; kk2 < DK / 32; ++kk2)
                    a2 = SC_MFMA(rd_row(ST_R, vt * 16 + r16, QS, kk2 * 32 + q4 * 8), rd_row(L0 + ((MODE == 1) ? O_QB : O_QA), t, QS, kk2 * 32 + q4 * 8), a2);
                oi[u2] = a1; oo[u2] = a2;
            }
            float den = 1.f, ei = 1.f;
            if (MODE == 0) {
                ei = 0.125f * SHI(v_e, t);
                const float dsum = oi[NV][0] + ei * oo[NV][0];
                const float dd = SHI(dsum, r16);
                den = frcp(fmaxf(fabsf(dd), SHI(v_low, t)));
            } else if (MODE == 2) {
                ei = fexp((float)(t + 1) * lg);
            }
#pragma unroll
            for (int u2 = 0; u2 < NV; ++u2) {
                const int vt = (MODE == 1) ? (wv >> 1) : 2 * (wv >> 2) + u2;
                float o[4];
#pragma unroll
                for (int jj = 0; jj < 4; ++jj) o[jj] = (oi[u2][jj] + ei * oo[u2][jj]) * den;
                *(uint2*)(HXo + (size_t)tok * 1024 + cO + vt * 16 + q4 * 4) = make_uint2(cvt_pk_bf16(o[0], o[1]), cvt_pk_bf16(o[2], o[3]));
            }
        }
        {
            constexpr int NS = (MODE == 0) ? 3 : 4;
            const int kt = (MODE == 0) ? (wv & 3) : wv;
            float dk[4] = {sp, sp, sp, sp};
            if (MODE == 1) { const f32x4 dv = *(const LAS f32x4*)(size_t)(L0 + O_DKV + (kt * 16 + q4 * 4) * 4); dk[0] = dv[0]; dk[1] = dv[1]; dk[2] = dv[2]; dk[3] = dv[3]; }
            f32x4 a[NS];
#pragma unroll
            for (int u2 = 0; u2 < NS; ++u2) { a[u2] = sacc[u2];
#pragma unroll
                for (int jj = 0; jj < 4; ++jj) a[u2][jj] *= dk[jj]; }
#pragma unroll
            for (int sb2 = 0; sb2 < CS / 32; ++sb2) {
                unsigned ta[5], ts[5]; bf16x8 ops[5];
                ta[0] = tr_addr(L0 + O_KW, sb2 * 32, kt * 16, QS, lane); ts[0] = 4u * QS;
#pragma unroll
                for (int u2 = 0; u2 < 4; ++u2) {
                    const int vt = (MODE == 0) ? ((u2 >= 2) ? 4 : 2 * (wv >> 2) + u2) : u2;
                    ta[1 + u2] = tr_addr(L0 + O_V, sb2 * 32, vt * 16, VS, lane); ts[1 + u2] = 4u * VS;
                }
                rd_tr5(ta, ts, ops);
#pragma unroll
                for (int u2 = 0; u2 < NS; ++u2) a[u2] = SC_MFMA(ops[0], ops[1 + u2], a[u2]);
            }
#pragma unroll
            for (int u2 = 0; u2 < NS; ++u2) {
                const int vt = (MODE == 0) ? ((u2 == 2) ? 4 : 2 * (wv >> 2) + u2) : u2;
                sacc[u2] = a[u2];
                st8(ST_W + (vt * 16 + r16) * QS + (kt * 16 + q4 * 4) * 2, make_uint2(cvt_pk_bf16(a[u2][0], a[u2][1]), cvt_pk_bf16(a[u2][2], a[u2][3])));
            }
        }
        __syncthreads();
    };
#pragma unroll 1
    for (int c = 0; c < NCH; c += 2) { chunk(c, RA); if (PD == 2) chunk(c + 1, RB); else chunk(c + 1, RA); }
}

}

__device__ __forceinline__ void ph_hy_filt2(KP p, int l, int bid, int nb, float* sm, int skip);
__device__ __forceinline__ void ph_scan_even2(KP p, int l, int bid, int nb, float* sm) {
#pragma unroll 1
    for (int item = bid; item < 256; item += nb) {
        const int kind = item >> 7, b = (item >> 4) & 7, h = (item >> 2) & 3, dir = (item >> 1) & 1, vs = item & 1;
        if (kind == 0) sc::scan_item<0>(p, l, b, h, dir, vs); else sc::scan_item<1>(p, l, b, h, dir, vs);
        __syncthreads();
    }
    if (bid < 128) { ph_hy_filt2(p, l + 1, bid, 128, sm, 0); __syncthreads(); ph_convert(p, l + 1, bid, 128, sm, 1); }
}
__device__ __forceinline__ void ph_scan_odd2(KP p, int l, int bid, int nb) {
#pragma unroll 1
    for (int item = bid; item < 128; item += nb) {
        const int b = (item >> 4) & 7, h = (item >> 2) & 3, dir = (item >> 1) & 1, vs = item & 1;
        sc::scan_item<2>(p, l, b, h, dir, vs);
        __syncthreads();
    }
}

__device__ __forceinline__ void unpack16(const uint4 a, const uint4 b, float (&x)[16]) {
    x[0] = bflo(a.x); x[1] = bfhi(a.x); x[2] = bflo(a.y); x[3] = bfhi(a.y); x[4] = bflo(a.z); x[5] = bfhi(a.z); x[6] = bflo(a.w); x[7] = bfhi(a.w);
    x[8] = bflo(b.x); x[9] = bfhi(b.x); x[10] = bflo(b.y); x[11] = bfhi(b.y); x[12] = bflo(b.z); x[13] = bfhi(b.z); x[14] = bflo(b.w); x[15] = bfhi(b.w);
}
__device__ __forceinline__ float sum8(float v) { v += WS_DPP(v, 0xB1, 0xf); v += WS_DPP(v, 0x4E, 0xf); v += WS_DPP(v, 0x141, 0xf); return v; }
struct Hng6 { uint4 a0, a1, b0, b1, g0, g1; };
__device__ __forceinline__ Hng6 hng_load(const bf16_t* h0, const bf16_t* h1, const bf16_t* gp) {
    Hng6 r; r.a0 = *(const uint4*)h0; r.a1 = *(const uint4*)(h0 + 8); r.b0 = *(const uint4*)h1; r.b1 = *(const uint4*)(h1 + 8); r.g0 = *(const uint4*)gp; r.g1 = *(const uint4*)(gp + 8); return r;
}
template <bool MEANSUB, bool SIG>
__device__ __forceinline__ void hng_compute(const Hng6& in, const float* nw, bf16_t* out) {
    float a[16], b[16], g[16];
    unpack16(in.a0, in.a1, a); unpack16(in.b0, in.b1, b); unpack16(in.g0, in.g1, g);
    float s = 0.f;
#pragma unroll
    for (int i = 0; i < 16; ++i) { a[i] += b[i]; s += a[i]; }
    if (MEANSUB) { const float mean = sum8(s) * (1.f / 128.f);
#pragma unroll
        for (int i = 0; i < 16; ++i) a[i] -= mean; }
    float q = 0.f;
#pragma unroll
    for (int i = 0; i < 16; ++i) q += a[i] * a[i];
    const float r = rsqrtf(sum8(q) * (1.f / 128.f) + LN_EPS);
    unsigned w[8];
#pragma unroll
    for (int i = 0; i < 16; i += 2) {
        const float y0 = a[i] * r * nw[i] * (SIG ? fsigmoid(g[i]) : fsilu(g[i])), y1 = a[i + 1] * r * nw[i + 1] * (SIG ? fsigmoid(g[i + 1]) : fsilu(g[i + 1]));
        w[i >> 1] = cvt_pk_bf16(y0, y1);
    }
    *(uint4*)out = make_uint4(w[0], w[1], w[2], w[3]); *(uint4*)(out + 8) = make_uint4(w[4], w[5], w[6], w[7]);
}
__device__ __forceinline__ void ph_normgate_even(KP p, int l, int bid, int nb) {
    const int tid = opaque_tid(), lane = tid & 63, wv = tid >> 6;
    const bf16_t* P = (const bf16_t*)(p->ws + OFF_BIG);
    const bf16_t* HX = (const bf16_t*)(p->ws + OFF_AUX);
    const bf16_t* HX1 = HX + (size_t)NT * 1024;
    bf16_t* MIX = (bf16_t*)(p->ws + OFF_U);
    const int e = l >> 1;
    const bool ml = lane < 32;
    const float* nw = ml ? p->in[I_MNW] + e * 512 + 16 * lane : p->in[I_HNW] + e * 512 + 16 * (lane - 32);
    const int gcol = ml ? E_MO + 16 * lane : E_HG + 16 * (lane - 32);
    int tok = bid * 8 + wv;
    Hng6 nx = hng_load(HX + (size_t)tok * 1024 + 16 * lane, HX1 + (size_t)tok * 1024 + 16 * lane, P + (size_t)tok * EVEN_LD + gcol);
#pragma unroll 1
    for (; tok < NT; tok += nb * 8) {
        const Hng6 cur = nx;
        const int tn = tok + nb * 8;
        const int tc = tn < NT ? tn : tok;
        nx = hng_load(HX + (size_t)tc * 1024 + 16 * lane, HX1 + (size_t)tc * 1024 + 16 * lane, P + (size_t)tc * EVEN_LD + gcol);
        bf16_t* o = MIX + (size_t)tok * 1024 + 16 * lane;
        if (ml) hng_compute<true, true>(cur, nw, o); else hng_compute<false, false>(cur, nw, o);
    }
}

#define OFF_UT   (OFF_AUX + 136 * MiB)
#define OFF_FKS(o) (984 * MiB + (size_t)(o) * 34 * MiB)
#define OFF_ZOT  (OFF_UT + 102 * MiB)

__device__ __forceinline__ void ph_hy_filt2(KP p, int l, int bid, int nb, float* sm, int skip) {
    const int tid = opaque_tid(), o = l >> 1;
    float* zf = sm;
    float* h1 = sm + 1024;
    float* h2 = sm + 2048;
    float* h3 = sm + 3072;
    const float* fw1 = p->in[I_HW1] + o * 33 * 64; const float* fb1 = p->in[I_HB1] + o * 64;
    const float* fw2 = p->in[I_HW2] + o * 64 * 64; const float* fb2 = p->in[I_HB2] + o * 64;
    const float* fw3 = p->in[I_HW3] + o * 64 * 64; const float* fb3 = p->in[I_HB3] + o * 64;
    const float* freq = p->in[I_HFREQ] + o * 64;
    const float* wout = p->in[I_HWOUT] + (size_t)o * 64 * 2048;
    float* FK = (float*)(p->ws + OFF_FKS(o)); float* FKC = FK + (size_t)2 * 512 * 8192;
#pragma unroll 1
    for (int item = bid - skip; item < (SEQ + CTXL) / 16; item += nb - skip) {
        if (item < 0) break;
        const bool isctx = item >= SEQ / 16;
        const int L = isctx ? CTXL : SEQ, pos0 = (isctx ? item - SEQ / 16 : item) * 16;
        __syncthreads();
        if (tid < 16 * 17) {
            const int pp = tid / 17, j = tid % 17, pos = pos0 + pp;
            if (j == 16) zf[pp * 36] = (float)pos / (float)(L - 1);
            else { const float f = 1e-4f + (float)j * ((15.0f - 1e-4f) / 15.0f); const float w = 2.0f * 3.14159265358979323846f * (float)pos / (float)L * f; zf[pp * 36 + 1 + j] = cosf(w); zf[pp * 36 + 17 + j] = sinf(w); }
        }
        __syncthreads();
        const int pp = tid >> 5, u0 = (tid & 31) * 2;
        { float a0 = fb1[u0], a1 = fb1[u0 + 1];
#pragma unroll 1
          for (int k = 0; k < 33; ++k) { const float z = zf[pp * 36 + k]; a0 += z * fw1[k * 64 + u0]; a1 += z * fw1[k * 64 + u0 + 1]; }
          h1[pp * 64 + u0] = sinf(freq[u0] * a0); h1[pp * 64 + u0 + 1] = sinf(freq[u0 + 1] * a1); }
        __syncthreads();
        { float a0 = fb2[u0], a1 = fb2[u0 + 1];
#pragma unroll 4
          for (int k = 0; k < 64; ++k) { const float z = h1[pp * 64 + k]; a0 += z * fw2[k * 64 + u0]; a1 += z * fw2[k * 64 + u0 + 1]; }
          h2[pp * 64 + u0] = sinf(freq[u0] * a0); h2[pp * 64 + u0 + 1] = sinf(freq[u0 + 1] * a1); }
        __syncthreads();
        { float a0 = fb3[u0], a1 = fb3[u0 + 1];
#pragma unroll 4
          for (int k = 0; k < 64; ++k) { const float z = h2[pp * 64 + k]; a0 += z * fw3[k * 64 + u0]; a1 += z * fw3[k * 64 + u0 + 1]; }
          h3[pp * 64 + u0] = sinf(freq[u0] * a0); h3[pp * 64 + u0 + 1] = sinf(freq[u0 + 1] * a1); }
        __syncthreads();
#pragma unroll 1
        for (int r = 0; r < 4; ++r) {
            const int col = tid + 512 * r, c = col & 511, od = col >> 9, order = od >> 1, dirn = od & 1;
            float a[16];
#pragma unroll
            for (int i = 0; i < 16; ++i) a[i] = 0.f;
#pragma unroll 1
            for (int k = 0; k < 64; k += 4) { const float w0 = wout[k * 2048 + col], w1 = wout[(k + 1) * 2048 + col], w2 = wout[(k + 2) * 2048 + col], w3 = wout[(k + 3) * 2048 + col];
#pragma unroll
                for (int i = 0; i < 16; ++i) { const float4 hh = *(const float4*)(h3 + i * 64 + k); a[i] += hh.x * w0 + hh.y * w1 + hh.z * w2 + hh.w * w3; } }
            const float delta = 3.0701134573253944f + (float)c * ((15.350567286626972f - 3.0701134573253944f) / 511.0f);
#pragma unroll
            for (int i = 0; i < 16; ++i) a[i] *= expf(-((float)(pos0 + i) / (float)(L - 1)) * delta);
            float* dst = isctx ? FKC + ((size_t)order * 512 + c) * 512 + 256 : FK + ((size_t)order * 512 + c) * 8192 + 4096;
            if (dirn == 0) {
#pragma unroll
                for (int i = 0; i < 16; i += 4) *(float4*)(dst + pos0 + i) = make_float4(a[i], a[i + 1], a[i + 2], a[i + 3]);
            } else {
#pragma unroll
                for (int i = 0; i < 16; ++i) if (pos0 + i > 0) dst[-(pos0 + i)] = a[i];
                if (pos0 == 0) dst[-L] = 0.f;
            }
        }
    }
}

__device__ __forceinline__ void ph_hy_prep(KP p, int l, int bid, int nb, float* sm) {
    const int tid = opaque_tid(), o = l >> 1;
    const bf16_t* P = (const bf16_t*)(p->ws + OFF_BIG);
    bf16_t* UT = (bf16_t*)(p->ws + OFF_UT);
    const float* cw = p->in[I_HCW] + o * 3 * 1536; const float* cb = p->in[I_HCB] + o * 1536;
    float* tile = sm;
#pragma unroll 1
    for (int item = bid; item < (NT / 256) * 24; item += nb) {
        const int tt = item / 24, ct = item % 24, tok0 = tt * 256, col0 = ct * 64;
        const bool lat = tok0 < NL;
        const int L = lat ? SEQ : CTXL, t0 = lat ? (tok0 & (SEQ - 1)) : ((tok0 - NL) & (CTXL - 1));
        __syncthreads();
#pragma unroll 1
        for (int i = tid; i < 258 * 8; i += 512) {
            const int rr = i >> 3, hf = i & 7, t = t0 + rr - 1;
            uint4 v = make_uint4(0u, 0u, 0u, 0u);
            if (t >= 0 && t < L) v = *(const uint4*)(P + (size_t)(tok0 + rr - 1) * ODD_LD + col0 + hf * 8);
            float* d = tile + rr * 65 + hf * 8;
            d[0] = bflo(v.x); d[1] = bfhi(v.x); d[2] = bflo(v.y); d[3] = bfhi(v.y); d[4] = bflo(v.z); d[5] = bfhi(v.z); d[6] = bflo(v.w); d[7] = bfhi(v.w);
        }
        __syncthreads();
#pragma unroll 1
        for (int r = 0; r < 4; ++r) {
            const int cc = (tid >> 5) + 16 * r, tc = (tid & 31) * 8, col = col0 + cc;
            const float w0 = cw[col], w1 = cw[1536 + col], w2 = cw[3072 + col], bb = cb[col];
            float y[8];
#pragma unroll
            for (int i = 0; i < 8; ++i) y[i] = tile[(tc + i) * 65 + cc] * w0 + tile[(tc + i + 1) * 65 + cc] * w1 + tile[(tc + i + 2) * 65 + cc] * w2 + bb;
            *(uint4*)(UT + (size_t)col * NT + tok0 + tc) = make_uint4(cvt_pk_bf16(y[0], y[1]), cvt_pk_bf16(y[2], y[3]), cvt_pk_bf16(y[4], y[5]), cvt_pk_bf16(y[6], y[7]));
        }
    }
}

__device__ __forceinline__ void hy_item_lat(KP p, int l, int c) {
    constexpr int ZSB = (SEQ + 8) * 2;
    constexpr unsigned O_Z = 0, O_PE = O_Z + 8 * ZSB, O_PO = O_PE + 4096 * 4, O_END = O_PO + 4096 * 4;
    static_assert(O_END <= BAR_LDS_, "hyena LDS");
    const int tid = opaque_tid(), lane = tid & 63, wv = __builtin_amdgcn_readfirstlane(tid >> 6), r16 = lane & 15, q4 = lane >> 4, o = l >> 1;
    const unsigned L0 = (unsigned)(size_t)smraw_base();
    const bf16_t* UT = (const bf16_t*)(p->ws + OFF_UT);
    bf16_t* ZOT = (bf16_t*)(p->ws + OFF_ZOT);
    const float* FK = (const float*)(p->ws + OFF_FKS(o));
    for (int i = tid; i < 8 * 512; i += 512) { const int b = i >> 9, ch = i & 511; sc::st16(L0 + O_Z + b * ZSB + ch * 16, *(const uint4*)(UT + (size_t)(1024 + c) * NT + b * SEQ + ch * 8)); }
#pragma unroll 1
    for (int order = 0; order < 2; ++order) {
        const float* fk = FK + ((size_t)order * 512 + c) * 8192;
        for (int i = tid; i < 4096; i += 512) {
            const float r0 = (i > 0) ? fk[8192 - 2 * i] : 0.f, r1 = fk[8191 - 2 * i], r2 = (i < 4095) ? fk[8190 - 2 * i] : 0.f;
            *(LAS unsigned*)(size_t)(L0 + O_PE + i * 4) = cvt_pk_bf16(r0, r1); *(LAS unsigned*)(size_t)(L0 + O_PO + i * 4) = cvt_pk_bf16(r1, r2);
        }
        __syncthreads();
        sc::f32x4 acc[4][4];
#pragma unroll
        for (int a = 0; a < 4; ++a)
#pragma unroll
            for (int b2 = 0; b2 < 4; ++b2) acc[a][b2] = (sc::f32x4){0.f, 0.f, 0.f, 0.f};
        const unsigned gbase = L0 + ((r16 & 1) ? O_PO : O_PE) + (unsigned)(((4096 - r16 + 8 * q4 - (r16 & 1)) >> 1) * 4);
        auto ldG = [&](int g) {
            const unsigned a0 = gbase - (unsigned)(32 * g);
            const unsigned w0 = *(const LAS unsigned*)(size_t)a0, w1 = *(const LAS unsigned*)(size_t)(a0 + 4), w2 = *(const LAS unsigned*)(size_t)(a0 + 8), w3 = *(const LAS unsigned*)(size_t)(a0 + 12);
            return __builtin_bit_cast(sc::bf16x8, (sc::u32x4_){w0, w1, w2, w3});
        };
        sc::bf16x8 bq[4][2], W[6];
#pragma unroll
        for (int i = 0; i < 4; ++i) { bq[i][0] = (sc::bf16x8){0, 0, 0, 0, 0, 0, 0, 0}; bq[i][1] = bq[i][0]; }
        const int D0 = 8 * wv - 63, D1 = (8 * wv + 7 < 63) ? 8 * wv + 7 : 63;
        W[4] = ldG(4 * D0 - 6 + 4); W[5] = ldG(4 * D0 - 6 + 5);
#pragma unroll 1
        for (int D = D0; D <= D1; ++D) {
            W[0] = W[4]; W[1] = W[5];
#pragma unroll
            for (int i = 0; i < 4; ++i) W[2 + i] = ldG(4 * D + i);
            bq[3][0] = bq[2][0]; bq[3][1] = bq[2][1]; bq[2][0] = bq[1][0]; bq[2][1] = bq[1][1]; bq[1][0] = bq[0][0]; bq[1][1] = bq[0][1];
            {
                const int s1 = 8 * wv - D + ((r16 < 8) ? 0 : 4);
                const bool ok = (unsigned)s1 < 64u;
                const unsigned za = L0 + O_Z + (unsigned)((r16 & 7) * ZSB + ((ok ? s1 : 0) * 64 + q4 * 8) * 2);
                sc::bf16x8 b0 = *(const LAS sc::bf16x8*)(size_t)za, b1 = *(const LAS sc::bf16x8*)(size_t)(za + 64);
                if (!ok) { b0 = (sc::bf16x8){0, 0, 0, 0, 0, 0, 0, 0}; b1 = b0; }
                bq[0][0] = b0; bq[0][1] = b1;
            }
#pragma unroll
            for (int cg = 0; cg < 4; ++cg) {
                const int sA = 8 * wv + cg - D;
                if ((unsigned)sA < 64u || (unsigned)(sA + 4) < 64u) {
#pragma unroll
                    for (int it = 0; it < 4; ++it) { acc[cg][it] = SC_MFMA(W[it + 2], bq[cg][0], acc[cg][it]); acc[cg][it] = SC_MFMA(W[it], bq[cg][1], acc[cg][it]); }
                }
            }
        }
        __syncthreads();
        const float sk = p->in[I_HSKIP][o * 1024 + order * 512 + c];
        const bf16_t* gt = UT + (size_t)(order * 512 + c) * NT;
        const int bb = r16 & 7;
#pragma unroll
        for (int cg = 0; cg < 4; ++cg) {
            const int t1 = 8 * wv + cg + ((r16 < 8) ? 0 : 4);
#pragma unroll
            for (int it = 0; it < 4; ++it) {
                const int t = t1 * 64 + it * 16 + q4 * 4;
                const sc::u32x2_ zo_ = *(const LAS sc::u32x2_*)(size_t)(L0 + O_Z + bb * ZSB + t * 2); const uint2 zo = make_uint2(zo_[0], zo_[1]);
                const uint2 gv = *(const uint2*)(gt + bb * SEQ + t);
                const float y0 = bflo(gv.x) * (acc[cg][it][0] + sk * bflo(zo.x)), y1 = bfhi(gv.x) * (acc[cg][it][1] + sk * bfhi(zo.x));
                const float y2 = bflo(gv.y) * (acc[cg][it][2] + sk * bflo(zo.y)), y3 = bfhi(gv.y) * (acc[cg][it][3] + sk * bfhi(zo.y));
                const uint2 w = make_uint2(cvt_pk_bf16(y0, y1), cvt_pk_bf16(y2, y3));
                if (order == 0) sc::st8(L0 + O_Z + bb * ZSB + t * 2, w);
                else *(uint2*)(ZOT + (size_t)c * NT + bb * SEQ + t) = w;
            }
        }
        __syncthreads();
    }
}

__device__ __forceinline__ void hy_item_ctx(KP p, int l, int c, float* sm) {
    const int tid = opaque_tid(), o = l >> 1;
    const bf16_t* UT = (const bf16_t*)(p->ws + OFF_UT);
    bf16_t* ZOT = (bf16_t*)(p->ws + OFF_ZOT);
    const float* FKC = (const float*)(p->ws + OFF_FKS(o)) + (size_t)2 * 512 * 8192;
    float* Kc = sm;
    float* zb = sm + 1024;
    for (int i = tid; i < 1024; i += 512) Kc[i] = FKC[((size_t)(i >> 9) * 512 + c) * 512 + (i & 511)];
    for (int i = tid; i < 8 * CTXL; i += 512) zb[i] = bf2f(UT[(size_t)(1024 + c) * NT + NL + i]);
    __syncthreads();
    const int bb = tid >> 6, tl = tid & 63;
#pragma unroll 1
    for (int order = 0; order < 2; ++order) {
        float acc[4] = {0.f, 0.f, 0.f, 0.f};
#pragma unroll 4
        for (int s = 0; s < CTXL; ++s) {
            const float zv = zb[bb * CTXL + s];
#pragma unroll
            for (int i = 0; i < 4; ++i) acc[i] += Kc[order * 512 + tl + 64 * i - s + 256] * zv;
        }
        const float sk = p->in[I_HSKIP][o * 1024 + order * 512 + c];
        float zn[4];
#pragma unroll
        for (int i = 0; i < 4; ++i) { const int t = tl + 64 * i; zn[i] = bf2f(UT[(size_t)(order * 512 + c) * NT + NL + bb * CTXL + t]) * (acc[i] + zb[bb * CTXL + t] * sk); }
        __syncthreads();
#pragma unroll
        for (int i = 0; i < 4; ++i) { const int t = tl + 64 * i; if (order == 0) zb[bb * CTXL + t] = bf2f((bf16_t)(cvt_pk_bf16(zn[i], 0.f) & 0xffffu)); else stf(ZOT + (size_t)c * NT + NL + bb * CTXL + t, zn[i]); }
        __syncthreads();
    }
}

__device__ __forceinline__ void ph_mix_odd(KP p, int l, int bid, int nb, float* sm) {
    int* head = (int*)(p->ws + OFF_CNT) + 1024 + (l >> 1) * 64;
    LAS int* slot = (LAS int*)(smraw_base() + BAR_LDS_ + 64);
#pragma unroll 1
    for (;;) {
        if (opaque_tid() == 0) *slot = atomicAdd(head, 1);
        __syncthreads();
        const int item = *slot;
        __syncthreads();
        if (item >= 128 + 512) break;
        if (item < 128) { const int b = (item >> 4) & 7, h = (item >> 2) & 3, dir = (item >> 1) & 1, vs = item & 1; sc::scan_item<2>(p, l, b, h, dir, vs); }
        else { const int c = item - 128; hy_item_lat(p, l, c); __syncthreads(); hy_item_ctx(p, l, c, sm); }
        __syncthreads();
    }
}

__device__ __forceinline__ void ph_hy_norm(KP p, int l, int bid, int nb, float* sm) {
    const int tid = opaque_tid(), o = l >> 1;
    const bf16_t* ZOT = (const bf16_t*)(p->ws + OFF_ZOT);
    bf16_t* MIX = (bf16_t*)(p->ws + OFF_U);
    const float* nw = p->in[I_HNORM] + o * 512;
    float* tile = sm;
    float* part = sm + 64 * 65;
#pragma unroll 1
    for (int item = bid; item < (NT / 64) * 8; item += nb) {
        const int tt = item >> 3, g = item & 7, tok0 = tt * 64;
        __syncthreads();
        { const int cc = tid >> 3, ch = tid & 7;
          const uint4 v = *(const uint4*)(ZOT + (size_t)(g * 64 + cc) * NT + tok0 + ch * 8);
          float* d = tile + cc * 65 + ch * 8;
          d[0] = bflo(v.x); d[1] = bfhi(v.x); d[2] = bflo(v.y); d[3] = bfhi(v.y); d[4] = bflo(v.z); d[5] = bfhi(v.z); d[6] = bflo(v.w); d[7] = bfhi(v.w); }
        __syncthreads();
        { const int tk = tid & 63, pt = tid >> 6; float s = 0.f;
#pragma unroll
          for (int i = 0; i < 8; ++i) { const float x = tile[(pt * 8 + i) * 65 + tk]; s += x * x; }
          part[pt * 64 + tk] = s; }
        __syncthreads();
        { const int tk = tid >> 3, ch = tid & 7; float s = 0.f;
#pragma unroll
          for (int i = 0; i < 8; ++i) s += part[i * 64 + tk];
          const float rs = rsqrtf(s * (1.f / 64.f) + LN_EPS);
          float y[8];
#pragma unroll
          for (int i = 0; i < 8; ++i) y[i] = tile[(ch * 8 + i) * 65 + tk] * rs * nw[g * 64 + ch * 8 + i];
          *(uint4*)(MIX + (size_t)(tok0 + tk) * DM + g * 64 + ch * 8) = make_uint4(cvt_pk_bf16(y[0], y[1]), cvt_pk_bf16(y[2], y[3]), cvt_pk_bf16(y[4], y[5]), cvt_pk_bf16(y[6], y[7])); }
    }
}

__device__ __forceinline__ void ph_normgate_odd(KP p, int l, int bid, int nb) {
    const int tid = opaque_tid(), lane = tid & 63, wv = tid >> 6, o2 = l >> 1;
    const bf16_t* P = (const bf16_t*)(p->ws + OFF_BIG);
    const bf16_t* HX = (const bf16_t*)(p->ws + OFF_AUX);
    const bf16_t* HX1 = HX + (size_t)NT * 1024;
    bf16_t* MIX = (bf16_t*)(p->ws + OFF_U);
    const int c16 = 16 * (lane & 31);
    const float* nw = p->in[I_RNW] + o2 * 512 + c16;
    int t2 = bid * 8 + wv;
    auto ld = [&](int t2_) { const int tok = t2_ * 2 + (lane >> 5); const size_t o = (size_t)tok * 1024 + 512 + c16; return hng_load(HX + o, HX1 + o, P + (size_t)tok * ODD_LD + 3072 + c16); };
    Hng6 nx = ld(t2);
#pragma unroll 1
    for (; t2 < NT / 2; t2 += nb * 8) {
        const Hng6 cur = nx;
        nx = ld(t2 + nb * 8 < NT / 2 ? t2 + nb * 8 : t2);
        const int tok = t2 * 2 + (lane >> 5);
        hng_compute<true, false>(cur, nw, MIX + (size_t)tok * 1024 + 512 + c16);
    }
}

__device__ __forceinline__ void ph_ln1_router(KP p, int l, int ntok, int bid, int nb, float* sm) {
    constexpr int VP = (1024 + 8) * 2;
    constexpr unsigned O_VH = 0, O_VL = 32 * VP, O_LG = 64 * VP;
    static_assert(O_LG + 2 * 32 * 64 * 4 <= BAR_LDS_, "router LDS");
    const int tid = opaque_tid(), lane = tid & 63, wv = __builtin_amdgcn_readfirstlane(tid >> 6), r16 = lane & 15, q4 = lane >> 4;
    const unsigned L0 = (unsigned)(size_t)smraw_base();
    const bf16_t* Y = (const bf16_t*)(p->ws + OFF_BIG);
    bf16_t* U = (bf16_t*)(p->ws + OFF_U);
    const float* lw = p->in[I_LNW] + (l * 2) * 1024; const float* lb = p->in[I_LNB] + (l * 2) * 1024;
    const bf16_t* RWH = (const bf16_t*)(p->ws + OFF_RWH); const bf16_t* RWL = RWH + 64 * 1024;
    const float rb = p->in[I_RB][l * 64 + lane];
    LAS int* lcnt = (LAS int*)(smraw_base() + BAR_LDS_ + 256);
    if (tid < 64) lcnt[tid] = 0;
    __syncthreads();
    int* tidx = (int*)(p->ws + OFF_TIDX); float* tgate = (float*)(p->ws + OFF_TGATE); int* tpos = (int*)(p->ws + OFF_TPOS);
    {
        int* stok = (int*)(p->ws + OFF_STOK); float* sgate = (float*)(p->ws + OFF_SGATE); int* sdst = (int*)(p->ws + OFF_SDST);
#pragma unroll 1
        for (int i = bid * 512 + tid; i < MAXROWS; i += nb * 512) { stok[i] = ZROW; sgate[i] = 0.f; sdst[i] = NT * 9; }
    }
    const int nfr = (ntok >> 5) / nb, nsteps = nfr + (((ntok >> 5) % nb) ? 1 : 0);
    uint2 ph_[4][4]; uint2 pr_[4][4];
    auto step_geom = [&](int step, int& tpw, int& base) { const bool full = step < nfr; tpw = full ? 4 : 1; base = full ? (step * nb + bid) * 32 : nfr * nb * 32 + bid * 8; };
    auto preload = [&](int step) {
        int tpw, base; step_geom(step, tpw, base);
#pragma unroll
        for (int j = 0; j < 4; ++j) {
            if (j < tpw) {
                const int tok = base + wv * tpw + j;
                const bf16_t* h = hrow(p, tok); const bf16_t* r = Y + (size_t)tok * DM;
#pragma unroll
                for (int c = 0; c < 4; ++c) { const int d = 4 * (lane + 64 * c); ph_[j][c] = *(const uint2*)(h + d); pr_[j][c] = *(const uint2*)(r + d); }
            }
        }
    };
    preload(0);
#pragma unroll 1
    for (int step = 0; step < nsteps; ++step) {
        int tpw, base; step_geom(step, tpw, base);
        float4 cg[4], cw[4], cb[4], csh[4], csc[4];
        {
            const float* m = modrow(p, l, base);
#pragma unroll
            for (int c = 0; c < 4; ++c) { const int d = 4 * (lane + 64 * c);
                cg[c] = *(const float4*)(m + 2 * 1024 + d); cw[c] = *(const float4*)(lw + d); cb[c] = *(const float4*)(lb + d); csh[c] = *(const float4*)(m + 3 * 1024 + d); csc[c] = *(const float4*)(m + 4 * 1024 + d); }
        }
#pragma unroll
        for (int j = 0; j < 4; ++j) {
            if (j >= tpw) break;
            const int tl = wv * tpw + j, tok = base + tl;
            bf16_t* h = hrow(p, tok);
            float x[16]; float s = 0.f;
#pragma unroll
            for (int c = 0; c < 4; ++c) {
                const uint2 hw2 = ph_[j][c]; const float4 hv = make_float4(bflo(hw2.x), bfhi(hw2.x), bflo(hw2.y), bfhi(hw2.y)), gv = cg[c]; const uint2 rw2 = pr_[j][c];
                const float4 rv = make_float4(bflo(rw2.x), bfhi(rw2.x), bflo(rw2.y), bfhi(rw2.y));
                x[4 * c] = ALPHA * hv.x + gv.x * rv.x; x[4 * c + 1] = ALPHA * hv.y + gv.y * rv.y; x[4 * c + 2] = ALPHA * hv.z + gv.z * rv.z; x[4 * c + 3] = ALPHA * hv.w + gv.w * rv.w;
                s += x[4 * c] + x[4 * c + 1] + x[4 * c + 2] + x[4 * c + 3];
            }
            const float mean = wave_sum(s) * (1.f / 1024.f);
            float q = 0.f;
#pragma unroll
            for (int i = 0; i < 16; ++i) { x[i] -= mean; q += x[i] * x[i]; }
            const float rs = rsqrtf(wave_sum(q) * (1.f / 1024.f) + LN_EPS);
#pragma unroll
            for (int c = 0; c < 4; ++c) {
                const int d = 4 * (lane + 64 * c);
                const float4 w4 = cw[c], b4 = cb[c], sh = csh[c], sc = csc[c];
                float4 y; y.x = x[4 * c] * rs * w4.x + b4.x; y.y = x[4 * c + 1] * rs * w4.y + b4.y; y.z = x[4 * c + 2] * rs * w4.z + b4.z; y.w = x[4 * c + 3] * rs * w4.w + b4.w;
                *(uint2*)(h + d) = make_uint2(cvt_pk_bf16(y.x, y.y), cvt_pk_bf16(y.z, y.w));
                float4 v; v.x = y.x * (1.f + sc.x) + sh.x; v.y = y.y * (1.f + sc.y) + sh.y; v.z = y.z * (1.f + sc.z) + sh.z; v.w = y.w * (1.f + sc.w) + sh.w;
                const unsigned h0 = cvt_pk_bf16(v.x, v.y), h1 = cvt_pk_bf16(v.z, v.w);
                *(uint2*)(U + (size_t)tok * DM + d) = make_uint2(h0, h1);
                sc::st8(L0 + O_VH + tl * VP + d * 2, make_uint2(h0, h1));
                sc::st8(L0 + O_VL + tl * VP + d * 2, make_uint2(cvt_pk_bf16(v.x - bflo(h0), v.y - bfhi(h0)), cvt_pk_bf16(v.z - bflo(h1), v.w - bfhi(h1))));
            }
        }
        __syncthreads();
        {
            const int et = wv & 3, kh = wv >> 2;
            sc::f32x4 acc0 = (sc::f32x4){0.f, 0.f, 0.f, 0.f}, acc1 = acc0;
            const bf16_t* bh = RWH + (size_t)(et * 16 + r16) * 1024 + kh * 512 + q4 * 8; const bf16_t* bl = RWL + (size_t)(et * 16 + r16) * 1024 + kh * 512 + q4 * 8;
#pragma unroll 4
            for (int ks = 0; ks < 16; ++ks) {
                const int kk = kh * 512 + ks * 32 + q4 * 8;
                const sc::bf16x8 wh = *(const sc::bf16x8*)(bh + ks * 32), wl = *(const sc::bf16x8*)(bl + ks * 32);
                const sc::bf16x8 a0h = sc::rd_row(L0 + O_VH, r16, VP, kk), a0l = sc::rd_row(L0 + O_VL, r16, VP, kk);
                const sc::bf16x8 a1h = sc::rd_row(L0 + O_VH, 16 + r16, VP, kk), a1l = sc::rd_row(L0 + O_VL, 16 + r16, VP, kk);
                acc0 = SC_MFMA(a0h, wh, acc0); acc1 = SC_MFMA(a1h, wh, acc1); acc0 = SC_MFMA(a0h, wl, acc0); acc1 = SC_MFMA(a1h, wl, acc1); acc0 = SC_MFMA(a0l, wh, acc0); acc1 = SC_MFMA(a1l, wh, acc1);
            }
#pragma unroll
            for (int jj = 0; jj < 4; ++jj) {
                *(LAS float*)(size_t)(L0 + O_LG + kh * 8192 + ((q4 * 4 + jj) * 64 + et * 16 + r16) * 4) = acc0[jj];
                *(LAS float*)(size_t)(L0 + O_LG + kh * 8192 + ((16 + q4 * 4 + jj) * 64 + et * 16 + r16) * 4) = acc1[jj]; }
        }
        preload(step + 1 < nsteps ? step + 1 : step);
        __syncthreads();
#pragma unroll 1
        for (int j = 0; j < tpw; ++j) {
            const int tl = wv * tpw + j, tok = base + tl;
            const float lg = *(const LAS float*)(size_t)(L0 + O_LG + (tl * 64 + lane) * 4) + *(const LAS float*)(size_t)(L0 + O_LG + 8192 + (tl * 64 + lane) * 4);
            const float score = sigmoidf_(lg);
            const float key = score + rb;
            int rank = 64; float kk = key;
#pragma unroll
            for (int r = 0; r < TOPK; ++r) {
                float m = kk; const float ni = -__builtin_inff();
                m = fmaxf(m, WS_DPPI(m, ni, 0x111, 0xf)); m = fmaxf(m, WS_DPPI(m, ni, 0x112, 0xf)); m = fmaxf(m, WS_DPPI(m, ni, 0x114, 0xf)); m = fmaxf(m, WS_DPPI(m, ni, 0x118, 0xf));
                m = fmaxf(m, WS_DPPI(m, ni, 0x142, 0xa)); m = fmaxf(m, WS_DPPI(m, ni, 0x143, 0xc));
                const float mx = __builtin_bit_cast(float, __builtin_amdgcn_readlane(__builtin_bit_cast(int, m), 63));
                const unsigned long long bal = __builtin_amdgcn_ballot_w64(kk == mx);
                const int first = (int)__builtin_ctzll(bal);
                if (lane == first) { rank = r; kk = ni; }
            }
            const bool sel = rank < TOPK;
            const float gsum = wave_sum(sel ? score : 0.f);
            if (sel) {
                const int pos = __hip_atomic_fetch_add(lcnt + lane, 1, __ATOMIC_RELAXED, __HIP_MEMORY_SCOPE_WORKGROUP);
                tidx[tok * 8 + rank] = lane; tgate[tok * 8 + rank] = 2.5f * score / gsum; tpos[tok * 8 + rank] = pos;
            }
        }
        __syncthreads();
    }
    __syncthreads();
    if (tid < 64) ((int*)(p->ws + OFF_BCNT))[bid * 64 + tid] = lcnt[tid];
}

__device__ __forceinline__ void moe_offsets(KP p, int l, int ntok, LAS int* offs) {
    const int t = opaque_tid();
    if (t < 66) offs[t] = ((const int*)(p->ws + OFF_GOFFS))[t];
    __syncthreads();
}
__device__ __forceinline__ int moe_expert_of(const LAS int* offs, int row) { int e = 0;
#pragma unroll 1
    while (e < 64 && row >= offs[e + 1]) ++e;
    return e; }

__device__ __forceinline__ void ph_scatter(KP p, int l, int ntok, int bid, int nb, LAS unsigned char* lds) {
    LAS int* offs = (LAS int*)lds;
    LAS int* myb = offs + 128;
    LAS int* part = offs + 256;
    const int tid = opaque_tid();
    const int* bcnt = (const int*)(p->ws + OFF_BCNT);
    { const int e = tid & 63, pt = tid >> 6; int tot = 0, mine = 0;
#pragma unroll 4
      for (int b = pt; b < nb; b += 8) { const int c = bcnt[b * 64 + e]; tot += c; mine += (b < bid) ? c : 0; }
      part[pt * 64 + e] = tot; part[512 + pt * 64 + e] = mine; }
    __syncthreads();
    if (tid < 64) {
        int tot = 0, mine = 0;
#pragma unroll
        for (int i = 0; i < 8; ++i) { tot += part[i * 64 + tid]; mine += part[512 + i * 64 + tid]; }
        const int pc = (tot + 255) & ~255;
        int incl = pc;
#pragma unroll
        for (int o = 1; o < 64; o <<= 1) { const int t = SHU(incl, o); if (tid >= o) incl += t; }
        offs[tid] = incl - pc; myb[tid] = mine;
        if (tid == 63) { offs[64] = incl; offs[65] = incl + ntok; }
    }
    __syncthreads();
    if (bid == 0 && tid < 66) ((int*)(p->ws + OFF_GOFFS))[tid] = offs[tid];
    const int* tidx = (const int*)(p->ws + OFF_TIDX); const float* tgate = (const float*)(p->ws + OFF_TGATE); const int* tpos = (const int*)(p->ws + OFF_TPOS);
    int* stok = (int*)(p->ws + OFF_STOK); float* sgate = (float*)(p->ws + OFF_SGATE); int* sdst = (int*)(p->ws + OFF_SDST);
    int* tile_e = (int*)(p->ws + OFF_TILEE);
    const int nfr = (ntok >> 5) / nb, nsteps = nfr + (((ntok >> 5) % nb) ? 1 : 0);
#pragma unroll 1
    for (int step = 0; step < nsteps; ++step) {
        const bool full = step < nfr;
        const int ntk = full ? 32 : 8, base = full ? (step * nb + bid) * 32 : nfr * nb * 32 + bid * 8;
        if (tid < ntk * 9) {
            const int tok = base + tid / 9, sl = tid % 9;
            if (sl < 8) { const int i = tok * 8 + sl, e = tidx[i], row = offs[e] + myb[e] + tpos[i]; stok[row] = tok; sgate[row] = tgate[i]; sdst[row] = tok * 9 + sl; }
            else { const int row = offs[64] + tok; stok[row] = tok; sgate[row] = 1.f; sdst[row] = tok * 9 + 8; }
        }
    }
    const int nrt = offs[65] >> 8;
#pragma unroll 1
    for (int rt = bid * 512 + tid; rt < nrt; rt += nb * 512) tile_e[rt] = moe_expert_of(offs, rt * 256);
    __syncthreads();
}

#define MOE_TAB (gp::STAGE_BYTES + 256)
#define MOE_MAXT 9
static_assert(131072 + 256 + 256 + MOE_MAXT * 2048 <= BAR_LDS_, "MoE tables");
struct MoeDeal {
    int nfull, rem, c, G;
    __device__ __forceinline__ void init(int nrt, int c_, int G_) { nfull = nrt / G_; rem = nrt % G_; c = ((c_ & 7) << 5) | (c_ >> 3); G = G_; }
    __device__ __forceinline__ int nleft(int NPN) const { const int tot = rem * NPN; return c < tot ? (tot - c + G - 1) / G : 0; }
    __device__ __forceinline__ int ntiles(int NPN) const { return nfull + nleft(NPN); }
    __device__ __forceinline__ int tile_of(int j, int NPN) const { return j < nfull ? c + j * G : nfull * G + (c + (j - nfull) * G) / NPN; }
    __device__ __forceinline__ bool unit(int i, int NPN, int& j, int& pn) const {
        if (i < nfull * NPN) { j = i / NPN; pn = i % NPN; return true; }
        const int k = i - nfull * NPN, lu = c + k * G;
        if (lu < rem * NPN) { j = nfull + k; pn = lu % NPN; return true; }
        return false;
    }
};
struct Moe1Sched {
    const char* U; const char* W; const LAS int* tabE; const LAS int* tabS; MoeDeal d;
    __device__ __forceinline__ bool next(int i, gp::Unit& u) const {
        int j, pn; if (!d.unit(i, 2, j, pn)) return false;
        u.A = U; u.B = W + (size_t)__builtin_amdgcn_readfirstlane(tabE[j]) * (512 * 1024 * 2) + (size_t)pn * (256 * 1024 * 2); u.r0 = d.tile_of(j, 2) * 256; u.c0 = pn * 256; u.aux = j; return true;
    }
    __device__ __forceinline__ void lane_off(const gp::Unit& u, unsigned (&vo)[2][2]) const {
        const int tid = opaque_tid(); int R0, C0, R1, C1; gp::stage_rc(tid * 16, R0, C0); gp::stage_rc(tid * 16 + 8192, R1, C1);
        const LAS int* t = tabS + u.aux * 256;
        vo[0][0] = (unsigned)t[R0] * 2048u + (unsigned)C0 * 2u; vo[0][1] = (unsigned)t[R1] * 2048u + (unsigned)C1 * 2u;
        vo[1][0] = (unsigned)t[128 + R0] * 2048u + (unsigned)C0 * 2u; vo[1][1] = (unsigned)t[128 + R1] * 2048u + (unsigned)C1 * 2u;
    }
};
struct EpiH {
    bf16_t* H;
    static constexpr int NSTQ = 12;
    __device__ __forceinline__ void quad(const gp::f32x4 (&acc)[2][2][4][2], const gp::Unit& u, int ai, int bj, int wr, int wc, int fr, int fq, unsigned (&)[4][2]) const {
        const int row0 = u.r0 + wr * 64 + fr + ai * 128, j0 = ((u.c0 + bj * 128 + wc * 32) >> 5) * 16 + 4 * fq;
#pragma unroll
        for (int m = 0; m < 4; ++m) {
            const gp::f32x4 a = acc[ai][bj][m][0], b = acc[ai][bj][m][1];
            const float h0 = fsilu(a[0]) * b[0], h1 = fsilu(a[1]) * b[1], h2 = fsilu(a[2]) * b[2], h3 = fsilu(a[3]) * b[3];
            *(uint2*)(H + (size_t)(row0 + m * 16) * 256 + j0) = make_uint2(cvt_pk_bf16(h0, h1), cvt_pk_bf16(h2, h3)); }
    }
    __device__ __forceinline__ void operator()(const gp::f32x4 (&acc)[2][2][4][2], const gp::Unit& u, int wr, int wc, int fr, int fq) const {
        const int row0 = u.r0 + wr * 64 + fr;
#pragma unroll
        for (int ai = 0; ai < 2; ++ai)
#pragma unroll
            for (int m = 0; m < 4; ++m) { bf16_t* rowp = H + (size_t)(row0 + ai * 128 + m * 16) * 256;
#pragma unroll
                for (int bj = 0; bj < 2; ++bj) {
                    const int j0 = ((u.c0 + bj * 128 + wc * 32) >> 5) * 16 + 4 * fq;
                    const gp::f32x4 a = acc[ai][bj][m][0], b = acc[ai][bj][m][1];
                    const float h0 = fsilu(a[0]) * b[0], h1 = fsilu(a[1]) * b[1], h2 = fsilu(a[2]) * b[2], h3 = fsilu(a[3]) * b[3];
                    *(uint2*)(rowp + j0) = make_uint2(cvt_pk_bf16(h0, h1), cvt_pk_bf16(h2, h3)); }
                __builtin_amdgcn_sched_barrier(0); }
    }
};
__device__ __forceinline__ void ph_moe1(KP p, int l, int ntok, int bid, int nb, LAS unsigned char* lds) {
    LAS int* tabE = (LAS int*)(lds + MOE_TAB);
    LAS int* tabS = tabE + 64;
    const int tid = opaque_tid();
    MoeDeal d; d.init(((const int*)(p->ws + OFF_GOFFS))[65] >> 8, bid, nb);
    const int nper = d.ntiles(2);
    const int* stok = (const int*)(p->ws + OFF_STOK); const int* tile_e = (const int*)(p->ws + OFF_TILEE);
    for (int i = tid; i < nper * 256; i += 512) tabS[i] = stok[(size_t)d.tile_of(i >> 8, 2) * 256 + (i & 255)];
    if (tid < nper) tabE[tid] = tile_e[d.tile_of(tid, 2)];
    __syncthreads();
    Moe1Sched S{(const char*)(p->ws + OFF_U), (const char*)(p->ws + OFF_W13L(l)), tabE, tabS, d};
    EpiH E{(bf16_t*)(p->ws + OFF_BIG)};
    gp::gemm_phase<true, false, true>(lds, 1024, S, E);
}

struct Moe2Sched {
    const char* H; const char* W; const LAS int* tabE; MoeDeal d;
    __device__ __forceinline__ bool next(int i, gp::Unit& u) const {
        int j, pn; if (!d.unit(i, 4, j, pn)) return false;
        u.A = H + (size_t)d.tile_of(j, 4) * (256 * 256 * 2); u.B = W + (size_t)__builtin_amdgcn_readfirstlane(tabE[j]) * (1024 * 256 * 2) + (size_t)pn * (256 * 256 * 2); u.r0 = j * 256; u.c0 = pn * 256; u.aux = j; return true;
    }
    __device__ __forceinline__ void lane_off(const gp::Unit&, unsigned (&)[2][2]) const {}
};
__device__ __forceinline__ unsigned pk_fp8x4(float a, float b, float c, float d) { int w = __builtin_amdgcn_cvt_pk_fp8_f32(a, b, 0, false); w = __builtin_amdgcn_cvt_pk_fp8_f32(c, d, w, true); return (unsigned)w; }
struct EpiY {
    unsigned char* Ys; const LAS int* tabD; const LAS float* tabG;
    static constexpr int NSTQ = 8;
    __device__ __forceinline__ void quad(const gp::f32x4 (&acc)[2][2][4][2], const gp::Unit& u, int ai, int bj, int wr, int wc, int fr, int fq, unsigned (&keep)[4][2]) const {
        const int rl0 = u.r0 + wr * 64 + fr + ai * 128, pos0 = u.c0 + wc * 64 + 16 * fq;
#pragma unroll
        for (int m = 0; m < 4; ++m) {
            const float g = tabG[rl0 + m * 16];
            const gp::f32x4 v0 = acc[ai][bj][m][0] * g, v1 = acc[ai][bj][m][1] * g;
            const unsigned p0 = pk_fp8x4(v0[0], v0[1], v0[2], v0[3]), p1 = pk_fp8x4(v1[0], v1[1], v1[2], v1[3]);
            if (bj == 0) { keep[m][0] = p0; keep[m][1] = p1; }
            else *(gp::u32x4*)(Ys + (size_t)tabD[rl0 + m * 16] * 1024 + pos0) = (gp::u32x4){keep[m][0], keep[m][1], p0, p1};
        }
    }
    __device__ __forceinline__ void operator()(const gp::f32x4 (&acc)[2][2][4][2], const gp::Unit& u, int wr, int wc, int fr, int fq) const {
        const int rl0 = u.r0 + wr * 64 + fr, pos0 = u.c0 + wc * 64 + 16 * fq;
#pragma unroll
        for (int ai = 0; ai < 2; ++ai)
#pragma unroll
            for (int m = 0; m < 4; ++m) {
                const int rl = rl0 + ai * 128 + m * 16;
                const int dst = tabD[rl]; const float g = tabG[rl];
                const gp::f32x4 a0 = acc[ai][0][m][0] * g, a1 = acc[ai][0][m][1] * g, b0 = acc[ai][1][m][0] * g, b1 = acc[ai][1][m][1] * g;
                *(gp::u32x4*)(Ys + (size_t)dst * 1024 + pos0) = (gp::u32x4){pk_fp8x4(a0[0], a0[1], a0[2], a0[3]), pk_fp8x4(a1[0], a1[1], a1[2], a1[3]), pk_fp8x4(b0[0], b0[1], b0[2], b0[3]), pk_fp8x4(b1[0], b1[1], b1[2], b1[3])};
                __builtin_amdgcn_sched_barrier(0); }
    }
};
__device__ __forceinline__ void ph_moe2(KP p, int l, int ntok, int bid, int nb, LAS unsigned char* lds) {
    LAS int* tabE = (LAS int*)(lds + MOE_TAB);
    LAS int* tabD = tabE + 64;
    LAS float* tabG = (LAS float*)(tabD + MOE_MAXT * 256);
    const int tid = opaque_tid();
    MoeDeal d; d.init(((const int*)(p->ws + OFF_GOFFS))[65] >> 8, bid, nb);
    const int nper = d.ntiles(4);
    const int* sdst = (const int*)(p->ws + OFF_SDST); const float* sgate = (const float*)(p->ws + OFF_SGATE); const int* tile_e = (const int*)(p->ws + OFF_TILEE);
    for (int i = tid; i < nper * 256; i += 512) { const size_t r = (size_t)d.tile_of(i >> 8, 4) * 256 + (i & 255); tabD[i] = sdst[r]; tabG[i] = sgate[r]; }
    if (tid < nper) tabE[tid] = tile_e[d.tile_of(tid, 4)];
    __syncthreads();
    Moe2Sched S{(const char*)(p->ws + OFF_BIG), (const char*)(p->ws + OFF_W2), tabE, d};
    EpiY E{(unsigned char*)(p->ws + OFF_YS), tabD, tabG};
    gp::gemm_phase<false, true, true>(lds, 256, S, E);
}

template <bool NEXT>
__device__ __forceinline__ void ph_combine_ln2(KP p, int l, int ntok, int bid, int nb) {
    bf16_t* U = (bf16_t*)(p->ws + OFF_U);
    float* G = (float*)(p->ws + OFF_G);
    const bool gates = NEXT && ((l + 1) & 1) == 0;
    LAS float* wl = (LAS float*)smraw_base();
    if (gates) stage_gate_w(p, (l + 1) >> 1, wl);
    const int tid = opaque_tid(), lane = tid & 63, wv = tid >> 6;
    const int cA = 256 * (lane >> 4) + 32 * ((lane >> 2) & 3) + 8 * (lane & 3);
    const unsigned char* Ys = (const unsigned char*)(p->ws + OFF_YS);
    const float* lw = p->in[I_LNW] + (l * 2 + 1) * 1024; const float* lb = p->in[I_LNB] + (l * 2 + 1) * 1024;
    uint4 yq[9]; uint4 hq[2];
    auto preload = [&](int tok) {
#pragma unroll
        for (int s9 = 0; s9 < 9; ++s9) yq[s9] = *(const uint4*)(Ys + ((size_t)tok * 9 + s9) * 1024 + 16 * lane);
        const bf16_t* h = hrow(p, tok);
        hq[0] = *(const uint4*)(h + cA); hq[1] = *(const uint4*)(h + cA + 128);
    };
    const int tpw = ntok >> 11, t0 = (bid * 8 + wv) * tpw;
    float4 cg[4], cw[4], cb[4], csh[4], csc[4];
    int rcur = -1;
    preload(t0);
#pragma unroll 1
    for (int k = 0; k < tpw; ++k) {
        const int tok = t0 + k;
        bf16_t* h = hrow(p, tok);
        const int rr = tok < NL ? (tok >> 12) : 8;
        if (rr != rcur) {
            rcur = rr;
            const float* m = modrow(p, l, tok);
            const float* m2 = modrow(p, NEXT ? l + 1 : l, tok);
#pragma unroll
            for (int q = 0; q < 4; ++q) {
                const int c = cA + (q >> 1) * 128 + (q & 1) * 4;
                cg[q] = *(const float4*)(m + 5 * 1024 + c); cw[q] = *(const float4*)(lw + c); cb[q] = *(const float4*)(lb + c);
                if (NEXT) { csh[q] = *(const float4*)(m2 + c); csc[q] = *(const float4*)(m2 + 1024 + c); }
            }
        }
        float f[16];
#pragma unroll
        for (int i = 0; i < 16; ++i) f[i] = 0.f;
#pragma unroll
        for (int s9 = 0; s9 < 9; ++s9) {
            const unsigned ww[4] = {yq[s9].x, yq[s9].y, yq[s9].z, yq[s9].w};
#pragma unroll
            for (int q = 0; q < 4; ++q) { const f32x2_n lo = __builtin_amdgcn_cvt_pk_f32_fp8((int)ww[q], false), hi = __builtin_amdgcn_cvt_pk_f32_fp8((int)ww[q], true);
                f[4 * q] += lo[0]; f[4 * q + 1] += lo[1]; f[4 * q + 2] += hi[0]; f[4 * q + 3] += hi[1]; }
        }
        float4 hc[4];
        hc[0] = make_float4(bflo(hq[0].x), bfhi(hq[0].x), bflo(hq[0].y), bfhi(hq[0].y)); hc[1] = make_float4(bflo(hq[0].z), bfhi(hq[0].z), bflo(hq[0].w), bfhi(hq[0].w));
        hc[2] = make_float4(bflo(hq[1].x), bfhi(hq[1].x), bflo(hq[1].y), bfhi(hq[1].y)); hc[3] = make_float4(bflo(hq[1].z), bfhi(hq[1].z), bflo(hq[1].w), bfhi(hq[1].w));
#pragma unroll
        for (int q = 0; q < 4; ++q) asm volatile("" : "+v"(hc[q].x), "+v"(hc[q].y), "+v"(hc[q].z), "+v"(hc[q].w), "+v"(f[4 * q]), "+v"(f[4 * q + 1]), "+v"(f[4 * q + 2]), "+v"(f[4 * q + 3]) :: "memory");
        preload(k + 1 < tpw ? tok + 1 : tok);
        float x[16]; float sum = 0.f;
#pragma unroll
        for (int q = 0; q < 4; ++q) {
            const float4 hv = hc[q], gv = cg[q];
            x[4 * q] = ALPHA * hv.x + gv.x * f[4 * q]; x[4 * q + 1] = ALPHA * hv.y + gv.y * f[4 * q + 1]; x[4 * q + 2] = ALPHA * hv.z + gv.z * f[4 * q + 2]; x[4 * q + 3] = ALPHA * hv.w + gv.w * f[4 * q + 3];
            sum += x[4 * q] + x[4 * q + 1] + x[4 * q + 2] + x[4 * q + 3];
        }
        const float mean = wave_sum(sum) * (1.f / 1024.f);
        float q2 = 0.f;
#pragma unroll
        for (int i = 0; i < 16; ++i) { x[i] -= mean; q2 += x[i] * x[i]; }
        const float rs = rsqrtf(wave_sum(q2) * (1.f / 1024.f) + LN_EPS);
        float u16[16]; unsigned yb[8];
#pragma unroll
        for (int q = 0; q < 4; ++q) {
            const int c = cA + (q >> 1) * 128 + (q & 1) * 4;
            const float4 w4 = cw[q], b4 = cb[q];
            float4 y; y.x = x[4 * q] * rs * w4.x + b4.x; y.y = x[4 * q + 1] * rs * w4.y + b4.y; y.z = x[4 * q + 2] * rs * w4.z + b4.z; y.w = x[4 * q + 3] * rs * w4.w + b4.w;
            if (NEXT) { yb[2 * q] = cvt_pk_bf16(y.x, y.y); yb[2 * q + 1] = cvt_pk_bf16(y.z, y.w); }
            else *(float4*)(p->out + (size_t)tok * DM + c) = y;
            if (NEXT) {
                const float4 sh = csh[q], sc = csc[q];
                u16[4 * q] = y.x * (1.f + sc.x) + sh.x; u16[4 * q + 1] = y.y * (1.f + sc.y) + sh.y; u16[4 * q + 2] = y.z * (1.f + sc.z) + sh.z; u16[4 * q + 3] = y.w * (1.f + sc.w) + sh.w;
            }
        }
        if (NEXT) {
            *(uint4*)(h + cA) = make_uint4(yb[0], yb[1], yb[2], yb[3]); *(uint4*)(h + cA + 128) = make_uint4(yb[4], yb[5], yb[6], yb[7]);
            *(uint4*)(U + (size_t)tok * DM + cA) = make_uint4(cvt_pk_bf16(u16[0], u16[1]), cvt_pk_bf16(u16[2], u16[3]), cvt_pk_bf16(u16[4], u16[5]), cvt_pk_bf16(u16[6], u16[7]));
            *(uint4*)(U + (size_t)tok * DM + cA + 128) = make_uint4(cvt_pk_bf16(u16[8], u16[9]), cvt_pk_bf16(u16[10], u16[11]), cvt_pk_bf16(u16[12], u16[13]), cvt_pk_bf16(u16[14], u16[15]));
        }
        if (gates) {
            float ga[16];
#pragma unroll
            for (int j = 0; j < 16; ++j) ga[j] = 0.f;
#pragma unroll
            for (int g4 = 0; g4 < 4; ++g4) {
                const int c = cA + (g4 >> 1) * 128 + (g4 & 1) * 4;
#pragma unroll
                for (int qq = 0; qq < 4; ++qq) {
                    const float uv = u16[4 * g4 + qq];
#pragma unroll
                    for (int j4 = 0; j4 < 4; ++j4) { const f32x4_l w = *(const LAS f32x4_l*)(wl + (c + qq) * 16 + j4 * 4); ga[4 * j4] += uv * w[0]; ga[4 * j4 + 1] += uv * w[1]; ga[4 * j4 + 2] += uv * w[2]; ga[4 * j4 + 3] += uv * w[3]; }
                }
                __builtin_amdgcn_sched_barrier(0);
            }
            float mine = 0.f;
#pragma unroll
            for (int j = 0; j < 16; ++j) { const float sg = wave_sum(ga[j]); if (lane == j) mine = sg; }
            if (lane < 16) G[(size_t)tok * 16 + lane] = mine;
        }
    }
}

#define MEGA_LDS (131072 + 256 + 20480)
#define NBLK 256
#define BAR_LDS BAR_LDS_
#define SYNC() do { XcdBarrier _b; _b.bar = (unsigned*)kparams()->ws; _b.x = xb_xcc_id(); _b.st = (volatile LAS unsigned*)((LAS unsigned char*)smraw_base() + BAR_LDS); xcd_barrier(_b); } while (0)
template <int PAR>
__device__ __forceinline__ void layer_fwd(const int l) {
    LAS unsigned char* lds = smraw_base(); float* sm = (float*)smraw_generic();
    const int bid = blockIdx.x; constexpr int nb = NBLK;
    const int ntok = (l == 3) ? NL : NT;
    ph_gemm_in(kparams(), l, bid, nb, lds); SYNC();
    if (PAR == 0) {
        ph_scan_even2(kparams(), l, bid, nb, sm); SYNC();
        ph_normgate_even(kparams(), l, bid, nb); SYNC();
    } else {
        ph_hy_prep(kparams(), l, bid, nb, sm); SYNC();
        ph_mix_odd(kparams(), l, bid, nb, sm); SYNC();
        ph_hy_norm(kparams(), l, bid, nb, sm); ph_normgate_odd(kparams(), l, bid, nb); SYNC();
    }
    ph_gemm_out(kparams(), l, bid, nb, lds); SYNC();
    ph_ln1_router(kparams(), l, ntok, bid, nb, sm); SYNC();
    ph_scatter(kparams(), l, ntok, bid, nb, lds); SYNC();
    ph_moe1(kparams(), l, ntok, bid, nb, lds); SYNC();
    ph_moe2(kparams(), l, ntok, bid, nb, lds); SYNC();
    if (l < 3) { ph_combine_ln2<true>(kparams(), l, ntok, bid, nb); ph_convert(kparams(), l + 1, bid, nb, sm, PAR == 0 ? 2 : 0); SYNC(); }
    else ph_combine_ln2<false>(kparams(), l, ntok, bid, nb);
}
__global__ void __launch_bounds__(512, 2) mega_fwd(Params p) {
    LAS unsigned char* lds = smraw_base(); float* sm = (float*)smraw_generic();
    {
        const int t0 = threadIdx.x;
        if ((t0 & 63) == 0) { unsigned h; asm volatile("s_getreg_b32 %0, hwreg(HW_REG_HW_ID, 0, 6)" : "=s"(h)); *(LAS int*)(size_t)(WTAB_LDS + (h & 63u) * 4u) = t0 >> 6; }
        if (t0 < 4) ((LAS unsigned*)(lds + BAR_LDS))[t0] = 0u;
    }
    __syncthreads();
    (void)xcd_barrier_post((unsigned*)kparams()->ws, (volatile LAS unsigned*)(lds + BAR_LDS));
    const int bid = blockIdx.x; constexpr int nb = NBLK;
    ph_prologue(kparams(), bid, nb, sm);
    __syncthreads();
    ph_convert(kparams(), 0, bid, nb, sm);
    SYNC();
    ph_modin<true>(kparams(), 0, bid, nb); SYNC();
#pragma unroll 1
    for (int lp = 0; lp < 2; ++lp) {
        layer_fwd<0>(2 * lp);
        layer_fwd<1>(2 * lp + 1);
    }
    __syncthreads();
    if (blockIdx.x == 0 && opaque_tid() == 0 && xb_ld((unsigned*)kparams()->ws + XB_TMO) != 0u) kparams()->out[0] = __builtin_nanf("");
}

extern "C" void kernel_launch(void* const* d_in, const int* in_sizes, int n_in, void* d_out, int out_size, void* d_ws, size_t ws_size, hipStream_t stream) {
    static int grid = 0;
    if (grid == 0) {
        if (n_in != 38 || out_size != NL * DM || ws_size < WS_END) { fprintf(stderr, "kernel_launch: bad shapes n_in %d out %d ws %zu (need %zu)\n", n_in, out_size, ws_size, (size_t)WS_END); grid = -1; return; }
        int dev = 0, cus = 0, per_cu = 0;
        if (hipGetDevice(&dev) != hipSuccess || hipDeviceGetAttribute(&cus, hipDeviceAttributeMultiprocessorCount, dev) != hipSuccess) { grid = -1; return; }
        if (hipFuncSetAttribute((const void*)mega_fwd, hipFuncAttributeMaxDynamicSharedMemorySize, MEGA_LDS) != hipSuccess) { fprintf(stderr, "kernel_launch: hipFuncSetAttribute failed\n"); grid = -1; return; }
        if (hipOccupancyMaxActiveBlocksPerMultiprocessor(&per_cu, (const void*)mega_fwd, 512, MEGA_LDS) != hipSuccess || per_cu < 1) { fprintf(stderr, "kernel_launch: occupancy query says %d\n", per_cu); (void)hipGetLastError(); grid = -1; return; }
        if (cus != 256) { fprintf(stderr, "kernel_launch: built for 256 CUs, found %d\n", cus); grid = -1; return; }
        grid = NBLK;
    }
    if (grid < 0) return;
    if (hipMemsetAsync(d_ws, 0, OFF_LB, stream) != hipSuccess) return;
    Params p{};
    for (int i = 0; i < 38; ++i) p.in[i] = (const float*)d_in[i];
    p.out = (float*)d_out; p.ws = (unsigned char*)d_ws;
    hipLaunchKernelGGL(mega_fwd, dim3(grid), dim3(512), MEGA_LDS, stream, p);
}
```

```cpp
#include <hip/hip_runtime.h>
#include <stdint.h>
#include <stdio.h>

#define DM 1024
#define NBATCH 8
#define SEQ 4096
#define CTXL 256
#define NL (NBATCH * SEQ)
#define NC (NBATCH * CTXL)
#define NT (NL + NC)
#define ZROW NT
#define TOPK 8
#define EVEN_N 4112
#define ODD_N 3584
#define EVEN_LD 4096
#define ODD_LD 3584
#define MAXROWS (NT * 8 + 64 * 256 + NT)
#define ALPHA 1.681792830507429f
#define LN_EPS 1e-5f
#define E_MQ 0
#define E_MK 256
#define E_MV 512
#define E_MO 1024
#define E_HQ 1536
#define E_HI 2048
#define E_HFF 2560
#define E_HFB 3072
#define E_HG 3584

typedef unsigned short bf16_t;
#define LAS __attribute__((address_space(3)))
#define BAR_LDS_ 150528

#define MiB ((size_t)1 << 20)
#define OFF_CNT   ((size_t)64 << 10)
#define OFF_LB    ((size_t)96 << 10)
#define OFF_MOD   ((size_t)128 << 10)
#define OFF_ROPE  ((size_t)1536 << 10)
#define OFF_BCNT  ((size_t)1600 << 10)
#define OFF_GOFFS ((size_t)1700 << 10)
#define OFF_RWH   ((size_t)2560 << 10)
#define OFF_TILEE (2 * MiB)
#define OFF_HCTX  (4 * MiB)
#define OFF_TIDX  (12 * MiB)
#define OFF_TGATE (14 * MiB)
#define OFF_TPOS  (16 * MiB)
#define OFF_STOK  (18 * MiB)
#define OFF_SGATE (20 * MiB)
#define OFF_SDST  (22 * MiB)
#define OFF_G     (24 * MiB)
#define OFF_U     (28 * MiB)
#define OFF_W     (98 * MiB)
#define OFF_WIN   (OFF_W)
#define OFF_WOUT  (OFF_W + 8 * MiB)
#define OFF_W13   (OFF_W + 10 * MiB)
#define OFF_W2    (OFF_W + 75 * MiB)
#define OFF_BIG   (208 * MiB)
#define OFF_AUX   (480 * MiB)
#define OFF_Z1    (OFF_AUX + 136 * MiB)
#define OFF_Z2    (OFF_Z1 + 68 * MiB)
#define OFF_FILT  (OFF_Z2 + 68 * MiB)
#define OFF_YS    (370 * MiB)
#define OFF_W13X  (822 * MiB)
#define OFF_W13L(l) (((l) & 1) ? OFF_W13X : OFF_W13)
#define OFF_HB    (900 * MiB)
#define WS_END    (1052 * MiB)

struct Params {
    const float* in[38];
    float* out;
    unsigned char* ws;
};

enum { I_X = 0, I_C, I_CTX, I_CCTX, I_ADAW, I_ADAB, I_LNW, I_LNB, I_EWIN, I_MGB, I_MNW, I_HLB, I_HNW, I_EWOUT, I_OWIN, I_HCW, I_HCB,
       I_HW1, I_HB1, I_HW2, I_HB2, I_HW3, I_HB3, I_HFREQ, I_HWOUT, I_HSKIP, I_HNORM, I_RLD, I_RNW, I_OWOUT, I_RW, I_RB, I_W1, I_W3, I_W2, I_SW1, I_SW3, I_SW2 };

typedef const __attribute__((address_space(4))) Params* KP;
__device__ __forceinline__ KP kparams() { KP k = (KP)__builtin_amdgcn_kernarg_segment_ptr(); asm volatile("" : "+s"(k)); return k; }
extern __shared__ __attribute__((aligned(16))) unsigned char smraw_all[];
__device__ __forceinline__ LAS unsigned char* smraw_base() { return (LAS unsigned char*)smraw_all; }
__device__ __forceinline__ unsigned char* smraw_generic() { return smraw_all; }
#define WTAB_LDS (BAR_LDS_ + 512)
__device__ __forceinline__ int opaque_tid() {
    unsigned h; asm volatile("s_getreg_b32 %0, hwreg(HW_REG_HW_ID, 0, 6)" : "=s"(h));
    const int wid = *(volatile LAS int*)(size_t)(WTAB_LDS + (h & 63u) * 4u);
    unsigned m = ~0u; asm volatile("" : "+s"(m));
    const int lane = (int)__builtin_amdgcn_mbcnt_hi(m, __builtin_amdgcn_mbcnt_lo(m, 0u));
    return __builtin_amdgcn_readfirstlane(wid) * 64 + lane;
}
typedef __bf16 bf16x2_n __attribute__((ext_vector_type(2)));
typedef float f32x2_n __attribute__((ext_vector_type(2)));
__device__ __forceinline__ unsigned cvt_pk_bf16(float lo, float hi) { const f32x2_n v = {lo, hi}; return __builtin_bit_cast(unsigned, __builtin_convertvector(v, bf16x2_n)); }
__device__ __forceinline__ float bf2f(bf16_t b) { return __uint_as_float(((unsigned)b) << 16); }
__device__ __forceinline__ float bflo(unsigned w) { return __uint_as_float(w << 16); }
__device__ __forceinline__ float bfhi(unsigned w) { return __uint_as_float(w & 0xffff0000u); }
__device__ __forceinline__ float ldf(const float* p) { return *p; }
__device__ __forceinline__ float ldf(const bf16_t* p) { return bf2f(*p); }
__device__ __forceinline__ void stf(float* p, float v) { *p = v; }
__device__ __forceinline__ void stf(bf16_t* p, float v) { *p = (bf16_t)(cvt_pk_bf16(v, 0.f) & 0xffffu); }
__device__ __forceinline__ float sigmoidf_(float x) { return 1.f / (1.f + expf(-x)); }
__device__ __forceinline__ float siluf_(float x) { return x / (1.f + expf(-x)); }
__device__ __forceinline__ int olane() { unsigned m = ~0u; asm volatile("" : "+s"(m)); return (int)__builtin_amdgcn_mbcnt_hi(m, __builtin_amdgcn_mbcnt_lo(m, 0u)); }
template <class T> __device__ __forceinline__ T shfl_idx(T v, int idx) { return __builtin_bit_cast(T, __builtin_amdgcn_ds_bpermute(idx << 2, __builtin_bit_cast(int, v))); }
#define SHX(v, o) shfl_idx(v, olane() ^ (o))
#define SHI(v, i) shfl_idx(v, (i))
#define SHI32(v, i) shfl_idx(v, (olane() & 32) | ((i) & 31))
#define SHU(v, o) shfl_idx(v, olane() - (o))
__device__ __forceinline__ float fexp(float x) { return __builtin_amdgcn_exp2f(x * 1.4426950408889634f); }
__device__ __forceinline__ float flog(float x) { return __builtin_amdgcn_logf(x) * 0.6931471805599453f; }
__device__ __forceinline__ float frcp(float x) { return __builtin_amdgcn_rcpf(x); }
__device__ __forceinline__ float fsigmoid(float x) { return frcp(1.f + fexp(-x)); }
__device__ __forceinline__ float fsilu(float x) { return x * frcp(1.f + fexp(-x)); }
#define WS_DPP(v, ctrl, rmask) __builtin_bit_cast(float, __builtin_amdgcn_update_dpp(0, __builtin_bit_cast(int, v), ctrl, rmask, 0xf, false))
#define WS_DPPI(v, ident, ctrl, rmask) __builtin_bit_cast(float, __builtin_amdgcn_update_dpp(__builtin_bit_cast(int, (float)(ident)), __builtin_bit_cast(int, v), ctrl, rmask, 0xf, false))
__device__ __forceinline__ float wave_sum(float v) {
    v += WS_DPP(v, 0x111, 0xf); v += WS_DPP(v, 0x112, 0xf); v += WS_DPP(v, 0x114, 0xf); v += WS_DPP(v, 0x118, 0xf);
    v += WS_DPP(v, 0x142, 0xa); v += WS_DPP(v, 0x143, 0xc);
    return __builtin_bit_cast(float, __builtin_amdgcn_readlane(__builtin_bit_cast(int, v), 63));
}
__device__ __forceinline__ bf16_t* hrow(KP p, int tok) { return (bf16_t*)(p->ws + OFF_HB) + (size_t)tok * DM; }
__device__ __forceinline__ const float* modrow(KP p, int l, int tok) {
    const int r = tok < NL ? (tok >> 12) : 8;
    return (const float*)(p->ws + OFF_MOD) + ((size_t)l * 9 + r) * 6144;
}
__device__ __forceinline__ int scan_tok(int b, int i, int dir) {
    return i < CTXL ? NL + b * CTXL + (dir ? CTXL - 1 - i : i) : b * SEQ + (dir ? SEQ - 1 - (i - CTXL) : (i - CTXL));
}

#define XB_TMO      128
#define XB_XCNT(j)  (256  + 64 * (j))
#define XB_XSUB(j)  (1280 + 64 * (j))
#define XB_XGEN(j)  (2304 + 64 * (j))
#define XB_TOP      3328
#define XB_TOPGEN   3392
#define XCD_BAR_WORDS 3456
#define XB_SPIN_CAP (1u << 24)
__device__ __forceinline__ unsigned xb_ld(unsigned* p)              { return __hip_atomic_load(p, __ATOMIC_RELAXED, __HIP_MEMORY_SCOPE_AGENT); }
__device__ __forceinline__ unsigned xb_add(unsigned* p, unsigned v) { return __hip_atomic_fetch_add(p, v, __ATOMIC_RELAXED, __HIP_MEMORY_SCOPE_AGENT); }
__device__ __forceinline__ unsigned xb_xcc_id() { return (unsigned)__builtin_amdgcn_s_getreg((3 << 11) | 20) & 0xFu; }
#define XB_SPIN(cond, bar) do { unsigned _sp = 0; while (cond) { __builtin_amdgcn_s_sleep(1); \
    if ((++_sp & 255u) == 0u) { if (xb_ld(&(bar)[XB_TMO])) break; if (_sp > XB_SPIN_CAP) { atomicAdd(&(bar)[XB_TMO], 1u); break; } } } } while (0)
struct XcdBarrier { unsigned* bar; unsigned x; volatile LAS unsigned* st; };
__device__ __forceinline__ XcdBarrier xcd_barrier_post(unsigned* bar, volatile LAS unsigned* st) {
    XcdBarrier b; b.bar = bar; b.x = xb_xcc_id(); b.st = st;
    if (opaque_tid() == 0) (void)xb_add(&bar[XB_XCNT(b.x)], 1u);
    return b;
}
__device__ __forceinline__ void xcd_barrier_complete(unsigned* bar, unsigned x, unsigned& nloc, unsigned& nx) {
    const unsigned G = gridDim.x * gridDim.y * gridDim.z;
    unsigned sum, cnt, mine, sp = 0u;
    for (;;) {
        sum = 0u; cnt = 0u; mine = 0u;
#pragma unroll
        for (unsigned j = 0; j < 16; ++j) { const unsigned c = xb_ld(&bar[XB_XCNT(j)]); sum += c; cnt += (c > 0u) ? 1u : 0u; mine = (j == x) ? c : mine; }
        if (sum == G) break;
        __builtin_amdgcn_s_sleep(1);
        if ((++sp & 255u) == 0u) { if (xb_ld(&bar[XB_TMO])) break; if (sp > XB_SPIN_CAP) { atomicAdd(&bar[XB_TMO], 1u); break; } }
    }
    nloc = mine > 0u ? mine : 1u; nx = cnt > 0u ? cnt : 1u;
}
__device__ __forceinline__ void xcd_barrier(const XcdBarrier& b) {
    asm volatile("s_waitcnt vmcnt(0)" ::: "memory");
    __syncthreads();
    if (opaque_tid() == 0) {
        unsigned* bar = b.bar;
        __builtin_amdgcn_s_waitcnt(0);
        unsigned nloc = b.st[0], nx = b.st[1];
        if (nloc == 0u) { xcd_barrier_complete(bar, b.x, nloc, nx); b.st[0] = nloc; b.st[1] = nx; }
        const unsigned old = xb_add(&bar[XB_XSUB(b.x)], 1u);
        const unsigned gen = old / nloc;
        if (old + 1u == (gen + 1u) * nloc) {
            __builtin_amdgcn_fence(__ATOMIC_RELEASE, "agent");
            asm volatile("s_waitcnt vmcnt(0)" ::: "memory");
            const unsigned og = xb_add(&bar[XB_TOP], 1u);
            const unsigned tg = og / nx;
            if (og + 1u == (tg + 1u) * nx) xb_add(&bar[XB_TOPGEN], 1u);
            else XB_SPIN(xb_ld(&bar[XB_TOPGEN]) == tg, bar);
            __builtin_amdgcn_fence(__ATOMIC_ACQUIRE, "agent");
            xb_add(&bar[XB_XGEN(b.x)], 1u);
            asm volatile("s_waitcnt vmcnt(0)" ::: "memory");
        } else {
            XB_SPIN(xb_ld(&bar[XB_XGEN(b.x)]) == gen, bar);
            __builtin_amdgcn_fence(__ATOMIC_ACQUIRE, "agent");
            asm volatile("s_waitcnt vmcnt(0)" ::: "memory");
        }
    }
    __syncthreads();
}

__device__ __forceinline__ void ph_prologue(KP p, int bid, int nb, float* sm) {
    const int tid = opaque_tid();
    if (bid == 0) {
        bf16_t* z = (bf16_t*)(p->ws + OFF_U) + (size_t)ZROW * DM;
        for (int i = tid; i < DM; i += 512) z[i] = 0;
    }
    if (bid == 1 % nb) {
        float* lb = (float*)(p->ws + OFF_LB);
        const float* hl = p->in[I_HLB];
        for (int j = tid; j < 512; j += 512) {
            const float a = hl[j], b = hl[512 + j], mx = fmaxf(a, b);
            const float ea = expf(a - mx), eb = expf(b - mx);
            lb[j] = 0.f; lb[512 + j] = eb / (ea + eb);
        }
    }
    if (bid == 2 % nb) {
        float2* rt = (float2*)(p->ws + OFF_ROPE);
        for (int i = tid; i < 64 * 32; i += 512) { const float ang = (float)(i >> 5) * powf(10000.f, -(float)(2 * (i & 31)) / 64.f); rt[i] = make_float2(cosf(ang), sinf(ang)); }
    }
    {
        float* act = sm;
        float* part = sm + 9 * 1024;
        bool filled = false;
        #pragma unroll 1
        for (int item = bid; item < 192; item += nb) {
            if (!filled) {
                for (int i = tid; i < 9 * 1024; i += 512) {
                    const int r = i >> 10, k = i & 1023;
                    const float v = r < 8 ? p->in[I_C][r * 1024 + k] : p->in[I_CCTX][k];
                    act[i] = siluf_(v);
                }
                filled = true;
            }
            __syncthreads();
            const int l = item / 48, jj = tid & 127, kq = tid >> 7, j = (item % 48) * 128 + jj;
            const float* w = p->in[I_ADAW] + (size_t)l * 1024 * 6144 + j;
            float acc[9];
#pragma unroll
            for (int r = 0; r < 9; ++r) acc[r] = 0.f;
#pragma unroll 8
            for (int k = kq * 256; k < kq * 256 + 256; ++k) {
                const float wv = w[(size_t)k * 6144];
#pragma unroll
                for (int r = 0; r < 9; ++r) acc[r] += act[r * 1024 + k] * wv;
            }
#pragma unroll
            for (int r = 0; r < 9; ++r) part[(kq * 9 + r) * 128 + jj] = acc[r];
            __syncthreads();
            float* mod = (float*)(p->ws + OFF_MOD);
            for (int i = tid; i < 9 * 128; i += 512) {
                const int r = i >> 7, c = i & 127;
                mod[((size_t)l * 9 + r) * 6144 + (item % 48) * 128 + c] = part[(0 * 9 + r) * 128 + c] + part[(1 * 9 + r) * 128 + c] + part[(2 * 9 + r) * 128 + c] + part[(3 * 9 + r) * 128 + c] + p->in[I_ADAB][l * 6144 + (item % 48) * 128 + c];
            }
        }
    }
}


struct CvtTile { const float* src; int srcld; bf16_t* dst; int dstld; int k0, n0; };
__device__ __forceinline__ CvtTile cvt_tile_of(KP p, int l, int t, int np4  ) {
    const bool even = (l & 1) == 0;
    const int NP = even ? EVEN_LD : ODD_LD;
    const int t_in = 16 * (NP / 128), t_out = 16 * 8, t_13 = 65 * 16 * 4;
    CvtTile c;
    if (t < t_in) {
        const int kt = t & 15, nt = t >> 4, n = nt * 128 + np4;
        const float* W = even ? p->in[I_EWIN] + (size_t)(l >> 1) * 1024 * EVEN_N : p->in[I_OWIN] + (size_t)(l >> 1) * 1024 * ODD_N;
        c.src = W + ((even && n >= 1536) ? n + 16 : n); c.srcld = even ? EVEN_N : ODD_N; c.dst = (bf16_t*)(p->ws + OFF_WIN); c.dstld = 1024; c.k0 = kt * 64; c.n0 = nt * 128;
    } else if (t < t_in + t_out) {
        const int u = t - t_in, kt = u & 15, nt = u >> 4;
        c.src = (even ? p->in[I_EWOUT] : p->in[I_OWOUT]) + (size_t)(l >> 1) * 1024 * 1024 + nt * 128 + np4; c.srcld = 1024; c.dst = (bf16_t*)(p->ws + OFF_WOUT); c.dstld = 1024; c.k0 = kt * 64; c.n0 = nt * 128;
    } else if (t < t_in + t_out + t_13) {
        const int u = t - t_in - t_out, e = u >> 6, kt = u & 15, nt = (u >> 4) & 3, n = nt * 128 + np4, g = n >> 5, w = n & 31;
        const float* w1 = e < 64 ? p->in[I_W1] + ((size_t)l * 64 + e) * 1024 * 256 : p->in[I_SW1] + (size_t)l * 1024 * 256;
        const float* w3 = e < 64 ? p->in[I_W3] + ((size_t)l * 64 + e) * 1024 * 256 : p->in[I_SW3] + (size_t)l * 1024 * 256;
        c.src = w < 16 ? w1 + 16 * g + w : w3 + 16 * g + w - 16; c.srcld = 256; c.dst = (bf16_t*)(p->ws + OFF_W13L(l)) + (size_t)e * 512 * 1024; c.dstld = 1024; c.k0 = kt * 64; c.n0 = nt * 128;
    } else {
        const int u = t - t_in - t_out - t_13, e = u >> 5, kt = u & 3, nt = (u >> 2) & 7;
        const float* w2 = e < 64 ? p->in[I_W2] + ((size_t)l * 64 + e) * 256 * 1024 : p->in[I_SW2] + (size_t)l * 256 * 1024;
        c.src = w2 + nt * 128 + np4; c.srcld = 1024; c.dst = (bf16_t*)(p->ws + OFF_W2) + (size_t)e * 1024 * 256; c.dstld = 256; c.k0 = kt * 64; c.n0 = nt * 128;
    }
    return c;
}
__device__ __forceinline__ void ph_convert(KP p, int l, int bid, int nb, float* sm, const int part = 0) {
    const int tid = opaque_tid();
    const int NP = ((l & 1) == 0) ? EVEN_LD : ODD_LD;
    const int t_io = 16 * (NP / 128) + 16 * 8, t_13_ = 65 * 16 * 4;
    const int total = (part == 1) ? t_13_ : (part == 2) ? t_io + 65 * 4 * 8 : t_io + t_13_ + 65 * 4 * 8;
    auto tmap = [&](int t) { return (part == 1) ? t + t_io : (part == 2 && t >= t_io) ? t + t_13_ : t; };
    const int kr = tid >> 5, np4 = (tid & 31) * 4;
    float4 v[4];
    int t = bid;
    CvtTile c = cvt_tile_of(p, l, tmap(t < total ? t : 0), np4);
    if (t < total) {
#pragma unroll
        for (int j = 0; j < 4; ++j) v[j] = *(const float4*)(c.src + (size_t)(c.k0 + kr + 16 * j) * c.srcld);
    }
#pragma unroll 1
    for (; t < total; t += nb) {
        __syncthreads();
#pragma unroll
        for (int j = 0; j < 4; ++j) { float* d = sm + (np4) * 65 + kr + 16 * j; d[0] = v[j].x; d[65] = v[j].y; d[130] = v[j].z; d[195] = v[j].w; }
        const CvtTile cur = c;
        const int tn = t + nb;
        if (tn < total) {
            c = cvt_tile_of(p, l, tmap(tn), np4);
#pragma unroll
            for (int j = 0; j < 4; ++j) v[j] = *(const float4*)(c.src + (size_t)(c.k0 + kr + 16 * j) * c.srcld);
        }
        __syncthreads();
        const int n = tid >> 2, kc = (tid & 3) * 16;
        unsigned w[8];
#pragma unroll
        for (int q = 0; q < 8; ++q) w[q] = cvt_pk_bf16(sm[n * 65 + kc + 2 * q], sm[n * 65 + kc + 2 * q + 1]);
        uint4* d4 = (uint4*)(cur.dst + (size_t)(cur.n0 + n) * cur.dstld + cur.k0 + kc);
        d4[0] = make_uint4(w[0], w[1], w[2], w[3]); d4[1] = make_uint4(w[4], w[5], w[6], w[7]);
    }
    __syncthreads();
    if (bid < 8 && part != 1) {
        const float* rw = p->in[I_RW] + (size_t)l * 1024 * 64;
        bf16_t* hi = (bf16_t*)(p->ws + OFF_RWH); bf16_t* lo = hi + 64 * 1024;
        const int e = tid & 63, kb = bid * 128 + (tid >> 6) * 16;
#pragma unroll
        for (int i = 0; i < 16; i += 2) {
            const float x0 = rw[(size_t)(kb + i) * 64 + e], x1 = rw[(size_t)(kb + i + 1) * 64 + e];
            const unsigned h = cvt_pk_bf16(x0, x1);
            const unsigned lw = cvt_pk_bf16(x0 - bflo(h), x1 - bfhi(h));
            *(unsigned*)(hi + (size_t)e * 1024 + kb + i) = h; *(unsigned*)(lo + (size_t)e * 1024 + kb + i) = lw;
        }
    }
}

namespace gp {
typedef short bf16x8 __attribute__((ext_vector_type(8)));
typedef float f32x4 __attribute__((ext_vector_type(4)));
typedef unsigned u32x4 __attribute__((ext_vector_type(4)));
typedef unsigned u32x2 __attribute__((ext_vector_type(2)));
constexpr int BM = 256, BK = 64, HALF = 128, HTB = HALF * BK * 2, STAGE_BYTES = 8 * HTB, NXCD = 8, WGM = 8;
__device__ __forceinline__ int lds_byte(int r, int c) { const int st = (r >> 4) * 2 + (c >> 5), rr = r & 15, cc = c & 31, ob = rr * 64 + cc * 2; return st * 1024 + (ob ^ (((ob >> 9) & 1) << 5)); }
__device__ __forceinline__ void stage_rc(int b, int& R, int& C) { const int st = b / 1024, sb = b % 1024, swz = sb ^ (((sb >> 9) & 1) << 5); R = (st >> 1) * 16 + swz / 64; C = (st & 1) * 32 + (swz % 64) / 2; }
__device__ __forceinline__ int perm32(int rho) { const int n = rho >> 4, i = rho & 15; return 8 * (i >> 2) + 4 * n + (i & 3); }

struct Unit { const char* A; const char* B; int r0, c0, aux; };

struct DenseSched {
    const char* A; const char* B; int nM, nN, nwg, G, c; size_t tstep;
    __device__ __forceinline__ void init(const void* A_, const void* B_, int M, int N, int K, int G_, int c_) { A = (const char*)A_; B = (const char*)B_; nM = M / BM; nN = N / BM; nwg = nM * nN; G = G_; c = c_; tstep = (size_t)BM * K * 2; }
    __device__ __forceinline__ bool next(int i, Unit& u) const {
        const long L = (long)i * G + c; if (L >= nwg) return false;
        int wgid = (int)L; { const int q = nwg / NXCD, r = nwg % NXCD, xcd = wgid % NXCD, off = wgid / NXCD; wgid = (xcd < r ? xcd * (q + 1) : r * (q + 1) + (xcd - r) * q) + off; }
        const int nig = WGM * nN, gid = wgid / nig, fm = gid * WGM, gsz = (nM - fm) < WGM ? (nM - fm) : WGM;
        const int pm = fm + ((wgid % nig) % gsz), pn = (wgid % nig) / gsz;
        u.A = A + (size_t)pm * tstep; u.B = B + (size_t)pn * tstep; u.r0 = pm * BM; u.c0 = pn * BM; u.aux = 0; return true;
    }
    __device__ __forceinline__ void lane_off(const Unit&, unsigned (&)[2][2]) const {}
};

template <bool GATHER, bool PERM, bool DEFER, class Sched, class Epi>
__device__ __forceinline__ void gemm_phase(LAS unsigned char* lds, const int K_, const Sched& S, const Epi& E) {
    int K = K_; asm volatile("" : "+s"(K));
    const int tid = opaque_tid(), wid = __builtin_amdgcn_readfirstlane(tid >> 6), lane = tid & 63, wr = wid >> 2, wc = wid & 3, fr = lane & 15, fq = lane >> 4;
    const int nt = K / BK;
    unsigned voffA[2], voffB[2];
#pragma unroll
    for (int i = 0; i < 2; ++i) { int R, C; stage_rc(tid * 16 + i * 8192, R, C); const int Rb = PERM ? ((R & ~31) + perm32(R & 31)) : R;
        voffA[i] = (unsigned)(R * K + C) * 2u; voffB[i] = (unsigned)(Rb * K + C) * 2u; }
    const size_t kstep = (size_t)(BK * 2);
    const size_t hstep = (size_t)HALF * K * 2;
    const unsigned ldsw = (unsigned)wid * 1024u;
    const int aoff = lds_byte(wr * 64 + fr, fq * 8), boff = lds_byte(wc * 32 + fr, fq * 8);
    unsigned cvo[2][2] = {{0u, 0u}, {0u, 0u}};
#define GP_SA(b, h) (((b) * 2 + (h)) * HTB)
#define GP_SB(b, h) ((4 + (b) * 2 + (h)) * HTB)
#define GP_GLDS(gp_, lp_) __builtin_amdgcn_global_load_lds((const unsigned*)(gp_), (LAS unsigned*)(lp_), 16, 0, 0)
#define GP_STAGE_B(bufoff, gbase, h) do { const char* _g = (gbase) + (size_t)(h) * hstep; \
        GP_GLDS(_g + voffB[0], lds + (bufoff) + ldsw); GP_GLDS(_g + voffB[1], lds + (bufoff) + ldsw + 8192); } while (0)
#define GP_STAGE_A(bufoff, gbase, h, usenext) do { \
        if (GATHER) { GP_GLDS((gbase) + cvo[h][0], lds + (bufoff) + ldsw); GP_GLDS((gbase) + cvo[h][1], lds + (bufoff) + ldsw + 8192); } \
        else { const char* _g = (gbase) + (size_t)(h) * hstep; GP_GLDS(_g + voffA[0], lds + (bufoff) + ldsw); GP_GLDS(_g + voffA[1], lds + (bufoff) + ldsw + 8192); } } while (0)
#define GP_LDA(dst, b, h) do { _Pragma("unroll") for (int m = 0; m < 4; ++m) _Pragma("unroll") for (int k = 0; k < 2; ++k) dst[m][k] = *(const LAS bf16x8*)(lds + GP_SA(b, h) + aoff + m * 2048 + k * 1024); } while (0)
#define GP_LDB(dst, b, h) do { _Pragma("unroll") for (int n = 0; n < 2; ++n) _Pragma("unroll") for (int k = 0; k < 2; ++k) dst[n][k] = *(const LAS bf16x8*)(lds + GP_SB(b, h) + boff + n * 2048 + k * 1024); } while (0)
#define GP_MMA(ai, bj, At, Bt) do { __builtin_amdgcn_s_setprio(1); _Pragma("unroll") for (int m = 0; m < 4; ++m) _Pragma("unroll") for (int n = 0; n < 2; ++n) _Pragma("unroll") for (int k = 0; k < 2; ++k) \
        acc[ai][bj][m][n] = __builtin_amdgcn_mfma_f32_16x16x32_bf16(Bt[n][k], At[m][k], acc[ai][bj][m][n], 0, 0, 0); __builtin_amdgcn_s_setprio(0); } while (0)
#define GP_WAIT_V(n) asm volatile("s_waitcnt vmcnt(" #n ")" ::: "memory")
#define GP_WAIT_L(n) asm volatile("s_waitcnt lgkmcnt(" #n ")" ::: "memory")
#define GP_BAR __builtin_amdgcn_s_barrier()
#define GP_SCHED __builtin_amdgcn_sched_barrier(0)
    Unit cur, nxt; int ui = 0;
    if (!S.next(0, cur)) return;
    f32x4 acc[2][2][4][2];
#pragma unroll
    for (int a = 0; a < 2; ++a)
#pragma unroll
        for (int b = 0; b < 2; ++b)
#pragma unroll
            for (int m = 0; m < 4; ++m)
#pragma unroll
                for (int n = 0; n < 2; ++n) acc[a][b][m][n] = (f32x4){0.f, 0.f, 0.f, 0.f};
    bf16x8 At[4][2], B0[2][2], B1[2][2];
    if (GATHER) S.lane_off(cur, cvo);
    const char* cA = cur.A; const char* cB = cur.B;
    GP_STAGE_B(GP_SB(0, 0), cB, 0); GP_STAGE_A(GP_SA(0, 0), cA, 0, false); GP_STAGE_B(GP_SB(0, 1), cB, 1); GP_STAGE_A(GP_SA(0, 1), cA, 1, false);
    if (wr == 1) GP_BAR;
    GP_WAIT_V(4); GP_BAR;
    GP_STAGE_B(GP_SB(1, 0), cB + kstep, 0); GP_STAGE_A(GP_SA(1, 0), cA + kstep, 0, false); GP_STAGE_B(GP_SB(1, 1), cB + kstep, 1);
    GP_WAIT_V(6); GP_BAR;
    bool pend = false; Unit pu = cur; unsigned keep[4][2] = {{0u, 0u}, {0u, 0u}, {0u, 0u}, {0u, 0u}};
#define GP_ZQ(ai, bj) do { _Pragma("unroll") for (int m = 0; m < 4; ++m) _Pragma("unroll") for (int n = 0; n < 2; ++n) acc[ai][bj][m][n] = (f32x4){0.f, 0.f, 0.f, 0.f}; } while (0)
#define GP_EQ(ai, bj) do { if (pe) { const int l_ = olane(); E.quad(acc, pu, ai, bj, wr, wc, l_ & 15, l_ >> 4, keep); GP_ZQ(ai, bj); } } while (0)
    for (;;) {
        const bool has_next = S.next(ui + 1, nxt);
        const char* nA = has_next ? nxt.A : cA; const char* nB = has_next ? nxt.B : cB;
        for (int t = 0; t < nt; t += 2) {
            const bool last = (t == nt - 2);
            const bool un = last && has_next;
            const char* a1 = cA + (size_t)(t + 1) * kstep;
            const char* a2 = last ? nA : cA + (size_t)(t + 2) * kstep; const char* b2 = last ? nB : cB + (size_t)(t + 2) * kstep;
            const char* a3 = a2 + kstep; const char* b3 = b2 + kstep;
            const bool pe = DEFER && pend && (t == 0);
            GP_LDB(B0, 0, 0); GP_SCHED; GP_LDA(At, 0, 0); GP_STAGE_A(GP_SA(1, 1), a1, 1, false);
            GP_EQ(0, 0);
            GP_WAIT_L(8); GP_BAR; GP_WAIT_L(0); GP_MMA(0, 0, At, B0); GP_BAR; GP_SCHED;
            GP_LDB(B1, 0, 1); GP_STAGE_B(GP_SB(0, 0), b2, 0);
            if (GATHER && un) S.lane_off(nxt, cvo);
            GP_EQ(0, 1);
            GP_BAR; GP_WAIT_L(0); GP_MMA(0, 1, At, B1); GP_BAR;
            GP_LDA(At, 0, 1); GP_STAGE_A(GP_SA(0, 0), a2, 0, un);
            GP_EQ(1, 0);
            GP_BAR; GP_WAIT_L(0); GP_MMA(1, 0, At, B0); GP_BAR; GP_SCHED;
            GP_EQ(1, 1);
            GP_STAGE_B(GP_SB(0, 1), b2, 1);
            if (pe) { if (Epi::NSTQ == 12) GP_WAIT_V(18); else GP_WAIT_V(14); } else GP_WAIT_V(6);
            GP_BAR; GP_MMA(1, 1, At, B1); GP_BAR;
            GP_LDB(B0, 1, 0); GP_SCHED; GP_LDA(At, 1, 0); GP_STAGE_A(GP_SA(0, 1), a2, 1, un);
            GP_WAIT_L(8); GP_BAR; GP_WAIT_L(0); GP_MMA(0, 0, At, B0); GP_BAR; GP_SCHED;
            GP_LDB(B1, 1, 1); GP_STAGE_B(GP_SB(1, 0), b3, 0);
            GP_BAR; GP_WAIT_L(0); GP_MMA(0, 1, At, B1); GP_BAR;
            GP_LDA(At, 1, 1); GP_STAGE_A(GP_SA(1, 0), a3, 0, un);
            GP_BAR; GP_WAIT_L(0); GP_MMA(1, 0, At, B0); GP_BAR; GP_SCHED;
            GP_STAGE_B(GP_SB(1, 1), b3, 1);
            GP_WAIT_V(6); GP_BAR; GP_MMA(1, 1, At, B1); GP_BAR;
        }
        if (!has_next) { E(acc, cur, wr, wc, fr, fq); break; }
        if (DEFER) { pend = true; pu = cur; }
        else { E(acc, cur, wr, wc, fr, fq); GP_ZQ(0, 0); GP_ZQ(0, 1); GP_ZQ(1, 0); GP_ZQ(1, 1); }
        cur = nxt; cA = nA; cB = nB; ++ui;
    }
    GP_WAIT_V(0);
    if (wr == 0) GP_BAR;
    GP_BAR;
#undef GP_ZQ
#undef GP_EQ
#undef GP_SA
#undef GP_SB
#undef GP_GLDS
#undef GP_STAGE_A
#undef GP_STAGE_B
#undef GP_LDA
#undef GP_LDB
#undef GP_MMA
#undef GP_WAIT_V
#undef GP_WAIT_L
#undef GP_BAR
#undef GP_SCHED
}

struct EpiF32 {
    float* C; int ldc;
    static constexpr int NSTQ = 12;
    __device__ __forceinline__ void quad(const f32x4 (&)[2][2][4][2], const Unit&, int, int, int, int, int, int, unsigned (&)[4][2]) const {}
    __device__ __forceinline__ void operator()(const f32x4 (&acc)[2][2][4][2], const Unit& u, int wr, int wc, int fr, int fq) const {
        const int row0 = u.r0 + wr * 64 + fr, col0 = u.c0 + wc * 32 + 4 * fq;
#pragma unroll
        for (int ai = 0; ai < 2; ++ai)
#pragma unroll
            for (int m = 0; m < 4; ++m) { float* rowp = C + (size_t)(row0 + ai * HALF + m * 16) * ldc + col0;
#pragma unroll
                for (int bj = 0; bj < 2; ++bj)
#pragma unroll
                    for (int n = 0; n < 2; ++n) *(f32x4*)(rowp + bj * HALF + n * 16) = acc[ai][bj][m][n];
                __builtin_amdgcn_sched_barrier(0); }
    }
};
struct EpiBf16 {
    bf16_t* O; int ldc;
    static constexpr int NSTQ = 12;
    __device__ __forceinline__ void quad(const f32x4 (&acc)[2][2][4][2], const Unit& u, int ai, int bj, int wr, int wc, int fr, int fq, unsigned (&)[4][2]) const {
        const int row0 = u.r0 + wr * 64 + fr + ai * HALF, col0 = u.c0 + wc * 32 + 8 * fq + bj * HALF;
#pragma unroll
        for (int m = 0; m < 4; ++m) { const f32x4 v0 = acc[ai][bj][m][0], v1 = acc[ai][bj][m][1];
            u32x4 w; w.x = cvt_pk_bf16(v0[0], v0[1]); w.y = cvt_pk_bf16(v0[2], v0[3]); w.z = cvt_pk_bf16(v1[0], v1[1]); w.w = cvt_pk_bf16(v1[2], v1[3]);
            *(u32x4*)(O + (size_t)(row0 + m * 16) * ldc + col0) = w; }
    }
    __device__ __forceinline__ void operator()(const f32x4 (&acc)[2][2][4][2], const Unit& u, int wr, int wc, int fr, int fq) const {
        const int row0 = u.r0 + wr * 64 + fr, col0 = u.c0 + wc * 32 + 8 * fq;
#pragma unroll
        for (int ai = 0; ai < 2; ++ai)
#pragma unroll
            for (int m = 0; m < 4; ++m) { bf16_t* rowp = O + (size_t)(row0 + ai * HALF + m * 16) * ldc + col0;
#pragma unroll
                for (int bj = 0; bj < 2; ++bj) { const f32x4 v0 = acc[ai][bj][m][0], v1 = acc[ai][bj][m][1];
                    u32x4 w; w.x = cvt_pk_bf16(v0[0], v0[1]); w.y = cvt_pk_bf16(v0[2], v0[3]); w.z = cvt_pk_bf16(v1[0], v1[1]); w.w = cvt_pk_bf16(v1[2], v1[3]);
                    *(u32x4*)(rowp + bj * HALF) = w; }
                __builtin_amdgcn_sched_barrier(0); }
    }
};
}


typedef float f32x4_l __attribute__((ext_vector_type(4)));
__device__ __forceinline__ void stage_gate_w(KP p, int e, LAS float* wl) {
    const int tid = opaque_tid();
    const float* wg = p->in[I_EWIN] + (size_t)e * 1024 * EVEN_N + 1536;
#pragma unroll
    for (int i = 0; i < 8; ++i) { const int idx = tid + 512 * i, d = idx >> 2, j4 = idx & 3; const float4 w = *(const float4*)(wg + (size_t)d * EVEN_N + j4 * 4); *(LAS f32x4_l*)(wl + d * 16 + j4 * 4) = (f32x4_l){w.x, w.y, w.z, w.w}; }
    __syncthreads();
}
template <bool FIRST>
__device__ __forceinline__ void ph_modin(KP p, int l, int bid, int nb) {
    const int tid = opaque_tid(), lane = tid & 63, wv = tid >> 6;
    const bool even = (l & 1) == 0;
    bf16_t* U = (bf16_t*)(p->ws + OFF_U);
    float* G = (float*)(p->ws + OFF_G);
    LAS float* wl = (LAS float*)smraw_base();
    if (even) stage_gate_w(p, l >> 1, wl);
    #pragma unroll 1
    for (int tok = bid * 8 + wv; tok < NT; tok += nb * 8) {
        bf16_t* hw = hrow(p, tok);
        const float* h = (tok < NL ? p->in[I_X] + (size_t)tok * DM : p->in[I_CTX] + (size_t)(tok - NL) * DM);
        static_assert(FIRST, "ph_modin is layer 0's only");
        const float* m = modrow(p, l, tok);
        float ga[16];
#pragma unroll
        for (int j = 0; j < 16; ++j) ga[j] = 0.f;
#pragma unroll
        for (int c = 0; c < 4; ++c) {
            const int d = 4 * (lane + 64 * c);
            const float4 hv = *(const float4*)(h + d), sh = *(const float4*)(m + d), sc = *(const float4*)(m + 1024 + d);
            *(uint2*)(hw + d) = make_uint2(cvt_pk_bf16(hv.x, hv.y), cvt_pk_bf16(hv.z, hv.w));
            const float u0 = hv.x * (1.f + sc.x) + sh.x, u1 = hv.y * (1.f + sc.y) + sh.y, u2 = hv.z * (1.f + sc.z) + sh.z, u3 = hv.w * (1.f + sc.w) + sh.w;
            *(uint2*)(U + (size_t)tok * DM + d) = make_uint2(cvt_pk_bf16(u0, u1), cvt_pk_bf16(u2, u3));
            if (even) {
                const float uu[4] = {u0, u1, u2, u3};
#pragma unroll
                for (int q = 0; q < 4; ++q) {
#pragma unroll
                    for (int j4 = 0; j4 < 4; ++j4) { const f32x4_l w = *(const LAS f32x4_l*)(wl + (d + q) * 16 + j4 * 4); ga[4 * j4] += uu[q] * w[0]; ga[4 * j4 + 1] += uu[q] * w[1]; ga[4 * j4 + 2] += uu[q] * w[2]; ga[4 * j4 + 3] += uu[q] * w[3]; }
                }
                __builtin_amdgcn_sched_barrier(0);
            }
        }
        if (even) {
            float mine = 0.f;
#pragma unroll
            for (int j = 0; j < 16; ++j) { const float s = wave_sum(ga[j]); if (lane == j) mine = s; }
            if (lane < 16) G[(size_t)tok * 16 + lane] = mine;
        }
    }
}

__device__ __forceinline__ void ph_gemm_in(KP p, int l, int bid, int nb, LAS unsigned char* lds) {
    const int N = ((l & 1) == 0) ? EVEN_LD : ODD_LD;
    gp::DenseSched S; S.init(p->ws + OFF_U, p->ws + OFF_WIN, NT, N, 1024, nb, bid);
    gp::EpiBf16 E{(bf16_t*)(p->ws + OFF_BIG), N};
    gp::gemm_phase<false, true, true>(lds, 1024, S, E);
}
__device__ __forceinline__ void ph_gemm_out(KP p, int l, int bid, int nb, LAS unsigned char* lds) {
    gp::DenseSched S; S.init(p->ws + OFF_U, p->ws + OFF_WOUT, (l == 3) ? NL : NT, 1024, 1024, nb, bid);
    gp::EpiBf16 E{(bf16_t*)(p->ws + OFF_BIG), 1024};
    gp::gemm_phase<false, true, true>(lds, 1024, S, E);
}


namespace sc {
typedef short bf16x8 __attribute__((ext_vector_type(8)));
typedef short bf16x4 __attribute__((ext_vector_type(4)));
typedef float f32x4 __attribute__((ext_vector_type(4)));
#define SC_MFMA(a, b, c) __builtin_amdgcn_mfma_f32_16x16x32_bf16(a, b, c, 0, 0, 0)
__device__ __forceinline__ bf16x8 rd_row(unsigned img, int row, int stride, int k0) { return *(const LAS bf16x8*)(size_t)(img + (unsigned)(row * stride + k0 * 2)); }
__device__ __forceinline__ bf16x8 rd_tr(unsigned img, int k0, int n0, int stride, int lane) {
    const int g = lane >> 4, i = lane & 15;
    const unsigned a0 = img + (unsigned)((k0 + 8 * g + (i >> 2)) * stride + (n0 + 4 * (i & 3)) * 2), a1 = a0 + 4u * (unsigned)stride;
    bf16x4 lo, hi;
    asm volatile("ds_read_b64_tr_b16 %0, %2\n\tds_read_b64_tr_b16 %1, %3\n\ts_waitcnt lgkmcnt(0)" : "=&v"(lo), "=&v"(hi) : "v"(a0), "v"(a1) : "memory");
    return (bf16x8){lo[0], lo[1], lo[2], lo[3], hi[0], hi[1], hi[2], hi[3]};
}
typedef unsigned u32x2_ __attribute__((ext_vector_type(2)));
typedef unsigned u32x4_ __attribute__((ext_vector_type(4)));
__device__ __forceinline__ unsigned tr_addr(unsigned img, int k0, int n0, int stride, int lane) { const int g = lane >> 4, i = lane & 15; return img + (unsigned)((k0 + 8 * g + (i >> 2)) * stride + (n0 + 4 * (i & 3)) * 2); }
__device__ __forceinline__ void rd_tr5(const unsigned (&a0)[5], const unsigned (&s4)[5], bf16x8 (&o)[5]) {
    bf16x4 l0, h0, l1, h1, l2, h2, l3, h3, l4, h4;
    asm volatile("ds_read_b64_tr_b16 %0, %10\n\tds_read_b64_tr_b16 %1, %11\n\tds_read_b64_tr_b16 %2, %12\n\tds_read_b64_tr_b16 %3, %13\n\tds_read_b64_tr_b16 %4, %14\n\t"
                 "ds_read_b64_tr_b16 %5, %15\n\tds_read_b64_tr_b16 %6, %16\n\tds_read_b64_tr_b16 %7, %17\n\tds_read_b64_tr_b16 %8, %18\n\tds_read_b64_tr_b16 %9, %19\n\ts_waitcnt lgkmcnt(0)"
                 : "=&v"(l0), "=&v"(h0), "=&v"(l1), "=&v"(h1), "=&v"(l2), "=&v"(h2), "=&v"(l3), "=&v"(h3), "=&v"(l4), "=&v"(h4)
                 : "v"(a0[0]), "v"(a0[0] + s4[0]), "v"(a0[1]), "v"(a0[1] + s4[1]), "v"(a0[2]), "v"(a0[2] + s4[2]), "v"(a0[3]), "v"(a0[3] + s4[3]), "v"(a0[4]), "v"(a0[4] + s4[4]) : "memory");
    o[0] = (bf16x8){l0[0], l0[1], l0[2], l0[3], h0[0], h0[1], h0[2], h0[3]}; o[1] = (bf16x8){l1[0], l1[1], l1[2], l1[3], h1[0], h1[1], h1[2], h1[3]};
    o[2] = (bf16x8){l2[0], l2[1], l2[2], l2[3], h2[0], h2[1], h2[2], h2[3]}; o[3] = (bf16x8){l3[0], l3[1], l3[2], l3[3], h3[0], h3[1], h3[2], h3[3]};
    o[4] = (bf16x8){l4[0], l4[1], l4[2], l4[3], h4[0], h4[1], h4[2], h4[3]};
}
__device__ __forceinline__ void st8(unsigned addr, uint2 v) { *(LAS u32x2_*)(size_t)addr = (u32x2_){v.x, v.y}; }
__device__ __forceinline__ void st16(unsigned addr, uint4 v) { *(LAS u32x4_*)(size_t)addr = (u32x4_){v.x, v.y, v.z, v.w}; }
#define SC_DPP(v, ident, ctrl, rmask) __builtin_bit_cast(float, __builtin_amdgcn_update_dpp(__builtin_bit_cast(int, (float)(ident)), __builtin_bit_cast(int, v), ctrl, rmask, 0xf, false))
__device__ __forceinline__ float scan_add64(float v, int) {
    v += SC_DPP(v, 0.f, 0x111, 0xf); v += SC_DPP(v, 0.f, 0x112, 0xf); v += SC_DPP(v, 0.f, 0x114, 0xf); v += SC_DPP(v, 0.f, 0x118, 0xf);
    v += SC_DPP(v, 0.f, 0x142, 0xa); v += SC_DPP(v, 0.f, 0x143, 0xc);
    return v;
}
__device__ __forceinline__ float scan_max64(float v, int) {
    const float ni = -__builtin_inff();
    v = fmaxf(v, SC_DPP(v, ni, 0x111, 0xf)); v = fmaxf(v, SC_DPP(v, ni, 0x112, 0xf)); v = fmaxf(v, SC_DPP(v, ni, 0x114, 0xf)); v = fmaxf(v, SC_DPP(v, ni, 0x118, 0xf));
    v = fmaxf(v, SC_DPP(v, ni, 0x142, 0xa)); v = fmaxf(v, SC_DPP(v, ni, 0x143, 0xc));
    return v;
}

template <int MODE>
__device__ __forceinline__ void scan_item(KP p, int l, int b, int h, int dir, int vs) {
    constexpr int CS = (MODE == 1) ? 32 : 64, DK = (MODE == 0) ? 64 : 128, EXT = (MODE == 0) ? 1 : 0;
    constexpr int QS = (DK + 8) * 2, VS = (64 + 16 * EXT + 8) * 2, SS = (CS + 8) * 2, NVR = 64 + 16 * EXT;
    constexpr int NCH = (CTXL + SEQ) / CS;
    constexpr int LD = (MODE == 2) ? ODD_LD : EVEN_LD;
    constexpr unsigned O_QA = 0, O_KA = O_QA + CS * QS, O_QB = O_KA + CS * QS, O_KW = O_QB + (MODE == 1 ? CS * QS : 0), O_V = O_KW + CS * QS,
                       O_SSC = O_V + CS * VS, O_ST = O_SSC + CS * SS, O_DKV = O_ST + 2 * NVR * QS, O_END = O_DKV + 512;
    static_assert(O_END <= 131072, "scan LDS");
    const int tid = opaque_tid(), lane = tid & 63, wv = __builtin_amdgcn_readfirstlane(tid >> 6), r16 = lane & 15, q4 = lane >> 4;
    const unsigned L0 = (unsigned)(size_t)smraw_base();
    const bf16_t* P = (const bf16_t*)(p->ws + OFF_BIG);
    bf16_t* HXo = (bf16_t*)(p->ws + OFF_AUX) + (size_t)dir * NT * 1024;
    const int e2 = l >> 1;
    const int cQ = (MODE == 0) ? E_MQ + h * 64 : (MODE == 1) ? E_HQ + h * 128 : 1536 + h * 128;
    const int cK = (MODE == 0) ? E_MK + h * 64 : (MODE == 1) ? (dir ? E_HFB : E_HFF) + h * 128 : 2048 + h * 128;
    const int cV = (MODE == 0) ? E_MV + h * 128 + vs * 64 : (MODE == 1) ? E_HI + h * 128 + vs * 64 : 2560 + h * 128 + vs * 64;
    const int cO = (MODE == 0) ? h * 128 + vs * 64 : 512 + h * 128 + vs * 64;
    const int lt = (MODE == 1) ? (tid & 31) : (tid >> 3);
    const int lj = (MODE == 0) ? (tid & 7) : (MODE == 1) ? (tid >> 5) : ((tid >> 2) & 1) * 8 + (tid & 3);
    const int vt_ = tid >> 3, vj = tid & 7;
    float lbv[8]; float gbi = 0.f, gbf = 0.f, lg = 0.f;
    if (MODE == 1) {
        const float* lbp = (const float*)(p->ws + OFF_LB) + e2 * 512 + h * 128 + lj * 8;
#pragma unroll
        for (int i = 0; i < 8; ++i) lbv[i] = lbp[i];
    } else {
#pragma unroll
        for (int i = 0; i < 8; ++i) lbv[i] = 0.f;
    }
    if (MODE == 0) { const float* gb = p->in[I_MGB] + e2 * 16; gbi = gb[(dir ? 2 : 0) * 4 + h]; gbf = gb[(dir ? 3 : 1) * 4 + h]; }
    if (MODE == 2) lg = p->in[I_RLD][e2 * 8 + dir * 4 + h];
    const float* G = (const float*)(p->ws + OFF_G);
    const float* ropet = (const float*)(p->ws + OFF_ROPE);
    unsigned oz = 0u; asm volatile("" : "+v"(oz));
    for (unsigned o = tid * 16; o < 2u * NVR * QS; o += 512 * 16) st16(L0 + O_ST + o, make_uint4(oz, oz, oz, oz));
    if (EXT) { if (tid < CS) { st16(L0 + O_V + tid * VS + 128, make_uint4(0x3f80u | oz, oz, oz, oz)); st16(L0 + O_V + tid * VS + 144, make_uint4(oz, oz, oz, oz)); } }
    f32x4 sacc[4];
#pragma unroll
    for (int i = 0; i < 4; ++i) sacc[i] = (f32x4){0.f, 0.f, 0.f, 0.f};
    float m_in = -1e30f;
    struct Raw { uint4 rq0, rq1, rk0, rk1, rv; float rg0, rg1; };
    Raw RA, RB;
    RA.rq1 = make_uint4(0u, 0u, 0u, 0u); RA.rk1 = RA.rq1; RA.rv = RA.rq1; RA.rg0 = 0.f; RA.rg1 = 0.f; RB = RA;
    auto load_chunk = [&](Raw& R, int c) {
        const int i0 = c * CS;
        const int tq = scan_tok(b, i0 + lt, dir);
        const bf16_t* pr = P + (size_t)tq * LD;
        R.rq0 = *(const uint4*)(pr + cQ + lj * 8); R.rk0 = *(const uint4*)(pr + cK + lj * 8);
        if (MODE == 2) { R.rq1 = *(const uint4*)(pr + cQ + lj * 8 + 32); R.rk1 = *(const uint4*)(pr + cK + lj * 8 + 32); }
        if (MODE != 1 || tid < 256) { const int tv = scan_tok(b, i0 + vt_, dir); R.rv = *(const uint4*)(P + (size_t)tv * LD + cV + vj * 8); }
        if (MODE == 0) { const int tg = scan_tok(b, i0 + lane, dir); R.rg0 = G[(size_t)tg * 16 + (dir ? 8 : 0) + h]; R.rg1 = G[(size_t)tg * 16 + (dir ? 12 : 4) + h]; }
    };
    constexpr int PD = (MODE == 2) ? 1 : 2;
    load_chunk(RA, 0); if (PD == 2) load_chunk(RB, 1);
    auto chunk = [&](const int c, Raw& R) {
        const uint4 rq0 = R.rq0, rq1 = R.rq1, rk0 = R.rk0, rk1 = R.rk1, rv = R.rv; const float rg0 = R.rg0, rg1 = R.rg1;
        const unsigned ST_R = L0 + O_ST + (unsigned)(c & 1) * NVR * QS, ST_W = L0 + O_ST + (unsigned)((c + 1) & 1) * NVR * QS;
        float sp = 1.f;
        float v_u = 0.f, v_M = 0.f, v_e = 1.f, v_low = 0.f, v_w = 1.f;
        if (MODE == 0) {
            const float ig = rg0 + gbi, fg = rg1 + gbf;
            const float lf = fminf(fg, 0.f) - flog(1.f + fexp(-fabsf(fg)));
            const float bb = scan_add64(lf, lane);
            const float g = SHI(bb, 63);
            v_u = ig - bb;
            const float cu = scan_max64(v_u, lane);
            v_M = fmaxf(m_in, cu);
            const float m_new = fmaxf(g + m_in, g + SHI(cu, 63));
            sp = fexp(g + m_in - m_new);
            v_w = fexp(g + v_u - m_new);
            v_e = fexp(m_in - v_M);
            v_low = fexp(-(bb + v_M));
            m_in = m_new;
            st16(L0 + O_QA + lt * QS + lj * 16, rq0);
            st16(L0 + O_KA + lt * QS + lj * 16, rk0);
            const float wr = SHI(v_w, lt);
            uint4 kw; kw.x = cvt_pk_bf16(bflo(rk0.x) * wr, bfhi(rk0.x) * wr); kw.y = cvt_pk_bf16(bflo(rk0.y) * wr, bfhi(rk0.y) * wr);
            kw.z = cvt_pk_bf16(bflo(rk0.z) * wr, bfhi(rk0.z) * wr); kw.w = cvt_pk_bf16(bflo(rk0.w) * wr, bfhi(rk0.w) * wr);
            st16(L0 + O_KW + lt * QS + lj * 16, kw);
            st16(L0 + O_V + vt_ * VS + vj * 16, rv);
        } else if (MODE == 2) {
            sp = fexp(64.f * lg);
            const bool lat = c >= CTXL / CS;
            float q[16], k[16];
            const unsigned qa[8] = {rq0.x, rq0.y, rq0.z, rq0.w, rq1.x, rq1.y, rq1.z, rq1.w}, ka[8] = {rk0.x, rk0.y, rk0.z, rk0.w, rk1.x, rk1.y, rk1.z, rk1.w};
#pragma unroll
            for (int i = 0; i < 8; ++i) { q[2 * i] = bflo(qa[i]); q[2 * i + 1] = bfhi(qa[i]); k[2 * i] = bflo(ka[i]); k[2 * i + 1] = bfhi(ka[i]); }
            if (lat) {
                const int tq = scan_tok(b, c * CS + lt, dir), tt = tq & (SEQ - 1);
                const int pos = ((tid >> 2) & 1) ? (tt & 63) : (tt >> 6);
                const float2* rt = (const float2*)ropet + pos * 32 + (tid & 3) * 8;
#pragma unroll
                for (int i = 0; i < 8; ++i) {
                    const float2 cs2 = rt[i];
                    const float q1 = q[i], q2 = q[8 + i], k1 = k[i], k2 = k[8 + i];
                    q[i] = q1 * cs2.x - q2 * cs2.y; q[8 + i] = q1 * cs2.y + q2 * cs2.x;
                    k[i] = k1 * cs2.x - k2 * cs2.y; k[8 + i] = k1 * cs2.y + k2 * cs2.x;
                }
            }
            const float wr = 0.08838834764831845f * fexp((float)(63 - lt) * lg);
            uint4 o0, o1, w0, w1, x0, x1;
            o0.x = cvt_pk_bf16(q[0], q[1]); o0.y = cvt_pk_bf16(q[2], q[3]); o0.z = cvt_pk_bf16(q[4], q[5]); o0.w = cvt_pk_bf16(q[6], q[7]);
            o1.x = cvt_pk_bf16(q[8], q[9]); o1.y = cvt_pk_bf16(q[10], q[11]); o1.z = cvt_pk_bf16(q[12], q[13]); o1.w = cvt_pk_bf16(q[14], q[15]);
            w0.x = cvt_pk_bf16(k[0], k[1]); w0.y = cvt_pk_bf16(k[2], k[3]); w0.z = cvt_pk_bf16(k[4], k[5]); w0.w = cvt_pk_bf16(k[6], k[7]);
            w1.x = cvt_pk_bf16(k[8], k[9]); w1.y = cvt_pk_bf16(k[10], k[11]); w1.z = cvt_pk_bf16(k[12], k[13]); w1.w = cvt_pk_bf16(k[14], k[15]);
            x0.x = cvt_pk_bf16(k[0] * wr, k[1] * wr); x0.y = cvt_pk_bf16(k[2] * wr, k[3] * wr); x0.z = cvt_pk_bf16(k[4] * wr, k[5] * wr); x0.w = cvt_pk_bf16(k[6] * wr, k[7] * wr);
            x1.x = cvt_pk_bf16(k[8] * wr, k[9] * wr); x1.y = cvt_pk_bf16(k[10] * wr, k[11] * wr); x1.z = cvt_pk_bf16(k[12] * wr, k[13] * wr); x1.w = cvt_pk_bf16(k[14] * wr, k[15] * wr);
            st16(L0 + O_QA + lt * QS + lj * 16, o0); st16(L0 + O_QA + lt * QS + lj * 16 + 64, o1);
            st16(L0 + O_KA + lt * QS + lj * 16, w0); st16(L0 + O_KA + lt * QS + lj * 16 + 64, w1);
            st16(L0 + O_KW + lt * QS + lj * 16, x0); st16(L0 + O_KW + lt * QS + lj * 16 + 64, x1);
            st16(L0 + O_V + vt_ * VS + vj * 16, rv);
        } else {
            const unsigned qa[4] = {rq0.x, rq0.y, rq0.z, rq0.w}, fa[4] = {rk0.x, rk0.y, rk0.z, rk0.w};
            float qv[8], kk[8], A[8];
#pragma unroll
            for (int i = 0; i < 8; ++i) {
                const float qr = (i & 1) ? bfhi(qa[i >> 1]) : bflo(qa[i >> 1]), fr = (i & 1) ? bfhi(fa[i >> 1]) : bflo(fa[i >> 1]);
                const float f = lbv[i] + (1.f - lbv[i]) * fsigmoid(fr);
                qv[i] = fsilu(qr); kk[i] = 1.f - f; A[i] = flog(f);
            }
#pragma unroll
            for (int i = 0; i < 8; ++i) {
                int v = __builtin_bit_cast(int, A[i]);
                v = __builtin_bit_cast(int, __builtin_bit_cast(float, v) + __builtin_bit_cast(float, __builtin_amdgcn_update_dpp(0, v, 0x111, 0xf, 0xf, false)));
                v = __builtin_bit_cast(int, __builtin_bit_cast(float, v) + __builtin_bit_cast(float, __builtin_amdgcn_update_dpp(0, v, 0x112, 0xf, 0xf, false)));
                v = __builtin_bit_cast(int, __builtin_bit_cast(float, v) + __builtin_bit_cast(float, __builtin_amdgcn_update_dpp(0, v, 0x114, 0xf, 0xf, false)));
                v = __builtin_bit_cast(int, __builtin_bit_cast(float, v) + __builtin_bit_cast(float, __builtin_amdgcn_update_dpp(0, v, 0x118, 0xf, 0xf, false)));
                v = __builtin_bit_cast(int, __builtin_bit_cast(float, v) + __builtin_bit_cast(float, __builtin_amdgcn_update_dpp(0, v, 0x142, 0xa, 0xf, false)));
                A[i] = __builtin_bit_cast(float, v);
            }
            float qa_[8], qb_[8], ka_[8], kw_[8];
#pragma unroll
            for (int i = 0; i < 8; ++i) {
                const float am = SHI32(A[i], 15), ae = SHI32(A[i], 31);
                qa_[i] = qv[i] * fexp(A[i] - am); qb_[i] = qv[i] * fexp(A[i]); ka_[i] = kk[i] * fexp(am - A[i]); kw_[i] = kk[i] * fexp(ae - A[i]);
                if (lt == 31) *(LAS float*)(size_t)(L0 + O_DKV + (lj * 8 + i) * 4) = fexp(ae);
            }
            uint4 w;
            w.x = cvt_pk_bf16(qa_[0], qa_[1]); w.y = cvt_pk_bf16(qa_[2], qa_[3]); w.z = cvt_pk_bf16(qa_[4], qa_[5]); w.w = cvt_pk_bf16(qa_[6], qa_[7]); st16(L0 + O_QA + lt * QS + lj * 16, w);
            w.x = cvt_pk_bf16(qb_[0], qb_[1]); w.y = cvt_pk_bf16(qb_[2], qb_[3]); w.z = cvt_pk_bf16(qb_[4], qb_[5]); w.w = cvt_pk_bf16(qb_[6], qb_[7]); st16(L0 + O_QB + lt * QS + lj * 16, w);
            w.x = cvt_pk_bf16(ka_[0], ka_[1]); w.y = cvt_pk_bf16(ka_[2], ka_[3]); w.z = cvt_pk_bf16(ka_[4], ka_[5]); w.w = cvt_pk_bf16(ka_[6], ka_[7]); st16(L0 + O_KA + lt * QS + lj * 16, w);
            w.x = cvt_pk_bf16(kw_[0], kw_[1]); w.y = cvt_pk_bf16(kw_[2], kw_[3]); w.z = cvt_pk_bf16(kw_[4], kw_[5]); w.w = cvt_pk_bf16(kw_[6], kw_[7]); st16(L0 + O_KW + lt * QS + lj * 16, w);
            if (tid < 256) st16(L0 + O_V + vt_ * VS + vj * 16, rv);
        }
        __syncthreads();
        if (c + PD < NCH) load_chunk(R, c + PD);
        {
            constexpr int NT1 = CS / 16;
            const bool act = (MODE == 1) ? (wv < 4) : true;
            const int tb = (MODE == 1) ? (wv & 1) : (wv & 3);
#pragma unroll
            for (int u2 = 0; u2 < ((MODE == 1) ? 1 : 2); ++u2) {
                const int sb = (MODE == 1) ? (wv >> 1) : 2 * (wv >> 2) + u2;
                if (act) {
                    f32x4 d = (f32x4){0.f, 0.f, 0.f, 0.f};
                    if (sb <= tb) {
#pragma unroll
                        for (int kk2 = 0; kk2 < DK / 32; ++kk2)
                            d = SC_MFMA(rd_row(L0 + O_KA, sb * 16 + r16, QS, kk2 * 32 + q4 * 8), rd_row(L0 + O_QA, tb * 16 + r16, QS, kk2 * 32 + q4 * 8), d);
                        const int t = tb * 16 + r16, s0 = sb * 16 + q4 * 4;
                        if (MODE == 0) {
                            const float Mt = SHI(v_M, t);
#pragma unroll
                            for (int jj = 0; jj < 4; ++jj) { const float us = SHI(v_u, s0 + jj); d[jj] = (s0 + jj <= t) ? d[jj] * 0.125f * fexp(us - Mt) : 0.f; }
                        } else if (MODE == 2) {
#pragma unroll
                            for (int jj = 0; jj < 4; ++jj) d[jj] = (s0 + jj <= t) ? d[jj] * 0.08838834764831845f * fexp((float)(t - s0 - jj) * lg) : 0.f;
                        } else {
#pragma unroll
                            for (int jj = 0; jj < 4; ++jj) d[jj] = (s0 + jj <= t) ? d[jj] : 0.f;
                        }
                    }
                    st8(L0 + O_SSC + (tb * 16 + r16) * SS + (sb * 16 + q4 * 4) * 2, make_uint2(cvt_pk_bf16(d[0], d[1]), cvt_pk_bf16(d[2], d[3])));
                }
            }
            (void)NT1;
        }
        __syncthreads();
        {
            const int tb = (MODE == 1) ? (wv & 1) : (wv & 3);
            const int t = tb * 16 + r16;
            const int tok = scan_tok(b, c * CS + t, dir);
            constexpr int NV = (MODE == 1) ? 1 : 2;
            f32x4 oi[NV + EXT], oo[NV + EXT];
#pragma unroll
            for (int u2 = 0; u2 < NV + EXT; ++u2) {
                const int vt = (u2 == NV) ? 4 : ((MODE == 1) ? (wv >> 1) : 2 * (wv >> 2) + u2);
                f32x4 a1 = (f32x4){0.f, 0.f, 0.f, 0.f}, a2 = a1;
#pragma unroll
                for (int sb2 = 0; sb2 < CS / 32; ++sb2)
                    a1 = SC_MFMA(rd_tr(L0 + O_V, sb2 * 32, vt * 16, VS, lane), rd_row(L0 + O_SSC, t, SS, sb2 * 32 + q4 * 8), a1);
#pragma unroll
                for (int kk2 = 0; kk2 < DK / 32; ++kk2)
                    a2 = SC_MFMA(rd_row(ST_R, vt * 16 + r16, QS, kk2 * 32 + q4 * 8), rd_row(L0 + ((MODE == 1) ? O_QB : O_QA), t, QS, kk2 * 32 + q4 * 8), a2);
                oi[u2] = a1; oo[u2] = a2;
            }
            float den = 1.f, ei = 1.f;
            if (MODE == 0) {
                ei = 0.125f * SHI(v_e, t);
                const float dsum = oi[NV][0] + ei * oo[NV][0];
                const float dd = SHI(dsum, r16);
                den = frcp(fmaxf(fabsf(dd), SHI(v_low, t)));
            } else if (MODE == 2) {
                ei = fexp((float)(t + 1) * lg);
            }
#pragma unroll
            for (int u2 = 0; u2 < NV; ++u2) {
                const int vt = (MODE == 1) ? (wv >> 1) : 2 * (wv >> 2) + u2;
                float o[4];
#pragma unroll
                for (int jj = 0; jj < 4; ++jj) o[jj] = (oi[u2][jj] + ei * oo[u2][jj]) * den;
                *(uint2*)(HXo + (size_t)tok * 1024 + cO + vt * 16 + q4 * 4) = make_uint2(cvt_pk_bf16(o[0], o[1]), cvt_pk_bf16(o[2], o[3]));
            }
        }
        {
            constexpr int NS = (MODE == 0) ? 3 : 4;
            const int kt = (MODE == 0) ? (wv & 3) : wv;
            float dk[4] = {sp, sp, sp, sp};
            if (MODE == 1) { const f32x4 dv = *(const LAS f32x4*)(size_t)(L0 + O_DKV + (kt * 16 + q4 * 4) * 4); dk[0] = dv[0]; dk[1] = dv[1]; dk[2] = dv[2]; dk[3] = dv[3]; }
            f32x4 a[NS];
#pragma unroll
            for (int u2 = 0; u2 < NS; ++u2) { a[u2] = sacc[u2];
#pragma unroll
                for (int jj = 0; jj < 4; ++jj) a[u2][jj] *= dk[jj]; }
#pragma unroll
            for (int sb2 = 0; sb2 < CS / 32; ++sb2) {
                unsigned ta[5], ts[5]; bf16x8 ops[5];
                ta[0] = tr_addr(L0 + O_KW, sb2 * 32, kt * 16, QS, lane); ts[0] = 4u * QS;
#pragma unroll
                for (int u2 = 0; u2 < 4; ++u2) {
                    const int vt = (MODE == 0) ? ((u2 >= 2) ? 4 : 2 * (wv >> 2) + u2) : u2;
                    ta[1 + u2] = tr_addr(L0 + O_V, sb2 * 32, vt * 16, VS, lane); ts[1 + u2] = 4u * VS;
                }
                rd_tr5(ta, ts, ops);
#pragma unroll
                for (int u2 = 0; u2 < NS; ++u2) a[u2] = SC_MFMA(ops[0], ops[1 + u2], a[u2]);
            }
#pragma unroll
            for (int u2 = 0; u2 < NS; ++u2) {
                const int vt = (MODE == 0) ? ((u2 == 2) ? 4 : 2 * (wv >> 2) + u2) : u2;
                sacc[u2] = a[u2];
                st8(ST_W + (vt * 16 + r16) * QS + (kt * 16 + q4 * 4) * 2, make_uint2(cvt_pk_bf16(a[u2][0], a[u2][1]), cvt_pk_bf16(a[u2][2], a[u2][3])));
            }
        }
        __syncthreads();
    };
#pragma unroll 1
    for (int c = 0; c < NCH; c += 2) { chunk(c, RA); if (PD == 2) chunk(c + 1, RB); else chunk(c + 1, RA); }
}

}

__device__ __forceinline__ void ph_hy_filt2(KP p, int l, int bid, int nb, float* sm, int skip);
__device__ __forceinline__ void ph_scan_even2(KP p, int l, int bid, int nb, float* sm) {
#pragma unroll 1
    for (int item = bid; item < 256; item += nb) {
        const int kind = item >> 7, b = (item >> 4) & 7, h = (item >> 2) & 3, dir = (item >> 1) & 1, vs = item & 1;
        if (kind == 0) sc::scan_item<0>(p, l, b, h, dir, vs); else sc::scan_item<1>(p, l, b, h, dir, vs);
        __syncthreads();
    }
    if (bid < 128) { ph_hy_filt2(p, l + 1, bid, 128, sm, 0); __syncthreads(); ph_convert(p, l + 1, bid, 128, sm, 1); }
}
__device__ __forceinline__ void ph_scan_odd2(KP p, int l, int bid, int nb) {
#pragma unroll 1
    for (int item = bid; item < 128; item += nb) {
        const int b = (item >> 4) & 7, h = (item >> 2) & 3, dir = (item >> 1) & 1, vs = item & 1;
        sc::scan_item<2>(p, l, b, h, dir, vs);
        __syncthreads();
    }
}

__device__ __forceinline__ void unpack16(const uint4 a, const uint4 b, float (&x)[16]) {
    x[0] = bflo(a.x); x[1] = bfhi(a.x); x[2] = bflo(a.y); x[3] = bfhi(a.y); x[4] = bflo(a.z); x[5] = bfhi(a.z); x[6] = bflo(a.w); x[7] = bfhi(a.w);
    x[8] = bflo(b.x); x[9] = bfhi(b.x); x[10] = bflo(b.y); x[11] = bfhi(b.y); x[12] = bflo(b.z); x[13] = bfhi(b.z); x[14] = bflo(b.w); x[15] = bfhi(b.w);
}
__device__ __forceinline__ float sum8(float v) { v += WS_DPP(v, 0xB1, 0xf); v += WS_DPP(v, 0x4E, 0xf); v += WS_DPP(v, 0x141, 0xf); return v; }
struct Hng6 { uint4 a0, a1, b0, b1, g0, g1; };
__device__ __forceinline__ Hng6 hng_load(const bf16_t* h0, const bf16_t* h1, const bf16_t* gp) {
    Hng6 r; r.a0 = *(const uint4*)h0; r.a1 = *(const uint4*)(h0 + 8); r.b0 = *(const uint4*)h1; r.b1 = *(const uint4*)(h1 + 8); r.g0 = *(const uint4*)gp; r.g1 = *(const uint4*)(gp + 8); return r;
}
template <bool MEANSUB, bool SIG>
__device__ __forceinline__ void hng_compute(const Hng6& in, const float* nw, bf16_t* out) {
    float a[16], b[16], g[16];
    unpack16(in.a0, in.a1, a); unpack16(in.b0, in.b1, b); unpack16(in.g0, in.g1, g);
    float s = 0.f;
#pragma unroll
    for (int i = 0; i < 16; ++i) { a[i] += b[i]; s += a[i]; }
    if (MEANSUB) { const float mean = sum8(s) * (1.f / 128.f);
#pragma unroll
        for (int i = 0; i < 16; ++i) a[i] -= mean; }
    float q = 0.f;
#pragma unroll
    for (int i = 0; i < 16; ++i) q += a[i] * a[i];
    const float r = rsqrtf(sum8(q) * (1.f / 128.f) + LN_EPS);
    unsigned w[8];
#pragma unroll
    for (int i = 0; i < 16; i += 2) {
        const float y0 = a[i] * r * nw[i] * (SIG ? fsigmoid(g[i]) : fsilu(g[i])), y1 = a[i + 1] * r * nw[i + 1] * (SIG ? fsigmoid(g[i + 1]) : fsilu(g[i + 1]));
        w[i >> 1] = cvt_pk_bf16(y0, y1);
    }
    *(uint4*)out = make_uint4(w[0], w[1], w[2], w[3]); *(uint4*)(out + 8) = make_uint4(w[4], w[5], w[6], w[7]);
}
__device__ __forceinline__ void ph_normgate_even(KP p, int l, int bid, int nb) {
    const int tid = opaque_tid(), lane = tid & 63, wv = tid >> 6;
    const bf16_t* P = (const bf16_t*)(p->ws + OFF_BIG);
    const bf16_t* HX = (const bf16_t*)(p->ws + OFF_AUX);
    const bf16_t* HX1 = HX + (size_t)NT * 1024;
    bf16_t* MIX = (bf16_t*)(p->ws + OFF_U);
    const int e = l >> 1;
    const bool ml = lane < 32;
    const float* nw = ml ? p->in[I_MNW] + e * 512 + 16 * lane : p->in[I_HNW] + e * 512 + 16 * (lane - 32);
    const int gcol = ml ? E_MO + 16 * lane : E_HG + 16 * (lane - 32);
    int tok = bid * 8 + wv;
    Hng6 nx = hng_load(HX + (size_t)tok * 1024 + 16 * lane, HX1 + (size_t)tok * 1024 + 16 * lane, P + (size_t)tok * EVEN_LD + gcol);
#pragma unroll 1
    for (; tok < NT; tok += nb * 8) {
        const Hng6 cur = nx;
        const int tn = tok + nb * 8;
        const int tc = tn < NT ? tn : tok;
        nx = hng_load(HX + (size_t)tc * 1024 + 16 * lane, HX1 + (size_t)tc * 1024 + 16 * lane, P + (size_t)tc * EVEN_LD + gcol);
        bf16_t* o = MIX + (size_t)tok * 1024 + 16 * lane;
        if (ml) hng_compute<true, true>(cur, nw, o); else hng_compute<false, false>(cur, nw, o);
    }
}

#define OFF_UT   (OFF_AUX + 136 * MiB)
#define OFF_FKS(o) (984 * MiB + (size_t)(o) * 34 * MiB)
#define OFF_ZOT  (OFF_UT + 102 * MiB)

__device__ __forceinline__ void ph_hy_filt2(KP p, int l, int bid, int nb, float* sm, int skip) {
    const int tid = opaque_tid(), o = l >> 1;
    float* zf = sm;
    float* h1 = sm + 1024;
    float* h2 = sm + 2048;
    float* h3 = sm + 3072;
    const float* fw1 = p->in[I_HW1] + o * 33 * 64; const float* fb1 = p->in[I_HB1] + o * 64;
    const float* fw2 = p->in[I_HW2] + o * 64 * 64; const float* fb2 = p->in[I_HB2] + o * 64;
    const float* fw3 = p->in[I_HW3] + o * 64 * 64; const float* fb3 = p->in[I_HB3] + o * 64;
    const float* freq = p->in[I_HFREQ] + o * 64;
    const float* wout = p->in[I_HWOUT] + (size_t)o * 64 * 2048;
    float* FK = (float*)(p->ws + OFF_FKS(o)); float* FKC = FK + (size_t)2 * 512 * 8192;
#pragma unroll 1
    for (int item = bid - skip; item < (SEQ + CTXL) / 16; item += nb - skip) {
        if (item < 0) break;
        const bool isctx = item >= SEQ / 16;
        const int L = isctx ? CTXL : SEQ, pos0 = (isctx ? item - SEQ / 16 : item) * 16;
        __syncthreads();
        if (tid < 16 * 17) {
            const int pp = tid / 17, j = tid % 17, pos = pos0 + pp;
            if (j == 16) zf[pp * 36] = (float)pos / (float)(L - 1);
            else { const float f = 1e-4f + (float)j * ((15.0f - 1e-4f) / 15.0f); const float w = 2.0f * 3.14159265358979323846f * (float)pos / (float)L * f; zf[pp * 36 + 1 + j] = cosf(w); zf[pp * 36 + 17 + j] = sinf(w); }
        }
        __syncthreads();
        const int pp = tid >> 5, u0 = (tid & 31) * 2;
        { float a0 = fb1[u0], a1 = fb1[u0 + 1];
#pragma unroll 1
          for (int k = 0; k < 33; ++k) { const float z = zf[pp * 36 + k]; a0 += z * fw1[k * 64 + u0]; a1 += z * fw1[k * 64 + u0 + 1]; }
          h1[pp * 64 + u0] = sinf(freq[u0] * a0); h1[pp * 64 + u0 + 1] = sinf(freq[u0 + 1] * a1); }
        __syncthreads();
        { float a0 = fb2[u0], a1 = fb2[u0 + 1];
#pragma unroll 4
          for (int k = 0; k < 64; ++k) { const float z = h1[pp * 64 + k]; a0 += z * fw2[k * 64 + u0]; a1 += z * fw2[k * 64 + u0 + 1]; }
          h2[pp * 64 + u0] = sinf(freq[u0] * a0); h2[pp * 64 + u0 + 1] = sinf(freq[u0 + 1] * a1); }
        __syncthreads();
        { float a0 = fb3[u0], a1 = fb3[u0 + 1];
#pragma unroll 4
          for (int k = 0; k < 64; ++k) { const float z = h2[pp * 64 + k]; a0 += z * fw3[k * 64 + u0]; a1 += z * fw3[k * 64 + u0 + 1]; }
          h3[pp * 64 + u0] = sinf(freq[u0] * a0); h3[pp * 64 + u0 + 1] = sinf(freq[u0 + 1] * a1); }
        __syncthreads();
#pragma unroll 1
        for (int r = 0; r < 4; ++r) {
            const int col = tid + 512 * r, c = col & 511, od = col >> 9, order = od >> 1, dirn = od & 1;
            float a[16];
#pragma unroll
            for (int i = 0; i < 16; ++i) a[i] = 0.f;
#pragma unroll 1
            for (int k = 0; k < 64; k += 4) { const float w0 = wout[k * 2048 + col], w1 = wout[(k + 1) * 2048 + col], w2 = wout[(k + 2) * 2048 + col], w3 = wout[(k + 3) * 2048 + col];
#pragma unroll
                for (int i = 0; i < 16; ++i) { const float4 hh = *(const float4*)(h3 + i * 64 + k); a[i] += hh.x * w0 + hh.y * w1 + hh.z * w2 + hh.w * w3; } }
            const float delta = 3.0701134573253944f + (float)c * ((15.350567286626972f - 3.0701134573253944f) / 511.0f);
#pragma unroll
            for (int i = 0; i < 16; ++i) a[i] *= expf(-((float)(pos0 + i) / (float)(L - 1)) * delta);
            float* dst = isctx ? FKC + ((size_t)order * 512 + c) * 512 + 256 : FK + ((size_t)order * 512 + c) * 8192 + 4096;
            if (dirn == 0) {
#pragma unroll
                for (int i = 0; i < 16; i += 4) *(float4*)(dst + pos0 + i) = make_float4(a[i], a[i + 1], a[i + 2], a[i + 3]);
            } else {
#pragma unroll
                for (int i = 0; i < 16; ++i) if (pos0 + i > 0) dst[-(pos0 + i)] = a[i];
                if (pos0 == 0) dst[-L] = 0.f;
            }
        }
    }
}

__device__ __forceinline__ void ph_hy_prep(KP p, int l, int bid, int nb, float* sm) {
    const int tid = opaque_tid(), o = l >> 1;
    const bf16_t* P = (const bf16_t*)(p->ws + OFF_BIG);
    bf16_t* UT = (bf16_t*)(p->ws + OFF_UT);
    const float* cw = p->in[I_HCW] + o * 3 * 1536; const float* cb = p->in[I_HCB] + o * 1536;
    float* tile = sm;
    const int ntk = (l == 3) ? NL : NT;
#pragma unroll 1
    for (int item = bid; item < (ntk / 256) * 24; item += nb) {
        const int tt = item / 24, ct = item % 24, tok0 = tt * 256, col0 = ct * 64;
        const bool lat = tok0 < NL;
        const int L = lat ? SEQ : CTXL, t0 = lat ? (tok0 & (SEQ - 1)) : ((tok0 - NL) & (CTXL - 1));
        __syncthreads();
#pragma unroll 1
        for (int i = tid; i < 258 * 8; i += 512) {
            const int rr = i >> 3, hf = i & 7, t = t0 + rr - 1;
            uint4 v = make_uint4(0u, 0u, 0u, 0u);
            if (t >= 0 && t < L) v = *(const uint4*)(P + (size_t)(tok0 + rr - 1) * ODD_LD + col0 + hf * 8);
            float* d = tile + rr * 65 + hf * 8;
            d[0] = bflo(v.x); d[1] = bfhi(v.x); d[2] = bflo(v.y); d[3] = bfhi(v.y); d[4] = bflo(v.z); d[5] = bfhi(v.z); d[6] = bflo(v.w); d[7] = bfhi(v.w);
        }
        __syncthreads();
#pragma unroll 1
        for (int r = 0; r < 4; ++r) {
            const int cc = (tid >> 5) + 16 * r, tc = (tid & 31) * 8, col = col0 + cc;
            const float w0 = cw[col], w1 = cw[1536 + col], w2 = cw[3072 + col], bb = cb[col];
            float y[8];
#pragma unroll
            for (int i = 0; i < 8; ++i) y[i] = tile[(tc + i) * 65 + cc] * w0 + tile[(tc + i + 1) * 65 + cc] * w1 + tile[(tc + i + 2) * 65 + cc] * w2 + bb;
            *(uint4*)(UT + (size_t)col * NT + tok0 + tc) = make_uint4(cvt_pk_bf16(y[0], y[1]), cvt_pk_bf16(y[2], y[3]), cvt_pk_bf16(y[4], y[5]), cvt_pk_bf16(y[6], y[7]));
        }
    }
}

__device__ __forceinline__ void hy_item_lat(KP p, int l, int c) {
    constexpr int ZSB = (SEQ + 8) * 2;
    constexpr unsigned O_Z = 0, O_PE = O_Z + 8 * ZSB, O_PO = O_PE + 4096 * 4, O_END = O_PO + 4096 * 4;
    static_assert(O_END <= BAR_LDS_, "hyena LDS");
    const int tid = opaque_tid(), lane = tid & 63, wv = __builtin_amdgcn_readfirstlane(tid >> 6), r16 = lane & 15, q4 = lane >> 4, o = l >> 1;
    const unsigned L0 = (unsigned)(size_t)smraw_base();
    const bf16_t* UT = (const bf16_t*)(p->ws + OFF_UT);
    bf16_t* ZOT = (bf16_t*)(p->ws + OFF_ZOT);
    const float* FK = (const float*)(p->ws + OFF_FKS(o));
    for (int i = tid; i < 8 * 512; i += 512) { const int b = i >> 9, ch = i & 511; sc::st16(L0 + O_Z + b * ZSB + ch * 16, *(const uint4*)(UT + (size_t)(1024 + c) * NT + b * SEQ + ch * 8)); }
#pragma unroll 1
    for (int order = 0; order < 2; ++order) {
        const float* fk = FK + ((size_t)order * 512 + c) * 8192;
        for (int i = tid; i < 4096; i += 512) {
            const float r0 = (i > 0) ? fk[8192 - 2 * i] : 0.f, r1 = fk[8191 - 2 * i], r2 = (i < 4095) ? fk[8190 - 2 * i] : 0.f;
            *(LAS unsigned*)(size_t)(L0 + O_PE + i * 4) = cvt_pk_bf16(r0, r1); *(LAS unsigned*)(size_t)(L0 + O_PO + i * 4) = cvt_pk_bf16(r1, r2);
        }
        __syncthreads();
        sc::f32x4 acc[4][4];
#pragma unroll
        for (int a = 0; a < 4; ++a)
#pragma unroll
            for (int b2 = 0; b2 < 4; ++b2) acc[a][b2] = (sc::f32x4){0.f, 0.f, 0.f, 0.f};
        const unsigned gbase = L0 + ((r16 & 1) ? O_PO : O_PE) + (unsigned)(((4096 - r16 + 8 * q4 - (r16 & 1)) >> 1) * 4);
        auto ldG = [&](int g) {
            const unsigned a0 = gbase - (unsigned)(32 * g);
            const unsigned w0 = *(const LAS unsigned*)(size_t)a0, w1 = *(const LAS unsigned*)(size_t)(a0 + 4), w2 = *(const LAS unsigned*)(size_t)(a0 + 8), w3 = *(const LAS unsigned*)(size_t)(a0 + 12);
            return __builtin_bit_cast(sc::bf16x8, (sc::u32x4_){w0, w1, w2, w3});
        };
        sc::bf16x8 bq[4][2], W[6];
#pragma unroll
        for (int i = 0; i < 4; ++i) { bq[i][0] = (sc::bf16x8){0, 0, 0, 0, 0, 0, 0, 0}; bq[i][1] = bq[i][0]; }
        const int D0 = 8 * wv - 63, D1 = (8 * wv + 7 < 63) ? 8 * wv + 7 : 63;
        W[4] = ldG(4 * D0 - 6 + 4); W[5] = ldG(4 * D0 - 6 + 5);
#pragma unroll 1
        for (int D = D0; D <= D1; ++D) {
            W[0] = W[4]; W[1] = W[5];
#pragma unroll
            for (int i = 0; i < 4; ++i) W[2 + i] = ldG(4 * D + i);
            bq[3][0] = bq[2][0]; bq[3][1] = bq[2][1]; bq[2][0] = bq[1][0]; bq[2][1] = bq[1][1]; bq[1][0] = bq[0][0]; bq[1][1] = bq[0][1];
            {
                const int s1 = 8 * wv - D + ((r16 < 8) ? 0 : 4);
                const bool ok = (unsigned)s1 < 64u;
                const unsigned za = L0 + O_Z + (unsigned)((r16 & 7) * ZSB + ((ok ? s1 : 0) * 64 + q4 * 8) * 2);
                sc::bf16x8 b0 = *(const LAS sc::bf16x8*)(size_t)za, b1 = *(const LAS sc::bf16x8*)(size_t)(za + 64);
                if (!ok) { b0 = (sc::bf16x8){0, 0, 0, 0, 0, 0, 0, 0}; b1 = b0; }
                bq[0][0] = b0; bq[0][1] = b1;
            }
#pragma unroll
            for (int cg = 0; cg < 4; ++cg) {
                const int sA = 8 * wv + cg - D;
                if ((unsigned)sA < 64u || (unsigned)(sA + 4) < 64u) {
#pragma unroll
                    for (int it = 0; it < 4; ++it) { acc[cg][it] = SC_MFMA(W[it + 2], bq[cg][0], acc[cg][it]); acc[cg][it] = SC_MFMA(W[it], bq[cg][1], acc[cg][it]); }
                }
            }
        }
        __syncthreads();
        const float sk = p->in[I_HSKIP][o * 1024 + order * 512 + c];
        const bf16_t* gt = UT + (size_t)(order * 512 + c) * NT;
        const int bb = r16 & 7;
#pragma unroll
        for (int cg = 0; cg < 4; ++cg) {
            const int t1 = 8 * wv + cg + ((r16 < 8) ? 0 : 4);
#pragma unroll
            for (int it = 0; it < 4; ++it) {
                const int t = t1 * 64 + it * 16 + q4 * 4;
                const sc::u32x2_ zo_ = *(const LAS sc::u32x2_*)(size_t)(L0 + O_Z + bb * ZSB + t * 2); const uint2 zo = make_uint2(zo_[0], zo_[1]);
                const uint2 gv = *(const uint2*)(gt + bb * SEQ + t);
                const float y0 = bflo(gv.x) * (acc[cg][it][0] + sk * bflo(zo.x)), y1 = bfhi(gv.x) * (acc[cg][it][1] + sk * bfhi(zo.x));
                const float y2 = bflo(gv.y) * (acc[cg][it][2] + sk * bflo(zo.y)), y3 = bfhi(gv.y) * (acc[cg][it][3] + sk * bfhi(zo.y));
                const uint2 w = make_uint2(cvt_pk_bf16(y0, y1), cvt_pk_bf16(y2, y3));
                if (order == 0) sc::st8(L0 + O_Z + bb * ZSB + t * 2, w);
                else *(uint2*)(ZOT + (size_t)c * NT + bb * SEQ + t) = w;
            }
        }
        __syncthreads();
    }
}

__device__ __forceinline__ void hy_item_ctx(KP p, int l, int c, float* sm) {
    const int tid = opaque_tid(), o = l >> 1;
    const bf16_t* UT = (const bf16_t*)(p->ws + OFF_UT);
    bf16_t* ZOT = (bf16_t*)(p->ws + OFF_ZOT);
    const float* FKC = (const float*)(p->ws + OFF_FKS(o)) + (size_t)2 * 512 * 8192;
    LAS float* Kc = (LAS float*)smraw_base();
    LAS float* zb = Kc + 1024;
    (void)sm;
    for (int i = tid; i < 1024; i += 512) Kc[i] = FKC[((size_t)(i >> 9) * 512 + c) * 512 + (i & 511)];
    for (int i = tid; i < 8 * CTXL; i += 512) zb[i] = bf2f(UT[(size_t)(1024 + c) * NT + NL + i]);
    __syncthreads();
    const int bb = tid >> 6, t0 = 4 * (tid & 63);
#pragma unroll 1
    for (int order = 0; order < 2; ++order) {
        float acc[4] = {0.f, 0.f, 0.f, 0.f};
        const LAS float* K = Kc + order * 512;
        f32x4_l hi = *(const LAS f32x4_l*)(K + t0 + 256);
#pragma unroll 4
        for (int m = 0; m < CTXL / 4; ++m) {
            const f32x4_l lo = *(const LAS f32x4_l*)(K + t0 + 252 - 4 * m);
            const f32x4_l z = *(const LAS f32x4_l*)(zb + bb * CTXL + 4 * m);
            acc[0] += hi[0] * z[0] + lo[3] * z[1] + lo[2] * z[2] + lo[1] * z[3];
            acc[1] += hi[1] * z[0] + hi[0] * z[1] + lo[3] * z[2] + lo[2] * z[3];
            acc[2] += hi[2] * z[0] + hi[1] * z[1] + hi[0] * z[2] + lo[3] * z[3];
            acc[3] += hi[3] * z[0] + hi[2] * z[1] + hi[1] * z[2] + hi[0] * z[3];
            hi = lo;
        }
        const float sk = p->in[I_HSKIP][o * 1024 + order * 512 + c];
        const uint2 g2 = *(const uint2*)(UT + (size_t)(order * 512 + c) * NT + NL + bb * CTXL + t0);
        const float gv[4] = {bflo(g2.x), bfhi(g2.x), bflo(g2.y), bfhi(g2.y)};
        const f32x4_l zc = *(const LAS f32x4_l*)(zb + bb * CTXL + t0);
        float zn[4];
#pragma unroll
        for (int j = 0; j < 4; ++j) zn[j] = gv[j] * (acc[j] + zc[j] * sk);
        __syncthreads();
        const unsigned w0 = cvt_pk_bf16(zn[0], zn[1]), w1 = cvt_pk_bf16(zn[2], zn[3]);
        if (order == 0) *(LAS f32x4_l*)(zb + bb * CTXL + t0) = (f32x4_l){bflo(w0), bfhi(w0), bflo(w1), bfhi(w1)};
        else *(uint2*)(ZOT + (size_t)c * NT + NL + bb * CTXL + t0) = make_uint2(w0, w1);
        __syncthreads();
    }
}

__device__ __forceinline__ void ph_mix_odd(KP p, int l, int bid, int nb, float* sm) {
    int* head = (int*)(p->ws + OFF_CNT) + 1024 + (l >> 1) * 64;
    LAS int* slot = (LAS int*)(smraw_base() + BAR_LDS_ + 64);
#pragma unroll 1
    for (;;) {
        if (opaque_tid() == 0) *slot = atomicAdd(head, 1);
        __syncthreads();
        const int item = *slot;
        __syncthreads();
        if (item >= 128 + 512) break;
        if (item < 128) { const int b = (item >> 4) & 7, h = (item >> 2) & 3, dir = (item >> 1) & 1, vs = item & 1; sc::scan_item<2>(p, l, b, h, dir, vs); }
        else { const int c = item - 128; hy_item_lat(p, l, c); __syncthreads(); if (l != 3) hy_item_ctx(p, l, c, sm); }
        __syncthreads();
    }
}

__device__ __forceinline__ void ph_hy_norm(KP p, int l, int bid, int nb, float* sm) {
    const int ntk = (l == 3) ? NL : NT;
    const int tid = opaque_tid(), o = l >> 1;
    const bf16_t* ZOT = (const bf16_t*)(p->ws + OFF_ZOT);
    bf16_t* MIX = (bf16_t*)(p->ws + OFF_U);
    const float* nw = p->in[I_HNORM] + o * 512;
    float* tile = sm;
    float* part = sm + 64 * 65;
#pragma unroll 1
    for (int item = bid; item < (ntk / 64) * 8; item += nb) {
        const int tt = item >> 3, g = item & 7, tok0 = tt * 64;
        __syncthreads();
        { const int cc = tid >> 3, ch = tid & 7;
          const uint4 v = *(const uint4*)(ZOT + (size_t)(g * 64 + cc) * NT + tok0 + ch * 8);
          float* d = tile + cc * 65 + ch * 8;
          d[0] = bflo(v.x); d[1] = bfhi(v.x); d[2] = bflo(v.y); d[3] = bfhi(v.y); d[4] = bflo(v.z); d[5] = bfhi(v.z); d[6] = bflo(v.w); d[7] = bfhi(v.w); }
        __syncthreads();
        { const int tk = tid & 63, pt = tid >> 6; float s = 0.f;
#pragma unroll
          for (int i = 0; i < 8; ++i) { const float x = tile[(pt * 8 + i) * 65 + tk]; s += x * x; }
          part[pt * 64 + tk] = s; }
        __syncthreads();
        { const int tk = tid >> 3, ch = tid & 7; float s = 0.f;
#pragma unroll
          for (int i = 0; i < 8; ++i) s += part[i * 64 + tk];
          const float rs = rsqrtf(s * (1.f / 64.f) + LN_EPS);
          float y[8];
#pragma unroll
          for (int i = 0; i < 8; ++i) y[i] = tile[(ch * 8 + i) * 65 + tk] * rs * nw[g * 64 + ch * 8 + i];
          *(uint4*)(MIX + (size_t)(tok0 + tk) * DM + g * 64 + ch * 8) = make_uint4(cvt_pk_bf16(y[0], y[1]), cvt_pk_bf16(y[2], y[3]), cvt_pk_bf16(y[4], y[5]), cvt_pk_bf16(y[6], y[7])); }
    }
}

__device__ __forceinline__ void ph_normgate_odd(KP p, int l, int bid, int nb) {
    const int ntk = (l == 3) ? NL : NT;
    const int tid = opaque_tid(), lane = tid & 63, wv = tid >> 6, o2 = l >> 1;
    const bf16_t* P = (const bf16_t*)(p->ws + OFF_BIG);
    const bf16_t* HX = (const bf16_t*)(p->ws + OFF_AUX);
    const bf16_t* HX1 = HX + (size_t)NT * 1024;
    bf16_t* MIX = (bf16_t*)(p->ws + OFF_U);
    const int c16 = 16 * (lane & 31);
    const float* nw = p->in[I_RNW] + o2 * 512 + c16;
    int t2 = bid * 8 + wv;
    auto ld = [&](int t2_) { const int tok = t2_ * 2 + (lane >> 5); const size_t o = (size_t)tok * 1024 + 512 + c16; return hng_load(HX + o, HX1 + o, P + (size_t)tok * ODD_LD + 3072 + c16); };
    Hng6 nx = ld(t2);
#pragma unroll 1
    for (; t2 < ntk / 2; t2 += nb * 8) {
        const Hng6 cur = nx;
        nx = ld(t2 + nb * 8 < ntk / 2 ? t2 + nb * 8 : t2);
        const int tok = t2 * 2 + (lane >> 5);
        hng_compute<true, false>(cur, nw, MIX + (size_t)tok * 1024 + 512 + c16);
    }
}

__device__ __forceinline__ void ph_ln1_router(KP p, int l, int ntok, int bid, int nb, float* sm) {
    constexpr int VP = (1024 + 8) * 2;
    constexpr unsigned O_VH = 0, O_VL = 32 * VP, O_LG = 64 * VP;
    static_assert(O_LG + 2 * 32 * 64 * 4 <= BAR_LDS_, "router LDS");
    const int tid = opaque_tid(), lane = tid & 63, wv = __builtin_amdgcn_readfirstlane(tid >> 6), r16 = lane & 15, q4 = lane >> 4;
    const unsigned L0 = (unsigned)(size_t)smraw_base();
    const bf16_t* Y = (const bf16_t*)(p->ws + OFF_BIG);
    bf16_t* U = (bf16_t*)(p->ws + OFF_U);
    const float* lw = p->in[I_LNW] + (l * 2) * 1024; const float* lb = p->in[I_LNB] + (l * 2) * 1024;
    const bf16_t* RWH = (const bf16_t*)(p->ws + OFF_RWH); const bf16_t* RWL = RWH + 64 * 1024;
    const float rb = p->in[I_RB][l * 64 + lane];
    LAS int* lcnt = (LAS int*)(smraw_base() + BAR_LDS_ + 256);
    if (tid < 64) lcnt[tid] = 0;
    __syncthreads();
    int* tidx = (int*)(p->ws + OFF_TIDX); float* tgate = (float*)(p->ws + OFF_TGATE); int* tpos = (int*)(p->ws + OFF_TPOS);
    {
        int* stok = (int*)(p->ws + OFF_STOK); float* sgate = (float*)(p->ws + OFF_SGATE); int* sdst = (int*)(p->ws + OFF_SDST);
#pragma unroll 1
        for (int i = bid * 512 + tid; i < MAXROWS; i += nb * 512) { stok[i] = ZROW; sgate[i] = 0.f; sdst[i] = NT * 9; }
    }
    const int nfr = (ntok >> 5) / nb, nsteps = nfr + (((ntok >> 5) % nb) ? 1 : 0);
    uint2 ph_[4][4]; uint2 pr_[4][4];
    auto step_geom = [&](int step, int& tpw, int& base) { const bool full = step < nfr; tpw = full ? 4 : 1; base = full ? (step * nb + bid) * 32 : nfr * nb * 32 + bid * 8; };
    auto preload = [&](int step) {
        int tpw, base; step_geom(step, tpw, base);
#pragma unroll
        for (int j = 0; j < 4; ++j) {
            if (j < tpw) {
                const int tok = base + wv * tpw + j;
                const bf16_t* h = hrow(p, tok); const bf16_t* r = Y + (size_t)tok * DM;
#pragma unroll
                for (int c = 0; c < 4; ++c) { const int d = 4 * (lane + 64 * c); ph_[j][c] = *(const uint2*)(h + d); pr_[j][c] = *(const uint2*)(r + d); }
            }
        }
    };
    preload(0);
#pragma unroll 1
    for (int step = 0; step < nsteps; ++step) {
        int tpw, base; step_geom(step, tpw, base);
        float4 cg[4], cw[4], cb[4], csh[4], csc[4];
        {
            const float* m = modrow(p, l, base);
#pragma unroll
            for (int c = 0; c < 4; ++c) { const int d = 4 * (lane + 64 * c);
                cg[c] = *(const float4*)(m + 2 * 1024 + d); cw[c] = *(const float4*)(lw + d); cb[c] = *(const float4*)(lb + d); csh[c] = *(const float4*)(m + 3 * 1024 + d); csc[c] = *(const float4*)(m + 4 * 1024 + d); }
        }
#pragma unroll
        for (int j = 0; j < 4; ++j) {
            if (j >= tpw) break;
            const int tl = wv * tpw + j, tok = base + tl;
            bf16_t* h = hrow(p, tok);
            float x[16]; float s = 0.f;
#pragma unroll
            for (int c = 0; c < 4; ++c) {
                const uint2 hw2 = ph_[j][c]; const float4 hv = make_float4(bflo(hw2.x), bfhi(hw2.x), bflo(hw2.y), bfhi(hw2.y)), gv = cg[c]; const uint2 rw2 = pr_[j][c];
                const float4 rv = make_float4(bflo(rw2.x), bfhi(rw2.x), bflo(rw2.y), bfhi(rw2.y));
                x[4 * c] = ALPHA * hv.x + gv.x * rv.x; x[4 * c + 1] = ALPHA * hv.y + gv.y * rv.y; x[4 * c + 2] = ALPHA * hv.z + gv.z * rv.z; x[4 * c + 3] = ALPHA * hv.w + gv.w * rv.w;
                s += x[4 * c] + x[4 * c + 1] + x[4 * c + 2] + x[4 * c + 3];
            }
            const float mean = wave_sum(s) * (1.f / 1024.f);
            float q = 0.f;
#pragma unroll
            for (int i = 0; i < 16; ++i) { x[i] -= mean; q += x[i] * x[i]; }
            const float rs = rsqrtf(wave_sum(q) * (1.f / 1024.f) + LN_EPS);
#pragma unroll
            for (int c = 0; c < 4; ++c) {
                const int d = 4 * (lane + 64 * c);
                const float4 w4 = cw[c], b4 = cb[c], sh = csh[c], sc = csc[c];
                float4 y; y.x = x[4 * c] * rs * w4.x + b4.x; y.y = x[4 * c + 1] * rs * w4.y + b4.y; y.z = x[4 * c + 2] * rs * w4.z + b4.z; y.w = x[4 * c + 3] * rs * w4.w + b4.w;
                *(uint2*)(h + d) = make_uint2(cvt_pk_bf16(y.x, y.y), cvt_pk_bf16(y.z, y.w));
                float4 v; v.x = y.x * (1.f + sc.x) + sh.x; v.y = y.y * (1.f + sc.y) + sh.y; v.z = y.z * (1.f + sc.z) + sh.z; v.w = y.w * (1.f + sc.w) + sh.w;
                const unsigned h0 = cvt_pk_bf16(v.x, v.y), h1 = cvt_pk_bf16(v.z, v.w);
                *(uint2*)(U + (size_t)tok * DM + d) = make_uint2(h0, h1);
                sc::st8(L0 + O_VH + tl * VP + d * 2, make_uint2(h0, h1));
                sc::st8(L0 + O_VL + tl * VP + d * 2, make_uint2(cvt_pk_bf16(v.x - bflo(h0), v.y - bfhi(h0)), cvt_pk_bf16(v.z - bflo(h1), v.w - bfhi(h1))));
            }
        }
        __syncthreads();
        {
            const int et = wv & 3, kh = wv >> 2;
            sc::f32x4 acc0 = (sc::f32x4){0.f, 0.f, 0.f, 0.f}, acc1 = acc0;
            const bf16_t* bh = RWH + (size_t)(et * 16 + r16) * 1024 + kh * 512 + q4 * 8; const bf16_t* bl = RWL + (size_t)(et * 16 + r16) * 1024 + kh * 512 + q4 * 8;
#pragma unroll 4
            for (int ks = 0; ks < 16; ++ks) {
                const int kk = kh * 512 + ks * 32 + q4 * 8;
                const sc::bf16x8 wh = *(const sc::bf16x8*)(bh + ks * 32), wl = *(const sc::bf16x8*)(bl + ks * 32);
                const sc::bf16x8 a0h = sc::rd_row(L0 + O_VH, r16, VP, kk), a0l = sc::rd_row(L0 + O_VL, r16, VP, kk);
                const sc::bf16x8 a1h = sc::rd_row(L0 + O_VH, 16 + r16, VP, kk), a1l = sc::rd_row(L0 + O_VL, 16 + r16, VP, kk);
                acc0 = SC_MFMA(a0h, wh, acc0); acc1 = SC_MFMA(a1h, wh, acc1); acc0 = SC_MFMA(a0h, wl, acc0); acc1 = SC_MFMA(a1h, wl, acc1); acc0 = SC_MFMA(a0l, wh, acc0); acc1 = SC_MFMA(a1l, wh, acc1);
            }
#pragma unroll
            for (int jj = 0; jj < 4; ++jj) {
                *(LAS float*)(size_t)(L0 + O_LG + kh * 8192 + ((q4 * 4 + jj) * 64 + et * 16 + r16) * 4) = acc0[jj];
                *(LAS float*)(size_t)(L0 + O_LG + kh * 8192 + ((16 + q4 * 4 + jj) * 64 + et * 16 + r16) * 4) = acc1[jj]; }
        }
        preload(step + 1 < nsteps ? step + 1 : step);
        __syncthreads();
#pragma unroll 1
        for (int j = 0; j < tpw; ++j) {
            const int tl = wv * tpw + j, tok = base + tl;
            const float lg = *(const LAS float*)(size_t)(L0 + O_LG + (tl * 64 + lane) * 4) + *(const LAS float*)(size_t)(L0 + O_LG + 8192 + (tl * 64 + lane) * 4);
            const float score = sigmoidf_(lg);
            const float key = score + rb;
            int rank = 64; float kk = key;
#pragma unroll
            for (int r = 0; r < TOPK; ++r) {
                float m = kk; const float ni = -__builtin_inff();
                m = fmaxf(m, WS_DPPI(m, ni, 0x111, 0xf)); m = fmaxf(m, WS_DPPI(m, ni, 0x112, 0xf)); m = fmaxf(m, WS_DPPI(m, ni, 0x114, 0xf)); m = fmaxf(m, WS_DPPI(m, ni, 0x118, 0xf));
                m = fmaxf(m, WS_DPPI(m, ni, 0x142, 0xa)); m = fmaxf(m, WS_DPPI(m, ni, 0x143, 0xc));
                const float mx = __builtin_bit_cast(float, __builtin_amdgcn_readlane(__builtin_bit_cast(int, m), 63));
                const unsigned long long bal = __builtin_amdgcn_ballot_w64(kk == mx);
                const int first = (int)__builtin_ctzll(bal);
                if (lane == first) { rank = r; kk = ni; }
            }
            const bool sel = rank < TOPK;
            const float gsum = wave_sum(sel ? score : 0.f);
            if (sel) {
                const int pos = __hip_atomic_fetch_add(lcnt + lane, 1, __ATOMIC_RELAXED, __HIP_MEMORY_SCOPE_WORKGROUP);
                tidx[tok * 8 + rank] = lane; tgate[tok * 8 + rank] = 2.5f * score / gsum; tpos[tok * 8 + rank] = pos;
            }
        }
        __syncthreads();
    }
    __syncthreads();
    if (tid < 64) ((int*)(p->ws + OFF_BCNT))[bid * 64 + tid] = lcnt[tid];
}

__device__ __forceinline__ void moe_offsets(KP p, int l, int ntok, LAS int* offs) {
    const int t = opaque_tid();
    if (t < 66) offs[t] = ((const int*)(p->ws + OFF_GOFFS))[t];
    __syncthreads();
}
__device__ __forceinline__ int moe_expert_of(const LAS int* offs, int row) { int e = 0;
#pragma unroll 1
    while (e < 64 && row >= offs[e + 1]) ++e;
    return e; }

__device__ __forceinline__ void ph_scatter(KP p, int l, int ntok, int bid, int nb, LAS unsigned char* lds) {
    LAS int* offs = (LAS int*)lds;
    LAS int* myb = offs + 128;
    LAS int* part = offs + 256;
    const int tid = opaque_tid();
    const int* bcnt = (const int*)(p->ws + OFF_BCNT);
    { const int e = tid & 63, pt = tid >> 6; int tot = 0, mine = 0;
#pragma unroll 4
      for (int b = pt; b < nb; b += 8) { const int c = bcnt[b * 64 + e]; tot += c; mine += (b < bid) ? c : 0; }
      part[pt * 64 + e] = tot; part[512 + pt * 64 + e] = mine; }
    __syncthreads();
    if (tid < 64) {
        int tot = 0, mine = 0;
#pragma unroll
        for (int i = 0; i < 8; ++i) { tot += part[i * 64 + tid]; mine += part[512 + i * 64 + tid]; }
        const int pc = (tot + 255) & ~255;
        int incl = pc;
#pragma unroll
        for (int o = 1; o < 64; o <<= 1) { const int t = SHU(incl, o); if (tid >= o) incl += t; }
        offs[tid] = incl - pc; myb[tid] = mine;
        if (tid == 63) { offs[64] = incl; offs[65] = incl + ntok; }
    }
    __syncthreads();
    if (bid == 0 && tid < 66) ((int*)(p->ws + OFF_GOFFS))[tid] = offs[tid];
    const int* tidx = (const int*)(p->ws + OFF_TIDX); const float* tgate = (const float*)(p->ws + OFF_TGATE); const int* tpos = (const int*)(p->ws + OFF_TPOS);
    int* stok = (int*)(p->ws + OFF_STOK); float* sgate = (float*)(p->ws + OFF_SGATE); int* sdst = (int*)(p->ws + OFF_SDST);
    int* tile_e = (int*)(p->ws + OFF_TILEE);
    const int nfr = (ntok >> 5) / nb, nsteps = nfr + (((ntok >> 5) % nb) ? 1 : 0);
#pragma unroll 1
    for (int step = 0; step < nsteps; ++step) {
        const bool full = step < nfr;
        const int ntk = full ? 32 : 8, base = full ? (step * nb + bid) * 32 : nfr * nb * 32 + bid * 8;
        if (tid < ntk * 9) {
            const int tok = base + tid / 9, sl = tid % 9;
            if (sl < 8) { const int i = tok * 8 + sl, e = tidx[i], row = offs[e] + myb[e] + tpos[i]; stok[row] = tok; sgate[row] = tgate[i]; sdst[row] = tok * 9 + sl; }
            else { const int row = offs[64] + tok; stok[row] = tok; sgate[row] = 1.f; sdst[row] = tok * 9 + 8; }
        }
    }
    const int nrt = offs[65] >> 8;
#pragma unroll 1
    for (int rt = bid * 512 + tid; rt < nrt; rt += nb * 512) tile_e[rt] = moe_expert_of(offs, rt * 256);
    __syncthreads();
}

#define MOE_TAB (gp::STAGE_BYTES + 256)
#define MOE_MAXT 9
static_assert(131072 + 256 + 256 + MOE_MAXT * 2048 <= BAR_LDS_, "MoE tables");
struct MoeDeal {
    int nfull, rem, c, G;
    __device__ __forceinline__ void init(int nrt, int c_, int G_) { nfull = nrt / G_; rem = nrt % G_; c = ((c_ & 7) << 5) | (c_ >> 3); G = G_; }
    __device__ __forceinline__ int nleft(int NPN) const { const int tot = rem * NPN; return c < tot ? (tot - c + G - 1) / G : 0; }
    __device__ __forceinline__ int ntiles(int NPN) const { return nfull + nleft(NPN); }
    __device__ __forceinline__ int tile_of(int j, int NPN) const { return j < nfull ? c + j * G : nfull * G + (c + (j - nfull) * G) / NPN; }
    __device__ __forceinline__ bool unit(int i, int NPN, int& j, int& pn) const {
        if (i < nfull * NPN) { j = i / NPN; pn = i % NPN; return true; }
        const int k = i - nfull * NPN, lu = c + k * G;
        if (lu < rem * NPN) { j = nfull + k; pn = lu % NPN; return true; }
        return false;
    }
};
struct Moe1Sched {
    const char* U; const char* W; const LAS int* tabE; const LAS int* tabS; MoeDeal d;
    __device__ __forceinline__ bool next(int i, gp::Unit& u) const {
        int j, pn; if (!d.unit(i, 2, j, pn)) return false;
        u.A = U; u.B = W + (size_t)__builtin_amdgcn_readfirstlane(tabE[j]) * (512 * 1024 * 2) + (size_t)pn * (256 * 1024 * 2); u.r0 = d.tile_of(j, 2) * 256; u.c0 = pn * 256; u.aux = j; return true;
    }
    __device__ __forceinline__ void lane_off(const gp::Unit& u, unsigned (&vo)[2][2]) const {
        const int tid = opaque_tid(); int R0, C0, R1, C1; gp::stage_rc(tid * 16, R0, C0); gp::stage_rc(tid * 16 + 8192, R1, C1);
        const LAS int* t = tabS + u.aux * 256;
        vo[0][0] = (unsigned)t[R0] * 2048u + (unsigned)C0 * 2u; vo[0][1] = (unsigned)t[R1] * 2048u + (unsigned)C1 * 2u;
        vo[1][0] = (unsigned)t[128 + R0] * 2048u + (unsigned)C0 * 2u; vo[1][1] = (unsigned)t[128 + R1] * 2048u + (unsigned)C1 * 2u;
    }
};
struct EpiH {
    bf16_t* H;
    static constexpr int NSTQ = 12;
    __device__ __forceinline__ void quad(const gp::f32x4 (&acc)[2][2][4][2], const gp::Unit& u, int ai, int bj, int wr, int wc, int fr, int fq, unsigned (&)[4][2]) const {
        const int row0 = u.r0 + wr * 64 + fr + ai * 128, j0 = ((u.c0 + bj * 128 + wc * 32) >> 5) * 16 + 4 * fq;
#pragma unroll
        for (int m = 0; m < 4; ++m) {
            const gp::f32x4 a = acc[ai][bj][m][0], b = acc[ai][bj][m][1];
            const float h0 = fsilu(a[0]) * b[0], h1 = fsilu(a[1]) * b[1], h2 = fsilu(a[2]) * b[2], h3 = fsilu(a[3]) * b[3];
            *(uint2*)(H + (size_t)(row0 + m * 16) * 256 + j0) = make_uint2(cvt_pk_bf16(h0, h1), cvt_pk_bf16(h2, h3)); }
    }
    __device__ __forceinline__ void operator()(const gp::f32x4 (&acc)[2][2][4][2], const gp::Unit& u, int wr, int wc, int fr, int fq) const {
        const int row0 = u.r0 + wr * 64 + fr;
#pragma unroll
        for (int ai = 0; ai < 2; ++ai)
#pragma unroll
            for (int m = 0; m < 4; ++m) { bf16_t* rowp = H + (size_t)(row0 + ai * 128 + m * 16) * 256;
#pragma unroll
                for (int bj = 0; bj < 2; ++bj) {
                    const int j0 = ((u.c0 + bj * 128 + wc * 32) >> 5) * 16 + 4 * fq;
                    const gp::f32x4 a = acc[ai][bj][m][0], b = acc[ai][bj][m][1];
                    const float h0 = fsilu(a[0]) * b[0], h1 = fsilu(a[1]) * b[1], h2 = fsilu(a[2]) * b[2], h3 = fsilu(a[3]) * b[3];
                    *(uint2*)(rowp + j0) = make_uint2(cvt_pk_bf16(h0, h1), cvt_pk_bf16(h2, h3)); }
                __builtin_amdgcn_sched_barrier(0); }
    }
};
__device__ __forceinline__ void ph_moe1(KP p, int l, int ntok, int bid, int nb, LAS unsigned char* lds) {
    LAS int* tabE = (LAS int*)(lds + MOE_TAB);
    LAS int* tabS = tabE + 64;
    const int tid = opaque_tid();
    MoeDeal d; d.init(((const int*)(p->ws + OFF_GOFFS))[65] >> 8, bid, nb);
    const int nper = d.ntiles(2);
    const int* stok = (const int*)(p->ws + OFF_STOK); const int* tile_e = (const int*)(p->ws + OFF_TILEE);
    for (int i = tid; i < nper * 256; i += 512) tabS[i] = stok[(size_t)d.tile_of(i >> 8, 2) * 256 + (i & 255)];
    if (tid < nper) tabE[tid] = tile_e[d.tile_of(tid, 2)];
    __syncthreads();
    Moe1Sched S{(const char*)(p->ws + OFF_U), (const char*)(p->ws + OFF_W13L(l)), tabE, tabS, d};
    EpiH E{(bf16_t*)(p->ws + OFF_BIG)};
    gp::gemm_phase<true, false, true>(lds, 1024, S, E);
}

struct Moe2Sched {
    const char* H; const char* W; const LAS int* tabE; MoeDeal d;
    __device__ __forceinline__ bool next(int i, gp::Unit& u) const {
        int j, pn; if (!d.unit(i, 4, j, pn)) return false;
        u.A = H + (size_t)d.tile_of(j, 4) * (256 * 256 * 2); u.B = W + (size_t)__builtin_amdgcn_readfirstlane(tabE[j]) * (1024 * 256 * 2) + (size_t)pn * (256 * 256 * 2); u.r0 = j * 256; u.c0 = pn * 256; u.aux = j; return true;
    }
    __device__ __forceinline__ void lane_off(const gp::Unit&, unsigned (&)[2][2]) const {}
};
__device__ __forceinline__ unsigned pk_fp8x4(float a, float b, float c, float d) { int w = __builtin_amdgcn_cvt_pk_fp8_f32(a, b, 0, false); w = __builtin_amdgcn_cvt_pk_fp8_f32(c, d, w, true); return (unsigned)w; }
struct EpiY {
    unsigned char* Ys; const LAS int* tabD; const LAS float* tabG;
    static constexpr int NSTQ = 8;
    __device__ __forceinline__ void quad(const gp::f32x4 (&acc)[2][2][4][2], const gp::Unit& u, int ai, int bj, int wr, int wc, int fr, int fq, unsigned (&keep)[4][2]) const {
        const int rl0 = u.r0 + wr * 64 + fr + ai * 128, pos0 = u.c0 + wc * 64 + 16 * fq;
#pragma unroll
        for (int m = 0; m < 4; ++m) {
            const float g = tabG[rl0 + m * 16];
            const gp::f32x4 v0 = acc[ai][bj][m][0] * g, v1 = acc[ai][bj][m][1] * g;
            const unsigned p0 = pk_fp8x4(v0[0], v0[1], v0[2], v0[3]), p1 = pk_fp8x4(v1[0], v1[1], v1[2], v1[3]);
            if (bj == 0) { keep[m][0] = p0; keep[m][1] = p1; }
            else *(gp::u32x4*)(Ys + (size_t)tabD[rl0 + m * 16] * 1024 + pos0) = (gp::u32x4){keep[m][0], keep[m][1], p0, p1};
        }
    }
    __device__ __forceinline__ void operator()(const gp::f32x4 (&acc)[2][2][4][2], const gp::Unit& u, int wr, int wc, int fr, int fq) const {
        const int rl0 = u.r0 + wr * 64 + fr, pos0 = u.c0 + wc * 64 + 16 * fq;
#pragma unroll
        for (int ai = 0; ai < 2; ++ai)
#pragma unroll
            for (int m = 0; m < 4; ++m) {
                const int rl = rl0 + ai * 128 + m * 16;
                const int dst = tabD[rl]; const float g = tabG[rl];
                const gp::f32x4 a0 = acc[ai][0][m][0] * g, a1 = acc[ai][0][m][1] * g, b0 = acc[ai][1][m][0] * g, b1 = acc[ai][1][m][1] * g;
                *(gp::u32x4*)(Ys + (size_t)dst * 1024 + pos0) = (gp::u32x4){pk_fp8x4(a0[0], a0[1], a0[2], a0[3]), pk_fp8x4(a1[0], a1[1], a1[2], a1[3]), pk_fp8x4(b0[0], b0[1], b0[2], b0[3]), pk_fp8x4(b1[0], b1[1], b1[2], b1[3])};
                __builtin_amdgcn_sched_barrier(0); }
    }
};
__device__ __forceinline__ void ph_moe2(KP p, int l, int ntok, int bid, int nb, LAS unsigned char* lds) {
    LAS int* tabE = (LAS int*)(lds + MOE_TAB);
    LAS int* tabD = tabE + 64;
    LAS float* tabG = (LAS float*)(tabD + MOE_MAXT * 256);
    const int tid = opaque_tid();
    MoeDeal d; d.init(((const int*)(p->ws + OFF_GOFFS))[65] >> 8, bid, nb);
    const int nper = d.ntiles(4);
    const int* sdst = (const int*)(p->ws + OFF_SDST); const float* sgate = (const float*)(p->ws + OFF_SGATE); const int* tile_e = (const int*)(p->ws + OFF_TILEE);
    for (int i = tid; i < nper * 256; i += 512) { const size_t r = (size_t)d.tile_of(i >> 8, 4) * 256 + (i & 255); tabD[i] = sdst[r]; tabG[i] = sgate[r]; }
    if (tid < nper) tabE[tid] = tile_e[d.tile_of(tid, 4)];
    __syncthreads();
    Moe2Sched S{(const char*)(p->ws + OFF_BIG), (const char*)(p->ws + OFF_W2), tabE, d};
    EpiY E{(unsigned char*)(p->ws + OFF_YS), tabD, tabG};
    gp::gemm_phase<false, true, true>(lds, 256, S, E);
}

template <bool NEXT>
__device__ __forceinline__ void ph_combine_ln2(KP p, int l, int ntok, int bid, int nb) {
    bf16_t* U = (bf16_t*)(p->ws + OFF_U);
    float* G = (float*)(p->ws + OFF_G);
    const bool gates = NEXT && ((l + 1) & 1) == 0;
    LAS float* wl = (LAS float*)smraw_base();
    if (gates) stage_gate_w(p, (l + 1) >> 1, wl);
    const int tid = opaque_tid(), lane = tid & 63, wv = tid >> 6;
    const int cA = 256 * (lane >> 4) + 32 * ((lane >> 2) & 3) + 8 * (lane & 3);
    const unsigned char* Ys = (const unsigned char*)(p->ws + OFF_YS);
    const float* lw = p->in[I_LNW] + (l * 2 + 1) * 1024; const float* lb = p->in[I_LNB] + (l * 2 + 1) * 1024;
    uint4 yq[9]; uint4 hq[2];
    auto preload = [&](int tok) {
#pragma unroll
        for (int s9 = 0; s9 < 9; ++s9) yq[s9] = *(const uint4*)(Ys + ((size_t)tok * 9 + s9) * 1024 + 16 * lane);
        const bf16_t* h = hrow(p, tok);
        hq[0] = *(const uint4*)(h + cA); hq[1] = *(const uint4*)(h + cA + 128);
    };
    const int tpw = ntok >> 11, t0 = (bid * 8 + wv) * tpw;
    float4 cg[4], cw[4], cb[4], csh[4], csc[4];
    int rcur = -1;
    preload(t0);
#pragma unroll 1
    for (int k = 0; k < tpw; ++k) {
        const int tok = t0 + k;
        bf16_t* h = hrow(p, tok);
        const int rr = tok < NL ? (tok >> 12) : 8;
        if (rr != rcur) {
            rcur = rr;
            const float* m = modrow(p, l, tok);
            const float* m2 = modrow(p, NEXT ? l + 1 : l, tok);
#pragma unroll
            for (int q = 0; q < 4; ++q) {
                const int c = cA + (q >> 1) * 128 + (q & 1) * 4;
                cg[q] = *(const float4*)(m + 5 * 1024 + c); cw[q] = *(const float4*)(lw + c); cb[q] = *(const float4*)(lb + c);
                if (NEXT) { csh[q] = *(const float4*)(m2 + c); csc[q] = *(const float4*)(m2 + 1024 + c); }
            }
        }
        float f[16];
#pragma unroll
        for (int i = 0; i < 16; ++i) f[i] = 0.f;
#pragma unroll
        for (int s9 = 0; s9 < 9; ++s9) {
            const unsigned ww[4] = {yq[s9].x, yq[s9].y, yq[s9].z, yq[s9].w};
#pragma unroll
            for (int q = 0; q < 4; ++q) { const f32x2_n lo = __builtin_amdgcn_cvt_pk_f32_fp8((int)ww[q], false), hi = __builtin_amdgcn_cvt_pk_f32_fp8((int)ww[q], true);
                f[4 * q] += lo[0]; f[4 * q + 1] += lo[1]; f[4 * q + 2] += hi[0]; f[4 * q + 3] += hi[1]; }
        }
        float4 hc[4];
        hc[0] = make_float4(bflo(hq[0].x), bfhi(hq[0].x), bflo(hq[0].y), bfhi(hq[0].y)); hc[1] = make_float4(bflo(hq[0].z), bfhi(hq[0].z), bflo(hq[0].w), bfhi(hq[0].w));
        hc[2] = make_float4(bflo(hq[1].x), bfhi(hq[1].x), bflo(hq[1].y), bfhi(hq[1].y)); hc[3] = make_float4(bflo(hq[1].z), bfhi(hq[1].z), bflo(hq[1].w), bfhi(hq[1].w));
#pragma unroll
        for (int q = 0; q < 4; ++q) asm volatile("" : "+v"(hc[q].x), "+v"(hc[q].y), "+v"(hc[q].z), "+v"(hc[q].w), "+v"(f[4 * q]), "+v"(f[4 * q + 1]), "+v"(f[4 * q + 2]), "+v"(f[4 * q + 3]) :: "memory");
        preload(k + 1 < tpw ? tok + 1 : tok);
        float x[16]; float sum = 0.f;
#pragma unroll
        for (int q = 0; q < 4; ++q) {
            const float4 hv = hc[q], gv = cg[q];
            x[4 * q] = ALPHA * hv.x + gv.x * f[4 * q]; x[4 * q + 1] = ALPHA * hv.y + gv.y * f[4 * q + 1]; x[4 * q + 2] = ALPHA * hv.z + gv.z * f[4 * q + 2]; x[4 * q + 3] = ALPHA * hv.w + gv.w * f[4 * q + 3];
            sum += x[4 * q] + x[4 * q + 1] + x[4 * q + 2] + x[4 * q + 3];
        }
        const float mean = wave_sum(sum) * (1.f / 1024.f);
        float q2 = 0.f;
#pragma unroll
        for (int i = 0; i < 16; ++i) { x[i] -= mean; q2 += x[i] * x[i]; }
        const float rs = rsqrtf(wave_sum(q2) * (1.f / 1024.f) + LN_EPS);
        float u16[16]; unsigned yb[8];
#pragma unroll
        for (int q = 0; q < 4; ++q) {
            const int c = cA + (q >> 1) * 128 + (q & 1) * 4;
            const float4 w4 = cw[q], b4 = cb[q];
            float4 y; y.x = x[4 * q] * rs * w4.x + b4.x; y.y = x[4 * q + 1] * rs * w4.y + b4.y; y.z = x[4 * q + 2] * rs * w4.z + b4.z; y.w = x[4 * q + 3] * rs * w4.w + b4.w;
            if (NEXT) { yb[2 * q] = cvt_pk_bf16(y.x, y.y); yb[2 * q + 1] = cvt_pk_bf16(y.z, y.w); }
            else *(float4*)(p->out + (size_t)tok * DM + c) = y;
            if (NEXT) {
                const float4 sh = csh[q], sc = csc[q];
                u16[4 * q] = y.x * (1.f + sc.x) + sh.x; u16[4 * q + 1] = y.y * (1.f + sc.y) + sh.y; u16[4 * q + 2] = y.z * (1.f + sc.z) + sh.z; u16[4 * q + 3] = y.w * (1.f + sc.w) + sh.w;
            }
        }
        if (NEXT) {
            *(uint4*)(h + cA) = make_uint4(yb[0], yb[1], yb[2], yb[3]); *(uint4*)(h + cA + 128) = make_uint4(yb[4], yb[5], yb[6], yb[7]);
            *(uint4*)(U + (size_t)tok * DM + cA) = make_uint4(cvt_pk_bf16(u16[0], u16[1]), cvt_pk_bf16(u16[2], u16[3]), cvt_pk_bf16(u16[4], u16[5]), cvt_pk_bf16(u16[6], u16[7]));
            *(uint4*)(U + (size_t)tok * DM + cA + 128) = make_uint4(cvt_pk_bf16(u16[8], u16[9]), cvt_pk_bf16(u16[10], u16[11]), cvt_pk_bf16(u16[12], u16[13]), cvt_pk_bf16(u16[14], u16[15]));
        }
        if (gates) {
            float ga[16];
#pragma unroll
            for (int j = 0; j < 16; ++j) ga[j] = 0.f;
#pragma unroll
            for (int g4 = 0; g4 < 4; ++g4) {
                const int c = cA + (g4 >> 1) * 128 + (g4 & 1) * 4;
#pragma unroll
                for (int qq = 0; qq < 4; ++qq) {
                    const float uv = u16[4 * g4 + qq];
#pragma unroll
                    for (int j4 = 0; j4 < 4; ++j4) { const f32x4_l w = *(const LAS f32x4_l*)(wl + (c + qq) * 16 + j4 * 4); ga[4 * j4] += uv * w[0]; ga[4 * j4 + 1] += uv * w[1]; ga[4 * j4 + 2] += uv * w[2]; ga[4 * j4 + 3] += uv * w[3]; }
                }
                __builtin_amdgcn_sched_barrier(0);
            }
            float mine = 0.f;
#pragma unroll
            for (int j = 0; j < 16; ++j) { const float sg = wave_sum(ga[j]); if (lane == j) mine = sg; }
            if (lane < 16) G[(size_t)tok * 16 + lane] = mine;
        }
    }
}

#define MEGA_LDS (131072 + 256 + 20480)
#define NBLK 256
#define BAR_LDS BAR_LDS_
#define SYNC() do { XcdBarrier _b; _b.bar = (unsigned*)kparams()->ws; _b.x = xb_xcc_id(); _b.st = (volatile LAS unsigned*)((LAS unsigned char*)smraw_base() + BAR_LDS); xcd_barrier(_b); } while (0)
template <int PAR>
__device__ __forceinline__ void layer_fwd(const int l) {
    LAS unsigned char* lds = smraw_base(); float* sm = (float*)smraw_generic();
    const int bid = blockIdx.x; constexpr int nb = NBLK;
    const int ntok = (l == 3) ? NL : NT;
    ph_gemm_in(kparams(), l, bid, nb, lds); SYNC();
    if (PAR == 0) {
        ph_scan_even2(kparams(), l, bid, nb, sm); SYNC();
        ph_normgate_even(kparams(), l, bid, nb); SYNC();
    } else {
        ph_hy_prep(kparams(), l, bid, nb, sm); SYNC();
        ph_mix_odd(kparams(), l, bid, nb, sm); SYNC();
        ph_hy_norm(kparams(), l, bid, nb, sm); ph_normgate_odd(kparams(), l, bid, nb); SYNC();
    }
    ph_gemm_out(kparams(), l, bid, nb, lds); SYNC();
    ph_ln1_router(kparams(), l, ntok, bid, nb, sm); SYNC();
    ph_scatter(kparams(), l, ntok, bid, nb, lds); SYNC();
    ph_moe1(kparams(), l, ntok, bid, nb, lds); SYNC();
    ph_moe2(kparams(), l, ntok, bid, nb, lds); SYNC();
    if (l < 3) { ph_combine_ln2<true>(kparams(), l, ntok, bid, nb); ph_convert(kparams(), l + 1, bid, nb, sm, PAR == 0 ? 2 : 0); SYNC(); }
    else ph_combine_ln2<false>(kparams(), l, ntok, bid, nb);
}
__global__ void __launch_bounds__(512, 2) mega_fwd(Params p) {
    LAS unsigned char* lds = smraw_base(); float* sm = (float*)smraw_generic();
    {
        const int t0 = threadIdx.x;
        if ((t0 & 63) == 0) { unsigned h; asm volatile("s_getreg_b32 %0, hwreg(HW_REG_HW_ID, 0, 6)" : "=s"(h)); *(LAS int*)(size_t)(WTAB_LDS + (h & 63u) * 4u) = t0 >> 6; }
        if (t0 < 4) ((LAS unsigned*)(lds + BAR_LDS))[t0] = 0u;
    }
    __syncthreads();
    (void)xcd_barrier_post((unsigned*)kparams()->ws, (volatile LAS unsigned*)(lds + BAR_LDS));
    const int bid = blockIdx.x; constexpr int nb = NBLK;
    ph_prologue(kparams(), bid, nb, sm);
    __syncthreads();
    ph_convert(kparams(), 0, bid, nb, sm);
    SYNC();
    ph_modin<true>(kparams(), 0, bid, nb); SYNC();
#pragma unroll 1
    for (int lp = 0; lp < 2; ++lp) {
        layer_fwd<0>(2 * lp);
        layer_fwd<1>(2 * lp + 1);
    }
    __syncthreads();
    if (blockIdx.x == 0 && opaque_tid() == 0 && xb_ld((unsigned*)kparams()->ws + XB_TMO) != 0u) kparams()->out[0] = __builtin_nanf("");
}

extern "C" void kernel_launch(void* const* d_in, const int* in_sizes, int n_in, void* d_out, int out_size, void* d_ws, size_t ws_size, hipStream_t stream) {
    static int grid = 0;
    if (grid == 0) {
        if (n_in != 38 || out_size != NL * DM || ws_size < WS_END) { fprintf(stderr, "kernel_launch: bad shapes n_in %d out %d ws %zu (need %zu)\n", n_in, out_size, ws_size, (size_t)WS_END); grid = -1; return; }
        int dev = 0, cus = 0, per_cu = 0;
        if (hipGetDevice(&dev) != hipSuccess || hipDeviceGetAttribute(&cus, hipDeviceAttributeMultiprocessorCount, dev) != hipSuccess) { grid = -1; return; }
        if (hipFuncSetAttribute((const void*)mega_fwd, hipFuncAttributeMaxDynamicSharedMemorySize, MEGA_LDS) != hipSuccess) { fprintf(stderr, "kernel_launch: hipFuncSetAttribute failed\n"); grid = -1; return; }
        if (hipOccupancyMaxActiveBlocksPerMultiprocessor(&per_cu, (const void*)mega_fwd, 512, MEGA_LDS) != hipSuccess || per_cu < 1) { fprintf(stderr, "kernel_launch: occupancy query says %d\n", per_cu); (void)hipGetLastError(); grid = -1; return; }
        if (cus != 256) { fprintf(stderr, "kernel_launch: built for 256 CUs, found %d\n", cus); grid = -1; return; }
        grid = NBLK;
    }
    if (grid < 0) return;
    if (hipMemsetAsync(d_ws, 0, OFF_LB, stream) != hipSuccess) return;
    Params p{};
    for (int i = 0; i < 38; ++i) p.in[i] = (const float*)d_in[i];
    p.out = (float*)d_out; p.ws = (unsigned char*)d_ws;
    hipLaunchKernelGGL(mega_fwd, dim3(grid), dim3(512), MEGA_LDS, stream, p);
}
```
